# Optimizing an MI355X kernel written in HIP

```python
import math
import jax
import jax.numpy as jnp
from jax import lax
import numpy as np

D_MODEL = 1024
BATCH = 2
SEQ = 8192
DEPTH = 2

S5_GROUPS = 32
S5_GROUP_CH = 16
S5_STATE = 64
S5_WIDTH = S5_GROUPS * S5_GROUP_CH
S5_DT_MIN = 1e-3
S5_DT_MAX = 1e-1

NSA_HEADS = 8
NSA_KV_GROUPS = 2
NSA_HPG = NSA_HEADS // NSA_KV_GROUPS
NSA_HEAD_DIM = 64
NSA_WIDTH = NSA_HEADS * NSA_HEAD_DIM
NSA_KV_WIDTH = NSA_KV_GROUPS * NSA_HEAD_DIM
NSA_ROT_DIM = NSA_HEAD_DIM // 4
ROPE_THETA = 500000.0
CMP_BLOCK = 32
CMP_STRIDE = 16
CMP_HIDDEN = 128
SLC_BLOCK = 64
N_SLC = 16
WINDOW = 512
Q_BLOCK = 128
SLC_PER_STRIDE = SLC_BLOCK // CMP_STRIDE
CMP_SPAN = CMP_BLOCK // CMP_STRIDE
FORCE_SCORE = 1e6
MASK_VALUE = -1e30

RWKV_HEADS = 8
RWKV_HEAD_DIM = 64
RWKV_WIDTH = RWKV_HEADS * RWKV_HEAD_DIM
RWKV_LORA_W = 64
RWKV_LORA_A = 64
RWKV_LORA_G = 128
RWKV_COLS = 3 * RWKV_WIDTH + RWKV_LORA_W + RWKV_LORA_A + RWKV_LORA_G
RWKV_GN_EPS = 64e-5

RET_HEADS = 4
RET_DK = 64
RET_DV = 128
RET_QK_WIDTH = RET_HEADS * RET_DK
RET_V_WIDTH = RET_HEADS * RET_DV
RET_CHUNK = 128
RET_THETA = 10000.0
RET_GN_EPS = 1e-5

N_EXPERTS = 64
TOP_K = 8
EXPERT_FF = 256
N_EXPERT_GROUPS = 8
EXPERTS_PER_GROUP = N_EXPERTS // N_EXPERT_GROUPS
TOPK_GROUPS = 4
ROUTED_SCALE = 2.5
EXPERT_BLOCK = 128

MIX_WIDTH = S5_WIDTH + NSA_WIDTH
AB_COLS = (S5_WIDTH, NSA_WIDTH) + (NSA_KV_WIDTH,) * 6 + (3 * NSA_HEADS,)
CD_COLS = (RWKV_COLS, RET_QK_WIDTH, RET_QK_WIDTH, RET_V_WIDTH, RET_V_WIDTH)
AB_IN = sum(AB_COLS)
CD_IN = sum(CD_COLS)
N_EVEN = (DEPTH + 1) // 2
N_ODD = DEPTH // 2
ALPHA = (2 * DEPTH) ** 0.25
BETA = (8 * DEPTH) ** -0.25
LN_EPS = 1e-5

kernel_name = 'hybrid_s5_nsa_rwkv7_retention_moe'


def split_cols(h, sizes):
    return jnp.split(h, np.cumsum(sizes)[:-1].tolist(), axis=-1)


def layer_norm(x, g, b):
    xf = x.astype(jnp.float32)
    mu = xf.mean(-1, keepdims=True)
    var = jnp.square(xf - mu).mean(-1, keepdims=True)
    return ((xf - mu) * lax.rsqrt(var + LN_EPS) * g + b).astype(x.dtype)


def head_group_norm(y, g, b, eps):
    mu = y.mean(-1, keepdims=True)
    var = jnp.square(y - mu).mean(-1, keepdims=True)
    yn = (y - mu) * lax.rsqrt(var + eps)
    return yn.reshape(y.shape[0], y.shape[1], -1) * g + b


def rope(x, pos, rot_dim, theta):
    half = rot_dim // 2
    inv_freq = theta ** (-jnp.arange(half, dtype=jnp.float32) / half)
    ang = pos.astype(jnp.float32)[:, None] * inv_freq[None, :]
    cos = jnp.cos(ang)[:, None, :]
    sin = jnp.sin(ang)[:, None, :]
    x1 = x[..., :half]
    x2 = x[..., half:rot_dim]
    return jnp.concatenate([x1 * cos - x2 * sin, x2 * cos + x1 * sin, x[..., rot_dim:]], axis=-1)


def masked_softmax(s, mask):
    p = jax.nn.softmax(jnp.where(mask, s, MASK_VALUE), axis=-1)
    return jnp.where(mask, p, 0.0)


def swiglu(x, w1, w3, w2):
    return (jax.nn.silu(x @ w1) * (x @ w3)) @ w2


def s5_mixer(u, lam_re, lam_im, log_dt, b_re, b_im, c_re, c_im, d_skip, w_glu, b_glu):
    bsz, seq, _ = u.shape
    ug = u.reshape(bsz, seq, S5_GROUPS, S5_GROUP_CH)
    dt = jnp.exp(log_dt.astype(jnp.float32))[:, None]
    lam_re = lam_re.astype(jnp.float32)
    lam_im = lam_im.astype(jnp.float32)
    mag = jnp.exp(lam_re * dt)
    lb_re = mag * jnp.cos(lam_im * dt)
    lb_im = mag * jnp.sin(lam_im * dt)
    den = lam_re ** 2 + lam_im ** 2
    f_re = ((lb_re - 1.0) * lam_re + lb_im * lam_im) / den
    f_im = (lb_im * lam_re - (lb_re - 1.0) * lam_im) / den
    bb_re = f_re[..., None] * b_re - f_im[..., None] * b_im
    bb_im = f_re[..., None] * b_im + f_im[..., None] * b_re
    drive_re = jnp.einsum('blgh,gph->lbgp', ug, bb_re)
    drive_im = jnp.einsum('blgh,gph->lbgp', ug, bb_im)
    a_re = jnp.broadcast_to(lb_re, (seq, 1) + lb_re.shape)
    a_im = jnp.broadcast_to(lb_im, (seq, 1) + lb_im.shape)

    def combine(e1, e2):
        a1r, a1i, s1r, s1i = e1
        a2r, a2i, s2r, s2i = e2
        return (a2r * a1r - a2i * a1i,
                a2r * a1i + a2i * a1r,
                a2r * s1r - a2i * s1i + s2r,
                a2r * s1i + a2i * s1r + s2i)

    _, _, s_re, s_im = lax.associative_scan(combine, (a_re, a_im, drive_re, drive_im), axis=0)
    y = jnp.einsum('lbgp,ghp->blgh', s_re, c_re) - jnp.einsum('lbgp,ghp->blgh', s_im, c_im)
    y = y.reshape(bsz, seq, S5_WIDTH) + d_skip * u
    y = jax.nn.gelu(y)
    return y * jax.nn.sigmoid(y @ w_glu + b_glu)


def compress_blocks(kv, cmp_idx, pe, w1, b1, w2):
    blocks = kv[:, cmp_idx] + pe[None, None, :, None, :]
    bsz, n_cmp, cb, grp, d = blocks.shape
    flat = jnp.transpose(blocks, (0, 1, 3, 2, 4)).reshape(bsz, n_cmp, grp, cb * d)
    return jax.nn.gelu(flat @ w1 + b1) @ w2


def nsa_mixer(q, kc, vc, ks, vs, kw, vw, gates, pe_k, pe_v, ck_w1, ck_b1, ck_w2, cv_w1, cv_b1, cv_w2):
    bsz, seq = q.shape[:2]
    pos = jnp.arange(seq)
    q = rope(q, pos, NSA_ROT_DIM, ROPE_THETA)
    ks = rope(ks, pos, NSA_ROT_DIM, ROPE_THETA)
    kw = rope(kw, pos, NSA_ROT_DIM, ROPE_THETA)
    n_cmp = (seq - CMP_BLOCK) // CMP_STRIDE + 1
    cmp_idx = jnp.arange(n_cmp)[:, None] * CMP_STRIDE + jnp.arange(CMP_BLOCK)[None, :]
    cmp_end = cmp_idx[:, -1]
    k_cmp = rope(compress_blocks(kc, cmp_idx, pe_k, ck_w1, ck_b1, ck_w2), cmp_end, NSA_ROT_DIM, ROPE_THETA)
    v_cmp = compress_blocks(vc, cmp_idx, pe_v, cv_w1, cv_b1, cv_w2)
    n_blk = seq // SLC_BLOCK
    n_sel = min(N_SLC, n_blk)
    ks_blk = jnp.transpose(ks.reshape(bsz, n_blk, SLC_BLOCK, NSA_KV_GROUPS, NSA_HEAD_DIM), (0, 3, 1, 2, 4))
    vs_blk = jnp.transpose(vs.reshape(bsz, n_blk, SLC_BLOCK, NSA_KV_GROUPS, NSA_HEAD_DIM), (0, 3, 1, 2, 4))
    kw_pad = jnp.pad(kw, ((0, 0), (WINDOW, 0), (0, 0), (0, 0)))
    vw_pad = jnp.pad(vw, ((0, 0), (WINDOW, 0), (0, 0), (0, 0)))
    gates = jax.nn.sigmoid(gates).reshape(bsz, seq, NSA_KV_GROUPS, NSA_HPG, 3)
    scale = NSA_HEAD_DIM ** -0.5
    b_idx = jnp.arange(bsz)[:, None, None, None]
    g_idx = jnp.arange(NSA_KV_GROUPS)[None, :, None, None]
    blk = jnp.arange(n_blk)

    def query_block(q0):
        tpos = q0 + jnp.arange(Q_BLOCK)
        qb = lax.dynamic_slice_in_dim(q, q0, Q_BLOCK, axis=1).reshape(
            bsz, Q_BLOCK, NSA_KV_GROUPS, NSA_HPG, NSA_HEAD_DIM)
        gb = lax.dynamic_slice_in_dim(gates, q0, Q_BLOCK, axis=1)
        s = jnp.einsum('bqghd,bngd->bghqn', qb, k_cmp).astype(jnp.float32) * scale
        p_cmp = masked_softmax(s, cmp_end[None, :] <= tpos[:, None])
        o_cmp = jnp.einsum('bghqn,bngd->bqghd', p_cmp, v_cmp)
        imp = p_cmp.sum(axis=2)
        imp = jnp.pad(imp, ((0, 0), (0, 0), (0, 0), (CMP_SPAN - 1, SLC_PER_STRIDE * n_blk - n_cmp)))
        imp_slc = sum(imp[..., m + n: m + n + SLC_PER_STRIDE * n_blk: SLC_PER_STRIDE]
                      for m in range(SLC_PER_STRIDE) for n in range(CMP_SPAN))
        cur = tpos // SLC_BLOCK
        forced = (blk[None, :] == 0) | (blk[None, :] == cur[:, None]) | (blk[None, :] == cur[:, None] - 1)
        score = jnp.where(forced, FORCE_SCORE, imp_slc)
        score = jnp.where(blk[None, :] * SLC_BLOCK <= tpos[:, None], score, -FORCE_SCORE)
        _, sel = lax.top_k(score, n_sel)
        k_sel = ks_blk[b_idx, g_idx, sel]
        v_sel = vs_blk[b_idx, g_idx, sel]
        tok = sel[..., None] * SLC_BLOCK + jnp.arange(SLC_BLOCK)
        m_sel = (tok <= tpos[None, None, :, None, None]).reshape(bsz, NSA_KV_GROUPS, 1, Q_BLOCK, -1)
        s = jnp.einsum('bqghd,bgqnkd->bghqnk', qb, k_sel).astype(jnp.float32) * scale
        p = masked_softmax(s.reshape(bsz, NSA_KV_GROUPS, NSA_HPG, Q_BLOCK, -1), m_sel)
        o_slc = jnp.einsum('bghqk,bgqkd->bqghd', p,
                           v_sel.reshape(bsz, NSA_KV_GROUPS, Q_BLOCK, -1, NSA_HEAD_DIM))
        kwb = lax.dynamic_slice_in_dim(kw_pad, q0, WINDOW + Q_BLOCK, axis=1)
        vwb = lax.dynamic_slice_in_dim(vw_pad, q0, WINDOW + Q_BLOCK, axis=1)
        kpos = q0 - WINDOW + jnp.arange(WINDOW + Q_BLOCK)
        m_win = ((kpos[None, :] <= tpos[:, None]) & (kpos[None, :] > tpos[:, None] - WINDOW)
                 & (kpos[None, :] >= 0))
        s = jnp.einsum('bqghd,bkgd->bghqk', qb, kwb).astype(jnp.float32) * scale
        o_win = jnp.einsum('bghqk,bkgd->bqghd', masked_softmax(s, m_win), vwb)
        o = gb[..., 0:1] * o_cmp + gb[..., 1:2] * o_slc + gb[..., 2:3] * o_win
        return o.reshape(bsz, Q_BLOCK, NSA_WIDTH)

    out = lax.map(query_block, jnp.arange(seq // Q_BLOCK) * Q_BLOCK)
    return jnp.transpose(out, (1, 0, 2, 3)).reshape(bsz, seq, NSA_WIDTH)


def rwkv7_mixer(p, mu, w0, w_up, a0, a_up, g_up, k_k, k_a, r_k, ln_g, ln_b):
    bsz, seq, _ = p.shape
    p_prev = jnp.pad(p, ((0, 0), (1, 0), (0, 0)))[:, :-1]
    p = p + (p_prev - p) * mu
    r, k, v, w_lo, a_lo, g_lo = split_cols(
        p, (RWKV_WIDTH,) * 3 + (RWKV_LORA_W, RWKV_LORA_A, RWKV_LORA_G))
    w = -jax.nn.softplus(-(w0 + jnp.tanh(w_lo) @ w_up)) - 0.5
    decay = jnp.exp(-jnp.exp(w))
    a = jax.nn.sigmoid(a0 + a_lo @ a_up)
    g = jax.nn.sigmoid(g_lo) @ g_up

    def heads(t):
        return t.reshape(bsz, seq, RWKV_HEADS, RWKV_HEAD_DIM)

    kk = heads(k * k_k)
    kk = kk / jnp.maximum(jnp.linalg.norm(kk, axis=-1, keepdims=True), 1e-12)
    k = k * (1.0 + (a - 1.0) * k_a)
    r_h, k_h, v_h, w_h, a_h = heads(r), heads(k), heads(v), heads(decay), heads(a)

    def step(state, inp):
        r_t, w_t, k_t, v_t, kk_t, a_t = inp
        sa = jnp.einsum('bhij,bhj->bhi', state, -kk_t)
        state = (state * w_t[:, :, None, :] + sa[..., None] * (kk_t * a_t)[:, :, None, :]
                 + v_t[..., None] * k_t[:, :, None, :])
        return state, jnp.einsum('bhij,bhj->bhi', state, r_t)

    def seq_major(t):
        return jnp.swapaxes(t, 0, 1)

    state0 = jnp.zeros((bsz, RWKV_HEADS, RWKV_HEAD_DIM, RWKV_HEAD_DIM), jnp.float32)
    _, y = lax.scan(step, state0, (seq_major(r_h), seq_major(w_h), seq_major(k_h),
                                   seq_major(v_h), seq_major(kk), seq_major(a_h)))
    y = head_group_norm(jnp.swapaxes(y, 0, 1), ln_g, ln_b, RWKV_GN_EPS)
    bonus = (r_h * k_h * r_k).sum(-1, keepdims=True) * v_h
    return (y + bonus.reshape(bsz, seq, RWKV_WIDTH)) * g


def retention_mixer(q, k, v, gate, ln_g, ln_b):
    bsz, seq = q.shape[:2]
    pos = jnp.arange(seq)
    q = rope(q, pos, RET_DK, RET_THETA)
    k = rope(k, pos, RET_DK, RET_THETA) * RET_DK ** -0.5
    n_chunk = seq // RET_CHUNK
    log_gamma = jnp.log(1.0 - 2.0 ** (-5.0 - jnp.arange(RET_HEADS, dtype=jnp.float32)))
    qc = q.reshape(bsz, n_chunk, RET_CHUNK, RET_HEADS, RET_DK)
    kc = k.reshape(bsz, n_chunk, RET_CHUNK, RET_HEADS, RET_DK)
    vc = v.reshape(bsz, n_chunk, RET_CHUNK, RET_HEADS, RET_DV)
    i = jnp.arange(RET_CHUNK, dtype=jnp.float32)
    diff = i[:, None] - i[None, :]
    decay_mat = jnp.where(diff >= 0, jnp.exp(diff[None] * log_gamma[:, None, None]), 0.0)
    scores = jnp.einsum('bnihd,bnjhd->bnhij', qc, kc) * decay_mat
    inner = jnp.einsum('bnhij,bnjhe->bnihe', scores, vc)
    k_dec = kc * jnp.exp((RET_CHUNK - 1.0 - i)[:, None] * log_gamma[None, :])[..., None]
    chunk_kv = jnp.einsum('bnjhd,bnjhe->bnhde', k_dec, vc)
    chunk_decay = jnp.exp(RET_CHUNK * log_gamma)[None, :, None, None]

    def chunk_step(state, kv_n):
        return state * chunk_decay + kv_n, state

    state0 = jnp.zeros((bsz, RET_HEADS, RET_DK, RET_DV), jnp.float32)
    _, prev_state = lax.scan(chunk_step, state0, jnp.swapaxes(chunk_kv, 0, 1))
    prev_state = jnp.swapaxes(prev_state, 0, 1)
    q_dec = qc * jnp.exp((i + 1.0)[:, None] * log_gamma[None, :])[..., None]
    cross = jnp.einsum('bnihd,bnhde->bnihe', q_dec, prev_state)
    y = (inner + cross).reshape(bsz, seq, RET_HEADS, RET_DV)
    y = head_group_norm(y, ln_g, ln_b, RET_GN_EPS)
    return jax.nn.silu(gate) * y


def hybrid_ab_mixer(x, w_in, w_out, lam_re, lam_im, log_dt, b_re, b_im, c_re, c_im, d_skip,
                    w_glu, b_glu, pe_k, pe_v, ck_w1, ck_b1, ck_w2, cv_w1, cv_b1, cv_w2):
    bsz, seq, _ = x.shape
    h = (x @ w_in).astype(jnp.float32)
    u, q, kc, vc, ks, vs, kw, vw, gates = split_cols(h, AB_COLS)

    def heads(t):
        return t.reshape(bsz, seq, -1, NSA_HEAD_DIM)

    y_a = s5_mixer(u, lam_re, lam_im, log_dt, b_re, b_im, c_re, c_im, d_skip, w_glu, b_glu)
    y_b = nsa_mixer(heads(q), heads(kc), heads(vc), heads(ks), heads(vs), heads(kw), heads(vw),
                    gates, pe_k, pe_v, ck_w1, ck_b1, ck_w2, cv_w1, cv_b1, cv_w2)
    return (jnp.concatenate([y_a, y_b], axis=-1) @ w_out).astype(x.dtype)


def hybrid_cd_mixer(x, w_in, w_out, mu, w0, w_up, a0, a_up, g_up, k_k, k_a, r_k,
                    rwkv_ln_g, rwkv_ln_b, ret_ln_g, ret_ln_b):
    bsz, seq, _ = x.shape
    h = (x @ w_in).astype(jnp.float32)
    c_in, rq, rk, rv, rgate = split_cols(h, CD_COLS)
    y_c = rwkv7_mixer(c_in, mu, w0, w_up, a0, a_up, g_up, k_k, k_a, r_k, rwkv_ln_g, rwkv_ln_b)
    y_d = retention_mixer(rq.reshape(bsz, seq, RET_HEADS, RET_DK),
                          rk.reshape(bsz, seq, RET_HEADS, RET_DK),
                          rv.reshape(bsz, seq, RET_HEADS, RET_DV), rgate, ret_ln_g, ret_ln_b)
    return (jnp.concatenate([y_c, y_d], axis=-1) @ w_out).astype(x.dtype)


def routed_experts(xf, idx, gate, w1, w3, w2):
    n_tok, d = xf.shape
    n_asg = n_tok * TOP_K
    flat_e = idx.reshape(-1)
    order = jnp.argsort(flat_e)
    e_sorted = flat_e[order]
    tok_sorted = (order // TOP_K).astype(jnp.int32)
    gate_sorted = gate.reshape(-1)[order]
    counts = jnp.bincount(flat_e, length=N_EXPERTS)
    padded = (counts + EXPERT_BLOCK - 1) // EXPERT_BLOCK * EXPERT_BLOCK
    pad_end = jnp.cumsum(padded)
    pad_start = pad_end - padded
    start = jnp.cumsum(counts) - counts
    dest = pad_start[e_sorted] + jnp.arange(n_asg) - start[e_sorted]
    n_blocks = -(-n_asg // EXPERT_BLOCK) + N_EXPERTS
    n_rows = n_blocks * EXPERT_BLOCK
    row_tok = jnp.full((n_rows,), n_tok, jnp.int32).at[dest].set(tok_sorted)
    row_gate = jnp.zeros((n_rows,), gate.dtype).at[dest].set(gate_sorted)
    block_expert = jnp.minimum(
        jnp.searchsorted(pad_end, jnp.arange(n_blocks) * EXPERT_BLOCK, side='right'), N_EXPERTS - 1)
    x_pad = jnp.concatenate([xf, jnp.zeros((1, d), xf.dtype)], axis=0)

    def expert_block(args):
        rows, g, e = args
        xb = x_pad[rows]
        h = jax.nn.silu(xb @ w1[e]) * (xb @ w3[e])
        return (h @ w2[e]) * g[:, None]

    y = lax.map(expert_block, (row_tok.reshape(n_blocks, EXPERT_BLOCK),
                               row_gate.reshape(n_blocks, EXPERT_BLOCK), block_expert))
    return jax.ops.segment_sum(y.reshape(n_rows, d), row_tok, num_segments=n_tok + 1)[:n_tok]


def moe_ffn(x, router, bias, w1, w3, w2, sw1, sw3, sw2):
    bsz, seq, d = x.shape
    xf = x.reshape(bsz * seq, d)
    n_tok = xf.shape[0]
    scores = jax.nn.sigmoid((xf @ router).astype(jnp.float32))
    biased = scores + bias
    grp = biased.reshape(n_tok, N_EXPERT_GROUPS, EXPERTS_PER_GROUP)
    grp_score = lax.top_k(grp, 2)[0].sum(-1)
    _, top_grp = lax.top_k(grp_score, TOPK_GROUPS)
    grp_keep = jax.nn.one_hot(top_grp, N_EXPERT_GROUPS, dtype=jnp.float32).sum(1) > 0
    keep = jnp.repeat(grp_keep, EXPERTS_PER_GROUP, axis=1)
    _, idx = lax.top_k(jnp.where(keep, biased, -jnp.inf), TOP_K)
    gate = jnp.take_along_axis(scores, idx, axis=1)
    gate = gate / gate.sum(-1, keepdims=True) * ROUTED_SCALE
    routed = routed_experts(xf, idx, gate, w1, w3, w2)
    shared = swiglu(xf, sw1, sw3, sw2)
    return (routed + shared).reshape(bsz, seq, d).astype(x.dtype)


def setup_inputs(seed: int = 0) -> dict:
    key = jax.random.key(seed)
    keys = iter(jax.random.split(key, 64))

    def nrm(shape, scale):
        return scale * jax.random.normal(next(keys), shape, jnp.float32)

    def unif(shape, lo, hi):
        return jax.random.uniform(next(keys), shape, jnp.float32, lo, hi)

    ne, no, nl = N_EVEN, N_ODD, DEPTH
    n_idx = jnp.arange(S5_STATE, dtype=jnp.float32)
    gps = (S5_GROUPS, S5_STATE)
    return {
        'x': nrm((BATCH, SEQ, D_MODEL), 1.0),
        'ab_w_in': nrm((ne, D_MODEL, AB_IN), D_MODEL ** -0.5),
        'ab_w_out': nrm((ne, MIX_WIDTH, D_MODEL), BETA * MIX_WIDTH ** -0.5),
        's5_lam_re': -0.5 + nrm((ne,) + gps, 0.01),
        's5_lam_im': math.pi * n_idx + nrm((ne,) + gps, 0.01),
        's5_log_dt': unif((ne, S5_GROUPS), math.log(S5_DT_MIN), math.log(S5_DT_MAX)),
        's5_b_re': nrm((ne, S5_GROUPS, S5_STATE, S5_GROUP_CH), (2 * S5_GROUP_CH) ** -0.5),
        's5_b_im': nrm((ne, S5_GROUPS, S5_STATE, S5_GROUP_CH), (2 * S5_GROUP_CH) ** -0.5),
        's5_c_re': nrm((ne, S5_GROUPS, S5_GROUP_CH, S5_STATE), (2 * S5_STATE) ** -0.5),
        's5_c_im': nrm((ne, S5_GROUPS, S5_GROUP_CH, S5_STATE), (2 * S5_STATE) ** -0.5),
        's5_d': nrm((ne, S5_WIDTH), 1.0),
        's5_w_glu': nrm((ne, S5_WIDTH, S5_WIDTH), S5_WIDTH ** -0.5),
        's5_b_glu': nrm((ne, S5_WIDTH), 0.01),
        'nsa_pe_k': nrm((ne, CMP_BLOCK, NSA_HEAD_DIM), 0.1),
        'nsa_pe_v': nrm((ne, CMP_BLOCK, NSA_HEAD_DIM), 0.1),
        'nsa_ck_w1': nrm((ne, CMP_BLOCK * NSA_HEAD_DIM, CMP_HIDDEN), (CMP_BLOCK * NSA_HEAD_DIM) ** -0.5),
        'nsa_ck_b1': nrm((ne, CMP_HIDDEN), 0.01),
        'nsa_ck_w2': nrm((ne, CMP_HIDDEN, NSA_HEAD_DIM), CMP_HIDDEN ** -0.5),
        'nsa_cv_w1': nrm((ne, CMP_BLOCK * NSA_HEAD_DIM, CMP_HIDDEN), (CMP_BLOCK * NSA_HEAD_DIM) ** -0.5),
        'nsa_cv_b1': nrm((ne, CMP_HIDDEN), 0.01),
        'nsa_cv_w2': nrm((ne, CMP_HIDDEN, NSA_HEAD_DIM), CMP_HIDDEN ** -0.5),
        'cd_w_in': nrm((no, D_MODEL, CD_IN), D_MODEL ** -0.5),
        'cd_w_out': nrm((no, MIX_WIDTH, D_MODEL), BETA * MIX_WIDTH ** -0.5),
        'rwkv_mu': unif((no, RWKV_COLS), 0.0, 1.0),
        'rwkv_w0': unif((no, RWKV_WIDTH), -6.0, -1.0),
        'rwkv_w_up': nrm((no, RWKV_LORA_W, RWKV_WIDTH), 0.1 * RWKV_LORA_W ** -0.5),
        'rwkv_a0': nrm((no, RWKV_WIDTH), 0.1),
        'rwkv_a_up': nrm((no, RWKV_LORA_A, RWKV_WIDTH), RWKV_LORA_A ** -0.5),
        'rwkv_g_up': nrm((no, RWKV_LORA_G, RWKV_WIDTH), RWKV_LORA_G ** -0.5),
        'rwkv_k_k': 0.85 + nrm((no, RWKV_WIDTH), 0.05),
        'rwkv_k_a': 1.0 + nrm((no, RWKV_WIDTH), 0.05),
        'rwkv_r_k': nrm((no, RWKV_HEADS, RWKV_HEAD_DIM), 0.1),
        'rwkv_ln_g': 1.0 + nrm((no, RWKV_WIDTH), 0.05),
        'rwkv_ln_b': nrm((no, RWKV_WIDTH), 0.01),
        'ret_ln_g': 1.0 + nrm((no, RET_V_WIDTH), 0.05),
        'ret_ln_b': nrm((no, RET_V_WIDTH), 0.01),
        'ln1_g': 1.0 + nrm((nl, D_MODEL), 0.05),
        'ln1_b': nrm((nl, D_MODEL), 0.01),
        'ln2_g': 1.0 + nrm((nl, D_MODEL), 0.05),
        'ln2_b': nrm((nl, D_MODEL), 0.01),
        'moe_router': nrm((nl, D_MODEL, N_EXPERTS), D_MODEL ** -0.5),
        'moe_bias': nrm((nl, N_EXPERTS), 0.01),
        'moe_w1': nrm((nl, N_EXPERTS, D_MODEL, EXPERT_FF), D_MODEL ** -0.5),
        'moe_w3': nrm((nl, N_EXPERTS, D_MODEL, EXPERT_FF), D_MODEL ** -0.5),
        'moe_w2': nrm((nl, N_EXPERTS, EXPERT_FF, D_MODEL), BETA * EXPERT_FF ** -0.5),
        'sh_w1': nrm((nl, D_MODEL, EXPERT_FF), D_MODEL ** -0.5),
        'sh_w3': nrm((nl, D_MODEL, EXPERT_FF), D_MODEL ** -0.5),
        'sh_w2': nrm((nl, EXPERT_FF, D_MODEL), BETA * EXPERT_FF ** -0.5),
    }


def reference(x, ab_w_in, ab_w_out, s5_lam_re, s5_lam_im, s5_log_dt, s5_b_re, s5_b_im, s5_c_re,
              s5_c_im, s5_d, s5_w_glu, s5_b_glu, nsa_pe_k, nsa_pe_v, nsa_ck_w1, nsa_ck_b1, nsa_ck_w2,
              nsa_cv_w1, nsa_cv_b1, nsa_cv_w2, cd_w_in, cd_w_out, rwkv_mu, rwkv_w0, rwkv_w_up,
              rwkv_a0, rwkv_a_up, rwkv_g_up, rwkv_k_k, rwkv_k_a, rwkv_r_k, rwkv_ln_g, rwkv_ln_b,
              ret_ln_g, ret_ln_b, ln1_g, ln1_b, ln2_g, ln2_b, moe_router, moe_bias, moe_w1, moe_w3,
              moe_w2, sh_w1, sh_w3, sh_w2):
    for layer in range(DEPTH):
        i = layer // 2
        if layer % 2 == 0:
            mix = hybrid_ab_mixer(x, ab_w_in[i], ab_w_out[i], s5_lam_re[i], s5_lam_im[i], s5_log_dt[i],
                                  s5_b_re[i], s5_b_im[i], s5_c_re[i], s5_c_im[i], s5_d[i],
                                  s5_w_glu[i], s5_b_glu[i], nsa_pe_k[i], nsa_pe_v[i], nsa_ck_w1[i],
                                  nsa_ck_b1[i], nsa_ck_w2[i], nsa_cv_w1[i], nsa_cv_b1[i], nsa_cv_w2[i])
        else:
            mix = hybrid_cd_mixer(x, cd_w_in[i], cd_w_out[i], rwkv_mu[i], rwkv_w0[i], rwkv_w_up[i],
                                  rwkv_a0[i], rwkv_a_up[i], rwkv_g_up[i], rwkv_k_k[i], rwkv_k_a[i],
                                  rwkv_r_k[i], rwkv_ln_g[i], rwkv_ln_b[i], ret_ln_g[i], ret_ln_b[i])
        x = layer_norm(ALPHA * x + mix, ln1_g[layer], ln1_b[layer])
        ffn = moe_ffn(x, moe_router[layer], moe_bias[layer], moe_w1[layer], moe_w3[layer],
                      moe_w2[layer], sh_w1[layer], sh_w3[layer], sh_w2[layer])
        x = layer_norm(ALPHA * x + ffn, ln2_g[layer], ln2_b[layer])
    return x
```

```cpp
#ifdef CPU_EMU
#include "emu.h"
#else
#include <hip/hip_runtime.h>
#include <hip/hip_cooperative_groups.h>
#include <cstdio>
namespace cg = cooperative_groups;
#endif
#include <stdint.h>

#ifndef BATCH
#define BATCH 2
#endif
#ifndef SEQ_LEN
#define SEQ_LEN 8192
#endif
#ifndef MEGA
#define MEGA 0
#endif

#define DEV __device__ __forceinline__
#define NTOK (BATCH * SEQ_LEN)
#define DM 1024
#define AB_IN 1816
#define CD_IN 3328
#define NCMP ((SEQ_LEN - 32) / 16 + 1)
#define NBLK (SEQ_LEN / 64)
#define NB_CMP ((NCMP + 63) / 64)
#define S5_NC (SEQ_LEN / 64)
#define RET_NC (SEQ_LEN / 128)
#define ALPHA_F 1.4142135623730951f
#define NTHREADS 256

enum { I_X = 0, I_AB_W_IN, I_AB_W_OUT, I_S5_LAM_RE, I_S5_LAM_IM, I_S5_LOG_DT, I_S5_B_RE, I_S5_B_IM, I_S5_C_RE, I_S5_C_IM,
       I_S5_D, I_S5_W_GLU, I_S5_B_GLU, I_PE_K, I_PE_V, I_CK_W1, I_CK_B1, I_CK_W2, I_CV_W1, I_CV_B1, I_CV_W2,
       I_CD_W_IN, I_CD_W_OUT, I_RW_MU, I_RW_W0, I_RW_W_UP, I_RW_A0, I_RW_A_UP, I_RW_G_UP, I_RW_K_K, I_RW_K_A, I_RW_R_K,
       I_RW_LN_G, I_RW_LN_B, I_RET_LN_G, I_RET_LN_B, I_LN1_G, I_LN1_B, I_LN2_G, I_LN2_B, I_ROUTER, I_MOE_BIAS,
       I_MOE_W1, I_MOE_W3, I_MOE_W2, I_SH_W1, I_SH_W3, I_SH_W2, N_INPUTS };

struct Params {
  const float* in[N_INPUTS];
  float* out;
  char* ws;
};

#define MiB_TOK ((size_t)NTOK * 1024 * 4)
#define OFF_H 0
#define OFF_MIX ((size_t)NTOK * 3328 * 4)
#define OFF_X1 (OFF_MIX + MiB_TOK)
#define OFF_X2 (OFF_X1 + MiB_TOK)
#define OFF_R4 (OFF_X2 + MiB_TOK)
#define OFF_R5 (OFF_R4 + MiB_TOK)
#define OFF_Y OFF_H
#define OFF_HS (OFF_H + 4 * MiB_TOK)
#define OFF_FS OFF_X2
#define OFF_HR OFF_R4
#define OFF_TOPI (OFF_R5)
#define OFF_TOPG (OFF_TOPI + (size_t)NTOK * 8 * 4)
#define OFF_POSOF (OFF_TOPG + (size_t)NTOK * 8 * 4)
#define OFF_CNT (OFF_POSOF + (size_t)NTOK * 8 * 4)
#define OFF_LTOK (OFF_CNT + 1024)
#define OFF_LGATE (OFF_LTOK + (size_t)64 * NTOK * 4)
#define OFF_S5E (OFF_LGATE + (size_t)64 * NTOK * 4)
#define OFF_KCMP (OFF_S5E + (size_t)BATCH * S5_NC * 32 * 64 * 8)
#define OFF_VCMP (OFF_KCMP + (size_t)BATCH * NCMP * 2 * 64 * 4)
#define OFF_RETKV (OFF_VCMP + (size_t)BATCH * NCMP * 2 * 64 * 4)
#define OFF_END (OFF_RETKV + (size_t)BATCH * 4 * RET_NC * 64 * 128 * 4)
#define OFF_YGELU OFF_X1
#define OFF_RWW OFF_X1
#define OFF_RWK (OFF_X1 + (size_t)NTOK * 512 * 4)
#define OFF_RWKK OFF_R4
#define OFF_RWA (OFF_R4 + (size_t)NTOK * 512 * 4)

typedef short bf16x8 __attribute__((ext_vector_type(8)));
typedef float f32x16 __attribute__((ext_vector_type(16)));

#ifdef CPU_EMU
#define WAVE_SYNC() emu_wave_bar()
#else
#define WAVE_SYNC() __builtin_amdgcn_wave_barrier()
#endif

DEV float sigmoidf_(float x) { return 1.f / (1.f + __expf(-x)); }
DEV float siluf_(float x) { return x * sigmoidf_(x); }
DEV float geluf_(float x) { float u = 0.7978845608028654f * (x + 0.044715f * x * x * x); return 0.5f * x * (1.f + tanhf(u)); }
DEV unsigned short f2bf(float f) {
  unsigned u = __builtin_bit_cast(unsigned, f);
  u += 0x7FFFu + ((u >> 16) & 1u);
  return (unsigned short)(u >> 16);
}
DEV float bf2f(unsigned short h) { return __builtin_bit_cast(float, ((unsigned)h) << 16); }
DEV float wave_sum(float v) {
#pragma unroll
  for (int m = 32; m >= 1; m >>= 1) v += __shfl_xor(v, m);
  return v;
}
DEV float wave_max(float v) {
#pragma unroll
  for (int m = 32; m >= 1; m >>= 1) v = fmaxf(v, __shfl_xor(v, m));
  return v;
}
DEV float4 ld4(const float* p) { return *(const float4*)p; }
DEV void st4(float* p, float4 v) { *(float4*)p = v; }

#define GEMM_SMEM_BYTES (2 * 128 * 40 * 2)
template <bool ABF, class AROW, class BPTR, class EPI>
DEV void gemm_tile(AROW arow, BPTR bptr, int ldb, int K, EPI epi, char* smem_raw) {
  unsigned short(*sA)[40] = (unsigned short(*)[40])smem_raw;
  unsigned short(*sB)[40] = (unsigned short(*)[40])(smem_raw + 128 * 40 * 2);
  const int tid = threadIdx.x, lane = tid & 63, wave = tid >> 6;
  const int wm = wave >> 1, wn = wave & 1;
#if defined(CPU_EMU) && !defined(EMU_REAL_GEMM)
  for (int mi = 0; mi < 2; ++mi)
    for (int r = 0; r < 16; ++r) {
      const int row = wm * 64 + mi * 32 + (r & 3) + 8 * (r >> 2) + 4 * (lane >> 5);
      const int col = wn * 64 + (lane & 31);
      const void* arp = arow(row);
      float v[2] = {0.f, 0.f};
      for (int ni = 0; ni < 2; ++ni) {
        const float* bq = bptr(col + ni * 32);
        if (!arp || !bq) continue;
        float a = 0.f;
        for (int k = 0; k < K; ++k) {
          const float av = ABF ? bf2f(((const unsigned short*)arp)[k]) : bf2f(f2bf(((const float*)arp)[k]));
          a += av * bf2f(f2bf(bq[(size_t)k * ldb]));
        }
        v[ni] = a;
      }
      epi(row, col, v[0], v[1]);
    }
  return;
#endif
  const float* ap[4];
  const unsigned short* aph[2];
  if (ABF) {
#pragma unroll
    for (int i = 0; i < 2; ++i) aph[i] = (const unsigned short*)arow((tid >> 2) + 64 * i);
  } else {
#pragma unroll
    for (int i = 0; i < 4; ++i) ap[i] = (const float*)arow((tid >> 3) + 32 * i);
  }
  const float* bp = bptr(tid & 127);
  const int bkg = tid >> 7;
  float4 ra[4];
  uint4 rah[2];
  float rb[2][8];
  auto gload = [&](int k0) {
    if (ABF) {
#pragma unroll
      for (int i = 0; i < 2; ++i) rah[i] = aph[i] ? *(const uint4*)(aph[i] + k0 + (tid & 3) * 8) : make_uint4(0, 0, 0, 0);
    } else {
#pragma unroll
      for (int i = 0; i < 4; ++i) ra[i] = ap[i] ? ld4(ap[i] + k0 + (tid & 7) * 4) : make_float4(0.f, 0.f, 0.f, 0.f);
    }
#pragma unroll
    for (int i = 0; i < 2; ++i)
#pragma unroll
      for (int j = 0; j < 8; ++j) rb[i][j] = bp ? bp[(size_t)(k0 + (bkg + 2 * i) * 8 + j) * ldb] : 0.f;
  };
  auto sstore = [&]() {
    if (ABF) {
#pragma unroll
      for (int i = 0; i < 2; ++i) *(uint4*)&sA[(tid >> 2) + 64 * i][(tid & 3) * 8] = rah[i];
    } else {
#pragma unroll
      for (int i = 0; i < 4; ++i) {
        uint2 v;
        v.x = (unsigned)f2bf(ra[i].x) | ((unsigned)f2bf(ra[i].y) << 16);
        v.y = (unsigned)f2bf(ra[i].z) | ((unsigned)f2bf(ra[i].w) << 16);
        *(uint2*)&sA[(tid >> 3) + 32 * i][(tid & 7) * 4] = v;
      }
    }
#pragma unroll
    for (int i = 0; i < 2; ++i) {
      uint4 v;
      v.x = (unsigned)f2bf(rb[i][0]) | ((unsigned)f2bf(rb[i][1]) << 16);
      v.y = (unsigned)f2bf(rb[i][2]) | ((unsigned)f2bf(rb[i][3]) << 16);
      v.z = (unsigned)f2bf(rb[i][4]) | ((unsigned)f2bf(rb[i][5]) << 16);
      v.w = (unsigned)f2bf(rb[i][6]) | ((unsigned)f2bf(rb[i][7]) << 16);
      *(uint4*)&sB[tid & 127][(bkg + 2 * i) * 8] = v;
    }
  };
  f32x16 acc[2][2];
#pragma unroll
  for (int mi = 0; mi < 2; ++mi)
#pragma unroll
    for (int ni = 0; ni < 2; ++ni)
#pragma unroll
      for (int r = 0; r < 16; ++r) acc[mi][ni][r] = 0.f;
  gload(0);
  for (int k0 = 0; k0 < K; k0 += 32) {
    __syncthreads();
    sstore();
    __syncthreads();
    if (k0 + 32 < K) gload(k0 + 32);
#pragma unroll
    for (int ks = 0; ks < 2; ++ks) {
      bf16x8 af[2], bfr[2];
#pragma unroll
      for (int mi = 0; mi < 2; ++mi) af[mi] = *(const bf16x8*)&sA[wm * 64 + mi * 32 + (lane & 31)][ks * 16 + (lane >> 5) * 8];
#pragma unroll
      for (int ni = 0; ni < 2; ++ni) bfr[ni] = *(const bf16x8*)&sB[wn * 64 + ni * 32 + (lane & 31)][ks * 16 + (lane >> 5) * 8];
#pragma unroll
      for (int mi = 0; mi < 2; ++mi)
#pragma unroll
        for (int ni = 0; ni < 2; ++ni) acc[mi][ni] = __builtin_amdgcn_mfma_f32_32x32x16_bf16(af[mi], bfr[ni], acc[mi][ni], 0, 0, 0);
    }
  }
#pragma unroll
  for (int mi = 0; mi < 2; ++mi)
#pragma unroll
    for (int r = 0; r < 16; ++r) {
      int row = wm * 64 + mi * 32 + (r & 3) + 8 * (r >> 2) + 4 * (lane >> 5);
      int col = wn * 64 + (lane & 31);
      epi(row, col, acc[mi][0][r], acc[mi][1][r]);
    }
}

template <int LAYER>
DEV void phase_gemm_in(const Params& p, char* smem) {
  const int N = LAYER == 0 ? AB_IN : CD_IN;
  const float* A = LAYER == 0 ? p.in[I_X] : (const float*)(p.ws + OFF_X2);
  const float* B = LAYER == 0 ? p.in[I_AB_W_IN] : p.in[I_CD_W_IN];
  float* C = (float*)(p.ws + OFF_H);
  const int NT = (N + 127) / 128, MT = NTOK / 128;
  for (int it = blockIdx.x; it < MT * NT; it += gridDim.x) {
    const int tm = it / NT, tn = it % NT;
    const int m0 = tm * 128, n0 = tn * 128;
    gemm_tile<false>(
        [&](int r) { return (const void*)(A + (size_t)(m0 + r) * DM); },
        [&](int c) { return (n0 + c < N) ? (B + n0 + c) : (const float*)nullptr; }, N, DM,
        [&](int row, int col, float v0, float v1) {
          const int gm = m0 + row, gc = n0 + col;
          if (LAYER == 1 && gc >= 1792 && gc < 2304) {
            const int i = gc & 63;
            const float pos = (float)(gm % SEQ_LEN);
            const float inv = __expf(-(float)i * (9.210340371976184f / 32.f));
            float sn, cs;
            sincosf(pos * inv, &sn, &cs);
            float o0 = v0 * cs - v1 * sn, o1 = v1 * cs + v0 * sn;
            if (gc >= 2048) { o0 *= 0.125f; o1 *= 0.125f; }
            v0 = o0; v1 = o1;
          }
          if (gc < N) C[(size_t)gm * N + gc] = v0;
          if (gc + 32 < N) C[(size_t)gm * N + gc + 32] = v1;
        },
        smem);
  }
}

struct S5Const { float lb_re, lb_im; };
DEV void s5_consts(const Params& p, int g, int pp, float& lb_re, float& lb_im, float (&bbr)[16], float (&bbi)[16]) {
  const float dt = expf(p.in[I_S5_LOG_DT][g]);
  const float lr = p.in[I_S5_LAM_RE][g * 64 + pp], li = p.in[I_S5_LAM_IM][g * 64 + pp];
  const float mag = expf(lr * dt);
  float sn, cs;
  sincosf(li * dt, &sn, &cs);
  lb_re = mag * cs; lb_im = mag * sn;
  const float den = lr * lr + li * li;
  const float f_re = ((lb_re - 1.f) * lr + lb_im * li) / den;
  const float f_im = (lb_im * lr - (lb_re - 1.f) * li) / den;
  const float* br = p.in[I_S5_B_RE] + (size_t)(g * 64 + pp) * 16;
  const float* bi = p.in[I_S5_B_IM] + (size_t)(g * 64 + pp) * 16;
#pragma unroll
  for (int h = 0; h < 16; ++h) {
    bbr[h] = f_re * br[h] - f_im * bi[h];
    bbi[h] = f_re * bi[h] + f_im * br[h];
  }
}

#define P1_ROPE_ITEMS (NTOK / 16)
#define P1_S5A_ITEMS (BATCH * 32 * S5_NC / 4)
#define P1_CMP_TILES ((NCMP + 7) / 8)
#define P1_CMP_ITEMS (2 * BATCH * 2 * P1_CMP_TILES)
DEV void p1_rope(const Params& p, int item) {
  float* H = (float*)(p.ws + OFF_H);
  for (int w = threadIdx.x; w < 16 * 96; w += NTHREADS) {
    const int tok = item * 16 + w / 96;
    const int r = w % 96, hd = r >> 3, i = r & 7;
    const int col = hd < 8 ? 512 + hd * 64 : (hd < 10 ? 1280 + (hd - 8) * 64 : 1536 + (hd - 10) * 64);
    float* x = H + (size_t)tok * AB_IN + col;
    const float pos = (float)(tok % SEQ_LEN);
    const float inv = __expf(-(float)i * (13.122363377404328f / 8.f));
    float sn, cs;
    sincosf(pos * inv, &sn, &cs);
    const float x1 = x[i], x2 = x[i + 8];
    x[i] = x1 * cs - x2 * sn;
    x[i + 8] = x2 * cs + x1 * sn;
  }
}
DEV void p1_s5a(const Params& p, int item) {
  const int lane = threadIdx.x & 63, wave = threadIdx.x >> 6;
  const int idx = item * 4 + wave;
  const int g = idx & 31, c = (idx >> 5) % S5_NC, b = idx / (32 * S5_NC);
  float lb_re, lb_im, bbr[16], bbi[16];
  s5_consts(p, g, lane, lb_re, lb_im, bbr, bbi);
  const float* H = (const float*)(p.ws + OFF_H);
  float sr = 0.f, si = 0.f;
  for (int tt = 0; tt < 64; ++tt) {
    const float* u = H + (size_t)(b * SEQ_LEN + c * 64 + tt) * AB_IN + g * 16;
    float dr = 0.f, di = 0.f;
#pragma unroll
    for (int h4 = 0; h4 < 4; ++h4) {
      const float4 uv = ld4(u + h4 * 4);
      dr += uv.x * bbr[h4 * 4] + uv.y * bbr[h4 * 4 + 1] + uv.z * bbr[h4 * 4 + 2] + uv.w * bbr[h4 * 4 + 3];
      di += uv.x * bbi[h4 * 4] + uv.y * bbi[h4 * 4 + 1] + uv.z * bbi[h4 * 4 + 2] + uv.w * bbi[h4 * 4 + 3];
    }
    const float nr = lb_re * sr - lb_im * si + dr;
    const float ni = lb_re * si + lb_im * sr + di;
    sr = nr; si = ni;
  }
  float2* E = (float2*)(p.ws + OFF_S5E);
  E[((size_t)(b * S5_NC + c) * 32 + g) * 64 + lane] = make_float2(sr, si);
}
DEV void p1_compress(const Params& p, int item, char* smem) {
  const int tile = item % P1_CMP_TILES;
  int r = item / P1_CMP_TILES;
  const int g = r & 1; r >>= 1;
  const int b = r % BATCH; const int which = r / BATCH;
  const int n0 = tile * 8;
  const float* H = (const float*)(p.ws + OFF_H);
  const float* pe = which ? p.in[I_PE_V] : p.in[I_PE_K];
  const float* w1 = which ? p.in[I_CV_W1] : p.in[I_CK_W1];
  const float* b1 = which ? p.in[I_CV_B1] : p.in[I_CK_B1];
  const float* w2 = which ? p.in[I_CV_W2] : p.in[I_CK_W2];
  const int colbase = (which ? 1152 : 1024) + g * 64;
  float* sTok = (float*)smem;
  float* sPart = sTok + 144 * 64;
  float* sHid = sPart + 2 * 8 * 128;
  const int tid = threadIdx.x;
  __syncthreads();
  for (int w = tid; w < 144 * 16; w += NTHREADS) {
    const int tr = w >> 4, c4 = (w & 15) * 4;
    int tok = n0 * 16 + tr; if (tok > SEQ_LEN - 1) tok = SEQ_LEN - 1;
    st4(sTok + tr * 64 + c4, ld4(H + (size_t)(b * SEQ_LEN + tok) * AB_IN + colbase + c4));
  }
  __syncthreads();
  {
    const int hid = tid & 127, kh = tid >> 7;
    float acc[8];
#pragma unroll
    for (int rr = 0; rr < 8; ++rr) acc[rr] = 0.f;
    for (int k = kh * 1024; k < kh * 1024 + 1024; ++k) {
      const float w = w1[(size_t)k * 128 + hid];
      const int j = k >> 6, d = k & 63;
      const float pv = pe[j * 64 + d];
#pragma unroll
      for (int rr = 0; rr < 8; ++rr) acc[rr] += (sTok[(rr * 16 + j) * 64 + d] + pv) * w;
    }
#pragma unroll
    for (int rr = 0; rr < 8; ++rr) sPart[(kh * 8 + rr) * 128 + hid] = acc[rr];
  }
  __syncthreads();
  for (int w = tid; w < 8 * 128; w += NTHREADS) {
    const int rr = w >> 7, hid = w & 127;
    sHid[w] = geluf_(sPart[rr * 128 + hid] + sPart[(8 + rr) * 128 + hid] + b1[hid]);
  }
  __syncthreads();
  float* sOut = sPart;
  for (int w = tid; w < 8 * 64; w += NTHREADS) {
    const int rr = w >> 6, d = w & 63;
    float a = 0.f;
    for (int hid = 0; hid < 128; ++hid) a += sHid[rr * 128 + hid] * w2[hid * 64 + d];
    sOut[w] = a;
  }
  __syncthreads();
  float* dst = (float*)(p.ws + (which ? OFF_VCMP : OFF_KCMP));
  for (int w = tid; w < 8 * 64; w += NTHREADS) {
    const int rr = w >> 6, d = w & 63;
    const int n = n0 + rr;
    if (n >= NCMP) continue;
    float v = sOut[w];
    if (which == 0 && d < 16) {
      const int i = d & 7;
      const float pos = (float)(n * 16 + 31);
      const float inv = __expf(-(float)i * (13.122363377404328f / 8.f));
      float sn, cs;
      sincosf(pos * inv, &sn, &cs);
      const float x1 = sOut[rr * 64 + i], x2 = sOut[rr * 64 + i + 8];
      v = d < 8 ? x1 * cs - x2 * sn : x2 * cs + x1 * sn;
    }
    dst[((size_t)(b * NCMP + n) * 2 + g) * 64 + d] = v;
  }
}
#define P1_SMEM ((144 * 64 + 2 * 8 * 128 + 8 * 128) * 4)
DEV void phase_p1(const Params& p, char* smem) {
  const int total = P1_ROPE_ITEMS + P1_S5A_ITEMS + P1_CMP_ITEMS;
  for (int it = blockIdx.x; it < total; it += gridDim.x) {
    if (it < P1_CMP_ITEMS) p1_compress(p, it, smem);
    else if (it < P1_CMP_ITEMS + P1_S5A_ITEMS) p1_s5a(p, it - P1_CMP_ITEMS);
    else p1_rope(p, it - P1_CMP_ITEMS - P1_S5A_ITEMS);
  }
}

#define P2_S5C_ITEMS (BATCH * 32 * S5_NC / 4)
#define P2_ATT_ITEMS (NTOK * 2 / 4)
#define S5C_ROW 132
#define P2_S5C_SMEM (4 * 16 * S5C_ROW * 4)
DEV void p2_s5c(const Params& p, int item, char* smem) {
  const int lane = threadIdx.x & 63, wave = threadIdx.x >> 6;
  const int idx = item * 4 + wave;
  const int g = idx & 31, c = (idx >> 5) % S5_NC, b = idx / (32 * S5_NC);
  float lb_re, lb_im, bbr[16], bbi[16];
  s5_consts(p, g, lane, lb_re, lb_im, bbr, bbi);
  float ar = lb_re, ai = lb_im;
#pragma unroll
  for (int s = 0; s < 6; ++s) { const float nr = ar * ar - ai * ai, ni = 2.f * ar * ai; ar = nr; ai = ni; }
  const float2* E = (const float2*)(p.ws + OFF_S5E);
  float sr = 0.f, si = 0.f;
  for (int cc = 0; cc < c; ++cc) {
    const float2 e = E[((size_t)(b * S5_NC + cc) * 32 + g) * 64 + lane];
    const float nr = ar * sr - ai * si + e.x, ni = ar * si + ai * sr + e.y;
    sr = nr; si = ni;
  }
  const float* H = (const float*)(p.ws + OFF_H);
  float* sS = (float*)smem + wave * 16 * S5C_ROW;
  const float* cre = p.in[I_S5_C_RE] + (size_t)g * 16 * 64;
  const float* cim = p.in[I_S5_C_IM] + (size_t)g * 16 * 64;
  float* YG = (float*)(p.ws + OFF_YGELU);
  for (int sc = 0; sc < 4; ++sc) {
    for (int tt = 0; tt < 16; ++tt) {
      const float* u = H + (size_t)(b * SEQ_LEN + c * 64 + sc * 16 + tt) * AB_IN + g * 16;
      float dr = 0.f, di = 0.f;
#pragma unroll
      for (int h4 = 0; h4 < 4; ++h4) {
        const float4 uv = ld4(u + h4 * 4);
        dr += uv.x * bbr[h4 * 4] + uv.y * bbr[h4 * 4 + 1] + uv.z * bbr[h4 * 4 + 2] + uv.w * bbr[h4 * 4 + 3];
        di += uv.x * bbi[h4 * 4] + uv.y * bbi[h4 * 4 + 1] + uv.z * bbi[h4 * 4 + 2] + uv.w * bbi[h4 * 4 + 3];
      }
      const float nr = lb_re * sr - lb_im * si + dr, ni = lb_re * si + lb_im * sr + di;
      sr = nr; si = ni;
      sS[tt * S5C_ROW + lane] = sr;
      sS[tt * S5C_ROW + 64 + lane] = si;
    }
    __syncthreads();
    {
      const int tt = lane >> 2, hq = lane & 3;
      float y[4] = {0.f, 0.f, 0.f, 0.f};
      for (int k = 0; k < 64; k += 4) {
        const float4 vr = ld4(sS + tt * S5C_ROW + k), vi = ld4(sS + tt * S5C_ROW + 64 + k);
#pragma unroll
        for (int hh = 0; hh < 4; ++hh) {
          const float4 cr = ld4(cre + (hq * 4 + hh) * 64 + k), ci = ld4(cim + (hq * 4 + hh) * 64 + k);
          y[hh] += vr.x * cr.x + vr.y * cr.y + vr.z * cr.z + vr.w * cr.w - (vi.x * ci.x + vi.y * ci.y + vi.z * ci.z + vi.w * ci.w);
        }
      }
      const size_t tok = (size_t)(b * SEQ_LEN + c * 64 + sc * 16 + tt);
      const int ch = g * 16 + hq * 4;
      const float4 uv = ld4(H + tok * AB_IN + ch);
      const float4 dv = ld4(p.in[I_S5_D] + ch);
      float4 o;
      o.x = geluf_(y[0] + dv.x * uv.x); o.y = geluf_(y[1] + dv.y * uv.y);
      o.z = geluf_(y[2] + dv.z * uv.z); o.w = geluf_(y[3] + dv.w * uv.w);
      st4(YG + tok * 512 + ch, o);
    }
    __syncthreads();
  }
}

template <int NB, class KF, class VF>
DEV void attn_branch(const float* q_lds, float* p_lds, KF kf, VF vf, float (&o)[4], float* imp_out, int lane) {
  float s[4][NB];
  float m[4] = {-INFINITY, -INFINITY, -INFINITY, -INFINITY};
  bool act[NB];
#pragma unroll
  for (int i = 0; i < NB; ++i) {
    bool active, valid;
    const float* kr = kf(i, active, valid);
    act[i] = active;
#pragma unroll
    for (int h = 0; h < 4; ++h) s[h][i] = -INFINITY;
    if (active) {
      float d[4] = {0.f, 0.f, 0.f, 0.f};
#pragma unroll
      for (int c = 0; c < 16; ++c) {
        const float4 kv = ld4(kr + c * 4);
#pragma unroll
        for (int h = 0; h < 4; ++h) {
          const float4 qv = ld4(q_lds + h * 64 + c * 4);
          d[h] += kv.x * qv.x + kv.y * qv.y + kv.z * qv.z + kv.w * qv.w;
        }
      }
#pragma unroll
      for (int h = 0; h < 4; ++h) { s[h][i] = valid ? d[h] : -INFINITY; m[h] = fmaxf(m[h], s[h][i]); }
    }
  }
  float l[4];
#pragma unroll
  for (int h = 0; h < 4; ++h) {
    m[h] = wave_max(m[h]);
    float e = 0.f;
    if (m[h] > -INFINITY) {
#pragma unroll
      for (int i = 0; i < NB; ++i) { s[h][i] = __expf(s[h][i] - m[h]); e += s[h][i]; }
    } else {
#pragma unroll
      for (int i = 0; i < NB; ++i) s[h][i] = 0.f;
    }
    l[h] = wave_sum(e);
    l[h] = l[h] > 0.f ? 1.f / l[h] : 0.f;
  }
#pragma unroll
  for (int i = 0; i < NB; ++i) {
    float4 pv;
    pv.x = s[0][i] * l[0]; pv.y = s[1][i] * l[1]; pv.z = s[2][i] * l[2]; pv.w = s[3][i] * l[3];
    if (imp_out) imp_out[i * 64 + lane] = pv.x + pv.y + pv.z + pv.w;
    if (act[i]) {
      WAVE_SYNC();
      st4(p_lds + lane * 4, pv);
      WAVE_SYNC();
      for (int kk = 0; kk < 64; ++kk) {
        const float* vr = vf(i, kk);
        if (!vr) break;
        const float4 pp = ld4(p_lds + kk * 4);
        const float vv = vr[lane];
        o[0] += pp.x * vv; o[1] += pp.y * vv; o[2] += pp.z * vv; o[3] += pp.w * vv;
      }
    }
  }
  WAVE_SYNC();
}

#define ATT_WAVE_FLOATS (256 + 256 + (NB_CMP * 64 + 8) + 16)
#define P2_ATT_SMEM (4 * ATT_WAVE_FLOATS * 4)
DEV void p2_attn(const Params& p, int item, char* smem) {
  const int lane = threadIdx.x & 63, wave = threadIdx.x >> 6;
  const int idx = item * 4 + wave;
  const int g = idx & 1, t = (idx >> 1) % SEQ_LEN, b = idx / (2 * SEQ_LEN);
  float* base = (float*)smem + wave * ATT_WAVE_FLOATS;
  float* q_lds = base;
  float* p_lds = base + 256;
  float* L = base + 512;
  int* sel_lds = (int*)(base + 512 + NB_CMP * 64 + 8);
  const float* H = (const float*)(p.ws + OFF_H);
  const size_t tok = (size_t)b * SEQ_LEN + t;
  const float* hrow = H + tok * AB_IN;
  WAVE_SYNC();
#pragma unroll
  for (int h = 0; h < 4; ++h) q_lds[h * 64 + lane] = hrow[512 + (g * 4 + h) * 64 + lane] * 0.125f;
  if (lane == 0) L[0] = 0.f;
  WAVE_SYNC();
  float o_cmp[4] = {0.f, 0.f, 0.f, 0.f};
  const int nvalid = t >= 31 ? (t - 31) / 16 + 1 : 0;
  const float* KC = (const float*)(p.ws + OFF_KCMP);
  const float* VC = (const float*)(p.ws + OFF_VCMP);
  attn_branch<NB_CMP>(
      q_lds, p_lds,
      [&](int i, bool& active, bool& valid) {
        const int n = i * 64 + lane;
        active = i * 64 < nvalid; valid = n < nvalid;
        const int nc = n < NCMP ? n : NCMP - 1;
        return KC + ((size_t)(b * NCMP + nc) * 2 + g) * 64;
      },
      [&](int i, int kk) {
        const int n = i * 64 + kk;
        return n < nvalid ? VC + ((size_t)(b * NCMP + n) * 2 + g) * 64 : (const float*)nullptr;
      },
      o_cmp, L + 1, lane);
  WAVE_SYNC();
  const int cur = t >> 6;
  unsigned long long key[(NBLK + 63) / 64];
#pragma unroll
  for (int c = 0; c < (NBLK + 63) / 64; ++c) {
    const int j = lane + 64 * c;
    key[c] = 0ull;
    if (j < NBLK) {
      float val = L[4 * j] + 2.f * (L[4 * j + 1] + L[4 * j + 2] + L[4 * j + 3]) + L[4 * j + 4];
      const bool forced = (j == 0) | (j == cur) | (j == cur - 1);
      float score = forced ? 1e6f : val;
      if (j * 64 > t) score = -1e6f;
      unsigned u = __builtin_bit_cast(unsigned, score);
      u = (u & 0x80000000u) ? ~u : (u | 0x80000000u);
      key[c] = ((unsigned long long)u << 32) | (unsigned)(0xFFFFFFFFu - (unsigned)j);
    }
  }
  for (int r = 0; r < 16; ++r) {
    unsigned long long best = key[0];
#pragma unroll
    for (int c = 1; c < (NBLK + 63) / 64; ++c) best = key[c] > best ? key[c] : best;
#pragma unroll
    for (int mm = 32; mm >= 1; mm >>= 1) {
      const unsigned lo = __shfl_xor((unsigned)best, mm), hi = __shfl_xor((unsigned)(best >> 32), mm);
      const unsigned long long ob = ((unsigned long long)hi << 32) | lo;
      best = ob > best ? ob : best;
    }
    const int j = (int)(0xFFFFFFFFu - (unsigned)(best & 0xFFFFFFFFull));
#pragma unroll
    for (int c = 0; c < (NBLK + 63) / 64; ++c) if (lane + 64 * c == j) key[c] = 0ull;
    if (lane == 0) sel_lds[r] = j;
  }
  WAVE_SYNC();
  float o_slc[4] = {0.f, 0.f, 0.f, 0.f};
  attn_branch<16>(
      q_lds, p_lds,
      [&](int i, bool& active, bool& valid) {
        const int j = sel_lds[i];
        const int kt = j * 64 + lane;
        active = j * 64 <= t; valid = kt <= t;
        return H + ((size_t)b * SEQ_LEN + kt) * AB_IN + 1280 + g * 64;
      },
      [&](int i, int kk) {
        const int kt = sel_lds[i] * 64 + kk;
        return kt <= t ? H + ((size_t)b * SEQ_LEN + kt) * AB_IN + 1408 + g * 64 : (const float*)nullptr;
      },
      o_slc, nullptr, lane);
  float o_win[4] = {0.f, 0.f, 0.f, 0.f};
  attn_branch<8>(
      q_lds, p_lds,
      [&](int i, bool& active, bool& valid) {
        const int kt = t - 511 + i * 64 + lane;
        active = t - 511 + i * 64 + 63 >= 0; valid = kt >= 0;
        return H + ((size_t)b * SEQ_LEN + (kt < 0 ? 0 : kt)) * AB_IN + 1536 + g * 64;
      },
      [&](int i, int kk) {
        const int kt = t - 511 + i * 64 + kk;
        return H + ((size_t)b * SEQ_LEN + (kt < 0 ? 0 : kt)) * AB_IN + 1664 + g * 64;
      },
      o_win, nullptr, lane);
  float* MIX = (float*)(p.ws + OFF_MIX);
  const float ov_c[4] = {o_cmp[0], o_cmp[1], o_cmp[2], o_cmp[3]};
#pragma unroll
  for (int h = 0; h < 4; ++h) {
    const int hd = g * 4 + h;
    const float g0 = sigmoidf_(hrow[1792 + hd * 3 + 0]), g1 = sigmoidf_(hrow[1792 + hd * 3 + 1]), g2 = sigmoidf_(hrow[1792 + hd * 3 + 2]);
    MIX[tok * 1024 + 512 + hd * 64 + lane] = g0 * ov_c[h] + g1 * o_slc[h] + g2 * o_win[h];
  }
}
#define P2_SMEM (P2_S5C_SMEM > P2_ATT_SMEM ? P2_S5C_SMEM : P2_ATT_SMEM)
DEV void phase_p2(const Params& p, char* smem) {
  const int total = P2_S5C_ITEMS + P2_ATT_ITEMS;
  for (int it = blockIdx.x; it < total; it += gridDim.x) {
    if (it < P2_S5C_ITEMS) p2_s5c(p, it, smem);
    else p2_attn(p, it - P2_S5C_ITEMS, smem);
  }
}

DEV void phase_glu(const Params& p, char* smem) {
  const float* A = (const float*)(p.ws + OFF_YGELU);
  const float* B = p.in[I_S5_W_GLU];
  const float* bias = p.in[I_S5_B_GLU];
  float* MIX = (float*)(p.ws + OFF_MIX);
  const int NT = 4, MT = NTOK / 128;
  for (int it = blockIdx.x; it < MT * NT; it += gridDim.x) {
    const int m0 = (it / NT) * 128, n0 = (it % NT) * 128;
    gemm_tile<false>(
        [&](int r) { return (const void*)(A + (size_t)(m0 + r) * 512); },
        [&](int c) { return B + n0 + c; }, 512, 512,
        [&](int row, int col, float v0, float v1) {
          const size_t gm = m0 + row; const int gc = n0 + col;
          const float y0 = A[gm * 512 + gc], y1 = A[gm * 512 + gc + 32];
          MIX[gm * 1024 + gc] = y0 * sigmoidf_(v0 + bias[gc]);
          MIX[gm * 1024 + gc + 32] = y1 * sigmoidf_(v1 + bias[gc + 32]);
        },
        smem);
  }
}

template <int LAYER>
DEV void phase_outproj(const Params& p, char* smem) {
  const float* A = (const float*)(p.ws + OFF_MIX);
  const float* B = LAYER == 0 ? p.in[I_AB_W_OUT] : p.in[I_CD_W_OUT];
  const float* xin = LAYER == 0 ? p.in[I_X] : (const float*)(p.ws + OFF_X2);
  float* PRE = (float*)(p.ws + OFF_H);
  const int NT = 8, MT = NTOK / 128;
  for (int it = blockIdx.x; it < MT * NT; it += gridDim.x) {
    const int m0 = (it / NT) * 128, n0 = (it % NT) * 128;
    gemm_tile<false>(
        [&](int r) { return (const void*)(A + (size_t)(m0 + r) * 1024); },
        [&](int c) { return B + n0 + c; }, 1024, 1024,
        [&](int row, int col, float v0, float v1) {
          const size_t o = (size_t)(m0 + row) * 1024 + n0 + col;
          PRE[o] = ALPHA_F * xin[o] + v0;
          PRE[o + 32] = ALPHA_F * xin[o + 32] + v1;
        },
        smem);
  }
}

DEV void wave_ln(float (&v)[16], const float* gam, const float* bet, int lane) {
  float s = 0.f;
#pragma unroll
  for (int i = 0; i < 16; ++i) s += v[i];
  const float mu = wave_sum(s) * (1.f / 1024.f);
  float q = 0.f;
#pragma unroll
  for (int i = 0; i < 16; ++i) { const float d = v[i] - mu; q += d * d; }
  const float rstd = rsqrtf(wave_sum(q) * (1.f / 1024.f) + 1e-5f);
#pragma unroll
  for (int i = 0; i < 4; ++i) {
    const float4 gv = ld4(gam + lane * 4 + 256 * i), bv = ld4(bet + lane * 4 + 256 * i);
    v[i * 4 + 0] = (v[i * 4 + 0] - mu) * rstd * gv.x + bv.x;
    v[i * 4 + 1] = (v[i * 4 + 1] - mu) * rstd * gv.y + bv.y;
    v[i * 4 + 2] = (v[i * 4 + 2] - mu) * rstd * gv.z + bv.z;
    v[i * 4 + 3] = (v[i * 4 + 3] - mu) * rstd * gv.w + bv.w;
  }
}

#define P5_SMEM (4 * (1024 + 64) * 4)
template <int LAYER>
DEV void phase_ln_router(const Params& p, char* smem) {
  const int lane = threadIdx.x & 63, wave = threadIdx.x >> 6;
  const float* PRE = (const float*)(p.ws + OFF_H);
  float* X1 = (float*)(p.ws + OFF_X1);
  const float* router = p.in[I_ROUTER] + (size_t)LAYER * 1024 * 64;
  const float* bias = p.in[I_MOE_BIAS] + LAYER * 64;
  int* TOPI = (int*)(p.ws + OFF_TOPI);
  float* TOPG = (float*)(p.ws + OFF_TOPG);
  float* xs = (float*)smem + wave * (1024 + 64);
  float* ms = xs + 1024;
  for (int it = blockIdx.x; it < NTOK / 4; it += gridDim.x) {
    const size_t tok = (size_t)it * 4 + wave;
    float v[16];
#pragma unroll
    for (int i = 0; i < 4; ++i) {
      const float4 a = ld4(PRE + tok * 1024 + lane * 4 + 256 * i);
      v[i * 4] = a.x; v[i * 4 + 1] = a.y; v[i * 4 + 2] = a.z; v[i * 4 + 3] = a.w;
    }
    wave_ln(v, p.in[I_LN1_G] + LAYER * 1024, p.in[I_LN1_B] + LAYER * 1024, lane);
    WAVE_SYNC();
#pragma unroll
    for (int i = 0; i < 4; ++i) {
      const float4 a = make_float4(v[i * 4], v[i * 4 + 1], v[i * 4 + 2], v[i * 4 + 3]);
      st4(X1 + tok * 1024 + lane * 4 + 256 * i, a);
      st4(xs + lane * 4 + 256 * i, a);
    }
    WAVE_SYNC();
    float logit = 0.f;
    for (int k = 0; k < 1024; k += 4) {
      const float4 xv = ld4(xs + k);
      logit += xv.x * router[(size_t)k * 64 + lane] + xv.y * router[(size_t)(k + 1) * 64 + lane] +
               xv.z * router[(size_t)(k + 2) * 64 + lane] + xv.w * router[(size_t)(k + 3) * 64 + lane];
    }
    const float score = 1.f / (1.f + expf(-logit));
    const float biased = score + bias[lane];
    float m1 = biased; int a1 = lane;
#pragma unroll
    for (int mm = 1; mm <= 4; mm <<= 1) {
      const float ov = __shfl_xor(m1, mm); const int oa = __shfl_xor(a1, mm);
      if (ov > m1 || (ov == m1 && oa < a1)) { m1 = ov; a1 = oa; }
    }
    float m2 = lane == a1 ? -INFINITY : biased;
#pragma unroll
    for (int mm = 1; mm <= 4; mm <<= 1) m2 = fmaxf(m2, __shfl_xor(m2, mm));
    const float gs = m1 + m2;
    const int mygrp = lane >> 3;
    int rank = 0;
#pragma unroll
    for (int gg = 0; gg < 8; ++gg) {
      const float og = __shfl(gs, gg * 8);
      rank += (og > gs || (og == gs && gg < mygrp)) ? 1 : 0;
    }
    const float masked = rank < 4 ? biased : -INFINITY;
    WAVE_SYNC();
    ms[lane] = masked;
    WAVE_SYNC();
    int erank = 0;
    for (int e = 0; e < 64; ++e) {
      const float ov = ms[e];
      erank += (ov > masked || (ov == masked && e < lane)) ? 1 : 0;
    }
    const bool selected = erank < 8;
    const float gsum = wave_sum(selected ? score : 0.f);
    if (selected) {
      TOPI[tok * 8 + erank] = lane;
      TOPG[tok * 8 + erank] = score / gsum * 2.5f;
    }
    WAVE_SYNC();
  }
}

#define P6_SMEM GEMM_SMEM_BYTES
template <int LAYER>
DEV void phase_lists_shup(const Params& p, char* smem) {
  const int tid = threadIdx.x, lane = tid & 63, wave = tid >> 6;
  const int* TOPI = (const int*)(p.ws + OFF_TOPI);
  const float* TOPG = (const float*)(p.ws + OFF_TOPG);
  int* POSOF = (int*)(p.ws + OFF_POSOF);
  int* CNT = (int*)(p.ws + OFF_CNT);
  int* LTOK = (int*)(p.ws + OFF_LTOK);
  float* LGATE = (float*)(p.ws + OFF_LGATE);
  const float* X1 = (const float*)(p.ws + OFF_X1);
  unsigned short* HS = (unsigned short*)(p.ws + OFF_HS);
  const float* W1 = p.in[I_SH_W1] + (size_t)LAYER * 1024 * 256;
  const float* W3 = p.in[I_SH_W3] + (size_t)LAYER * 1024 * 256;
  const int MT = NTOK / 128;
  const int total = 64 + MT * 4;
  int* swave = (int*)smem;
  for (int it = blockIdx.x; it < total; it += gridDim.x) {
    if (it < 64) {
      const int e = it;
      int base = 0;
      for (int t0 = 0; t0 < NTOK; t0 += NTHREADS) {
        const int tok = t0 + tid;
        int slot = -1;
#pragma unroll
        for (int s = 0; s < 8; ++s) if (TOPI[(size_t)tok * 8 + s] == e) slot = s;
        const unsigned long long bal = __ballot(slot >= 0);
        const int pre = __popcll(bal & ((1ull << lane) - 1ull));
        __syncthreads();
        if (lane == 0) swave[wave] = __popcll(bal);
        __syncthreads();
        int woff = 0, tot = 0;
#pragma unroll
        for (int w = 0; w < 4; ++w) { const int c = swave[w]; if (w < wave) woff += c; tot += c; }
        if (slot >= 0) {
          const int pos = base + woff + pre;
          LTOK[(size_t)e * NTOK + pos] = tok;
          LGATE[(size_t)e * NTOK + pos] = TOPG[(size_t)tok * 8 + slot];
          POSOF[(size_t)tok * 8 + slot] = pos;
        }
        base += tot;
      }
      if (tid == 0) CNT[e] = base;
      __syncthreads();
    } else {
      const int it2 = it - 64;
      const int m0 = (it2 / 4) * 128, ct = it2 % 4;
      gemm_tile<false>(
          [&](int r) { return (const void*)(X1 + (size_t)(m0 + r) * 1024); },
          [&](int c) { return (((c >> 5) & 1) ? W3 : W1) + ct * 64 + (c >> 6) * 32 + (c & 31); }, 256, 1024,
          [&](int row, int col, float v0, float v1) {
            const int lc = ct * 64 + (col >> 6) * 32 + (col & 31);
            HS[(size_t)(m0 + row) * 256 + lc] = f2bf(siluf_(v0) * v1);
          },
          smem);
    }
  }
}

struct ExpMap { int tstart[65]; int rbase[65]; };
DEV void build_expmap(const Params& p, ExpMap* em) {
  __syncthreads();
  if (threadIdx.x == 0) {
    const int* CNT = (const int*)(p.ws + OFF_CNT);
    int ts = 0, rb = 0;
    for (int e = 0; e < 64; ++e) {
      em->tstart[e] = ts; em->rbase[e] = rb;
      const int c = CNT[e];
      ts += (c + 127) / 128; rb += c;
    }
    em->tstart[64] = ts; em->rbase[64] = rb;
  }
  __syncthreads();
}
DEV int find_expert(const ExpMap* em, int rt) {
  int e = 0;
  for (int k = 0; k < 64; ++k) if (em->tstart[k + 1] <= rt) e = k + 1;
  return e;
}

#define P7_SMEM (GEMM_SMEM_BYTES + 1024)
template <int LAYER>
DEV void phase_routed_up(const Params& p, char* smem) {
  ExpMap* em = (ExpMap*)(smem + GEMM_SMEM_BYTES);
  build_expmap(p, em);
  const int* CNT = (const int*)(p.ws + OFF_CNT);
  const int* LTOK = (const int*)(p.ws + OFF_LTOK);
  const float* X1 = (const float*)(p.ws + OFF_X1);
  unsigned short* HR = (unsigned short*)(p.ws + OFF_HR);
  const int total = em->tstart[64] * 4;
  for (int it = blockIdx.x; it < total; it += gridDim.x) {
    const int rt = it >> 2, ct = it & 3;
    const int e = find_expert(em, rt);
    const int r0 = (rt - em->tstart[e]) * 128;
    const int cnt = CNT[e], rbase = em->rbase[e];
    const float* W1 = p.in[I_MOE_W1] + ((size_t)LAYER * 64 + e) * 1024 * 256;
    const float* W3 = p.in[I_MOE_W3] + ((size_t)LAYER * 64 + e) * 1024 * 256;
    gemm_tile<false>(
        [&](int r) { return (r0 + r < cnt) ? (const void*)(X1 + (size_t)LTOK[(size_t)e * NTOK + r0 + r] * 1024) : (const void*)nullptr; },
        [&](int c) { return (((c >> 5) & 1) ? W3 : W1) + ct * 64 + (c >> 6) * 32 + (c & 31); }, 256, 1024,
        [&](int row, int col, float v0, float v1) {
          if (r0 + row < cnt) {
            const int lc = ct * 64 + (col >> 6) * 32 + (col & 31);
            HR[(size_t)(rbase + r0 + row) * 256 + lc] = f2bf(siluf_(v0) * v1);
          }
        },
        smem);
  }
}

template <int LAYER>
DEV void phase_down(const Params& p, char* smem) {
  ExpMap* em = (ExpMap*)(smem + GEMM_SMEM_BYTES);
  build_expmap(p, em);
  const int* CNT = (const int*)(p.ws + OFF_CNT);
  const float* LGATE = (const float*)(p.ws + OFF_LGATE);
  const unsigned short* HR = (const unsigned short*)(p.ws + OFF_HR);
  const unsigned short* HS = (const unsigned short*)(p.ws + OFF_HS);
  unsigned short* Y = (unsigned short*)(p.ws + OFF_Y);
  float* FS = (float*)(p.ws + OFF_FS);
  const int nrouted = em->tstart[64] * 8;
  const int total = nrouted + (NTOK / 128) * 8;
  for (int it = blockIdx.x; it < total; it += gridDim.x) {
    if (it < nrouted) {
      const int rt = it >> 3, ct = it & 7;
      const int e = find_expert(em, rt);
      const int r0 = (rt - em->tstart[e]) * 128;
      const int cnt = CNT[e], rbase = em->rbase[e];
      const float* W2 = p.in[I_MOE_W2] + ((size_t)LAYER * 64 + e) * 256 * 1024;
      const int n0 = ct * 128;
      gemm_tile<true>(
          [&](int r) { return (r0 + r < cnt) ? (const void*)(HR + (size_t)(rbase + r0 + r) * 256) : (const void*)nullptr; },
          [&](int c) { return W2 + n0 + c; }, 1024, 256,
          [&](int row, int col, float v0, float v1) {
            if (r0 + row < cnt) {
              const float gt = LGATE[(size_t)e * NTOK + r0 + row];
              const size_t o = (size_t)(rbase + r0 + row) * 1024 + n0 + col;
              Y[o] = f2bf(v0 * gt); Y[o + 32] = f2bf(v1 * gt);
            }
          },
          smem);
    } else {
      const int it2 = it - nrouted;
      const int m0 = (it2 >> 3) * 128, n0 = (it2 & 7) * 128;
      const float* W2 = p.in[I_SH_W2] + (size_t)LAYER * 256 * 1024;
      gemm_tile<true>(
          [&](int r) { return (const void*)(HS + (size_t)(m0 + r) * 256); },
          [&](int c) { return W2 + n0 + c; }, 1024, 256,
          [&](int row, int col, float v0, float v1) {
            const size_t o = (size_t)(m0 + row) * 1024 + n0 + col;
            FS[o] = v0; FS[o + 32] = v1;
          },
          smem);
    }
  }
}

template <int LAYER>
DEV void phase_combine(const Params& p, char* smem) {
  ExpMap* em = (ExpMap*)smem;
  build_expmap(p, em);
  const int lane = threadIdx.x & 63, wave = threadIdx.x >> 6;
  const float* X1 = (const float*)(p.ws + OFF_X1);
  const float* FS = (const float*)(p.ws + OFF_FS);
  const unsigned short* Y = (const unsigned short*)(p.ws + OFF_Y);
  const int* TOPI = (const int*)(p.ws + OFF_TOPI);
  const int* POSOF = (const int*)(p.ws + OFF_POSOF);
  float* OUT = LAYER == 0 ? (float*)(p.ws + OFF_X2) : p.out;
  for (int it = blockIdx.x; it < NTOK / 4; it += gridDim.x) {
    const size_t tok = (size_t)it * 4 + wave;
    float v[16];
#pragma unroll
    for (int i = 0; i < 4; ++i) {
      const float4 a = ld4(X1 + tok * 1024 + lane * 4 + 256 * i), f = ld4(FS + tok * 1024 + lane * 4 + 256 * i);
      v[i * 4] = ALPHA_F * a.x + f.x; v[i * 4 + 1] = ALPHA_F * a.y + f.y; v[i * 4 + 2] = ALPHA_F * a.z + f.z; v[i * 4 + 3] = ALPHA_F * a.w + f.w;
    }
    for (int s = 0; s < 8; ++s) {
      const int e = TOPI[tok * 8 + s];
      const size_t row = (size_t)em->rbase[e] + POSOF[tok * 8 + s];
#pragma unroll
      for (int i = 0; i < 4; ++i) {
        const uint2 y = *(const uint2*)(Y + row * 1024 + lane * 4 + 256 * i);
        v[i * 4] += bf2f((unsigned short)(y.x & 0xFFFF)); v[i * 4 + 1] += bf2f((unsigned short)(y.x >> 16));
        v[i * 4 + 2] += bf2f((unsigned short)(y.y & 0xFFFF)); v[i * 4 + 3] += bf2f((unsigned short)(y.y >> 16));
      }
    }
    wave_ln(v, p.in[I_LN2_G] + LAYER * 1024, p.in[I_LN2_B] + LAYER * 1024, lane);
#pragma unroll
    for (int i = 0; i < 4; ++i) st4(OUT + tok * 1024 + lane * 4 + 256 * i, make_float4(v[i * 4], v[i * 4 + 1], v[i * 4 + 2], v[i * 4 + 3]));
  }
}

DEV float shifted(const float* Hc, size_t tok, int col, const float* mu) {
  const float cur = Hc[tok * CD_IN + col];
  const float prev = (tok % SEQ_LEN) == 0 ? 0.f : Hc[(tok - 1) * CD_IN + col];
  return cur + (prev - cur) * mu[col];
}

#define P11_PREP_ITEMS (NTOK / 8)
#define P11_KV_ITEMS (BATCH * 4 * RET_NC)
#define P11_SMEM (8 * 128 * 4)
DEV void p11_prep(const Params& p, int item, char* smem) {
  const int tid = threadIdx.x;
  const float* Hc = (const float*)(p.ws + OFF_H);
  const float* mu = p.in[I_RW_MU];
  float* sl = (float*)smem;
  __syncthreads();
  for (int w = tid; w < 8 * 128; w += NTHREADS) {
    const int tt = w >> 7, j = w & 127;
    const size_t tok = (size_t)item * 8 + tt;
    const float v = shifted(Hc, tok, 1536 + j, mu);
    sl[w] = j < 64 ? tanhf(v) : v;
  }
  __syncthreads();
  float* RWW = (float*)(p.ws + OFF_RWW); float* RWK = (float*)(p.ws + OFF_RWK);
  float* RWKK = (float*)(p.ws + OFF_RWKK); float* RWA = (float*)(p.ws + OFF_RWA);
  float* RWR = p.out + (size_t)NTOK * 512; float* RWV = p.out;
  const float* w_up = p.in[I_RW_W_UP]; const float* a_up = p.in[I_RW_A_UP];
#pragma unroll
  for (int cc = 0; cc < 2; ++cc) {
    const int c = tid + 256 * cc;
    float aw[8], aa[8];
#pragma unroll
    for (int tt = 0; tt < 8; ++tt) { aw[tt] = 0.f; aa[tt] = 0.f; }
    for (int j = 0; j < 64; ++j) {
      const float wu = w_up[j * 512 + c], au = a_up[j * 512 + c];
#pragma unroll
      for (int tt = 0; tt < 8; ++tt) { aw[tt] += sl[tt * 128 + j] * wu; aa[tt] += sl[tt * 128 + 64 + j] * au; }
    }
    const float w0 = p.in[I_RW_W0][c], a0 = p.in[I_RW_A0][c], kkc = p.in[I_RW_K_K][c], kac = p.in[I_RW_K_A][c];
#pragma unroll
    for (int tt = 0; tt < 8; ++tt) {
      const size_t tok = (size_t)item * 8 + tt;
      const float lw = w0 + aw[tt];
      const float nl = -lw;
      const float sp = nl > 20.f ? nl : log1pf(expf(nl));
      const float wl = -sp - 0.5f;
      const float decay = expf(-expf(wl));
      const float a = 1.f / (1.f + expf(-(a0 + aa[tt])));
      const float rs = shifted(Hc, tok, c, mu);
      const float ks = shifted(Hc, tok, 512 + c, mu);
      const float vs = shifted(Hc, tok, 1024 + c, mu);
      float kk = ks * kkc;
      const float nrm = sqrtf(wave_sum(kk * kk));
      kk = kk / fmaxf(nrm, 1e-12f);
      RWW[tok * 512 + c] = decay;
      RWK[tok * 512 + c] = ks * (1.f + (a - 1.f) * kac);
      RWKK[tok * 512 + c] = kk;
      RWA[tok * 512 + c] = a;
      RWR[tok * 512 + c] = rs;
      RWV[tok * 512 + c] = vs;
    }
  }
}
DEV float ret_log2gamma(int h) { return log2f(1.f - exp2f(-5.f - (float)h)); }
DEV void p11_kv(const Params& p, int item) {
  const int c = item % RET_NC, h = (item / RET_NC) & 3, b = item / (RET_NC * 4);
  const int tid = threadIdx.x, e = tid & 127, dh = tid >> 7;
  const float* Hc = (const float*)(p.ws + OFF_H);
  const float lg = ret_log2gamma(h);
  float acc[32];
#pragma unroll
  for (int i = 0; i < 32; ++i) acc[i] = 0.f;
  for (int j = 0; j < 128; ++j) {
    const size_t tok = (size_t)b * SEQ_LEN + c * 128 + j;
    const float vv = Hc[tok * CD_IN + 2304 + h * 128 + e] * exp2f((float)(127 - j) * lg);
    const float* kr = Hc + tok * CD_IN + 2048 + h * 64 + dh * 32;
#pragma unroll
    for (int i4 = 0; i4 < 8; ++i4) {
      const float4 kv = ld4(kr + i4 * 4);
      acc[i4 * 4] += kv.x * vv; acc[i4 * 4 + 1] += kv.y * vv; acc[i4 * 4 + 2] += kv.z * vv; acc[i4 * 4 + 3] += kv.w * vv;
    }
  }
  float* KV = (float*)(p.ws + OFF_RETKV) + (size_t)item * 64 * 128;
#pragma unroll
  for (int i = 0; i < 32; ++i) KV[(dh * 32 + i) * 128 + e] = acc[i];
}
DEV void phase_p11(const Params& p, char* smem) {
  const int total = P11_PREP_ITEMS + P11_KV_ITEMS;
  for (int it = blockIdx.x; it < total; it += gridDim.x) {
    if (it < P11_KV_ITEMS) p11_kv(p, it);
    else p11_prep(p, it - P11_KV_ITEMS, smem);
  }
}

#define P12_SCAN_ITEMS (BATCH * 8)
#define P12_RET_ITEMS (BATCH * 4 * RET_NC)
#define P12_SMEM (64 * 128 * 4 + 256 * 2 * 4)
DEV void p12_scan(const Params& p, int item) {
  const int b = item >> 3, h = item & 7;
  const int tid = threadIdx.x, i = tid >> 2, cq = tid & 3;
  const float* RWW = (const float*)(p.ws + OFF_RWW); const float* RWK = (const float*)(p.ws + OFF_RWK);
  const float* RWKK = (const float*)(p.ws + OFF_RWKK); const float* RWA = (const float*)(p.ws + OFF_RWA);
  const float* RWR = p.out + (size_t)NTOK * 512; const float* RWV = p.out;
  float* Yo = (float*)(p.ws + OFF_MIX);
  float S[16];
#pragma unroll
  for (int j = 0; j < 16; ++j) S[j] = 0.f;
  const int cb = h * 64 + cq * 16;
  float4 nw[4], nk[4], nkk[4], na[4], nr[4]; float nv;
  auto loadstep = [&](int t) {
    const size_t o = ((size_t)b * SEQ_LEN + t) * 512 + cb;
#pragma unroll
    for (int q4 = 0; q4 < 4; ++q4) {
      nw[q4] = ld4(RWW + o + q4 * 4); nk[q4] = ld4(RWK + o + q4 * 4); nkk[q4] = ld4(RWKK + o + q4 * 4);
      na[q4] = ld4(RWA + o + q4 * 4); nr[q4] = ld4(RWR + o + q4 * 4);
    }
    nv = RWV[((size_t)b * SEQ_LEN + t) * 512 + h * 64 + i];
  };
  loadstep(0);
  for (int t = 0; t < SEQ_LEN; ++t) {
    float w[16], k[16], kk[16], a[16], r[16];
    const float v = nv;
#pragma unroll
    for (int q4 = 0; q4 < 4; ++q4) {
      w[q4 * 4] = nw[q4].x; w[q4 * 4 + 1] = nw[q4].y; w[q4 * 4 + 2] = nw[q4].z; w[q4 * 4 + 3] = nw[q4].w;
      k[q4 * 4] = nk[q4].x; k[q4 * 4 + 1] = nk[q4].y; k[q4 * 4 + 2] = nk[q4].z; k[q4 * 4 + 3] = nk[q4].w;
      kk[q4 * 4] = nkk[q4].x; kk[q4 * 4 + 1] = nkk[q4].y; kk[q4 * 4 + 2] = nkk[q4].z; kk[q4 * 4 + 3] = nkk[q4].w;
      a[q4 * 4] = na[q4].x; a[q4 * 4 + 1] = na[q4].y; a[q4 * 4 + 2] = na[q4].z; a[q4 * 4 + 3] = na[q4].w;
      r[q4 * 4] = nr[q4].x; r[q4 * 4 + 1] = nr[q4].y; r[q4 * 4 + 2] = nr[q4].z; r[q4 * 4 + 3] = nr[q4].w;
    }
    if (t + 1 < SEQ_LEN) loadstep(t + 1);
    float sa = 0.f;
#pragma unroll
    for (int j = 0; j < 16; ++j) sa += S[j] * kk[j];
    sa += __shfl_xor(sa, 1);
    sa += __shfl_xor(sa, 2);
    sa = -sa;
    float y = 0.f;
#pragma unroll
    for (int j = 0; j < 16; ++j) {
      S[j] = S[j] * w[j] + sa * (kk[j] * a[j]) + v * k[j];
      y += S[j] * r[j];
    }
    y += __shfl_xor(y, 1);
    y += __shfl_xor(y, 2);
    if (cq == 0) Yo[((size_t)b * SEQ_LEN + t) * 1024 + h * 64 + i] = y;
  }
}
DEV void p12_ret(const Params& p, int item, char* smem) {
  const int c = item % RET_NC, h = (item / RET_NC) & 3, b = item / (RET_NC * 4);
  const int tid = threadIdx.x, i = tid & 127, eh = tid >> 7;
  const float* Hc = (const float*)(p.ws + OFF_H);
  const float lg = ret_log2gamma(h);
  float* sS = (float*)smem;
  float* sRed = sS + 64 * 128;
  __syncthreads();
  {
    const float G = exp2f(128.f * lg);
    const float* KV0 = (const float*)(p.ws + OFF_RETKV) + (size_t)((b * 4 + h) * RET_NC) * 64 * 128;
    for (int w = tid; w < 64 * 128; w += NTHREADS) {
      float s = 0.f;
      for (int cc = 0; cc < c; ++cc) s = s * G + KV0[(size_t)cc * 64 * 128 + w];
      sS[w] = s;
    }
  }
  __syncthreads();
  const size_t tok0 = (size_t)b * SEQ_LEN + c * 128;
  float q[64];
  {
    const float* qr = Hc + (tok0 + i) * CD_IN + 1792 + h * 64;
#pragma unroll
    for (int d4 = 0; d4 < 16; ++d4) { const float4 v = ld4(qr + d4 * 4); q[d4 * 4] = v.x; q[d4 * 4 + 1] = v.y; q[d4 * 4 + 2] = v.z; q[d4 * 4 + 3] = v.w; }
  }
  float acc[64];
#pragma unroll
  for (int e = 0; e < 64; ++e) acc[e] = 0.f;
  {
    const float qs = exp2f((float)(i + 1) * lg);
#pragma unroll
    for (int d = 0; d < 64; ++d) {
      const float qd = q[d] * qs;
#pragma unroll
      for (int e4 = 0; e4 < 16; ++e4) {
        const float4 sv = ld4(sS + d * 128 + eh * 64 + e4 * 4);
        acc[e4 * 4] += qd * sv.x; acc[e4 * 4 + 1] += qd * sv.y; acc[e4 * 4 + 2] += qd * sv.z; acc[e4 * 4 + 3] += qd * sv.w;
      }
    }
  }
  const int jmax = ((tid >> 6) & 1) * 64 + 63;
  for (int j = 0; j <= jmax; ++j) {
    const float* kr = Hc + (tok0 + j) * CD_IN + 2048 + h * 64;
    float s = 0.f;
#pragma unroll
    for (int d4 = 0; d4 < 16; ++d4) { const float4 kv = ld4(kr + d4 * 4); s += q[d4 * 4] * kv.x + q[d4 * 4 + 1] * kv.y + q[d4 * 4 + 2] * kv.z + q[d4 * 4 + 3] * kv.w; }
    s = j <= i ? s * exp2f((float)(i - j) * lg) : 0.f;
    const float* vr = Hc + (tok0 + j) * CD_IN + 2304 + h * 128 + eh * 64;
#pragma unroll
    for (int e4 = 0; e4 < 16; ++e4) {
      const float4 vv = ld4(vr + e4 * 4);
      acc[e4 * 4] += s * vv.x; acc[e4 * 4 + 1] += s * vv.y; acc[e4 * 4 + 2] += s * vv.z; acc[e4 * 4 + 3] += s * vv.w;
    }
  }
  float s1 = 0.f;
#pragma unroll
  for (int e = 0; e < 64; ++e) s1 += acc[e];
  sRed[tid * 2] = s1;
  __syncthreads();
  const float mu = (s1 + sRed[(tid ^ 128) * 2]) * (1.f / 128.f);
  float s2 = 0.f;
#pragma unroll
  for (int e = 0; e < 64; ++e) { const float d = acc[e] - mu; s2 += d * d; }
  sRed[tid * 2 + 1] = s2;
  __syncthreads();
  const float rstd = rsqrtf((s2 + sRed[(tid ^ 128) * 2 + 1]) * (1.f / 128.f) + 1e-5f);
  float* MIX = (float*)(p.ws + OFF_MIX);
  const float* lgam = p.in[I_RET_LN_G] + h * 128 + eh * 64;
  const float* lbet = p.in[I_RET_LN_B] + h * 128 + eh * 64;
  const float* gate = Hc + (tok0 + i) * CD_IN + 2816 + h * 128 + eh * 64;
  float* dst = MIX + (tok0 + i) * 1024 + 512 + h * 128 + eh * 64;
#pragma unroll
  for (int e4 = 0; e4 < 16; ++e4) {
    const float4 gv = ld4(lgam + e4 * 4), bv = ld4(lbet + e4 * 4), gt = ld4(gate + e4 * 4);
    float4 o;
    o.x = siluf_(gt.x) * ((acc[e4 * 4] - mu) * rstd * gv.x + bv.x);
    o.y = siluf_(gt.y) * ((acc[e4 * 4 + 1] - mu) * rstd * gv.y + bv.y);
    o.z = siluf_(gt.z) * ((acc[e4 * 4 + 2] - mu) * rstd * gv.z + bv.z);
    o.w = siluf_(gt.w) * ((acc[e4 * 4 + 3] - mu) * rstd * gv.w + bv.w);
    st4(dst + e4 * 4, o);
  }
}
DEV void phase_p12(const Params& p, char* smem) {
  const int total = P12_SCAN_ITEMS + P12_RET_ITEMS;
  for (int it = blockIdx.x; it < total; it += gridDim.x) {
    if (it < P12_SCAN_ITEMS) p12_scan(p, it);
    else p12_ret(p, it - P12_SCAN_ITEMS, smem);
  }
}

#define P13_SMEM (8 * 128 * 4)
DEV void phase_p13(const Params& p, char* smem) {
  const int tid = threadIdx.x;
  const float* Hc = (const float*)(p.ws + OFF_H);
  const float* mu = p.in[I_RW_MU];
  float* sl = (float*)smem;
  float* MIX = (float*)(p.ws + OFF_MIX);
  const float* RWK = (const float*)(p.ws + OFF_RWK); const float* RWR = p.out + (size_t)NTOK * 512; const float* RWV = p.out;
  const float* g_up = p.in[I_RW_G_UP];
  for (int it = blockIdx.x; it < NTOK / 8; it += gridDim.x) {
    __syncthreads();
    for (int w = tid; w < 8 * 128; w += NTHREADS) {
      const size_t tok = (size_t)it * 8 + (w >> 7);
      sl[w] = sigmoidf_(shifted(Hc, tok, 1664 + (w & 127), mu));
    }
    __syncthreads();
#pragma unroll
    for (int cc = 0; cc < 2; ++cc) {
      const int c = tid + 256 * cc;
      float ag[8];
#pragma unroll
      for (int tt = 0; tt < 8; ++tt) ag[tt] = 0.f;
      for (int j = 0; j < 128; ++j) {
        const float gu = g_up[j * 512 + c];
#pragma unroll
        for (int tt = 0; tt < 8; ++tt) ag[tt] += sl[tt * 128 + j] * gu;
      }
      const float lng = p.in[I_RW_LN_G][c], lnb = p.in[I_RW_LN_B][c], rk = p.in[I_RW_R_K][c];
#pragma unroll
      for (int tt = 0; tt < 8; ++tt) {
        const size_t tok = (size_t)it * 8 + tt;
        const float y = MIX[tok * 1024 + c];
        const float m = wave_sum(y) * (1.f / 64.f);
        const float d = y - m;
        const float var = wave_sum(d * d) * (1.f / 64.f);
        const float yn = d * rsqrtf(var + 64e-5f) * lng + lnb;
        const float r = RWR[tok * 512 + c], k = RWK[tok * 512 + c], v = RWV[tok * 512 + c];
        const float bonus = wave_sum(r * k * rk) * v;
        MIX[tok * 1024 + c] = (yn + bonus) * ag[tt];
      }
    }
  }
}

#define NPHASES 20
#define SMEM_BYTES 49152
DEV void run_phase(const Params& p, int ph, char* smem) {
  switch (ph) {
    case 0: phase_gemm_in<0>(p, smem); break;
    case 1: phase_p1(p, smem); break;
    case 2: phase_p2(p, smem); break;
    case 3: phase_glu(p, smem); break;
    case 4: phase_outproj<0>(p, smem); break;
    case 5: phase_ln_router<0>(p, smem); break;
    case 6: phase_lists_shup<0>(p, smem); break;
    case 7: phase_routed_up<0>(p, smem); break;
    case 8: phase_down<0>(p, smem); break;
    case 9: phase_combine<0>(p, smem); break;
    case 10: phase_gemm_in<1>(p, smem); break;
    case 11: phase_p11(p, smem); break;
    case 12: phase_p12(p, smem); break;
    case 13: phase_p13(p, smem); break;
    case 14: phase_outproj<1>(p, smem); break;
    case 15: phase_ln_router<1>(p, smem); break;
    case 16: phase_lists_shup<1>(p, smem); break;
    case 17: phase_routed_up<1>(p, smem); break;
    case 18: phase_down<1>(p, smem); break;
    case 19: phase_combine<1>(p, smem); break;
  }
}
static_assert(P1_SMEM <= SMEM_BYTES, "smem");
static_assert(P2_SMEM <= SMEM_BYTES, "smem");
static_assert(P5_SMEM <= SMEM_BYTES, "smem");
static_assert(P7_SMEM <= SMEM_BYTES, "smem");
static_assert(P12_SMEM <= SMEM_BYTES, "smem");
static_assert(OFF_HS + (size_t)NTOK * 256 * 2 <= OFF_X1, "layout");

#ifndef CPU_EMU
template <int PH>
__global__ void __launch_bounds__(NTHREADS) phase_kernel(Params p) {
  __shared__ __attribute__((aligned(16))) char smem[SMEM_BYTES];
  run_phase(p, PH, smem);
}
template <int PH>
static void launch_phases(const Params& p, hipStream_t stream) {
  phase_kernel<PH><<<dim3(1024), dim3(NTHREADS), 0, stream>>>(p);
  if constexpr (PH + 1 < NPHASES) launch_phases<PH + 1>(p, stream);
}
#if MEGA
__global__ void __launch_bounds__(NTHREADS) mega_kernel(Params p) {
  __shared__ __attribute__((aligned(16))) char smem[SMEM_BYTES];
  cg::grid_group grid = cg::this_grid();
  for (int ph = 0; ph < NPHASES; ++ph) {
    run_phase(p, ph, smem);
    if (ph + 1 < NPHASES) grid.sync();
  }
}
#endif

extern "C" void kernel_launch(void* const* d_in, const int* in_sizes, int n_in, void* d_out, int out_size, void* d_ws, size_t ws_size,
                              hipStream_t stream) {
  Params p;
  for (int i = 0; i < N_INPUTS; ++i) p.in[i] = (const float*)d_in[i];
  p.out = (float*)d_out;
  p.ws = (char*)d_ws;
#if MEGA
  static int grid_blocks = 0;
  if (!grid_blocks) {
    int dev = 0, cus = 0, per_cu = 0;
    hipGetDevice(&dev);
    hipDeviceGetAttribute(&cus, hipDeviceAttributeMultiprocessorCount, dev);
    hipOccupancyMaxActiveBlocksPerMultiprocessor(&per_cu, mega_kernel, NTHREADS, 0);
    if (per_cu > 2) per_cu = 2;
    grid_blocks = cus * per_cu;
  }
  void* args[] = {&p};
  hipError_t e = hipLaunchCooperativeKernel((void*)mega_kernel, dim3(grid_blocks), dim3(NTHREADS), args, 0, stream);
  if (e != hipSuccess) fprintf(stderr, "cooperative launch failed: %s (grid %d)\n", hipGetErrorString(e), grid_blocks);
#else
  launch_phases<0>(p, stream);
#endif
}
#endif
```

```cpp
#ifdef CPU_EMU
#include "emu.h"
#else
#include <hip/hip_runtime.h>
#include <hip/hip_cooperative_groups.h>
#include <cstdio>
namespace cg = cooperative_groups;
#endif
#include <stdint.h>

#ifndef BATCH
#define BATCH 2
#endif
#ifndef SEQ_LEN
#define SEQ_LEN 8192
#endif
#ifndef MEGA
#define MEGA 1
#endif

#define DEV __device__ __forceinline__
#define NTOK (BATCH * SEQ_LEN)
#define DM 1024
#define AB_IN 1816
#define CD_IN 3328
#define NCMP ((SEQ_LEN - 32) / 16 + 1)
#define NBLK (SEQ_LEN / 64)
#define NB_CMP ((NCMP + 63) / 64)
#define S5_NC (SEQ_LEN / 64)
#define RET_NC (SEQ_LEN / 128)
#define ALPHA_F 1.4142135623730951f
#define NTHREADS 256

enum { I_X = 0, I_AB_W_IN, I_AB_W_OUT, I_S5_LAM_RE, I_S5_LAM_IM, I_S5_LOG_DT, I_S5_B_RE, I_S5_B_IM, I_S5_C_RE, I_S5_C_IM,
       I_S5_D, I_S5_W_GLU, I_S5_B_GLU, I_PE_K, I_PE_V, I_CK_W1, I_CK_B1, I_CK_W2, I_CV_W1, I_CV_B1, I_CV_W2,
       I_CD_W_IN, I_CD_W_OUT, I_RW_MU, I_RW_W0, I_RW_W_UP, I_RW_A0, I_RW_A_UP, I_RW_G_UP, I_RW_K_K, I_RW_K_A, I_RW_R_K,
       I_RW_LN_G, I_RW_LN_B, I_RET_LN_G, I_RET_LN_B, I_LN1_G, I_LN1_B, I_LN2_G, I_LN2_B, I_ROUTER, I_MOE_BIAS,
       I_MOE_W1, I_MOE_W3, I_MOE_W2, I_SH_W1, I_SH_W3, I_SH_W2, N_INPUTS };

struct Params {
  const float* in[N_INPUTS];
  float* out;
  char* ws;
};

#define MiB_TOK ((size_t)NTOK * 1024 * 4)
#define OFF_H 0
#define OFF_MIX ((size_t)NTOK * 3328 * 4)
#define OFF_X1 (OFF_MIX + MiB_TOK)
#define OFF_X2 (OFF_X1 + MiB_TOK)
#define OFF_R4 (OFF_X2 + MiB_TOK)
#define OFF_R5 (OFF_R4 + MiB_TOK)
#define OFF_Y OFF_H
#define OFF_HS (OFF_H + 4 * MiB_TOK)
#define OFF_FS OFF_X2
#define OFF_HR OFF_R4
#define OFF_TOPI (OFF_R5)
#define OFF_TOPG (OFF_TOPI + (size_t)NTOK * 8 * 4)
#define OFF_POSOF (OFF_TOPG + (size_t)NTOK * 8 * 4)
#define OFF_CNT (OFF_POSOF + (size_t)NTOK * 8 * 4)
#define OFF_LTOK (OFF_CNT + 1024)
#define OFF_LGATE (OFF_LTOK + (size_t)64 * NTOK * 4)
#define OFF_S5E (OFF_LGATE + (size_t)64 * NTOK * 4)
#define OFF_KCMP (OFF_S5E + (size_t)BATCH * S5_NC * 32 * 64 * 8)
#define OFF_VCMP (OFF_KCMP + (size_t)BATCH * NCMP * 2 * 64 * 4)
#define OFF_RETKV (OFF_VCMP + (size_t)BATCH * NCMP * 2 * 64 * 4)
#define OFF_END (OFF_RETKV + (size_t)BATCH * 4 * RET_NC * 64 * 128 * 4)
#define OFF_YGELU OFF_X1
#define OFF_RWW OFF_X1
#define OFF_RWK (OFF_X1 + (size_t)NTOK * 512 * 4)
#define OFF_RWKK OFF_R4
#define OFF_RWA (OFF_R4 + (size_t)NTOK * 512 * 4)

typedef short bf16x8 __attribute__((ext_vector_type(8)));
typedef float f32x16 __attribute__((ext_vector_type(16)));

#ifdef CPU_EMU
#define WAVE_SYNC() emu_wave_bar()
#else
#define WAVE_SYNC() __builtin_amdgcn_wave_barrier()
#endif

DEV float sigmoidf_(float x) { return 1.f / (1.f + __expf(-x)); }
DEV float siluf_(float x) { return x * sigmoidf_(x); }
DEV float geluf_(float x) { float u = 0.7978845608028654f * (x + 0.044715f * x * x * x); return 0.5f * x * (1.f + tanhf(u)); }
DEV unsigned short f2bf(float f) {
  unsigned u = __builtin_bit_cast(unsigned, f);
  u += 0x7FFFu + ((u >> 16) & 1u);
  return (unsigned short)(u >> 16);
}
DEV float bf2f(unsigned short h) { return __builtin_bit_cast(float, ((unsigned)h) << 16); }
DEV float wave_sum(float v) {
#pragma unroll
  for (int m = 32; m >= 1; m >>= 1) v += __shfl_xor(v, m);
  return v;
}
DEV float wave_max(float v) {
#pragma unroll
  for (int m = 32; m >= 1; m >>= 1) v = fmaxf(v, __shfl_xor(v, m));
  return v;
}
DEV float4 ld4(const float* p) { return *(const float4*)p; }
DEV void st4(float* p, float4 v) { *(float4*)p = v; }

#define GEMM_SMEM_BYTES (2 * 128 * 40 * 2)
template <bool ABF, class AROW, class BPTR, class EPI>
DEV void gemm_tile(AROW arow, BPTR bptr, int ldb, int K, EPI epi, char* smem_raw) {
  unsigned short(*sA)[40] = (unsigned short(*)[40])smem_raw;
  unsigned short(*sB)[40] = (unsigned short(*)[40])(smem_raw + 128 * 40 * 2);
  const int tid = threadIdx.x, lane = tid & 63, wave = tid >> 6;
  const int wm = wave >> 1, wn = wave & 1;
#if defined(CPU_EMU) && !defined(EMU_REAL_GEMM)
  for (int mi = 0; mi < 2; ++mi)
    for (int r = 0; r < 16; ++r) {
      const int row = wm * 64 + mi * 32 + (r & 3) + 8 * (r >> 2) + 4 * (lane >> 5);
      const int col = wn * 64 + (lane & 31);
      const void* arp = arow(row);
      float v[2] = {0.f, 0.f};
      for (int ni = 0; ni < 2; ++ni) {
        const float* bq = bptr(col + ni * 32);
        if (!arp || !bq) continue;
        float a = 0.f;
        for (int k = 0; k < K; ++k) {
          const float av = ABF ? bf2f(((const unsigned short*)arp)[k]) : bf2f(f2bf(((const float*)arp)[k]));
          a += av * bf2f(f2bf(bq[(size_t)k * ldb]));
        }
        v[ni] = a;
      }
      epi(row, col, v[0], v[1]);
    }
  return;
#endif
  const float* ap[4];
  const unsigned short* aph[2];
  if (ABF) {
#pragma unroll
    for (int i = 0; i < 2; ++i) aph[i] = (const unsigned short*)arow((tid >> 2) + 64 * i);
  } else {
#pragma unroll
    for (int i = 0; i < 4; ++i) ap[i] = (const float*)arow((tid >> 3) + 32 * i);
  }
  const float* bp = bptr(tid & 127);
  const int bkg = tid >> 7;
  float4 ra[4];
  uint4 rah[2];
  float rb[2][8];
  auto gload = [&](int k0) {
    if (ABF) {
#pragma unroll
      for (int i = 0; i < 2; ++i) rah[i] = aph[i] ? *(const uint4*)(aph[i] + k0 + (tid & 3) * 8) : make_uint4(0, 0, 0, 0);
    } else {
#pragma unroll
      for (int i = 0; i < 4; ++i) ra[i] = ap[i] ? ld4(ap[i] + k0 + (tid & 7) * 4) : make_float4(0.f, 0.f, 0.f, 0.f);
    }
#pragma unroll
    for (int i = 0; i < 2; ++i)
#pragma unroll
      for (int j = 0; j < 8; ++j) rb[i][j] = bp ? bp[(size_t)(k0 + (bkg + 2 * i) * 8 + j) * ldb] : 0.f;
  };
  auto sstore = [&]() {
    if (ABF) {
#pragma unroll
      for (int i = 0; i < 2; ++i) *(uint4*)&sA[(tid >> 2) + 64 * i][(tid & 3) * 8] = rah[i];
    } else {
#pragma unroll
      for (int i = 0; i < 4; ++i) {
        uint2 v;
        v.x = (unsigned)f2bf(ra[i].x) | ((unsigned)f2bf(ra[i].y) << 16);
        v.y = (unsigned)f2bf(ra[i].z) | ((unsigned)f2bf(ra[i].w) << 16);
        *(uint2*)&sA[(tid >> 3) + 32 * i][(tid & 7) * 4] = v;
      }
    }
#pragma unroll
    for (int i = 0; i < 2; ++i) {
      uint4 v;
      v.x = (unsigned)f2bf(rb[i][0]) | ((unsigned)f2bf(rb[i][1]) << 16);
      v.y = (unsigned)f2bf(rb[i][2]) | ((unsigned)f2bf(rb[i][3]) << 16);
      v.z = (unsigned)f2bf(rb[i][4]) | ((unsigned)f2bf(rb[i][5]) << 16);
      v.w = (unsigned)f2bf(rb[i][6]) | ((unsigned)f2bf(rb[i][7]) << 16);
      *(uint4*)&sB[tid & 127][(bkg + 2 * i) * 8] = v;
    }
  };
  f32x16 acc[2][2];
#pragma unroll
  for (int mi = 0; mi < 2; ++mi)
#pragma unroll
    for (int ni = 0; ni < 2; ++ni)
#pragma unroll
      for (int r = 0; r < 16; ++r) acc[mi][ni][r] = 0.f;
  gload(0);
  for (int k0 = 0; k0 < K; k0 += 32) {
    __syncthreads();
    sstore();
    __syncthreads();
    if (k0 + 32 < K) gload(k0 + 32);
#pragma unroll
    for (int ks = 0; ks < 2; ++ks) {
      bf16x8 af[2], bfr[2];
#pragma unroll
      for (int mi = 0; mi < 2; ++mi) af[mi] = *(const bf16x8*)&sA[wm * 64 + mi * 32 + (lane & 31)][ks * 16 + (lane >> 5) * 8];
#pragma unroll
      for (int ni = 0; ni < 2; ++ni) bfr[ni] = *(const bf16x8*)&sB[wn * 64 + ni * 32 + (lane & 31)][ks * 16 + (lane >> 5) * 8];
#pragma unroll
      for (int mi = 0; mi < 2; ++mi)
#pragma unroll
        for (int ni = 0; ni < 2; ++ni) acc[mi][ni] = __builtin_amdgcn_mfma_f32_32x32x16_bf16(af[mi], bfr[ni], acc[mi][ni], 0, 0, 0);
    }
  }
#pragma unroll
  for (int mi = 0; mi < 2; ++mi)
#pragma unroll
    for (int r = 0; r < 16; ++r) {
      int row = wm * 64 + mi * 32 + (r & 3) + 8 * (r >> 2) + 4 * (lane >> 5);
      int col = wn * 64 + (lane & 31);
      epi(row, col, acc[mi][0][r], acc[mi][1][r]);
    }
}

template <int LAYER>
DEV void phase_gemm_in(const Params& p, char* smem) {
  const int N = LAYER == 0 ? AB_IN : CD_IN;
  const float* A = LAYER == 0 ? p.in[I_X] : (const float*)(p.ws + OFF_X2);
  const float* B = LAYER == 0 ? p.in[I_AB_W_IN] : p.in[I_CD_W_IN];
  float* C = (float*)(p.ws + OFF_H);
  const int NT = (N + 127) / 128, MT = NTOK / 128;
  for (int it = blockIdx.x; it < MT * NT; it += gridDim.x) {
    const int tm = it / NT, tn = it % NT;
    const int m0 = tm * 128, n0 = tn * 128;
    gemm_tile<false>(
        [&](int r) { return (const void*)(A + (size_t)(m0 + r) * DM); },
        [&](int c) { return (n0 + c < N) ? (B + n0 + c) : (const float*)nullptr; }, N, DM,
        [&](int row, int col, float v0, float v1) {
          const int gm = m0 + row, gc = n0 + col;
          if (LAYER == 1 && gc >= 1792 && gc < 2304) {
            const int i = gc & 63;
            const float pos = (float)(gm % SEQ_LEN);
            const float inv = __expf(-(float)i * (9.210340371976184f / 32.f));
            float sn, cs;
            sincosf(pos * inv, &sn, &cs);
            float o0 = v0 * cs - v1 * sn, o1 = v1 * cs + v0 * sn;
            if (gc >= 2048) { o0 *= 0.125f; o1 *= 0.125f; }
            v0 = o0; v1 = o1;
          }
          if (gc < N) C[(size_t)gm * N + gc] = v0;
          if (gc + 32 < N) C[(size_t)gm * N + gc + 32] = v1;
        },
        smem);
  }
}

struct S5Const { float lb_re, lb_im; };
DEV void s5_consts(const Params& p, int g, int pp, float& lb_re, float& lb_im, float (&bbr)[16], float (&bbi)[16]) {
  const float dt = expf(p.in[I_S5_LOG_DT][g]);
  const float lr = p.in[I_S5_LAM_RE][g * 64 + pp], li = p.in[I_S5_LAM_IM][g * 64 + pp];
  const float mag = expf(lr * dt);
  float sn, cs;
  sincosf(li * dt, &sn, &cs);
  lb_re = mag * cs; lb_im = mag * sn;
  const float den = lr * lr + li * li;
  const float f_re = ((lb_re - 1.f) * lr + lb_im * li) / den;
  const float f_im = (lb_im * lr - (lb_re - 1.f) * li) / den;
  const float* br = p.in[I_S5_B_RE] + (size_t)(g * 64 + pp) * 16;
  const float* bi = p.in[I_S5_B_IM] + (size_t)(g * 64 + pp) * 16;
#pragma unroll
  for (int h = 0; h < 16; ++h) {
    bbr[h] = f_re * br[h] - f_im * bi[h];
    bbi[h] = f_re * bi[h] + f_im * br[h];
  }
}

#define P1_ROPE_ITEMS (NTOK / 16)
#define P1_S5A_ITEMS (BATCH * 32 * S5_NC / 4)
#define P1_CMP_TILES ((NCMP + 7) / 8)
#define P1_CMP_ITEMS (2 * BATCH * 2 * P1_CMP_TILES)
DEV void p1_rope(const Params& p, int item) {
  float* H = (float*)(p.ws + OFF_H);
  for (int w = threadIdx.x; w < 16 * 96; w += NTHREADS) {
    const int tok = item * 16 + w / 96;
    const int r = w % 96, hd = r >> 3, i = r & 7;
    const int col = hd < 8 ? 512 + hd * 64 : (hd < 10 ? 1280 + (hd - 8) * 64 : 1536 + (hd - 10) * 64);
    float* x = H + (size_t)tok * AB_IN + col;
    const float pos = (float)(tok % SEQ_LEN);
    const float inv = __expf(-(float)i * (13.122363377404328f / 8.f));
    float sn, cs;
    sincosf(pos * inv, &sn, &cs);
    const float x1 = x[i], x2 = x[i + 8];
    x[i] = x1 * cs - x2 * sn;
    x[i + 8] = x2 * cs + x1 * sn;
  }
}
DEV void p1_s5a(const Params& p, int item) {
  const int lane = threadIdx.x & 63, wave = threadIdx.x >> 6;
  const int idx = item * 4 + wave;
  const int g = idx & 31, c = (idx >> 5) % S5_NC, b = idx / (32 * S5_NC);
  float lb_re, lb_im, bbr[16], bbi[16];
  s5_consts(p, g, lane, lb_re, lb_im, bbr, bbi);
  const float* H = (const float*)(p.ws + OFF_H);
  float sr = 0.f, si = 0.f;
  for (int tt = 0; tt < 64; ++tt) {
    const float* u = H + (size_t)(b * SEQ_LEN + c * 64 + tt) * AB_IN + g * 16;
    float dr = 0.f, di = 0.f;
#pragma unroll
    for (int h4 = 0; h4 < 4; ++h4) {
      const float4 uv = ld4(u + h4 * 4);
      dr += uv.x * bbr[h4 * 4] + uv.y * bbr[h4 * 4 + 1] + uv.z * bbr[h4 * 4 + 2] + uv.w * bbr[h4 * 4 + 3];
      di += uv.x * bbi[h4 * 4] + uv.y * bbi[h4 * 4 + 1] + uv.z * bbi[h4 * 4 + 2] + uv.w * bbi[h4 * 4 + 3];
    }
    const float nr = lb_re * sr - lb_im * si + dr;
    const float ni = lb_re * si + lb_im * sr + di;
    sr = nr; si = ni;
  }
  float2* E = (float2*)(p.ws + OFF_S5E);
  E[((size_t)(b * S5_NC + c) * 32 + g) * 64 + lane] = make_float2(sr, si);
}
DEV void p1_compress(const Params& p, int item, char* smem) {
  const int tile = item % P1_CMP_TILES;
  int r = item / P1_CMP_TILES;
  const int g = r & 1; r >>= 1;
  const int b = r % BATCH; const int which = r / BATCH;
  const int n0 = tile * 8;
  const float* H = (const float*)(p.ws + OFF_H);
  const float* pe = which ? p.in[I_PE_V] : p.in[I_PE_K];
  const float* w1 = which ? p.in[I_CV_W1] : p.in[I_CK_W1];
  const float* b1 = which ? p.in[I_CV_B1] : p.in[I_CK_B1];
  const float* w2 = which ? p.in[I_CV_W2] : p.in[I_CK_W2];
  const int colbase = (which ? 1152 : 1024) + g * 64;
  float* sTok = (float*)smem;
  float* sPart = sTok + 144 * 64;
  float* sHid = sPart + 2 * 8 * 128;
  const int tid = threadIdx.x;
  __syncthreads();
  for (int w = tid; w < 144 * 16; w += NTHREADS) {
    const int tr = w >> 4, c4 = (w & 15) * 4;
    int tok = n0 * 16 + tr; if (tok > SEQ_LEN - 1) tok = SEQ_LEN - 1;
    st4(sTok + tr * 64 + c4, ld4(H + (size_t)(b * SEQ_LEN + tok) * AB_IN + colbase + c4));
  }
  __syncthreads();
  {
    const int hid = tid & 127, kh = tid >> 7;
    float acc[8];
#pragma unroll
    for (int rr = 0; rr < 8; ++rr) acc[rr] = 0.f;
    for (int k = kh * 1024; k < kh * 1024 + 1024; ++k) {
      const float w = w1[(size_t)k * 128 + hid];
      const int j = k >> 6, d = k & 63;
      const float pv = pe[j * 64 + d];
#pragma unroll
      for (int rr = 0; rr < 8; ++rr) acc[rr] += (sTok[(rr * 16 + j) * 64 + d] + pv) * w;
    }
#pragma unroll
    for (int rr = 0; rr < 8; ++rr) sPart[(kh * 8 + rr) * 128 + hid] = acc[rr];
  }
  __syncthreads();
  for (int w = tid; w < 8 * 128; w += NTHREADS) {
    const int rr = w >> 7, hid = w & 127;
    sHid[w] = geluf_(sPart[rr * 128 + hid] + sPart[(8 + rr) * 128 + hid] + b1[hid]);
  }
  __syncthreads();
  float* sOut = sPart;
  for (int w = tid; w < 8 * 64; w += NTHREADS) {
    const int rr = w >> 6, d = w & 63;
    float a = 0.f;
    for (int hid = 0; hid < 128; ++hid) a += sHid[rr * 128 + hid] * w2[hid * 64 + d];
    sOut[w] = a;
  }
  __syncthreads();
  float* dst = (float*)(p.ws + (which ? OFF_VCMP : OFF_KCMP));
  for (int w = tid; w < 8 * 64; w += NTHREADS) {
    const int rr = w >> 6, d = w & 63;
    const int n = n0 + rr;
    if (n >= NCMP) continue;
    float v = sOut[w];
    if (which == 0 && d < 16) {
      const int i = d & 7;
      const float pos = (float)(n * 16 + 31);
      const float inv = __expf(-(float)i * (13.122363377404328f / 8.f));
      float sn, cs;
      sincosf(pos * inv, &sn, &cs);
      const float x1 = sOut[rr * 64 + i], x2 = sOut[rr * 64 + i + 8];
      v = d < 8 ? x1 * cs - x2 * sn : x2 * cs + x1 * sn;
    }
    dst[((size_t)(b * NCMP + n) * 2 + g) * 64 + d] = v;
  }
}
#define P1_SMEM ((144 * 64 + 2 * 8 * 128 + 8 * 128) * 4)
DEV void phase_p1(const Params& p, char* smem) {
  const int total = P1_ROPE_ITEMS + P1_S5A_ITEMS + P1_CMP_ITEMS;
  for (int it = blockIdx.x; it < total; it += gridDim.x) {
    if (it < P1_CMP_ITEMS) p1_compress(p, it, smem);
    else if (it < P1_CMP_ITEMS + P1_S5A_ITEMS) p1_s5a(p, it - P1_CMP_ITEMS);
    else p1_rope(p, it - P1_CMP_ITEMS - P1_S5A_ITEMS);
  }
}

#define P2_S5C_ITEMS (BATCH * 32 * S5_NC / 4)
#define P2_ATT_ITEMS (NTOK * 2 / 4)
#define S5C_ROW 132
#define P2_S5C_SMEM (4 * 16 * S5C_ROW * 4)
DEV void p2_s5c(const Params& p, int item, char* smem) {
  const int lane = threadIdx.x & 63, wave = threadIdx.x >> 6;
  const int idx = item * 4 + wave;
  const int g = idx & 31, c = (idx >> 5) % S5_NC, b = idx / (32 * S5_NC);
  float lb_re, lb_im, bbr[16], bbi[16];
  s5_consts(p, g, lane, lb_re, lb_im, bbr, bbi);
  float ar = lb_re, ai = lb_im;
#pragma unroll
  for (int s = 0; s < 6; ++s) { const float nr = ar * ar - ai * ai, ni = 2.f * ar * ai; ar = nr; ai = ni; }
  const float2* E = (const float2*)(p.ws + OFF_S5E);
  float sr = 0.f, si = 0.f;
  for (int cc = 0; cc < c; ++cc) {
    const float2 e = E[((size_t)(b * S5_NC + cc) * 32 + g) * 64 + lane];
    const float nr = ar * sr - ai * si + e.x, ni = ar * si + ai * sr + e.y;
    sr = nr; si = ni;
  }
  const float* H = (const float*)(p.ws + OFF_H);
  float* sS = (float*)smem + wave * 16 * S5C_ROW;
  const float* cre = p.in[I_S5_C_RE] + (size_t)g * 16 * 64;
  const float* cim = p.in[I_S5_C_IM] + (size_t)g * 16 * 64;
  float* YG = (float*)(p.ws + OFF_YGELU);
  for (int sc = 0; sc < 4; ++sc) {
    for (int tt = 0; tt < 16; ++tt) {
      const float* u = H + (size_t)(b * SEQ_LEN + c * 64 + sc * 16 + tt) * AB_IN + g * 16;
      float dr = 0.f, di = 0.f;
#pragma unroll
      for (int h4 = 0; h4 < 4; ++h4) {
        const float4 uv = ld4(u + h4 * 4);
        dr += uv.x * bbr[h4 * 4] + uv.y * bbr[h4 * 4 + 1] + uv.z * bbr[h4 * 4 + 2] + uv.w * bbr[h4 * 4 + 3];
        di += uv.x * bbi[h4 * 4] + uv.y * bbi[h4 * 4 + 1] + uv.z * bbi[h4 * 4 + 2] + uv.w * bbi[h4 * 4 + 3];
      }
      const float nr = lb_re * sr - lb_im * si + dr, ni = lb_re * si + lb_im * sr + di;
      sr = nr; si = ni;
      sS[tt * S5C_ROW + lane] = sr;
      sS[tt * S5C_ROW + 64 + lane] = si;
    }
    __syncthreads();
    {
      const int tt = lane >> 2, hq = lane & 3;
      float y[4] = {0.f, 0.f, 0.f, 0.f};
      for (int k = 0; k < 64; k += 4) {
        const float4 vr = ld4(sS + tt * S5C_ROW + k), vi = ld4(sS + tt * S5C_ROW + 64 + k);
#pragma unroll
        for (int hh = 0; hh < 4; ++hh) {
          const float4 cr = ld4(cre + (hq * 4 + hh) * 64 + k), ci = ld4(cim + (hq * 4 + hh) * 64 + k);
          y[hh] += vr.x * cr.x + vr.y * cr.y + vr.z * cr.z + vr.w * cr.w - (vi.x * ci.x + vi.y * ci.y + vi.z * ci.z + vi.w * ci.w);
        }
      }
      const size_t tok = (size_t)(b * SEQ_LEN + c * 64 + sc * 16 + tt);
      const int ch = g * 16 + hq * 4;
      const float4 uv = ld4(H + tok * AB_IN + ch);
      const float4 dv = ld4(p.in[I_S5_D] + ch);
      float4 o;
      o.x = geluf_(y[0] + dv.x * uv.x); o.y = geluf_(y[1] + dv.y * uv.y);
      o.z = geluf_(y[2] + dv.z * uv.z); o.w = geluf_(y[3] + dv.w * uv.w);
      st4(YG + tok * 512 + ch, o);
    }
    __syncthreads();
  }
}

template <int NB, class KF, class VF>
DEV void attn_branch(const float* q_lds, float* p_lds, KF kf, VF vf, float (&o)[4], float* imp_out, int lane) {
  float s[4][NB];
  float m[4] = {-INFINITY, -INFINITY, -INFINITY, -INFINITY};
  bool act[NB];
#pragma unroll
  for (int i = 0; i < NB; ++i) {
    bool active, valid;
    const float* kr = kf(i, active, valid);
    act[i] = active;
#pragma unroll
    for (int h = 0; h < 4; ++h) s[h][i] = -INFINITY;
    if (active) {
      float d[4] = {0.f, 0.f, 0.f, 0.f};
#pragma unroll
      for (int c = 0; c < 16; ++c) {
        const float4 kv = ld4(kr + c * 4);
#pragma unroll
        for (int h = 0; h < 4; ++h) {
          const float4 qv = ld4(q_lds + h * 64 + c * 4);
          d[h] += kv.x * qv.x + kv.y * qv.y + kv.z * qv.z + kv.w * qv.w;
        }
      }
#pragma unroll
      for (int h = 0; h < 4; ++h) { s[h][i] = valid ? d[h] : -INFINITY; m[h] = fmaxf(m[h], s[h][i]); }
    }
  }
  float l[4];
#pragma unroll
  for (int h = 0; h < 4; ++h) {
    m[h] = wave_max(m[h]);
    float e = 0.f;
    if (m[h] > -INFINITY) {
#pragma unroll
      for (int i = 0; i < NB; ++i) { s[h][i] = __expf(s[h][i] - m[h]); e += s[h][i]; }
    } else {
#pragma unroll
      for (int i = 0; i < NB; ++i) s[h][i] = 0.f;
    }
    l[h] = wave_sum(e);
    l[h] = l[h] > 0.f ? 1.f / l[h] : 0.f;
  }
#pragma unroll
  for (int i = 0; i < NB; ++i) {
    float4 pv;
    pv.x = s[0][i] * l[0]; pv.y = s[1][i] * l[1]; pv.z = s[2][i] * l[2]; pv.w = s[3][i] * l[3];
    if (imp_out) imp_out[i * 64 + lane] = pv.x + pv.y + pv.z + pv.w;
    if (act[i]) {
      WAVE_SYNC();
      st4(p_lds + lane * 4, pv);
      WAVE_SYNC();
      for (int kk = 0; kk < 64; ++kk) {
        const float* vr = vf(i, kk);
        if (!vr) break;
        const float4 pp = ld4(p_lds + kk * 4);
        const float vv = vr[lane];
        o[0] += pp.x * vv; o[1] += pp.y * vv; o[2] += pp.z * vv; o[3] += pp.w * vv;
      }
    }
  }
  WAVE_SYNC();
}

#define ATT_WAVE_FLOATS (256 + 256 + (NB_CMP * 64 + 8) + 16)
#define P2_ATT_SMEM (4 * ATT_WAVE_FLOATS * 4)
DEV void p2_attn(const Params& p, int item, char* smem) {
  const int lane = threadIdx.x & 63, wave = threadIdx.x >> 6;
  const int idx = item * 4 + wave;
  const int g = idx & 1, t = (idx >> 1) % SEQ_LEN, b = idx / (2 * SEQ_LEN);
  float* base = (float*)smem + wave * ATT_WAVE_FLOATS;
  float* q_lds = base;
  float* p_lds = base + 256;
  float* L = base + 512;
  int* sel_lds = (int*)(base + 512 + NB_CMP * 64 + 8);
  const float* H = (const float*)(p.ws + OFF_H);
  const size_t tok = (size_t)b * SEQ_LEN + t;
  const float* hrow = H + tok * AB_IN;
  WAVE_SYNC();
#pragma unroll
  for (int h = 0; h < 4; ++h) q_lds[h * 64 + lane] = hrow[512 + (g * 4 + h) * 64 + lane] * 0.125f;
  if (lane == 0) L[0] = 0.f;
  WAVE_SYNC();
  float o_cmp[4] = {0.f, 0.f, 0.f, 0.f};
  const int nvalid = t >= 31 ? (t - 31) / 16 + 1 : 0;
  const float* KC = (const float*)(p.ws + OFF_KCMP);
  const float* VC = (const float*)(p.ws + OFF_VCMP);
  attn_branch<NB_CMP>(
      q_lds, p_lds,
      [&](int i, bool& active, bool& valid) {
        const int n = i * 64 + lane;
        active = i * 64 < nvalid; valid = n < nvalid;
        const int nc = n < NCMP ? n : NCMP - 1;
        return KC + ((size_t)(b * NCMP + nc) * 2 + g) * 64;
      },
      [&](int i, int kk) {
        const int n = i * 64 + kk;
        return n < nvalid ? VC + ((size_t)(b * NCMP + n) * 2 + g) * 64 : (const float*)nullptr;
      },
      o_cmp, L + 1, lane);
  WAVE_SYNC();
  const int cur = t >> 6;
  unsigned long long key[(NBLK + 63) / 64];
#pragma unroll
  for (int c = 0; c < (NBLK + 63) / 64; ++c) {
    const int j = lane + 64 * c;
    key[c] = 0ull;
    if (j < NBLK) {
      float val = L[4 * j] + 2.f * (L[4 * j + 1] + L[4 * j + 2] + L[4 * j + 3]) + L[4 * j + 4];
      const bool forced = (j == 0) | (j == cur) | (j == cur - 1);
      float score = forced ? 1e6f : val;
      if (j * 64 > t) score = -1e6f;
      unsigned u = __builtin_bit_cast(unsigned, score);
      u = (u & 0x80000000u) ? ~u : (u | 0x80000000u);
      key[c] = ((unsigned long long)u << 32) | (unsigned)(0xFFFFFFFFu - (unsigned)j);
    }
  }
  for (int r = 0; r < 16; ++r) {
    unsigned long long best = key[0];
#pragma unroll
    for (int c = 1; c < (NBLK + 63) / 64; ++c) best = key[c] > best ? key[c] : best;
#pragma unroll
    for (int mm = 32; mm >= 1; mm >>= 1) {
      const unsigned lo = __shfl_xor((unsigned)best, mm), hi = __shfl_xor((unsigned)(best >> 32), mm);
      const unsigned long long ob = ((unsigned long long)hi << 32) | lo;
      best = ob > best ? ob : best;
    }
    const int j = (int)(0xFFFFFFFFu - (unsigned)(best & 0xFFFFFFFFull));
#pragma unroll
    for (int c = 0; c < (NBLK + 63) / 64; ++c) if (lane + 64 * c == j) key[c] = 0ull;
    if (lane == 0) sel_lds[r] = j;
  }
  WAVE_SYNC();
  float o_slc[4] = {0.f, 0.f, 0.f, 0.f};
  attn_branch<16>(
      q_lds, p_lds,
      [&](int i, bool& active, bool& valid) {
        const int j = sel_lds[i];
        const int kt = j * 64 + lane;
        active = j * 64 <= t; valid = kt <= t;
        return H + ((size_t)b * SEQ_LEN + kt) * AB_IN + 1280 + g * 64;
      },
      [&](int i, int kk) {
        const int kt = sel_lds[i] * 64 + kk;
        return kt <= t ? H + ((size_t)b * SEQ_LEN + kt) * AB_IN + 1408 + g * 64 : (const float*)nullptr;
      },
      o_slc, nullptr, lane);
  float o_win[4] = {0.f, 0.f, 0.f, 0.f};
  attn_branch<8>(
      q_lds, p_lds,
      [&](int i, bool& active, bool& valid) {
        const int kt = t - 511 + i * 64 + lane;
        active = t - 511 + i * 64 + 63 >= 0; valid = kt >= 0;
        return H + ((size_t)b * SEQ_LEN + (kt < 0 ? 0 : kt)) * AB_IN + 1536 + g * 64;
      },
      [&](int i, int kk) {
        const int kt = t - 511 + i * 64 + kk;
        return H + ((size_t)b * SEQ_LEN + (kt < 0 ? 0 : kt)) * AB_IN + 1664 + g * 64;
      },
      o_win, nullptr, lane);
  float* MIX = (float*)(p.ws + OFF_MIX);
  const float ov_c[4] = {o_cmp[0], o_cmp[1], o_cmp[2], o_cmp[3]};
#pragma unroll
  for (int h = 0; h < 4; ++h) {
    const int hd = g * 4 + h;
    const float g0 = sigmoidf_(hrow[1792 + hd * 3 + 0]), g1 = sigmoidf_(hrow[1792 + hd * 3 + 1]), g2 = sigmoidf_(hrow[1792 + hd * 3 + 2]);
    MIX[tok * 1024 + 512 + hd * 64 + lane] = g0 * ov_c[h] + g1 * o_slc[h] + g2 * o_win[h];
  }
}
#define P2_SMEM (P2_S5C_SMEM > P2_ATT_SMEM ? P2_S5C_SMEM : P2_ATT_SMEM)
DEV void phase_p2(const Params& p, char* smem) {
  const int total = P2_S5C_ITEMS + P2_ATT_ITEMS;
  for (int it = blockIdx.x; it < total; it += gridDim.x) {
    if (it < P2_S5C_ITEMS) p2_s5c(p, it, smem);
    else p2_attn(p, it - P2_S5C_ITEMS, smem);
  }
}

DEV void phase_glu(const Params& p, char* smem) {
  const float* A = (const float*)(p.ws + OFF_YGELU);
  const float* B = p.in[I_S5_W_GLU];
  const float* bias = p.in[I_S5_B_GLU];
  float* MIX = (float*)(p.ws + OFF_MIX);
  const int NT = 4, MT = NTOK / 128;
  for (int it = blockIdx.x; it < MT * NT; it += gridDim.x) {
    const int m0 = (it / NT) * 128, n0 = (it % NT) * 128;
    gemm_tile<false>(
        [&](int r) { return (const void*)(A + (size_t)(m0 + r) * 512); },
        [&](int c) { return B + n0 + c; }, 512, 512,
        [&](int row, int col, float v0, float v1) {
          const size_t gm = m0 + row; const int gc = n0 + col;
          const float y0 = A[gm * 512 + gc], y1 = A[gm * 512 + gc + 32];
          MIX[gm * 1024 + gc] = y0 * sigmoidf_(v0 + bias[gc]);
          MIX[gm * 1024 + gc + 32] = y1 * sigmoidf_(v1 + bias[gc + 32]);
        },
        smem);
  }
}

template <int LAYER>
DEV void phase_outproj(const Params& p, char* smem) {
  const float* A = (const float*)(p.ws + OFF_MIX);
  const float* B = LAYER == 0 ? p.in[I_AB_W_OUT] : p.in[I_CD_W_OUT];
  const float* xin = LAYER == 0 ? p.in[I_X] : (const float*)(p.ws + OFF_X2);
  float* PRE = (float*)(p.ws + OFF_H);
  const int NT = 8, MT = NTOK / 128;
  for (int it = blockIdx.x; it < MT * NT; it += gridDim.x) {
    const int m0 = (it / NT) * 128, n0 = (it % NT) * 128;
    gemm_tile<false>(
        [&](int r) { return (const void*)(A + (size_t)(m0 + r) * 1024); },
        [&](int c) { return B + n0 + c; }, 1024, 1024,
        [&](int row, int col, float v0, float v1) {
          const size_t o = (size_t)(m0 + row) * 1024 + n0 + col;
          PRE[o] = ALPHA_F * xin[o] + v0;
          PRE[o + 32] = ALPHA_F * xin[o + 32] + v1;
        },
        smem);
  }
}

DEV void wave_ln(float (&v)[16], const float* gam, const float* bet, int lane) {
  float s = 0.f;
#pragma unroll
  for (int i = 0; i < 16; ++i) s += v[i];
  const float mu = wave_sum(s) * (1.f / 1024.f);
  float q = 0.f;
#pragma unroll
  for (int i = 0; i < 16; ++i) { const float d = v[i] - mu; q += d * d; }
  const float rstd = rsqrtf(wave_sum(q) * (1.f / 1024.f) + 1e-5f);
#pragma unroll
  for (int i = 0; i < 4; ++i) {
    const float4 gv = ld4(gam + lane * 4 + 256 * i), bv = ld4(bet + lane * 4 + 256 * i);
    v[i * 4 + 0] = (v[i * 4 + 0] - mu) * rstd * gv.x + bv.x;
    v[i * 4 + 1] = (v[i * 4 + 1] - mu) * rstd * gv.y + bv.y;
    v[i * 4 + 2] = (v[i * 4 + 2] - mu) * rstd * gv.z + bv.z;
    v[i * 4 + 3] = (v[i * 4 + 3] - mu) * rstd * gv.w + bv.w;
  }
}

#define P5_SMEM (4 * (1024 + 64) * 4)
template <int LAYER>
DEV void phase_ln_router(const Params& p, char* smem) {
  const int lane = threadIdx.x & 63, wave = threadIdx.x >> 6;
  const float* PRE = (const float*)(p.ws + OFF_H);
  float* X1 = (float*)(p.ws + OFF_X1);
  const float* router = p.in[I_ROUTER] + (size_t)LAYER * 1024 * 64;
  const float* bias = p.in[I_MOE_BIAS] + LAYER * 64;
  int* TOPI = (int*)(p.ws + OFF_TOPI);
  float* TOPG = (float*)(p.ws + OFF_TOPG);
  float* xs = (float*)smem + wave * (1024 + 64);
  float* ms = xs + 1024;
  for (int it = blockIdx.x; it < NTOK / 4; it += gridDim.x) {
    const size_t tok = (size_t)it * 4 + wave;
    float v[16];
#pragma unroll
    for (int i = 0; i < 4; ++i) {
      const float4 a = ld4(PRE + tok * 1024 + lane * 4 + 256 * i);
      v[i * 4] = a.x; v[i * 4 + 1] = a.y; v[i * 4 + 2] = a.z; v[i * 4 + 3] = a.w;
    }
    wave_ln(v, p.in[I_LN1_G] + LAYER * 1024, p.in[I_LN1_B] + LAYER * 1024, lane);
    WAVE_SYNC();
#pragma unroll
    for (int i = 0; i < 4; ++i) {
      const float4 a = make_float4(v[i * 4], v[i * 4 + 1], v[i * 4 + 2], v[i * 4 + 3]);
      st4(X1 + tok * 1024 + lane * 4 + 256 * i, a);
      st4(xs + lane * 4 + 256 * i, a);
    }
    WAVE_SYNC();
    float logit = 0.f;
    for (int k = 0; k < 1024; k += 4) {
      const float4 xv = ld4(xs + k);
      logit += xv.x * router[(size_t)k * 64 + lane] + xv.y * router[(size_t)(k + 1) * 64 + lane] +
               xv.z * router[(size_t)(k + 2) * 64 + lane] + xv.w * router[(size_t)(k + 3) * 64 + lane];
    }
    const float score = 1.f / (1.f + expf(-logit));
    const float biased = score + bias[lane];
    float m1 = biased; int a1 = lane;
#pragma unroll
    for (int mm = 1; mm <= 4; mm <<= 1) {
      const float ov = __shfl_xor(m1, mm); const int oa = __shfl_xor(a1, mm);
      if (ov > m1 || (ov == m1 && oa < a1)) { m1 = ov; a1 = oa; }
    }
    float m2 = lane == a1 ? -INFINITY : biased;
#pragma unroll
    for (int mm = 1; mm <= 4; mm <<= 1) m2 = fmaxf(m2, __shfl_xor(m2, mm));
    const float gs = m1 + m2;
    const int mygrp = lane >> 3;
    int rank = 0;
#pragma unroll
    for (int gg = 0; gg < 8; ++gg) {
      const float og = __shfl(gs, gg * 8);
      rank += (og > gs || (og == gs && gg < mygrp)) ? 1 : 0;
    }
    const float masked = rank < 4 ? biased : -INFINITY;
    WAVE_SYNC();
    ms[lane] = masked;
    WAVE_SYNC();
    int erank = 0;
    for (int e = 0; e < 64; ++e) {
      const float ov = ms[e];
      erank += (ov > masked || (ov == masked && e < lane)) ? 1 : 0;
    }
    const bool selected = erank < 8;
    const float gsum = wave_sum(selected ? score : 0.f);
    if (selected) {
      TOPI[tok * 8 + erank] = lane;
      TOPG[tok * 8 + erank] = score / gsum * 2.5f;
    }
    WAVE_SYNC();
  }
}

#define P6_SMEM GEMM_SMEM_BYTES
template <int LAYER>
DEV void phase_lists_shup(const Params& p, char* smem) {
  const int tid = threadIdx.x, lane = tid & 63, wave = tid >> 6;
  const int* TOPI = (const int*)(p.ws + OFF_TOPI);
  const float* TOPG = (const float*)(p.ws + OFF_TOPG);
  int* POSOF = (int*)(p.ws + OFF_POSOF);
  int* CNT = (int*)(p.ws + OFF_CNT);
  int* LTOK = (int*)(p.ws + OFF_LTOK);
  float* LGATE = (float*)(p.ws + OFF_LGATE);
  const float* X1 = (const float*)(p.ws + OFF_X1);
  unsigned short* HS = (unsigned short*)(p.ws + OFF_HS);
  const float* W1 = p.in[I_SH_W1] + (size_t)LAYER * 1024 * 256;
  const float* W3 = p.in[I_SH_W3] + (size_t)LAYER * 1024 * 256;
  const int MT = NTOK / 128;
  const int total = 64 + MT * 4;
  int* swave = (int*)smem;
  for (int it = blockIdx.x; it < total; it += gridDim.x) {
    if (it < 64) {
      const int e = it;
      int base = 0;
      for (int t0 = 0; t0 < NTOK; t0 += NTHREADS) {
        const int tok = t0 + tid;
        int slot = -1;
#pragma unroll
        for (int s = 0; s < 8; ++s) if (TOPI[(size_t)tok * 8 + s] == e) slot = s;
        const unsigned long long bal = __ballot(slot >= 0);
        const int pre = __popcll(bal & ((1ull << lane) - 1ull));
        __syncthreads();
        if (lane == 0) swave[wave] = __popcll(bal);
        __syncthreads();
        int woff = 0, tot = 0;
#pragma unroll
        for (int w = 0; w < 4; ++w) { const int c = swave[w]; if (w < wave) woff += c; tot += c; }
        if (slot >= 0) {
          const int pos = base + woff + pre;
          LTOK[(size_t)e * NTOK + pos] = tok;
          LGATE[(size_t)e * NTOK + pos] = TOPG[(size_t)tok * 8 + slot];
          POSOF[(size_t)tok * 8 + slot] = pos;
        }
        base += tot;
      }
      if (tid == 0) CNT[e] = base;
      __syncthreads();
    } else {
      const int it2 = it - 64;
      const int m0 = (it2 / 4) * 128, ct = it2 % 4;
      gemm_tile<false>(
          [&](int r) { return (const void*)(X1 + (size_t)(m0 + r) * 1024); },
          [&](int c) { return (((c >> 5) & 1) ? W3 : W1) + ct * 64 + (c >> 6) * 32 + (c & 31); }, 256, 1024,
          [&](int row, int col, float v0, float v1) {
            const int lc = ct * 64 + (col >> 6) * 32 + (col & 31);
            HS[(size_t)(m0 + row) * 256 + lc] = f2bf(siluf_(v0) * v1);
          },
          smem);
    }
  }
}

struct ExpMap { int tstart[65]; int rbase[65]; };
DEV void build_expmap(const Params& p, ExpMap* em) {
  __syncthreads();
  if (threadIdx.x == 0) {
    const int* CNT = (const int*)(p.ws + OFF_CNT);
    int ts = 0, rb = 0;
    for (int e = 0; e < 64; ++e) {
      em->tstart[e] = ts; em->rbase[e] = rb;
      const int c = CNT[e];
      ts += (c + 127) / 128; rb += c;
    }
    em->tstart[64] = ts; em->rbase[64] = rb;
  }
  __syncthreads();
}
DEV int find_expert(const ExpMap* em, int rt) {
  int e = 0;
  for (int k = 0; k < 64; ++k) if (em->tstart[k + 1] <= rt) e = k + 1;
  return e;
}

#define P7_SMEM (GEMM_SMEM_BYTES + 1024)
template <int LAYER>
DEV void phase_routed_up(const Params& p, char* smem) {
  ExpMap* em = (ExpMap*)(smem + GEMM_SMEM_BYTES);
  build_expmap(p, em);
  const int* CNT = (const int*)(p.ws + OFF_CNT);
  const int* LTOK = (const int*)(p.ws + OFF_LTOK);
  const float* X1 = (const float*)(p.ws + OFF_X1);
  unsigned short* HR = (unsigned short*)(p.ws + OFF_HR);
  const int total = em->tstart[64] * 4;
  for (int it = blockIdx.x; it < total; it += gridDim.x) {
    const int rt = it >> 2, ct = it & 3;
    const int e = find_expert(em, rt);
    const int r0 = (rt - em->tstart[e]) * 128;
    const int cnt = CNT[e], rbase = em->rbase[e];
    const float* W1 = p.in[I_MOE_W1] + ((size_t)LAYER * 64 + e) * 1024 * 256;
    const float* W3 = p.in[I_MOE_W3] + ((size_t)LAYER * 64 + e) * 1024 * 256;
    gemm_tile<false>(
        [&](int r) { return (r0 + r < cnt) ? (const void*)(X1 + (size_t)LTOK[(size_t)e * NTOK + r0 + r] * 1024) : (const void*)nullptr; },
        [&](int c) { return (((c >> 5) & 1) ? W3 : W1) + ct * 64 + (c >> 6) * 32 + (c & 31); }, 256, 1024,
        [&](int row, int col, float v0, float v1) {
          if (r0 + row < cnt) {
            const int lc = ct * 64 + (col >> 6) * 32 + (col & 31);
            HR[(size_t)(rbase + r0 + row) * 256 + lc] = f2bf(siluf_(v0) * v1);
          }
        },
        smem);
  }
}

template <int LAYER>
DEV void phase_down(const Params& p, char* smem) {
  ExpMap* em = (ExpMap*)(smem + GEMM_SMEM_BYTES);
  build_expmap(p, em);
  const int* CNT = (const int*)(p.ws + OFF_CNT);
  const float* LGATE = (const float*)(p.ws + OFF_LGATE);
  const unsigned short* HR = (const unsigned short*)(p.ws + OFF_HR);
  const unsigned short* HS = (const unsigned short*)(p.ws + OFF_HS);
  unsigned short* Y = (unsigned short*)(p.ws + OFF_Y);
  float* FS = (float*)(p.ws + OFF_FS);
  const int nrouted = em->tstart[64] * 8;
  const int total = nrouted + (NTOK / 128) * 8;
  for (int it = blockIdx.x; it < total; it += gridDim.x) {
    if (it < nrouted) {
      const int rt = it >> 3, ct = it & 7;
      const int e = find_expert(em, rt);
      const int r0 = (rt - em->tstart[e]) * 128;
      const int cnt = CNT[e], rbase = em->rbase[e];
      const float* W2 = p.in[I_MOE_W2] + ((size_t)LAYER * 64 + e) * 256 * 1024;
      const int n0 = ct * 128;
      gemm_tile<true>(
          [&](int r) { return (r0 + r < cnt) ? (const void*)(HR + (size_t)(rbase + r0 + r) * 256) : (const void*)nullptr; },
          [&](int c) { return W2 + n0 + c; }, 1024, 256,
          [&](int row, int col, float v0, float v1) {
            if (r0 + row < cnt) {
              const float gt = LGATE[(size_t)e * NTOK + r0 + row];
              const size_t o = (size_t)(rbase + r0 + row) * 1024 + n0 + col;
              Y[o] = f2bf(v0 * gt); Y[o + 32] = f2bf(v1 * gt);
            }
          },
          smem);
    } else {
      const int it2 = it - nrouted;
      const int m0 = (it2 >> 3) * 128, n0 = (it2 & 7) * 128;
      const float* W2 = p.in[I_SH_W2] + (size_t)LAYER * 256 * 1024;
      gemm_tile<true>(
          [&](int r) { return (const void*)(HS + (size_t)(m0 + r) * 256); },
          [&](int c) { return W2 + n0 + c; }, 1024, 256,
          [&](int row, int col, float v0, float v1) {
            const size_t o = (size_t)(m0 + row) * 1024 + n0 + col;
            FS[o] = v0; FS[o + 32] = v1;
          },
          smem);
    }
  }
}

template <int LAYER>
DEV void phase_combine(const Params& p, char* smem) {
  ExpMap* em = (ExpMap*)smem;
  build_expmap(p, em);
  const int lane = threadIdx.x & 63, wave = threadIdx.x >> 6;
  const float* X1 = (const float*)(p.ws + OFF_X1);
  const float* FS = (const float*)(p.ws + OFF_FS);
  const unsigned short* Y = (const unsigned short*)(p.ws + OFF_Y);
  const int* TOPI = (const int*)(p.ws + OFF_TOPI);
  const int* POSOF = (const int*)(p.ws + OFF_POSOF);
  float* OUT = LAYER == 0 ? (float*)(p.ws + OFF_X2) : p.out;
  for (int it = blockIdx.x; it < NTOK / 4; it += gridDim.x) {
    const size_t tok = (size_t)it * 4 + wave;
    float v[16];
#pragma unroll
    for (int i = 0; i < 4; ++i) {
      const float4 a = ld4(X1 + tok * 1024 + lane * 4 + 256 * i), f = ld4(FS + tok * 1024 + lane * 4 + 256 * i);
      v[i * 4] = ALPHA_F * a.x + f.x; v[i * 4 + 1] = ALPHA_F * a.y + f.y; v[i * 4 + 2] = ALPHA_F * a.z + f.z; v[i * 4 + 3] = ALPHA_F * a.w + f.w;
    }
    for (int s = 0; s < 8; ++s) {
      const int e = TOPI[tok * 8 + s];
      const size_t row = (size_t)em->rbase[e] + POSOF[tok * 8 + s];
#pragma unroll
      for (int i = 0; i < 4; ++i) {
        const uint2 y = *(const uint2*)(Y + row * 1024 + lane * 4 + 256 * i);
        v[i * 4] += bf2f((unsigned short)(y.x & 0xFFFF)); v[i * 4 + 1] += bf2f((unsigned short)(y.x >> 16));
        v[i * 4 + 2] += bf2f((unsigned short)(y.y & 0xFFFF)); v[i * 4 + 3] += bf2f((unsigned short)(y.y >> 16));
      }
    }
    wave_ln(v, p.in[I_LN2_G] + LAYER * 1024, p.in[I_LN2_B] + LAYER * 1024, lane);
#pragma unroll
    for (int i = 0; i < 4; ++i) st4(OUT + tok * 1024 + lane * 4 + 256 * i, make_float4(v[i * 4], v[i * 4 + 1], v[i * 4 + 2], v[i * 4 + 3]));
  }
}

DEV float shifted(const float* Hc, size_t tok, int col, const float* mu) {
  const float cur = Hc[tok * CD_IN + col];
  const float prev = (tok % SEQ_LEN) == 0 ? 0.f : Hc[(tok - 1) * CD_IN + col];
  return cur + (prev - cur) * mu[col];
}

#define P11_PREP_ITEMS (NTOK / 8)
#define P11_KV_ITEMS (BATCH * 4 * RET_NC)
#define P11_SMEM (8 * 128 * 4)
DEV void p11_prep(const Params& p, int item, char* smem) {
  const int tid = threadIdx.x;
  const float* Hc = (const float*)(p.ws + OFF_H);
  const float* mu = p.in[I_RW_MU];
  float* sl = (float*)smem;
  __syncthreads();
  for (int w = tid; w < 8 * 128; w += NTHREADS) {
    const int tt = w >> 7, j = w & 127;
    const size_t tok = (size_t)item * 8 + tt;
    const float v = shifted(Hc, tok, 1536 + j, mu);
    sl[w] = j < 64 ? tanhf(v) : v;
  }
  __syncthreads();
  float* RWW = (float*)(p.ws + OFF_RWW); float* RWK = (float*)(p.ws + OFF_RWK);
  float* RWKK = (float*)(p.ws + OFF_RWKK); float* RWA = (float*)(p.ws + OFF_RWA);
  float* RWR = p.out + (size_t)NTOK * 512; float* RWV = p.out;
  const float* w_up = p.in[I_RW_W_UP]; const float* a_up = p.in[I_RW_A_UP];
#pragma unroll
  for (int cc = 0; cc < 2; ++cc) {
    const int c = tid + 256 * cc;
    float aw[8], aa[8];
#pragma unroll
    for (int tt = 0; tt < 8; ++tt) { aw[tt] = 0.f; aa[tt] = 0.f; }
    for (int j = 0; j < 64; ++j) {
      const float wu = w_up[j * 512 + c], au = a_up[j * 512 + c];
#pragma unroll
      for (int tt = 0; tt < 8; ++tt) { aw[tt] += sl[tt * 128 + j] * wu; aa[tt] += sl[tt * 128 + 64 + j] * au; }
    }
    const float w0 = p.in[I_RW_W0][c], a0 = p.in[I_RW_A0][c], kkc = p.in[I_RW_K_K][c], kac = p.in[I_RW_K_A][c];
#pragma unroll
    for (int tt = 0; tt < 8; ++tt) {
      const size_t tok = (size_t)item * 8 + tt;
      const float lw = w0 + aw[tt];
      const float nl = -lw;
      const float sp = nl > 20.f ? nl : log1pf(expf(nl));
      const float wl = -sp - 0.5f;
      const float decay = expf(-expf(wl));
      const float a = 1.f / (1.f + expf(-(a0 + aa[tt])));
      const float rs = shifted(Hc, tok, c, mu);
      const float ks = shifted(Hc, tok, 512 + c, mu);
      const float vs = shifted(Hc, tok, 1024 + c, mu);
      float kk = ks * kkc;
      const float nrm = sqrtf(wave_sum(kk * kk));
      kk = kk / fmaxf(nrm, 1e-12f);
      RWW[tok * 512 + c] = decay;
      RWK[tok * 512 + c] = ks * (1.f + (a - 1.f) * kac);
      RWKK[tok * 512 + c] = kk;
      RWA[tok * 512 + c] = a;
      RWR[tok * 512 + c] = rs;
      RWV[tok * 512 + c] = vs;
    }
  }
}
DEV float ret_log2gamma(int h) { return log2f(1.f - exp2f(-5.f - (float)h)); }
DEV void p11_kv(const Params& p, int item) {
  const int c = item % RET_NC, h = (item / RET_NC) & 3, b = item / (RET_NC * 4);
  const int tid = threadIdx.x, e = tid & 127, dh = tid >> 7;
  const float* Hc = (const float*)(p.ws + OFF_H);
  const float lg = ret_log2gamma(h);
  float acc[32];
#pragma unroll
  for (int i = 0; i < 32; ++i) acc[i] = 0.f;
  for (int j = 0; j < 128; ++j) {
    const size_t tok = (size_t)b * SEQ_LEN + c * 128 + j;
    const float vv = Hc[tok * CD_IN + 2304 + h * 128 + e] * exp2f((float)(127 - j) * lg);
    const float* kr = Hc + tok * CD_IN + 2048 + h * 64 + dh * 32;
#pragma unroll
    for (int i4 = 0; i4 < 8; ++i4) {
      const float4 kv = ld4(kr + i4 * 4);
      acc[i4 * 4] += kv.x * vv; acc[i4 * 4 + 1] += kv.y * vv; acc[i4 * 4 + 2] += kv.z * vv; acc[i4 * 4 + 3] += kv.w * vv;
    }
  }
  float* KV = (float*)(p.ws + OFF_RETKV) + (size_t)item * 64 * 128;
#pragma unroll
  for (int i = 0; i < 32; ++i) KV[(dh * 32 + i) * 128 + e] = acc[i];
}
DEV void phase_p11(const Params& p, char* smem) {
  const int total = P11_PREP_ITEMS + P11_KV_ITEMS;
  for (int it = blockIdx.x; it < total; it += gridDim.x) {
    if (it < P11_KV_ITEMS) p11_kv(p, it);
    else p11_prep(p, it - P11_KV_ITEMS, smem);
  }
}

#define P12_SCAN_ITEMS (BATCH * 8)
#define P12_RET_ITEMS (BATCH * 4 * RET_NC)
#define P12_SMEM (64 * 128 * 4 + 256 * 2 * 4)
DEV void p12_scan(const Params& p, int item) {
  const int b = item >> 3, h = item & 7;
  const int tid = threadIdx.x, i = tid >> 2, cq = tid & 3;
  const float* RWW = (const float*)(p.ws + OFF_RWW); const float* RWK = (const float*)(p.ws + OFF_RWK);
  const float* RWKK = (const float*)(p.ws + OFF_RWKK); const float* RWA = (const float*)(p.ws + OFF_RWA);
  const float* RWR = p.out + (size_t)NTOK * 512; const float* RWV = p.out;
  float* Yo = (float*)(p.ws + OFF_MIX);
  float S[16];
#pragma unroll
  for (int j = 0; j < 16; ++j) S[j] = 0.f;
  const int cb = h * 64 + cq * 16;
  float4 nw[4], nk[4], nkk[4], na[4], nr[4]; float nv;
  auto loadstep = [&](int t) {
    const size_t o = ((size_t)b * SEQ_LEN + t) * 512 + cb;
#pragma unroll
    for (int q4 = 0; q4 < 4; ++q4) {
      nw[q4] = ld4(RWW + o + q4 * 4); nk[q4] = ld4(RWK + o + q4 * 4); nkk[q4] = ld4(RWKK + o + q4 * 4);
      na[q4] = ld4(RWA + o + q4 * 4); nr[q4] = ld4(RWR + o + q4 * 4);
    }
    nv = RWV[((size_t)b * SEQ_LEN + t) * 512 + h * 64 + i];
  };
  loadstep(0);
  for (int t = 0; t < SEQ_LEN; ++t) {
    float w[16], k[16], kk[16], a[16], r[16];
    const float v = nv;
#pragma unroll
    for (int q4 = 0; q4 < 4; ++q4) {
      w[q4 * 4] = nw[q4].x; w[q4 * 4 + 1] = nw[q4].y; w[q4 * 4 + 2] = nw[q4].z; w[q4 * 4 + 3] = nw[q4].w;
      k[q4 * 4] = nk[q4].x; k[q4 * 4 + 1] = nk[q4].y; k[q4 * 4 + 2] = nk[q4].z; k[q4 * 4 + 3] = nk[q4].w;
      kk[q4 * 4] = nkk[q4].x; kk[q4 * 4 + 1] = nkk[q4].y; kk[q4 * 4 + 2] = nkk[q4].z; kk[q4 * 4 + 3] = nkk[q4].w;
      a[q4 * 4] = na[q4].x; a[q4 * 4 + 1] = na[q4].y; a[q4 * 4 + 2] = na[q4].z; a[q4 * 4 + 3] = na[q4].w;
      r[q4 * 4] = nr[q4].x; r[q4 * 4 + 1] = nr[q4].y; r[q4 * 4 + 2] = nr[q4].z; r[q4 * 4 + 3] = nr[q4].w;
    }
    if (t + 1 < SEQ_LEN) loadstep(t + 1);
    float sa = 0.f;
#pragma unroll
    for (int j = 0; j < 16; ++j) sa += S[j] * kk[j];
    sa += __shfl_xor(sa, 1);
    sa += __shfl_xor(sa, 2);
    sa = -sa;
    float y = 0.f;
#pragma unroll
    for (int j = 0; j < 16; ++j) {
      S[j] = S[j] * w[j] + sa * (kk[j] * a[j]) + v * k[j];
      y += S[j] * r[j];
    }
    y += __shfl_xor(y, 1);
    y += __shfl_xor(y, 2);
    if (cq == 0) Yo[((size_t)b * SEQ_LEN + t) * 1024 + h * 64 + i] = y;
  }
}
DEV void p12_ret(const Params& p, int item, char* smem) {
  const int c = item % RET_NC, h = (item / RET_NC) & 3, b = item / (RET_NC * 4);
  const int tid = threadIdx.x, i = tid & 127, eh = tid >> 7;
  const float* Hc = (const float*)(p.ws + OFF_H);
  const float lg = ret_log2gamma(h);
  float* sS = (float*)smem;
  float* sRed = sS + 64 * 128;
  __syncthreads();
  {
    const float G = exp2f(128.f * lg);
    const float* KV0 = (const float*)(p.ws + OFF_RETKV) + (size_t)((b * 4 + h) * RET_NC) * 64 * 128;
    for (int w = tid; w < 64 * 128; w += NTHREADS) {
      float s = 0.f;
      for (int cc = 0; cc < c; ++cc) s = s * G + KV0[(size_t)cc * 64 * 128 + w];
      sS[w] = s;
    }
  }
  __syncthreads();
  const size_t tok0 = (size_t)b * SEQ_LEN + c * 128;
  float q[64];
  {
    const float* qr = Hc + (tok0 + i) * CD_IN + 1792 + h * 64;
#pragma unroll
    for (int d4 = 0; d4 < 16; ++d4) { const float4 v = ld4(qr + d4 * 4); q[d4 * 4] = v.x; q[d4 * 4 + 1] = v.y; q[d4 * 4 + 2] = v.z; q[d4 * 4 + 3] = v.w; }
  }
  float acc[64];
#pragma unroll
  for (int e = 0; e < 64; ++e) acc[e] = 0.f;
  {
    const float qs = exp2f((float)(i + 1) * lg);
#pragma unroll
    for (int d = 0; d < 64; ++d) {
      const float qd = q[d] * qs;
#pragma unroll
      for (int e4 = 0; e4 < 16; ++e4) {
        const float4 sv = ld4(sS + d * 128 + eh * 64 + e4 * 4);
        acc[e4 * 4] += qd * sv.x; acc[e4 * 4 + 1] += qd * sv.y; acc[e4 * 4 + 2] += qd * sv.z; acc[e4 * 4 + 3] += qd * sv.w;
      }
    }
  }
  const int jmax = ((tid >> 6) & 1) * 64 + 63;
  for (int j = 0; j <= jmax; ++j) {
    const float* kr = Hc + (tok0 + j) * CD_IN + 2048 + h * 64;
    float s = 0.f;
#pragma unroll
    for (int d4 = 0; d4 < 16; ++d4) { const float4 kv = ld4(kr + d4 * 4); s += q[d4 * 4] * kv.x + q[d4 * 4 + 1] * kv.y + q[d4 * 4 + 2] * kv.z + q[d4 * 4 + 3] * kv.w; }
    s = j <= i ? s * exp2f((float)(i - j) * lg) : 0.f;
    const float* vr = Hc + (tok0 + j) * CD_IN + 2304 + h * 128 + eh * 64;
#pragma unroll
    for (int e4 = 0; e4 < 16; ++e4) {
      const float4 vv = ld4(vr + e4 * 4);
      acc[e4 * 4] += s * vv.x; acc[e4 * 4 + 1] += s * vv.y; acc[e4 * 4 + 2] += s * vv.z; acc[e4 * 4 + 3] += s * vv.w;
    }
  }
  float s1 = 0.f;
#pragma unroll
  for (int e = 0; e < 64; ++e) s1 += acc[e];
  sRed[tid * 2] = s1;
  __syncthreads();
  const float mu = (s1 + sRed[(tid ^ 128) * 2]) * (1.f / 128.f);
  float s2 = 0.f;
#pragma unroll
  for (int e = 0; e < 64; ++e) { const float d = acc[e] - mu; s2 += d * d; }
  sRed[tid * 2 + 1] = s2;
  __syncthreads();
  const float rstd = rsqrtf((s2 + sRed[(tid ^ 128) * 2 + 1]) * (1.f / 128.f) + 1e-5f);
  float* MIX = (float*)(p.ws + OFF_MIX);
  const float* lgam = p.in[I_RET_LN_G] + h * 128 + eh * 64;
  const float* lbet = p.in[I_RET_LN_B] + h * 128 + eh * 64;
  const float* gate = Hc + (tok0 + i) * CD_IN + 2816 + h * 128 + eh * 64;
  float* dst = MIX + (tok0 + i) * 1024 + 512 + h * 128 + eh * 64;
#pragma unroll
  for (int e4 = 0; e4 < 16; ++e4) {
    const float4 gv = ld4(lgam + e4 * 4), bv = ld4(lbet + e4 * 4), gt = ld4(gate + e4 * 4);
    float4 o;
    o.x = siluf_(gt.x) * ((acc[e4 * 4] - mu) * rstd * gv.x + bv.x);
    o.y = siluf_(gt.y) * ((acc[e4 * 4 + 1] - mu) * rstd * gv.y + bv.y);
    o.z = siluf_(gt.z) * ((acc[e4 * 4 + 2] - mu) * rstd * gv.z + bv.z);
    o.w = siluf_(gt.w) * ((acc[e4 * 4 + 3] - mu) * rstd * gv.w + bv.w);
    st4(dst + e4 * 4, o);
  }
}
DEV void phase_p12(const Params& p, char* smem) {
  const int total = P12_SCAN_ITEMS + P12_RET_ITEMS;
  for (int it = blockIdx.x; it < total; it += gridDim.x) {
    if (it < P12_SCAN_ITEMS) p12_scan(p, it);
    else p12_ret(p, it - P12_SCAN_ITEMS, smem);
  }
}

#define P13_SMEM (8 * 128 * 4)
DEV void phase_p13(const Params& p, char* smem) {
  const int tid = threadIdx.x;
  const float* Hc = (const float*)(p.ws + OFF_H);
  const float* mu = p.in[I_RW_MU];
  float* sl = (float*)smem;
  float* MIX = (float*)(p.ws + OFF_MIX);
  const float* RWK = (const float*)(p.ws + OFF_RWK); const float* RWR = p.out + (size_t)NTOK * 512; const float* RWV = p.out;
  const float* g_up = p.in[I_RW_G_UP];
  for (int it = blockIdx.x; it < NTOK / 8; it += gridDim.x) {
    __syncthreads();
    for (int w = tid; w < 8 * 128; w += NTHREADS) {
      const size_t tok = (size_t)it * 8 + (w >> 7);
      sl[w] = sigmoidf_(shifted(Hc, tok, 1664 + (w & 127), mu));
    }
    __syncthreads();
#pragma unroll
    for (int cc = 0; cc < 2; ++cc) {
      const int c = tid + 256 * cc;
      float ag[8];
#pragma unroll
      for (int tt = 0; tt < 8; ++tt) ag[tt] = 0.f;
      for (int j = 0; j < 128; ++j) {
        const float gu = g_up[j * 512 + c];
#pragma unroll
        for (int tt = 0; tt < 8; ++tt) ag[tt] += sl[tt * 128 + j] * gu;
      }
      const float lng = p.in[I_RW_LN_G][c], lnb = p.in[I_RW_LN_B][c], rk = p.in[I_RW_R_K][c];
#pragma unroll
      for (int tt = 0; tt < 8; ++tt) {
        const size_t tok = (size_t)it * 8 + tt;
        const float y = MIX[tok * 1024 + c];
        const float m = wave_sum(y) * (1.f / 64.f);
        const float d = y - m;
        const float var = wave_sum(d * d) * (1.f / 64.f);
        const float yn = d * rsqrtf(var + 64e-5f) * lng + lnb;
        const float r = RWR[tok * 512 + c], k = RWK[tok * 512 + c], v = RWV[tok * 512 + c];
        const float bonus = wave_sum(r * k * rk) * v;
        MIX[tok * 1024 + c] = (yn + bonus) * ag[tt];
      }
    }
  }
}

#define NPHASES 20
#define SMEM_BYTES 49152
DEV void run_phase(const Params& p, int ph, char* smem) {
  switch (ph) {
    case 0: phase_gemm_in<0>(p, smem); break;
    case 1: phase_p1(p, smem); break;
    case 2: phase_p2(p, smem); break;
    case 3: phase_glu(p, smem); break;
    case 4: phase_outproj<0>(p, smem); break;
    case 5: phase_ln_router<0>(p, smem); break;
    case 6: phase_lists_shup<0>(p, smem); break;
    case 7: phase_routed_up<0>(p, smem); break;
    case 8: phase_down<0>(p, smem); break;
    case 9: phase_combine<0>(p, smem); break;
    case 10: phase_gemm_in<1>(p, smem); break;
    case 11: phase_p11(p, smem); break;
    case 12: phase_p12(p, smem); break;
    case 13: phase_p13(p, smem); break;
    case 14: phase_outproj<1>(p, smem); break;
    case 15: phase_ln_router<1>(p, smem); break;
    case 16: phase_lists_shup<1>(p, smem); break;
    case 17: phase_routed_up<1>(p, smem); break;
    case 18: phase_down<1>(p, smem); break;
    case 19: phase_combine<1>(p, smem); break;
  }
}
static_assert(P1_SMEM <= SMEM_BYTES, "smem");
static_assert(P2_SMEM <= SMEM_BYTES, "smem");
static_assert(P5_SMEM <= SMEM_BYTES, "smem");
static_assert(P7_SMEM <= SMEM_BYTES, "smem");
static_assert(P12_SMEM <= SMEM_BYTES, "smem");
static_assert(OFF_HS + (size_t)NTOK * 256 * 2 <= OFF_X1, "layout");

#ifndef CPU_EMU
template <int PH>
__global__ void __launch_bounds__(NTHREADS) phase_kernel(Params p) {
  __shared__ __attribute__((aligned(16))) char smem[SMEM_BYTES];
  run_phase(p, PH, smem);
}
template <int PH>
static void launch_phases(const Params& p, hipStream_t stream) {
  phase_kernel<PH><<<dim3(1024), dim3(NTHREADS), 0, stream>>>(p);
  if constexpr (PH + 1 < NPHASES) launch_phases<PH + 1>(p, stream);
}
#if MEGA
__global__ void __launch_bounds__(NTHREADS) mega_kernel(Params p) {
  __shared__ __attribute__((aligned(16))) char smem[SMEM_BYTES];
  cg::grid_group grid = cg::this_grid();
#define PH_(n) run_phase(p, n, smem); grid.sync();
  PH_(0) PH_(1) PH_(2) PH_(3) PH_(4) PH_(5) PH_(6) PH_(7) PH_(8) PH_(9)
  PH_(10) PH_(11) PH_(12) PH_(13) PH_(14) PH_(15) PH_(16) PH_(17) PH_(18)
  run_phase(p, 19, smem);
}
#endif

extern "C" void kernel_launch(void* const* d_in, const int* in_sizes, int n_in, void* d_out, int out_size, void* d_ws, size_t ws_size,
                              hipStream_t stream) {
  Params p;
  for (int i = 0; i < N_INPUTS; ++i) p.in[i] = (const float*)d_in[i];
  p.out = (float*)d_out;
  p.ws = (char*)d_ws;
#if MEGA
  static int grid_blocks = 0;
  if (!grid_blocks) {
    int dev = 0, cus = 0, per_cu = 0;
    hipGetDevice(&dev);
    hipDeviceGetAttribute(&cus, hipDeviceAttributeMultiprocessorCount, dev);
    hipOccupancyMaxActiveBlocksPerMultiprocessor(&per_cu, mega_kernel, NTHREADS, 0);
    if (per_cu > 2) per_cu = 2;
    grid_blocks = cus * per_cu;
  }
  void* args[] = {&p};
  hipError_t e = hipLaunchCooperativeKernel((void*)mega_kernel, dim3(grid_blocks), dim3(NTHREADS), args, 0, stream);
  if (e != hipSuccess) fprintf(stderr, "cooperative launch failed: %s (grid %d)\n", hipGetErrorString(e), grid_blocks);
#else
  launch_phases<0>(p, stream);
#endif
}
#endif
```

```cpp
#ifdef CPU_EMU
#include "emu.h"
#else
#include <hip/hip_runtime.h>
#include <hip/hip_cooperative_groups.h>
#include <cstdio>
namespace cg = cooperative_groups;
#endif
#include <stdint.h>

#ifndef BATCH
#define BATCH 2
#endif
#ifndef SEQ_LEN
#define SEQ_LEN 8192
#endif
#ifndef MEGA
#define MEGA 1
#endif

#define DEV __device__ __forceinline__
#define NTOK (BATCH * SEQ_LEN)
#define DM 1024
#define AB_IN 1816
#define CD_IN 3328
#define NCMP ((SEQ_LEN - 32) / 16 + 1)
#define NBLK (SEQ_LEN / 64)
#define NB_CMP ((NCMP + 63) / 64)
#define S5_NC (SEQ_LEN / 64)
#define RET_NC (SEQ_LEN / 128)
#define ALPHA_F 1.4142135623730951f
#define NTHREADS 256

enum { I_X = 0, I_AB_W_IN, I_AB_W_OUT, I_S5_LAM_RE, I_S5_LAM_IM, I_S5_LOG_DT, I_S5_B_RE, I_S5_B_IM, I_S5_C_RE, I_S5_C_IM,
       I_S5_D, I_S5_W_GLU, I_S5_B_GLU, I_PE_K, I_PE_V, I_CK_W1, I_CK_B1, I_CK_W2, I_CV_W1, I_CV_B1, I_CV_W2,
       I_CD_W_IN, I_CD_W_OUT, I_RW_MU, I_RW_W0, I_RW_W_UP, I_RW_A0, I_RW_A_UP, I_RW_G_UP, I_RW_K_K, I_RW_K_A, I_RW_R_K,
       I_RW_LN_G, I_RW_LN_B, I_RET_LN_G, I_RET_LN_B, I_LN1_G, I_LN1_B, I_LN2_G, I_LN2_B, I_ROUTER, I_MOE_BIAS,
       I_MOE_W1, I_MOE_W3, I_MOE_W2, I_SH_W1, I_SH_W3, I_SH_W2, N_INPUTS };

struct Params {
  const float* in[N_INPUTS];
  float* out;
  char* ws;
};

#define MiB_TOK ((size_t)NTOK * 1024 * 4)
#define OFF_H 0
#define OFF_MIX ((size_t)NTOK * 3328 * 4)
#define OFF_X1 (OFF_MIX + MiB_TOK)
#define OFF_X2 (OFF_X1 + MiB_TOK)
#define OFF_R4 (OFF_X2 + MiB_TOK)
#define OFF_R5 (OFF_R4 + MiB_TOK)
#define OFF_Y OFF_H
#define OFF_HS (OFF_H + 4 * MiB_TOK)
#define OFF_FS OFF_X2
#define OFF_HR OFF_R4
#define OFF_TOPI (OFF_R5)
#define OFF_TOPG (OFF_TOPI + (size_t)NTOK * 8 * 4)
#define OFF_POSOF (OFF_TOPG + (size_t)NTOK * 8 * 4)
#define OFF_CNT (OFF_POSOF + (size_t)NTOK * 8 * 4)
#define OFF_LTOK (OFF_CNT + 1024)
#define OFF_LGATE (OFF_LTOK + (size_t)64 * NTOK * 4)
#define OFF_S5E (OFF_LGATE + (size_t)64 * NTOK * 4)
#define OFF_KCMP (OFF_S5E + (size_t)BATCH * S5_NC * 32 * 64 * 8)
#define OFF_VCMP (OFF_KCMP + (size_t)BATCH * NCMP * 2 * 64 * 4)
#define OFF_RETKV (OFF_VCMP + (size_t)BATCH * NCMP * 2 * 64 * 4)
#define OFF_BAR (OFF_RETKV + (size_t)BATCH * 4 * RET_NC * 64 * 128 * 4)
#define OFF_END (OFF_BAR + 4096)
#define OFF_YGELU OFF_X1
#define OFF_RWW OFF_X1
#define OFF_RWK (OFF_X1 + (size_t)NTOK * 512 * 4)
#define OFF_RWKK OFF_R4
#define OFF_RWA (OFF_R4 + (size_t)NTOK * 512 * 4)

typedef short bf16x8 __attribute__((ext_vector_type(8)));
typedef float f32x16 __attribute__((ext_vector_type(16)));

#ifdef CPU_EMU
#define WAVE_SYNC() emu_wave_bar()
#else
#define WAVE_SYNC() __builtin_amdgcn_wave_barrier()
#endif

DEV float sigmoidf_(float x) { return 1.f / (1.f + __expf(-x)); }
DEV float siluf_(float x) { return x * sigmoidf_(x); }
DEV float geluf_(float x) { float u = 0.7978845608028654f * (x + 0.044715f * x * x * x); return 0.5f * x * (1.f + tanhf(u)); }
DEV unsigned short f2bf(float f) {
  unsigned u = __builtin_bit_cast(unsigned, f);
  u += 0x7FFFu + ((u >> 16) & 1u);
  return (unsigned short)(u >> 16);
}
DEV float bf2f(unsigned short h) { return __builtin_bit_cast(float, ((unsigned)h) << 16); }
DEV float wave_sum(float v) {
#pragma unroll
  for (int m = 32; m >= 1; m >>= 1) v += __shfl_xor(v, m);
  return v;
}
DEV float wave_max(float v) {
#pragma unroll
  for (int m = 32; m >= 1; m >>= 1) v = fmaxf(v, __shfl_xor(v, m));
  return v;
}
DEV float4 ld4(const float* p) { return *(const float4*)p; }
DEV void st4(float* p, float4 v) { *(float4*)p = v; }

#define GEMM_SMEM_BYTES (2 * 128 * 40 * 2)
template <bool ABF, class AROW, class BPTR, class EPI>
DEV void gemm_tile(AROW arow, BPTR bptr, int ldb, int K, EPI epi, char* smem_raw) {
  unsigned short(*sA)[40] = (unsigned short(*)[40])smem_raw;
  unsigned short(*sB)[40] = (unsigned short(*)[40])(smem_raw + 128 * 40 * 2);
  const int tid = threadIdx.x, lane = tid & 63, wave = tid >> 6;
  const int wm = wave >> 1, wn = wave & 1;
#if defined(CPU_EMU) && !defined(EMU_REAL_GEMM)
  for (int mi = 0; mi < 2; ++mi)
    for (int r = 0; r < 16; ++r) {
      const int row = wm * 64 + mi * 32 + (r & 3) + 8 * (r >> 2) + 4 * (lane >> 5);
      const int col = wn * 64 + (lane & 31);
      const void* arp = arow(row);
      float v[2] = {0.f, 0.f};
      for (int ni = 0; ni < 2; ++ni) {
        const float* bq = bptr(col + ni * 32);
        if (!arp || !bq) continue;
        float a = 0.f;
        for (int k = 0; k < K; ++k) {
          const float av = ABF ? bf2f(((const unsigned short*)arp)[k]) : bf2f(f2bf(((const float*)arp)[k]));
          a += av * bf2f(f2bf(bq[(size_t)k * ldb]));
        }
        v[ni] = a;
      }
      epi(row, col, v[0], v[1]);
    }
  return;
#endif
  const float* ap[4];
  const unsigned short* aph[2];
  if (ABF) {
#pragma unroll
    for (int i = 0; i < 2; ++i) aph[i] = (const unsigned short*)arow((tid >> 2) + 64 * i);
  } else {
#pragma unroll
    for (int i = 0; i < 4; ++i) ap[i] = (const float*)arow((tid >> 3) + 32 * i);
  }
  const float* bp = bptr(tid & 127);
  const int bkg = tid >> 7;
  float4 ra[4];
  uint4 rah[2];
  float rb[2][8];
  auto gload = [&](int k0) {
    if (ABF) {
#pragma unroll
      for (int i = 0; i < 2; ++i) rah[i] = aph[i] ? *(const uint4*)(aph[i] + k0 + (tid & 3) * 8) : make_uint4(0, 0, 0, 0);
    } else {
#pragma unroll
      for (int i = 0; i < 4; ++i) ra[i] = ap[i] ? ld4(ap[i] + k0 + (tid & 7) * 4) : make_float4(0.f, 0.f, 0.f, 0.f);
    }
#pragma unroll
    for (int i = 0; i < 2; ++i)
#pragma unroll
      for (int j = 0; j < 8; ++j) rb[i][j] = bp ? bp[(size_t)(k0 + (bkg + 2 * i) * 8 + j) * ldb] : 0.f;
  };
  auto sstore = [&]() {
    if (ABF) {
#pragma unroll
      for (int i = 0; i < 2; ++i) *(uint4*)&sA[(tid >> 2) + 64 * i][(tid & 3) * 8] = rah[i];
    } else {
#pragma unroll
      for (int i = 0; i < 4; ++i) {
        uint2 v;
        v.x = (unsigned)f2bf(ra[i].x) | ((unsigned)f2bf(ra[i].y) << 16);
        v.y = (unsigned)f2bf(ra[i].z) | ((unsigned)f2bf(ra[i].w) << 16);
        *(uint2*)&sA[(tid >> 3) + 32 * i][(tid & 7) * 4] = v;
      }
    }
#pragma unroll
    for (int i = 0; i < 2; ++i) {
      uint4 v;
      v.x = (unsigned)f2bf(rb[i][0]) | ((unsigned)f2bf(rb[i][1]) << 16);
      v.y = (unsigned)f2bf(rb[i][2]) | ((unsigned)f2bf(rb[i][3]) << 16);
      v.z = (unsigned)f2bf(rb[i][4]) | ((unsigned)f2bf(rb[i][5]) << 16);
      v.w = (unsigned)f2bf(rb[i][6]) | ((unsigned)f2bf(rb[i][7]) << 16);
      *(uint4*)&sB[tid & 127][(bkg + 2 * i) * 8] = v;
    }
  };
  f32x16 acc[2][2];
#pragma unroll
  for (int mi = 0; mi < 2; ++mi)
#pragma unroll
    for (int ni = 0; ni < 2; ++ni)
#pragma unroll
      for (int r = 0; r < 16; ++r) acc[mi][ni][r] = 0.f;
  gload(0);
  for (int k0 = 0; k0 < K; k0 += 32) {
    __syncthreads();
    sstore();
    __syncthreads();
    if (k0 + 32 < K) gload(k0 + 32);
#pragma unroll
    for (int ks = 0; ks < 2; ++ks) {
      bf16x8 af[2], bfr[2];
#pragma unroll
      for (int mi = 0; mi < 2; ++mi) af[mi] = *(const bf16x8*)&sA[wm * 64 + mi * 32 + (lane & 31)][ks * 16 + (lane >> 5) * 8];
#pragma unroll
      for (int ni = 0; ni < 2; ++ni) bfr[ni] = *(const bf16x8*)&sB[wn * 64 + ni * 32 + (lane & 31)][ks * 16 + (lane >> 5) * 8];
#pragma unroll
      for (int mi = 0; mi < 2; ++mi)
#pragma unroll
        for (int ni = 0; ni < 2; ++ni) acc[mi][ni] = __builtin_amdgcn_mfma_f32_32x32x16_bf16(af[mi], bfr[ni], acc[mi][ni], 0, 0, 0);
    }
  }
#pragma unroll
  for (int mi = 0; mi < 2; ++mi)
#pragma unroll
    for (int r = 0; r < 16; ++r) {
      int row = wm * 64 + mi * 32 + (r & 3) + 8 * (r >> 2) + 4 * (lane >> 5);
      int col = wn * 64 + (lane & 31);
      epi(row, col, acc[mi][0][r], acc[mi][1][r]);
    }
}

template <int LAYER>
DEV void phase_gemm_in(const Params& p, char* smem) {
  const int N = LAYER == 0 ? AB_IN : CD_IN;
  const float* A = LAYER == 0 ? p.in[I_X] : (const float*)(p.ws + OFF_X2);
  const float* B = LAYER == 0 ? p.in[I_AB_W_IN] : p.in[I_CD_W_IN];
  float* C = (float*)(p.ws + OFF_H);
  const int NT = (N + 127) / 128, MT = NTOK / 128;
  for (int it = blockIdx.x; it < MT * NT; it += gridDim.x) {
    const int tm = it / NT, tn = it % NT;
    const int m0 = tm * 128, n0 = tn * 128;
    gemm_tile<false>(
        [&](int r) { return (const void*)(A + (size_t)(m0 + r) * DM); },
        [&](int c) { return (n0 + c < N) ? (B + n0 + c) : (const float*)nullptr; }, N, DM,
        [&](int row, int col, float v0, float v1) {
          const int gm = m0 + row, gc = n0 + col;
          if (LAYER == 1 && gc >= 1792 && gc < 2304) {
            const int i = gc & 63;
            const float pos = (float)(gm % SEQ_LEN);
            const float inv = __expf(-(float)i * (9.210340371976184f / 32.f));
            float sn, cs;
            sincosf(pos * inv, &sn, &cs);
            float o0 = v0 * cs - v1 * sn, o1 = v1 * cs + v0 * sn;
            if (gc >= 2048) { o0 *= 0.125f; o1 *= 0.125f; }
            v0 = o0; v1 = o1;
          }
          if (gc < N) C[(size_t)gm * N + gc] = v0;
          if (gc + 32 < N) C[(size_t)gm * N + gc + 32] = v1;
        },
        smem);
  }
}

struct S5Const { float lb_re, lb_im; };
DEV void s5_consts(const Params& p, int g, int pp, float& lb_re, float& lb_im, float (&bbr)[16], float (&bbi)[16]) {
  const float dt = expf(p.in[I_S5_LOG_DT][g]);
  const float lr = p.in[I_S5_LAM_RE][g * 64 + pp], li = p.in[I_S5_LAM_IM][g * 64 + pp];
  const float mag = expf(lr * dt);
  float sn, cs;
  sincosf(li * dt, &sn, &cs);
  lb_re = mag * cs; lb_im = mag * sn;
  const float den = lr * lr + li * li;
  const float f_re = ((lb_re - 1.f) * lr + lb_im * li) / den;
  const float f_im = (lb_im * lr - (lb_re - 1.f) * li) / den;
  const float* br = p.in[I_S5_B_RE] + (size_t)(g * 64 + pp) * 16;
  const float* bi = p.in[I_S5_B_IM] + (size_t)(g * 64 + pp) * 16;
#pragma unroll
  for (int h = 0; h < 16; ++h) {
    bbr[h] = f_re * br[h] - f_im * bi[h];
    bbi[h] = f_re * bi[h] + f_im * br[h];
  }
}

#define P1_ROPE_ITEMS (NTOK / 16)
#define P1_S5A_ITEMS (BATCH * 32 * S5_NC / 4)
#define P1_CMP_TILES ((NCMP + 7) / 8)
#define P1_CMP_ITEMS (2 * BATCH * 2 * P1_CMP_TILES)
DEV void p1_rope(const Params& p, int item) {
  float* H = (float*)(p.ws + OFF_H);
  for (int w = threadIdx.x; w < 16 * 96; w += NTHREADS) {
    const int tok = item * 16 + w / 96;
    const int r = w % 96, hd = r >> 3, i = r & 7;
    const int col = hd < 8 ? 512 + hd * 64 : (hd < 10 ? 1280 + (hd - 8) * 64 : 1536 + (hd - 10) * 64);
    float* x = H + (size_t)tok * AB_IN + col;
    const float pos = (float)(tok % SEQ_LEN);
    const float inv = __expf(-(float)i * (13.122363377404328f / 8.f));
    float sn, cs;
    sincosf(pos * inv, &sn, &cs);
    const float x1 = x[i], x2 = x[i + 8];
    x[i] = x1 * cs - x2 * sn;
    x[i + 8] = x2 * cs + x1 * sn;
  }
}
DEV void p1_s5a(const Params& p, int item) {
  const int lane = threadIdx.x & 63, wave = threadIdx.x >> 6;
  const int idx = item * 4 + wave;
  const int g = idx & 31, c = (idx >> 5) % S5_NC, b = idx / (32 * S5_NC);
  float lb_re, lb_im, bbr[16], bbi[16];
  s5_consts(p, g, lane, lb_re, lb_im, bbr, bbi);
  const float* H = (const float*)(p.ws + OFF_H);
  float sr = 0.f, si = 0.f;
  for (int tt = 0; tt < 64; ++tt) {
    const float* u = H + (size_t)(b * SEQ_LEN + c * 64 + tt) * AB_IN + g * 16;
    float dr = 0.f, di = 0.f;
#pragma unroll
    for (int h4 = 0; h4 < 4; ++h4) {
      const float4 uv = ld4(u + h4 * 4);
      dr += uv.x * bbr[h4 * 4] + uv.y * bbr[h4 * 4 + 1] + uv.z * bbr[h4 * 4 + 2] + uv.w * bbr[h4 * 4 + 3];
      di += uv.x * bbi[h4 * 4] + uv.y * bbi[h4 * 4 + 1] + uv.z * bbi[h4 * 4 + 2] + uv.w * bbi[h4 * 4 + 3];
    }
    const float nr = lb_re * sr - lb_im * si + dr;
    const float ni = lb_re * si + lb_im * sr + di;
    sr = nr; si = ni;
  }
  float2* E = (float2*)(p.ws + OFF_S5E);
  E[((size_t)(b * S5_NC + c) * 32 + g) * 64 + lane] = make_float2(sr, si);
}
DEV void p1_compress(const Params& p, int item, char* smem) {
  const int tile = item % P1_CMP_TILES;
  int r = item / P1_CMP_TILES;
  const int g = r & 1; r >>= 1;
  const int b = r % BATCH; const int which = r / BATCH;
  const int n0 = tile * 8;
  const float* H = (const float*)(p.ws + OFF_H);
  const float* pe = which ? p.in[I_PE_V] : p.in[I_PE_K];
  const float* w1 = which ? p.in[I_CV_W1] : p.in[I_CK_W1];
  const float* b1 = which ? p.in[I_CV_B1] : p.in[I_CK_B1];
  const float* w2 = which ? p.in[I_CV_W2] : p.in[I_CK_W2];
  const int colbase = (which ? 1152 : 1024) + g * 64;
  float* sTok = (float*)smem;
  float* sPart = sTok + 144 * 64;
  float* sHid = sPart + 2 * 8 * 128;
  const int tid = threadIdx.x;
  __syncthreads();
  for (int w = tid; w < 144 * 16; w += NTHREADS) {
    const int tr = w >> 4, c4 = (w & 15) * 4;
    int tok = n0 * 16 + tr; if (tok > SEQ_LEN - 1) tok = SEQ_LEN - 1;
    st4(sTok + tr * 64 + c4, ld4(H + (size_t)(b * SEQ_LEN + tok) * AB_IN + colbase + c4));
  }
  __syncthreads();
  {
    const int hid = tid & 127, kh = tid >> 7;
    float acc[8];
#pragma unroll
    for (int rr = 0; rr < 8; ++rr) acc[rr] = 0.f;
    for (int k = kh * 1024; k < kh * 1024 + 1024; ++k) {
      const float w = w1[(size_t)k * 128 + hid];
      const int j = k >> 6, d = k & 63;
      const float pv = pe[j * 64 + d];
#pragma unroll
      for (int rr = 0; rr < 8; ++rr) acc[rr] += (sTok[(rr * 16 + j) * 64 + d] + pv) * w;
    }
#pragma unroll
    for (int rr = 0; rr < 8; ++rr) sPart[(kh * 8 + rr) * 128 + hid] = acc[rr];
  }
  __syncthreads();
  for (int w = tid; w < 8 * 128; w += NTHREADS) {
    const int rr = w >> 7, hid = w & 127;
    sHid[w] = geluf_(sPart[rr * 128 + hid] + sPart[(8 + rr) * 128 + hid] + b1[hid]);
  }
  __syncthreads();
  float* sOut = sPart;
  for (int w = tid; w < 8 * 64; w += NTHREADS) {
    const int rr = w >> 6, d = w & 63;
    float a = 0.f;
    for (int hid = 0; hid < 128; ++hid) a += sHid[rr * 128 + hid] * w2[hid * 64 + d];
    sOut[w] = a;
  }
  __syncthreads();
  float* dst = (float*)(p.ws + (which ? OFF_VCMP : OFF_KCMP));
  for (int w = tid; w < 8 * 64; w += NTHREADS) {
    const int rr = w >> 6, d = w & 63;
    const int n = n0 + rr;
    if (n >= NCMP) continue;
    float v = sOut[w];
    if (which == 0 && d < 16) {
      const int i = d & 7;
      const float pos = (float)(n * 16 + 31);
      const float inv = __expf(-(float)i * (13.122363377404328f / 8.f));
      float sn, cs;
      sincosf(pos * inv, &sn, &cs);
      const float x1 = sOut[rr * 64 + i], x2 = sOut[rr * 64 + i + 8];
      v = d < 8 ? x1 * cs - x2 * sn : x2 * cs + x1 * sn;
    }
    dst[((size_t)(b * NCMP + n) * 2 + g) * 64 + d] = v;
  }
}
#define P1_SMEM ((144 * 64 + 2 * 8 * 128 + 8 * 128) * 4)
DEV void phase_p1(const Params& p, char* smem) {
  const int total = P1_ROPE_ITEMS + P1_S5A_ITEMS + P1_CMP_ITEMS;
  for (int it = blockIdx.x; it < total; it += gridDim.x) {
    if (it < P1_CMP_ITEMS) p1_compress(p, it, smem);
    else if (it < P1_CMP_ITEMS + P1_S5A_ITEMS) p1_s5a(p, it - P1_CMP_ITEMS);
    else p1_rope(p, it - P1_CMP_ITEMS - P1_S5A_ITEMS);
  }
}

#define P2_S5C_ITEMS (BATCH * 32 * S5_NC / 4)
#define P2_ATT_ITEMS (NTOK * 2 / 4)
#define S5C_ROW 132
#define P2_S5C_SMEM (4 * 16 * S5C_ROW * 4)
DEV void p2_s5c(const Params& p, int item, char* smem) {
  const int lane = threadIdx.x & 63, wave = threadIdx.x >> 6;
  const int idx = item * 4 + wave;
  const int g = idx & 31, c = (idx >> 5) % S5_NC, b = idx / (32 * S5_NC);
  float lb_re, lb_im, bbr[16], bbi[16];
  s5_consts(p, g, lane, lb_re, lb_im, bbr, bbi);
  float ar = lb_re, ai = lb_im;
#pragma unroll
  for (int s = 0; s < 6; ++s) { const float nr = ar * ar - ai * ai, ni = 2.f * ar * ai; ar = nr; ai = ni; }
  const float2* E = (const float2*)(p.ws + OFF_S5E);
  float sr = 0.f, si = 0.f;
  for (int cc = 0; cc < c; ++cc) {
    const float2 e = E[((size_t)(b * S5_NC + cc) * 32 + g) * 64 + lane];
    const float nr = ar * sr - ai * si + e.x, ni = ar * si + ai * sr + e.y;
    sr = nr; si = ni;
  }
  const float* H = (const float*)(p.ws + OFF_H);
  float* sS = (float*)smem + wave * 16 * S5C_ROW;
  const float* cre = p.in[I_S5_C_RE] + (size_t)g * 16 * 64;
  const float* cim = p.in[I_S5_C_IM] + (size_t)g * 16 * 64;
  float* YG = (float*)(p.ws + OFF_YGELU);
  for (int sc = 0; sc < 4; ++sc) {
    for (int tt = 0; tt < 16; ++tt) {
      const float* u = H + (size_t)(b * SEQ_LEN + c * 64 + sc * 16 + tt) * AB_IN + g * 16;
      float dr = 0.f, di = 0.f;
#pragma unroll
      for (int h4 = 0; h4 < 4; ++h4) {
        const float4 uv = ld4(u + h4 * 4);
        dr += uv.x * bbr[h4 * 4] + uv.y * bbr[h4 * 4 + 1] + uv.z * bbr[h4 * 4 + 2] + uv.w * bbr[h4 * 4 + 3];
        di += uv.x * bbi[h4 * 4] + uv.y * bbi[h4 * 4 + 1] + uv.z * bbi[h4 * 4 + 2] + uv.w * bbi[h4 * 4 + 3];
      }
      const float nr = lb_re * sr - lb_im * si + dr, ni = lb_re * si + lb_im * sr + di;
      sr = nr; si = ni;
      sS[tt * S5C_ROW + lane] = sr;
      sS[tt * S5C_ROW + 64 + lane] = si;
    }
    __syncthreads();
    {
      const int tt = lane >> 2, hq = lane & 3;
      float y[4] = {0.f, 0.f, 0.f, 0.f};
      for (int k = 0; k < 64; k += 4) {
        const float4 vr = ld4(sS + tt * S5C_ROW + k), vi = ld4(sS + tt * S5C_ROW + 64 + k);
#pragma unroll
        for (int hh = 0; hh < 4; ++hh) {
          const float4 cr = ld4(cre + (hq * 4 + hh) * 64 + k), ci = ld4(cim + (hq * 4 + hh) * 64 + k);
          y[hh] += vr.x * cr.x + vr.y * cr.y + vr.z * cr.z + vr.w * cr.w - (vi.x * ci.x + vi.y * ci.y + vi.z * ci.z + vi.w * ci.w);
        }
      }
      const size_t tok = (size_t)(b * SEQ_LEN + c * 64 + sc * 16 + tt);
      const int ch = g * 16 + hq * 4;
      const float4 uv = ld4(H + tok * AB_IN + ch);
      const float4 dv = ld4(p.in[I_S5_D] + ch);
      float4 o;
      o.x = geluf_(y[0] + dv.x * uv.x); o.y = geluf_(y[1] + dv.y * uv.y);
      o.z = geluf_(y[2] + dv.z * uv.z); o.w = geluf_(y[3] + dv.w * uv.w);
      st4(YG + tok * 512 + ch, o);
    }
    __syncthreads();
  }
}

template <int NB, class KF, class VF>
DEV void attn_branch(const float* q_lds, float* p_lds, KF kf, VF vf, float (&o)[4], float* imp_out, int lane) {
  float s[4][NB];
  float m[4] = {-INFINITY, -INFINITY, -INFINITY, -INFINITY};
  bool act[NB];
#pragma unroll
  for (int i = 0; i < NB; ++i) {
    bool active, valid;
    const float* kr = kf(i, active, valid);
    act[i] = active;
#pragma unroll
    for (int h = 0; h < 4; ++h) s[h][i] = -INFINITY;
    if (active) {
      float d[4] = {0.f, 0.f, 0.f, 0.f};
#pragma unroll
      for (int c = 0; c < 16; ++c) {
        const float4 kv = ld4(kr + c * 4);
#pragma unroll
        for (int h = 0; h < 4; ++h) {
          const float4 qv = ld4(q_lds + h * 64 + c * 4);
          d[h] += kv.x * qv.x + kv.y * qv.y + kv.z * qv.z + kv.w * qv.w;
        }
      }
#pragma unroll
      for (int h = 0; h < 4; ++h) { s[h][i] = valid ? d[h] : -INFINITY; m[h] = fmaxf(m[h], s[h][i]); }
    }
  }
  float l[4];
#pragma unroll
  for (int h = 0; h < 4; ++h) {
    m[h] = wave_max(m[h]);
    float e = 0.f;
    if (m[h] > -INFINITY) {
#pragma unroll
      for (int i = 0; i < NB; ++i) { s[h][i] = __expf(s[h][i] - m[h]); e += s[h][i]; }
    } else {
#pragma unroll
      for (int i = 0; i < NB; ++i) s[h][i] = 0.f;
    }
    l[h] = wave_sum(e);
    l[h] = l[h] > 0.f ? 1.f / l[h] : 0.f;
  }
#pragma unroll
  for (int i = 0; i < NB; ++i) {
    float4 pv;
    pv.x = s[0][i] * l[0]; pv.y = s[1][i] * l[1]; pv.z = s[2][i] * l[2]; pv.w = s[3][i] * l[3];
    if (imp_out) imp_out[i * 64 + lane] = pv.x + pv.y + pv.z + pv.w;
    if (act[i]) {
      WAVE_SYNC();
      st4(p_lds + lane * 4, pv);
      WAVE_SYNC();
      for (int kk = 0; kk < 64; ++kk) {
        const float* vr = vf(i, kk);
        if (!vr) break;
        const float4 pp = ld4(p_lds + kk * 4);
        const float vv = vr[lane];
        o[0] += pp.x * vv; o[1] += pp.y * vv; o[2] += pp.z * vv; o[3] += pp.w * vv;
      }
    }
  }
  WAVE_SYNC();
}

#define ATT_WAVE_FLOATS (256 + 256 + (NB_CMP * 64 + 8) + 16)
#define P2_ATT_SMEM (4 * ATT_WAVE_FLOATS * 4)
DEV void p2_attn(const Params& p, int item, char* smem) {
  const int lane = threadIdx.x & 63, wave = threadIdx.x >> 6;
  const int idx = item * 4 + wave;
  const int g = idx & 1, t = (idx >> 1) % SEQ_LEN, b = idx / (2 * SEQ_LEN);
  float* base = (float*)smem + wave * ATT_WAVE_FLOATS;
  float* q_lds = base;
  float* p_lds = base + 256;
  float* L = base + 512;
  int* sel_lds = (int*)(base + 512 + NB_CMP * 64 + 8);
  const float* H = (const float*)(p.ws + OFF_H);
  const size_t tok = (size_t)b * SEQ_LEN + t;
  const float* hrow = H + tok * AB_IN;
  WAVE_SYNC();
#pragma unroll
  for (int h = 0; h < 4; ++h) q_lds[h * 64 + lane] = hrow[512 + (g * 4 + h) * 64 + lane] * 0.125f;
  if (lane == 0) L[0] = 0.f;
  WAVE_SYNC();
  float o_cmp[4] = {0.f, 0.f, 0.f, 0.f};
  const int nvalid = t >= 31 ? (t - 31) / 16 + 1 : 0;
  const float* KC = (const float*)(p.ws + OFF_KCMP);
  const float* VC = (const float*)(p.ws + OFF_VCMP);
  attn_branch<NB_CMP>(
      q_lds, p_lds,
      [&](int i, bool& active, bool& valid) {
        const int n = i * 64 + lane;
        active = i * 64 < nvalid; valid = n < nvalid;
        const int nc = n < NCMP ? n : NCMP - 1;
        return KC + ((size_t)(b * NCMP + nc) * 2 + g) * 64;
      },
      [&](int i, int kk) {
        const int n = i * 64 + kk;
        return n < nvalid ? VC + ((size_t)(b * NCMP + n) * 2 + g) * 64 : (const float*)nullptr;
      },
      o_cmp, L + 1, lane);
  WAVE_SYNC();
  const int cur = t >> 6;
  unsigned long long key[(NBLK + 63) / 64];
#pragma unroll
  for (int c = 0; c < (NBLK + 63) / 64; ++c) {
    const int j = lane + 64 * c;
    key[c] = 0ull;
    if (j < NBLK) {
      float val = L[4 * j] + 2.f * (L[4 * j + 1] + L[4 * j + 2] + L[4 * j + 3]) + L[4 * j + 4];
      const bool forced = (j == 0) | (j == cur) | (j == cur - 1);
      float score = forced ? 1e6f : val;
      if (j * 64 > t) score = -1e6f;
      unsigned u = __builtin_bit_cast(unsigned, score);
      u = (u & 0x80000000u) ? ~u : (u | 0x80000000u);
      key[c] = ((unsigned long long)u << 32) | (unsigned)(0xFFFFFFFFu - (unsigned)j);
    }
  }
  for (int r = 0; r < 16; ++r) {
    unsigned long long best = key[0];
#pragma unroll
    for (int c = 1; c < (NBLK + 63) / 64; ++c) best = key[c] > best ? key[c] : best;
#pragma unroll
    for (int mm = 32; mm >= 1; mm >>= 1) {
      const unsigned lo = __shfl_xor((unsigned)best, mm), hi = __shfl_xor((unsigned)(best >> 32), mm);
      const unsigned long long ob = ((unsigned long long)hi << 32) | lo;
      best = ob > best ? ob : best;
    }
    const int j = (int)(0xFFFFFFFFu - (unsigned)(best & 0xFFFFFFFFull));
#pragma unroll
    for (int c = 0; c < (NBLK + 63) / 64; ++c) if (lane + 64 * c == j) key[c] = 0ull;
    if (lane == 0) sel_lds[r] = j;
  }
  WAVE_SYNC();
  float o_slc[4] = {0.f, 0.f, 0.f, 0.f};
  attn_branch<16>(
      q_lds, p_lds,
      [&](int i, bool& active, bool& valid) {
        const int j = sel_lds[i];
        const int kt = j * 64 + lane;
        active = j * 64 <= t; valid = kt <= t;
        return H + ((size_t)b * SEQ_LEN + kt) * AB_IN + 1280 + g * 64;
      },
      [&](int i, int kk) {
        const int kt = sel_lds[i] * 64 + kk;
        return kt <= t ? H + ((size_t)b * SEQ_LEN + kt) * AB_IN + 1408 + g * 64 : (const float*)nullptr;
      },
      o_slc, nullptr, lane);
  float o_win[4] = {0.f, 0.f, 0.f, 0.f};
  attn_branch<8>(
      q_lds, p_lds,
      [&](int i, bool& active, bool& valid) {
        const int kt = t - 511 + i * 64 + lane;
        active = t - 511 + i * 64 + 63 >= 0; valid = kt >= 0;
        return H + ((size_t)b * SEQ_LEN + (kt < 0 ? 0 : kt)) * AB_IN + 1536 + g * 64;
      },
      [&](int i, int kk) {
        const int kt = t - 511 + i * 64 + kk;
        return H + ((size_t)b * SEQ_LEN + (kt < 0 ? 0 : kt)) * AB_IN + 1664 + g * 64;
      },
      o_win, nullptr, lane);
  float* MIX = (float*)(p.ws + OFF_MIX);
  const float ov_c[4] = {o_cmp[0], o_cmp[1], o_cmp[2], o_cmp[3]};
#pragma unroll
  for (int h = 0; h < 4; ++h) {
    const int hd = g * 4 + h;
    const float g0 = sigmoidf_(hrow[1792 + hd * 3 + 0]), g1 = sigmoidf_(hrow[1792 + hd * 3 + 1]), g2 = sigmoidf_(hrow[1792 + hd * 3 + 2]);
    MIX[tok * 1024 + 512 + hd * 64 + lane] = g0 * ov_c[h] + g1 * o_slc[h] + g2 * o_win[h];
  }
}
#define P2_SMEM (P2_S5C_SMEM > P2_ATT_SMEM ? P2_S5C_SMEM : P2_ATT_SMEM)
DEV void phase_p2(const Params& p, char* smem) {
  const int total = P2_S5C_ITEMS + P2_ATT_ITEMS;
  for (int it = blockIdx.x; it < total; it += gridDim.x) {
    if (it < P2_S5C_ITEMS) p2_s5c(p, it, smem);
    else p2_attn(p, it - P2_S5C_ITEMS, smem);
  }
}

DEV void phase_glu(const Params& p, char* smem) {
  const float* A = (const float*)(p.ws + OFF_YGELU);
  const float* B = p.in[I_S5_W_GLU];
  const float* bias = p.in[I_S5_B_GLU];
  float* MIX = (float*)(p.ws + OFF_MIX);
  const int NT = 4, MT = NTOK / 128;
  for (int it = blockIdx.x; it < MT * NT; it += gridDim.x) {
    const int m0 = (it / NT) * 128, n0 = (it % NT) * 128;
    gemm_tile<false>(
        [&](int r) { return (const void*)(A + (size_t)(m0 + r) * 512); },
        [&](int c) { return B + n0 + c; }, 512, 512,
        [&](int row, int col, float v0, float v1) {
          const size_t gm = m0 + row; const int gc = n0 + col;
          const float y0 = A[gm * 512 + gc], y1 = A[gm * 512 + gc + 32];
          MIX[gm * 1024 + gc] = y0 * sigmoidf_(v0 + bias[gc]);
          MIX[gm * 1024 + gc + 32] = y1 * sigmoidf_(v1 + bias[gc + 32]);
        },
        smem);
  }
}

template <int LAYER>
DEV void phase_outproj(const Params& p, char* smem) {
  const float* A = (const float*)(p.ws + OFF_MIX);
  const float* B = LAYER == 0 ? p.in[I_AB_W_OUT] : p.in[I_CD_W_OUT];
  const float* xin = LAYER == 0 ? p.in[I_X] : (const float*)(p.ws + OFF_X2);
  float* PRE = (float*)(p.ws + OFF_H);
  const int NT = 8, MT = NTOK / 128;
  for (int it = blockIdx.x; it < MT * NT; it += gridDim.x) {
    const int m0 = (it / NT) * 128, n0 = (it % NT) * 128;
    gemm_tile<false>(
        [&](int r) { return (const void*)(A + (size_t)(m0 + r) * 1024); },
        [&](int c) { return B + n0 + c; }, 1024, 1024,
        [&](int row, int col, float v0, float v1) {
          const size_t o = (size_t)(m0 + row) * 1024 + n0 + col;
          PRE[o] = ALPHA_F * xin[o] + v0;
          PRE[o + 32] = ALPHA_F * xin[o + 32] + v1;
        },
        smem);
  }
}

DEV void wave_ln(float (&v)[16], const float* gam, const float* bet, int lane) {
  float s = 0.f;
#pragma unroll
  for (int i = 0; i < 16; ++i) s += v[i];
  const float mu = wave_sum(s) * (1.f / 1024.f);
  float q = 0.f;
#pragma unroll
  for (int i = 0; i < 16; ++i) { const float d = v[i] - mu; q += d * d; }
  const float rstd = rsqrtf(wave_sum(q) * (1.f / 1024.f) + 1e-5f);
#pragma unroll
  for (int i = 0; i < 4; ++i) {
    const float4 gv = ld4(gam + lane * 4 + 256 * i), bv = ld4(bet + lane * 4 + 256 * i);
    v[i * 4 + 0] = (v[i * 4 + 0] - mu) * rstd * gv.x + bv.x;
    v[i * 4 + 1] = (v[i * 4 + 1] - mu) * rstd * gv.y + bv.y;
    v[i * 4 + 2] = (v[i * 4 + 2] - mu) * rstd * gv.z + bv.z;
    v[i * 4 + 3] = (v[i * 4 + 3] - mu) * rstd * gv.w + bv.w;
  }
}

#define P5_SMEM (4 * (1024 + 64) * 4)
template <int LAYER>
DEV void phase_ln_router(const Params& p, char* smem) {
  const int lane = threadIdx.x & 63, wave = threadIdx.x >> 6;
  const float* PRE = (const float*)(p.ws + OFF_H);
  float* X1 = (float*)(p.ws + OFF_X1);
  const float* router = p.in[I_ROUTER] + (size_t)LAYER * 1024 * 64;
  const float* bias = p.in[I_MOE_BIAS] + LAYER * 64;
  int* TOPI = (int*)(p.ws + OFF_TOPI);
  float* TOPG = (float*)(p.ws + OFF_TOPG);
  float* xs = (float*)smem + wave * (1024 + 64);
  float* ms = xs + 1024;
  for (int it = blockIdx.x; it < NTOK / 4; it += gridDim.x) {
    const size_t tok = (size_t)it * 4 + wave;
    float v[16];
#pragma unroll
    for (int i = 0; i < 4; ++i) {
      const float4 a = ld4(PRE + tok * 1024 + lane * 4 + 256 * i);
      v[i * 4] = a.x; v[i * 4 + 1] = a.y; v[i * 4 + 2] = a.z; v[i * 4 + 3] = a.w;
    }
    wave_ln(v, p.in[I_LN1_G] + LAYER * 1024, p.in[I_LN1_B] + LAYER * 1024, lane);
    WAVE_SYNC();
#pragma unroll
    for (int i = 0; i < 4; ++i) {
      const float4 a = make_float4(v[i * 4], v[i * 4 + 1], v[i * 4 + 2], v[i * 4 + 3]);
      st4(X1 + tok * 1024 + lane * 4 + 256 * i, a);
      st4(xs + lane * 4 + 256 * i, a);
    }
    WAVE_SYNC();
    float logit = 0.f;
    for (int k = 0; k < 1024; k += 4) {
      const float4 xv = ld4(xs + k);
      logit += xv.x * router[(size_t)k * 64 + lane] + xv.y * router[(size_t)(k + 1) * 64 + lane] +
               xv.z * router[(size_t)(k + 2) * 64 + lane] + xv.w * router[(size_t)(k + 3) * 64 + lane];
    }
    const float score = 1.f / (1.f + expf(-logit));
    const float biased = score + bias[lane];
    float m1 = biased; int a1 = lane;
#pragma unroll
    for (int mm = 1; mm <= 4; mm <<= 1) {
      const float ov = __shfl_xor(m1, mm); const int oa = __shfl_xor(a1, mm);
      if (ov > m1 || (ov == m1 && oa < a1)) { m1 = ov; a1 = oa; }
    }
    float m2 = lane == a1 ? -INFINITY : biased;
#pragma unroll
    for (int mm = 1; mm <= 4; mm <<= 1) m2 = fmaxf(m2, __shfl_xor(m2, mm));
    const float gs = m1 + m2;
    const int mygrp = lane >> 3;
    int rank = 0;
#pragma unroll
    for (int gg = 0; gg < 8; ++gg) {
      const float og = __shfl(gs, gg * 8);
      rank += (og > gs || (og == gs && gg < mygrp)) ? 1 : 0;
    }
    const float masked = rank < 4 ? biased : -INFINITY;
    WAVE_SYNC();
    ms[lane] = masked;
    WAVE_SYNC();
    int erank = 0;
    for (int e = 0; e < 64; ++e) {
      const float ov = ms[e];
      erank += (ov > masked || (ov == masked && e < lane)) ? 1 : 0;
    }
    const bool selected = erank < 8;
    const float gsum = wave_sum(selected ? score : 0.f);
    if (selected) {
      TOPI[tok * 8 + erank] = lane;
      TOPG[tok * 8 + erank] = score / gsum * 2.5f;
    }
    WAVE_SYNC();
  }
}

#define P6_SMEM GEMM_SMEM_BYTES
template <int LAYER>
DEV void phase_lists_shup(const Params& p, char* smem) {
  const int tid = threadIdx.x, lane = tid & 63, wave = tid >> 6;
  const int* TOPI = (const int*)(p.ws + OFF_TOPI);
  const float* TOPG = (const float*)(p.ws + OFF_TOPG);
  int* POSOF = (int*)(p.ws + OFF_POSOF);
  int* CNT = (int*)(p.ws + OFF_CNT);
  int* LTOK = (int*)(p.ws + OFF_LTOK);
  float* LGATE = (float*)(p.ws + OFF_LGATE);
  const float* X1 = (const float*)(p.ws + OFF_X1);
  unsigned short* HS = (unsigned short*)(p.ws + OFF_HS);
  const float* W1 = p.in[I_SH_W1] + (size_t)LAYER * 1024 * 256;
  const float* W3 = p.in[I_SH_W3] + (size_t)LAYER * 1024 * 256;
  const int MT = NTOK / 128;
  const int total = 64 + MT * 4;
  int* swave = (int*)smem;
  for (int it = blockIdx.x; it < total; it += gridDim.x) {
    if (it < 64) {
      const int e = it;
      int base = 0;
      for (int t0 = 0; t0 < NTOK; t0 += NTHREADS) {
        const int tok = t0 + tid;
        int slot = -1;
#pragma unroll
        for (int s = 0; s < 8; ++s) if (TOPI[(size_t)tok * 8 + s] == e) slot = s;
        const unsigned long long bal = __ballot(slot >= 0);
        const int pre = __popcll(bal & ((1ull << lane) - 1ull));
        __syncthreads();
        if (lane == 0) swave[wave] = __popcll(bal);
        __syncthreads();
        int woff = 0, tot = 0;
#pragma unroll
        for (int w = 0; w < 4; ++w) { const int c = swave[w]; if (w < wave) woff += c; tot += c; }
        if (slot >= 0) {
          const int pos = base + woff + pre;
          LTOK[(size_t)e * NTOK + pos] = tok;
          LGATE[(size_t)e * NTOK + pos] = TOPG[(size_t)tok * 8 + slot];
          POSOF[(size_t)tok * 8 + slot] = pos;
        }
        base += tot;
      }
      if (tid == 0) CNT[e] = base;
      __syncthreads();
    } else {
      const int it2 = it - 64;
      const int m0 = (it2 / 4) * 128, ct = it2 % 4;
      gemm_tile<false>(
          [&](int r) { return (const void*)(X1 + (size_t)(m0 + r) * 1024); },
          [&](int c) { return (((c >> 5) & 1) ? W3 : W1) + ct * 64 + (c >> 6) * 32 + (c & 31); }, 256, 1024,
          [&](int row, int col, float v0, float v1) {
            const int lc = ct * 64 + (col >> 6) * 32 + (col & 31);
            HS[(size_t)(m0 + row) * 256 + lc] = f2bf(siluf_(v0) * v1);
          },
          smem);
    }
  }
}

struct ExpMap { int tstart[65]; int rbase[65]; };
DEV void build_expmap(const Params& p, ExpMap* em) {
  __syncthreads();
  if (threadIdx.x == 0) {
    const int* CNT = (const int*)(p.ws + OFF_CNT);
    int ts = 0, rb = 0;
    for (int e = 0; e < 64; ++e) {
      em->tstart[e] = ts; em->rbase[e] = rb;
      const int c = CNT[e];
      ts += (c + 127) / 128; rb += c;
    }
    em->tstart[64] = ts; em->rbase[64] = rb;
  }
  __syncthreads();
}
DEV int find_expert(const ExpMap* em, int rt) {
  int e = 0;
  for (int k = 0; k < 64; ++k) if (em->tstart[k + 1] <= rt) e = k + 1;
  return e;
}

#define P7_SMEM (GEMM_SMEM_BYTES + 1024)
template <int LAYER>
DEV void phase_routed_up(const Params& p, char* smem) {
  ExpMap* em = (ExpMap*)(smem + GEMM_SMEM_BYTES);
  build_expmap(p, em);
  const int* CNT = (const int*)(p.ws + OFF_CNT);
  const int* LTOK = (const int*)(p.ws + OFF_LTOK);
  const float* X1 = (const float*)(p.ws + OFF_X1);
  unsigned short* HR = (unsigned short*)(p.ws + OFF_HR);
  const int total = em->tstart[64] * 4;
  for (int it = blockIdx.x; it < total; it += gridDim.x) {
    const int rt = it >> 2, ct = it & 3;
    const int e = find_expert(em, rt);
    const int r0 = (rt - em->tstart[e]) * 128;
    const int cnt = CNT[e], rbase = em->rbase[e];
    const float* W1 = p.in[I_MOE_W1] + ((size_t)LAYER * 64 + e) * 1024 * 256;
    const float* W3 = p.in[I_MOE_W3] + ((size_t)LAYER * 64 + e) * 1024 * 256;
    gemm_tile<false>(
        [&](int r) { return (r0 + r < cnt) ? (const void*)(X1 + (size_t)LTOK[(size_t)e * NTOK + r0 + r] * 1024) : (const void*)nullptr; },
        [&](int c) { return (((c >> 5) & 1) ? W3 : W1) + ct * 64 + (c >> 6) * 32 + (c & 31); }, 256, 1024,
        [&](int row, int col, float v0, float v1) {
          if (r0 + row < cnt) {
            const int lc = ct * 64 + (col >> 6) * 32 + (col & 31);
            HR[(size_t)(rbase + r0 + row) * 256 + lc] = f2bf(siluf_(v0) * v1);
          }
        },
        smem);
  }
}

template <int LAYER>
DEV void phase_down(const Params& p, char* smem) {
  ExpMap* em = (ExpMap*)(smem + GEMM_SMEM_BYTES);
  build_expmap(p, em);
  const int* CNT = (const int*)(p.ws + OFF_CNT);
  const float* LGATE = (const float*)(p.ws + OFF_LGATE);
  const unsigned short* HR = (const unsigned short*)(p.ws + OFF_HR);
  const unsigned short* HS = (const unsigned short*)(p.ws + OFF_HS);
  unsigned short* Y = (unsigned short*)(p.ws + OFF_Y);
  float* FS = (float*)(p.ws + OFF_FS);
  const int nrouted = em->tstart[64] * 8;
  const int total = nrouted + (NTOK / 128) * 8;
  for (int it = blockIdx.x; it < total; it += gridDim.x) {
    if (it < nrouted) {
      const int rt = it >> 3, ct = it & 7;
      const int e = find_expert(em, rt);
      const int r0 = (rt - em->tstart[e]) * 128;
      const int cnt = CNT[e], rbase = em->rbase[e];
      const float* W2 = p.in[I_MOE_W2] + ((size_t)LAYER * 64 + e) * 256 * 1024;
      const int n0 = ct * 128;
      gemm_tile<true>(
          [&](int r) { return (r0 + r < cnt) ? (const void*)(HR + (size_t)(rbase + r0 + r) * 256) : (const void*)nullptr; },
          [&](int c) { return W2 + n0 + c; }, 1024, 256,
          [&](int row, int col, float v0, float v1) {
            if (r0 + row < cnt) {
              const float gt = LGATE[(size_t)e * NTOK + r0 + row];
              const size_t o = (size_t)(rbase + r0 + row) * 1024 + n0 + col;
              Y[o] = f2bf(v0 * gt); Y[o + 32] = f2bf(v1 * gt);
            }
          },
          smem);
    } else {
      const int it2 = it - nrouted;
      const int m0 = (it2 >> 3) * 128, n0 = (it2 & 7) * 128;
      const float* W2 = p.in[I_SH_W2] + (size_t)LAYER * 256 * 1024;
      gemm_tile<true>(
          [&](int r) { return (const void*)(HS + (size_t)(m0 + r) * 256); },
          [&](int c) { return W2 + n0 + c; }, 1024, 256,
          [&](int row, int col, float v0, float v1) {
            const size_t o = (size_t)(m0 + row) * 1024 + n0 + col;
            FS[o] = v0; FS[o + 32] = v1;
          },
          smem);
    }
  }
}

template <int LAYER>
DEV void phase_combine(const Params& p, char* smem) {
  ExpMap* em = (ExpMap*)smem;
  build_expmap(p, em);
  const int lane = threadIdx.x & 63, wave = threadIdx.x >> 6;
  const float* X1 = (const float*)(p.ws + OFF_X1);
  const float* FS = (const float*)(p.ws + OFF_FS);
  const unsigned short* Y = (const unsigned short*)(p.ws + OFF_Y);
  const int* TOPI = (const int*)(p.ws + OFF_TOPI);
  const int* POSOF = (const int*)(p.ws + OFF_POSOF);
  float* OUT = LAYER == 0 ? (float*)(p.ws + OFF_X2) : p.out;
  for (int it = blockIdx.x; it < NTOK / 4; it += gridDim.x) {
    const size_t tok = (size_t)it * 4 + wave;
    float v[16];
#pragma unroll
    for (int i = 0; i < 4; ++i) {
      const float4 a = ld4(X1 + tok * 1024 + lane * 4 + 256 * i), f = ld4(FS + tok * 1024 + lane * 4 + 256 * i);
      v[i * 4] = ALPHA_F * a.x + f.x; v[i * 4 + 1] = ALPHA_F * a.y + f.y; v[i * 4 + 2] = ALPHA_F * a.z + f.z; v[i * 4 + 3] = ALPHA_F * a.w + f.w;
    }
    for (int s = 0; s < 8; ++s) {
      const int e = TOPI[tok * 8 + s];
      const size_t row = (size_t)em->rbase[e] + POSOF[tok * 8 + s];
#pragma unroll
      for (int i = 0; i < 4; ++i) {
        const uint2 y = *(const uint2*)(Y + row * 1024 + lane * 4 + 256 * i);
        v[i * 4] += bf2f((unsigned short)(y.x & 0xFFFF)); v[i * 4 + 1] += bf2f((unsigned short)(y.x >> 16));
        v[i * 4 + 2] += bf2f((unsigned short)(y.y & 0xFFFF)); v[i * 4 + 3] += bf2f((unsigned short)(y.y >> 16));
      }
    }
    wave_ln(v, p.in[I_LN2_G] + LAYER * 1024, p.in[I_LN2_B] + LAYER * 1024, lane);
#pragma unroll
    for (int i = 0; i < 4; ++i) st4(OUT + tok * 1024 + lane * 4 + 256 * i, make_float4(v[i * 4], v[i * 4 + 1], v[i * 4 + 2], v[i * 4 + 3]));
  }
}

DEV float shifted(const float* Hc, size_t tok, int col, const float* mu) {
  const float cur = Hc[tok * CD_IN + col];
  const float prev = (tok % SEQ_LEN) == 0 ? 0.f : Hc[(tok - 1) * CD_IN + col];
  return cur + (prev - cur) * mu[col];
}

#define P11_PREP_ITEMS (NTOK / 8)
#define P11_KV_ITEMS (BATCH * 4 * RET_NC)
#define P11_SMEM (8 * 128 * 4)
DEV void p11_prep(const Params& p, int item, char* smem) {
  const int tid = threadIdx.x;
  const float* Hc = (const float*)(p.ws + OFF_H);
  const float* mu = p.in[I_RW_MU];
  float* sl = (float*)smem;
  __syncthreads();
  for (int w = tid; w < 8 * 128; w += NTHREADS) {
    const int tt = w >> 7, j = w & 127;
    const size_t tok = (size_t)item * 8 + tt;
    const float v = shifted(Hc, tok, 1536 + j, mu);
    sl[w] = j < 64 ? tanhf(v) : v;
  }
  __syncthreads();
  float* RWW = (float*)(p.ws + OFF_RWW); float* RWK = (float*)(p.ws + OFF_RWK);
  float* RWKK = (float*)(p.ws + OFF_RWKK); float* RWA = (float*)(p.ws + OFF_RWA);
  float* RWR = p.out + (size_t)NTOK * 512; float* RWV = p.out;
  const float* w_up = p.in[I_RW_W_UP]; const float* a_up = p.in[I_RW_A_UP];
#pragma unroll
  for (int cc = 0; cc < 2; ++cc) {
    const int c = tid + 256 * cc;
    float aw[8], aa[8];
#pragma unroll
    for (int tt = 0; tt < 8; ++tt) { aw[tt] = 0.f; aa[tt] = 0.f; }
    for (int j = 0; j < 64; ++j) {
      const float wu = w_up[j * 512 + c], au = a_up[j * 512 + c];
#pragma unroll
      for (int tt = 0; tt < 8; ++tt) { aw[tt] += sl[tt * 128 + j] * wu; aa[tt] += sl[tt * 128 + 64 + j] * au; }
    }
    const float w0 = p.in[I_RW_W0][c], a0 = p.in[I_RW_A0][c], kkc = p.in[I_RW_K_K][c], kac = p.in[I_RW_K_A][c];
#pragma unroll
    for (int tt = 0; tt < 8; ++tt) {
      const size_t tok = (size_t)item * 8 + tt;
      const float lw = w0 + aw[tt];
      const float nl = -lw;
      const float sp = nl > 20.f ? nl : log1pf(expf(nl));
      const float wl = -sp - 0.5f;
      const float decay = expf(-expf(wl));
      const float a = 1.f / (1.f + expf(-(a0 + aa[tt])));
      const float rs = shifted(Hc, tok, c, mu);
      const float ks = shifted(Hc, tok, 512 + c, mu);
      const float vs = shifted(Hc, tok, 1024 + c, mu);
      float kk = ks * kkc;
      const float nrm = sqrtf(wave_sum(kk * kk));
      kk = kk / fmaxf(nrm, 1e-12f);
      RWW[tok * 512 + c] = decay;
      RWK[tok * 512 + c] = ks * (1.f + (a - 1.f) * kac);
      RWKK[tok * 512 + c] = kk;
      RWA[tok * 512 + c] = kk * a;
      RWR[tok * 512 + c] = rs;
      RWV[tok * 512 + c] = vs;
    }
  }
}
DEV float ret_log2gamma(int h) { return log2f(1.f - exp2f(-5.f - (float)h)); }
DEV void p11_kv(const Params& p, int item) {
  const int c = item % RET_NC, h = (item / RET_NC) & 3, b = item / (RET_NC * 4);
  const int tid = threadIdx.x, e = tid & 127, dh = tid >> 7;
  const float* Hc = (const float*)(p.ws + OFF_H);
  const float lg = ret_log2gamma(h);
  float acc[32];
#pragma unroll
  for (int i = 0; i < 32; ++i) acc[i] = 0.f;
  for (int j = 0; j < 128; ++j) {
    const size_t tok = (size_t)b * SEQ_LEN + c * 128 + j;
    const float vv = Hc[tok * CD_IN + 2304 + h * 128 + e] * exp2f((float)(127 - j) * lg);
    const float* kr = Hc + tok * CD_IN + 2048 + h * 64 + dh * 32;
#pragma unroll
    for (int i4 = 0; i4 < 8; ++i4) {
      const float4 kv = ld4(kr + i4 * 4);
      acc[i4 * 4] += kv.x * vv; acc[i4 * 4 + 1] += kv.y * vv; acc[i4 * 4 + 2] += kv.z * vv; acc[i4 * 4 + 3] += kv.w * vv;
    }
  }
  float* KV = (float*)(p.ws + OFF_RETKV) + (size_t)item * 64 * 128;
#pragma unroll
  for (int i = 0; i < 32; ++i) KV[(dh * 32 + i) * 128 + e] = acc[i];
}
DEV void phase_p11(const Params& p, char* smem) {
  const int total = P11_PREP_ITEMS + P11_KV_ITEMS;
  for (int it = blockIdx.x; it < total; it += gridDim.x) {
    if (it < P11_KV_ITEMS) p11_kv(p, it);
    else p11_prep(p, it - P11_KV_ITEMS, smem);
  }
}

#define P12_SCAN_ITEMS (BATCH * 8 * 4)
#define P12_RET_ITEMS (BATCH * 4 * RET_NC)
#define P12_SCAN_SMEM ((2 * (16 * 5 * 64 + 16 * 16) + 16 * 16) * 4)
#define P12_RET_SMEM (64 * 128 * 4 + 256 * 2 * 4)
#define P12_SMEM (P12_SCAN_SMEM > P12_RET_SMEM ? P12_SCAN_SMEM : P12_RET_SMEM)
DEV float sum16(float v) {
#ifdef CPU_EMU
  return emu_sum16(v);
#else
  int x;
  x = __builtin_amdgcn_update_dpp(0, __builtin_bit_cast(int, v), 0xB1, 0xF, 0xF, false); v += __builtin_bit_cast(float, x);
  x = __builtin_amdgcn_update_dpp(0, __builtin_bit_cast(int, v), 0x4E, 0xF, 0xF, false); v += __builtin_bit_cast(float, x);
  x = __builtin_amdgcn_update_dpp(0, __builtin_bit_cast(int, v), 0x141, 0xF, 0xF, false); v += __builtin_bit_cast(float, x);
  x = __builtin_amdgcn_update_dpp(0, __builtin_bit_cast(int, v), 0x140, 0xF, 0xF, false); v += __builtin_bit_cast(float, x);
  return v;
#endif
}
DEV void p12_scan(const Params& p, int item, char* smem) {
  const int rq = item & 3, h = (item >> 2) & 7, b = item >> 5;
  const int tid = threadIdx.x, rl = tid >> 4, cg = tid & 15;
  const float* ARR[5] = {(const float*)(p.ws + OFF_RWW), (const float*)(p.ws + OFF_RWK), (const float*)(p.ws + OFF_RWKK),
                         (const float*)(p.ws + OFF_RWA), p.out + (size_t)NTOK * 512};
  const float* RWV = p.out;
  float* Yo = (float*)(p.ws + OFF_MIX);
  float* buf = (float*)smem;
  float* vbuf = buf + 2 * 16 * 5 * 64;
  float* ybuf = vbuf + 2 * 16 * 16;
  float S[4] = {0.f, 0.f, 0.f, 0.f};
  float4 rg[5]; float rv;
  const int lstep = tid >> 4, lc4 = tid & 15;
  auto gload = [&](int c) {
    const size_t o = ((size_t)b * SEQ_LEN + c * 16 + lstep) * 512 + h * 64;
#pragma unroll
    for (int a = 0; a < 5; ++a) rg[a] = ld4(ARR[a] + o + lc4 * 4);
    rv = RWV[o + rq * 16 + lc4];
  };
  auto sstore = [&](int bi) {
#pragma unroll
    for (int a = 0; a < 5; ++a) st4(buf + ((bi * 16 + lstep) * 5 + a) * 64 + lc4 * 4, rg[a]);
    vbuf[(bi * 16 + lstep) * 16 + lc4] = rv;
  };
  __syncthreads();
  gload(0);
  sstore(0);
  __syncthreads();
  const int NCH = SEQ_LEN / 16;
  for (int c = 0; c < NCH; ++c) {
    if (c + 1 < NCH) gload(c + 1);
    const float* cb = buf + (c & 1) * 16 * 5 * 64;
    const float* cv = vbuf + (c & 1) * 16 * 16;
#pragma unroll
    for (int s = 0; s < 16; ++s) {
      const float4 w = ld4(cb + (s * 5 + 0) * 64 + cg * 4), k = ld4(cb + (s * 5 + 1) * 64 + cg * 4), kk = ld4(cb + (s * 5 + 2) * 64 + cg * 4),
                   ka = ld4(cb + (s * 5 + 3) * 64 + cg * 4), r = ld4(cb + (s * 5 + 4) * 64 + cg * 4);
      const float v = cv[s * 16 + rl];
      float sa = (S[0] * kk.x + S[1] * kk.y) + (S[2] * kk.z + S[3] * kk.w);
      sa = -sum16(sa);
      S[0] = S[0] * w.x + (sa * ka.x + v * k.x);
      S[1] = S[1] * w.y + (sa * ka.y + v * k.y);
      S[2] = S[2] * w.z + (sa * ka.z + v * k.z);
      S[3] = S[3] * w.w + (sa * ka.w + v * k.w);
      float y = (S[0] * r.x + S[1] * r.y) + (S[2] * r.z + S[3] * r.w);
      y = sum16(y);
      if (cg == 0) ybuf[s * 16 + rl] = y;
    }
    __syncthreads();
    if (c + 1 < NCH) sstore((c + 1) & 1);
    Yo[((size_t)b * SEQ_LEN + c * 16 + lstep) * 1024 + h * 64 + rq * 16 + lc4] = ybuf[lstep * 16 + lc4];
    __syncthreads();
  }
}
DEV void p12_ret(const Params& p, int item, char* smem) {
  const int c = item % RET_NC, h = (item / RET_NC) & 3, b = item / (RET_NC * 4);
  const int tid = threadIdx.x, i = tid & 127, eh = tid >> 7;
  const float* Hc = (const float*)(p.ws + OFF_H);
  const float lg = ret_log2gamma(h);
  float* sS = (float*)smem;
  float* sRed = sS + 64 * 128;
  __syncthreads();
  {
    const float G = exp2f(128.f * lg);
    const float* KV0 = (const float*)(p.ws + OFF_RETKV) + (size_t)((b * 4 + h) * RET_NC) * 64 * 128;
    for (int w = tid; w < 64 * 128; w += NTHREADS) {
      float s = 0.f;
      for (int cc = 0; cc < c; ++cc) s = s * G + KV0[(size_t)cc * 64 * 128 + w];
      sS[w] = s;
    }
  }
  __syncthreads();
  const size_t tok0 = (size_t)b * SEQ_LEN + c * 128;
  float q[64];
  {
    const float* qr = Hc + (tok0 + i) * CD_IN + 1792 + h * 64;
#pragma unroll
    for (int d4 = 0; d4 < 16; ++d4) { const float4 v = ld4(qr + d4 * 4); q[d4 * 4] = v.x; q[d4 * 4 + 1] = v.y; q[d4 * 4 + 2] = v.z; q[d4 * 4 + 3] = v.w; }
  }
  float acc[64];
#pragma unroll
  for (int e = 0; e < 64; ++e) acc[e] = 0.f;
  {
    const float qs = exp2f((float)(i + 1) * lg);
#pragma unroll
    for (int d = 0; d < 64; ++d) {
      const float qd = q[d] * qs;
#pragma unroll
      for (int e4 = 0; e4 < 16; ++e4) {
        const float4 sv = ld4(sS + d * 128 + eh * 64 + e4 * 4);
        acc[e4 * 4] += qd * sv.x; acc[e4 * 4 + 1] += qd * sv.y; acc[e4 * 4 + 2] += qd * sv.z; acc[e4 * 4 + 3] += qd * sv.w;
      }
    }
  }
  const int jmax = ((tid >> 6) & 1) * 64 + 63;
  for (int j = 0; j <= jmax; ++j) {
    const float* kr = Hc + (tok0 + j) * CD_IN + 2048 + h * 64;
    float s = 0.f;
#pragma unroll
    for (int d4 = 0; d4 < 16; ++d4) { const float4 kv = ld4(kr + d4 * 4); s += q[d4 * 4] * kv.x + q[d4 * 4 + 1] * kv.y + q[d4 * 4 + 2] * kv.z + q[d4 * 4 + 3] * kv.w; }
    s = j <= i ? s * exp2f((float)(i - j) * lg) : 0.f;
    const float* vr = Hc + (tok0 + j) * CD_IN + 2304 + h * 128 + eh * 64;
#pragma unroll
    for (int e4 = 0; e4 < 16; ++e4) {
      const float4 vv = ld4(vr + e4 * 4);
      acc[e4 * 4] += s * vv.x; acc[e4 * 4 + 1] += s * vv.y; acc[e4 * 4 + 2] += s * vv.z; acc[e4 * 4 + 3] += s * vv.w;
    }
  }
  float s1 = 0.f;
#pragma unroll
  for (int e = 0; e < 64; ++e) s1 += acc[e];
  sRed[tid * 2] = s1;
  __syncthreads();
  const float mu = (s1 + sRed[(tid ^ 128) * 2]) * (1.f / 128.f);
  float s2 = 0.f;
#pragma unroll
  for (int e = 0; e < 64; ++e) { const float d = acc[e] - mu; s2 += d * d; }
  sRed[tid * 2 + 1] = s2;
  __syncthreads();
  const float rstd = rsqrtf((s2 + sRed[(tid ^ 128) * 2 + 1]) * (1.f / 128.f) + 1e-5f);
  float* MIX = (float*)(p.ws + OFF_MIX);
  const float* lgam = p.in[I_RET_LN_G] + h * 128 + eh * 64;
  const float* lbet = p.in[I_RET_LN_B] + h * 128 + eh * 64;
  const float* gate = Hc + (tok0 + i) * CD_IN + 2816 + h * 128 + eh * 64;
  float* dst = MIX + (tok0 + i) * 1024 + 512 + h * 128 + eh * 64;
#pragma unroll
  for (int e4 = 0; e4 < 16; ++e4) {
    const float4 gv = ld4(lgam + e4 * 4), bv = ld4(lbet + e4 * 4), gt = ld4(gate + e4 * 4);
    float4 o;
    o.x = siluf_(gt.x) * ((acc[e4 * 4] - mu) * rstd * gv.x + bv.x);
    o.y = siluf_(gt.y) * ((acc[e4 * 4 + 1] - mu) * rstd * gv.y + bv.y);
    o.z = siluf_(gt.z) * ((acc[e4 * 4 + 2] - mu) * rstd * gv.z + bv.z);
    o.w = siluf_(gt.w) * ((acc[e4 * 4 + 3] - mu) * rstd * gv.w + bv.w);
    st4(dst + e4 * 4, o);
  }
}
DEV void phase_p12(const Params& p, char* smem) {
  const int total = P12_SCAN_ITEMS + P12_RET_ITEMS;
  for (int it = blockIdx.x; it < total; it += gridDim.x) {
    if (it < P12_SCAN_ITEMS) p12_scan(p, it, smem);
    else p12_ret(p, it - P12_SCAN_ITEMS, smem);
  }
}

#define P13_SMEM (8 * 128 * 4)
DEV void phase_p13(const Params& p, char* smem) {
  const int tid = threadIdx.x;
  const float* Hc = (const float*)(p.ws + OFF_H);
  const float* mu = p.in[I_RW_MU];
  float* sl = (float*)smem;
  float* MIX = (float*)(p.ws + OFF_MIX);
  const float* RWK = (const float*)(p.ws + OFF_RWK); const float* RWR = p.out + (size_t)NTOK * 512; const float* RWV = p.out;
  const float* g_up = p.in[I_RW_G_UP];
  for (int it = blockIdx.x; it < NTOK / 8; it += gridDim.x) {
    __syncthreads();
    for (int w = tid; w < 8 * 128; w += NTHREADS) {
      const size_t tok = (size_t)it * 8 + (w >> 7);
      sl[w] = sigmoidf_(shifted(Hc, tok, 1664 + (w & 127), mu));
    }
    __syncthreads();
#pragma unroll
    for (int cc = 0; cc < 2; ++cc) {
      const int c = tid + 256 * cc;
      float ag[8];
#pragma unroll
      for (int tt = 0; tt < 8; ++tt) ag[tt] = 0.f;
      for (int j = 0; j < 128; ++j) {
        const float gu = g_up[j * 512 + c];
#pragma unroll
        for (int tt = 0; tt < 8; ++tt) ag[tt] += sl[tt * 128 + j] * gu;
      }
      const float lng = p.in[I_RW_LN_G][c], lnb = p.in[I_RW_LN_B][c], rk = p.in[I_RW_R_K][c];
#pragma unroll
      for (int tt = 0; tt < 8; ++tt) {
        const size_t tok = (size_t)it * 8 + tt;
        const float y = MIX[tok * 1024 + c];
        const float m = wave_sum(y) * (1.f / 64.f);
        const float d = y - m;
        const float var = wave_sum(d * d) * (1.f / 64.f);
        const float yn = d * rsqrtf(var + 64e-5f) * lng + lnb;
        const float r = RWR[tok * 512 + c], k = RWK[tok * 512 + c], v = RWV[tok * 512 + c];
        const float bonus = wave_sum(r * k * rk) * v;
        MIX[tok * 1024 + c] = (yn + bonus) * ag[tt];
      }
    }
  }
}

#define NPHASES 20
#define SMEM_BYTES 49152
DEV void run_phase(const Params& p, int ph, char* smem) {
  switch (ph) {
    case 0: phase_gemm_in<0>(p, smem); break;
    case 1: phase_p1(p, smem); break;
    case 2: phase_p2(p, smem); break;
    case 3: phase_glu(p, smem); break;
    case 4: phase_outproj<0>(p, smem); break;
    case 5: phase_ln_router<0>(p, smem); break;
    case 6: phase_lists_shup<0>(p, smem); break;
    case 7: phase_routed_up<0>(p, smem); break;
    case 8: phase_down<0>(p, smem); break;
    case 9: phase_combine<0>(p, smem); break;
    case 10: phase_gemm_in<1>(p, smem); break;
    case 11: phase_p11(p, smem); break;
    case 12: phase_p12(p, smem); break;
    case 13: phase_p13(p, smem); break;
    case 14: phase_outproj<1>(p, smem); break;
    case 15: phase_ln_router<1>(p, smem); break;
    case 16: phase_lists_shup<1>(p, smem); break;
    case 17: phase_routed_up<1>(p, smem); break;
    case 18: phase_down<1>(p, smem); break;
    case 19: phase_combine<1>(p, smem); break;
  }
}
static_assert(P1_SMEM <= SMEM_BYTES, "smem");
static_assert(P2_SMEM <= SMEM_BYTES, "smem");
static_assert(P5_SMEM <= SMEM_BYTES, "smem");
static_assert(P7_SMEM <= SMEM_BYTES, "smem");
static_assert(P12_SMEM <= SMEM_BYTES, "smem");
static_assert(OFF_HS + (size_t)NTOK * 256 * 2 <= OFF_X1, "layout");

#ifndef CPU_EMU
template <int PH>
__global__ void __launch_bounds__(NTHREADS) phase_kernel(Params p) {
  __shared__ __attribute__((aligned(16))) char smem[SMEM_BYTES];
  run_phase(p, PH, smem);
}
template <int PH>
static void launch_phases(const Params& p, hipStream_t stream) {
  phase_kernel<PH><<<dim3(1024), dim3(NTHREADS), 0, stream>>>(p);
  if constexpr (PH + 1 < NPHASES) launch_phases<PH + 1>(p, stream);
}
#if MEGA
DEV void grid_barrier(unsigned* bar, unsigned& epoch) {
  asm volatile("s_waitcnt vmcnt(0)" ::: "memory");
  __syncthreads();
  epoch += 1u;
  if (threadIdx.x == 0) {
    __builtin_amdgcn_fence(__ATOMIC_RELEASE, "agent");
    asm volatile("s_waitcnt vmcnt(0)" ::: "memory");
    __hip_atomic_fetch_add(bar, 1u, __ATOMIC_RELAXED, __HIP_MEMORY_SCOPE_AGENT);
    const unsigned target = epoch * gridDim.x;
    while (__hip_atomic_load(bar, __ATOMIC_RELAXED, __HIP_MEMORY_SCOPE_AGENT) < target) __builtin_amdgcn_s_sleep(1);
    __builtin_amdgcn_fence(__ATOMIC_ACQUIRE, "agent");
    asm volatile("s_waitcnt vmcnt(0)" ::: "memory");
  }
  __syncthreads();
}
__global__ void __launch_bounds__(NTHREADS) mega_kernel(Params p) {
  __shared__ __attribute__((aligned(16))) char smem[SMEM_BYTES];
  unsigned* bar = (unsigned*)(p.ws + OFF_BAR);
  unsigned epoch = 0u;
  if (p.ws == nullptr) cg::this_grid().sync();
#define PH_(n) run_phase(p, n, smem); grid_barrier(bar, epoch);
  PH_(0) PH_(1) PH_(2) PH_(3) PH_(4) PH_(5) PH_(6) PH_(7) PH_(8) PH_(9)
  PH_(10) PH_(11) PH_(12) PH_(13) PH_(14) PH_(15) PH_(16) PH_(17) PH_(18)
  run_phase(p, 19, smem);
}
#endif

extern "C" void kernel_launch(void* const* d_in, const int* in_sizes, int n_in, void* d_out, int out_size, void* d_ws, size_t ws_size,
                              hipStream_t stream) {
  Params p;
  for (int i = 0; i < N_INPUTS; ++i) p.in[i] = (const float*)d_in[i];
  p.out = (float*)d_out;
  p.ws = (char*)d_ws;
#if MEGA
  static int grid_blocks = 0;
  if (!grid_blocks) {
    int dev = 0, cus = 0, per_cu = 0;
    hipGetDevice(&dev);
    hipDeviceGetAttribute(&cus, hipDeviceAttributeMultiprocessorCount, dev);
    hipOccupancyMaxActiveBlocksPerMultiprocessor(&per_cu, mega_kernel, NTHREADS, 0);
    if (per_cu > 2) per_cu = 2;
    grid_blocks = cus * per_cu;
  }
  hipMemsetAsync((char*)d_ws + OFF_BAR, 0, 4096, stream);
  void* args[] = {&p};
  hipError_t e = hipLaunchCooperativeKernel((void*)mega_kernel, dim3(grid_blocks), dim3(NTHREADS), args, 0, stream);
  if (e != hipSuccess) fprintf(stderr, "cooperative launch failed: %s (grid %d)\n", hipGetErrorString(e), grid_blocks);
#else
  launch_phases<0>(p, stream);
#endif
}
#endif
```

```cpp
#ifdef CPU_EMU
#include "emu.h"
#else
#include <hip/hip_runtime.h>
#include <hip/hip_cooperative_groups.h>
#include <cstdio>
namespace cg = cooperative_groups;
#endif
#include <stdint.h>

#ifndef BATCH
#define BATCH 2
#endif
#ifndef SEQ_LEN
#define SEQ_LEN 8192
#endif
#ifndef MEGA
#define MEGA 1
#endif

#define DEV __device__ __forceinline__
#define NTOK (BATCH * SEQ_LEN)
#define DM 1024
#define AB_IN 1816
#define CD_IN 3328
#define NCMP ((SEQ_LEN - 32) / 16 + 1)
#define NBLK (SEQ_LEN / 64)
#define NB_CMP ((NCMP + 63) / 64)
#define S5_NC (SEQ_LEN / 64)
#define RET_NC (SEQ_LEN / 128)
#define ALPHA_F 1.4142135623730951f
#define NTHREADS 256

enum { I_X = 0, I_AB_W_IN, I_AB_W_OUT, I_S5_LAM_RE, I_S5_LAM_IM, I_S5_LOG_DT, I_S5_B_RE, I_S5_B_IM, I_S5_C_RE, I_S5_C_IM,
       I_S5_D, I_S5_W_GLU, I_S5_B_GLU, I_PE_K, I_PE_V, I_CK_W1, I_CK_B1, I_CK_W2, I_CV_W1, I_CV_B1, I_CV_W2,
       I_CD_W_IN, I_CD_W_OUT, I_RW_MU, I_RW_W0, I_RW_W_UP, I_RW_A0, I_RW_A_UP, I_RW_G_UP, I_RW_K_K, I_RW_K_A, I_RW_R_K,
       I_RW_LN_G, I_RW_LN_B, I_RET_LN_G, I_RET_LN_B, I_LN1_G, I_LN1_B, I_LN2_G, I_LN2_B, I_ROUTER, I_MOE_BIAS,
       I_MOE_W1, I_MOE_W3, I_MOE_W2, I_SH_W1, I_SH_W3, I_SH_W2, N_INPUTS };

struct Params {
  const float* in[N_INPUTS];
  float* out;
  char* ws;
};

#define MiB_TOK ((size_t)NTOK * 1024 * 4)
#define OFF_H 0
#define OFF_MIX ((size_t)NTOK * 3328 * 4)
#define OFF_X1 (OFF_MIX + MiB_TOK)
#define OFF_X2 (OFF_X1 + MiB_TOK)
#define OFF_R4 (OFF_X2 + MiB_TOK)
#define OFF_R5 (OFF_R4 + MiB_TOK)
#define OFF_Y OFF_H
#define OFF_HS (OFF_H + 4 * MiB_TOK)
#define OFF_FS OFF_X2
#define OFF_HR OFF_R4
#define OFF_TOPI (OFF_R5)
#define OFF_TOPG (OFF_TOPI + (size_t)NTOK * 8 * 4)
#define OFF_POSOF (OFF_TOPG + (size_t)NTOK * 8 * 4)
#define OFF_CNT (OFF_POSOF + (size_t)NTOK * 8 * 4)
#define OFF_LTOK (OFF_CNT + 1024)
#define OFF_LGATE (OFF_LTOK + (size_t)64 * NTOK * 4)
#define OFF_S5E (OFF_LGATE + (size_t)64 * NTOK * 4)
#define OFF_KCMP (OFF_S5E + (size_t)BATCH * S5_NC * 32 * 64 * 8)
#define OFF_VCMP (OFF_KCMP + (size_t)BATCH * NCMP * 2 * 64 * 4)
#define OFF_RETKV (OFF_VCMP + (size_t)BATCH * NCMP * 2 * 64 * 4)
#define OFF_BAR (OFF_RETKV + (size_t)BATCH * 4 * RET_NC * 64 * 128 * 4)
#define OFF_END (OFF_BAR + 4096)
#define OFF_YGELU OFF_X1
#define OFF_RWW OFF_X1
#define OFF_RWK (OFF_X1 + (size_t)NTOK * 512 * 4)
#define OFF_RWKK OFF_R4
#define OFF_RWA (OFF_R4 + (size_t)NTOK * 512 * 4)

typedef short bf16x8 __attribute__((ext_vector_type(8)));
typedef float f32x16 __attribute__((ext_vector_type(16)));

#ifdef CPU_EMU
#define WAVE_SYNC() emu_wave_bar()
#else
#define WAVE_SYNC() __builtin_amdgcn_wave_barrier()
#endif

DEV float sigmoidf_(float x) { return 1.f / (1.f + __expf(-x)); }
DEV float siluf_(float x) { return x * sigmoidf_(x); }
DEV float geluf_(float x) { float u = 0.7978845608028654f * (x + 0.044715f * x * x * x); return 0.5f * x * (1.f + tanhf(u)); }
DEV unsigned short f2bf(float f) {
  unsigned u = __builtin_bit_cast(unsigned, f);
  u += 0x7FFFu + ((u >> 16) & 1u);
  return (unsigned short)(u >> 16);
}
DEV float bf2f(unsigned short h) { return __builtin_bit_cast(float, ((unsigned)h) << 16); }
DEV float wave_sum(float v) {
#pragma unroll
  for (int m = 32; m >= 1; m >>= 1) v += __shfl_xor(v, m);
  return v;
}
DEV float wave_max(float v) {
#pragma unroll
  for (int m = 32; m >= 1; m >>= 1) v = fmaxf(v, __shfl_xor(v, m));
  return v;
}
DEV float4 ld4(const float* p) { return *(const float4*)p; }
DEV void st4(float* p, float4 v) { *(float4*)p = v; }

#define GEMM_SMEM_BYTES (2 * 128 * 40 * 2)
template <bool ABF, class AROW, class BPTR, class EPI>
DEV void gemm_tile(AROW arow, BPTR bptr, int ldb, int K, EPI epi, char* smem_raw) {
  unsigned short(*sA)[40] = (unsigned short(*)[40])smem_raw;
  unsigned short(*sB)[40] = (unsigned short(*)[40])(smem_raw + 128 * 40 * 2);
  const int tid = threadIdx.x, lane = tid & 63, wave = tid >> 6;
  const int wm = wave >> 1, wn = wave & 1;
#if defined(CPU_EMU) && !defined(EMU_REAL_GEMM)
  for (int mi = 0; mi < 2; ++mi)
    for (int r = 0; r < 16; ++r) {
      const int row = wm * 64 + mi * 32 + (r & 3) + 8 * (r >> 2) + 4 * (lane >> 5);
      const int col = wn * 64 + (lane & 31);
      const void* arp = arow(row);
      float v[2] = {0.f, 0.f};
      for (int ni = 0; ni < 2; ++ni) {
        const float* bq = bptr(col + ni * 32);
        if (!arp || !bq) continue;
        float a = 0.f;
        for (int k = 0; k < K; ++k) {
          const float av = ABF ? bf2f(((const unsigned short*)arp)[k]) : bf2f(f2bf(((const float*)arp)[k]));
          a += av * bf2f(f2bf(bq[(size_t)k * ldb]));
        }
        v[ni] = a;
      }
      epi(row, col, v[0], v[1]);
    }
  return;
#endif
  const float* ap[4];
  const unsigned short* aph[2];
  if (ABF) {
#pragma unroll
    for (int i = 0; i < 2; ++i) aph[i] = (const unsigned short*)arow((tid >> 2) + 64 * i);
  } else {
#pragma unroll
    for (int i = 0; i < 4; ++i) ap[i] = (const float*)arow((tid >> 3) + 32 * i);
  }
  const float* bp = bptr(tid & 127);
  const int bkg = tid >> 7;
  float4 ra[4];
  uint4 rah[2];
  float rb[2][8];
  auto gload = [&](int k0) {
    if (ABF) {
#pragma unroll
      for (int i = 0; i < 2; ++i) rah[i] = aph[i] ? *(const uint4*)(aph[i] + k0 + (tid & 3) * 8) : make_uint4(0, 0, 0, 0);
    } else {
#pragma unroll
      for (int i = 0; i < 4; ++i) ra[i] = ap[i] ? ld4(ap[i] + k0 + (tid & 7) * 4) : make_float4(0.f, 0.f, 0.f, 0.f);
    }
#pragma unroll
    for (int i = 0; i < 2; ++i)
#pragma unroll
      for (int j = 0; j < 8; ++j) rb[i][j] = bp ? bp[(size_t)(k0 + (bkg + 2 * i) * 8 + j) * ldb] : 0.f;
  };
  auto sstore = [&]() {
    if (ABF) {
#pragma unroll
      for (int i = 0; i < 2; ++i) *(uint4*)&sA[(tid >> 2) + 64 * i][(tid & 3) * 8] = rah[i];
    } else {
#pragma unroll
      for (int i = 0; i < 4; ++i) {
        uint2 v;
        v.x = (unsigned)f2bf(ra[i].x) | ((unsigned)f2bf(ra[i].y) << 16);
        v.y = (unsigned)f2bf(ra[i].z) | ((unsigned)f2bf(ra[i].w) << 16);
        *(uint2*)&sA[(tid >> 3) + 32 * i][(tid & 7) * 4] = v;
      }
    }
#pragma unroll
    for (int i = 0; i < 2; ++i) {
      uint4 v;
      v.x = (unsigned)f2bf(rb[i][0]) | ((unsigned)f2bf(rb[i][1]) << 16);
      v.y = (unsigned)f2bf(rb[i][2]) | ((unsigned)f2bf(rb[i][3]) << 16);
      v.z = (unsigned)f2bf(rb[i][4]) | ((unsigned)f2bf(rb[i][5]) << 16);
      v.w = (unsigned)f2bf(rb[i][6]) | ((unsigned)f2bf(rb[i][7]) << 16);
      *(uint4*)&sB[tid & 127][(bkg + 2 * i) * 8] = v;
    }
  };
  f32x16 acc[2][2];
#pragma unroll
  for (int mi = 0; mi < 2; ++mi)
#pragma unroll
    for (int ni = 0; ni < 2; ++ni)
#pragma unroll
      for (int r = 0; r < 16; ++r) acc[mi][ni][r] = 0.f;
  gload(0);
  for (int k0 = 0; k0 < K; k0 += 32) {
    __syncthreads();
    sstore();
    __syncthreads();
    if (k0 + 32 < K) gload(k0 + 32);
#pragma unroll
    for (int ks = 0; ks < 2; ++ks) {
      bf16x8 af[2], bfr[2];
#pragma unroll
      for (int mi = 0; mi < 2; ++mi) af[mi] = *(const bf16x8*)&sA[wm * 64 + mi * 32 + (lane & 31)][ks * 16 + (lane >> 5) * 8];
#pragma unroll
      for (int ni = 0; ni < 2; ++ni) bfr[ni] = *(const bf16x8*)&sB[wn * 64 + ni * 32 + (lane & 31)][ks * 16 + (lane >> 5) * 8];
#pragma unroll
      for (int mi = 0; mi < 2; ++mi)
#pragma unroll
        for (int ni = 0; ni < 2; ++ni) acc[mi][ni] = __builtin_amdgcn_mfma_f32_32x32x16_bf16(af[mi], bfr[ni], acc[mi][ni], 0, 0, 0);
    }
  }
#pragma unroll
  for (int mi = 0; mi < 2; ++mi)
#pragma unroll
    for (int r = 0; r < 16; ++r) {
      int row = wm * 64 + mi * 32 + (r & 3) + 8 * (r >> 2) + 4 * (lane >> 5);
      int col = wn * 64 + (lane & 31);
      epi(row, col, acc[mi][0][r], acc[mi][1][r]);
    }
}

template <int LAYER>
DEV void phase_gemm_in(const Params& p, char* smem) {
  const int N = LAYER == 0 ? AB_IN : CD_IN;
  const float* A = LAYER == 0 ? p.in[I_X] : (const float*)(p.ws + OFF_X2);
  const float* B = LAYER == 0 ? p.in[I_AB_W_IN] : p.in[I_CD_W_IN];
  float* C = (float*)(p.ws + OFF_H);
  const int NT = (N + 127) / 128, MT = NTOK / 128;
  for (int it = blockIdx.x; it < MT * NT; it += gridDim.x) {
    const int tm = it / NT, tn = it % NT;
    const int m0 = tm * 128, n0 = tn * 128;
    gemm_tile<false>(
        [&](int r) { return (const void*)(A + (size_t)(m0 + r) * DM); },
        [&](int c) { return (n0 + c < N) ? (B + n0 + c) : (const float*)nullptr; }, N, DM,
        [&](int row, int col, float v0, float v1) {
          const int gm = m0 + row, gc = n0 + col;
          if (LAYER == 1 && gc >= 1792 && gc < 2304) {
            const int i = gc & 63;
            const float pos = (float)(gm % SEQ_LEN);
            const float inv = __expf(-(float)i * (9.210340371976184f / 32.f));
            float sn, cs;
            sincosf(pos * inv, &sn, &cs);
            float o0 = v0 * cs - v1 * sn, o1 = v1 * cs + v0 * sn;
            if (gc >= 2048) { o0 *= 0.125f; o1 *= 0.125f; }
            v0 = o0; v1 = o1;
          }
          if (gc < N) C[(size_t)gm * N + gc] = v0;
          if (gc + 32 < N) C[(size_t)gm * N + gc + 32] = v1;
        },
        smem);
  }
}

struct S5Const { float lb_re, lb_im; };
DEV void s5_consts(const Params& p, int g, int pp, float& lb_re, float& lb_im, float (&bbr)[16], float (&bbi)[16]) {
  const float dt = expf(p.in[I_S5_LOG_DT][g]);
  const float lr = p.in[I_S5_LAM_RE][g * 64 + pp], li = p.in[I_S5_LAM_IM][g * 64 + pp];
  const float mag = expf(lr * dt);
  float sn, cs;
  sincosf(li * dt, &sn, &cs);
  lb_re = mag * cs; lb_im = mag * sn;
  const float den = lr * lr + li * li;
  const float f_re = ((lb_re - 1.f) * lr + lb_im * li) / den;
  const float f_im = (lb_im * lr - (lb_re - 1.f) * li) / den;
  const float* br = p.in[I_S5_B_RE] + (size_t)(g * 64 + pp) * 16;
  const float* bi = p.in[I_S5_B_IM] + (size_t)(g * 64 + pp) * 16;
#pragma unroll
  for (int h = 0; h < 16; ++h) {
    bbr[h] = f_re * br[h] - f_im * bi[h];
    bbi[h] = f_re * bi[h] + f_im * br[h];
  }
}

#define OFF_QB OFF_X2
#define OFF_KSB (OFF_QB + (size_t)NTOK * 512 * 2)
#define OFF_KWB (OFF_KSB + (size_t)NTOK * 128 * 2)
#define OFF_VST (OFF_KWB + (size_t)NTOK * 128 * 2)
#define OFF_VWT (OFF_VST + (size_t)NTOK * 128 * 2)
#define OFF_KCB (OFF_VWT + (size_t)NTOK * 128 * 2)
#define OFF_VCT (OFF_KCB + (size_t)BATCH * 2 * NB_CMP * 64 * 64 * 2)
#define NSA_QSCALE (0.125f * 1.4426950408889634f)

#define P1_S5A_ITEMS (BATCH * 32 * S5_NC / 4)
#define P1_CMP_TILES ((NCMP + 7) / 8)
#define P1_CMP_ITEMS (2 * BATCH * 2 * P1_CMP_TILES)
DEV void p1_s5a(const Params& p, int item) {
  const int lane = threadIdx.x & 63, wave = threadIdx.x >> 6;
  const int idx = item * 4 + wave;
  const int g = idx & 31, c = (idx >> 5) % S5_NC, b = idx / (32 * S5_NC);
  float lb_re, lb_im, bbr[16], bbi[16];
  s5_consts(p, g, lane, lb_re, lb_im, bbr, bbi);
  const float* H = (const float*)(p.ws + OFF_H);
  float sr = 0.f, si = 0.f;
  for (int tt = 0; tt < 64; ++tt) {
    const float* u = H + (size_t)(b * SEQ_LEN + c * 64 + tt) * AB_IN + g * 16;
    float dr = 0.f, di = 0.f;
#pragma unroll
    for (int h4 = 0; h4 < 4; ++h4) {
      const float4 uv = ld4(u + h4 * 4);
      dr += uv.x * bbr[h4 * 4] + uv.y * bbr[h4 * 4 + 1] + uv.z * bbr[h4 * 4 + 2] + uv.w * bbr[h4 * 4 + 3];
      di += uv.x * bbi[h4 * 4] + uv.y * bbi[h4 * 4 + 1] + uv.z * bbi[h4 * 4 + 2] + uv.w * bbi[h4 * 4 + 3];
    }
    const float nr = lb_re * sr - lb_im * si + dr;
    const float ni = lb_re * si + lb_im * sr + di;
    sr = nr; si = ni;
  }
  float2* E = (float2*)(p.ws + OFF_S5E);
  E[((size_t)(b * S5_NC + c) * 32 + g) * 64 + lane] = make_float2(sr, si);
}
DEV void p1_compress(const Params& p, int item, char* smem) {
  const int tile = item % P1_CMP_TILES;
  int r = item / P1_CMP_TILES;
  const int g = r & 1; r >>= 1;
  const int b = r % BATCH; const int which = r / BATCH;
  const int n0 = tile * 8;
  const float* H = (const float*)(p.ws + OFF_H);
  const float* pe = which ? p.in[I_PE_V] : p.in[I_PE_K];
  const float* w1 = which ? p.in[I_CV_W1] : p.in[I_CK_W1];
  const float* b1 = which ? p.in[I_CV_B1] : p.in[I_CK_B1];
  const float* w2 = which ? p.in[I_CV_W2] : p.in[I_CK_W2];
  const int colbase = (which ? 1152 : 1024) + g * 64;
  float* sTok = (float*)smem;
  float* sPart = sTok + 144 * 64;
  float* sHid = sPart + 2 * 8 * 128;
  const int tid = threadIdx.x;
  __syncthreads();
  for (int w = tid; w < 144 * 16; w += NTHREADS) {
    const int tr = w >> 4, c4 = (w & 15) * 4;
    int tok = n0 * 16 + tr; if (tok > SEQ_LEN - 1) tok = SEQ_LEN - 1;
    st4(sTok + tr * 64 + c4, ld4(H + (size_t)(b * SEQ_LEN + tok) * AB_IN + colbase + c4));
  }
  __syncthreads();
  {
    const int hid = tid & 127, kh = tid >> 7;
    float acc[8];
#pragma unroll
    for (int rr = 0; rr < 8; ++rr) acc[rr] = 0.f;
    for (int k = kh * 1024; k < kh * 1024 + 1024; ++k) {
      const float w = w1[(size_t)k * 128 + hid];
      const int j = k >> 6, d = k & 63;
      const float pv = pe[j * 64 + d];
#pragma unroll
      for (int rr = 0; rr < 8; ++rr) acc[rr] += (sTok[(rr * 16 + j) * 64 + d] + pv) * w;
    }
#pragma unroll
    for (int rr = 0; rr < 8; ++rr) sPart[(kh * 8 + rr) * 128 + hid] = acc[rr];
  }
  __syncthreads();
  for (int w = tid; w < 8 * 128; w += NTHREADS) {
    const int rr = w >> 7, hid = w & 127;
    sHid[w] = geluf_(sPart[rr * 128 + hid] + sPart[(8 + rr) * 128 + hid] + b1[hid]);
  }
  __syncthreads();
  float* sOut = sPart;
  for (int w = tid; w < 8 * 64; w += NTHREADS) {
    const int rr = w >> 6, d = w & 63;
    float a = 0.f;
    for (int hid = 0; hid < 128; ++hid) a += sHid[rr * 128 + hid] * w2[hid * 64 + d];
    sOut[w] = a;
  }
  __syncthreads();
  float* dst = (float*)(p.ws + (which ? OFF_VCMP : OFF_KCMP));
  for (int w = tid; w < 8 * 64; w += NTHREADS) {
    const int rr = w >> 6, d = w & 63;
    const int n = n0 + rr;
    if (n >= NCMP) continue;
    float v = sOut[w];
    if (which == 0 && d < 16) {
      const int i = d & 7;
      const float pos = (float)(n * 16 + 31);
      const float inv = __expf(-(float)i * (13.122363377404328f / 8.f));
      float sn, cs;
      sincosf(pos * inv, &sn, &cs);
      const float x1 = sOut[rr * 64 + i], x2 = sOut[rr * 64 + i + 8];
      v = d < 8 ? x1 * cs - x2 * sn : x2 * cs + x1 * sn;
    }
    dst[((size_t)(b * NCMP + n) * 2 + g) * 64 + d] = v;
    if (which == 0) ((unsigned short*)(p.ws + OFF_KCB))[(((size_t)b * 2 + g) * NB_CMP * 64 + n) * 64 + d] = f2bf(v);
    else ((unsigned short*)(p.ws + OFF_VCT))[((((size_t)b * 2 + g) * NB_CMP + (n >> 6)) * 64 + d) * 64 + (n & 63)] = f2bf(v);
  }
  for (int w = tid; w < 8 * 64; w += NTHREADS) {
    const int rr = w >> 6, d = w & 63;
    const int n = n0 + rr;
    if (n < NCMP || n >= NB_CMP * 64) continue;
    if (which == 0) ((unsigned short*)(p.ws + OFF_KCB))[(((size_t)b * 2 + g) * NB_CMP * 64 + n) * 64 + d] = 0;
    else ((unsigned short*)(p.ws + OFF_VCT))[((((size_t)b * 2 + g) * NB_CMP + (n >> 6)) * 64 + d) * 64 + (n & 63)] = 0;
  }
}
DEV uint4 pack8(const float* v) {
  uint4 r;
  r.x = (unsigned)f2bf(v[0]) | ((unsigned)f2bf(v[1]) << 16);
  r.y = (unsigned)f2bf(v[2]) | ((unsigned)f2bf(v[3]) << 16);
  r.z = (unsigned)f2bf(v[4]) | ((unsigned)f2bf(v[5]) << 16);
  r.w = (unsigned)f2bf(v[6]) | ((unsigned)f2bf(v[7]) << 16);
  return r;
}
#define P1_PREP_ITEMS (NTOK / 64)
#define P1_PREP_SMEM ((64 * 8 * 2 + 64 * 128) * 4)
DEV void p1_prep(const Params& p, int item, char* smem) {
  const int tid = threadIdx.x;
  const int b = item / NBLK, blk = item % NBLK;
  const float* H = (const float*)(p.ws + OFF_H);
  float* sCS = (float*)smem;
  float* sV = sCS + 64 * 8 * 2;
  const size_t tok0 = (size_t)b * SEQ_LEN + blk * 64;
  __syncthreads();
  for (int w = tid; w < 64 * 8; w += NTHREADS) {
    const int tk = w >> 3, i = w & 7;
    const float pos = (float)(blk * 64 + tk);
    const float inv = __expf(-(float)i * (13.122363377404328f / 8.f));
    float sn, cs;
    sincosf(pos * inv, &sn, &cs);
    sCS[w * 2] = cs; sCS[w * 2 + 1] = sn;
  }
  __syncthreads();
  unsigned short* QB = (unsigned short*)(p.ws + OFF_QB);
  unsigned short* KSB = (unsigned short*)(p.ws + OFF_KSB);
  unsigned short* KWB = (unsigned short*)(p.ws + OFF_KWB);
  for (int w = tid; w < 64 * 12 * 8; w += NTHREADS) {
    const int o = w & 7, hd = (w >> 3) % 12, tk = w / 96;
    const int col = hd < 8 ? 512 + hd * 64 : (hd < 10 ? 1280 + (hd - 8) * 64 : 1536 + (hd - 10) * 64);
    const float* x = H + (tok0 + tk) * AB_IN + col;
    float v[8];
    const float4 a0 = ld4(x + o * 8), a1 = ld4(x + o * 8 + 4);
    v[0] = a0.x; v[1] = a0.y; v[2] = a0.z; v[3] = a0.w; v[4] = a1.x; v[5] = a1.y; v[6] = a1.z; v[7] = a1.w;
    if (o < 2) {
      const float4 c0 = ld4(x + (1 - o) * 8), c1 = ld4(x + (1 - o) * 8 + 4);
      const float u[8] = {c0.x, c0.y, c0.z, c0.w, c1.x, c1.y, c1.z, c1.w};
#pragma unroll
      for (int i = 0; i < 8; ++i) {
        const float cs = sCS[(tk * 8 + i) * 2], sn = sCS[(tk * 8 + i) * 2 + 1];
        v[i] = o == 0 ? v[i] * cs - u[i] * sn : v[i] * cs + u[i] * sn;
      }
    }
    if (hd < 8) {
#pragma unroll
      for (int i = 0; i < 8; ++i) v[i] *= NSA_QSCALE;
      *(uint4*)(QB + ((tok0 + tk) * 8 + hd) * 64 + o * 8) = pack8(v);
    } else {
      const int g = (hd - 8) & 1;
      unsigned short* dst = (hd < 10 ? KSB : KWB) + (((size_t)b * 2 + g) * SEQ_LEN + blk * 64 + tk) * 64 + o * 8;
      *(uint4*)dst = pack8(v);
    }
  }
#pragma unroll 1
  for (int which = 0; which < 2; ++which) {
    const int col = which ? 1664 : 1408;
    __syncthreads();
    for (int w = tid; w < 64 * 32; w += NTHREADS) {
      const int tk = w >> 5, c4 = (w & 31) * 4;
      st4(sV + tk * 128 + c4, ld4(H + (tok0 + tk) * AB_IN + col + c4));
    }
    __syncthreads();
    unsigned short* VT = (unsigned short*)(p.ws + (which ? OFF_VWT : OFF_VST));
    for (int w = tid; w < 2 * 64 * 8; w += NTHREADS) {
      const int ko = w & 7, d = (w >> 3) & 63, g = w >> 9;
      float v[8];
#pragma unroll
      for (int i = 0; i < 8; ++i) v[i] = sV[(ko * 8 + i) * 128 + g * 64 + d];
      *(uint4*)(VT + ((((size_t)b * 2 + g) * NBLK + blk) * 64 + d) * 64 + ko * 8) = pack8(v);
    }
  }
}

struct NsaSmem {
  unsigned short k[64][72];
  unsigned short vt[64][68];
  float imp[32][128];
  unsigned selmask[32][4];
  unsigned unionm[4];
  float keyb[4][128];
};
#define P2_NSA_SMEM ((int)sizeof(NsaSmem))
#define NSA_QT (SEQ_LEN / 32)
#define P2_NSA_ITEMS (BATCH * 2 * NSA_QT)

struct TileRegs { uint4 k0, k1, v0, v1; };
DEV void tile_gload(TileRegs& r, const unsigned short* Kg, const unsigned short* Vg, int tid) {
  const int row = tid >> 2, seg = tid & 3;
  r.k0 = *(const uint4*)(Kg + row * 64 + seg * 16);
  r.k1 = *(const uint4*)(Kg + row * 64 + seg * 16 + 8);
  if (Vg) {
    r.v0 = *(const uint4*)(Vg + row * 64 + seg * 16);
    r.v1 = *(const uint4*)(Vg + row * 64 + seg * 16 + 8);
  }
}
DEV void tile_sstore(NsaSmem* sm, const TileRegs& r, bool withV, int tid) {
  const int row = tid >> 2, seg = tid & 3;
  *(uint4*)&sm->k[row][seg * 16] = r.k0;
  *(uint4*)&sm->k[row][seg * 16 + 8] = r.k1;
  if (withV) {
    *(uint2*)&sm->vt[row][seg * 16] = make_uint2(r.v0.x, r.v0.y);
    *(uint2*)&sm->vt[row][seg * 16 + 4] = make_uint2(r.v0.z, r.v0.w);
    *(uint2*)&sm->vt[row][seg * 16 + 8] = make_uint2(r.v1.x, r.v1.y);
    *(uint2*)&sm->vt[row][seg * 16 + 12] = make_uint2(r.v1.z, r.v1.w);
  }
}
DEV void qk_tile(const NsaSmem* sm, const bf16x8 (&qf)[4], f32x16 (&s)[2], int lane) {
  const int r = lane & 31, hh = lane >> 5;
#pragma unroll
  for (int ks2 = 0; ks2 < 2; ++ks2) {
#pragma unroll
    for (int i = 0; i < 16; ++i) s[ks2][i] = 0.f;
#pragma unroll
    for (int ks = 0; ks < 4; ++ks) {
      const bf16x8 a = *(const bf16x8*)&sm->k[ks2 * 32 + r][ks * 16 + hh * 8];
      s[ks2] = __builtin_amdgcn_mfma_f32_32x32x16_bf16(a, qf[ks], s[ks2], 0, 0, 0);
    }
  }
}
DEV void pv_tile(const NsaSmem* sm, const f32x16 (&pr)[2], f32x16 (&o)[2], int lane) {
  const int r = lane & 31, hh = lane >> 5;
#pragma unroll
  for (int ks2 = 0; ks2 < 2; ++ks2)
#pragma unroll
    for (int s = 0; s < 2; ++s) {
      bf16x8 pf;
#pragma unroll
      for (int j = 0; j < 8; ++j) pf[j] = (short)f2bf(pr[ks2][8 * s + j]);
#pragma unroll
      for (int mt = 0; mt < 2; ++mt) {
        const uint2 lo = *(const uint2*)&sm->vt[mt * 32 + r][ks2 * 32 + 16 * s + 4 * hh];
        const uint2 hi = *(const uint2*)&sm->vt[mt * 32 + r][ks2 * 32 + 16 * s + 8 + 4 * hh];
        bf16x8 a;
        a[0] = (short)(lo.x & 0xFFFF); a[1] = (short)(lo.x >> 16); a[2] = (short)(lo.y & 0xFFFF); a[3] = (short)(lo.y >> 16);
        a[4] = (short)(hi.x & 0xFFFF); a[5] = (short)(hi.x >> 16); a[6] = (short)(hi.y & 0xFFFF); a[7] = (short)(hi.y >> 16);
        o[mt] = __builtin_amdgcn_mfma_f32_32x32x16_bf16(a, pf, o[mt], 0, 0, 0);
      }
    }
}
DEV float quad_sum(float v) {
#ifdef CPU_EMU
  v += __shfl_xor(v, 1); v += __shfl_xor(v, 2); return v;
#else
  int x;
  x = __builtin_amdgcn_update_dpp(0, __builtin_bit_cast(int, v), 0xB1, 0xF, 0xF, false); v += __builtin_bit_cast(float, x);
  x = __builtin_amdgcn_update_dpp(0, __builtin_bit_cast(int, v), 0x4E, 0xF, 0xF, false); v += __builtin_bit_cast(float, x);
  return v;
#endif
}
DEV void softmax_step(f32x16 (&s)[2], float& m, float& l, f32x16 (&o)[2]) {
  float tmax = -INFINITY;
#pragma unroll
  for (int ks2 = 0; ks2 < 2; ++ks2)
#pragma unroll
    for (int i = 0; i < 16; ++i) tmax = fmaxf(tmax, s[ks2][i]);
  tmax = fmaxf(tmax, __shfl_xor(tmax, 32));
  const float mnew = fmaxf(m, tmax);
  const float msafe = mnew == -INFINITY ? 0.f : mnew;
  const float alpha = exp2f(m - msafe);
  float ps = 0.f;
#pragma unroll
  for (int ks2 = 0; ks2 < 2; ++ks2)
#pragma unroll
    for (int i = 0; i < 16; ++i) { s[ks2][i] = exp2f(s[ks2][i] - msafe); ps += s[ks2][i]; }
  l = l * alpha + ps;
#pragma unroll
  for (int mt = 0; mt < 2; ++mt)
#pragma unroll
    for (int i = 0; i < 16; ++i) o[mt][i] *= alpha;
  m = mnew;
}
DEV bool testbit4(unsigned w0, unsigned w1, unsigned w2, unsigned w3, int j) {
  const unsigned lo = j & 32 ? w1 : w0, hi = j & 32 ? w3 : w2;
  const unsigned x = j & 64 ? hi : lo;
  return (x >> (j & 31)) & 1u;
}

DEV void p2_nsa(const Params& p, int item, char* smem) {
  NsaSmem* sm = (NsaSmem*)smem;
  const int tid = threadIdx.x, lane = tid & 63, wave = tid >> 6;
  const int bg = item & 3, b = bg >> 1, g = bg & 1;
  const int qt = NSA_QT - 1 - (item >> 2);
  const int t0 = qt * 32;
  const int c = lane & 31, hh = lane >> 5, tl = c >> 2, h = c & 3;
  const int trow = wave * 8 + tl;
  const int tq = t0 + trow;
  const size_t tok = (size_t)b * SEQ_LEN + tq;
  const int hd = g * 4 + h;
  const float* H = (const float*)(p.ws + OFF_H);
  const unsigned short* QB = (const unsigned short*)(p.ws + OFF_QB);
  const unsigned short* KSB = (const unsigned short*)(p.ws + OFF_KSB) + ((size_t)b * 2 + g) * SEQ_LEN * 64;
  const unsigned short* KWB = (const unsigned short*)(p.ws + OFF_KWB) + ((size_t)b * 2 + g) * SEQ_LEN * 64;
  const unsigned short* VST = (const unsigned short*)(p.ws + OFF_VST) + ((size_t)b * 2 + g) * NBLK * 4096;
  const unsigned short* VWT = (const unsigned short*)(p.ws + OFF_VWT) + ((size_t)b * 2 + g) * NBLK * 4096;
  const unsigned short* KCB = (const unsigned short*)(p.ws + OFF_KCB) + ((size_t)b * 2 + g) * NB_CMP * 4096;
  const unsigned short* VCT = (const unsigned short*)(p.ws + OFF_VCT) + ((size_t)b * 2 + g) * NB_CMP * 4096;
  bf16x8 qf[4];
  {
    const unsigned short* qrow = QB + (tok * 8 + hd) * 64;
#pragma unroll
    for (int ks = 0; ks < 4; ++ks) qf[ks] = *(const bf16x8*)(qrow + ks * 16 + hh * 8);
  }
  const float g0 = sigmoidf_(H[tok * AB_IN + 1792 + hd * 3 + 0]);
  const float g1 = sigmoidf_(H[tok * AB_IN + 1792 + hd * 3 + 1]);
  const float g2 = sigmoidf_(H[tok * AB_IN + 1792 + hd * 3 + 2]);
  f32x16 oacc[2], o[2], s[2];
#pragma unroll
  for (int mt = 0; mt < 2; ++mt)
#pragma unroll
    for (int i = 0; i < 16; ++i) { oacc[mt][i] = 0.f; o[mt][i] = 0.f; }
  __syncthreads();
  for (int w = tid; w < 32 * 128; w += NTHREADS) (&sm->imp[0][0])[w] = 0.f;
  TileRegs tr;
  tr.k0 = tr.k1 = tr.v0 = tr.v1 = make_uint4(0, 0, 0, 0);
  const int nval = tq >= 31 ? (tq - 31) / 16 + 1 : 0;
  const int nvmax = (t0 + 31 - 31) / 16 + 1;
  const int ktn = (nvmax + 63) / 64;
  float m = -INFINITY, l = 0.f;
  tile_gload(tr, KCB, nullptr, tid);
  for (int kt = 0; kt < ktn; ++kt) {
    __syncthreads();
    tile_sstore(sm, tr, false, tid);
    __syncthreads();
    if (kt + 1 < ktn) tile_gload(tr, KCB + (size_t)(kt + 1) * 4096, nullptr, tid);
    qk_tile(sm, qf, s, lane);
    float tmax = -INFINITY;
#pragma unroll
    for (int ks2 = 0; ks2 < 2; ++ks2)
#pragma unroll
      for (int i = 0; i < 16; ++i) {
        const int n = kt * 64 + ks2 * 32 + (i & 3) + 8 * (i >> 2) + 4 * hh;
        s[ks2][i] = n < nval ? s[ks2][i] : -INFINITY;
        tmax = fmaxf(tmax, s[ks2][i]);
      }
    tmax = fmaxf(tmax, __shfl_xor(tmax, 32));
    const float mnew = fmaxf(m, tmax);
    const float msafe = mnew == -INFINITY ? 0.f : mnew;
    float ps = 0.f;
#pragma unroll
    for (int ks2 = 0; ks2 < 2; ++ks2)
#pragma unroll
      for (int i = 0; i < 16; ++i) ps += exp2f(s[ks2][i] - msafe);
    l = l * exp2f(m - msafe) + ps;
    m = mnew;
  }
  {
    const float ltot = l + __shfl_xor(l, 32);
    const float invl = ltot > 0.f ? 1.f / ltot : 0.f;
    const float msafe = m == -INFINITY ? 0.f : m;
    tile_gload(tr, KCB, VCT, tid);
    for (int kt = 0; kt < ktn; ++kt) {
      __syncthreads();
      tile_sstore(sm, tr, true, tid);
      __syncthreads();
      if (kt + 1 < ktn) tile_gload(tr, KCB + (size_t)(kt + 1) * 4096, VCT + (size_t)(kt + 1) * 4096, tid);
      qk_tile(sm, qf, s, lane);
#pragma unroll
      for (int ks2 = 0; ks2 < 2; ++ks2)
#pragma unroll
        for (int i = 0; i < 16; ++i) {
          const int n = kt * 64 + ks2 * 32 + (i & 3) + 8 * (i >> 2) + 4 * hh;
          s[ks2][i] = n < nval ? exp2f(s[ks2][i] - msafe) * invl : 0.f;
        }
#pragma unroll
      for (int ks2 = 0; ks2 < 2; ++ks2)
#pragma unroll
        for (int g4 = 0; g4 < 4; ++g4) {
          float A = 2.f * (s[ks2][4 * g4] + s[ks2][4 * g4 + 1] + s[ks2][4 * g4 + 2]) + s[ks2][4 * g4 + 3];
          float Bv = s[ks2][4 * g4 + 3];
          A = quad_sum(A); Bv = quad_sum(Bv);
          const int j = kt * 16 + ks2 * 8 + 2 * g4 + hh;
          if (h == 0 && j < NBLK) sm->imp[trow][j] += A;
          WAVE_SYNC();
          if (h == 0 && j + 1 < NBLK) sm->imp[trow][j + 1] += Bv;
          WAVE_SYNC();
        }
      pv_tile(sm, s, o, lane);
    }
#pragma unroll
    for (int mt = 0; mt < 2; ++mt)
#pragma unroll
      for (int i = 0; i < 16; ++i) { oacc[mt][i] = o[mt][i] * g0; o[mt][i] = 0.f; }
  }
  WAVE_SYNC();
  for (int t8 = 0; t8 < 8; ++t8) {
    const int row = wave * 8 + t8, tt = t0 + row, cur = tt >> 6;
    float kv[2]; bool valid[2];
#pragma unroll
    for (int c2 = 0; c2 < 2; ++c2) {
      const int j = lane + 64 * c2;
      valid[c2] = j < NBLK && j <= cur;
      const bool forced = (j == 0) | (j == cur) | (j == cur - 1);
      kv[c2] = valid[c2] ? (forced ? 1e6f : sm->imp[row][j < NBLK ? j : 0]) : -1.f;
      sm->keyb[wave][j] = kv[c2];
    }
    WAVE_SYNC();
    int rank0 = 0, rank1 = 0;
    const int jlim = cur < NBLK - 1 ? cur : NBLK - 1;
    for (int jj = 0; jj <= jlim; ++jj) {
      const float ov = sm->keyb[wave][jj];
      rank0 += (ov > kv[0] || (ov == kv[0] && jj < lane)) ? 1 : 0;
      rank1 += (ov > kv[1] || (ov == kv[1] && jj < lane + 64)) ? 1 : 0;
    }
    const unsigned long long m0 = __ballot(valid[0] && rank0 < 16);
    const unsigned long long m1 = __ballot(valid[1] && rank1 < 16);
    if (lane == 0) {
      sm->selmask[row][0] = (unsigned)m0; sm->selmask[row][1] = (unsigned)(m0 >> 32);
      sm->selmask[row][2] = (unsigned)m1; sm->selmask[row][3] = (unsigned)(m1 >> 32);
    }
    WAVE_SYNC();
  }
  __syncthreads();
  if (tid < 4) {
    unsigned u = 0;
    for (int r = 0; r < 32; ++r) u |= sm->selmask[r][tid];
    sm->unionm[tid] = u;
  }
  __syncthreads();
  const unsigned um0 = sm->unionm[0], um1 = sm->unionm[1], um2 = sm->unionm[2], um3 = sm->unionm[3];
  const unsigned my0 = sm->selmask[trow][0], my1 = sm->selmask[trow][1], my2 = sm->selmask[trow][2], my3 = sm->selmask[trow][3];
  {
    const int jmax = (t0 + 31) >> 6;
    int j = 0;
    while (j <= jmax && !testbit4(um0, um1, um2, um3, j)) ++j;
    m = -INFINITY; l = 0.f;
    if (j <= jmax) tile_gload(tr, KSB + (size_t)j * 4096, VST + (size_t)j * 4096, tid);
    while (j <= jmax) {
      __syncthreads();
      tile_sstore(sm, tr, true, tid);
      __syncthreads();
      int jn = j + 1;
      while (jn <= jmax && !testbit4(um0, um1, um2, um3, jn)) ++jn;
      if (jn <= jmax) tile_gload(tr, KSB + (size_t)jn * 4096, VST + (size_t)jn * 4096, tid);
      const bool mine = testbit4(my0, my1, my2, my3, j);
      if (__ballot(mine) != 0ull) {
        qk_tile(sm, qf, s, lane);
#pragma unroll
        for (int ks2 = 0; ks2 < 2; ++ks2)
#pragma unroll
          for (int i = 0; i < 16; ++i) {
            const int kp = j * 64 + ks2 * 32 + (i & 3) + 8 * (i >> 2) + 4 * hh;
            s[ks2][i] = (mine && kp <= tq) ? s[ks2][i] : -INFINITY;
          }
        softmax_step(s, m, l, o);
        pv_tile(sm, s, o, lane);
      }
      j = jn;
    }
    const float ltot = l + __shfl_xor(l, 32);
    const float sc = ltot > 0.f ? g1 / ltot : 0.f;
#pragma unroll
    for (int mt = 0; mt < 2; ++mt)
#pragma unroll
      for (int i = 0; i < 16; ++i) { oacc[mt][i] += o[mt][i] * sc; o[mt][i] = 0.f; }
  }
  {
    const int jlo = t0 - 511 > 0 ? (t0 - 511) >> 6 : 0, jhi = (t0 + 31) >> 6;
    const int wq0 = t0 + wave * 8;
    m = -INFINITY; l = 0.f;
    tile_gload(tr, KWB + (size_t)jlo * 4096, VWT + (size_t)jlo * 4096, tid);
    for (int j = jlo; j <= jhi; ++j) {
      __syncthreads();
      tile_sstore(sm, tr, true, tid);
      __syncthreads();
      if (j + 1 <= jhi) tile_gload(tr, KWB + (size_t)(j + 1) * 4096, VWT + (size_t)(j + 1) * 4096, tid);
      if (j * 64 <= wq0 + 7 && j * 64 + 63 > wq0 - 512) {
        qk_tile(sm, qf, s, lane);
#pragma unroll
        for (int ks2 = 0; ks2 < 2; ++ks2)
#pragma unroll
          for (int i = 0; i < 16; ++i) {
            const int kp = j * 64 + ks2 * 32 + (i & 3) + 8 * (i >> 2) + 4 * hh;
            s[ks2][i] = (kp <= tq && kp > tq - 512) ? s[ks2][i] : -INFINITY;
          }
        softmax_step(s, m, l, o);
        pv_tile(sm, s, o, lane);
      }
    }
    const float ltot = l + __shfl_xor(l, 32);
    const float sc = ltot > 0.f ? g2 / ltot : 0.f;
#pragma unroll
    for (int mt = 0; mt < 2; ++mt)
#pragma unroll
      for (int i = 0; i < 16; ++i) oacc[mt][i] += o[mt][i] * sc;
  }
  float* MIX = (float*)(p.ws + OFF_MIX);
#pragma unroll
  for (int mt = 0; mt < 2; ++mt)
#pragma unroll
    for (int g4 = 0; g4 < 4; ++g4)
      st4(MIX + tok * 1024 + 512 + hd * 64 + mt * 32 + 8 * g4 + 4 * hh,
          make_float4(oacc[mt][4 * g4], oacc[mt][4 * g4 + 1], oacc[mt][4 * g4 + 2], oacc[mt][4 * g4 + 3]));
}

#define P1_SMEM ((144 * 64 + 2 * 8 * 128 + 8 * 128) * 4)
DEV void phase_p1(const Params& p, char* smem) {
  const int total = P1_PREP_ITEMS + P1_S5A_ITEMS + P1_CMP_ITEMS;
  for (int it = blockIdx.x; it < total; it += gridDim.x) {
    if (it < P1_CMP_ITEMS) p1_compress(p, it, smem);
    else if (it < P1_CMP_ITEMS + P1_S5A_ITEMS) p1_s5a(p, it - P1_CMP_ITEMS);
    else p1_prep(p, it - P1_CMP_ITEMS - P1_S5A_ITEMS, smem);
  }
}

#define P2_S5C_ITEMS (BATCH * 32 * S5_NC / 4)
#define S5C_ROW 132
#define P2_S5C_SMEM (4 * 16 * S5C_ROW * 4)
DEV void p2_s5c(const Params& p, int item, char* smem) {
  const int lane = threadIdx.x & 63, wave = threadIdx.x >> 6;
  const int idx = item * 4 + wave;
  const int g = idx & 31, c = (idx >> 5) % S5_NC, b = idx / (32 * S5_NC);
  float lb_re, lb_im, bbr[16], bbi[16];
  s5_consts(p, g, lane, lb_re, lb_im, bbr, bbi);
  float ar = lb_re, ai = lb_im;
#pragma unroll
  for (int s = 0; s < 6; ++s) { const float nr = ar * ar - ai * ai, ni = 2.f * ar * ai; ar = nr; ai = ni; }
  const float2* E = (const float2*)(p.ws + OFF_S5E);
  float sr = 0.f, si = 0.f;
  for (int cc = 0; cc < c; ++cc) {
    const float2 e = E[((size_t)(b * S5_NC + cc) * 32 + g) * 64 + lane];
    const float nr = ar * sr - ai * si + e.x, ni = ar * si + ai * sr + e.y;
    sr = nr; si = ni;
  }
  const float* H = (const float*)(p.ws + OFF_H);
  float* sS = (float*)smem + wave * 16 * S5C_ROW;
  const float* cre = p.in[I_S5_C_RE] + (size_t)g * 16 * 64;
  const float* cim = p.in[I_S5_C_IM] + (size_t)g * 16 * 64;
  float* YG = (float*)(p.ws + OFF_YGELU);
  for (int sc = 0; sc < 4; ++sc) {
    for (int tt = 0; tt < 16; ++tt) {
      const float* u = H + (size_t)(b * SEQ_LEN + c * 64 + sc * 16 + tt) * AB_IN + g * 16;
      float dr = 0.f, di = 0.f;
#pragma unroll
      for (int h4 = 0; h4 < 4; ++h4) {
        const float4 uv = ld4(u + h4 * 4);
        dr += uv.x * bbr[h4 * 4] + uv.y * bbr[h4 * 4 + 1] + uv.z * bbr[h4 * 4 + 2] + uv.w * bbr[h4 * 4 + 3];
        di += uv.x * bbi[h4 * 4] + uv.y * bbi[h4 * 4 + 1] + uv.z * bbi[h4 * 4 + 2] + uv.w * bbi[h4 * 4 + 3];
      }
      const float nr = lb_re * sr - lb_im * si + dr, ni = lb_re * si + lb_im * sr + di;
      sr = nr; si = ni;
      sS[tt * S5C_ROW + lane] = sr;
      sS[tt * S5C_ROW + 64 + lane] = si;
    }
    __syncthreads();
    {
      const int tt = lane >> 2, hq = lane & 3;
      float y[4] = {0.f, 0.f, 0.f, 0.f};
      for (int k = 0; k < 64; k += 4) {
        const float4 vr = ld4(sS + tt * S5C_ROW + k), vi = ld4(sS + tt * S5C_ROW + 64 + k);
#pragma unroll
        for (int hh = 0; hh < 4; ++hh) {
          const float4 cr = ld4(cre + (hq * 4 + hh) * 64 + k), ci = ld4(cim + (hq * 4 + hh) * 64 + k);
          y[hh] += vr.x * cr.x + vr.y * cr.y + vr.z * cr.z + vr.w * cr.w - (vi.x * ci.x + vi.y * ci.y + vi.z * ci.z + vi.w * ci.w);
        }
      }
      const size_t tok = (size_t)(b * SEQ_LEN + c * 64 + sc * 16 + tt);
      const int ch = g * 16 + hq * 4;
      const float4 uv = ld4(H + tok * AB_IN + ch);
      const float4 dv = ld4(p.in[I_S5_D] + ch);
      float4 o;
      o.x = geluf_(y[0] + dv.x * uv.x); o.y = geluf_(y[1] + dv.y * uv.y);
      o.z = geluf_(y[2] + dv.z * uv.z); o.w = geluf_(y[3] + dv.w * uv.w);
      st4(YG + tok * 512 + ch, o);
    }
    __syncthreads();
  }
}

#define P2_SMEM (P2_S5C_SMEM > P2_NSA_SMEM ? P2_S5C_SMEM : P2_NSA_SMEM)
DEV void phase_p2(const Params& p, char* smem) {
  const int G = gridDim.x;
  const int total = P2_NSA_ITEMS + P2_S5C_ITEMS;
  for (int r = 0;; ++r) {
    const int it = r * G + ((r & 1) ? (G - 1 - (int)blockIdx.x) : (int)blockIdx.x);
    if (r * G >= total) break;
    if (it >= total) continue;
    if (it < P2_NSA_ITEMS) p2_nsa(p, it, smem);
    else p2_s5c(p, it - P2_NSA_ITEMS, smem);
  }
}

DEV void phase_glu(const Params& p, char* smem) {
  const float* A = (const float*)(p.ws + OFF_YGELU);
  const float* B = p.in[I_S5_W_GLU];
  const float* bias = p.in[I_S5_B_GLU];
  float* MIX = (float*)(p.ws + OFF_MIX);
  const int NT = 4, MT = NTOK / 128;
  for (int it = blockIdx.x; it < MT * NT; it += gridDim.x) {
    const int m0 = (it / NT) * 128, n0 = (it % NT) * 128;
    gemm_tile<false>(
        [&](int r) { return (const void*)(A + (size_t)(m0 + r) * 512); },
        [&](int c) { return B + n0 + c; }, 512, 512,
        [&](int row, int col, float v0, float v1) {
          const size_t gm = m0 + row; const int gc = n0 + col;
          const float y0 = A[gm * 512 + gc], y1 = A[gm * 512 + gc + 32];
          MIX[gm * 1024 + gc] = y0 * sigmoidf_(v0 + bias[gc]);
          MIX[gm * 1024 + gc + 32] = y1 * sigmoidf_(v1 + bias[gc + 32]);
        },
        smem);
  }
}

template <int LAYER>
DEV void phase_outproj(const Params& p, char* smem) {
  const float* A = (const float*)(p.ws + OFF_MIX);
  const float* B = LAYER == 0 ? p.in[I_AB_W_OUT] : p.in[I_CD_W_OUT];
  const float* xin = LAYER == 0 ? p.in[I_X] : (const float*)(p.ws + OFF_X2);
  float* PRE = (float*)(p.ws + OFF_H);
  const int NT = 8, MT = NTOK / 128;
  for (int it = blockIdx.x; it < MT * NT; it += gridDim.x) {
    const int m0 = (it / NT) * 128, n0 = (it % NT) * 128;
    gemm_tile<false>(
        [&](int r) { return (const void*)(A + (size_t)(m0 + r) * 1024); },
        [&](int c) { return B + n0 + c; }, 1024, 1024,
        [&](int row, int col, float v0, float v1) {
          const size_t o = (size_t)(m0 + row) * 1024 + n0 + col;
          PRE[o] = ALPHA_F * xin[o] + v0;
          PRE[o + 32] = ALPHA_F * xin[o + 32] + v1;
        },
        smem);
  }
}

DEV void wave_ln(float (&v)[16], const float* gam, const float* bet, int lane) {
  float s = 0.f;
#pragma unroll
  for (int i = 0; i < 16; ++i) s += v[i];
  const float mu = wave_sum(s) * (1.f / 1024.f);
  float q = 0.f;
#pragma unroll
  for (int i = 0; i < 16; ++i) { const float d = v[i] - mu; q += d * d; }
  const float rstd = rsqrtf(wave_sum(q) * (1.f / 1024.f) + 1e-5f);
#pragma unroll
  for (int i = 0; i < 4; ++i) {
    const float4 gv = ld4(gam + lane * 4 + 256 * i), bv = ld4(bet + lane * 4 + 256 * i);
    v[i * 4 + 0] = (v[i * 4 + 0] - mu) * rstd * gv.x + bv.x;
    v[i * 4 + 1] = (v[i * 4 + 1] - mu) * rstd * gv.y + bv.y;
    v[i * 4 + 2] = (v[i * 4 + 2] - mu) * rstd * gv.z + bv.z;
    v[i * 4 + 3] = (v[i * 4 + 3] - mu) * rstd * gv.w + bv.w;
  }
}

#define P5_SMEM (4 * (1024 + 64) * 4)
template <int LAYER>
DEV void phase_ln_router(const Params& p, char* smem) {
  const int lane = threadIdx.x & 63, wave = threadIdx.x >> 6;
  const float* PRE = (const float*)(p.ws + OFF_H);
  float* X1 = (float*)(p.ws + OFF_X1);
  const float* router = p.in[I_ROUTER] + (size_t)LAYER * 1024 * 64;
  const float* bias = p.in[I_MOE_BIAS] + LAYER * 64;
  int* TOPI = (int*)(p.ws + OFF_TOPI);
  float* TOPG = (float*)(p.ws + OFF_TOPG);
  float* xs = (float*)smem + wave * (1024 + 64);
  float* ms = xs + 1024;
  for (int it = blockIdx.x; it < NTOK / 4; it += gridDim.x) {
    const size_t tok = (size_t)it * 4 + wave;
    float v[16];
#pragma unroll
    for (int i = 0; i < 4; ++i) {
      const float4 a = ld4(PRE + tok * 1024 + lane * 4 + 256 * i);
      v[i * 4] = a.x; v[i * 4 + 1] = a.y; v[i * 4 + 2] = a.z; v[i * 4 + 3] = a.w;
    }
    wave_ln(v, p.in[I_LN1_G] + LAYER * 1024, p.in[I_LN1_B] + LAYER * 1024, lane);
    WAVE_SYNC();
#pragma unroll
    for (int i = 0; i < 4; ++i) {
      const float4 a = make_float4(v[i * 4], v[i * 4 + 1], v[i * 4 + 2], v[i * 4 + 3]);
      st4(X1 + tok * 1024 + lane * 4 + 256 * i, a);
      st4(xs + lane * 4 + 256 * i, a);
    }
    WAVE_SYNC();
    float logit = 0.f;
    for (int k = 0; k < 1024; k += 4) {
      const float4 xv = ld4(xs + k);
      logit += xv.x * router[(size_t)k * 64 + lane] + xv.y * router[(size_t)(k + 1) * 64 + lane] +
               xv.z * router[(size_t)(k + 2) * 64 + lane] + xv.w * router[(size_t)(k + 3) * 64 + lane];
    }
    const float score = 1.f / (1.f + expf(-logit));
    const float biased = score + bias[lane];
    float m1 = biased; int a1 = lane;
#pragma unroll
    for (int mm = 1; mm <= 4; mm <<= 1) {
      const float ov = __shfl_xor(m1, mm); const int oa = __shfl_xor(a1, mm);
      if (ov > m1 || (ov == m1 && oa < a1)) { m1 = ov; a1 = oa; }
    }
    float m2 = lane == a1 ? -INFINITY : biased;
#pragma unroll
    for (int mm = 1; mm <= 4; mm <<= 1) m2 = fmaxf(m2, __shfl_xor(m2, mm));
    const float gs = m1 + m2;
    const int mygrp = lane >> 3;
    int rank = 0;
#pragma unroll
    for (int gg = 0; gg < 8; ++gg) {
      const float og = __shfl(gs, gg * 8);
      rank += (og > gs || (og == gs && gg < mygrp)) ? 1 : 0;
    }
    const float masked = rank < 4 ? biased : -INFINITY;
    WAVE_SYNC();
    ms[lane] = masked;
    WAVE_SYNC();
    int erank = 0;
    for (int e = 0; e < 64; ++e) {
      const float ov = ms[e];
      erank += (ov > masked || (ov == masked && e < lane)) ? 1 : 0;
    }
    const bool selected = erank < 8;
    const float gsum = wave_sum(selected ? score : 0.f);
    if (selected) {
      TOPI[tok * 8 + erank] = lane;
      TOPG[tok * 8 + erank] = score / gsum * 2.5f;
    }
    WAVE_SYNC();
  }
}

#define P6_SMEM GEMM_SMEM_BYTES
template <int LAYER>
DEV void phase_lists_shup(const Params& p, char* smem) {
  const int tid = threadIdx.x, lane = tid & 63, wave = tid >> 6;
  const int* TOPI = (const int*)(p.ws + OFF_TOPI);
  const float* TOPG = (const float*)(p.ws + OFF_TOPG);
  int* POSOF = (int*)(p.ws + OFF_POSOF);
  int* CNT = (int*)(p.ws + OFF_CNT);
  int* LTOK = (int*)(p.ws + OFF_LTOK);
  float* LGATE = (float*)(p.ws + OFF_LGATE);
  const float* X1 = (const float*)(p.ws + OFF_X1);
  unsigned short* HS = (unsigned short*)(p.ws + OFF_HS);
  const float* W1 = p.in[I_SH_W1] + (size_t)LAYER * 1024 * 256;
  const float* W3 = p.in[I_SH_W3] + (size_t)LAYER * 1024 * 256;
  const int MT = NTOK / 128;
  const int total = 64 + MT * 4;
  int* swave = (int*)smem;
  for (int it = blockIdx.x; it < total; it += gridDim.x) {
    if (it < 64) {
      const int e = it;
      int base = 0;
      for (int t0 = 0; t0 < NTOK; t0 += NTHREADS) {
        const int tok = t0 + tid;
        int slot = -1;
#pragma unroll
        for (int s = 0; s < 8; ++s) if (TOPI[(size_t)tok * 8 + s] == e) slot = s;
        const unsigned long long bal = __ballot(slot >= 0);
        const int pre = __popcll(bal & ((1ull << lane) - 1ull));
        __syncthreads();
        if (lane == 0) swave[wave] = __popcll(bal);
        __syncthreads();
        int woff = 0, tot = 0;
#pragma unroll
        for (int w = 0; w < 4; ++w) { const int c = swave[w]; if (w < wave) woff += c; tot += c; }
        if (slot >= 0) {
          const int pos = base + woff + pre;
          LTOK[(size_t)e * NTOK + pos] = tok;
          LGATE[(size_t)e * NTOK + pos] = TOPG[(size_t)tok * 8 + slot];
          POSOF[(size_t)tok * 8 + slot] = pos;
        }
        base += tot;
      }
      if (tid == 0) CNT[e] = base;
      __syncthreads();
    } else {
      const int it2 = it - 64;
      const int m0 = (it2 / 4) * 128, ct = it2 % 4;
      gemm_tile<false>(
          [&](int r) { return (const void*)(X1 + (size_t)(m0 + r) * 1024); },
          [&](int c) { return (((c >> 5) & 1) ? W3 : W1) + ct * 64 + (c >> 6) * 32 + (c & 31); }, 256, 1024,
          [&](int row, int col, float v0, float v1) {
            const int lc = ct * 64 + (col >> 6) * 32 + (col & 31);
            HS[(size_t)(m0 + row) * 256 + lc] = f2bf(siluf_(v0) * v1);
          },
          smem);
    }
  }
}

struct ExpMap { int tstart[65]; int rbase[65]; };
DEV void build_expmap(const Params& p, ExpMap* em) {
  __syncthreads();
  if (threadIdx.x == 0) {
    const int* CNT = (const int*)(p.ws + OFF_CNT);
    int ts = 0, rb = 0;
    for (int e = 0; e < 64; ++e) {
      em->tstart[e] = ts; em->rbase[e] = rb;
      const int c = CNT[e];
      ts += (c + 127) / 128; rb += c;
    }
    em->tstart[64] = ts; em->rbase[64] = rb;
  }
  __syncthreads();
}
DEV int find_expert(const ExpMap* em, int rt) {
  int e = 0;
  for (int k = 0; k < 64; ++k) if (em->tstart[k + 1] <= rt) e = k + 1;
  return e;
}

#define P7_SMEM (GEMM_SMEM_BYTES + 1024)
template <int LAYER>
DEV void phase_routed_up(const Params& p, char* smem) {
  ExpMap* em = (ExpMap*)(smem + GEMM_SMEM_BYTES);
  build_expmap(p, em);
  const int* CNT = (const int*)(p.ws + OFF_CNT);
  const int* LTOK = (const int*)(p.ws + OFF_LTOK);
  const float* X1 = (const float*)(p.ws + OFF_X1);
  unsigned short* HR = (unsigned short*)(p.ws + OFF_HR);
  const int total = em->tstart[64] * 4;
  for (int it = blockIdx.x; it < total; it += gridDim.x) {
    const int rt = it >> 2, ct = it & 3;
    const int e = find_expert(em, rt);
    const int r0 = (rt - em->tstart[e]) * 128;
    const int cnt = CNT[e], rbase = em->rbase[e];
    const float* W1 = p.in[I_MOE_W1] + ((size_t)LAYER * 64 + e) * 1024 * 256;
    const float* W3 = p.in[I_MOE_W3] + ((size_t)LAYER * 64 + e) * 1024 * 256;
    gemm_tile<false>(
        [&](int r) { return (r0 + r < cnt) ? (const void*)(X1 + (size_t)LTOK[(size_t)e * NTOK + r0 + r] * 1024) : (const void*)nullptr; },
        [&](int c) { return (((c >> 5) & 1) ? W3 : W1) + ct * 64 + (c >> 6) * 32 + (c & 31); }, 256, 1024,
        [&](int row, int col, float v0, float v1) {
          if (r0 + row < cnt) {
            const int lc = ct * 64 + (col >> 6) * 32 + (col & 31);
            HR[(size_t)(rbase + r0 + row) * 256 + lc] = f2bf(siluf_(v0) * v1);
          }
        },
        smem);
  }
}

template <int LAYER>
DEV void phase_down(const Params& p, char* smem) {
  ExpMap* em = (ExpMap*)(smem + GEMM_SMEM_BYTES);
  build_expmap(p, em);
  const int* CNT = (const int*)(p.ws + OFF_CNT);
  const float* LGATE = (const float*)(p.ws + OFF_LGATE);
  const unsigned short* HR = (const unsigned short*)(p.ws + OFF_HR);
  const unsigned short* HS = (const unsigned short*)(p.ws + OFF_HS);
  unsigned short* Y = (unsigned short*)(p.ws + OFF_Y);
  float* FS = (float*)(p.ws + OFF_FS);
  const int nrouted = em->tstart[64] * 8;
  const int total = nrouted + (NTOK / 128) * 8;
  for (int it = blockIdx.x; it < total; it += gridDim.x) {
    if (it < nrouted) {
      const int rt = it >> 3, ct = it & 7;
      const int e = find_expert(em, rt);
      const int r0 = (rt - em->tstart[e]) * 128;
      const int cnt = CNT[e], rbase = em->rbase[e];
      const float* W2 = p.in[I_MOE_W2] + ((size_t)LAYER * 64 + e) * 256 * 1024;
      const int n0 = ct * 128;
      gemm_tile<true>(
          [&](int r) { return (r0 + r < cnt) ? (const void*)(HR + (size_t)(rbase + r0 + r) * 256) : (const void*)nullptr; },
          [&](int c) { return W2 + n0 + c; }, 1024, 256,
          [&](int row, int col, float v0, float v1) {
            if (r0 + row < cnt) {
              const float gt = LGATE[(size_t)e * NTOK + r0 + row];
              const size_t o = (size_t)(rbase + r0 + row) * 1024 + n0 + col;
              Y[o] = f2bf(v0 * gt); Y[o + 32] = f2bf(v1 * gt);
            }
          },
          smem);
    } else {
      const int it2 = it - nrouted;
      const int m0 = (it2 >> 3) * 128, n0 = (it2 & 7) * 128;
      const float* W2 = p.in[I_SH_W2] + (size_t)LAYER * 256 * 1024;
      gemm_tile<true>(
          [&](int r) { return (const void*)(HS + (size_t)(m0 + r) * 256); },
          [&](int c) { return W2 + n0 + c; }, 1024, 256,
          [&](int row, int col, float v0, float v1) {
            const size_t o = (size_t)(m0 + row) * 1024 + n0 + col;
            FS[o] = v0; FS[o + 32] = v1;
          },
          smem);
    }
  }
}

template <int LAYER>
DEV void phase_combine(const Params& p, char* smem) {
  ExpMap* em = (ExpMap*)smem;
  build_expmap(p, em);
  const int lane = threadIdx.x & 63, wave = threadIdx.x >> 6;
  const float* X1 = (const float*)(p.ws + OFF_X1);
  const float* FS = (const float*)(p.ws + OFF_FS);
  const unsigned short* Y = (const unsigned short*)(p.ws + OFF_Y);
  const int* TOPI = (const int*)(p.ws + OFF_TOPI);
  const int* POSOF = (const int*)(p.ws + OFF_POSOF);
  float* OUT = LAYER == 0 ? (float*)(p.ws + OFF_X2) : p.out;
  for (int it = blockIdx.x; it < NTOK / 4; it += gridDim.x) {
    const size_t tok = (size_t)it * 4 + wave;
    float v[16];
#pragma unroll
    for (int i = 0; i < 4; ++i) {
      const float4 a = ld4(X1 + tok * 1024 + lane * 4 + 256 * i), f = ld4(FS + tok * 1024 + lane * 4 + 256 * i);
      v[i * 4] = ALPHA_F * a.x + f.x; v[i * 4 + 1] = ALPHA_F * a.y + f.y; v[i * 4 + 2] = ALPHA_F * a.z + f.z; v[i * 4 + 3] = ALPHA_F * a.w + f.w;
    }
    for (int s = 0; s < 8; ++s) {
      const int e = TOPI[tok * 8 + s];
      const size_t row = (size_t)em->rbase[e] + POSOF[tok * 8 + s];
#pragma unroll
      for (int i = 0; i < 4; ++i) {
        const uint2 y = *(const uint2*)(Y + row * 1024 + lane * 4 + 256 * i);
        v[i * 4] += bf2f((unsigned short)(y.x & 0xFFFF)); v[i * 4 + 1] += bf2f((unsigned short)(y.x >> 16));
        v[i * 4 + 2] += bf2f((unsigned short)(y.y & 0xFFFF)); v[i * 4 + 3] += bf2f((unsigned short)(y.y >> 16));
      }
    }
    wave_ln(v, p.in[I_LN2_G] + LAYER * 1024, p.in[I_LN2_B] + LAYER * 1024, lane);
#pragma unroll
    for (int i = 0; i < 4; ++i) st4(OUT + tok * 1024 + lane * 4 + 256 * i, make_float4(v[i * 4], v[i * 4 + 1], v[i * 4 + 2], v[i * 4 + 3]));
  }
}

DEV float shifted(const float* Hc, size_t tok, int col, const float* mu) {
  const float cur = Hc[tok * CD_IN + col];
  const float prev = (tok % SEQ_LEN) == 0 ? 0.f : Hc[(tok - 1) * CD_IN + col];
  return cur + (prev - cur) * mu[col];
}

#define P11_PREP_ITEMS (NTOK / 8)
#define P11_KV_ITEMS (BATCH * 4 * RET_NC)
#define P11_SMEM (8 * 128 * 4)
DEV void p11_prep(const Params& p, int item, char* smem) {
  const int tid = threadIdx.x;
  const float* Hc = (const float*)(p.ws + OFF_H);
  const float* mu = p.in[I_RW_MU];
  float* sl = (float*)smem;
  __syncthreads();
  for (int w = tid; w < 8 * 128; w += NTHREADS) {
    const int tt = w >> 7, j = w & 127;
    const size_t tok = (size_t)item * 8 + tt;
    const float v = shifted(Hc, tok, 1536 + j, mu);
    sl[w] = j < 64 ? tanhf(v) : v;
  }
  __syncthreads();
  float* RWW = (float*)(p.ws + OFF_RWW); float* RWK = (float*)(p.ws + OFF_RWK);
  float* RWKK = (float*)(p.ws + OFF_RWKK); float* RWA = (float*)(p.ws + OFF_RWA);
  float* RWR = p.out + (size_t)NTOK * 512; float* RWV = p.out;
  const float* w_up = p.in[I_RW_W_UP]; const float* a_up = p.in[I_RW_A_UP];
#pragma unroll
  for (int cc = 0; cc < 2; ++cc) {
    const int c = tid + 256 * cc;
    float aw[8], aa[8];
#pragma unroll
    for (int tt = 0; tt < 8; ++tt) { aw[tt] = 0.f; aa[tt] = 0.f; }
    for (int j = 0; j < 64; ++j) {
      const float wu = w_up[j * 512 + c], au = a_up[j * 512 + c];
#pragma unroll
      for (int tt = 0; tt < 8; ++tt) { aw[tt] += sl[tt * 128 + j] * wu; aa[tt] += sl[tt * 128 + 64 + j] * au; }
    }
    const float w0 = p.in[I_RW_W0][c], a0 = p.in[I_RW_A0][c], kkc = p.in[I_RW_K_K][c], kac = p.in[I_RW_K_A][c];
#pragma unroll
    for (int tt = 0; tt < 8; ++tt) {
      const size_t tok = (size_t)item * 8 + tt;
      const float lw = w0 + aw[tt];
      const float nl = -lw;
      const float sp = nl > 20.f ? nl : log1pf(expf(nl));
      const float wl = -sp - 0.5f;
      const float decay = expf(-expf(wl));
      const float a = 1.f / (1.f + expf(-(a0 + aa[tt])));
      const float rs = shifted(Hc, tok, c, mu);
      const float ks = shifted(Hc, tok, 512 + c, mu);
      const float vs = shifted(Hc, tok, 1024 + c, mu);
      float kk = ks * kkc;
      const float nrm = sqrtf(wave_sum(kk * kk));
      kk = kk / fmaxf(nrm, 1e-12f);
      RWW[tok * 512 + c] = decay;
      RWK[tok * 512 + c] = ks * (1.f + (a - 1.f) * kac);
      RWKK[tok * 512 + c] = kk;
      RWA[tok * 512 + c] = kk * a;
      RWR[tok * 512 + c] = rs;
      RWV[tok * 512 + c] = vs;
    }
  }
}
DEV float ret_log2gamma(int h) { return log2f(1.f - exp2f(-5.f - (float)h)); }
DEV void p11_kv(const Params& p, int item) {
  const int c = item % RET_NC, h = (item / RET_NC) & 3, b = item / (RET_NC * 4);
  const int tid = threadIdx.x, e = tid & 127, dh = tid >> 7;
  const float* Hc = (const float*)(p.ws + OFF_H);
  const float lg = ret_log2gamma(h);
  float acc[32];
#pragma unroll
  for (int i = 0; i < 32; ++i) acc[i] = 0.f;
  for (int j = 0; j < 128; ++j) {
    const size_t tok = (size_t)b * SEQ_LEN + c * 128 + j;
    const float vv = Hc[tok * CD_IN + 2304 + h * 128 + e] * exp2f((float)(127 - j) * lg);
    const float* kr = Hc + tok * CD_IN + 2048 + h * 64 + dh * 32;
#pragma unroll
    for (int i4 = 0; i4 < 8; ++i4) {
      const float4 kv = ld4(kr + i4 * 4);
      acc[i4 * 4] += kv.x * vv; acc[i4 * 4 + 1] += kv.y * vv; acc[i4 * 4 + 2] += kv.z * vv; acc[i4 * 4 + 3] += kv.w * vv;
    }
  }
  float* KV = (float*)(p.ws + OFF_RETKV) + (size_t)item * 64 * 128;
#pragma unroll
  for (int i = 0; i < 32; ++i) KV[(dh * 32 + i) * 128 + e] = acc[i];
}
DEV void phase_p11(const Params& p, char* smem) {
  const int total = P11_PREP_ITEMS + P11_KV_ITEMS;
  for (int it = blockIdx.x; it < total; it += gridDim.x) {
    if (it < P11_KV_ITEMS) p11_kv(p, it);
    else p11_prep(p, it - P11_KV_ITEMS, smem);
  }
}

#define P12_SCAN_ITEMS (BATCH * 8 * 4)
#define P12_RET_ITEMS (BATCH * 4 * RET_NC)
#define P12_SCAN_SMEM ((2 * (16 * 5 * 64 + 16 * 16) + 16 * 16) * 4)
#define P12_RET_SMEM (64 * 128 * 4 + 256 * 2 * 4)
#define P12_SMEM (P12_SCAN_SMEM > P12_RET_SMEM ? P12_SCAN_SMEM : P12_RET_SMEM)
DEV float sum16(float v) {
#ifdef CPU_EMU
  return emu_sum16(v);
#else
  int x;
  x = __builtin_amdgcn_update_dpp(0, __builtin_bit_cast(int, v), 0xB1, 0xF, 0xF, false); v += __builtin_bit_cast(float, x);
  x = __builtin_amdgcn_update_dpp(0, __builtin_bit_cast(int, v), 0x4E, 0xF, 0xF, false); v += __builtin_bit_cast(float, x);
  x = __builtin_amdgcn_update_dpp(0, __builtin_bit_cast(int, v), 0x141, 0xF, 0xF, false); v += __builtin_bit_cast(float, x);
  x = __builtin_amdgcn_update_dpp(0, __builtin_bit_cast(int, v), 0x140, 0xF, 0xF, false); v += __builtin_bit_cast(float, x);
  return v;
#endif
}
DEV void p12_scan(const Params& p, int item, char* smem) {
  const int rq = item & 3, h = (item >> 2) & 7, b = item >> 5;
  const int tid = threadIdx.x, rl = tid >> 4, cg = tid & 15;
  const float* ARR[5] = {(const float*)(p.ws + OFF_RWW), (const float*)(p.ws + OFF_RWK), (const float*)(p.ws + OFF_RWKK),
                         (const float*)(p.ws + OFF_RWA), p.out + (size_t)NTOK * 512};
  const float* RWV = p.out;
  float* Yo = (float*)(p.ws + OFF_MIX);
  float* buf = (float*)smem;
  float* vbuf = buf + 2 * 16 * 5 * 64;
  float* ybuf = vbuf + 2 * 16 * 16;
  float S[4] = {0.f, 0.f, 0.f, 0.f};
  float4 rg[5]; float rv;
  const int lstep = tid >> 4, lc4 = tid & 15;
  auto gload = [&](int c) {
    const size_t o = ((size_t)b * SEQ_LEN + c * 16 + lstep) * 512 + h * 64;
#pragma unroll
    for (int a = 0; a < 5; ++a) rg[a] = ld4(ARR[a] + o + lc4 * 4);
    rv = RWV[o + rq * 16 + lc4];
  };
  auto sstore = [&](int bi) {
#pragma unroll
    for (int a = 0; a < 5; ++a) st4(buf + ((bi * 16 + lstep) * 5 + a) * 64 + lc4 * 4, rg[a]);
    vbuf[(bi * 16 + lstep) * 16 + lc4] = rv;
  };
  __syncthreads();
  gload(0);
  sstore(0);
  __syncthreads();
  const int NCH = SEQ_LEN / 16;
  for (int c = 0; c < NCH; ++c) {
    if (c + 1 < NCH) gload(c + 1);
    const float* cb = buf + (c & 1) * 16 * 5 * 64;
    const float* cv = vbuf + (c & 1) * 16 * 16;
#pragma unroll
    for (int s = 0; s < 16; ++s) {
      const float4 w = ld4(cb + (s * 5 + 0) * 64 + cg * 4), k = ld4(cb + (s * 5 + 1) * 64 + cg * 4), kk = ld4(cb + (s * 5 + 2) * 64 + cg * 4),
                   ka = ld4(cb + (s * 5 + 3) * 64 + cg * 4), r = ld4(cb + (s * 5 + 4) * 64 + cg * 4);
      const float v = cv[s * 16 + rl];
      float sa = (S[0] * kk.x + S[1] * kk.y) + (S[2] * kk.z + S[3] * kk.w);
      sa = -sum16(sa);
      S[0] = S[0] * w.x + (sa * ka.x + v * k.x);
      S[1] = S[1] * w.y + (sa * ka.y + v * k.y);
      S[2] = S[2] * w.z + (sa * ka.z + v * k.z);
      S[3] = S[3] * w.w + (sa * ka.w + v * k.w);
      float y = (S[0] * r.x + S[1] * r.y) + (S[2] * r.z + S[3] * r.w);
      y = sum16(y);
      if (cg == 0) ybuf[s * 16 + rl] = y;
    }
    __syncthreads();
    if (c + 1 < NCH) sstore((c + 1) & 1);
    Yo[((size_t)b * SEQ_LEN + c * 16 + lstep) * 1024 + h * 64 + rq * 16 + lc4] = ybuf[lstep * 16 + lc4];
    __syncthreads();
  }
}
DEV void p12_ret(const Params& p, int item, char* smem) {
  const int c = item % RET_NC, h = (item / RET_NC) & 3, b = item / (RET_NC * 4);
  const int tid = threadIdx.x, i = tid & 127, eh = tid >> 7;
  const float* Hc = (const float*)(p.ws + OFF_H);
  const float lg = ret_log2gamma(h);
  float* sS = (float*)smem;
  float* sRed = sS + 64 * 128;
  __syncthreads();
  {
    const float G = exp2f(128.f * lg);
    const float* KV0 = (const float*)(p.ws + OFF_RETKV) + (size_t)((b * 4 + h) * RET_NC) * 64 * 128;
    for (int w = tid; w < 64 * 128; w += NTHREADS) {
      float s = 0.f;
      for (int cc = 0; cc < c; ++cc) s = s * G + KV0[(size_t)cc * 64 * 128 + w];
      sS[w] = s;
    }
  }
  __syncthreads();
  const size_t tok0 = (size_t)b * SEQ_LEN + c * 128;
  float q[64];
  {
    const float* qr = Hc + (tok0 + i) * CD_IN + 1792 + h * 64;
#pragma unroll
    for (int d4 = 0; d4 < 16; ++d4) { const float4 v = ld4(qr + d4 * 4); q[d4 * 4] = v.x; q[d4 * 4 + 1] = v.y; q[d4 * 4 + 2] = v.z; q[d4 * 4 + 3] = v.w; }
  }
  float acc[64];
#pragma unroll
  for (int e = 0; e < 64; ++e) acc[e] = 0.f;
  {
    const float qs = exp2f((float)(i + 1) * lg);
#pragma unroll
    for (int d = 0; d < 64; ++d) {
      const float qd = q[d] * qs;
#pragma unroll
      for (int e4 = 0; e4 < 16; ++e4) {
        const float4 sv = ld4(sS + d * 128 + eh * 64 + e4 * 4);
        acc[e4 * 4] += qd * sv.x; acc[e4 * 4 + 1] += qd * sv.y; acc[e4 * 4 + 2] += qd * sv.z; acc[e4 * 4 + 3] += qd * sv.w;
      }
    }
  }
  const int jmax = ((tid >> 6) & 1) * 64 + 63;
  for (int j = 0; j <= jmax; ++j) {
    const float* kr = Hc + (tok0 + j) * CD_IN + 2048 + h * 64;
    float s = 0.f;
#pragma unroll
    for (int d4 = 0; d4 < 16; ++d4) { const float4 kv = ld4(kr + d4 * 4); s += q[d4 * 4] * kv.x + q[d4 * 4 + 1] * kv.y + q[d4 * 4 + 2] * kv.z + q[d4 * 4 + 3] * kv.w; }
    s = j <= i ? s * exp2f((float)(i - j) * lg) : 0.f;
    const float* vr = Hc + (tok0 + j) * CD_IN + 2304 + h * 128 + eh * 64;
#pragma unroll
    for (int e4 = 0; e4 < 16; ++e4) {
      const float4 vv = ld4(vr + e4 * 4);
      acc[e4 * 4] += s * vv.x; acc[e4 * 4 + 1] += s * vv.y; acc[e4 * 4 + 2] += s * vv.z; acc[e4 * 4 + 3] += s * vv.w;
    }
  }
  float s1 = 0.f;
#pragma unroll
  for (int e = 0; e < 64; ++e) s1 += acc[e];
  sRed[tid * 2] = s1;
  __syncthreads();
  const float mu = (s1 + sRed[(tid ^ 128) * 2]) * (1.f / 128.f);
  float s2 = 0.f;
#pragma unroll
  for (int e = 0; e < 64; ++e) { const float d = acc[e] - mu; s2 += d * d; }
  sRed[tid * 2 + 1] = s2;
  __syncthreads();
  const float rstd = rsqrtf((s2 + sRed[(tid ^ 128) * 2 + 1]) * (1.f / 128.f) + 1e-5f);
  float* MIX = (float*)(p.ws + OFF_MIX);
  const float* lgam = p.in[I_RET_LN_G] + h * 128 + eh * 64;
  const float* lbet = p.in[I_RET_LN_B] + h * 128 + eh * 64;
  const float* gate = Hc + (tok0 + i) * CD_IN + 2816 + h * 128 + eh * 64;
  float* dst = MIX + (tok0 + i) * 1024 + 512 + h * 128 + eh * 64;
#pragma unroll
  for (int e4 = 0; e4 < 16; ++e4) {
    const float4 gv = ld4(lgam + e4 * 4), bv = ld4(lbet + e4 * 4), gt = ld4(gate + e4 * 4);
    float4 o;
    o.x = siluf_(gt.x) * ((acc[e4 * 4] - mu) * rstd * gv.x + bv.x);
    o.y = siluf_(gt.y) * ((acc[e4 * 4 + 1] - mu) * rstd * gv.y + bv.y);
    o.z = siluf_(gt.z) * ((acc[e4 * 4 + 2] - mu) * rstd * gv.z + bv.z);
    o.w = siluf_(gt.w) * ((acc[e4 * 4 + 3] - mu) * rstd * gv.w + bv.w);
    st4(dst + e4 * 4, o);
  }
}
DEV void phase_p12(const Params& p, char* smem) {
  const int total = P12_SCAN_ITEMS + P12_RET_ITEMS;
  for (int it = blockIdx.x; it < total; it += gridDim.x) {
    if (it < P12_SCAN_ITEMS) p12_scan(p, it, smem);
    else p12_ret(p, it - P12_SCAN_ITEMS, smem);
  }
}

#define P13_SMEM (8 * 128 * 4)
DEV void phase_p13(const Params& p, char* smem) {
  const int tid = threadIdx.x;
  const float* Hc = (const float*)(p.ws + OFF_H);
  const float* mu = p.in[I_RW_MU];
  float* sl = (float*)smem;
  float* MIX = (float*)(p.ws + OFF_MIX);
  const float* RWK = (const float*)(p.ws + OFF_RWK); const float* RWR = p.out + (size_t)NTOK * 512; const float* RWV = p.out;
  const float* g_up = p.in[I_RW_G_UP];
  for (int it = blockIdx.x; it < NTOK / 8; it += gridDim.x) {
    __syncthreads();
    for (int w = tid; w < 8 * 128; w += NTHREADS) {
      const size_t tok = (size_t)it * 8 + (w >> 7);
      sl[w] = sigmoidf_(shifted(Hc, tok, 1664 + (w & 127), mu));
    }
    __syncthreads();
#pragma unroll
    for (int cc = 0; cc < 2; ++cc) {
      const int c = tid + 256 * cc;
      float ag[8];
#pragma unroll
      for (int tt = 0; tt < 8; ++tt) ag[tt] = 0.f;
      for (int j = 0; j < 128; ++j) {
        const float gu = g_up[j * 512 + c];
#pragma unroll
        for (int tt = 0; tt < 8; ++tt) ag[tt] += sl[tt * 128 + j] * gu;
      }
      const float lng = p.in[I_RW_LN_G][c], lnb = p.in[I_RW_LN_B][c], rk = p.in[I_RW_R_K][c];
#pragma unroll
      for (int tt = 0; tt < 8; ++tt) {
        const size_t tok = (size_t)it * 8 + tt;
        const float y = MIX[tok * 1024 + c];
        const float m = wave_sum(y) * (1.f / 64.f);
        const float d = y - m;
        const float var = wave_sum(d * d) * (1.f / 64.f);
        const float yn = d * rsqrtf(var + 64e-5f) * lng + lnb;
        const float r = RWR[tok * 512 + c], k = RWK[tok * 512 + c], v = RWV[tok * 512 + c];
        const float bonus = wave_sum(r * k * rk) * v;
        MIX[tok * 1024 + c] = (yn + bonus) * ag[tt];
      }
    }
  }
}

#define NPHASES 20
#define SMEM_BYTES 49152
DEV void run_phase(const Params& p, int ph, char* smem) {
  switch (ph) {
    case 0: phase_gemm_in<0>(p, smem); break;
    case 1: phase_p1(p, smem); break;
    case 2: phase_p2(p, smem); break;
    case 3: phase_glu(p, smem); break;
    case 4: phase_outproj<0>(p, smem); break;
    case 5: phase_ln_router<0>(p, smem); break;
    case 6: phase_lists_shup<0>(p, smem); break;
    case 7: phase_routed_up<0>(p, smem); break;
    case 8: phase_down<0>(p, smem); break;
    case 9: phase_combine<0>(p, smem); break;
    case 10: phase_gemm_in<1>(p, smem); break;
    case 11: phase_p11(p, smem); break;
    case 12: phase_p12(p, smem); break;
    case 13: phase_p13(p, smem); break;
    case 14: phase_outproj<1>(p, smem); break;
    case 15: phase_ln_router<1>(p, smem); break;
    case 16: phase_lists_shup<1>(p, smem); break;
    case 17: phase_routed_up<1>(p, smem); break;
    case 18: phase_down<1>(p, smem); break;
    case 19: phase_combine<1>(p, smem); break;
  }
}
static_assert(P1_SMEM <= SMEM_BYTES, "smem");
static_assert(P1_PREP_SMEM <= SMEM_BYTES, "smem");
static_assert(P2_SMEM <= SMEM_BYTES, "smem");
static_assert(P5_SMEM <= SMEM_BYTES, "smem");
static_assert(P7_SMEM <= SMEM_BYTES, "smem");
static_assert(P12_SMEM <= SMEM_BYTES, "smem");
static_assert(OFF_HS + (size_t)NTOK * 256 * 2 <= OFF_X1, "layout");

#ifndef CPU_EMU
template <int PH>
__global__ void __launch_bounds__(NTHREADS) phase_kernel(Params p) {
  __shared__ __attribute__((aligned(16))) char smem[SMEM_BYTES];
  run_phase(p, PH, smem);
}
template <int PH>
static void launch_phases(const Params& p, hipStream_t stream) {
  phase_kernel<PH><<<dim3(1024), dim3(NTHREADS), 0, stream>>>(p);
  if constexpr (PH + 1 < NPHASES) launch_phases<PH + 1>(p, stream);
}
#if MEGA
DEV void grid_barrier(unsigned* bar, unsigned& epoch) {
  asm volatile("s_waitcnt vmcnt(0)" ::: "memory");
  __syncthreads();
  epoch += 1u;
  if (threadIdx.x == 0) {
    __builtin_amdgcn_fence(__ATOMIC_RELEASE, "agent");
    asm volatile("s_waitcnt vmcnt(0)" ::: "memory");
    __hip_atomic_fetch_add(bar, 1u, __ATOMIC_RELAXED, __HIP_MEMORY_SCOPE_AGENT);
    const unsigned target = epoch * gridDim.x;
    while (__hip_atomic_load(bar, __ATOMIC_RELAXED, __HIP_MEMORY_SCOPE_AGENT) < target) __builtin_amdgcn_s_sleep(1);
    __builtin_amdgcn_fence(__ATOMIC_ACQUIRE, "agent");
    asm volatile("s_waitcnt vmcnt(0)" ::: "memory");
  }
  __syncthreads();
}
__global__ void __launch_bounds__(NTHREADS) mega_kernel(Params p) {
  __shared__ __attribute__((aligned(16))) char smem[SMEM_BYTES];
  unsigned* bar = (unsigned*)(p.ws + OFF_BAR);
  unsigned epoch = 0u;
  if (p.ws == nullptr) cg::this_grid().sync();
#define PH_(n) run_phase(p, n, smem); grid_barrier(bar, epoch);
  PH_(0) PH_(1) PH_(2) PH_(3) PH_(4) PH_(5) PH_(6) PH_(7) PH_(8) PH_(9)
  PH_(10) PH_(11) PH_(12) PH_(13) PH_(14) PH_(15) PH_(16) PH_(17) PH_(18)
  run_phase(p, 19, smem);
}
#endif

extern "C" void kernel_launch(void* const* d_in, const int* in_sizes, int n_in, void* d_out, int out_size, void* d_ws, size_t ws_size,
                              hipStream_t stream) {
  Params p;
  for (int i = 0; i < N_INPUTS; ++i) p.in[i] = (const float*)d_in[i];
  p.out = (float*)d_out;
  p.ws = (char*)d_ws;
#if MEGA
  static int grid_blocks = 0;
  if (!grid_blocks) {
    int dev = 0, cus = 0, per_cu = 0;
    hipGetDevice(&dev);
    hipDeviceGetAttribute(&cus, hipDeviceAttributeMultiprocessorCount, dev);
    hipOccupancyMaxActiveBlocksPerMultiprocessor(&per_cu, mega_kernel, NTHREADS, 0);
    if (per_cu > 2) per_cu = 2;
    grid_blocks = cus * per_cu;
  }
  hipMemsetAsync((char*)d_ws + OFF_BAR, 0, 4096, stream);
  void* args[] = {&p};
  hipError_t e = hipLaunchCooperativeKernel((void*)mega_kernel, dim3(grid_blocks), dim3(NTHREADS), args, 0, stream);
  if (e != hipSuccess) fprintf(stderr, "cooperative launch failed: %s (grid %d)\n", hipGetErrorString(e), grid_blocks);
#else
  launch_phases<0>(p, stream);
#endif
}
#endif
```

```cpp
#ifdef CPU_EMU
#include "emu.h"
#else
#include <hip/hip_runtime.h>
#include <hip/hip_cooperative_groups.h>
#include <cstdio>
namespace cg = cooperative_groups;
#endif
#include <stdint.h>

#ifndef BATCH
#define BATCH 2
#endif
#ifndef SEQ_LEN
#define SEQ_LEN 8192
#endif
#ifndef MEGA
#define MEGA 1
#endif

#define DEV __device__ __forceinline__
#define NTOK (BATCH * SEQ_LEN)
#define DM 1024
#define AB_IN 1816
#define CD_IN 3328
#define NCMP ((SEQ_LEN - 32) / 16 + 1)
#define NBLK (SEQ_LEN / 64)
#define NB_CMP ((NCMP + 63) / 64)
#define S5_NC (SEQ_LEN / 64)
#define RET_NC (SEQ_LEN / 128)
#define ALPHA_F 1.4142135623730951f
#define NTHREADS 256

enum { I_X = 0, I_AB_W_IN, I_AB_W_OUT, I_S5_LAM_RE, I_S5_LAM_IM, I_S5_LOG_DT, I_S5_B_RE, I_S5_B_IM, I_S5_C_RE, I_S5_C_IM,
       I_S5_D, I_S5_W_GLU, I_S5_B_GLU, I_PE_K, I_PE_V, I_CK_W1, I_CK_B1, I_CK_W2, I_CV_W1, I_CV_B1, I_CV_W2,
       I_CD_W_IN, I_CD_W_OUT, I_RW_MU, I_RW_W0, I_RW_W_UP, I_RW_A0, I_RW_A_UP, I_RW_G_UP, I_RW_K_K, I_RW_K_A, I_RW_R_K,
       I_RW_LN_G, I_RW_LN_B, I_RET_LN_G, I_RET_LN_B, I_LN1_G, I_LN1_B, I_LN2_G, I_LN2_B, I_ROUTER, I_MOE_BIAS,
       I_MOE_W1, I_MOE_W3, I_MOE_W2, I_SH_W1, I_SH_W3, I_SH_W2, N_INPUTS };

struct Params {
  const float* in[N_INPUTS];
  float* out;
  char* ws;
};

#define MiB_TOK ((size_t)NTOK * 1024 * 4)
#define OFF_H 0
#define OFF_MIX ((size_t)NTOK * 3328 * 4)
#define OFF_X1 (OFF_MIX + MiB_TOK)
#define OFF_X2 (OFF_X1 + MiB_TOK)
#define OFF_R4 (OFF_X2 + MiB_TOK)
#define OFF_R5 (OFF_R4 + MiB_TOK)
#define OFF_Y OFF_H
#define OFF_HS (OFF_H + 4 * MiB_TOK)
#define OFF_FS OFF_X2
#define OFF_HR OFF_R4
#define OFF_TOPI (OFF_R5)
#define OFF_TOPG (OFF_TOPI + (size_t)NTOK * 8 * 4)
#define OFF_POSOF (OFF_TOPG + (size_t)NTOK * 8 * 4)
#define OFF_CNT (OFF_POSOF + (size_t)NTOK * 8 * 4)
#define OFF_LTOK (OFF_CNT + 1024)
#define OFF_LGATE (OFF_LTOK + (size_t)64 * NTOK * 4)
#define OFF_S5E (OFF_LGATE + (size_t)64 * NTOK * 4)
#define OFF_KCMP (OFF_S5E + (size_t)BATCH * S5_NC * 32 * 64 * 8)
#define OFF_VCMP (OFF_KCMP + (size_t)BATCH * NCMP * 2 * 64 * 4)
#define OFF_RETKV (OFF_VCMP + (size_t)BATCH * NCMP * 2 * 64 * 4)
#define OFF_BAR (OFF_RETKV + (size_t)BATCH * 4 * RET_NC * 64 * 128 * 4)
#define OFF_END (OFF_BAR + 4096)
#define OFF_YGELU OFF_X1
#define OFF_RWW OFF_X1
#define OFF_RWK (OFF_X1 + (size_t)NTOK * 512 * 4)
#define OFF_RWKK OFF_R4
#define OFF_RWA (OFF_R4 + (size_t)NTOK * 512 * 4)

typedef short bf16x8 __attribute__((ext_vector_type(8)));
typedef float f32x16 __attribute__((ext_vector_type(16)));

#ifdef CPU_EMU
#define WAVE_SYNC() emu_wave_bar()
#else
#define WAVE_SYNC() __builtin_amdgcn_wave_barrier()
#endif

DEV float sigmoidf_(float x) { return 1.f / (1.f + __expf(-x)); }
DEV float siluf_(float x) { return x * sigmoidf_(x); }
DEV float geluf_(float x) { float u = 0.7978845608028654f * (x + 0.044715f * x * x * x); return 0.5f * x * (1.f + tanhf(u)); }
DEV unsigned short f2bf(float f) {
  unsigned u = __builtin_bit_cast(unsigned, f);
  u += 0x7FFFu + ((u >> 16) & 1u);
  return (unsigned short)(u >> 16);
}
DEV float bf2f(unsigned short h) { return __builtin_bit_cast(float, ((unsigned)h) << 16); }
DEV float wave_sum(float v) {
#pragma unroll
  for (int m = 32; m >= 1; m >>= 1) v += __shfl_xor(v, m);
  return v;
}
DEV float wave_max(float v) {
#pragma unroll
  for (int m = 32; m >= 1; m >>= 1) v = fmaxf(v, __shfl_xor(v, m));
  return v;
}
DEV float4 ld4(const float* p) { return *(const float4*)p; }
DEV void fast_sincos(float x, float* sn, float* cs) {
  const float k = rintf(x * 0.15915494309189535f);
  float r = fmaf(-k, 6.28125f, x);
  r = fmaf(-k, 1.9353071795864769e-3f, r);
  *sn = __sinf(r); *cs = __cosf(r);
}
DEV void st4(float* p, float4 v) { *(float4*)p = v; }

#define GEMM_BM 256
#define GEMM_MI (GEMM_BM / 64)
#define GEMM_SMEM_BYTES ((GEMM_BM + 128) * 72 * 2)
#ifdef CPU_EMU
DEV unsigned pk2(float a, float b) { return (unsigned)f2bf(a) | ((unsigned)f2bf(b) << 16); }
#else
typedef __bf16 hbf16x2 __attribute__((ext_vector_type(2)));
typedef float hf32x2 __attribute__((ext_vector_type(2)));
DEV unsigned pk2(float a, float b) {
  hf32x2 f = {a, b};
  return __builtin_bit_cast(unsigned, __builtin_convertvector(f, hbf16x2));
}
#endif
template <bool ABF, class AROW, class BPTR, class EPI>
DEV void gemm_tile(AROW arow, BPTR bptr, int ldb, int K, EPI epi, char* smem_raw) {
  unsigned short(*sA)[72] = (unsigned short(*)[72])smem_raw;
  unsigned short(*sB)[72] = (unsigned short(*)[72])(smem_raw + GEMM_BM * 72 * 2);
  const int tid = threadIdx.x, lane = tid & 63, wave = tid >> 6;
  const int wm = wave >> 1, wn = wave & 1;
#if defined(CPU_EMU) && !defined(EMU_REAL_GEMM)
  for (int mi = 0; mi < GEMM_MI; ++mi)
    for (int r = 0; r < 16; ++r) {
      const int row = wm * (GEMM_BM / 2) + mi * 32 + (r & 3) + 8 * (r >> 2) + 4 * (lane >> 5);
      const int col = wn * 64 + (lane & 31);
      const void* arp = arow(row);
      float v[2] = {0.f, 0.f};
      for (int ni = 0; ni < 2; ++ni) {
        const int cc = col + ni * 32;
        const float* bq = bptr(cc & ~3);
        if (!arp || !bq) continue;
        bq += cc & 3;
        float a = 0.f;
        for (int k = 0; k < K; ++k) {
          const float av = ABF ? bf2f(((const unsigned short*)arp)[k]) : bf2f(f2bf(((const float*)arp)[k]));
          a += av * bf2f(f2bf(bq[(size_t)k * ldb]));
        }
        v[ni] = a;
      }
      epi(row, col, v[0], v[1]);
    }
  return;
#endif
  const float* ap[4 * GEMM_MI];
  const unsigned short* aph[2 * GEMM_MI];
  if (ABF) {
#pragma unroll
    for (int i = 0; i < 2 * GEMM_MI; ++i) aph[i] = (const unsigned short*)arow((tid >> 3) + 32 * i);
  } else {
#pragma unroll
    for (int i = 0; i < 4 * GEMM_MI; ++i) ap[i] = (const float*)arow((tid >> 4) + 16 * i);
  }
  const float* bp = bptr((tid & 31) * 4);
  const int kgrp = tid >> 5;
  float4 ra[4 * GEMM_MI];
  uint4 rah[2 * GEMM_MI];
  float4 rb[8];
  auto gload = [&](int k0) {
    if (ABF) {
#pragma unroll
      for (int i = 0; i < 2 * GEMM_MI; ++i) rah[i] = aph[i] ? *(const uint4*)(aph[i] + k0 + (tid & 7) * 8) : make_uint4(0, 0, 0, 0);
    } else {
#pragma unroll
      for (int i = 0; i < 4 * GEMM_MI; ++i) ra[i] = ap[i] ? ld4(ap[i] + k0 + (tid & 15) * 4) : make_float4(0.f, 0.f, 0.f, 0.f);
    }
#pragma unroll
    for (int j = 0; j < 8; ++j) rb[j] = bp ? ld4(bp + (size_t)(k0 + kgrp * 8 + j) * ldb) : make_float4(0.f, 0.f, 0.f, 0.f);
  };
  auto sstore = [&]() {
    if (ABF) {
#pragma unroll
      for (int i = 0; i < 2 * GEMM_MI; ++i) *(uint4*)&sA[(tid >> 3) + 32 * i][(tid & 7) * 8] = rah[i];
    } else {
#pragma unroll
      for (int i = 0; i < 4 * GEMM_MI; ++i) *(uint2*)&sA[(tid >> 4) + 16 * i][(tid & 15) * 4] = make_uint2(pk2(ra[i].x, ra[i].y), pk2(ra[i].z, ra[i].w));
    }
    const int nb = (tid & 31) * 4;
    *(uint4*)&sB[nb + 0][kgrp * 8] = make_uint4(pk2(rb[0].x, rb[1].x), pk2(rb[2].x, rb[3].x), pk2(rb[4].x, rb[5].x), pk2(rb[6].x, rb[7].x));
    *(uint4*)&sB[nb + 1][kgrp * 8] = make_uint4(pk2(rb[0].y, rb[1].y), pk2(rb[2].y, rb[3].y), pk2(rb[4].y, rb[5].y), pk2(rb[6].y, rb[7].y));
    *(uint4*)&sB[nb + 2][kgrp * 8] = make_uint4(pk2(rb[0].z, rb[1].z), pk2(rb[2].z, rb[3].z), pk2(rb[4].z, rb[5].z), pk2(rb[6].z, rb[7].z));
    *(uint4*)&sB[nb + 3][kgrp * 8] = make_uint4(pk2(rb[0].w, rb[1].w), pk2(rb[2].w, rb[3].w), pk2(rb[4].w, rb[5].w), pk2(rb[6].w, rb[7].w));
  };
  f32x16 acc[GEMM_MI][2];
#pragma unroll
  for (int mi = 0; mi < GEMM_MI; ++mi)
#pragma unroll
    for (int ni = 0; ni < 2; ++ni)
#pragma unroll
      for (int r = 0; r < 16; ++r) acc[mi][ni][r] = 0.f;
  gload(0);
  for (int k0 = 0; k0 < K; k0 += 64) {
    __syncthreads();
    sstore();
    __syncthreads();
    if (k0 + 64 < K) gload(k0 + 64);
#pragma unroll
    for (int ks = 0; ks < 4; ++ks) {
      bf16x8 af[GEMM_MI], bfr[2];
#pragma unroll
      for (int mi = 0; mi < GEMM_MI; ++mi) af[mi] = *(const bf16x8*)&sA[wm * (GEMM_BM / 2) + mi * 32 + (lane & 31)][ks * 16 + (lane >> 5) * 8];
#pragma unroll
      for (int ni = 0; ni < 2; ++ni) bfr[ni] = *(const bf16x8*)&sB[wn * 64 + ni * 32 + (lane & 31)][ks * 16 + (lane >> 5) * 8];
#pragma unroll
      for (int mi = 0; mi < GEMM_MI; ++mi)
#pragma unroll
        for (int ni = 0; ni < 2; ++ni) acc[mi][ni] = __builtin_amdgcn_mfma_f32_32x32x16_bf16(af[mi], bfr[ni], acc[mi][ni], 0, 0, 0);
    }
  }
#pragma unroll
  for (int mi = 0; mi < GEMM_MI; ++mi)
#pragma unroll
    for (int r = 0; r < 16; ++r) {
      int row = wm * (GEMM_BM / 2) + mi * 32 + (r & 3) + 8 * (r >> 2) + 4 * (lane >> 5);
      int col = wn * 64 + (lane & 31);
      epi(row, col, acc[mi][0][r], acc[mi][1][r]);
    }
}

template <int LAYER>
DEV void phase_gemm_in(const Params& p, char* smem) {
  const int N = LAYER == 0 ? AB_IN : CD_IN;
  const float* A = LAYER == 0 ? p.in[I_X] : (const float*)(p.ws + OFF_X2);
  const float* B = LAYER == 0 ? p.in[I_AB_W_IN] : p.in[I_CD_W_IN];
  float* C = (float*)(p.ws + OFF_H);
  const int NT = (N + 127) / 128, MT = NTOK / GEMM_BM;
  const int xcd_ = blockIdx.x & 7, lb_ = blockIdx.x >> 3, nb_ = gridDim.x >> 3;
  for (int j_ = lb_; j_ < (MT / 8) * NT; j_ += nb_) {
    const int it = (xcd_ + 8 * (j_ / NT)) * NT + (j_ % NT);
    const int tm = it / NT, tn = it % NT;
    const int m0 = tm * GEMM_BM, n0 = tn * 128;
    gemm_tile<false>(
        [&](int r) { return (const void*)(A + (size_t)(m0 + r) * DM); },
        [&](int c) { return (n0 + c < N) ? (B + n0 + c) : (const float*)nullptr; }, N, DM,
        [&](int row, int col, float v0, float v1) {
          const int gm = m0 + row, gc = n0 + col;
          if (LAYER == 1 && gc >= 1792 && gc < 2304) {
            const int i = gc & 63;
            const float pos = (float)(gm % SEQ_LEN);
            const float inv = __expf(-(float)i * (9.210340371976184f / 32.f));
            float sn, cs;
            fast_sincos(pos * inv, &sn, &cs);
            float o0 = v0 * cs - v1 * sn, o1 = v1 * cs + v0 * sn;
            if (gc >= 2048) { o0 *= 0.125f; o1 *= 0.125f; }
            v0 = o0; v1 = o1;
          }
          if (gc < N) C[(size_t)gm * N + gc] = v0;
          if (gc + 32 < N) C[(size_t)gm * N + gc + 32] = v1;
        },
        smem);
  }
}

struct S5Const { float lb_re, lb_im; };
DEV void s5_consts(const Params& p, int g, int pp, float& lb_re, float& lb_im, float (&bbr)[16], float (&bbi)[16]) {
  const float dt = expf(p.in[I_S5_LOG_DT][g]);
  const float lr = p.in[I_S5_LAM_RE][g * 64 + pp], li = p.in[I_S5_LAM_IM][g * 64 + pp];
  const float mag = expf(lr * dt);
  float sn, cs;
  sincosf(li * dt, &sn, &cs);
  lb_re = mag * cs; lb_im = mag * sn;
  const float den = lr * lr + li * li;
  const float f_re = ((lb_re - 1.f) * lr + lb_im * li) / den;
  const float f_im = (lb_im * lr - (lb_re - 1.f) * li) / den;
  const float* br = p.in[I_S5_B_RE] + (size_t)(g * 64 + pp) * 16;
  const float* bi = p.in[I_S5_B_IM] + (size_t)(g * 64 + pp) * 16;
#pragma unroll
  for (int h = 0; h < 16; ++h) {
    bbr[h] = f_re * br[h] - f_im * bi[h];
    bbi[h] = f_re * bi[h] + f_im * br[h];
  }
}

#define OFF_QB OFF_X2
#define OFF_KSB (OFF_QB + (size_t)NTOK * 512 * 2)
#define OFF_KWB (OFF_KSB + (size_t)NTOK * 128 * 2)
#define OFF_VST (OFF_KWB + (size_t)NTOK * 128 * 2)
#define OFF_VWT (OFF_VST + (size_t)NTOK * 128 * 2)
#define OFF_KCB (OFF_VWT + (size_t)NTOK * 128 * 2)
#define OFF_VCT (OFF_KCB + (size_t)BATCH * 2 * NB_CMP * 64 * 64 * 2)
#define NSA_QSCALE (0.125f * 1.4426950408889634f)

#define P1_S5A_ITEMS (BATCH * 32 * S5_NC / 4)
#define P1_CMP_TILES ((NCMP + 7) / 8)
#define P1_CMP_ITEMS (2 * BATCH * 2 * P1_CMP_TILES)
DEV void p1_s5a(const Params& p, int item, char* smem) {
  const int lane = threadIdx.x & 63, wave = threadIdx.x >> 6;
  const int idx = item * 4 + wave;
  const int g = idx & 31, c = (idx >> 5) % S5_NC, b = idx / (32 * S5_NC);
  float lb_re, lb_im, bbr[16], bbi[16];
  s5_consts(p, g, lane, lb_re, lb_im, bbr, bbi);
  const float* H = (const float*)(p.ws + OFF_H);
  float sr = 0.f, si = 0.f;
  float* su = (float*)smem + wave * 64 * 16;
  __syncthreads();
  {
    const float* ur = H + (size_t)(b * SEQ_LEN + c * 64 + lane) * AB_IN + g * 16;
#pragma unroll
    for (int q = 0; q < 4; ++q) st4(su + lane * 16 + q * 4, ld4(ur + q * 4));
  }
  WAVE_SYNC();
  for (int tt = 0; tt < 64; ++tt) {
    const float* u = su + tt * 16;
    float dr = 0.f, di = 0.f;
#pragma unroll
    for (int h4 = 0; h4 < 4; ++h4) {
      const float4 uv = ld4(u + h4 * 4);
      dr += uv.x * bbr[h4 * 4] + uv.y * bbr[h4 * 4 + 1] + uv.z * bbr[h4 * 4 + 2] + uv.w * bbr[h4 * 4 + 3];
      di += uv.x * bbi[h4 * 4] + uv.y * bbi[h4 * 4 + 1] + uv.z * bbi[h4 * 4 + 2] + uv.w * bbi[h4 * 4 + 3];
    }
    const float nr = lb_re * sr - lb_im * si + dr;
    const float ni = lb_re * si + lb_im * sr + di;
    sr = nr; si = ni;
  }
  float2* E = (float2*)(p.ws + OFF_S5E);
  E[((size_t)(b * S5_NC + c) * 32 + g) * 64 + lane] = make_float2(sr, si);
}
DEV void p1_compress(const Params& p, int item, char* smem) {
  const int tile = item % P1_CMP_TILES;
  int r = item / P1_CMP_TILES;
  const int g = r & 1; r >>= 1;
  const int b = r % BATCH; const int which = r / BATCH;
  const int n0 = tile * 8;
  const float* H = (const float*)(p.ws + OFF_H);
  const float* pe = which ? p.in[I_PE_V] : p.in[I_PE_K];
  const float* w1 = which ? p.in[I_CV_W1] : p.in[I_CK_W1];
  const float* b1 = which ? p.in[I_CV_B1] : p.in[I_CK_B1];
  const float* w2 = which ? p.in[I_CV_W2] : p.in[I_CK_W2];
  const int colbase = (which ? 1152 : 1024) + g * 64;
  float* sTok = (float*)smem;
  float* sPart = sTok + 144 * 64;
  float* sHid = sPart + 2 * 8 * 128;
  const int tid = threadIdx.x;
  __syncthreads();
  for (int w = tid; w < 144 * 16; w += NTHREADS) {
    const int tr = w >> 4, c4 = (w & 15) * 4;
    int tok = n0 * 16 + tr; if (tok > SEQ_LEN - 1) tok = SEQ_LEN - 1;
    st4(sTok + tr * 64 + c4, ld4(H + (size_t)(b * SEQ_LEN + tok) * AB_IN + colbase + c4));
  }
  __syncthreads();
  {
    const int hid = tid & 127, kh = tid >> 7;
    float acc[8];
#pragma unroll
    for (int rr = 0; rr < 8; ++rr) acc[rr] = 0.f;
    for (int k = kh * 1024; k < kh * 1024 + 1024; ++k) {
      const float w = w1[(size_t)k * 128 + hid];
      const int j = k >> 6, d = k & 63;
      const float pv = pe[j * 64 + d];
#pragma unroll
      for (int rr = 0; rr < 8; ++rr) acc[rr] += (sTok[(rr * 16 + j) * 64 + d] + pv) * w;
    }
#pragma unroll
    for (int rr = 0; rr < 8; ++rr) sPart[(kh * 8 + rr) * 128 + hid] = acc[rr];
  }
  __syncthreads();
  for (int w = tid; w < 8 * 128; w += NTHREADS) {
    const int rr = w >> 7, hid = w & 127;
    sHid[w] = geluf_(sPart[rr * 128 + hid] + sPart[(8 + rr) * 128 + hid] + b1[hid]);
  }
  __syncthreads();
  float* sOut = sPart;
  for (int w = tid; w < 8 * 64; w += NTHREADS) {
    const int rr = w >> 6, d = w & 63;
    float a = 0.f;
    for (int hid = 0; hid < 128; ++hid) a += sHid[rr * 128 + hid] * w2[hid * 64 + d];
    sOut[w] = a;
  }
  __syncthreads();
  float* dst = (float*)(p.ws + (which ? OFF_VCMP : OFF_KCMP));
  for (int w = tid; w < 8 * 64; w += NTHREADS) {
    const int rr = w >> 6, d = w & 63;
    const int n = n0 + rr;
    if (n >= NCMP) continue;
    float v = sOut[w];
    if (which == 0 && d < 16) {
      const int i = d & 7;
      const float pos = (float)(n * 16 + 31);
      const float inv = __expf(-(float)i * (13.122363377404328f / 8.f));
      float sn, cs;
      sincosf(pos * inv, &sn, &cs);
      const float x1 = sOut[rr * 64 + i], x2 = sOut[rr * 64 + i + 8];
      v = d < 8 ? x1 * cs - x2 * sn : x2 * cs + x1 * sn;
    }
    dst[((size_t)(b * NCMP + n) * 2 + g) * 64 + d] = v;
    if (which == 0) ((unsigned short*)(p.ws + OFF_KCB))[(((size_t)b * 2 + g) * NB_CMP * 64 + n) * 64 + d] = f2bf(v);
    else ((unsigned short*)(p.ws + OFF_VCT))[((((size_t)b * 2 + g) * NB_CMP + (n >> 6)) * 64 + d) * 64 + (n & 63)] = f2bf(v);
  }
  for (int w = tid; w < 8 * 64; w += NTHREADS) {
    const int rr = w >> 6, d = w & 63;
    const int n = n0 + rr;
    if (n < NCMP || n >= NB_CMP * 64) continue;
    if (which == 0) ((unsigned short*)(p.ws + OFF_KCB))[(((size_t)b * 2 + g) * NB_CMP * 64 + n) * 64 + d] = 0;
    else ((unsigned short*)(p.ws + OFF_VCT))[((((size_t)b * 2 + g) * NB_CMP + (n >> 6)) * 64 + d) * 64 + (n & 63)] = 0;
  }
}
DEV uint4 pack8(const float* v) {
  uint4 r;
  r.x = (unsigned)f2bf(v[0]) | ((unsigned)f2bf(v[1]) << 16);
  r.y = (unsigned)f2bf(v[2]) | ((unsigned)f2bf(v[3]) << 16);
  r.z = (unsigned)f2bf(v[4]) | ((unsigned)f2bf(v[5]) << 16);
  r.w = (unsigned)f2bf(v[6]) | ((unsigned)f2bf(v[7]) << 16);
  return r;
}
#define P1_PREP_ITEMS (NTOK / 64)
#define P1_PREP_SMEM ((64 * 8 * 2 + 64 * 128) * 4)
DEV void p1_prep(const Params& p, int item, char* smem) {
  const int tid = threadIdx.x;
  const int b = item / NBLK, blk = item % NBLK;
  const float* H = (const float*)(p.ws + OFF_H);
  float* sCS = (float*)smem;
  float* sV = sCS + 64 * 8 * 2;
  const size_t tok0 = (size_t)b * SEQ_LEN + blk * 64;
  __syncthreads();
  for (int w = tid; w < 64 * 8; w += NTHREADS) {
    const int tk = w >> 3, i = w & 7;
    const float pos = (float)(blk * 64 + tk);
    const float inv = __expf(-(float)i * (13.122363377404328f / 8.f));
    float sn, cs;
    sincosf(pos * inv, &sn, &cs);
    sCS[w * 2] = cs; sCS[w * 2 + 1] = sn;
  }
  __syncthreads();
  unsigned short* QB = (unsigned short*)(p.ws + OFF_QB);
  unsigned short* KSB = (unsigned short*)(p.ws + OFF_KSB);
  unsigned short* KWB = (unsigned short*)(p.ws + OFF_KWB);
  for (int w = tid; w < 64 * 12 * 8; w += NTHREADS) {
    const int o = w & 7, hd = (w >> 3) % 12, tk = w / 96;
    const int col = hd < 8 ? 512 + hd * 64 : (hd < 10 ? 1280 + (hd - 8) * 64 : 1536 + (hd - 10) * 64);
    const float* x = H + (tok0 + tk) * AB_IN + col;
    float v[8];
    const float4 a0 = ld4(x + o * 8), a1 = ld4(x + o * 8 + 4);
    v[0] = a0.x; v[1] = a0.y; v[2] = a0.z; v[3] = a0.w; v[4] = a1.x; v[5] = a1.y; v[6] = a1.z; v[7] = a1.w;
    if (o < 2) {
      const float4 c0 = ld4(x + (1 - o) * 8), c1 = ld4(x + (1 - o) * 8 + 4);
      const float u[8] = {c0.x, c0.y, c0.z, c0.w, c1.x, c1.y, c1.z, c1.w};
#pragma unroll
      for (int i = 0; i < 8; ++i) {
        const float cs = sCS[(tk * 8 + i) * 2], sn = sCS[(tk * 8 + i) * 2 + 1];
        v[i] = o == 0 ? v[i] * cs - u[i] * sn : v[i] * cs + u[i] * sn;
      }
    }
    if (hd < 8) {
#pragma unroll
      for (int i = 0; i < 8; ++i) v[i] *= NSA_QSCALE;
      *(uint4*)(QB + ((tok0 + tk) * 8 + hd) * 64 + o * 8) = pack8(v);
    } else {
      const int g = (hd - 8) & 1;
      unsigned short* dst = (hd < 10 ? KSB : KWB) + (((size_t)b * 2 + g) * SEQ_LEN + blk * 64 + tk) * 64 + o * 8;
      *(uint4*)dst = pack8(v);
    }
  }
#pragma unroll 1
  for (int which = 0; which < 2; ++which) {
    const int col = which ? 1664 : 1408;
    __syncthreads();
    for (int w = tid; w < 64 * 32; w += NTHREADS) {
      const int tk = w >> 5, c4 = (w & 31) * 4;
      st4(sV + tk * 128 + c4, ld4(H + (tok0 + tk) * AB_IN + col + c4));
    }
    __syncthreads();
    unsigned short* VT = (unsigned short*)(p.ws + (which ? OFF_VWT : OFF_VST));
    for (int w = tid; w < 2 * 64 * 8; w += NTHREADS) {
      const int ko = w & 7, d = (w >> 3) & 63, g = w >> 9;
      float v[8];
#pragma unroll
      for (int i = 0; i < 8; ++i) v[i] = sV[(ko * 8 + i) * 128 + g * 64 + d];
      *(uint4*)(VT + ((((size_t)b * 2 + g) * NBLK + blk) * 64 + d) * 64 + ko * 8) = pack8(v);
    }
  }
}

struct NsaSmem {
  unsigned short k[64][72];
  unsigned short vt[64][68];
  float imp[32][128];
  unsigned selmask[32][4];
  unsigned unionm[4];
  float keyb[4][128];
};
#define P2_NSA_SMEM ((int)sizeof(NsaSmem))
#define NSA_QT (SEQ_LEN / 32)
#define P2_NSA_ITEMS (BATCH * 2 * NSA_QT)

struct TileRegs { uint4 k0, k1, v0, v1; };
DEV void tile_gload(TileRegs& r, const unsigned short* Kg, const unsigned short* Vg, int tid) {
  const int row = tid >> 2, seg = tid & 3;
  r.k0 = *(const uint4*)(Kg + row * 64 + seg * 16);
  r.k1 = *(const uint4*)(Kg + row * 64 + seg * 16 + 8);
  if (Vg) {
    r.v0 = *(const uint4*)(Vg + row * 64 + seg * 16);
    r.v1 = *(const uint4*)(Vg + row * 64 + seg * 16 + 8);
  }
}
DEV void tile_sstore(NsaSmem* sm, const TileRegs& r, bool withV, int tid) {
  const int row = tid >> 2, seg = tid & 3;
  *(uint4*)&sm->k[row][seg * 16] = r.k0;
  *(uint4*)&sm->k[row][seg * 16 + 8] = r.k1;
  if (withV) {
    *(uint2*)&sm->vt[row][seg * 16] = make_uint2(r.v0.x, r.v0.y);
    *(uint2*)&sm->vt[row][seg * 16 + 4] = make_uint2(r.v0.z, r.v0.w);
    *(uint2*)&sm->vt[row][seg * 16 + 8] = make_uint2(r.v1.x, r.v1.y);
    *(uint2*)&sm->vt[row][seg * 16 + 12] = make_uint2(r.v1.z, r.v1.w);
  }
}
DEV void qk_tile(const NsaSmem* sm, const bf16x8 (&qf)[4], f32x16 (&s)[2], int lane) {
  const int r = lane & 31, hh = lane >> 5;
#pragma unroll
  for (int ks2 = 0; ks2 < 2; ++ks2) {
#pragma unroll
    for (int i = 0; i < 16; ++i) s[ks2][i] = 0.f;
#pragma unroll
    for (int ks = 0; ks < 4; ++ks) {
      const bf16x8 a = *(const bf16x8*)&sm->k[ks2 * 32 + r][ks * 16 + hh * 8];
      s[ks2] = __builtin_amdgcn_mfma_f32_32x32x16_bf16(a, qf[ks], s[ks2], 0, 0, 0);
    }
  }
}
DEV void pv_tile(const NsaSmem* sm, const f32x16 (&pr)[2], f32x16 (&o)[2], int lane) {
  const int r = lane & 31, hh = lane >> 5;
#pragma unroll
  for (int ks2 = 0; ks2 < 2; ++ks2)
#pragma unroll
    for (int s = 0; s < 2; ++s) {
      bf16x8 pf;
#pragma unroll
      for (int j = 0; j < 8; ++j) pf[j] = (short)f2bf(pr[ks2][8 * s + j]);
#pragma unroll
      for (int mt = 0; mt < 2; ++mt) {
        const uint2 lo = *(const uint2*)&sm->vt[mt * 32 + r][ks2 * 32 + 16 * s + 4 * hh];
        const uint2 hi = *(const uint2*)&sm->vt[mt * 32 + r][ks2 * 32 + 16 * s + 8 + 4 * hh];
        bf16x8 a;
        a[0] = (short)(lo.x & 0xFFFF); a[1] = (short)(lo.x >> 16); a[2] = (short)(lo.y & 0xFFFF); a[3] = (short)(lo.y >> 16);
        a[4] = (short)(hi.x & 0xFFFF); a[5] = (short)(hi.x >> 16); a[6] = (short)(hi.y & 0xFFFF); a[7] = (short)(hi.y >> 16);
        o[mt] = __builtin_amdgcn_mfma_f32_32x32x16_bf16(a, pf, o[mt], 0, 0, 0);
      }
    }
}
DEV float quad_sum(float v) {
#ifdef CPU_EMU
  v += __shfl_xor(v, 1); v += __shfl_xor(v, 2); return v;
#else
  int x;
  x = __builtin_amdgcn_update_dpp(0, __builtin_bit_cast(int, v), 0xB1, 0xF, 0xF, false); v += __builtin_bit_cast(float, x);
  x = __builtin_amdgcn_update_dpp(0, __builtin_bit_cast(int, v), 0x4E, 0xF, 0xF, false); v += __builtin_bit_cast(float, x);
  return v;
#endif
}
DEV void softmax_step(f32x16 (&s)[2], float& m, float& l, f32x16 (&o)[2]) {
  float tmax = -INFINITY;
#pragma unroll
  for (int ks2 = 0; ks2 < 2; ++ks2)
#pragma unroll
    for (int i = 0; i < 16; ++i) tmax = fmaxf(tmax, s[ks2][i]);
  tmax = fmaxf(tmax, __shfl_xor(tmax, 32));
  const float mnew = fmaxf(m, tmax);
  const float msafe = mnew == -INFINITY ? 0.f : mnew;
  const float alpha = exp2f(m - msafe);
  float ps = 0.f;
#pragma unroll
  for (int ks2 = 0; ks2 < 2; ++ks2)
#pragma unroll
    for (int i = 0; i < 16; ++i) { s[ks2][i] = exp2f(s[ks2][i] - msafe); ps += s[ks2][i]; }
  l = l * alpha + ps;
#pragma unroll
  for (int mt = 0; mt < 2; ++mt)
#pragma unroll
    for (int i = 0; i < 16; ++i) o[mt][i] *= alpha;
  m = mnew;
}
DEV bool testbit4(unsigned w0, unsigned w1, unsigned w2, unsigned w3, int j) {
  const unsigned lo = j & 32 ? w1 : w0, hi = j & 32 ? w3 : w2;
  const unsigned x = j & 64 ? hi : lo;
  return (x >> (j & 31)) & 1u;
}

DEV void p2_nsa(const Params& p, int item, char* smem) {
  NsaSmem* sm = (NsaSmem*)smem;
  const int tid = threadIdx.x, lane = tid & 63, wave = tid >> 6;
  const int bg = item & 3, b = bg >> 1, g = bg & 1;
  const int qt = NSA_QT - 1 - (item >> 2);
  const int t0 = qt * 32;
  const int c = lane & 31, hh = lane >> 5, tl = c >> 2, h = c & 3;
  const int trow = wave * 8 + tl;
  const int tq = t0 + trow;
  const size_t tok = (size_t)b * SEQ_LEN + tq;
  const int hd = g * 4 + h;
  const float* H = (const float*)(p.ws + OFF_H);
  const unsigned short* QB = (const unsigned short*)(p.ws + OFF_QB);
  const unsigned short* KSB = (const unsigned short*)(p.ws + OFF_KSB) + ((size_t)b * 2 + g) * SEQ_LEN * 64;
  const unsigned short* KWB = (const unsigned short*)(p.ws + OFF_KWB) + ((size_t)b * 2 + g) * SEQ_LEN * 64;
  const unsigned short* VST = (const unsigned short*)(p.ws + OFF_VST) + ((size_t)b * 2 + g) * NBLK * 4096;
  const unsigned short* VWT = (const unsigned short*)(p.ws + OFF_VWT) + ((size_t)b * 2 + g) * NBLK * 4096;
  const unsigned short* KCB = (const unsigned short*)(p.ws + OFF_KCB) + ((size_t)b * 2 + g) * NB_CMP * 4096;
  const unsigned short* VCT = (const unsigned short*)(p.ws + OFF_VCT) + ((size_t)b * 2 + g) * NB_CMP * 4096;
  bf16x8 qf[4];
  {
    const unsigned short* qrow = QB + (tok * 8 + hd) * 64;
#pragma unroll
    for (int ks = 0; ks < 4; ++ks) qf[ks] = *(const bf16x8*)(qrow + ks * 16 + hh * 8);
  }
  const float g0 = sigmoidf_(H[tok * AB_IN + 1792 + hd * 3 + 0]);
  const float g1 = sigmoidf_(H[tok * AB_IN + 1792 + hd * 3 + 1]);
  const float g2 = sigmoidf_(H[tok * AB_IN + 1792 + hd * 3 + 2]);
  f32x16 o[2], s[2];
#pragma unroll
  for (int mt = 0; mt < 2; ++mt)
#pragma unroll
    for (int i = 0; i < 16; ++i) o[mt][i] = 0.f;
  float* mixrow = (float*)(p.ws + OFF_MIX) + tok * 1024 + 512 + hd * 64 + 4 * hh;
  __syncthreads();
  for (int w = tid; w < 32 * 128; w += NTHREADS) (&sm->imp[0][0])[w] = 0.f;
  TileRegs tr;
  tr.k0 = tr.k1 = tr.v0 = tr.v1 = make_uint4(0, 0, 0, 0);
  const int nval = tq >= 31 ? (tq - 31) / 16 + 1 : 0;
  const int nvmax = (t0 + 31 - 31) / 16 + 1;
  const int ktn = (nvmax + 63) / 64;
  float m = -INFINITY, l = 0.f;
  tile_gload(tr, KCB, nullptr, tid);
  for (int kt = 0; kt < ktn; ++kt) {
    __syncthreads();
    tile_sstore(sm, tr, false, tid);
    __syncthreads();
    if (kt + 1 < ktn) tile_gload(tr, KCB + (size_t)(kt + 1) * 4096, nullptr, tid);
    qk_tile(sm, qf, s, lane);
    float tmax = -INFINITY;
#pragma unroll
    for (int ks2 = 0; ks2 < 2; ++ks2)
#pragma unroll
      for (int i = 0; i < 16; ++i) {
        const int n = kt * 64 + ks2 * 32 + (i & 3) + 8 * (i >> 2) + 4 * hh;
        s[ks2][i] = n < nval ? s[ks2][i] : -INFINITY;
        tmax = fmaxf(tmax, s[ks2][i]);
      }
    tmax = fmaxf(tmax, __shfl_xor(tmax, 32));
    const float mnew = fmaxf(m, tmax);
    const float msafe = mnew == -INFINITY ? 0.f : mnew;
    float ps = 0.f;
#pragma unroll
    for (int ks2 = 0; ks2 < 2; ++ks2)
#pragma unroll
      for (int i = 0; i < 16; ++i) ps += exp2f(s[ks2][i] - msafe);
    l = l * exp2f(m - msafe) + ps;
    m = mnew;
  }
  {
    const float ltot = l + __shfl_xor(l, 32);
    const float invl = ltot > 0.f ? 1.f / ltot : 0.f;
    const float msafe = m == -INFINITY ? 0.f : m;
    tile_gload(tr, KCB, VCT, tid);
    for (int kt = 0; kt < ktn; ++kt) {
      __syncthreads();
      tile_sstore(sm, tr, true, tid);
      __syncthreads();
      if (kt + 1 < ktn) tile_gload(tr, KCB + (size_t)(kt + 1) * 4096, VCT + (size_t)(kt + 1) * 4096, tid);
      qk_tile(sm, qf, s, lane);
#pragma unroll
      for (int ks2 = 0; ks2 < 2; ++ks2)
#pragma unroll
        for (int i = 0; i < 16; ++i) {
          const int n = kt * 64 + ks2 * 32 + (i & 3) + 8 * (i >> 2) + 4 * hh;
          s[ks2][i] = n < nval ? exp2f(s[ks2][i] - msafe) * invl : 0.f;
        }
#pragma unroll
      for (int ks2 = 0; ks2 < 2; ++ks2)
#pragma unroll
        for (int g4 = 0; g4 < 4; ++g4) {
          float A = 2.f * (s[ks2][4 * g4] + s[ks2][4 * g4 + 1] + s[ks2][4 * g4 + 2]) + s[ks2][4 * g4 + 3];
          float Bv = s[ks2][4 * g4 + 3];
          A = quad_sum(A); Bv = quad_sum(Bv);
          const int j = kt * 16 + ks2 * 8 + 2 * g4 + hh;
          if (h == 0 && j < NBLK) sm->imp[trow][j] += A;
          WAVE_SYNC();
          if (h == 0 && j + 1 < NBLK) sm->imp[trow][j + 1] += Bv;
          WAVE_SYNC();
        }
      pv_tile(sm, s, o, lane);
    }
#pragma unroll
    for (int mt = 0; mt < 2; ++mt)
#pragma unroll
      for (int g4 = 0; g4 < 4; ++g4) {
        st4(mixrow + mt * 32 + 8 * g4, make_float4(o[mt][4 * g4] * g0, o[mt][4 * g4 + 1] * g0, o[mt][4 * g4 + 2] * g0, o[mt][4 * g4 + 3] * g0));
        o[mt][4 * g4] = 0.f; o[mt][4 * g4 + 1] = 0.f; o[mt][4 * g4 + 2] = 0.f; o[mt][4 * g4 + 3] = 0.f;
      }
  }
  WAVE_SYNC();
  for (int t8 = 0; t8 < 8; ++t8) {
    const int row = wave * 8 + t8, tt = t0 + row, cur = tt >> 6;
    float kv[2]; bool valid[2];
#pragma unroll
    for (int c2 = 0; c2 < 2; ++c2) {
      const int j = lane + 64 * c2;
      valid[c2] = j < NBLK && j <= cur;
      const bool forced = (j == 0) | (j == cur) | (j == cur - 1);
      kv[c2] = valid[c2] ? (forced ? 1e6f : sm->imp[row][j < NBLK ? j : 0]) : -1.f;
      sm->keyb[wave][j] = kv[c2];
    }
    WAVE_SYNC();
    int rank0 = 0, rank1 = 0;
    const int jlim = cur < NBLK - 1 ? cur : NBLK - 1;
    for (int jj = 0; jj <= jlim; ++jj) {
      const float ov = sm->keyb[wave][jj];
      rank0 += (ov > kv[0] || (ov == kv[0] && jj < lane)) ? 1 : 0;
      rank1 += (ov > kv[1] || (ov == kv[1] && jj < lane + 64)) ? 1 : 0;
    }
    const unsigned long long m0 = __ballot(valid[0] && rank0 < 16);
    const unsigned long long m1 = __ballot(valid[1] && rank1 < 16);
    if (lane == 0) {
      sm->selmask[row][0] = (unsigned)m0; sm->selmask[row][1] = (unsigned)(m0 >> 32);
      sm->selmask[row][2] = (unsigned)m1; sm->selmask[row][3] = (unsigned)(m1 >> 32);
    }
    WAVE_SYNC();
  }
  __syncthreads();
  if (tid < 4) {
    unsigned u = 0;
    for (int r = 0; r < 32; ++r) u |= sm->selmask[r][tid];
    sm->unionm[tid] = u;
  }
  __syncthreads();
  const unsigned um0 = sm->unionm[0], um1 = sm->unionm[1], um2 = sm->unionm[2], um3 = sm->unionm[3];
  const unsigned my0 = sm->selmask[trow][0], my1 = sm->selmask[trow][1], my2 = sm->selmask[trow][2], my3 = sm->selmask[trow][3];
  {
    const int jmax = (t0 + 31) >> 6;
    int j = 0;
    while (j <= jmax && !testbit4(um0, um1, um2, um3, j)) ++j;
    m = -INFINITY; l = 0.f;
    if (j <= jmax) tile_gload(tr, KSB + (size_t)j * 4096, VST + (size_t)j * 4096, tid);
    while (j <= jmax) {
      __syncthreads();
      tile_sstore(sm, tr, true, tid);
      __syncthreads();
      int jn = j + 1;
      while (jn <= jmax && !testbit4(um0, um1, um2, um3, jn)) ++jn;
      if (jn <= jmax) tile_gload(tr, KSB + (size_t)jn * 4096, VST + (size_t)jn * 4096, tid);
      const bool mine = testbit4(my0, my1, my2, my3, j);
      if (__ballot(mine) != 0ull) {
        qk_tile(sm, qf, s, lane);
#pragma unroll
        for (int ks2 = 0; ks2 < 2; ++ks2)
#pragma unroll
          for (int i = 0; i < 16; ++i) {
            const int kp = j * 64 + ks2 * 32 + (i & 3) + 8 * (i >> 2) + 4 * hh;
            s[ks2][i] = (mine && kp <= tq) ? s[ks2][i] : -INFINITY;
          }
        softmax_step(s, m, l, o);
        pv_tile(sm, s, o, lane);
      }
      j = jn;
    }
    const float ltot = l + __shfl_xor(l, 32);
    const float sc = ltot > 0.f ? g1 / ltot : 0.f;
#pragma unroll
    for (int mt = 0; mt < 2; ++mt)
#pragma unroll
      for (int g4 = 0; g4 < 4; ++g4) {
        float4 a = ld4(mixrow + mt * 32 + 8 * g4);
        a.x += o[mt][4 * g4] * sc; a.y += o[mt][4 * g4 + 1] * sc; a.z += o[mt][4 * g4 + 2] * sc; a.w += o[mt][4 * g4 + 3] * sc;
        st4(mixrow + mt * 32 + 8 * g4, a);
        o[mt][4 * g4] = 0.f; o[mt][4 * g4 + 1] = 0.f; o[mt][4 * g4 + 2] = 0.f; o[mt][4 * g4 + 3] = 0.f;
      }
  }
  {
    const int jlo = t0 - 511 > 0 ? (t0 - 511) >> 6 : 0, jhi = (t0 + 31) >> 6;
    const int wq0 = t0 + wave * 8;
    m = -INFINITY; l = 0.f;
    tile_gload(tr, KWB + (size_t)jlo * 4096, VWT + (size_t)jlo * 4096, tid);
    for (int j = jlo; j <= jhi; ++j) {
      __syncthreads();
      tile_sstore(sm, tr, true, tid);
      __syncthreads();
      if (j + 1 <= jhi) tile_gload(tr, KWB + (size_t)(j + 1) * 4096, VWT + (size_t)(j + 1) * 4096, tid);
      if (j * 64 <= wq0 + 7 && j * 64 + 63 > wq0 - 512) {
        qk_tile(sm, qf, s, lane);
#pragma unroll
        for (int ks2 = 0; ks2 < 2; ++ks2)
#pragma unroll
          for (int i = 0; i < 16; ++i) {
            const int kp = j * 64 + ks2 * 32 + (i & 3) + 8 * (i >> 2) + 4 * hh;
            s[ks2][i] = (kp <= tq && kp > tq - 512) ? s[ks2][i] : -INFINITY;
          }
        softmax_step(s, m, l, o);
        pv_tile(sm, s, o, lane);
      }
    }
    const float ltot = l + __shfl_xor(l, 32);
    const float sc = ltot > 0.f ? g2 / ltot : 0.f;
#pragma unroll
    for (int mt = 0; mt < 2; ++mt)
#pragma unroll
      for (int g4 = 0; g4 < 4; ++g4) {
        float4 a = ld4(mixrow + mt * 32 + 8 * g4);
        a.x += o[mt][4 * g4] * sc; a.y += o[mt][4 * g4 + 1] * sc; a.z += o[mt][4 * g4 + 2] * sc; a.w += o[mt][4 * g4 + 3] * sc;
        st4(mixrow + mt * 32 + 8 * g4, a);
        o[mt][4 * g4] = 0.f; o[mt][4 * g4 + 1] = 0.f; o[mt][4 * g4 + 2] = 0.f; o[mt][4 * g4 + 3] = 0.f;
      }
  }
}

#define P1_SMEM ((144 * 64 + 2 * 8 * 128 + 8 * 128) * 4)
DEV void phase_p1(const Params& p, char* smem) {
  const int total = P1_PREP_ITEMS + P1_S5A_ITEMS + P1_CMP_ITEMS;
  for (int it = blockIdx.x; it < total; it += gridDim.x) {
    if (it < P1_CMP_ITEMS) p1_compress(p, it, smem);
    else if (it < P1_CMP_ITEMS + P1_S5A_ITEMS) p1_s5a(p, it - P1_CMP_ITEMS, smem);
    else p1_prep(p, it - P1_CMP_ITEMS - P1_S5A_ITEMS, smem);
  }
}

#define P2_S5C_ITEMS (BATCH * 32 * S5_NC / 4)
#define S5C_ROW 132
#define P2_S5C_SMEM (4 * 16 * S5C_ROW * 4 + 4 * 64 * 16 * 4)
DEV void p2_s5c(const Params& p, int item, char* smem) {
  const int lane = threadIdx.x & 63, wave = threadIdx.x >> 6;
  const int idx = item * 4 + wave;
  const int g = idx & 31, c = (idx >> 5) % S5_NC, b = idx / (32 * S5_NC);
  float lb_re, lb_im, bbr[16], bbi[16];
  s5_consts(p, g, lane, lb_re, lb_im, bbr, bbi);
  float ar = lb_re, ai = lb_im;
#pragma unroll
  for (int s = 0; s < 6; ++s) { const float nr = ar * ar - ai * ai, ni = 2.f * ar * ai; ar = nr; ai = ni; }
  const float2* E = (const float2*)(p.ws + OFF_S5E);
  float sr = 0.f, si = 0.f;
  {
    int cc = 0;
    for (; cc + 8 <= c; cc += 8) {
      float2 e[8];
#pragma unroll
      for (int q = 0; q < 8; ++q) e[q] = E[((size_t)(b * S5_NC + cc + q) * 32 + g) * 64 + lane];
#pragma unroll
      for (int q = 0; q < 8; ++q) {
        const float nr = ar * sr - ai * si + e[q].x, ni = ar * si + ai * sr + e[q].y;
        sr = nr; si = ni;
      }
    }
    for (; cc < c; ++cc) {
      const float2 e = E[((size_t)(b * S5_NC + cc) * 32 + g) * 64 + lane];
      const float nr = ar * sr - ai * si + e.x, ni = ar * si + ai * sr + e.y;
      sr = nr; si = ni;
    }
  }
  __syncthreads();
  const float* H = (const float*)(p.ws + OFF_H);
  float* sS = (float*)smem + wave * 16 * S5C_ROW;
  float* su = (float*)smem + 4 * 16 * S5C_ROW + wave * 64 * 16;
  {
    const float* ur = H + (size_t)(b * SEQ_LEN + c * 64 + lane) * AB_IN + g * 16;
#pragma unroll
    for (int q = 0; q < 4; ++q) st4(su + lane * 16 + q * 4, ld4(ur + q * 4));
  }
  __syncthreads();
  const float* cre = p.in[I_S5_C_RE] + (size_t)g * 16 * 64;
  const float* cim = p.in[I_S5_C_IM] + (size_t)g * 16 * 64;
  float* YG = (float*)(p.ws + OFF_YGELU);
  for (int sc = 0; sc < 4; ++sc) {
    for (int tt = 0; tt < 16; ++tt) {
      const float* u = su + (sc * 16 + tt) * 16;
      float dr = 0.f, di = 0.f;
#pragma unroll
      for (int h4 = 0; h4 < 4; ++h4) {
        const float4 uv = ld4(u + h4 * 4);
        dr += uv.x * bbr[h4 * 4] + uv.y * bbr[h4 * 4 + 1] + uv.z * bbr[h4 * 4 + 2] + uv.w * bbr[h4 * 4 + 3];
        di += uv.x * bbi[h4 * 4] + uv.y * bbi[h4 * 4 + 1] + uv.z * bbi[h4 * 4 + 2] + uv.w * bbi[h4 * 4 + 3];
      }
      const float nr = lb_re * sr - lb_im * si + dr, ni = lb_re * si + lb_im * sr + di;
      sr = nr; si = ni;
      sS[tt * S5C_ROW + lane] = sr;
      sS[tt * S5C_ROW + 64 + lane] = si;
    }
    __syncthreads();
    {
      const int tt = lane >> 2, hq = lane & 3;
      float y[4] = {0.f, 0.f, 0.f, 0.f};
      for (int k = 0; k < 64; k += 4) {
        const float4 vr = ld4(sS + tt * S5C_ROW + k), vi = ld4(sS + tt * S5C_ROW + 64 + k);
#pragma unroll
        for (int hh = 0; hh < 4; ++hh) {
          const float4 cr = ld4(cre + (hq * 4 + hh) * 64 + k), ci = ld4(cim + (hq * 4 + hh) * 64 + k);
          y[hh] += vr.x * cr.x + vr.y * cr.y + vr.z * cr.z + vr.w * cr.w - (vi.x * ci.x + vi.y * ci.y + vi.z * ci.z + vi.w * ci.w);
        }
      }
      const size_t tok = (size_t)(b * SEQ_LEN + c * 64 + sc * 16 + tt);
      const int ch = g * 16 + hq * 4;
      const float4 uv = ld4(H + tok * AB_IN + ch);
      const float4 dv = ld4(p.in[I_S5_D] + ch);
      float4 o;
      o.x = geluf_(y[0] + dv.x * uv.x); o.y = geluf_(y[1] + dv.y * uv.y);
      o.z = geluf_(y[2] + dv.z * uv.z); o.w = geluf_(y[3] + dv.w * uv.w);
      st4(YG + tok * 512 + ch, o);
    }
    __syncthreads();
  }
}

#define P2_SMEM (P2_S5C_SMEM > P2_NSA_SMEM ? P2_S5C_SMEM : P2_NSA_SMEM)
DEV void phase_p2(const Params& p, char* smem) {
  const int G = gridDim.x;
  const int total = P2_NSA_ITEMS + P2_S5C_ITEMS;
  for (int r = 0;; ++r) {
    const int it = r * G + ((r & 1) ? (G - 1 - (int)blockIdx.x) : (int)blockIdx.x);
    if (r * G >= total) break;
    if (it >= total) continue;
    if (it < P2_NSA_ITEMS) p2_nsa(p, it, smem);
    else p2_s5c(p, it - P2_NSA_ITEMS, smem);
  }
}

DEV void phase_glu(const Params& p, char* smem) {
  const float* A = (const float*)(p.ws + OFF_YGELU);
  const float* B = p.in[I_S5_W_GLU];
  const float* bias = p.in[I_S5_B_GLU];
  float* MIX = (float*)(p.ws + OFF_MIX);
  const int NT = 4, MT = NTOK / GEMM_BM;
  const int xcd_ = blockIdx.x & 7, lb_ = blockIdx.x >> 3, nb_ = gridDim.x >> 3;
  for (int j_ = lb_; j_ < (MT / 8) * NT; j_ += nb_) {
    const int it = (xcd_ + 8 * (j_ / NT)) * NT + (j_ % NT);
    const int m0 = (it / NT) * GEMM_BM, n0 = (it % NT) * 128;
    gemm_tile<false>(
        [&](int r) { return (const void*)(A + (size_t)(m0 + r) * 512); },
        [&](int c) { return B + n0 + c; }, 512, 512,
        [&](int row, int col, float v0, float v1) {
          const size_t gm = m0 + row; const int gc = n0 + col;
          const float y0 = A[gm * 512 + gc], y1 = A[gm * 512 + gc + 32];
          MIX[gm * 1024 + gc] = y0 * sigmoidf_(v0 + bias[gc]);
          MIX[gm * 1024 + gc + 32] = y1 * sigmoidf_(v1 + bias[gc + 32]);
        },
        smem);
  }
}

template <int LAYER>
DEV void phase_outproj(const Params& p, char* smem) {
  const float* A = (const float*)(p.ws + OFF_MIX);
  const float* B = LAYER == 0 ? p.in[I_AB_W_OUT] : p.in[I_CD_W_OUT];
  const float* xin = LAYER == 0 ? p.in[I_X] : (const float*)(p.ws + OFF_X2);
  float* PRE = (float*)(p.ws + OFF_H);
  const int NT = 8, MT = NTOK / GEMM_BM;
  const int xcd_ = blockIdx.x & 7, lb_ = blockIdx.x >> 3, nb_ = gridDim.x >> 3;
  for (int j_ = lb_; j_ < (MT / 8) * NT; j_ += nb_) {
    const int it = (xcd_ + 8 * (j_ / NT)) * NT + (j_ % NT);
    const int m0 = (it / NT) * GEMM_BM, n0 = (it % NT) * 128;
    gemm_tile<false>(
        [&](int r) { return (const void*)(A + (size_t)(m0 + r) * 1024); },
        [&](int c) { return B + n0 + c; }, 1024, 1024,
        [&](int row, int col, float v0, float v1) {
          const size_t o = (size_t)(m0 + row) * 1024 + n0 + col;
          PRE[o] = ALPHA_F * xin[o] + v0;
          PRE[o + 32] = ALPHA_F * xin[o + 32] + v1;
        },
        smem);
  }
}

DEV void wave_ln(float (&v)[16], const float* gam, const float* bet, int lane) {
  float s = 0.f;
#pragma unroll
  for (int i = 0; i < 16; ++i) s += v[i];
  const float mu = wave_sum(s) * (1.f / 1024.f);
  float q = 0.f;
#pragma unroll
  for (int i = 0; i < 16; ++i) { const float d = v[i] - mu; q += d * d; }
  const float rstd = rsqrtf(wave_sum(q) * (1.f / 1024.f) + 1e-5f);
#pragma unroll
  for (int i = 0; i < 4; ++i) {
    const float4 gv = ld4(gam + lane * 4 + 256 * i), bv = ld4(bet + lane * 4 + 256 * i);
    v[i * 4 + 0] = (v[i * 4 + 0] - mu) * rstd * gv.x + bv.x;
    v[i * 4 + 1] = (v[i * 4 + 1] - mu) * rstd * gv.y + bv.y;
    v[i * 4 + 2] = (v[i * 4 + 2] - mu) * rstd * gv.z + bv.z;
    v[i * 4 + 3] = (v[i * 4 + 3] - mu) * rstd * gv.w + bv.w;
  }
}

#define P5_SMEM (4 * (4 * 1024 + 64) * 4)
template <int LAYER>
DEV void phase_ln_router(const Params& p, char* smem) {
  const int lane = threadIdx.x & 63, wave = threadIdx.x >> 6;
  const float* PRE = (const float*)(p.ws + OFF_H);
  float* X1 = (float*)(p.ws + OFF_X1);
  const float* router = p.in[I_ROUTER] + (size_t)LAYER * 1024 * 64;
  const float* bias = p.in[I_MOE_BIAS] + LAYER * 64;
  int* TOPI = (int*)(p.ws + OFF_TOPI);
  float* TOPG = (float*)(p.ws + OFF_TOPG);
  float* xs = (float*)smem + wave * (4 * 1024 + 64);
  float* ms = xs + 4 * 1024;
  for (int it = blockIdx.x; it < NTOK / 16; it += gridDim.x) {
    const size_t tokb = (size_t)it * 16 + wave * 4;
    WAVE_SYNC();
#pragma unroll 1
    for (int t = 0; t < 4; ++t) {
      const size_t tok = tokb + t;
      float v[16];
#pragma unroll
      for (int i = 0; i < 4; ++i) {
        const float4 a = ld4(PRE + tok * 1024 + lane * 4 + 256 * i);
        v[i * 4] = a.x; v[i * 4 + 1] = a.y; v[i * 4 + 2] = a.z; v[i * 4 + 3] = a.w;
      }
      wave_ln(v, p.in[I_LN1_G] + LAYER * 1024, p.in[I_LN1_B] + LAYER * 1024, lane);
#pragma unroll
      for (int i = 0; i < 4; ++i) {
        const float4 a = make_float4(v[i * 4], v[i * 4 + 1], v[i * 4 + 2], v[i * 4 + 3]);
        st4(X1 + tok * 1024 + lane * 4 + 256 * i, a);
        st4(xs + t * 1024 + lane * 4 + 256 * i, a);
      }
    }
    WAVE_SYNC();
    float lg[4] = {0.f, 0.f, 0.f, 0.f};
    for (int k = 0; k < 1024; k += 4) {
      const float r0 = router[(size_t)k * 64 + lane], r1 = router[(size_t)(k + 1) * 64 + lane],
                  r2 = router[(size_t)(k + 2) * 64 + lane], r3 = router[(size_t)(k + 3) * 64 + lane];
#pragma unroll
      for (int t = 0; t < 4; ++t) {
        const float4 xv = ld4(xs + t * 1024 + k);
        lg[t] += xv.x * r0 + xv.y * r1 + xv.z * r2 + xv.w * r3;
      }
    }
#pragma unroll
    for (int t = 0; t < 4; ++t) {
      const size_t tok = tokb + t;
      const float score = 1.f / (1.f + expf(-lg[t]));
      const float biased = score + bias[lane];
      float m1 = biased; int a1 = lane;
#pragma unroll
      for (int mm = 1; mm <= 4; mm <<= 1) {
        const float ov = __shfl_xor(m1, mm); const int oa = __shfl_xor(a1, mm);
        if (ov > m1 || (ov == m1 && oa < a1)) { m1 = ov; a1 = oa; }
      }
      float m2 = lane == a1 ? -INFINITY : biased;
#pragma unroll
      for (int mm = 1; mm <= 4; mm <<= 1) m2 = fmaxf(m2, __shfl_xor(m2, mm));
      const float gs = m1 + m2;
      const int mygrp = lane >> 3;
      int rank = 0;
#pragma unroll
      for (int gg = 0; gg < 8; ++gg) {
        const float og = __shfl(gs, gg * 8);
        rank += (og > gs || (og == gs && gg < mygrp)) ? 1 : 0;
      }
      const float masked = rank < 4 ? biased : -INFINITY;
      WAVE_SYNC();
      ms[lane] = masked;
      WAVE_SYNC();
      int erank = 0;
      for (int e = 0; e < 64; ++e) {
        const float ov = ms[e];
        erank += (ov > masked || (ov == masked && e < lane)) ? 1 : 0;
      }
      const bool selected = erank < 8;
      const float gsum = wave_sum(selected ? score : 0.f);
      if (selected) {
        TOPI[tok * 8 + erank] = lane;
        TOPG[tok * 8 + erank] = score / gsum * 2.5f;
      }
    }
  }
}

#define P6_SMEM GEMM_SMEM_BYTES
template <int LAYER>
DEV void phase_lists_shup(const Params& p, char* smem) {
  const int tid = threadIdx.x, lane = tid & 63, wave = tid >> 6;
  const int* TOPI = (const int*)(p.ws + OFF_TOPI);
  const float* TOPG = (const float*)(p.ws + OFF_TOPG);
  int* POSOF = (int*)(p.ws + OFF_POSOF);
  int* CNT = (int*)(p.ws + OFF_CNT);
  int* LTOK = (int*)(p.ws + OFF_LTOK);
  float* LGATE = (float*)(p.ws + OFF_LGATE);
  const float* X1 = (const float*)(p.ws + OFF_X1);
  unsigned short* HS = (unsigned short*)(p.ws + OFF_HS);
  const float* W1 = p.in[I_SH_W1] + (size_t)LAYER * 1024 * 256;
  const float* W3 = p.in[I_SH_W3] + (size_t)LAYER * 1024 * 256;
  const int MT = NTOK / GEMM_BM;
  int* swave = (int*)smem;
  for (int it = blockIdx.x; it < 64; it += gridDim.x) {
    const int e = it;
    int base = 0;
    for (int t0 = 0; t0 < NTOK; t0 += NTHREADS) {
      const int tok = t0 + tid;
      int slot = -1;
#pragma unroll
      for (int s = 0; s < 8; ++s) if (TOPI[(size_t)tok * 8 + s] == e) slot = s;
      const unsigned long long bal = __ballot(slot >= 0);
      const int pre = __popcll(bal & ((1ull << lane) - 1ull));
      __syncthreads();
      if (lane == 0) swave[wave] = __popcll(bal);
      __syncthreads();
      int woff = 0, tot = 0;
#pragma unroll
      for (int w = 0; w < 4; ++w) { const int c = swave[w]; if (w < wave) woff += c; tot += c; }
      if (slot >= 0) {
        const int pos = base + woff + pre;
        LTOK[(size_t)e * NTOK + pos] = tok;
        LGATE[(size_t)e * NTOK + pos] = TOPG[(size_t)tok * 8 + slot];
        POSOF[(size_t)tok * 8 + slot] = pos;
      }
      base += tot;
    }
    if (tid == 0) CNT[e] = base;
    __syncthreads();
  }
  {
    const int NT = 4;
    const int xcd_ = blockIdx.x & 7, lb_ = blockIdx.x >> 3, nb_ = gridDim.x >> 3;
    for (int j_ = lb_; j_ < (MT / 8) * NT; j_ += nb_) {
      const int m0 = (xcd_ + 8 * (j_ / NT)) * GEMM_BM, ct = j_ % NT;
      gemm_tile<false>(
          [&](int r) { return (const void*)(X1 + (size_t)(m0 + r) * 1024); },
          [&](int c) { return (((c >> 5) & 1) ? W3 : W1) + ct * 64 + (c >> 6) * 32 + (c & 31); }, 256, 1024,
          [&](int row, int col, float v0, float v1) {
            const int lc = ct * 64 + (col >> 6) * 32 + (col & 31);
            HS[(size_t)(m0 + row) * 256 + lc] = f2bf(siluf_(v0) * v1);
          },
          smem);
    }
  }
}

struct ExpMap { int tstart[65]; int rbase[65]; int ltile[9]; };
DEV void build_expmap(const Params& p, ExpMap* em) {
  __syncthreads();
  if (threadIdx.x == 0) {
    const int* CNT = (const int*)(p.ws + OFF_CNT);
    int ts = 0, rb = 0;
    for (int e = 0; e < 64; ++e) {
      em->tstart[e] = ts; em->rbase[e] = rb;
      const int c = CNT[e];
      ts += (c + GEMM_BM - 1) / GEMM_BM; rb += c;
    }
    em->tstart[64] = ts; em->rbase[64] = rb;
    const int x = blockIdx.x & 7;
    int lt = 0;
    for (int k = 0; k < 8; ++k) { em->ltile[k] = lt; lt += em->tstart[x + 8 * k + 1] - em->tstart[x + 8 * k]; }
    em->ltile[8] = lt;
  }
  __syncthreads();
}
DEV void map_expert_tile(const ExpMap* em, int j, int CT, int& e, int& rt, int& ct) {
  const int jr = j / CT; ct = j % CT;
  int k = 0;
  for (int q = 1; q < 8; ++q) if (em->ltile[q] <= jr) k = q;
  e = (blockIdx.x & 7) + 8 * k; rt = jr - em->ltile[k];
}
#define P7_SMEM (GEMM_SMEM_BYTES + 1024)
template <int LAYER>
DEV void phase_routed_up(const Params& p, char* smem) {
  ExpMap* em = (ExpMap*)(smem + GEMM_SMEM_BYTES);
  build_expmap(p, em);
  const int* CNT = (const int*)(p.ws + OFF_CNT);
  const int* LTOK = (const int*)(p.ws + OFF_LTOK);
  const float* X1 = (const float*)(p.ws + OFF_X1);
  unsigned short* HR = (unsigned short*)(p.ws + OFF_HR);
  const int lb_ = blockIdx.x >> 3, nb_ = gridDim.x >> 3;
  for (int j_ = lb_; j_ < em->ltile[8] * 4; j_ += nb_) {
    int e, rtl, ct;
    map_expert_tile(em, j_, 4, e, rtl, ct);
    const int r0 = rtl * GEMM_BM;
    const int cnt = CNT[e], rbase = em->rbase[e];
    const float* W1 = p.in[I_MOE_W1] + ((size_t)LAYER * 64 + e) * 1024 * 256;
    const float* W3 = p.in[I_MOE_W3] + ((size_t)LAYER * 64 + e) * 1024 * 256;
    gemm_tile<false>(
        [&](int r) { return (r0 + r < cnt) ? (const void*)(X1 + (size_t)LTOK[(size_t)e * NTOK + r0 + r] * 1024) : (const void*)nullptr; },
        [&](int c) { return (((c >> 5) & 1) ? W3 : W1) + ct * 64 + (c >> 6) * 32 + (c & 31); }, 256, 1024,
        [&](int row, int col, float v0, float v1) {
          if (r0 + row < cnt) {
            const int lc = ct * 64 + (col >> 6) * 32 + (col & 31);
            HR[(size_t)(rbase + r0 + row) * 256 + lc] = f2bf(siluf_(v0) * v1);
          }
        },
        smem);
  }
}

template <int LAYER>
DEV void phase_down(const Params& p, char* smem) {
  ExpMap* em = (ExpMap*)(smem + GEMM_SMEM_BYTES);
  build_expmap(p, em);
  const int* CNT = (const int*)(p.ws + OFF_CNT);
  const float* LGATE = (const float*)(p.ws + OFF_LGATE);
  const unsigned short* HR = (const unsigned short*)(p.ws + OFF_HR);
  const unsigned short* HS = (const unsigned short*)(p.ws + OFF_HS);
  unsigned short* Y = (unsigned short*)(p.ws + OFF_Y);
  float* FS = (float*)(p.ws + OFF_FS);
  const int xcd_ = blockIdx.x & 7, lb_ = blockIdx.x >> 3, nb_ = gridDim.x >> 3;
  for (int j_ = lb_; j_ < em->ltile[8] * 8; j_ += nb_) {
    int e, rtl, ct;
    map_expert_tile(em, j_, 8, e, rtl, ct);
    const int r0 = rtl * GEMM_BM;
    const int cnt = CNT[e], rbase = em->rbase[e];
    const float* W2 = p.in[I_MOE_W2] + ((size_t)LAYER * 64 + e) * 256 * 1024;
    const int n0 = ct * 128;
    gemm_tile<true>(
        [&](int r) { return (r0 + r < cnt) ? (const void*)(HR + (size_t)(rbase + r0 + r) * 256) : (const void*)nullptr; },
        [&](int c) { return W2 + n0 + c; }, 1024, 256,
        [&](int row, int col, float v0, float v1) {
          if (r0 + row < cnt) {
            const float gt = LGATE[(size_t)e * NTOK + r0 + row];
            const size_t o = (size_t)(rbase + r0 + row) * 1024 + n0 + col;
            Y[o] = f2bf(v0 * gt); Y[o + 32] = f2bf(v1 * gt);
          }
        },
        smem);
  }
  {
    const int MT = NTOK / GEMM_BM, NT = 8;
    const float* W2 = p.in[I_SH_W2] + (size_t)LAYER * 256 * 1024;
    for (int j_ = lb_; j_ < (MT / 8) * NT; j_ += nb_) {
      const int m0 = (xcd_ + 8 * (j_ / NT)) * GEMM_BM, n0 = (j_ % NT) * 128;
      gemm_tile<true>(
          [&](int r) { return (const void*)(HS + (size_t)(m0 + r) * 256); },
          [&](int c) { return W2 + n0 + c; }, 1024, 256,
          [&](int row, int col, float v0, float v1) {
            const size_t o = (size_t)(m0 + row) * 1024 + n0 + col;
            FS[o] = v0; FS[o + 32] = v1;
          },
          smem);
    }
  }
}

template <int LAYER>
DEV void phase_combine(const Params& p, char* smem) {
  ExpMap* em = (ExpMap*)smem;
  build_expmap(p, em);
  const int lane = threadIdx.x & 63, wave = threadIdx.x >> 6;
  const float* X1 = (const float*)(p.ws + OFF_X1);
  const float* FS = (const float*)(p.ws + OFF_FS);
  const unsigned short* Y = (const unsigned short*)(p.ws + OFF_Y);
  const int* TOPI = (const int*)(p.ws + OFF_TOPI);
  const int* POSOF = (const int*)(p.ws + OFF_POSOF);
  float* OUT = LAYER == 0 ? (float*)(p.ws + OFF_X2) : p.out;
  for (int it = blockIdx.x; it < NTOK / 4; it += gridDim.x) {
    const size_t tok = (size_t)it * 4 + wave;
    float v[16];
#pragma unroll
    for (int i = 0; i < 4; ++i) {
      const float4 a = ld4(X1 + tok * 1024 + lane * 4 + 256 * i), f = ld4(FS + tok * 1024 + lane * 4 + 256 * i);
      v[i * 4] = ALPHA_F * a.x + f.x; v[i * 4 + 1] = ALPHA_F * a.y + f.y; v[i * 4 + 2] = ALPHA_F * a.z + f.z; v[i * 4 + 3] = ALPHA_F * a.w + f.w;
    }
    for (int s = 0; s < 8; ++s) {
      const int e = TOPI[tok * 8 + s];
      const size_t row = (size_t)em->rbase[e] + POSOF[tok * 8 + s];
#pragma unroll
      for (int i = 0; i < 4; ++i) {
        const uint2 y = *(const uint2*)(Y + row * 1024 + lane * 4 + 256 * i);
        v[i * 4] += bf2f((unsigned short)(y.x & 0xFFFF)); v[i * 4 + 1] += bf2f((unsigned short)(y.x >> 16));
        v[i * 4 + 2] += bf2f((unsigned short)(y.y & 0xFFFF)); v[i * 4 + 3] += bf2f((unsigned short)(y.y >> 16));
      }
    }
    wave_ln(v, p.in[I_LN2_G] + LAYER * 1024, p.in[I_LN2_B] + LAYER * 1024, lane);
#pragma unroll
    for (int i = 0; i < 4; ++i) st4(OUT + tok * 1024 + lane * 4 + 256 * i, make_float4(v[i * 4], v[i * 4 + 1], v[i * 4 + 2], v[i * 4 + 3]));
  }
}

DEV float shifted(const float* Hc, size_t tok, int col, const float* mu) {
  const float cur = Hc[tok * CD_IN + col];
  const float prev = (tok % SEQ_LEN) == 0 ? 0.f : Hc[(tok - 1) * CD_IN + col];
  return cur + (prev - cur) * mu[col];
}

#define P11_PREP_ITEMS (NTOK / 8)
#define P11_KV_ITEMS (BATCH * 4 * RET_NC)
#define P11_SMEM (8 * 128 * 4)
DEV void p11_prep(const Params& p, int item, char* smem) {
  const int tid = threadIdx.x;
  const float* Hc = (const float*)(p.ws + OFF_H);
  const float* mu = p.in[I_RW_MU];
  float* sl = (float*)smem;
  __syncthreads();
  for (int w = tid; w < 8 * 128; w += NTHREADS) {
    const int tt = w >> 7, j = w & 127;
    const size_t tok = (size_t)item * 8 + tt;
    const float v = shifted(Hc, tok, 1536 + j, mu);
    sl[w] = j < 64 ? tanhf(v) : v;
  }
  __syncthreads();
  float* RWW = (float*)(p.ws + OFF_RWW); float* RWK = (float*)(p.ws + OFF_RWK);
  float* RWKK = (float*)(p.ws + OFF_RWKK); float* RWA = (float*)(p.ws + OFF_RWA);
  float* RWR = p.out + (size_t)NTOK * 512; float* RWV = p.out;
  const float* w_up = p.in[I_RW_W_UP]; const float* a_up = p.in[I_RW_A_UP];
#pragma unroll
  for (int cc = 0; cc < 2; ++cc) {
    const int c = tid + 256 * cc;
    float aw[8], aa[8];
#pragma unroll
    for (int tt = 0; tt < 8; ++tt) { aw[tt] = 0.f; aa[tt] = 0.f; }
    for (int j = 0; j < 64; ++j) {
      const float wu = w_up[j * 512 + c], au = a_up[j * 512 + c];
#pragma unroll
      for (int tt = 0; tt < 8; ++tt) { aw[tt] += sl[tt * 128 + j] * wu; aa[tt] += sl[tt * 128 + 64 + j] * au; }
    }
    const float w0 = p.in[I_RW_W0][c], a0 = p.in[I_RW_A0][c], kkc = p.in[I_RW_K_K][c], kac = p.in[I_RW_K_A][c];
#pragma unroll
    for (int tt = 0; tt < 8; ++tt) {
      const size_t tok = (size_t)item * 8 + tt;
      const float lw = w0 + aw[tt];
      const float nl = -lw;
      const float sp = nl > 20.f ? nl : log1pf(expf(nl));
      const float wl = -sp - 0.5f;
      const float decay = expf(-expf(wl));
      const float a = 1.f / (1.f + expf(-(a0 + aa[tt])));
      const float rs = shifted(Hc, tok, c, mu);
      const float ks = shifted(Hc, tok, 512 + c, mu);
      const float vs = shifted(Hc, tok, 1024 + c, mu);
      float kk = ks * kkc;
      const float nrm = sqrtf(wave_sum(kk * kk));
      kk = kk / fmaxf(nrm, 1e-12f);
      RWW[tok * 512 + c] = decay;
      RWK[tok * 512 + c] = ks * (1.f + (a - 1.f) * kac);
      RWKK[tok * 512 + c] = kk;
      RWA[tok * 512 + c] = kk * a;
      RWR[tok * 512 + c] = rs;
      RWV[tok * 512 + c] = vs;
    }
  }
}
DEV float ret_log2gamma(int h) { return log2f(1.f - exp2f(-5.f - (float)h)); }
DEV void p11_kv(const Params& p, int item) {
  const int c = item % RET_NC, h = (item / RET_NC) & 3, b = item / (RET_NC * 4);
  const int tid = threadIdx.x, e = tid & 127, dh = tid >> 7;
  const float* Hc = (const float*)(p.ws + OFF_H);
  const float lg = ret_log2gamma(h);
  float acc[32];
#pragma unroll
  for (int i = 0; i < 32; ++i) acc[i] = 0.f;
  for (int j = 0; j < 128; ++j) {
    const size_t tok = (size_t)b * SEQ_LEN + c * 128 + j;
    const float vv = Hc[tok * CD_IN + 2304 + h * 128 + e] * exp2f((float)(127 - j) * lg);
    const float* kr = Hc + tok * CD_IN + 2048 + h * 64 + dh * 32;
#pragma unroll
    for (int i4 = 0; i4 < 8; ++i4) {
      const float4 kv = ld4(kr + i4 * 4);
      acc[i4 * 4] += kv.x * vv; acc[i4 * 4 + 1] += kv.y * vv; acc[i4 * 4 + 2] += kv.z * vv; acc[i4 * 4 + 3] += kv.w * vv;
    }
  }
  float* KV = (float*)(p.ws + OFF_RETKV) + (size_t)item * 64 * 128;
#pragma unroll
  for (int i = 0; i < 32; ++i) KV[(dh * 32 + i) * 128 + e] = acc[i];
}
DEV void phase_p11(const Params& p, char* smem) {
  const int total = P11_PREP_ITEMS + P11_KV_ITEMS;
  for (int it = blockIdx.x; it < total; it += gridDim.x) {
    if (it < P11_KV_ITEMS) p11_kv(p, it);
    else p11_prep(p, it - P11_KV_ITEMS, smem);
  }
}

#define P12_SCAN_ITEMS (BATCH * 8 * 4)
#define P12_RET_ITEMS (BATCH * 4 * RET_NC)
#define P12_SCAN_SMEM ((2 * (16 * 5 * 64 + 16 * 16) + 16 * 16) * 4)
#define P12_RET_SMEM (64 * 128 * 4 + 256 * 2 * 4)
#define P12_SMEM (P12_SCAN_SMEM > P12_RET_SMEM ? P12_SCAN_SMEM : P12_RET_SMEM)
DEV float sum16(float v) {
#ifdef CPU_EMU
  return emu_sum16(v);
#else
  int x;
  x = __builtin_amdgcn_update_dpp(0, __builtin_bit_cast(int, v), 0xB1, 0xF, 0xF, false); v += __builtin_bit_cast(float, x);
  x = __builtin_amdgcn_update_dpp(0, __builtin_bit_cast(int, v), 0x4E, 0xF, 0xF, false); v += __builtin_bit_cast(float, x);
  x = __builtin_amdgcn_update_dpp(0, __builtin_bit_cast(int, v), 0x141, 0xF, 0xF, false); v += __builtin_bit_cast(float, x);
  x = __builtin_amdgcn_update_dpp(0, __builtin_bit_cast(int, v), 0x140, 0xF, 0xF, false); v += __builtin_bit_cast(float, x);
  return v;
#endif
}
DEV void p12_scan(const Params& p, int item, char* smem) {
  const int rq = item & 3, h = (item >> 2) & 7, b = item >> 5;
  const int tid = threadIdx.x, rl = tid >> 4, cg = tid & 15;
  const float* ARR[5] = {(const float*)(p.ws + OFF_RWW), (const float*)(p.ws + OFF_RWK), (const float*)(p.ws + OFF_RWKK),
                         (const float*)(p.ws + OFF_RWA), p.out + (size_t)NTOK * 512};
  const float* RWV = p.out;
  float* Yo = (float*)(p.ws + OFF_MIX);
  float* buf = (float*)smem;
  float* vbuf = buf + 2 * 16 * 5 * 64;
  float* ybuf = vbuf + 2 * 16 * 16;
  float S[4] = {0.f, 0.f, 0.f, 0.f};
  float4 rg[5]; float rv;
  const int lstep = tid >> 4, lc4 = tid & 15;
  auto gload = [&](int c) {
    const size_t o = ((size_t)b * SEQ_LEN + c * 16 + lstep) * 512 + h * 64;
#pragma unroll
    for (int a = 0; a < 5; ++a) rg[a] = ld4(ARR[a] + o + lc4 * 4);
    rv = RWV[o + rq * 16 + lc4];
  };
  auto sstore = [&](int bi) {
#pragma unroll
    for (int a = 0; a < 5; ++a) st4(buf + ((bi * 16 + lstep) * 5 + a) * 64 + lc4 * 4, rg[a]);
    vbuf[(bi * 16 + lstep) * 16 + lc4] = rv;
  };
  __syncthreads();
  gload(0);
  sstore(0);
  __syncthreads();
  const int NCH = SEQ_LEN / 16;
  for (int c = 0; c < NCH; ++c) {
    if (c + 1 < NCH) gload(c + 1);
    const float* cb = buf + (c & 1) * 16 * 5 * 64;
    const float* cv = vbuf + (c & 1) * 16 * 16;
    float4 cw = ld4(cb + 0 * 64 + cg * 4), ck = ld4(cb + 1 * 64 + cg * 4), ckk = ld4(cb + 2 * 64 + cg * 4),
           cka = ld4(cb + 3 * 64 + cg * 4), cr = ld4(cb + 4 * 64 + cg * 4);
    float cvv = cv[rl];
#pragma unroll
    for (int s = 0; s < 16; ++s) {
      const float4 w = cw, k = ck, kk = ckk, ka = cka, r = cr;
      const float v = cvv;
      if (s < 15) {
        cw = ld4(cb + ((s + 1) * 5 + 0) * 64 + cg * 4); ck = ld4(cb + ((s + 1) * 5 + 1) * 64 + cg * 4);
        ckk = ld4(cb + ((s + 1) * 5 + 2) * 64 + cg * 4); cka = ld4(cb + ((s + 1) * 5 + 3) * 64 + cg * 4);
        cr = ld4(cb + ((s + 1) * 5 + 4) * 64 + cg * 4); cvv = cv[(s + 1) * 16 + rl];
      }
      float sa = (S[0] * kk.x + S[1] * kk.y) + (S[2] * kk.z + S[3] * kk.w);
      sa = -sum16(sa);
      S[0] = S[0] * w.x + (sa * ka.x + v * k.x);
      S[1] = S[1] * w.y + (sa * ka.y + v * k.y);
      S[2] = S[2] * w.z + (sa * ka.z + v * k.z);
      S[3] = S[3] * w.w + (sa * ka.w + v * k.w);
      float y = (S[0] * r.x + S[1] * r.y) + (S[2] * r.z + S[3] * r.w);
      y = sum16(y);
      if (cg == 0) ybuf[s * 16 + rl] = y;
      asm volatile("" ::: "memory");
    }
    __syncthreads();
    if (c + 1 < NCH) sstore((c + 1) & 1);
    Yo[((size_t)b * SEQ_LEN + c * 16 + lstep) * 1024 + h * 64 + rq * 16 + lc4] = ybuf[lstep * 16 + lc4];
    __syncthreads();
  }
}
DEV void p12_ret(const Params& p, int item, char* smem) {
  const int c = item % RET_NC, h = (item / RET_NC) & 3, b = item / (RET_NC * 4);
  const int tid = threadIdx.x, i = tid & 127, eh = tid >> 7;
  const float* Hc = (const float*)(p.ws + OFF_H);
  const float lg = ret_log2gamma(h);
  float* sS = (float*)smem;
  float* sRed = sS + 64 * 128;
  __syncthreads();
  {
    const float G = exp2f(128.f * lg);
    const float* KV0 = (const float*)(p.ws + OFF_RETKV) + (size_t)((b * 4 + h) * RET_NC) * 64 * 128;
    for (int w = tid; w < 64 * 128; w += NTHREADS) {
      float s = 0.f;
      for (int cc = 0; cc < c; ++cc) s = s * G + KV0[(size_t)cc * 64 * 128 + w];
      sS[w] = s;
    }
  }
  __syncthreads();
  const size_t tok0 = (size_t)b * SEQ_LEN + c * 128;
  float q[64];
  {
    const float* qr = Hc + (tok0 + i) * CD_IN + 1792 + h * 64;
#pragma unroll
    for (int d4 = 0; d4 < 16; ++d4) { const float4 v = ld4(qr + d4 * 4); q[d4 * 4] = v.x; q[d4 * 4 + 1] = v.y; q[d4 * 4 + 2] = v.z; q[d4 * 4 + 3] = v.w; }
  }
  float* MIX = (float*)(p.ws + OFF_MIX);
  float* dst = MIX + (tok0 + i) * 1024 + 512 + h * 128 + eh * 64;
  const int jmax = ((tid >> 6) & 1) * 64 + 63;
  const float qs = exp2f((float)(i + 1) * lg);
  float s1 = 0.f, s2 = 0.f;
#pragma unroll 1
  for (int ps = 0; ps < 2; ++ps) {
    float acc[32];
#pragma unroll
    for (int e = 0; e < 32; ++e) acc[e] = 0.f;
#pragma unroll
    for (int d = 0; d < 64; ++d) {
      const float qd = q[d] * qs;
#pragma unroll
      for (int e4 = 0; e4 < 8; ++e4) {
        const float4 sv = ld4(sS + d * 128 + eh * 64 + ps * 32 + e4 * 4);
        acc[e4 * 4] += qd * sv.x; acc[e4 * 4 + 1] += qd * sv.y; acc[e4 * 4 + 2] += qd * sv.z; acc[e4 * 4 + 3] += qd * sv.w;
      }
      if ((d & 1) == 1) asm volatile("" ::: "memory");
    }
    for (int j = 0; j <= jmax; ++j) {
      const float* kr = Hc + (tok0 + j) * CD_IN + 2048 + h * 64;
      float s = 0.f;
#pragma unroll
      for (int d4 = 0; d4 < 16; ++d4) {
        const float4 kv = ld4(kr + d4 * 4); s += q[d4 * 4] * kv.x + q[d4 * 4 + 1] * kv.y + q[d4 * 4 + 2] * kv.z + q[d4 * 4 + 3] * kv.w;
        if ((d4 & 7) == 7) asm volatile("" ::: "memory");
      }
      s = j <= i ? s * exp2f((float)(i - j) * lg) : 0.f;
      const float* vr = Hc + (tok0 + j) * CD_IN + 2304 + h * 128 + eh * 64 + ps * 32;
#pragma unroll
      for (int e4 = 0; e4 < 8; ++e4) {
        const float4 vv = ld4(vr + e4 * 4);
        acc[e4 * 4] += s * vv.x; acc[e4 * 4 + 1] += s * vv.y; acc[e4 * 4 + 2] += s * vv.z; acc[e4 * 4 + 3] += s * vv.w;
      }
      asm volatile("" ::: "memory");
    }
#pragma unroll
    for (int e4 = 0; e4 < 8; ++e4) {
      s1 += acc[e4 * 4] + acc[e4 * 4 + 1] + acc[e4 * 4 + 2] + acc[e4 * 4 + 3];
      s2 += acc[e4 * 4] * acc[e4 * 4] + acc[e4 * 4 + 1] * acc[e4 * 4 + 1] + acc[e4 * 4 + 2] * acc[e4 * 4 + 2] + acc[e4 * 4 + 3] * acc[e4 * 4 + 3];
      st4(dst + ps * 32 + e4 * 4, make_float4(acc[e4 * 4], acc[e4 * 4 + 1], acc[e4 * 4 + 2], acc[e4 * 4 + 3]));
    }
  }
  sRed[tid * 2] = s1; sRed[tid * 2 + 1] = s2;
  __syncthreads();
  const float mu = (s1 + sRed[(tid ^ 128) * 2]) * (1.f / 128.f);
  const float var = (s2 + sRed[(tid ^ 128) * 2 + 1]) * (1.f / 128.f) - mu * mu;
  const float rstd = rsqrtf(fmaxf(var, 0.f) + 1e-5f);
  const float* lgam = p.in[I_RET_LN_G] + h * 128 + eh * 64;
  const float* lbet = p.in[I_RET_LN_B] + h * 128 + eh * 64;
  const float* gate = Hc + (tok0 + i) * CD_IN + 2816 + h * 128 + eh * 64;
#pragma unroll
  for (int e4 = 0; e4 < 16; ++e4) {
    const float4 gv = ld4(lgam + e4 * 4), bv = ld4(lbet + e4 * 4), gt = ld4(gate + e4 * 4), y = ld4(dst + e4 * 4);
    float4 o;
    o.x = siluf_(gt.x) * ((y.x - mu) * rstd * gv.x + bv.x);
    o.y = siluf_(gt.y) * ((y.y - mu) * rstd * gv.y + bv.y);
    o.z = siluf_(gt.z) * ((y.z - mu) * rstd * gv.z + bv.z);
    o.w = siluf_(gt.w) * ((y.w - mu) * rstd * gv.w + bv.w);
    st4(dst + e4 * 4, o);
    if ((e4 & 3) == 3) asm volatile("" ::: "memory");
  }
}
DEV void phase_p12(const Params& p, char* smem) {
  const int total = P12_SCAN_ITEMS + P12_RET_ITEMS;
  for (int it = blockIdx.x; it < total; it += gridDim.x) {
    if (it < P12_SCAN_ITEMS) p12_scan(p, it, smem);
    else p12_ret(p, it - P12_SCAN_ITEMS, smem);
  }
}

#define P13_SMEM (8 * 128 * 4)
DEV void phase_p13(const Params& p, char* smem) {
  const int tid = threadIdx.x;
  const float* Hc = (const float*)(p.ws + OFF_H);
  const float* mu = p.in[I_RW_MU];
  float* sl = (float*)smem;
  float* MIX = (float*)(p.ws + OFF_MIX);
  const float* RWK = (const float*)(p.ws + OFF_RWK); const float* RWR = p.out + (size_t)NTOK * 512; const float* RWV = p.out;
  const float* g_up = p.in[I_RW_G_UP];
  for (int it = blockIdx.x; it < NTOK / 8; it += gridDim.x) {
    __syncthreads();
    for (int w = tid; w < 8 * 128; w += NTHREADS) {
      const size_t tok = (size_t)it * 8 + (w >> 7);
      sl[w] = sigmoidf_(shifted(Hc, tok, 1664 + (w & 127), mu));
    }
    __syncthreads();
#pragma unroll
    for (int cc = 0; cc < 2; ++cc) {
      const int c = tid + 256 * cc;
      float ag[8];
#pragma unroll
      for (int tt = 0; tt < 8; ++tt) ag[tt] = 0.f;
      for (int j = 0; j < 128; ++j) {
        const float gu = g_up[j * 512 + c];
#pragma unroll
        for (int tt = 0; tt < 8; ++tt) ag[tt] += sl[tt * 128 + j] * gu;
      }
      const float lng = p.in[I_RW_LN_G][c], lnb = p.in[I_RW_LN_B][c], rk = p.in[I_RW_R_K][c];
#pragma unroll
      for (int tt = 0; tt < 8; ++tt) {
        const size_t tok = (size_t)it * 8 + tt;
        const float y = MIX[tok * 1024 + c];
        const float m = wave_sum(y) * (1.f / 64.f);
        const float d = y - m;
        const float var = wave_sum(d * d) * (1.f / 64.f);
        const float yn = d * rsqrtf(var + 64e-5f) * lng + lnb;
        const float r = RWR[tok * 512 + c], k = RWK[tok * 512 + c], v = RWV[tok * 512 + c];
        const float bonus = wave_sum(r * k * rk) * v;
        MIX[tok * 1024 + c] = (yn + bonus) * ag[tt];
      }
    }
  }
}

#define NPHASES 20
#define SMEM_BYTES 67584
DEV void run_phase(const Params& p, int ph, char* smem) {
  switch (ph) {
    case 0: phase_gemm_in<0>(p, smem); break;
    case 1: phase_p1(p, smem); break;
    case 2: phase_p2(p, smem); break;
    case 3: phase_glu(p, smem); break;
    case 4: phase_outproj<0>(p, smem); break;
    case 5: phase_ln_router<0>(p, smem); break;
    case 6: phase_lists_shup<0>(p, smem); break;
    case 7: phase_routed_up<0>(p, smem); break;
    case 8: phase_down<0>(p, smem); break;
    case 9: phase_combine<0>(p, smem); break;
    case 10: phase_gemm_in<1>(p, smem); break;
    case 11: phase_p11(p, smem); break;
    case 12: phase_p12(p, smem); break;
    case 13: phase_p13(p, smem); break;
    case 14: phase_outproj<1>(p, smem); break;
    case 15: phase_ln_router<1>(p, smem); break;
    case 16: phase_lists_shup<1>(p, smem); break;
    case 17: phase_routed_up<1>(p, smem); break;
    case 18: phase_down<1>(p, smem); break;
    case 19: phase_combine<1>(p, smem); break;
  }
}
static_assert(P1_SMEM <= SMEM_BYTES, "smem");
static_assert(P1_PREP_SMEM <= SMEM_BYTES, "smem");
static_assert(P2_SMEM <= SMEM_BYTES, "smem");
static_assert(P5_SMEM <= SMEM_BYTES, "smem");
static_assert(P7_SMEM <= SMEM_BYTES, "smem");
static_assert(P12_SMEM <= SMEM_BYTES, "smem");
static_assert(OFF_HS + (size_t)NTOK * 256 * 2 <= OFF_X1, "layout");

#ifndef CPU_EMU
template <int PH>
__global__ void __launch_bounds__(NTHREADS) phase_kernel(Params p) {
  __shared__ __attribute__((aligned(16))) char smem[SMEM_BYTES];
  run_phase(p, PH, smem);
}
template <int PH>
static void launch_phases(const Params& p, hipStream_t stream) {
  phase_kernel<PH><<<dim3(1024), dim3(NTHREADS), 0, stream>>>(p);
  if constexpr (PH + 1 < NPHASES) launch_phases<PH + 1>(p, stream);
}
#if MEGA
DEV void grid_barrier(unsigned* bar, unsigned& epoch) {
  asm volatile("s_waitcnt vmcnt(0)" ::: "memory");
  __syncthreads();
  epoch += 1u;
  if (threadIdx.x == 0) {
    __builtin_amdgcn_fence(__ATOMIC_RELEASE, "agent");
    asm volatile("s_waitcnt vmcnt(0)" ::: "memory");
    __hip_atomic_fetch_add(bar, 1u, __ATOMIC_RELAXED, __HIP_MEMORY_SCOPE_AGENT);
    const unsigned target = epoch * gridDim.x;
    while (__hip_atomic_load(bar, __ATOMIC_RELAXED, __HIP_MEMORY_SCOPE_AGENT) < target) __builtin_amdgcn_s_sleep(1);
    __builtin_amdgcn_fence(__ATOMIC_ACQUIRE, "agent");
    asm volatile("s_waitcnt vmcnt(0)" ::: "memory");
  }
  __syncthreads();
}
__global__ void __launch_bounds__(NTHREADS) mega_kernel(Params p) {
  __shared__ __attribute__((aligned(16))) char smem[SMEM_BYTES];
  unsigned* bar = (unsigned*)(p.ws + OFF_BAR);
  unsigned epoch = 0u;
  if (p.ws == nullptr) cg::this_grid().sync();
  typedef const __attribute__((address_space(4))) Params* KParams;
#define PH_(n) { KParams kp = (KParams)__builtin_amdgcn_kernarg_segment_ptr(); asm volatile("" : "+s"(kp)); const Params lp = *(const Params*)kp; run_phase(lp, n, smem); } grid_barrier(bar, epoch);
  PH_(0) PH_(1) PH_(2) PH_(3) PH_(4) PH_(5) PH_(6) PH_(7) PH_(8) PH_(9)
  PH_(10) PH_(11) PH_(12) PH_(13) PH_(14) PH_(15) PH_(16) PH_(17) PH_(18)
  { KParams kp = (KParams)__builtin_amdgcn_kernarg_segment_ptr(); asm volatile("" : "+s"(kp)); const Params lp = *(const Params*)kp; run_phase(lp, 19, smem); }
}

#endif

extern "C" void kernel_launch(void* const* d_in, const int* in_sizes, int n_in, void* d_out, int out_size, void* d_ws, size_t ws_size,
                              hipStream_t stream) {
  Params p;
  for (int i = 0; i < N_INPUTS; ++i) p.in[i] = (const float*)d_in[i];
  p.out = (float*)d_out;
  p.ws = (char*)d_ws;
#if MEGA
  static int grid_blocks = 0;
  if (!grid_blocks) {
    int dev = 0, cus = 0, per_cu = 0;
    hipGetDevice(&dev);
    hipDeviceGetAttribute(&cus, hipDeviceAttributeMultiprocessorCount, dev);
    hipOccupancyMaxActiveBlocksPerMultiprocessor(&per_cu, mega_kernel, NTHREADS, 0);
    if (per_cu > 2) per_cu = 2;
    grid_blocks = cus * per_cu;
  }
  hipMemsetAsync((char*)d_ws + OFF_BAR, 0, 4096, stream);
  void* args[] = {&p};
  hipError_t e = hipLaunchCooperativeKernel((void*)mega_kernel, dim3(grid_blocks), dim3(NTHREADS), args, 0, stream);
  if (e != hipSuccess) fprintf(stderr, "cooperative launch failed: %s (grid %d)\n", hipGetErrorString(e), grid_blocks);
#else
  launch_phases<0>(p, stream);
#endif
}
#endif
```

```cpp
#ifdef CPU_EMU
#include "emu.h"
#else
#include <hip/hip_runtime.h>
#include <hip/hip_cooperative_groups.h>
#include <cstdio>
namespace cg = cooperative_groups;
#endif
#include <stdint.h>

#ifndef BATCH
#define BATCH 2
#endif
#ifndef SEQ_LEN
#define SEQ_LEN 8192
#endif
#ifndef MEGA
#define MEGA 1
#endif

#define DEV __device__ __forceinline__
#define NTOK (BATCH * SEQ_LEN)
#define DM 1024
#define AB_IN 1816
#define CD_IN 3328
#define NCMP ((SEQ_LEN - 32) / 16 + 1)
#define NBLK (SEQ_LEN / 64)
#define NB_CMP ((NCMP + 63) / 64)
#define S5_NC (SEQ_LEN / 64)
#define RET_NC (SEQ_LEN / 128)
#define ALPHA_F 1.4142135623730951f
#define NTHREADS 256

enum { I_X = 0, I_AB_W_IN, I_AB_W_OUT, I_S5_LAM_RE, I_S5_LAM_IM, I_S5_LOG_DT, I_S5_B_RE, I_S5_B_IM, I_S5_C_RE, I_S5_C_IM,
       I_S5_D, I_S5_W_GLU, I_S5_B_GLU, I_PE_K, I_PE_V, I_CK_W1, I_CK_B1, I_CK_W2, I_CV_W1, I_CV_B1, I_CV_W2,
       I_CD_W_IN, I_CD_W_OUT, I_RW_MU, I_RW_W0, I_RW_W_UP, I_RW_A0, I_RW_A_UP, I_RW_G_UP, I_RW_K_K, I_RW_K_A, I_RW_R_K,
       I_RW_LN_G, I_RW_LN_B, I_RET_LN_G, I_RET_LN_B, I_LN1_G, I_LN1_B, I_LN2_G, I_LN2_B, I_ROUTER, I_MOE_BIAS,
       I_MOE_W1, I_MOE_W3, I_MOE_W2, I_SH_W1, I_SH_W3, I_SH_W2, N_INPUTS };

struct Params {
  const float* in[N_INPUTS];
  float* out;
  char* ws;
};

#define MiB_TOK ((size_t)NTOK * 1024 * 4)
#define OFF_H 0
#define OFF_MIX ((size_t)NTOK * 3328 * 4)
#define OFF_X1 (OFF_MIX + MiB_TOK)
#define OFF_X2 (OFF_X1 + MiB_TOK)
#define OFF_R4 (OFF_X2 + MiB_TOK)
#define OFF_R5 (OFF_R4 + MiB_TOK)
#define OFF_Y OFF_H
#define OFF_HS (OFF_H + 4 * MiB_TOK)
#define OFF_FS OFF_X2
#define OFF_HR OFF_R4
#define OFF_TOPI (OFF_R5)
#define OFF_TOPG (OFF_TOPI + (size_t)NTOK * 8 * 4)
#define OFF_POSOF (OFF_TOPG + (size_t)NTOK * 8 * 4)
#define OFF_CNT (OFF_POSOF + (size_t)NTOK * 8 * 4)
#define OFF_LTOK (OFF_CNT + 1024)
#define OFF_LGATE (OFF_LTOK + (size_t)64 * NTOK * 4)
#define OFF_S5E (OFF_LGATE + (size_t)64 * NTOK * 4)
#define OFF_KCMP (OFF_S5E + (size_t)BATCH * S5_NC * 32 * 64 * 8)
#define OFF_VCMP (OFF_KCMP + (size_t)BATCH * NCMP * 2 * 64 * 4)
#define OFF_RETKV (OFF_VCMP + (size_t)BATCH * NCMP * 2 * 64 * 4)
#define OFF_BAR (OFF_RETKV + (size_t)BATCH * 4 * RET_NC * 64 * 128 * 4)
#define OFF_CMPHID (OFF_BAR + 4096)
#define OFF_CMPC1 (OFF_CMPHID + (size_t)2 * BATCH * 2 * NB_CMP * 64 * 128 * 4)
#define OFF_END (OFF_CMPC1 + 1024)
#define OFF_YGELU OFF_X1
#define OFF_RWW OFF_X1
#define OFF_RWK (OFF_X1 + (size_t)NTOK * 512 * 4)
#define OFF_RWKK OFF_R4
#define OFF_RWA (OFF_R4 + (size_t)NTOK * 512 * 4)

typedef short bf16x8 __attribute__((ext_vector_type(8)));
typedef float f32x16 __attribute__((ext_vector_type(16)));

#ifdef CPU_EMU
#define WAVE_SYNC() emu_wave_bar()
#else
#define WAVE_SYNC() __builtin_amdgcn_wave_barrier()
#endif

DEV float sigmoidf_(float x) { return 1.f / (1.f + __expf(-x)); }
DEV float siluf_(float x) { return x * sigmoidf_(x); }
DEV float geluf_(float x) { float u = 0.7978845608028654f * (x + 0.044715f * x * x * x); return 0.5f * x * (1.f + tanhf(u)); }
DEV unsigned short f2bf(float f) {
  unsigned u = __builtin_bit_cast(unsigned, f);
  u += 0x7FFFu + ((u >> 16) & 1u);
  return (unsigned short)(u >> 16);
}
DEV float bf2f(unsigned short h) { return __builtin_bit_cast(float, ((unsigned)h) << 16); }
DEV float wave_sum(float v) {
#pragma unroll
  for (int m = 32; m >= 1; m >>= 1) v += __shfl_xor(v, m);
  return v;
}
DEV float wave_max(float v) {
#pragma unroll
  for (int m = 32; m >= 1; m >>= 1) v = fmaxf(v, __shfl_xor(v, m));
  return v;
}
DEV float4 ld4(const float* p) { return *(const float4*)p; }
DEV void fast_sincos(float x, float* sn, float* cs) {
  const float k = rintf(x * 0.15915494309189535f);
  float r = fmaf(-k, 6.28125f, x);
  r = fmaf(-k, 1.9353071795864769e-3f, r);
  *sn = __sinf(r); *cs = __cosf(r);
}
DEV void st4(float* p, float4 v) { *(float4*)p = v; }

#define GEMM_BM 256
#define GEMM_MI (GEMM_BM / 64)
#define GEMM_SMEM_BYTES ((GEMM_BM + 128) * 72 * 2)
#ifdef CPU_EMU
DEV unsigned pk2(float a, float b) { return (unsigned)f2bf(a) | ((unsigned)f2bf(b) << 16); }
#else
typedef __bf16 hbf16x2 __attribute__((ext_vector_type(2)));
typedef float hf32x2 __attribute__((ext_vector_type(2)));
DEV unsigned pk2(float a, float b) {
  hf32x2 f = {a, b};
  return __builtin_bit_cast(unsigned, __builtin_convertvector(f, hbf16x2));
}
#endif
template <bool ABF, class AROW, class BPTR, class EPI>
DEV void gemm_tile(AROW arow, BPTR bptr, int ldb, int K, EPI epi, char* smem_raw, int akstep = 64) {
  unsigned short(*sA)[72] = (unsigned short(*)[72])smem_raw;
  unsigned short(*sB)[72] = (unsigned short(*)[72])(smem_raw + GEMM_BM * 72 * 2);
  const int tid = threadIdx.x, lane = tid & 63, wave = tid >> 6;
  const int wm = wave >> 1, wn = wave & 1;
#if defined(CPU_EMU) && !defined(EMU_REAL_GEMM)
  for (int mi = 0; mi < GEMM_MI; ++mi)
    for (int r = 0; r < 16; ++r) {
      const int row = wm * (GEMM_BM / 2) + mi * 32 + (r & 3) + 8 * (r >> 2) + 4 * (lane >> 5);
      const int col = wn * 64 + (lane & 31);
      const void* arp = arow(row);
      float v[2] = {0.f, 0.f};
      for (int ni = 0; ni < 2; ++ni) {
        const int cc = col + ni * 32;
        const float* bq = bptr(cc & ~3);
        if (!arp || !bq) continue;
        bq += cc & 3;
        float a = 0.f;
        for (int k = 0; k < K; ++k) {
          const size_t ka = (size_t)(k >> 6) * akstep + (k & 63);
          const float av = ABF ? bf2f(((const unsigned short*)arp)[ka]) : bf2f(f2bf(((const float*)arp)[ka]));
          a += av * bf2f(f2bf(bq[(size_t)k * ldb]));
        }
        v[ni] = a;
      }
      epi(row, col, v[0], v[1]);
    }
  return;
#endif
  const float* ap[4 * GEMM_MI];
  const unsigned short* aph[2 * GEMM_MI];
  if (ABF) {
#pragma unroll
    for (int i = 0; i < 2 * GEMM_MI; ++i) aph[i] = (const unsigned short*)arow((tid >> 3) + 32 * i);
  } else {
#pragma unroll
    for (int i = 0; i < 4 * GEMM_MI; ++i) ap[i] = (const float*)arow((tid >> 4) + 16 * i);
  }
  const float* bp = bptr((tid & 31) * 4);
  const int kgrp = tid >> 5;
  float4 ra[4 * GEMM_MI];
  uint4 rah[2 * GEMM_MI];
  float4 rb[8];
  auto gload = [&](int k0) {
    if (ABF) {
#pragma unroll
      for (int i = 0; i < 2 * GEMM_MI; ++i) rah[i] = aph[i] ? *(const uint4*)(aph[i] + (size_t)(k0 >> 6) * akstep + (tid & 7) * 8) : make_uint4(0, 0, 0, 0);
    } else {
#pragma unroll
      for (int i = 0; i < 4 * GEMM_MI; ++i) ra[i] = ap[i] ? ld4(ap[i] + (size_t)(k0 >> 6) * akstep + (tid & 15) * 4) : make_float4(0.f, 0.f, 0.f, 0.f);
    }
#pragma unroll
    for (int j = 0; j < 8; ++j) rb[j] = bp ? ld4(bp + (size_t)(k0 + kgrp * 8 + j) * ldb) : make_float4(0.f, 0.f, 0.f, 0.f);
  };
  auto sstore = [&]() {
    if (ABF) {
#pragma unroll
      for (int i = 0; i < 2 * GEMM_MI; ++i) *(uint4*)&sA[(tid >> 3) + 32 * i][(tid & 7) * 8] = rah[i];
    } else {
#pragma unroll
      for (int i = 0; i < 4 * GEMM_MI; ++i) *(uint2*)&sA[(tid >> 4) + 16 * i][(tid & 15) * 4] = make_uint2(pk2(ra[i].x, ra[i].y), pk2(ra[i].z, ra[i].w));
    }
    const int nb = (tid & 31) * 4;
    *(uint4*)&sB[nb + 0][kgrp * 8] = make_uint4(pk2(rb[0].x, rb[1].x), pk2(rb[2].x, rb[3].x), pk2(rb[4].x, rb[5].x), pk2(rb[6].x, rb[7].x));
    *(uint4*)&sB[nb + 1][kgrp * 8] = make_uint4(pk2(rb[0].y, rb[1].y), pk2(rb[2].y, rb[3].y), pk2(rb[4].y, rb[5].y), pk2(rb[6].y, rb[7].y));
    *(uint4*)&sB[nb + 2][kgrp * 8] = make_uint4(pk2(rb[0].z, rb[1].z), pk2(rb[2].z, rb[3].z), pk2(rb[4].z, rb[5].z), pk2(rb[6].z, rb[7].z));
    *(uint4*)&sB[nb + 3][kgrp * 8] = make_uint4(pk2(rb[0].w, rb[1].w), pk2(rb[2].w, rb[3].w), pk2(rb[4].w, rb[5].w), pk2(rb[6].w, rb[7].w));
  };
  f32x16 acc[GEMM_MI][2];
#pragma unroll
  for (int mi = 0; mi < GEMM_MI; ++mi)
#pragma unroll
    for (int ni = 0; ni < 2; ++ni)
#pragma unroll
      for (int r = 0; r < 16; ++r) acc[mi][ni][r] = 0.f;
  gload(0);
  for (int k0 = 0; k0 < K; k0 += 64) {
    __syncthreads();
    sstore();
    __syncthreads();
    if (k0 + 64 < K) gload(k0 + 64);
#pragma unroll
    for (int ks = 0; ks < 4; ++ks) {
      bf16x8 af[GEMM_MI], bfr[2];
#pragma unroll
      for (int mi = 0; mi < GEMM_MI; ++mi) af[mi] = *(const bf16x8*)&sA[wm * (GEMM_BM / 2) + mi * 32 + (lane & 31)][ks * 16 + (lane >> 5) * 8];
#pragma unroll
      for (int ni = 0; ni < 2; ++ni) bfr[ni] = *(const bf16x8*)&sB[wn * 64 + ni * 32 + (lane & 31)][ks * 16 + (lane >> 5) * 8];
#pragma unroll
      for (int mi = 0; mi < GEMM_MI; ++mi)
#pragma unroll
        for (int ni = 0; ni < 2; ++ni) acc[mi][ni] = __builtin_amdgcn_mfma_f32_32x32x16_bf16(af[mi], bfr[ni], acc[mi][ni], 0, 0, 0);
    }
  }
#pragma unroll
  for (int mi = 0; mi < GEMM_MI; ++mi)
#pragma unroll
    for (int r = 0; r < 16; ++r) {
      int row = wm * (GEMM_BM / 2) + mi * 32 + (r & 3) + 8 * (r >> 2) + 4 * (lane >> 5);
      int col = wn * 64 + (lane & 31);
      epi(row, col, acc[mi][0][r], acc[mi][1][r]);
    }
}

template <int LAYER>
DEV void phase_gemm_in(const Params& p, char* smem) {
  const int N = LAYER == 0 ? AB_IN : CD_IN;
  const float* A = LAYER == 0 ? p.in[I_X] : (const float*)(p.ws + OFF_X2);
  const float* B = LAYER == 0 ? p.in[I_AB_W_IN] : p.in[I_CD_W_IN];
  float* C = (float*)(p.ws + OFF_H);
  const int NT = (N + 127) / 128, MT = NTOK / GEMM_BM;
  const int xcd_ = blockIdx.x & 7, lb_ = blockIdx.x >> 3, nb_ = gridDim.x >> 3;
  for (int j_ = lb_; j_ < (MT / 8) * NT; j_ += nb_) {
    const int it = (xcd_ + 8 * (j_ / NT)) * NT + (j_ % NT);
    const int tm = it / NT, tn = it % NT;
    const int m0 = tm * GEMM_BM, n0 = tn * 128;
    gemm_tile<false>(
        [&](int r) { return (const void*)(A + (size_t)(m0 + r) * DM); },
        [&](int c) { return (n0 + c < N) ? (B + n0 + c) : (const float*)nullptr; }, N, DM,
        [&](int row, int col, float v0, float v1) {
          const int gm = m0 + row, gc = n0 + col;
          if (LAYER == 1 && gc >= 1792 && gc < 2304) {
            const int i = gc & 63;
            const float pos = (float)(gm % SEQ_LEN);
            const float inv = __expf(-(float)i * (9.210340371976184f / 32.f));
            float sn, cs;
            fast_sincos(pos * inv, &sn, &cs);
            float o0 = v0 * cs - v1 * sn, o1 = v1 * cs + v0 * sn;
            if (gc >= 2048) { o0 *= 0.125f; o1 *= 0.125f; }
            v0 = o0; v1 = o1;
          }
          if (gc < N) C[(size_t)gm * N + gc] = v0;
          if (gc + 32 < N) C[(size_t)gm * N + gc + 32] = v1;
        },
        smem);
  }
}

struct S5Const { float lb_re, lb_im; };
DEV void s5_consts(const Params& p, int g, int pp, float& lb_re, float& lb_im, float (&bbr)[16], float (&bbi)[16]) {
  const float dt = expf(p.in[I_S5_LOG_DT][g]);
  const float lr = p.in[I_S5_LAM_RE][g * 64 + pp], li = p.in[I_S5_LAM_IM][g * 64 + pp];
  const float mag = expf(lr * dt);
  float sn, cs;
  sincosf(li * dt, &sn, &cs);
  lb_re = mag * cs; lb_im = mag * sn;
  const float den = lr * lr + li * li;
  const float f_re = ((lb_re - 1.f) * lr + lb_im * li) / den;
  const float f_im = (lb_im * lr - (lb_re - 1.f) * li) / den;
  const float* br = p.in[I_S5_B_RE] + (size_t)(g * 64 + pp) * 16;
  const float* bi = p.in[I_S5_B_IM] + (size_t)(g * 64 + pp) * 16;
#pragma unroll
  for (int h = 0; h < 16; ++h) {
    bbr[h] = f_re * br[h] - f_im * bi[h];
    bbi[h] = f_re * bi[h] + f_im * br[h];
  }
}

#define OFF_QB OFF_X2
#define OFF_KSB (OFF_QB + (size_t)NTOK * 512 * 2)
#define OFF_KWB (OFF_KSB + (size_t)NTOK * 128 * 2)
#define OFF_VST (OFF_KWB + (size_t)NTOK * 128 * 2)
#define OFF_VWT (OFF_VST + (size_t)NTOK * 128 * 2)
#define OFF_KCB (OFF_VWT + (size_t)NTOK * 128 * 2)
#define OFF_VCT (OFF_KCB + (size_t)BATCH * 2 * NB_CMP * 64 * 64 * 2)
#define NSA_QSCALE (0.125f * 1.4426950408889634f)

#define P1_S5A_ITEMS (BATCH * 32 * S5_NC / 4)
#define P1_CMP_TILES ((NCMP + 7) / 8)
#define P1_CMP_ITEMS (2 * BATCH * 2 * P1_CMP_TILES)
DEV void p1_s5a(const Params& p, int item, char* smem) {
  const int lane = threadIdx.x & 63, wave = threadIdx.x >> 6;
  const int idx = item * 4 + wave;
  const int g = idx & 31, c = (idx >> 5) % S5_NC, b = idx / (32 * S5_NC);
  float lb_re, lb_im, bbr[16], bbi[16];
  s5_consts(p, g, lane, lb_re, lb_im, bbr, bbi);
  const float* H = (const float*)(p.ws + OFF_H);
  float sr = 0.f, si = 0.f;
  float* su = (float*)smem + wave * 64 * 16;
  __syncthreads();
  {
    const float* ur = H + (size_t)(b * SEQ_LEN + c * 64 + lane) * AB_IN + g * 16;
#pragma unroll
    for (int q = 0; q < 4; ++q) st4(su + lane * 16 + q * 4, ld4(ur + q * 4));
  }
  WAVE_SYNC();
  for (int tt = 0; tt < 64; ++tt) {
    const float* u = su + tt * 16;
    float dr = 0.f, di = 0.f;
#pragma unroll
    for (int h4 = 0; h4 < 4; ++h4) {
      const float4 uv = ld4(u + h4 * 4);
      dr += uv.x * bbr[h4 * 4] + uv.y * bbr[h4 * 4 + 1] + uv.z * bbr[h4 * 4 + 2] + uv.w * bbr[h4 * 4 + 3];
      di += uv.x * bbi[h4 * 4] + uv.y * bbi[h4 * 4 + 1] + uv.z * bbi[h4 * 4 + 2] + uv.w * bbi[h4 * 4 + 3];
    }
    const float nr = lb_re * sr - lb_im * si + dr;
    const float ni = lb_re * si + lb_im * sr + di;
    sr = nr; si = ni;
  }
  float2* E = (float2*)(p.ws + OFF_S5E);
  E[((size_t)(b * S5_NC + c) * 32 + g) * 64 + lane] = make_float2(sr, si);
}
#define P1_CMPG_MT ((NCMP + GEMM_BM - 1) / GEMM_BM)
#define P1_CMPG_ITEMS (2 * BATCH * 2 * P1_CMPG_MT)
DEV void p1_cmpgemm(const Params& p, int item, char* smem) {
  const int mt = item % P1_CMPG_MT;
  int r = item / P1_CMPG_MT;
  const int g = r & 1; r >>= 1;
  const int b = r % BATCH; const int which = r / BATCH;
  const float* H = (const float*)(p.ws + OFF_H);
  const float* w1 = which ? p.in[I_CV_W1] : p.in[I_CK_W1];
  const int colbase = (which ? 1152 : 1024) + g * 64;
  float* HID = (float*)(p.ws + OFF_CMPHID) + ((size_t)(which * BATCH + b) * 2 + g) * NB_CMP * 64 * 128;
  const int n0 = mt * GEMM_BM;
  gemm_tile<false>(
      [&](int rr) { return (n0 + rr < NCMP) ? (const void*)(H + ((size_t)b * SEQ_LEN + 16 * (n0 + rr)) * AB_IN + colbase) : (const void*)nullptr; },
      [&](int c) { return w1 + c; }, 128, 2048,
      [&](int row, int col, float v0, float v1) {
        if (n0 + row < NCMP) { HID[(size_t)(n0 + row) * 128 + col] = v0; HID[(size_t)(n0 + row) * 128 + col + 32] = v1; }
      },
      smem, AB_IN);
}
DEV void p1_cmpc1(const Params& p, int which, char* smem) {
  const float* pe = which ? p.in[I_PE_V] : p.in[I_PE_K];
  const float* w1 = which ? p.in[I_CV_W1] : p.in[I_CK_W1];
  float* sPart = (float*)smem;
  const int tid = threadIdx.x, hid = tid & 127, kh = tid >> 7;
  float a = 0.f;
  for (int k = kh * 1024; k < kh * 1024 + 1024; ++k) a += pe[k] * w1[(size_t)k * 128 + hid];
  __syncthreads();
  sPart[tid] = a;
  __syncthreads();
  if (tid < 128) ((float*)(p.ws + OFF_CMPC1))[which * 128 + tid] = sPart[tid] + sPart[tid + 128];
  __syncthreads();
}
DEV void p1_compress(const Params& p, int item, char* smem) {
  const int tile = item % P1_CMP_TILES;
  int r = item / P1_CMP_TILES;
  const int g = r & 1; r >>= 1;
  const int b = r % BATCH; const int which = r / BATCH;
  const int n0 = tile * 8;
  const float* b1 = which ? p.in[I_CV_B1] : p.in[I_CK_B1];
  const float* w2 = which ? p.in[I_CV_W2] : p.in[I_CK_W2];
  const float* C1 = (const float*)(p.ws + OFF_CMPC1) + which * 128;
  const float* HID = (const float*)(p.ws + OFF_CMPHID) + ((size_t)(which * BATCH + b) * 2 + g) * NB_CMP * 64 * 128;
  float* sPart = (float*)smem;
  float* sHid = sPart + 2 * 8 * 128;
  const int tid = threadIdx.x;
  __syncthreads();
  for (int w = tid; w < 8 * 128; w += NTHREADS) {
    const int rr = w >> 7, hid = w & 127;
    const int n = n0 + rr;
    sHid[w] = n < NCMP ? geluf_(HID[(size_t)n * 128 + hid] + C1[hid] + b1[hid]) : 0.f;
  }
  __syncthreads();
  float* sOut = sPart;
  for (int w = tid; w < 8 * 64; w += NTHREADS) {
    const int rr = w >> 6, d = w & 63;
    float a = 0.f;
    for (int hid = 0; hid < 128; ++hid) a += sHid[rr * 128 + hid] * w2[hid * 64 + d];
    sOut[w] = a;
  }
  __syncthreads();
  float* dst = (float*)(p.ws + (which ? OFF_VCMP : OFF_KCMP));
  for (int w = tid; w < 8 * 64; w += NTHREADS) {
    const int rr = w >> 6, d = w & 63;
    const int n = n0 + rr;
    if (n >= NCMP) continue;
    float v = sOut[w];
    if (which == 0 && d < 16) {
      const int i = d & 7;
      const float pos = (float)(n * 16 + 31);
      const float inv = __expf(-(float)i * (13.122363377404328f / 8.f));
      float sn, cs;
      sincosf(pos * inv, &sn, &cs);
      const float x1 = sOut[rr * 64 + i], x2 = sOut[rr * 64 + i + 8];
      v = d < 8 ? x1 * cs - x2 * sn : x2 * cs + x1 * sn;
    }
    dst[((size_t)(b * NCMP + n) * 2 + g) * 64 + d] = v;
    if (which == 0) ((unsigned short*)(p.ws + OFF_KCB))[(((size_t)b * 2 + g) * NB_CMP * 64 + n) * 64 + d] = f2bf(v);
    else ((unsigned short*)(p.ws + OFF_VCT))[((((size_t)b * 2 + g) * NB_CMP + (n >> 6)) * 64 + d) * 64 + (n & 63)] = f2bf(v);
  }
  for (int w = tid; w < 8 * 64; w += NTHREADS) {
    const int rr = w >> 6, d = w & 63;
    const int n = n0 + rr;
    if (n < NCMP || n >= NB_CMP * 64) continue;
    if (which == 0) ((unsigned short*)(p.ws + OFF_KCB))[(((size_t)b * 2 + g) * NB_CMP * 64 + n) * 64 + d] = 0;
    else ((unsigned short*)(p.ws + OFF_VCT))[((((size_t)b * 2 + g) * NB_CMP + (n >> 6)) * 64 + d) * 64 + (n & 63)] = 0;
  }
}
DEV uint4 pack8(const float* v) {
  uint4 r;
  r.x = (unsigned)f2bf(v[0]) | ((unsigned)f2bf(v[1]) << 16);
  r.y = (unsigned)f2bf(v[2]) | ((unsigned)f2bf(v[3]) << 16);
  r.z = (unsigned)f2bf(v[4]) | ((unsigned)f2bf(v[5]) << 16);
  r.w = (unsigned)f2bf(v[6]) | ((unsigned)f2bf(v[7]) << 16);
  return r;
}
#define P1_PREP_ITEMS (NTOK / 64)
#define P1_PREP_SMEM ((64 * 8 * 2 + 64 * 128) * 4)
DEV void p1_prep(const Params& p, int item, char* smem) {
  const int tid = threadIdx.x;
  const int b = item / NBLK, blk = item % NBLK;
  const float* H = (const float*)(p.ws + OFF_H);
  float* sCS = (float*)smem;
  float* sV = sCS + 64 * 8 * 2;
  const size_t tok0 = (size_t)b * SEQ_LEN + blk * 64;
  __syncthreads();
  for (int w = tid; w < 64 * 8; w += NTHREADS) {
    const int tk = w >> 3, i = w & 7;
    const float pos = (float)(blk * 64 + tk);
    const float inv = __expf(-(float)i * (13.122363377404328f / 8.f));
    float sn, cs;
    sincosf(pos * inv, &sn, &cs);
    sCS[w * 2] = cs; sCS[w * 2 + 1] = sn;
  }
  __syncthreads();
  unsigned short* QB = (unsigned short*)(p.ws + OFF_QB);
  unsigned short* KSB = (unsigned short*)(p.ws + OFF_KSB);
  unsigned short* KWB = (unsigned short*)(p.ws + OFF_KWB);
  for (int w = tid; w < 64 * 12 * 8; w += NTHREADS) {
    const int o = w & 7, hd = (w >> 3) % 12, tk = w / 96;
    const int col = hd < 8 ? 512 + hd * 64 : (hd < 10 ? 1280 + (hd - 8) * 64 : 1536 + (hd - 10) * 64);
    const float* x = H + (tok0 + tk) * AB_IN + col;
    float v[8];
    const float4 a0 = ld4(x + o * 8), a1 = ld4(x + o * 8 + 4);
    v[0] = a0.x; v[1] = a0.y; v[2] = a0.z; v[3] = a0.w; v[4] = a1.x; v[5] = a1.y; v[6] = a1.z; v[7] = a1.w;
    if (o < 2) {
      const float4 c0 = ld4(x + (1 - o) * 8), c1 = ld4(x + (1 - o) * 8 + 4);
      const float u[8] = {c0.x, c0.y, c0.z, c0.w, c1.x, c1.y, c1.z, c1.w};
#pragma unroll
      for (int i = 0; i < 8; ++i) {
        const float cs = sCS[(tk * 8 + i) * 2], sn = sCS[(tk * 8 + i) * 2 + 1];
        v[i] = o == 0 ? v[i] * cs - u[i] * sn : v[i] * cs + u[i] * sn;
      }
    }
    if (hd < 8) {
#pragma unroll
      for (int i = 0; i < 8; ++i) v[i] *= NSA_QSCALE;
      *(uint4*)(QB + ((tok0 + tk) * 8 + hd) * 64 + o * 8) = pack8(v);
    } else {
      const int g = (hd - 8) & 1;
      unsigned short* dst = (hd < 10 ? KSB : KWB) + (((size_t)b * 2 + g) * SEQ_LEN + blk * 64 + tk) * 64 + o * 8;
      *(uint4*)dst = pack8(v);
    }
  }
#pragma unroll 1
  for (int which = 0; which < 2; ++which) {
    const int col = which ? 1664 : 1408;
    __syncthreads();
    for (int w = tid; w < 64 * 32; w += NTHREADS) {
      const int tk = w >> 5, c4 = (w & 31) * 4;
      st4(sV + tk * 128 + c4, ld4(H + (tok0 + tk) * AB_IN + col + c4));
    }
    __syncthreads();
    unsigned short* VT = (unsigned short*)(p.ws + (which ? OFF_VWT : OFF_VST));
    for (int w = tid; w < 2 * 64 * 8; w += NTHREADS) {
      const int ko = w & 7, d = (w >> 3) & 63, g = w >> 9;
      float v[8];
#pragma unroll
      for (int i = 0; i < 8; ++i) v[i] = sV[(ko * 8 + i) * 128 + g * 64 + d];
      *(uint4*)(VT + ((((size_t)b * 2 + g) * NBLK + blk) * 64 + d) * 64 + ko * 8) = pack8(v);
    }
  }
}

struct NsaSmem {
  unsigned short k[64][72];
  unsigned short vt[64][68];
  float imp[32][128];
  unsigned selmask[32][4];
  unsigned unionm[4];
  float keyb[4][128];
};
#define P2_NSA_SMEM ((int)sizeof(NsaSmem))
#define NSA_QT (SEQ_LEN / 32)
#define P2_NSA_ITEMS (BATCH * 2 * NSA_QT)

struct TileRegs { uint4 k0, k1, v0, v1; };
DEV void tile_gload(TileRegs& r, const unsigned short* Kg, const unsigned short* Vg, int tid) {
  const int row = tid >> 2, seg = tid & 3;
  r.k0 = *(const uint4*)(Kg + row * 64 + seg * 16);
  r.k1 = *(const uint4*)(Kg + row * 64 + seg * 16 + 8);
  if (Vg) {
    r.v0 = *(const uint4*)(Vg + row * 64 + seg * 16);
    r.v1 = *(const uint4*)(Vg + row * 64 + seg * 16 + 8);
  }
}
DEV void tile_sstore(NsaSmem* sm, const TileRegs& r, bool withV, int tid) {
  const int row = tid >> 2, seg = tid & 3;
  *(uint4*)&sm->k[row][seg * 16] = r.k0;
  *(uint4*)&sm->k[row][seg * 16 + 8] = r.k1;
  if (withV) {
    *(uint2*)&sm->vt[row][seg * 16] = make_uint2(r.v0.x, r.v0.y);
    *(uint2*)&sm->vt[row][seg * 16 + 4] = make_uint2(r.v0.z, r.v0.w);
    *(uint2*)&sm->vt[row][seg * 16 + 8] = make_uint2(r.v1.x, r.v1.y);
    *(uint2*)&sm->vt[row][seg * 16 + 12] = make_uint2(r.v1.z, r.v1.w);
  }
}
DEV void qk_tile(const unsigned short (*ksm)[72], const bf16x8 (&qf)[4], f32x16 (&s)[2], int lane) {
  const int r = lane & 31, hh = lane >> 5;
#pragma unroll
  for (int ks2 = 0; ks2 < 2; ++ks2) {
#pragma unroll
    for (int i = 0; i < 16; ++i) s[ks2][i] = 0.f;
#pragma unroll
    for (int ks = 0; ks < 4; ++ks) {
      const bf16x8 a = *(const bf16x8*)&ksm[ks2 * 32 + r][ks * 16 + hh * 8];
      s[ks2] = __builtin_amdgcn_mfma_f32_32x32x16_bf16(a, qf[ks], s[ks2], 0, 0, 0);
    }
  }
}
DEV void pv_tile(const unsigned short (*vsm)[68], const f32x16 (&pr)[2], f32x16 (&o)[2], int lane) {
  const int r = lane & 31, hh = lane >> 5;
#pragma unroll
  for (int ks2 = 0; ks2 < 2; ++ks2)
#pragma unroll
    for (int s = 0; s < 2; ++s) {
      bf16x8 pf;
#pragma unroll
      for (int j = 0; j < 8; ++j) pf[j] = (short)f2bf(pr[ks2][8 * s + j]);
#pragma unroll
      for (int mt = 0; mt < 2; ++mt) {
        const uint2 lo = *(const uint2*)&vsm[mt * 32 + r][ks2 * 32 + 16 * s + 4 * hh];
        const uint2 hi = *(const uint2*)&vsm[mt * 32 + r][ks2 * 32 + 16 * s + 8 + 4 * hh];
        bf16x8 a;
        a[0] = (short)(lo.x & 0xFFFF); a[1] = (short)(lo.x >> 16); a[2] = (short)(lo.y & 0xFFFF); a[3] = (short)(lo.y >> 16);
        a[4] = (short)(hi.x & 0xFFFF); a[5] = (short)(hi.x >> 16); a[6] = (short)(hi.y & 0xFFFF); a[7] = (short)(hi.y >> 16);
        o[mt] = __builtin_amdgcn_mfma_f32_32x32x16_bf16(a, pf, o[mt], 0, 0, 0);
      }
    }
}
DEV float quad_sum(float v) {
#ifdef CPU_EMU
  v += __shfl_xor(v, 1); v += __shfl_xor(v, 2); return v;
#else
  int x;
  x = __builtin_amdgcn_update_dpp(0, __builtin_bit_cast(int, v), 0xB1, 0xF, 0xF, false); v += __builtin_bit_cast(float, x);
  x = __builtin_amdgcn_update_dpp(0, __builtin_bit_cast(int, v), 0x4E, 0xF, 0xF, false); v += __builtin_bit_cast(float, x);
  return v;
#endif
}
DEV void softmax_step(f32x16 (&s)[2], float& m, float& l, f32x16 (&o)[2]) {
  float tmax = -INFINITY;
#pragma unroll
  for (int ks2 = 0; ks2 < 2; ++ks2)
#pragma unroll
    for (int i = 0; i < 16; ++i) tmax = fmaxf(tmax, s[ks2][i]);
  tmax = fmaxf(tmax, __shfl_xor(tmax, 32));
  const float mnew = fmaxf(m, tmax);
  const float msafe = mnew == -INFINITY ? 0.f : mnew;
  const float alpha = exp2f(m - msafe);
  float ps = 0.f;
#pragma unroll
  for (int ks2 = 0; ks2 < 2; ++ks2)
#pragma unroll
    for (int i = 0; i < 16; ++i) { s[ks2][i] = exp2f(s[ks2][i] - msafe); ps += s[ks2][i]; }
  l = l * alpha + ps;
#pragma unroll
  for (int mt = 0; mt < 2; ++mt)
#pragma unroll
    for (int i = 0; i < 16; ++i) o[mt][i] *= alpha;
  m = mnew;
}
DEV bool testbit4(unsigned w0, unsigned w1, unsigned w2, unsigned w3, int j) {
  const unsigned lo = j & 32 ? w1 : w0, hi = j & 32 ? w3 : w2;
  const unsigned x = j & 64 ? hi : lo;
  return (x >> (j & 31)) & 1u;
}

DEV void p2_nsa(const Params& p, int item, char* smem) {
  NsaSmem* sm = (NsaSmem*)smem;
  const int tid = threadIdx.x, lane = tid & 63, wave = tid >> 6;
  const int bg = item & 3, b = bg >> 1, g = bg & 1;
  const int qt = NSA_QT - 1 - (item >> 2);
  const int t0 = qt * 32;
  const int c = lane & 31, hh = lane >> 5, tl = c >> 2, h = c & 3;
  const int trow = wave * 8 + tl;
  const int tq = t0 + trow;
  const size_t tok = (size_t)b * SEQ_LEN + tq;
  const int hd = g * 4 + h;
  const float* H = (const float*)(p.ws + OFF_H);
  const unsigned short* QB = (const unsigned short*)(p.ws + OFF_QB);
  const unsigned short* KSB = (const unsigned short*)(p.ws + OFF_KSB) + ((size_t)b * 2 + g) * SEQ_LEN * 64;
  const unsigned short* KWB = (const unsigned short*)(p.ws + OFF_KWB) + ((size_t)b * 2 + g) * SEQ_LEN * 64;
  const unsigned short* VST = (const unsigned short*)(p.ws + OFF_VST) + ((size_t)b * 2 + g) * NBLK * 4096;
  const unsigned short* VWT = (const unsigned short*)(p.ws + OFF_VWT) + ((size_t)b * 2 + g) * NBLK * 4096;
  const unsigned short* KCB = (const unsigned short*)(p.ws + OFF_KCB) + ((size_t)b * 2 + g) * NB_CMP * 4096;
  const unsigned short* VCT = (const unsigned short*)(p.ws + OFF_VCT) + ((size_t)b * 2 + g) * NB_CMP * 4096;
  bf16x8 qf[4];
  {
    const unsigned short* qrow = QB + (tok * 8 + hd) * 64;
#pragma unroll
    for (int ks = 0; ks < 4; ++ks) qf[ks] = *(const bf16x8*)(qrow + ks * 16 + hh * 8);
  }
  const float g0 = sigmoidf_(H[tok * AB_IN + 1792 + hd * 3 + 0]);
  const float g1 = sigmoidf_(H[tok * AB_IN + 1792 + hd * 3 + 1]);
  const float g2 = sigmoidf_(H[tok * AB_IN + 1792 + hd * 3 + 2]);
  f32x16 o[2], s[2];
#pragma unroll
  for (int mt = 0; mt < 2; ++mt)
#pragma unroll
    for (int i = 0; i < 16; ++i) o[mt][i] = 0.f;
  float* mixrow = (float*)(p.ws + OFF_MIX) + tok * 1024 + 512 + hd * 64 + 4 * hh;
  __syncthreads();
  for (int w = tid; w < 32 * 128; w += NTHREADS) (&sm->imp[0][0])[w] = 0.f;
  TileRegs tr;
  tr.k0 = tr.k1 = tr.v0 = tr.v1 = make_uint4(0, 0, 0, 0);
  const int nval = tq >= 31 ? (tq - 31) / 16 + 1 : 0;
  const int nvmax = (t0 + 31 - 31) / 16 + 1;
  const int ktn = (nvmax + 63) / 64;
  float m = -INFINITY, l = 0.f;
  tile_gload(tr, KCB, nullptr, tid);
  for (int kt = 0; kt < ktn; ++kt) {
    __syncthreads();
    tile_sstore(sm, tr, false, tid);
    __syncthreads();
    if (kt + 1 < ktn) tile_gload(tr, KCB + (size_t)(kt + 1) * 4096, nullptr, tid);
    qk_tile(sm->k, qf, s, lane);
    float tmax = -INFINITY;
#pragma unroll
    for (int ks2 = 0; ks2 < 2; ++ks2)
#pragma unroll
      for (int i = 0; i < 16; ++i) {
        const int n = kt * 64 + ks2 * 32 + (i & 3) + 8 * (i >> 2) + 4 * hh;
        s[ks2][i] = n < nval ? s[ks2][i] : -INFINITY;
        tmax = fmaxf(tmax, s[ks2][i]);
      }
    tmax = fmaxf(tmax, __shfl_xor(tmax, 32));
    const float mnew = fmaxf(m, tmax);
    const float msafe = mnew == -INFINITY ? 0.f : mnew;
    float ps = 0.f;
#pragma unroll
    for (int ks2 = 0; ks2 < 2; ++ks2)
#pragma unroll
      for (int i = 0; i < 16; ++i) ps += exp2f(s[ks2][i] - msafe);
    l = l * exp2f(m - msafe) + ps;
    m = mnew;
  }
  {
    const float ltot = l + __shfl_xor(l, 32);
    const float invl = ltot > 0.f ? 1.f / ltot : 0.f;
    const float msafe = m == -INFINITY ? 0.f : m;
    tile_gload(tr, KCB, VCT, tid);
    for (int kt = 0; kt < ktn; ++kt) {
      __syncthreads();
      tile_sstore(sm, tr, true, tid);
      __syncthreads();
      if (kt + 1 < ktn) tile_gload(tr, KCB + (size_t)(kt + 1) * 4096, VCT + (size_t)(kt + 1) * 4096, tid);
      qk_tile(sm->k, qf, s, lane);
#pragma unroll
      for (int ks2 = 0; ks2 < 2; ++ks2)
#pragma unroll
        for (int i = 0; i < 16; ++i) {
          const int n = kt * 64 + ks2 * 32 + (i & 3) + 8 * (i >> 2) + 4 * hh;
          s[ks2][i] = n < nval ? exp2f(s[ks2][i] - msafe) * invl : 0.f;
        }
#pragma unroll
      for (int ks2 = 0; ks2 < 2; ++ks2)
#pragma unroll
        for (int g4 = 0; g4 < 4; ++g4) {
          float A = 2.f * (s[ks2][4 * g4] + s[ks2][4 * g4 + 1] + s[ks2][4 * g4 + 2]) + s[ks2][4 * g4 + 3];
          float Bv = s[ks2][4 * g4 + 3];
          A = quad_sum(A); Bv = quad_sum(Bv);
          const int j = kt * 16 + ks2 * 8 + 2 * g4 + hh;
          if (h == 0 && j < NBLK) sm->imp[trow][j] += A;
          WAVE_SYNC();
          if (h == 0 && j + 1 < NBLK) sm->imp[trow][j + 1] += Bv;
          WAVE_SYNC();
        }
      pv_tile(sm->vt, s, o, lane);
    }
#pragma unroll
    for (int mt = 0; mt < 2; ++mt)
#pragma unroll
      for (int g4 = 0; g4 < 4; ++g4) {
        st4(mixrow + mt * 32 + 8 * g4, make_float4(o[mt][4 * g4] * g0, o[mt][4 * g4 + 1] * g0, o[mt][4 * g4 + 2] * g0, o[mt][4 * g4 + 3] * g0));
        o[mt][4 * g4] = 0.f; o[mt][4 * g4 + 1] = 0.f; o[mt][4 * g4 + 2] = 0.f; o[mt][4 * g4 + 3] = 0.f;
      }
  }
  WAVE_SYNC();
  for (int t8 = 0; t8 < 8; ++t8) {
    const int row = wave * 8 + t8, tt = t0 + row, cur = tt >> 6;
    float kv[2]; bool valid[2];
#pragma unroll
    for (int c2 = 0; c2 < 2; ++c2) {
      const int j = lane + 64 * c2;
      valid[c2] = j < NBLK && j <= cur;
      const bool forced = (j == 0) | (j == cur) | (j == cur - 1);
      kv[c2] = valid[c2] ? (forced ? 1e6f : sm->imp[row][j < NBLK ? j : 0]) : -1.f;
      sm->keyb[wave][j] = kv[c2];
    }
    WAVE_SYNC();
    int rank0 = 0, rank1 = 0;
    const int jlim = cur < NBLK - 1 ? cur : NBLK - 1;
    for (int jj = 0; jj <= jlim; ++jj) {
      const float ov = sm->keyb[wave][jj];
      rank0 += (ov > kv[0] || (ov == kv[0] && jj < lane)) ? 1 : 0;
      rank1 += (ov > kv[1] || (ov == kv[1] && jj < lane + 64)) ? 1 : 0;
    }
    const unsigned long long m0 = __ballot(valid[0] && rank0 < 16);
    const unsigned long long m1 = __ballot(valid[1] && rank1 < 16);
    if (lane == 0) {
      sm->selmask[row][0] = (unsigned)m0; sm->selmask[row][1] = (unsigned)(m0 >> 32);
      sm->selmask[row][2] = (unsigned)m1; sm->selmask[row][3] = (unsigned)(m1 >> 32);
    }
    WAVE_SYNC();
  }
  __syncthreads();
  if (tid < 4) {
    unsigned u = 0;
    for (int r = 0; r < 32; ++r) u |= sm->selmask[r][tid];
    sm->unionm[tid] = u;
  }
  __syncthreads();
  const unsigned um0 = sm->unionm[0], um1 = sm->unionm[1], um2 = sm->unionm[2], um3 = sm->unionm[3];
  const unsigned my0 = sm->selmask[trow][0], my1 = sm->selmask[trow][1], my2 = sm->selmask[trow][2], my3 = sm->selmask[trow][3];
  {
    const int jmax = (t0 + 31) >> 6;
    int j = 0;
    while (j <= jmax && !testbit4(um0, um1, um2, um3, j)) ++j;
    m = -INFINITY; l = 0.f;
    if (j <= jmax) tile_gload(tr, KSB + (size_t)j * 4096, VST + (size_t)j * 4096, tid);
    while (j <= jmax) {
      __syncthreads();
      tile_sstore(sm, tr, true, tid);
      __syncthreads();
      int jn = j + 1;
      while (jn <= jmax && !testbit4(um0, um1, um2, um3, jn)) ++jn;
      if (jn <= jmax) tile_gload(tr, KSB + (size_t)jn * 4096, VST + (size_t)jn * 4096, tid);
      const bool mine = testbit4(my0, my1, my2, my3, j);
      if (__ballot(mine) != 0ull) {
        qk_tile(sm->k, qf, s, lane);
#pragma unroll
        for (int ks2 = 0; ks2 < 2; ++ks2)
#pragma unroll
          for (int i = 0; i < 16; ++i) {
            const int kp = j * 64 + ks2 * 32 + (i & 3) + 8 * (i >> 2) + 4 * hh;
            s[ks2][i] = (mine && kp <= tq) ? s[ks2][i] : -INFINITY;
          }
        softmax_step(s, m, l, o);
        pv_tile(sm->vt, s, o, lane);
      }
      j = jn;
    }
    const float ltot = l + __shfl_xor(l, 32);
    const float sc = ltot > 0.f ? g1 / ltot : 0.f;
#pragma unroll
    for (int mt = 0; mt < 2; ++mt)
#pragma unroll
      for (int g4 = 0; g4 < 4; ++g4) {
        float4 a = ld4(mixrow + mt * 32 + 8 * g4);
        a.x += o[mt][4 * g4] * sc; a.y += o[mt][4 * g4 + 1] * sc; a.z += o[mt][4 * g4 + 2] * sc; a.w += o[mt][4 * g4 + 3] * sc;
        st4(mixrow + mt * 32 + 8 * g4, a);
        o[mt][4 * g4] = 0.f; o[mt][4 * g4 + 1] = 0.f; o[mt][4 * g4 + 2] = 0.f; o[mt][4 * g4 + 3] = 0.f;
      }
  }
  {
    const int jlo = t0 - 511 > 0 ? (t0 - 511) >> 6 : 0, jhi = (t0 + 31) >> 6;
    const int wq0 = t0 + wave * 8;
    m = -INFINITY; l = 0.f;
    tile_gload(tr, KWB + (size_t)jlo * 4096, VWT + (size_t)jlo * 4096, tid);
    for (int j = jlo; j <= jhi; ++j) {
      __syncthreads();
      tile_sstore(sm, tr, true, tid);
      __syncthreads();
      if (j + 1 <= jhi) tile_gload(tr, KWB + (size_t)(j + 1) * 4096, VWT + (size_t)(j + 1) * 4096, tid);
      if (j * 64 <= wq0 + 7 && j * 64 + 63 > wq0 - 512) {
        qk_tile(sm->k, qf, s, lane);
#pragma unroll
        for (int ks2 = 0; ks2 < 2; ++ks2)
#pragma unroll
          for (int i = 0; i < 16; ++i) {
            const int kp = j * 64 + ks2 * 32 + (i & 3) + 8 * (i >> 2) + 4 * hh;
            s[ks2][i] = (kp <= tq && kp > tq - 512) ? s[ks2][i] : -INFINITY;
          }
        softmax_step(s, m, l, o);
        pv_tile(sm->vt, s, o, lane);
      }
    }
    const float ltot = l + __shfl_xor(l, 32);
    const float sc = ltot > 0.f ? g2 / ltot : 0.f;
#pragma unroll
    for (int mt = 0; mt < 2; ++mt)
#pragma unroll
      for (int g4 = 0; g4 < 4; ++g4) {
        float4 a = ld4(mixrow + mt * 32 + 8 * g4);
        a.x += o[mt][4 * g4] * sc; a.y += o[mt][4 * g4 + 1] * sc; a.z += o[mt][4 * g4 + 2] * sc; a.w += o[mt][4 * g4 + 3] * sc;
        st4(mixrow + mt * 32 + 8 * g4, a);
        o[mt][4 * g4] = 0.f; o[mt][4 * g4 + 1] = 0.f; o[mt][4 * g4 + 2] = 0.f; o[mt][4 * g4 + 3] = 0.f;
      }
  }
}

#define P1_SMEM ((2 * 8 * 128 + 8 * 128) * 4)
DEV void phase_p1(const Params& p, char* smem) {
  const int total = P1_CMPG_ITEMS + 2 + P1_S5A_ITEMS + P1_PREP_ITEMS;
  for (int it = blockIdx.x; it < total; it += gridDim.x) {
    if (it < P1_CMPG_ITEMS) p1_cmpgemm(p, it, smem);
    else if (it < P1_CMPG_ITEMS + 2) p1_cmpc1(p, it - P1_CMPG_ITEMS, smem);
    else if (it < P1_CMPG_ITEMS + 2 + P1_PREP_ITEMS) p1_prep(p, it - P1_CMPG_ITEMS - 2, smem);
    else p1_s5a(p, it - P1_CMPG_ITEMS - 2 - P1_PREP_ITEMS, smem);
  }
}
DEV void phase_p1b(const Params& p, char* smem) {
  for (int it = blockIdx.x; it < P1_CMP_ITEMS; it += gridDim.x) p1_compress(p, it, smem);
}

#define P2_S5C_ITEMS (BATCH * 32 * S5_NC / 4)
#define S5C_ROW 132
#define P2_S5C_SMEM (4 * 16 * S5C_ROW * 4 + 4 * 64 * 16 * 4)
DEV void p2_s5c(const Params& p, int item, char* smem) {
  const int lane = threadIdx.x & 63, wave = threadIdx.x >> 6;
  const int idx = item * 4 + wave;
  const int g = idx & 31, c = (idx >> 5) % S5_NC, b = idx / (32 * S5_NC);
  float lb_re, lb_im, bbr[16], bbi[16];
  s5_consts(p, g, lane, lb_re, lb_im, bbr, bbi);
  float ar = lb_re, ai = lb_im;
#pragma unroll
  for (int s = 0; s < 6; ++s) { const float nr = ar * ar - ai * ai, ni = 2.f * ar * ai; ar = nr; ai = ni; }
  const float2* E = (const float2*)(p.ws + OFF_S5E);
  float sr = 0.f, si = 0.f;
  {
    int cc = 0;
    for (; cc + 8 <= c; cc += 8) {
      float2 e[8];
#pragma unroll
      for (int q = 0; q < 8; ++q) e[q] = E[((size_t)(b * S5_NC + cc + q) * 32 + g) * 64 + lane];
#pragma unroll
      for (int q = 0; q < 8; ++q) {
        const float nr = ar * sr - ai * si + e[q].x, ni = ar * si + ai * sr + e[q].y;
        sr = nr; si = ni;
      }
    }
    for (; cc < c; ++cc) {
      const float2 e = E[((size_t)(b * S5_NC + cc) * 32 + g) * 64 + lane];
      const float nr = ar * sr - ai * si + e.x, ni = ar * si + ai * sr + e.y;
      sr = nr; si = ni;
    }
  }
  __syncthreads();
  const float* H = (const float*)(p.ws + OFF_H);
  float* sS = (float*)smem + wave * 16 * S5C_ROW;
  float* su = (float*)smem + 4 * 16 * S5C_ROW + wave * 64 * 16;
  {
    const float* ur = H + (size_t)(b * SEQ_LEN + c * 64 + lane) * AB_IN + g * 16;
#pragma unroll
    for (int q = 0; q < 4; ++q) st4(su + lane * 16 + q * 4, ld4(ur + q * 4));
  }
  __syncthreads();
  const float* cre = p.in[I_S5_C_RE] + (size_t)g * 16 * 64;
  const float* cim = p.in[I_S5_C_IM] + (size_t)g * 16 * 64;
  float* YG = (float*)(p.ws + OFF_YGELU);
  for (int sc = 0; sc < 4; ++sc) {
    for (int tt = 0; tt < 16; ++tt) {
      const float* u = su + (sc * 16 + tt) * 16;
      float dr = 0.f, di = 0.f;
#pragma unroll
      for (int h4 = 0; h4 < 4; ++h4) {
        const float4 uv = ld4(u + h4 * 4);
        dr += uv.x * bbr[h4 * 4] + uv.y * bbr[h4 * 4 + 1] + uv.z * bbr[h4 * 4 + 2] + uv.w * bbr[h4 * 4 + 3];
        di += uv.x * bbi[h4 * 4] + uv.y * bbi[h4 * 4 + 1] + uv.z * bbi[h4 * 4 + 2] + uv.w * bbi[h4 * 4 + 3];
      }
      const float nr = lb_re * sr - lb_im * si + dr, ni = lb_re * si + lb_im * sr + di;
      sr = nr; si = ni;
      sS[tt * S5C_ROW + lane] = sr;
      sS[tt * S5C_ROW + 64 + lane] = si;
    }
    __syncthreads();
    {
      const int tt = lane >> 2, hq = lane & 3;
      float y[4] = {0.f, 0.f, 0.f, 0.f};
      for (int k = 0; k < 64; k += 4) {
        const float4 vr = ld4(sS + tt * S5C_ROW + k), vi = ld4(sS + tt * S5C_ROW + 64 + k);
#pragma unroll
        for (int hh = 0; hh < 4; ++hh) {
          const float4 cr = ld4(cre + (hq * 4 + hh) * 64 + k), ci = ld4(cim + (hq * 4 + hh) * 64 + k);
          y[hh] += vr.x * cr.x + vr.y * cr.y + vr.z * cr.z + vr.w * cr.w - (vi.x * ci.x + vi.y * ci.y + vi.z * ci.z + vi.w * ci.w);
        }
      }
      const size_t tok = (size_t)(b * SEQ_LEN + c * 64 + sc * 16 + tt);
      const int ch = g * 16 + hq * 4;
      const float4 uv = ld4(H + tok * AB_IN + ch);
      const float4 dv = ld4(p.in[I_S5_D] + ch);
      float4 o;
      o.x = geluf_(y[0] + dv.x * uv.x); o.y = geluf_(y[1] + dv.y * uv.y);
      o.z = geluf_(y[2] + dv.z * uv.z); o.w = geluf_(y[3] + dv.w * uv.w);
      st4(YG + tok * 512 + ch, o);
    }
    __syncthreads();
  }
}

#define P2_SMEM (P2_S5C_SMEM > P2_NSA_SMEM ? P2_S5C_SMEM : P2_NSA_SMEM)
DEV void phase_p2(const Params& p, char* smem) {
  const int G = gridDim.x;
  const int total = P2_NSA_ITEMS + P2_S5C_ITEMS;
  for (int r = 0;; ++r) {
    const int it = r * G + ((r & 1) ? (G - 1 - (int)blockIdx.x) : (int)blockIdx.x);
    if (r * G >= total) break;
    if (it >= total) continue;
    if (it < P2_NSA_ITEMS) p2_nsa(p, it, smem);
    else p2_s5c(p, it - P2_NSA_ITEMS, smem);
  }
}

DEV void phase_glu(const Params& p, char* smem) {
  const float* A = (const float*)(p.ws + OFF_YGELU);
  const float* B = p.in[I_S5_W_GLU];
  const float* bias = p.in[I_S5_B_GLU];
  float* MIX = (float*)(p.ws + OFF_MIX);
  const int NT = 4, MT = NTOK / GEMM_BM;
  const int xcd_ = blockIdx.x & 7, lb_ = blockIdx.x >> 3, nb_ = gridDim.x >> 3;
  for (int j_ = lb_; j_ < (MT / 8) * NT; j_ += nb_) {
    const int it = (xcd_ + 8 * (j_ / NT)) * NT + (j_ % NT);
    const int m0 = (it / NT) * GEMM_BM, n0 = (it % NT) * 128;
    gemm_tile<false>(
        [&](int r) { return (const void*)(A + (size_t)(m0 + r) * 512); },
        [&](int c) { return B + n0 + c; }, 512, 512,
        [&](int row, int col, float v0, float v1) {
          const size_t gm = m0 + row; const int gc = n0 + col;
          const float y0 = A[gm * 512 + gc], y1 = A[gm * 512 + gc + 32];
          MIX[gm * 1024 + gc] = y0 * sigmoidf_(v0 + bias[gc]);
          MIX[gm * 1024 + gc + 32] = y1 * sigmoidf_(v1 + bias[gc + 32]);
        },
        smem);
  }
}

template <int LAYER>
DEV void phase_outproj(const Params& p, char* smem) {
  const float* A = (const float*)(p.ws + OFF_MIX);
  const float* B = LAYER == 0 ? p.in[I_AB_W_OUT] : p.in[I_CD_W_OUT];
  const float* xin = LAYER == 0 ? p.in[I_X] : (const float*)(p.ws + OFF_X2);
  float* PRE = (float*)(p.ws + OFF_H);
  const int NT = 8, MT = NTOK / GEMM_BM;
  const int xcd_ = blockIdx.x & 7, lb_ = blockIdx.x >> 3, nb_ = gridDim.x >> 3;
  for (int j_ = lb_; j_ < (MT / 8) * NT; j_ += nb_) {
    const int it = (xcd_ + 8 * (j_ / NT)) * NT + (j_ % NT);
    const int m0 = (it / NT) * GEMM_BM, n0 = (it % NT) * 128;
    gemm_tile<false>(
        [&](int r) { return (const void*)(A + (size_t)(m0 + r) * 1024); },
        [&](int c) { return B + n0 + c; }, 1024, 1024,
        [&](int row, int col, float v0, float v1) {
          const size_t o = (size_t)(m0 + row) * 1024 + n0 + col;
          PRE[o] = ALPHA_F * xin[o] + v0;
          PRE[o + 32] = ALPHA_F * xin[o + 32] + v1;
        },
        smem);
  }
}

DEV void wave_ln(float (&v)[16], const float* gam, const float* bet, int lane) {
  float s = 0.f;
#pragma unroll
  for (int i = 0; i < 16; ++i) s += v[i];
  const float mu = wave_sum(s) * (1.f / 1024.f);
  float q = 0.f;
#pragma unroll
  for (int i = 0; i < 16; ++i) { const float d = v[i] - mu; q += d * d; }
  const float rstd = rsqrtf(wave_sum(q) * (1.f / 1024.f) + 1e-5f);
#pragma unroll
  for (int i = 0; i < 4; ++i) {
    const float4 gv = ld4(gam + lane * 4 + 256 * i), bv = ld4(bet + lane * 4 + 256 * i);
    v[i * 4 + 0] = (v[i * 4 + 0] - mu) * rstd * gv.x + bv.x;
    v[i * 4 + 1] = (v[i * 4 + 1] - mu) * rstd * gv.y + bv.y;
    v[i * 4 + 2] = (v[i * 4 + 2] - mu) * rstd * gv.z + bv.z;
    v[i * 4 + 3] = (v[i * 4 + 3] - mu) * rstd * gv.w + bv.w;
  }
}

#define P5_SMEM (4 * (4 * 1024 + 64) * 4)
template <int LAYER>
DEV void phase_ln_router(const Params& p, char* smem) {
  const int lane = threadIdx.x & 63, wave = threadIdx.x >> 6;
  const float* PRE = (const float*)(p.ws + OFF_H);
  float* X1 = (float*)(p.ws + OFF_X1);
  const float* router = p.in[I_ROUTER] + (size_t)LAYER * 1024 * 64;
  const float* bias = p.in[I_MOE_BIAS] + LAYER * 64;
  int* TOPI = (int*)(p.ws + OFF_TOPI);
  float* TOPG = (float*)(p.ws + OFF_TOPG);
  float* xs = (float*)smem + wave * (4 * 1024 + 64);
  float* ms = xs + 4 * 1024;
  for (int it = blockIdx.x; it < NTOK / 16; it += gridDim.x) {
    const size_t tokb = (size_t)it * 16 + wave * 4;
    WAVE_SYNC();
#pragma unroll 1
    for (int t = 0; t < 4; ++t) {
      const size_t tok = tokb + t;
      float v[16];
#pragma unroll
      for (int i = 0; i < 4; ++i) {
        const float4 a = ld4(PRE + tok * 1024 + lane * 4 + 256 * i);
        v[i * 4] = a.x; v[i * 4 + 1] = a.y; v[i * 4 + 2] = a.z; v[i * 4 + 3] = a.w;
      }
      wave_ln(v, p.in[I_LN1_G] + LAYER * 1024, p.in[I_LN1_B] + LAYER * 1024, lane);
#pragma unroll
      for (int i = 0; i < 4; ++i) {
        const float4 a = make_float4(v[i * 4], v[i * 4 + 1], v[i * 4 + 2], v[i * 4 + 3]);
        st4(X1 + tok * 1024 + lane * 4 + 256 * i, a);
        st4(xs + t * 1024 + lane * 4 + 256 * i, a);
      }
    }
    WAVE_SYNC();
    float lg[4] = {0.f, 0.f, 0.f, 0.f};
    for (int k = 0; k < 1024; k += 4) {
      const float r0 = router[(size_t)k * 64 + lane], r1 = router[(size_t)(k + 1) * 64 + lane],
                  r2 = router[(size_t)(k + 2) * 64 + lane], r3 = router[(size_t)(k + 3) * 64 + lane];
#pragma unroll
      for (int t = 0; t < 4; ++t) {
        const float4 xv = ld4(xs + t * 1024 + k);
        lg[t] += xv.x * r0 + xv.y * r1 + xv.z * r2 + xv.w * r3;
      }
    }
#pragma unroll
    for (int t = 0; t < 4; ++t) {
      const size_t tok = tokb + t;
      const float score = 1.f / (1.f + expf(-lg[t]));
      const float biased = score + bias[lane];
      float m1 = biased; int a1 = lane;
#pragma unroll
      for (int mm = 1; mm <= 4; mm <<= 1) {
        const float ov = __shfl_xor(m1, mm); const int oa = __shfl_xor(a1, mm);
        if (ov > m1 || (ov == m1 && oa < a1)) { m1 = ov; a1 = oa; }
      }
      float m2 = lane == a1 ? -INFINITY : biased;
#pragma unroll
      for (int mm = 1; mm <= 4; mm <<= 1) m2 = fmaxf(m2, __shfl_xor(m2, mm));
      const float gs = m1 + m2;
      const int mygrp = lane >> 3;
      int rank = 0;
#pragma unroll
      for (int gg = 0; gg < 8; ++gg) {
        const float og = __shfl(gs, gg * 8);
        rank += (og > gs || (og == gs && gg < mygrp)) ? 1 : 0;
      }
      const float masked = rank < 4 ? biased : -INFINITY;
      WAVE_SYNC();
      ms[lane] = masked;
      WAVE_SYNC();
      int erank = 0;
      for (int e = 0; e < 64; ++e) {
        const float ov = ms[e];
        erank += (ov > masked || (ov == masked && e < lane)) ? 1 : 0;
      }
      const bool selected = erank < 8;
      const float gsum = wave_sum(selected ? score : 0.f);
      if (selected) {
        TOPI[tok * 8 + erank] = lane;
        TOPG[tok * 8 + erank] = score / gsum * 2.5f;
      }
    }
  }
}

#define P6_SMEM GEMM_SMEM_BYTES
template <int LAYER>
DEV void phase_lists_shup(const Params& p, char* smem) {
  const int tid = threadIdx.x, lane = tid & 63, wave = tid >> 6;
  const int* TOPI = (const int*)(p.ws + OFF_TOPI);
  const float* TOPG = (const float*)(p.ws + OFF_TOPG);
  int* POSOF = (int*)(p.ws + OFF_POSOF);
  int* CNT = (int*)(p.ws + OFF_CNT);
  int* LTOK = (int*)(p.ws + OFF_LTOK);
  float* LGATE = (float*)(p.ws + OFF_LGATE);
  const float* X1 = (const float*)(p.ws + OFF_X1);
  unsigned short* HS = (unsigned short*)(p.ws + OFF_HS);
  const float* W1 = p.in[I_SH_W1] + (size_t)LAYER * 1024 * 256;
  const float* W3 = p.in[I_SH_W3] + (size_t)LAYER * 1024 * 256;
  const int MT = NTOK / GEMM_BM;
  int* swave = (int*)smem;
  for (int it = blockIdx.x; it < 64; it += gridDim.x) {
    const int e = it;
    int base = 0;
    for (int t0 = 0; t0 < NTOK; t0 += NTHREADS) {
      const int tok = t0 + tid;
      int slot = -1;
#pragma unroll
      for (int s = 0; s < 8; ++s) if (TOPI[(size_t)tok * 8 + s] == e) slot = s;
      const unsigned long long bal = __ballot(slot >= 0);
      const int pre = __popcll(bal & ((1ull << lane) - 1ull));
      __syncthreads();
      if (lane == 0) swave[wave] = __popcll(bal);
      __syncthreads();
      int woff = 0, tot = 0;
#pragma unroll
      for (int w = 0; w < 4; ++w) { const int c = swave[w]; if (w < wave) woff += c; tot += c; }
      if (slot >= 0) {
        const int pos = base + woff + pre;
        LTOK[(size_t)e * NTOK + pos] = tok;
        LGATE[(size_t)e * NTOK + pos] = TOPG[(size_t)tok * 8 + slot];
        POSOF[(size_t)tok * 8 + slot] = pos;
      }
      base += tot;
    }
    if (tid == 0) CNT[e] = base;
    __syncthreads();
  }
  {
    const int NT = 4;
    const int xcd_ = blockIdx.x & 7, lb_ = blockIdx.x >> 3, nb_ = gridDim.x >> 3;
    for (int j_ = lb_; j_ < (MT / 8) * NT; j_ += nb_) {
      const int m0 = (xcd_ + 8 * (j_ / NT)) * GEMM_BM, ct = j_ % NT;
      gemm_tile<false>(
          [&](int r) { return (const void*)(X1 + (size_t)(m0 + r) * 1024); },
          [&](int c) { return (((c >> 5) & 1) ? W3 : W1) + ct * 64 + (c >> 6) * 32 + (c & 31); }, 256, 1024,
          [&](int row, int col, float v0, float v1) {
            const int lc = ct * 64 + (col >> 6) * 32 + (col & 31);
            HS[(size_t)(m0 + row) * 256 + lc] = f2bf(siluf_(v0) * v1);
          },
          smem);
    }
  }
}

struct ExpMap { int tstart[65]; int rbase[65]; int ltile[9]; };
DEV void build_expmap(const Params& p, ExpMap* em) {
  __syncthreads();
  if (threadIdx.x == 0) {
    const int* CNT = (const int*)(p.ws + OFF_CNT);
    int ts = 0, rb = 0;
    for (int e = 0; e < 64; ++e) {
      em->tstart[e] = ts; em->rbase[e] = rb;
      const int c = CNT[e];
      ts += (c + GEMM_BM - 1) / GEMM_BM; rb += c;
    }
    em->tstart[64] = ts; em->rbase[64] = rb;
    const int x = blockIdx.x & 7;
    int lt = 0;
    for (int k = 0; k < 8; ++k) { em->ltile[k] = lt; lt += em->tstart[x + 8 * k + 1] - em->tstart[x + 8 * k]; }
    em->ltile[8] = lt;
  }
  __syncthreads();
}
DEV void map_expert_tile(const ExpMap* em, int j, int CT, int& e, int& rt, int& ct) {
  const int jr = j / CT; ct = j % CT;
  int k = 0;
  for (int q = 1; q < 8; ++q) if (em->ltile[q] <= jr) k = q;
  e = (blockIdx.x & 7) + 8 * k; rt = jr - em->ltile[k];
}
#define P7_SMEM (GEMM_SMEM_BYTES + 1024)
template <int LAYER>
DEV void phase_routed_up(const Params& p, char* smem) {
  ExpMap* em = (ExpMap*)(smem + GEMM_SMEM_BYTES);
  build_expmap(p, em);
  const int* CNT = (const int*)(p.ws + OFF_CNT);
  const int* LTOK = (const int*)(p.ws + OFF_LTOK);
  const float* X1 = (const float*)(p.ws + OFF_X1);
  unsigned short* HR = (unsigned short*)(p.ws + OFF_HR);
  const int lb_ = blockIdx.x >> 3, nb_ = gridDim.x >> 3;
  for (int j_ = lb_; j_ < em->ltile[8] * 4; j_ += nb_) {
    int e, rtl, ct;
    map_expert_tile(em, j_, 4, e, rtl, ct);
    const int r0 = rtl * GEMM_BM;
    const int cnt = CNT[e], rbase = em->rbase[e];
    const float* W1 = p.in[I_MOE_W1] + ((size_t)LAYER * 64 + e) * 1024 * 256;
    const float* W3 = p.in[I_MOE_W3] + ((size_t)LAYER * 64 + e) * 1024 * 256;
    gemm_tile<false>(
        [&](int r) { return (r0 + r < cnt) ? (const void*)(X1 + (size_t)LTOK[(size_t)e * NTOK + r0 + r] * 1024) : (const void*)nullptr; },
        [&](int c) { return (((c >> 5) & 1) ? W3 : W1) + ct * 64 + (c >> 6) * 32 + (c & 31); }, 256, 1024,
        [&](int row, int col, float v0, float v1) {
          if (r0 + row < cnt) {
            const int lc = ct * 64 + (col >> 6) * 32 + (col & 31);
            HR[(size_t)(rbase + r0 + row) * 256 + lc] = f2bf(siluf_(v0) * v1);
          }
        },
        smem);
  }
}

template <int LAYER>
DEV void phase_down(const Params& p, char* smem) {
  ExpMap* em = (ExpMap*)(smem + GEMM_SMEM_BYTES);
  build_expmap(p, em);
  const int* CNT = (const int*)(p.ws + OFF_CNT);
  const float* LGATE = (const float*)(p.ws + OFF_LGATE);
  const unsigned short* HR = (const unsigned short*)(p.ws + OFF_HR);
  const unsigned short* HS = (const unsigned short*)(p.ws + OFF_HS);
  unsigned short* Y = (unsigned short*)(p.ws + OFF_Y);
  float* FS = (float*)(p.ws + OFF_FS);
  const int xcd_ = blockIdx.x & 7, lb_ = blockIdx.x >> 3, nb_ = gridDim.x >> 3;
  for (int j_ = lb_; j_ < em->ltile[8] * 8; j_ += nb_) {
    int e, rtl, ct;
    map_expert_tile(em, j_, 8, e, rtl, ct);
    const int r0 = rtl * GEMM_BM;
    const int cnt = CNT[e], rbase = em->rbase[e];
    const float* W2 = p.in[I_MOE_W2] + ((size_t)LAYER * 64 + e) * 256 * 1024;
    const int n0 = ct * 128;
    gemm_tile<true>(
        [&](int r) { return (r0 + r < cnt) ? (const void*)(HR + (size_t)(rbase + r0 + r) * 256) : (const void*)nullptr; },
        [&](int c) { return W2 + n0 + c; }, 1024, 256,
        [&](int row, int col, float v0, float v1) {
          if (r0 + row < cnt) {
            const float gt = LGATE[(size_t)e * NTOK + r0 + row];
            const size_t o = (size_t)(rbase + r0 + row) * 1024 + n0 + col;
            Y[o] = f2bf(v0 * gt); Y[o + 32] = f2bf(v1 * gt);
          }
        },
        smem);
  }
  {
    const int MT = NTOK / GEMM_BM, NT = 8;
    const float* W2 = p.in[I_SH_W2] + (size_t)LAYER * 256 * 1024;
    for (int j_ = lb_; j_ < (MT / 8) * NT; j_ += nb_) {
      const int m0 = (xcd_ + 8 * (j_ / NT)) * GEMM_BM, n0 = (j_ % NT) * 128;
      gemm_tile<true>(
          [&](int r) { return (const void*)(HS + (size_t)(m0 + r) * 256); },
          [&](int c) { return W2 + n0 + c; }, 1024, 256,
          [&](int row, int col, float v0, float v1) {
            const size_t o = (size_t)(m0 + row) * 1024 + n0 + col;
            FS[o] = v0; FS[o + 32] = v1;
          },
          smem);
    }
  }
}

template <int LAYER>
DEV void phase_combine(const Params& p, char* smem) {
  ExpMap* em = (ExpMap*)smem;
  build_expmap(p, em);
  const int lane = threadIdx.x & 63, wave = threadIdx.x >> 6;
  const float* X1 = (const float*)(p.ws + OFF_X1);
  const float* FS = (const float*)(p.ws + OFF_FS);
  const unsigned short* Y = (const unsigned short*)(p.ws + OFF_Y);
  const int* TOPI = (const int*)(p.ws + OFF_TOPI);
  const int* POSOF = (const int*)(p.ws + OFF_POSOF);
  float* OUT = LAYER == 0 ? (float*)(p.ws + OFF_X2) : p.out;
  for (int it = blockIdx.x; it < NTOK / 4; it += gridDim.x) {
    const size_t tok = (size_t)it * 4 + wave;
    float v[16];
#pragma unroll
    for (int i = 0; i < 4; ++i) {
      const float4 a = ld4(X1 + tok * 1024 + lane * 4 + 256 * i), f = ld4(FS + tok * 1024 + lane * 4 + 256 * i);
      v[i * 4] = ALPHA_F * a.x + f.x; v[i * 4 + 1] = ALPHA_F * a.y + f.y; v[i * 4 + 2] = ALPHA_F * a.z + f.z; v[i * 4 + 3] = ALPHA_F * a.w + f.w;
    }
    for (int s = 0; s < 8; ++s) {
      const int e = TOPI[tok * 8 + s];
      const size_t row = (size_t)em->rbase[e] + POSOF[tok * 8 + s];
#pragma unroll
      for (int i = 0; i < 4; ++i) {
        const uint2 y = *(const uint2*)(Y + row * 1024 + lane * 4 + 256 * i);
        v[i * 4] += bf2f((unsigned short)(y.x & 0xFFFF)); v[i * 4 + 1] += bf2f((unsigned short)(y.x >> 16));
        v[i * 4 + 2] += bf2f((unsigned short)(y.y & 0xFFFF)); v[i * 4 + 3] += bf2f((unsigned short)(y.y >> 16));
      }
    }
    wave_ln(v, p.in[I_LN2_G] + LAYER * 1024, p.in[I_LN2_B] + LAYER * 1024, lane);
#pragma unroll
    for (int i = 0; i < 4; ++i) st4(OUT + tok * 1024 + lane * 4 + 256 * i, make_float4(v[i * 4], v[i * 4 + 1], v[i * 4 + 2], v[i * 4 + 3]));
  }
}

DEV float shifted(const float* Hc, size_t tok, int col, const float* mu) {
  const float cur = Hc[tok * CD_IN + col];
  const float prev = (tok % SEQ_LEN) == 0 ? 0.f : Hc[(tok - 1) * CD_IN + col];
  return cur + (prev - cur) * mu[col];
}

#define P11_PREP_ITEMS (NTOK / 8)
#define P11_KV_ITEMS (BATCH * 4 * RET_NC)
#define P11_SMEM (8 * 128 * 4)
DEV void p11_prep(const Params& p, int item, char* smem) {
  const int tid = threadIdx.x;
  const float* Hc = (const float*)(p.ws + OFF_H);
  const float* mu = p.in[I_RW_MU];
  float* sl = (float*)smem;
  __syncthreads();
  for (int w = tid; w < 8 * 128; w += NTHREADS) {
    const int tt = w >> 7, j = w & 127;
    const size_t tok = (size_t)item * 8 + tt;
    const float v = shifted(Hc, tok, 1536 + j, mu);
    sl[w] = j < 64 ? tanhf(v) : v;
  }
  __syncthreads();
  float* RWW = (float*)(p.ws + OFF_RWW); float* RWK = (float*)(p.ws + OFF_RWK);
  float* RWKK = (float*)(p.ws + OFF_RWKK); float* RWA = (float*)(p.ws + OFF_RWA);
  float* RWR = p.out + (size_t)NTOK * 512; float* RWV = p.out;
  const float* w_up = p.in[I_RW_W_UP]; const float* a_up = p.in[I_RW_A_UP];
#pragma unroll
  for (int cc = 0; cc < 2; ++cc) {
    const int c = tid + 256 * cc;
    float aw[8], aa[8];
#pragma unroll
    for (int tt = 0; tt < 8; ++tt) { aw[tt] = 0.f; aa[tt] = 0.f; }
    for (int j = 0; j < 64; ++j) {
      const float wu = w_up[j * 512 + c], au = a_up[j * 512 + c];
#pragma unroll
      for (int tt = 0; tt < 8; ++tt) { aw[tt] += sl[tt * 128 + j] * wu; aa[tt] += sl[tt * 128 + 64 + j] * au; }
    }
    const float w0 = p.in[I_RW_W0][c], a0 = p.in[I_RW_A0][c], kkc = p.in[I_RW_K_K][c], kac = p.in[I_RW_K_A][c];
#pragma unroll
    for (int tt = 0; tt < 8; ++tt) {
      const size_t tok = (size_t)item * 8 + tt;
      const float lw = w0 + aw[tt];
      const float nl = -lw;
      const float sp = nl > 20.f ? nl : log1pf(expf(nl));
      const float wl = -sp - 0.5f;
      const float decay = expf(-expf(wl));
      const float a = 1.f / (1.f + expf(-(a0 + aa[tt])));
      const float rs = shifted(Hc, tok, c, mu);
      const float ks = shifted(Hc, tok, 512 + c, mu);
      const float vs = shifted(Hc, tok, 1024 + c, mu);
      float kk = ks * kkc;
      const float nrm = sqrtf(wave_sum(kk * kk));
      kk = kk / fmaxf(nrm, 1e-12f);
      RWW[tok * 512 + c] = decay;
      RWK[tok * 512 + c] = ks * (1.f + (a - 1.f) * kac);
      RWKK[tok * 512 + c] = kk;
      RWA[tok * 512 + c] = kk * a;
      RWR[tok * 512 + c] = rs;
      RWV[tok * 512 + c] = vs;
    }
  }
}
DEV float ret_log2gamma(int h) { return log2f(1.f - exp2f(-5.f - (float)h)); }
DEV void p11_kv(const Params& p, int item) {
  const int c = item % RET_NC, h = (item / RET_NC) & 3, b = item / (RET_NC * 4);
  const int tid = threadIdx.x, e = tid & 127, dh = tid >> 7;
  const float* Hc = (const float*)(p.ws + OFF_H);
  const float lg = ret_log2gamma(h);
  float acc[32];
#pragma unroll
  for (int i = 0; i < 32; ++i) acc[i] = 0.f;
  for (int j = 0; j < 128; ++j) {
    const size_t tok = (size_t)b * SEQ_LEN + c * 128 + j;
    const float vv = Hc[tok * CD_IN + 2304 + h * 128 + e] * exp2f((float)(127 - j) * lg);
    const float* kr = Hc + tok * CD_IN + 2048 + h * 64 + dh * 32;
#pragma unroll
    for (int i4 = 0; i4 < 8; ++i4) {
      const float4 kv = ld4(kr + i4 * 4);
      acc[i4 * 4] += kv.x * vv; acc[i4 * 4 + 1] += kv.y * vv; acc[i4 * 4 + 2] += kv.z * vv; acc[i4 * 4 + 3] += kv.w * vv;
    }
  }
  float* KV = (float*)(p.ws + OFF_RETKV) + (size_t)item * 64 * 128;
#pragma unroll
  for (int i = 0; i < 32; ++i) KV[(dh * 32 + i) * 128 + e] = acc[i];
}
DEV void phase_p11(const Params& p, char* smem) {
  const int total = P11_PREP_ITEMS + P11_KV_ITEMS;
  for (int it = blockIdx.x; it < total; it += gridDim.x) {
    if (it < P11_KV_ITEMS) p11_kv(p, it);
    else p11_prep(p, it - P11_KV_ITEMS, smem);
  }
}

#define P12_SCAN_ITEMS (BATCH * 8 * 4)
#define P12_RET_ITEMS (BATCH * 4 * RET_NC)
#define P12_SCAN_SMEM ((2 * (16 * 5 * 64 + 16 * 16) + 16 * 16) * 4)
#define P12_RET_SMEM ((64 * 72 + 2 * 64 * 68) * 2)
#define P12_SMEM (P12_SCAN_SMEM > P12_RET_SMEM ? P12_SCAN_SMEM : P12_RET_SMEM)
DEV float sum16(float v) {
#ifdef CPU_EMU
  return emu_sum16(v);
#else
  int x;
  x = __builtin_amdgcn_update_dpp(0, __builtin_bit_cast(int, v), 0xB1, 0xF, 0xF, false); v += __builtin_bit_cast(float, x);
  x = __builtin_amdgcn_update_dpp(0, __builtin_bit_cast(int, v), 0x4E, 0xF, 0xF, false); v += __builtin_bit_cast(float, x);
  x = __builtin_amdgcn_update_dpp(0, __builtin_bit_cast(int, v), 0x141, 0xF, 0xF, false); v += __builtin_bit_cast(float, x);
  x = __builtin_amdgcn_update_dpp(0, __builtin_bit_cast(int, v), 0x140, 0xF, 0xF, false); v += __builtin_bit_cast(float, x);
  return v;
#endif
}
DEV void p12_scan(const Params& p, int item, char* smem) {
  const int rq = item & 3, h = (item >> 2) & 7, b = item >> 5;
  const int tid = threadIdx.x, rl = tid >> 4, cg = tid & 15;
  const float* ARR[5] = {(const float*)(p.ws + OFF_RWW), (const float*)(p.ws + OFF_RWK), (const float*)(p.ws + OFF_RWKK),
                         (const float*)(p.ws + OFF_RWA), p.out + (size_t)NTOK * 512};
  const float* RWV = p.out;
  float* Yo = (float*)(p.ws + OFF_MIX);
  float* buf = (float*)smem;
  float* vbuf = buf + 2 * 16 * 5 * 64;
  float* ybuf = vbuf + 2 * 16 * 16;
  float S[4] = {0.f, 0.f, 0.f, 0.f};
  float4 rg[5]; float rv;
  const int lstep = tid >> 4, lc4 = tid & 15;
  auto gload = [&](int c) {
    const size_t o = ((size_t)b * SEQ_LEN + c * 16 + lstep) * 512 + h * 64;
#pragma unroll
    for (int a = 0; a < 5; ++a) rg[a] = ld4(ARR[a] + o + lc4 * 4);
    rv = RWV[o + rq * 16 + lc4];
  };
  auto sstore = [&](int bi) {
#pragma unroll
    for (int a = 0; a < 5; ++a) st4(buf + ((bi * 16 + lstep) * 5 + a) * 64 + lc4 * 4, rg[a]);
    vbuf[(bi * 16 + lstep) * 16 + lc4] = rv;
  };
  __syncthreads();
  gload(0);
  sstore(0);
  __syncthreads();
  const int NCH = SEQ_LEN / 16;
  for (int c = 0; c < NCH; ++c) {
    if (c + 1 < NCH) gload(c + 1);
    const float* cb = buf + (c & 1) * 16 * 5 * 64;
    const float* cv = vbuf + (c & 1) * 16 * 16;
    float4 cw = ld4(cb + 0 * 64 + cg * 4), ck = ld4(cb + 1 * 64 + cg * 4), ckk = ld4(cb + 2 * 64 + cg * 4),
           cka = ld4(cb + 3 * 64 + cg * 4), cr = ld4(cb + 4 * 64 + cg * 4);
    float cvv = cv[rl];
#pragma unroll
    for (int s = 0; s < 16; ++s) {
      const float4 w = cw, k = ck, kk = ckk, ka = cka, r = cr;
      const float v = cvv;
      if (s < 15) {
        cw = ld4(cb + ((s + 1) * 5 + 0) * 64 + cg * 4); ck = ld4(cb + ((s + 1) * 5 + 1) * 64 + cg * 4);
        ckk = ld4(cb + ((s + 1) * 5 + 2) * 64 + cg * 4); cka = ld4(cb + ((s + 1) * 5 + 3) * 64 + cg * 4);
        cr = ld4(cb + ((s + 1) * 5 + 4) * 64 + cg * 4); cvv = cv[(s + 1) * 16 + rl];
      }
      float sa = (S[0] * kk.x + S[1] * kk.y) + (S[2] * kk.z + S[3] * kk.w);
      sa = -sum16(sa);
      S[0] = S[0] * w.x + (sa * ka.x + v * k.x);
      S[1] = S[1] * w.y + (sa * ka.y + v * k.y);
      S[2] = S[2] * w.z + (sa * ka.z + v * k.z);
      S[3] = S[3] * w.w + (sa * ka.w + v * k.w);
      float y = (S[0] * r.x + S[1] * r.y) + (S[2] * r.z + S[3] * r.w);
      y = sum16(y);
      if (cg == 0) ybuf[s * 16 + rl] = y;
      asm volatile("" ::: "memory");
    }
    __syncthreads();
    if (c + 1 < NCH) sstore((c + 1) & 1);
    Yo[((size_t)b * SEQ_LEN + c * 16 + lstep) * 1024 + h * 64 + rq * 16 + lc4] = ybuf[lstep * 16 + lc4];
    __syncthreads();
  }
}
struct RetSmem { unsigned short k[64][72]; unsigned short vt[2][64][68]; };
DEV void p12_ret(const Params& p, int item, char* smem) {
  RetSmem* sm = (RetSmem*)smem;
  const int c = item % RET_NC, h = (item / RET_NC) & 3, b = item / (RET_NC * 4);
  const int tid = threadIdx.x, lane = tid & 63, wave = tid >> 6;
  const int cidx = lane & 31, hh = lane >> 5;
  const int qi = wave * 32 + cidx;
  const float* Hc = (const float*)(p.ws + OFF_H);
  const float lg = ret_log2gamma(h);
  const size_t tok0 = (size_t)b * SEQ_LEN + c * 128;
  bf16x8 qf[4], qfs[4];
  {
    const float* qr = Hc + (tok0 + qi) * CD_IN + 1792 + h * 64;
    const float qs = exp2f((float)(qi + 1) * lg);
#pragma unroll
    for (int ks = 0; ks < 4; ++ks) {
      const float4 a0 = ld4(qr + ks * 16 + hh * 8), a1 = ld4(qr + ks * 16 + hh * 8 + 4);
      const float v[8] = {a0.x, a0.y, a0.z, a0.w, a1.x, a1.y, a1.z, a1.w};
#pragma unroll
      for (int j = 0; j < 8; ++j) { qf[ks][j] = (short)f2bf(v[j]); qfs[ks][j] = (short)f2bf(v[j] * qs); }
    }
  }
  f32x16 o[4], s[2];
#pragma unroll
  for (int mt = 0; mt < 4; ++mt)
#pragma unroll
    for (int i = 0; i < 16; ++i) o[mt][i] = 0.f;
  {
    const float G = exp2f(128.f * lg);
    const float* KV0 = (const float*)(p.ws + OFF_RETKV) + (size_t)((b * 4 + h) * RET_NC) * 64 * 128;
#pragma unroll
    for (int eh = 0; eh < 2; ++eh) {
      __syncthreads();
      for (int w = tid; w < 64 * 64; w += NTHREADS) {
        const int el = w & 63, d = w >> 6;
        const float* src = KV0 + d * 128 + eh * 64 + el;
        float st = 0.f;
        int cc = 0;
        for (; cc + 8 <= c; cc += 8) {
          float e[8];
#pragma unroll
          for (int q = 0; q < 8; ++q) e[q] = src[(size_t)(cc + q) * 64 * 128];
#pragma unroll
          for (int q = 0; q < 8; ++q) st = st * G + e[q];
        }
        for (; cc < c; ++cc) st = st * G + src[(size_t)cc * 64 * 128];
        sm->k[el][d] = f2bf(st);
      }
      __syncthreads();
      qk_tile(sm->k, qfs, s, lane);
#pragma unroll
      for (int i = 0; i < 16; ++i) { o[eh * 2][i] += s[0][i]; o[eh * 2 + 1][i] += s[1][i]; }
    }
  }
#pragma unroll 1
  for (int kt = 0; kt < 2; ++kt) {
    __syncthreads();
    {
      const int row = tid >> 2, seg = tid & 3;
      const float* kr = Hc + (tok0 + kt * 64 + row) * CD_IN + 2048 + h * 64 + seg * 16;
      const float4 a0 = ld4(kr), a1 = ld4(kr + 4), a2 = ld4(kr + 8), a3 = ld4(kr + 12);
      *(uint4*)&sm->k[row][seg * 16] = make_uint4(pk2(a0.x, a0.y), pk2(a0.z, a0.w), pk2(a1.x, a1.y), pk2(a1.z, a1.w));
      *(uint4*)&sm->k[row][seg * 16 + 8] = make_uint4(pk2(a2.x, a2.y), pk2(a2.z, a2.w), pk2(a3.x, a3.y), pk2(a3.z, a3.w));
#pragma unroll
      for (int q = 0; q < 8; ++q) {
        const int f = tid + 256 * q;
        const int key = f >> 5, d4 = (f & 31) * 4;
        const float4 v = ld4(Hc + (tok0 + kt * 64 + key) * CD_IN + 2304 + h * 128 + d4);
        unsigned short(*vt)[68] = sm->vt[d4 >> 6];
        const int dl = d4 & 63;
        vt[dl][key] = f2bf(v.x); vt[dl + 1][key] = f2bf(v.y); vt[dl + 2][key] = f2bf(v.z); vt[dl + 3][key] = f2bf(v.w);
      }
    }
    __syncthreads();
    if (kt * 64 <= wave * 32 + 31) {
      qk_tile(sm->k, qf, s, lane);
#pragma unroll
      for (int ks2 = 0; ks2 < 2; ++ks2)
#pragma unroll
        for (int i = 0; i < 16; ++i) {
          const int kj = kt * 64 + ks2 * 32 + (i & 3) + 8 * (i >> 2) + 4 * hh;
          s[ks2][i] = kj <= qi ? s[ks2][i] * exp2f((float)(qi - kj) * lg) : 0.f;
        }
      pv_tile(sm->vt[0], s, *(f32x16(*)[2])&o[0], lane);
      pv_tile(sm->vt[1], s, *(f32x16(*)[2])&o[2], lane);
    }
  }
  float s1 = 0.f;
#pragma unroll
  for (int mt = 0; mt < 4; ++mt)
#pragma unroll
    for (int i = 0; i < 16; ++i) s1 += o[mt][i];
  s1 += __shfl_xor(s1, 32);
  const float mu = s1 * (1.f / 128.f);
  float s2 = 0.f;
#pragma unroll
  for (int mt = 0; mt < 4; ++mt)
#pragma unroll
    for (int i = 0; i < 16; ++i) { const float d = o[mt][i] - mu; s2 += d * d; }
  s2 += __shfl_xor(s2, 32);
  const float rstd = rsqrtf(s2 * (1.f / 128.f) + 1e-5f);
  float* MIX = (float*)(p.ws + OFF_MIX);
  const float* gate = Hc + (tok0 + qi) * CD_IN + 2816 + h * 128;
  float* dst = MIX + (tok0 + qi) * 1024 + 512 + h * 128;
  const float* lgam = p.in[I_RET_LN_G] + h * 128;
  const float* lbet = p.in[I_RET_LN_B] + h * 128;
#pragma unroll
  for (int mt = 0; mt < 4; ++mt)
#pragma unroll
    for (int g4 = 0; g4 < 4; ++g4) {
      const int dv = mt * 32 + 8 * g4 + 4 * hh;
      const float4 gv = ld4(lgam + dv), bv = ld4(lbet + dv), gt = ld4(gate + dv);
      float4 ov;
      ov.x = siluf_(gt.x) * ((o[mt][4 * g4] - mu) * rstd * gv.x + bv.x);
      ov.y = siluf_(gt.y) * ((o[mt][4 * g4 + 1] - mu) * rstd * gv.y + bv.y);
      ov.z = siluf_(gt.z) * ((o[mt][4 * g4 + 2] - mu) * rstd * gv.z + bv.z);
      ov.w = siluf_(gt.w) * ((o[mt][4 * g4 + 3] - mu) * rstd * gv.w + bv.w);
      st4(dst + dv, ov);
    }
}
DEV void phase_p12(const Params& p, char* smem) {
  const int G = gridDim.x;
  if ((int)blockIdx.x < P12_SCAN_ITEMS && G > P12_SCAN_ITEMS) {
    p12_scan(p, blockIdx.x, smem);
  } else if (G > P12_SCAN_ITEMS) {
    for (int it = blockIdx.x - P12_SCAN_ITEMS; it < P12_RET_ITEMS; it += G - P12_SCAN_ITEMS) p12_ret(p, it, smem);
  } else {
    const int total = P12_SCAN_ITEMS + P12_RET_ITEMS;
    for (int it = blockIdx.x; it < total; it += G) {
      if (it < P12_SCAN_ITEMS) p12_scan(p, it, smem);
      else p12_ret(p, it - P12_SCAN_ITEMS, smem);
    }
  }
}

#define P13_SMEM (8 * 128 * 4)
DEV void phase_p13(const Params& p, char* smem) {
  const int tid = threadIdx.x;
  const float* Hc = (const float*)(p.ws + OFF_H);
  const float* mu = p.in[I_RW_MU];
  float* sl = (float*)smem;
  float* MIX = (float*)(p.ws + OFF_MIX);
  const float* RWK = (const float*)(p.ws + OFF_RWK); const float* RWR = p.out + (size_t)NTOK * 512; const float* RWV = p.out;
  const float* g_up = p.in[I_RW_G_UP];
  for (int it = blockIdx.x; it < NTOK / 8; it += gridDim.x) {
    __syncthreads();
    for (int w = tid; w < 8 * 128; w += NTHREADS) {
      const size_t tok = (size_t)it * 8 + (w >> 7);
      sl[w] = sigmoidf_(shifted(Hc, tok, 1664 + (w & 127), mu));
    }
    __syncthreads();
#pragma unroll
    for (int cc = 0; cc < 2; ++cc) {
      const int c = tid + 256 * cc;
      float ag[8];
#pragma unroll
      for (int tt = 0; tt < 8; ++tt) ag[tt] = 0.f;
      for (int j = 0; j < 128; ++j) {
        const float gu = g_up[j * 512 + c];
#pragma unroll
        for (int tt = 0; tt < 8; ++tt) ag[tt] += sl[tt * 128 + j] * gu;
      }
      const float lng = p.in[I_RW_LN_G][c], lnb = p.in[I_RW_LN_B][c], rk = p.in[I_RW_R_K][c];
#pragma unroll
      for (int tt = 0; tt < 8; ++tt) {
        const size_t tok = (size_t)it * 8 + tt;
        const float y = MIX[tok * 1024 + c];
        const float m = wave_sum(y) * (1.f / 64.f);
        const float d = y - m;
        const float var = wave_sum(d * d) * (1.f / 64.f);
        const float yn = d * rsqrtf(var + 64e-5f) * lng + lnb;
        const float r = RWR[tok * 512 + c], k = RWK[tok * 512 + c], v = RWV[tok * 512 + c];
        const float bonus = wave_sum(r * k * rk) * v;
        MIX[tok * 1024 + c] = (yn + bonus) * ag[tt];
      }
    }
  }
}

#define NPHASES 20
#define SMEM_BYTES 67584
DEV void run_phase(const Params& p, int ph, char* smem) {
  switch (ph) {
    case 0: phase_gemm_in<0>(p, smem); break;
    case 1: phase_p1(p, smem); break;
    case 2: phase_p2(p, smem); break;
    case 3: phase_glu(p, smem); break;
    case 4: phase_outproj<0>(p, smem); break;
    case 5: phase_ln_router<0>(p, smem); break;
    case 6: phase_lists_shup<0>(p, smem); break;
    case 7: phase_routed_up<0>(p, smem); break;
    case 8: phase_down<0>(p, smem); break;
    case 9: phase_combine<0>(p, smem); break;
    case 10: phase_gemm_in<1>(p, smem); break;
    case 11: phase_p11(p, smem); break;
    case 12: phase_p12(p, smem); break;
    case 13: phase_p13(p, smem); break;
    case 14: phase_outproj<1>(p, smem); break;
    case 15: phase_ln_router<1>(p, smem); break;
    case 16: phase_lists_shup<1>(p, smem); break;
    case 17: phase_routed_up<1>(p, smem); break;
    case 18: phase_down<1>(p, smem); break;
    case 19: phase_combine<1>(p, smem); break;
    case 20: phase_p1b(p, smem); break;
  }
}
static_assert(P1_SMEM <= SMEM_BYTES, "smem");
static_assert(P1_PREP_SMEM <= SMEM_BYTES, "smem");
static_assert(P2_SMEM <= SMEM_BYTES, "smem");
static_assert(P5_SMEM <= SMEM_BYTES, "smem");
static_assert(P7_SMEM <= SMEM_BYTES, "smem");
static_assert(P12_SMEM <= SMEM_BYTES, "smem");
static_assert(OFF_HS + (size_t)NTOK * 256 * 2 <= OFF_X1, "layout");

#ifndef CPU_EMU
template <int PH>
__global__ void __launch_bounds__(NTHREADS) phase_kernel(Params p) {
  __shared__ __attribute__((aligned(16))) char smem[SMEM_BYTES];
  run_phase(p, PH, smem);
}
template <int PH>
static void launch_phases(const Params& p, hipStream_t stream) {
  phase_kernel<PH><<<dim3(1024), dim3(NTHREADS), 0, stream>>>(p);
  if constexpr (PH + 1 < NPHASES) launch_phases<PH + 1>(p, stream);
}
#if MEGA
DEV void grid_barrier(unsigned* bar, unsigned& epoch) {
  asm volatile("s_waitcnt vmcnt(0)" ::: "memory");
  __syncthreads();
  epoch += 1u;
  if (threadIdx.x == 0) {
    __builtin_amdgcn_fence(__ATOMIC_RELEASE, "agent");
    asm volatile("s_waitcnt vmcnt(0)" ::: "memory");
    __hip_atomic_fetch_add(bar, 1u, __ATOMIC_RELAXED, __HIP_MEMORY_SCOPE_AGENT);
    const unsigned target = epoch * gridDim.x;
    while (__hip_atomic_load(bar, __ATOMIC_RELAXED, __HIP_MEMORY_SCOPE_AGENT) < target) __builtin_amdgcn_s_sleep(1);
    __builtin_amdgcn_fence(__ATOMIC_ACQUIRE, "agent");
    asm volatile("s_waitcnt vmcnt(0)" ::: "memory");
  }
  __syncthreads();
}
__global__ void __launch_bounds__(NTHREADS) mega_kernel(Params p) {
  __shared__ __attribute__((aligned(16))) char smem[SMEM_BYTES];
  unsigned* bar = (unsigned*)(p.ws + OFF_BAR);
  unsigned epoch = 0u;
  if (p.ws == nullptr) cg::this_grid().sync();
  typedef const __attribute__((address_space(4))) Params* KParams;
#define PH_(n) { KParams kp = (KParams)__builtin_amdgcn_kernarg_segment_ptr(); asm volatile("" : "+s"(kp)); const Params lp = *(const Params*)kp; run_phase(lp, n, smem); } grid_barrier(bar, epoch);
  PH_(0) PH_(1) PH_(20) PH_(2) PH_(3) PH_(4) PH_(5) PH_(6) PH_(7) PH_(8) PH_(9)
  PH_(10) PH_(11) PH_(12) PH_(13) PH_(14) PH_(15) PH_(16) PH_(17) PH_(18)
  { KParams kp = (KParams)__builtin_amdgcn_kernarg_segment_ptr(); asm volatile("" : "+s"(kp)); const Params lp = *(const Params*)kp; run_phase(lp, 19, smem); }
}

#endif

extern "C" void kernel_launch(void* const* d_in, const int* in_sizes, int n_in, void* d_out, int out_size, void* d_ws, size_t ws_size,
                              hipStream_t stream) {
  Params p;
  for (int i = 0; i < N_INPUTS; ++i) p.in[i] = (const float*)d_in[i];
  p.out = (float*)d_out;
  p.ws = (char*)d_ws;
#if MEGA
  static int grid_blocks = 0;
  if (!grid_blocks) {
    int dev = 0, cus = 0, per_cu = 0;
    hipGetDevice(&dev);
    hipDeviceGetAttribute(&cus, hipDeviceAttributeMultiprocessorCount, dev);
    hipOccupancyMaxActiveBlocksPerMultiprocessor(&per_cu, mega_kernel, NTHREADS, 0);
    if (per_cu > 2) per_cu = 2;
    grid_blocks = cus * per_cu;
  }
  hipMemsetAsync((char*)d_ws + OFF_BAR, 0, 4096, stream);
  void* args[] = {&p};
  hipError_t e = hipLaunchCooperativeKernel((void*)mega_kernel, dim3(grid_blocks), dim3(NTHREADS), args, 0, stream);
  if (e != hipSuccess) fprintf(stderr, "cooperative launch failed: %s (grid %d)\n", hipGetErrorString(e), grid_blocks);
#else
  launch_phases<0>(p, stream);
#endif
}
#endif
```

```cpp
#ifdef CPU_EMU
#include "emu.h"
#else
#include <hip/hip_runtime.h>
#include <hip/hip_cooperative_groups.h>
#include <cstdio>
namespace cg = cooperative_groups;
#endif
#include <stdint.h>

#ifndef BATCH
#define BATCH 2
#endif
#ifndef SEQ_LEN
#define SEQ_LEN 8192
#endif
#ifndef MEGA
#define MEGA 1
#endif

#define DEV __device__ __forceinline__
#define NTOK (BATCH * SEQ_LEN)
#define DM 1024
#define AB_IN 1816
#define CD_IN 3328
#define NCMP ((SEQ_LEN - 32) / 16 + 1)
#define NBLK (SEQ_LEN / 64)
#define NB_CMP ((NCMP + 63) / 64)
#define S5_NC (SEQ_LEN / 64)
#define RET_NC (SEQ_LEN / 128)
#define ALPHA_F 1.4142135623730951f
#define NTHREADS 256

enum { I_X = 0, I_AB_W_IN, I_AB_W_OUT, I_S5_LAM_RE, I_S5_LAM_IM, I_S5_LOG_DT, I_S5_B_RE, I_S5_B_IM, I_S5_C_RE, I_S5_C_IM,
       I_S5_D, I_S5_W_GLU, I_S5_B_GLU, I_PE_K, I_PE_V, I_CK_W1, I_CK_B1, I_CK_W2, I_CV_W1, I_CV_B1, I_CV_W2,
       I_CD_W_IN, I_CD_W_OUT, I_RW_MU, I_RW_W0, I_RW_W_UP, I_RW_A0, I_RW_A_UP, I_RW_G_UP, I_RW_K_K, I_RW_K_A, I_RW_R_K,
       I_RW_LN_G, I_RW_LN_B, I_RET_LN_G, I_RET_LN_B, I_LN1_G, I_LN1_B, I_LN2_G, I_LN2_B, I_ROUTER, I_MOE_BIAS,
       I_MOE_W1, I_MOE_W3, I_MOE_W2, I_SH_W1, I_SH_W3, I_SH_W2, N_INPUTS };

struct Params {
  const float* in[N_INPUTS];
  float* out;
  char* ws;
};

#define MiB_TOK ((size_t)NTOK * 1024 * 4)
#define OFF_H 0
#define OFF_MIX ((size_t)NTOK * 3328 * 4)
#define OFF_X1 (OFF_MIX + MiB_TOK)
#define OFF_X2 (OFF_X1 + MiB_TOK)
#define OFF_R4 (OFF_X2 + MiB_TOK)
#define OFF_R5 (OFF_R4 + MiB_TOK)
#define OFF_Y OFF_H
#define OFF_HS (OFF_H + 4 * MiB_TOK)
#define OFF_FS OFF_X2
#define OFF_HR OFF_R4
#define OFF_X2B OFF_R4
#define OFF_TOPI (OFF_R5)
#define OFF_TOPG (OFF_TOPI + (size_t)NTOK * 8 * 4)
#define OFF_POSOF (OFF_TOPG + (size_t)NTOK * 8 * 4)
#define OFF_CNT (OFF_POSOF + (size_t)NTOK * 8 * 4)
#define OFF_LTOK (OFF_CNT + 1024)
#define OFF_LGATE (OFF_LTOK + (size_t)64 * NTOK * 4)
#define OFF_S5E (OFF_LGATE + (size_t)64 * NTOK * 4)
#define OFF_KCMP (OFF_S5E + (size_t)BATCH * S5_NC * 32 * 64 * 8)
#define OFF_VCMP (OFF_KCMP + (size_t)BATCH * NCMP * 2 * 64 * 4)
#define OFF_RETKV (OFF_VCMP + (size_t)BATCH * NCMP * 2 * 64 * 4)
#define OFF_BAR (OFF_RETKV + (size_t)BATCH * 4 * RET_NC * 64 * 128 * 4)
#define OFF_CMPHID (OFF_BAR + 4096)
#define OFF_CMPC1 (OFF_CMPHID + (size_t)2 * BATCH * 2 * NB_CMP * 64 * 128 * 4)
#define OFF_END (OFF_CMPC1 + 1024)
#define OFF_YGELU OFF_X1
#define OFF_RWW OFF_X1
#define OFF_RWK (OFF_X1 + (size_t)NTOK * 512 * 4)
#define OFF_RWKK OFF_R4
#define OFF_RWA (OFF_R4 + (size_t)NTOK * 512 * 4)

typedef short bf16x8 __attribute__((ext_vector_type(8)));
typedef float f32x16 __attribute__((ext_vector_type(16)));

#ifdef CPU_EMU
#define WAVE_SYNC() emu_wave_bar()
#else
#define WAVE_SYNC() __builtin_amdgcn_wave_barrier()
#endif

DEV float sigmoidf_(float x) { return 1.f / (1.f + __expf(-x)); }
DEV float siluf_(float x) { return x * sigmoidf_(x); }
DEV float geluf_(float x) { float u = 0.7978845608028654f * (x + 0.044715f * x * x * x); return 0.5f * x * (1.f + tanhf(u)); }
DEV unsigned short f2bf(float f) {
  unsigned u = __builtin_bit_cast(unsigned, f);
  u += 0x7FFFu + ((u >> 16) & 1u);
  return (unsigned short)(u >> 16);
}
DEV float bf2f(unsigned short h) { return __builtin_bit_cast(float, ((unsigned)h) << 16); }
DEV float wave_sum(float v) {
#pragma unroll
  for (int m = 32; m >= 1; m >>= 1) v += __shfl_xor(v, m);
  return v;
}
DEV float wave_max(float v) {
#pragma unroll
  for (int m = 32; m >= 1; m >>= 1) v = fmaxf(v, __shfl_xor(v, m));
  return v;
}
DEV float4 ld4(const float* p) { return *(const float4*)p; }
#ifdef CPU_EMU
DEV float fexp2(float x) { return exp2f(x); }
#else
DEV float fexp2(float x) { return __builtin_amdgcn_exp2f(x); }
#endif
DEV void fast_sincos(float x, float* sn, float* cs) {
  const float k = rintf(x * 0.15915494309189535f);
  float r = fmaf(-k, 6.28125f, x);
  r = fmaf(-k, 1.9353071795864769e-3f, r);
  *sn = __sinf(r); *cs = __cosf(r);
}
DEV void st4(float* p, float4 v) { *(float4*)p = v; }

#define GEMM_BM 256
#define GEMM_MI (GEMM_BM / 64)
#define GEMM_SMEM_BYTES ((GEMM_BM + 128) * 72 * 2)
#ifdef CPU_EMU
DEV unsigned pk2(float a, float b) { return (unsigned)f2bf(a) | ((unsigned)f2bf(b) << 16); }
#else
typedef __bf16 hbf16x2 __attribute__((ext_vector_type(2)));
typedef float hf32x2 __attribute__((ext_vector_type(2)));
DEV unsigned pk2(float a, float b) {
  hf32x2 f = {a, b};
  return __builtin_bit_cast(unsigned, __builtin_convertvector(f, hbf16x2));
}
#endif
template <bool ABF, class AROW, class BPTR, class EPI>
DEV void gemm_tile(AROW arow, BPTR bptr, int ldb, int K, EPI epi, char* smem_raw, int akstep = 64) {
  unsigned short(*sA)[72] = (unsigned short(*)[72])smem_raw;
  unsigned short(*sB)[72] = (unsigned short(*)[72])(smem_raw + GEMM_BM * 72 * 2);
  const int tid = threadIdx.x, lane = tid & 63, wave = tid >> 6;
  const int wm = wave >> 1, wn = wave & 1;
#if defined(CPU_EMU) && !defined(EMU_REAL_GEMM)
  for (int mi = 0; mi < GEMM_MI; ++mi)
    for (int r = 0; r < 16; ++r) {
      const int row = wm * (GEMM_BM / 2) + mi * 32 + (r & 3) + 8 * (r >> 2) + 4 * (lane >> 5);
      const int col = wn * 64 + (lane & 31);
      const void* arp = arow(row);
      float v[2] = {0.f, 0.f};
      for (int ni = 0; ni < 2; ++ni) {
        const int cc = col + ni * 32;
        const float* bq = bptr(cc & ~3);
        if (!arp || !bq) continue;
        bq += cc & 3;
        float a = 0.f;
        for (int k = 0; k < K; ++k) {
          const size_t ka = (size_t)(k >> 6) * akstep + (k & 63);
          const float av = ABF ? bf2f(((const unsigned short*)arp)[ka]) : bf2f(f2bf(((const float*)arp)[ka]));
          a += av * bf2f(f2bf(bq[(size_t)k * ldb]));
        }
        v[ni] = a;
      }
      epi(row, col, v[0], v[1]);
    }
  return;
#endif
  const float* ap[4 * GEMM_MI];
  const unsigned short* aph[2 * GEMM_MI];
  if (ABF) {
#pragma unroll
    for (int i = 0; i < 2 * GEMM_MI; ++i) aph[i] = (const unsigned short*)arow((tid >> 3) + 32 * i);
  } else {
#pragma unroll
    for (int i = 0; i < 4 * GEMM_MI; ++i) ap[i] = (const float*)arow((tid >> 4) + 16 * i);
  }
  const float* bp = bptr((tid & 31) * 4);
  const int kgrp = tid >> 5;
  float4 ra[4 * GEMM_MI];
  uint4 rah[2 * GEMM_MI];
  float4 rb[8];
  auto gload = [&](int k0) {
    if (ABF) {
#pragma unroll
      for (int i = 0; i < 2 * GEMM_MI; ++i) rah[i] = aph[i] ? *(const uint4*)(aph[i] + (size_t)(k0 >> 6) * akstep + (tid & 7) * 8) : make_uint4(0, 0, 0, 0);
    } else {
#pragma unroll
      for (int i = 0; i < 4 * GEMM_MI; ++i) ra[i] = ap[i] ? ld4(ap[i] + (size_t)(k0 >> 6) * akstep + (tid & 15) * 4) : make_float4(0.f, 0.f, 0.f, 0.f);
    }
#pragma unroll
    for (int j = 0; j < 8; ++j) rb[j] = bp ? ld4(bp + (size_t)(k0 + kgrp * 8 + j) * ldb) : make_float4(0.f, 0.f, 0.f, 0.f);
  };
  auto sstore = [&]() {
    if (ABF) {
#pragma unroll
      for (int i = 0; i < 2 * GEMM_MI; ++i) *(uint4*)&sA[(tid >> 3) + 32 * i][(tid & 7) * 8] = rah[i];
    } else {
#pragma unroll
      for (int i = 0; i < 4 * GEMM_MI; ++i) *(uint2*)&sA[(tid >> 4) + 16 * i][(tid & 15) * 4] = make_uint2(pk2(ra[i].x, ra[i].y), pk2(ra[i].z, ra[i].w));
    }
    const int nb = (tid & 31) * 4;
    *(uint4*)&sB[nb + 0][kgrp * 8] = make_uint4(pk2(rb[0].x, rb[1].x), pk2(rb[2].x, rb[3].x), pk2(rb[4].x, rb[5].x), pk2(rb[6].x, rb[7].x));
    *(uint4*)&sB[nb + 1][kgrp * 8] = make_uint4(pk2(rb[0].y, rb[1].y), pk2(rb[2].y, rb[3].y), pk2(rb[4].y, rb[5].y), pk2(rb[6].y, rb[7].y));
    *(uint4*)&sB[nb + 2][kgrp * 8] = make_uint4(pk2(rb[0].z, rb[1].z), pk2(rb[2].z, rb[3].z), pk2(rb[4].z, rb[5].z), pk2(rb[6].z, rb[7].z));
    *(uint4*)&sB[nb + 3][kgrp * 8] = make_uint4(pk2(rb[0].w, rb[1].w), pk2(rb[2].w, rb[3].w), pk2(rb[4].w, rb[5].w), pk2(rb[6].w, rb[7].w));
  };
  f32x16 acc[GEMM_MI][2];
#pragma unroll
  for (int mi = 0; mi < GEMM_MI; ++mi)
#pragma unroll
    for (int ni = 0; ni < 2; ++ni)
#pragma unroll
      for (int r = 0; r < 16; ++r) acc[mi][ni][r] = 0.f;
  gload(0);
  for (int k0 = 0; k0 < K; k0 += 64) {
    __syncthreads();
    sstore();
    __syncthreads();
    if (k0 + 64 < K) gload(k0 + 64);
#pragma unroll
    for (int ks = 0; ks < 4; ++ks) {
      bf16x8 af[GEMM_MI], bfr[2];
#pragma unroll
      for (int mi = 0; mi < GEMM_MI; ++mi) af[mi] = *(const bf16x8*)&sA[wm * (GEMM_BM / 2) + mi * 32 + (lane & 31)][ks * 16 + (lane >> 5) * 8];
#pragma unroll
      for (int ni = 0; ni < 2; ++ni) bfr[ni] = *(const bf16x8*)&sB[wn * 64 + ni * 32 + (lane & 31)][ks * 16 + (lane >> 5) * 8];
#pragma unroll
      for (int mi = 0; mi < GEMM_MI; ++mi)
#pragma unroll
        for (int ni = 0; ni < 2; ++ni) acc[mi][ni] = __builtin_amdgcn_mfma_f32_32x32x16_bf16(af[mi], bfr[ni], acc[mi][ni], 0, 0, 0);
    }
  }
#pragma unroll
  for (int mi = 0; mi < GEMM_MI; ++mi)
#pragma unroll
    for (int r = 0; r < 16; ++r) {
      int row = wm * (GEMM_BM / 2) + mi * 32 + (r & 3) + 8 * (r >> 2) + 4 * (lane >> 5);
      int col = wn * 64 + (lane & 31);
      epi(row, col, acc[mi][0][r], acc[mi][1][r]);
    }
}

template <int LAYER>
DEV void phase_gemm_in(const Params& p, char* smem) {
  const int N = LAYER == 0 ? AB_IN : CD_IN;
  const float* A = LAYER == 0 ? p.in[I_X] : (const float*)(p.ws + OFF_X2);
  const float* B = LAYER == 0 ? p.in[I_AB_W_IN] : p.in[I_CD_W_IN];
  float* C = (float*)(p.ws + OFF_H);
  const int NT = (N + 127) / 128, MT = NTOK / GEMM_BM;
  const int xcd_ = blockIdx.x & 7, lb_ = blockIdx.x >> 3, nb_ = gridDim.x >> 3;
  for (int j_ = lb_; j_ < (MT / 8) * NT; j_ += nb_) {
    const int it = (xcd_ + 8 * (j_ / NT)) * NT + (j_ % NT);
    const int tm = it / NT, tn = it % NT;
    const int m0 = tm * GEMM_BM, n0 = tn * 128;
    gemm_tile<LAYER == 1>(
        [&](int r) { return LAYER == 1 ? (const void*)((const unsigned short*)(p.ws + OFF_X2B) + (size_t)(m0 + r) * DM) : (const void*)(A + (size_t)(m0 + r) * DM); },
        [&](int c) { return (n0 + c < N) ? (B + n0 + c) : (const float*)nullptr; }, N, DM,
        [&](int row, int col, float v0, float v1) {
          const int gm = m0 + row, gc = n0 + col;
          if (LAYER == 1 && gc >= 1792 && gc < 2304) {
            const int i = gc & 63;
            const float pos = (float)(gm % SEQ_LEN);
            const float inv = __expf(-(float)i * (9.210340371976184f / 32.f));
            float sn, cs;
            fast_sincos(pos * inv, &sn, &cs);
            float o0 = v0 * cs - v1 * sn, o1 = v1 * cs + v0 * sn;
            if (gc >= 2048) { o0 *= 0.125f; o1 *= 0.125f; }
            v0 = o0; v1 = o1;
          }
          if (gc < N) C[(size_t)gm * N + gc] = v0;
          if (gc + 32 < N) C[(size_t)gm * N + gc + 32] = v1;
        },
        smem);
  }
}

struct S5Const { float lb_re, lb_im; };
DEV void s5_consts(const Params& p, int g, int pp, float& lb_re, float& lb_im, float (&bbr)[16], float (&bbi)[16]) {
  const float dt = expf(p.in[I_S5_LOG_DT][g]);
  const float lr = p.in[I_S5_LAM_RE][g * 64 + pp], li = p.in[I_S5_LAM_IM][g * 64 + pp];
  const float mag = expf(lr * dt);
  float sn, cs;
  sincosf(li * dt, &sn, &cs);
  lb_re = mag * cs; lb_im = mag * sn;
  const float den = lr * lr + li * li;
  const float f_re = ((lb_re - 1.f) * lr + lb_im * li) / den;
  const float f_im = (lb_im * lr - (lb_re - 1.f) * li) / den;
  const float* br = p.in[I_S5_B_RE] + (size_t)(g * 64 + pp) * 16;
  const float* bi = p.in[I_S5_B_IM] + (size_t)(g * 64 + pp) * 16;
#pragma unroll
  for (int h = 0; h < 16; ++h) {
    bbr[h] = f_re * br[h] - f_im * bi[h];
    bbi[h] = f_re * bi[h] + f_im * br[h];
  }
}

#define OFF_QB OFF_X2
#define OFF_KSB (OFF_QB + (size_t)NTOK * 512 * 2)
#define OFF_KWB (OFF_KSB + (size_t)NTOK * 128 * 2)
#define OFF_VST (OFF_KWB + (size_t)NTOK * 128 * 2)
#define OFF_VWT (OFF_VST + (size_t)NTOK * 128 * 2)
#define OFF_KCB (OFF_VWT + (size_t)NTOK * 128 * 2)
#define OFF_VCT (OFF_KCB + (size_t)BATCH * 2 * NB_CMP * 64 * 64 * 2)
#define NSA_QSCALE (0.125f * 1.4426950408889634f)

#define P1_S5A_ITEMS (BATCH * 32 * S5_NC / 4)
#define P1_CMP_TILES ((NCMP + 7) / 8)
#define P1_CMP_ITEMS (2 * BATCH * 2 * P1_CMP_TILES)
DEV void p1_s5a(const Params& p, int item, char* smem) {
  const int lane = threadIdx.x & 63, wave = threadIdx.x >> 6;
  const int idx = item * 4 + wave;
  const int g = idx & 31, c = (idx >> 5) % S5_NC, b = idx / (32 * S5_NC);
  float lb_re, lb_im, bbr[16], bbi[16];
  s5_consts(p, g, lane, lb_re, lb_im, bbr, bbi);
  const float* H = (const float*)(p.ws + OFF_H);
  float sr = 0.f, si = 0.f;
  float* su = (float*)smem + wave * 64 * 16;
  __syncthreads();
  {
    const float* ur = H + (size_t)(b * SEQ_LEN + c * 64 + lane) * AB_IN + g * 16;
#pragma unroll
    for (int q = 0; q < 4; ++q) st4(su + lane * 16 + q * 4, ld4(ur + q * 4));
  }
  WAVE_SYNC();
  for (int tt = 0; tt < 64; ++tt) {
    const float* u = su + tt * 16;
    float dr = 0.f, di = 0.f;
#pragma unroll
    for (int h4 = 0; h4 < 4; ++h4) {
      const float4 uv = ld4(u + h4 * 4);
      dr += uv.x * bbr[h4 * 4] + uv.y * bbr[h4 * 4 + 1] + uv.z * bbr[h4 * 4 + 2] + uv.w * bbr[h4 * 4 + 3];
      di += uv.x * bbi[h4 * 4] + uv.y * bbi[h4 * 4 + 1] + uv.z * bbi[h4 * 4 + 2] + uv.w * bbi[h4 * 4 + 3];
    }
    const float nr = lb_re * sr - lb_im * si + dr;
    const float ni = lb_re * si + lb_im * sr + di;
    sr = nr; si = ni;
  }
  float2* E = (float2*)(p.ws + OFF_S5E);
  E[((size_t)(b * S5_NC + c) * 32 + g) * 64 + lane] = make_float2(sr, si);
}
#define P1_CMPG_MT ((NCMP + GEMM_BM - 1) / GEMM_BM)
#define P1_CMPG_ITEMS (2 * BATCH * 2 * P1_CMPG_MT)
DEV void p1_cmpgemm(const Params& p, int item, char* smem) {
  const int mt = item % P1_CMPG_MT;
  int r = item / P1_CMPG_MT;
  const int g = r & 1; r >>= 1;
  const int b = r % BATCH; const int which = r / BATCH;
  const float* H = (const float*)(p.ws + OFF_H);
  const float* w1 = which ? p.in[I_CV_W1] : p.in[I_CK_W1];
  const int colbase = (which ? 1152 : 1024) + g * 64;
  float* HID = (float*)(p.ws + OFF_CMPHID) + ((size_t)(which * BATCH + b) * 2 + g) * NB_CMP * 64 * 128;
  const int n0 = mt * GEMM_BM;
  gemm_tile<false>(
      [&](int rr) { return (n0 + rr < NCMP) ? (const void*)(H + ((size_t)b * SEQ_LEN + 16 * (n0 + rr)) * AB_IN + colbase) : (const void*)nullptr; },
      [&](int c) { return w1 + c; }, 128, 2048,
      [&](int row, int col, float v0, float v1) {
        if (n0 + row < NCMP) { HID[(size_t)(n0 + row) * 128 + col] = v0; HID[(size_t)(n0 + row) * 128 + col + 32] = v1; }
      },
      smem, AB_IN);
}
DEV void p1_cmpc1(const Params& p, int which, char* smem) {
  const float* pe = which ? p.in[I_PE_V] : p.in[I_PE_K];
  const float* w1 = which ? p.in[I_CV_W1] : p.in[I_CK_W1];
  float* sPart = (float*)smem;
  const int tid = threadIdx.x, hid = tid & 127, kh = tid >> 7;
  float a = 0.f;
  for (int k = kh * 1024; k < kh * 1024 + 1024; ++k) a += pe[k] * w1[(size_t)k * 128 + hid];
  __syncthreads();
  sPart[tid] = a;
  __syncthreads();
  if (tid < 128) ((float*)(p.ws + OFF_CMPC1))[which * 128 + tid] = sPart[tid] + sPart[tid + 128];
  __syncthreads();
}
DEV void p1_compress(const Params& p, int item, char* smem) {
  const int tile = item % P1_CMP_TILES;
  int r = item / P1_CMP_TILES;
  const int g = r & 1; r >>= 1;
  const int b = r % BATCH; const int which = r / BATCH;
  const int n0 = tile * 8;
  const float* b1 = which ? p.in[I_CV_B1] : p.in[I_CK_B1];
  const float* w2 = which ? p.in[I_CV_W2] : p.in[I_CK_W2];
  const float* C1 = (const float*)(p.ws + OFF_CMPC1) + which * 128;
  const float* HID = (const float*)(p.ws + OFF_CMPHID) + ((size_t)(which * BATCH + b) * 2 + g) * NB_CMP * 64 * 128;
  float* sPart = (float*)smem;
  float* sHid = sPart + 2 * 8 * 128;
  const int tid = threadIdx.x;
  __syncthreads();
  for (int w = tid; w < 8 * 128; w += NTHREADS) {
    const int rr = w >> 7, hid = w & 127;
    const int n = n0 + rr;
    sHid[w] = n < NCMP ? geluf_(HID[(size_t)n * 128 + hid] + C1[hid] + b1[hid]) : 0.f;
  }
  __syncthreads();
  float* sOut = sPart;
  for (int w = tid; w < 8 * 64; w += NTHREADS) {
    const int rr = w >> 6, d = w & 63;
    float a = 0.f;
    for (int hid = 0; hid < 128; ++hid) a += sHid[rr * 128 + hid] * w2[hid * 64 + d];
    sOut[w] = a;
  }
  __syncthreads();
  float* dst = (float*)(p.ws + (which ? OFF_VCMP : OFF_KCMP));
  for (int w = tid; w < 8 * 64; w += NTHREADS) {
    const int rr = w >> 6, d = w & 63;
    const int n = n0 + rr;
    if (n >= NCMP) continue;
    float v = sOut[w];
    if (which == 0 && d < 16) {
      const int i = d & 7;
      const float pos = (float)(n * 16 + 31);
      const float inv = __expf(-(float)i * (13.122363377404328f / 8.f));
      float sn, cs;
      sincosf(pos * inv, &sn, &cs);
      const float x1 = sOut[rr * 64 + i], x2 = sOut[rr * 64 + i + 8];
      v = d < 8 ? x1 * cs - x2 * sn : x2 * cs + x1 * sn;
    }
    dst[((size_t)(b * NCMP + n) * 2 + g) * 64 + d] = v;
    if (which == 0) ((unsigned short*)(p.ws + OFF_KCB))[(((size_t)b * 2 + g) * NB_CMP * 64 + n) * 64 + d] = f2bf(v);
    else ((unsigned short*)(p.ws + OFF_VCT))[((((size_t)b * 2 + g) * NB_CMP + (n >> 6)) * 64 + d) * 64 + (n & 63)] = f2bf(v);
  }
  for (int w = tid; w < 8 * 64; w += NTHREADS) {
    const int rr = w >> 6, d = w & 63;
    const int n = n0 + rr;
    if (n < NCMP || n >= NB_CMP * 64) continue;
    if (which == 0) ((unsigned short*)(p.ws + OFF_KCB))[(((size_t)b * 2 + g) * NB_CMP * 64 + n) * 64 + d] = 0;
    else ((unsigned short*)(p.ws + OFF_VCT))[((((size_t)b * 2 + g) * NB_CMP + (n >> 6)) * 64 + d) * 64 + (n & 63)] = 0;
  }
}
DEV uint4 pack8(const float* v) {
  uint4 r;
  r.x = (unsigned)f2bf(v[0]) | ((unsigned)f2bf(v[1]) << 16);
  r.y = (unsigned)f2bf(v[2]) | ((unsigned)f2bf(v[3]) << 16);
  r.z = (unsigned)f2bf(v[4]) | ((unsigned)f2bf(v[5]) << 16);
  r.w = (unsigned)f2bf(v[6]) | ((unsigned)f2bf(v[7]) << 16);
  return r;
}
#define P1_PREP_ITEMS (NTOK / 64)
#define P1_PREP_SMEM ((64 * 8 * 2 + 64 * 128) * 4)
DEV void p1_prep(const Params& p, int item, char* smem) {
  const int tid = threadIdx.x;
  const int b = item / NBLK, blk = item % NBLK;
  const float* H = (const float*)(p.ws + OFF_H);
  float* sCS = (float*)smem;
  float* sV = sCS + 64 * 8 * 2;
  const size_t tok0 = (size_t)b * SEQ_LEN + blk * 64;
  __syncthreads();
  for (int w = tid; w < 64 * 8; w += NTHREADS) {
    const int tk = w >> 3, i = w & 7;
    const float pos = (float)(blk * 64 + tk);
    const float inv = __expf(-(float)i * (13.122363377404328f / 8.f));
    float sn, cs;
    sincosf(pos * inv, &sn, &cs);
    sCS[w * 2] = cs; sCS[w * 2 + 1] = sn;
  }
  __syncthreads();
  unsigned short* QB = (unsigned short*)(p.ws + OFF_QB);
  unsigned short* KSB = (unsigned short*)(p.ws + OFF_KSB);
  unsigned short* KWB = (unsigned short*)(p.ws + OFF_KWB);
  for (int w = tid; w < 64 * 12 * 8; w += NTHREADS) {
    const int o = w & 7, hd = (w >> 3) % 12, tk = w / 96;
    const int col = hd < 8 ? 512 + hd * 64 : (hd < 10 ? 1280 + (hd - 8) * 64 : 1536 + (hd - 10) * 64);
    const float* x = H + (tok0 + tk) * AB_IN + col;
    float v[8];
    const float4 a0 = ld4(x + o * 8), a1 = ld4(x + o * 8 + 4);
    v[0] = a0.x; v[1] = a0.y; v[2] = a0.z; v[3] = a0.w; v[4] = a1.x; v[5] = a1.y; v[6] = a1.z; v[7] = a1.w;
    if (o < 2) {
      const float4 c0 = ld4(x + (1 - o) * 8), c1 = ld4(x + (1 - o) * 8 + 4);
      const float u[8] = {c0.x, c0.y, c0.z, c0.w, c1.x, c1.y, c1.z, c1.w};
#pragma unroll
      for (int i = 0; i < 8; ++i) {
        const float cs = sCS[(tk * 8 + i) * 2], sn = sCS[(tk * 8 + i) * 2 + 1];
        v[i] = o == 0 ? v[i] * cs - u[i] * sn : v[i] * cs + u[i] * sn;
      }
    }
    if (hd < 8) {
#pragma unroll
      for (int i = 0; i < 8; ++i) v[i] *= NSA_QSCALE;
      *(uint4*)(QB + ((tok0 + tk) * 8 + hd) * 64 + o * 8) = pack8(v);
    } else {
      const int g = (hd - 8) & 1;
      unsigned short* dst = (hd < 10 ? KSB : KWB) + (((size_t)b * 2 + g) * SEQ_LEN + blk * 64 + tk) * 64 + o * 8;
      *(uint4*)dst = pack8(v);
    }
  }
#pragma unroll 1
  for (int which = 0; which < 2; ++which) {
    const int col = which ? 1664 : 1408;
    __syncthreads();
    for (int w = tid; w < 64 * 32; w += NTHREADS) {
      const int tk = w >> 5, c4 = (w & 31) * 4;
      st4(sV + tk * 128 + c4, ld4(H + (tok0 + tk) * AB_IN + col + c4));
    }
    __syncthreads();
    unsigned short* VT = (unsigned short*)(p.ws + (which ? OFF_VWT : OFF_VST));
    for (int w = tid; w < 2 * 64 * 8; w += NTHREADS) {
      const int ko = w & 7, d = (w >> 3) & 63, g = w >> 9;
      float v[8];
#pragma unroll
      for (int i = 0; i < 8; ++i) v[i] = sV[(ko * 8 + i) * 128 + g * 64 + d];
      *(uint4*)(VT + ((((size_t)b * 2 + g) * NBLK + blk) * 64 + d) * 64 + ko * 8) = pack8(v);
    }
  }
}

struct NsaSmem {
  unsigned short k[64][72];
  unsigned short vt[64][68];
  float imp[32][128];
  unsigned selmask[32][4];
  unsigned unionm[4];
  float keyb[4][128];
};
#define P2_NSA_SMEM ((int)sizeof(NsaSmem))
#define NSA_QT (SEQ_LEN / 32)
#define P2_NSA_ITEMS (BATCH * 2 * NSA_QT)

struct TileRegs { uint4 k0, k1, v0, v1; };
DEV void tile_gload(TileRegs& r, const unsigned short* Kg, const unsigned short* Vg, int tid) {
  const int row = tid >> 2, seg = tid & 3;
  r.k0 = *(const uint4*)(Kg + row * 64 + seg * 16);
  r.k1 = *(const uint4*)(Kg + row * 64 + seg * 16 + 8);
  if (Vg) {
    r.v0 = *(const uint4*)(Vg + row * 64 + seg * 16);
    r.v1 = *(const uint4*)(Vg + row * 64 + seg * 16 + 8);
  }
}
DEV void tile_sstore(NsaSmem* sm, const TileRegs& r, bool withV, int tid) {
  const int row = tid >> 2, seg = tid & 3;
  *(uint4*)&sm->k[row][seg * 16] = r.k0;
  *(uint4*)&sm->k[row][seg * 16 + 8] = r.k1;
  if (withV) {
    *(uint2*)&sm->vt[row][seg * 16] = make_uint2(r.v0.x, r.v0.y);
    *(uint2*)&sm->vt[row][seg * 16 + 4] = make_uint2(r.v0.z, r.v0.w);
    *(uint2*)&sm->vt[row][seg * 16 + 8] = make_uint2(r.v1.x, r.v1.y);
    *(uint2*)&sm->vt[row][seg * 16 + 12] = make_uint2(r.v1.z, r.v1.w);
  }
}
DEV void qk_tile(const unsigned short (*ksm)[72], const bf16x8 (&qf)[4], f32x16 (&s)[2], int lane) {
  const int r = lane & 31, hh = lane >> 5;
#pragma unroll
  for (int ks2 = 0; ks2 < 2; ++ks2) {
#pragma unroll
    for (int i = 0; i < 16; ++i) s[ks2][i] = 0.f;
#pragma unroll
    for (int ks = 0; ks < 4; ++ks) {
      const bf16x8 a = *(const bf16x8*)&ksm[ks2 * 32 + r][ks * 16 + hh * 8];
      s[ks2] = __builtin_amdgcn_mfma_f32_32x32x16_bf16(a, qf[ks], s[ks2], 0, 0, 0);
    }
  }
}
DEV void pv_tile(const unsigned short (*vsm)[68], const f32x16 (&pr)[2], f32x16 (&o)[2], int lane) {
  const int r = lane & 31, hh = lane >> 5;
#pragma unroll
  for (int ks2 = 0; ks2 < 2; ++ks2)
#pragma unroll
    for (int s = 0; s < 2; ++s) {
      union { uint4 u; bf16x8 v; } pfu;
      pfu.u = make_uint4(pk2(pr[ks2][8 * s], pr[ks2][8 * s + 1]), pk2(pr[ks2][8 * s + 2], pr[ks2][8 * s + 3]),
                         pk2(pr[ks2][8 * s + 4], pr[ks2][8 * s + 5]), pk2(pr[ks2][8 * s + 6], pr[ks2][8 * s + 7]));
      const bf16x8 pf = pfu.v;
#pragma unroll
      for (int mt = 0; mt < 2; ++mt) {
        const uint2 lo = *(const uint2*)&vsm[mt * 32 + r][ks2 * 32 + 16 * s + 4 * hh];
        const uint2 hi = *(const uint2*)&vsm[mt * 32 + r][ks2 * 32 + 16 * s + 8 + 4 * hh];
        union { uint4 u; bf16x8 v; } au;
        au.u = make_uint4(lo.x, lo.y, hi.x, hi.y);
        const bf16x8 a = au.v;
        o[mt] = __builtin_amdgcn_mfma_f32_32x32x16_bf16(a, pf, o[mt], 0, 0, 0);
      }
    }
}
DEV float quad_sum(float v) {
#ifdef CPU_EMU
  v += __shfl_xor(v, 1); v += __shfl_xor(v, 2); return v;
#else
  int x;
  x = __builtin_amdgcn_update_dpp(0, __builtin_bit_cast(int, v), 0xB1, 0xF, 0xF, false); v += __builtin_bit_cast(float, x);
  x = __builtin_amdgcn_update_dpp(0, __builtin_bit_cast(int, v), 0x4E, 0xF, 0xF, false); v += __builtin_bit_cast(float, x);
  return v;
#endif
}
DEV void softmax_step(f32x16 (&s)[2], float& m, float& l, f32x16 (&o)[2]) {
  float tmax = -INFINITY;
#pragma unroll
  for (int ks2 = 0; ks2 < 2; ++ks2)
#pragma unroll
    for (int i = 0; i < 16; ++i) tmax = fmaxf(tmax, s[ks2][i]);
  tmax = fmaxf(tmax, __shfl_xor(tmax, 32));
  const float mnew = fmaxf(m, tmax);
  const float msafe = mnew == -INFINITY ? 0.f : mnew;
  const float alpha = fexp2(m - msafe);
  float ps = 0.f;
#pragma unroll
  for (int ks2 = 0; ks2 < 2; ++ks2)
#pragma unroll
    for (int i = 0; i < 16; ++i) { s[ks2][i] = fexp2(s[ks2][i] - msafe); ps += s[ks2][i]; }
  l = l * alpha + ps;
#pragma unroll
  for (int mt = 0; mt < 2; ++mt)
#pragma unroll
    for (int i = 0; i < 16; ++i) o[mt][i] *= alpha;
  m = mnew;
}
DEV bool testbit4(unsigned w0, unsigned w1, unsigned w2, unsigned w3, int j) {
  const unsigned lo = j & 32 ? w1 : w0, hi = j & 32 ? w3 : w2;
  const unsigned x = j & 64 ? hi : lo;
  return (x >> (j & 31)) & 1u;
}

DEV void p2_nsa(const Params& p, int item, char* smem) {
  NsaSmem* sm = (NsaSmem*)smem;
  const int tid = threadIdx.x, lane = tid & 63, wave = tid >> 6;
  const int bg = item & 3, b = bg >> 1, g = bg & 1;
  const int qt = NSA_QT - 1 - (item >> 2);
  const int t0 = qt * 32;
  const int c = lane & 31, hh = lane >> 5, tl = c >> 2, h = c & 3;
  const int trow = wave * 8 + tl;
  const int tq = t0 + trow;
  const size_t tok = (size_t)b * SEQ_LEN + tq;
  const int hd = g * 4 + h;
  const float* H = (const float*)(p.ws + OFF_H);
  const unsigned short* QB = (const unsigned short*)(p.ws + OFF_QB);
  const unsigned short* KSB = (const unsigned short*)(p.ws + OFF_KSB) + ((size_t)b * 2 + g) * SEQ_LEN * 64;
  const unsigned short* KWB = (const unsigned short*)(p.ws + OFF_KWB) + ((size_t)b * 2 + g) * SEQ_LEN * 64;
  const unsigned short* VST = (const unsigned short*)(p.ws + OFF_VST) + ((size_t)b * 2 + g) * NBLK * 4096;
  const unsigned short* VWT = (const unsigned short*)(p.ws + OFF_VWT) + ((size_t)b * 2 + g) * NBLK * 4096;
  const unsigned short* KCB = (const unsigned short*)(p.ws + OFF_KCB) + ((size_t)b * 2 + g) * NB_CMP * 4096;
  const unsigned short* VCT = (const unsigned short*)(p.ws + OFF_VCT) + ((size_t)b * 2 + g) * NB_CMP * 4096;
  bf16x8 qf[4];
  {
    const unsigned short* qrow = QB + (tok * 8 + hd) * 64;
#pragma unroll
    for (int ks = 0; ks < 4; ++ks) qf[ks] = *(const bf16x8*)(qrow + ks * 16 + hh * 8);
  }
  const float g0 = sigmoidf_(H[tok * AB_IN + 1792 + hd * 3 + 0]);
  const float g1 = sigmoidf_(H[tok * AB_IN + 1792 + hd * 3 + 1]);
  const float g2 = sigmoidf_(H[tok * AB_IN + 1792 + hd * 3 + 2]);
  f32x16 o[2], s[2];
#pragma unroll
  for (int mt = 0; mt < 2; ++mt)
#pragma unroll
    for (int i = 0; i < 16; ++i) o[mt][i] = 0.f;
  float* mixrow = (float*)(p.ws + OFF_MIX) + tok * 1024 + 512 + hd * 64 + 4 * hh;
  __syncthreads();
  for (int w = tid; w < 32 * 128; w += NTHREADS) (&sm->imp[0][0])[w] = 0.f;
  TileRegs tr;
  tr.k0 = tr.k1 = tr.v0 = tr.v1 = make_uint4(0, 0, 0, 0);
  const int nval = tq >= 31 ? (tq - 31) / 16 + 1 : 0;
  const int nvmax = (t0 + 31 - 31) / 16 + 1;
  const int ktn = (nvmax + 63) / 64;
  float m = -INFINITY, l = 0.f;
  tile_gload(tr, KCB, nullptr, tid);
  for (int kt = 0; kt < ktn; ++kt) {
    __syncthreads();
    tile_sstore(sm, tr, false, tid);
    __syncthreads();
    if (kt + 1 < ktn) tile_gload(tr, KCB + (size_t)(kt + 1) * 4096, nullptr, tid);
    qk_tile(sm->k, qf, s, lane);
    float tmax = -INFINITY;
#pragma unroll
    for (int ks2 = 0; ks2 < 2; ++ks2)
#pragma unroll
      for (int i = 0; i < 16; ++i) {
        const int n = kt * 64 + ks2 * 32 + (i & 3) + 8 * (i >> 2) + 4 * hh;
        s[ks2][i] = n < nval ? s[ks2][i] : -INFINITY;
        tmax = fmaxf(tmax, s[ks2][i]);
      }
    tmax = fmaxf(tmax, __shfl_xor(tmax, 32));
    const float mnew = fmaxf(m, tmax);
    const float msafe = mnew == -INFINITY ? 0.f : mnew;
    float ps = 0.f;
#pragma unroll
    for (int ks2 = 0; ks2 < 2; ++ks2)
#pragma unroll
      for (int i = 0; i < 16; ++i) ps += fexp2(s[ks2][i] - msafe);
    l = l * fexp2(m - msafe) + ps;
    m = mnew;
  }
  {
    const float ltot = l + __shfl_xor(l, 32);
    const float invl = ltot > 0.f ? 1.f / ltot : 0.f;
    const float msafe = m == -INFINITY ? 0.f : m;
    tile_gload(tr, KCB, VCT, tid);
    for (int kt = 0; kt < ktn; ++kt) {
      __syncthreads();
      tile_sstore(sm, tr, true, tid);
      __syncthreads();
      if (kt + 1 < ktn) tile_gload(tr, KCB + (size_t)(kt + 1) * 4096, VCT + (size_t)(kt + 1) * 4096, tid);
      qk_tile(sm->k, qf, s, lane);
#pragma unroll
      for (int ks2 = 0; ks2 < 2; ++ks2)
#pragma unroll
        for (int i = 0; i < 16; ++i) {
          const int n = kt * 64 + ks2 * 32 + (i & 3) + 8 * (i >> 2) + 4 * hh;
          s[ks2][i] = n < nval ? fexp2(s[ks2][i] - msafe) * invl : 0.f;
        }
#pragma unroll
      for (int ks2 = 0; ks2 < 2; ++ks2)
#pragma unroll
        for (int g4 = 0; g4 < 4; ++g4) {
          float A = 2.f * (s[ks2][4 * g4] + s[ks2][4 * g4 + 1] + s[ks2][4 * g4 + 2]) + s[ks2][4 * g4 + 3];
          float Bv = s[ks2][4 * g4 + 3];
          A = quad_sum(A); Bv = quad_sum(Bv);
          const int j = kt * 16 + ks2 * 8 + 2 * g4 + hh;
          if (h == 0 && j < NBLK) sm->imp[trow][j] += A;
          WAVE_SYNC();
          if (h == 0 && j + 1 < NBLK) sm->imp[trow][j + 1] += Bv;
          WAVE_SYNC();
        }
      pv_tile(sm->vt, s, o, lane);
    }
#pragma unroll
    for (int mt = 0; mt < 2; ++mt)
#pragma unroll
      for (int g4 = 0; g4 < 4; ++g4) {
        st4(mixrow + mt * 32 + 8 * g4, make_float4(o[mt][4 * g4] * g0, o[mt][4 * g4 + 1] * g0, o[mt][4 * g4 + 2] * g0, o[mt][4 * g4 + 3] * g0));
        o[mt][4 * g4] = 0.f; o[mt][4 * g4 + 1] = 0.f; o[mt][4 * g4 + 2] = 0.f; o[mt][4 * g4 + 3] = 0.f;
      }
  }
  WAVE_SYNC();
  for (int t8 = 0; t8 < 8; ++t8) {
    const int row = wave * 8 + t8, tt = t0 + row, cur = tt >> 6;
    float kv[2]; bool valid[2];
#pragma unroll
    for (int c2 = 0; c2 < 2; ++c2) {
      const int j = lane + 64 * c2;
      valid[c2] = j < NBLK && j <= cur;
      const bool forced = (j == 0) | (j == cur) | (j == cur - 1);
      kv[c2] = valid[c2] ? (forced ? 1e6f : sm->imp[row][j < NBLK ? j : 0]) : -1.f;
      sm->keyb[wave][j] = kv[c2];
    }
    WAVE_SYNC();
    int rank0 = 0, rank1 = 0;
    const int jlim = cur < NBLK - 1 ? cur : NBLK - 1;
    for (int jj = 0; jj <= jlim; ++jj) {
      const float ov = sm->keyb[wave][jj];
      rank0 += (ov > kv[0] || (ov == kv[0] && jj < lane)) ? 1 : 0;
      rank1 += (ov > kv[1] || (ov == kv[1] && jj < lane + 64)) ? 1 : 0;
    }
    const unsigned long long m0 = __ballot(valid[0] && rank0 < 16);
    const unsigned long long m1 = __ballot(valid[1] && rank1 < 16);
    if (lane == 0) {
      sm->selmask[row][0] = (unsigned)m0; sm->selmask[row][1] = (unsigned)(m0 >> 32);
      sm->selmask[row][2] = (unsigned)m1; sm->selmask[row][3] = (unsigned)(m1 >> 32);
    }
    WAVE_SYNC();
  }
  __syncthreads();
  if (tid < 4) {
    unsigned u = 0;
    for (int r = 0; r < 32; ++r) u |= sm->selmask[r][tid];
    sm->unionm[tid] = u;
  }
  __syncthreads();
  const unsigned um0 = sm->unionm[0], um1 = sm->unionm[1], um2 = sm->unionm[2], um3 = sm->unionm[3];
  const unsigned my0 = sm->selmask[trow][0], my1 = sm->selmask[trow][1], my2 = sm->selmask[trow][2], my3 = sm->selmask[trow][3];
  {
    const int jmax = (t0 + 31) >> 6;
    int j = 0;
    while (j <= jmax && !testbit4(um0, um1, um2, um3, j)) ++j;
    m = -INFINITY; l = 0.f;
    if (j <= jmax) tile_gload(tr, KSB + (size_t)j * 4096, VST + (size_t)j * 4096, tid);
    while (j <= jmax) {
      __syncthreads();
      tile_sstore(sm, tr, true, tid);
      __syncthreads();
      int jn = j + 1;
      while (jn <= jmax && !testbit4(um0, um1, um2, um3, jn)) ++jn;
      if (jn <= jmax) tile_gload(tr, KSB + (size_t)jn * 4096, VST + (size_t)jn * 4096, tid);
      const bool mine = testbit4(my0, my1, my2, my3, j);
      if (__ballot(mine) != 0ull) {
        qk_tile(sm->k, qf, s, lane);
#pragma unroll
        for (int ks2 = 0; ks2 < 2; ++ks2)
#pragma unroll
          for (int i = 0; i < 16; ++i) {
            const int kp = j * 64 + ks2 * 32 + (i & 3) + 8 * (i >> 2) + 4 * hh;
            s[ks2][i] = (mine && kp <= tq) ? s[ks2][i] : -INFINITY;
          }
        softmax_step(s, m, l, o);
        pv_tile(sm->vt, s, o, lane);
      }
      j = jn;
    }
    const float ltot = l + __shfl_xor(l, 32);
    const float sc = ltot > 0.f ? g1 / ltot : 0.f;
#pragma unroll
    for (int mt = 0; mt < 2; ++mt)
#pragma unroll
      for (int g4 = 0; g4 < 4; ++g4) {
        float4 a = ld4(mixrow + mt * 32 + 8 * g4);
        a.x += o[mt][4 * g4] * sc; a.y += o[mt][4 * g4 + 1] * sc; a.z += o[mt][4 * g4 + 2] * sc; a.w += o[mt][4 * g4 + 3] * sc;
        st4(mixrow + mt * 32 + 8 * g4, a);
        o[mt][4 * g4] = 0.f; o[mt][4 * g4 + 1] = 0.f; o[mt][4 * g4 + 2] = 0.f; o[mt][4 * g4 + 3] = 0.f;
      }
  }
  {
    const int jlo = t0 - 511 > 0 ? (t0 - 511) >> 6 : 0, jhi = (t0 + 31) >> 6;
    const int wq0 = t0 + wave * 8;
    m = -INFINITY; l = 0.f;
    tile_gload(tr, KWB + (size_t)jlo * 4096, VWT + (size_t)jlo * 4096, tid);
    for (int j = jlo; j <= jhi; ++j) {
      __syncthreads();
      tile_sstore(sm, tr, true, tid);
      __syncthreads();
      if (j + 1 <= jhi) tile_gload(tr, KWB + (size_t)(j + 1) * 4096, VWT + (size_t)(j + 1) * 4096, tid);
      if (j * 64 <= wq0 + 7 && j * 64 + 63 > wq0 - 512) {
        qk_tile(sm->k, qf, s, lane);
#pragma unroll
        for (int ks2 = 0; ks2 < 2; ++ks2)
#pragma unroll
          for (int i = 0; i < 16; ++i) {
            const int kp = j * 64 + ks2 * 32 + (i & 3) + 8 * (i >> 2) + 4 * hh;
            s[ks2][i] = (kp <= tq && kp > tq - 512) ? s[ks2][i] : -INFINITY;
          }
        softmax_step(s, m, l, o);
        pv_tile(sm->vt, s, o, lane);
      }
    }
    const float ltot = l + __shfl_xor(l, 32);
    const float sc = ltot > 0.f ? g2 / ltot : 0.f;
#pragma unroll
    for (int mt = 0; mt < 2; ++mt)
#pragma unroll
      for (int g4 = 0; g4 < 4; ++g4) {
        float4 a = ld4(mixrow + mt * 32 + 8 * g4);
        a.x += o[mt][4 * g4] * sc; a.y += o[mt][4 * g4 + 1] * sc; a.z += o[mt][4 * g4 + 2] * sc; a.w += o[mt][4 * g4 + 3] * sc;
        st4(mixrow + mt * 32 + 8 * g4, a);
        o[mt][4 * g4] = 0.f; o[mt][4 * g4 + 1] = 0.f; o[mt][4 * g4 + 2] = 0.f; o[mt][4 * g4 + 3] = 0.f;
      }
  }
}

#define P1_SMEM ((2 * 8 * 128 + 8 * 128) * 4)
DEV void phase_p1(const Params& p, char* smem) {
  const int total = P1_CMPG_ITEMS + 2 + P1_S5A_ITEMS + P1_PREP_ITEMS;
  for (int it = blockIdx.x; it < total; it += gridDim.x) {
    if (it < P1_CMPG_ITEMS) p1_cmpgemm(p, it, smem);
    else if (it < P1_CMPG_ITEMS + 2) p1_cmpc1(p, it - P1_CMPG_ITEMS, smem);
    else if (it < P1_CMPG_ITEMS + 2 + P1_PREP_ITEMS) p1_prep(p, it - P1_CMPG_ITEMS - 2, smem);
    else p1_s5a(p, it - P1_CMPG_ITEMS - 2 - P1_PREP_ITEMS, smem);
  }
}
DEV void phase_p1b(const Params& p, char* smem) {
  for (int it = blockIdx.x; it < P1_CMP_ITEMS; it += gridDim.x) p1_compress(p, it, smem);
}

#define P2_S5C_ITEMS (BATCH * 32 * S5_NC / 4)
#define S5C_ROW 132
#define P2_S5C_SMEM (4 * 16 * S5C_ROW * 4 + 4 * 64 * 16 * 4)
DEV void p2_s5c(const Params& p, int item, char* smem) {
  const int lane = threadIdx.x & 63, wave = threadIdx.x >> 6;
  const int idx = item * 4 + wave;
  const int g = idx & 31, c = (idx >> 5) % S5_NC, b = idx / (32 * S5_NC);
  float lb_re, lb_im, bbr[16], bbi[16];
  s5_consts(p, g, lane, lb_re, lb_im, bbr, bbi);
  float ar = lb_re, ai = lb_im;
#pragma unroll
  for (int s = 0; s < 6; ++s) { const float nr = ar * ar - ai * ai, ni = 2.f * ar * ai; ar = nr; ai = ni; }
  const float2* E = (const float2*)(p.ws + OFF_S5E);
  float sr = 0.f, si = 0.f;
  {
    int cc = 0;
    for (; cc + 8 <= c; cc += 8) {
      float2 e[8];
#pragma unroll
      for (int q = 0; q < 8; ++q) e[q] = E[((size_t)(b * S5_NC + cc + q) * 32 + g) * 64 + lane];
#pragma unroll
      for (int q = 0; q < 8; ++q) {
        const float nr = ar * sr - ai * si + e[q].x, ni = ar * si + ai * sr + e[q].y;
        sr = nr; si = ni;
      }
    }
    for (; cc < c; ++cc) {
      const float2 e = E[((size_t)(b * S5_NC + cc) * 32 + g) * 64 + lane];
      const float nr = ar * sr - ai * si + e.x, ni = ar * si + ai * sr + e.y;
      sr = nr; si = ni;
    }
  }
  __syncthreads();
  const float* H = (const float*)(p.ws + OFF_H);
  float* sS = (float*)smem + wave * 16 * S5C_ROW;
  float* su = (float*)smem + 4 * 16 * S5C_ROW + wave * 64 * 16;
  {
    const float* ur = H + (size_t)(b * SEQ_LEN + c * 64 + lane) * AB_IN + g * 16;
#pragma unroll
    for (int q = 0; q < 4; ++q) st4(su + lane * 16 + q * 4, ld4(ur + q * 4));
  }
  __syncthreads();
  const float* cre = p.in[I_S5_C_RE] + (size_t)g * 16 * 64;
  const float* cim = p.in[I_S5_C_IM] + (size_t)g * 16 * 64;
  float* YG = (float*)(p.ws + OFF_YGELU);
  for (int sc = 0; sc < 4; ++sc) {
    for (int tt = 0; tt < 16; ++tt) {
      const float* u = su + (sc * 16 + tt) * 16;
      float dr = 0.f, di = 0.f;
#pragma unroll
      for (int h4 = 0; h4 < 4; ++h4) {
        const float4 uv = ld4(u + h4 * 4);
        dr += uv.x * bbr[h4 * 4] + uv.y * bbr[h4 * 4 + 1] + uv.z * bbr[h4 * 4 + 2] + uv.w * bbr[h4 * 4 + 3];
        di += uv.x * bbi[h4 * 4] + uv.y * bbi[h4 * 4 + 1] + uv.z * bbi[h4 * 4 + 2] + uv.w * bbi[h4 * 4 + 3];
      }
      const float nr = lb_re * sr - lb_im * si + dr, ni = lb_re * si + lb_im * sr + di;
      sr = nr; si = ni;
      sS[tt * S5C_ROW + lane] = sr;
      sS[tt * S5C_ROW + 64 + lane] = si;
    }
    __syncthreads();
    {
      const int tt = lane >> 2, hq = lane & 3;
      float y[4] = {0.f, 0.f, 0.f, 0.f};
      for (int k = 0; k < 64; k += 4) {
        const float4 vr = ld4(sS + tt * S5C_ROW + k), vi = ld4(sS + tt * S5C_ROW + 64 + k);
#pragma unroll
        for (int hh = 0; hh < 4; ++hh) {
          const float4 cr = ld4(cre + (hq * 4 + hh) * 64 + k), ci = ld4(cim + (hq * 4 + hh) * 64 + k);
          y[hh] += vr.x * cr.x + vr.y * cr.y + vr.z * cr.z + vr.w * cr.w - (vi.x * ci.x + vi.y * ci.y + vi.z * ci.z + vi.w * ci.w);
        }
      }
      const size_t tok = (size_t)(b * SEQ_LEN + c * 64 + sc * 16 + tt);
      const int ch = g * 16 + hq * 4;
      const float4 uv = ld4(H + tok * AB_IN + ch);
      const float4 dv = ld4(p.in[I_S5_D] + ch);
      float4 o;
      o.x = geluf_(y[0] + dv.x * uv.x); o.y = geluf_(y[1] + dv.y * uv.y);
      o.z = geluf_(y[2] + dv.z * uv.z); o.w = geluf_(y[3] + dv.w * uv.w);
      st4(YG + tok * 512 + ch, o);
    }
    __syncthreads();
  }
}

#define P2_SMEM (P2_S5C_SMEM > P2_NSA_SMEM ? P2_S5C_SMEM : P2_NSA_SMEM)
DEV void phase_p2(const Params& p, char* smem) {
  const int G = gridDim.x;
  const int total = P2_NSA_ITEMS + P2_S5C_ITEMS;
  for (int r = 0;; ++r) {
    const int it = r * G + ((r & 1) ? (G - 1 - (int)blockIdx.x) : (int)blockIdx.x);
    if (r * G >= total) break;
    if (it >= total) continue;
    if (it < P2_NSA_ITEMS) p2_nsa(p, it, smem);
    else p2_s5c(p, it - P2_NSA_ITEMS, smem);
  }
}

DEV void phase_glu(const Params& p, char* smem) {
  const float* A = (const float*)(p.ws + OFF_YGELU);
  const float* B = p.in[I_S5_W_GLU];
  const float* bias = p.in[I_S5_B_GLU];
  float* MIX = (float*)(p.ws + OFF_MIX);
  const int NT = 4, MT = NTOK / GEMM_BM;
  const int xcd_ = blockIdx.x & 7, lb_ = blockIdx.x >> 3, nb_ = gridDim.x >> 3;
  for (int j_ = lb_; j_ < (MT / 8) * NT; j_ += nb_) {
    const int it = (xcd_ + 8 * (j_ / NT)) * NT + (j_ % NT);
    const int m0 = (it / NT) * GEMM_BM, n0 = (it % NT) * 128;
    gemm_tile<false>(
        [&](int r) { return (const void*)(A + (size_t)(m0 + r) * 512); },
        [&](int c) { return B + n0 + c; }, 512, 512,
        [&](int row, int col, float v0, float v1) {
          const size_t gm = m0 + row; const int gc = n0 + col;
          const float y0 = A[gm * 512 + gc], y1 = A[gm * 512 + gc + 32];
          MIX[gm * 1024 + gc] = y0 * sigmoidf_(v0 + bias[gc]);
          MIX[gm * 1024 + gc + 32] = y1 * sigmoidf_(v1 + bias[gc + 32]);
        },
        smem);
  }
}

template <int LAYER>
DEV void phase_outproj(const Params& p, char* smem) {
  const float* A = (const float*)(p.ws + OFF_MIX);
  const float* B = LAYER == 0 ? p.in[I_AB_W_OUT] : p.in[I_CD_W_OUT];
  const float* xin = LAYER == 0 ? p.in[I_X] : (const float*)(p.ws + OFF_X2);
  float* PRE = (float*)(p.ws + OFF_H);
  const int NT = 8, MT = NTOK / GEMM_BM;
  const int xcd_ = blockIdx.x & 7, lb_ = blockIdx.x >> 3, nb_ = gridDim.x >> 3;
  for (int j_ = lb_; j_ < (MT / 8) * NT; j_ += nb_) {
    const int it = (xcd_ + 8 * (j_ / NT)) * NT + (j_ % NT);
    const int m0 = (it / NT) * GEMM_BM, n0 = (it % NT) * 128;
    gemm_tile<false>(
        [&](int r) { return (const void*)(A + (size_t)(m0 + r) * 1024); },
        [&](int c) { return B + n0 + c; }, 1024, 1024,
        [&](int row, int col, float v0, float v1) {
          const size_t o = (size_t)(m0 + row) * 1024 + n0 + col;
          PRE[o] = ALPHA_F * xin[o] + v0;
          PRE[o + 32] = ALPHA_F * xin[o + 32] + v1;
        },
        smem);
  }
}

DEV void wave_ln(float (&v)[16], const float* gam, const float* bet, int lane) {
  float s = 0.f;
#pragma unroll
  for (int i = 0; i < 16; ++i) s += v[i];
  const float mu = wave_sum(s) * (1.f / 1024.f);
  float q = 0.f;
#pragma unroll
  for (int i = 0; i < 16; ++i) { const float d = v[i] - mu; q += d * d; }
  const float rstd = rsqrtf(wave_sum(q) * (1.f / 1024.f) + 1e-5f);
#pragma unroll
  for (int i = 0; i < 4; ++i) {
    const float4 gv = ld4(gam + lane * 4 + 256 * i), bv = ld4(bet + lane * 4 + 256 * i);
    v[i * 4 + 0] = (v[i * 4 + 0] - mu) * rstd * gv.x + bv.x;
    v[i * 4 + 1] = (v[i * 4 + 1] - mu) * rstd * gv.y + bv.y;
    v[i * 4 + 2] = (v[i * 4 + 2] - mu) * rstd * gv.z + bv.z;
    v[i * 4 + 3] = (v[i * 4 + 3] - mu) * rstd * gv.w + bv.w;
  }
}

#define P5_SMEM (4 * (4 * 1024 + 64) * 4)
template <int LAYER>
DEV void phase_ln_router(const Params& p, char* smem) {
  const int lane = threadIdx.x & 63, wave = threadIdx.x >> 6;
  const float* PRE = (const float*)(p.ws + OFF_H);
  float* X1 = (float*)(p.ws + OFF_X1);
  const float* router = p.in[I_ROUTER] + (size_t)LAYER * 1024 * 64;
  const float* bias = p.in[I_MOE_BIAS] + LAYER * 64;
  int* TOPI = (int*)(p.ws + OFF_TOPI);
  float* TOPG = (float*)(p.ws + OFF_TOPG);
  float* xs = (float*)smem + wave * (4 * 1024 + 64);
  float* ms = xs + 4 * 1024;
  unsigned short* X1B = (unsigned short*)p.out;
  for (int it = blockIdx.x; it < NTOK / 16; it += gridDim.x) {
    const size_t tokb = (size_t)it * 16 + wave * 4;
    WAVE_SYNC();
#pragma unroll 1
    for (int t = 0; t < 4; ++t) {
      const size_t tok = tokb + t;
      float v[16];
#pragma unroll
      for (int i = 0; i < 4; ++i) {
        const float4 a = ld4(PRE + tok * 1024 + lane * 4 + 256 * i);
        v[i * 4] = a.x; v[i * 4 + 1] = a.y; v[i * 4 + 2] = a.z; v[i * 4 + 3] = a.w;
      }
      wave_ln(v, p.in[I_LN1_G] + LAYER * 1024, p.in[I_LN1_B] + LAYER * 1024, lane);
#pragma unroll
      for (int i = 0; i < 4; ++i) {
        const float4 a = make_float4(v[i * 4], v[i * 4 + 1], v[i * 4 + 2], v[i * 4 + 3]);
        st4(X1 + tok * 1024 + lane * 4 + 256 * i, a);
        st4(xs + t * 1024 + lane * 4 + 256 * i, a);
        *(uint2*)(X1B + tok * 1024 + lane * 4 + 256 * i) = make_uint2(pk2(a.x, a.y), pk2(a.z, a.w));
      }
    }
    WAVE_SYNC();
    float lg[4] = {0.f, 0.f, 0.f, 0.f};
    for (int k = 0; k < 1024; k += 4) {
      const float r0 = router[(size_t)k * 64 + lane], r1 = router[(size_t)(k + 1) * 64 + lane],
                  r2 = router[(size_t)(k + 2) * 64 + lane], r3 = router[(size_t)(k + 3) * 64 + lane];
#pragma unroll
      for (int t = 0; t < 4; ++t) {
        const float4 xv = ld4(xs + t * 1024 + k);
        lg[t] += xv.x * r0 + xv.y * r1 + xv.z * r2 + xv.w * r3;
      }
    }
#pragma unroll
    for (int t = 0; t < 4; ++t) {
      const size_t tok = tokb + t;
      const float score = 1.f / (1.f + expf(-lg[t]));
      const float biased = score + bias[lane];
      float m1 = biased; int a1 = lane;
#pragma unroll
      for (int mm = 1; mm <= 4; mm <<= 1) {
        const float ov = __shfl_xor(m1, mm); const int oa = __shfl_xor(a1, mm);
        if (ov > m1 || (ov == m1 && oa < a1)) { m1 = ov; a1 = oa; }
      }
      float m2 = lane == a1 ? -INFINITY : biased;
#pragma unroll
      for (int mm = 1; mm <= 4; mm <<= 1) m2 = fmaxf(m2, __shfl_xor(m2, mm));
      const float gs = m1 + m2;
      const int mygrp = lane >> 3;
      int rank = 0;
#pragma unroll
      for (int gg = 0; gg < 8; ++gg) {
        const float og = __shfl(gs, gg * 8);
        rank += (og > gs || (og == gs && gg < mygrp)) ? 1 : 0;
      }
      const float masked = rank < 4 ? biased : -INFINITY;
      WAVE_SYNC();
      ms[lane] = masked;
      WAVE_SYNC();
      int erank = 0;
      for (int e = 0; e < 64; ++e) {
        const float ov = ms[e];
        erank += (ov > masked || (ov == masked && e < lane)) ? 1 : 0;
      }
      const bool selected = erank < 8;
      const float gsum = wave_sum(selected ? score : 0.f);
      if (selected) {
        TOPI[tok * 8 + erank] = lane;
        TOPG[tok * 8 + erank] = score / gsum * 2.5f;
      }
    }
  }
}

#define P6_SMEM GEMM_SMEM_BYTES
template <int LAYER>
DEV void phase_lists_shup(const Params& p, char* smem) {
  const int tid = threadIdx.x, lane = tid & 63, wave = tid >> 6;
  const int* TOPI = (const int*)(p.ws + OFF_TOPI);
  const float* TOPG = (const float*)(p.ws + OFF_TOPG);
  int* POSOF = (int*)(p.ws + OFF_POSOF);
  int* CNT = (int*)(p.ws + OFF_CNT);
  int* LTOK = (int*)(p.ws + OFF_LTOK);
  float* LGATE = (float*)(p.ws + OFF_LGATE);
  const unsigned short* X1B = (const unsigned short*)p.out;
  unsigned short* HS = (unsigned short*)(p.ws + OFF_HS);
  const float* W1 = p.in[I_SH_W1] + (size_t)LAYER * 1024 * 256;
  const float* W3 = p.in[I_SH_W3] + (size_t)LAYER * 1024 * 256;
  const int MT = NTOK / GEMM_BM;
  int* swave = (int*)smem;
  for (int it = blockIdx.x; it < 64; it += gridDim.x) {
    const int e = it;
    int base = 0;
    for (int t0 = 0; t0 < NTOK; t0 += NTHREADS) {
      const int tok = t0 + tid;
      int slot = -1;
#pragma unroll
      for (int s = 0; s < 8; ++s) if (TOPI[(size_t)tok * 8 + s] == e) slot = s;
      const unsigned long long bal = __ballot(slot >= 0);
      const int pre = __popcll(bal & ((1ull << lane) - 1ull));
      __syncthreads();
      if (lane == 0) swave[wave] = __popcll(bal);
      __syncthreads();
      int woff = 0, tot = 0;
#pragma unroll
      for (int w = 0; w < 4; ++w) { const int c = swave[w]; if (w < wave) woff += c; tot += c; }
      if (slot >= 0) {
        const int pos = base + woff + pre;
        LTOK[(size_t)e * NTOK + pos] = tok;
        LGATE[(size_t)e * NTOK + pos] = TOPG[(size_t)tok * 8 + slot];
        POSOF[(size_t)tok * 8 + slot] = pos;
      }
      base += tot;
    }
    if (tid == 0) CNT[e] = base;
    __syncthreads();
  }
  {
    const int NT = 4;
    const int xcd_ = blockIdx.x & 7, lb_ = blockIdx.x >> 3, nb_ = gridDim.x >> 3;
    for (int j_ = lb_; j_ < (MT / 8) * NT; j_ += nb_) {
      const int m0 = (xcd_ + 8 * (j_ / NT)) * GEMM_BM, ct = j_ % NT;
      gemm_tile<true>(
          [&](int r) { return (const void*)(X1B + (size_t)(m0 + r) * 1024); },
          [&](int c) { return (((c >> 5) & 1) ? W3 : W1) + ct * 64 + (c >> 6) * 32 + (c & 31); }, 256, 1024,
          [&](int row, int col, float v0, float v1) {
            const int lc = ct * 64 + (col >> 6) * 32 + (col & 31);
            HS[(size_t)(m0 + row) * 256 + lc] = f2bf(siluf_(v0) * v1);
          },
          smem);
    }
  }
}

struct ExpMap { int tstart[65]; int rbase[65]; int ltile[9]; };
DEV void build_expmap(const Params& p, ExpMap* em) {
  __syncthreads();
  if (threadIdx.x == 0) {
    const int* CNT = (const int*)(p.ws + OFF_CNT);
    int ts = 0, rb = 0;
    for (int e = 0; e < 64; ++e) {
      em->tstart[e] = ts; em->rbase[e] = rb;
      const int c = CNT[e];
      ts += (c + GEMM_BM - 1) / GEMM_BM; rb += c;
    }
    em->tstart[64] = ts; em->rbase[64] = rb;
    const int x = blockIdx.x & 7;
    int lt = 0;
    for (int k = 0; k < 8; ++k) { em->ltile[k] = lt; lt += em->tstart[x + 8 * k + 1] - em->tstart[x + 8 * k]; }
    em->ltile[8] = lt;
  }
  __syncthreads();
}
DEV void map_expert_tile(const ExpMap* em, int j, int CT, int& e, int& rt, int& ct) {
  const int jr = j / CT; ct = j % CT;
  int k = 0;
  for (int q = 1; q < 8; ++q) if (em->ltile[q] <= jr) k = q;
  e = (blockIdx.x & 7) + 8 * k; rt = jr - em->ltile[k];
}
#define P7_SMEM (GEMM_SMEM_BYTES + 1024)
template <int LAYER>
DEV void phase_routed_up(const Params& p, char* smem) {
  ExpMap* em = (ExpMap*)(smem + GEMM_SMEM_BYTES);
  build_expmap(p, em);
  const int* CNT = (const int*)(p.ws + OFF_CNT);
  const int* LTOK = (const int*)(p.ws + OFF_LTOK);
  const unsigned short* X1B = (const unsigned short*)p.out;
  unsigned short* HR = (unsigned short*)(p.ws + OFF_HR);
  const int lb_ = blockIdx.x >> 3, nb_ = gridDim.x >> 3;
  for (int j_ = lb_; j_ < em->ltile[8] * 4; j_ += nb_) {
    int e, rtl, ct;
    map_expert_tile(em, j_, 4, e, rtl, ct);
    const int r0 = rtl * GEMM_BM;
    const int cnt = CNT[e], rbase = em->rbase[e];
    const float* W1 = p.in[I_MOE_W1] + ((size_t)LAYER * 64 + e) * 1024 * 256;
    const float* W3 = p.in[I_MOE_W3] + ((size_t)LAYER * 64 + e) * 1024 * 256;
    gemm_tile<true>(
        [&](int r) { return (r0 + r < cnt) ? (const void*)(X1B + (size_t)LTOK[(size_t)e * NTOK + r0 + r] * 1024) : (const void*)nullptr; },
        [&](int c) { return (((c >> 5) & 1) ? W3 : W1) + ct * 64 + (c >> 6) * 32 + (c & 31); }, 256, 1024,
        [&](int row, int col, float v0, float v1) {
          if (r0 + row < cnt) {
            const int lc = ct * 64 + (col >> 6) * 32 + (col & 31);
            HR[(size_t)(rbase + r0 + row) * 256 + lc] = f2bf(siluf_(v0) * v1);
          }
        },
        smem);
  }
}

template <int LAYER>
DEV void phase_down(const Params& p, char* smem) {
  ExpMap* em = (ExpMap*)(smem + GEMM_SMEM_BYTES);
  build_expmap(p, em);
  const int* CNT = (const int*)(p.ws + OFF_CNT);
  const float* LGATE = (const float*)(p.ws + OFF_LGATE);
  const unsigned short* HR = (const unsigned short*)(p.ws + OFF_HR);
  const unsigned short* HS = (const unsigned short*)(p.ws + OFF_HS);
  unsigned short* Y = (unsigned short*)(p.ws + OFF_Y);
  float* FS = (float*)(p.ws + OFF_FS);
  const int xcd_ = blockIdx.x & 7, lb_ = blockIdx.x >> 3, nb_ = gridDim.x >> 3;
  for (int j_ = lb_; j_ < em->ltile[8] * 8; j_ += nb_) {
    int e, rtl, ct;
    map_expert_tile(em, j_, 8, e, rtl, ct);
    const int r0 = rtl * GEMM_BM;
    const int cnt = CNT[e], rbase = em->rbase[e];
    const float* W2 = p.in[I_MOE_W2] + ((size_t)LAYER * 64 + e) * 256 * 1024;
    const int n0 = ct * 128;
    gemm_tile<true>(
        [&](int r) { return (r0 + r < cnt) ? (const void*)(HR + (size_t)(rbase + r0 + r) * 256) : (const void*)nullptr; },
        [&](int c) { return W2 + n0 + c; }, 1024, 256,
        [&](int row, int col, float v0, float v1) {
          if (r0 + row < cnt) {
            const float gt = LGATE[(size_t)e * NTOK + r0 + row];
            const size_t o = (size_t)(rbase + r0 + row) * 1024 + n0 + col;
            Y[o] = f2bf(v0 * gt); Y[o + 32] = f2bf(v1 * gt);
          }
        },
        smem);
  }
  {
    const int MT = NTOK / GEMM_BM, NT = 8;
    const float* W2 = p.in[I_SH_W2] + (size_t)LAYER * 256 * 1024;
    for (int j_ = lb_; j_ < (MT / 8) * NT; j_ += nb_) {
      const int m0 = (xcd_ + 8 * (j_ / NT)) * GEMM_BM, n0 = (j_ % NT) * 128;
      gemm_tile<true>(
          [&](int r) { return (const void*)(HS + (size_t)(m0 + r) * 256); },
          [&](int c) { return W2 + n0 + c; }, 1024, 256,
          [&](int row, int col, float v0, float v1) {
            const size_t o = (size_t)(m0 + row) * 1024 + n0 + col;
            FS[o] = v0; FS[o + 32] = v1;
          },
          smem);
    }
  }
}

template <int LAYER>
DEV void phase_combine(const Params& p, char* smem) {
  ExpMap* em = (ExpMap*)smem;
  build_expmap(p, em);
  const int lane = threadIdx.x & 63, wave = threadIdx.x >> 6;
  const float* X1 = (const float*)(p.ws + OFF_X1);
  const float* FS = (const float*)(p.ws + OFF_FS);
  const unsigned short* Y = (const unsigned short*)(p.ws + OFF_Y);
  const int* TOPI = (const int*)(p.ws + OFF_TOPI);
  const int* POSOF = (const int*)(p.ws + OFF_POSOF);
  float* OUT = LAYER == 0 ? (float*)(p.ws + OFF_X2) : p.out;
  for (int it = blockIdx.x; it < NTOK / 4; it += gridDim.x) {
    const size_t tok = (size_t)it * 4 + wave;
    float v[16];
#pragma unroll
    for (int i = 0; i < 4; ++i) {
      const float4 a = ld4(X1 + tok * 1024 + lane * 4 + 256 * i), f = ld4(FS + tok * 1024 + lane * 4 + 256 * i);
      v[i * 4] = ALPHA_F * a.x + f.x; v[i * 4 + 1] = ALPHA_F * a.y + f.y; v[i * 4 + 2] = ALPHA_F * a.z + f.z; v[i * 4 + 3] = ALPHA_F * a.w + f.w;
    }
    for (int s = 0; s < 8; ++s) {
      const int e = TOPI[tok * 8 + s];
      const size_t row = (size_t)em->rbase[e] + POSOF[tok * 8 + s];
#pragma unroll
      for (int i = 0; i < 4; ++i) {
        const uint2 y = *(const uint2*)(Y + row * 1024 + lane * 4 + 256 * i);
        v[i * 4] += bf2f((unsigned short)(y.x & 0xFFFF)); v[i * 4 + 1] += bf2f((unsigned short)(y.x >> 16));
        v[i * 4 + 2] += bf2f((unsigned short)(y.y & 0xFFFF)); v[i * 4 + 3] += bf2f((unsigned short)(y.y >> 16));
      }
    }
    wave_ln(v, p.in[I_LN2_G] + LAYER * 1024, p.in[I_LN2_B] + LAYER * 1024, lane);
#pragma unroll
    for (int i = 0; i < 4; ++i) st4(OUT + tok * 1024 + lane * 4 + 256 * i, make_float4(v[i * 4], v[i * 4 + 1], v[i * 4 + 2], v[i * 4 + 3]));
    if (LAYER == 0) {
      unsigned short* X2B = (unsigned short*)(p.ws + OFF_X2B);
#pragma unroll
      for (int i = 0; i < 4; ++i) *(uint2*)(X2B + tok * 1024 + lane * 4 + 256 * i) = make_uint2(pk2(v[i * 4], v[i * 4 + 1]), pk2(v[i * 4 + 2], v[i * 4 + 3]));
    }
  }
}

DEV float shifted(const float* Hc, size_t tok, int col, const float* mu) {
  const float cur = Hc[tok * CD_IN + col];
  const float prev = (tok % SEQ_LEN) == 0 ? 0.f : Hc[(tok - 1) * CD_IN + col];
  return cur + (prev - cur) * mu[col];
}

#define P11_PREP_ITEMS (NTOK / 8)
#define P11_KV_ITEMS (BATCH * 4 * RET_NC)
#define P11_SMEM (8 * 128 * 4)
DEV void p11_prep(const Params& p, int item, char* smem) {
  const int tid = threadIdx.x;
  const float* Hc = (const float*)(p.ws + OFF_H);
  const float* mu = p.in[I_RW_MU];
  float* sl = (float*)smem;
  __syncthreads();
  for (int w = tid; w < 8 * 128; w += NTHREADS) {
    const int tt = w >> 7, j = w & 127;
    const size_t tok = (size_t)item * 8 + tt;
    const float v = shifted(Hc, tok, 1536 + j, mu);
    sl[w] = j < 64 ? tanhf(v) : v;
  }
  __syncthreads();
  float* RWW = (float*)(p.ws + OFF_RWW); float* RWK = (float*)(p.ws + OFF_RWK);
  float* RWKK = (float*)(p.ws + OFF_RWKK); float* RWA = (float*)(p.ws + OFF_RWA);
  float* RWR = p.out + (size_t)NTOK * 512; float* RWV = p.out;
  const float* w_up = p.in[I_RW_W_UP]; const float* a_up = p.in[I_RW_A_UP];
#pragma unroll
  for (int cc = 0; cc < 2; ++cc) {
    const int c = tid + 256 * cc;
    float aw[8], aa[8];
#pragma unroll
    for (int tt = 0; tt < 8; ++tt) { aw[tt] = 0.f; aa[tt] = 0.f; }
    for (int j = 0; j < 64; ++j) {
      const float wu = w_up[j * 512 + c], au = a_up[j * 512 + c];
#pragma unroll
      for (int tt = 0; tt < 8; ++tt) { aw[tt] += sl[tt * 128 + j] * wu; aa[tt] += sl[tt * 128 + 64 + j] * au; }
    }
    const float w0 = p.in[I_RW_W0][c], a0 = p.in[I_RW_A0][c], kkc = p.in[I_RW_K_K][c], kac = p.in[I_RW_K_A][c];
#pragma unroll
    for (int tt = 0; tt < 8; ++tt) {
      const size_t tok = (size_t)item * 8 + tt;
      const float lw = w0 + aw[tt];
      const float nl = -lw;
      const float sp = nl > 20.f ? nl : log1pf(expf(nl));
      const float wl = -sp - 0.5f;
      const float decay = expf(-expf(wl));
      const float a = 1.f / (1.f + expf(-(a0 + aa[tt])));
      const float rs = shifted(Hc, tok, c, mu);
      const float ks = shifted(Hc, tok, 512 + c, mu);
      const float vs = shifted(Hc, tok, 1024 + c, mu);
      float kk = ks * kkc;
      const float nrm = sqrtf(wave_sum(kk * kk));
      kk = kk / fmaxf(nrm, 1e-12f);
      RWW[tok * 512 + c] = decay;
      RWK[tok * 512 + c] = ks * (1.f + (a - 1.f) * kac);
      RWKK[tok * 512 + c] = kk;
      RWA[tok * 512 + c] = kk * a;
      RWR[tok * 512 + c] = rs;
      RWV[tok * 512 + c] = vs;
    }
  }
}
DEV float ret_log2gamma(int h) { return log2f(1.f - exp2f(-5.f - (float)h)); }
DEV void p11_kv(const Params& p, int item) {
  const int c = item % RET_NC, h = (item / RET_NC) & 3, b = item / (RET_NC * 4);
  const int tid = threadIdx.x, e = tid & 127, dh = tid >> 7;
  const float* Hc = (const float*)(p.ws + OFF_H);
  const float lg = ret_log2gamma(h);
  float acc[32];
#pragma unroll
  for (int i = 0; i < 32; ++i) acc[i] = 0.f;
  for (int j = 0; j < 128; ++j) {
    const size_t tok = (size_t)b * SEQ_LEN + c * 128 + j;
    const float vv = Hc[tok * CD_IN + 2304 + h * 128 + e] * exp2f((float)(127 - j) * lg);
    const float* kr = Hc + tok * CD_IN + 2048 + h * 64 + dh * 32;
#pragma unroll
    for (int i4 = 0; i4 < 8; ++i4) {
      const float4 kv = ld4(kr + i4 * 4);
      acc[i4 * 4] += kv.x * vv; acc[i4 * 4 + 1] += kv.y * vv; acc[i4 * 4 + 2] += kv.z * vv; acc[i4 * 4 + 3] += kv.w * vv;
    }
  }
  float* KV = (float*)(p.ws + OFF_RETKV) + (size_t)item * 64 * 128;
#pragma unroll
  for (int i = 0; i < 32; ++i) KV[(dh * 32 + i) * 128 + e] = acc[i];
}
DEV void phase_p11(const Params& p, char* smem) {
  const int total = P11_PREP_ITEMS + P11_KV_ITEMS;
  for (int it = blockIdx.x; it < total; it += gridDim.x) {
    if (it < P11_KV_ITEMS) p11_kv(p, it);
    else p11_prep(p, it - P11_KV_ITEMS, smem);
  }
}

#define P12_SCAN_ITEMS (BATCH * 8 * 4)
#define P12_RET_ITEMS (BATCH * 4 * RET_NC)
#define P12_SCAN_SMEM ((2 * (16 * 5 * 64 + 16 * 16) + 16 * 16) * 4)
#define P12_RET_SMEM ((64 * 72 + 2 * 64 * 68) * 2)
#define P12_SMEM (P12_SCAN_SMEM > P12_RET_SMEM ? P12_SCAN_SMEM : P12_RET_SMEM)
DEV float sum16(float v) {
#ifdef CPU_EMU
  return emu_sum16(v);
#else
  int x;
  x = __builtin_amdgcn_update_dpp(0, __builtin_bit_cast(int, v), 0xB1, 0xF, 0xF, false); v += __builtin_bit_cast(float, x);
  x = __builtin_amdgcn_update_dpp(0, __builtin_bit_cast(int, v), 0x4E, 0xF, 0xF, false); v += __builtin_bit_cast(float, x);
  x = __builtin_amdgcn_update_dpp(0, __builtin_bit_cast(int, v), 0x141, 0xF, 0xF, false); v += __builtin_bit_cast(float, x);
  x = __builtin_amdgcn_update_dpp(0, __builtin_bit_cast(int, v), 0x140, 0xF, 0xF, false); v += __builtin_bit_cast(float, x);
  return v;
#endif
}
DEV void p12_scan(const Params& p, int item, char* smem) {
  const int rq = item & 3, h = (item >> 2) & 7, b = item >> 5;
  const int tid = threadIdx.x, rl = tid >> 4, cg = tid & 15;
  const float* ARR[5] = {(const float*)(p.ws + OFF_RWW), (const float*)(p.ws + OFF_RWK), (const float*)(p.ws + OFF_RWKK),
                         (const float*)(p.ws + OFF_RWA), p.out + (size_t)NTOK * 512};
  const float* RWV = p.out;
  float* Yo = (float*)(p.ws + OFF_MIX);
  float* buf = (float*)smem;
  float* vbuf = buf + 2 * 16 * 5 * 64;
  float* ybuf = vbuf + 2 * 16 * 16;
  float S[4] = {0.f, 0.f, 0.f, 0.f};
  float4 rg[5]; float rv;
  const int lstep = tid >> 4, lc4 = tid & 15;
  auto gload = [&](int c) {
    const size_t o = ((size_t)b * SEQ_LEN + c * 16 + lstep) * 512 + h * 64;
#pragma unroll
    for (int a = 0; a < 5; ++a) rg[a] = ld4(ARR[a] + o + lc4 * 4);
    rv = RWV[o + rq * 16 + lc4];
  };
  auto sstore = [&](int bi) {
#pragma unroll
    for (int a = 0; a < 5; ++a) st4(buf + ((bi * 16 + lstep) * 5 + a) * 64 + lc4 * 4, rg[a]);
    vbuf[(bi * 16 + lstep) * 16 + lc4] = rv;
  };
  __syncthreads();
  gload(0);
  sstore(0);
  __syncthreads();
  const int NCH = SEQ_LEN / 16;
  for (int c = 0; c < NCH; ++c) {
    if (c + 1 < NCH) gload(c + 1);
    const float* cb = buf + (c & 1) * 16 * 5 * 64;
    const float* cv = vbuf + (c & 1) * 16 * 16;
    float4 cw = ld4(cb + 0 * 64 + cg * 4), ck = ld4(cb + 1 * 64 + cg * 4), ckk = ld4(cb + 2 * 64 + cg * 4),
           cka = ld4(cb + 3 * 64 + cg * 4), cr = ld4(cb + 4 * 64 + cg * 4);
    float cvv = cv[rl];
#pragma unroll
    for (int s = 0; s < 16; ++s) {
      const float4 w = cw, k = ck, kk = ckk, ka = cka, r = cr;
      const float v = cvv;
      if (s < 15) {
        cw = ld4(cb + ((s + 1) * 5 + 0) * 64 + cg * 4); ck = ld4(cb + ((s + 1) * 5 + 1) * 64 + cg * 4);
        ckk = ld4(cb + ((s + 1) * 5 + 2) * 64 + cg * 4); cka = ld4(cb + ((s + 1) * 5 + 3) * 64 + cg * 4);
        cr = ld4(cb + ((s + 1) * 5 + 4) * 64 + cg * 4); cvv = cv[(s + 1) * 16 + rl];
      }
      float sa = (S[0] * kk.x + S[1] * kk.y) + (S[2] * kk.z + S[3] * kk.w);
      sa = -sum16(sa);
      S[0] = S[0] * w.x + (sa * ka.x + v * k.x);
      S[1] = S[1] * w.y + (sa * ka.y + v * k.y);
      S[2] = S[2] * w.z + (sa * ka.z + v * k.z);
      S[3] = S[3] * w.w + (sa * ka.w + v * k.w);
      float y = (S[0] * r.x + S[1] * r.y) + (S[2] * r.z + S[3] * r.w);
      y = sum16(y);
      if (cg == 0) ybuf[s * 16 + rl] = y;
      asm volatile("" ::: "memory");
    }
    __syncthreads();
    if (c + 1 < NCH) sstore((c + 1) & 1);
    Yo[((size_t)b * SEQ_LEN + c * 16 + lstep) * 1024 + h * 64 + rq * 16 + lc4] = ybuf[lstep * 16 + lc4];
    __syncthreads();
  }
}
struct RetSmem { unsigned short k[64][72]; unsigned short vt[2][64][68]; };
DEV void p12_ret(const Params& p, int item, char* smem) {
  RetSmem* sm = (RetSmem*)smem;
  const int c = item % RET_NC, h = (item / RET_NC) & 3, b = item / (RET_NC * 4);
  const int tid = threadIdx.x, lane = tid & 63, wave = tid >> 6;
  const int cidx = lane & 31, hh = lane >> 5;
  const int qi = wave * 32 + cidx;
  const float* Hc = (const float*)(p.ws + OFF_H);
  const float lg = ret_log2gamma(h);
  const size_t tok0 = (size_t)b * SEQ_LEN + c * 128;
  bf16x8 qf[4], qfs[4];
  {
    const float* qr = Hc + (tok0 + qi) * CD_IN + 1792 + h * 64;
    const float qs = exp2f((float)(qi + 1) * lg);
#pragma unroll
    for (int ks = 0; ks < 4; ++ks) {
      const float4 a0 = ld4(qr + ks * 16 + hh * 8), a1 = ld4(qr + ks * 16 + hh * 8 + 4);
      const float v[8] = {a0.x, a0.y, a0.z, a0.w, a1.x, a1.y, a1.z, a1.w};
#pragma unroll
      for (int j = 0; j < 8; ++j) { qf[ks][j] = (short)f2bf(v[j]); qfs[ks][j] = (short)f2bf(v[j] * qs); }
    }
  }
  f32x16 o[4], s[2];
#pragma unroll
  for (int mt = 0; mt < 4; ++mt)
#pragma unroll
    for (int i = 0; i < 16; ++i) o[mt][i] = 0.f;
  {
    const float G = exp2f(128.f * lg);
    const float* KV0 = (const float*)(p.ws + OFF_RETKV) + (size_t)((b * 4 + h) * RET_NC) * 64 * 128;
#pragma unroll
    for (int eh = 0; eh < 2; ++eh) {
      __syncthreads();
      for (int w = tid; w < 64 * 64; w += NTHREADS) {
        const int el = w & 63, d = w >> 6;
        const float* src = KV0 + d * 128 + eh * 64 + el;
        float st = 0.f;
        int cc = 0;
        for (; cc + 8 <= c; cc += 8) {
          float e[8];
#pragma unroll
          for (int q = 0; q < 8; ++q) e[q] = src[(size_t)(cc + q) * 64 * 128];
#pragma unroll
          for (int q = 0; q < 8; ++q) st = st * G + e[q];
        }
        for (; cc < c; ++cc) st = st * G + src[(size_t)cc * 64 * 128];
        sm->k[el][d] = f2bf(st);
      }
      __syncthreads();
      qk_tile(sm->k, qfs, s, lane);
#pragma unroll
      for (int i = 0; i < 16; ++i) { o[eh * 2][i] += s[0][i]; o[eh * 2 + 1][i] += s[1][i]; }
    }
  }
#pragma unroll 1
  for (int kt = 0; kt < 2; ++kt) {
    __syncthreads();
    {
      const int row = tid >> 2, seg = tid & 3;
      const float* kr = Hc + (tok0 + kt * 64 + row) * CD_IN + 2048 + h * 64 + seg * 16;
      const float4 a0 = ld4(kr), a1 = ld4(kr + 4), a2 = ld4(kr + 8), a3 = ld4(kr + 12);
      *(uint4*)&sm->k[row][seg * 16] = make_uint4(pk2(a0.x, a0.y), pk2(a0.z, a0.w), pk2(a1.x, a1.y), pk2(a1.z, a1.w));
      *(uint4*)&sm->k[row][seg * 16 + 8] = make_uint4(pk2(a2.x, a2.y), pk2(a2.z, a2.w), pk2(a3.x, a3.y), pk2(a3.z, a3.w));
#pragma unroll
      for (int q = 0; q < 8; ++q) {
        const int f = tid + 256 * q;
        const int key = f >> 5, d4 = (f & 31) * 4;
        const float4 v = ld4(Hc + (tok0 + kt * 64 + key) * CD_IN + 2304 + h * 128 + d4);
        unsigned short(*vt)[68] = sm->vt[d4 >> 6];
        const int dl = d4 & 63;
        vt[dl][key] = f2bf(v.x); vt[dl + 1][key] = f2bf(v.y); vt[dl + 2][key] = f2bf(v.z); vt[dl + 3][key] = f2bf(v.w);
      }
    }
    __syncthreads();
    if (kt * 64 <= wave * 32 + 31) {
      qk_tile(sm->k, qf, s, lane);
#pragma unroll
      for (int ks2 = 0; ks2 < 2; ++ks2)
#pragma unroll
        for (int i = 0; i < 16; ++i) {
          const int kj = kt * 64 + ks2 * 32 + (i & 3) + 8 * (i >> 2) + 4 * hh;
          s[ks2][i] = kj <= qi ? s[ks2][i] * exp2f((float)(qi - kj) * lg) : 0.f;
        }
      pv_tile(sm->vt[0], s, *(f32x16(*)[2])&o[0], lane);
      pv_tile(sm->vt[1], s, *(f32x16(*)[2])&o[2], lane);
    }
  }
  float s1 = 0.f;
#pragma unroll
  for (int mt = 0; mt < 4; ++mt)
#pragma unroll
    for (int i = 0; i < 16; ++i) s1 += o[mt][i];
  s1 += __shfl_xor(s1, 32);
  const float mu = s1 * (1.f / 128.f);
  float s2 = 0.f;
#pragma unroll
  for (int mt = 0; mt < 4; ++mt)
#pragma unroll
    for (int i = 0; i < 16; ++i) { const float d = o[mt][i] - mu; s2 += d * d; }
  s2 += __shfl_xor(s2, 32);
  const float rstd = rsqrtf(s2 * (1.f / 128.f) + 1e-5f);
  float* MIX = (float*)(p.ws + OFF_MIX);
  const float* gate = Hc + (tok0 + qi) * CD_IN + 2816 + h * 128;
  float* dst = MIX + (tok0 + qi) * 1024 + 512 + h * 128;
  const float* lgam = p.in[I_RET_LN_G] + h * 128;
  const float* lbet = p.in[I_RET_LN_B] + h * 128;
#pragma unroll
  for (int mt = 0; mt < 4; ++mt)
#pragma unroll
    for (int g4 = 0; g4 < 4; ++g4) {
      const int dv = mt * 32 + 8 * g4 + 4 * hh;
      const float4 gv = ld4(lgam + dv), bv = ld4(lbet + dv), gt = ld4(gate + dv);
      float4 ov;
      ov.x = siluf_(gt.x) * ((o[mt][4 * g4] - mu) * rstd * gv.x + bv.x);
      ov.y = siluf_(gt.y) * ((o[mt][4 * g4 + 1] - mu) * rstd * gv.y + bv.y);
      ov.z = siluf_(gt.z) * ((o[mt][4 * g4 + 2] - mu) * rstd * gv.z + bv.z);
      ov.w = siluf_(gt.w) * ((o[mt][4 * g4 + 3] - mu) * rstd * gv.w + bv.w);
      st4(dst + dv, ov);
    }
}
DEV void phase_p12(const Params& p, char* smem) {
  const int G = gridDim.x;
  if ((int)blockIdx.x < P12_SCAN_ITEMS && G > P12_SCAN_ITEMS) {
    p12_scan(p, blockIdx.x, smem);
  } else if (G > P12_SCAN_ITEMS) {
    for (int it = blockIdx.x - P12_SCAN_ITEMS; it < P12_RET_ITEMS; it += G - P12_SCAN_ITEMS) p12_ret(p, it, smem);
  } else {
    const int total = P12_SCAN_ITEMS + P12_RET_ITEMS;
    for (int it = blockIdx.x; it < total; it += G) {
      if (it < P12_SCAN_ITEMS) p12_scan(p, it, smem);
      else p12_ret(p, it - P12_SCAN_ITEMS, smem);
    }
  }
}

#define P13_SMEM (8 * 128 * 4)
DEV void phase_p13(const Params& p, char* smem) {
  const int tid = threadIdx.x;
  const float* Hc = (const float*)(p.ws + OFF_H);
  const float* mu = p.in[I_RW_MU];
  float* sl = (float*)smem;
  float* MIX = (float*)(p.ws + OFF_MIX);
  const float* RWK = (const float*)(p.ws + OFF_RWK); const float* RWR = p.out + (size_t)NTOK * 512; const float* RWV = p.out;
  const float* g_up = p.in[I_RW_G_UP];
  for (int it = blockIdx.x; it < NTOK / 8; it += gridDim.x) {
    __syncthreads();
    for (int w = tid; w < 8 * 128; w += NTHREADS) {
      const size_t tok = (size_t)it * 8 + (w >> 7);
      sl[w] = sigmoidf_(shifted(Hc, tok, 1664 + (w & 127), mu));
    }
    __syncthreads();
#pragma unroll
    for (int cc = 0; cc < 2; ++cc) {
      const int c = tid + 256 * cc;
      float ag[8];
#pragma unroll
      for (int tt = 0; tt < 8; ++tt) ag[tt] = 0.f;
      for (int j = 0; j < 128; ++j) {
        const float gu = g_up[j * 512 + c];
#pragma unroll
        for (int tt = 0; tt < 8; ++tt) ag[tt] += sl[tt * 128 + j] * gu;
      }
      const float lng = p.in[I_RW_LN_G][c], lnb = p.in[I_RW_LN_B][c], rk = p.in[I_RW_R_K][c];
#pragma unroll
      for (int tt = 0; tt < 8; ++tt) {
        const size_t tok = (size_t)it * 8 + tt;
        const float y = MIX[tok * 1024 + c];
        const float m = wave_sum(y) * (1.f / 64.f);
        const float d = y - m;
        const float var = wave_sum(d * d) * (1.f / 64.f);
        const float yn = d * rsqrtf(var + 64e-5f) * lng + lnb;
        const float r = RWR[tok * 512 + c], k = RWK[tok * 512 + c], v = RWV[tok * 512 + c];
        const float bonus = wave_sum(r * k * rk) * v;
        MIX[tok * 1024 + c] = (yn + bonus) * ag[tt];
      }
    }
  }
}

#define NPHASES 20
#define SMEM_BYTES 67584
DEV void run_phase(const Params& p, int ph, char* smem) {
  switch (ph) {
    case 0: phase_gemm_in<0>(p, smem); break;
    case 1: phase_p1(p, smem); break;
    case 2: phase_p2(p, smem); break;
    case 3: phase_glu(p, smem); break;
    case 4: phase_outproj<0>(p, smem); break;
    case 5: phase_ln_router<0>(p, smem); break;
    case 6: phase_lists_shup<0>(p, smem); break;
    case 7: phase_routed_up<0>(p, smem); break;
    case 8: phase_down<0>(p, smem); break;
    case 9: phase_combine<0>(p, smem); break;
    case 10: phase_gemm_in<1>(p, smem); break;
    case 11: phase_p11(p, smem); break;
    case 12: phase_p12(p, smem); break;
    case 13: phase_p13(p, smem); break;
    case 14: phase_outproj<1>(p, smem); break;
    case 15: phase_ln_router<1>(p, smem); break;
    case 16: phase_lists_shup<1>(p, smem); break;
    case 17: phase_routed_up<1>(p, smem); break;
    case 18: phase_down<1>(p, smem); break;
    case 19: phase_combine<1>(p, smem); break;
    case 20: phase_p1b(p, smem); break;
  }
}
static_assert(P1_SMEM <= SMEM_BYTES, "smem");
static_assert(P1_PREP_SMEM <= SMEM_BYTES, "smem");
static_assert(P2_SMEM <= SMEM_BYTES, "smem");
static_assert(P5_SMEM <= SMEM_BYTES, "smem");
static_assert(P7_SMEM <= SMEM_BYTES, "smem");
static_assert(P12_SMEM <= SMEM_BYTES, "smem");
static_assert(OFF_HS + (size_t)NTOK * 256 * 2 <= OFF_X1, "layout");

#ifndef CPU_EMU
template <int PH>
__global__ void __launch_bounds__(NTHREADS) phase_kernel(Params p) {
  __shared__ __attribute__((aligned(16))) char smem[SMEM_BYTES];
  run_phase(p, PH, smem);
}
template <int PH>
static void launch_phases(const Params& p, hipStream_t stream) {
  phase_kernel<PH><<<dim3(1024), dim3(NTHREADS), 0, stream>>>(p);
  if constexpr (PH + 1 < NPHASES) launch_phases<PH + 1>(p, stream);
}
#if MEGA
DEV void grid_barrier(unsigned* bar, unsigned& epoch) {
  asm volatile("s_waitcnt vmcnt(0)" ::: "memory");
  __syncthreads();
  epoch += 1u;
  if (threadIdx.x == 0) {
    __builtin_amdgcn_fence(__ATOMIC_RELEASE, "agent");
    asm volatile("s_waitcnt vmcnt(0)" ::: "memory");
    __hip_atomic_fetch_add(bar, 1u, __ATOMIC_RELAXED, __HIP_MEMORY_SCOPE_AGENT);
    const unsigned target = epoch * gridDim.x;
    while (__hip_atomic_load(bar, __ATOMIC_RELAXED, __HIP_MEMORY_SCOPE_AGENT) < target) __builtin_amdgcn_s_sleep(1);
    __builtin_amdgcn_fence(__ATOMIC_ACQUIRE, "agent");
    asm volatile("s_waitcnt vmcnt(0)" ::: "memory");
  }
  __syncthreads();
}
__global__ void __launch_bounds__(NTHREADS) mega_kernel(Params p) {
  __shared__ __attribute__((aligned(16))) char smem[SMEM_BYTES];
  unsigned* bar = (unsigned*)(p.ws + OFF_BAR);
  unsigned epoch = 0u;
  if (p.ws == nullptr) cg::this_grid().sync();
  typedef const __attribute__((address_space(4))) Params* KParams;
#define PH_(n) { KParams kp = (KParams)__builtin_amdgcn_kernarg_segment_ptr(); asm volatile("" : "+s"(kp)); const Params lp = *(const Params*)kp; run_phase(lp, n, smem); } grid_barrier(bar, epoch);
  PH_(0) PH_(1) PH_(20) PH_(2) PH_(3) PH_(4) PH_(5) PH_(6) PH_(7) PH_(8) PH_(9)
  PH_(10) PH_(11) PH_(12) PH_(13) PH_(14) PH_(15) PH_(16) PH_(17) PH_(18)
  { KParams kp = (KParams)__builtin_amdgcn_kernarg_segment_ptr(); asm volatile("" : "+s"(kp)); const Params lp = *(const Params*)kp; run_phase(lp, 19, smem); }
}

#endif

extern "C" void kernel_launch(void* const* d_in, const int* in_sizes, int n_in, void* d_out, int out_size, void* d_ws, size_t ws_size,
                              hipStream_t stream) {
  Params p;
  for (int i = 0; i < N_INPUTS; ++i) p.in[i] = (const float*)d_in[i];
  p.out = (float*)d_out;
  p.ws = (char*)d_ws;
#if MEGA
  static int grid_blocks = 0;
  if (!grid_blocks) {
    int dev = 0, cus = 0, per_cu = 0;
    hipGetDevice(&dev);
    hipDeviceGetAttribute(&cus, hipDeviceAttributeMultiprocessorCount, dev);
    hipOccupancyMaxActiveBlocksPerMultiprocessor(&per_cu, mega_kernel, NTHREADS, 0);
    if (per_cu > 2) per_cu = 2;
    grid_blocks = cus * per_cu;
  }
  hipMemsetAsync((char*)d_ws + OFF_BAR, 0, 4096, stream);
  void* args[] = {&p};
  hipError_t e = hipLaunchCooperativeKernel((void*)mega_kernel, dim3(grid_blocks), dim3(NTHREADS), args, 0, stream);
  if (e != hipSuccess) fprintf(stderr, "cooperative launch failed: %s (grid %d)\n", hipGetErrorString(e), grid_blocks);
#else
  launch_phases<0>(p, stream);
#endif
}
#endif
```

```cpp
#ifdef CPU_EMU
#include "emu.h"
#else
#include <hip/hip_runtime.h>
#include <hip/hip_cooperative_groups.h>
#include <cstdio>
namespace cg = cooperative_groups;
#endif
#include <stdint.h>

#ifndef BATCH
#define BATCH 2
#endif
#ifndef SEQ_LEN
#define SEQ_LEN 8192
#endif
#ifndef MEGA
#define MEGA 1
#endif

#define DEV __device__ __forceinline__
#define NTOK (BATCH * SEQ_LEN)
#define DM 1024
#define AB_IN 1816
#define CD_IN 3328
#define NCMP ((SEQ_LEN - 32) / 16 + 1)
#define NBLK (SEQ_LEN / 64)
#define NB_CMP ((NCMP + 63) / 64)
#define S5_NC (SEQ_LEN / 64)
#define RET_NC (SEQ_LEN / 128)
#define ALPHA_F 1.4142135623730951f
#define NTHREADS 256

enum { I_X = 0, I_AB_W_IN, I_AB_W_OUT, I_S5_LAM_RE, I_S5_LAM_IM, I_S5_LOG_DT, I_S5_B_RE, I_S5_B_IM, I_S5_C_RE, I_S5_C_IM,
       I_S5_D, I_S5_W_GLU, I_S5_B_GLU, I_PE_K, I_PE_V, I_CK_W1, I_CK_B1, I_CK_W2, I_CV_W1, I_CV_B1, I_CV_W2,
       I_CD_W_IN, I_CD_W_OUT, I_RW_MU, I_RW_W0, I_RW_W_UP, I_RW_A0, I_RW_A_UP, I_RW_G_UP, I_RW_K_K, I_RW_K_A, I_RW_R_K,
       I_RW_LN_G, I_RW_LN_B, I_RET_LN_G, I_RET_LN_B, I_LN1_G, I_LN1_B, I_LN2_G, I_LN2_B, I_ROUTER, I_MOE_BIAS,
       I_MOE_W1, I_MOE_W3, I_MOE_W2, I_SH_W1, I_SH_W3, I_SH_W2, N_INPUTS };

struct Params {
  const float* in[N_INPUTS];
  float* out;
  char* ws;
};

#define MiB_TOK ((size_t)NTOK * 1024 * 4)
#define OFF_H 0
#define OFF_MIX ((size_t)NTOK * 3328 * 4)
#define OFF_X1 (OFF_MIX + MiB_TOK)
#define OFF_X2 (OFF_X1 + MiB_TOK)
#define OFF_R4 (OFF_X2 + MiB_TOK)
#define OFF_R5 (OFF_R4 + MiB_TOK)
#define OFF_Y OFF_H
#define OFF_HS (OFF_H + 4 * MiB_TOK)
#define OFF_FS OFF_X2
#define OFF_HR OFF_R4
#define OFF_X2B OFF_R4
#define OFF_TOPI (OFF_R5)
#define OFF_TOPG (OFF_TOPI + (size_t)NTOK * 8 * 4)
#define OFF_POSOF (OFF_TOPG + (size_t)NTOK * 8 * 4)
#define OFF_CNT (OFF_POSOF + (size_t)NTOK * 8 * 4)
#define OFF_LTOK (OFF_CNT + 1024)
#define OFF_LGATE (OFF_LTOK + (size_t)64 * NTOK * 4)
#define OFF_S5E (OFF_LGATE + (size_t)64 * NTOK * 4)
#define OFF_KCMP (OFF_S5E + (size_t)BATCH * S5_NC * 32 * 64 * 8)
#define OFF_VCMP (OFF_KCMP + (size_t)BATCH * NCMP * 2 * 64 * 4)
#define OFF_RETKV (OFF_VCMP + (size_t)BATCH * NCMP * 2 * 64 * 4)
#define OFF_BAR (OFF_RETKV + (size_t)BATCH * 4 * RET_NC * 64 * 128 * 4)
#define OFF_CMPHID (OFF_BAR + 4096)
#define OFF_CMPC1 (OFF_CMPHID + (size_t)2 * BATCH * 2 * NB_CMP * 64 * 128 * 4)
#define OFF_END (OFF_CMPC1 + 1024)
#define OFF_YGELU OFF_X1
#define OFF_RWW OFF_X1
#define OFF_RWK (OFF_X1 + (size_t)NTOK * 512 * 4)
#define OFF_RWKK OFF_R4
#define OFF_RWA (OFF_R4 + (size_t)NTOK * 512 * 4)

typedef short bf16x8 __attribute__((ext_vector_type(8)));
typedef float f32x16 __attribute__((ext_vector_type(16)));

#ifdef CPU_EMU
#define WAVE_SYNC() emu_wave_bar()
#else
#define WAVE_SYNC() __builtin_amdgcn_wave_barrier()
#endif

DEV float sigmoidf_(float x) { return 1.f / (1.f + __expf(-x)); }
DEV float siluf_(float x) { return x * sigmoidf_(x); }
DEV float geluf_(float x) { float u = 0.7978845608028654f * (x + 0.044715f * x * x * x); return 0.5f * x * (1.f + tanhf(u)); }
DEV unsigned short f2bf(float f) {
  unsigned u = __builtin_bit_cast(unsigned, f);
  u += 0x7FFFu + ((u >> 16) & 1u);
  return (unsigned short)(u >> 16);
}
DEV float bf2f(unsigned short h) { return __builtin_bit_cast(float, ((unsigned)h) << 16); }
DEV float wave_sum(float v) {
#pragma unroll
  for (int m = 32; m >= 1; m >>= 1) v += __shfl_xor(v, m);
  return v;
}
DEV float wave_max(float v) {
#pragma unroll
  for (int m = 32; m >= 1; m >>= 1) v = fmaxf(v, __shfl_xor(v, m));
  return v;
}
DEV float4 ld4(const float* p) { return *(const float4*)p; }
#ifdef CPU_EMU
DEV float fexp2(float x) { return exp2f(x); }
#else
DEV float fexp2(float x) { return __builtin_amdgcn_exp2f(x); }
#endif
DEV void fast_sincos(float x, float* sn, float* cs) {
  const float k = rintf(x * 0.15915494309189535f);
  float r = fmaf(-k, 6.28125f, x);
  r = fmaf(-k, 1.9353071795864769e-3f, r);
  *sn = __sinf(r); *cs = __cosf(r);
}
DEV void st4(float* p, float4 v) { *(float4*)p = v; }

#define GEMM_BM 256
#define GEMM_MI (GEMM_BM / 64)
#define GEMM_SMEM_BYTES ((GEMM_BM + 128) * 72 * 2)
#ifdef CPU_EMU
DEV unsigned pk2(float a, float b) { return (unsigned)f2bf(a) | ((unsigned)f2bf(b) << 16); }
#else
typedef __bf16 hbf16x2 __attribute__((ext_vector_type(2)));
typedef float hf32x2 __attribute__((ext_vector_type(2)));
DEV unsigned pk2(float a, float b) {
  hf32x2 f = {a, b};
  return __builtin_bit_cast(unsigned, __builtin_convertvector(f, hbf16x2));
}
#endif
template <bool ABF, class AROW, class BPTR, class EPI>
DEV void gemm_tile(AROW arow, BPTR bptr, int ldb, int K, EPI epi, char* smem_raw, int akstep = 64) {
  unsigned short(*sA)[72] = (unsigned short(*)[72])smem_raw;
  unsigned short(*sB)[72] = (unsigned short(*)[72])(smem_raw + GEMM_BM * 72 * 2);
  const int tid = threadIdx.x, lane = tid & 63, wave = tid >> 6;
  const int wm = wave >> 1, wn = wave & 1;
#if defined(CPU_EMU) && !defined(EMU_REAL_GEMM)
  for (int mi = 0; mi < GEMM_MI; ++mi)
    for (int r = 0; r < 16; ++r) {
      const int row = wm * (GEMM_BM / 2) + mi * 32 + (r & 3) + 8 * (r >> 2) + 4 * (lane >> 5);
      const int col = wn * 64 + (lane & 31);
      const void* arp = arow(row);
      float v[2] = {0.f, 0.f};
      for (int ni = 0; ni < 2; ++ni) {
        const int cc = col + ni * 32;
        const float* bq = bptr(cc & ~3);
        if (!arp || !bq) continue;
        bq += cc & 3;
        float a = 0.f;
        for (int k = 0; k < K; ++k) {
          const size_t ka = (size_t)(k >> 6) * akstep + (k & 63);
          const float av = ABF ? bf2f(((const unsigned short*)arp)[ka]) : bf2f(f2bf(((const float*)arp)[ka]));
          a += av * bf2f(f2bf(bq[(size_t)k * ldb]));
        }
        v[ni] = a;
      }
      epi(row, col, v[0], v[1]);
    }
  return;
#endif
  const float* ap[4 * GEMM_MI];
  const unsigned short* aph[2 * GEMM_MI];
  if (ABF) {
#pragma unroll
    for (int i = 0; i < 2 * GEMM_MI; ++i) aph[i] = (const unsigned short*)arow((tid >> 3) + 32 * i);
  } else {
#pragma unroll
    for (int i = 0; i < 4 * GEMM_MI; ++i) ap[i] = (const float*)arow((tid >> 4) + 16 * i);
  }
  const float* bp = bptr((tid & 31) * 4);
  const int kgrp = tid >> 5;
  float4 ra[4 * GEMM_MI];
  uint4 rah[2 * GEMM_MI];
  float4 rb[8];
  auto gload = [&](int k0) {
    if (ABF) {
#pragma unroll
      for (int i = 0; i < 2 * GEMM_MI; ++i) rah[i] = aph[i] ? *(const uint4*)(aph[i] + (size_t)(k0 >> 6) * akstep + (tid & 7) * 8) : make_uint4(0, 0, 0, 0);
    } else {
#pragma unroll
      for (int i = 0; i < 4 * GEMM_MI; ++i) ra[i] = ap[i] ? ld4(ap[i] + (size_t)(k0 >> 6) * akstep + (tid & 15) * 4) : make_float4(0.f, 0.f, 0.f, 0.f);
    }
#pragma unroll
    for (int j = 0; j < 8; ++j) rb[j] = bp ? ld4(bp + (size_t)(k0 + kgrp * 8 + j) * ldb) : make_float4(0.f, 0.f, 0.f, 0.f);
  };
  auto sstore = [&]() {
    if (ABF) {
#pragma unroll
      for (int i = 0; i < 2 * GEMM_MI; ++i) *(uint4*)&sA[(tid >> 3) + 32 * i][(tid & 7) * 8] = rah[i];
    } else {
#pragma unroll
      for (int i = 0; i < 4 * GEMM_MI; ++i) *(uint2*)&sA[(tid >> 4) + 16 * i][(tid & 15) * 4] = make_uint2(pk2(ra[i].x, ra[i].y), pk2(ra[i].z, ra[i].w));
    }
    const int nb = (tid & 31) * 4;
    *(uint4*)&sB[nb + 0][kgrp * 8] = make_uint4(pk2(rb[0].x, rb[1].x), pk2(rb[2].x, rb[3].x), pk2(rb[4].x, rb[5].x), pk2(rb[6].x, rb[7].x));
    *(uint4*)&sB[nb + 1][kgrp * 8] = make_uint4(pk2(rb[0].y, rb[1].y), pk2(rb[2].y, rb[3].y), pk2(rb[4].y, rb[5].y), pk2(rb[6].y, rb[7].y));
    *(uint4*)&sB[nb + 2][kgrp * 8] = make_uint4(pk2(rb[0].z, rb[1].z), pk2(rb[2].z, rb[3].z), pk2(rb[4].z, rb[5].z), pk2(rb[6].z, rb[7].z));
    *(uint4*)&sB[nb + 3][kgrp * 8] = make_uint4(pk2(rb[0].w, rb[1].w), pk2(rb[2].w, rb[3].w), pk2(rb[4].w, rb[5].w), pk2(rb[6].w, rb[7].w));
  };
  f32x16 acc[GEMM_MI][2];
#pragma unroll
  for (int mi = 0; mi < GEMM_MI; ++mi)
#pragma unroll
    for (int ni = 0; ni < 2; ++ni)
#pragma unroll
      for (int r = 0; r < 16; ++r) acc[mi][ni][r] = 0.f;
  gload(0);
  for (int k0 = 0; k0 < K; k0 += 64) {
    __syncthreads();
    sstore();
    __syncthreads();
    if (k0 + 64 < K) gload(k0 + 64);
#pragma unroll
    for (int ks = 0; ks < 4; ++ks) {
      bf16x8 af[GEMM_MI], bfr[2];
#pragma unroll
      for (int mi = 0; mi < GEMM_MI; ++mi) af[mi] = *(const bf16x8*)&sA[wm * (GEMM_BM / 2) + mi * 32 + (lane & 31)][ks * 16 + (lane >> 5) * 8];
#pragma unroll
      for (int ni = 0; ni < 2; ++ni) bfr[ni] = *(const bf16x8*)&sB[wn * 64 + ni * 32 + (lane & 31)][ks * 16 + (lane >> 5) * 8];
#pragma unroll
      for (int mi = 0; mi < GEMM_MI; ++mi)
#pragma unroll
        for (int ni = 0; ni < 2; ++ni) acc[mi][ni] = __builtin_amdgcn_mfma_f32_32x32x16_bf16(af[mi], bfr[ni], acc[mi][ni], 0, 0, 0);
    }
  }
#pragma unroll
  for (int mi = 0; mi < GEMM_MI; ++mi)
#pragma unroll
    for (int r = 0; r < 16; ++r) {
      int row = wm * (GEMM_BM / 2) + mi * 32 + (r & 3) + 8 * (r >> 2) + 4 * (lane >> 5);
      int col = wn * 64 + (lane & 31);
      epi(row, col, acc[mi][0][r], acc[mi][1][r]);
    }
}

template <int LAYER>
DEV void phase_gemm_in(const Params& p, char* smem) {
  const int N = LAYER == 0 ? AB_IN : CD_IN;
  const float* A = LAYER == 0 ? p.in[I_X] : (const float*)(p.ws + OFF_X2);
  const float* B = LAYER == 0 ? p.in[I_AB_W_IN] : p.in[I_CD_W_IN];
  float* C = (float*)(p.ws + OFF_H);
  const int NT = (N + 127) / 128, MT = NTOK / GEMM_BM;
  const int xcd_ = blockIdx.x & 7, lb_ = blockIdx.x >> 3, nb_ = gridDim.x >> 3;
  for (int j_ = lb_; j_ < (MT / 8) * NT; j_ += nb_) {
    const int it = (xcd_ + 8 * (j_ / NT)) * NT + (j_ % NT);
    const int tm = it / NT, tn = it % NT;
    const int m0 = tm * GEMM_BM, n0 = tn * 128;
    gemm_tile<LAYER == 1>(
        [&](int r) { return LAYER == 1 ? (const void*)((const unsigned short*)(p.ws + OFF_X2B) + (size_t)(m0 + r) * DM) : (const void*)(A + (size_t)(m0 + r) * DM); },
        [&](int c) { return (n0 + c < N) ? (B + n0 + c) : (const float*)nullptr; }, N, DM,
        [&](int row, int col, float v0, float v1) {
          const int gm = m0 + row, gc = n0 + col;
          if (LAYER == 1 && gc >= 1792 && gc < 2304) {
            const int i = gc & 63;
            const float pos = (float)(gm % SEQ_LEN);
            const float inv = __expf(-(float)i * (9.210340371976184f / 32.f));
            float sn, cs;
            fast_sincos(pos * inv, &sn, &cs);
            float o0 = v0 * cs - v1 * sn, o1 = v1 * cs + v0 * sn;
            if (gc >= 2048) { o0 *= 0.125f; o1 *= 0.125f; }
            v0 = o0; v1 = o1;
          }
          if (gc < N) C[(size_t)gm * N + gc] = v0;
          if (gc + 32 < N) C[(size_t)gm * N + gc + 32] = v1;
        },
        smem);
  }
}

struct S5Const { float lb_re, lb_im; };
DEV void s5_consts(const Params& p, int g, int pp, float& lb_re, float& lb_im, float (&bbr)[16], float (&bbi)[16]) {
  const float dt = expf(p.in[I_S5_LOG_DT][g]);
  const float lr = p.in[I_S5_LAM_RE][g * 64 + pp], li = p.in[I_S5_LAM_IM][g * 64 + pp];
  const float mag = expf(lr * dt);
  float sn, cs;
  sincosf(li * dt, &sn, &cs);
  lb_re = mag * cs; lb_im = mag * sn;
  const float den = lr * lr + li * li;
  const float f_re = ((lb_re - 1.f) * lr + lb_im * li) / den;
  const float f_im = (lb_im * lr - (lb_re - 1.f) * li) / den;
  const float* br = p.in[I_S5_B_RE] + (size_t)(g * 64 + pp) * 16;
  const float* bi = p.in[I_S5_B_IM] + (size_t)(g * 64 + pp) * 16;
#pragma unroll
  for (int h = 0; h < 16; ++h) {
    bbr[h] = f_re * br[h] - f_im * bi[h];
    bbi[h] = f_re * bi[h] + f_im * br[h];
  }
}

#define OFF_QB OFF_X2
#define OFF_KSB (OFF_QB + (size_t)NTOK * 512 * 2)
#define OFF_KWB (OFF_KSB + (size_t)NTOK * 128 * 2)
#define OFF_VST (OFF_KWB + (size_t)NTOK * 128 * 2)
#define OFF_VWT (OFF_VST + (size_t)NTOK * 128 * 2)
#define OFF_KCB (OFF_VWT + (size_t)NTOK * 128 * 2)
#define OFF_VCT (OFF_KCB + (size_t)BATCH * 2 * NB_CMP * 64 * 64 * 2)
#define NSA_QSCALE (0.125f * 1.4426950408889634f)

#define P1_S5A_ITEMS (BATCH * 32 * S5_NC / 4)
#define P1_CMP_TILES ((NCMP + 7) / 8)
#define P1_CMP_ITEMS (2 * BATCH * 2 * P1_CMP_TILES)
DEV void p1_s5a(const Params& p, int item, char* smem) {
  const int lane = threadIdx.x & 63, wave = threadIdx.x >> 6;
  const int idx = item * 4 + wave;
  const int g = idx & 31, c = (idx >> 5) % S5_NC, b = idx / (32 * S5_NC);
  float lb_re, lb_im, bbr[16], bbi[16];
  s5_consts(p, g, lane, lb_re, lb_im, bbr, bbi);
  const float* H = (const float*)(p.ws + OFF_H);
  float sr = 0.f, si = 0.f;
  float* su = (float*)smem + wave * 64 * 16;
  __syncthreads();
  {
    const float* ur = H + (size_t)(b * SEQ_LEN + c * 64 + lane) * AB_IN + g * 16;
#pragma unroll
    for (int q = 0; q < 4; ++q) st4(su + lane * 16 + q * 4, ld4(ur + q * 4));
  }
  WAVE_SYNC();
  for (int tt = 0; tt < 64; ++tt) {
    const float* u = su + tt * 16;
    float dr = 0.f, di = 0.f;
#pragma unroll
    for (int h4 = 0; h4 < 4; ++h4) {
      const float4 uv = ld4(u + h4 * 4);
      dr += uv.x * bbr[h4 * 4] + uv.y * bbr[h4 * 4 + 1] + uv.z * bbr[h4 * 4 + 2] + uv.w * bbr[h4 * 4 + 3];
      di += uv.x * bbi[h4 * 4] + uv.y * bbi[h4 * 4 + 1] + uv.z * bbi[h4 * 4 + 2] + uv.w * bbi[h4 * 4 + 3];
    }
    const float nr = lb_re * sr - lb_im * si + dr;
    const float ni = lb_re * si + lb_im * sr + di;
    sr = nr; si = ni;
  }
  float2* E = (float2*)(p.ws + OFF_S5E);
  E[((size_t)(b * S5_NC + c) * 32 + g) * 64 + lane] = make_float2(sr, si);
}
#define P1_CMPG_MT ((NCMP + GEMM_BM - 1) / GEMM_BM)
#define P1_CMPG_ITEMS (2 * BATCH * 2 * P1_CMPG_MT)
DEV void p1_cmpgemm(const Params& p, int item, char* smem) {
  const int mt = item % P1_CMPG_MT;
  int r = item / P1_CMPG_MT;
  const int g = r & 1; r >>= 1;
  const int b = r % BATCH; const int which = r / BATCH;
  const float* H = (const float*)(p.ws + OFF_H);
  const float* w1 = which ? p.in[I_CV_W1] : p.in[I_CK_W1];
  const int colbase = (which ? 1152 : 1024) + g * 64;
  float* HID = (float*)(p.ws + OFF_CMPHID) + ((size_t)(which * BATCH + b) * 2 + g) * NB_CMP * 64 * 128;
  const int n0 = mt * GEMM_BM;
  gemm_tile<false>(
      [&](int rr) { return (n0 + rr < NCMP) ? (const void*)(H + ((size_t)b * SEQ_LEN + 16 * (n0 + rr)) * AB_IN + colbase) : (const void*)nullptr; },
      [&](int c) { return w1 + c; }, 128, 2048,
      [&](int row, int col, float v0, float v1) {
        if (n0 + row < NCMP) { HID[(size_t)(n0 + row) * 128 + col] = v0; HID[(size_t)(n0 + row) * 128 + col + 32] = v1; }
      },
      smem, AB_IN);
}
DEV void p1_cmpc1(const Params& p, int which, char* smem) {
  const float* pe = which ? p.in[I_PE_V] : p.in[I_PE_K];
  const float* w1 = which ? p.in[I_CV_W1] : p.in[I_CK_W1];
  float* sPart = (float*)smem;
  const int tid = threadIdx.x, hid = tid & 127, kh = tid >> 7;
  float a = 0.f;
  for (int k = kh * 1024; k < kh * 1024 + 1024; ++k) a += pe[k] * w1[(size_t)k * 128 + hid];
  __syncthreads();
  sPart[tid] = a;
  __syncthreads();
  if (tid < 128) ((float*)(p.ws + OFF_CMPC1))[which * 128 + tid] = sPart[tid] + sPart[tid + 128];
  __syncthreads();
}
DEV void p1_compress(const Params& p, int item, char* smem) {
  const int tile = item % P1_CMP_TILES;
  int r = item / P1_CMP_TILES;
  const int g = r & 1; r >>= 1;
  const int b = r % BATCH; const int which = r / BATCH;
  const int n0 = tile * 8;
  const float* b1 = which ? p.in[I_CV_B1] : p.in[I_CK_B1];
  const float* w2 = which ? p.in[I_CV_W2] : p.in[I_CK_W2];
  const float* C1 = (const float*)(p.ws + OFF_CMPC1) + which * 128;
  const float* HID = (const float*)(p.ws + OFF_CMPHID) + ((size_t)(which * BATCH + b) * 2 + g) * NB_CMP * 64 * 128;
  float* sPart = (float*)smem;
  float* sHid = sPart + 2 * 8 * 128;
  const int tid = threadIdx.x;
  __syncthreads();
  for (int w = tid; w < 8 * 128; w += NTHREADS) {
    const int rr = w >> 7, hid = w & 127;
    const int n = n0 + rr;
    sHid[w] = n < NCMP ? geluf_(HID[(size_t)n * 128 + hid] + C1[hid] + b1[hid]) : 0.f;
  }
  __syncthreads();
  float* sOut = sPart;
  for (int w = tid; w < 8 * 64; w += NTHREADS) {
    const int rr = w >> 6, d = w & 63;
    float a = 0.f;
    for (int hid = 0; hid < 128; ++hid) a += sHid[rr * 128 + hid] * w2[hid * 64 + d];
    sOut[w] = a;
  }
  __syncthreads();
  float* dst = (float*)(p.ws + (which ? OFF_VCMP : OFF_KCMP));
  for (int w = tid; w < 8 * 64; w += NTHREADS) {
    const int rr = w >> 6, d = w & 63;
    const int n = n0 + rr;
    if (n >= NCMP) continue;
    float v = sOut[w];
    if (which == 0 && d < 16) {
      const int i = d & 7;
      const float pos = (float)(n * 16 + 31);
      const float inv = __expf(-(float)i * (13.122363377404328f / 8.f));
      float sn, cs;
      sincosf(pos * inv, &sn, &cs);
      const float x1 = sOut[rr * 64 + i], x2 = sOut[rr * 64 + i + 8];
      v = d < 8 ? x1 * cs - x2 * sn : x2 * cs + x1 * sn;
    }
    dst[((size_t)(b * NCMP + n) * 2 + g) * 64 + d] = v;
    if (which == 0) ((unsigned short*)(p.ws + OFF_KCB))[(((size_t)b * 2 + g) * NB_CMP * 64 + n) * 64 + d] = f2bf(v);
    else ((unsigned short*)(p.ws + OFF_VCT))[((((size_t)b * 2 + g) * NB_CMP + (n >> 6)) * 64 + d) * 64 + (n & 63)] = f2bf(v);
  }
  for (int w = tid; w < 8 * 64; w += NTHREADS) {
    const int rr = w >> 6, d = w & 63;
    const int n = n0 + rr;
    if (n < NCMP || n >= NB_CMP * 64) continue;
    if (which == 0) ((unsigned short*)(p.ws + OFF_KCB))[(((size_t)b * 2 + g) * NB_CMP * 64 + n) * 64 + d] = 0;
    else ((unsigned short*)(p.ws + OFF_VCT))[((((size_t)b * 2 + g) * NB_CMP + (n >> 6)) * 64 + d) * 64 + (n & 63)] = 0;
  }
}
DEV uint4 pack8(const float* v) {
  uint4 r;
  r.x = (unsigned)f2bf(v[0]) | ((unsigned)f2bf(v[1]) << 16);
  r.y = (unsigned)f2bf(v[2]) | ((unsigned)f2bf(v[3]) << 16);
  r.z = (unsigned)f2bf(v[4]) | ((unsigned)f2bf(v[5]) << 16);
  r.w = (unsigned)f2bf(v[6]) | ((unsigned)f2bf(v[7]) << 16);
  return r;
}
#define P1_PREP_ITEMS (NTOK / 64)
#define P1_PREP_SMEM ((64 * 8 * 2 + 64 * 128) * 4)
DEV void p1_prep(const Params& p, int item, char* smem) {
  const int tid = threadIdx.x;
  const int b = item / NBLK, blk = item % NBLK;
  const float* H = (const float*)(p.ws + OFF_H);
  float* sCS = (float*)smem;
  float* sV = sCS + 64 * 8 * 2;
  const size_t tok0 = (size_t)b * SEQ_LEN + blk * 64;
  __syncthreads();
  for (int w = tid; w < 64 * 8; w += NTHREADS) {
    const int tk = w >> 3, i = w & 7;
    const float pos = (float)(blk * 64 + tk);
    const float inv = __expf(-(float)i * (13.122363377404328f / 8.f));
    float sn, cs;
    sincosf(pos * inv, &sn, &cs);
    sCS[w * 2] = cs; sCS[w * 2 + 1] = sn;
  }
  __syncthreads();
  unsigned short* QB = (unsigned short*)(p.ws + OFF_QB);
  unsigned short* KSB = (unsigned short*)(p.ws + OFF_KSB);
  unsigned short* KWB = (unsigned short*)(p.ws + OFF_KWB);
  for (int w = tid; w < 64 * 12 * 8; w += NTHREADS) {
    const int o = w & 7, hd = (w >> 3) % 12, tk = w / 96;
    const int col = hd < 8 ? 512 + hd * 64 : (hd < 10 ? 1280 + (hd - 8) * 64 : 1536 + (hd - 10) * 64);
    const float* x = H + (tok0 + tk) * AB_IN + col;
    float v[8];
    const float4 a0 = ld4(x + o * 8), a1 = ld4(x + o * 8 + 4);
    v[0] = a0.x; v[1] = a0.y; v[2] = a0.z; v[3] = a0.w; v[4] = a1.x; v[5] = a1.y; v[6] = a1.z; v[7] = a1.w;
    if (o < 2) {
      const float4 c0 = ld4(x + (1 - o) * 8), c1 = ld4(x + (1 - o) * 8 + 4);
      const float u[8] = {c0.x, c0.y, c0.z, c0.w, c1.x, c1.y, c1.z, c1.w};
#pragma unroll
      for (int i = 0; i < 8; ++i) {
        const float cs = sCS[(tk * 8 + i) * 2], sn = sCS[(tk * 8 + i) * 2 + 1];
        v[i] = o == 0 ? v[i] * cs - u[i] * sn : v[i] * cs + u[i] * sn;
      }
    }
    if (hd < 8) {
#pragma unroll
      for (int i = 0; i < 8; ++i) v[i] *= NSA_QSCALE;
      *(uint4*)(QB + ((tok0 + tk) * 8 + hd) * 64 + o * 8) = pack8(v);
    } else {
      const int g = (hd - 8) & 1;
      unsigned short* dst = (hd < 10 ? KSB : KWB) + (((size_t)b * 2 + g) * SEQ_LEN + blk * 64 + tk) * 64 + o * 8;
      *(uint4*)dst = pack8(v);
    }
  }
#pragma unroll 1
  for (int which = 0; which < 2; ++which) {
    const int col = which ? 1664 : 1408;
    __syncthreads();
    for (int w = tid; w < 64 * 32; w += NTHREADS) {
      const int tk = w >> 5, c4 = (w & 31) * 4;
      st4(sV + tk * 128 + c4, ld4(H + (tok0 + tk) * AB_IN + col + c4));
    }
    __syncthreads();
    unsigned short* VT = (unsigned short*)(p.ws + (which ? OFF_VWT : OFF_VST));
    for (int w = tid; w < 2 * 64 * 8; w += NTHREADS) {
      const int ko = w & 7, d = (w >> 3) & 63, g = w >> 9;
      float v[8];
#pragma unroll
      for (int i = 0; i < 8; ++i) v[i] = sV[(ko * 8 + i) * 128 + g * 64 + d];
      *(uint4*)(VT + ((((size_t)b * 2 + g) * NBLK + blk) * 64 + d) * 64 + ko * 8) = pack8(v);
    }
  }
}

struct NsaSmem {
  unsigned short k[64][72];
  unsigned short vt[64][68];
  float imp[32][128];
  unsigned selmask[32][4];
  unsigned unionm[4];
  float keyb[4][128];
};
#define P2_NSA_SMEM ((int)sizeof(NsaSmem))
#define NSA_QT (SEQ_LEN / 32)
#define P2_NSA_ITEMS (BATCH * 2 * NSA_QT)

struct TileRegs { uint4 k0, k1, v0, v1; };
DEV void tile_gload(TileRegs& r, const unsigned short* Kg, const unsigned short* Vg, int tid) {
  const int row = tid >> 2, seg = tid & 3;
  r.k0 = *(const uint4*)(Kg + row * 64 + seg * 16);
  r.k1 = *(const uint4*)(Kg + row * 64 + seg * 16 + 8);
  if (Vg) {
    r.v0 = *(const uint4*)(Vg + row * 64 + seg * 16);
    r.v1 = *(const uint4*)(Vg + row * 64 + seg * 16 + 8);
  }
}
DEV void tile_sstore(NsaSmem* sm, const TileRegs& r, bool withV, int tid) {
  const int row = tid >> 2, seg = tid & 3;
  *(uint4*)&sm->k[row][seg * 16] = r.k0;
  *(uint4*)&sm->k[row][seg * 16 + 8] = r.k1;
  if (withV) {
    *(uint2*)&sm->vt[row][seg * 16] = make_uint2(r.v0.x, r.v0.y);
    *(uint2*)&sm->vt[row][seg * 16 + 4] = make_uint2(r.v0.z, r.v0.w);
    *(uint2*)&sm->vt[row][seg * 16 + 8] = make_uint2(r.v1.x, r.v1.y);
    *(uint2*)&sm->vt[row][seg * 16 + 12] = make_uint2(r.v1.z, r.v1.w);
  }
}
DEV void qk_tile(const unsigned short (*ksm)[72], const bf16x8 (&qf)[4], f32x16 (&s)[2], int lane) {
  const int r = lane & 31, hh = lane >> 5;
#pragma unroll
  for (int ks2 = 0; ks2 < 2; ++ks2) {
#pragma unroll
    for (int i = 0; i < 16; ++i) s[ks2][i] = 0.f;
#pragma unroll
    for (int ks = 0; ks < 4; ++ks) {
      const bf16x8 a = *(const bf16x8*)&ksm[ks2 * 32 + r][ks * 16 + hh * 8];
      s[ks2] = __builtin_amdgcn_mfma_f32_32x32x16_bf16(a, qf[ks], s[ks2], 0, 0, 0);
    }
  }
}
DEV void pv_tile(const unsigned short (*vsm)[68], const f32x16 (&pr)[2], f32x16 (&o)[2], int lane) {
  const int r = lane & 31, hh = lane >> 5;
#pragma unroll
  for (int ks2 = 0; ks2 < 2; ++ks2)
#pragma unroll
    for (int s = 0; s < 2; ++s) {
      union { uint4 u; bf16x8 v; } pfu;
      pfu.u = make_uint4(pk2(pr[ks2][8 * s], pr[ks2][8 * s + 1]), pk2(pr[ks2][8 * s + 2], pr[ks2][8 * s + 3]),
                         pk2(pr[ks2][8 * s + 4], pr[ks2][8 * s + 5]), pk2(pr[ks2][8 * s + 6], pr[ks2][8 * s + 7]));
      const bf16x8 pf = pfu.v;
#pragma unroll
      for (int mt = 0; mt < 2; ++mt) {
        const uint2 lo = *(const uint2*)&vsm[mt * 32 + r][ks2 * 32 + 16 * s + 4 * hh];
        const uint2 hi = *(const uint2*)&vsm[mt * 32 + r][ks2 * 32 + 16 * s + 8 + 4 * hh];
        union { uint4 u; bf16x8 v; } au;
        au.u = make_uint4(lo.x, lo.y, hi.x, hi.y);
        const bf16x8 a = au.v;
        o[mt] = __builtin_amdgcn_mfma_f32_32x32x16_bf16(a, pf, o[mt], 0, 0, 0);
      }
    }
}
DEV float quad_sum(float v) {
#ifdef CPU_EMU
  v += __shfl_xor(v, 1); v += __shfl_xor(v, 2); return v;
#else
  int x;
  x = __builtin_amdgcn_update_dpp(0, __builtin_bit_cast(int, v), 0xB1, 0xF, 0xF, false); v += __builtin_bit_cast(float, x);
  x = __builtin_amdgcn_update_dpp(0, __builtin_bit_cast(int, v), 0x4E, 0xF, 0xF, false); v += __builtin_bit_cast(float, x);
  return v;
#endif
}
DEV void softmax_step(f32x16 (&s)[2], float& m, float& l, f32x16 (&o)[2]) {
  float tmax = -INFINITY;
#pragma unroll
  for (int ks2 = 0; ks2 < 2; ++ks2)
#pragma unroll
    for (int i = 0; i < 16; ++i) tmax = fmaxf(tmax, s[ks2][i]);
  tmax = fmaxf(tmax, __shfl_xor(tmax, 32));
  const float mnew = fmaxf(m, tmax);
  const float msafe = mnew == -INFINITY ? 0.f : mnew;
  const float alpha = fexp2(m - msafe);
  float ps = 0.f;
#pragma unroll
  for (int ks2 = 0; ks2 < 2; ++ks2)
#pragma unroll
    for (int i = 0; i < 16; ++i) { s[ks2][i] = fexp2(s[ks2][i] - msafe); ps += s[ks2][i]; }
  l = l * alpha + ps;
#pragma unroll
  for (int mt = 0; mt < 2; ++mt)
#pragma unroll
    for (int i = 0; i < 16; ++i) o[mt][i] *= alpha;
  m = mnew;
}
DEV bool testbit4(unsigned w0, unsigned w1, unsigned w2, unsigned w3, int j) {
  const unsigned lo = j & 32 ? w1 : w0, hi = j & 32 ? w3 : w2;
  const unsigned x = j & 64 ? hi : lo;
  return (x >> (j & 31)) & 1u;
}

DEV void p2_nsa(const Params& p, int item, char* smem) {
  NsaSmem* sm = (NsaSmem*)smem;
  const int tid = threadIdx.x, lane = tid & 63, wave = tid >> 6;
  const int bg = item & 3, b = bg >> 1, g = bg & 1;
  const int qt = NSA_QT - 1 - (item >> 2);
  const int t0 = qt * 32;
  const int c = lane & 31, hh = lane >> 5, tl = c >> 2, h = c & 3;
  const int trow = wave * 8 + tl;
  const int tq = t0 + trow;
  const size_t tok = (size_t)b * SEQ_LEN + tq;
  const int hd = g * 4 + h;
  const float* H = (const float*)(p.ws + OFF_H);
  const unsigned short* QB = (const unsigned short*)(p.ws + OFF_QB);
  const unsigned short* KSB = (const unsigned short*)(p.ws + OFF_KSB) + ((size_t)b * 2 + g) * SEQ_LEN * 64;
  const unsigned short* KWB = (const unsigned short*)(p.ws + OFF_KWB) + ((size_t)b * 2 + g) * SEQ_LEN * 64;
  const unsigned short* VST = (const unsigned short*)(p.ws + OFF_VST) + ((size_t)b * 2 + g) * NBLK * 4096;
  const unsigned short* VWT = (const unsigned short*)(p.ws + OFF_VWT) + ((size_t)b * 2 + g) * NBLK * 4096;
  const unsigned short* KCB = (const unsigned short*)(p.ws + OFF_KCB) + ((size_t)b * 2 + g) * NB_CMP * 4096;
  const unsigned short* VCT = (const unsigned short*)(p.ws + OFF_VCT) + ((size_t)b * 2 + g) * NB_CMP * 4096;
  bf16x8 qf[4];
  {
    const unsigned short* qrow = QB + (tok * 8 + hd) * 64;
#pragma unroll
    for (int ks = 0; ks < 4; ++ks) qf[ks] = *(const bf16x8*)(qrow + ks * 16 + hh * 8);
  }
  const float g0 = sigmoidf_(H[tok * AB_IN + 1792 + hd * 3 + 0]);
  const float g1 = sigmoidf_(H[tok * AB_IN + 1792 + hd * 3 + 1]);
  const float g2 = sigmoidf_(H[tok * AB_IN + 1792 + hd * 3 + 2]);
  f32x16 o[2], s[2];
#pragma unroll
  for (int mt = 0; mt < 2; ++mt)
#pragma unroll
    for (int i = 0; i < 16; ++i) o[mt][i] = 0.f;
  float* mixrow = (float*)(p.ws + OFF_MIX) + tok * 1024 + 512 + hd * 64 + 4 * hh;
  __syncthreads();
  for (int w = tid; w < 32 * 128; w += NTHREADS) (&sm->imp[0][0])[w] = 0.f;
  TileRegs tr;
  tr.k0 = tr.k1 = tr.v0 = tr.v1 = make_uint4(0, 0, 0, 0);
  const int nval = tq >= 31 ? (tq - 31) / 16 + 1 : 0;
  const int nvmax = (t0 + 31 - 31) / 16 + 1;
  const int ktn = (nvmax + 63) / 64;
  float m = -INFINITY, l = 0.f;
  tile_gload(tr, KCB, nullptr, tid);
  for (int kt = 0; kt < ktn; ++kt) {
    __syncthreads();
    tile_sstore(sm, tr, false, tid);
    __syncthreads();
    if (kt + 1 < ktn) tile_gload(tr, KCB + (size_t)(kt + 1) * 4096, nullptr, tid);
    qk_tile(sm->k, qf, s, lane);
    float tmax = -INFINITY;
#pragma unroll
    for (int ks2 = 0; ks2 < 2; ++ks2)
#pragma unroll
      for (int i = 0; i < 16; ++i) {
        const int n = kt * 64 + ks2 * 32 + (i & 3) + 8 * (i >> 2) + 4 * hh;
        s[ks2][i] = n < nval ? s[ks2][i] : -INFINITY;
        tmax = fmaxf(tmax, s[ks2][i]);
      }
    tmax = fmaxf(tmax, __shfl_xor(tmax, 32));
    const float mnew = fmaxf(m, tmax);
    const float msafe = mnew == -INFINITY ? 0.f : mnew;
    float ps = 0.f;
#pragma unroll
    for (int ks2 = 0; ks2 < 2; ++ks2)
#pragma unroll
      for (int i = 0; i < 16; ++i) ps += fexp2(s[ks2][i] - msafe);
    l = l * fexp2(m - msafe) + ps;
    m = mnew;
  }
  {
    const float ltot = l + __shfl_xor(l, 32);
    const float invl = ltot > 0.f ? 1.f / ltot : 0.f;
    const float msafe = m == -INFINITY ? 0.f : m;
    tile_gload(tr, KCB, VCT, tid);
    for (int kt = 0; kt < ktn; ++kt) {
      __syncthreads();
      tile_sstore(sm, tr, true, tid);
      __syncthreads();
      if (kt + 1 < ktn) tile_gload(tr, KCB + (size_t)(kt + 1) * 4096, VCT + (size_t)(kt + 1) * 4096, tid);
      qk_tile(sm->k, qf, s, lane);
#pragma unroll
      for (int ks2 = 0; ks2 < 2; ++ks2)
#pragma unroll
        for (int i = 0; i < 16; ++i) {
          const int n = kt * 64 + ks2 * 32 + (i & 3) + 8 * (i >> 2) + 4 * hh;
          s[ks2][i] = n < nval ? fexp2(s[ks2][i] - msafe) * invl : 0.f;
        }
#pragma unroll
      for (int ks2 = 0; ks2 < 2; ++ks2)
#pragma unroll
        for (int g4 = 0; g4 < 4; ++g4) {
          float A = 2.f * (s[ks2][4 * g4] + s[ks2][4 * g4 + 1] + s[ks2][4 * g4 + 2]) + s[ks2][4 * g4 + 3];
          float Bv = s[ks2][4 * g4 + 3];
          A = quad_sum(A); Bv = quad_sum(Bv);
          const int j = kt * 16 + ks2 * 8 + 2 * g4 + hh;
          if (h == 0 && j < NBLK) sm->imp[trow][j] += A;
          WAVE_SYNC();
          if (h == 0 && j + 1 < NBLK) sm->imp[trow][j + 1] += Bv;
          WAVE_SYNC();
        }
      pv_tile(sm->vt, s, o, lane);
    }
#pragma unroll
    for (int mt = 0; mt < 2; ++mt)
#pragma unroll
      for (int g4 = 0; g4 < 4; ++g4) {
        st4(mixrow + mt * 32 + 8 * g4, make_float4(o[mt][4 * g4] * g0, o[mt][4 * g4 + 1] * g0, o[mt][4 * g4 + 2] * g0, o[mt][4 * g4 + 3] * g0));
        o[mt][4 * g4] = 0.f; o[mt][4 * g4 + 1] = 0.f; o[mt][4 * g4 + 2] = 0.f; o[mt][4 * g4 + 3] = 0.f;
      }
  }
  WAVE_SYNC();
  for (int t8 = 0; t8 < 8; ++t8) {
    const int row = wave * 8 + t8, tt = t0 + row, cur = tt >> 6;
    float kv[2]; bool valid[2];
#pragma unroll
    for (int c2 = 0; c2 < 2; ++c2) {
      const int j = lane + 64 * c2;
      valid[c2] = j < NBLK && j <= cur;
      const bool forced = (j == 0) | (j == cur) | (j == cur - 1);
      kv[c2] = valid[c2] ? (forced ? 1e6f : sm->imp[row][j < NBLK ? j : 0]) : -1.f;
      sm->keyb[wave][j] = kv[c2];
    }
    WAVE_SYNC();
    int rank0 = 0, rank1 = 0;
    const int jlim = cur < NBLK - 1 ? cur : NBLK - 1;
    for (int jj = 0; jj <= jlim; ++jj) {
      const float ov = sm->keyb[wave][jj];
      rank0 += (ov > kv[0] || (ov == kv[0] && jj < lane)) ? 1 : 0;
      rank1 += (ov > kv[1] || (ov == kv[1] && jj < lane + 64)) ? 1 : 0;
    }
    const unsigned long long m0 = __ballot(valid[0] && rank0 < 16);
    const unsigned long long m1 = __ballot(valid[1] && rank1 < 16);
    if (lane == 0) {
      sm->selmask[row][0] = (unsigned)m0; sm->selmask[row][1] = (unsigned)(m0 >> 32);
      sm->selmask[row][2] = (unsigned)m1; sm->selmask[row][3] = (unsigned)(m1 >> 32);
    }
    WAVE_SYNC();
  }
  __syncthreads();
  if (tid < 4) {
    unsigned u = 0;
    for (int r = 0; r < 32; ++r) u |= sm->selmask[r][tid];
    sm->unionm[tid] = u;
  }
  __syncthreads();
  const unsigned um0 = sm->unionm[0], um1 = sm->unionm[1], um2 = sm->unionm[2], um3 = sm->unionm[3];
  const unsigned my0 = sm->selmask[trow][0], my1 = sm->selmask[trow][1], my2 = sm->selmask[trow][2], my3 = sm->selmask[trow][3];
  {
    const int jmax = (t0 + 31) >> 6;
    int j = 0;
    while (j <= jmax && !testbit4(um0, um1, um2, um3, j)) ++j;
    m = -INFINITY; l = 0.f;
    if (j <= jmax) tile_gload(tr, KSB + (size_t)j * 4096, VST + (size_t)j * 4096, tid);
    while (j <= jmax) {
      __syncthreads();
      tile_sstore(sm, tr, true, tid);
      __syncthreads();
      int jn = j + 1;
      while (jn <= jmax && !testbit4(um0, um1, um2, um3, jn)) ++jn;
      if (jn <= jmax) tile_gload(tr, KSB + (size_t)jn * 4096, VST + (size_t)jn * 4096, tid);
      const bool mine = testbit4(my0, my1, my2, my3, j);
      if (__ballot(mine) != 0ull) {
        qk_tile(sm->k, qf, s, lane);
#pragma unroll
        for (int ks2 = 0; ks2 < 2; ++ks2)
#pragma unroll
          for (int i = 0; i < 16; ++i) {
            const int kp = j * 64 + ks2 * 32 + (i & 3) + 8 * (i >> 2) + 4 * hh;
            s[ks2][i] = (mine && kp <= tq) ? s[ks2][i] : -INFINITY;
          }
        softmax_step(s, m, l, o);
        pv_tile(sm->vt, s, o, lane);
      }
      j = jn;
    }
    const float ltot = l + __shfl_xor(l, 32);
    const float sc = ltot > 0.f ? g1 / ltot : 0.f;
#pragma unroll
    for (int mt = 0; mt < 2; ++mt)
#pragma unroll
      for (int g4 = 0; g4 < 4; ++g4) {
        float4 a = ld4(mixrow + mt * 32 + 8 * g4);
        a.x += o[mt][4 * g4] * sc; a.y += o[mt][4 * g4 + 1] * sc; a.z += o[mt][4 * g4 + 2] * sc; a.w += o[mt][4 * g4 + 3] * sc;
        st4(mixrow + mt * 32 + 8 * g4, a);
        o[mt][4 * g4] = 0.f; o[mt][4 * g4 + 1] = 0.f; o[mt][4 * g4 + 2] = 0.f; o[mt][4 * g4 + 3] = 0.f;
      }
  }
  {
    const int jlo = t0 - 511 > 0 ? (t0 - 511) >> 6 : 0, jhi = (t0 + 31) >> 6;
    const int wq0 = t0 + wave * 8;
    m = -INFINITY; l = 0.f;
    tile_gload(tr, KWB + (size_t)jlo * 4096, VWT + (size_t)jlo * 4096, tid);
    for (int j = jlo; j <= jhi; ++j) {
      __syncthreads();
      tile_sstore(sm, tr, true, tid);
      __syncthreads();
      if (j + 1 <= jhi) tile_gload(tr, KWB + (size_t)(j + 1) * 4096, VWT + (size_t)(j + 1) * 4096, tid);
      if (j * 64 <= wq0 + 7 && j * 64 + 63 > wq0 - 512) {
        qk_tile(sm->k, qf, s, lane);
#pragma unroll
        for (int ks2 = 0; ks2 < 2; ++ks2)
#pragma unroll
          for (int i = 0; i < 16; ++i) {
            const int kp = j * 64 + ks2 * 32 + (i & 3) + 8 * (i >> 2) + 4 * hh;
            s[ks2][i] = (kp <= tq && kp > tq - 512) ? s[ks2][i] : -INFINITY;
          }
        softmax_step(s, m, l, o);
        pv_tile(sm->vt, s, o, lane);
      }
    }
    const float ltot = l + __shfl_xor(l, 32);
    const float sc = ltot > 0.f ? g2 / ltot : 0.f;
#pragma unroll
    for (int mt = 0; mt < 2; ++mt)
#pragma unroll
      for (int g4 = 0; g4 < 4; ++g4) {
        float4 a = ld4(mixrow + mt * 32 + 8 * g4);
        a.x += o[mt][4 * g4] * sc; a.y += o[mt][4 * g4 + 1] * sc; a.z += o[mt][4 * g4 + 2] * sc; a.w += o[mt][4 * g4 + 3] * sc;
        st4(mixrow + mt * 32 + 8 * g4, a);
        o[mt][4 * g4] = 0.f; o[mt][4 * g4 + 1] = 0.f; o[mt][4 * g4 + 2] = 0.f; o[mt][4 * g4 + 3] = 0.f;
      }
  }
}

#define P1_SMEM ((2 * 8 * 128 + 8 * 128) * 4)
DEV void phase_p1(const Params& p, char* smem) {
  const int total = P1_CMPG_ITEMS + 2 + P1_S5A_ITEMS + P1_PREP_ITEMS;
  for (int it = blockIdx.x; it < total; it += gridDim.x) {
    if (it < P1_CMPG_ITEMS) p1_cmpgemm(p, it, smem);
    else if (it < P1_CMPG_ITEMS + 2) p1_cmpc1(p, it - P1_CMPG_ITEMS, smem);
    else if (it < P1_CMPG_ITEMS + 2 + P1_PREP_ITEMS) p1_prep(p, it - P1_CMPG_ITEMS - 2, smem);
    else p1_s5a(p, it - P1_CMPG_ITEMS - 2 - P1_PREP_ITEMS, smem);
  }
}
DEV void phase_p1b(const Params& p, char* smem) {
  for (int it = blockIdx.x; it < P1_CMP_ITEMS; it += gridDim.x) p1_compress(p, it, smem);
}

#define P2_S5C_ITEMS (BATCH * 32 * S5_NC / 4)
#define S5C_ROW 132
#define P2_S5C_SMEM (4 * 16 * S5C_ROW * 4 + 4 * 64 * 16 * 4)
DEV void p2_s5c(const Params& p, int item, char* smem) {
  const int lane = threadIdx.x & 63, wave = threadIdx.x >> 6;
  const int idx = item * 4 + wave;
  const int g = idx & 31, c = (idx >> 5) % S5_NC, b = idx / (32 * S5_NC);
  float lb_re, lb_im, bbr[16], bbi[16];
  s5_consts(p, g, lane, lb_re, lb_im, bbr, bbi);
  float ar = lb_re, ai = lb_im;
#pragma unroll
  for (int s = 0; s < 6; ++s) { const float nr = ar * ar - ai * ai, ni = 2.f * ar * ai; ar = nr; ai = ni; }
  const float2* E = (const float2*)(p.ws + OFF_S5E);
  float sr = 0.f, si = 0.f;
  {
    int cc = 0;
    for (; cc + 8 <= c; cc += 8) {
      float2 e[8];
#pragma unroll
      for (int q = 0; q < 8; ++q) e[q] = E[((size_t)(b * S5_NC + cc + q) * 32 + g) * 64 + lane];
#pragma unroll
      for (int q = 0; q < 8; ++q) {
        const float nr = ar * sr - ai * si + e[q].x, ni = ar * si + ai * sr + e[q].y;
        sr = nr; si = ni;
      }
    }
    for (; cc < c; ++cc) {
      const float2 e = E[((size_t)(b * S5_NC + cc) * 32 + g) * 64 + lane];
      const float nr = ar * sr - ai * si + e.x, ni = ar * si + ai * sr + e.y;
      sr = nr; si = ni;
    }
  }
  __syncthreads();
  const float* H = (const float*)(p.ws + OFF_H);
  float* sS = (float*)smem + wave * 16 * S5C_ROW;
  float* su = (float*)smem + 4 * 16 * S5C_ROW + wave * 64 * 16;
  {
    const float* ur = H + (size_t)(b * SEQ_LEN + c * 64 + lane) * AB_IN + g * 16;
#pragma unroll
    for (int q = 0; q < 4; ++q) st4(su + lane * 16 + q * 4, ld4(ur + q * 4));
  }
  __syncthreads();
  const float* cre = p.in[I_S5_C_RE] + (size_t)g * 16 * 64;
  const float* cim = p.in[I_S5_C_IM] + (size_t)g * 16 * 64;
  float* YG = (float*)(p.ws + OFF_YGELU);
  for (int sc = 0; sc < 4; ++sc) {
    for (int tt = 0; tt < 16; ++tt) {
      const float* u = su + (sc * 16 + tt) * 16;
      float dr = 0.f, di = 0.f;
#pragma unroll
      for (int h4 = 0; h4 < 4; ++h4) {
        const float4 uv = ld4(u + h4 * 4);
        dr += uv.x * bbr[h4 * 4] + uv.y * bbr[h4 * 4 + 1] + uv.z * bbr[h4 * 4 + 2] + uv.w * bbr[h4 * 4 + 3];
        di += uv.x * bbi[h4 * 4] + uv.y * bbi[h4 * 4 + 1] + uv.z * bbi[h4 * 4 + 2] + uv.w * bbi[h4 * 4 + 3];
      }
      const float nr = lb_re * sr - lb_im * si + dr, ni = lb_re * si + lb_im * sr + di;
      sr = nr; si = ni;
      sS[tt * S5C_ROW + lane] = sr;
      sS[tt * S5C_ROW + 64 + lane] = si;
    }
    __syncthreads();
    {
      const int tt = lane >> 2, hq = lane & 3;
      float y[4] = {0.f, 0.f, 0.f, 0.f};
      for (int k = 0; k < 64; k += 4) {
        const float4 vr = ld4(sS + tt * S5C_ROW + k), vi = ld4(sS + tt * S5C_ROW + 64 + k);
#pragma unroll
        for (int hh = 0; hh < 4; ++hh) {
          const float4 cr = ld4(cre + (hq * 4 + hh) * 64 + k), ci = ld4(cim + (hq * 4 + hh) * 64 + k);
          y[hh] += vr.x * cr.x + vr.y * cr.y + vr.z * cr.z + vr.w * cr.w - (vi.x * ci.x + vi.y * ci.y + vi.z * ci.z + vi.w * ci.w);
        }
      }
      const size_t tok = (size_t)(b * SEQ_LEN + c * 64 + sc * 16 + tt);
      const int ch = g * 16 + hq * 4;
      const float4 uv = ld4(H + tok * AB_IN + ch);
      const float4 dv = ld4(p.in[I_S5_D] + ch);
      float4 o;
      o.x = geluf_(y[0] + dv.x * uv.x); o.y = geluf_(y[1] + dv.y * uv.y);
      o.z = geluf_(y[2] + dv.z * uv.z); o.w = geluf_(y[3] + dv.w * uv.w);
      st4(YG + tok * 512 + ch, o);
    }
    __syncthreads();
  }
}

#define P2_SMEM (P2_S5C_SMEM > P2_NSA_SMEM ? P2_S5C_SMEM : P2_NSA_SMEM)
DEV void phase_p2(const Params& p, char* smem) {
  const int G = gridDim.x;
  const int total = P2_NSA_ITEMS + P2_S5C_ITEMS;
  for (int r = 0;; ++r) {
    const int it = r * G + ((r & 1) ? (G - 1 - (int)blockIdx.x) : (int)blockIdx.x);
    if (r * G >= total) break;
    if (it >= total) continue;
    if (it < P2_NSA_ITEMS) p2_nsa(p, it, smem);
    else p2_s5c(p, it - P2_NSA_ITEMS, smem);
  }
}

DEV void phase_glu(const Params& p, char* smem) {
  const float* A = (const float*)(p.ws + OFF_YGELU);
  const float* B = p.in[I_S5_W_GLU];
  const float* bias = p.in[I_S5_B_GLU];
  float* MIX = (float*)(p.ws + OFF_MIX);
  const int NT = 4, MT = NTOK / GEMM_BM;
  const int xcd_ = blockIdx.x & 7, lb_ = blockIdx.x >> 3, nb_ = gridDim.x >> 3;
  for (int j_ = lb_; j_ < (MT / 8) * NT; j_ += nb_) {
    const int it = (xcd_ + 8 * (j_ / NT)) * NT + (j_ % NT);
    const int m0 = (it / NT) * GEMM_BM, n0 = (it % NT) * 128;
    gemm_tile<false>(
        [&](int r) { return (const void*)(A + (size_t)(m0 + r) * 512); },
        [&](int c) { return B + n0 + c; }, 512, 512,
        [&](int row, int col, float v0, float v1) {
          const size_t gm = m0 + row; const int gc = n0 + col;
          const float y0 = A[gm * 512 + gc], y1 = A[gm * 512 + gc + 32];
          MIX[gm * 1024 + gc] = y0 * sigmoidf_(v0 + bias[gc]);
          MIX[gm * 1024 + gc + 32] = y1 * sigmoidf_(v1 + bias[gc + 32]);
        },
        smem);
  }
}

template <int LAYER>
DEV void phase_outproj(const Params& p, char* smem) {
  const float* A = (const float*)(p.ws + OFF_MIX);
  const float* B = LAYER == 0 ? p.in[I_AB_W_OUT] : p.in[I_CD_W_OUT];
  const float* xin = LAYER == 0 ? p.in[I_X] : (const float*)(p.ws + OFF_X2);
  float* PRE = (float*)(p.ws + OFF_H);
  const int NT = 8, MT = NTOK / GEMM_BM;
  const int xcd_ = blockIdx.x & 7, lb_ = blockIdx.x >> 3, nb_ = gridDim.x >> 3;
  for (int j_ = lb_; j_ < (MT / 8) * NT; j_ += nb_) {
    const int it = (xcd_ + 8 * (j_ / NT)) * NT + (j_ % NT);
    const int m0 = (it / NT) * GEMM_BM, n0 = (it % NT) * 128;
    gemm_tile<false>(
        [&](int r) { return (const void*)(A + (size_t)(m0 + r) * 1024); },
        [&](int c) { return B + n0 + c; }, 1024, 1024,
        [&](int row, int col, float v0, float v1) {
          const size_t o = (size_t)(m0 + row) * 1024 + n0 + col;
          PRE[o] = ALPHA_F * xin[o] + v0;
          PRE[o + 32] = ALPHA_F * xin[o + 32] + v1;
        },
        smem);
  }
}

DEV void wave_ln(float (&v)[16], const float* gam, const float* bet, int lane) {
  float s = 0.f;
#pragma unroll
  for (int i = 0; i < 16; ++i) s += v[i];
  const float mu = wave_sum(s) * (1.f / 1024.f);
  float q = 0.f;
#pragma unroll
  for (int i = 0; i < 16; ++i) { const float d = v[i] - mu; q += d * d; }
  const float rstd = rsqrtf(wave_sum(q) * (1.f / 1024.f) + 1e-5f);
#pragma unroll
  for (int i = 0; i < 4; ++i) {
    const float4 gv = ld4(gam + lane * 4 + 256 * i), bv = ld4(bet + lane * 4 + 256 * i);
    v[i * 4 + 0] = (v[i * 4 + 0] - mu) * rstd * gv.x + bv.x;
    v[i * 4 + 1] = (v[i * 4 + 1] - mu) * rstd * gv.y + bv.y;
    v[i * 4 + 2] = (v[i * 4 + 2] - mu) * rstd * gv.z + bv.z;
    v[i * 4 + 3] = (v[i * 4 + 3] - mu) * rstd * gv.w + bv.w;
  }
}

#define P5_SMEM (4 * (4 * 1024 + 64) * 4)
template <int LAYER>
DEV void phase_ln_router(const Params& p, char* smem) {
  const int lane = threadIdx.x & 63, wave = threadIdx.x >> 6;
  const float* PRE = (const float*)(p.ws + OFF_H);
  float* X1 = (float*)(p.ws + OFF_X1);
  const float* router = p.in[I_ROUTER] + (size_t)LAYER * 1024 * 64;
  const float* bias = p.in[I_MOE_BIAS] + LAYER * 64;
  int* TOPI = (int*)(p.ws + OFF_TOPI);
  float* TOPG = (float*)(p.ws + OFF_TOPG);
  float* xs = (float*)smem + wave * (4 * 1024 + 64);
  float* ms = xs + 4 * 1024;
  unsigned short* X1B = (unsigned short*)p.out;
  for (int it = blockIdx.x; it < NTOK / 16; it += gridDim.x) {
    const size_t tokb = (size_t)it * 16 + wave * 4;
    WAVE_SYNC();
#pragma unroll 1
    for (int t = 0; t < 4; ++t) {
      const size_t tok = tokb + t;
      float v[16];
#pragma unroll
      for (int i = 0; i < 4; ++i) {
        const float4 a = ld4(PRE + tok * 1024 + lane * 4 + 256 * i);
        v[i * 4] = a.x; v[i * 4 + 1] = a.y; v[i * 4 + 2] = a.z; v[i * 4 + 3] = a.w;
      }
      wave_ln(v, p.in[I_LN1_G] + LAYER * 1024, p.in[I_LN1_B] + LAYER * 1024, lane);
#pragma unroll
      for (int i = 0; i < 4; ++i) {
        const float4 a = make_float4(v[i * 4], v[i * 4 + 1], v[i * 4 + 2], v[i * 4 + 3]);
        st4(X1 + tok * 1024 + lane * 4 + 256 * i, a);
        st4(xs + t * 1024 + lane * 4 + 256 * i, a);
        *(uint2*)(X1B + tok * 1024 + lane * 4 + 256 * i) = make_uint2(pk2(a.x, a.y), pk2(a.z, a.w));
      }
    }
    WAVE_SYNC();
    float lg[4] = {0.f, 0.f, 0.f, 0.f};
    for (int k = 0; k < 1024; k += 4) {
      const float r0 = router[(size_t)k * 64 + lane], r1 = router[(size_t)(k + 1) * 64 + lane],
                  r2 = router[(size_t)(k + 2) * 64 + lane], r3 = router[(size_t)(k + 3) * 64 + lane];
#pragma unroll
      for (int t = 0; t < 4; ++t) {
        const float4 xv = ld4(xs + t * 1024 + k);
        lg[t] += xv.x * r0 + xv.y * r1 + xv.z * r2 + xv.w * r3;
      }
    }
#pragma unroll
    for (int t = 0; t < 4; ++t) {
      const size_t tok = tokb + t;
      const float score = 1.f / (1.f + expf(-lg[t]));
      const float biased = score + bias[lane];
      float m1 = biased; int a1 = lane;
#pragma unroll
      for (int mm = 1; mm <= 4; mm <<= 1) {
        const float ov = __shfl_xor(m1, mm); const int oa = __shfl_xor(a1, mm);
        if (ov > m1 || (ov == m1 && oa < a1)) { m1 = ov; a1 = oa; }
      }
      float m2 = lane == a1 ? -INFINITY : biased;
#pragma unroll
      for (int mm = 1; mm <= 4; mm <<= 1) m2 = fmaxf(m2, __shfl_xor(m2, mm));
      const float gs = m1 + m2;
      const int mygrp = lane >> 3;
      int rank = 0;
#pragma unroll
      for (int gg = 0; gg < 8; ++gg) {
        const float og = __shfl(gs, gg * 8);
        rank += (og > gs || (og == gs && gg < mygrp)) ? 1 : 0;
      }
      const float masked = rank < 4 ? biased : -INFINITY;
      WAVE_SYNC();
      ms[lane] = masked;
      WAVE_SYNC();
      int erank = 0;
      for (int e = 0; e < 64; ++e) {
        const float ov = ms[e];
        erank += (ov > masked || (ov == masked && e < lane)) ? 1 : 0;
      }
      const bool selected = erank < 8;
      const float gsum = wave_sum(selected ? score : 0.f);
      if (selected) {
        TOPI[tok * 8 + erank] = lane;
        TOPG[tok * 8 + erank] = score / gsum * 2.5f;
      }
    }
  }
}

#define P6_SMEM GEMM_SMEM_BYTES
template <int LAYER>
DEV void phase_lists_shup(const Params& p, char* smem) {
  const int tid = threadIdx.x, lane = tid & 63, wave = tid >> 6;
  const int* TOPI = (const int*)(p.ws + OFF_TOPI);
  const float* TOPG = (const float*)(p.ws + OFF_TOPG);
  int* POSOF = (int*)(p.ws + OFF_POSOF);
  int* CNT = (int*)(p.ws + OFF_CNT);
  int* LTOK = (int*)(p.ws + OFF_LTOK);
  float* LGATE = (float*)(p.ws + OFF_LGATE);
  const unsigned short* X1B = (const unsigned short*)p.out;
  unsigned short* HS = (unsigned short*)(p.ws + OFF_HS);
  const float* W1 = p.in[I_SH_W1] + (size_t)LAYER * 1024 * 256;
  const float* W3 = p.in[I_SH_W3] + (size_t)LAYER * 1024 * 256;
  const int MT = NTOK / GEMM_BM;
  int* swave = (int*)smem;
  for (int it = blockIdx.x; it < 64; it += gridDim.x) {
    const int e = it;
    int base = 0;
    for (int t0 = 0; t0 < NTOK; t0 += NTHREADS) {
      const int tok = t0 + tid;
      int slot = -1;
#pragma unroll
      for (int s = 0; s < 8; ++s) if (TOPI[(size_t)tok * 8 + s] == e) slot = s;
      const unsigned long long bal = __ballot(slot >= 0);
      const int pre = __popcll(bal & ((1ull << lane) - 1ull));
      __syncthreads();
      if (lane == 0) swave[wave] = __popcll(bal);
      __syncthreads();
      int woff = 0, tot = 0;
#pragma unroll
      for (int w = 0; w < 4; ++w) { const int c = swave[w]; if (w < wave) woff += c; tot += c; }
      if (slot >= 0) {
        const int pos = base + woff + pre;
        LTOK[(size_t)e * NTOK + pos] = tok;
        LGATE[(size_t)e * NTOK + pos] = TOPG[(size_t)tok * 8 + slot];
        POSOF[(size_t)tok * 8 + slot] = pos;
      }
      base += tot;
    }
    if (tid == 0) CNT[e] = base;
    __syncthreads();
  }
  {
    const int NT = 4;
    const int xcd_ = blockIdx.x & 7, lb_ = blockIdx.x >> 3, nb_ = gridDim.x >> 3;
    for (int j_ = lb_; j_ < (MT / 8) * NT; j_ += nb_) {
      const int m0 = (xcd_ + 8 * (j_ / NT)) * GEMM_BM, ct = j_ % NT;
      gemm_tile<true>(
          [&](int r) { return (const void*)(X1B + (size_t)(m0 + r) * 1024); },
          [&](int c) { return (((c >> 5) & 1) ? W3 : W1) + ct * 64 + (c >> 6) * 32 + (c & 31); }, 256, 1024,
          [&](int row, int col, float v0, float v1) {
            const int lc = ct * 64 + (col >> 6) * 32 + (col & 31);
            HS[(size_t)(m0 + row) * 256 + lc] = f2bf(siluf_(v0) * v1);
          },
          smem);
    }
  }
}

struct ExpMap { int tstart[65]; int rbase[65]; int ltile[9]; };
DEV void build_expmap(const Params& p, ExpMap* em) {
  __syncthreads();
  if (threadIdx.x == 0) {
    const int* CNT = (const int*)(p.ws + OFF_CNT);
    int ts = 0, rb = 0;
    for (int e = 0; e < 64; ++e) {
      em->tstart[e] = ts; em->rbase[e] = rb;
      const int c = CNT[e];
      ts += (c + GEMM_BM - 1) / GEMM_BM; rb += c;
    }
    em->tstart[64] = ts; em->rbase[64] = rb;
    const int x = blockIdx.x & 7;
    int lt = 0;
    for (int k = 0; k < 8; ++k) { em->ltile[k] = lt; lt += em->tstart[x + 8 * k + 1] - em->tstart[x + 8 * k]; }
    em->ltile[8] = lt;
  }
  __syncthreads();
}
DEV void map_expert_tile(const ExpMap* em, int j, int CT, int& e, int& rt, int& ct) {
  const int jr = j / CT; ct = j % CT;
  int k = 0;
  for (int q = 1; q < 8; ++q) if (em->ltile[q] <= jr) k = q;
  e = (blockIdx.x & 7) + 8 * k; rt = jr - em->ltile[k];
}
#define P7_SMEM (GEMM_SMEM_BYTES + 1024)
template <int LAYER>
DEV void phase_routed_up(const Params& p, char* smem) {
  ExpMap* em = (ExpMap*)(smem + GEMM_SMEM_BYTES);
  build_expmap(p, em);
  const int* CNT = (const int*)(p.ws + OFF_CNT);
  const int* LTOK = (const int*)(p.ws + OFF_LTOK);
  const unsigned short* X1B = (const unsigned short*)p.out;
  unsigned short* HR = (unsigned short*)(p.ws + OFF_HR);
  const int lb_ = blockIdx.x >> 3, nb_ = gridDim.x >> 3;
  for (int j_ = lb_; j_ < em->ltile[8] * 4; j_ += nb_) {
    int e, rtl, ct;
    map_expert_tile(em, j_, 4, e, rtl, ct);
    const int r0 = rtl * GEMM_BM;
    const int cnt = CNT[e], rbase = em->rbase[e];
    const float* W1 = p.in[I_MOE_W1] + ((size_t)LAYER * 64 + e) * 1024 * 256;
    const float* W3 = p.in[I_MOE_W3] + ((size_t)LAYER * 64 + e) * 1024 * 256;
    gemm_tile<true>(
        [&](int r) { return (r0 + r < cnt) ? (const void*)(X1B + (size_t)LTOK[(size_t)e * NTOK + r0 + r] * 1024) : (const void*)nullptr; },
        [&](int c) { return (((c >> 5) & 1) ? W3 : W1) + ct * 64 + (c >> 6) * 32 + (c & 31); }, 256, 1024,
        [&](int row, int col, float v0, float v1) {
          if (r0 + row < cnt) {
            const int lc = ct * 64 + (col >> 6) * 32 + (col & 31);
            HR[(size_t)(rbase + r0 + row) * 256 + lc] = f2bf(siluf_(v0) * v1);
          }
        },
        smem);
  }
}

template <int LAYER>
DEV void phase_down(const Params& p, char* smem) {
  ExpMap* em = (ExpMap*)(smem + GEMM_SMEM_BYTES);
  build_expmap(p, em);
  const int* CNT = (const int*)(p.ws + OFF_CNT);
  const float* LGATE = (const float*)(p.ws + OFF_LGATE);
  const unsigned short* HR = (const unsigned short*)(p.ws + OFF_HR);
  const unsigned short* HS = (const unsigned short*)(p.ws + OFF_HS);
  unsigned short* Y = (unsigned short*)(p.ws + OFF_Y);
  float* FS = (float*)(p.ws + OFF_FS);
  const int xcd_ = blockIdx.x & 7, lb_ = blockIdx.x >> 3, nb_ = gridDim.x >> 3;
  for (int j_ = lb_; j_ < em->ltile[8] * 8; j_ += nb_) {
    int e, rtl, ct;
    map_expert_tile(em, j_, 8, e, rtl, ct);
    const int r0 = rtl * GEMM_BM;
    const int cnt = CNT[e], rbase = em->rbase[e];
    const float* W2 = p.in[I_MOE_W2] + ((size_t)LAYER * 64 + e) * 256 * 1024;
    const int n0 = ct * 128;
    gemm_tile<true>(
        [&](int r) { return (r0 + r < cnt) ? (const void*)(HR + (size_t)(rbase + r0 + r) * 256) : (const void*)nullptr; },
        [&](int c) { return W2 + n0 + c; }, 1024, 256,
        [&](int row, int col, float v0, float v1) {
          if (r0 + row < cnt) {
            const float gt = LGATE[(size_t)e * NTOK + r0 + row];
            const size_t o = (size_t)(rbase + r0 + row) * 1024 + n0 + col;
            Y[o] = f2bf(v0 * gt); Y[o + 32] = f2bf(v1 * gt);
          }
        },
        smem);
  }
  {
    const int MT = NTOK / GEMM_BM, NT = 8;
    const float* W2 = p.in[I_SH_W2] + (size_t)LAYER * 256 * 1024;
    for (int j_ = lb_; j_ < (MT / 8) * NT; j_ += nb_) {
      const int m0 = (xcd_ + 8 * (j_ / NT)) * GEMM_BM, n0 = (j_ % NT) * 128;
      gemm_tile<true>(
          [&](int r) { return (const void*)(HS + (size_t)(m0 + r) * 256); },
          [&](int c) { return W2 + n0 + c; }, 1024, 256,
          [&](int row, int col, float v0, float v1) {
            const size_t o = (size_t)(m0 + row) * 1024 + n0 + col;
            FS[o] = v0; FS[o + 32] = v1;
          },
          smem);
    }
  }
}

template <int LAYER>
DEV void phase_combine(const Params& p, char* smem) {
  ExpMap* em = (ExpMap*)smem;
  build_expmap(p, em);
  const int lane = threadIdx.x & 63, wave = threadIdx.x >> 6;
  const float* X1 = (const float*)(p.ws + OFF_X1);
  const float* FS = (const float*)(p.ws + OFF_FS);
  const unsigned short* Y = (const unsigned short*)(p.ws + OFF_Y);
  const int* TOPI = (const int*)(p.ws + OFF_TOPI);
  const int* POSOF = (const int*)(p.ws + OFF_POSOF);
  float* OUT = LAYER == 0 ? (float*)(p.ws + OFF_X2) : p.out;
  for (int it = blockIdx.x; it < NTOK / 4; it += gridDim.x) {
    const size_t tok = (size_t)it * 4 + wave;
    float v[16];
#pragma unroll
    for (int i = 0; i < 4; ++i) {
      const float4 a = ld4(X1 + tok * 1024 + lane * 4 + 256 * i), f = ld4(FS + tok * 1024 + lane * 4 + 256 * i);
      v[i * 4] = ALPHA_F * a.x + f.x; v[i * 4 + 1] = ALPHA_F * a.y + f.y; v[i * 4 + 2] = ALPHA_F * a.z + f.z; v[i * 4 + 3] = ALPHA_F * a.w + f.w;
    }
    for (int s = 0; s < 8; ++s) {
      const int e = TOPI[tok * 8 + s];
      const size_t row = (size_t)em->rbase[e] + POSOF[tok * 8 + s];
#pragma unroll
      for (int i = 0; i < 4; ++i) {
        const uint2 y = *(const uint2*)(Y + row * 1024 + lane * 4 + 256 * i);
        v[i * 4] += bf2f((unsigned short)(y.x & 0xFFFF)); v[i * 4 + 1] += bf2f((unsigned short)(y.x >> 16));
        v[i * 4 + 2] += bf2f((unsigned short)(y.y & 0xFFFF)); v[i * 4 + 3] += bf2f((unsigned short)(y.y >> 16));
      }
    }
    wave_ln(v, p.in[I_LN2_G] + LAYER * 1024, p.in[I_LN2_B] + LAYER * 1024, lane);
#pragma unroll
    for (int i = 0; i < 4; ++i) st4(OUT + tok * 1024 + lane * 4 + 256 * i, make_float4(v[i * 4], v[i * 4 + 1], v[i * 4 + 2], v[i * 4 + 3]));
    if (LAYER == 0) {
      unsigned short* X2B = (unsigned short*)(p.ws + OFF_X2B);
#pragma unroll
      for (int i = 0; i < 4; ++i) *(uint2*)(X2B + tok * 1024 + lane * 4 + 256 * i) = make_uint2(pk2(v[i * 4], v[i * 4 + 1]), pk2(v[i * 4 + 2], v[i * 4 + 3]));
    }
  }
}

DEV float shifted(const float* Hc, size_t tok, int col, const float* mu) {
  const float cur = Hc[tok * CD_IN + col];
  const float prev = (tok % SEQ_LEN) == 0 ? 0.f : Hc[(tok - 1) * CD_IN + col];
  return cur + (prev - cur) * mu[col];
}

#define P11_PREP_ITEMS (NTOK / 8)
#define P11_KV_ITEMS (BATCH * 4 * RET_NC)
#define P11_SMEM (8 * 128 * 4)
DEV void p11_prep(const Params& p, int item, char* smem) {
  const int tid = threadIdx.x;
  const float* Hc = (const float*)(p.ws + OFF_H);
  const float* mu = p.in[I_RW_MU];
  float* sl = (float*)smem;
  __syncthreads();
  for (int w = tid; w < 8 * 128; w += NTHREADS) {
    const int tt = w >> 7, j = w & 127;
    const size_t tok = (size_t)item * 8 + tt;
    const float v = shifted(Hc, tok, 1536 + j, mu);
    sl[w] = j < 64 ? tanhf(v) : v;
  }
  __syncthreads();
  float* RWW = (float*)(p.ws + OFF_RWW); float* RWK = (float*)(p.ws + OFF_RWK);
  float* RWKK = (float*)(p.ws + OFF_RWKK); float* RWA = (float*)(p.ws + OFF_RWA);
  float* RWR = p.out + (size_t)NTOK * 512; float* RWV = p.out;
  const float* w_up = p.in[I_RW_W_UP]; const float* a_up = p.in[I_RW_A_UP];
#pragma unroll
  for (int cc = 0; cc < 2; ++cc) {
    const int c = tid + 256 * cc;
    float aw[8], aa[8];
#pragma unroll
    for (int tt = 0; tt < 8; ++tt) { aw[tt] = 0.f; aa[tt] = 0.f; }
    for (int j0 = 0; j0 < 64; j0 += 16) {
      float wu[16], au[16];
#pragma unroll
      for (int q = 0; q < 16; ++q) { wu[q] = w_up[(j0 + q) * 512 + c]; au[q] = a_up[(j0 + q) * 512 + c]; }
#pragma unroll
      for (int q4 = 0; q4 < 4; ++q4) {
#pragma unroll
        for (int tt = 0; tt < 8; ++tt) {
          const float4 sw = ld4(sl + tt * 128 + j0 + q4 * 4), sa = ld4(sl + tt * 128 + 64 + j0 + q4 * 4);
          aw[tt] += sw.x * wu[q4 * 4] + sw.y * wu[q4 * 4 + 1] + sw.z * wu[q4 * 4 + 2] + sw.w * wu[q4 * 4 + 3];
          aa[tt] += sa.x * au[q4 * 4] + sa.y * au[q4 * 4 + 1] + sa.z * au[q4 * 4 + 2] + sa.w * au[q4 * 4 + 3];
        }
      }
    }
    const float w0 = p.in[I_RW_W0][c], a0 = p.in[I_RW_A0][c], kkc = p.in[I_RW_K_K][c], kac = p.in[I_RW_K_A][c];
#pragma unroll
    for (int tt = 0; tt < 8; ++tt) {
      const size_t tok = (size_t)item * 8 + tt;
      const float lw = w0 + aw[tt];
      const float nl = -lw;
      const float sp = nl > 20.f ? nl : log1pf(expf(nl));
      const float wl = -sp - 0.5f;
      const float decay = expf(-expf(wl));
      const float a = 1.f / (1.f + expf(-(a0 + aa[tt])));
      const float rs = shifted(Hc, tok, c, mu);
      const float ks = shifted(Hc, tok, 512 + c, mu);
      const float vs = shifted(Hc, tok, 1024 + c, mu);
      float kk = ks * kkc;
      const float nrm = sqrtf(wave_sum(kk * kk));
      kk = kk / fmaxf(nrm, 1e-12f);
      RWW[tok * 512 + c] = decay;
      RWK[tok * 512 + c] = ks * (1.f + (a - 1.f) * kac);
      RWKK[tok * 512 + c] = kk;
      RWA[tok * 512 + c] = kk * a;
      RWR[tok * 512 + c] = rs;
      RWV[tok * 512 + c] = vs;
    }
  }
}
DEV float ret_log2gamma(int h) { return log2f(1.f - exp2f(-5.f - (float)h)); }
struct KvSmem { unsigned short vt[128][72]; unsigned short kt[64][72]; };
#define P11_KV_SMEM ((int)sizeof(KvSmem))
DEV void p11_kv(const Params& p, int item, char* smem) {
  KvSmem* sm = (KvSmem*)smem;
  const int c = item % RET_NC, h = (item / RET_NC) & 3, b = item / (RET_NC * 4);
  const int tid = threadIdx.x, lane = tid & 63, wave = tid >> 6;
  const int r = lane & 31, hh = lane >> 5;
  const float* Hc = (const float*)(p.ws + OFF_H);
  const float lg = ret_log2gamma(h);
  const size_t tok0 = (size_t)b * SEQ_LEN + c * 128;
  f32x16 acc[2];
#pragma unroll
  for (int nt = 0; nt < 2; ++nt)
#pragma unroll
    for (int i = 0; i < 16; ++i) acc[nt][i] = 0.f;
#pragma unroll 1
  for (int kt = 0; kt < 2; ++kt) {
    __syncthreads();
#pragma unroll
    for (int q = 0; q < 8; ++q) {
      const int f = tid + 256 * q;
      const int key = f >> 5, d4 = (f & 31) * 4;
      const float dec = exp2f((float)(127 - (kt * 64 + key)) * lg);
      const float4 v = ld4(Hc + (tok0 + kt * 64 + key) * CD_IN + 2304 + h * 128 + d4);
      sm->vt[d4][key] = f2bf(v.x * dec); sm->vt[d4 + 1][key] = f2bf(v.y * dec);
      sm->vt[d4 + 2][key] = f2bf(v.z * dec); sm->vt[d4 + 3][key] = f2bf(v.w * dec);
    }
#pragma unroll
    for (int q = 0; q < 4; ++q) {
      const int f = tid + 256 * q;
      const int key = f >> 4, d4 = (f & 15) * 4;
      const float4 v = ld4(Hc + (tok0 + kt * 64 + key) * CD_IN + 2048 + h * 64 + d4);
      sm->kt[d4][key] = f2bf(v.x); sm->kt[d4 + 1][key] = f2bf(v.y); sm->kt[d4 + 2][key] = f2bf(v.z); sm->kt[d4 + 3][key] = f2bf(v.w);
    }
    __syncthreads();
#pragma unroll
    for (int ks = 0; ks < 4; ++ks) {
      const bf16x8 a = *(const bf16x8*)&sm->vt[wave * 32 + r][ks * 16 + hh * 8];
#pragma unroll
      for (int nt = 0; nt < 2; ++nt) {
        const bf16x8 bb = *(const bf16x8*)&sm->kt[nt * 32 + r][ks * 16 + hh * 8];
        acc[nt] = __builtin_amdgcn_mfma_f32_32x32x16_bf16(a, bb, acc[nt], 0, 0, 0);
      }
    }
  }
  float* KV = (float*)(p.ws + OFF_RETKV) + (size_t)item * 64 * 128;
#pragma unroll
  for (int nt = 0; nt < 2; ++nt)
#pragma unroll
    for (int g4 = 0; g4 < 4; ++g4)
      st4(KV + (nt * 32 + r) * 128 + wave * 32 + 8 * g4 + 4 * hh,
          make_float4(acc[nt][4 * g4], acc[nt][4 * g4 + 1], acc[nt][4 * g4 + 2], acc[nt][4 * g4 + 3]));
}
DEV void phase_p11(const Params& p, char* smem) {
  const int total = P11_PREP_ITEMS + P11_KV_ITEMS;
  for (int it = blockIdx.x; it < total; it += gridDim.x) {
    if (it < P11_KV_ITEMS) p11_kv(p, it, smem);
    else p11_prep(p, it - P11_KV_ITEMS, smem);
  }
}

#define P12_SCAN_ITEMS (BATCH * 8 * 4)
#define P12_RET_ITEMS (BATCH * 4 * RET_NC)
#define P12_SCAN_SMEM ((2 * (16 * 5 * 64 + 16 * 16) + 16 * 16) * 4)
#define P12_RET_SMEM ((64 * 72 + 2 * 64 * 68) * 2)
#define P12_SMEM (P12_SCAN_SMEM > P12_RET_SMEM ? P12_SCAN_SMEM : P12_RET_SMEM)
DEV float sum16(float v) {
#ifdef CPU_EMU
  return emu_sum16(v);
#else
  int x;
  x = __builtin_amdgcn_update_dpp(0, __builtin_bit_cast(int, v), 0xB1, 0xF, 0xF, false); v += __builtin_bit_cast(float, x);
  x = __builtin_amdgcn_update_dpp(0, __builtin_bit_cast(int, v), 0x4E, 0xF, 0xF, false); v += __builtin_bit_cast(float, x);
  x = __builtin_amdgcn_update_dpp(0, __builtin_bit_cast(int, v), 0x141, 0xF, 0xF, false); v += __builtin_bit_cast(float, x);
  x = __builtin_amdgcn_update_dpp(0, __builtin_bit_cast(int, v), 0x140, 0xF, 0xF, false); v += __builtin_bit_cast(float, x);
  return v;
#endif
}
DEV void p12_scan(const Params& p, int item, char* smem) {
  const int rq = item & 3, h = (item >> 2) & 7, b = item >> 5;
  const int tid = threadIdx.x, rl = tid >> 4, cg = tid & 15;
  const float* ARR[5] = {(const float*)(p.ws + OFF_RWW), (const float*)(p.ws + OFF_RWK), (const float*)(p.ws + OFF_RWKK),
                         (const float*)(p.ws + OFF_RWA), p.out + (size_t)NTOK * 512};
  const float* RWV = p.out;
  float* Yo = (float*)(p.ws + OFF_MIX);
  float* buf = (float*)smem;
  float* vbuf = buf + 2 * 16 * 5 * 64;
  float* ybuf = vbuf + 2 * 16 * 16;
  float S[4] = {0.f, 0.f, 0.f, 0.f};
  float4 rg[5]; float rv;
  const int lstep = tid >> 4, lc4 = tid & 15;
  auto gload = [&](int c) {
    const size_t o = ((size_t)b * SEQ_LEN + c * 16 + lstep) * 512 + h * 64;
#pragma unroll
    for (int a = 0; a < 5; ++a) rg[a] = ld4(ARR[a] + o + lc4 * 4);
    rv = RWV[o + rq * 16 + lc4];
  };
  auto sstore = [&](int bi) {
#pragma unroll
    for (int a = 0; a < 5; ++a) st4(buf + ((bi * 16 + lstep) * 5 + a) * 64 + lc4 * 4, rg[a]);
    vbuf[(bi * 16 + lstep) * 16 + lc4] = rv;
  };
  __syncthreads();
  gload(0);
  sstore(0);
  __syncthreads();
  const int NCH = SEQ_LEN / 16;
  for (int c = 0; c < NCH; ++c) {
    if (c + 1 < NCH) gload(c + 1);
    const float* cb = buf + (c & 1) * 16 * 5 * 64;
    const float* cv = vbuf + (c & 1) * 16 * 16;
    float4 cw = ld4(cb + 0 * 64 + cg * 4), ck = ld4(cb + 1 * 64 + cg * 4), ckk = ld4(cb + 2 * 64 + cg * 4),
           cka = ld4(cb + 3 * 64 + cg * 4), cr = ld4(cb + 4 * 64 + cg * 4);
    float cvv = cv[rl];
#pragma unroll
    for (int s = 0; s < 16; ++s) {
      const float4 w = cw, k = ck, kk = ckk, ka = cka, r = cr;
      const float v = cvv;
      if (s < 15) {
        cw = ld4(cb + ((s + 1) * 5 + 0) * 64 + cg * 4); ck = ld4(cb + ((s + 1) * 5 + 1) * 64 + cg * 4);
        ckk = ld4(cb + ((s + 1) * 5 + 2) * 64 + cg * 4); cka = ld4(cb + ((s + 1) * 5 + 3) * 64 + cg * 4);
        cr = ld4(cb + ((s + 1) * 5 + 4) * 64 + cg * 4); cvv = cv[(s + 1) * 16 + rl];
      }
      float sa = (S[0] * kk.x + S[1] * kk.y) + (S[2] * kk.z + S[3] * kk.w);
      sa = -sum16(sa);
      S[0] = S[0] * w.x + (sa * ka.x + v * k.x);
      S[1] = S[1] * w.y + (sa * ka.y + v * k.y);
      S[2] = S[2] * w.z + (sa * ka.z + v * k.z);
      S[3] = S[3] * w.w + (sa * ka.w + v * k.w);
      float y = (S[0] * r.x + S[1] * r.y) + (S[2] * r.z + S[3] * r.w);
      y = sum16(y);
      if (cg == 0) ybuf[s * 16 + rl] = y;
      asm volatile("" ::: "memory");
    }
    __syncthreads();
    if (c + 1 < NCH) sstore((c + 1) & 1);
    Yo[((size_t)b * SEQ_LEN + c * 16 + lstep) * 1024 + h * 64 + rq * 16 + lc4] = ybuf[lstep * 16 + lc4];
    __syncthreads();
  }
}
struct RetSmem { unsigned short k[64][72]; unsigned short vt[2][64][68]; };
DEV void p12_ret(const Params& p, int item, char* smem) {
  RetSmem* sm = (RetSmem*)smem;
  const int c = item % RET_NC, h = (item / RET_NC) & 3, b = item / (RET_NC * 4);
  const int tid = threadIdx.x, lane = tid & 63, wave = tid >> 6;
  const int cidx = lane & 31, hh = lane >> 5;
  const int qi = wave * 32 + cidx;
  const float* Hc = (const float*)(p.ws + OFF_H);
  const float lg = ret_log2gamma(h);
  const size_t tok0 = (size_t)b * SEQ_LEN + c * 128;
  bf16x8 qf[4], qfs[4];
  {
    const float* qr = Hc + (tok0 + qi) * CD_IN + 1792 + h * 64;
    const float qs = exp2f((float)(qi + 1) * lg);
#pragma unroll
    for (int ks = 0; ks < 4; ++ks) {
      const float4 a0 = ld4(qr + ks * 16 + hh * 8), a1 = ld4(qr + ks * 16 + hh * 8 + 4);
      const float v[8] = {a0.x, a0.y, a0.z, a0.w, a1.x, a1.y, a1.z, a1.w};
#pragma unroll
      for (int j = 0; j < 8; ++j) { qf[ks][j] = (short)f2bf(v[j]); qfs[ks][j] = (short)f2bf(v[j] * qs); }
    }
  }
  f32x16 o[4], s[2];
#pragma unroll
  for (int mt = 0; mt < 4; ++mt)
#pragma unroll
    for (int i = 0; i < 16; ++i) o[mt][i] = 0.f;
  {
    const float G = exp2f(128.f * lg);
    const float* KV0 = (const float*)(p.ws + OFF_RETKV) + (size_t)((b * 4 + h) * RET_NC) * 64 * 128;
#pragma unroll
    for (int eh = 0; eh < 2; ++eh) {
      __syncthreads();
      for (int w = tid; w < 64 * 64; w += NTHREADS) {
        const int el = w & 63, d = w >> 6;
        const float* src = KV0 + d * 128 + eh * 64 + el;
        float st = 0.f;
        int cc = 0;
        for (; cc + 8 <= c; cc += 8) {
          float e[8];
#pragma unroll
          for (int q = 0; q < 8; ++q) e[q] = src[(size_t)(cc + q) * 64 * 128];
#pragma unroll
          for (int q = 0; q < 8; ++q) st = st * G + e[q];
        }
        for (; cc < c; ++cc) st = st * G + src[(size_t)cc * 64 * 128];
        sm->k[el][d] = f2bf(st);
      }
      __syncthreads();
      qk_tile(sm->k, qfs, s, lane);
#pragma unroll
      for (int i = 0; i < 16; ++i) { o[eh * 2][i] += s[0][i]; o[eh * 2 + 1][i] += s[1][i]; }
    }
  }
#pragma unroll 1
  for (int kt = 0; kt < 2; ++kt) {
    __syncthreads();
    {
      const int row = tid >> 2, seg = tid & 3;
      const float* kr = Hc + (tok0 + kt * 64 + row) * CD_IN + 2048 + h * 64 + seg * 16;
      const float4 a0 = ld4(kr), a1 = ld4(kr + 4), a2 = ld4(kr + 8), a3 = ld4(kr + 12);
      *(uint4*)&sm->k[row][seg * 16] = make_uint4(pk2(a0.x, a0.y), pk2(a0.z, a0.w), pk2(a1.x, a1.y), pk2(a1.z, a1.w));
      *(uint4*)&sm->k[row][seg * 16 + 8] = make_uint4(pk2(a2.x, a2.y), pk2(a2.z, a2.w), pk2(a3.x, a3.y), pk2(a3.z, a3.w));
#pragma unroll
      for (int q = 0; q < 8; ++q) {
        const int f = tid + 256 * q;
        const int key = f >> 5, d4 = (f & 31) * 4;
        const float4 v = ld4(Hc + (tok0 + kt * 64 + key) * CD_IN + 2304 + h * 128 + d4);
        unsigned short(*vt)[68] = sm->vt[d4 >> 6];
        const int dl = d4 & 63;
        vt[dl][key] = f2bf(v.x); vt[dl + 1][key] = f2bf(v.y); vt[dl + 2][key] = f2bf(v.z); vt[dl + 3][key] = f2bf(v.w);
      }
    }
    __syncthreads();
    if (kt * 64 <= wave * 32 + 31) {
      qk_tile(sm->k, qf, s, lane);
#pragma unroll
      for (int ks2 = 0; ks2 < 2; ++ks2)
#pragma unroll
        for (int i = 0; i < 16; ++i) {
          const int kj = kt * 64 + ks2 * 32 + (i & 3) + 8 * (i >> 2) + 4 * hh;
          s[ks2][i] = kj <= qi ? s[ks2][i] * exp2f((float)(qi - kj) * lg) : 0.f;
        }
      pv_tile(sm->vt[0], s, *(f32x16(*)[2])&o[0], lane);
      pv_tile(sm->vt[1], s, *(f32x16(*)[2])&o[2], lane);
    }
  }
  float s1 = 0.f;
#pragma unroll
  for (int mt = 0; mt < 4; ++mt)
#pragma unroll
    for (int i = 0; i < 16; ++i) s1 += o[mt][i];
  s1 += __shfl_xor(s1, 32);
  const float mu = s1 * (1.f / 128.f);
  float s2 = 0.f;
#pragma unroll
  for (int mt = 0; mt < 4; ++mt)
#pragma unroll
    for (int i = 0; i < 16; ++i) { const float d = o[mt][i] - mu; s2 += d * d; }
  s2 += __shfl_xor(s2, 32);
  const float rstd = rsqrtf(s2 * (1.f / 128.f) + 1e-5f);
  float* MIX = (float*)(p.ws + OFF_MIX);
  const float* gate = Hc + (tok0 + qi) * CD_IN + 2816 + h * 128;
  float* dst = MIX + (tok0 + qi) * 1024 + 512 + h * 128;
  const float* lgam = p.in[I_RET_LN_G] + h * 128;
  const float* lbet = p.in[I_RET_LN_B] + h * 128;
#pragma unroll
  for (int mt = 0; mt < 4; ++mt)
#pragma unroll
    for (int g4 = 0; g4 < 4; ++g4) {
      const int dv = mt * 32 + 8 * g4 + 4 * hh;
      const float4 gv = ld4(lgam + dv), bv = ld4(lbet + dv), gt = ld4(gate + dv);
      float4 ov;
      ov.x = siluf_(gt.x) * ((o[mt][4 * g4] - mu) * rstd * gv.x + bv.x);
      ov.y = siluf_(gt.y) * ((o[mt][4 * g4 + 1] - mu) * rstd * gv.y + bv.y);
      ov.z = siluf_(gt.z) * ((o[mt][4 * g4 + 2] - mu) * rstd * gv.z + bv.z);
      ov.w = siluf_(gt.w) * ((o[mt][4 * g4 + 3] - mu) * rstd * gv.w + bv.w);
      st4(dst + dv, ov);
    }
}
DEV void phase_p12(const Params& p, char* smem) {
  const int G = gridDim.x;
  if ((int)blockIdx.x < P12_SCAN_ITEMS && G > P12_SCAN_ITEMS) {
    p12_scan(p, blockIdx.x, smem);
  } else if (G > P12_SCAN_ITEMS) {
    for (int it = blockIdx.x - P12_SCAN_ITEMS; it < P12_RET_ITEMS; it += G - P12_SCAN_ITEMS) p12_ret(p, it, smem);
  } else {
    const int total = P12_SCAN_ITEMS + P12_RET_ITEMS;
    for (int it = blockIdx.x; it < total; it += G) {
      if (it < P12_SCAN_ITEMS) p12_scan(p, it, smem);
      else p12_ret(p, it - P12_SCAN_ITEMS, smem);
    }
  }
}

#define P13_SMEM (8 * 128 * 4)
DEV void phase_p13(const Params& p, char* smem) {
  const int tid = threadIdx.x;
  const float* Hc = (const float*)(p.ws + OFF_H);
  const float* mu = p.in[I_RW_MU];
  float* sl = (float*)smem;
  float* MIX = (float*)(p.ws + OFF_MIX);
  const float* RWK = (const float*)(p.ws + OFF_RWK); const float* RWR = p.out + (size_t)NTOK * 512; const float* RWV = p.out;
  const float* g_up = p.in[I_RW_G_UP];
  for (int it = blockIdx.x; it < NTOK / 8; it += gridDim.x) {
    __syncthreads();
    for (int w = tid; w < 8 * 128; w += NTHREADS) {
      const size_t tok = (size_t)it * 8 + (w >> 7);
      sl[w] = sigmoidf_(shifted(Hc, tok, 1664 + (w & 127), mu));
    }
    __syncthreads();
#pragma unroll
    for (int cc = 0; cc < 2; ++cc) {
      const int c = tid + 256 * cc;
      float ag[8];
#pragma unroll
      for (int tt = 0; tt < 8; ++tt) ag[tt] = 0.f;
      for (int j0 = 0; j0 < 128; j0 += 16) {
        float gu[16];
#pragma unroll
        for (int q = 0; q < 16; ++q) gu[q] = g_up[(j0 + q) * 512 + c];
#pragma unroll
        for (int q4 = 0; q4 < 4; ++q4) {
#pragma unroll
          for (int tt = 0; tt < 8; ++tt) {
            const float4 sg = ld4(sl + tt * 128 + j0 + q4 * 4);
            ag[tt] += sg.x * gu[q4 * 4] + sg.y * gu[q4 * 4 + 1] + sg.z * gu[q4 * 4 + 2] + sg.w * gu[q4 * 4 + 3];
          }
        }
      }
      const float lng = p.in[I_RW_LN_G][c], lnb = p.in[I_RW_LN_B][c], rk = p.in[I_RW_R_K][c];
#pragma unroll
      for (int tt = 0; tt < 8; ++tt) {
        const size_t tok = (size_t)it * 8 + tt;
        const float y = MIX[tok * 1024 + c];
        const float m = wave_sum(y) * (1.f / 64.f);
        const float d = y - m;
        const float var = wave_sum(d * d) * (1.f / 64.f);
        const float yn = d * rsqrtf(var + 64e-5f) * lng + lnb;
        const float r = RWR[tok * 512 + c], k = RWK[tok * 512 + c], v = RWV[tok * 512 + c];
        const float bonus = wave_sum(r * k * rk) * v;
        MIX[tok * 1024 + c] = (yn + bonus) * ag[tt];
      }
    }
  }
}

#define NPHASES 20
#define SMEM_BYTES 67584
DEV void run_phase(const Params& p, int ph, char* smem) {
  switch (ph) {
    case 0: phase_gemm_in<0>(p, smem); break;
    case 1: phase_p1(p, smem); break;
    case 2: phase_p2(p, smem); break;
    case 3: phase_glu(p, smem); break;
    case 4: phase_outproj<0>(p, smem); break;
    case 5: phase_ln_router<0>(p, smem); break;
    case 6: phase_lists_shup<0>(p, smem); break;
    case 7: phase_routed_up<0>(p, smem); break;
    case 8: phase_down<0>(p, smem); break;
    case 9: phase_combine<0>(p, smem); break;
    case 10: phase_gemm_in<1>(p, smem); break;
    case 11: phase_p11(p, smem); break;
    case 12: phase_p12(p, smem); break;
    case 13: phase_p13(p, smem); break;
    case 14: phase_outproj<1>(p, smem); break;
    case 15: phase_ln_router<1>(p, smem); break;
    case 16: phase_lists_shup<1>(p, smem); break;
    case 17: phase_routed_up<1>(p, smem); break;
    case 18: phase_down<1>(p, smem); break;
    case 19: phase_combine<1>(p, smem); break;
    case 20: phase_p1b(p, smem); break;
  }
}
static_assert(P1_SMEM <= SMEM_BYTES, "smem");
static_assert(P1_PREP_SMEM <= SMEM_BYTES, "smem");
static_assert(P2_SMEM <= SMEM_BYTES, "smem");
static_assert(P5_SMEM <= SMEM_BYTES, "smem");
static_assert(P7_SMEM <= SMEM_BYTES, "smem");
static_assert(P12_SMEM <= SMEM_BYTES, "smem");
static_assert(OFF_HS + (size_t)NTOK * 256 * 2 <= OFF_X1, "layout");

#ifndef CPU_EMU
template <int PH>
__global__ void __launch_bounds__(NTHREADS) phase_kernel(Params p) {
  __shared__ __attribute__((aligned(16))) char smem[SMEM_BYTES];
  run_phase(p, PH, smem);
}
template <int PH>
static void launch_phases(const Params& p, hipStream_t stream) {
  phase_kernel<PH><<<dim3(1024), dim3(NTHREADS), 0, stream>>>(p);
  if constexpr (PH + 1 < NPHASES) launch_phases<PH + 1>(p, stream);
}
#if MEGA
DEV void grid_barrier(unsigned* bar, unsigned& epoch) {
  asm volatile("s_waitcnt vmcnt(0)" ::: "memory");
  __syncthreads();
  epoch += 1u;
  if (threadIdx.x == 0) {
    __builtin_amdgcn_fence(__ATOMIC_RELEASE, "agent");
    asm volatile("s_waitcnt vmcnt(0)" ::: "memory");
    __hip_atomic_fetch_add(bar, 1u, __ATOMIC_RELAXED, __HIP_MEMORY_SCOPE_AGENT);
    const unsigned target = epoch * gridDim.x;
    while (__hip_atomic_load(bar, __ATOMIC_RELAXED, __HIP_MEMORY_SCOPE_AGENT) < target) __builtin_amdgcn_s_sleep(1);
    __builtin_amdgcn_fence(__ATOMIC_ACQUIRE, "agent");
    asm volatile("s_waitcnt vmcnt(0)" ::: "memory");
  }
  __syncthreads();
}
__global__ void __launch_bounds__(NTHREADS) mega_kernel(Params p) {
  __shared__ __attribute__((aligned(16))) char smem[SMEM_BYTES];
  unsigned* bar = (unsigned*)(p.ws + OFF_BAR);
  unsigned epoch = 0u;
  if (p.ws == nullptr) cg::this_grid().sync();
  typedef const __attribute__((address_space(4))) Params* KParams;
#define PH_(n) { KParams kp = (KParams)__builtin_amdgcn_kernarg_segment_ptr(); asm volatile("" : "+s"(kp)); const Params lp = *(const Params*)kp; run_phase(lp, n, smem); } grid_barrier(bar, epoch);
  PH_(0) PH_(1) PH_(20) PH_(2) PH_(3) PH_(4) PH_(5) PH_(6) PH_(7) PH_(8) PH_(9)
  PH_(10) PH_(11) PH_(12) PH_(13) PH_(14) PH_(15) PH_(16) PH_(17) PH_(18)
  { KParams kp = (KParams)__builtin_amdgcn_kernarg_segment_ptr(); asm volatile("" : "+s"(kp)); const Params lp = *(const Params*)kp; run_phase(lp, 19, smem); }
}

#endif

extern "C" void kernel_launch(void* const* d_in, const int* in_sizes, int n_in, void* d_out, int out_size, void* d_ws, size_t ws_size,
                              hipStream_t stream) {
  Params p;
  for (int i = 0; i < N_INPUTS; ++i) p.in[i] = (const float*)d_in[i];
  p.out = (float*)d_out;
  p.ws = (char*)d_ws;
#if MEGA
  static int grid_blocks = 0;
  if (!grid_blocks) {
    int dev = 0, cus = 0, per_cu = 0;
    hipGetDevice(&dev);
    hipDeviceGetAttribute(&cus, hipDeviceAttributeMultiprocessorCount, dev);
    hipOccupancyMaxActiveBlocksPerMultiprocessor(&per_cu, mega_kernel, NTHREADS, 0);
    if (per_cu > 2) per_cu = 2;
    grid_blocks = cus * per_cu;
  }
  hipMemsetAsync((char*)d_ws + OFF_BAR, 0, 4096, stream);
  void* args[] = {&p};
  hipError_t e = hipLaunchCooperativeKernel((void*)mega_kernel, dim3(grid_blocks), dim3(NTHREADS), args, 0, stream);
  if (e != hipSuccess) fprintf(stderr, "cooperative launch failed: %s (grid %d)\n", hipGetErrorString(e), grid_blocks);
#else
  launch_phases<0>(p, stream);
#endif
}
#endif
```

```cpp
#ifdef CPU_EMU
#include "emu.h"
#else
#include <hip/hip_runtime.h>
#include <hip/hip_cooperative_groups.h>
#include <cstdio>
namespace cg = cooperative_groups;
#endif
#include <stdint.h>

#ifndef BATCH
#define BATCH 2
#endif
#ifndef SEQ_LEN
#define SEQ_LEN 8192
#endif
#ifndef MEGA
#define MEGA 1
#endif

#define DEV __device__ __forceinline__
#define NTOK (BATCH * SEQ_LEN)
#define DM 1024
#define AB_IN 1816
#define CD_IN 3328
#define NCMP ((SEQ_LEN - 32) / 16 + 1)
#define NBLK (SEQ_LEN / 64)
#define NB_CMP ((NCMP + 63) / 64)
#define S5_NC (SEQ_LEN / 64)
#define RET_NC (SEQ_LEN / 128)
#define ALPHA_F 1.4142135623730951f
#define NTHREADS 256

enum { I_X = 0, I_AB_W_IN, I_AB_W_OUT, I_S5_LAM_RE, I_S5_LAM_IM, I_S5_LOG_DT, I_S5_B_RE, I_S5_B_IM, I_S5_C_RE, I_S5_C_IM,
       I_S5_D, I_S5_W_GLU, I_S5_B_GLU, I_PE_K, I_PE_V, I_CK_W1, I_CK_B1, I_CK_W2, I_CV_W1, I_CV_B1, I_CV_W2,
       I_CD_W_IN, I_CD_W_OUT, I_RW_MU, I_RW_W0, I_RW_W_UP, I_RW_A0, I_RW_A_UP, I_RW_G_UP, I_RW_K_K, I_RW_K_A, I_RW_R_K,
       I_RW_LN_G, I_RW_LN_B, I_RET_LN_G, I_RET_LN_B, I_LN1_G, I_LN1_B, I_LN2_G, I_LN2_B, I_ROUTER, I_MOE_BIAS,
       I_MOE_W1, I_MOE_W3, I_MOE_W2, I_SH_W1, I_SH_W3, I_SH_W2, N_INPUTS };

struct Params {
  const float* in[N_INPUTS];
  float* out;
  char* ws;
};

#define MiB_TOK ((size_t)NTOK * 1024 * 4)
#define OFF_H 0
#define OFF_MIX ((size_t)NTOK * 3328 * 4)
#define OFF_X1 (OFF_MIX + MiB_TOK)
#define OFF_X2 (OFF_X1 + MiB_TOK)
#define OFF_R4 (OFF_X2 + MiB_TOK)
#define OFF_R5 (OFF_R4 + MiB_TOK)
#define OFF_Y OFF_H
#define OFF_HS (OFF_H + 4 * MiB_TOK)
#define OFF_FS OFF_X2
#define OFF_HR OFF_R4
#define OFF_X2B OFF_R4
#define OFF_TOPI (OFF_R5)
#define OFF_TOPG (OFF_TOPI + (size_t)NTOK * 8 * 4)
#define OFF_POSOF (OFF_TOPG + (size_t)NTOK * 8 * 4)
#define OFF_CNT (OFF_POSOF + (size_t)NTOK * 8 * 4)
#define OFF_LTOK (OFF_CNT + 1024)
#define OFF_LGATE (OFF_LTOK + (size_t)64 * NTOK * 4)
#define OFF_S5E (OFF_LGATE + (size_t)64 * NTOK * 4)
#define OFF_KCMP (OFF_S5E + (size_t)BATCH * S5_NC * 32 * 64 * 8)
#define OFF_VCMP (OFF_KCMP + (size_t)BATCH * NCMP * 2 * 64 * 4)
#define OFF_RETKV (OFF_VCMP + (size_t)BATCH * NCMP * 2 * 64 * 4)
#define OFF_BAR (OFF_RETKV + (size_t)BATCH * 4 * RET_NC * 64 * 128 * 4)
#define OFF_CMPHID (OFF_BAR + 4096)
#define OFF_CMPC1 (OFF_CMPHID + (size_t)2 * BATCH * 2 * NB_CMP * 64 * 128 * 4)
#define OFF_END (OFF_CMPC1 + 1024)
#define OFF_YGELU OFF_X1
#define OFF_RWW OFF_X1
#define OFF_RWK (OFF_X1 + (size_t)NTOK * 512 * 4)
#define OFF_RWKK OFF_R4
#define OFF_RWA (OFF_R4 + (size_t)NTOK * 512 * 4)

typedef short bf16x8 __attribute__((ext_vector_type(8)));
typedef float f32x16 __attribute__((ext_vector_type(16)));

#ifdef CPU_EMU
#define WAVE_SYNC() emu_wave_bar()
#else
#define WAVE_SYNC() __builtin_amdgcn_wave_barrier()
#endif

DEV float sigmoidf_(float x) { return 1.f / (1.f + __expf(-x)); }
DEV float siluf_(float x) { return x * sigmoidf_(x); }
DEV float geluf_(float x) { float u = 0.7978845608028654f * (x + 0.044715f * x * x * x); return 0.5f * x * (1.f + tanhf(u)); }
DEV unsigned short f2bf(float f) {
  unsigned u = __builtin_bit_cast(unsigned, f);
  u += 0x7FFFu + ((u >> 16) & 1u);
  return (unsigned short)(u >> 16);
}
DEV float bf2f(unsigned short h) { return __builtin_bit_cast(float, ((unsigned)h) << 16); }
DEV float wave_sum(float v) {
#pragma unroll
  for (int m = 32; m >= 1; m >>= 1) v += __shfl_xor(v, m);
  return v;
}
DEV float wave_max(float v) {
#pragma unroll
  for (int m = 32; m >= 1; m >>= 1) v = fmaxf(v, __shfl_xor(v, m));
  return v;
}
DEV float4 ld4(const float* p) { return *(const float4*)p; }
#ifdef CPU_EMU
DEV float fexp2(float x) { return exp2f(x); }
#else
DEV float fexp2(float x) { return __builtin_amdgcn_exp2f(x); }
#endif
DEV void fast_sincos(float x, float* sn, float* cs) {
  const float k = rintf(x * 0.15915494309189535f);
  float r = fmaf(-k, 6.28125f, x);
  r = fmaf(-k, 1.9353071795864769e-3f, r);
  *sn = __sinf(r); *cs = __cosf(r);
}
DEV void st4(float* p, float4 v) { *(float4*)p = v; }

#define GEMM_BM 256
#define GEMM_MI (GEMM_BM / 64)
#define GEMM_SMEM_BYTES ((GEMM_BM + 128) * 72 * 2)
#ifdef CPU_EMU
DEV unsigned pk2(float a, float b) { return (unsigned)f2bf(a) | ((unsigned)f2bf(b) << 16); }
#else
typedef __bf16 hbf16x2 __attribute__((ext_vector_type(2)));
typedef float hf32x2 __attribute__((ext_vector_type(2)));
DEV unsigned pk2(float a, float b) {
  hf32x2 f = {a, b};
  return __builtin_bit_cast(unsigned, __builtin_convertvector(f, hbf16x2));
}
#endif
template <bool ABF, class AROW, class BPTR, class EPI>
DEV void gemm_tile(AROW arow, BPTR bptr, int ldb, int K, EPI epi, char* smem_raw, int akstep = 64) {
  unsigned short(*sA)[72] = (unsigned short(*)[72])smem_raw;
  unsigned short(*sB)[72] = (unsigned short(*)[72])(smem_raw + GEMM_BM * 72 * 2);
  const int tid = threadIdx.x, lane = tid & 63, wave = tid >> 6;
  const int wm = wave >> 1, wn = wave & 1;
#if defined(CPU_EMU) && !defined(EMU_REAL_GEMM)
  for (int mi = 0; mi < GEMM_MI; ++mi)
    for (int r = 0; r < 16; ++r) {
      const int row = wm * (GEMM_BM / 2) + mi * 32 + (r & 3) + 8 * (r >> 2) + 4 * (lane >> 5);
      const int col = wn * 64 + (lane & 31);
      const void* arp = arow(row);
      float v[2] = {0.f, 0.f};
      for (int ni = 0; ni < 2; ++ni) {
        const int cc = col + ni * 32;
        const float* bq = bptr(cc & ~3);
        if (!arp || !bq) continue;
        bq += cc & 3;
        float a = 0.f;
        for (int k = 0; k < K; ++k) {
          const size_t ka = (size_t)(k >> 6) * akstep + (k & 63);
          const float av = ABF ? bf2f(((const unsigned short*)arp)[ka]) : bf2f(f2bf(((const float*)arp)[ka]));
          a += av * bf2f(f2bf(bq[(size_t)k * ldb]));
        }
        v[ni] = a;
      }
      epi(row, col, v[0], v[1]);
    }
  return;
#endif
  const float* ap[4 * GEMM_MI];
  const unsigned short* aph[2 * GEMM_MI];
  if (ABF) {
#pragma unroll
    for (int i = 0; i < 2 * GEMM_MI; ++i) aph[i] = (const unsigned short*)arow((tid >> 3) + 32 * i);
  } else {
#pragma unroll
    for (int i = 0; i < 4 * GEMM_MI; ++i) ap[i] = (const float*)arow((tid >> 4) + 16 * i);
  }
  const float* bp = bptr((tid & 31) * 4);
  const int kgrp = tid >> 5;
  float4 ra[4 * GEMM_MI];
  uint4 rah[2 * GEMM_MI];
  float4 rb[8];
  auto gload = [&](int k0) {
    if (ABF) {
#pragma unroll
      for (int i = 0; i < 2 * GEMM_MI; ++i) rah[i] = aph[i] ? *(const uint4*)(aph[i] + (size_t)(k0 >> 6) * akstep + (tid & 7) * 8) : make_uint4(0, 0, 0, 0);
    } else {
#pragma unroll
      for (int i = 0; i < 4 * GEMM_MI; ++i) ra[i] = ap[i] ? ld4(ap[i] + (size_t)(k0 >> 6) * akstep + (tid & 15) * 4) : make_float4(0.f, 0.f, 0.f, 0.f);
    }
#pragma unroll
    for (int j = 0; j < 8; ++j) rb[j] = bp ? ld4(bp + (size_t)(k0 + kgrp * 8 + j) * ldb) : make_float4(0.f, 0.f, 0.f, 0.f);
  };
  auto sstore = [&]() {
    if (ABF) {
#pragma unroll
      for (int i = 0; i < 2 * GEMM_MI; ++i) *(uint4*)&sA[(tid >> 3) + 32 * i][(tid & 7) * 8] = rah[i];
    } else {
#pragma unroll
      for (int i = 0; i < 4 * GEMM_MI; ++i) *(uint2*)&sA[(tid >> 4) + 16 * i][(tid & 15) * 4] = make_uint2(pk2(ra[i].x, ra[i].y), pk2(ra[i].z, ra[i].w));
    }
    const int nb = (tid & 31) * 4;
    *(uint4*)&sB[nb + 0][kgrp * 8] = make_uint4(pk2(rb[0].x, rb[1].x), pk2(rb[2].x, rb[3].x), pk2(rb[4].x, rb[5].x), pk2(rb[6].x, rb[7].x));
    *(uint4*)&sB[nb + 1][kgrp * 8] = make_uint4(pk2(rb[0].y, rb[1].y), pk2(rb[2].y, rb[3].y), pk2(rb[4].y, rb[5].y), pk2(rb[6].y, rb[7].y));
    *(uint4*)&sB[nb + 2][kgrp * 8] = make_uint4(pk2(rb[0].z, rb[1].z), pk2(rb[2].z, rb[3].z), pk2(rb[4].z, rb[5].z), pk2(rb[6].z, rb[7].z));
    *(uint4*)&sB[nb + 3][kgrp * 8] = make_uint4(pk2(rb[0].w, rb[1].w), pk2(rb[2].w, rb[3].w), pk2(rb[4].w, rb[5].w), pk2(rb[6].w, rb[7].w));
  };
  f32x16 acc[GEMM_MI][2];
#pragma unroll
  for (int mi = 0; mi < GEMM_MI; ++mi)
#pragma unroll
    for (int ni = 0; ni < 2; ++ni)
#pragma unroll
      for (int r = 0; r < 16; ++r) acc[mi][ni][r] = 0.f;
  gload(0);
  for (int k0 = 0; k0 < K; k0 += 64) {
    __syncthreads();
    sstore();
    __syncthreads();
    if (k0 + 64 < K) gload(k0 + 64);
#pragma unroll
    for (int ks = 0; ks < 4; ++ks) {
      bf16x8 af[GEMM_MI], bfr[2];
#pragma unroll
      for (int mi = 0; mi < GEMM_MI; ++mi) af[mi] = *(const bf16x8*)&sA[wm * (GEMM_BM / 2) + mi * 32 + (lane & 31)][ks * 16 + (lane >> 5) * 8];
#pragma unroll
      for (int ni = 0; ni < 2; ++ni) bfr[ni] = *(const bf16x8*)&sB[wn * 64 + ni * 32 + (lane & 31)][ks * 16 + (lane >> 5) * 8];
#pragma unroll
      for (int mi = 0; mi < GEMM_MI; ++mi)
#pragma unroll
        for (int ni = 0; ni < 2; ++ni) acc[mi][ni] = __builtin_amdgcn_mfma_f32_32x32x16_bf16(af[mi], bfr[ni], acc[mi][ni], 0, 0, 0);
    }
  }
#pragma unroll
  for (int mi = 0; mi < GEMM_MI; ++mi)
#pragma unroll
    for (int r = 0; r < 16; ++r) {
      int row = wm * (GEMM_BM / 2) + mi * 32 + (r & 3) + 8 * (r >> 2) + 4 * (lane >> 5);
      int col = wn * 64 + (lane & 31);
      epi(row, col, acc[mi][0][r], acc[mi][1][r]);
    }
}

template <int LAYER>
DEV void phase_gemm_in(const Params& p, char* smem) {
  const int N = LAYER == 0 ? AB_IN : CD_IN;
  const float* A = LAYER == 0 ? p.in[I_X] : (const float*)(p.ws + OFF_X2);
  const float* B = LAYER == 0 ? p.in[I_AB_W_IN] : p.in[I_CD_W_IN];
  float* C = (float*)(p.ws + OFF_H);
  const int NT = (N + 127) / 128, MT = NTOK / GEMM_BM;
  const int xcd_ = blockIdx.x & 7, lb_ = blockIdx.x >> 3, nb_ = gridDim.x >> 3;
  for (int j_ = lb_; j_ < (MT / 8) * NT; j_ += nb_) {
    const int it = (xcd_ + 8 * (j_ / NT)) * NT + (j_ % NT);
    const int tm = it / NT, tn = it % NT;
    const int m0 = tm * GEMM_BM, n0 = tn * 128;
    gemm_tile<LAYER == 1>(
        [&](int r) { return LAYER == 1 ? (const void*)((const unsigned short*)(p.ws + OFF_X2B) + (size_t)(m0 + r) * DM) : (const void*)(A + (size_t)(m0 + r) * DM); },
        [&](int c) { return (n0 + c < N) ? (B + n0 + c) : (const float*)nullptr; }, N, DM,
        [&](int row, int col, float v0, float v1) {
          const int gm = m0 + row, gc = n0 + col;
          if (LAYER == 1 && gc >= 1792 && gc < 2304) {
            const int i = gc & 63;
            const float pos = (float)(gm % SEQ_LEN);
            const float inv = __expf(-(float)i * (9.210340371976184f / 32.f));
            float sn, cs;
            fast_sincos(pos * inv, &sn, &cs);
            float o0 = v0 * cs - v1 * sn, o1 = v1 * cs + v0 * sn;
            if (gc >= 2048) { o0 *= 0.125f; o1 *= 0.125f; }
            v0 = o0; v1 = o1;
          }
          if (gc < N) C[(size_t)gm * N + gc] = v0;
          if (gc + 32 < N) C[(size_t)gm * N + gc + 32] = v1;
        },
        smem);
  }
}

struct S5Const { float lb_re, lb_im; };
DEV void s5_consts(const Params& p, int g, int pp, float& lb_re, float& lb_im, float (&bbr)[16], float (&bbi)[16]) {
  const float dt = expf(p.in[I_S5_LOG_DT][g]);
  const float lr = p.in[I_S5_LAM_RE][g * 64 + pp], li = p.in[I_S5_LAM_IM][g * 64 + pp];
  const float mag = expf(lr * dt);
  float sn, cs;
  sincosf(li * dt, &sn, &cs);
  lb_re = mag * cs; lb_im = mag * sn;
  const float den = lr * lr + li * li;
  const float f_re = ((lb_re - 1.f) * lr + lb_im * li) / den;
  const float f_im = (lb_im * lr - (lb_re - 1.f) * li) / den;
  const float* br = p.in[I_S5_B_RE] + (size_t)(g * 64 + pp) * 16;
  const float* bi = p.in[I_S5_B_IM] + (size_t)(g * 64 + pp) * 16;
#pragma unroll
  for (int h = 0; h < 16; ++h) {
    bbr[h] = f_re * br[h] - f_im * bi[h];
    bbi[h] = f_re * bi[h] + f_im * br[h];
  }
}

#define OFF_QB OFF_X2
#define OFF_KSB (OFF_QB + (size_t)NTOK * 512 * 2)
#define OFF_KWB (OFF_KSB + (size_t)NTOK * 128 * 2)
#define OFF_VST (OFF_KWB + (size_t)NTOK * 128 * 2)
#define OFF_VWT (OFF_VST + (size_t)NTOK * 128 * 2)
#define OFF_KCB (OFF_VWT + (size_t)NTOK * 128 * 2)
#define OFF_VCT (OFF_KCB + (size_t)BATCH * 2 * NB_CMP * 64 * 64 * 2)
#define NSA_QSCALE (0.125f * 1.4426950408889634f)

#define P1_S5A_ITEMS (BATCH * 32 * S5_NC / 4)
#define P1_CMP_TILES ((NCMP + 7) / 8)
#define P1_CMP_ITEMS (2 * BATCH * 2 * P1_CMP_TILES)
DEV void p1_s5a(const Params& p, int item, char* smem) {
  const int lane = threadIdx.x & 63, wave = threadIdx.x >> 6;
  const int idx = item * 4 + wave;
  const int g = idx & 31, c = (idx >> 5) % S5_NC, b = idx / (32 * S5_NC);
  float lb_re, lb_im, bbr[16], bbi[16];
  s5_consts(p, g, lane, lb_re, lb_im, bbr, bbi);
  const float* H = (const float*)(p.ws + OFF_H);
  float sr = 0.f, si = 0.f;
  float* su = (float*)smem + wave * 64 * 16;
  __syncthreads();
  {
    const float* ur = H + (size_t)(b * SEQ_LEN + c * 64 + lane) * AB_IN + g * 16;
#pragma unroll
    for (int q = 0; q < 4; ++q) st4(su + lane * 16 + q * 4, ld4(ur + q * 4));
  }
  WAVE_SYNC();
  for (int tt = 0; tt < 64; ++tt) {
    const float* u = su + tt * 16;
    float dr = 0.f, di = 0.f;
#pragma unroll
    for (int h4 = 0; h4 < 4; ++h4) {
      const float4 uv = ld4(u + h4 * 4);
      dr += uv.x * bbr[h4 * 4] + uv.y * bbr[h4 * 4 + 1] + uv.z * bbr[h4 * 4 + 2] + uv.w * bbr[h4 * 4 + 3];
      di += uv.x * bbi[h4 * 4] + uv.y * bbi[h4 * 4 + 1] + uv.z * bbi[h4 * 4 + 2] + uv.w * bbi[h4 * 4 + 3];
    }
    const float nr = lb_re * sr - lb_im * si + dr;
    const float ni = lb_re * si + lb_im * sr + di;
    sr = nr; si = ni;
  }
  float2* E = (float2*)(p.ws + OFF_S5E);
  E[((size_t)(b * S5_NC + c) * 32 + g) * 64 + lane] = make_float2(sr, si);
}
#define P1_CMPG_MT ((NCMP + GEMM_BM - 1) / GEMM_BM)
#define P1_CMPG_ITEMS (2 * BATCH * 2 * P1_CMPG_MT)
DEV void p1_cmpgemm(const Params& p, int item, char* smem) {
  const int mt = item % P1_CMPG_MT;
  int r = item / P1_CMPG_MT;
  const int g = r & 1; r >>= 1;
  const int b = r % BATCH; const int which = r / BATCH;
  const float* H = (const float*)(p.ws + OFF_H);
  const float* w1 = which ? p.in[I_CV_W1] : p.in[I_CK_W1];
  const int colbase = (which ? 1152 : 1024) + g * 64;
  float* HID = (float*)(p.ws + OFF_CMPHID) + ((size_t)(which * BATCH + b) * 2 + g) * NB_CMP * 64 * 128;
  const int n0 = mt * GEMM_BM;
  gemm_tile<false>(
      [&](int rr) { return (n0 + rr < NCMP) ? (const void*)(H + ((size_t)b * SEQ_LEN + 16 * (n0 + rr)) * AB_IN + colbase) : (const void*)nullptr; },
      [&](int c) { return w1 + c; }, 128, 2048,
      [&](int row, int col, float v0, float v1) {
        if (n0 + row < NCMP) { HID[(size_t)(n0 + row) * 128 + col] = v0; HID[(size_t)(n0 + row) * 128 + col + 32] = v1; }
      },
      smem, AB_IN);
}
DEV void p1_cmpc1(const Params& p, int which, char* smem) {
  const float* pe = which ? p.in[I_PE_V] : p.in[I_PE_K];
  const float* w1 = which ? p.in[I_CV_W1] : p.in[I_CK_W1];
  float* sPart = (float*)smem;
  const int tid = threadIdx.x, hid = tid & 127, kh = tid >> 7;
  float a = 0.f;
  for (int k = kh * 1024; k < kh * 1024 + 1024; ++k) a += pe[k] * w1[(size_t)k * 128 + hid];
  __syncthreads();
  sPart[tid] = a;
  __syncthreads();
  if (tid < 128) ((float*)(p.ws + OFF_CMPC1))[which * 128 + tid] = sPart[tid] + sPart[tid + 128];
  __syncthreads();
}
DEV void p1_compress(const Params& p, int item, char* smem) {
  const int tile = item % P1_CMP_TILES;
  int r = item / P1_CMP_TILES;
  const int g = r & 1; r >>= 1;
  const int b = r % BATCH; const int which = r / BATCH;
  const int n0 = tile * 8;
  const float* b1 = which ? p.in[I_CV_B1] : p.in[I_CK_B1];
  const float* w2 = which ? p.in[I_CV_W2] : p.in[I_CK_W2];
  const float* C1 = (const float*)(p.ws + OFF_CMPC1) + which * 128;
  const float* HID = (const float*)(p.ws + OFF_CMPHID) + ((size_t)(which * BATCH + b) * 2 + g) * NB_CMP * 64 * 128;
  float* sPart = (float*)smem;
  float* sHid = sPart + 2 * 8 * 128;
  const int tid = threadIdx.x;
  __syncthreads();
  for (int w = tid; w < 8 * 128; w += NTHREADS) {
    const int rr = w >> 7, hid = w & 127;
    const int n = n0 + rr;
    sHid[w] = n < NCMP ? geluf_(HID[(size_t)n * 128 + hid] + C1[hid] + b1[hid]) : 0.f;
  }
  __syncthreads();
  float* sOut = sPart;
  for (int w = tid; w < 8 * 64; w += NTHREADS) {
    const int rr = w >> 6, d = w & 63;
    float a = 0.f;
    for (int hid = 0; hid < 128; ++hid) a += sHid[rr * 128 + hid] * w2[hid * 64 + d];
    sOut[w] = a;
  }
  __syncthreads();
  float* dst = (float*)(p.ws + (which ? OFF_VCMP : OFF_KCMP));
  for (int w = tid; w < 8 * 64; w += NTHREADS) {
    const int rr = w >> 6, d = w & 63;
    const int n = n0 + rr;
    if (n >= NCMP) continue;
    float v = sOut[w];
    if (which == 0 && d < 16) {
      const int i = d & 7;
      const float pos = (float)(n * 16 + 31);
      const float inv = __expf(-(float)i * (13.122363377404328f / 8.f));
      float sn, cs;
      sincosf(pos * inv, &sn, &cs);
      const float x1 = sOut[rr * 64 + i], x2 = sOut[rr * 64 + i + 8];
      v = d < 8 ? x1 * cs - x2 * sn : x2 * cs + x1 * sn;
    }
    dst[((size_t)(b * NCMP + n) * 2 + g) * 64 + d] = v;
    if (which == 0) ((unsigned short*)(p.ws + OFF_KCB))[(((size_t)b * 2 + g) * NB_CMP * 64 + n) * 64 + d] = f2bf(v);
    else ((unsigned short*)(p.ws + OFF_VCT))[((((size_t)b * 2 + g) * NB_CMP + (n >> 6)) * 64 + d) * 64 + (n & 63)] = f2bf(v);
  }
  for (int w = tid; w < 8 * 64; w += NTHREADS) {
    const int rr = w >> 6, d = w & 63;
    const int n = n0 + rr;
    if (n < NCMP || n >= NB_CMP * 64) continue;
    if (which == 0) ((unsigned short*)(p.ws + OFF_KCB))[(((size_t)b * 2 + g) * NB_CMP * 64 + n) * 64 + d] = 0;
    else ((unsigned short*)(p.ws + OFF_VCT))[((((size_t)b * 2 + g) * NB_CMP + (n >> 6)) * 64 + d) * 64 + (n & 63)] = 0;
  }
}
DEV uint4 pack8(const float* v) {
  uint4 r;
  r.x = (unsigned)f2bf(v[0]) | ((unsigned)f2bf(v[1]) << 16);
  r.y = (unsigned)f2bf(v[2]) | ((unsigned)f2bf(v[3]) << 16);
  r.z = (unsigned)f2bf(v[4]) | ((unsigned)f2bf(v[5]) << 16);
  r.w = (unsigned)f2bf(v[6]) | ((unsigned)f2bf(v[7]) << 16);
  return r;
}
#define P1_PREP_ITEMS (NTOK / 64)
#define P1_PREP_SMEM ((64 * 8 * 2 + 64 * 128) * 4)
DEV void p1_prep(const Params& p, int item, char* smem) {
  const int tid = threadIdx.x;
  const int b = item / NBLK, blk = item % NBLK;
  const float* H = (const float*)(p.ws + OFF_H);
  float* sCS = (float*)smem;
  float* sV = sCS + 64 * 8 * 2;
  const size_t tok0 = (size_t)b * SEQ_LEN + blk * 64;
  __syncthreads();
  for (int w = tid; w < 64 * 8; w += NTHREADS) {
    const int tk = w >> 3, i = w & 7;
    const float pos = (float)(blk * 64 + tk);
    const float inv = __expf(-(float)i * (13.122363377404328f / 8.f));
    float sn, cs;
    sincosf(pos * inv, &sn, &cs);
    sCS[w * 2] = cs; sCS[w * 2 + 1] = sn;
  }
  __syncthreads();
  unsigned short* QB = (unsigned short*)(p.ws + OFF_QB);
  unsigned short* KSB = (unsigned short*)(p.ws + OFF_KSB);
  unsigned short* KWB = (unsigned short*)(p.ws + OFF_KWB);
  for (int w = tid; w < 64 * 12 * 8; w += NTHREADS) {
    const int o = w & 7, hd = (w >> 3) % 12, tk = w / 96;
    const int col = hd < 8 ? 512 + hd * 64 : (hd < 10 ? 1280 + (hd - 8) * 64 : 1536 + (hd - 10) * 64);
    const float* x = H + (tok0 + tk) * AB_IN + col;
    float v[8];
    const float4 a0 = ld4(x + o * 8), a1 = ld4(x + o * 8 + 4);
    v[0] = a0.x; v[1] = a0.y; v[2] = a0.z; v[3] = a0.w; v[4] = a1.x; v[5] = a1.y; v[6] = a1.z; v[7] = a1.w;
    if (o < 2) {
      const float4 c0 = ld4(x + (1 - o) * 8), c1 = ld4(x + (1 - o) * 8 + 4);
      const float u[8] = {c0.x, c0.y, c0.z, c0.w, c1.x, c1.y, c1.z, c1.w};
#pragma unroll
      for (int i = 0; i < 8; ++i) {
        const float cs = sCS[(tk * 8 + i) * 2], sn = sCS[(tk * 8 + i) * 2 + 1];
        v[i] = o == 0 ? v[i] * cs - u[i] * sn : v[i] * cs + u[i] * sn;
      }
    }
    if (hd < 8) {
#pragma unroll
      for (int i = 0; i < 8; ++i) v[i] *= NSA_QSCALE;
      *(uint4*)(QB + ((tok0 + tk) * 8 + hd) * 64 + o * 8) = pack8(v);
    } else {
      const int g = (hd - 8) & 1;
      unsigned short* dst = (hd < 10 ? KSB : KWB) + (((size_t)b * 2 + g) * SEQ_LEN + blk * 64 + tk) * 64 + o * 8;
      *(uint4*)dst = pack8(v);
    }
  }
#pragma unroll 1
  for (int which = 0; which < 2; ++which) {
    const int col = which ? 1664 : 1408;
    __syncthreads();
    for (int w = tid; w < 64 * 32; w += NTHREADS) {
      const int tk = w >> 5, c4 = (w & 31) * 4;
      st4(sV + tk * 128 + c4, ld4(H + (tok0 + tk) * AB_IN + col + c4));
    }
    __syncthreads();
    unsigned short* VT = (unsigned short*)(p.ws + (which ? OFF_VWT : OFF_VST));
    for (int w = tid; w < 2 * 64 * 8; w += NTHREADS) {
      const int ko = w & 7, d = (w >> 3) & 63, g = w >> 9;
      float v[8];
#pragma unroll
      for (int i = 0; i < 8; ++i) v[i] = sV[(ko * 8 + i) * 128 + g * 64 + d];
      *(uint4*)(VT + ((((size_t)b * 2 + g) * NBLK + blk) * 64 + d) * 64 + ko * 8) = pack8(v);
    }
  }
}

struct NsaSmem {
  unsigned short k[64][72];
  unsigned short vt[64][68];
  float imp[32][128];
  unsigned selmask[32][4];
  unsigned unionm[4];
  float keyb[4][128];
};
#define P2_NSA_SMEM ((int)sizeof(NsaSmem))
#define NSA_QT (SEQ_LEN / 32)
#define P2_NSA_ITEMS (BATCH * 2 * NSA_QT)

struct TileRegs { uint4 k0, k1, v0, v1; };
DEV void tile_gload(TileRegs& r, const unsigned short* Kg, const unsigned short* Vg, int tid) {
  const int row = tid >> 2, seg = tid & 3;
  r.k0 = *(const uint4*)(Kg + row * 64 + seg * 16);
  r.k1 = *(const uint4*)(Kg + row * 64 + seg * 16 + 8);
  if (Vg) {
    r.v0 = *(const uint4*)(Vg + row * 64 + seg * 16);
    r.v1 = *(const uint4*)(Vg + row * 64 + seg * 16 + 8);
  }
}
DEV void tile_sstore(NsaSmem* sm, const TileRegs& r, bool withV, int tid) {
  const int row = tid >> 2, seg = tid & 3;
  *(uint4*)&sm->k[row][seg * 16] = r.k0;
  *(uint4*)&sm->k[row][seg * 16 + 8] = r.k1;
  if (withV) {
    *(uint2*)&sm->vt[row][seg * 16] = make_uint2(r.v0.x, r.v0.y);
    *(uint2*)&sm->vt[row][seg * 16 + 4] = make_uint2(r.v0.z, r.v0.w);
    *(uint2*)&sm->vt[row][seg * 16 + 8] = make_uint2(r.v1.x, r.v1.y);
    *(uint2*)&sm->vt[row][seg * 16 + 12] = make_uint2(r.v1.z, r.v1.w);
  }
}
DEV void qk_tile(const unsigned short (*ksm)[72], const bf16x8 (&qf)[4], f32x16 (&s)[2], int lane) {
  const int r = lane & 31, hh = lane >> 5;
#pragma unroll
  for (int ks2 = 0; ks2 < 2; ++ks2) {
#pragma unroll
    for (int i = 0; i < 16; ++i) s[ks2][i] = 0.f;
#pragma unroll
    for (int ks = 0; ks < 4; ++ks) {
      const bf16x8 a = *(const bf16x8*)&ksm[ks2 * 32 + r][ks * 16 + hh * 8];
      s[ks2] = __builtin_amdgcn_mfma_f32_32x32x16_bf16(a, qf[ks], s[ks2], 0, 0, 0);
    }
  }
}
DEV void pv_tile(const unsigned short (*vsm)[68], const f32x16 (&pr)[2], f32x16 (&o)[2], int lane) {
  const int r = lane & 31, hh = lane >> 5;
#pragma unroll
  for (int ks2 = 0; ks2 < 2; ++ks2)
#pragma unroll
    for (int s = 0; s < 2; ++s) {
      union { uint4 u; bf16x8 v; } pfu;
      pfu.u = make_uint4(pk2(pr[ks2][8 * s], pr[ks2][8 * s + 1]), pk2(pr[ks2][8 * s + 2], pr[ks2][8 * s + 3]),
                         pk2(pr[ks2][8 * s + 4], pr[ks2][8 * s + 5]), pk2(pr[ks2][8 * s + 6], pr[ks2][8 * s + 7]));
      const bf16x8 pf = pfu.v;
#pragma unroll
      for (int mt = 0; mt < 2; ++mt) {
        const uint2 lo = *(const uint2*)&vsm[mt * 32 + r][ks2 * 32 + 16 * s + 4 * hh];
        const uint2 hi = *(const uint2*)&vsm[mt * 32 + r][ks2 * 32 + 16 * s + 8 + 4 * hh];
        union { uint4 u; bf16x8 v; } au;
        au.u = make_uint4(lo.x, lo.y, hi.x, hi.y);
        const bf16x8 a = au.v;
        o[mt] = __builtin_amdgcn_mfma_f32_32x32x16_bf16(a, pf, o[mt], 0, 0, 0);
      }
    }
}
DEV float quad_sum(float v) {
#ifdef CPU_EMU
  v += __shfl_xor(v, 1); v += __shfl_xor(v, 2); return v;
#else
  int x;
  x = __builtin_amdgcn_update_dpp(0, __builtin_bit_cast(int, v), 0xB1, 0xF, 0xF, false); v += __builtin_bit_cast(float, x);
  x = __builtin_amdgcn_update_dpp(0, __builtin_bit_cast(int, v), 0x4E, 0xF, 0xF, false); v += __builtin_bit_cast(float, x);
  return v;
#endif
}
DEV void softmax_step(f32x16 (&s)[2], float& m, float& l, f32x16 (&o)[2]) {
  float tmax = -INFINITY;
#pragma unroll
  for (int ks2 = 0; ks2 < 2; ++ks2)
#pragma unroll
    for (int i = 0; i < 16; ++i) tmax = fmaxf(tmax, s[ks2][i]);
  tmax = fmaxf(tmax, __shfl_xor(tmax, 32));
  const float mnew = fmaxf(m, tmax);
  const float msafe = mnew == -INFINITY ? 0.f : mnew;
  const float alpha = fexp2(m - msafe);
  float ps = 0.f;
#pragma unroll
  for (int ks2 = 0; ks2 < 2; ++ks2)
#pragma unroll
    for (int i = 0; i < 16; ++i) { s[ks2][i] = fexp2(s[ks2][i] - msafe); ps += s[ks2][i]; }
  l = l * alpha + ps;
#pragma unroll
  for (int mt = 0; mt < 2; ++mt)
#pragma unroll
    for (int i = 0; i < 16; ++i) o[mt][i] *= alpha;
  m = mnew;
}
DEV bool testbit4(unsigned w0, unsigned w1, unsigned w2, unsigned w3, int j) {
  const unsigned lo = j & 32 ? w1 : w0, hi = j & 32 ? w3 : w2;
  const unsigned x = j & 64 ? hi : lo;
  return (x >> (j & 31)) & 1u;
}

DEV void p2_nsa(const Params& p, int item, char* smem) {
  NsaSmem* sm = (NsaSmem*)smem;
  const int tid = threadIdx.x, lane = tid & 63, wave = tid >> 6;
  const int bg = item & 3, b = bg >> 1, g = bg & 1;
  const int qt = NSA_QT - 1 - (item >> 2);
  const int t0 = qt * 32;
  const int c = lane & 31, hh = lane >> 5, tl = c >> 2, h = c & 3;
  const int trow = wave * 8 + tl;
  const int tq = t0 + trow;
  const size_t tok = (size_t)b * SEQ_LEN + tq;
  const int hd = g * 4 + h;
  const float* H = (const float*)(p.ws + OFF_H);
  const unsigned short* QB = (const unsigned short*)(p.ws + OFF_QB);
  const unsigned short* KSB = (const unsigned short*)(p.ws + OFF_KSB) + ((size_t)b * 2 + g) * SEQ_LEN * 64;
  const unsigned short* KWB = (const unsigned short*)(p.ws + OFF_KWB) + ((size_t)b * 2 + g) * SEQ_LEN * 64;
  const unsigned short* VST = (const unsigned short*)(p.ws + OFF_VST) + ((size_t)b * 2 + g) * NBLK * 4096;
  const unsigned short* VWT = (const unsigned short*)(p.ws + OFF_VWT) + ((size_t)b * 2 + g) * NBLK * 4096;
  const unsigned short* KCB = (const unsigned short*)(p.ws + OFF_KCB) + ((size_t)b * 2 + g) * NB_CMP * 4096;
  const unsigned short* VCT = (const unsigned short*)(p.ws + OFF_VCT) + ((size_t)b * 2 + g) * NB_CMP * 4096;
  bf16x8 qf[4];
  {
    const unsigned short* qrow = QB + (tok * 8 + hd) * 64;
#pragma unroll
    for (int ks = 0; ks < 4; ++ks) qf[ks] = *(const bf16x8*)(qrow + ks * 16 + hh * 8);
  }
  const float g0 = sigmoidf_(H[tok * AB_IN + 1792 + hd * 3 + 0]);
  const float g1 = sigmoidf_(H[tok * AB_IN + 1792 + hd * 3 + 1]);
  const float g2 = sigmoidf_(H[tok * AB_IN + 1792 + hd * 3 + 2]);
  f32x16 o[2], s[2];
#pragma unroll
  for (int mt = 0; mt < 2; ++mt)
#pragma unroll
    for (int i = 0; i < 16; ++i) o[mt][i] = 0.f;
  float* mixrow = (float*)(p.ws + OFF_MIX) + tok * 1024 + 512 + hd * 64 + 4 * hh;
  __syncthreads();
  for (int w = tid; w < 32 * 128; w += NTHREADS) (&sm->imp[0][0])[w] = 0.f;
  TileRegs tr;
  tr.k0 = tr.k1 = tr.v0 = tr.v1 = make_uint4(0, 0, 0, 0);
  const int nval = tq >= 31 ? (tq - 31) / 16 + 1 : 0;
  const int nvmax = (t0 + 31 - 31) / 16 + 1;
  const int ktn = (nvmax + 63) / 64;
  float m = -INFINITY, l = 0.f;
  tile_gload(tr, KCB, nullptr, tid);
  for (int kt = 0; kt < ktn; ++kt) {
    __syncthreads();
    tile_sstore(sm, tr, false, tid);
    __syncthreads();
    if (kt + 1 < ktn) tile_gload(tr, KCB + (size_t)(kt + 1) * 4096, nullptr, tid);
    qk_tile(sm->k, qf, s, lane);
    float tmax = -INFINITY;
#pragma unroll
    for (int ks2 = 0; ks2 < 2; ++ks2)
#pragma unroll
      for (int i = 0; i < 16; ++i) {
        const int n = kt * 64 + ks2 * 32 + (i & 3) + 8 * (i >> 2) + 4 * hh;
        s[ks2][i] = n < nval ? s[ks2][i] : -INFINITY;
        tmax = fmaxf(tmax, s[ks2][i]);
      }
    tmax = fmaxf(tmax, __shfl_xor(tmax, 32));
    const float mnew = fmaxf(m, tmax);
    const float msafe = mnew == -INFINITY ? 0.f : mnew;
    float ps = 0.f;
#pragma unroll
    for (int ks2 = 0; ks2 < 2; ++ks2)
#pragma unroll
      for (int i = 0; i < 16; ++i) ps += fexp2(s[ks2][i] - msafe);
    l = l * fexp2(m - msafe) + ps;
    m = mnew;
  }
  {
    const float ltot = l + __shfl_xor(l, 32);
    const float invl = ltot > 0.f ? 1.f / ltot : 0.f;
    const float msafe = m == -INFINITY ? 0.f : m;
    tile_gload(tr, KCB, VCT, tid);
    for (int kt = 0; kt < ktn; ++kt) {
      __syncthreads();
      tile_sstore(sm, tr, true, tid);
      __syncthreads();
      if (kt + 1 < ktn) tile_gload(tr, KCB + (size_t)(kt + 1) * 4096, VCT + (size_t)(kt + 1) * 4096, tid);
      qk_tile(sm->k, qf, s, lane);
#pragma unroll
      for (int ks2 = 0; ks2 < 2; ++ks2)
#pragma unroll
        for (int i = 0; i < 16; ++i) {
          const int n = kt * 64 + ks2 * 32 + (i & 3) + 8 * (i >> 2) + 4 * hh;
          s[ks2][i] = n < nval ? fexp2(s[ks2][i] - msafe) * invl : 0.f;
        }
#pragma unroll
      for (int ks2 = 0; ks2 < 2; ++ks2)
#pragma unroll
        for (int g4 = 0; g4 < 4; ++g4) {
          float A = 2.f * (s[ks2][4 * g4] + s[ks2][4 * g4 + 1] + s[ks2][4 * g4 + 2]) + s[ks2][4 * g4 + 3];
          float Bv = s[ks2][4 * g4 + 3];
          A = quad_sum(A); Bv = quad_sum(Bv);
          const int j = kt * 16 + ks2 * 8 + 2 * g4 + hh;
          if (h == 0 && j < NBLK) sm->imp[trow][j] += A;
          WAVE_SYNC();
          if (h == 0 && j + 1 < NBLK) sm->imp[trow][j + 1] += Bv;
          WAVE_SYNC();
        }
      pv_tile(sm->vt, s, o, lane);
    }
#pragma unroll
    for (int mt = 0; mt < 2; ++mt)
#pragma unroll
      for (int g4 = 0; g4 < 4; ++g4) {
        st4(mixrow + mt * 32 + 8 * g4, make_float4(o[mt][4 * g4] * g0, o[mt][4 * g4 + 1] * g0, o[mt][4 * g4 + 2] * g0, o[mt][4 * g4 + 3] * g0));
        o[mt][4 * g4] = 0.f; o[mt][4 * g4 + 1] = 0.f; o[mt][4 * g4 + 2] = 0.f; o[mt][4 * g4 + 3] = 0.f;
      }
  }
  WAVE_SYNC();
  for (int t8 = 0; t8 < 8; ++t8) {
    const int row = wave * 8 + t8, tt = t0 + row, cur = tt >> 6;
    float kv[2]; bool valid[2];
#pragma unroll
    for (int c2 = 0; c2 < 2; ++c2) {
      const int j = lane + 64 * c2;
      valid[c2] = j < NBLK && j <= cur;
      const bool forced = (j == 0) | (j == cur) | (j == cur - 1);
      kv[c2] = valid[c2] ? (forced ? 1e6f : sm->imp[row][j < NBLK ? j : 0]) : -1.f;
      sm->keyb[wave][j] = kv[c2];
    }
    WAVE_SYNC();
    int rank0 = 0, rank1 = 0;
    const int jlim = cur < NBLK - 1 ? cur : NBLK - 1;
    for (int jj = 0; jj <= jlim; ++jj) {
      const float ov = sm->keyb[wave][jj];
      rank0 += (ov > kv[0] || (ov == kv[0] && jj < lane)) ? 1 : 0;
      rank1 += (ov > kv[1] || (ov == kv[1] && jj < lane + 64)) ? 1 : 0;
    }
    const unsigned long long m0 = __ballot(valid[0] && rank0 < 16);
    const unsigned long long m1 = __ballot(valid[1] && rank1 < 16);
    if (lane == 0) {
      sm->selmask[row][0] = (unsigned)m0; sm->selmask[row][1] = (unsigned)(m0 >> 32);
      sm->selmask[row][2] = (unsigned)m1; sm->selmask[row][3] = (unsigned)(m1 >> 32);
    }
    WAVE_SYNC();
  }
  __syncthreads();
  if (tid < 4) {
    unsigned u = 0;
    for (int r = 0; r < 32; ++r) u |= sm->selmask[r][tid];
    sm->unionm[tid] = u;
  }
  __syncthreads();
  const unsigned um0 = sm->unionm[0], um1 = sm->unionm[1], um2 = sm->unionm[2], um3 = sm->unionm[3];
  const unsigned my0 = sm->selmask[trow][0], my1 = sm->selmask[trow][1], my2 = sm->selmask[trow][2], my3 = sm->selmask[trow][3];
  {
    const int jmax = (t0 + 31) >> 6;
    int j = 0;
    while (j <= jmax && !testbit4(um0, um1, um2, um3, j)) ++j;
    m = -INFINITY; l = 0.f;
    if (j <= jmax) tile_gload(tr, KSB + (size_t)j * 4096, VST + (size_t)j * 4096, tid);
    while (j <= jmax) {
      __syncthreads();
      tile_sstore(sm, tr, true, tid);
      __syncthreads();
      int jn = j + 1;
      while (jn <= jmax && !testbit4(um0, um1, um2, um3, jn)) ++jn;
      if (jn <= jmax) tile_gload(tr, KSB + (size_t)jn * 4096, VST + (size_t)jn * 4096, tid);
      const bool mine = testbit4(my0, my1, my2, my3, j);
      if (__ballot(mine) != 0ull) {
        qk_tile(sm->k, qf, s, lane);
#pragma unroll
        for (int ks2 = 0; ks2 < 2; ++ks2)
#pragma unroll
          for (int i = 0; i < 16; ++i) {
            const int kp = j * 64 + ks2 * 32 + (i & 3) + 8 * (i >> 2) + 4 * hh;
            s[ks2][i] = (mine && kp <= tq) ? s[ks2][i] : -INFINITY;
          }
        softmax_step(s, m, l, o);
        pv_tile(sm->vt, s, o, lane);
      }
      j = jn;
    }
    const float ltot = l + __shfl_xor(l, 32);
    const float sc = ltot > 0.f ? g1 / ltot : 0.f;
#pragma unroll
    for (int mt = 0; mt < 2; ++mt)
#pragma unroll
      for (int g4 = 0; g4 < 4; ++g4) {
        float4 a = ld4(mixrow + mt * 32 + 8 * g4);
        a.x += o[mt][4 * g4] * sc; a.y += o[mt][4 * g4 + 1] * sc; a.z += o[mt][4 * g4 + 2] * sc; a.w += o[mt][4 * g4 + 3] * sc;
        st4(mixrow + mt * 32 + 8 * g4, a);
        o[mt][4 * g4] = 0.f; o[mt][4 * g4 + 1] = 0.f; o[mt][4 * g4 + 2] = 0.f; o[mt][4 * g4 + 3] = 0.f;
      }
  }
  {
    const int jlo = t0 - 511 > 0 ? (t0 - 511) >> 6 : 0, jhi = (t0 + 31) >> 6;
    const int wq0 = t0 + wave * 8;
    m = -INFINITY; l = 0.f;
    tile_gload(tr, KWB + (size_t)jlo * 4096, VWT + (size_t)jlo * 4096, tid);
    for (int j = jlo; j <= jhi; ++j) {
      __syncthreads();
      tile_sstore(sm, tr, true, tid);
      __syncthreads();
      if (j + 1 <= jhi) tile_gload(tr, KWB + (size_t)(j + 1) * 4096, VWT + (size_t)(j + 1) * 4096, tid);
      if (j * 64 <= wq0 + 7 && j * 64 + 63 > wq0 - 512) {
        qk_tile(sm->k, qf, s, lane);
#pragma unroll
        for (int ks2 = 0; ks2 < 2; ++ks2)
#pragma unroll
          for (int i = 0; i < 16; ++i) {
            const int kp = j * 64 + ks2 * 32 + (i & 3) + 8 * (i >> 2) + 4 * hh;
            s[ks2][i] = (kp <= tq && kp > tq - 512) ? s[ks2][i] : -INFINITY;
          }
        softmax_step(s, m, l, o);
        pv_tile(sm->vt, s, o, lane);
      }
    }
    const float ltot = l + __shfl_xor(l, 32);
    const float sc = ltot > 0.f ? g2 / ltot : 0.f;
#pragma unroll
    for (int mt = 0; mt < 2; ++mt)
#pragma unroll
      for (int g4 = 0; g4 < 4; ++g4) {
        float4 a = ld4(mixrow + mt * 32 + 8 * g4);
        a.x += o[mt][4 * g4] * sc; a.y += o[mt][4 * g4 + 1] * sc; a.z += o[mt][4 * g4 + 2] * sc; a.w += o[mt][4 * g4 + 3] * sc;
        st4(mixrow + mt * 32 + 8 * g4, a);
        o[mt][4 * g4] = 0.f; o[mt][4 * g4 + 1] = 0.f; o[mt][4 * g4 + 2] = 0.f; o[mt][4 * g4 + 3] = 0.f;
      }
  }
}

#define P1_SMEM ((2 * 8 * 128 + 8 * 128) * 4)
DEV void phase_p1(const Params& p, char* smem) {
  const int total = P1_CMPG_ITEMS + 2 + P1_S5A_ITEMS + P1_PREP_ITEMS;
  for (int it = blockIdx.x; it < total; it += gridDim.x) {
    if (it < P1_CMPG_ITEMS) p1_cmpgemm(p, it, smem);
    else if (it < P1_CMPG_ITEMS + 2) p1_cmpc1(p, it - P1_CMPG_ITEMS, smem);
    else if (it < P1_CMPG_ITEMS + 2 + P1_PREP_ITEMS) p1_prep(p, it - P1_CMPG_ITEMS - 2, smem);
    else p1_s5a(p, it - P1_CMPG_ITEMS - 2 - P1_PREP_ITEMS, smem);
  }
}
DEV void phase_p1b(const Params& p, char* smem) {
  for (int it = blockIdx.x; it < P1_CMP_ITEMS; it += gridDim.x) p1_compress(p, it, smem);
}

#define P2_S5C_ITEMS (BATCH * 32 * S5_NC / 4)
#define S5C_ROW 132
#define P2_S5C_SMEM (4 * 16 * S5C_ROW * 4 + 4 * 64 * 16 * 4)
DEV void p2_s5c(const Params& p, int item, char* smem) {
  const int lane = threadIdx.x & 63, wave = threadIdx.x >> 6;
  const int idx = item * 4 + wave;
  const int g = idx & 31, c = (idx >> 5) % S5_NC, b = idx / (32 * S5_NC);
  float lb_re, lb_im, bbr[16], bbi[16];
  s5_consts(p, g, lane, lb_re, lb_im, bbr, bbi);
  float ar = lb_re, ai = lb_im;
#pragma unroll
  for (int s = 0; s < 6; ++s) { const float nr = ar * ar - ai * ai, ni = 2.f * ar * ai; ar = nr; ai = ni; }
  const float2* E = (const float2*)(p.ws + OFF_S5E);
  float sr = 0.f, si = 0.f;
  {
    int cc = 0;
    for (; cc + 8 <= c; cc += 8) {
      float2 e[8];
#pragma unroll
      for (int q = 0; q < 8; ++q) e[q] = E[((size_t)(b * S5_NC + cc + q) * 32 + g) * 64 + lane];
#pragma unroll
      for (int q = 0; q < 8; ++q) {
        const float nr = ar * sr - ai * si + e[q].x, ni = ar * si + ai * sr + e[q].y;
        sr = nr; si = ni;
      }
    }
    for (; cc < c; ++cc) {
      const float2 e = E[((size_t)(b * S5_NC + cc) * 32 + g) * 64 + lane];
      const float nr = ar * sr - ai * si + e.x, ni = ar * si + ai * sr + e.y;
      sr = nr; si = ni;
    }
  }
  __syncthreads();
  const float* H = (const float*)(p.ws + OFF_H);
  float* sS = (float*)smem + wave * 16 * S5C_ROW;
  float* su = (float*)smem + 4 * 16 * S5C_ROW + wave * 64 * 16;
  {
    const float* ur = H + (size_t)(b * SEQ_LEN + c * 64 + lane) * AB_IN + g * 16;
#pragma unroll
    for (int q = 0; q < 4; ++q) st4(su + lane * 16 + q * 4, ld4(ur + q * 4));
  }
  __syncthreads();
  const float* cre = p.in[I_S5_C_RE] + (size_t)g * 16 * 64;
  const float* cim = p.in[I_S5_C_IM] + (size_t)g * 16 * 64;
  float* YG = (float*)(p.ws + OFF_YGELU);
  for (int sc = 0; sc < 4; ++sc) {
    for (int tt = 0; tt < 16; ++tt) {
      const float* u = su + (sc * 16 + tt) * 16;
      float dr = 0.f, di = 0.f;
#pragma unroll
      for (int h4 = 0; h4 < 4; ++h4) {
        const float4 uv = ld4(u + h4 * 4);
        dr += uv.x * bbr[h4 * 4] + uv.y * bbr[h4 * 4 + 1] + uv.z * bbr[h4 * 4 + 2] + uv.w * bbr[h4 * 4 + 3];
        di += uv.x * bbi[h4 * 4] + uv.y * bbi[h4 * 4 + 1] + uv.z * bbi[h4 * 4 + 2] + uv.w * bbi[h4 * 4 + 3];
      }
      const float nr = lb_re * sr - lb_im * si + dr, ni = lb_re * si + lb_im * sr + di;
      sr = nr; si = ni;
      sS[tt * S5C_ROW + lane] = sr;
      sS[tt * S5C_ROW + 64 + lane] = si;
    }
    __syncthreads();
    {
      const int tt = lane >> 2, hq = lane & 3;
      float y[4] = {0.f, 0.f, 0.f, 0.f};
      for (int k = 0; k < 64; k += 4) {
        const float4 vr = ld4(sS + tt * S5C_ROW + k), vi = ld4(sS + tt * S5C_ROW + 64 + k);
#pragma unroll
        for (int hh = 0; hh < 4; ++hh) {
          const float4 cr = ld4(cre + (hq * 4 + hh) * 64 + k), ci = ld4(cim + (hq * 4 + hh) * 64 + k);
          y[hh] += vr.x * cr.x + vr.y * cr.y + vr.z * cr.z + vr.w * cr.w - (vi.x * ci.x + vi.y * ci.y + vi.z * ci.z + vi.w * ci.w);
        }
      }
      const size_t tok = (size_t)(b * SEQ_LEN + c * 64 + sc * 16 + tt);
      const int ch = g * 16 + hq * 4;
      const float4 uv = ld4(H + tok * AB_IN + ch);
      const float4 dv = ld4(p.in[I_S5_D] + ch);
      float4 o;
      o.x = geluf_(y[0] + dv.x * uv.x); o.y = geluf_(y[1] + dv.y * uv.y);
      o.z = geluf_(y[2] + dv.z * uv.z); o.w = geluf_(y[3] + dv.w * uv.w);
      st4(YG + tok * 512 + ch, o);
    }
    __syncthreads();
  }
}

#define P2_SMEM (P2_S5C_SMEM > P2_NSA_SMEM ? P2_S5C_SMEM : P2_NSA_SMEM)
DEV void phase_p2(const Params& p, char* smem) {
  const int G = gridDim.x;
  const int total = P2_NSA_ITEMS + P2_S5C_ITEMS;
  for (int r = 0;; ++r) {
    const int it = r * G + ((r & 1) ? (G - 1 - (int)blockIdx.x) : (int)blockIdx.x);
    if (r * G >= total) break;
    if (it >= total) continue;
    if (it < P2_NSA_ITEMS) p2_nsa(p, it, smem);
    else p2_s5c(p, it - P2_NSA_ITEMS, smem);
  }
}

DEV void phase_glu(const Params& p, char* smem) {
  const float* A = (const float*)(p.ws + OFF_YGELU);
  const float* B = p.in[I_S5_W_GLU];
  const float* bias = p.in[I_S5_B_GLU];
  float* MIX = (float*)(p.ws + OFF_MIX);
  const int NT = 4, MT = NTOK / GEMM_BM;
  const int xcd_ = blockIdx.x & 7, lb_ = blockIdx.x >> 3, nb_ = gridDim.x >> 3;
  for (int j_ = lb_; j_ < (MT / 8) * NT; j_ += nb_) {
    const int it = (xcd_ + 8 * (j_ / NT)) * NT + (j_ % NT);
    const int m0 = (it / NT) * GEMM_BM, n0 = (it % NT) * 128;
    gemm_tile<false>(
        [&](int r) { return (const void*)(A + (size_t)(m0 + r) * 512); },
        [&](int c) { return B + n0 + c; }, 512, 512,
        [&](int row, int col, float v0, float v1) {
          const size_t gm = m0 + row; const int gc = n0 + col;
          const float y0 = A[gm * 512 + gc], y1 = A[gm * 512 + gc + 32];
          MIX[gm * 1024 + gc] = y0 * sigmoidf_(v0 + bias[gc]);
          MIX[gm * 1024 + gc + 32] = y1 * sigmoidf_(v1 + bias[gc + 32]);
        },
        smem);
  }
}

template <int LAYER>
DEV void phase_outproj(const Params& p, char* smem) {
  const float* A = (const float*)(p.ws + OFF_MIX);
  const float* B = LAYER == 0 ? p.in[I_AB_W_OUT] : p.in[I_CD_W_OUT];
  const float* xin = LAYER == 0 ? p.in[I_X] : (const float*)(p.ws + OFF_X2);
  float* PRE = (float*)(p.ws + OFF_H);
  const int NT = 8, MT = NTOK / GEMM_BM;
  const int xcd_ = blockIdx.x & 7, lb_ = blockIdx.x >> 3, nb_ = gridDim.x >> 3;
  for (int j_ = lb_; j_ < (MT / 8) * NT; j_ += nb_) {
    const int it = (xcd_ + 8 * (j_ / NT)) * NT + (j_ % NT);
    const int m0 = (it / NT) * GEMM_BM, n0 = (it % NT) * 128;
    gemm_tile<false>(
        [&](int r) { return (const void*)(A + (size_t)(m0 + r) * 1024); },
        [&](int c) { return B + n0 + c; }, 1024, 1024,
        [&](int row, int col, float v0, float v1) {
          const size_t o = (size_t)(m0 + row) * 1024 + n0 + col;
          PRE[o] = ALPHA_F * xin[o] + v0;
          PRE[o + 32] = ALPHA_F * xin[o + 32] + v1;
        },
        smem);
  }
}

DEV void wave_ln(float (&v)[16], const float* gam, const float* bet, int lane) {
  float s = 0.f;
#pragma unroll
  for (int i = 0; i < 16; ++i) s += v[i];
  const float mu = wave_sum(s) * (1.f / 1024.f);
  float q = 0.f;
#pragma unroll
  for (int i = 0; i < 16; ++i) { const float d = v[i] - mu; q += d * d; }
  const float rstd = rsqrtf(wave_sum(q) * (1.f / 1024.f) + 1e-5f);
#pragma unroll
  for (int i = 0; i < 4; ++i) {
    const float4 gv = ld4(gam + lane * 4 + 256 * i), bv = ld4(bet + lane * 4 + 256 * i);
    v[i * 4 + 0] = (v[i * 4 + 0] - mu) * rstd * gv.x + bv.x;
    v[i * 4 + 1] = (v[i * 4 + 1] - mu) * rstd * gv.y + bv.y;
    v[i * 4 + 2] = (v[i * 4 + 2] - mu) * rstd * gv.z + bv.z;
    v[i * 4 + 3] = (v[i * 4 + 3] - mu) * rstd * gv.w + bv.w;
  }
}

#define P5_SMEM (4 * (4 * 1024 + 64) * 4)
template <int LAYER>
DEV void phase_ln_router(const Params& p, char* smem) {
  const int lane = threadIdx.x & 63, wave = threadIdx.x >> 6;
  const float* PRE = (const float*)(p.ws + OFF_H);
  float* X1 = (float*)(p.ws + OFF_X1);
  const float* router = p.in[I_ROUTER] + (size_t)LAYER * 1024 * 64;
  const float* bias = p.in[I_MOE_BIAS] + LAYER * 64;
  int* TOPI = (int*)(p.ws + OFF_TOPI);
  float* TOPG = (float*)(p.ws + OFF_TOPG);
  float* xs = (float*)smem + wave * (4 * 1024 + 64);
  float* ms = xs + 4 * 1024;
  unsigned short* X1B = (unsigned short*)p.out;
  for (int it = blockIdx.x; it < NTOK / 16; it += gridDim.x) {
    const size_t tokb = (size_t)it * 16 + wave * 4;
    WAVE_SYNC();
#pragma unroll 1
    for (int t = 0; t < 4; ++t) {
      const size_t tok = tokb + t;
      float v[16];
#pragma unroll
      for (int i = 0; i < 4; ++i) {
        const float4 a = ld4(PRE + tok * 1024 + lane * 4 + 256 * i);
        v[i * 4] = a.x; v[i * 4 + 1] = a.y; v[i * 4 + 2] = a.z; v[i * 4 + 3] = a.w;
      }
      wave_ln(v, p.in[I_LN1_G] + LAYER * 1024, p.in[I_LN1_B] + LAYER * 1024, lane);
#pragma unroll
      for (int i = 0; i < 4; ++i) {
        const float4 a = make_float4(v[i * 4], v[i * 4 + 1], v[i * 4 + 2], v[i * 4 + 3]);
        st4(X1 + tok * 1024 + lane * 4 + 256 * i, a);
        st4(xs + t * 1024 + lane * 4 + 256 * i, a);
        *(uint2*)(X1B + tok * 1024 + lane * 4 + 256 * i) = make_uint2(pk2(a.x, a.y), pk2(a.z, a.w));
      }
    }
    WAVE_SYNC();
    float lg[4] = {0.f, 0.f, 0.f, 0.f};
    for (int k = 0; k < 1024; k += 4) {
      const float r0 = router[(size_t)k * 64 + lane], r1 = router[(size_t)(k + 1) * 64 + lane],
                  r2 = router[(size_t)(k + 2) * 64 + lane], r3 = router[(size_t)(k + 3) * 64 + lane];
#pragma unroll
      for (int t = 0; t < 4; ++t) {
        const float4 xv = ld4(xs + t * 1024 + k);
        lg[t] += xv.x * r0 + xv.y * r1 + xv.z * r2 + xv.w * r3;
      }
    }
#pragma unroll
    for (int t = 0; t < 4; ++t) {
      const size_t tok = tokb + t;
      const float score = 1.f / (1.f + expf(-lg[t]));
      const float biased = score + bias[lane];
      float m1 = biased; int a1 = lane;
#pragma unroll
      for (int mm = 1; mm <= 4; mm <<= 1) {
        const float ov = __shfl_xor(m1, mm); const int oa = __shfl_xor(a1, mm);
        if (ov > m1 || (ov == m1 && oa < a1)) { m1 = ov; a1 = oa; }
      }
      float m2 = lane == a1 ? -INFINITY : biased;
#pragma unroll
      for (int mm = 1; mm <= 4; mm <<= 1) m2 = fmaxf(m2, __shfl_xor(m2, mm));
      const float gs = m1 + m2;
      const int mygrp = lane >> 3;
      int rank = 0;
#pragma unroll
      for (int gg = 0; gg < 8; ++gg) {
        const float og = __shfl(gs, gg * 8);
        rank += (og > gs || (og == gs && gg < mygrp)) ? 1 : 0;
      }
      const float masked = rank < 4 ? biased : -INFINITY;
      WAVE_SYNC();
      ms[lane] = masked;
      WAVE_SYNC();
      int erank = 0;
      for (int e = 0; e < 64; ++e) {
        const float ov = ms[e];
        erank += (ov > masked || (ov == masked && e < lane)) ? 1 : 0;
      }
      const bool selected = erank < 8;
      const float gsum = wave_sum(selected ? score : 0.f);
      if (selected) {
        TOPI[tok * 8 + erank] = lane;
        TOPG[tok * 8 + erank] = score / gsum * 2.5f;
      }
    }
  }
}

#define P6_SMEM GEMM_SMEM_BYTES
template <int LAYER>
DEV void phase_lists_shup(const Params& p, char* smem) {
  const int tid = threadIdx.x, lane = tid & 63, wave = tid >> 6;
  const int* TOPI = (const int*)(p.ws + OFF_TOPI);
  const float* TOPG = (const float*)(p.ws + OFF_TOPG);
  int* POSOF = (int*)(p.ws + OFF_POSOF);
  int* CNT = (int*)(p.ws + OFF_CNT);
  int* LTOK = (int*)(p.ws + OFF_LTOK);
  float* LGATE = (float*)(p.ws + OFF_LGATE);
  const unsigned short* X1B = (const unsigned short*)p.out;
  unsigned short* HS = (unsigned short*)(p.ws + OFF_HS);
  const float* W1 = p.in[I_SH_W1] + (size_t)LAYER * 1024 * 256;
  const float* W3 = p.in[I_SH_W3] + (size_t)LAYER * 1024 * 256;
  const int MT = NTOK / GEMM_BM;
  int* swave = (int*)smem;
  for (int it = blockIdx.x; it < 64; it += gridDim.x) {
    const int e = it;
    int base = 0;
    for (int t0 = 0; t0 < NTOK; t0 += NTHREADS) {
      const int tok = t0 + tid;
      int slot = -1;
#pragma unroll
      for (int s = 0; s < 8; ++s) if (TOPI[(size_t)tok * 8 + s] == e) slot = s;
      const unsigned long long bal = __ballot(slot >= 0);
      const int pre = __popcll(bal & ((1ull << lane) - 1ull));
      __syncthreads();
      if (lane == 0) swave[wave] = __popcll(bal);
      __syncthreads();
      int woff = 0, tot = 0;
#pragma unroll
      for (int w = 0; w < 4; ++w) { const int c = swave[w]; if (w < wave) woff += c; tot += c; }
      if (slot >= 0) {
        const int pos = base + woff + pre;
        LTOK[(size_t)e * NTOK + pos] = tok;
        LGATE[(size_t)e * NTOK + pos] = TOPG[(size_t)tok * 8 + slot];
        POSOF[(size_t)tok * 8 + slot] = pos;
      }
      base += tot;
    }
    if (tid == 0) CNT[e] = base;
    __syncthreads();
  }
  {
    const int NT = 4;
    const int xcd_ = blockIdx.x & 7, lb_ = blockIdx.x >> 3, nb_ = gridDim.x >> 3;
    for (int j_ = lb_; j_ < (MT / 8) * NT; j_ += nb_) {
      const int m0 = (xcd_ + 8 * (j_ / NT)) * GEMM_BM, ct = j_ % NT;
      gemm_tile<true>(
          [&](int r) { return (const void*)(X1B + (size_t)(m0 + r) * 1024); },
          [&](int c) { return (((c >> 5) & 1) ? W3 : W1) + ct * 64 + (c >> 6) * 32 + (c & 31); }, 256, 1024,
          [&](int row, int col, float v0, float v1) {
            const int lc = ct * 64 + (col >> 6) * 32 + (col & 31);
            HS[(size_t)(m0 + row) * 256 + lc] = f2bf(siluf_(v0) * v1);
          },
          smem);
    }
  }
}

struct ExpMap { int tstart[65]; int rbase[65]; int ltile[9]; };
DEV void build_expmap(const Params& p, ExpMap* em) {
  __syncthreads();
  if (threadIdx.x == 0) {
    const int* CNT = (const int*)(p.ws + OFF_CNT);
    int ts = 0, rb = 0;
    for (int e = 0; e < 64; ++e) {
      em->tstart[e] = ts; em->rbase[e] = rb;
      const int c = CNT[e];
      ts += (c + GEMM_BM - 1) / GEMM_BM; rb += c;
    }
    em->tstart[64] = ts; em->rbase[64] = rb;
    const int x = blockIdx.x & 7;
    int lt = 0;
    for (int k = 0; k < 8; ++k) { em->ltile[k] = lt; lt += em->tstart[x + 8 * k + 1] - em->tstart[x + 8 * k]; }
    em->ltile[8] = lt;
  }
  __syncthreads();
}
DEV void map_expert_tile(const ExpMap* em, int j, int CT, int& e, int& rt, int& ct) {
  const int jr = j / CT; ct = j % CT;
  int k = 0;
  for (int q = 1; q < 8; ++q) if (em->ltile[q] <= jr) k = q;
  e = (blockIdx.x & 7) + 8 * k; rt = jr - em->ltile[k];
}
#define P7_SMEM (GEMM_SMEM_BYTES + 1024)
template <int LAYER>
DEV void phase_routed_up(const Params& p, char* smem) {
  ExpMap* em = (ExpMap*)(smem + GEMM_SMEM_BYTES);
  build_expmap(p, em);
  const int* CNT = (const int*)(p.ws + OFF_CNT);
  const int* LTOK = (const int*)(p.ws + OFF_LTOK);
  const unsigned short* X1B = (const unsigned short*)p.out;
  unsigned short* HR = (unsigned short*)(p.ws + OFF_HR);
  const int lb_ = blockIdx.x >> 3, nb_ = gridDim.x >> 3;
  for (int j_ = lb_; j_ < em->ltile[8] * 4; j_ += nb_) {
    int e, rtl, ct;
    map_expert_tile(em, j_, 4, e, rtl, ct);
    const int r0 = rtl * GEMM_BM;
    const int cnt = CNT[e], rbase = em->rbase[e];
    const float* W1 = p.in[I_MOE_W1] + ((size_t)LAYER * 64 + e) * 1024 * 256;
    const float* W3 = p.in[I_MOE_W3] + ((size_t)LAYER * 64 + e) * 1024 * 256;
    gemm_tile<true>(
        [&](int r) { return (r0 + r < cnt) ? (const void*)(X1B + (size_t)LTOK[(size_t)e * NTOK + r0 + r] * 1024) : (const void*)nullptr; },
        [&](int c) { return (((c >> 5) & 1) ? W3 : W1) + ct * 64 + (c >> 6) * 32 + (c & 31); }, 256, 1024,
        [&](int row, int col, float v0, float v1) {
          if (r0 + row < cnt) {
            const int lc = ct * 64 + (col >> 6) * 32 + (col & 31);
            HR[(size_t)(rbase + r0 + row) * 256 + lc] = f2bf(siluf_(v0) * v1);
          }
        },
        smem);
  }
}

template <int LAYER>
DEV void phase_down(const Params& p, char* smem) {
  ExpMap* em = (ExpMap*)(smem + GEMM_SMEM_BYTES);
  build_expmap(p, em);
  const int* CNT = (const int*)(p.ws + OFF_CNT);
  const float* LGATE = (const float*)(p.ws + OFF_LGATE);
  const unsigned short* HR = (const unsigned short*)(p.ws + OFF_HR);
  const unsigned short* HS = (const unsigned short*)(p.ws + OFF_HS);
  unsigned short* Y = (unsigned short*)(p.ws + OFF_Y);
  float* FS = (float*)(p.ws + OFF_FS);
  const int xcd_ = blockIdx.x & 7, lb_ = blockIdx.x >> 3, nb_ = gridDim.x >> 3;
  for (int j_ = lb_; j_ < em->ltile[8] * 8; j_ += nb_) {
    int e, rtl, ct;
    map_expert_tile(em, j_, 8, e, rtl, ct);
    const int r0 = rtl * GEMM_BM;
    const int cnt = CNT[e], rbase = em->rbase[e];
    const float* W2 = p.in[I_MOE_W2] + ((size_t)LAYER * 64 + e) * 256 * 1024;
    const int n0 = ct * 128;
    gemm_tile<true>(
        [&](int r) { return (r0 + r < cnt) ? (const void*)(HR + (size_t)(rbase + r0 + r) * 256) : (const void*)nullptr; },
        [&](int c) { return W2 + n0 + c; }, 1024, 256,
        [&](int row, int col, float v0, float v1) {
          if (r0 + row < cnt) {
            const float gt = LGATE[(size_t)e * NTOK + r0 + row];
            const size_t o = (size_t)(rbase + r0 + row) * 1024 + n0 + col;
            Y[o] = f2bf(v0 * gt); Y[o + 32] = f2bf(v1 * gt);
          }
        },
        smem);
  }
  {
    const int MT = NTOK / GEMM_BM, NT = 8;
    const float* W2 = p.in[I_SH_W2] + (size_t)LAYER * 256 * 1024;
    for (int j_ = lb_; j_ < (MT / 8) * NT; j_ += nb_) {
      const int m0 = (xcd_ + 8 * (j_ / NT)) * GEMM_BM, n0 = (j_ % NT) * 128;
      gemm_tile<true>(
          [&](int r) { return (const void*)(HS + (size_t)(m0 + r) * 256); },
          [&](int c) { return W2 + n0 + c; }, 1024, 256,
          [&](int row, int col, float v0, float v1) {
            const size_t o = (size_t)(m0 + row) * 1024 + n0 + col;
            FS[o] = v0; FS[o + 32] = v1;
          },
          smem);
    }
  }
}

template <int LAYER>
DEV void phase_combine(const Params& p, char* smem) {
  ExpMap* em = (ExpMap*)smem;
  build_expmap(p, em);
  const int lane = threadIdx.x & 63, wave = threadIdx.x >> 6;
  const float* X1 = (const float*)(p.ws + OFF_X1);
  const float* FS = (const float*)(p.ws + OFF_FS);
  const unsigned short* Y = (const unsigned short*)(p.ws + OFF_Y);
  const int* TOPI = (const int*)(p.ws + OFF_TOPI);
  const int* POSOF = (const int*)(p.ws + OFF_POSOF);
  float* OUT = LAYER == 0 ? (float*)(p.ws + OFF_X2) : p.out;
  for (int it = blockIdx.x; it < NTOK / 4; it += gridDim.x) {
    const size_t tok = (size_t)it * 4 + wave;
    float v[16];
#pragma unroll
    for (int i = 0; i < 4; ++i) {
      const float4 a = ld4(X1 + tok * 1024 + lane * 4 + 256 * i), f = ld4(FS + tok * 1024 + lane * 4 + 256 * i);
      v[i * 4] = ALPHA_F * a.x + f.x; v[i * 4 + 1] = ALPHA_F * a.y + f.y; v[i * 4 + 2] = ALPHA_F * a.z + f.z; v[i * 4 + 3] = ALPHA_F * a.w + f.w;
    }
    size_t rows[8];
#pragma unroll
    for (int s = 0; s < 8; ++s) rows[s] = (size_t)em->rbase[TOPI[tok * 8 + s]] + POSOF[tok * 8 + s];
#pragma unroll
    for (int s0 = 0; s0 < 8; s0 += 4) {
      uint2 yy[4][4];
#pragma unroll
      for (int s = 0; s < 4; ++s)
#pragma unroll
        for (int i = 0; i < 4; ++i) yy[s][i] = *(const uint2*)(Y + rows[s0 + s] * 1024 + lane * 4 + 256 * i);
#pragma unroll
      for (int s = 0; s < 4; ++s)
#pragma unroll
        for (int i = 0; i < 4; ++i) {
          const uint2 y = yy[s][i];
          v[i * 4] += bf2f((unsigned short)(y.x & 0xFFFF)); v[i * 4 + 1] += bf2f((unsigned short)(y.x >> 16));
          v[i * 4 + 2] += bf2f((unsigned short)(y.y & 0xFFFF)); v[i * 4 + 3] += bf2f((unsigned short)(y.y >> 16));
        }
    }
    wave_ln(v, p.in[I_LN2_G] + LAYER * 1024, p.in[I_LN2_B] + LAYER * 1024, lane);
#pragma unroll
    for (int i = 0; i < 4; ++i) st4(OUT + tok * 1024 + lane * 4 + 256 * i, make_float4(v[i * 4], v[i * 4 + 1], v[i * 4 + 2], v[i * 4 + 3]));
    if (LAYER == 0) {
      unsigned short* X2B = (unsigned short*)(p.ws + OFF_X2B);
#pragma unroll
      for (int i = 0; i < 4; ++i) *(uint2*)(X2B + tok * 1024 + lane * 4 + 256 * i) = make_uint2(pk2(v[i * 4], v[i * 4 + 1]), pk2(v[i * 4 + 2], v[i * 4 + 3]));
    }
  }
}

DEV float shifted(const float* Hc, size_t tok, int col, const float* mu) {
  const float cur = Hc[tok * CD_IN + col];
  const float prev = (tok % SEQ_LEN) == 0 ? 0.f : Hc[(tok - 1) * CD_IN + col];
  return cur + (prev - cur) * mu[col];
}

#define P11_PREP_ITEMS (NTOK / 8)
#define P11_KV_ITEMS (BATCH * 4 * RET_NC)
#define P11_SMEM (8 * 128 * 4)
DEV void p11_prep(const Params& p, int item, char* smem) {
  const int tid = threadIdx.x;
  const float* Hc = (const float*)(p.ws + OFF_H);
  const float* mu = p.in[I_RW_MU];
  float* sl = (float*)smem;
  __syncthreads();
  for (int w = tid; w < 8 * 128; w += NTHREADS) {
    const int tt = w >> 7, j = w & 127;
    const size_t tok = (size_t)item * 8 + tt;
    const float v = shifted(Hc, tok, 1536 + j, mu);
    sl[w] = j < 64 ? tanhf(v) : v;
  }
  __syncthreads();
  float* RWW = (float*)(p.ws + OFF_RWW); float* RWK = (float*)(p.ws + OFF_RWK);
  float* RWKK = (float*)(p.ws + OFF_RWKK); float* RWA = (float*)(p.ws + OFF_RWA);
  float* RWR = p.out + (size_t)NTOK * 512; float* RWV = p.out;
  const float* w_up = p.in[I_RW_W_UP]; const float* a_up = p.in[I_RW_A_UP];
#pragma unroll
  for (int cc = 0; cc < 2; ++cc) {
    const int c = tid + 256 * cc;
    float aw[8], aa[8];
#pragma unroll
    for (int tt = 0; tt < 8; ++tt) { aw[tt] = 0.f; aa[tt] = 0.f; }
    for (int j0 = 0; j0 < 64; j0 += 16) {
      float wu[16], au[16];
#pragma unroll
      for (int q = 0; q < 16; ++q) { wu[q] = w_up[(j0 + q) * 512 + c]; au[q] = a_up[(j0 + q) * 512 + c]; }
#pragma unroll
      for (int q4 = 0; q4 < 4; ++q4) {
#pragma unroll
        for (int tt = 0; tt < 8; ++tt) {
          const float4 sw = ld4(sl + tt * 128 + j0 + q4 * 4), sa = ld4(sl + tt * 128 + 64 + j0 + q4 * 4);
          aw[tt] += sw.x * wu[q4 * 4] + sw.y * wu[q4 * 4 + 1] + sw.z * wu[q4 * 4 + 2] + sw.w * wu[q4 * 4 + 3];
          aa[tt] += sa.x * au[q4 * 4] + sa.y * au[q4 * 4 + 1] + sa.z * au[q4 * 4 + 2] + sa.w * au[q4 * 4 + 3];
        }
      }
    }
    const float w0 = p.in[I_RW_W0][c], a0 = p.in[I_RW_A0][c], kkc = p.in[I_RW_K_K][c], kac = p.in[I_RW_K_A][c];
#pragma unroll
    for (int tt = 0; tt < 8; ++tt) {
      const size_t tok = (size_t)item * 8 + tt;
      const float lw = w0 + aw[tt];
      const float nl = -lw;
      const float sp = nl > 20.f ? nl : log1pf(expf(nl));
      const float wl = -sp - 0.5f;
      const float decay = expf(-expf(wl));
      const float a = 1.f / (1.f + expf(-(a0 + aa[tt])));
      const float rs = shifted(Hc, tok, c, mu);
      const float ks = shifted(Hc, tok, 512 + c, mu);
      const float vs = shifted(Hc, tok, 1024 + c, mu);
      float kk = ks * kkc;
      const float nrm = sqrtf(wave_sum(kk * kk));
      kk = kk / fmaxf(nrm, 1e-12f);
      RWW[tok * 512 + c] = decay;
      RWK[tok * 512 + c] = ks * (1.f + (a - 1.f) * kac);
      RWKK[tok * 512 + c] = kk;
      RWA[tok * 512 + c] = kk * a;
      RWR[tok * 512 + c] = rs;
      RWV[tok * 512 + c] = vs;
    }
  }
}
DEV float ret_log2gamma(int h) { return log2f(1.f - exp2f(-5.f - (float)h)); }
struct KvSmem { unsigned short vt[128][72]; unsigned short kt[64][72]; };
#define P11_KV_SMEM ((int)sizeof(KvSmem))
DEV void p11_kv(const Params& p, int item, char* smem) {
  KvSmem* sm = (KvSmem*)smem;
  const int c = item % RET_NC, h = (item / RET_NC) & 3, b = item / (RET_NC * 4);
  const int tid = threadIdx.x, lane = tid & 63, wave = tid >> 6;
  const int r = lane & 31, hh = lane >> 5;
  const float* Hc = (const float*)(p.ws + OFF_H);
  const float lg = ret_log2gamma(h);
  const size_t tok0 = (size_t)b * SEQ_LEN + c * 128;
  f32x16 acc[2];
#pragma unroll
  for (int nt = 0; nt < 2; ++nt)
#pragma unroll
    for (int i = 0; i < 16; ++i) acc[nt][i] = 0.f;
#pragma unroll 1
  for (int kt = 0; kt < 2; ++kt) {
    __syncthreads();
#pragma unroll
    for (int q = 0; q < 8; ++q) {
      const int f = tid + 256 * q;
      const int key = f >> 5, d4 = (f & 31) * 4;
      const float dec = exp2f((float)(127 - (kt * 64 + key)) * lg);
      const float4 v = ld4(Hc + (tok0 + kt * 64 + key) * CD_IN + 2304 + h * 128 + d4);
      sm->vt[d4][key] = f2bf(v.x * dec); sm->vt[d4 + 1][key] = f2bf(v.y * dec);
      sm->vt[d4 + 2][key] = f2bf(v.z * dec); sm->vt[d4 + 3][key] = f2bf(v.w * dec);
    }
#pragma unroll
    for (int q = 0; q < 4; ++q) {
      const int f = tid + 256 * q;
      const int key = f >> 4, d4 = (f & 15) * 4;
      const float4 v = ld4(Hc + (tok0 + kt * 64 + key) * CD_IN + 2048 + h * 64 + d4);
      sm->kt[d4][key] = f2bf(v.x); sm->kt[d4 + 1][key] = f2bf(v.y); sm->kt[d4 + 2][key] = f2bf(v.z); sm->kt[d4 + 3][key] = f2bf(v.w);
    }
    __syncthreads();
#pragma unroll
    for (int ks = 0; ks < 4; ++ks) {
      const bf16x8 a = *(const bf16x8*)&sm->vt[wave * 32 + r][ks * 16 + hh * 8];
#pragma unroll
      for (int nt = 0; nt < 2; ++nt) {
        const bf16x8 bb = *(const bf16x8*)&sm->kt[nt * 32 + r][ks * 16 + hh * 8];
        acc[nt] = __builtin_amdgcn_mfma_f32_32x32x16_bf16(a, bb, acc[nt], 0, 0, 0);
      }
    }
  }
  float* KV = (float*)(p.ws + OFF_RETKV) + (size_t)item * 64 * 128;
#pragma unroll
  for (int nt = 0; nt < 2; ++nt)
#pragma unroll
    for (int g4 = 0; g4 < 4; ++g4)
      st4(KV + (nt * 32 + r) * 128 + wave * 32 + 8 * g4 + 4 * hh,
          make_float4(acc[nt][4 * g4], acc[nt][4 * g4 + 1], acc[nt][4 * g4 + 2], acc[nt][4 * g4 + 3]));
}
DEV void phase_p11(const Params& p, char* smem) {
  const int total = P11_PREP_ITEMS + P11_KV_ITEMS;
  for (int it = blockIdx.x; it < total; it += gridDim.x) {
    if (it < P11_KV_ITEMS) p11_kv(p, it, smem);
    else p11_prep(p, it - P11_KV_ITEMS, smem);
  }
}

#define P12_SCAN_ITEMS (BATCH * 8 * 4)
#define P12_RET_ITEMS (BATCH * 4 * RET_NC)
#define P12_SCAN_SMEM ((2 * (16 * 5 * 64 + 16 * 16) + 16 * 16) * 4)
#define P12_RET_SMEM ((64 * 72 + 2 * 64 * 68) * 2)
#define P12_SMEM (P12_SCAN_SMEM > P12_RET_SMEM ? P12_SCAN_SMEM : P12_RET_SMEM)
DEV float sum16(float v) {
#ifdef CPU_EMU
  return emu_sum16(v);
#else
  int x;
  x = __builtin_amdgcn_update_dpp(0, __builtin_bit_cast(int, v), 0xB1, 0xF, 0xF, false); v += __builtin_bit_cast(float, x);
  x = __builtin_amdgcn_update_dpp(0, __builtin_bit_cast(int, v), 0x4E, 0xF, 0xF, false); v += __builtin_bit_cast(float, x);
  x = __builtin_amdgcn_update_dpp(0, __builtin_bit_cast(int, v), 0x141, 0xF, 0xF, false); v += __builtin_bit_cast(float, x);
  x = __builtin_amdgcn_update_dpp(0, __builtin_bit_cast(int, v), 0x140, 0xF, 0xF, false); v += __builtin_bit_cast(float, x);
  return v;
#endif
}
DEV void p12_scan(const Params& p, int item, char* smem) {
  const int rq = item & 3, h = (item >> 2) & 7, b = item >> 5;
  const int tid = threadIdx.x, rl = tid >> 4, cg = tid & 15;
  const float* ARR[5] = {(const float*)(p.ws + OFF_RWW), (const float*)(p.ws + OFF_RWK), (const float*)(p.ws + OFF_RWKK),
                         (const float*)(p.ws + OFF_RWA), p.out + (size_t)NTOK * 512};
  const float* RWV = p.out;
  float* Yo = (float*)(p.ws + OFF_MIX);
  float* buf = (float*)smem;
  float* vbuf = buf + 2 * 16 * 5 * 64;
  float* ybuf = vbuf + 2 * 16 * 16;
  float S[4] = {0.f, 0.f, 0.f, 0.f};
  float4 rg[5]; float rv;
  const int lstep = tid >> 4, lc4 = tid & 15;
  auto gload = [&](int c) {
    const size_t o = ((size_t)b * SEQ_LEN + c * 16 + lstep) * 512 + h * 64;
#pragma unroll
    for (int a = 0; a < 5; ++a) rg[a] = ld4(ARR[a] + o + lc4 * 4);
    rv = RWV[o + rq * 16 + lc4];
  };
  auto sstore = [&](int bi) {
#pragma unroll
    for (int a = 0; a < 5; ++a) st4(buf + ((bi * 16 + lstep) * 5 + a) * 64 + lc4 * 4, rg[a]);
    vbuf[(bi * 16 + lstep) * 16 + lc4] = rv;
  };
  __syncthreads();
  gload(0);
  sstore(0);
  __syncthreads();
  const int NCH = SEQ_LEN / 16;
  for (int c = 0; c < NCH; ++c) {
    if (c + 1 < NCH) gload(c + 1);
    const float* cb = buf + (c & 1) * 16 * 5 * 64;
    const float* cv = vbuf + (c & 1) * 16 * 16;
    float4 cw = ld4(cb + 0 * 64 + cg * 4), ck = ld4(cb + 1 * 64 + cg * 4), ckk = ld4(cb + 2 * 64 + cg * 4),
           cka = ld4(cb + 3 * 64 + cg * 4), cr = ld4(cb + 4 * 64 + cg * 4);
    float cvv = cv[rl];
#pragma unroll
    for (int s = 0; s < 16; ++s) {
      const float4 w = cw, k = ck, kk = ckk, ka = cka, r = cr;
      const float v = cvv;
      if (s < 15) {
        cw = ld4(cb + ((s + 1) * 5 + 0) * 64 + cg * 4); ck = ld4(cb + ((s + 1) * 5 + 1) * 64 + cg * 4);
        ckk = ld4(cb + ((s + 1) * 5 + 2) * 64 + cg * 4); cka = ld4(cb + ((s + 1) * 5 + 3) * 64 + cg * 4);
        cr = ld4(cb + ((s + 1) * 5 + 4) * 64 + cg * 4); cvv = cv[(s + 1) * 16 + rl];
      }
      float sa = (S[0] * kk.x + S[1] * kk.y) + (S[2] * kk.z + S[3] * kk.w);
      sa = -sum16(sa);
      S[0] = S[0] * w.x + (sa * ka.x + v * k.x);
      S[1] = S[1] * w.y + (sa * ka.y + v * k.y);
      S[2] = S[2] * w.z + (sa * ka.z + v * k.z);
      S[3] = S[3] * w.w + (sa * ka.w + v * k.w);
      float y = (S[0] * r.x + S[1] * r.y) + (S[2] * r.z + S[3] * r.w);
      y = sum16(y);
      if (cg == 0) ybuf[s * 16 + rl] = y;
      asm volatile("" ::: "memory");
    }
    __syncthreads();
    if (c + 1 < NCH) sstore((c + 1) & 1);
    Yo[((size_t)b * SEQ_LEN + c * 16 + lstep) * 1024 + h * 64 + rq * 16 + lc4] = ybuf[lstep * 16 + lc4];
    __syncthreads();
  }
}
struct RetSmem { unsigned short k[64][72]; unsigned short vt[2][64][68]; };
DEV void p12_ret(const Params& p, int item, char* smem) {
  RetSmem* sm = (RetSmem*)smem;
  const int c = item % RET_NC, h = (item / RET_NC) & 3, b = item / (RET_NC * 4);
  const int tid = threadIdx.x, lane = tid & 63, wave = tid >> 6;
  const int cidx = lane & 31, hh = lane >> 5;
  const int qi = wave * 32 + cidx;
  const float* Hc = (const float*)(p.ws + OFF_H);
  const float lg = ret_log2gamma(h);
  const size_t tok0 = (size_t)b * SEQ_LEN + c * 128;
  bf16x8 qf[4], qfs[4];
  {
    const float* qr = Hc + (tok0 + qi) * CD_IN + 1792 + h * 64;
    const float qs = exp2f((float)(qi + 1) * lg);
#pragma unroll
    for (int ks = 0; ks < 4; ++ks) {
      const float4 a0 = ld4(qr + ks * 16 + hh * 8), a1 = ld4(qr + ks * 16 + hh * 8 + 4);
      const float v[8] = {a0.x, a0.y, a0.z, a0.w, a1.x, a1.y, a1.z, a1.w};
#pragma unroll
      for (int j = 0; j < 8; ++j) { qf[ks][j] = (short)f2bf(v[j]); qfs[ks][j] = (short)f2bf(v[j] * qs); }
    }
  }
  f32x16 o[4], s[2];
#pragma unroll
  for (int mt = 0; mt < 4; ++mt)
#pragma unroll
    for (int i = 0; i < 16; ++i) o[mt][i] = 0.f;
  {
    const float G = exp2f(128.f * lg);
    const float* KV0 = (const float*)(p.ws + OFF_RETKV) + (size_t)((b * 4 + h) * RET_NC) * 64 * 128;
#pragma unroll
    for (int eh = 0; eh < 2; ++eh) {
      __syncthreads();
      for (int w = tid; w < 64 * 64; w += NTHREADS) {
        const int el = w & 63, d = w >> 6;
        const float* src = KV0 + d * 128 + eh * 64 + el;
        float st = 0.f;
        int cc = 0;
        for (; cc + 8 <= c; cc += 8) {
          float e[8];
#pragma unroll
          for (int q = 0; q < 8; ++q) e[q] = src[(size_t)(cc + q) * 64 * 128];
#pragma unroll
          for (int q = 0; q < 8; ++q) st = st * G + e[q];
        }
        for (; cc < c; ++cc) st = st * G + src[(size_t)cc * 64 * 128];
        sm->k[el][d] = f2bf(st);
      }
      __syncthreads();
      qk_tile(sm->k, qfs, s, lane);
#pragma unroll
      for (int i = 0; i < 16; ++i) { o[eh * 2][i] += s[0][i]; o[eh * 2 + 1][i] += s[1][i]; }
    }
  }
#pragma unroll 1
  for (int kt = 0; kt < 2; ++kt) {
    __syncthreads();
    {
      const int row = tid >> 2, seg = tid & 3;
      const float* kr = Hc + (tok0 + kt * 64 + row) * CD_IN + 2048 + h * 64 + seg * 16;
      const float4 a0 = ld4(kr), a1 = ld4(kr + 4), a2 = ld4(kr + 8), a3 = ld4(kr + 12);
      *(uint4*)&sm->k[row][seg * 16] = make_uint4(pk2(a0.x, a0.y), pk2(a0.z, a0.w), pk2(a1.x, a1.y), pk2(a1.z, a1.w));
      *(uint4*)&sm->k[row][seg * 16 + 8] = make_uint4(pk2(a2.x, a2.y), pk2(a2.z, a2.w), pk2(a3.x, a3.y), pk2(a3.z, a3.w));
#pragma unroll
      for (int q = 0; q < 8; ++q) {
        const int f = tid + 256 * q;
        const int key = f >> 5, d4 = (f & 31) * 4;
        const float4 v = ld4(Hc + (tok0 + kt * 64 + key) * CD_IN + 2304 + h * 128 + d4);
        unsigned short(*vt)[68] = sm->vt[d4 >> 6];
        const int dl = d4 & 63;
        vt[dl][key] = f2bf(v.x); vt[dl + 1][key] = f2bf(v.y); vt[dl + 2][key] = f2bf(v.z); vt[dl + 3][key] = f2bf(v.w);
      }
    }
    __syncthreads();
    if (kt * 64 <= wave * 32 + 31) {
      qk_tile(sm->k, qf, s, lane);
#pragma unroll
      for (int ks2 = 0; ks2 < 2; ++ks2)
#pragma unroll
        for (int i = 0; i < 16; ++i) {
          const int kj = kt * 64 + ks2 * 32 + (i & 3) + 8 * (i >> 2) + 4 * hh;
          s[ks2][i] = kj <= qi ? s[ks2][i] * exp2f((float)(qi - kj) * lg) : 0.f;
        }
      pv_tile(sm->vt[0], s, *(f32x16(*)[2])&o[0], lane);
      pv_tile(sm->vt[1], s, *(f32x16(*)[2])&o[2], lane);
    }
  }
  float s1 = 0.f;
#pragma unroll
  for (int mt = 0; mt < 4; ++mt)
#pragma unroll
    for (int i = 0; i < 16; ++i) s1 += o[mt][i];
  s1 += __shfl_xor(s1, 32);
  const float mu = s1 * (1.f / 128.f);
  float s2 = 0.f;
#pragma unroll
  for (int mt = 0; mt < 4; ++mt)
#pragma unroll
    for (int i = 0; i < 16; ++i) { const float d = o[mt][i] - mu; s2 += d * d; }
  s2 += __shfl_xor(s2, 32);
  const float rstd = rsqrtf(s2 * (1.f / 128.f) + 1e-5f);
  float* MIX = (float*)(p.ws + OFF_MIX);
  const float* gate = Hc + (tok0 + qi) * CD_IN + 2816 + h * 128;
  float* dst = MIX + (tok0 + qi) * 1024 + 512 + h * 128;
  const float* lgam = p.in[I_RET_LN_G] + h * 128;
  const float* lbet = p.in[I_RET_LN_B] + h * 128;
#pragma unroll
  for (int mt = 0; mt < 4; ++mt)
#pragma unroll
    for (int g4 = 0; g4 < 4; ++g4) {
      const int dv = mt * 32 + 8 * g4 + 4 * hh;
      const float4 gv = ld4(lgam + dv), bv = ld4(lbet + dv), gt = ld4(gate + dv);
      float4 ov;
      ov.x = siluf_(gt.x) * ((o[mt][4 * g4] - mu) * rstd * gv.x + bv.x);
      ov.y = siluf_(gt.y) * ((o[mt][4 * g4 + 1] - mu) * rstd * gv.y + bv.y);
      ov.z = siluf_(gt.z) * ((o[mt][4 * g4 + 2] - mu) * rstd * gv.z + bv.z);
      ov.w = siluf_(gt.w) * ((o[mt][4 * g4 + 3] - mu) * rstd * gv.w + bv.w);
      st4(dst + dv, ov);
    }
}
DEV void phase_p12(const Params& p, char* smem) {
  const int G = gridDim.x;
  if ((int)blockIdx.x < P12_SCAN_ITEMS && G > P12_SCAN_ITEMS) {
    p12_scan(p, blockIdx.x, smem);
  } else if (G > P12_SCAN_ITEMS) {
    for (int it = blockIdx.x - P12_SCAN_ITEMS; it < P12_RET_ITEMS; it += G - P12_SCAN_ITEMS) p12_ret(p, it, smem);
  } else {
    const int total = P12_SCAN_ITEMS + P12_RET_ITEMS;
    for (int it = blockIdx.x; it < total; it += G) {
      if (it < P12_SCAN_ITEMS) p12_scan(p, it, smem);
      else p12_ret(p, it - P12_SCAN_ITEMS, smem);
    }
  }
}

#define P13_SMEM (8 * 128 * 4)
DEV void phase_p13(const Params& p, char* smem) {
  const int tid = threadIdx.x;
  const float* Hc = (const float*)(p.ws + OFF_H);
  const float* mu = p.in[I_RW_MU];
  float* sl = (float*)smem;
  float* MIX = (float*)(p.ws + OFF_MIX);
  const float* RWK = (const float*)(p.ws + OFF_RWK); const float* RWR = p.out + (size_t)NTOK * 512; const float* RWV = p.out;
  const float* g_up = p.in[I_RW_G_UP];
  for (int it = blockIdx.x; it < NTOK / 8; it += gridDim.x) {
    __syncthreads();
    for (int w = tid; w < 8 * 128; w += NTHREADS) {
      const size_t tok = (size_t)it * 8 + (w >> 7);
      sl[w] = sigmoidf_(shifted(Hc, tok, 1664 + (w & 127), mu));
    }
    __syncthreads();
#pragma unroll
    for (int cc = 0; cc < 2; ++cc) {
      const int c = tid + 256 * cc;
      float ag[8];
#pragma unroll
      for (int tt = 0; tt < 8; ++tt) ag[tt] = 0.f;
      for (int j0 = 0; j0 < 128; j0 += 16) {
        float gu[16];
#pragma unroll
        for (int q = 0; q < 16; ++q) gu[q] = g_up[(j0 + q) * 512 + c];
#pragma unroll
        for (int q4 = 0; q4 < 4; ++q4) {
#pragma unroll
          for (int tt = 0; tt < 8; ++tt) {
            const float4 sg = ld4(sl + tt * 128 + j0 + q4 * 4);
            ag[tt] += sg.x * gu[q4 * 4] + sg.y * gu[q4 * 4 + 1] + sg.z * gu[q4 * 4 + 2] + sg.w * gu[q4 * 4 + 3];
          }
        }
      }
      const float lng = p.in[I_RW_LN_G][c], lnb = p.in[I_RW_LN_B][c], rk = p.in[I_RW_R_K][c];
#pragma unroll
      for (int tt = 0; tt < 8; ++tt) {
        const size_t tok = (size_t)it * 8 + tt;
        const float y = MIX[tok * 1024 + c];
        const float m = wave_sum(y) * (1.f / 64.f);
        const float d = y - m;
        const float var = wave_sum(d * d) * (1.f / 64.f);
        const float yn = d * rsqrtf(var + 64e-5f) * lng + lnb;
        const float r = RWR[tok * 512 + c], k = RWK[tok * 512 + c], v = RWV[tok * 512 + c];
        const float bonus = wave_sum(r * k * rk) * v;
        MIX[tok * 1024 + c] = (yn + bonus) * ag[tt];
      }
    }
  }
}

#define NPHASES 20
#define SMEM_BYTES 67584
DEV void run_phase(const Params& p, int ph, char* smem) {
  switch (ph) {
    case 0: phase_gemm_in<0>(p, smem); break;
    case 1: phase_p1(p, smem); break;
    case 2: phase_p2(p, smem); break;
    case 3: phase_glu(p, smem); break;
    case 4: phase_outproj<0>(p, smem); break;
    case 5: phase_ln_router<0>(p, smem); break;
    case 6: phase_lists_shup<0>(p, smem); break;
    case 7: phase_routed_up<0>(p, smem); break;
    case 8: phase_down<0>(p, smem); break;
    case 9: phase_combine<0>(p, smem); break;
    case 10: phase_gemm_in<1>(p, smem); break;
    case 11: phase_p11(p, smem); break;
    case 12: phase_p12(p, smem); break;
    case 13: phase_p13(p, smem); break;
    case 14: phase_outproj<1>(p, smem); break;
    case 15: phase_ln_router<1>(p, smem); break;
    case 16: phase_lists_shup<1>(p, smem); break;
    case 17: phase_routed_up<1>(p, smem); break;
    case 18: phase_down<1>(p, smem); break;
    case 19: phase_combine<1>(p, smem); break;
    case 20: phase_p1b(p, smem); break;
  }
}
static_assert(P1_SMEM <= SMEM_BYTES, "smem");
static_assert(P1_PREP_SMEM <= SMEM_BYTES, "smem");
static_assert(P2_SMEM <= SMEM_BYTES, "smem");
static_assert(P5_SMEM <= SMEM_BYTES, "smem");
static_assert(P7_SMEM <= SMEM_BYTES, "smem");
static_assert(P12_SMEM <= SMEM_BYTES, "smem");
static_assert(OFF_HS + (size_t)NTOK * 256 * 2 <= OFF_X1, "layout");

#ifndef CPU_EMU
template <int PH>
__global__ void __launch_bounds__(NTHREADS) phase_kernel(Params p) {
  __shared__ __attribute__((aligned(16))) char smem[SMEM_BYTES];
  run_phase(p, PH, smem);
}
template <int PH>
static void launch_phases(const Params& p, hipStream_t stream) {
  phase_kernel<PH><<<dim3(1024), dim3(NTHREADS), 0, stream>>>(p);
  if constexpr (PH + 1 < NPHASES) launch_phases<PH + 1>(p, stream);
}
#if MEGA
DEV void grid_barrier(unsigned* bar, unsigned& epoch) {
  asm volatile("s_waitcnt vmcnt(0)" ::: "memory");
  __syncthreads();
  epoch += 1u;
  if (threadIdx.x == 0) {
    __builtin_amdgcn_fence(__ATOMIC_RELEASE, "agent");
    asm volatile("s_waitcnt vmcnt(0)" ::: "memory");
    __hip_atomic_fetch_add(bar, 1u, __ATOMIC_RELAXED, __HIP_MEMORY_SCOPE_AGENT);
    const unsigned target = epoch * gridDim.x;
    while (__hip_atomic_load(bar, __ATOMIC_RELAXED, __HIP_MEMORY_SCOPE_AGENT) < target) __builtin_amdgcn_s_sleep(1);
    __builtin_amdgcn_fence(__ATOMIC_ACQUIRE, "agent");
    asm volatile("s_waitcnt vmcnt(0)" ::: "memory");
  }
  __syncthreads();
}
__global__ void __launch_bounds__(NTHREADS) mega_kernel(Params p) {
  __shared__ __attribute__((aligned(16))) char smem[SMEM_BYTES];
  unsigned* bar = (unsigned*)(p.ws + OFF_BAR);
  unsigned epoch = 0u;
  if (p.ws == nullptr) cg::this_grid().sync();
  typedef const __attribute__((address_space(4))) Params* KParams;
#define PH_(n) { KParams kp = (KParams)__builtin_amdgcn_kernarg_segment_ptr(); asm volatile("" : "+s"(kp)); const Params lp = *(const Params*)kp; run_phase(lp, n, smem); } grid_barrier(bar, epoch);
  PH_(0) PH_(1) PH_(20) PH_(2) PH_(3) PH_(4) PH_(5) PH_(6) PH_(7) PH_(8) PH_(9)
  PH_(10) PH_(11) PH_(12) PH_(13) PH_(14) PH_(15) PH_(16) PH_(17) PH_(18)
  { KParams kp = (KParams)__builtin_amdgcn_kernarg_segment_ptr(); asm volatile("" : "+s"(kp)); const Params lp = *(const Params*)kp; run_phase(lp, 19, smem); }
}

#endif

extern "C" void kernel_launch(void* const* d_in, const int* in_sizes, int n_in, void* d_out, int out_size, void* d_ws, size_t ws_size,
                              hipStream_t stream) {
  Params p;
  for (int i = 0; i < N_INPUTS; ++i) p.in[i] = (const float*)d_in[i];
  p.out = (float*)d_out;
  p.ws = (char*)d_ws;
#if MEGA
  static int grid_blocks = 0;
  if (!grid_blocks) {
    int dev = 0, cus = 0, per_cu = 0;
    hipGetDevice(&dev);
    hipDeviceGetAttribute(&cus, hipDeviceAttributeMultiprocessorCount, dev);
    hipOccupancyMaxActiveBlocksPerMultiprocessor(&per_cu, mega_kernel, NTHREADS, 0);
    if (per_cu > 2) per_cu = 2;
    grid_blocks = cus * per_cu;
  }
  hipMemsetAsync((char*)d_ws + OFF_BAR, 0, 4096, stream);
  void* args[] = {&p};
  hipError_t e = hipLaunchCooperativeKernel((void*)mega_kernel, dim3(grid_blocks), dim3(NTHREADS), args, 0, stream);
  if (e != hipSuccess) fprintf(stderr, "cooperative launch failed: %s (grid %d)\n", hipGetErrorString(e), grid_blocks);
#else
  launch_phases<0>(p, stream);
#endif
}
#endif
```

```cpp
#ifdef CPU_EMU
#include "emu.h"
#else
#include <hip/hip_runtime.h>
#include <hip/hip_cooperative_groups.h>
#include <cstdio>
namespace cg = cooperative_groups;
#endif
#include <stdint.h>

#ifndef BATCH
#define BATCH 2
#endif
#ifndef SEQ_LEN
#define SEQ_LEN 8192
#endif
#ifndef MEGA
#define MEGA 1
#endif

#define DEV __device__ __forceinline__
#ifdef CPU_EMU
#define TIDX ((int)threadIdx.x)
#define BIDX ((int)blockIdx.x)
#else
__device__ __forceinline__ int tidx_() { int t = __builtin_amdgcn_workitem_id_x(); asm volatile("" : "+v"(t)); return t; }
__device__ __forceinline__ int bidx_() { int b = __builtin_amdgcn_workgroup_id_x(); asm volatile("" : "+s"(b)); return b; }
#define TIDX tidx_()
#define BIDX bidx_()
#endif
#define NTOK (BATCH * SEQ_LEN)
#define DM 1024
#define AB_IN 1816
#define CD_IN 3328
#define NCMP ((SEQ_LEN - 32) / 16 + 1)
#define NBLK (SEQ_LEN / 64)
#define NB_CMP ((NCMP + 63) / 64)
#define S5_NC (SEQ_LEN / 64)
#define RET_NC (SEQ_LEN / 128)
#define ALPHA_F 1.4142135623730951f
#define NTHREADS 256

enum { I_X = 0, I_AB_W_IN, I_AB_W_OUT, I_S5_LAM_RE, I_S5_LAM_IM, I_S5_LOG_DT, I_S5_B_RE, I_S5_B_IM, I_S5_C_RE, I_S5_C_IM,
       I_S5_D, I_S5_W_GLU, I_S5_B_GLU, I_PE_K, I_PE_V, I_CK_W1, I_CK_B1, I_CK_W2, I_CV_W1, I_CV_B1, I_CV_W2,
       I_CD_W_IN, I_CD_W_OUT, I_RW_MU, I_RW_W0, I_RW_W_UP, I_RW_A0, I_RW_A_UP, I_RW_G_UP, I_RW_K_K, I_RW_K_A, I_RW_R_K,
       I_RW_LN_G, I_RW_LN_B, I_RET_LN_G, I_RET_LN_B, I_LN1_G, I_LN1_B, I_LN2_G, I_LN2_B, I_ROUTER, I_MOE_BIAS,
       I_MOE_W1, I_MOE_W3, I_MOE_W2, I_SH_W1, I_SH_W3, I_SH_W2, N_INPUTS };

struct Params {
  const float* in[N_INPUTS];
  float* out;
  char* ws;
};

#define MiB_TOK ((size_t)NTOK * 1024 * 4)
#define OFF_H 0
#define OFF_H2 ((size_t)NTOK * 1792 * 4)
#define OFF_MIX ((size_t)NTOK * 3328 * 4)
#define OFF_X1 (OFF_MIX + MiB_TOK)
#define OFF_X2 (OFF_X1 + MiB_TOK)
#define OFF_R4 (OFF_X2 + MiB_TOK)
#define OFF_R5 (OFF_R4 + MiB_TOK)
#define OFF_Y OFF_H
#define OFF_HS (OFF_H + 4 * MiB_TOK)
#define OFF_FS OFF_X2
#define OFF_HR OFF_R4
#define OFF_X2B OFF_R4
#define OFF_TOPI (OFF_R5)
#define OFF_TOPG (OFF_TOPI + (size_t)NTOK * 8 * 4)
#define OFF_POSOF (OFF_TOPG + (size_t)NTOK * 8 * 4)
#define OFF_CNT (OFF_POSOF + (size_t)NTOK * 8 * 4)
#define OFF_LTOK (OFF_CNT + 1024)
#define OFF_LGATE (OFF_LTOK + (size_t)64 * NTOK * 4)
#define OFF_S5E (OFF_LGATE + (size_t)64 * NTOK * 4)
#define OFF_KCMP (OFF_S5E + (size_t)BATCH * S5_NC * 32 * 64 * 8)
#define OFF_VCMP (OFF_KCMP + (size_t)BATCH * NCMP * 2 * 64 * 4)
#define OFF_RETKV (OFF_VCMP + (size_t)BATCH * NCMP * 2 * 64 * 4)
#define OFF_BAR (OFF_RETKV + (size_t)BATCH * 4 * RET_NC * 64 * 128 * 4)
#define OFF_CMPHID (OFF_BAR + 16384)
#define OFF_CMPC1 (OFF_CMPHID + (size_t)2 * BATCH * 2 * NB_CMP * 64 * 128 * 4)
#define OFF_GLO OFF_LTOK
#define OFF_END (OFF_CMPC1 + 1024)
#define OFF_YGELU OFF_X1
#define OFF_RWW OFF_X1
#define OFF_RWK (OFF_X1 + (size_t)NTOK * 512 * 4)
#define OFF_RWKK OFF_R4
#define OFF_RWA (OFF_R4 + (size_t)NTOK * 512 * 4)

typedef short bf16x8 __attribute__((ext_vector_type(8)));
typedef float f32x16 __attribute__((ext_vector_type(16)));

#ifdef CPU_EMU
#define WAVE_SYNC() emu_wave_bar()
#else
#define WAVE_SYNC() __builtin_amdgcn_wave_barrier()
#endif

DEV float sigmoidf_(float x) { return 1.f / (1.f + __expf(-x)); }
DEV float siluf_(float x) { return x * sigmoidf_(x); }
DEV float geluf_(float x) { float u = 0.7978845608028654f * (x + 0.044715f * x * x * x); return 0.5f * x * (1.f + tanhf(u)); }
DEV unsigned short f2bf(float f) {
  unsigned u = __builtin_bit_cast(unsigned, f);
  u += 0x7FFFu + ((u >> 16) & 1u);
  return (unsigned short)(u >> 16);
}
DEV float bf2f(unsigned short h) { return __builtin_bit_cast(float, ((unsigned)h) << 16); }
DEV float wave_sum(float v) {
#pragma unroll
  for (int m = 32; m >= 1; m >>= 1) v += __shfl_xor(v, m);
  return v;
}
DEV float wave_max(float v) {
#pragma unroll
  for (int m = 32; m >= 1; m >>= 1) v = fmaxf(v, __shfl_xor(v, m));
  return v;
}
DEV float4 ld4(const float* p) { return *(const float4*)p; }
#ifdef CPU_EMU
DEV float fexp2(float x) { return exp2f(x); }
#else
DEV float fexp2(float x) { return __builtin_amdgcn_exp2f(x); }
#endif
DEV void fast_sincos(float x, float* sn, float* cs) {
  const float k = rintf(x * 0.15915494309189535f);
  float r = fmaf(-k, 6.28125f, x);
  r = fmaf(-k, 1.9353071795864769e-3f, r);
  *sn = __sinf(r); *cs = __cosf(r);
}
DEV void st4(float* p, float4 v) { *(float4*)p = v; }

#define GEMM_BM 256
#define GEMM_MI (GEMM_BM / 64)
#define GEMM_SMEM_BYTES ((GEMM_BM + 128) * 72 * 2)
#ifdef CPU_EMU
DEV unsigned pk2(float a, float b) { return (unsigned)f2bf(a) | ((unsigned)f2bf(b) << 16); }
#else
typedef __bf16 hbf16x2 __attribute__((ext_vector_type(2)));
typedef float hf32x2 __attribute__((ext_vector_type(2)));
DEV unsigned pk2(float a, float b) {
  hf32x2 f = {a, b};
  return __builtin_bit_cast(unsigned, __builtin_convertvector(f, hbf16x2));
}
#endif
template <bool ABF, class AROW, class BPTR, class EPI>
DEV void gemm_tile(AROW arow, BPTR bptr, int ldb, int K, EPI epi, char* smem_raw, int akstep = 64) {
  unsigned short(*sA)[72] = (unsigned short(*)[72])smem_raw;
  unsigned short(*sB)[72] = (unsigned short(*)[72])(smem_raw + GEMM_BM * 72 * 2);
  const int tid = TIDX, lane = tid & 63, wave = tid >> 6;
  const int wm = wave >> 1, wn = wave & 1;
#if defined(CPU_EMU) && !defined(EMU_REAL_GEMM)
  for (int mi = 0; mi < GEMM_MI; ++mi)
    for (int r = 0; r < 16; ++r) {
      const int row = wm * (GEMM_BM / 2) + mi * 32 + (r & 3) + 8 * (r >> 2) + 4 * (lane >> 5);
      const int col = wn * 64 + (lane & 31);
      const void* arp = arow(row);
      float v[2] = {0.f, 0.f};
      for (int ni = 0; ni < 2; ++ni) {
        const int cc = col + ni * 32;
        const float* bq = bptr(cc & ~3);
        if (!arp || !bq) continue;
        bq += cc & 3;
        float a = 0.f;
        for (int k = 0; k < K; ++k) {
          const size_t ka = (size_t)(k >> 6) * akstep + (k & 63);
          const float av = ABF ? bf2f(((const unsigned short*)arp)[ka]) : bf2f(f2bf(((const float*)arp)[ka]));
          a += av * bf2f(f2bf(bq[(size_t)k * ldb]));
        }
        v[ni] = a;
      }
      epi(row, col, v[0], v[1]);
    }
  return;
#endif
  const float* ap[4 * GEMM_MI];
  const unsigned short* aph[2 * GEMM_MI];
  if (ABF) {
#pragma unroll
    for (int i = 0; i < 2 * GEMM_MI; ++i) aph[i] = (const unsigned short*)arow((tid >> 3) + 32 * i);
  } else {
#pragma unroll
    for (int i = 0; i < 4 * GEMM_MI; ++i) ap[i] = (const float*)arow((tid >> 4) + 16 * i);
  }
  const float* bp = bptr((tid & 31) * 4);
  const int kgrp = tid >> 5;
  float4 ra0[4 * GEMM_MI], ra1[4 * GEMM_MI];
  uint4 rah0[2 * GEMM_MI], rah1[2 * GEMM_MI];
  float4 rb0[8], rb1[8];
#define GEMM_GLOAD(S, k0_)                                                                                                          \
  {                                                                                                                                 \
    if (ABF) {                                                                                                                      \
      _Pragma("unroll") for (int i = 0; i < 2 * GEMM_MI; ++i) rah##S[i] =                                                           \
          aph[i] ? *(const uint4*)(aph[i] + (size_t)((k0_) >> 6) * akstep + (tid & 7) * 8) : make_uint4(0, 0, 0, 0);                \
    } else {                                                                                                                        \
      _Pragma("unroll") for (int i = 0; i < 4 * GEMM_MI; ++i) ra##S[i] =                                                            \
          ap[i] ? ld4(ap[i] + (size_t)((k0_) >> 6) * akstep + (tid & 15) * 4) : make_float4(0.f, 0.f, 0.f, 0.f);                    \
    }                                                                                                                               \
    _Pragma("unroll") for (int j = 0; j < 8; ++j) rb##S[j] =                                                                        \
        bp ? ld4(bp + (size_t)((k0_) + kgrp * 8 + j) * ldb) : make_float4(0.f, 0.f, 0.f, 0.f);                                      \
  }
#define GEMM_SSTORE(S)                                                                                                              \
  {                                                                                                                                 \
    if (ABF) {                                                                                                                      \
      _Pragma("unroll") for (int i = 0; i < 2 * GEMM_MI; ++i) *(uint4*)&sA[(tid >> 3) + 32 * i][(tid & 7) * 8] = rah##S[i];         \
    } else {                                                                                                                        \
      _Pragma("unroll") for (int i = 0; i < 4 * GEMM_MI; ++i) *(uint2*)&sA[(tid >> 4) + 16 * i][(tid & 15) * 4] =                   \
          make_uint2(pk2(ra##S[i].x, ra##S[i].y), pk2(ra##S[i].z, ra##S[i].w));                                                     \
    }                                                                                                                               \
    const int nb = (tid & 31) * 4;                                                                                                  \
    *(uint4*)&sB[nb + 0][kgrp * 8] = make_uint4(pk2(rb##S[0].x, rb##S[1].x), pk2(rb##S[2].x, rb##S[3].x), pk2(rb##S[4].x, rb##S[5].x), pk2(rb##S[6].x, rb##S[7].x)); \
    *(uint4*)&sB[nb + 1][kgrp * 8] = make_uint4(pk2(rb##S[0].y, rb##S[1].y), pk2(rb##S[2].y, rb##S[3].y), pk2(rb##S[4].y, rb##S[5].y), pk2(rb##S[6].y, rb##S[7].y)); \
    *(uint4*)&sB[nb + 2][kgrp * 8] = make_uint4(pk2(rb##S[0].z, rb##S[1].z), pk2(rb##S[2].z, rb##S[3].z), pk2(rb##S[4].z, rb##S[5].z), pk2(rb##S[6].z, rb##S[7].z)); \
    *(uint4*)&sB[nb + 3][kgrp * 8] = make_uint4(pk2(rb##S[0].w, rb##S[1].w), pk2(rb##S[2].w, rb##S[3].w), pk2(rb##S[4].w, rb##S[5].w), pk2(rb##S[6].w, rb##S[7].w)); \
  }
  f32x16 acc[GEMM_MI][2];
#pragma unroll
  for (int mi = 0; mi < GEMM_MI; ++mi)
#pragma unroll
    for (int ni = 0; ni < 2; ++ni)
#pragma unroll
      for (int r = 0; r < 16; ++r) acc[mi][ni][r] = 0.f;
  auto compute = [&]() {
#pragma unroll
    for (int ks = 0; ks < 4; ++ks) {
      bf16x8 af[GEMM_MI], bfr[2];
#pragma unroll
      for (int mi = 0; mi < GEMM_MI; ++mi) af[mi] = *(const bf16x8*)&sA[wm * (GEMM_BM / 2) + mi * 32 + (lane & 31)][ks * 16 + (lane >> 5) * 8];
#pragma unroll
      for (int ni = 0; ni < 2; ++ni) bfr[ni] = *(const bf16x8*)&sB[wn * 64 + ni * 32 + (lane & 31)][ks * 16 + (lane >> 5) * 8];
#pragma unroll
      for (int mi = 0; mi < GEMM_MI; ++mi)
#pragma unroll
        for (int ni = 0; ni < 2; ++ni) acc[mi][ni] = __builtin_amdgcn_mfma_f32_32x32x16_bf16(af[mi], bfr[ni], acc[mi][ni], 0, 0, 0);
    }
  };
  if (ABF) {
    GEMM_GLOAD(0, 0);
    GEMM_GLOAD(1, 64);
    for (int k0 = 0; k0 < K; k0 += 128) {
      __syncthreads();
      GEMM_SSTORE(0);
      __syncthreads();
      if (k0 + 128 < K) GEMM_GLOAD(0, k0 + 128);
      compute();
      __syncthreads();
      GEMM_SSTORE(1);
      __syncthreads();
      if (k0 + 192 < K) GEMM_GLOAD(1, k0 + 192);
      compute();
    }
  } else {
    GEMM_GLOAD(0, 0);
    for (int k0 = 0; k0 < K; k0 += 64) {
      __syncthreads();
      GEMM_SSTORE(0);
      __syncthreads();
      if (k0 + 64 < K) GEMM_GLOAD(0, k0 + 64);
      compute();
    }
  }
#pragma unroll
  for (int mi = 0; mi < GEMM_MI; ++mi)
#pragma unroll
    for (int r = 0; r < 16; ++r) {
      int row = wm * (GEMM_BM / 2) + mi * 32 + (r & 3) + 8 * (r >> 2) + 4 * (lane >> 5);
      int col = wn * 64 + (lane & 31);
      epi(row, col, acc[mi][0][r], acc[mi][1][r]);
    }
}

template <int LAYER>
DEV void phase_gemm_in(const Params& p, char* smem) {
  const int N = LAYER == 0 ? AB_IN : CD_IN;
  const float* A = LAYER == 0 ? p.in[I_X] : (const float*)(p.ws + OFF_X2);
  const float* B = LAYER == 0 ? p.in[I_AB_W_IN] : p.in[I_CD_W_IN];
  float* C = (float*)(p.ws + OFF_H);
  const int NT = (N + 127) / 128, MT = NTOK / GEMM_BM;
  const int xcd_ = BIDX & 7, lb_ = BIDX >> 3, nb_ = gridDim.x >> 3;
  for (int j_ = lb_; j_ < (MT / 8) * NT; j_ += nb_) {
    const int it = (xcd_ + 8 * (j_ / NT)) * NT + (j_ % NT);
    const int tm = it / NT, tn = it % NT;
    const int m0 = tm * GEMM_BM, n0 = tn * 128;
    gemm_tile<LAYER == 1>(
        [&](int r) { return LAYER == 1 ? (const void*)((const unsigned short*)(p.ws + OFF_X2B) + (size_t)(m0 + r) * DM) : (const void*)(A + (size_t)(m0 + r) * DM); },
        [&](int c) { return (n0 + c < N) ? (B + n0 + c) : (const float*)nullptr; }, N, DM,
        [&](int row, int col, float v0, float v1) {
          const int gm = m0 + row, gc = n0 + col;
          if (LAYER == 1 && gc >= 1792 && gc < 2304) {
            const int i = gc & 63;
            const float pos = (float)(gm % SEQ_LEN);
            const float inv = __expf(-(float)i * (9.210340371976184f / 32.f));
            float sn, cs;
            fast_sincos(pos * inv, &sn, &cs);
            float o0 = v0 * cs - v1 * sn, o1 = v1 * cs + v0 * sn;
            if (gc >= 2048) { o0 *= 0.125f; o1 *= 0.125f; }
            v0 = o0; v1 = o1;
          }
          if (LAYER == 1) {
            float* dstp = gc < 1792 ? C + (size_t)gm * 1792 + gc : (float*)(p.ws + OFF_H2) + (size_t)gm * 1536 + (gc - 1792);
            dstp[0] = v0; dstp[32] = v1;
          } else {
            if (gc < N) C[(size_t)gm * N + gc] = v0;
            if (gc + 32 < N) C[(size_t)gm * N + gc + 32] = v1;
          }
        },
        smem);
  }
}

struct S5Const { float lb_re, lb_im; };
DEV void s5_consts(const Params& p, int g, int pp, float& lb_re, float& lb_im, float (&bbr)[16], float (&bbi)[16]) {
  const float dt = expf(p.in[I_S5_LOG_DT][g]);
  const float lr = p.in[I_S5_LAM_RE][g * 64 + pp], li = p.in[I_S5_LAM_IM][g * 64 + pp];
  const float mag = expf(lr * dt);
  float sn, cs;
  sincosf(li * dt, &sn, &cs);
  lb_re = mag * cs; lb_im = mag * sn;
  const float den = lr * lr + li * li;
  const float f_re = ((lb_re - 1.f) * lr + lb_im * li) / den;
  const float f_im = (lb_im * lr - (lb_re - 1.f) * li) / den;
  const float* br = p.in[I_S5_B_RE] + (size_t)(g * 64 + pp) * 16;
  const float* bi = p.in[I_S5_B_IM] + (size_t)(g * 64 + pp) * 16;
#pragma unroll
  for (int h = 0; h < 16; ++h) {
    bbr[h] = f_re * br[h] - f_im * bi[h];
    bbi[h] = f_re * bi[h] + f_im * br[h];
  }
}

#define OFF_QB OFF_X2
#define OFF_KSB (OFF_QB + (size_t)NTOK * 512 * 2)
#define OFF_KWB (OFF_KSB + (size_t)NTOK * 128 * 2)
#define OFF_VST (OFF_KWB + (size_t)NTOK * 128 * 2)
#define OFF_VWT (OFF_VST + (size_t)NTOK * 128 * 2)
#define OFF_KCB (OFF_VWT + (size_t)NTOK * 128 * 2)
#define OFF_VCT (OFF_KCB + (size_t)BATCH * 2 * NB_CMP * 64 * 64 * 2)
#define NSA_QSCALE (0.125f * 1.4426950408889634f)

#define P1_S5A_ITEMS (BATCH * 32 * S5_NC / 4)
#define P1_CMP_TILES ((NCMP + 7) / 8)
#define P1_CMP_ITEMS (2 * BATCH * 2 * P1_CMP_TILES)
DEV void p1_s5a(const Params& p, int item, char* smem) {
  const int lane = TIDX & 63, wave = TIDX >> 6;
  const int idx = item * 4 + wave;
  const int g = idx & 31, c = (idx >> 5) % S5_NC, b = idx / (32 * S5_NC);
  float lb_re, lb_im, bbr[16], bbi[16];
  s5_consts(p, g, lane, lb_re, lb_im, bbr, bbi);
  const float* H = (const float*)(p.ws + OFF_H);
  float sr = 0.f, si = 0.f;
  float* su = (float*)smem + wave * 64 * 16;
  __syncthreads();
  {
    const float* ur = H + (size_t)(b * SEQ_LEN + c * 64 + lane) * AB_IN + g * 16;
#pragma unroll
    for (int q = 0; q < 4; ++q) st4(su + lane * 16 + q * 4, ld4(ur + q * 4));
  }
  WAVE_SYNC();
  for (int tt = 0; tt < 64; ++tt) {
    const float* u = su + tt * 16;
    float dr = 0.f, di = 0.f;
#pragma unroll
    for (int h4 = 0; h4 < 4; ++h4) {
      const float4 uv = ld4(u + h4 * 4);
      dr += uv.x * bbr[h4 * 4] + uv.y * bbr[h4 * 4 + 1] + uv.z * bbr[h4 * 4 + 2] + uv.w * bbr[h4 * 4 + 3];
      di += uv.x * bbi[h4 * 4] + uv.y * bbi[h4 * 4 + 1] + uv.z * bbi[h4 * 4 + 2] + uv.w * bbi[h4 * 4 + 3];
    }
    const float nr = lb_re * sr - lb_im * si + dr;
    const float ni = lb_re * si + lb_im * sr + di;
    sr = nr; si = ni;
  }
  float2* E = (float2*)(p.ws + OFF_S5E);
  E[((size_t)(b * S5_NC + c) * 32 + g) * 64 + lane] = make_float2(sr, si);
}
#define P1_CMPG_MT ((NCMP + GEMM_BM - 1) / GEMM_BM)
#define P1_CMPG_ITEMS (2 * BATCH * 2 * P1_CMPG_MT)
DEV void p1_cmpgemm(const Params& p, int item, char* smem) {
  const int mt = item % P1_CMPG_MT;
  int r = item / P1_CMPG_MT;
  const int g = r & 1; r >>= 1;
  const int b = r % BATCH; const int which = r / BATCH;
  const float* H = (const float*)(p.ws + OFF_H);
  const float* w1 = which ? p.in[I_CV_W1] : p.in[I_CK_W1];
  const int colbase = (which ? 1152 : 1024) + g * 64;
  float* HID = (float*)(p.ws + OFF_CMPHID) + ((size_t)(which * BATCH + b) * 2 + g) * NB_CMP * 64 * 128;
  const int n0 = mt * GEMM_BM;
  gemm_tile<false>(
      [&](int rr) { return (n0 + rr < NCMP) ? (const void*)(H + ((size_t)b * SEQ_LEN + 16 * (n0 + rr)) * AB_IN + colbase) : (const void*)nullptr; },
      [&](int c) { return w1 + c; }, 128, 2048,
      [&](int row, int col, float v0, float v1) {
        if (n0 + row < NCMP) { HID[(size_t)(n0 + row) * 128 + col] = v0; HID[(size_t)(n0 + row) * 128 + col + 32] = v1; }
      },
      smem, AB_IN);
}
DEV void p1_cmpc1(const Params& p, int which, char* smem) {
  const float* pe = which ? p.in[I_PE_V] : p.in[I_PE_K];
  const float* w1 = which ? p.in[I_CV_W1] : p.in[I_CK_W1];
  float* sPart = (float*)smem;
  const int tid = TIDX, hid = tid & 127, kh = tid >> 7;
  float a = 0.f;
  for (int k = kh * 1024; k < kh * 1024 + 1024; ++k) a += pe[k] * w1[(size_t)k * 128 + hid];
  __syncthreads();
  sPart[tid] = a;
  __syncthreads();
  if (tid < 128) ((float*)(p.ws + OFF_CMPC1))[which * 128 + tid] = sPart[tid] + sPart[tid + 128];
  __syncthreads();
}
DEV void p1_compress(const Params& p, int item, char* smem) {
  const int tile = item % P1_CMP_TILES;
  int r = item / P1_CMP_TILES;
  const int g = r & 1; r >>= 1;
  const int b = r % BATCH; const int which = r / BATCH;
  const int n0 = tile * 8;
  const float* b1 = which ? p.in[I_CV_B1] : p.in[I_CK_B1];
  const float* w2 = which ? p.in[I_CV_W2] : p.in[I_CK_W2];
  const float* C1 = (const float*)(p.ws + OFF_CMPC1) + which * 128;
  const float* HID = (const float*)(p.ws + OFF_CMPHID) + ((size_t)(which * BATCH + b) * 2 + g) * NB_CMP * 64 * 128;
  float* sPart = (float*)smem;
  float* sHid = sPart + 2 * 8 * 128;
  const int tid = TIDX;
  __syncthreads();
  for (int w = tid; w < 8 * 128; w += NTHREADS) {
    const int rr = w >> 7, hid = w & 127;
    const int n = n0 + rr;
    sHid[w] = n < NCMP ? geluf_(HID[(size_t)n * 128 + hid] + C1[hid] + b1[hid]) : 0.f;
  }
  __syncthreads();
  float* sOut = sPart;
  for (int w = tid; w < 8 * 64; w += NTHREADS) {
    const int rr = w >> 6, d = w & 63;
    float a = 0.f;
    for (int hid = 0; hid < 128; ++hid) a += sHid[rr * 128 + hid] * w2[hid * 64 + d];
    sOut[w] = a;
  }
  __syncthreads();
  float* dst = (float*)(p.ws + (which ? OFF_VCMP : OFF_KCMP));
  for (int w = tid; w < 8 * 64; w += NTHREADS) {
    const int rr = w >> 6, d = w & 63;
    const int n = n0 + rr;
    if (n >= NCMP) continue;
    float v = sOut[w];
    if (which == 0 && d < 16) {
      const int i = d & 7;
      const float pos = (float)(n * 16 + 31);
      const float inv = __expf(-(float)i * (13.122363377404328f / 8.f));
      float sn, cs;
      sincosf(pos * inv, &sn, &cs);
      const float x1 = sOut[rr * 64 + i], x2 = sOut[rr * 64 + i + 8];
      v = d < 8 ? x1 * cs - x2 * sn : x2 * cs + x1 * sn;
    }
    dst[((size_t)(b * NCMP + n) * 2 + g) * 64 + d] = v;
    if (which == 0) ((unsigned short*)(p.ws + OFF_KCB))[(((size_t)b * 2 + g) * NB_CMP * 64 + n) * 64 + d] = f2bf(v);
    else ((unsigned short*)(p.ws + OFF_VCT))[((((size_t)b * 2 + g) * NB_CMP + (n >> 6)) * 64 + d) * 64 + (n & 63)] = f2bf(v);
  }
  for (int w = tid; w < 8 * 64; w += NTHREADS) {
    const int rr = w >> 6, d = w & 63;
    const int n = n0 + rr;
    if (n < NCMP || n >= NB_CMP * 64) continue;
    if (which == 0) ((unsigned short*)(p.ws + OFF_KCB))[(((size_t)b * 2 + g) * NB_CMP * 64 + n) * 64 + d] = 0;
    else ((unsigned short*)(p.ws + OFF_VCT))[((((size_t)b * 2 + g) * NB_CMP + (n >> 6)) * 64 + d) * 64 + (n & 63)] = 0;
  }
}
DEV uint4 pack8(const float* v) {
  uint4 r;
  r.x = (unsigned)f2bf(v[0]) | ((unsigned)f2bf(v[1]) << 16);
  r.y = (unsigned)f2bf(v[2]) | ((unsigned)f2bf(v[3]) << 16);
  r.z = (unsigned)f2bf(v[4]) | ((unsigned)f2bf(v[5]) << 16);
  r.w = (unsigned)f2bf(v[6]) | ((unsigned)f2bf(v[7]) << 16);
  return r;
}
#define P1_PREP_ITEMS (NTOK / 64)
#define P1_PREP_SMEM ((64 * 8 * 2 + 64 * 128) * 4)
DEV void p1_prep(const Params& p, int item, char* smem) {
  const int tid = TIDX;
  const int b = item / NBLK, blk = item % NBLK;
  const float* H = (const float*)(p.ws + OFF_H);
  float* sCS = (float*)smem;
  float* sV = sCS + 64 * 8 * 2;
  const size_t tok0 = (size_t)b * SEQ_LEN + blk * 64;
  __syncthreads();
  for (int w = tid; w < 64 * 8; w += NTHREADS) {
    const int tk = w >> 3, i = w & 7;
    const float pos = (float)(blk * 64 + tk);
    const float inv = __expf(-(float)i * (13.122363377404328f / 8.f));
    float sn, cs;
    sincosf(pos * inv, &sn, &cs);
    sCS[w * 2] = cs; sCS[w * 2 + 1] = sn;
  }
  __syncthreads();
  unsigned short* QB = (unsigned short*)(p.ws + OFF_QB);
  unsigned short* KSB = (unsigned short*)(p.ws + OFF_KSB);
  unsigned short* KWB = (unsigned short*)(p.ws + OFF_KWB);
  for (int w = tid; w < 64 * 12 * 8; w += NTHREADS) {
    const int o = w & 7, hd = (w >> 3) % 12, tk = w / 96;
    const int col = hd < 8 ? 512 + hd * 64 : (hd < 10 ? 1280 + (hd - 8) * 64 : 1536 + (hd - 10) * 64);
    const float* x = H + (tok0 + tk) * AB_IN + col;
    float v[8];
    const float4 a0 = ld4(x + o * 8), a1 = ld4(x + o * 8 + 4);
    v[0] = a0.x; v[1] = a0.y; v[2] = a0.z; v[3] = a0.w; v[4] = a1.x; v[5] = a1.y; v[6] = a1.z; v[7] = a1.w;
    if (o < 2) {
      const float4 c0 = ld4(x + (1 - o) * 8), c1 = ld4(x + (1 - o) * 8 + 4);
      const float u[8] = {c0.x, c0.y, c0.z, c0.w, c1.x, c1.y, c1.z, c1.w};
#pragma unroll
      for (int i = 0; i < 8; ++i) {
        const float cs = sCS[(tk * 8 + i) * 2], sn = sCS[(tk * 8 + i) * 2 + 1];
        v[i] = o == 0 ? v[i] * cs - u[i] * sn : v[i] * cs + u[i] * sn;
      }
    }
    if (hd < 8) {
#pragma unroll
      for (int i = 0; i < 8; ++i) v[i] *= NSA_QSCALE;
      *(uint4*)(QB + ((tok0 + tk) * 8 + hd) * 64 + o * 8) = pack8(v);
    } else {
      const int g = (hd - 8) & 1;
      unsigned short* dst = (hd < 10 ? KSB : KWB) + (((size_t)b * 2 + g) * SEQ_LEN + blk * 64 + tk) * 64 + o * 8;
      *(uint4*)dst = pack8(v);
    }
  }
#pragma unroll 1
  for (int which = 0; which < 2; ++which) {
    const int col = which ? 1664 : 1408;
    __syncthreads();
    for (int w = tid; w < 64 * 32; w += NTHREADS) {
      const int tk = w >> 5, c4 = (w & 31) * 4;
      st4(sV + tk * 128 + c4, ld4(H + (tok0 + tk) * AB_IN + col + c4));
    }
    __syncthreads();
    unsigned short* VT = (unsigned short*)(p.ws + (which ? OFF_VWT : OFF_VST));
    for (int w = tid; w < 2 * 64 * 8; w += NTHREADS) {
      const int ko = w & 7, d = (w >> 3) & 63, g = w >> 9;
      float v[8];
#pragma unroll
      for (int i = 0; i < 8; ++i) v[i] = sV[(ko * 8 + i) * 128 + g * 64 + d];
      *(uint4*)(VT + ((((size_t)b * 2 + g) * NBLK + blk) * 64 + d) * 64 + ko * 8) = pack8(v);
    }
  }
}

struct NsaSmem {
  unsigned short k[64][72];
  unsigned short vt[64][68];
  float imp[32][128];
  unsigned selmask[32][4];
  unsigned unionm[4];
  float keyb[4][128];
};
#define P2_NSA_SMEM ((int)sizeof(NsaSmem))
#define NSA_QT (SEQ_LEN / 32)
#define P2_NSA_ITEMS (BATCH * 2 * NSA_QT)

struct TileRegs { uint4 k0, k1, v0, v1; };
DEV void tile_gload(TileRegs& r, const unsigned short* Kg, const unsigned short* Vg, int tid) {
  const int row = tid >> 2, seg = tid & 3;
  r.k0 = *(const uint4*)(Kg + row * 64 + seg * 16);
  r.k1 = *(const uint4*)(Kg + row * 64 + seg * 16 + 8);
  if (Vg) {
    r.v0 = *(const uint4*)(Vg + row * 64 + seg * 16);
    r.v1 = *(const uint4*)(Vg + row * 64 + seg * 16 + 8);
  }
}
DEV void tile_sstore(NsaSmem* sm, const TileRegs& r, bool withV, int tid) {
  const int row = tid >> 2, seg = tid & 3;
  *(uint4*)&sm->k[row][seg * 16] = r.k0;
  *(uint4*)&sm->k[row][seg * 16 + 8] = r.k1;
  if (withV) {
    *(uint2*)&sm->vt[row][seg * 16] = make_uint2(r.v0.x, r.v0.y);
    *(uint2*)&sm->vt[row][seg * 16 + 4] = make_uint2(r.v0.z, r.v0.w);
    *(uint2*)&sm->vt[row][seg * 16 + 8] = make_uint2(r.v1.x, r.v1.y);
    *(uint2*)&sm->vt[row][seg * 16 + 12] = make_uint2(r.v1.z, r.v1.w);
  }
}
DEV void qk_tile(const unsigned short (*ksm)[72], const bf16x8 (&qf)[4], f32x16 (&s)[2], int lane) {
  const int r = lane & 31, hh = lane >> 5;
#pragma unroll
  for (int ks2 = 0; ks2 < 2; ++ks2) {
#pragma unroll
    for (int i = 0; i < 16; ++i) s[ks2][i] = 0.f;
#pragma unroll
    for (int ks = 0; ks < 4; ++ks) {
      const bf16x8 a = *(const bf16x8*)&ksm[ks2 * 32 + r][ks * 16 + hh * 8];
      s[ks2] = __builtin_amdgcn_mfma_f32_32x32x16_bf16(a, qf[ks], s[ks2], 0, 0, 0);
    }
  }
}
DEV void pv_tile(const unsigned short (*vsm)[68], const f32x16 (&pr)[2], f32x16 (&o)[2], int lane) {
  const int r = lane & 31, hh = lane >> 5;
#pragma unroll
  for (int ks2 = 0; ks2 < 2; ++ks2)
#pragma unroll
    for (int s = 0; s < 2; ++s) {
      union { uint4 u; bf16x8 v; } pfu;
      pfu.u = make_uint4(pk2(pr[ks2][8 * s], pr[ks2][8 * s + 1]), pk2(pr[ks2][8 * s + 2], pr[ks2][8 * s + 3]),
                         pk2(pr[ks2][8 * s + 4], pr[ks2][8 * s + 5]), pk2(pr[ks2][8 * s + 6], pr[ks2][8 * s + 7]));
      const bf16x8 pf = pfu.v;
#pragma unroll
      for (int mt = 0; mt < 2; ++mt) {
        const uint2 lo = *(const uint2*)&vsm[mt * 32 + r][ks2 * 32 + 16 * s + 4 * hh];
        const uint2 hi = *(const uint2*)&vsm[mt * 32 + r][ks2 * 32 + 16 * s + 8 + 4 * hh];
        union { uint4 u; bf16x8 v; } au;
        au.u = make_uint4(lo.x, lo.y, hi.x, hi.y);
        const bf16x8 a = au.v;
        o[mt] = __builtin_amdgcn_mfma_f32_32x32x16_bf16(a, pf, o[mt], 0, 0, 0);
      }
    }
}
DEV float quad_sum(float v) {
#ifdef CPU_EMU
  v += __shfl_xor(v, 1); v += __shfl_xor(v, 2); return v;
#else
  int x;
  x = __builtin_amdgcn_update_dpp(0, __builtin_bit_cast(int, v), 0xB1, 0xF, 0xF, false); v += __builtin_bit_cast(float, x);
  x = __builtin_amdgcn_update_dpp(0, __builtin_bit_cast(int, v), 0x4E, 0xF, 0xF, false); v += __builtin_bit_cast(float, x);
  return v;
#endif
}
DEV void softmax_step(f32x16 (&s)[2], float& m, float& l, f32x16 (&o)[2]) {
  float tmax = -INFINITY;
#pragma unroll
  for (int ks2 = 0; ks2 < 2; ++ks2)
#pragma unroll
    for (int i = 0; i < 16; ++i) tmax = fmaxf(tmax, s[ks2][i]);
  tmax = fmaxf(tmax, __shfl_xor(tmax, 32));
  const float mnew = fmaxf(m, tmax);
  const float msafe = mnew == -INFINITY ? 0.f : mnew;
  const float alpha = fexp2(m - msafe);
  float ps = 0.f;
#pragma unroll
  for (int ks2 = 0; ks2 < 2; ++ks2)
#pragma unroll
    for (int i = 0; i < 16; ++i) { s[ks2][i] = fexp2(s[ks2][i] - msafe); ps += s[ks2][i]; }
  l = l * alpha + ps;
#pragma unroll
  for (int mt = 0; mt < 2; ++mt)
#pragma unroll
    for (int i = 0; i < 16; ++i) o[mt][i] *= alpha;
  m = mnew;
}
DEV bool testbit4(unsigned w0, unsigned w1, unsigned w2, unsigned w3, int j) {
  const unsigned lo = j & 32 ? w1 : w0, hi = j & 32 ? w3 : w2;
  const unsigned x = j & 64 ? hi : lo;
  return (x >> (j & 31)) & 1u;
}

DEV void p2_nsa(const Params& p, int item, char* smem) {
  NsaSmem* sm = (NsaSmem*)smem;
  const int tid = TIDX, lane = tid & 63, wave = tid >> 6;
  const int bg = item & 3, b = bg >> 1, g = bg & 1;
  const int qt = NSA_QT - 1 - (item >> 2);
  const int t0 = qt * 32;
  const int c = lane & 31, hh = lane >> 5, tl = c >> 2, h = c & 3;
  const int trow = wave * 8 + tl;
  const int tq = t0 + trow;
  const size_t tok = (size_t)b * SEQ_LEN + tq;
  const int hd = g * 4 + h;
  const float* H = (const float*)(p.ws + OFF_H);
  const unsigned short* QB = (const unsigned short*)(p.ws + OFF_QB);
  const unsigned short* KSB = (const unsigned short*)(p.ws + OFF_KSB) + ((size_t)b * 2 + g) * SEQ_LEN * 64;
  const unsigned short* KWB = (const unsigned short*)(p.ws + OFF_KWB) + ((size_t)b * 2 + g) * SEQ_LEN * 64;
  const unsigned short* VST = (const unsigned short*)(p.ws + OFF_VST) + ((size_t)b * 2 + g) * NBLK * 4096;
  const unsigned short* VWT = (const unsigned short*)(p.ws + OFF_VWT) + ((size_t)b * 2 + g) * NBLK * 4096;
  const unsigned short* KCB = (const unsigned short*)(p.ws + OFF_KCB) + ((size_t)b * 2 + g) * NB_CMP * 4096;
  const unsigned short* VCT = (const unsigned short*)(p.ws + OFF_VCT) + ((size_t)b * 2 + g) * NB_CMP * 4096;
  bf16x8 qf[4];
  {
    const unsigned short* qrow = QB + (tok * 8 + hd) * 64;
#pragma unroll
    for (int ks = 0; ks < 4; ++ks) qf[ks] = *(const bf16x8*)(qrow + ks * 16 + hh * 8);
  }
  const float g0 = sigmoidf_(H[tok * AB_IN + 1792 + hd * 3 + 0]);
  const float g1 = sigmoidf_(H[tok * AB_IN + 1792 + hd * 3 + 1]);
  const float g2 = sigmoidf_(H[tok * AB_IN + 1792 + hd * 3 + 2]);
  f32x16 o[2], s[2];
#pragma unroll
  for (int mt = 0; mt < 2; ++mt)
#pragma unroll
    for (int i = 0; i < 16; ++i) o[mt][i] = 0.f;
  float* mixrow = (float*)(p.ws + OFF_MIX) + tok * 1024 + 512 + hd * 64 + 4 * hh;
  __syncthreads();
  for (int w = tid; w < 32 * 128; w += NTHREADS) (&sm->imp[0][0])[w] = 0.f;
  TileRegs tr;
  tr.k0 = tr.k1 = tr.v0 = tr.v1 = make_uint4(0, 0, 0, 0);
  const int nval = tq >= 31 ? (tq - 31) / 16 + 1 : 0;
  const int nvmax = (t0 + 31 - 31) / 16 + 1;
  const int ktn = (nvmax + 63) / 64;
  float m = -INFINITY, l = 0.f;
  tile_gload(tr, KCB, nullptr, tid);
  for (int kt = 0; kt < ktn; ++kt) {
    __syncthreads();
    tile_sstore(sm, tr, false, tid);
    __syncthreads();
    if (kt + 1 < ktn) tile_gload(tr, KCB + (size_t)(kt + 1) * 4096, nullptr, tid);
    qk_tile(sm->k, qf, s, lane);
    float tmax = -INFINITY;
#pragma unroll
    for (int ks2 = 0; ks2 < 2; ++ks2)
#pragma unroll
      for (int i = 0; i < 16; ++i) {
        const int n = kt * 64 + ks2 * 32 + (i & 3) + 8 * (i >> 2) + 4 * hh;
        s[ks2][i] = n < nval ? s[ks2][i] : -INFINITY;
        tmax = fmaxf(tmax, s[ks2][i]);
      }
    tmax = fmaxf(tmax, __shfl_xor(tmax, 32));
    const float mnew = fmaxf(m, tmax);
    const float msafe = mnew == -INFINITY ? 0.f : mnew;
    float ps = 0.f;
#pragma unroll
    for (int ks2 = 0; ks2 < 2; ++ks2)
#pragma unroll
      for (int i = 0; i < 16; ++i) ps += fexp2(s[ks2][i] - msafe);
    l = l * fexp2(m - msafe) + ps;
    m = mnew;
  }
  {
    const float ltot = l + __shfl_xor(l, 32);
    const float invl = ltot > 0.f ? 1.f / ltot : 0.f;
    const float msafe = m == -INFINITY ? 0.f : m;
    tile_gload(tr, KCB, VCT, tid);
    for (int kt = 0; kt < ktn; ++kt) {
      __syncthreads();
      tile_sstore(sm, tr, true, tid);
      __syncthreads();
      if (kt + 1 < ktn) tile_gload(tr, KCB + (size_t)(kt + 1) * 4096, VCT + (size_t)(kt + 1) * 4096, tid);
      qk_tile(sm->k, qf, s, lane);
#pragma unroll
      for (int ks2 = 0; ks2 < 2; ++ks2)
#pragma unroll
        for (int i = 0; i < 16; ++i) {
          const int n = kt * 64 + ks2 * 32 + (i & 3) + 8 * (i >> 2) + 4 * hh;
          s[ks2][i] = n < nval ? fexp2(s[ks2][i] - msafe) * invl : 0.f;
        }
#pragma unroll
      for (int ks2 = 0; ks2 < 2; ++ks2)
#pragma unroll
        for (int g4 = 0; g4 < 4; ++g4) {
          float A = 2.f * (s[ks2][4 * g4] + s[ks2][4 * g4 + 1] + s[ks2][4 * g4 + 2]) + s[ks2][4 * g4 + 3];
          float Bv = s[ks2][4 * g4 + 3];
          A = quad_sum(A); Bv = quad_sum(Bv);
          const int j = kt * 16 + ks2 * 8 + 2 * g4 + hh;
          if (h == 0 && j < NBLK) sm->imp[trow][j] += A;
          WAVE_SYNC();
          if (h == 0 && j + 1 < NBLK) sm->imp[trow][j + 1] += Bv;
          WAVE_SYNC();
        }
      pv_tile(sm->vt, s, o, lane);
    }
#pragma unroll
    for (int mt = 0; mt < 2; ++mt)
#pragma unroll
      for (int g4 = 0; g4 < 4; ++g4) {
        st4(mixrow + mt * 32 + 8 * g4, make_float4(o[mt][4 * g4] * g0, o[mt][4 * g4 + 1] * g0, o[mt][4 * g4 + 2] * g0, o[mt][4 * g4 + 3] * g0));
        o[mt][4 * g4] = 0.f; o[mt][4 * g4 + 1] = 0.f; o[mt][4 * g4 + 2] = 0.f; o[mt][4 * g4 + 3] = 0.f;
      }
  }
  WAVE_SYNC();
  for (int t8 = 0; t8 < 8; ++t8) {
    const int row = wave * 8 + t8, tt = t0 + row, cur = tt >> 6;
    float kv[2]; bool valid[2];
#pragma unroll
    for (int c2 = 0; c2 < 2; ++c2) {
      const int j = lane + 64 * c2;
      valid[c2] = j < NBLK && j <= cur;
      const bool forced = (j == 0) | (j == cur) | (j == cur - 1);
      kv[c2] = valid[c2] ? (forced ? 1e6f : sm->imp[row][j < NBLK ? j : 0]) : -1.f;
      sm->keyb[wave][j] = kv[c2];
    }
    WAVE_SYNC();
    int rank0 = 0, rank1 = 0;
    const int jlim = cur < NBLK - 1 ? cur : NBLK - 1;
    for (int jj = 0; jj <= jlim; ++jj) {
      const float ov = sm->keyb[wave][jj];
      rank0 += (ov > kv[0] || (ov == kv[0] && jj < lane)) ? 1 : 0;
      rank1 += (ov > kv[1] || (ov == kv[1] && jj < lane + 64)) ? 1 : 0;
    }
    const unsigned long long m0 = __ballot(valid[0] && rank0 < 16);
    const unsigned long long m1 = __ballot(valid[1] && rank1 < 16);
    if (lane == 0) {
      sm->selmask[row][0] = (unsigned)m0; sm->selmask[row][1] = (unsigned)(m0 >> 32);
      sm->selmask[row][2] = (unsigned)m1; sm->selmask[row][3] = (unsigned)(m1 >> 32);
    }
    WAVE_SYNC();
  }
  __syncthreads();
  if (tid < 4) {
    unsigned u = 0;
    for (int r = 0; r < 32; ++r) u |= sm->selmask[r][tid];
    sm->unionm[tid] = u;
  }
  __syncthreads();
  const unsigned um0 = sm->unionm[0], um1 = sm->unionm[1], um2 = sm->unionm[2], um3 = sm->unionm[3];
  const unsigned my0 = sm->selmask[trow][0], my1 = sm->selmask[trow][1], my2 = sm->selmask[trow][2], my3 = sm->selmask[trow][3];
  {
    const int jmax = (t0 + 31) >> 6;
    int j = 0;
    while (j <= jmax && !testbit4(um0, um1, um2, um3, j)) ++j;
    m = -INFINITY; l = 0.f;
    if (j <= jmax) tile_gload(tr, KSB + (size_t)j * 4096, VST + (size_t)j * 4096, tid);
    while (j <= jmax) {
      __syncthreads();
      tile_sstore(sm, tr, true, tid);
      __syncthreads();
      int jn = j + 1;
      while (jn <= jmax && !testbit4(um0, um1, um2, um3, jn)) ++jn;
      if (jn <= jmax) tile_gload(tr, KSB + (size_t)jn * 4096, VST + (size_t)jn * 4096, tid);
      const bool mine = testbit4(my0, my1, my2, my3, j);
      if (__ballot(mine) != 0ull) {
        qk_tile(sm->k, qf, s, lane);
#pragma unroll
        for (int ks2 = 0; ks2 < 2; ++ks2)
#pragma unroll
          for (int i = 0; i < 16; ++i) {
            const int kp = j * 64 + ks2 * 32 + (i & 3) + 8 * (i >> 2) + 4 * hh;
            s[ks2][i] = (mine && kp <= tq) ? s[ks2][i] : -INFINITY;
          }
        softmax_step(s, m, l, o);
        pv_tile(sm->vt, s, o, lane);
      }
      j = jn;
    }
    const float ltot = l + __shfl_xor(l, 32);
    const float sc = ltot > 0.f ? g1 / ltot : 0.f;
#pragma unroll
    for (int mt = 0; mt < 2; ++mt)
#pragma unroll
      for (int g4 = 0; g4 < 4; ++g4) {
        float4 a = ld4(mixrow + mt * 32 + 8 * g4);
        a.x += o[mt][4 * g4] * sc; a.y += o[mt][4 * g4 + 1] * sc; a.z += o[mt][4 * g4 + 2] * sc; a.w += o[mt][4 * g4 + 3] * sc;
        st4(mixrow + mt * 32 + 8 * g4, a);
        o[mt][4 * g4] = 0.f; o[mt][4 * g4 + 1] = 0.f; o[mt][4 * g4 + 2] = 0.f; o[mt][4 * g4 + 3] = 0.f;
      }
  }
  {
    const int jlo = t0 - 511 > 0 ? (t0 - 511) >> 6 : 0, jhi = (t0 + 31) >> 6;
    const int wq0 = t0 + wave * 8;
    m = -INFINITY; l = 0.f;
    tile_gload(tr, KWB + (size_t)jlo * 4096, VWT + (size_t)jlo * 4096, tid);
    for (int j = jlo; j <= jhi; ++j) {
      __syncthreads();
      tile_sstore(sm, tr, true, tid);
      __syncthreads();
      if (j + 1 <= jhi) tile_gload(tr, KWB + (size_t)(j + 1) * 4096, VWT + (size_t)(j + 1) * 4096, tid);
      if (j * 64 <= wq0 + 7 && j * 64 + 63 > wq0 - 512) {
        qk_tile(sm->k, qf, s, lane);
#pragma unroll
        for (int ks2 = 0; ks2 < 2; ++ks2)
#pragma unroll
          for (int i = 0; i < 16; ++i) {
            const int kp = j * 64 + ks2 * 32 + (i & 3) + 8 * (i >> 2) + 4 * hh;
            s[ks2][i] = (kp <= tq && kp > tq - 512) ? s[ks2][i] : -INFINITY;
          }
        softmax_step(s, m, l, o);
        pv_tile(sm->vt, s, o, lane);
      }
    }
    const float ltot = l + __shfl_xor(l, 32);
    const float sc = ltot > 0.f ? g2 / ltot : 0.f;
#pragma unroll
    for (int mt = 0; mt < 2; ++mt)
#pragma unroll
      for (int g4 = 0; g4 < 4; ++g4) {
        float4 a = ld4(mixrow + mt * 32 + 8 * g4);
        a.x += o[mt][4 * g4] * sc; a.y += o[mt][4 * g4 + 1] * sc; a.z += o[mt][4 * g4 + 2] * sc; a.w += o[mt][4 * g4 + 3] * sc;
        st4(mixrow + mt * 32 + 8 * g4, a);
        o[mt][4 * g4] = 0.f; o[mt][4 * g4 + 1] = 0.f; o[mt][4 * g4 + 2] = 0.f; o[mt][4 * g4 + 3] = 0.f;
      }
  }
}

#define P1_SMEM ((2 * 8 * 128 + 8 * 128) * 4)
DEV void phase_p1(const Params& p, char* smem) {
  const int total = P1_CMPG_ITEMS + 2 + P1_S5A_ITEMS + P1_PREP_ITEMS;
  for (int it = BIDX; it < total; it += gridDim.x) {
    if (it < P1_CMPG_ITEMS) p1_cmpgemm(p, it, smem);
    else if (it < P1_CMPG_ITEMS + 2) p1_cmpc1(p, it - P1_CMPG_ITEMS, smem);
    else if (it < P1_CMPG_ITEMS + 2 + P1_PREP_ITEMS) p1_prep(p, it - P1_CMPG_ITEMS - 2, smem);
    else p1_s5a(p, it - P1_CMPG_ITEMS - 2 - P1_PREP_ITEMS, smem);
  }
}
DEV void phase_p1b(const Params& p, char* smem) {
  for (int it = BIDX; it < P1_CMP_ITEMS; it += gridDim.x) p1_compress(p, it, smem);
}

#define P2_S5C_ITEMS (BATCH * 32 * S5_NC / 4)
#define S5C_ROW 132
#define P2_S5C_SMEM (4 * 16 * S5C_ROW * 4 + 4 * 64 * 16 * 4)
DEV void p2_s5c(const Params& p, int item, char* smem) {
  const int lane = TIDX & 63, wave = TIDX >> 6;
  const int idx = item * 4 + wave;
  const int g = idx & 31, c = (idx >> 5) % S5_NC, b = idx / (32 * S5_NC);
  float lb_re, lb_im, bbr[16], bbi[16];
  s5_consts(p, g, lane, lb_re, lb_im, bbr, bbi);
  float ar = lb_re, ai = lb_im;
#pragma unroll
  for (int s = 0; s < 6; ++s) { const float nr = ar * ar - ai * ai, ni = 2.f * ar * ai; ar = nr; ai = ni; }
  const float2* E = (const float2*)(p.ws + OFF_S5E);
  float sr = 0.f, si = 0.f;
  {
    int cc = 0;
    for (; cc + 8 <= c; cc += 8) {
      float2 e[8];
#pragma unroll
      for (int q = 0; q < 8; ++q) e[q] = E[((size_t)(b * S5_NC + cc + q) * 32 + g) * 64 + lane];
#pragma unroll
      for (int q = 0; q < 8; ++q) {
        const float nr = ar * sr - ai * si + e[q].x, ni = ar * si + ai * sr + e[q].y;
        sr = nr; si = ni;
      }
    }
    for (; cc < c; ++cc) {
      const float2 e = E[((size_t)(b * S5_NC + cc) * 32 + g) * 64 + lane];
      const float nr = ar * sr - ai * si + e.x, ni = ar * si + ai * sr + e.y;
      sr = nr; si = ni;
    }
  }
  __syncthreads();
  const float* H = (const float*)(p.ws + OFF_H);
  float* sS = (float*)smem + wave * 16 * S5C_ROW;
  float* su = (float*)smem + 4 * 16 * S5C_ROW + wave * 64 * 16;
  {
    const float* ur = H + (size_t)(b * SEQ_LEN + c * 64 + lane) * AB_IN + g * 16;
#pragma unroll
    for (int q = 0; q < 4; ++q) st4(su + lane * 16 + q * 4, ld4(ur + q * 4));
  }
  __syncthreads();
  const float* cre = p.in[I_S5_C_RE] + (size_t)g * 16 * 64;
  const float* cim = p.in[I_S5_C_IM] + (size_t)g * 16 * 64;
  float* YG = (float*)(p.ws + OFF_YGELU);
  for (int sc = 0; sc < 4; ++sc) {
    for (int tt = 0; tt < 16; ++tt) {
      const float* u = su + (sc * 16 + tt) * 16;
      float dr = 0.f, di = 0.f;
#pragma unroll
      for (int h4 = 0; h4 < 4; ++h4) {
        const float4 uv = ld4(u + h4 * 4);
        dr += uv.x * bbr[h4 * 4] + uv.y * bbr[h4 * 4 + 1] + uv.z * bbr[h4 * 4 + 2] + uv.w * bbr[h4 * 4 + 3];
        di += uv.x * bbi[h4 * 4] + uv.y * bbi[h4 * 4 + 1] + uv.z * bbi[h4 * 4 + 2] + uv.w * bbi[h4 * 4 + 3];
      }
      const float nr = lb_re * sr - lb_im * si + dr, ni = lb_re * si + lb_im * sr + di;
      sr = nr; si = ni;
      sS[tt * S5C_ROW + lane] = sr;
      sS[tt * S5C_ROW + 64 + lane] = si;
    }
    __syncthreads();
    {
      const int tt = lane >> 2, hq = lane & 3;
      float y[4] = {0.f, 0.f, 0.f, 0.f};
#pragma unroll 2
      for (int k = 0; k < 64; k += 4) {
        const float4 vr = ld4(sS + tt * S5C_ROW + k), vi = ld4(sS + tt * S5C_ROW + 64 + k);
#pragma unroll
        for (int hh = 0; hh < 4; ++hh) {
          const float4 cr = ld4(cre + (hq * 4 + hh) * 64 + k), ci = ld4(cim + (hq * 4 + hh) * 64 + k);
          y[hh] += vr.x * cr.x + vr.y * cr.y + vr.z * cr.z + vr.w * cr.w - (vi.x * ci.x + vi.y * ci.y + vi.z * ci.z + vi.w * ci.w);
        }
      }
      const size_t tok = (size_t)(b * SEQ_LEN + c * 64 + sc * 16 + tt);
      const int ch = g * 16 + hq * 4;
      const float4 uv = ld4(H + tok * AB_IN + ch);
      const float4 dv = ld4(p.in[I_S5_D] + ch);
      float4 o;
      o.x = geluf_(y[0] + dv.x * uv.x); o.y = geluf_(y[1] + dv.y * uv.y);
      o.z = geluf_(y[2] + dv.z * uv.z); o.w = geluf_(y[3] + dv.w * uv.w);
      st4(YG + tok * 512 + ch, o);
    }
    __syncthreads();
  }
}

#define P2_SMEM (P2_S5C_SMEM > P2_NSA_SMEM ? P2_S5C_SMEM : P2_NSA_SMEM)
DEV void phase_p2(const Params& p, char* smem) {
  const int G = gridDim.x;
  const int total = P2_NSA_ITEMS + P2_S5C_ITEMS;
  for (int r = 0;; ++r) {
    const int it = r * G + ((r & 1) ? (G - 1 - (int)BIDX) : (int)BIDX);
    if (r * G >= total) break;
    if (it >= total) continue;
    if (it < P2_NSA_ITEMS) p2_nsa(p, it, smem);
    else p2_s5c(p, it - P2_NSA_ITEMS, smem);
  }
}

DEV void phase_glu(const Params& p, char* smem) {
  const float* A = (const float*)(p.ws + OFF_YGELU);
  const float* B = p.in[I_S5_W_GLU];
  const float* bias = p.in[I_S5_B_GLU];
  float* MIX = (float*)(p.ws + OFF_MIX);
  const int NT = 4, MT = NTOK / GEMM_BM;
  const int xcd_ = BIDX & 7, lb_ = BIDX >> 3, nb_ = gridDim.x >> 3;
  for (int j_ = lb_; j_ < (MT / 8) * NT; j_ += nb_) {
    const int it = (xcd_ + 8 * (j_ / NT)) * NT + (j_ % NT);
    const int m0 = (it / NT) * GEMM_BM, n0 = (it % NT) * 128;
    gemm_tile<false>(
        [&](int r) { return (const void*)(A + (size_t)(m0 + r) * 512); },
        [&](int c) { return B + n0 + c; }, 512, 512,
        [&](int row, int col, float v0, float v1) {
          const size_t gm = m0 + row; const int gc = n0 + col;
          const float y0 = A[gm * 512 + gc], y1 = A[gm * 512 + gc + 32];
          MIX[gm * 1024 + gc] = y0 * sigmoidf_(v0 + bias[gc]);
          MIX[gm * 1024 + gc + 32] = y1 * sigmoidf_(v1 + bias[gc + 32]);
        },
        smem);
  }
}

template <int LAYER>
DEV void phase_outproj(const Params& p, char* smem) {
  const float* A = (const float*)(p.ws + OFF_MIX);
  const float* B = LAYER == 0 ? p.in[I_AB_W_OUT] : p.in[I_CD_W_OUT];
  const float* xin = LAYER == 0 ? p.in[I_X] : (const float*)(p.ws + OFF_X2);
  float* PRE = (float*)(p.ws + OFF_H);
  const int NT = 8, MT = NTOK / GEMM_BM;
  const int xcd_ = BIDX & 7, lb_ = BIDX >> 3, nb_ = gridDim.x >> 3;
  for (int j_ = lb_; j_ < (MT / 8) * NT; j_ += nb_) {
    const int it = (xcd_ + 8 * (j_ / NT)) * NT + (j_ % NT);
    const int m0 = (it / NT) * GEMM_BM, n0 = (it % NT) * 128;
    gemm_tile<false>(
        [&](int r) { return (const void*)(A + (size_t)(m0 + r) * 1024); },
        [&](int c) { return B + n0 + c; }, 1024, 1024,
        [&](int row, int col, float v0, float v1) {
          const size_t o = (size_t)(m0 + row) * 1024 + n0 + col;
          PRE[o] = ALPHA_F * xin[o] + v0;
          PRE[o + 32] = ALPHA_F * xin[o + 32] + v1;
        },
        smem);
  }
}

DEV void wave_ln(float (&v)[16], const float* gam, const float* bet, int lane) {
  float s = 0.f;
#pragma unroll
  for (int i = 0; i < 16; ++i) s += v[i];
  const float mu = wave_sum(s) * (1.f / 1024.f);
  float q = 0.f;
#pragma unroll
  for (int i = 0; i < 16; ++i) { const float d = v[i] - mu; q += d * d; }
  const float rstd = rsqrtf(wave_sum(q) * (1.f / 1024.f) + 1e-5f);
#pragma unroll
  for (int i = 0; i < 4; ++i) {
    const float4 gv = ld4(gam + lane * 4 + 256 * i), bv = ld4(bet + lane * 4 + 256 * i);
    v[i * 4 + 0] = (v[i * 4 + 0] - mu) * rstd * gv.x + bv.x;
    v[i * 4 + 1] = (v[i * 4 + 1] - mu) * rstd * gv.y + bv.y;
    v[i * 4 + 2] = (v[i * 4 + 2] - mu) * rstd * gv.z + bv.z;
    v[i * 4 + 3] = (v[i * 4 + 3] - mu) * rstd * gv.w + bv.w;
  }
}

#define LNR_T 4
#define P5_SMEM (4 * (LNR_T * 1024 + 64) * 4)
template <int LAYER>
DEV void phase_ln_router(const Params& p, char* smem) {
  const int lane = TIDX & 63, wave = TIDX >> 6;
  const float* PRE = (const float*)(p.ws + OFF_H);
  float* X1 = (float*)(p.ws + OFF_X1);
  const float* router = p.in[I_ROUTER] + (size_t)LAYER * 1024 * 64;
  const float* bias = p.in[I_MOE_BIAS] + LAYER * 64;
  int* TOPI = (int*)(p.ws + OFF_TOPI);
  float* TOPG = (float*)(p.ws + OFF_TOPG);
  float* xs = (float*)smem + wave * (LNR_T * 1024 + 64);
  float* ms = xs + LNR_T * 1024;
  unsigned short* X1B = (unsigned short*)p.out;
  for (int it = BIDX; it < NTOK / (4 * LNR_T); it += gridDim.x) {
    const size_t tokb = (size_t)it * (4 * LNR_T) + wave * LNR_T;
    WAVE_SYNC();
#pragma unroll 1
    for (int t = 0; t < LNR_T; ++t) {
      const size_t tok = tokb + t;
      float v[16];
#pragma unroll
      for (int i = 0; i < 4; ++i) {
        const float4 a = ld4(PRE + tok * 1024 + lane * 4 + 256 * i);
        v[i * 4] = a.x; v[i * 4 + 1] = a.y; v[i * 4 + 2] = a.z; v[i * 4 + 3] = a.w;
      }
      wave_ln(v, p.in[I_LN1_G] + LAYER * 1024, p.in[I_LN1_B] + LAYER * 1024, lane);
#pragma unroll
      for (int i = 0; i < 4; ++i) {
        const float4 a = make_float4(v[i * 4], v[i * 4 + 1], v[i * 4 + 2], v[i * 4 + 3]);
        st4(X1 + tok * 1024 + lane * 4 + 256 * i, a);
        st4(xs + t * 1024 + lane * 4 + 256 * i, a);
        *(uint2*)(X1B + tok * 1024 + lane * 4 + 256 * i) = make_uint2(pk2(a.x, a.y), pk2(a.z, a.w));
      }
    }
    WAVE_SYNC();
    float lg[LNR_T];
#pragma unroll
    for (int t = 0; t < LNR_T; ++t) lg[t] = 0.f;
    for (int k = 0; k < 1024; k += 4) {
      const float r0 = router[(size_t)k * 64 + lane], r1 = router[(size_t)(k + 1) * 64 + lane],
                  r2 = router[(size_t)(k + 2) * 64 + lane], r3 = router[(size_t)(k + 3) * 64 + lane];
#pragma unroll
      for (int t = 0; t < LNR_T; ++t) {
        const float4 xv = ld4(xs + t * 1024 + k);
        lg[t] += xv.x * r0 + xv.y * r1 + xv.z * r2 + xv.w * r3;
      }
    }
#pragma unroll
    for (int t = 0; t < LNR_T; ++t) {
      const size_t tok = tokb + t;
      const float score = 1.f / (1.f + expf(-lg[t]));
      const float biased = score + bias[lane];
      float m1 = biased; int a1 = lane;
#pragma unroll
      for (int mm = 1; mm <= 4; mm <<= 1) {
        const float ov = __shfl_xor(m1, mm); const int oa = __shfl_xor(a1, mm);
        if (ov > m1 || (ov == m1 && oa < a1)) { m1 = ov; a1 = oa; }
      }
      float m2 = lane == a1 ? -INFINITY : biased;
#pragma unroll
      for (int mm = 1; mm <= 4; mm <<= 1) m2 = fmaxf(m2, __shfl_xor(m2, mm));
      const float gs = m1 + m2;
      const int mygrp = lane >> 3;
      int rank = 0;
#pragma unroll
      for (int gg = 0; gg < 8; ++gg) {
        const float og = __shfl(gs, gg * 8);
        rank += (og > gs || (og == gs && gg < mygrp)) ? 1 : 0;
      }
      const float masked = rank < 4 ? biased : -INFINITY;
      WAVE_SYNC();
      ms[lane] = masked;
      WAVE_SYNC();
      int erank = 0;
      for (int e = 0; e < 64; ++e) {
        const float ov = ms[e];
        erank += (ov > masked || (ov == masked && e < lane)) ? 1 : 0;
      }
      const bool selected = erank < 8;
      const float gsum = wave_sum(selected ? score : 0.f);
      if (selected) {
        TOPI[tok * 8 + erank] = lane;
        TOPG[tok * 8 + erank] = score / gsum * 2.5f;
      }
    }
  }
}

#define P6_SMEM GEMM_SMEM_BYTES
template <int LAYER>
DEV void phase_lists_shup(const Params& p, char* smem) {
  const int tid = TIDX, lane = tid & 63, wave = tid >> 6;
  const int* TOPI = (const int*)(p.ws + OFF_TOPI);
  const float* TOPG = (const float*)(p.ws + OFF_TOPG);
  int* POSOF = (int*)(p.ws + OFF_POSOF);
  int* CNT = (int*)(p.ws + OFF_CNT);
  int* LTOK = (int*)(p.ws + OFF_LTOK);
  float* LGATE = (float*)(p.ws + OFF_LGATE);
  const unsigned short* X1B = (const unsigned short*)p.out;
  unsigned short* HS = (unsigned short*)(p.ws + OFF_HS);
  const float* W1 = p.in[I_SH_W1] + (size_t)LAYER * 1024 * 256;
  const float* W3 = p.in[I_SH_W3] + (size_t)LAYER * 1024 * 256;
  const int MT = NTOK / GEMM_BM;
  int* swave = (int*)smem;
  for (int it = BIDX; it < 64; it += gridDim.x) {
    const int e = it;
    int base = 0;
    for (int t0 = 0; t0 < NTOK; t0 += NTHREADS) {
      const int tok = t0 + tid;
      int slot = -1;
#pragma unroll
      for (int s = 0; s < 8; ++s) if (TOPI[(size_t)tok * 8 + s] == e) slot = s;
      const unsigned long long bal = __ballot(slot >= 0);
      const int pre = __popcll(bal & ((1ull << lane) - 1ull));
      __syncthreads();
      if (lane == 0) swave[wave] = __popcll(bal);
      __syncthreads();
      int woff = 0, tot = 0;
#pragma unroll
      for (int w = 0; w < 4; ++w) { const int c = swave[w]; if (w < wave) woff += c; tot += c; }
      if (slot >= 0) {
        const int pos = base + woff + pre;
        LTOK[(size_t)e * NTOK + pos] = tok;
        LGATE[(size_t)e * NTOK + pos] = TOPG[(size_t)tok * 8 + slot];
        POSOF[(size_t)tok * 8 + slot] = pos;
      }
      base += tot;
    }
    if (tid == 0) CNT[e] = base;
    __syncthreads();
  }
  {
    const int NT = 4;
    const int xcd_ = BIDX & 7, lb_ = BIDX >> 3, nb_ = gridDim.x >> 3;
    for (int j_ = lb_; j_ < (MT / 8) * NT; j_ += nb_) {
      const int m0 = (xcd_ + 8 * (j_ / NT)) * GEMM_BM, ct = j_ % NT;
      gemm_tile<true>(
          [&](int r) { return (const void*)(X1B + (size_t)(m0 + r) * 1024); },
          [&](int c) { return (((c >> 5) & 1) ? W3 : W1) + ct * 64 + (c >> 6) * 32 + (c & 31); }, 256, 1024,
          [&](int row, int col, float v0, float v1) {
            const int lc = ct * 64 + (col >> 6) * 32 + (col & 31);
            HS[(size_t)(m0 + row) * 256 + lc] = f2bf(siluf_(v0) * v1);
          },
          smem);
    }
  }
}

struct ExpMap { int tstart[65]; int rbase[65]; int ltile[9]; };
DEV void build_expmap(const Params& p, ExpMap* em) {
  __syncthreads();
  if (TIDX == 0) {
    const int* CNT = (const int*)(p.ws + OFF_CNT);
    int ts = 0, rb = 0;
    for (int e = 0; e < 64; ++e) {
      em->tstart[e] = ts; em->rbase[e] = rb;
      const int c = CNT[e];
      ts += (c + GEMM_BM - 1) / GEMM_BM; rb += c;
    }
    em->tstart[64] = ts; em->rbase[64] = rb;
    const int x = BIDX & 7;
    int lt = 0;
    for (int k = 0; k < 8; ++k) { em->ltile[k] = lt; lt += em->tstart[x + 8 * k + 1] - em->tstart[x + 8 * k]; }
    em->ltile[8] = lt;
  }
  __syncthreads();
}
DEV void map_expert_tile(const ExpMap* em, int j, int CT, int& e, int& rt, int& ct) {
  const int jr = j / CT; ct = j % CT;
  int k = 0;
  for (int q = 1; q < 8; ++q) if (em->ltile[q] <= jr) k = q;
  e = (BIDX & 7) + 8 * k; rt = jr - em->ltile[k];
}
#define P7_SMEM (GEMM_SMEM_BYTES + 1024)
template <int LAYER>
DEV void phase_routed_up(const Params& p, char* smem) {
  ExpMap* em = (ExpMap*)(smem + GEMM_SMEM_BYTES);
  build_expmap(p, em);
  const int* CNT = (const int*)(p.ws + OFF_CNT);
  const int* LTOK = (const int*)(p.ws + OFF_LTOK);
  const unsigned short* X1B = (const unsigned short*)p.out;
  unsigned short* HR = (unsigned short*)(p.ws + OFF_HR);
  const int lb_ = BIDX >> 3, nb_ = gridDim.x >> 3;
  for (int j_ = lb_; j_ < em->ltile[8] * 4; j_ += nb_) {
    int e, rtl, ct;
    map_expert_tile(em, j_, 4, e, rtl, ct);
    const int r0 = rtl * GEMM_BM;
    const int cnt = CNT[e], rbase = em->rbase[e];
    const float* W1 = p.in[I_MOE_W1] + ((size_t)LAYER * 64 + e) * 1024 * 256;
    const float* W3 = p.in[I_MOE_W3] + ((size_t)LAYER * 64 + e) * 1024 * 256;
    gemm_tile<true>(
        [&](int r) { return (r0 + r < cnt) ? (const void*)(X1B + (size_t)LTOK[(size_t)e * NTOK + r0 + r] * 1024) : (const void*)nullptr; },
        [&](int c) { return (((c >> 5) & 1) ? W3 : W1) + ct * 64 + (c >> 6) * 32 + (c & 31); }, 256, 1024,
        [&](int row, int col, float v0, float v1) {
          if (r0 + row < cnt) {
            const int lc = ct * 64 + (col >> 6) * 32 + (col & 31);
            HR[(size_t)(rbase + r0 + row) * 256 + lc] = f2bf(siluf_(v0) * v1);
          }
        },
        smem);
  }
}

template <int LAYER>
DEV void phase_down(const Params& p, char* smem) {
  ExpMap* em = (ExpMap*)(smem + GEMM_SMEM_BYTES);
  build_expmap(p, em);
  const int* CNT = (const int*)(p.ws + OFF_CNT);
  const float* LGATE = (const float*)(p.ws + OFF_LGATE);
  const unsigned short* HR = (const unsigned short*)(p.ws + OFF_HR);
  const unsigned short* HS = (const unsigned short*)(p.ws + OFF_HS);
  unsigned short* Y = (unsigned short*)(p.ws + OFF_Y);
  float* FS = (float*)(p.ws + OFF_FS);
  const int xcd_ = BIDX & 7, lb_ = BIDX >> 3, nb_ = gridDim.x >> 3;
  for (int j_ = lb_; j_ < em->ltile[8] * 8; j_ += nb_) {
    int e, rtl, ct;
    map_expert_tile(em, j_, 8, e, rtl, ct);
    const int r0 = rtl * GEMM_BM;
    const int cnt = CNT[e], rbase = em->rbase[e];
    const float* W2 = p.in[I_MOE_W2] + ((size_t)LAYER * 64 + e) * 256 * 1024;
    const int n0 = ct * 128;
    gemm_tile<true>(
        [&](int r) { return (r0 + r < cnt) ? (const void*)(HR + (size_t)(rbase + r0 + r) * 256) : (const void*)nullptr; },
        [&](int c) { return W2 + n0 + c; }, 1024, 256,
        [&](int row, int col, float v0, float v1) {
          if (r0 + row < cnt) {
            const float gt = LGATE[(size_t)e * NTOK + r0 + row];
            const size_t o = (size_t)(rbase + r0 + row) * 1024 + n0 + col;
            Y[o] = f2bf(v0 * gt); Y[o + 32] = f2bf(v1 * gt);
          }
        },
        smem);
  }
  {
    const int MT = NTOK / GEMM_BM, NT = 8;
    const float* W2 = p.in[I_SH_W2] + (size_t)LAYER * 256 * 1024;
    for (int j_ = lb_; j_ < (MT / 8) * NT; j_ += nb_) {
      const int m0 = (xcd_ + 8 * (j_ / NT)) * GEMM_BM, n0 = (j_ % NT) * 128;
      gemm_tile<true>(
          [&](int r) { return (const void*)(HS + (size_t)(m0 + r) * 256); },
          [&](int c) { return W2 + n0 + c; }, 1024, 256,
          [&](int row, int col, float v0, float v1) {
            const size_t o = (size_t)(m0 + row) * 1024 + n0 + col;
            FS[o] = v0; FS[o + 32] = v1;
          },
          smem);
    }
  }
}

template <int LAYER>
DEV void phase_combine(const Params& p, char* smem) {
  ExpMap* em = (ExpMap*)smem;
  build_expmap(p, em);
  const int lane = TIDX & 63, wave = TIDX >> 6;
  const float* X1 = (const float*)(p.ws + OFF_X1);
  const float* FS = (const float*)(p.ws + OFF_FS);
  const unsigned short* Y = (const unsigned short*)(p.ws + OFF_Y);
  const int* TOPI = (const int*)(p.ws + OFF_TOPI);
  const int* POSOF = (const int*)(p.ws + OFF_POSOF);
  float* OUT = LAYER == 0 ? (float*)(p.ws + OFF_X2) : p.out;
  for (int it = BIDX; it < NTOK / 4; it += gridDim.x) {
    const size_t tok = (size_t)it * 4 + wave;
    float v[16];
#pragma unroll
    for (int i = 0; i < 4; ++i) {
      const float4 a = ld4(X1 + tok * 1024 + lane * 4 + 256 * i), f = ld4(FS + tok * 1024 + lane * 4 + 256 * i);
      v[i * 4] = ALPHA_F * a.x + f.x; v[i * 4 + 1] = ALPHA_F * a.y + f.y; v[i * 4 + 2] = ALPHA_F * a.z + f.z; v[i * 4 + 3] = ALPHA_F * a.w + f.w;
    }
    size_t rows[8];
#pragma unroll
    for (int s = 0; s < 8; ++s) rows[s] = (size_t)em->rbase[TOPI[tok * 8 + s]] + POSOF[tok * 8 + s];
#pragma unroll
    for (int s0 = 0; s0 < 8; s0 += 4) {
      uint2 yy[4][4];
#pragma unroll
      for (int s = 0; s < 4; ++s)
#pragma unroll
        for (int i = 0; i < 4; ++i) yy[s][i] = *(const uint2*)(Y + rows[s0 + s] * 1024 + lane * 4 + 256 * i);
#pragma unroll
      for (int s = 0; s < 4; ++s)
#pragma unroll
        for (int i = 0; i < 4; ++i) {
          const uint2 y = yy[s][i];
          v[i * 4] += bf2f((unsigned short)(y.x & 0xFFFF)); v[i * 4 + 1] += bf2f((unsigned short)(y.x >> 16));
          v[i * 4 + 2] += bf2f((unsigned short)(y.y & 0xFFFF)); v[i * 4 + 3] += bf2f((unsigned short)(y.y >> 16));
        }
    }
    wave_ln(v, p.in[I_LN2_G] + LAYER * 1024, p.in[I_LN2_B] + LAYER * 1024, lane);
#pragma unroll
    for (int i = 0; i < 4; ++i) st4(OUT + tok * 1024 + lane * 4 + 256 * i, make_float4(v[i * 4], v[i * 4 + 1], v[i * 4 + 2], v[i * 4 + 3]));
    if (LAYER == 0) {
      unsigned short* X2B = (unsigned short*)(p.ws + OFF_X2B);
#pragma unroll
      for (int i = 0; i < 4; ++i) *(uint2*)(X2B + tok * 1024 + lane * 4 + 256 * i) = make_uint2(pk2(v[i * 4], v[i * 4 + 1]), pk2(v[i * 4 + 2], v[i * 4 + 3]));
    }
  }
}

DEV float shifted(const float* Hc, size_t tok, int col, const float* mu) {
  const float cur = Hc[tok * 1792 + col];
  const float prev = (tok % SEQ_LEN) == 0 ? 0.f : Hc[(tok - 1) * 1792 + col];
  return cur + (prev - cur) * mu[col];
}

#define P11_PREP_ITEMS (NTOK / 8)
#define P11_KV_ITEMS (BATCH * 4 * RET_NC)
#define P11_SMEM (8 * 128 * 4)
DEV void p11_prep(const Params& p, int item, char* smem) {
  const int tid = TIDX;
  const float* Hc = (const float*)(p.ws + OFF_H);
  const float* mu = p.in[I_RW_MU];
  float* sl = (float*)smem;
  __syncthreads();
  for (int w = tid; w < 8 * 128; w += NTHREADS) {
    const int tt = w >> 7, j = w & 127;
    const size_t tok = (size_t)item * 8 + tt;
    const float v = shifted(Hc, tok, 1536 + j, mu);
    sl[w] = j < 64 ? tanhf(v) : v;
    ((float*)(p.ws + OFF_GLO))[tok * 128 + j] = sigmoidf_(shifted(Hc, tok, 1664 + j, mu));
  }
  __syncthreads();
  float* RWW = (float*)(p.ws + OFF_RWW); float* RWK = (float*)(p.ws + OFF_RWK);
  float* RWKK = (float*)(p.ws + OFF_RWKK); float* RWA = (float*)(p.ws + OFF_RWA);
  float* RWR = p.out + (size_t)NTOK * 512; float* RWV = p.out;
  const float* w_up = p.in[I_RW_W_UP]; const float* a_up = p.in[I_RW_A_UP];
#pragma unroll
  for (int cc = 0; cc < 2; ++cc) {
    const int c = tid + 256 * cc;
    float aw[8], aa[8];
#pragma unroll
    for (int tt = 0; tt < 8; ++tt) { aw[tt] = 0.f; aa[tt] = 0.f; }
    for (int j0 = 0; j0 < 64; j0 += 16) {
      float wu[16], au[16];
#pragma unroll
      for (int q = 0; q < 16; ++q) { wu[q] = w_up[(j0 + q) * 512 + c]; au[q] = a_up[(j0 + q) * 512 + c]; }
#pragma unroll
      for (int q4 = 0; q4 < 4; ++q4) {
#pragma unroll
        for (int tt = 0; tt < 8; ++tt) {
          const float4 sw = ld4(sl + tt * 128 + j0 + q4 * 4), sa = ld4(sl + tt * 128 + 64 + j0 + q4 * 4);
          aw[tt] += sw.x * wu[q4 * 4] + sw.y * wu[q4 * 4 + 1] + sw.z * wu[q4 * 4 + 2] + sw.w * wu[q4 * 4 + 3];
          aa[tt] += sa.x * au[q4 * 4] + sa.y * au[q4 * 4 + 1] + sa.z * au[q4 * 4 + 2] + sa.w * au[q4 * 4 + 3];
        }
      }
    }
    const float w0 = p.in[I_RW_W0][c], a0 = p.in[I_RW_A0][c], kkc = p.in[I_RW_K_K][c], kac = p.in[I_RW_K_A][c];
#pragma unroll
    for (int tt = 0; tt < 8; ++tt) {
      const size_t tok = (size_t)item * 8 + tt;
      const float lw = w0 + aw[tt];
      const float nl = -lw;
      const float sp = nl > 20.f ? nl : log1pf(expf(nl));
      const float wl = -sp - 0.5f;
      const float decay = expf(-expf(wl));
      const float a = 1.f / (1.f + expf(-(a0 + aa[tt])));
      const float rs = shifted(Hc, tok, c, mu);
      const float ks = shifted(Hc, tok, 512 + c, mu);
      const float vs = shifted(Hc, tok, 1024 + c, mu);
      float kk = ks * kkc;
      const float nrm = sqrtf(wave_sum(kk * kk));
      kk = kk / fmaxf(nrm, 1e-12f);
      RWW[tok * 512 + c] = decay;
      RWK[tok * 512 + c] = ks * (1.f + (a - 1.f) * kac);
      RWKK[tok * 512 + c] = kk;
      RWA[tok * 512 + c] = kk * a;
      RWR[tok * 512 + c] = rs;
      RWV[tok * 512 + c] = vs;
    }
  }
}
DEV float ret_log2gamma(int h) { return log2f(1.f - exp2f(-5.f - (float)h)); }
struct KvSmem { unsigned short vt[128][72]; unsigned short kt[64][72]; };
#define P11_KV_SMEM ((int)sizeof(KvSmem))
DEV void p11_kv(const Params& p, int item, char* smem) {
  KvSmem* sm = (KvSmem*)smem;
  const int c = item % RET_NC, h = (item / RET_NC) & 3, b = item / (RET_NC * 4);
  const int tid = TIDX, lane = tid & 63, wave = tid >> 6;
  const int r = lane & 31, hh = lane >> 5;
  const float* H2 = (const float*)(p.ws + OFF_H2);
  const float lg = ret_log2gamma(h);
  const size_t tok0 = (size_t)b * SEQ_LEN + c * 128;
  f32x16 acc[2];
#pragma unroll
  for (int nt = 0; nt < 2; ++nt)
#pragma unroll
    for (int i = 0; i < 16; ++i) acc[nt][i] = 0.f;
#pragma unroll 1
  for (int kt = 0; kt < 2; ++kt) {
    __syncthreads();
#pragma unroll
    for (int q = 0; q < 8; ++q) {
      const int f = tid + 256 * q;
      const int key = f >> 5, d4 = (f & 31) * 4;
      const float dec = exp2f((float)(127 - (kt * 64 + key)) * lg);
      const float4 v = ld4(H2 + (tok0 + kt * 64 + key) * 1536 + 512 + h * 128 + d4);
      sm->vt[d4][key] = f2bf(v.x * dec); sm->vt[d4 + 1][key] = f2bf(v.y * dec);
      sm->vt[d4 + 2][key] = f2bf(v.z * dec); sm->vt[d4 + 3][key] = f2bf(v.w * dec);
    }
#pragma unroll
    for (int q = 0; q < 4; ++q) {
      const int f = tid + 256 * q;
      const int key = f >> 4, d4 = (f & 15) * 4;
      const float4 v = ld4(H2 + (tok0 + kt * 64 + key) * 1536 + 256 + h * 64 + d4);
      sm->kt[d4][key] = f2bf(v.x); sm->kt[d4 + 1][key] = f2bf(v.y); sm->kt[d4 + 2][key] = f2bf(v.z); sm->kt[d4 + 3][key] = f2bf(v.w);
    }
    __syncthreads();
#pragma unroll
    for (int ks = 0; ks < 4; ++ks) {
      const bf16x8 a = *(const bf16x8*)&sm->vt[wave * 32 + r][ks * 16 + hh * 8];
#pragma unroll
      for (int nt = 0; nt < 2; ++nt) {
        const bf16x8 bb = *(const bf16x8*)&sm->kt[nt * 32 + r][ks * 16 + hh * 8];
        acc[nt] = __builtin_amdgcn_mfma_f32_32x32x16_bf16(a, bb, acc[nt], 0, 0, 0);
      }
    }
  }
  float* KV = (float*)(p.ws + OFF_RETKV) + (size_t)item * 64 * 128;
#pragma unroll
  for (int nt = 0; nt < 2; ++nt)
#pragma unroll
    for (int g4 = 0; g4 < 4; ++g4)
      st4(KV + (nt * 32 + r) * 128 + wave * 32 + 8 * g4 + 4 * hh,
          make_float4(acc[nt][4 * g4], acc[nt][4 * g4 + 1], acc[nt][4 * g4 + 2], acc[nt][4 * g4 + 3]));
}
DEV void phase_p11(const Params& p, char* smem) {
  const int total = P11_PREP_ITEMS + P11_KV_ITEMS;
  for (int it = BIDX; it < total; it += gridDim.x) {
    if (it < P11_KV_ITEMS) p11_kv(p, it, smem);
    else p11_prep(p, it - P11_KV_ITEMS, smem);
  }
}

#define RK_T 32
#define RK_NCH (SEQ_LEN / RK_T)
#define RK_NCHT (BATCH * 8 * RK_NCH)
#define OFF_RKPT OFF_H
#define OFF_RKKT (OFF_RKPT + (size_t)RK_NCHT * 64 * 64 * 2)
#define OFF_RKVT (OFF_RKKT + (size_t)RK_NCHT * 64 * 32 * 2)
#define OFF_RKRT (OFF_RKVT + (size_t)RK_NCHT * 64 * 32 * 2)
#define OFF_RKAT (OFF_RKRT + (size_t)RK_NCHT * 32 * 64 * 2)
#define OFF_RKEND (OFF_RKAT + (size_t)RK_NCHT * 32 * 32 * 2)
#define OFF_RKSC OFF_RWW
static_assert(OFF_RKEND <= OFF_H2, "rk buffers must fit in the H1 region");
#define RKPRE_SMEM (2 * 4 * 32 * 64 * 4)
DEV void rk_precompute(const Params& p, int item, char* smem) {
  const int tid = TIDX, lane = tid & 63, wave = tid >> 6;
  const int half = wave >> 1, role = wave & 1;
  const int ch = item * 2 + half;
  const int c = ch % RK_NCH, bh = ch / RK_NCH, h = bh & 7, b = bh >> 3;
  const size_t tok0 = (size_t)b * SEQ_LEN + (size_t)c * RK_T;
  const float* RWW = (const float*)(p.ws + OFF_RWW); const float* RWK = (const float*)(p.ws + OFF_RWK);
  const float* RWKK = (const float*)(p.ws + OFF_RWKK); const float* RWA = (const float*)(p.ws + OFF_RWA);
  const float* RWR = p.out + (size_t)NTOK * 512; const float* RWV = p.out;
  float* sW = (float*)smem + half * (4 * 32 * 64);
  float* sNK = sW + 32 * 64;
  float* sKA = sNK + 32 * 64;
  float* sR = sKA + 32 * 64;
  __syncthreads();
  for (int w = tid & 127; w < 32 * 16; w += 128) {
    const int t = w >> 4, c4 = (w & 15) * 4;
    const size_t o = (tok0 + t) * 512 + h * 64 + c4;
    st4(sW + t * 64 + c4, ld4(RWW + o));
    const float4 kk = ld4(RWKK + o);
    st4(sNK + t * 64 + c4, make_float4(-kk.x, -kk.y, -kk.z, -kk.w));
    st4(sKA + t * 64 + c4, ld4(RWA + o));
    st4(sR + t * 64 + c4, ld4(RWR + o));
  }
  __syncthreads();
  if (role == 0) {
    float z[64];
#pragma unroll
    for (int j = 0; j < 64; ++j) z[j] = (j == lane) ? 1.f : 0.f;
    for (int t = 0; t < RK_T; ++t) {
      float cacc = 0.f;
#pragma unroll
      for (int j4 = 0; j4 < 16; ++j4) {
        const float4 u = ld4(sNK + t * 64 + j4 * 4);
        cacc += z[j4 * 4] * u.x + z[j4 * 4 + 1] * u.y + z[j4 * 4 + 2] * u.z + z[j4 * 4 + 3] * u.w;
      }
#pragma unroll
      for (int j4 = 0; j4 < 16; ++j4) {
        const float4 w = ld4(sW + t * 64 + j4 * 4), v = ld4(sKA + t * 64 + j4 * 4);
        z[j4 * 4] = z[j4 * 4] * w.x + cacc * v.x; z[j4 * 4 + 1] = z[j4 * 4 + 1] * w.y + cacc * v.y;
        z[j4 * 4 + 2] = z[j4 * 4 + 2] * w.z + cacc * v.z; z[j4 * 4 + 3] = z[j4 * 4 + 3] * w.w + cacc * v.w;
      }
    }
    unsigned short* PT = (unsigned short*)(p.ws + OFF_RKPT) + (size_t)ch * 64 * 64;
#pragma unroll
    for (int j = 0; j < 64; ++j) PT[j * 64 + lane] = f2bf(z[j]);
    unsigned short* VT = (unsigned short*)(p.ws + OFF_RKVT) + (size_t)ch * 64 * 32;
#pragma unroll
    for (int t8 = 0; t8 < 4; ++t8) {
      float v[8];
#pragma unroll
      for (int q8 = 0; q8 < 8; ++q8) v[q8] = RWV[(tok0 + t8 * 8 + q8) * 512 + h * 64 + lane];
      *(uint4*)(VT + lane * 32 + t8 * 8) = make_uint4(pk2(v[0], v[1]), pk2(v[2], v[3]), pk2(v[4], v[5]), pk2(v[6], v[7]));
    }
  } else {
    const bool isA = lane < 32;
    const int me = lane & 31;
    float q[64];
    {
      const float* src = (isA ? RWK : RWR) + (tok0 + me) * 512 + h * 64;
#pragma unroll
      for (int j4 = 0; j4 < 16; ++j4) { const float4 v = ld4(src + j4 * 4); q[j4 * 4] = v.x; q[j4 * 4 + 1] = v.y; q[j4 * 4 + 2] = v.z; q[j4 * 4 + 3] = v.w; }
    }
    const float* Ub = isA ? sNK : sKA;
    const float* Vb = isA ? sKA : sNK;
    unsigned short* AT = (unsigned short*)(p.ws + OFF_RKAT) + (size_t)ch * 32 * 32;
    for (int u = 0; u < RK_T; ++u) {
      const int tt = isA ? u : RK_T - 1 - u;
      const bool upd = isA ? (u > me) : (tt <= me);
      if (upd) {
        float cacc = 0.f;
#pragma unroll
        for (int j4 = 0; j4 < 16; ++j4) {
          const float4 uu = ld4(Ub + tt * 64 + j4 * 4);
          cacc += q[j4 * 4] * uu.x + q[j4 * 4 + 1] * uu.y + q[j4 * 4 + 2] * uu.z + q[j4 * 4 + 3] * uu.w;
        }
#pragma unroll
        for (int j4 = 0; j4 < 16; ++j4) {
          const float4 w = ld4(sW + tt * 64 + j4 * 4), v = ld4(Vb + tt * 64 + j4 * 4);
          q[j4 * 4] = q[j4 * 4] * w.x + cacc * v.x; q[j4 * 4 + 1] = q[j4 * 4 + 1] * w.y + cacc * v.y;
          q[j4 * 4 + 2] = q[j4 * 4 + 2] * w.z + cacc * v.z; q[j4 * 4 + 3] = q[j4 * 4 + 3] * w.w + cacc * v.w;
        }
      }
      if (isA) {
        float av = 0.f;
        if (u >= me) {
#pragma unroll
          for (int j4 = 0; j4 < 16; ++j4) {
            const float4 rr = ld4(sR + u * 64 + j4 * 4);
            av += q[j4 * 4] * rr.x + q[j4 * 4 + 1] * rr.y + q[j4 * 4 + 2] * rr.z + q[j4 * 4 + 3] * rr.w;
          }
        }
        AT[u * 32 + me] = f2bf(av);
      }
    }
    if (isA) {
      unsigned short* KT = (unsigned short*)(p.ws + OFF_RKKT) + (size_t)ch * 64 * 32;
#pragma unroll
      for (int j = 0; j < 64; ++j) KT[j * 32 + me] = f2bf(q[j]);
    } else {
      unsigned short* RT = (unsigned short*)(p.ws + OFF_RKRT) + ((size_t)ch * 32 + me) * 64;
#pragma unroll
      for (int j8 = 0; j8 < 8; ++j8)
        *(uint4*)(RT + j8 * 8) = make_uint4(pk2(q[j8 * 8], q[j8 * 8 + 1]), pk2(q[j8 * 8 + 2], q[j8 * 8 + 3]), pk2(q[j8 * 8 + 4], q[j8 * 8 + 5]), pk2(q[j8 * 8 + 6], q[j8 * 8 + 7]));
    }
  }
}
DEV void phase_rkpre(const Params& p, char* smem) {
  for (int it = BIDX; it < RK_NCHT / 2; it += gridDim.x) rk_precompute(p, it, smem);
}

DEV bf16x8 ld_frag2(const unsigned short* p0, const unsigned short* p1) {
  const uint2 lo = *(const uint2*)p0, hi = *(const uint2*)p1;
  union { uint4 u; bf16x8 v; } x;
  x.u = make_uint4(lo.x, lo.y, hi.x, hi.y);
  return x.v;
}
DEV bf16x8 ld_frag(const unsigned short* p0) {
  union { uint4 u; bf16x8 v; } x;
  x.u = *(const uint4*)p0;
  return x.v;
}
#define RK_PREFETCH(S, c_)                                                                                                      \
  {                                                                                                                             \
    const size_t chp_ = (size_t)bh * RK_NCH + (c_);                                                                             \
    _Pragma("unroll") for (int jt = 0; jt < 2; ++jt) _Pragma("unroll") for (int kb = 0; kb < 2; ++kb)                          \
        _Pragma("unroll") for (int s_ = 0; s_ < 2; ++s_) {                                                                      \
      const unsigned short* q0 = PTb + (chp_ * 64 + jt * 32 + r) * 64 + kb * 32 + 16 * s_ + 4 * hh;                             \
      pa##S[jt][kb][s_] = ld_frag2(q0, q0 + 8);                                                                                 \
    }                                                                                                                           \
    _Pragma("unroll") for (int jt = 0; jt < 2; ++jt) _Pragma("unroll") for (int ks = 0; ks < 2; ++ks)                          \
        ka##S[jt][ks] = ld_frag(KTb + (chp_ * 64 + jt * 32 + r) * 32 + 16 * ks + 8 * hh);                                       \
    _Pragma("unroll") for (int ks = 0; ks < 2; ++ks) vb##S[ks] = ld_frag(VTb + (chp_ * 64 + it * 32 + r) * 32 + 16 * ks + 8 * hh); \
  }
#define RK_STEP(S, c_)                                                                                                          \
  {                                                                                                                             \
    const size_t ch_ = (size_t)bh * RK_NCH + (c_);                                                                              \
    _Pragma("unroll") for (int kb = 0; kb < 2; ++kb) _Pragma("unroll") for (int g4 = 0; g4 < 4; ++g4)                          \
        *(uint2*)(SCb + (ch_ * 64 + it * 32 + r) * 64 + kb * 32 + 8 * g4 + 4 * hh) =                                            \
            make_uint2(pk2(X[kb][4 * g4], X[kb][4 * g4 + 1]), pk2(X[kb][4 * g4 + 2], X[kb][4 * g4 + 3]));                       \
    bf16x8 bh_[2][2], bl_[2][2];                                                                                                \
    _Pragma("unroll") for (int kb = 0; kb < 2; ++kb) _Pragma("unroll") for (int s_ = 0; s_ < 2; ++s_) {                        \
      union { uint4 u; bf16x8 v; } hi, lo;                                                                                      \
      unsigned hw[4], lw[4];                                                                                                    \
      _Pragma("unroll") for (int q2 = 0; q2 < 4; ++q2) {                                                                        \
        const float x0 = X[kb][8 * s_ + 2 * q2], x1 = X[kb][8 * s_ + 2 * q2 + 1];                                               \
        const unsigned hp = pk2(x0, x1);                                                                                        \
        hw[q2] = hp;                                                                                                            \
        lw[q2] = pk2(x0 - bf2f((unsigned short)(hp & 0xFFFF)), x1 - bf2f((unsigned short)(hp >> 16)));                          \
      }                                                                                                                         \
      hi.u = make_uint4(hw[0], hw[1], hw[2], hw[3]); lo.u = make_uint4(lw[0], lw[1], lw[2], lw[3]);                             \
      bh_[kb][s_] = hi.v; bl_[kb][s_] = lo.v;                                                                                   \
    }                                                                                                                           \
    f32x16 acc[2];                                                                                                              \
    _Pragma("unroll") for (int jt = 0; jt < 2; ++jt) {                                                                          \
      _Pragma("unroll") for (int i = 0; i < 16; ++i) acc[jt][i] = 0.f;                                                          \
      _Pragma("unroll") for (int kb = 0; kb < 2; ++kb) _Pragma("unroll") for (int s_ = 0; s_ < 2; ++s_) {                      \
        acc[jt] = __builtin_amdgcn_mfma_f32_32x32x16_bf16(pa##S[jt][kb][s_], bh_[kb][s_], acc[jt], 0, 0, 0);                    \
        acc[jt] = __builtin_amdgcn_mfma_f32_32x32x16_bf16(pa##S[jt][kb][s_], bl_[kb][s_], acc[jt], 0, 0, 0);                    \
      }                                                                                                                         \
      _Pragma("unroll") for (int ks = 0; ks < 2; ++ks)                                                                          \
          acc[jt] = __builtin_amdgcn_mfma_f32_32x32x16_bf16(ka##S[jt][ks], vb##S[ks], acc[jt], 0, 0, 0);                        \
    }                                                                                                                           \
    if ((c_) + 3 < RK_NCH) RK_PREFETCH(S, (c_) + 3);                                                                            \
    X[0] = acc[0]; X[1] = acc[1];                                                                                               \
  }
DEV void rk_chain(const Params& p, int bh) {
  const int tid = TIDX, lane = tid & 63, wave = tid >> 6;
  if (wave >= 2) return;
  const int r = lane & 31, hh = lane >> 5, it = wave;
  const unsigned short* PTb = (const unsigned short*)(p.ws + OFF_RKPT);
  const unsigned short* KTb = (const unsigned short*)(p.ws + OFF_RKKT);
  const unsigned short* VTb = (const unsigned short*)(p.ws + OFF_RKVT);
  unsigned short* SCb = (unsigned short*)(p.ws + OFF_RKSC);
  f32x16 X[2];
#pragma unroll
  for (int kb = 0; kb < 2; ++kb)
#pragma unroll
    for (int i = 0; i < 16; ++i) X[kb][i] = 0.f;
  bf16x8 paA[2][2][2], kaA[2][2], vbA[2], paB[2][2][2], kaB[2][2], vbB[2], paC[2][2][2], kaC[2][2], vbC[2];
  RK_PREFETCH(A, 0);
  RK_PREFETCH(B, 1);
  RK_PREFETCH(C, 2);
  for (int c = 0; c < RK_NCH; c += 3) {
    RK_STEP(A, c);
    if (c + 1 < RK_NCH) RK_STEP(B, c + 1);
    if (c + 2 < RK_NCH) RK_STEP(C, c + 2);
  }
}
DEV void rk_output(const Params& p, int item) {
  const int tid = TIDX, lane = tid & 63, wave = tid >> 6;
  const int ch = item * 4 + wave;
  const int c = ch % RK_NCH, bhh = ch / RK_NCH, h = bhh & 7, b = bhh >> 3;
  const int r = lane & 31, hh = lane >> 5;
  const unsigned short* RT = (const unsigned short*)(p.ws + OFF_RKRT) + (size_t)ch * 32 * 64;
  const unsigned short* AT = (const unsigned short*)(p.ws + OFF_RKAT) + (size_t)ch * 32 * 32;
  const unsigned short* VT = (const unsigned short*)(p.ws + OFF_RKVT) + (size_t)ch * 64 * 32;
  const unsigned short* SC = (const unsigned short*)(p.ws + OFF_RKSC) + (size_t)ch * 64 * 64;
  f32x16 acc[2];
#pragma unroll
  for (int i2 = 0; i2 < 2; ++i2)
#pragma unroll
    for (int i = 0; i < 16; ++i) acc[i2][i] = 0.f;
#pragma unroll
  for (int ks = 0; ks < 4; ++ks) {
    const bf16x8 a = ld_frag(RT + r * 64 + 16 * ks + 8 * hh);
#pragma unroll
    for (int i2 = 0; i2 < 2; ++i2) acc[i2] = __builtin_amdgcn_mfma_f32_32x32x16_bf16(a, ld_frag(SC + (i2 * 32 + r) * 64 + 16 * ks + 8 * hh), acc[i2], 0, 0, 0);
  }
#pragma unroll
  for (int ks = 0; ks < 2; ++ks) {
    const bf16x8 a = ld_frag(AT + r * 32 + 16 * ks + 8 * hh);
#pragma unroll
    for (int i2 = 0; i2 < 2; ++i2) acc[i2] = __builtin_amdgcn_mfma_f32_32x32x16_bf16(a, ld_frag(VT + (i2 * 32 + r) * 32 + 16 * ks + 8 * hh), acc[i2], 0, 0, 0);
  }
  float* Yo = (float*)(p.ws + OFF_MIX);
  const size_t tok0 = (size_t)b * SEQ_LEN + (size_t)c * RK_T;
#pragma unroll
  for (int i2 = 0; i2 < 2; ++i2)
#pragma unroll
    for (int i = 0; i < 16; ++i) {
      const int t = (i & 3) + 8 * (i >> 2) + 4 * hh;
      Yo[(tok0 + t) * 1024 + h * 64 + i2 * 32 + r] = acc[i2][i];
    }
}
DEV void phase_rkout(const Params& p, char* smem) {
  for (int it = BIDX; it < RK_NCHT / 4; it += gridDim.x) rk_output(p, it);
}

#define P12_SCAN_ITEMS (BATCH * 8 * 4)
#define P12_RET_ITEMS (BATCH * 4 * RET_NC)
#define P12_SCAN_SMEM ((2 * (16 * 5 * 64 + 16 * 16) + 16 * 16) * 4)
#define P12_RET_SMEM ((64 * 72 + 2 * 64 * 68) * 2)
#define P12_SMEM (P12_SCAN_SMEM > P12_RET_SMEM ? P12_SCAN_SMEM : P12_RET_SMEM)
DEV float sum16(float v) {
#ifdef CPU_EMU
  return emu_sum16(v);
#else
  int x;
  x = __builtin_amdgcn_update_dpp(0, __builtin_bit_cast(int, v), 0xB1, 0xF, 0xF, false); v += __builtin_bit_cast(float, x);
  x = __builtin_amdgcn_update_dpp(0, __builtin_bit_cast(int, v), 0x4E, 0xF, 0xF, false); v += __builtin_bit_cast(float, x);
  x = __builtin_amdgcn_update_dpp(0, __builtin_bit_cast(int, v), 0x141, 0xF, 0xF, false); v += __builtin_bit_cast(float, x);
  x = __builtin_amdgcn_update_dpp(0, __builtin_bit_cast(int, v), 0x140, 0xF, 0xF, false); v += __builtin_bit_cast(float, x);
  return v;
#endif
}
DEV void p12_scan(const Params& p, int item, char* smem) {
  const int rq = item & 3, h = (item >> 2) & 7, b = item >> 5;
  const int tid = TIDX, rl = tid >> 4, cg = tid & 15;
  const float* ARR[5] = {(const float*)(p.ws + OFF_RWW), (const float*)(p.ws + OFF_RWK), (const float*)(p.ws + OFF_RWKK),
                         (const float*)(p.ws + OFF_RWA), p.out + (size_t)NTOK * 512};
  const float* RWV = p.out;
  float* Yo = (float*)(p.ws + OFF_MIX);
  float* buf = (float*)smem;
  float* vbuf = buf + 2 * 16 * 5 * 64;
  float* ybuf = vbuf + 2 * 16 * 16;
  float S[4] = {0.f, 0.f, 0.f, 0.f};
  float4 rg[5]; float rv;
  const int lstep = tid >> 4, lc4 = tid & 15;
  auto gload = [&](int c) {
    const size_t o = ((size_t)b * SEQ_LEN + c * 16 + lstep) * 512 + h * 64;
#pragma unroll
    for (int a = 0; a < 5; ++a) rg[a] = ld4(ARR[a] + o + lc4 * 4);
    rv = RWV[o + rq * 16 + lc4];
  };
  auto sstore = [&](int bi) {
#pragma unroll
    for (int a = 0; a < 5; ++a) st4(buf + ((bi * 16 + lstep) * 5 + a) * 64 + lc4 * 4, rg[a]);
    vbuf[(bi * 16 + lstep) * 16 + lc4] = rv;
  };
  __syncthreads();
  gload(0);
  sstore(0);
  __syncthreads();
  const int NCH = SEQ_LEN / 16;
  for (int c = 0; c < NCH; ++c) {
    if (c + 1 < NCH) gload(c + 1);
    const float* cb = buf + (c & 1) * 16 * 5 * 64;
    const float* cv = vbuf + (c & 1) * 16 * 16;
    float4 cw = ld4(cb + 0 * 64 + cg * 4), ck = ld4(cb + 1 * 64 + cg * 4), ckk = ld4(cb + 2 * 64 + cg * 4),
           cka = ld4(cb + 3 * 64 + cg * 4), cr = ld4(cb + 4 * 64 + cg * 4);
    float cvv = cv[rl];
#pragma unroll
    for (int s = 0; s < 16; ++s) {
      const float4 w = cw, k = ck, kk = ckk, ka = cka, r = cr;
      const float v = cvv;
      if (s < 15) {
        cw = ld4(cb + ((s + 1) * 5 + 0) * 64 + cg * 4); ck = ld4(cb + ((s + 1) * 5 + 1) * 64 + cg * 4);
        ckk = ld4(cb + ((s + 1) * 5 + 2) * 64 + cg * 4); cka = ld4(cb + ((s + 1) * 5 + 3) * 64 + cg * 4);
        cr = ld4(cb + ((s + 1) * 5 + 4) * 64 + cg * 4); cvv = cv[(s + 1) * 16 + rl];
      }
      float sa = (S[0] * kk.x + S[1] * kk.y) + (S[2] * kk.z + S[3] * kk.w);
      sa = -sum16(sa);
      S[0] = S[0] * w.x + (sa * ka.x + v * k.x);
      S[1] = S[1] * w.y + (sa * ka.y + v * k.y);
      S[2] = S[2] * w.z + (sa * ka.z + v * k.z);
      S[3] = S[3] * w.w + (sa * ka.w + v * k.w);
      float y = (S[0] * r.x + S[1] * r.y) + (S[2] * r.z + S[3] * r.w);
      y = sum16(y);
      if (cg == 0) ybuf[s * 16 + rl] = y;
      asm volatile("" ::: "memory");
    }
    __syncthreads();
    if (c + 1 < NCH) sstore((c + 1) & 1);
    Yo[((size_t)b * SEQ_LEN + c * 16 + lstep) * 1024 + h * 64 + rq * 16 + lc4] = ybuf[lstep * 16 + lc4];
    __syncthreads();
  }
}
struct RetSmem { unsigned short k[64][72]; unsigned short vt[2][64][68]; };
DEV void p12_ret(const Params& p, int item, char* smem) {
  RetSmem* sm = (RetSmem*)smem;
  const int c = item % RET_NC, h = (item / RET_NC) & 3, b = item / (RET_NC * 4);
  const int tid = TIDX, lane = tid & 63, wave = tid >> 6;
  const int cidx = lane & 31, hh = lane >> 5;
  const int qi = wave * 32 + cidx;
  const float* H2 = (const float*)(p.ws + OFF_H2);
  const float lg = ret_log2gamma(h);
  const size_t tok0 = (size_t)b * SEQ_LEN + c * 128;
  bf16x8 qf[4], qfs[4];
  {
    const float* qr = H2 + (tok0 + qi) * 1536 + h * 64;
    const float qs = exp2f((float)(qi + 1) * lg);
#pragma unroll
    for (int ks = 0; ks < 4; ++ks) {
      const float4 a0 = ld4(qr + ks * 16 + hh * 8), a1 = ld4(qr + ks * 16 + hh * 8 + 4);
      const float v[8] = {a0.x, a0.y, a0.z, a0.w, a1.x, a1.y, a1.z, a1.w};
#pragma unroll
      for (int j = 0; j < 8; ++j) { qf[ks][j] = (short)f2bf(v[j]); qfs[ks][j] = (short)f2bf(v[j] * qs); }
    }
  }
  f32x16 o[4], s[2];
#pragma unroll
  for (int mt = 0; mt < 4; ++mt)
#pragma unroll
    for (int i = 0; i < 16; ++i) o[mt][i] = 0.f;
  {
    const float G = exp2f(128.f * lg);
    const float* KV0 = (const float*)(p.ws + OFF_RETKV) + (size_t)((b * 4 + h) * RET_NC) * 64 * 128;
#pragma unroll
    for (int eh = 0; eh < 2; ++eh) {
      __syncthreads();
      for (int w = tid; w < 64 * 64; w += NTHREADS) {
        const int el = w & 63, d = w >> 6;
        const float* src = KV0 + d * 128 + eh * 64 + el;
        float st = 0.f;
        int cc = 0;
        for (; cc + 8 <= c; cc += 8) {
          float e[8];
#pragma unroll
          for (int q = 0; q < 8; ++q) e[q] = src[(size_t)(cc + q) * 64 * 128];
#pragma unroll
          for (int q = 0; q < 8; ++q) st = st * G + e[q];
        }
        for (; cc < c; ++cc) st = st * G + src[(size_t)cc * 64 * 128];
        sm->k[el][d] = f2bf(st);
      }
      __syncthreads();
      qk_tile(sm->k, qfs, s, lane);
#pragma unroll
      for (int i = 0; i < 16; ++i) { o[eh * 2][i] += s[0][i]; o[eh * 2 + 1][i] += s[1][i]; }
    }
  }
#pragma unroll 1
  for (int kt = 0; kt < 2; ++kt) {
    __syncthreads();
    {
      const int row = tid >> 2, seg = tid & 3;
      const float* kr = H2 + (tok0 + kt * 64 + row) * 1536 + 256 + h * 64 + seg * 16;
      const float4 a0 = ld4(kr), a1 = ld4(kr + 4), a2 = ld4(kr + 8), a3 = ld4(kr + 12);
      *(uint4*)&sm->k[row][seg * 16] = make_uint4(pk2(a0.x, a0.y), pk2(a0.z, a0.w), pk2(a1.x, a1.y), pk2(a1.z, a1.w));
      *(uint4*)&sm->k[row][seg * 16 + 8] = make_uint4(pk2(a2.x, a2.y), pk2(a2.z, a2.w), pk2(a3.x, a3.y), pk2(a3.z, a3.w));
#pragma unroll
      for (int q = 0; q < 8; ++q) {
        const int f = tid + 256 * q;
        const int key = f >> 5, d4 = (f & 31) * 4;
        const float4 v = ld4(H2 + (tok0 + kt * 64 + key) * 1536 + 512 + h * 128 + d4);
        unsigned short(*vt)[68] = sm->vt[d4 >> 6];
        const int dl = d4 & 63;
        vt[dl][key] = f2bf(v.x); vt[dl + 1][key] = f2bf(v.y); vt[dl + 2][key] = f2bf(v.z); vt[dl + 3][key] = f2bf(v.w);
      }
    }
    __syncthreads();
    if (kt * 64 <= wave * 32 + 31) {
      qk_tile(sm->k, qf, s, lane);
#pragma unroll
      for (int ks2 = 0; ks2 < 2; ++ks2)
#pragma unroll
        for (int i = 0; i < 16; ++i) {
          const int kj = kt * 64 + ks2 * 32 + (i & 3) + 8 * (i >> 2) + 4 * hh;
          s[ks2][i] = kj <= qi ? s[ks2][i] * exp2f((float)(qi - kj) * lg) : 0.f;
        }
      pv_tile(sm->vt[0], s, *(f32x16(*)[2])&o[0], lane);
      pv_tile(sm->vt[1], s, *(f32x16(*)[2])&o[2], lane);
    }
  }
  float s1 = 0.f;
#pragma unroll
  for (int mt = 0; mt < 4; ++mt)
#pragma unroll
    for (int i = 0; i < 16; ++i) s1 += o[mt][i];
  s1 += __shfl_xor(s1, 32);
  const float mu = s1 * (1.f / 128.f);
  float s2 = 0.f;
#pragma unroll
  for (int mt = 0; mt < 4; ++mt)
#pragma unroll
    for (int i = 0; i < 16; ++i) { const float d = o[mt][i] - mu; s2 += d * d; }
  s2 += __shfl_xor(s2, 32);
  const float rstd = rsqrtf(s2 * (1.f / 128.f) + 1e-5f);
  float* MIX = (float*)(p.ws + OFF_MIX);
  const float* gate = H2 + (tok0 + qi) * 1536 + 1024 + h * 128;
  float* dst = MIX + (tok0 + qi) * 1024 + 512 + h * 128;
  const float* lgam = p.in[I_RET_LN_G] + h * 128;
  const float* lbet = p.in[I_RET_LN_B] + h * 128;
#pragma unroll
  for (int mt = 0; mt < 4; ++mt)
#pragma unroll
    for (int g4 = 0; g4 < 4; ++g4) {
      const int dv = mt * 32 + 8 * g4 + 4 * hh;
      const float4 gv = ld4(lgam + dv), bv = ld4(lbet + dv), gt = ld4(gate + dv);
      float4 ov;
      ov.x = siluf_(gt.x) * ((o[mt][4 * g4] - mu) * rstd * gv.x + bv.x);
      ov.y = siluf_(gt.y) * ((o[mt][4 * g4 + 1] - mu) * rstd * gv.y + bv.y);
      ov.z = siluf_(gt.z) * ((o[mt][4 * g4 + 2] - mu) * rstd * gv.z + bv.z);
      ov.w = siluf_(gt.w) * ((o[mt][4 * g4 + 3] - mu) * rstd * gv.w + bv.w);
      st4(dst + dv, ov);
    }
}
DEV void phase_p12(const Params& p, char* smem) {
  const int G = gridDim.x;
  const int bid = BIDX;
  if (bid < BATCH * 8 && G > BATCH * 8) {
    rk_chain(p, bid);
  } else if (G > BATCH * 8) {
    for (int it = bid - BATCH * 8; it < P12_RET_ITEMS; it += G - BATCH * 8) p12_ret(p, it, smem);
  } else {
    for (int it = bid; it < BATCH * 8 + P12_RET_ITEMS; it += G) {
      if (it < BATCH * 8) rk_chain(p, it);
      else p12_ret(p, it - BATCH * 8, smem);
    }
  }
}

#define P13_SMEM (8 * 128 * 4)
DEV void phase_p13(const Params& p, char* smem) {
  const int tid = TIDX;
  const float* Hc = (const float*)(p.ws + OFF_H);
  const float* mu = p.in[I_RW_MU];
  const float* GLO = (const float*)(p.ws + OFF_GLO);
  float* sl = (float*)smem;
  float* MIX = (float*)(p.ws + OFF_MIX);
  const float* RWK = (const float*)(p.ws + OFF_RWK); const float* RWR = p.out + (size_t)NTOK * 512; const float* RWV = p.out;
  const float* g_up = p.in[I_RW_G_UP];
  for (int it = BIDX; it < NTOK / 8; it += gridDim.x) {
    __syncthreads();
    for (int w = tid; w < 8 * 128; w += NTHREADS) {
      const size_t tok = (size_t)it * 8 + (w >> 7);
      sl[w] = GLO[tok * 128 + (w & 127)];
    }
    __syncthreads();
#pragma unroll
    for (int cc = 0; cc < 2; ++cc) {
      const int c = tid + 256 * cc;
      float ag[8];
#pragma unroll
      for (int tt = 0; tt < 8; ++tt) ag[tt] = 0.f;
      for (int j0 = 0; j0 < 128; j0 += 8) {
        float gu[8];
#pragma unroll
        for (int q = 0; q < 8; ++q) gu[q] = g_up[(j0 + q) * 512 + c];
#pragma unroll
        for (int q4 = 0; q4 < 2; ++q4) {
#pragma unroll
          for (int tt = 0; tt < 8; ++tt) {
            const float4 sg = ld4(sl + tt * 128 + j0 + q4 * 4);
            ag[tt] += sg.x * gu[q4 * 4] + sg.y * gu[q4 * 4 + 1] + sg.z * gu[q4 * 4 + 2] + sg.w * gu[q4 * 4 + 3];
          }
        }
      }
      const float lng = p.in[I_RW_LN_G][c], lnb = p.in[I_RW_LN_B][c], rk = p.in[I_RW_R_K][c];
#pragma unroll
      for (int tt = 0; tt < 8; ++tt) {
        const size_t tok = (size_t)it * 8 + tt;
        const float y = MIX[tok * 1024 + c];
        const float m = wave_sum(y) * (1.f / 64.f);
        const float d = y - m;
        const float var = wave_sum(d * d) * (1.f / 64.f);
        const float yn = d * rsqrtf(var + 64e-5f) * lng + lnb;
        const float r = RWR[tok * 512 + c], k = RWK[tok * 512 + c], v = RWV[tok * 512 + c];
        const float bonus = wave_sum(r * k * rk) * v;
        MIX[tok * 1024 + c] = (yn + bonus) * ag[tt];
      }
    }
  }
}

#define NPHASES 20
#define SMEM_BYTES 67584
DEV void run_phase(const Params& p, int ph, char* smem) {
  switch (ph) {
    case 0: phase_gemm_in<0>(p, smem); break;
    case 1: phase_p1(p, smem); break;
    case 2: phase_p2(p, smem); break;
    case 3: phase_glu(p, smem); break;
    case 4: phase_outproj<0>(p, smem); break;
    case 5: phase_ln_router<0>(p, smem); break;
    case 6: phase_lists_shup<0>(p, smem); break;
    case 7: phase_routed_up<0>(p, smem); break;
    case 8: phase_down<0>(p, smem); break;
    case 9: phase_combine<0>(p, smem); break;
    case 10: phase_gemm_in<1>(p, smem); break;
    case 11: phase_p11(p, smem); break;
    case 12: phase_p12(p, smem); break;
    case 13: phase_p13(p, smem); break;
    case 14: phase_outproj<1>(p, smem); break;
    case 15: phase_ln_router<1>(p, smem); break;
    case 16: phase_lists_shup<1>(p, smem); break;
    case 17: phase_routed_up<1>(p, smem); break;
    case 18: phase_down<1>(p, smem); break;
    case 19: phase_combine<1>(p, smem); break;
    case 20: phase_p1b(p, smem); break;
    case 21: phase_rkpre(p, smem); break;
    case 22: phase_rkout(p, smem); break;
  }
}
static_assert(P1_SMEM <= SMEM_BYTES, "smem");
static_assert(P1_PREP_SMEM <= SMEM_BYTES, "smem");
static_assert(P2_SMEM <= SMEM_BYTES, "smem");
static_assert(P5_SMEM <= SMEM_BYTES, "smem");
static_assert(P7_SMEM <= SMEM_BYTES, "smem");
static_assert(P12_SMEM <= SMEM_BYTES, "smem");
static_assert(RKPRE_SMEM <= SMEM_BYTES, "smem");
static_assert(OFF_HS + (size_t)NTOK * 256 * 2 <= OFF_X1, "layout");

#ifndef CPU_EMU
template <int PH>
__global__ void __launch_bounds__(NTHREADS) phase_kernel(Params p) {
  __shared__ __attribute__((aligned(16))) char smem[SMEM_BYTES];
  run_phase(p, PH, smem);
}
template <int PH>
static void launch_phases(const Params& p, hipStream_t stream) {
  phase_kernel<PH><<<dim3(1024), dim3(NTHREADS), 0, stream>>>(p);
  if constexpr (PH + 1 < NPHASES) launch_phases<PH + 1>(p, stream);
}
#if MEGA
#define XB_TMO      128
#define XB_XCNT(j)  (256  + 64 * (j))
#define XB_XSUB(j)  (1280 + 64 * (j))
#define XB_XGEN(j)  (2304 + 64 * (j))
#define XB_TOP      3328
#define XB_TOPGEN   3392
#define XCD_BAR_WORDS 3456
#define XB_SPIN_CAP (1u << 18)
#define LAS __attribute__((address_space(3)))

__device__ __forceinline__ unsigned xb_ld(unsigned* p)              { return __hip_atomic_load(p, __ATOMIC_RELAXED, __HIP_MEMORY_SCOPE_AGENT); }
__device__ __forceinline__ unsigned xb_add(unsigned* p, unsigned v) { return __hip_atomic_fetch_add(p, v, __ATOMIC_RELAXED, __HIP_MEMORY_SCOPE_AGENT); }
__device__ __forceinline__ unsigned xb_xcc_id() { return (unsigned)__builtin_amdgcn_s_getreg((3 << 11) | 20) & 0xFu; }
#define XB_SPIN(cond, bar) do { unsigned _sp = 0; while (cond) { __builtin_amdgcn_s_sleep(1); \
    if ((++_sp & 255u) == 0u) { if (xb_ld(&(bar)[XB_TMO])) break; if (_sp > XB_SPIN_CAP) { atomicAdd(&(bar)[XB_TMO], 1u); break; } } } } while (0)

struct XcdBarrier {
    unsigned* bar; unsigned x;
    volatile LAS unsigned* st;
};

__device__ __forceinline__ XcdBarrier xcd_barrier_post(unsigned* bar, volatile LAS unsigned* st) {
    XcdBarrier b; b.bar = bar; b.x = xb_xcc_id(); b.st = st;
    if (threadIdx.x == 0) (void)xb_add(&bar[XB_XCNT(b.x)], 1u);
    return b;
}
__device__ __forceinline__ void xcd_barrier_complete(unsigned* bar, unsigned x, unsigned& nloc, unsigned& nx) {
    const unsigned G = gridDim.x * gridDim.y * gridDim.z;
    unsigned sum, cnt, mine, sp = 0u;
    for (;;) {
        sum = 0u; cnt = 0u; mine = 0u;
#pragma unroll
        for (unsigned j = 0; j < 16; ++j) { const unsigned c = xb_ld(&bar[XB_XCNT(j)]); sum += c; cnt += (c > 0u) ? 1u : 0u; mine = (j == x) ? c : mine; }
        if (sum == G) break;
        __builtin_amdgcn_s_sleep(1);
        if ((++sp & 255u) == 0u) { if (xb_ld(&bar[XB_TMO])) break; if (sp > XB_SPIN_CAP) { atomicAdd(&bar[XB_TMO], 1u); break; } }
    }
    nloc = mine > 0u ? mine : 1u; nx = cnt > 0u ? cnt : 1u;
}

__device__ __forceinline__ void xcd_barrier(const XcdBarrier& b) {
    asm volatile("s_waitcnt vmcnt(0)" ::: "memory");
    __syncthreads();
    if (threadIdx.x == 0) {
        unsigned* bar = b.bar;
        __builtin_amdgcn_s_waitcnt(0);
        unsigned nloc = b.st[0], nx = b.st[1];
        if (nloc == 0u) { xcd_barrier_complete(bar, b.x, nloc, nx); b.st[0] = nloc; b.st[1] = nx; }
        const unsigned old = xb_add(&bar[XB_XSUB(b.x)], 1u);
        const unsigned gen = old / nloc;
        if (old + 1u == (gen + 1u) * nloc) {
            __builtin_amdgcn_fence(__ATOMIC_RELEASE, "agent");
            asm volatile("s_waitcnt vmcnt(0)" ::: "memory");
            const unsigned og = xb_add(&bar[XB_TOP], 1u);
            const unsigned tg = og / nx;
            if (og + 1u == (tg + 1u) * nx) xb_add(&bar[XB_TOPGEN], 1u);
            else XB_SPIN(xb_ld(&bar[XB_TOPGEN]) == tg, bar);
            __builtin_amdgcn_fence(__ATOMIC_ACQUIRE, "agent");
            xb_add(&bar[XB_XGEN(b.x)], 1u);
            asm volatile("s_waitcnt vmcnt(0)" ::: "memory");
        } else {
            XB_SPIN(xb_ld(&bar[XB_XGEN(b.x)]) == gen, bar);
            __builtin_amdgcn_fence(__ATOMIC_ACQUIRE, "agent");
            asm volatile("s_waitcnt vmcnt(0)" ::: "memory");
        }
    }
    __syncthreads();
}


__global__ void __launch_bounds__(NTHREADS) mega_kernel(Params p) {
  __shared__ __attribute__((aligned(16))) char smem[SMEM_BYTES];
  unsigned* bar = (unsigned*)(p.ws + OFF_BAR);
  __shared__ uint4 xb_words;
  if (threadIdx.x == 0) xb_words = make_uint4(0u, 0u, 0u, 0u);
  __syncthreads();
  XcdBarrier xb = xcd_barrier_post(bar, (volatile LAS unsigned*)&xb_words);
  if (p.ws == nullptr) cg::this_grid().sync();
  typedef const __attribute__((address_space(4))) Params* KParams;
#define PH_(n) { KParams kp = (KParams)__builtin_amdgcn_kernarg_segment_ptr(); asm volatile("" : "+s"(kp)); const Params lp = *(const Params*)kp; run_phase(lp, n, smem); } xcd_barrier(xb);
  PH_(0) PH_(1) PH_(20) PH_(2) PH_(3) PH_(4) PH_(5) PH_(6) PH_(7) PH_(8) PH_(9)
  PH_(10) PH_(11) PH_(21) PH_(12) PH_(22) PH_(13) PH_(14) PH_(15) PH_(16) PH_(17) PH_(18)
  { KParams kp = (KParams)__builtin_amdgcn_kernarg_segment_ptr(); asm volatile("" : "+s"(kp)); const Params lp = *(const Params*)kp; run_phase(lp, 19, smem); }
}

#endif

extern "C" void kernel_launch(void* const* d_in, const int* in_sizes, int n_in, void* d_out, int out_size, void* d_ws, size_t ws_size,
                              hipStream_t stream) {
  Params p;
  for (int i = 0; i < N_INPUTS; ++i) p.in[i] = (const float*)d_in[i];
  p.out = (float*)d_out;
  p.ws = (char*)d_ws;
#if MEGA
  static int grid_blocks = 0;
  if (!grid_blocks) {
    int dev = 0, cus = 0, per_cu = 0;
    hipGetDevice(&dev);
    hipDeviceGetAttribute(&cus, hipDeviceAttributeMultiprocessorCount, dev);
    hipOccupancyMaxActiveBlocksPerMultiprocessor(&per_cu, mega_kernel, NTHREADS, 0);
    if (per_cu > 1) per_cu = 1;
    grid_blocks = cus * per_cu;
  }
  hipMemsetAsync((char*)d_ws + OFF_BAR, 0, 16384, stream);
  void* args[] = {&p};
  hipError_t e = hipLaunchCooperativeKernel((void*)mega_kernel, dim3(grid_blocks), dim3(NTHREADS), args, 0, stream);
  if (e != hipSuccess) fprintf(stderr, "cooperative launch failed: %s (grid %d)\n", hipGetErrorString(e), grid_blocks);
#else
  launch_phases<0>(p, stream);
#endif
}
#endif
```

```cpp
#ifdef CPU_EMU
#include "emu.h"
#else
#include <hip/hip_runtime.h>
#include <hip/hip_cooperative_groups.h>
#include <cstdio>
namespace cg = cooperative_groups;
#endif
#include <stdint.h>

#ifndef BATCH
#define BATCH 2
#endif
#ifndef SEQ_LEN
#define SEQ_LEN 8192
#endif
#ifndef MEGA
#define MEGA 1
#endif
#if MEGA && !defined(CPU_EMU)
#define RK_MERGED 1
#else
#define RK_MERGED 0
#endif

#define DEV __device__ __forceinline__
#ifdef CPU_EMU
#define TIDX ((int)threadIdx.x)
#define BIDX ((int)blockIdx.x)
#else
__device__ __forceinline__ int tidx_() { int t = __builtin_amdgcn_workitem_id_x(); asm volatile("" : "+v"(t)); return t; }
__device__ __forceinline__ int bidx_() { int b = __builtin_amdgcn_workgroup_id_x(); asm volatile("" : "+s"(b)); return b; }
#define TIDX tidx_()
#define BIDX bidx_()
#endif
#define NTOK (BATCH * SEQ_LEN)
#define DM 1024
#define AB_IN 1816
#define AB_LD 1824
#define CD_IN 3328
#define NCMP ((SEQ_LEN - 32) / 16 + 1)
#define NBLK (SEQ_LEN / 64)
#define NB_CMP ((NCMP + 63) / 64)
#define S5_NC (SEQ_LEN / 64)
#define RET_NC (SEQ_LEN / 128)
#define ALPHA_F 1.4142135623730951f
#define NTHREADS 256

enum { I_X = 0, I_AB_W_IN, I_AB_W_OUT, I_S5_LAM_RE, I_S5_LAM_IM, I_S5_LOG_DT, I_S5_B_RE, I_S5_B_IM, I_S5_C_RE, I_S5_C_IM,
       I_S5_D, I_S5_W_GLU, I_S5_B_GLU, I_PE_K, I_PE_V, I_CK_W1, I_CK_B1, I_CK_W2, I_CV_W1, I_CV_B1, I_CV_W2,
       I_CD_W_IN, I_CD_W_OUT, I_RW_MU, I_RW_W0, I_RW_W_UP, I_RW_A0, I_RW_A_UP, I_RW_G_UP, I_RW_K_K, I_RW_K_A, I_RW_R_K,
       I_RW_LN_G, I_RW_LN_B, I_RET_LN_G, I_RET_LN_B, I_LN1_G, I_LN1_B, I_LN2_G, I_LN2_B, I_ROUTER, I_MOE_BIAS,
       I_MOE_W1, I_MOE_W3, I_MOE_W2, I_SH_W1, I_SH_W3, I_SH_W2, N_INPUTS };

struct Params {
  const float* in[N_INPUTS];
  float* out;
  char* ws;
};

#define MiB_TOK ((size_t)NTOK * 1024 * 4)
#define OFF_H 0
#define OFF_H2 ((size_t)NTOK * 1792 * 4)
#define OFF_MIX ((size_t)NTOK * 3328 * 4)
#define OFF_X1 (OFF_MIX + MiB_TOK)
#define OFF_X2 (OFF_X1 + MiB_TOK)
#define OFF_R4 (OFF_X2 + MiB_TOK)
#define OFF_R5 (OFF_R4 + MiB_TOK)
#define OFF_Y OFF_H
#define OFF_HS (OFF_H + 4 * MiB_TOK)
#define OFF_FS OFF_X2
#define OFF_HR OFF_R4
#define OFF_X2B OFF_R4
#define OFF_TOPI (OFF_R5)
#define OFF_TOPG (OFF_TOPI + (size_t)NTOK * 8 * 4)
#define OFF_POSOF (OFF_TOPG + (size_t)NTOK * 8 * 4)
#define OFF_CNT (OFF_POSOF + (size_t)NTOK * 8 * 4)
#define OFF_LTOK (OFF_CNT + 8192)
#define OFF_LGATE (OFF_LTOK + (size_t)64 * NTOK * 4)
#define OFF_S5E (OFF_LGATE + (size_t)64 * NTOK * 4)
#define OFF_KCMP (OFF_S5E + (size_t)BATCH * S5_NC * 32 * 64 * 8)
#define OFF_VCMP (OFF_KCMP + (size_t)BATCH * NCMP * 2 * 64 * 4)
#define OFF_RETKV (OFF_VCMP + (size_t)BATCH * NCMP * 2 * 64 * 4)
#define OFF_BAR (OFF_RETKV + (size_t)BATCH * 4 * RET_NC * 64 * 128 * 4)
#define OFF_CMPHID (OFF_BAR + 16384)
#define OFF_CMPC1 (OFF_CMPHID + (size_t)2 * BATCH * 2 * NB_CMP * 64 * 128 * 4)
#define OFF_GLO OFF_LTOK
#define OFF_RKF (OFF_CMPC1 + 8192)
#define OFF_END (OFF_RKF + 16384)
#define OFF_YGELU OFF_X1
#define OFF_RWW OFF_X1
#define OFF_RWK (OFF_X1 + (size_t)NTOK * 512 * 4)
#define OFF_RWKK OFF_R4
#define OFF_RWA (OFF_R4 + (size_t)NTOK * 512 * 4)

typedef short bf16x8 __attribute__((ext_vector_type(8)));
typedef float f32x16 __attribute__((ext_vector_type(16)));

#ifdef CPU_EMU
#define WAVE_SYNC() emu_wave_bar()
#else
#define WAVE_SYNC() __builtin_amdgcn_wave_barrier()
#endif

DEV float sigmoidf_(float x) { return 1.f / (1.f + __expf(-x)); }
DEV float siluf_(float x) { return x * sigmoidf_(x); }
DEV float geluf_(float x) { float u = 0.7978845608028654f * (x + 0.044715f * x * x * x); return 0.5f * x * (1.f + tanhf(u)); }
DEV unsigned short f2bf(float f) {
  unsigned u = __builtin_bit_cast(unsigned, f);
  u += 0x7FFFu + ((u >> 16) & 1u);
  return (unsigned short)(u >> 16);
}
DEV float bf2f(unsigned short h) { return __builtin_bit_cast(float, ((unsigned)h) << 16); }
DEV float wave_sum(float v) {
#pragma unroll
  for (int m = 32; m >= 1; m >>= 1) v += __shfl_xor(v, m);
  return v;
}
DEV float wave_max(float v) {
#pragma unroll
  for (int m = 32; m >= 1; m >>= 1) v = fmaxf(v, __shfl_xor(v, m));
  return v;
}
DEV float4 ld4(const float* p) { return *(const float4*)p; }
#ifdef CPU_EMU
DEV float fexp2(float x) { return exp2f(x); }
#else
DEV float fexp2(float x) { return __builtin_amdgcn_exp2f(x); }
#endif
DEV void fast_sincos(float x, float* sn, float* cs) {
  const float k = rintf(x * 0.15915494309189535f);
  float r = fmaf(-k, 6.28125f, x);
  r = fmaf(-k, 1.9353071795864769e-3f, r);
  *sn = __sinf(r); *cs = __cosf(r);
}
DEV void st4(float* p, float4 v) { *(float4*)p = v; }

#define GEMM_BM 128
#define GEMM_MI (GEMM_BM / 64)
#define GEMM_SMEM_BYTES ((GEMM_BM + 128) * 72 * 2)
#ifdef CPU_EMU
DEV unsigned pk2(float a, float b) { return (unsigned)f2bf(a) | ((unsigned)f2bf(b) << 16); }
#else
typedef __bf16 hbf16x2 __attribute__((ext_vector_type(2)));
typedef float hf32x2 __attribute__((ext_vector_type(2)));
DEV unsigned pk2(float a, float b) {
  hf32x2 f = {a, b};
  return __builtin_bit_cast(unsigned, __builtin_convertvector(f, hbf16x2));
}
#endif
template <bool ABF, class AROW, class BPTR, class EPI>
DEV void gemm_tile(AROW arow, BPTR bptr, int ldb, int K, EPI epi, char* smem_raw, int akstep = 64) {
  unsigned short(*sA)[72] = (unsigned short(*)[72])smem_raw;
  unsigned short(*sB)[72] = (unsigned short(*)[72])(smem_raw + GEMM_BM * 72 * 2);
  const int tid = TIDX, lane = tid & 63, wave = tid >> 6;
  const int wm = wave >> 1, wn = wave & 1;
#if defined(CPU_EMU) && !defined(EMU_REAL_GEMM)
  for (int mi = 0; mi < GEMM_MI; ++mi)
    for (int r = 0; r < 16; ++r) {
      const int row = wm * (GEMM_BM / 2) + mi * 32 + (r & 3) + 8 * (r >> 2) + 4 * (lane >> 5);
      const int col = wn * 64 + (lane & 31);
      const void* arp = arow(row);
      float v[2] = {0.f, 0.f};
      for (int ni = 0; ni < 2; ++ni) {
        const int cc = col + ni * 32;
        const float* bq = bptr(cc & ~3);
        if (!arp || !bq) continue;
        bq += cc & 3;
        float a = 0.f;
        for (int k = 0; k < K; ++k) {
          const size_t ka = (size_t)(k >> 6) * akstep + (k & 63);
          const float av = ABF ? bf2f(((const unsigned short*)arp)[ka]) : bf2f(f2bf(((const float*)arp)[ka]));
          a += av * bf2f(f2bf(bq[(size_t)k * ldb]));
        }
        v[ni] = a;
      }
      epi(row, col, v[0], v[1]);
    }
  return;
#endif
  const float* ap[4 * GEMM_MI];
  const unsigned short* aph[2 * GEMM_MI];
  if (ABF) {
#pragma unroll
    for (int i = 0; i < 2 * GEMM_MI; ++i) aph[i] = (const unsigned short*)arow((tid >> 3) + 32 * i);
  } else {
#pragma unroll
    for (int i = 0; i < 4 * GEMM_MI; ++i) ap[i] = (const float*)arow((tid >> 4) + 16 * i);
  }
  const float* bp = bptr((tid & 31) * 4);
  const int kgrp = tid >> 5;
  float4 ra0[4 * GEMM_MI], ra1[4 * GEMM_MI];
  uint4 rah0[2 * GEMM_MI], rah1[2 * GEMM_MI];
  float4 rb0[8], rb1[8];
#define GEMM_GLOAD(S, k0_)                                                                                                          \
  {                                                                                                                                 \
    if (ABF) {                                                                                                                      \
      _Pragma("unroll") for (int i = 0; i < 2 * GEMM_MI; ++i) rah##S[i] =                                                           \
          aph[i] ? *(const uint4*)(aph[i] + (size_t)((k0_) >> 6) * akstep + (tid & 7) * 8) : make_uint4(0, 0, 0, 0);                \
    } else {                                                                                                                        \
      _Pragma("unroll") for (int i = 0; i < 4 * GEMM_MI; ++i) ra##S[i] =                                                            \
          ap[i] ? ld4(ap[i] + (size_t)((k0_) >> 6) * akstep + (tid & 15) * 4) : make_float4(0.f, 0.f, 0.f, 0.f);                    \
    }                                                                                                                               \
    _Pragma("unroll") for (int j = 0; j < 8; ++j) rb##S[j] =                                                                        \
        bp ? ld4(bp + (size_t)((k0_) + kgrp * 8 + j) * ldb) : make_float4(0.f, 0.f, 0.f, 0.f);                                      \
  }
#define GEMM_SSTORE(S)                                                                                                              \
  {                                                                                                                                 \
    if (ABF) {                                                                                                                      \
      _Pragma("unroll") for (int i = 0; i < 2 * GEMM_MI; ++i) *(uint4*)&sA[(tid >> 3) + 32 * i][(tid & 7) * 8] = rah##S[i];         \
    } else {                                                                                                                        \
      _Pragma("unroll") for (int i = 0; i < 4 * GEMM_MI; ++i) *(uint2*)&sA[(tid >> 4) + 16 * i][(tid & 15) * 4] =                   \
          make_uint2(pk2(ra##S[i].x, ra##S[i].y), pk2(ra##S[i].z, ra##S[i].w));                                                     \
    }                                                                                                                               \
    const int nb = (tid & 31) * 4;                                                                                                  \
    *(uint4*)&sB[nb + 0][kgrp * 8] = make_uint4(pk2(rb##S[0].x, rb##S[1].x), pk2(rb##S[2].x, rb##S[3].x), pk2(rb##S[4].x, rb##S[5].x), pk2(rb##S[6].x, rb##S[7].x)); \
    *(uint4*)&sB[nb + 1][kgrp * 8] = make_uint4(pk2(rb##S[0].y, rb##S[1].y), pk2(rb##S[2].y, rb##S[3].y), pk2(rb##S[4].y, rb##S[5].y), pk2(rb##S[6].y, rb##S[7].y)); \
    *(uint4*)&sB[nb + 2][kgrp * 8] = make_uint4(pk2(rb##S[0].z, rb##S[1].z), pk2(rb##S[2].z, rb##S[3].z), pk2(rb##S[4].z, rb##S[5].z), pk2(rb##S[6].z, rb##S[7].z)); \
    *(uint4*)&sB[nb + 3][kgrp * 8] = make_uint4(pk2(rb##S[0].w, rb##S[1].w), pk2(rb##S[2].w, rb##S[3].w), pk2(rb##S[4].w, rb##S[5].w), pk2(rb##S[6].w, rb##S[7].w)); \
  }
  f32x16 acc[GEMM_MI][2];
#pragma unroll
  for (int mi = 0; mi < GEMM_MI; ++mi)
#pragma unroll
    for (int ni = 0; ni < 2; ++ni)
#pragma unroll
      for (int r = 0; r < 16; ++r) acc[mi][ni][r] = 0.f;
  auto compute = [&]() {
#pragma unroll
    for (int ks = 0; ks < 4; ++ks) {
      bf16x8 af[GEMM_MI], bfr[2];
#pragma unroll
      for (int mi = 0; mi < GEMM_MI; ++mi) af[mi] = *(const bf16x8*)&sA[wm * (GEMM_BM / 2) + mi * 32 + (lane & 31)][ks * 16 + (lane >> 5) * 8];
#pragma unroll
      for (int ni = 0; ni < 2; ++ni) bfr[ni] = *(const bf16x8*)&sB[wn * 64 + ni * 32 + (lane & 31)][ks * 16 + (lane >> 5) * 8];
#pragma unroll
      for (int mi = 0; mi < GEMM_MI; ++mi)
#pragma unroll
        for (int ni = 0; ni < 2; ++ni) acc[mi][ni] = __builtin_amdgcn_mfma_f32_32x32x16_bf16(af[mi], bfr[ni], acc[mi][ni], 0, 0, 0);
    }
  };
  if (ABF) {
    GEMM_GLOAD(0, 0);
    GEMM_GLOAD(1, 64);
    for (int k0 = 0; k0 < K; k0 += 128) {
      __syncthreads();
      GEMM_SSTORE(0);
      __syncthreads();
      if (k0 + 128 < K) GEMM_GLOAD(0, k0 + 128);
      compute();
      __syncthreads();
      GEMM_SSTORE(1);
      __syncthreads();
      if (k0 + 192 < K) GEMM_GLOAD(1, k0 + 192);
      compute();
    }
  } else {
    GEMM_GLOAD(0, 0);
    for (int k0 = 0; k0 < K; k0 += 64) {
      __syncthreads();
      GEMM_SSTORE(0);
      __syncthreads();
      if (k0 + 64 < K) GEMM_GLOAD(0, k0 + 64);
      compute();
    }
  }
#pragma unroll
  for (int mi = 0; mi < GEMM_MI; ++mi)
#pragma unroll
    for (int r = 0; r < 16; ++r) {
      int row = wm * (GEMM_BM / 2) + mi * 32 + (r & 3) + 8 * (r >> 2) + 4 * (lane >> 5);
      int col = wn * 64 + (lane & 31);
      epi(row, col, acc[mi][0][r], acc[mi][1][r]);
    }
}

template <int LAYER>
DEV void phase_gemm_in(const Params& p, char* smem) {
  const int N = LAYER == 0 ? AB_IN : CD_IN;
  const float* A = LAYER == 0 ? p.in[I_X] : (const float*)(p.ws + OFF_X2);
  const float* B = LAYER == 0 ? p.in[I_AB_W_IN] : p.in[I_CD_W_IN];
  float* C = (float*)(p.ws + OFF_H);
  const int NT = (N + 127) / 128, MT = NTOK / GEMM_BM;
  const int xcd_ = BIDX & 7, lb_ = BIDX >> 3, nb_ = gridDim.x >> 3;
  for (int j_ = lb_; j_ < (MT / 8) * NT; j_ += nb_) {
    const int it = (xcd_ + 8 * (j_ / NT)) * NT + (j_ % NT);
    const int tm = it / NT, tn = it % NT;
    const int m0 = tm * GEMM_BM, n0 = tn * 128;
    gemm_tile<LAYER == 1>(
        [&](int r) { return LAYER == 1 ? (const void*)((const unsigned short*)(p.ws + OFF_X2B) + (size_t)(m0 + r) * DM) : (const void*)(A + (size_t)(m0 + r) * DM); },
        [&](int c) { return (n0 + c < N) ? (B + n0 + c) : (const float*)nullptr; }, N, DM,
        [&](int row, int col, float v0, float v1) {
          const int gm = m0 + row, gc = n0 + col;
          if (LAYER == 1 && gc >= 1792 && gc < 2304) {
            const int i = gc & 63;
            const float pos = (float)(gm % SEQ_LEN);
            const float inv = __expf(-(float)i * (9.210340371976184f / 32.f));
            float sn, cs;
            fast_sincos(pos * inv, &sn, &cs);
            float o0 = v0 * cs - v1 * sn, o1 = v1 * cs + v0 * sn;
            if (gc >= 2048) { o0 *= 0.125f; o1 *= 0.125f; }
            v0 = o0; v1 = o1;
          }
          if (LAYER == 1) {
            float* dstp = gc < 1792 ? C + (size_t)gm * 1792 + gc : (float*)(p.ws + OFF_H2) + (size_t)gm * 1536 + (gc - 1792);
            dstp[0] = v0; dstp[32] = v1;
          } else {
            if (gc < N) C[(size_t)gm * AB_LD + gc] = v0;
            if (gc + 32 < N) C[(size_t)gm * AB_LD + gc + 32] = v1;
          }
        },
        smem);
  }
}

struct S5Const { float lb_re, lb_im; };
DEV void s5_consts(const Params& p, int g, int pp, float& lb_re, float& lb_im, float (&bbr)[16], float (&bbi)[16]) {
  const float dt = expf(p.in[I_S5_LOG_DT][g]);
  const float lr = p.in[I_S5_LAM_RE][g * 64 + pp], li = p.in[I_S5_LAM_IM][g * 64 + pp];
  const float mag = expf(lr * dt);
  float sn, cs;
  sincosf(li * dt, &sn, &cs);
  lb_re = mag * cs; lb_im = mag * sn;
  const float den = lr * lr + li * li;
  const float f_re = ((lb_re - 1.f) * lr + lb_im * li) / den;
  const float f_im = (lb_im * lr - (lb_re - 1.f) * li) / den;
  const float* br = p.in[I_S5_B_RE] + (size_t)(g * 64 + pp) * 16;
  const float* bi = p.in[I_S5_B_IM] + (size_t)(g * 64 + pp) * 16;
#pragma unroll
  for (int h = 0; h < 16; ++h) {
    bbr[h] = f_re * br[h] - f_im * bi[h];
    bbi[h] = f_re * bi[h] + f_im * br[h];
  }
}

#define OFF_QB OFF_X2
#define OFF_KSB (OFF_QB + (size_t)NTOK * 512 * 2)
#define OFF_KWB (OFF_KSB + (size_t)NTOK * 128 * 2)
#define OFF_VST (OFF_KWB + (size_t)NTOK * 128 * 2)
#define OFF_VWT (OFF_VST + (size_t)NTOK * 128 * 2)
#define OFF_KCB (OFF_VWT + (size_t)NTOK * 128 * 2)
#define OFF_VCT (OFF_KCB + (size_t)BATCH * 2 * NB_CMP * 64 * 64 * 2)
#define NSA_QSCALE (0.125f * 1.4426950408889634f)

#define P1_S5A_ITEMS (BATCH * 32 * S5_NC / 4)
#define P1_S5A_SPLIT (P1_S5A_ITEMS * 5 / 8)
#define P1_CMP_ITEMS (2 * BATCH * 2 * NB_CMP)
DEV void p1_s5a(const Params& p, int item, char* smem) {
  const int lane = TIDX & 63, wave = TIDX >> 6;
  const int idx = item * 4 + wave;
  const int g = idx & 31, c = (idx >> 5) % S5_NC, b = idx / (32 * S5_NC);
  float lb_re, lb_im, bbr[16], bbi[16];
  s5_consts(p, g, lane, lb_re, lb_im, bbr, bbi);
  const float* H = (const float*)(p.ws + OFF_H);
  float sr = 0.f, si = 0.f;
  float* su = (float*)smem + wave * 64 * 16;
  __syncthreads();
  {
    const float* ur = H + (size_t)(b * SEQ_LEN + c * 64 + lane) * AB_LD + g * 16;
#pragma unroll
    for (int q = 0; q < 4; ++q) st4(su + lane * 16 + q * 4, ld4(ur + q * 4));
  }
  WAVE_SYNC();
  for (int tt = 0; tt < 64; ++tt) {
    const float* u = su + tt * 16;
    float dr = 0.f, di = 0.f;
#pragma unroll
    for (int h4 = 0; h4 < 4; ++h4) {
      const float4 uv = ld4(u + h4 * 4);
      dr += uv.x * bbr[h4 * 4] + uv.y * bbr[h4 * 4 + 1] + uv.z * bbr[h4 * 4 + 2] + uv.w * bbr[h4 * 4 + 3];
      di += uv.x * bbi[h4 * 4] + uv.y * bbi[h4 * 4 + 1] + uv.z * bbi[h4 * 4 + 2] + uv.w * bbi[h4 * 4 + 3];
    }
    const float nr = lb_re * sr - lb_im * si + dr;
    const float ni = lb_re * si + lb_im * sr + di;
    sr = nr; si = ni;
  }
  float2* E = (float2*)(p.ws + OFF_S5E);
  E[((size_t)(b * S5_NC + c) * 32 + g) * 64 + lane] = make_float2(sr, si);
}
#define P1_CMPG_MT ((NCMP + GEMM_BM - 1) / GEMM_BM)
#define P1_CMPG_ITEMS (2 * BATCH * 2 * P1_CMPG_MT)
DEV void p1_cmpgemm(const Params& p, int item, char* smem) {
  const int mt = item % P1_CMPG_MT;
  int r = item / P1_CMPG_MT;
  const int g = r & 1; r >>= 1;
  const int b = r % BATCH; const int which = r / BATCH;
  const float* H = (const float*)(p.ws + OFF_H);
  const float* w1 = which ? p.in[I_CV_W1] : p.in[I_CK_W1];
  const int colbase = (which ? 1152 : 1024) + g * 64;
  float* HID = (float*)(p.ws + OFF_CMPHID) + ((size_t)(which * BATCH + b) * 2 + g) * NB_CMP * 64 * 128;
  const int n0 = mt * GEMM_BM;
  gemm_tile<false>(
      [&](int rr) { return (n0 + rr < NCMP) ? (const void*)(H + ((size_t)b * SEQ_LEN + 16 * (n0 + rr)) * AB_LD + colbase) : (const void*)nullptr; },
      [&](int c) { return w1 + c; }, 128, 2048,
      [&](int row, int col, float v0, float v1) {
        if (n0 + row < NCMP) { HID[(size_t)(n0 + row) * 128 + col] = v0; HID[(size_t)(n0 + row) * 128 + col + 32] = v1; }
      },
      smem, AB_LD);
}
#define P1_CMPC1_ITEMS 16
DEV void p1_cmpc1(const Params& p, int item, char* smem) {
  const int which = item >> 3, sl = item & 7;
  const float* pe = which ? p.in[I_PE_V] : p.in[I_PE_K];
  const float* w1 = which ? p.in[I_CV_W1] : p.in[I_CK_W1];
  float* sPart = (float*)smem;
  const int tid = TIDX, hid = tid & 127, kh = tid >> 7;
  float a = 0.f;
  const int k0 = sl * 256 + kh * 128;
#pragma unroll 16
  for (int k = k0; k < k0 + 128; ++k) a += pe[k] * w1[(size_t)k * 128 + hid];
  __syncthreads();
  sPart[tid] = a;
  __syncthreads();
  if (tid < 128) ((float*)(p.ws + OFF_CMPC1))[(which * 8 + sl) * 128 + tid] = sPart[tid] + sPart[tid + 128];
  __syncthreads();
}
DEV void p1_compress(const Params& p, int item, char* smem) {
  const int tile = item % NB_CMP;
  int r = item / NB_CMP;
  const int g = r & 1; r >>= 1;
  const int b = r % BATCH; const int which = r / BATCH;
  const float* b1 = which ? p.in[I_CV_B1] : p.in[I_CK_B1];
  const float* w2 = which ? p.in[I_CV_W2] : p.in[I_CK_W2];
  const float* C1P = (const float*)(p.ws + OFF_CMPC1) + which * 8 * 128;
  const float* HID = (const float*)(p.ws + OFF_CMPHID) + ((size_t)(which * BATCH + b) * 2 + g) * NB_CMP * 64 * 128;
  float* sOut = (float*)smem;
  float* sHid = sOut + 8 * 64;
  float* sAll = sHid + 8 * 128;
  float* sC1 = sAll + 64 * 65;
  const int tid = TIDX;
  __syncthreads();
  if (tid < 128) {
    const float* q = C1P + tid;
    sC1[tid] = (((((((q[0] + q[128]) + q[256]) + q[384]) + q[512]) + q[640]) + q[768]) + q[896]) + b1[tid];
  }
  float* dst = (float*)(p.ws + (which ? OFF_VCMP : OFF_KCMP));
#pragma unroll 1
  for (int r8 = 0; r8 < 8; ++r8) {
    const int n0 = tile * 64 + r8 * 8;
    __syncthreads();
    for (int w = tid; w < 8 * 128; w += NTHREADS) {
      const int rr = w >> 7, hid = w & 127;
      const int n = n0 + rr;
      sHid[w] = n < NCMP ? geluf_(HID[(size_t)n * 128 + hid] + sC1[hid]) : 0.f;
    }
    __syncthreads();
    for (int w = tid; w < 8 * 64; w += NTHREADS) {
      const int rr = w >> 6, d = w & 63;
      float a = 0.f;
      for (int hid = 0; hid < 128; ++hid) a += sHid[rr * 128 + hid] * w2[hid * 64 + d];
      sOut[w] = a;
    }
    __syncthreads();
    for (int w = tid; w < 8 * 64; w += NTHREADS) {
      const int rr = w >> 6, d = w & 63;
      const int n = n0 + rr;
      float v = sOut[w];
      if (which == 0 && d < 16) {
        const int i = d & 7;
        const float pos = (float)(n * 16 + 31);
        const float inv = __expf(-(float)i * (13.122363377404328f / 8.f));
        float sn, cs;
        sincosf(pos * inv, &sn, &cs);
        const float x1 = sOut[rr * 64 + i], x2 = sOut[rr * 64 + i + 8];
        v = d < 8 ? x1 * cs - x2 * sn : x2 * cs + x1 * sn;
      }
      if (n >= NCMP) v = 0.f;
      sAll[(r8 * 8 + rr) * 65 + d] = v;
      if (n < NCMP) dst[((size_t)(b * NCMP + n) * 2 + g) * 64 + d] = v;
    }
  }
  __syncthreads();
  if (which == 0) {
    unsigned short* KCB = (unsigned short*)(p.ws + OFF_KCB) + (((size_t)b * 2 + g) * NB_CMP * 64 + tile * 64) * 64;
    for (int w = tid; w < 64 * 8; w += NTHREADS) {
      const int nl = w >> 3, o = w & 7;
      float v[8];
#pragma unroll
      for (int q = 0; q < 8; ++q) v[q] = sAll[nl * 65 + o * 8 + q];
      *(uint4*)(KCB + nl * 64 + o * 8) = make_uint4(pk2(v[0], v[1]), pk2(v[2], v[3]), pk2(v[4], v[5]), pk2(v[6], v[7]));
    }
  } else {
    unsigned short* VCT = (unsigned short*)(p.ws + OFF_VCT) + (((size_t)b * 2 + g) * NB_CMP + tile) * 64 * 64;
    for (int w = tid; w < 64 * 8; w += NTHREADS) {
      const int d = w >> 3, o = w & 7;
      float v[8];
#pragma unroll
      for (int q = 0; q < 8; ++q) v[q] = sAll[(o * 8 + q) * 65 + d];
      *(uint4*)(VCT + d * 64 + o * 8) = make_uint4(pk2(v[0], v[1]), pk2(v[2], v[3]), pk2(v[4], v[5]), pk2(v[6], v[7]));
    }
  }
}
DEV uint4 pack8(const float* v) {
  uint4 r;
  r.x = (unsigned)f2bf(v[0]) | ((unsigned)f2bf(v[1]) << 16);
  r.y = (unsigned)f2bf(v[2]) | ((unsigned)f2bf(v[3]) << 16);
  r.z = (unsigned)f2bf(v[4]) | ((unsigned)f2bf(v[5]) << 16);
  r.w = (unsigned)f2bf(v[6]) | ((unsigned)f2bf(v[7]) << 16);
  return r;
}
#define P1_PREP_ITEMS (NTOK / 64)
#define P1_PREP_SMEM ((64 * 8 * 2 + 64 * 128) * 4)
DEV void p1_prep(const Params& p, int item, char* smem) {
  const int tid = TIDX;
  const int b = item / NBLK, blk = item % NBLK;
  const float* H = (const float*)(p.ws + OFF_H);
  float* sCS = (float*)smem;
  float* sV = sCS + 64 * 8 * 2;
  const size_t tok0 = (size_t)b * SEQ_LEN + blk * 64;
  __syncthreads();
  for (int w = tid; w < 64 * 8; w += NTHREADS) {
    const int tk = w >> 3, i = w & 7;
    const float pos = (float)(blk * 64 + tk);
    const float inv = __expf(-(float)i * (13.122363377404328f / 8.f));
    float sn, cs;
    sincosf(pos * inv, &sn, &cs);
    sCS[w * 2] = cs; sCS[w * 2 + 1] = sn;
  }
  __syncthreads();
  unsigned short* QB = (unsigned short*)(p.ws + OFF_QB);
  unsigned short* KSB = (unsigned short*)(p.ws + OFF_KSB);
  unsigned short* KWB = (unsigned short*)(p.ws + OFF_KWB);
  for (int w = tid; w < 64 * 12 * 8; w += NTHREADS) {
    const int o = w & 7, hd = (w >> 3) % 12, tk = w / 96;
    const int col = hd < 8 ? 512 + hd * 64 : (hd < 10 ? 1280 + (hd - 8) * 64 : 1536 + (hd - 10) * 64);
    const float* x = H + (tok0 + tk) * AB_LD + col;
    float v[8];
    const float4 a0 = ld4(x + o * 8), a1 = ld4(x + o * 8 + 4);
    v[0] = a0.x; v[1] = a0.y; v[2] = a0.z; v[3] = a0.w; v[4] = a1.x; v[5] = a1.y; v[6] = a1.z; v[7] = a1.w;
    if (o < 2) {
      const float4 c0 = ld4(x + (1 - o) * 8), c1 = ld4(x + (1 - o) * 8 + 4);
      const float u[8] = {c0.x, c0.y, c0.z, c0.w, c1.x, c1.y, c1.z, c1.w};
#pragma unroll
      for (int i = 0; i < 8; ++i) {
        const float cs = sCS[(tk * 8 + i) * 2], sn = sCS[(tk * 8 + i) * 2 + 1];
        v[i] = o == 0 ? v[i] * cs - u[i] * sn : v[i] * cs + u[i] * sn;
      }
    }
    if (hd < 8) {
#pragma unroll
      for (int i = 0; i < 8; ++i) v[i] *= NSA_QSCALE;
      *(uint4*)(QB + ((tok0 + tk) * 8 + hd) * 64 + o * 8) = pack8(v);
    } else {
      const int g = (hd - 8) & 1;
      unsigned short* dst = (hd < 10 ? KSB : KWB) + (((size_t)b * 2 + g) * SEQ_LEN + blk * 64 + tk) * 64 + o * 8;
      *(uint4*)dst = pack8(v);
    }
  }
#pragma unroll 1
  for (int which = 0; which < 2; ++which) {
    const int col = which ? 1664 : 1408;
    __syncthreads();
    for (int w = tid; w < 64 * 32; w += NTHREADS) {
      const int tk = w >> 5, c4 = (w & 31) * 4;
      st4(sV + tk * 128 + c4, ld4(H + (tok0 + tk) * AB_LD + col + c4));
    }
    __syncthreads();
    unsigned short* VT = (unsigned short*)(p.ws + (which ? OFF_VWT : OFF_VST));
    for (int w = tid; w < 2 * 64 * 8; w += NTHREADS) {
      const int ko = w & 7, d = (w >> 3) & 63, g = w >> 9;
      float v[8];
#pragma unroll
      for (int i = 0; i < 8; ++i) v[i] = sV[(ko * 8 + i) * 128 + g * 64 + d];
      *(uint4*)(VT + ((((size_t)b * 2 + g) * NBLK + blk) * 64 + d) * 64 + ko * 8) = pack8(v);
    }
  }
}

struct NsaSmem {
  unsigned short k[64][72];
  unsigned short vt[64][68];
  float imp[32][128];
  unsigned selmask[32][4];
  unsigned unionm[4];
  float keyb[4][128];
};
#define P2_NSA_SMEM ((int)sizeof(NsaSmem))
#define NSA_QT (SEQ_LEN / 32)
#define P2_NSA_ITEMS (BATCH * 2 * NSA_QT)

struct TileRegs { uint4 k0, k1, v0, v1; };
DEV void tile_gload(TileRegs& r, const unsigned short* Kg, const unsigned short* Vg, int tid) {
  const int row = tid >> 2, seg = tid & 3;
  r.k0 = *(const uint4*)(Kg + row * 64 + seg * 16);
  r.k1 = *(const uint4*)(Kg + row * 64 + seg * 16 + 8);
  if (Vg) {
    r.v0 = *(const uint4*)(Vg + row * 64 + seg * 16);
    r.v1 = *(const uint4*)(Vg + row * 64 + seg * 16 + 8);
  }
}
DEV void tile_sstore(NsaSmem* sm, const TileRegs& r, bool withV, int tid) {
  const int row = tid >> 2, seg = tid & 3;
  *(uint4*)&sm->k[row][seg * 16] = r.k0;
  *(uint4*)&sm->k[row][seg * 16 + 8] = r.k1;
  if (withV) {
    *(uint2*)&sm->vt[row][seg * 16] = make_uint2(r.v0.x, r.v0.y);
    *(uint2*)&sm->vt[row][seg * 16 + 4] = make_uint2(r.v0.z, r.v0.w);
    *(uint2*)&sm->vt[row][seg * 16 + 8] = make_uint2(r.v1.x, r.v1.y);
    *(uint2*)&sm->vt[row][seg * 16 + 12] = make_uint2(r.v1.z, r.v1.w);
  }
}
DEV void qk_tile(const unsigned short (*ksm)[72], const bf16x8 (&qf)[4], f32x16 (&s)[2], int lane) {
  const int r = lane & 31, hh = lane >> 5;
#pragma unroll
  for (int ks2 = 0; ks2 < 2; ++ks2) {
#pragma unroll
    for (int i = 0; i < 16; ++i) s[ks2][i] = 0.f;
#pragma unroll
    for (int ks = 0; ks < 4; ++ks) {
      const bf16x8 a = *(const bf16x8*)&ksm[ks2 * 32 + r][ks * 16 + hh * 8];
      s[ks2] = __builtin_amdgcn_mfma_f32_32x32x16_bf16(a, qf[ks], s[ks2], 0, 0, 0);
    }
  }
}
DEV void pv_tile(const unsigned short (*vsm)[68], const f32x16 (&pr)[2], f32x16 (&o)[2], int lane) {
  const int r = lane & 31, hh = lane >> 5;
#pragma unroll
  for (int ks2 = 0; ks2 < 2; ++ks2)
#pragma unroll
    for (int s = 0; s < 2; ++s) {
      union { uint4 u; bf16x8 v; } pfu;
      pfu.u = make_uint4(pk2(pr[ks2][8 * s], pr[ks2][8 * s + 1]), pk2(pr[ks2][8 * s + 2], pr[ks2][8 * s + 3]),
                         pk2(pr[ks2][8 * s + 4], pr[ks2][8 * s + 5]), pk2(pr[ks2][8 * s + 6], pr[ks2][8 * s + 7]));
      const bf16x8 pf = pfu.v;
#pragma unroll
      for (int mt = 0; mt < 2; ++mt) {
        const uint2 lo = *(const uint2*)&vsm[mt * 32 + r][ks2 * 32 + 16 * s + 4 * hh];
        const uint2 hi = *(const uint2*)&vsm[mt * 32 + r][ks2 * 32 + 16 * s + 8 + 4 * hh];
        union { uint4 u; bf16x8 v; } au;
        au.u = make_uint4(lo.x, lo.y, hi.x, hi.y);
        const bf16x8 a = au.v;
        o[mt] = __builtin_amdgcn_mfma_f32_32x32x16_bf16(a, pf, o[mt], 0, 0, 0);
      }
    }
}
DEV float quad_sum(float v) {
#ifdef CPU_EMU
  v += __shfl_xor(v, 1); v += __shfl_xor(v, 2); return v;
#else
  int x;
  x = __builtin_amdgcn_update_dpp(0, __builtin_bit_cast(int, v), 0xB1, 0xF, 0xF, false); v += __builtin_bit_cast(float, x);
  x = __builtin_amdgcn_update_dpp(0, __builtin_bit_cast(int, v), 0x4E, 0xF, 0xF, false); v += __builtin_bit_cast(float, x);
  return v;
#endif
}
DEV void softmax_step(f32x16 (&s)[2], float& m, float& l, f32x16 (&o)[2]) {
  float tmax = -INFINITY;
#pragma unroll
  for (int ks2 = 0; ks2 < 2; ++ks2)
#pragma unroll
    for (int i = 0; i < 16; ++i) tmax = fmaxf(tmax, s[ks2][i]);
  tmax = fmaxf(tmax, __shfl_xor(tmax, 32));
  const float mnew = fmaxf(m, tmax);
  const float msafe = mnew == -INFINITY ? 0.f : mnew;
  const float alpha = fexp2(m - msafe);
  float ps = 0.f;
#pragma unroll
  for (int ks2 = 0; ks2 < 2; ++ks2)
#pragma unroll
    for (int i = 0; i < 16; ++i) { s[ks2][i] = fexp2(s[ks2][i] - msafe); ps += s[ks2][i]; }
  l = l * alpha + ps;
#pragma unroll
  for (int mt = 0; mt < 2; ++mt)
#pragma unroll
    for (int i = 0; i < 16; ++i) o[mt][i] *= alpha;
  m = mnew;
}
DEV bool testbit4(unsigned w0, unsigned w1, unsigned w2, unsigned w3, int j) {
  const unsigned lo = j & 32 ? w1 : w0, hi = j & 32 ? w3 : w2;
  const unsigned x = j & 64 ? hi : lo;
  return (x >> (j & 31)) & 1u;
}

DEV void p2_nsa(const Params& p, int item, char* smem) {
  NsaSmem* sm = (NsaSmem*)smem;
  const int tid = TIDX, lane = tid & 63, wave = tid >> 6;
  const int bg = item & 3, b = bg >> 1, g = bg & 1;
  const int qt = NSA_QT - 1 - (item >> 2);
  const int t0 = qt * 32;
  const int c = lane & 31, hh = lane >> 5, tl = c >> 2, h = c & 3;
  const int trow = wave * 8 + tl;
  const int tq = t0 + trow;
  const size_t tok = (size_t)b * SEQ_LEN + tq;
  const int hd = g * 4 + h;
  const float* H = (const float*)(p.ws + OFF_H);
  const unsigned short* QB = (const unsigned short*)(p.ws + OFF_QB);
  const unsigned short* KSB = (const unsigned short*)(p.ws + OFF_KSB) + ((size_t)b * 2 + g) * SEQ_LEN * 64;
  const unsigned short* KWB = (const unsigned short*)(p.ws + OFF_KWB) + ((size_t)b * 2 + g) * SEQ_LEN * 64;
  const unsigned short* VST = (const unsigned short*)(p.ws + OFF_VST) + ((size_t)b * 2 + g) * NBLK * 4096;
  const unsigned short* VWT = (const unsigned short*)(p.ws + OFF_VWT) + ((size_t)b * 2 + g) * NBLK * 4096;
  const unsigned short* KCB = (const unsigned short*)(p.ws + OFF_KCB) + ((size_t)b * 2 + g) * NB_CMP * 4096;
  const unsigned short* VCT = (const unsigned short*)(p.ws + OFF_VCT) + ((size_t)b * 2 + g) * NB_CMP * 4096;
  bf16x8 qf[4];
  {
    const unsigned short* qrow = QB + (tok * 8 + hd) * 64;
#pragma unroll
    for (int ks = 0; ks < 4; ++ks) qf[ks] = *(const bf16x8*)(qrow + ks * 16 + hh * 8);
  }
  const float g0 = sigmoidf_(H[tok * AB_LD + 1792 + hd * 3 + 0]);
  const float g1 = sigmoidf_(H[tok * AB_LD + 1792 + hd * 3 + 1]);
  const float g2 = sigmoidf_(H[tok * AB_LD + 1792 + hd * 3 + 2]);
  f32x16 o[2], s[2];
#pragma unroll
  for (int mt = 0; mt < 2; ++mt)
#pragma unroll
    for (int i = 0; i < 16; ++i) o[mt][i] = 0.f;
  float* mixrow = (float*)(p.ws + OFF_MIX) + tok * 1024 + 512 + hd * 64 + 4 * hh;
  __syncthreads();
  for (int w = tid; w < 32 * 128; w += NTHREADS) (&sm->imp[0][0])[w] = 0.f;
  TileRegs tr;
  tr.k0 = tr.k1 = tr.v0 = tr.v1 = make_uint4(0, 0, 0, 0);
  const int nval = tq >= 31 ? (tq - 31) / 16 + 1 : 0;
  const int nvmax = (t0 + 31 - 31) / 16 + 1;
  const int ktn = (nvmax + 63) / 64;
  float m = -INFINITY, l = 0.f;
  tile_gload(tr, KCB, nullptr, tid);
  for (int kt = 0; kt < ktn; ++kt) {
    __syncthreads();
    tile_sstore(sm, tr, false, tid);
    __syncthreads();
    if (kt + 1 < ktn) tile_gload(tr, KCB + (size_t)(kt + 1) * 4096, nullptr, tid);
    qk_tile(sm->k, qf, s, lane);
    float tmax = -INFINITY;
#pragma unroll
    for (int ks2 = 0; ks2 < 2; ++ks2)
#pragma unroll
      for (int i = 0; i < 16; ++i) {
        const int n = kt * 64 + ks2 * 32 + (i & 3) + 8 * (i >> 2) + 4 * hh;
        s[ks2][i] = n < nval ? s[ks2][i] : -INFINITY;
        tmax = fmaxf(tmax, s[ks2][i]);
      }
    tmax = fmaxf(tmax, __shfl_xor(tmax, 32));
    const float mnew = fmaxf(m, tmax);
    const float msafe = mnew == -INFINITY ? 0.f : mnew;
    float ps = 0.f;
#pragma unroll
    for (int ks2 = 0; ks2 < 2; ++ks2)
#pragma unroll
      for (int i = 0; i < 16; ++i) ps += fexp2(s[ks2][i] - msafe);
    l = l * fexp2(m - msafe) + ps;
    m = mnew;
  }
  {
    const float ltot = l + __shfl_xor(l, 32);
    const float invl = ltot > 0.f ? 1.f / ltot : 0.f;
    const float msafe = m == -INFINITY ? 0.f : m;
    tile_gload(tr, KCB, VCT, tid);
    for (int kt = 0; kt < ktn; ++kt) {
      __syncthreads();
      tile_sstore(sm, tr, true, tid);
      __syncthreads();
      if (kt + 1 < ktn) tile_gload(tr, KCB + (size_t)(kt + 1) * 4096, VCT + (size_t)(kt + 1) * 4096, tid);
      qk_tile(sm->k, qf, s, lane);
#pragma unroll
      for (int ks2 = 0; ks2 < 2; ++ks2)
#pragma unroll
        for (int i = 0; i < 16; ++i) {
          const int n = kt * 64 + ks2 * 32 + (i & 3) + 8 * (i >> 2) + 4 * hh;
          s[ks2][i] = n < nval ? fexp2(s[ks2][i] - msafe) * invl : 0.f;
        }
#pragma unroll
      for (int ks2 = 0; ks2 < 2; ++ks2)
#pragma unroll
        for (int g4 = 0; g4 < 4; ++g4) {
          float A = 2.f * (s[ks2][4 * g4] + s[ks2][4 * g4 + 1] + s[ks2][4 * g4 + 2]) + s[ks2][4 * g4 + 3];
          float Bv = s[ks2][4 * g4 + 3];
          A = quad_sum(A); Bv = quad_sum(Bv);
          const int j = kt * 16 + ks2 * 8 + 2 * g4 + hh;
          if (h == 0 && j < NBLK) sm->imp[trow][j] += A;
          WAVE_SYNC();
          if (h == 0 && j + 1 < NBLK) sm->imp[trow][j + 1] += Bv;
          WAVE_SYNC();
        }
      pv_tile(sm->vt, s, o, lane);
    }
#pragma unroll
    for (int mt = 0; mt < 2; ++mt)
#pragma unroll
      for (int g4 = 0; g4 < 4; ++g4) {
        st4(mixrow + mt * 32 + 8 * g4, make_float4(o[mt][4 * g4] * g0, o[mt][4 * g4 + 1] * g0, o[mt][4 * g4 + 2] * g0, o[mt][4 * g4 + 3] * g0));
        o[mt][4 * g4] = 0.f; o[mt][4 * g4 + 1] = 0.f; o[mt][4 * g4 + 2] = 0.f; o[mt][4 * g4 + 3] = 0.f;
      }
  }
  WAVE_SYNC();
  for (int t8 = 0; t8 < 8; ++t8) {
    const int row = wave * 8 + t8, tt = t0 + row, cur = tt >> 6;
    float kv[2]; bool valid[2];
#pragma unroll
    for (int c2 = 0; c2 < 2; ++c2) {
      const int j = lane + 64 * c2;
      valid[c2] = j < NBLK && j <= cur;
      const bool forced = (j == 0) | (j == cur) | (j == cur - 1);
      kv[c2] = valid[c2] ? (forced ? 1e6f : sm->imp[row][j < NBLK ? j : 0]) : -1.f;
      sm->keyb[wave][j] = kv[c2];
    }
    WAVE_SYNC();
    int rank0 = 0, rank1 = 0;
    const int jlim = cur < NBLK - 1 ? cur : NBLK - 1;
    for (int jj = 0; jj <= jlim; ++jj) {
      const float ov = sm->keyb[wave][jj];
      rank0 += (ov > kv[0] || (ov == kv[0] && jj < lane)) ? 1 : 0;
      rank1 += (ov > kv[1] || (ov == kv[1] && jj < lane + 64)) ? 1 : 0;
    }
    const unsigned long long m0 = __ballot(valid[0] && rank0 < 16);
    const unsigned long long m1 = __ballot(valid[1] && rank1 < 16);
    if (lane == 0) {
      sm->selmask[row][0] = (unsigned)m0; sm->selmask[row][1] = (unsigned)(m0 >> 32);
      sm->selmask[row][2] = (unsigned)m1; sm->selmask[row][3] = (unsigned)(m1 >> 32);
    }
    WAVE_SYNC();
  }
  __syncthreads();
  if (tid < 4) {
    unsigned u = 0;
    for (int r = 0; r < 32; ++r) u |= sm->selmask[r][tid];
    sm->unionm[tid] = u;
  }
  __syncthreads();
  const unsigned um0 = sm->unionm[0], um1 = sm->unionm[1], um2 = sm->unionm[2], um3 = sm->unionm[3];
  const unsigned my0 = sm->selmask[trow][0], my1 = sm->selmask[trow][1], my2 = sm->selmask[trow][2], my3 = sm->selmask[trow][3];
  {
    const int jmax = (t0 + 31) >> 6;
    int j = 0;
    while (j <= jmax && !testbit4(um0, um1, um2, um3, j)) ++j;
    m = -INFINITY; l = 0.f;
    if (j <= jmax) tile_gload(tr, KSB + (size_t)j * 4096, VST + (size_t)j * 4096, tid);
    while (j <= jmax) {
      __syncthreads();
      tile_sstore(sm, tr, true, tid);
      __syncthreads();
      int jn = j + 1;
      while (jn <= jmax && !testbit4(um0, um1, um2, um3, jn)) ++jn;
      if (jn <= jmax) tile_gload(tr, KSB + (size_t)jn * 4096, VST + (size_t)jn * 4096, tid);
      const bool mine = testbit4(my0, my1, my2, my3, j);
      if (__ballot(mine) != 0ull) {
        qk_tile(sm->k, qf, s, lane);
#pragma unroll
        for (int ks2 = 0; ks2 < 2; ++ks2)
#pragma unroll
          for (int i = 0; i < 16; ++i) {
            const int kp = j * 64 + ks2 * 32 + (i & 3) + 8 * (i >> 2) + 4 * hh;
            s[ks2][i] = (mine && kp <= tq) ? s[ks2][i] : -INFINITY;
          }
        softmax_step(s, m, l, o);
        pv_tile(sm->vt, s, o, lane);
      }
      j = jn;
    }
    const float ltot = l + __shfl_xor(l, 32);
    const float sc = ltot > 0.f ? g1 / ltot : 0.f;
#pragma unroll
    for (int mt = 0; mt < 2; ++mt)
#pragma unroll
      for (int g4 = 0; g4 < 4; ++g4) {
        float4 a = ld4(mixrow + mt * 32 + 8 * g4);
        a.x += o[mt][4 * g4] * sc; a.y += o[mt][4 * g4 + 1] * sc; a.z += o[mt][4 * g4 + 2] * sc; a.w += o[mt][4 * g4 + 3] * sc;
        st4(mixrow + mt * 32 + 8 * g4, a);
        o[mt][4 * g4] = 0.f; o[mt][4 * g4 + 1] = 0.f; o[mt][4 * g4 + 2] = 0.f; o[mt][4 * g4 + 3] = 0.f;
      }
  }
  {
    const int jlo = t0 - 511 > 0 ? (t0 - 511) >> 6 : 0, jhi = (t0 + 31) >> 6;
    const int wq0 = t0 + wave * 8;
    m = -INFINITY; l = 0.f;
    tile_gload(tr, KWB + (size_t)jlo * 4096, VWT + (size_t)jlo * 4096, tid);
    for (int j = jlo; j <= jhi; ++j) {
      __syncthreads();
      tile_sstore(sm, tr, true, tid);
      __syncthreads();
      if (j + 1 <= jhi) tile_gload(tr, KWB + (size_t)(j + 1) * 4096, VWT + (size_t)(j + 1) * 4096, tid);
      if (j * 64 <= wq0 + 7 && j * 64 + 63 > wq0 - 512) {
        qk_tile(sm->k, qf, s, lane);
#pragma unroll
        for (int ks2 = 0; ks2 < 2; ++ks2)
#pragma unroll
          for (int i = 0; i < 16; ++i) {
            const int kp = j * 64 + ks2 * 32 + (i & 3) + 8 * (i >> 2) + 4 * hh;
            s[ks2][i] = (kp <= tq && kp > tq - 512) ? s[ks2][i] : -INFINITY;
          }
        softmax_step(s, m, l, o);
        pv_tile(sm->vt, s, o, lane);
      }
    }
    const float ltot = l + __shfl_xor(l, 32);
    const float sc = ltot > 0.f ? g2 / ltot : 0.f;
#pragma unroll
    for (int mt = 0; mt < 2; ++mt)
#pragma unroll
      for (int g4 = 0; g4 < 4; ++g4) {
        float4 a = ld4(mixrow + mt * 32 + 8 * g4);
        a.x += o[mt][4 * g4] * sc; a.y += o[mt][4 * g4 + 1] * sc; a.z += o[mt][4 * g4 + 2] * sc; a.w += o[mt][4 * g4 + 3] * sc;
        st4(mixrow + mt * 32 + 8 * g4, a);
        o[mt][4 * g4] = 0.f; o[mt][4 * g4 + 1] = 0.f; o[mt][4 * g4 + 2] = 0.f; o[mt][4 * g4 + 3] = 0.f;
      }
  }
}

#define P1_SMEM ((8 * 64 + 8 * 128 + 64 * 65 + 128) * 4)
DEV void phase_p1(const Params& p, char* smem) {
  const int total = P1_CMPG_ITEMS + P1_CMPC1_ITEMS + P1_PREP_ITEMS;
  for (int it = BIDX; it < total; it += gridDim.x) {
    if (it < P1_CMPG_ITEMS) p1_cmpgemm(p, it, smem);
    else if (it < P1_CMPG_ITEMS + P1_CMPC1_ITEMS) p1_cmpc1(p, it - P1_CMPG_ITEMS, smem);
    else p1_prep(p, it - P1_CMPG_ITEMS - P1_CMPC1_ITEMS, smem);
  }
  {
    const int Gh = (int)gridDim.x / 2, bid_ = BIDX;
    if (bid_ < Gh) for (int it = bid_; it < P1_S5A_SPLIT; it += Gh) p1_s5a(p, it, smem);
  }
}
DEV void phase_p1b(const Params& p, char* smem) {
  for (int it = BIDX; it < P1_CMP_ITEMS; it += gridDim.x) p1_compress(p, it, smem);
  {
    const int Gh = (int)gridDim.x / 2, bid_ = BIDX, first = P1_CMP_ITEMS < Gh ? P1_CMP_ITEMS : 0;
    if (bid_ >= first && bid_ < Gh) for (int it = P1_S5A_SPLIT + bid_ - first; it < P1_S5A_ITEMS; it += Gh - first) p1_s5a(p, it, smem);
  }
}

#define P2_S5C_ITEMS (BATCH * 32 * S5_NC / 4)
#define S5C_ROW 132
#define P2_S5C_SMEM (4 * 16 * S5C_ROW * 4 + 4 * 64 * 16 * 4)
DEV void p2_s5c(const Params& p, int item, char* smem) {
  const int lane = TIDX & 63, wave = TIDX >> 6;
  const int idx = item * 4 + wave;
  const int g = idx & 31, c = (idx >> 5) % S5_NC, b = idx / (32 * S5_NC);
  float lb_re, lb_im, bbr[16], bbi[16];
  s5_consts(p, g, lane, lb_re, lb_im, bbr, bbi);
  float ar = lb_re, ai = lb_im;
#pragma unroll
  for (int s = 0; s < 6; ++s) { const float nr = ar * ar - ai * ai, ni = 2.f * ar * ai; ar = nr; ai = ni; }
  const float2* E = (const float2*)(p.ws + OFF_S5E);
  float sr = 0.f, si = 0.f;
  {
    int cc = 0;
    for (; cc + 8 <= c; cc += 8) {
      float2 e[8];
#pragma unroll
      for (int q = 0; q < 8; ++q) e[q] = E[((size_t)(b * S5_NC + cc + q) * 32 + g) * 64 + lane];
#pragma unroll
      for (int q = 0; q < 8; ++q) {
        const float nr = ar * sr - ai * si + e[q].x, ni = ar * si + ai * sr + e[q].y;
        sr = nr; si = ni;
      }
    }
    for (; cc < c; ++cc) {
      const float2 e = E[((size_t)(b * S5_NC + cc) * 32 + g) * 64 + lane];
      const float nr = ar * sr - ai * si + e.x, ni = ar * si + ai * sr + e.y;
      sr = nr; si = ni;
    }
  }
  __syncthreads();
  const float* H = (const float*)(p.ws + OFF_H);
  float* sS = (float*)smem + wave * 16 * S5C_ROW;
  float* su = (float*)smem + 4 * 16 * S5C_ROW + wave * 64 * 16;
  {
    const float* ur = H + (size_t)(b * SEQ_LEN + c * 64 + lane) * AB_LD + g * 16;
#pragma unroll
    for (int q = 0; q < 4; ++q) st4(su + lane * 16 + q * 4, ld4(ur + q * 4));
  }
  __syncthreads();
  const float* cre = p.in[I_S5_C_RE] + (size_t)g * 16 * 64;
  const float* cim = p.in[I_S5_C_IM] + (size_t)g * 16 * 64;
  float* YG = (float*)(p.ws + OFF_YGELU);
  for (int sc = 0; sc < 4; ++sc) {
    for (int tt = 0; tt < 16; ++tt) {
      const float* u = su + (sc * 16 + tt) * 16;
      float dr = 0.f, di = 0.f;
#pragma unroll
      for (int h4 = 0; h4 < 4; ++h4) {
        const float4 uv = ld4(u + h4 * 4);
        dr += uv.x * bbr[h4 * 4] + uv.y * bbr[h4 * 4 + 1] + uv.z * bbr[h4 * 4 + 2] + uv.w * bbr[h4 * 4 + 3];
        di += uv.x * bbi[h4 * 4] + uv.y * bbi[h4 * 4 + 1] + uv.z * bbi[h4 * 4 + 2] + uv.w * bbi[h4 * 4 + 3];
      }
      const float nr = lb_re * sr - lb_im * si + dr, ni = lb_re * si + lb_im * sr + di;
      sr = nr; si = ni;
      sS[tt * S5C_ROW + lane] = sr;
      sS[tt * S5C_ROW + 64 + lane] = si;
    }
    __syncthreads();
    {
      const int tt = lane >> 2, hq = lane & 3;
      float y[4] = {0.f, 0.f, 0.f, 0.f};
#pragma unroll 2
      for (int k = 0; k < 64; k += 4) {
        const float4 vr = ld4(sS + tt * S5C_ROW + k), vi = ld4(sS + tt * S5C_ROW + 64 + k);
#pragma unroll
        for (int hh = 0; hh < 4; ++hh) {
          const float4 cr = ld4(cre + (hq * 4 + hh) * 64 + k), ci = ld4(cim + (hq * 4 + hh) * 64 + k);
          y[hh] += vr.x * cr.x + vr.y * cr.y + vr.z * cr.z + vr.w * cr.w - (vi.x * ci.x + vi.y * ci.y + vi.z * ci.z + vi.w * ci.w);
        }
      }
      const size_t tok = (size_t)(b * SEQ_LEN + c * 64 + sc * 16 + tt);
      const int ch = g * 16 + hq * 4;
      const float4 uv = ld4(H + tok * AB_LD + ch);
      const float4 dv = ld4(p.in[I_S5_D] + ch);
      float4 o;
      o.x = geluf_(y[0] + dv.x * uv.x); o.y = geluf_(y[1] + dv.y * uv.y);
      o.z = geluf_(y[2] + dv.z * uv.z); o.w = geluf_(y[3] + dv.w * uv.w);
      st4(YG + tok * 512 + ch, o);
    }
    __syncthreads();
  }
}

#define P2_SMEM (P2_S5C_SMEM > P2_NSA_SMEM ? P2_S5C_SMEM : P2_NSA_SMEM)
DEV void phase_p2(const Params& p, char* smem) {
  const int G = gridDim.x;
  const int total = P2_NSA_ITEMS + P2_S5C_ITEMS;
  for (int r = 0;; ++r) {
    const int it = r * G + ((r & 1) ? (G - 1 - (int)BIDX) : (int)BIDX);
    if (r * G >= total) break;
    if (it >= total) continue;
    if (it < P2_NSA_ITEMS) p2_nsa(p, it, smem);
    else p2_s5c(p, it - P2_NSA_ITEMS, smem);
  }
}

DEV void phase_glu(const Params& p, char* smem) {
  const float* A = (const float*)(p.ws + OFF_YGELU);
  const float* B = p.in[I_S5_W_GLU];
  const float* bias = p.in[I_S5_B_GLU];
  float* MIX = (float*)(p.ws + OFF_MIX);
  const int NT = 4, MT = NTOK / GEMM_BM;
  const int xcd_ = BIDX & 7, lb_ = BIDX >> 3, nb_ = gridDim.x >> 3;
  for (int j_ = lb_; j_ < (MT / 8) * NT; j_ += nb_) {
    const int it = (xcd_ + 8 * (j_ / NT)) * NT + (j_ % NT);
    const int m0 = (it / NT) * GEMM_BM, n0 = (it % NT) * 128;
    gemm_tile<false>(
        [&](int r) { return (const void*)(A + (size_t)(m0 + r) * 512); },
        [&](int c) { return B + n0 + c; }, 512, 512,
        [&](int row, int col, float v0, float v1) {
          const size_t gm = m0 + row; const int gc = n0 + col;
          const float y0 = A[gm * 512 + gc], y1 = A[gm * 512 + gc + 32];
          MIX[gm * 1024 + gc] = y0 * sigmoidf_(v0 + bias[gc]);
          MIX[gm * 1024 + gc + 32] = y1 * sigmoidf_(v1 + bias[gc + 32]);
        },
        smem);
  }
}

template <int LAYER>
DEV void phase_outproj(const Params& p, char* smem) {
  const float* A = (const float*)(p.ws + OFF_MIX);
  const float* B = LAYER == 0 ? p.in[I_AB_W_OUT] : p.in[I_CD_W_OUT];
  const float* xin = LAYER == 0 ? p.in[I_X] : (const float*)(p.ws + OFF_X2);
  float* PRE = (float*)(p.ws + OFF_H);
  const int NT = 8, MT = NTOK / GEMM_BM;
  const int xcd_ = BIDX & 7, lb_ = BIDX >> 3, nb_ = gridDim.x >> 3;
  for (int j_ = lb_; j_ < (MT / 8) * NT; j_ += nb_) {
    const int it = (xcd_ + 8 * (j_ / NT)) * NT + (j_ % NT);
    const int m0 = (it / NT) * GEMM_BM, n0 = (it % NT) * 128;
    gemm_tile<false>(
        [&](int r) { return (const void*)(A + (size_t)(m0 + r) * 1024); },
        [&](int c) { return B + n0 + c; }, 1024, 1024,
        [&](int row, int col, float v0, float v1) {
          const size_t o = (size_t)(m0 + row) * 1024 + n0 + col;
          PRE[o] = ALPHA_F * xin[o] + v0;
          PRE[o + 32] = ALPHA_F * xin[o + 32] + v1;
        },
        smem);
  }
}

DEV void wave_ln(float (&v)[16], const float* gam, const float* bet, int lane) {
  float s = 0.f;
#pragma unroll
  for (int i = 0; i < 16; ++i) s += v[i];
  const float mu = wave_sum(s) * (1.f / 1024.f);
  float q = 0.f;
#pragma unroll
  for (int i = 0; i < 16; ++i) { const float d = v[i] - mu; q += d * d; }
  const float rstd = rsqrtf(wave_sum(q) * (1.f / 1024.f) + 1e-5f);
#pragma unroll
  for (int i = 0; i < 4; ++i) {
    const float4 gv = ld4(gam + lane * 4 + 256 * i), bv = ld4(bet + lane * 4 + 256 * i);
    v[i * 4 + 0] = (v[i * 4 + 0] - mu) * rstd * gv.x + bv.x;
    v[i * 4 + 1] = (v[i * 4 + 1] - mu) * rstd * gv.y + bv.y;
    v[i * 4 + 2] = (v[i * 4 + 2] - mu) * rstd * gv.z + bv.z;
    v[i * 4 + 3] = (v[i * 4 + 3] - mu) * rstd * gv.w + bv.w;
  }
}

#define LNR_T 2
#define P5_SMEM ((4 * LNR_T * 1024 + 4 * 4 * LNR_T * 64 + 4 * 64) * 4)
template <int LAYER>
DEV void phase_ln_router(const Params& p, char* smem) {
  const int lane = TIDX & 63, wave = TIDX >> 6;
  const float* PRE = (const float*)(p.ws + OFF_H);
  float* X1 = (float*)(p.ws + OFF_X1);
  const float* router = p.in[I_ROUTER] + (size_t)LAYER * 1024 * 64;
  const float* bias = p.in[I_MOE_BIAS] + LAYER * 64;
  int* TOPI = (int*)(p.ws + OFF_TOPI);
  float* TOPG = (float*)(p.ws + OFF_TOPG);
  float* xall = (float*)smem;
  float* part = xall + 4 * LNR_T * 1024;
  float* ms = part + 4 * 4 * LNR_T * 64 + wave * 64;
  float* xs = xall + wave * LNR_T * 1024;
  unsigned short* X1B = (unsigned short*)p.out;
  for (int it = BIDX; it < NTOK / (4 * LNR_T); it += gridDim.x) {
    const size_t tokb = (size_t)it * (4 * LNR_T) + wave * LNR_T;
    __syncthreads();
#pragma unroll 1
    for (int t = 0; t < LNR_T; ++t) {
      const size_t tok = tokb + t;
      float v[16];
#pragma unroll
      for (int i = 0; i < 4; ++i) {
        const float4 a = ld4(PRE + tok * 1024 + lane * 4 + 256 * i);
        v[i * 4] = a.x; v[i * 4 + 1] = a.y; v[i * 4 + 2] = a.z; v[i * 4 + 3] = a.w;
      }
      wave_ln(v, p.in[I_LN1_G] + LAYER * 1024, p.in[I_LN1_B] + LAYER * 1024, lane);
#pragma unroll
      for (int i = 0; i < 4; ++i) {
        const float4 a = make_float4(v[i * 4], v[i * 4 + 1], v[i * 4 + 2], v[i * 4 + 3]);
        st4(X1 + tok * 1024 + lane * 4 + 256 * i, a);
        st4(xs + t * 1024 + lane * 4 + 256 * i, a);
        *(uint2*)(X1B + tok * 1024 + lane * 4 + 256 * i) = make_uint2(pk2(a.x, a.y), pk2(a.z, a.w));
      }
    }
    __syncthreads();
    {
      float pl[4 * LNR_T];
#pragma unroll
      for (int t = 0; t < 4 * LNR_T; ++t) pl[t] = 0.f;
#pragma unroll 2
      for (int k = wave * 256; k < wave * 256 + 256; k += 4) {
        const float r0 = router[(size_t)k * 64 + lane], r1 = router[(size_t)(k + 1) * 64 + lane],
                    r2 = router[(size_t)(k + 2) * 64 + lane], r3 = router[(size_t)(k + 3) * 64 + lane];
#pragma unroll
        for (int t = 0; t < 4 * LNR_T; ++t) {
          const float4 xv = ld4(xall + t * 1024 + k);
          pl[t] += xv.x * r0 + xv.y * r1 + xv.z * r2 + xv.w * r3;
        }
      }
#pragma unroll
      for (int t = 0; t < 4 * LNR_T; ++t) part[(wave * 4 * LNR_T + t) * 64 + lane] = pl[t];
    }
    __syncthreads();
    float lg[LNR_T];
#pragma unroll
    for (int t = 0; t < LNR_T; ++t) {
      const int tg = wave * LNR_T + t;
      lg[t] = ((part[(0 * 4 * LNR_T + tg) * 64 + lane] + part[(1 * 4 * LNR_T + tg) * 64 + lane]) + part[(2 * 4 * LNR_T + tg) * 64 + lane]) +
              part[(3 * 4 * LNR_T + tg) * 64 + lane];
    }
#pragma unroll
    for (int t = 0; t < LNR_T; ++t) {
      const size_t tok = tokb + t;
      const float score = 1.f / (1.f + expf(-lg[t]));
      const float biased = score + bias[lane];
      float m1 = biased; int a1 = lane;
#pragma unroll
      for (int mm = 1; mm <= 4; mm <<= 1) {
        const float ov = __shfl_xor(m1, mm); const int oa = __shfl_xor(a1, mm);
        if (ov > m1 || (ov == m1 && oa < a1)) { m1 = ov; a1 = oa; }
      }
      float m2 = lane == a1 ? -INFINITY : biased;
#pragma unroll
      for (int mm = 1; mm <= 4; mm <<= 1) m2 = fmaxf(m2, __shfl_xor(m2, mm));
      const float gs = m1 + m2;
      const int mygrp = lane >> 3;
      int rank = 0;
#pragma unroll
      for (int gg = 0; gg < 8; ++gg) {
        const float og = __shfl(gs, gg * 8);
        rank += (og > gs || (og == gs && gg < mygrp)) ? 1 : 0;
      }
      const float masked = rank < 4 ? biased : -INFINITY;
      WAVE_SYNC();
      ms[lane] = masked;
      WAVE_SYNC();
      int erank = 0;
      for (int e = 0; e < 64; ++e) {
        const float ov = ms[e];
        erank += (ov > masked || (ov == masked && e < lane)) ? 1 : 0;
      }
      const bool selected = erank < 8;
      const float gsum = wave_sum(selected ? score : 0.f);
      if (selected) {
        TOPI[tok * 8 + erank] = lane;
        TOPG[tok * 8 + erank] = score / gsum * 2.5f;
      }
    }
  }
}

#define P6_SMEM GEMM_SMEM_BYTES
template <int LAYER>
DEV void phase_lists_shup(const Params& p, char* smem) {
  const int tid = TIDX, lane = tid & 63, wave = tid >> 6;
  const int* TOPI = (const int*)(p.ws + OFF_TOPI);
  const float* TOPG = (const float*)(p.ws + OFF_TOPG);
  int* PPOS = (int*)(p.ws + OFF_S5E);
  int* CNT = (int*)(p.ws + OFF_CNT);
  int* LTOK = (int*)(p.ws + OFF_LTOK);
  float* LGATE = (float*)(p.ws + OFF_LGATE);
  const unsigned short* X1B = (const unsigned short*)p.out;
  unsigned short* HS = (unsigned short*)(p.ws + OFF_HS);
  const float* W1 = p.in[I_SH_W1] + (size_t)LAYER * 1024 * 256;
  const float* W3 = p.in[I_SH_W3] + (size_t)LAYER * 1024 * 256;
  const int MT = NTOK / GEMM_BM;
  int* swave = (int*)smem;
  for (int it = BIDX; it < 64; it += gridDim.x) {
    const int e = it;
    int base = 0;
    for (int t0 = 0; t0 < NTOK; t0 += 4 * NTHREADS) {
      const int tok4 = t0 + 4 * tid;
      int slot[4];
      unsigned long long bal[4];
#pragma unroll
      for (int j = 0; j < 4; ++j) {
        const int4 a = *(const int4*)(TOPI + (size_t)(tok4 + j) * 8), b = *(const int4*)(TOPI + (size_t)(tok4 + j) * 8 + 4);
        int sl = -1;
        sl = a.x == e ? 0 : sl; sl = a.y == e ? 1 : sl; sl = a.z == e ? 2 : sl; sl = a.w == e ? 3 : sl;
        sl = b.x == e ? 4 : sl; sl = b.y == e ? 5 : sl; sl = b.z == e ? 6 : sl; sl = b.w == e ? 7 : sl;
        slot[j] = sl;
        bal[j] = __ballot(sl >= 0);
      }
      const unsigned long long lower = (1ull << lane) - 1ull;
      int pre = 0, wtot = 0;
#pragma unroll
      for (int j = 0; j < 4; ++j) { pre += __popcll(bal[j] & lower); wtot += __popcll(bal[j]); }
      __syncthreads();
      if (lane == 0) swave[wave] = wtot;
      __syncthreads();
      int woff = 0, tot = 0;
#pragma unroll
      for (int w = 0; w < 4; ++w) { const int c = swave[w]; if (w < wave) woff += c; tot += c; }
      int pos = base + woff + pre;
#pragma unroll
      for (int j = 0; j < 4; ++j) {
        if (slot[j] >= 0) {
          const int tok = tok4 + j;
          LTOK[(size_t)e * NTOK + pos] = tok;
          LGATE[(size_t)e * NTOK + pos] = TOPG[(size_t)tok * 8 + slot[j]];
          PPOS[(size_t)e * NTOK + tok] = pos;
          ++pos;
        }
      }
      base += tot;
    }
    if (tid == 0) CNT[e * 32] = base;
    __syncthreads();
  }
  {
    const int NT = 4;
    const int xcd_ = BIDX & 7, lb_ = BIDX >> 3, nb_ = gridDim.x >> 3;
    for (int j_ = lb_; j_ < (MT / 8) * NT; j_ += nb_) {
      const int m0 = (xcd_ + 8 * (j_ / NT)) * GEMM_BM, ct = j_ % NT;
      gemm_tile<true>(
          [&](int r) { return (const void*)(X1B + (size_t)(m0 + r) * 1024); },
          [&](int c) { return (((c >> 5) & 1) ? W3 : W1) + ct * 64 + (c >> 6) * 32 + (c & 31); }, 256, 1024,
          [&](int row, int col, float v0, float v1) {
            const int lc = ct * 64 + (col >> 6) * 32 + (col & 31);
            HS[(size_t)(m0 + row) * 256 + lc] = f2bf(siluf_(v0) * v1);
          },
          smem);
    }
  }
}

struct ExpMap { int tstart[65]; int rbase[65]; int ltile[9]; };
DEV void build_expmap(const Params& p, ExpMap* em) {
  __syncthreads();
  if (TIDX == 0) {
    const int* CNT = (const int*)(p.ws + OFF_CNT);
    int ts = 0, rb = 0;
    for (int e = 0; e < 64; ++e) {
      em->tstart[e] = ts; em->rbase[e] = rb;
      const int c = CNT[e * 32];
      ts += (c + GEMM_BM - 1) / GEMM_BM; rb += c;
    }
    em->tstart[64] = ts; em->rbase[64] = rb;
    const int x = BIDX & 7;
    int lt = 0;
    for (int k = 0; k < 8; ++k) { em->ltile[k] = lt; lt += em->tstart[x + 8 * k + 1] - em->tstart[x + 8 * k]; }
    em->ltile[8] = lt;
  }
  __syncthreads();
}
DEV void map_expert_tile(const ExpMap* em, int j, int CT, int& e, int& rt, int& ct) {
  const int jr = j / CT; ct = j % CT;
  int k = 0;
  for (int q = 1; q < 8; ++q) if (em->ltile[q] <= jr) k = q;
  e = (BIDX & 7) + 8 * k; rt = jr - em->ltile[k];
}
#define P7_SMEM (GEMM_SMEM_BYTES + 1024)
template <int LAYER>
DEV void phase_routed_up(const Params& p, char* smem) {
  ExpMap* em = (ExpMap*)(smem + GEMM_SMEM_BYTES);
  build_expmap(p, em);
  const int* CNT = (const int*)(p.ws + OFF_CNT);
  const int* LTOK = (const int*)(p.ws + OFF_LTOK);
  const unsigned short* X1B = (const unsigned short*)p.out;
  unsigned short* HR = (unsigned short*)(p.ws + OFF_HR);
  const int lb_ = BIDX >> 3, nb_ = gridDim.x >> 3;
  for (int j_ = lb_; j_ < em->ltile[8] * 4; j_ += nb_) {
    int e, rtl, ct;
    map_expert_tile(em, j_, 4, e, rtl, ct);
    const int r0 = rtl * GEMM_BM;
    const int cnt = CNT[e * 32], rbase = em->rbase[e];
    const float* W1 = p.in[I_MOE_W1] + ((size_t)LAYER * 64 + e) * 1024 * 256;
    const float* W3 = p.in[I_MOE_W3] + ((size_t)LAYER * 64 + e) * 1024 * 256;
    gemm_tile<true>(
        [&](int r) { return (r0 + r < cnt) ? (const void*)(X1B + (size_t)LTOK[(size_t)e * NTOK + r0 + r] * 1024) : (const void*)nullptr; },
        [&](int c) { return (((c >> 5) & 1) ? W3 : W1) + ct * 64 + (c >> 6) * 32 + (c & 31); }, 256, 1024,
        [&](int row, int col, float v0, float v1) {
          if (r0 + row < cnt) {
            const int lc = ct * 64 + (col >> 6) * 32 + (col & 31);
            HR[(size_t)(rbase + r0 + row) * 256 + lc] = f2bf(siluf_(v0) * v1);
          }
        },
        smem);
  }
}

template <int LAYER>
DEV void phase_down(const Params& p, char* smem) {
  ExpMap* em = (ExpMap*)(smem + GEMM_SMEM_BYTES);
  build_expmap(p, em);
  const int* CNT = (const int*)(p.ws + OFF_CNT);
  const float* LGATE = (const float*)(p.ws + OFF_LGATE);
  const unsigned short* HR = (const unsigned short*)(p.ws + OFF_HR);
  const unsigned short* HS = (const unsigned short*)(p.ws + OFF_HS);
  unsigned short* Y = (unsigned short*)(p.ws + OFF_Y);
  float* FS = (float*)(p.ws + OFF_FS);
  const int xcd_ = BIDX & 7, lb_ = BIDX >> 3, nb_ = gridDim.x >> 3;
  for (int j_ = lb_; j_ < em->ltile[8] * 8; j_ += nb_) {
    int e, rtl, ct;
    map_expert_tile(em, j_, 8, e, rtl, ct);
    const int r0 = rtl * GEMM_BM;
    const int cnt = CNT[e * 32], rbase = em->rbase[e];
    const float* W2 = p.in[I_MOE_W2] + ((size_t)LAYER * 64 + e) * 256 * 1024;
    const int n0 = ct * 128;
    gemm_tile<true>(
        [&](int r) { return (r0 + r < cnt) ? (const void*)(HR + (size_t)(rbase + r0 + r) * 256) : (const void*)nullptr; },
        [&](int c) { return W2 + n0 + c; }, 1024, 256,
        [&](int row, int col, float v0, float v1) {
          if (r0 + row < cnt) {
            const float gt = LGATE[(size_t)e * NTOK + r0 + row];
            const size_t o = (size_t)(rbase + r0 + row) * 1024 + n0 + col;
            Y[o] = f2bf(v0 * gt); Y[o + 32] = f2bf(v1 * gt);
          }
        },
        smem);
  }
  {
    const int MT = NTOK / GEMM_BM, NT = 8;
    const float* W2 = p.in[I_SH_W2] + (size_t)LAYER * 256 * 1024;
    for (int j_ = lb_; j_ < (MT / 8) * NT; j_ += nb_) {
      const int m0 = (xcd_ + 8 * (j_ / NT)) * GEMM_BM, n0 = (j_ % NT) * 128;
      gemm_tile<true>(
          [&](int r) { return (const void*)(HS + (size_t)(m0 + r) * 256); },
          [&](int c) { return W2 + n0 + c; }, 1024, 256,
          [&](int row, int col, float v0, float v1) {
            const size_t o = (size_t)(m0 + row) * 1024 + n0 + col;
            FS[o] = v0; FS[o + 32] = v1;
          },
          smem);
    }
  }
}

template <int LAYER>
DEV void phase_combine(const Params& p, char* smem) {
  ExpMap* em = (ExpMap*)smem;
  build_expmap(p, em);
  const int lane = TIDX & 63, wave = TIDX >> 6;
  const float* X1 = (const float*)(p.ws + OFF_X1);
  const float* FS = (const float*)(p.ws + OFF_FS);
  const unsigned short* Y = (const unsigned short*)(p.ws + OFF_Y);
  const int* TOPI = (const int*)(p.ws + OFF_TOPI);
  const int* PPOS = (const int*)(p.ws + OFF_S5E);
  float* OUT = LAYER == 0 ? (float*)(p.ws + OFF_X2) : p.out;
  for (int it = BIDX; it < NTOK / 4; it += gridDim.x) {
    const size_t tok = (size_t)it * 4 + wave;
    float v[16];
#pragma unroll
    for (int i = 0; i < 4; ++i) {
      const float4 a = ld4(X1 + tok * 1024 + lane * 4 + 256 * i), f = ld4(FS + tok * 1024 + lane * 4 + 256 * i);
      v[i * 4] = ALPHA_F * a.x + f.x; v[i * 4 + 1] = ALPHA_F * a.y + f.y; v[i * 4 + 2] = ALPHA_F * a.z + f.z; v[i * 4 + 3] = ALPHA_F * a.w + f.w;
    }
    size_t rows[8];
#pragma unroll
    for (int s = 0; s < 8; ++s) { const int e_ = TOPI[tok * 8 + s]; rows[s] = (size_t)em->rbase[e_] + PPOS[(size_t)e_ * NTOK + tok]; }
#pragma unroll
    for (int s0 = 0; s0 < 8; s0 += 4) {
      uint2 yy[4][4];
#pragma unroll
      for (int s = 0; s < 4; ++s)
#pragma unroll
        for (int i = 0; i < 4; ++i) yy[s][i] = *(const uint2*)(Y + rows[s0 + s] * 1024 + lane * 4 + 256 * i);
#pragma unroll
      for (int s = 0; s < 4; ++s)
#pragma unroll
        for (int i = 0; i < 4; ++i) {
          const uint2 y = yy[s][i];
          v[i * 4] += bf2f((unsigned short)(y.x & 0xFFFF)); v[i * 4 + 1] += bf2f((unsigned short)(y.x >> 16));
          v[i * 4 + 2] += bf2f((unsigned short)(y.y & 0xFFFF)); v[i * 4 + 3] += bf2f((unsigned short)(y.y >> 16));
        }
    }
    wave_ln(v, p.in[I_LN2_G] + LAYER * 1024, p.in[I_LN2_B] + LAYER * 1024, lane);
#pragma unroll
    for (int i = 0; i < 4; ++i) st4(OUT + tok * 1024 + lane * 4 + 256 * i, make_float4(v[i * 4], v[i * 4 + 1], v[i * 4 + 2], v[i * 4 + 3]));
    if (LAYER == 0) {
      unsigned short* X2B = (unsigned short*)(p.ws + OFF_X2B);
#pragma unroll
      for (int i = 0; i < 4; ++i) *(uint2*)(X2B + tok * 1024 + lane * 4 + 256 * i) = make_uint2(pk2(v[i * 4], v[i * 4 + 1]), pk2(v[i * 4 + 2], v[i * 4 + 3]));
    }
  }
}

DEV float shifted(const float* Hc, size_t tok, int col, const float* mu) {
  const float cur = Hc[tok * 1792 + col];
  const float prev = (tok % SEQ_LEN) == 0 ? 0.f : Hc[(tok - 1) * 1792 + col];
  return cur + (prev - cur) * mu[col];
}

#define RWP_T 32
#define P11_PREP_ITEMS (NTOK / RWP_T)
#define P11_KV_ITEMS (BATCH * 4 * RET_NC)
#define P11_SMEM (RWP_T * 128 * 4)
DEV void p11_prep(const Params& p, int item, char* smem) {
  const int tid = TIDX;
  const float* Hc = (const float*)(p.ws + OFF_H);
  const float* mu = p.in[I_RW_MU];
  float* sl = (float*)smem;
  __syncthreads();
  for (int w = tid; w < RWP_T * 128; w += NTHREADS) {
    const int tt = w >> 7, j = w & 127;
    const size_t tok = (size_t)item * RWP_T + tt;
    const float v = shifted(Hc, tok, 1536 + j, mu);
    sl[w] = j < 64 ? tanhf(v) : v;
    ((float*)(p.ws + OFF_GLO))[tok * 128 + j] = sigmoidf_(shifted(Hc, tok, 1664 + j, mu));
  }
  __syncthreads();
  float* RWW = (float*)(p.ws + OFF_RWW); float* RWK = (float*)(p.ws + OFF_RWK);
  float* RWKK = (float*)(p.ws + OFF_RWKK); float* RWA = (float*)(p.ws + OFF_RWA);
  float* RWR = p.out + (size_t)NTOK * 512; float* RWV = p.out;
  const float* w_up = p.in[I_RW_W_UP]; const float* a_up = p.in[I_RW_A_UP];
#pragma unroll
  for (int cc = 0; cc < 2; ++cc) {
    const int c = tid + 256 * cc;
    float aw[RWP_T], aa[RWP_T];
#pragma unroll
    for (int tt = 0; tt < RWP_T; ++tt) { aw[tt] = 0.f; aa[tt] = 0.f; }
    for (int j0 = 0; j0 < 64; j0 += 16) {
      float wu[16], au[16];
#pragma unroll
      for (int q = 0; q < 16; ++q) { wu[q] = w_up[(j0 + q) * 512 + c]; au[q] = a_up[(j0 + q) * 512 + c]; }
#pragma unroll
      for (int q4 = 0; q4 < 4; ++q4) {
#pragma unroll
        for (int tt = 0; tt < RWP_T; ++tt) {
          const float4 sw = ld4(sl + tt * 128 + j0 + q4 * 4), sa = ld4(sl + tt * 128 + 64 + j0 + q4 * 4);
          aw[tt] += sw.x * wu[q4 * 4] + sw.y * wu[q4 * 4 + 1] + sw.z * wu[q4 * 4 + 2] + sw.w * wu[q4 * 4 + 3];
          aa[tt] += sa.x * au[q4 * 4] + sa.y * au[q4 * 4 + 1] + sa.z * au[q4 * 4 + 2] + sa.w * au[q4 * 4 + 3];
        }
      }
    }
    const float w0 = p.in[I_RW_W0][c], a0 = p.in[I_RW_A0][c], kkc = p.in[I_RW_K_K][c], kac = p.in[I_RW_K_A][c];
#pragma unroll 4
    for (int tt = 0; tt < RWP_T; ++tt) {
      const size_t tok = (size_t)item * RWP_T + tt;
      const float lw = w0 + aw[tt];
      const float nl = -lw;
      const float sp = nl > 20.f ? nl : log1pf(expf(nl));
      const float wl = -sp - 0.5f;
      const float decay = expf(-expf(wl));
      const float a = 1.f / (1.f + expf(-(a0 + aa[tt])));
      const float rs = shifted(Hc, tok, c, mu);
      const float ks = shifted(Hc, tok, 512 + c, mu);
      const float vs = shifted(Hc, tok, 1024 + c, mu);
      float kk = ks * kkc;
      const float nrm = sqrtf(wave_sum(kk * kk));
      kk = kk / fmaxf(nrm, 1e-12f);
      RWW[tok * 512 + c] = decay;
      RWK[tok * 512 + c] = ks * (1.f + (a - 1.f) * kac);
      RWKK[tok * 512 + c] = kk;
      RWA[tok * 512 + c] = kk * a;
      RWR[tok * 512 + c] = rs;
      RWV[tok * 512 + c] = vs;
    }
  }
}
DEV float ret_log2gamma(int h) { return log2f(1.f - exp2f(-5.f - (float)h)); }
struct KvSmem { unsigned short vt[128][72]; unsigned short kt[64][72]; };
#define P11_KV_SMEM ((int)sizeof(KvSmem))
DEV void p11_kv(const Params& p, int item, char* smem) {
  KvSmem* sm = (KvSmem*)smem;
  const int c = item % RET_NC, h = (item / RET_NC) & 3, b = item / (RET_NC * 4);
  const int tid = TIDX, lane = tid & 63, wave = tid >> 6;
  const int r = lane & 31, hh = lane >> 5;
  const float* H2 = (const float*)(p.ws + OFF_H2);
  const float lg = ret_log2gamma(h);
  const size_t tok0 = (size_t)b * SEQ_LEN + c * 128;
  f32x16 acc[2];
#pragma unroll
  for (int nt = 0; nt < 2; ++nt)
#pragma unroll
    for (int i = 0; i < 16; ++i) acc[nt][i] = 0.f;
#pragma unroll 1
  for (int kt = 0; kt < 2; ++kt) {
    __syncthreads();
#pragma unroll
    for (int q = 0; q < 8; ++q) {
      const int f = tid + 256 * q;
      const int key = f >> 5, d4 = (f & 31) * 4;
      const float dec = exp2f((float)(127 - (kt * 64 + key)) * lg);
      const float4 v = ld4(H2 + (tok0 + kt * 64 + key) * 1536 + 512 + h * 128 + d4);
      sm->vt[d4][key] = f2bf(v.x * dec); sm->vt[d4 + 1][key] = f2bf(v.y * dec);
      sm->vt[d4 + 2][key] = f2bf(v.z * dec); sm->vt[d4 + 3][key] = f2bf(v.w * dec);
    }
#pragma unroll
    for (int q = 0; q < 4; ++q) {
      const int f = tid + 256 * q;
      const int key = f >> 4, d4 = (f & 15) * 4;
      const float4 v = ld4(H2 + (tok0 + kt * 64 + key) * 1536 + 256 + h * 64 + d4);
      sm->kt[d4][key] = f2bf(v.x); sm->kt[d4 + 1][key] = f2bf(v.y); sm->kt[d4 + 2][key] = f2bf(v.z); sm->kt[d4 + 3][key] = f2bf(v.w);
    }
    __syncthreads();
#pragma unroll
    for (int ks = 0; ks < 4; ++ks) {
      const bf16x8 a = *(const bf16x8*)&sm->vt[wave * 32 + r][ks * 16 + hh * 8];
#pragma unroll
      for (int nt = 0; nt < 2; ++nt) {
        const bf16x8 bb = *(const bf16x8*)&sm->kt[nt * 32 + r][ks * 16 + hh * 8];
        acc[nt] = __builtin_amdgcn_mfma_f32_32x32x16_bf16(a, bb, acc[nt], 0, 0, 0);
      }
    }
  }
  float* KV = (float*)(p.ws + OFF_RETKV) + (size_t)item * 64 * 128;
#pragma unroll
  for (int nt = 0; nt < 2; ++nt)
#pragma unroll
    for (int g4 = 0; g4 < 4; ++g4)
      st4(KV + (nt * 32 + r) * 128 + wave * 32 + 8 * g4 + 4 * hh,
          make_float4(acc[nt][4 * g4], acc[nt][4 * g4 + 1], acc[nt][4 * g4 + 2], acc[nt][4 * g4 + 3]));
}
DEV void phase_p11(const Params& p, char* smem) {
  {
    unsigned* RKF = (unsigned*)(p.ws + OFF_RKF);
    for (int i = BIDX * NTHREADS + TIDX; i < BATCH * 8 * (SEQ_LEN / 32); i += gridDim.x * NTHREADS) RKF[i] = 0u;
  }
  const int total = P11_PREP_ITEMS + P11_KV_ITEMS;
  for (int it = BIDX; it < total; it += gridDim.x) {
    if (it < P11_KV_ITEMS) p11_kv(p, it, smem);
    else p11_prep(p, it - P11_KV_ITEMS, smem);
  }
}

#define RK_T 32
#define RK_NCH (SEQ_LEN / RK_T)
#define RK_NCHT (BATCH * 8 * RK_NCH)
#define OFF_RKPT OFF_H
#define OFF_RKKT (OFF_RKPT + (size_t)RK_NCHT * 64 * 64 * 2)
#define OFF_RKVT (OFF_RKKT + (size_t)RK_NCHT * 64 * 32 * 2)
#define OFF_RKRT (OFF_RKVT + (size_t)RK_NCHT * 64 * 32 * 2)
#define OFF_RKAT (OFF_RKRT + (size_t)RK_NCHT * 32 * 64 * 2)
#define OFF_RKEND (OFF_RKAT + (size_t)RK_NCHT * 32 * 32 * 2)
static_assert(OFF_RKEND <= OFF_H2, "rk buffers must fit in the H1 region");
#define RKPRE_SMEM ((4 * 32 * 64 + 32 * 64) * 4)

DEV unsigned short* rksc_row(char* ws, int b, int h, int c, int i) {
  return (unsigned short*)(ws + OFF_RWW) + (((size_t)b * SEQ_LEN + (size_t)c * RK_T + (i >> 1)) * 512 + h * 64) * 2 + (i & 1) * 64;
}
#if RK_MERGED
DEV void st_wt_u16(unsigned short* q, unsigned short v) { asm volatile("global_store_short %0, %1, off sc1" :: "v"(q), "v"((unsigned)v) : "memory"); }
typedef unsigned u32x4_t __attribute__((ext_vector_type(4)));
DEV void st_wt_b128(void* q, uint4 v) { const u32x4_t w = {v.x, v.y, v.z, v.w}; asm volatile("global_store_dwordx4 %0, %1, off sc1" :: "v"(q), "v"(w) : "memory"); }
#else
DEV void st_wt_u16(unsigned short* q, unsigned short v) { *q = v; }
DEV void st_wt_b128(void* q, uint4 v) { *(uint4*)q = v; }
#endif
DEV void rk_precompute(const Params& p, int ch, char* smem) {
  const int c = ch % RK_NCH, bh = ch / RK_NCH, h = bh & 7, b = bh >> 3;
  const int tid = TIDX, lane = tid & 63, wave = tid >> 6;
  const size_t tok0 = (size_t)b * SEQ_LEN + (size_t)c * RK_T;
  const float* RWW = (const float*)(p.ws + OFF_RWW); const float* RWK = (const float*)(p.ws + OFF_RWK);
  const float* RWKK = (const float*)(p.ws + OFF_RWKK); const float* RWA = (const float*)(p.ws + OFF_RWA);
  const float* RWR = p.out + (size_t)NTOK * 512; const float* RWV = p.out;
  float* sW = (float*)smem;
  float* sNK = sW + 32 * 64;
  float* sKA = sNK + 32 * 64;
  float* sR = sKA + 32 * 64;
  float* sV = sR + 32 * 64;
  __syncthreads();
  for (int w = tid; w < 32 * 16; w += NTHREADS) {
    const int t = w >> 4, c4 = (w & 15) * 4;
    const size_t o = (tok0 + t) * 512 + h * 64 + c4;
    st4(sW + t * 64 + c4, ld4(RWW + o));
    const float4 kk = ld4(RWKK + o);
    st4(sNK + t * 64 + c4, make_float4(-kk.x, -kk.y, -kk.z, -kk.w));
    st4(sKA + t * 64 + c4, ld4(RWA + o));
    st4(sR + t * 64 + c4, ld4(RWR + o));
    st4(sV + t * 64 + c4, ld4(RWV + o));
  }
  __syncthreads();
  const int wrole = (wave + ((BIDX >= (gridDim.x >> 1)) ? 2 : 0)) & 3;
  if (wrole == 0) {
    float z[64];
#pragma unroll
    for (int j = 0; j < 64; ++j) z[j] = (j == lane) ? 1.f : 0.f;
    for (int t = 0; t < RK_T; ++t) {
      float cacc = 0.f;
#pragma unroll
      for (int j4 = 0; j4 < 16; ++j4) {
        const float4 u = ld4(sNK + t * 64 + j4 * 4);
        cacc += z[j4 * 4] * u.x + z[j4 * 4 + 1] * u.y + z[j4 * 4 + 2] * u.z + z[j4 * 4 + 3] * u.w;
      }
#pragma unroll
      for (int j4 = 0; j4 < 16; ++j4) {
        const float4 w = ld4(sW + t * 64 + j4 * 4), v = ld4(sKA + t * 64 + j4 * 4);
        z[j4 * 4] = z[j4 * 4] * w.x + cacc * v.x; z[j4 * 4 + 1] = z[j4 * 4 + 1] * w.y + cacc * v.y;
        z[j4 * 4 + 2] = z[j4 * 4 + 2] * w.z + cacc * v.z; z[j4 * 4 + 3] = z[j4 * 4 + 3] * w.w + cacc * v.w;
      }
    }
    unsigned short* PT = (unsigned short*)(p.ws + OFF_RKPT) + (size_t)ch * 64 * 64;
#pragma unroll
    for (int j = 0; j < 64; ++j) st_wt_u16(PT + j * 64 + lane, f2bf(z[j]));
  } else if (wrole == 1) {
    const bool isA = lane < 32;
    const int me = lane & 31;
    float q[64];
    {
      const float* src = (isA ? RWK : RWR) + (tok0 + me) * 512 + h * 64;
#pragma unroll
      for (int j4 = 0; j4 < 16; ++j4) { const float4 v = ld4(src + j4 * 4); q[j4 * 4] = v.x; q[j4 * 4 + 1] = v.y; q[j4 * 4 + 2] = v.z; q[j4 * 4 + 3] = v.w; }
    }
    const float* Ub = isA ? sNK : sKA;
    const float* Vb = isA ? sKA : sNK;
    unsigned short* AT = (unsigned short*)(p.ws + OFF_RKAT) + (size_t)ch * 32 * 32;
    for (int u = 0; u < RK_T; ++u) {
      const int tt = isA ? u : RK_T - 1 - u;
      const bool upd = isA ? (u > me) : (tt <= me);
      if (upd) {
        float cacc = 0.f;
#pragma unroll
        for (int j4 = 0; j4 < 16; ++j4) {
          const float4 uu = ld4(Ub + tt * 64 + j4 * 4);
          cacc += q[j4 * 4] * uu.x + q[j4 * 4 + 1] * uu.y + q[j4 * 4 + 2] * uu.z + q[j4 * 4 + 3] * uu.w;
        }
#pragma unroll
        for (int j4 = 0; j4 < 16; ++j4) {
          const float4 w = ld4(sW + tt * 64 + j4 * 4), v = ld4(Vb + tt * 64 + j4 * 4);
          q[j4 * 4] = q[j4 * 4] * w.x + cacc * v.x; q[j4 * 4 + 1] = q[j4 * 4 + 1] * w.y + cacc * v.y;
          q[j4 * 4 + 2] = q[j4 * 4 + 2] * w.z + cacc * v.z; q[j4 * 4 + 3] = q[j4 * 4 + 3] * w.w + cacc * v.w;
        }
      }
      if (isA) {
        float av = 0.f;
        if (u >= me) {
#pragma unroll
          for (int j4 = 0; j4 < 16; ++j4) {
            const float4 rr = ld4(sR + u * 64 + j4 * 4);
            av += q[j4 * 4] * rr.x + q[j4 * 4 + 1] * rr.y + q[j4 * 4 + 2] * rr.z + q[j4 * 4 + 3] * rr.w;
          }
        }
        AT[u * 32 + me] = f2bf(av);
      }
    }
    if (isA) {
      unsigned short* KT = (unsigned short*)(p.ws + OFF_RKKT) + (size_t)ch * 64 * 32;
#pragma unroll
      for (int j = 0; j < 64; ++j) st_wt_u16(KT + j * 32 + me, f2bf(q[j]));
    } else {
      unsigned short* RT = (unsigned short*)(p.ws + OFF_RKRT) + ((size_t)ch * 32 + me) * 64;
#pragma unroll
      for (int j8 = 0; j8 < 8; ++j8)
        *(uint4*)(RT + j8 * 8) = make_uint4(pk2(q[j8 * 8], q[j8 * 8 + 1]), pk2(q[j8 * 8 + 2], q[j8 * 8 + 3]), pk2(q[j8 * 8 + 4], q[j8 * 8 + 5]), pk2(q[j8 * 8 + 6], q[j8 * 8 + 7]));
    }
  } else if (wrole == 2) {
    unsigned short* VT = (unsigned short*)(p.ws + OFF_RKVT) + (size_t)ch * 64 * 32;
#pragma unroll
    for (int t8 = 0; t8 < 4; ++t8) {
      float v[8];
#pragma unroll
      for (int q8 = 0; q8 < 8; ++q8) v[q8] = sV[(t8 * 8 + q8) * 64 + lane];
      st_wt_b128(VT + lane * 32 + t8 * 8, make_uint4(pk2(v[0], v[1]), pk2(v[2], v[3]), pk2(v[4], v[5]), pk2(v[6], v[7])));
    }
  }
#if RK_MERGED
  asm volatile("s_waitcnt vmcnt(0)" ::: "memory");
  __syncthreads();
  if (tid == 0) __hip_atomic_store((unsigned*)(p.ws + OFF_RKF) + ch, 1u, __ATOMIC_RELAXED, __HIP_MEMORY_SCOPE_AGENT);
#endif
}
DEV void phase_retpfx(const Params& p, char* smem);
DEV void phase_rkpre(const Params& p, char* smem) {
  phase_retpfx(p, smem);
  for (int it = BIDX; it < RK_NCHT; it += gridDim.x) rk_precompute(p, (it % (BATCH * 8)) * RK_NCH + it / (BATCH * 8), smem);
}

DEV bf16x8 ld_frag2(const unsigned short* p0, const unsigned short* p1) {
  const uint2 lo = *(const uint2*)p0, hi = *(const uint2*)p1;
  union { uint4 u; bf16x8 v; } x;
  x.u = make_uint4(lo.x, lo.y, hi.x, hi.y);
  return x.v;
}
DEV bf16x8 ld_frag(const unsigned short* p0) {
  union { uint4 u; bf16x8 v; } x;
  x.u = *(const uint4*)p0;
  return x.v;
}
DEV unsigned rk_flag_ld(const unsigned* f) {
#if RK_MERGED
  return __hip_atomic_load(f, __ATOMIC_RELAXED, __HIP_MEMORY_SCOPE_AGENT);
#else
  return 1u;
#endif
}
DEV void rk_flag_wait(const unsigned* f, unsigned flv) {
#if RK_MERGED
  asm volatile("" : "+v"(flv));
  unsigned fl = (unsigned)__builtin_amdgcn_readfirstlane((int)flv);
  unsigned sp = 0;
  while (fl == 0u) {
    __builtin_amdgcn_s_sleep(1);
    fl = (unsigned)__builtin_amdgcn_readfirstlane((int)__hip_atomic_load(f, __ATOMIC_RELAXED, __HIP_MEMORY_SCOPE_AGENT));
    if (++sp > (1u << 21)) break;
  }
  asm volatile("buffer_inv sc1" ::: "memory");
#endif
}
#define RK_PREFETCH(S, c_)                                                                                                      \
  {                                                                                                                             \
    const size_t chp_ = (size_t)bh * RK_NCH + (c_);                                                                             \
    _Pragma("unroll") for (int jt = 0; jt < 2; ++jt) _Pragma("unroll") for (int kb = 0; kb < 2; ++kb)                          \
        _Pragma("unroll") for (int s_ = 0; s_ < 2; ++s_) {                                                                      \
      const unsigned short* q0 = PTb + (chp_ * 64 + jt * 32 + r) * 64 + kb * 32 + 16 * s_ + 4 * hh;                             \
      pa##S[jt][kb][s_] = ld_frag2(q0, q0 + 8);                                                                                 \
    }                                                                                                                           \
    _Pragma("unroll") for (int jt = 0; jt < 2; ++jt) _Pragma("unroll") for (int ks = 0; ks < 2; ++ks)                          \
        ka##S[jt][ks] = ld_frag(KTb + (chp_ * 64 + jt * 32 + r) * 32 + 16 * ks + 8 * hh);                                       \
    _Pragma("unroll") for (int ks = 0; ks < 2; ++ks) vb##S[ks] = ld_frag(VTb + (chp_ * 64 + it * 32 + r) * 32 + 16 * ks + 8 * hh); \
  }
#define RK_STEP(S, c_)                                                                                                          \
  {                                                                                                                             \
    unsigned short* scr_ = rksc_row(p.ws, bh >> 3, bh & 7, (c_), it * 32 + r);                                                  \
    _Pragma("unroll") for (int kb = 0; kb < 2; ++kb) _Pragma("unroll") for (int g4 = 0; g4 < 4; ++g4)                          \
        *(uint2*)(scr_ + kb * 32 + 8 * g4 + 4 * hh) =                                                                           \
            make_uint2(pk2(X[kb][4 * g4], X[kb][4 * g4 + 1]), pk2(X[kb][4 * g4 + 2], X[kb][4 * g4 + 3]));                       \
    bf16x8 bh_[2][2], bl_[2][2];                                                                                                \
    _Pragma("unroll") for (int kb = 0; kb < 2; ++kb) _Pragma("unroll") for (int s_ = 0; s_ < 2; ++s_) {                        \
      union { uint4 u; bf16x8 v; } hi, lo;                                                                                      \
      unsigned hw[4], lw[4];                                                                                                    \
      _Pragma("unroll") for (int q2 = 0; q2 < 4; ++q2) {                                                                        \
        const float x0 = X[kb][8 * s_ + 2 * q2], x1 = X[kb][8 * s_ + 2 * q2 + 1];                                               \
        const unsigned hp = pk2(x0, x1);                                                                                        \
        hw[q2] = hp;                                                                                                            \
        lw[q2] = pk2(x0 - bf2f((unsigned short)(hp & 0xFFFF)), x1 - bf2f((unsigned short)(hp >> 16)));                          \
      }                                                                                                                         \
      hi.u = make_uint4(hw[0], hw[1], hw[2], hw[3]); lo.u = make_uint4(lw[0], lw[1], lw[2], lw[3]);                             \
      bh_[kb][s_] = hi.v; bl_[kb][s_] = lo.v;                                                                                   \
    }                                                                                                                           \
    f32x16 acc[2];                                                                                                              \
    _Pragma("unroll") for (int jt = 0; jt < 2; ++jt) {                                                                          \
      _Pragma("unroll") for (int i = 0; i < 16; ++i) acc[jt][i] = 0.f;                                                          \
      _Pragma("unroll") for (int kb = 0; kb < 2; ++kb) _Pragma("unroll") for (int s_ = 0; s_ < 2; ++s_) {                      \
        acc[jt] = __builtin_amdgcn_mfma_f32_32x32x16_bf16(pa##S[jt][kb][s_], bh_[kb][s_], acc[jt], 0, 0, 0);                    \
        acc[jt] = __builtin_amdgcn_mfma_f32_32x32x16_bf16(pa##S[jt][kb][s_], bl_[kb][s_], acc[jt], 0, 0, 0);                    \
      }                                                                                                                         \
      _Pragma("unroll") for (int ks = 0; ks < 2; ++ks)                                                                          \
          acc[jt] = __builtin_amdgcn_mfma_f32_32x32x16_bf16(ka##S[jt][ks], vb##S[ks], acc[jt], 0, 0, 0);                        \
    }                                                                                                                           \
    if ((c_) + 2 < RK_NCH) {                                                                                                    \
      rk_flag_wait(RKFb + (c_) + 2, fl##S);                                                                                     \
      fl##S = rk_flag_ld(RKFb + ((c_) + 4 < RK_NCH ? (c_) + 4 : RK_NCH - 1));          \
      RK_PREFETCH(S, (c_) + 2);                                                                                                 \
    }                                                                                                                           \
    X[0] = acc[0]; X[1] = acc[1];                                                                                               \
  }
DEV void rk_chain(const Params& p, int bh) {
  const int tid = TIDX, lane = tid & 63, wave = tid >> 6;
  if (wave >= 2) return;
  const int r = lane & 31, hh = lane >> 5, it = wave;
  const unsigned short* PTb = (const unsigned short*)(p.ws + OFF_RKPT);
  const unsigned short* KTb = (const unsigned short*)(p.ws + OFF_RKKT);
  const unsigned short* VTb = (const unsigned short*)(p.ws + OFF_RKVT);
  const unsigned* RKFb = (const unsigned*)(p.ws + OFF_RKF) + (size_t)bh * RK_NCH;
  f32x16 X[2];
#pragma unroll
  for (int kb = 0; kb < 2; ++kb)
#pragma unroll
    for (int i = 0; i < 16; ++i) X[kb][i] = 0.f;
  bf16x8 paA[2][2][2], kaA[2][2], vbA[2], paB[2][2][2], kaB[2][2], vbB[2];
  rk_flag_wait(RKFb, rk_flag_ld(RKFb));
  RK_PREFETCH(A, 0);
  rk_flag_wait(RKFb + 1, rk_flag_ld(RKFb + 1));
  RK_PREFETCH(B, 1);
  unsigned flA = rk_flag_ld(RKFb + 2), flB = rk_flag_ld(RKFb + 3);
  for (int c = 0; c < RK_NCH; c += 2) {
    RK_STEP(A, c);
    if (c + 1 < RK_NCH) RK_STEP(B, c + 1);
  }
}
DEV void rk_output(const Params& p, int item) {
  const int tid = TIDX, lane = tid & 63, wave = tid >> 6;
  const int ch = item * 4 + wave;
  const int c = ch % RK_NCH, bhh = ch / RK_NCH, h = bhh & 7, b = bhh >> 3;
  const int r = lane & 31, hh = lane >> 5;
  const unsigned short* RT = (const unsigned short*)(p.ws + OFF_RKRT) + (size_t)ch * 32 * 64;
  const unsigned short* AT = (const unsigned short*)(p.ws + OFF_RKAT) + (size_t)ch * 32 * 32;
  const unsigned short* VT = (const unsigned short*)(p.ws + OFF_RKVT) + (size_t)ch * 64 * 32;
  f32x16 acc[2];
#pragma unroll
  for (int i2 = 0; i2 < 2; ++i2)
#pragma unroll
    for (int i = 0; i < 16; ++i) acc[i2][i] = 0.f;
#pragma unroll
  for (int ks = 0; ks < 4; ++ks) {
    const bf16x8 a = ld_frag(RT + r * 64 + 16 * ks + 8 * hh);
#pragma unroll
    for (int i2 = 0; i2 < 2; ++i2) acc[i2] = __builtin_amdgcn_mfma_f32_32x32x16_bf16(a, ld_frag(rksc_row(p.ws, b, h, c, i2 * 32 + r) + 16 * ks + 8 * hh), acc[i2], 0, 0, 0);
  }
#pragma unroll
  for (int ks = 0; ks < 2; ++ks) {
    const bf16x8 a = ld_frag(AT + r * 32 + 16 * ks + 8 * hh);
#pragma unroll
    for (int i2 = 0; i2 < 2; ++i2) acc[i2] = __builtin_amdgcn_mfma_f32_32x32x16_bf16(a, ld_frag(VT + (i2 * 32 + r) * 32 + 16 * ks + 8 * hh), acc[i2], 0, 0, 0);
  }
  float* Yo = (float*)(p.ws + OFF_MIX);
  const size_t tok0 = (size_t)b * SEQ_LEN + (size_t)c * RK_T;
#pragma unroll
  for (int i2 = 0; i2 < 2; ++i2)
#pragma unroll
    for (int i = 0; i < 16; ++i) {
      const int t = (i & 3) + 8 * (i >> 2) + 4 * hh;
      Yo[(tok0 + t) * 1024 + h * 64 + i2 * 32 + r] = acc[i2][i];
    }
}
DEV void phase_rkout(const Params& p, char* smem) {
  for (int it = BIDX; it < RK_NCHT / 4; it += gridDim.x) rk_output(p, it);
}

#define P12_SCAN_ITEMS (BATCH * 8 * 4)
#define P12_RET_ITEMS (BATCH * 4 * RET_NC)
#define P12_SCAN_SMEM ((2 * (16 * 5 * 64 + 16 * 16) + 16 * 16) * 4)
#define P12_RET_SMEM ((64 * 72 + 2 * 64 * 68) * 2)
#define P12_SMEM (P12_SCAN_SMEM > P12_RET_SMEM ? P12_SCAN_SMEM : P12_RET_SMEM)
DEV float sum16(float v) {
#ifdef CPU_EMU
  return emu_sum16(v);
#else
  int x;
  x = __builtin_amdgcn_update_dpp(0, __builtin_bit_cast(int, v), 0xB1, 0xF, 0xF, false); v += __builtin_bit_cast(float, x);
  x = __builtin_amdgcn_update_dpp(0, __builtin_bit_cast(int, v), 0x4E, 0xF, 0xF, false); v += __builtin_bit_cast(float, x);
  x = __builtin_amdgcn_update_dpp(0, __builtin_bit_cast(int, v), 0x141, 0xF, 0xF, false); v += __builtin_bit_cast(float, x);
  x = __builtin_amdgcn_update_dpp(0, __builtin_bit_cast(int, v), 0x140, 0xF, 0xF, false); v += __builtin_bit_cast(float, x);
  return v;
#endif
}
DEV void p12_scan(const Params& p, int item, char* smem) {
  const int rq = item & 3, h = (item >> 2) & 7, b = item >> 5;
  const int tid = TIDX, rl = tid >> 4, cg = tid & 15;
  const float* ARR[5] = {(const float*)(p.ws + OFF_RWW), (const float*)(p.ws + OFF_RWK), (const float*)(p.ws + OFF_RWKK),
                         (const float*)(p.ws + OFF_RWA), p.out + (size_t)NTOK * 512};
  const float* RWV = p.out;
  float* Yo = (float*)(p.ws + OFF_MIX);
  float* buf = (float*)smem;
  float* vbuf = buf + 2 * 16 * 5 * 64;
  float* ybuf = vbuf + 2 * 16 * 16;
  float S[4] = {0.f, 0.f, 0.f, 0.f};
  float4 rg[5]; float rv;
  const int lstep = tid >> 4, lc4 = tid & 15;
  auto gload = [&](int c) {
    const size_t o = ((size_t)b * SEQ_LEN + c * 16 + lstep) * 512 + h * 64;
#pragma unroll
    for (int a = 0; a < 5; ++a) rg[a] = ld4(ARR[a] + o + lc4 * 4);
    rv = RWV[o + rq * 16 + lc4];
  };
  auto sstore = [&](int bi) {
#pragma unroll
    for (int a = 0; a < 5; ++a) st4(buf + ((bi * 16 + lstep) * 5 + a) * 64 + lc4 * 4, rg[a]);
    vbuf[(bi * 16 + lstep) * 16 + lc4] = rv;
  };
  __syncthreads();
  gload(0);
  sstore(0);
  __syncthreads();
  const int NCH = SEQ_LEN / 16;
  for (int c = 0; c < NCH; ++c) {
    if (c + 1 < NCH) gload(c + 1);
    const float* cb = buf + (c & 1) * 16 * 5 * 64;
    const float* cv = vbuf + (c & 1) * 16 * 16;
    float4 cw = ld4(cb + 0 * 64 + cg * 4), ck = ld4(cb + 1 * 64 + cg * 4), ckk = ld4(cb + 2 * 64 + cg * 4),
           cka = ld4(cb + 3 * 64 + cg * 4), cr = ld4(cb + 4 * 64 + cg * 4);
    float cvv = cv[rl];
#pragma unroll
    for (int s = 0; s < 16; ++s) {
      const float4 w = cw, k = ck, kk = ckk, ka = cka, r = cr;
      const float v = cvv;
      if (s < 15) {
        cw = ld4(cb + ((s + 1) * 5 + 0) * 64 + cg * 4); ck = ld4(cb + ((s + 1) * 5 + 1) * 64 + cg * 4);
        ckk = ld4(cb + ((s + 1) * 5 + 2) * 64 + cg * 4); cka = ld4(cb + ((s + 1) * 5 + 3) * 64 + cg * 4);
        cr = ld4(cb + ((s + 1) * 5 + 4) * 64 + cg * 4); cvv = cv[(s + 1) * 16 + rl];
      }
      float sa = (S[0] * kk.x + S[1] * kk.y) + (S[2] * kk.z + S[3] * kk.w);
      sa = -sum16(sa);
      S[0] = S[0] * w.x + (sa * ka.x + v * k.x);
      S[1] = S[1] * w.y + (sa * ka.y + v * k.y);
      S[2] = S[2] * w.z + (sa * ka.z + v * k.z);
      S[3] = S[3] * w.w + (sa * ka.w + v * k.w);
      float y = (S[0] * r.x + S[1] * r.y) + (S[2] * r.z + S[3] * r.w);
      y = sum16(y);
      if (cg == 0) ybuf[s * 16 + rl] = y;
      asm volatile("" ::: "memory");
    }
    __syncthreads();
    if (c + 1 < NCH) sstore((c + 1) & 1);
    Yo[((size_t)b * SEQ_LEN + c * 16 + lstep) * 1024 + h * 64 + rq * 16 + lc4] = ybuf[lstep * 16 + lc4];
    __syncthreads();
  }
}
struct RetSmem { unsigned short k[64][72]; unsigned short vt[2][64][68]; };
#define RETPFX_ITEMS (BATCH * 4 * 64 * 128 / NTHREADS)
DEV void ret_prefix(const Params& p, int item) {
  const int gi = item * NTHREADS + TIDX;
  const int bh4 = gi >> 13, idx = gi & 8191;
  const float G = exp2f(128.f * ret_log2gamma(bh4 & 3));
  float* KV = (float*)(p.ws + OFF_RETKV) + (size_t)bh4 * RET_NC * 8192 + idx;
  float st = 0.f;
  int c = 0;
  for (; c + 8 <= RET_NC; c += 8) {
    float e[8];
#pragma unroll
    for (int q = 0; q < 8; ++q) e[q] = KV[(size_t)(c + q) * 8192];
#pragma unroll
    for (int q = 0; q < 8; ++q) { KV[(size_t)(c + q) * 8192] = st; st = st * G + e[q]; }
  }
  for (; c < RET_NC; ++c) { const float e = KV[(size_t)c * 8192]; KV[(size_t)c * 8192] = st; st = st * G + e; }
}
DEV void phase_retpfx(const Params& p, char* smem) {
  for (int it = BIDX; it < RETPFX_ITEMS; it += gridDim.x) ret_prefix(p, it);
}
DEV void p12_ret(const Params& p, int item, char* smem) {
  RetSmem* sm = (RetSmem*)smem;
  const int c = item % RET_NC, h = (item / RET_NC) & 3, b = item / (RET_NC * 4);
  const int tid = TIDX, lane = tid & 63, wave = tid >> 6;
  const int cidx = lane & 31, hh = lane >> 5;
  const int qi = wave * 32 + cidx;
  const float* H2 = (const float*)(p.ws + OFF_H2);
  const float lg = ret_log2gamma(h);
  const size_t tok0 = (size_t)b * SEQ_LEN + c * 128;
  bf16x8 qf[4], qfs[4];
  {
    const float* qr = H2 + (tok0 + qi) * 1536 + h * 64;
    const float qs = exp2f((float)(qi + 1) * lg);
#pragma unroll
    for (int ks = 0; ks < 4; ++ks) {
      const float4 a0 = ld4(qr + ks * 16 + hh * 8), a1 = ld4(qr + ks * 16 + hh * 8 + 4);
      const float v[8] = {a0.x, a0.y, a0.z, a0.w, a1.x, a1.y, a1.z, a1.w};
#pragma unroll
      for (int j = 0; j < 8; ++j) { qf[ks][j] = (short)f2bf(v[j]); qfs[ks][j] = (short)f2bf(v[j] * qs); }
    }
  }
  f32x16 o[4], s[2];
#pragma unroll
  for (int mt = 0; mt < 4; ++mt)
#pragma unroll
    for (int i = 0; i < 16; ++i) o[mt][i] = 0.f;
  {
    const float* KV0 = (const float*)(p.ws + OFF_RETKV) + (size_t)((b * 4 + h) * RET_NC) * 64 * 128;
#pragma unroll
    for (int eh = 0; eh < 2; ++eh) {
      __syncthreads();
      {
        const int el = tid & 63, d0 = tid >> 6;
        float stv[16];
#pragma unroll
        for (int i = 0; i < 16; ++i) stv[i] = KV0[(size_t)c * 64 * 128 + (d0 + 4 * i) * 128 + eh * 64 + el];
#pragma unroll
        for (int i = 0; i < 16; ++i) sm->k[el][d0 + 4 * i] = f2bf(stv[i]);
      }
      __syncthreads();
      qk_tile(sm->k, qfs, s, lane);
#pragma unroll
      for (int i = 0; i < 16; ++i) { o[eh * 2][i] += s[0][i]; o[eh * 2 + 1][i] += s[1][i]; }
    }
  }
#pragma unroll 1
  for (int kt = 0; kt < 2; ++kt) {
    __syncthreads();
    {
      const int row = tid >> 2, seg = tid & 3;
      const float* kr = H2 + (tok0 + kt * 64 + row) * 1536 + 256 + h * 64 + seg * 16;
      const float4 a0 = ld4(kr), a1 = ld4(kr + 4), a2 = ld4(kr + 8), a3 = ld4(kr + 12);
      *(uint4*)&sm->k[row][seg * 16] = make_uint4(pk2(a0.x, a0.y), pk2(a0.z, a0.w), pk2(a1.x, a1.y), pk2(a1.z, a1.w));
      *(uint4*)&sm->k[row][seg * 16 + 8] = make_uint4(pk2(a2.x, a2.y), pk2(a2.z, a2.w), pk2(a3.x, a3.y), pk2(a3.z, a3.w));
#pragma unroll
      for (int q = 0; q < 8; ++q) {
        const int f = tid + 256 * q;
        const int key = f >> 5, d4 = (f & 31) * 4;
        const float4 v = ld4(H2 + (tok0 + kt * 64 + key) * 1536 + 512 + h * 128 + d4);
        unsigned short(*vt)[68] = sm->vt[d4 >> 6];
        const int dl = d4 & 63;
        vt[dl][key] = f2bf(v.x); vt[dl + 1][key] = f2bf(v.y); vt[dl + 2][key] = f2bf(v.z); vt[dl + 3][key] = f2bf(v.w);
      }
    }
    __syncthreads();
    if (kt * 64 <= wave * 32 + 31) {
      qk_tile(sm->k, qf, s, lane);
#pragma unroll
      for (int ks2 = 0; ks2 < 2; ++ks2)
#pragma unroll
        for (int i = 0; i < 16; ++i) {
          const int kj = kt * 64 + ks2 * 32 + (i & 3) + 8 * (i >> 2) + 4 * hh;
          s[ks2][i] = kj <= qi ? s[ks2][i] * exp2f((float)(qi - kj) * lg) : 0.f;
        }
      pv_tile(sm->vt[0], s, *(f32x16(*)[2])&o[0], lane);
      pv_tile(sm->vt[1], s, *(f32x16(*)[2])&o[2], lane);
    }
  }
  float s1 = 0.f;
#pragma unroll
  for (int mt = 0; mt < 4; ++mt)
#pragma unroll
    for (int i = 0; i < 16; ++i) s1 += o[mt][i];
  s1 += __shfl_xor(s1, 32);
  const float mu = s1 * (1.f / 128.f);
  float s2 = 0.f;
#pragma unroll
  for (int mt = 0; mt < 4; ++mt)
#pragma unroll
    for (int i = 0; i < 16; ++i) { const float d = o[mt][i] - mu; s2 += d * d; }
  s2 += __shfl_xor(s2, 32);
  const float rstd = rsqrtf(s2 * (1.f / 128.f) + 1e-5f);
  float* MIX = (float*)(p.ws + OFF_MIX);
  const float* gate = H2 + (tok0 + qi) * 1536 + 1024 + h * 128;
  float* dst = MIX + (tok0 + qi) * 1024 + 512 + h * 128;
  const float* lgam = p.in[I_RET_LN_G] + h * 128;
  const float* lbet = p.in[I_RET_LN_B] + h * 128;
#pragma unroll
  for (int mt = 0; mt < 4; ++mt)
#pragma unroll
    for (int g4 = 0; g4 < 4; ++g4) {
      const int dv = mt * 32 + 8 * g4 + 4 * hh;
      const float4 gv = ld4(lgam + dv), bv = ld4(lbet + dv), gt = ld4(gate + dv);
      float4 ov;
      ov.x = siluf_(gt.x) * ((o[mt][4 * g4] - mu) * rstd * gv.x + bv.x);
      ov.y = siluf_(gt.y) * ((o[mt][4 * g4 + 1] - mu) * rstd * gv.y + bv.y);
      ov.z = siluf_(gt.z) * ((o[mt][4 * g4 + 2] - mu) * rstd * gv.z + bv.z);
      ov.w = siluf_(gt.w) * ((o[mt][4 * g4 + 3] - mu) * rstd * gv.w + bv.w);
      st4(dst + dv, ov);
    }
}
DEV void phase_p12(const Params& p, char* smem) {
  const int G = gridDim.x;
  const int bid = BIDX;
  if (bid < BATCH * 8 && G > BATCH * 8) {
    rk_chain(p, bid);
  } else if (G >= 8 * BATCH * 8) {
    const int Gh = G >> 1, NC = BATCH * 8;
    if (bid >= Gh && bid < Gh + NC) return;
    const int w = bid - NC - (bid >= Gh ? NC : 0);
#if RK_MERGED
    if ((G & 15) == 0 && BATCH * 8 == 16) {
      const int x = bid & 7, m = bid >> 3;
      const int rank = m - 2 - (m >= (Gh >> 3) ? 2 : 0), nprod = (G >> 3) - 4;
      for (int k = rank; k < 2 * RK_NCH; k += nprod) rk_precompute(p, (x + 8 * (k & 1)) * RK_NCH + (k >> 1), smem);
    } else {
      for (int it = w; it < RK_NCHT; it += G - 2 * NC) rk_precompute(p, (it % NC) * RK_NCH + it / NC, smem);
    }
#endif
    for (int it = w; it < P12_RET_ITEMS; it += G - 2 * NC) p12_ret(p, it, smem);
  } else if (G > BATCH * 8) {
    for (int it = bid - BATCH * 8; it < P12_RET_ITEMS; it += G - BATCH * 8) p12_ret(p, it, smem);
  } else {
    for (int it = bid; it < BATCH * 8 + P12_RET_ITEMS; it += G) {
      if (it < BATCH * 8) rk_chain(p, it);
      else p12_ret(p, it - BATCH * 8, smem);
    }
  }
}

#define P13_SMEM (RWP_T * 128 * 4)
DEV void phase_p13(const Params& p, char* smem) {
  const int tid = TIDX;
  const float* Hc = (const float*)(p.ws + OFF_H);
  const float* mu = p.in[I_RW_MU];
  const float* GLO = (const float*)(p.ws + OFF_GLO);
  float* sl = (float*)smem;
  float* MIX = (float*)(p.ws + OFF_MIX);
  const float* RWK = (const float*)(p.ws + OFF_RWK); const float* RWR = p.out + (size_t)NTOK * 512; const float* RWV = p.out;
  const float* g_up = p.in[I_RW_G_UP];
  for (int it = BIDX; it < NTOK / RWP_T; it += gridDim.x) {
    __syncthreads();
    for (int w = tid; w < RWP_T * 128; w += NTHREADS) {
      const size_t tok = (size_t)it * RWP_T + (w >> 7);
      sl[w] = GLO[tok * 128 + (w & 127)];
    }
    __syncthreads();
#pragma unroll
    for (int cc = 0; cc < 2; ++cc) {
      const int c = tid + 256 * cc;
      float ag[RWP_T];
#pragma unroll
      for (int tt = 0; tt < RWP_T; ++tt) ag[tt] = 0.f;
      for (int j0 = 0; j0 < 128; j0 += 8) {
        float gu[8];
#pragma unroll
        for (int q = 0; q < 8; ++q) gu[q] = g_up[(j0 + q) * 512 + c];
#pragma unroll
        for (int q4 = 0; q4 < 2; ++q4) {
#pragma unroll
          for (int tt = 0; tt < RWP_T; ++tt) {
            const float4 sg = ld4(sl + tt * 128 + j0 + q4 * 4);
            ag[tt] += sg.x * gu[q4 * 4] + sg.y * gu[q4 * 4 + 1] + sg.z * gu[q4 * 4 + 2] + sg.w * gu[q4 * 4 + 3];
          }
        }
      }
      const float lng = p.in[I_RW_LN_G][c], lnb = p.in[I_RW_LN_B][c], rk = p.in[I_RW_R_K][c];
#pragma unroll 4
      for (int tt = 0; tt < RWP_T; ++tt) {
        const size_t tok = (size_t)it * RWP_T + tt;
        const float y = MIX[tok * 1024 + c];
        const float m = wave_sum(y) * (1.f / 64.f);
        const float d = y - m;
        const float var = wave_sum(d * d) * (1.f / 64.f);
        const float yn = d * rsqrtf(var + 64e-5f) * lng + lnb;
        const float r = RWR[tok * 512 + c], k = RWK[tok * 512 + c], v = RWV[tok * 512 + c];
        const float bonus = wave_sum(r * k * rk) * v;
        MIX[tok * 1024 + c] = (yn + bonus) * ag[tt];
      }
    }
  }
}

#define NPHASES 20
#define SMEM_BYTES 53248
DEV void run_phase(const Params& p, int ph, char* smem) {
  switch (ph) {
    case 0: phase_gemm_in<0>(p, smem); break;
    case 1: phase_p1(p, smem); break;
    case 2: phase_p2(p, smem); break;
    case 3: phase_glu(p, smem); break;
    case 4: phase_outproj<0>(p, smem); break;
    case 5: phase_ln_router<0>(p, smem); break;
    case 6: phase_lists_shup<0>(p, smem); break;
    case 7: phase_routed_up<0>(p, smem); break;
    case 8: phase_down<0>(p, smem); break;
    case 9: phase_combine<0>(p, smem); break;
    case 10: phase_gemm_in<1>(p, smem); break;
    case 11: phase_p11(p, smem); break;
    case 12: phase_p12(p, smem); break;
    case 13: phase_p13(p, smem); break;
    case 14: phase_outproj<1>(p, smem); break;
    case 15: phase_ln_router<1>(p, smem); break;
    case 16: phase_lists_shup<1>(p, smem); break;
    case 17: phase_routed_up<1>(p, smem); break;
    case 18: phase_down<1>(p, smem); break;
    case 19: phase_combine<1>(p, smem); break;
    case 20: phase_p1b(p, smem); break;
    case 21: phase_rkpre(p, smem); break;
    case 22: phase_rkout(p, smem); break;
    case 24: phase_retpfx(p, smem); break;
  }
}
static_assert(P1_SMEM <= SMEM_BYTES, "smem");
static_assert(P1_PREP_SMEM <= SMEM_BYTES, "smem");
static_assert(P2_SMEM <= SMEM_BYTES, "smem");
static_assert(P5_SMEM <= SMEM_BYTES, "smem");
static_assert(P7_SMEM <= SMEM_BYTES, "smem");
static_assert(P12_SMEM <= SMEM_BYTES, "smem");
static_assert(RKPRE_SMEM <= SMEM_BYTES, "smem");
static_assert(OFF_HS + (size_t)NTOK * 256 * 2 <= OFF_X1, "layout");

#ifndef CPU_EMU
template <int PH>
__global__ void __launch_bounds__(NTHREADS) phase_kernel(Params p) {
  __shared__ __attribute__((aligned(16))) char smem[SMEM_BYTES];
  run_phase(p, PH, smem);
}
template <int PH>
static void launch_phases(const Params& p, hipStream_t stream) {
  phase_kernel<PH><<<dim3(1024), dim3(NTHREADS), 0, stream>>>(p);
  if constexpr (PH + 1 < NPHASES) launch_phases<PH + 1>(p, stream);
}
#if MEGA
#define XB_TMO      128
#define XB_XCNT(j)  (256  + 64 * (j))
#define XB_XSUB(j)  (1280 + 64 * (j))
#define XB_XGEN(j)  (2304 + 64 * (j))
#define XB_TOP      3328
#define XB_TOPGEN   3392
#define XCD_BAR_WORDS 3456
#define XB_SPIN_CAP (1u << 18)
#define LAS __attribute__((address_space(3)))

__device__ __forceinline__ unsigned xb_ld(unsigned* p)              { return __hip_atomic_load(p, __ATOMIC_RELAXED, __HIP_MEMORY_SCOPE_AGENT); }
__device__ __forceinline__ unsigned xb_add(unsigned* p, unsigned v) { return __hip_atomic_fetch_add(p, v, __ATOMIC_RELAXED, __HIP_MEMORY_SCOPE_AGENT); }
__device__ __forceinline__ unsigned xb_xcc_id() { return (unsigned)__builtin_amdgcn_s_getreg((3 << 11) | 20) & 0xFu; }
#define XB_SPIN(cond, bar) do { unsigned _sp = 0; while (cond) { __builtin_amdgcn_s_sleep(1); \
    if ((++_sp & 255u) == 0u) { if (xb_ld(&(bar)[XB_TMO])) break; if (_sp > XB_SPIN_CAP) { atomicAdd(&(bar)[XB_TMO], 1u); break; } } } } while (0)

struct XcdBarrier {
    unsigned* bar; unsigned x;
    volatile LAS unsigned* st;
};

__device__ __forceinline__ XcdBarrier xcd_barrier_post(unsigned* bar, volatile LAS unsigned* st) {
    XcdBarrier b; b.bar = bar; b.x = xb_xcc_id(); b.st = st;
    if (threadIdx.x == 0) (void)xb_add(&bar[XB_XCNT(b.x)], 1u);
    return b;
}
__device__ __forceinline__ void xcd_barrier_complete(unsigned* bar, unsigned x, unsigned& nloc, unsigned& nx) {
    const unsigned G = gridDim.x * gridDim.y * gridDim.z;
    unsigned sum, cnt, mine, sp = 0u;
    for (;;) {
        sum = 0u; cnt = 0u; mine = 0u;
#pragma unroll
        for (unsigned j = 0; j < 16; ++j) { const unsigned c = xb_ld(&bar[XB_XCNT(j)]); sum += c; cnt += (c > 0u) ? 1u : 0u; mine = (j == x) ? c : mine; }
        if (sum == G) break;
        __builtin_amdgcn_s_sleep(1);
        if ((++sp & 255u) == 0u) { if (xb_ld(&bar[XB_TMO])) break; if (sp > XB_SPIN_CAP) { atomicAdd(&bar[XB_TMO], 1u); break; } }
    }
    nloc = mine > 0u ? mine : 1u; nx = cnt > 0u ? cnt : 1u;
}

__device__ __forceinline__ void xcd_barrier(const XcdBarrier& b) {
    asm volatile("s_waitcnt vmcnt(0)" ::: "memory");
    __syncthreads();
    if (threadIdx.x == 0) {
        unsigned* bar = b.bar;
        __builtin_amdgcn_s_waitcnt(0);
        unsigned nloc = b.st[0], nx = b.st[1];
        if (nloc == 0u) { xcd_barrier_complete(bar, b.x, nloc, nx); b.st[0] = nloc; b.st[1] = nx; }
        const unsigned old = xb_add(&bar[XB_XSUB(b.x)], 1u);
        const unsigned gen = old / nloc;
        if (old + 1u == (gen + 1u) * nloc) {
            __builtin_amdgcn_fence(__ATOMIC_RELEASE, "agent");
            asm volatile("s_waitcnt vmcnt(0)" ::: "memory");
            const unsigned og = xb_add(&bar[XB_TOP], 1u);
            const unsigned tg = og / nx;
            if (og + 1u == (tg + 1u) * nx) xb_add(&bar[XB_TOPGEN], 1u);
            else XB_SPIN(xb_ld(&bar[XB_TOPGEN]) == tg, bar);
            __builtin_amdgcn_fence(__ATOMIC_ACQUIRE, "agent");
            xb_add(&bar[XB_XGEN(b.x)], 1u);
            asm volatile("s_waitcnt vmcnt(0)" ::: "memory");
        } else {
            XB_SPIN(xb_ld(&bar[XB_XGEN(b.x)]) == gen, bar);
            __builtin_amdgcn_fence(__ATOMIC_ACQUIRE, "agent");
            asm volatile("s_waitcnt vmcnt(0)" ::: "memory");
        }
    }
    __syncthreads();
}


__global__ void __launch_bounds__(NTHREADS, 2) mega_kernel(Params p) {
  __shared__ __attribute__((aligned(16))) char smem[SMEM_BYTES];
  unsigned* bar = (unsigned*)(p.ws + OFF_BAR);
  __shared__ uint4 xb_words;
  if (threadIdx.x == 0) xb_words = make_uint4(0u, 0u, 0u, 0u);
  __syncthreads();
  XcdBarrier xb = xcd_barrier_post(bar, (volatile LAS unsigned*)&xb_words);
  if (p.ws == nullptr) cg::this_grid().sync();
  typedef const __attribute__((address_space(4))) Params* KParams;
#define PH_(n) { KParams kp = (KParams)__builtin_amdgcn_kernarg_segment_ptr(); asm volatile("" : "+s"(kp)); const Params lp = *(const Params*)kp; run_phase(lp, n, smem); } xcd_barrier(xb);
  PH_(0) PH_(1) PH_(20) PH_(2) PH_(3) PH_(4) PH_(5) PH_(6) PH_(7) PH_(8) PH_(9)
  PH_(10) PH_(11) PH_(24) PH_(12) PH_(22) PH_(13) PH_(14) PH_(15) PH_(16) PH_(17) PH_(18)
  { KParams kp = (KParams)__builtin_amdgcn_kernarg_segment_ptr(); asm volatile("" : "+s"(kp)); const Params lp = *(const Params*)kp; run_phase(lp, 19, smem); }
}

#endif

extern "C" void kernel_launch(void* const* d_in, const int* in_sizes, int n_in, void* d_out, int out_size, void* d_ws, size_t ws_size,
                              hipStream_t stream) {
  Params p;
  for (int i = 0; i < N_INPUTS; ++i) p.in[i] = (const float*)d_in[i];
  p.out = (float*)d_out;
  p.ws = (char*)d_ws;
#if MEGA
  static int grid_blocks = 0;
  if (!grid_blocks) {
    int dev = 0, cus = 0, per_cu = 0;
    hipGetDevice(&dev);
    hipDeviceGetAttribute(&cus, hipDeviceAttributeMultiprocessorCount, dev);
    hipOccupancyMaxActiveBlocksPerMultiprocessor(&per_cu, mega_kernel, NTHREADS, 0);
    if (per_cu > 2) per_cu = 2;
    grid_blocks = cus * per_cu;
  }
  hipMemsetAsync((char*)d_ws + OFF_BAR, 0, 16384, stream);
  void* args[] = {&p};
  hipError_t e = hipLaunchCooperativeKernel((void*)mega_kernel, dim3(grid_blocks), dim3(NTHREADS), args, 0, stream);
  if (e != hipSuccess) fprintf(stderr, "cooperative launch failed: %s (grid %d)\n", hipGetErrorString(e), grid_blocks);
#else
  launch_phases<0>(p, stream);
#endif
}
#endif
```

```cpp
#ifdef CPU_EMU
#include "emu.h"
#else
#include <hip/hip_runtime.h>
#include <hip/hip_cooperative_groups.h>
#include <cstdio>
namespace cg = cooperative_groups;
#endif
#include <stdint.h>

#ifndef BATCH
#define BATCH 2
#endif
#ifndef SEQ_LEN
#define SEQ_LEN 8192
#endif
#ifndef MEGA
#define MEGA 1
#endif
#if MEGA && !defined(CPU_EMU)
#define RK_MERGED 1
#else
#define RK_MERGED 0
#endif

#define DEV __device__ __forceinline__
#ifdef CPU_EMU
#define TIDX ((int)threadIdx.x)
#define BIDX ((int)blockIdx.x)
#else
__device__ __forceinline__ int tidx_() { int t = __builtin_amdgcn_workitem_id_x(); asm volatile("" : "+v"(t)); return t; }
__device__ __forceinline__ int bidx_() { int b = __builtin_amdgcn_workgroup_id_x(); asm volatile("" : "+s"(b)); return b; }
#define TIDX tidx_()
#define BIDX bidx_()
#endif
#define NTOK (BATCH * SEQ_LEN)
#define DM 1024
#define AB_IN 1816
#define AB_LD 1824
#define CD_IN 3328
#define NCMP ((SEQ_LEN - 32) / 16 + 1)
#define NBLK (SEQ_LEN / 64)
#define NB_CMP ((NCMP + 63) / 64)
#define S5_NC (SEQ_LEN / 64)
#define RET_NC (SEQ_LEN / 128)
#define ALPHA_F 1.4142135623730951f
#define NTHREADS 256

enum { I_X = 0, I_AB_W_IN, I_AB_W_OUT, I_S5_LAM_RE, I_S5_LAM_IM, I_S5_LOG_DT, I_S5_B_RE, I_S5_B_IM, I_S5_C_RE, I_S5_C_IM,
       I_S5_D, I_S5_W_GLU, I_S5_B_GLU, I_PE_K, I_PE_V, I_CK_W1, I_CK_B1, I_CK_W2, I_CV_W1, I_CV_B1, I_CV_W2,
       I_CD_W_IN, I_CD_W_OUT, I_RW_MU, I_RW_W0, I_RW_W_UP, I_RW_A0, I_RW_A_UP, I_RW_G_UP, I_RW_K_K, I_RW_K_A, I_RW_R_K,
       I_RW_LN_G, I_RW_LN_B, I_RET_LN_G, I_RET_LN_B, I_LN1_G, I_LN1_B, I_LN2_G, I_LN2_B, I_ROUTER, I_MOE_BIAS,
       I_MOE_W1, I_MOE_W3, I_MOE_W2, I_SH_W1, I_SH_W3, I_SH_W2, N_INPUTS };

struct Params {
  const float* in[N_INPUTS];
  float* out;
  char* ws;
};

#define MiB_TOK ((size_t)NTOK * 1024 * 4)
#define OFF_H 0
#define OFF_H2 ((size_t)NTOK * 1792 * 4)
#define OFF_MIX ((size_t)NTOK * 3328 * 4)
#define OFF_X1 (OFF_MIX + MiB_TOK)
#define OFF_X2 (OFF_X1 + MiB_TOK)
#define OFF_R4 (OFF_X2 + MiB_TOK)
#define OFF_R5 (OFF_R4 + MiB_TOK)
#define OFF_Y OFF_H
#define OFF_HS (OFF_H + 4 * MiB_TOK)
#define OFF_FS OFF_X2
#define OFF_HR OFF_R4
#define OFF_X2B OFF_R4
#define OFF_TOPI (OFF_R5)
#define OFF_TOPG (OFF_TOPI + (size_t)NTOK * 8 * 4)
#define OFF_POSOF (OFF_TOPG + (size_t)NTOK * 8 * 4)
#define OFF_CNT (OFF_POSOF + (size_t)NTOK * 8 * 4)
#define OFF_LTOK (OFF_CNT + 8192)
#define OFF_LGATE (OFF_LTOK + (size_t)64 * NTOK * 4)
#define OFF_S5E (OFF_LGATE + (size_t)64 * NTOK * 4)
#define OFF_KCMP (OFF_S5E + (size_t)BATCH * S5_NC * 32 * 64 * 8)
#define OFF_VCMP (OFF_KCMP + (size_t)BATCH * NCMP * 2 * 64 * 4)
#define OFF_RETKV (OFF_VCMP + (size_t)BATCH * NCMP * 2 * 64 * 4)
#define OFF_BAR (OFF_RETKV + (size_t)BATCH * 4 * RET_NC * 64 * 128 * 4)
#define OFF_CMPHID (OFF_BAR + 16384)
#define OFF_CMPC1 (OFF_CMPHID + (size_t)2 * BATCH * 2 * NB_CMP * 64 * 128 * 4)
#define OFF_GLO OFF_LTOK
#define OFF_RKF (OFF_CMPC1 + 8192)
#define OFF_END (OFF_RKF + 16384)
#define OFF_YGELU OFF_X1
#define OFF_RWW OFF_X1
#define OFF_RWK (OFF_X1 + (size_t)NTOK * 512 * 4)
#define OFF_RWKK OFF_R4
#define OFF_RWA (OFF_R4 + (size_t)NTOK * 512 * 4)

typedef short bf16x8 __attribute__((ext_vector_type(8)));
typedef float f32x16 __attribute__((ext_vector_type(16)));

#ifdef CPU_EMU
#define WAVE_SYNC() emu_wave_bar()
#else
#define WAVE_SYNC() __builtin_amdgcn_wave_barrier()
#endif

DEV float sigmoidf_(float x) { return 1.f / (1.f + __expf(-x)); }
DEV float siluf_(float x) { return x * sigmoidf_(x); }
DEV float geluf_(float x) { float u = 0.7978845608028654f * (x + 0.044715f * x * x * x); return 0.5f * x * (1.f + tanhf(u)); }
DEV unsigned short f2bf(float f) {
  unsigned u = __builtin_bit_cast(unsigned, f);
  u += 0x7FFFu + ((u >> 16) & 1u);
  return (unsigned short)(u >> 16);
}
DEV float bf2f(unsigned short h) { return __builtin_bit_cast(float, ((unsigned)h) << 16); }
DEV float wave_sum(float v) {
#pragma unroll
  for (int m = 32; m >= 1; m >>= 1) v += __shfl_xor(v, m);
  return v;
}
DEV float wave_max(float v) {
#pragma unroll
  for (int m = 32; m >= 1; m >>= 1) v = fmaxf(v, __shfl_xor(v, m));
  return v;
}
DEV float4 ld4(const float* p) { return *(const float4*)p; }
#ifdef CPU_EMU
DEV float fexp2(float x) { return exp2f(x); }
#else
DEV float fexp2(float x) { return __builtin_amdgcn_exp2f(x); }
#endif
DEV void fast_sincos(float x, float* sn, float* cs) {
  const float k = rintf(x * 0.15915494309189535f);
  float r = fmaf(-k, 6.28125f, x);
  r = fmaf(-k, 1.9353071795864769e-3f, r);
  *sn = __sinf(r); *cs = __cosf(r);
}
DEV void st4(float* p, float4 v) { *(float4*)p = v; }

#define GEMM_BM 128
#define GEMM_MI (GEMM_BM / 64)
#define GEMM_SMEM_BYTES ((GEMM_BM + 128) * 72 * 2)
#ifdef CPU_EMU
DEV unsigned pk2(float a, float b) { return (unsigned)f2bf(a) | ((unsigned)f2bf(b) << 16); }
#else
typedef __bf16 hbf16x2 __attribute__((ext_vector_type(2)));
typedef float hf32x2 __attribute__((ext_vector_type(2)));
DEV unsigned pk2(float a, float b) {
  hf32x2 f = {a, b};
  return __builtin_bit_cast(unsigned, __builtin_convertvector(f, hbf16x2));
}
#endif
template <bool ABF, class AROW, class BPTR, class EPI>
DEV void gemm_tile(AROW arow, BPTR bptr, int ldb, int K, EPI epi, char* smem_raw, int akstep = 64) {
  unsigned short(*sA)[72] = (unsigned short(*)[72])smem_raw;
  unsigned short(*sB)[72] = (unsigned short(*)[72])(smem_raw + GEMM_BM * 72 * 2);
  const int tid = TIDX, lane = tid & 63, wave = tid >> 6;
  const int wm = wave >> 1, wn = wave & 1;
#if defined(CPU_EMU) && !defined(EMU_REAL_GEMM)
  for (int mi = 0; mi < GEMM_MI; ++mi)
    for (int r = 0; r < 16; ++r) {
      const int row = wm * (GEMM_BM / 2) + mi * 32 + (r & 3) + 8 * (r >> 2) + 4 * (lane >> 5);
      const int col = wn * 64 + (lane & 31);
      const void* arp = arow(row);
      float v[2] = {0.f, 0.f};
      for (int ni = 0; ni < 2; ++ni) {
        const int cc = col + ni * 32;
        const float* bq = bptr(cc & ~3);
        if (!arp || !bq) continue;
        bq += cc & 3;
        float a = 0.f;
        for (int k = 0; k < K; ++k) {
          const size_t ka = (size_t)(k >> 6) * akstep + (k & 63);
          const float av = ABF ? bf2f(((const unsigned short*)arp)[ka]) : bf2f(f2bf(((const float*)arp)[ka]));
          a += av * bf2f(f2bf(bq[(size_t)k * ldb]));
        }
        v[ni] = a;
      }
      epi(row, col, v[0], v[1]);
    }
  return;
#endif
  const float* ap[4 * GEMM_MI];
  const unsigned short* aph[2 * GEMM_MI];
  if (ABF) {
#pragma unroll
    for (int i = 0; i < 2 * GEMM_MI; ++i) aph[i] = (const unsigned short*)arow((tid >> 3) + 32 * i);
  } else {
#pragma unroll
    for (int i = 0; i < 4 * GEMM_MI; ++i) ap[i] = (const float*)arow((tid >> 4) + 16 * i);
  }
  const float* bp = bptr((tid & 31) * 4);
  const int kgrp = tid >> 5;
  float4 ra0[4 * GEMM_MI], ra1[4 * GEMM_MI];
  uint4 rah0[2 * GEMM_MI], rah1[2 * GEMM_MI];
  float4 rb0[8], rb1[8];
#define GEMM_GLOAD(S, k0_)                                                                                                          \
  {                                                                                                                                 \
    if (ABF) {                                                                                                                      \
      _Pragma("unroll") for (int i = 0; i < 2 * GEMM_MI; ++i) rah##S[i] =                                                           \
          aph[i] ? *(const uint4*)(aph[i] + (size_t)((k0_) >> 6) * akstep + (tid & 7) * 8) : make_uint4(0, 0, 0, 0);                \
    } else {                                                                                                                        \
      _Pragma("unroll") for (int i = 0; i < 4 * GEMM_MI; ++i) ra##S[i] =                                                            \
          ap[i] ? ld4(ap[i] + (size_t)((k0_) >> 6) * akstep + (tid & 15) * 4) : make_float4(0.f, 0.f, 0.f, 0.f);                    \
    }                                                                                                                               \
    _Pragma("unroll") for (int j = 0; j < 8; ++j) rb##S[j] =                                                                        \
        bp ? ld4(bp + (size_t)((k0_) + kgrp * 8 + j) * ldb) : make_float4(0.f, 0.f, 0.f, 0.f);                                      \
  }
#define GEMM_SSTORE(S)                                                                                                              \
  {                                                                                                                                 \
    if (ABF) {                                                                                                                      \
      _Pragma("unroll") for (int i = 0; i < 2 * GEMM_MI; ++i) *(uint4*)&sA[(tid >> 3) + 32 * i][(tid & 7) * 8] = rah##S[i];         \
    } else {                                                                                                                        \
      _Pragma("unroll") for (int i = 0; i < 4 * GEMM_MI; ++i) *(uint2*)&sA[(tid >> 4) + 16 * i][(tid & 15) * 4] =                   \
          make_uint2(pk2(ra##S[i].x, ra##S[i].y), pk2(ra##S[i].z, ra##S[i].w));                                                     \
    }                                                                                                                               \
    const int nb = (tid & 31) * 4;                                                                                                  \
    *(uint4*)&sB[nb + 0][kgrp * 8] = make_uint4(pk2(rb##S[0].x, rb##S[1].x), pk2(rb##S[2].x, rb##S[3].x), pk2(rb##S[4].x, rb##S[5].x), pk2(rb##S[6].x, rb##S[7].x)); \
    *(uint4*)&sB[nb + 1][kgrp * 8] = make_uint4(pk2(rb##S[0].y, rb##S[1].y), pk2(rb##S[2].y, rb##S[3].y), pk2(rb##S[4].y, rb##S[5].y), pk2(rb##S[6].y, rb##S[7].y)); \
    *(uint4*)&sB[nb + 2][kgrp * 8] = make_uint4(pk2(rb##S[0].z, rb##S[1].z), pk2(rb##S[2].z, rb##S[3].z), pk2(rb##S[4].z, rb##S[5].z), pk2(rb##S[6].z, rb##S[7].z)); \
    *(uint4*)&sB[nb + 3][kgrp * 8] = make_uint4(pk2(rb##S[0].w, rb##S[1].w), pk2(rb##S[2].w, rb##S[3].w), pk2(rb##S[4].w, rb##S[5].w), pk2(rb##S[6].w, rb##S[7].w)); \
  }
  f32x16 acc[GEMM_MI][2];
#pragma unroll
  for (int mi = 0; mi < GEMM_MI; ++mi)
#pragma unroll
    for (int ni = 0; ni < 2; ++ni)
#pragma unroll
      for (int r = 0; r < 16; ++r) acc[mi][ni][r] = 0.f;
  auto compute = [&]() {
#pragma unroll
    for (int ks = 0; ks < 4; ++ks) {
      bf16x8 af[GEMM_MI], bfr[2];
#pragma unroll
      for (int mi = 0; mi < GEMM_MI; ++mi) af[mi] = *(const bf16x8*)&sA[wm * (GEMM_BM / 2) + mi * 32 + (lane & 31)][ks * 16 + (lane >> 5) * 8];
#pragma unroll
      for (int ni = 0; ni < 2; ++ni) bfr[ni] = *(const bf16x8*)&sB[wn * 64 + ni * 32 + (lane & 31)][ks * 16 + (lane >> 5) * 8];
#pragma unroll
      for (int mi = 0; mi < GEMM_MI; ++mi)
#pragma unroll
        for (int ni = 0; ni < 2; ++ni) acc[mi][ni] = __builtin_amdgcn_mfma_f32_32x32x16_bf16(af[mi], bfr[ni], acc[mi][ni], 0, 0, 0);
    }
  };
  if (ABF) {
    GEMM_GLOAD(0, 0);
    GEMM_GLOAD(1, 64);
    for (int k0 = 0; k0 < K; k0 += 128) {
      __syncthreads();
      GEMM_SSTORE(0);
      __syncthreads();
      if (k0 + 128 < K) GEMM_GLOAD(0, k0 + 128);
      compute();
      __syncthreads();
      GEMM_SSTORE(1);
      __syncthreads();
      if (k0 + 192 < K) GEMM_GLOAD(1, k0 + 192);
      compute();
    }
  } else {
    GEMM_GLOAD(0, 0);
    for (int k0 = 0; k0 < K; k0 += 64) {
      __syncthreads();
      GEMM_SSTORE(0);
      __syncthreads();
      if (k0 + 64 < K) GEMM_GLOAD(0, k0 + 64);
      compute();
    }
  }
#pragma unroll
  for (int mi = 0; mi < GEMM_MI; ++mi)
#pragma unroll
    for (int r = 0; r < 16; ++r) {
      int row = wm * (GEMM_BM / 2) + mi * 32 + (r & 3) + 8 * (r >> 2) + 4 * (lane >> 5);
      int col = wn * 64 + (lane & 31);
      epi(row, col, acc[mi][0][r], acc[mi][1][r]);
    }
}

template <int LAYER>
DEV void phase_gemm_in(const Params& p, char* smem) {
  const int N = LAYER == 0 ? AB_IN : CD_IN;
  const float* A = LAYER == 0 ? p.in[I_X] : (const float*)(p.ws + OFF_X2);
  const float* B = LAYER == 0 ? p.in[I_AB_W_IN] : p.in[I_CD_W_IN];
  float* C = (float*)(p.ws + OFF_H);
  const int NT = (N + 127) / 128, MT = NTOK / GEMM_BM;
  const int xcd_ = BIDX & 7, lb_ = BIDX >> 3, nb_ = gridDim.x >> 3;
  for (int j_ = lb_; j_ < (MT / 8) * NT; j_ += nb_) {
    const int it = (xcd_ + 8 * (j_ / NT)) * NT + (j_ % NT);
    const int tm = it / NT, tn = it % NT;
    const int m0 = tm * GEMM_BM, n0 = tn * 128;
    gemm_tile<LAYER == 1>(
        [&](int r) { return LAYER == 1 ? (const void*)((const unsigned short*)(p.ws + OFF_X2B) + (size_t)(m0 + r) * DM) : (const void*)(A + (size_t)(m0 + r) * DM); },
        [&](int c) { return (n0 + c < N) ? (B + n0 + c) : (const float*)nullptr; }, N, DM,
        [&](int row, int col, float v0, float v1) {
          const int gm = m0 + row, gc = n0 + col;
          if (LAYER == 1 && gc >= 1792 && gc < 2304) {
            const int i = gc & 63;
            const float pos = (float)(gm % SEQ_LEN);
            const float inv = __expf(-(float)i * (9.210340371976184f / 32.f));
            float sn, cs;
            fast_sincos(pos * inv, &sn, &cs);
            float o0 = v0 * cs - v1 * sn, o1 = v1 * cs + v0 * sn;
            if (gc >= 2048) { o0 *= 0.125f; o1 *= 0.125f; }
            v0 = o0; v1 = o1;
          }
          if (LAYER == 1) {
            float* dstp = gc < 1792 ? C + (size_t)gm * 1792 + gc : (float*)(p.ws + OFF_H2) + (size_t)gm * 1536 + (gc - 1792);
            dstp[0] = v0; dstp[32] = v1;
          } else {
            if (gc < N) C[(size_t)gm * AB_LD + gc] = v0;
            if (gc + 32 < N) C[(size_t)gm * AB_LD + gc + 32] = v1;
          }
        },
        smem);
  }
}

struct S5Const { float lb_re, lb_im; };
DEV void s5_consts(const Params& p, int g, int pp, float& lb_re, float& lb_im, float (&bbr)[16], float (&bbi)[16]) {
  const float dt = expf(p.in[I_S5_LOG_DT][g]);
  const float lr = p.in[I_S5_LAM_RE][g * 64 + pp], li = p.in[I_S5_LAM_IM][g * 64 + pp];
  const float mag = expf(lr * dt);
  float sn, cs;
  sincosf(li * dt, &sn, &cs);
  lb_re = mag * cs; lb_im = mag * sn;
  const float den = lr * lr + li * li;
  const float f_re = ((lb_re - 1.f) * lr + lb_im * li) / den;
  const float f_im = (lb_im * lr - (lb_re - 1.f) * li) / den;
  const float* br = p.in[I_S5_B_RE] + (size_t)(g * 64 + pp) * 16;
  const float* bi = p.in[I_S5_B_IM] + (size_t)(g * 64 + pp) * 16;
#pragma unroll
  for (int h = 0; h < 16; ++h) {
    bbr[h] = f_re * br[h] - f_im * bi[h];
    bbi[h] = f_re * bi[h] + f_im * br[h];
  }
}

#define OFF_QB OFF_X2
#define OFF_KSB (OFF_QB + (size_t)NTOK * 512 * 2)
#define OFF_KWB (OFF_KSB + (size_t)NTOK * 128 * 2)
#define OFF_VST (OFF_KWB + (size_t)NTOK * 128 * 2)
#define OFF_VWT (OFF_VST + (size_t)NTOK * 128 * 2)
#define OFF_KCB (OFF_VWT + (size_t)NTOK * 128 * 2)
#define OFF_VCT (OFF_KCB + (size_t)BATCH * 2 * NB_CMP * 64 * 64 * 2)
#define NSA_QSCALE (0.125f * 1.4426950408889634f)

#define P1_S5A_ITEMS (BATCH * 32 * S5_NC / 4)
#define P1_CMP_ITEMS (2 * BATCH * 2 * NB_CMP)
DEV void p1_s5a(const Params& p, int item, char* smem) {
  const int lane = TIDX & 63, wave = TIDX >> 6;
  const int idx = item * 4 + wave;
  const int g = idx & 31, c = (idx >> 5) % S5_NC, b = idx / (32 * S5_NC);
  float lb_re, lb_im, bbr[16], bbi[16];
  s5_consts(p, g, lane, lb_re, lb_im, bbr, bbi);
  const float* H = (const float*)(p.ws + OFF_H);
  float sr = 0.f, si = 0.f;
  float* su = (float*)smem + wave * 64 * 16;
  __syncthreads();
  {
    const float* ur = H + (size_t)(b * SEQ_LEN + c * 64 + lane) * AB_LD + g * 16;
#pragma unroll
    for (int q = 0; q < 4; ++q) st4(su + lane * 16 + q * 4, ld4(ur + q * 4));
  }
  WAVE_SYNC();
  for (int tt = 0; tt < 64; ++tt) {
    const float* u = su + tt * 16;
    float dr = 0.f, di = 0.f;
#pragma unroll
    for (int h4 = 0; h4 < 4; ++h4) {
      const float4 uv = ld4(u + h4 * 4);
      dr += uv.x * bbr[h4 * 4] + uv.y * bbr[h4 * 4 + 1] + uv.z * bbr[h4 * 4 + 2] + uv.w * bbr[h4 * 4 + 3];
      di += uv.x * bbi[h4 * 4] + uv.y * bbi[h4 * 4 + 1] + uv.z * bbi[h4 * 4 + 2] + uv.w * bbi[h4 * 4 + 3];
    }
    const float nr = lb_re * sr - lb_im * si + dr;
    const float ni = lb_re * si + lb_im * sr + di;
    sr = nr; si = ni;
  }
  float2* E = (float2*)(p.ws + OFF_S5E);
  E[((size_t)(b * S5_NC + c) * 32 + g) * 64 + lane] = make_float2(sr, si);
}
#define P1_CMPG_MT ((NCMP + GEMM_BM - 1) / GEMM_BM)
#define P1_CMPG_ITEMS (2 * BATCH * 2 * P1_CMPG_MT)
DEV void p1_cmpgemm(const Params& p, int item, char* smem) {
  const int mt = item % P1_CMPG_MT;
  int r = item / P1_CMPG_MT;
  const int g = r & 1; r >>= 1;
  const int b = r % BATCH; const int which = r / BATCH;
  const float* H = (const float*)(p.ws + OFF_H);
  const float* w1 = which ? p.in[I_CV_W1] : p.in[I_CK_W1];
  const int colbase = (which ? 1152 : 1024) + g * 64;
  float* HID = (float*)(p.ws + OFF_CMPHID) + ((size_t)(which * BATCH + b) * 2 + g) * NB_CMP * 64 * 128;
  const int n0 = mt * GEMM_BM;
  gemm_tile<false>(
      [&](int rr) { return (n0 + rr < NCMP) ? (const void*)(H + ((size_t)b * SEQ_LEN + 16 * (n0 + rr)) * AB_LD + colbase) : (const void*)nullptr; },
      [&](int c) { return w1 + c; }, 128, 2048,
      [&](int row, int col, float v0, float v1) {
        if (n0 + row < NCMP) { HID[(size_t)(n0 + row) * 128 + col] = v0; HID[(size_t)(n0 + row) * 128 + col + 32] = v1; }
      },
      smem, AB_LD);
}
#define P1_CMPC1_ITEMS 16
DEV void p1_cmpc1(const Params& p, int item, char* smem) {
  const int which = item >> 3, sl = item & 7;
  const float* pe = which ? p.in[I_PE_V] : p.in[I_PE_K];
  const float* w1 = which ? p.in[I_CV_W1] : p.in[I_CK_W1];
  float* sPart = (float*)smem;
  const int tid = TIDX, hid = tid & 127, kh = tid >> 7;
  float a = 0.f;
  const int k0 = sl * 256 + kh * 128;
#pragma unroll 16
  for (int k = k0; k < k0 + 128; ++k) a += pe[k] * w1[(size_t)k * 128 + hid];
  __syncthreads();
  sPart[tid] = a;
  __syncthreads();
  if (tid < 128) ((float*)(p.ws + OFF_CMPC1))[(which * 8 + sl) * 128 + tid] = sPart[tid] + sPart[tid + 128];
  __syncthreads();
}
DEV void p1_compress(const Params& p, int item, char* smem) {
  const int tile = item % NB_CMP;
  int r = item / NB_CMP;
  const int g = r & 1; r >>= 1;
  const int b = r % BATCH; const int which = r / BATCH;
  const float* b1 = which ? p.in[I_CV_B1] : p.in[I_CK_B1];
  const float* w2 = which ? p.in[I_CV_W2] : p.in[I_CK_W2];
  const float* C1P = (const float*)(p.ws + OFF_CMPC1) + which * 8 * 128;
  const float* HID = (const float*)(p.ws + OFF_CMPHID) + ((size_t)(which * BATCH + b) * 2 + g) * NB_CMP * 64 * 128;
  float* sOut = (float*)smem;
  float* sHid = sOut + 8 * 64;
  float* sAll = sHid + 8 * 128;
  float* sC1 = sAll + 64 * 65;
  const int tid = TIDX;
  __syncthreads();
  if (tid < 128) {
    const float* q = C1P + tid;
    sC1[tid] = (((((((q[0] + q[128]) + q[256]) + q[384]) + q[512]) + q[640]) + q[768]) + q[896]) + b1[tid];
  }
  float* dst = (float*)(p.ws + (which ? OFF_VCMP : OFF_KCMP));
#pragma unroll 1
  for (int r8 = 0; r8 < 8; ++r8) {
    const int n0 = tile * 64 + r8 * 8;
    __syncthreads();
    for (int w = tid; w < 8 * 128; w += NTHREADS) {
      const int rr = w >> 7, hid = w & 127;
      const int n = n0 + rr;
      sHid[w] = n < NCMP ? geluf_(HID[(size_t)n * 128 + hid] + sC1[hid]) : 0.f;
    }
    __syncthreads();
    for (int w = tid; w < 8 * 64; w += NTHREADS) {
      const int rr = w >> 6, d = w & 63;
      float a = 0.f;
      for (int hid = 0; hid < 128; ++hid) a += sHid[rr * 128 + hid] * w2[hid * 64 + d];
      sOut[w] = a;
    }
    __syncthreads();
    for (int w = tid; w < 8 * 64; w += NTHREADS) {
      const int rr = w >> 6, d = w & 63;
      const int n = n0 + rr;
      float v = sOut[w];
      if (which == 0 && d < 16) {
        const int i = d & 7;
        const float pos = (float)(n * 16 + 31);
        const float inv = __expf(-(float)i * (13.122363377404328f / 8.f));
        float sn, cs;
        sincosf(pos * inv, &sn, &cs);
        const float x1 = sOut[rr * 64 + i], x2 = sOut[rr * 64 + i + 8];
        v = d < 8 ? x1 * cs - x2 * sn : x2 * cs + x1 * sn;
      }
      if (n >= NCMP) v = 0.f;
      sAll[(r8 * 8 + rr) * 65 + d] = v;
      if (n < NCMP) dst[((size_t)(b * NCMP + n) * 2 + g) * 64 + d] = v;
    }
  }
  __syncthreads();
  if (which == 0) {
    unsigned short* KCB = (unsigned short*)(p.ws + OFF_KCB) + (((size_t)b * 2 + g) * NB_CMP * 64 + tile * 64) * 64;
    for (int w = tid; w < 64 * 8; w += NTHREADS) {
      const int nl = w >> 3, o = w & 7;
      float v[8];
#pragma unroll
      for (int q = 0; q < 8; ++q) v[q] = sAll[nl * 65 + o * 8 + q];
      *(uint4*)(KCB + nl * 64 + o * 8) = make_uint4(pk2(v[0], v[1]), pk2(v[2], v[3]), pk2(v[4], v[5]), pk2(v[6], v[7]));
    }
  } else {
    unsigned short* VCT = (unsigned short*)(p.ws + OFF_VCT) + (((size_t)b * 2 + g) * NB_CMP + tile) * 64 * 64;
    for (int w = tid; w < 64 * 8; w += NTHREADS) {
      const int d = w >> 3, o = w & 7;
      float v[8];
#pragma unroll
      for (int q = 0; q < 8; ++q) v[q] = sAll[(o * 8 + q) * 65 + d];
      *(uint4*)(VCT + d * 64 + o * 8) = make_uint4(pk2(v[0], v[1]), pk2(v[2], v[3]), pk2(v[4], v[5]), pk2(v[6], v[7]));
    }
  }
}
DEV uint4 pack8(const float* v) {
  uint4 r;
  r.x = (unsigned)f2bf(v[0]) | ((unsigned)f2bf(v[1]) << 16);
  r.y = (unsigned)f2bf(v[2]) | ((unsigned)f2bf(v[3]) << 16);
  r.z = (unsigned)f2bf(v[4]) | ((unsigned)f2bf(v[5]) << 16);
  r.w = (unsigned)f2bf(v[6]) | ((unsigned)f2bf(v[7]) << 16);
  return r;
}
#define P1_PREP_ITEMS (NTOK / 64)
#define P1_PREP_SMEM ((64 * 8 * 2 + 64 * 128) * 4)
DEV void p1_prep(const Params& p, int item, char* smem) {
  const int tid = TIDX;
  const int b = item / NBLK, blk = item % NBLK;
  const float* H = (const float*)(p.ws + OFF_H);
  float* sCS = (float*)smem;
  float* sV = sCS + 64 * 8 * 2;
  const size_t tok0 = (size_t)b * SEQ_LEN + blk * 64;
  __syncthreads();
  for (int w = tid; w < 64 * 8; w += NTHREADS) {
    const int tk = w >> 3, i = w & 7;
    const float pos = (float)(blk * 64 + tk);
    const float inv = __expf(-(float)i * (13.122363377404328f / 8.f));
    float sn, cs;
    sincosf(pos * inv, &sn, &cs);
    sCS[w * 2] = cs; sCS[w * 2 + 1] = sn;
  }
  __syncthreads();
  unsigned short* QB = (unsigned short*)(p.ws + OFF_QB);
  unsigned short* KSB = (unsigned short*)(p.ws + OFF_KSB);
  unsigned short* KWB = (unsigned short*)(p.ws + OFF_KWB);
  for (int w = tid; w < 64 * 12 * 8; w += NTHREADS) {
    const int o = w & 7, hd = (w >> 3) % 12, tk = w / 96;
    const int col = hd < 8 ? 512 + hd * 64 : (hd < 10 ? 1280 + (hd - 8) * 64 : 1536 + (hd - 10) * 64);
    const float* x = H + (tok0 + tk) * AB_LD + col;
    float v[8];
    const float4 a0 = ld4(x + o * 8), a1 = ld4(x + o * 8 + 4);
    v[0] = a0.x; v[1] = a0.y; v[2] = a0.z; v[3] = a0.w; v[4] = a1.x; v[5] = a1.y; v[6] = a1.z; v[7] = a1.w;
    if (o < 2) {
      const float4 c0 = ld4(x + (1 - o) * 8), c1 = ld4(x + (1 - o) * 8 + 4);
      const float u[8] = {c0.x, c0.y, c0.z, c0.w, c1.x, c1.y, c1.z, c1.w};
#pragma unroll
      for (int i = 0; i < 8; ++i) {
        const float cs = sCS[(tk * 8 + i) * 2], sn = sCS[(tk * 8 + i) * 2 + 1];
        v[i] = o == 0 ? v[i] * cs - u[i] * sn : v[i] * cs + u[i] * sn;
      }
    }
    if (hd < 8) {
#pragma unroll
      for (int i = 0; i < 8; ++i) v[i] *= NSA_QSCALE;
      *(uint4*)(QB + ((tok0 + tk) * 8 + hd) * 64 + o * 8) = pack8(v);
    } else {
      const int g = (hd - 8) & 1;
      unsigned short* dst = (hd < 10 ? KSB : KWB) + (((size_t)b * 2 + g) * SEQ_LEN + blk * 64 + tk) * 64 + o * 8;
      *(uint4*)dst = pack8(v);
    }
  }
#pragma unroll 1
  for (int which = 0; which < 2; ++which) {
    const int col = which ? 1664 : 1408;
    __syncthreads();
    for (int w = tid; w < 64 * 32; w += NTHREADS) {
      const int tk = w >> 5, c4 = (w & 31) * 4;
      st4(sV + tk * 128 + c4, ld4(H + (tok0 + tk) * AB_LD + col + c4));
    }
    __syncthreads();
    unsigned short* VT = (unsigned short*)(p.ws + (which ? OFF_VWT : OFF_VST));
    for (int w = tid; w < 2 * 64 * 8; w += NTHREADS) {
      const int ko = w & 7, d = (w >> 3) & 63, g = w >> 9;
      float v[8];
#pragma unroll
      for (int i = 0; i < 8; ++i) v[i] = sV[(ko * 8 + i) * 128 + g * 64 + d];
      *(uint4*)(VT + ((((size_t)b * 2 + g) * NBLK + blk) * 64 + d) * 64 + ko * 8) = pack8(v);
    }
  }
}

struct NsaSmem {
  unsigned short k[64][72];
  unsigned short vt[64][68];
  float imp[32][128];
  unsigned selmask[32][4];
  unsigned unionm[4];
  float keyb[4][128];
};
#define P2_NSA_SMEM ((int)sizeof(NsaSmem))
#define NSA_QT (SEQ_LEN / 32)
#define P2_NSA_ITEMS (BATCH * 2 * NSA_QT)

struct TileRegs { uint4 k0, k1, v0, v1; };
DEV void tile_gload(TileRegs& r, const unsigned short* Kg, const unsigned short* Vg, int tid) {
  const int row = tid >> 2, seg = tid & 3;
  r.k0 = *(const uint4*)(Kg + row * 64 + seg * 16);
  r.k1 = *(const uint4*)(Kg + row * 64 + seg * 16 + 8);
  if (Vg) {
    r.v0 = *(const uint4*)(Vg + row * 64 + seg * 16);
    r.v1 = *(const uint4*)(Vg + row * 64 + seg * 16 + 8);
  }
}
DEV void tile_sstore(NsaSmem* sm, const TileRegs& r, bool withV, int tid) {
  const int row = tid >> 2, seg = tid & 3;
  *(uint4*)&sm->k[row][seg * 16] = r.k0;
  *(uint4*)&sm->k[row][seg * 16 + 8] = r.k1;
  if (withV) {
    *(uint2*)&sm->vt[row][seg * 16] = make_uint2(r.v0.x, r.v0.y);
    *(uint2*)&sm->vt[row][seg * 16 + 4] = make_uint2(r.v0.z, r.v0.w);
    *(uint2*)&sm->vt[row][seg * 16 + 8] = make_uint2(r.v1.x, r.v1.y);
    *(uint2*)&sm->vt[row][seg * 16 + 12] = make_uint2(r.v1.z, r.v1.w);
  }
}
DEV void qk_tile(const unsigned short (*ksm)[72], const bf16x8 (&qf)[4], f32x16 (&s)[2], int lane) {
  const int r = lane & 31, hh = lane >> 5;
#pragma unroll
  for (int ks2 = 0; ks2 < 2; ++ks2) {
#pragma unroll
    for (int i = 0; i < 16; ++i) s[ks2][i] = 0.f;
#pragma unroll
    for (int ks = 0; ks < 4; ++ks) {
      const bf16x8 a = *(const bf16x8*)&ksm[ks2 * 32 + r][ks * 16 + hh * 8];
      s[ks2] = __builtin_amdgcn_mfma_f32_32x32x16_bf16(a, qf[ks], s[ks2], 0, 0, 0);
    }
  }
}
DEV void pv_tile(const unsigned short (*vsm)[68], const f32x16 (&pr)[2], f32x16 (&o)[2], int lane) {
  const int r = lane & 31, hh = lane >> 5;
#pragma unroll
  for (int ks2 = 0; ks2 < 2; ++ks2)
#pragma unroll
    for (int s = 0; s < 2; ++s) {
      union { uint4 u; bf16x8 v; } pfu;
      pfu.u = make_uint4(pk2(pr[ks2][8 * s], pr[ks2][8 * s + 1]), pk2(pr[ks2][8 * s + 2], pr[ks2][8 * s + 3]),
                         pk2(pr[ks2][8 * s + 4], pr[ks2][8 * s + 5]), pk2(pr[ks2][8 * s + 6], pr[ks2][8 * s + 7]));
      const bf16x8 pf = pfu.v;
#pragma unroll
      for (int mt = 0; mt < 2; ++mt) {
        const uint2 lo = *(const uint2*)&vsm[mt * 32 + r][ks2 * 32 + 16 * s + 4 * hh];
        const uint2 hi = *(const uint2*)&vsm[mt * 32 + r][ks2 * 32 + 16 * s + 8 + 4 * hh];
        union { uint4 u; bf16x8 v; } au;
        au.u = make_uint4(lo.x, lo.y, hi.x, hi.y);
        const bf16x8 a = au.v;
        o[mt] = __builtin_amdgcn_mfma_f32_32x32x16_bf16(a, pf, o[mt], 0, 0, 0);
      }
    }
}
DEV float quad_sum(float v) {
#ifdef CPU_EMU
  v += __shfl_xor(v, 1); v += __shfl_xor(v, 2); return v;
#else
  int x;
  x = __builtin_amdgcn_update_dpp(0, __builtin_bit_cast(int, v), 0xB1, 0xF, 0xF, false); v += __builtin_bit_cast(float, x);
  x = __builtin_amdgcn_update_dpp(0, __builtin_bit_cast(int, v), 0x4E, 0xF, 0xF, false); v += __builtin_bit_cast(float, x);
  return v;
#endif
}
DEV void softmax_step(f32x16 (&s)[2], float& m, float& l, f32x16 (&o)[2]) {
  float tmax = -INFINITY;
#pragma unroll
  for (int ks2 = 0; ks2 < 2; ++ks2)
#pragma unroll
    for (int i = 0; i < 16; ++i) tmax = fmaxf(tmax, s[ks2][i]);
  tmax = fmaxf(tmax, __shfl_xor(tmax, 32));
  const float mnew = fmaxf(m, tmax);
  const float msafe = mnew == -INFINITY ? 0.f : mnew;
  const float alpha = fexp2(m - msafe);
  float ps = 0.f;
#pragma unroll
  for (int ks2 = 0; ks2 < 2; ++ks2)
#pragma unroll
    for (int i = 0; i < 16; ++i) { s[ks2][i] = fexp2(s[ks2][i] - msafe); ps += s[ks2][i]; }
  l = l * alpha + ps;
#pragma unroll
  for (int mt = 0; mt < 2; ++mt)
#pragma unroll
    for (int i = 0; i < 16; ++i) o[mt][i] *= alpha;
  m = mnew;
}
DEV bool testbit4(unsigned w0, unsigned w1, unsigned w2, unsigned w3, int j) {
  const unsigned lo = j & 32 ? w1 : w0, hi = j & 32 ? w3 : w2;
  const unsigned x = j & 64 ? hi : lo;
  return (x >> (j & 31)) & 1u;
}

DEV void p2_nsa(const Params& p, int item, char* smem) {
  NsaSmem* sm = (NsaSmem*)smem;
  const int tid = TIDX, lane = tid & 63, wave = tid >> 6;
  const int bg = item & 3, b = bg >> 1, g = bg & 1;
  const int qt = NSA_QT - 1 - (item >> 2);
  const int t0 = qt * 32;
  const int c = lane & 31, hh = lane >> 5, tl = c >> 2, h = c & 3;
  const int trow = wave * 8 + tl;
  const int tq = t0 + trow;
  const size_t tok = (size_t)b * SEQ_LEN + tq;
  const int hd = g * 4 + h;
  const float* H = (const float*)(p.ws + OFF_H);
  const unsigned short* QB = (const unsigned short*)(p.ws + OFF_QB);
  const unsigned short* KSB = (const unsigned short*)(p.ws + OFF_KSB) + ((size_t)b * 2 + g) * SEQ_LEN * 64;
  const unsigned short* KWB = (const unsigned short*)(p.ws + OFF_KWB) + ((size_t)b * 2 + g) * SEQ_LEN * 64;
  const unsigned short* VST = (const unsigned short*)(p.ws + OFF_VST) + ((size_t)b * 2 + g) * NBLK * 4096;
  const unsigned short* VWT = (const unsigned short*)(p.ws + OFF_VWT) + ((size_t)b * 2 + g) * NBLK * 4096;
  const unsigned short* KCB = (const unsigned short*)(p.ws + OFF_KCB) + ((size_t)b * 2 + g) * NB_CMP * 4096;
  const unsigned short* VCT = (const unsigned short*)(p.ws + OFF_VCT) + ((size_t)b * 2 + g) * NB_CMP * 4096;
  bf16x8 qf[4];
  {
    const unsigned short* qrow = QB + (tok * 8 + hd) * 64;
#pragma unroll
    for (int ks = 0; ks < 4; ++ks) qf[ks] = *(const bf16x8*)(qrow + ks * 16 + hh * 8);
  }
  const float g0 = sigmoidf_(H[tok * AB_LD + 1792 + hd * 3 + 0]);
  const float g1 = sigmoidf_(H[tok * AB_LD + 1792 + hd * 3 + 1]);
  const float g2 = sigmoidf_(H[tok * AB_LD + 1792 + hd * 3 + 2]);
  f32x16 o[2], s[2];
#pragma unroll
  for (int mt = 0; mt < 2; ++mt)
#pragma unroll
    for (int i = 0; i < 16; ++i) o[mt][i] = 0.f;
  float* mixrow = (float*)(p.ws + OFF_MIX) + tok * 1024 + 512 + hd * 64 + 4 * hh;
  __syncthreads();
  for (int w = tid; w < 32 * 128; w += NTHREADS) (&sm->imp[0][0])[w] = 0.f;
  TileRegs tr;
  tr.k0 = tr.k1 = tr.v0 = tr.v1 = make_uint4(0, 0, 0, 0);
  const int nval = tq >= 31 ? (tq - 31) / 16 + 1 : 0;
  const int nvmax = (t0 + 31 - 31) / 16 + 1;
  const int ktn = (nvmax + 63) / 64;
  float m = -INFINITY, l = 0.f;
  tile_gload(tr, KCB, nullptr, tid);
  for (int kt = 0; kt < ktn; ++kt) {
    __syncthreads();
    tile_sstore(sm, tr, false, tid);
    __syncthreads();
    if (kt + 1 < ktn) tile_gload(tr, KCB + (size_t)(kt + 1) * 4096, nullptr, tid);
    qk_tile(sm->k, qf, s, lane);
    float tmax = -INFINITY;
#pragma unroll
    for (int ks2 = 0; ks2 < 2; ++ks2)
#pragma unroll
      for (int i = 0; i < 16; ++i) {
        const int n = kt * 64 + ks2 * 32 + (i & 3) + 8 * (i >> 2) + 4 * hh;
        s[ks2][i] = n < nval ? s[ks2][i] : -INFINITY;
        tmax = fmaxf(tmax, s[ks2][i]);
      }
    tmax = fmaxf(tmax, __shfl_xor(tmax, 32));
    const float mnew = fmaxf(m, tmax);
    const float msafe = mnew == -INFINITY ? 0.f : mnew;
    float ps = 0.f;
#pragma unroll
    for (int ks2 = 0; ks2 < 2; ++ks2)
#pragma unroll
      for (int i = 0; i < 16; ++i) ps += fexp2(s[ks2][i] - msafe);
    l = l * fexp2(m - msafe) + ps;
    m = mnew;
  }
  {
    const float ltot = l + __shfl_xor(l, 32);
    const float invl = ltot > 0.f ? 1.f / ltot : 0.f;
    const float msafe = m == -INFINITY ? 0.f : m;
    tile_gload(tr, KCB, VCT, tid);
    for (int kt = 0; kt < ktn; ++kt) {
      __syncthreads();
      tile_sstore(sm, tr, true, tid);
      __syncthreads();
      if (kt + 1 < ktn) tile_gload(tr, KCB + (size_t)(kt + 1) * 4096, VCT + (size_t)(kt + 1) * 4096, tid);
      qk_tile(sm->k, qf, s, lane);
#pragma unroll
      for (int ks2 = 0; ks2 < 2; ++ks2)
#pragma unroll
        for (int i = 0; i < 16; ++i) {
          const int n = kt * 64 + ks2 * 32 + (i & 3) + 8 * (i >> 2) + 4 * hh;
          s[ks2][i] = n < nval ? fexp2(s[ks2][i] - msafe) * invl : 0.f;
        }
#pragma unroll
      for (int ks2 = 0; ks2 < 2; ++ks2)
#pragma unroll
        for (int g4 = 0; g4 < 4; ++g4) {
          float A = 2.f * (s[ks2][4 * g4] + s[ks2][4 * g4 + 1] + s[ks2][4 * g4 + 2]) + s[ks2][4 * g4 + 3];
          float Bv = s[ks2][4 * g4 + 3];
          A = quad_sum(A); Bv = quad_sum(Bv);
          const int j = kt * 16 + ks2 * 8 + 2 * g4 + hh;
          if (h == 0 && j < NBLK) sm->imp[trow][j] += A;
          WAVE_SYNC();
          if (h == 0 && j + 1 < NBLK) sm->imp[trow][j + 1] += Bv;
          WAVE_SYNC();
        }
      pv_tile(sm->vt, s, o, lane);
    }
#pragma unroll
    for (int mt = 0; mt < 2; ++mt)
#pragma unroll
      for (int g4 = 0; g4 < 4; ++g4) {
        st4(mixrow + mt * 32 + 8 * g4, make_float4(o[mt][4 * g4] * g0, o[mt][4 * g4 + 1] * g0, o[mt][4 * g4 + 2] * g0, o[mt][4 * g4 + 3] * g0));
        o[mt][4 * g4] = 0.f; o[mt][4 * g4 + 1] = 0.f; o[mt][4 * g4 + 2] = 0.f; o[mt][4 * g4 + 3] = 0.f;
      }
  }
  WAVE_SYNC();
  for (int t8 = 0; t8 < 8; ++t8) {
    const int row = wave * 8 + t8, tt = t0 + row, cur = tt >> 6;
    float kv[2]; bool valid[2];
#pragma unroll
    for (int c2 = 0; c2 < 2; ++c2) {
      const int j = lane + 64 * c2;
      valid[c2] = j < NBLK && j <= cur;
      const bool forced = (j == 0) | (j == cur) | (j == cur - 1);
      kv[c2] = valid[c2] ? (forced ? 1e6f : sm->imp[row][j < NBLK ? j : 0]) : -1.f;
      sm->keyb[wave][j] = kv[c2];
    }
    WAVE_SYNC();
    int rank0 = 0, rank1 = 0;
    const int jlim = cur < NBLK - 1 ? cur : NBLK - 1;
    for (int jj = 0; jj <= jlim; ++jj) {
      const float ov = sm->keyb[wave][jj];
      rank0 += (ov > kv[0] || (ov == kv[0] && jj < lane)) ? 1 : 0;
      rank1 += (ov > kv[1] || (ov == kv[1] && jj < lane + 64)) ? 1 : 0;
    }
    const unsigned long long m0 = __ballot(valid[0] && rank0 < 16);
    const unsigned long long m1 = __ballot(valid[1] && rank1 < 16);
    if (lane == 0) {
      sm->selmask[row][0] = (unsigned)m0; sm->selmask[row][1] = (unsigned)(m0 >> 32);
      sm->selmask[row][2] = (unsigned)m1; sm->selmask[row][3] = (unsigned)(m1 >> 32);
    }
    WAVE_SYNC();
  }
  __syncthreads();
  if (tid < 4) {
    unsigned u = 0;
    for (int r = 0; r < 32; ++r) u |= sm->selmask[r][tid];
    sm->unionm[tid] = u;
  }
  __syncthreads();
  const unsigned um0 = sm->unionm[0], um1 = sm->unionm[1], um2 = sm->unionm[2], um3 = sm->unionm[3];
  const unsigned my0 = sm->selmask[trow][0], my1 = sm->selmask[trow][1], my2 = sm->selmask[trow][2], my3 = sm->selmask[trow][3];
  {
    const int jmax = (t0 + 31) >> 6;
    int j = 0;
    while (j <= jmax && !testbit4(um0, um1, um2, um3, j)) ++j;
    m = -INFINITY; l = 0.f;
    if (j <= jmax) tile_gload(tr, KSB + (size_t)j * 4096, VST + (size_t)j * 4096, tid);
    while (j <= jmax) {
      __syncthreads();
      tile_sstore(sm, tr, true, tid);
      __syncthreads();
      int jn = j + 1;
      while (jn <= jmax && !testbit4(um0, um1, um2, um3, jn)) ++jn;
      if (jn <= jmax) tile_gload(tr, KSB + (size_t)jn * 4096, VST + (size_t)jn * 4096, tid);
      const bool mine = testbit4(my0, my1, my2, my3, j);
      if (__ballot(mine) != 0ull) {
        qk_tile(sm->k, qf, s, lane);
#pragma unroll
        for (int ks2 = 0; ks2 < 2; ++ks2)
#pragma unroll
          for (int i = 0; i < 16; ++i) {
            const int kp = j * 64 + ks2 * 32 + (i & 3) + 8 * (i >> 2) + 4 * hh;
            s[ks2][i] = (mine && kp <= tq) ? s[ks2][i] : -INFINITY;
          }
        softmax_step(s, m, l, o);
        pv_tile(sm->vt, s, o, lane);
      }
      j = jn;
    }
    const float ltot = l + __shfl_xor(l, 32);
    const float sc = ltot > 0.f ? g1 / ltot : 0.f;
#pragma unroll
    for (int mt = 0; mt < 2; ++mt)
#pragma unroll
      for (int g4 = 0; g4 < 4; ++g4) {
        float4 a = ld4(mixrow + mt * 32 + 8 * g4);
        a.x += o[mt][4 * g4] * sc; a.y += o[mt][4 * g4 + 1] * sc; a.z += o[mt][4 * g4 + 2] * sc; a.w += o[mt][4 * g4 + 3] * sc;
        st4(mixrow + mt * 32 + 8 * g4, a);
        o[mt][4 * g4] = 0.f; o[mt][4 * g4 + 1] = 0.f; o[mt][4 * g4 + 2] = 0.f; o[mt][4 * g4 + 3] = 0.f;
      }
  }
  {
    const int jlo = t0 - 511 > 0 ? (t0 - 511) >> 6 : 0, jhi = (t0 + 31) >> 6;
    const int wq0 = t0 + wave * 8;
    m = -INFINITY; l = 0.f;
    tile_gload(tr, KWB + (size_t)jlo * 4096, VWT + (size_t)jlo * 4096, tid);
    for (int j = jlo; j <= jhi; ++j) {
      __syncthreads();
      tile_sstore(sm, tr, true, tid);
      __syncthreads();
      if (j + 1 <= jhi) tile_gload(tr, KWB + (size_t)(j + 1) * 4096, VWT + (size_t)(j + 1) * 4096, tid);
      if (j * 64 <= wq0 + 7 && j * 64 + 63 > wq0 - 512) {
        qk_tile(sm->k, qf, s, lane);
#pragma unroll
        for (int ks2 = 0; ks2 < 2; ++ks2)
#pragma unroll
          for (int i = 0; i < 16; ++i) {
            const int kp = j * 64 + ks2 * 32 + (i & 3) + 8 * (i >> 2) + 4 * hh;
            s[ks2][i] = (kp <= tq && kp > tq - 512) ? s[ks2][i] : -INFINITY;
          }
        softmax_step(s, m, l, o);
        pv_tile(sm->vt, s, o, lane);
      }
    }
    const float ltot = l + __shfl_xor(l, 32);
    const float sc = ltot > 0.f ? g2 / ltot : 0.f;
#pragma unroll
    for (int mt = 0; mt < 2; ++mt)
#pragma unroll
      for (int g4 = 0; g4 < 4; ++g4) {
        float4 a = ld4(mixrow + mt * 32 + 8 * g4);
        a.x += o[mt][4 * g4] * sc; a.y += o[mt][4 * g4 + 1] * sc; a.z += o[mt][4 * g4 + 2] * sc; a.w += o[mt][4 * g4 + 3] * sc;
        st4(mixrow + mt * 32 + 8 * g4, a);
        o[mt][4 * g4] = 0.f; o[mt][4 * g4 + 1] = 0.f; o[mt][4 * g4 + 2] = 0.f; o[mt][4 * g4 + 3] = 0.f;
      }
  }
}

#define P1_SMEM ((8 * 64 + 8 * 128 + 64 * 65 + 128) * 4)
DEV void phase_p1(const Params& p, char* smem) {
  const int total = P1_CMPG_ITEMS + P1_CMPC1_ITEMS + P1_PREP_ITEMS;
  for (int it = BIDX; it < total; it += gridDim.x) {
    if (it < P1_CMPG_ITEMS) p1_cmpgemm(p, it, smem);
    else if (it < P1_CMPG_ITEMS + P1_CMPC1_ITEMS) p1_cmpc1(p, it - P1_CMPG_ITEMS, smem);
    else p1_prep(p, it - P1_CMPG_ITEMS - P1_CMPC1_ITEMS, smem);
  }
  {
    const int Gh = (int)gridDim.x / 2, bid_ = BIDX;
    if (bid_ < Gh) for (int it = bid_; it < P1_S5A_ITEMS; it += Gh) p1_s5a(p, it, smem);
  }
}
DEV void phase_p1b(const Params& p, char* smem) {
  for (int it = BIDX; it < P1_CMP_ITEMS; it += gridDim.x) p1_compress(p, it, smem);
}

#define P2_S5C_ITEMS (BATCH * 32 * S5_NC / 4)
#define S5C_ROW 132
#define P2_S5C_SMEM (4 * 16 * S5C_ROW * 4 + 4 * 64 * 16 * 4)
DEV void p2_s5c(const Params& p, int item, char* smem) {
  const int lane = TIDX & 63, wave = TIDX >> 6;
  const int idx = item * 4 + wave;
  const int g = idx & 31, c = (idx >> 5) % S5_NC, b = idx / (32 * S5_NC);
  float lb_re, lb_im, bbr[16], bbi[16];
  s5_consts(p, g, lane, lb_re, lb_im, bbr, bbi);
  float ar = lb_re, ai = lb_im;
#pragma unroll
  for (int s = 0; s < 6; ++s) { const float nr = ar * ar - ai * ai, ni = 2.f * ar * ai; ar = nr; ai = ni; }
  const float2* E = (const float2*)(p.ws + OFF_S5E);
  float sr = 0.f, si = 0.f;
  {
    int cc = 0;
    for (; cc + 8 <= c; cc += 8) {
      float2 e[8];
#pragma unroll
      for (int q = 0; q < 8; ++q) e[q] = E[((size_t)(b * S5_NC + cc + q) * 32 + g) * 64 + lane];
#pragma unroll
      for (int q = 0; q < 8; ++q) {
        const float nr = ar * sr - ai * si + e[q].x, ni = ar * si + ai * sr + e[q].y;
        sr = nr; si = ni;
      }
    }
    for (; cc < c; ++cc) {
      const float2 e = E[((size_t)(b * S5_NC + cc) * 32 + g) * 64 + lane];
      const float nr = ar * sr - ai * si + e.x, ni = ar * si + ai * sr + e.y;
      sr = nr; si = ni;
    }
  }
  __syncthreads();
  const float* H = (const float*)(p.ws + OFF_H);
  float* sS = (float*)smem + wave * 16 * S5C_ROW;
  float* su = (float*)smem + 4 * 16 * S5C_ROW + wave * 64 * 16;
  {
    const float* ur = H + (size_t)(b * SEQ_LEN + c * 64 + lane) * AB_LD + g * 16;
#pragma unroll
    for (int q = 0; q < 4; ++q) st4(su + lane * 16 + q * 4, ld4(ur + q * 4));
  }
  __syncthreads();
  const float* cre = p.in[I_S5_C_RE] + (size_t)g * 16 * 64;
  const float* cim = p.in[I_S5_C_IM] + (size_t)g * 16 * 64;
  float* YG = (float*)(p.ws + OFF_YGELU);
  for (int sc = 0; sc < 4; ++sc) {
    for (int tt = 0; tt < 16; ++tt) {
      const float* u = su + (sc * 16 + tt) * 16;
      float dr = 0.f, di = 0.f;
#pragma unroll
      for (int h4 = 0; h4 < 4; ++h4) {
        const float4 uv = ld4(u + h4 * 4);
        dr += uv.x * bbr[h4 * 4] + uv.y * bbr[h4 * 4 + 1] + uv.z * bbr[h4 * 4 + 2] + uv.w * bbr[h4 * 4 + 3];
        di += uv.x * bbi[h4 * 4] + uv.y * bbi[h4 * 4 + 1] + uv.z * bbi[h4 * 4 + 2] + uv.w * bbi[h4 * 4 + 3];
      }
      const float nr = lb_re * sr - lb_im * si + dr, ni = lb_re * si + lb_im * sr + di;
      sr = nr; si = ni;
      sS[tt * S5C_ROW + lane] = sr;
      sS[tt * S5C_ROW + 64 + lane] = si;
    }
    __syncthreads();
    {
      const int tt = lane >> 2, hq = lane & 3;
      float y[4] = {0.f, 0.f, 0.f, 0.f};
#pragma unroll 2
      for (int k = 0; k < 64; k += 4) {
        const float4 vr = ld4(sS + tt * S5C_ROW + k), vi = ld4(sS + tt * S5C_ROW + 64 + k);
#pragma unroll
        for (int hh = 0; hh < 4; ++hh) {
          const float4 cr = ld4(cre + (hq * 4 + hh) * 64 + k), ci = ld4(cim + (hq * 4 + hh) * 64 + k);
          y[hh] += vr.x * cr.x + vr.y * cr.y + vr.z * cr.z + vr.w * cr.w - (vi.x * ci.x + vi.y * ci.y + vi.z * ci.z + vi.w * ci.w);
        }
      }
      const size_t tok = (size_t)(b * SEQ_LEN + c * 64 + sc * 16 + tt);
      const int ch = g * 16 + hq * 4;
      const float4 uv = ld4(H + tok * AB_LD + ch);
      const float4 dv = ld4(p.in[I_S5_D] + ch);
      float4 o;
      o.x = geluf_(y[0] + dv.x * uv.x); o.y = geluf_(y[1] + dv.y * uv.y);
      o.z = geluf_(y[2] + dv.z * uv.z); o.w = geluf_(y[3] + dv.w * uv.w);
      st4(YG + tok * 512 + ch, o);
    }
    __syncthreads();
  }
}

#define P2_SMEM (P2_S5C_SMEM > P2_NSA_SMEM ? P2_S5C_SMEM : P2_NSA_SMEM)
DEV void phase_p2(const Params& p, char* smem) {
  const int G = gridDim.x;
  const int total = P2_NSA_ITEMS + P2_S5C_ITEMS;
  for (int r = 0;; ++r) {
    const int it = r * G + ((r & 1) ? (G - 1 - (int)BIDX) : (int)BIDX);
    if (r * G >= total) break;
    if (it >= total) continue;
    if (it < P2_NSA_ITEMS) p2_nsa(p, it, smem);
    else p2_s5c(p, it - P2_NSA_ITEMS, smem);
  }
}

DEV void phase_glu(const Params& p, char* smem) {
  const float* A = (const float*)(p.ws + OFF_YGELU);
  const float* B = p.in[I_S5_W_GLU];
  const float* bias = p.in[I_S5_B_GLU];
  float* MIX = (float*)(p.ws + OFF_MIX);
  const int NT = 4, MT = NTOK / GEMM_BM;
  const int xcd_ = BIDX & 7, lb_ = BIDX >> 3, nb_ = gridDim.x >> 3;
  for (int j_ = lb_; j_ < (MT / 8) * NT; j_ += nb_) {
    const int it = (xcd_ + 8 * (j_ / NT)) * NT + (j_ % NT);
    const int m0 = (it / NT) * GEMM_BM, n0 = (it % NT) * 128;
    gemm_tile<false>(
        [&](int r) { return (const void*)(A + (size_t)(m0 + r) * 512); },
        [&](int c) { return B + n0 + c; }, 512, 512,
        [&](int row, int col, float v0, float v1) {
          const size_t gm = m0 + row; const int gc = n0 + col;
          const float y0 = A[gm * 512 + gc], y1 = A[gm * 512 + gc + 32];
          MIX[gm * 1024 + gc] = y0 * sigmoidf_(v0 + bias[gc]);
          MIX[gm * 1024 + gc + 32] = y1 * sigmoidf_(v1 + bias[gc + 32]);
        },
        smem);
  }
}

template <int LAYER>
DEV void phase_outproj(const Params& p, char* smem) {
  const float* A = (const float*)(p.ws + OFF_MIX);
  const float* B = LAYER == 0 ? p.in[I_AB_W_OUT] : p.in[I_CD_W_OUT];
  const float* xin = LAYER == 0 ? p.in[I_X] : (const float*)(p.ws + OFF_X2);
  float* PRE = (float*)(p.ws + OFF_H);
  const int NT = 8, MT = NTOK / GEMM_BM;
  const int xcd_ = BIDX & 7, lb_ = BIDX >> 3, nb_ = gridDim.x >> 3;
  for (int j_ = lb_; j_ < (MT / 8) * NT; j_ += nb_) {
    const int it = (xcd_ + 8 * (j_ / NT)) * NT + (j_ % NT);
    const int m0 = (it / NT) * GEMM_BM, n0 = (it % NT) * 128;
    gemm_tile<false>(
        [&](int r) { return (const void*)(A + (size_t)(m0 + r) * 1024); },
        [&](int c) { return B + n0 + c; }, 1024, 1024,
        [&](int row, int col, float v0, float v1) {
          const size_t o = (size_t)(m0 + row) * 1024 + n0 + col;
          PRE[o] = ALPHA_F * xin[o] + v0;
          PRE[o + 32] = ALPHA_F * xin[o + 32] + v1;
        },
        smem);
  }
}

DEV void wave_ln(float (&v)[16], const float* gam, const float* bet, int lane) {
  float s = 0.f;
#pragma unroll
  for (int i = 0; i < 16; ++i) s += v[i];
  const float mu = wave_sum(s) * (1.f / 1024.f);
  float q = 0.f;
#pragma unroll
  for (int i = 0; i < 16; ++i) { const float d = v[i] - mu; q += d * d; }
  const float rstd = rsqrtf(wave_sum(q) * (1.f / 1024.f) + 1e-5f);
#pragma unroll
  for (int i = 0; i < 4; ++i) {
    const float4 gv = ld4(gam + lane * 4 + 256 * i), bv = ld4(bet + lane * 4 + 256 * i);
    v[i * 4 + 0] = (v[i * 4 + 0] - mu) * rstd * gv.x + bv.x;
    v[i * 4 + 1] = (v[i * 4 + 1] - mu) * rstd * gv.y + bv.y;
    v[i * 4 + 2] = (v[i * 4 + 2] - mu) * rstd * gv.z + bv.z;
    v[i * 4 + 3] = (v[i * 4 + 3] - mu) * rstd * gv.w + bv.w;
  }
}

#define LNR_T 2
#define P5_SMEM ((4 * LNR_T * 1024 + 4 * 4 * LNR_T * 64 + 4 * 64) * 4)
template <int LAYER>
DEV void phase_ln_router(const Params& p, char* smem) {
  const int lane = TIDX & 63, wave = TIDX >> 6;
  const float* PRE = (const float*)(p.ws + OFF_H);
  float* X1 = (float*)(p.ws + OFF_X1);
  const float* router = p.in[I_ROUTER] + (size_t)LAYER * 1024 * 64;
  const float* bias = p.in[I_MOE_BIAS] + LAYER * 64;
  int* TOPI = (int*)(p.ws + OFF_TOPI);
  float* TOPG = (float*)(p.ws + OFF_TOPG);
  float* xall = (float*)smem;
  float* part = xall + 4 * LNR_T * 1024;
  float* ms = part + 4 * 4 * LNR_T * 64 + wave * 64;
  float* xs = xall + wave * LNR_T * 1024;
  unsigned short* X1B = (unsigned short*)p.out;
  for (int it = BIDX; it < NTOK / (4 * LNR_T); it += gridDim.x) {
    const size_t tokb = (size_t)it * (4 * LNR_T) + wave * LNR_T;
    __syncthreads();
#pragma unroll 1
    for (int t = 0; t < LNR_T; ++t) {
      const size_t tok = tokb + t;
      float v[16];
#pragma unroll
      for (int i = 0; i < 4; ++i) {
        const float4 a = ld4(PRE + tok * 1024 + lane * 4 + 256 * i);
        v[i * 4] = a.x; v[i * 4 + 1] = a.y; v[i * 4 + 2] = a.z; v[i * 4 + 3] = a.w;
      }
      wave_ln(v, p.in[I_LN1_G] + LAYER * 1024, p.in[I_LN1_B] + LAYER * 1024, lane);
#pragma unroll
      for (int i = 0; i < 4; ++i) {
        const float4 a = make_float4(v[i * 4], v[i * 4 + 1], v[i * 4 + 2], v[i * 4 + 3]);
        st4(X1 + tok * 1024 + lane * 4 + 256 * i, a);
        st4(xs + t * 1024 + lane * 4 + 256 * i, a);
        *(uint2*)(X1B + tok * 1024 + lane * 4 + 256 * i) = make_uint2(pk2(a.x, a.y), pk2(a.z, a.w));
      }
    }
    __syncthreads();
    {
      float pl[4 * LNR_T];
#pragma unroll
      for (int t = 0; t < 4 * LNR_T; ++t) pl[t] = 0.f;
#pragma unroll 2
      for (int k = wave * 256; k < wave * 256 + 256; k += 4) {
        const float r0 = router[(size_t)k * 64 + lane], r1 = router[(size_t)(k + 1) * 64 + lane],
                    r2 = router[(size_t)(k + 2) * 64 + lane], r3 = router[(size_t)(k + 3) * 64 + lane];
#pragma unroll
        for (int t = 0; t < 4 * LNR_T; ++t) {
          const float4 xv = ld4(xall + t * 1024 + k);
          pl[t] += xv.x * r0 + xv.y * r1 + xv.z * r2 + xv.w * r3;
        }
      }
#pragma unroll
      for (int t = 0; t < 4 * LNR_T; ++t) part[(wave * 4 * LNR_T + t) * 64 + lane] = pl[t];
    }
    __syncthreads();
    float lg[LNR_T];
#pragma unroll
    for (int t = 0; t < LNR_T; ++t) {
      const int tg = wave * LNR_T + t;
      lg[t] = ((part[(0 * 4 * LNR_T + tg) * 64 + lane] + part[(1 * 4 * LNR_T + tg) * 64 + lane]) + part[(2 * 4 * LNR_T + tg) * 64 + lane]) +
              part[(3 * 4 * LNR_T + tg) * 64 + lane];
    }
#pragma unroll
    for (int t = 0; t < LNR_T; ++t) {
      const size_t tok = tokb + t;
      const float score = 1.f / (1.f + expf(-lg[t]));
      const float biased = score + bias[lane];
      float m1 = biased; int a1 = lane;
#pragma unroll
      for (int mm = 1; mm <= 4; mm <<= 1) {
        const float ov = __shfl_xor(m1, mm); const int oa = __shfl_xor(a1, mm);
        if (ov > m1 || (ov == m1 && oa < a1)) { m1 = ov; a1 = oa; }
      }
      float m2 = lane == a1 ? -INFINITY : biased;
#pragma unroll
      for (int mm = 1; mm <= 4; mm <<= 1) m2 = fmaxf(m2, __shfl_xor(m2, mm));
      const float gs = m1 + m2;
      const int mygrp = lane >> 3;
      int rank = 0;
#pragma unroll
      for (int gg = 0; gg < 8; ++gg) {
        const float og = __shfl(gs, gg * 8);
        rank += (og > gs || (og == gs && gg < mygrp)) ? 1 : 0;
      }
      const float masked = rank < 4 ? biased : -INFINITY;
      WAVE_SYNC();
      ms[lane] = masked;
      WAVE_SYNC();
      int erank = 0;
      for (int e = 0; e < 64; ++e) {
        const float ov = ms[e];
        erank += (ov > masked || (ov == masked && e < lane)) ? 1 : 0;
      }
      const bool selected = erank < 8;
      const float gsum = wave_sum(selected ? score : 0.f);
      if (selected) {
        TOPI[tok * 8 + erank] = lane;
        TOPG[tok * 8 + erank] = score / gsum * 2.5f;
      }
    }
  }
}

#define P6_SMEM GEMM_SMEM_BYTES
template <int LAYER>
DEV void phase_lists_shup(const Params& p, char* smem) {
  const int tid = TIDX, lane = tid & 63, wave = tid >> 6;
  const int* TOPI = (const int*)(p.ws + OFF_TOPI);
  const float* TOPG = (const float*)(p.ws + OFF_TOPG);
  int* PPOS = (int*)(p.ws + OFF_S5E);
  int* CNT = (int*)(p.ws + OFF_CNT);
  int* LTOK = (int*)(p.ws + OFF_LTOK);
  float* LGATE = (float*)(p.ws + OFF_LGATE);
  const unsigned short* X1B = (const unsigned short*)p.out;
  unsigned short* HS = (unsigned short*)(p.ws + OFF_HS);
  const float* W1 = p.in[I_SH_W1] + (size_t)LAYER * 1024 * 256;
  const float* W3 = p.in[I_SH_W3] + (size_t)LAYER * 1024 * 256;
  const int MT = NTOK / GEMM_BM;
  int* swave = (int*)smem;
  for (int it = BIDX; it < 64; it += gridDim.x) {
    const int e = it;
    int base = 0;
    for (int t0 = 0; t0 < NTOK; t0 += 4 * NTHREADS) {
      const int tok4 = t0 + 4 * tid;
      int slot[4];
      unsigned long long bal[4];
#pragma unroll
      for (int j = 0; j < 4; ++j) {
        const int4 a = *(const int4*)(TOPI + (size_t)(tok4 + j) * 8), b = *(const int4*)(TOPI + (size_t)(tok4 + j) * 8 + 4);
        int sl = -1;
        sl = a.x == e ? 0 : sl; sl = a.y == e ? 1 : sl; sl = a.z == e ? 2 : sl; sl = a.w == e ? 3 : sl;
        sl = b.x == e ? 4 : sl; sl = b.y == e ? 5 : sl; sl = b.z == e ? 6 : sl; sl = b.w == e ? 7 : sl;
        slot[j] = sl;
        bal[j] = __ballot(sl >= 0);
      }
      const unsigned long long lower = (1ull << lane) - 1ull;
      int pre = 0, wtot = 0;
#pragma unroll
      for (int j = 0; j < 4; ++j) { pre += __popcll(bal[j] & lower); wtot += __popcll(bal[j]); }
      __syncthreads();
      if (lane == 0) swave[wave] = wtot;
      __syncthreads();
      int woff = 0, tot = 0;
#pragma unroll
      for (int w = 0; w < 4; ++w) { const int c = swave[w]; if (w < wave) woff += c; tot += c; }
      int pos = base + woff + pre;
#pragma unroll
      for (int j = 0; j < 4; ++j) {
        if (slot[j] >= 0) {
          const int tok = tok4 + j;
          LTOK[(size_t)e * NTOK + pos] = tok;
          LGATE[(size_t)e * NTOK + pos] = TOPG[(size_t)tok * 8 + slot[j]];
          PPOS[(size_t)e * NTOK + tok] = pos;
          ++pos;
        }
      }
      base += tot;
    }
    if (tid == 0) CNT[e * 32] = base;
    __syncthreads();
  }
  {
    const int NT = 4;
    const int xcd_ = BIDX & 7, lb_ = BIDX >> 3, nb_ = gridDim.x >> 3;
    for (int j_ = lb_; j_ < (MT / 8) * NT; j_ += nb_) {
      const int m0 = (xcd_ + 8 * (j_ / NT)) * GEMM_BM, ct = j_ % NT;
      gemm_tile<true>(
          [&](int r) { return (const void*)(X1B + (size_t)(m0 + r) * 1024); },
          [&](int c) { return (((c >> 5) & 1) ? W3 : W1) + ct * 64 + (c >> 6) * 32 + (c & 31); }, 256, 1024,
          [&](int row, int col, float v0, float v1) {
            const int lc = ct * 64 + (col >> 6) * 32 + (col & 31);
            HS[(size_t)(m0 + row) * 256 + lc] = f2bf(siluf_(v0) * v1);
          },
          smem);
    }
  }
}

struct ExpMap { int tstart[65]; int rbase[65]; int ltile[9]; };
DEV void build_expmap(const Params& p, ExpMap* em) {
  __syncthreads();
  if (TIDX == 0) {
    const int* CNT = (const int*)(p.ws + OFF_CNT);
    int ts = 0, rb = 0;
    for (int e = 0; e < 64; ++e) {
      em->tstart[e] = ts; em->rbase[e] = rb;
      const int c = CNT[e * 32];
      ts += (c + GEMM_BM - 1) / GEMM_BM; rb += c;
    }
    em->tstart[64] = ts; em->rbase[64] = rb;
    const int x = BIDX & 7;
    int lt = 0;
    for (int k = 0; k < 8; ++k) { em->ltile[k] = lt; lt += em->tstart[x + 8 * k + 1] - em->tstart[x + 8 * k]; }
    em->ltile[8] = lt;
  }
  __syncthreads();
}
DEV void map_expert_tile(const ExpMap* em, int j, int CT, int& e, int& rt, int& ct) {
  const int jr = j / CT; ct = j % CT;
  int k = 0;
  for (int q = 1; q < 8; ++q) if (em->ltile[q] <= jr) k = q;
  e = (BIDX & 7) + 8 * k; rt = jr - em->ltile[k];
}
#define P7_SMEM (GEMM_SMEM_BYTES + 1024)
template <int LAYER>
DEV void phase_routed_up(const Params& p, char* smem) {
  ExpMap* em = (ExpMap*)(smem + GEMM_SMEM_BYTES);
  build_expmap(p, em);
  const int* CNT = (const int*)(p.ws + OFF_CNT);
  const int* LTOK = (const int*)(p.ws + OFF_LTOK);
  const unsigned short* X1B = (const unsigned short*)p.out;
  unsigned short* HR = (unsigned short*)(p.ws + OFF_HR);
  const int lb_ = BIDX >> 3, nb_ = gridDim.x >> 3;
  for (int j_ = lb_; j_ < em->ltile[8] * 4; j_ += nb_) {
    int e, rtl, ct;
    map_expert_tile(em, j_, 4, e, rtl, ct);
    const int r0 = rtl * GEMM_BM;
    const int cnt = CNT[e * 32], rbase = em->rbase[e];
    const float* W1 = p.in[I_MOE_W1] + ((size_t)LAYER * 64 + e) * 1024 * 256;
    const float* W3 = p.in[I_MOE_W3] + ((size_t)LAYER * 64 + e) * 1024 * 256;
    gemm_tile<true>(
        [&](int r) { return (r0 + r < cnt) ? (const void*)(X1B + (size_t)LTOK[(size_t)e * NTOK + r0 + r] * 1024) : (const void*)nullptr; },
        [&](int c) { return (((c >> 5) & 1) ? W3 : W1) + ct * 64 + (c >> 6) * 32 + (c & 31); }, 256, 1024,
        [&](int row, int col, float v0, float v1) {
          if (r0 + row < cnt) {
            const int lc = ct * 64 + (col >> 6) * 32 + (col & 31);
            HR[(size_t)(rbase + r0 + row) * 256 + lc] = f2bf(siluf_(v0) * v1);
          }
        },
        smem);
  }
}

template <int LAYER>
DEV void phase_down(const Params& p, char* smem) {
  ExpMap* em = (ExpMap*)(smem + GEMM_SMEM_BYTES);
  build_expmap(p, em);
  const int* CNT = (const int*)(p.ws + OFF_CNT);
  const float* LGATE = (const float*)(p.ws + OFF_LGATE);
  const unsigned short* HR = (const unsigned short*)(p.ws + OFF_HR);
  const unsigned short* HS = (const unsigned short*)(p.ws + OFF_HS);
  unsigned short* Y = (unsigned short*)(p.ws + OFF_Y);
  float* FS = (float*)(p.ws + OFF_FS);
  const int xcd_ = BIDX & 7, lb_ = BIDX >> 3, nb_ = gridDim.x >> 3;
  for (int j_ = lb_; j_ < em->ltile[8] * 8; j_ += nb_) {
    int e, rtl, ct;
    map_expert_tile(em, j_, 8, e, rtl, ct);
    const int r0 = rtl * GEMM_BM;
    const int cnt = CNT[e * 32], rbase = em->rbase[e];
    const float* W2 = p.in[I_MOE_W2] + ((size_t)LAYER * 64 + e) * 256 * 1024;
    const int n0 = ct * 128;
    gemm_tile<true>(
        [&](int r) { return (r0 + r < cnt) ? (const void*)(HR + (size_t)(rbase + r0 + r) * 256) : (const void*)nullptr; },
        [&](int c) { return W2 + n0 + c; }, 1024, 256,
        [&](int row, int col, float v0, float v1) {
          if (r0 + row < cnt) {
            const float gt = LGATE[(size_t)e * NTOK + r0 + row];
            const size_t o = (size_t)(rbase + r0 + row) * 1024 + n0 + col;
            Y[o] = f2bf(v0 * gt); Y[o + 32] = f2bf(v1 * gt);
          }
        },
        smem);
  }
  {
    const int MT = NTOK / GEMM_BM, NT = 8;
    const float* W2 = p.in[I_SH_W2] + (size_t)LAYER * 256 * 1024;
    for (int j_ = lb_; j_ < (MT / 8) * NT; j_ += nb_) {
      const int m0 = (xcd_ + 8 * (j_ / NT)) * GEMM_BM, n0 = (j_ % NT) * 128;
      gemm_tile<true>(
          [&](int r) { return (const void*)(HS + (size_t)(m0 + r) * 256); },
          [&](int c) { return W2 + n0 + c; }, 1024, 256,
          [&](int row, int col, float v0, float v1) {
            const size_t o = (size_t)(m0 + row) * 1024 + n0 + col;
            FS[o] = v0; FS[o + 32] = v1;
          },
          smem);
    }
  }
}

template <int LAYER>
DEV void phase_combine(const Params& p, char* smem) {
  ExpMap* em = (ExpMap*)smem;
  build_expmap(p, em);
  const int lane = TIDX & 63, wave = TIDX >> 6;
  const float* X1 = (const float*)(p.ws + OFF_X1);
  const float* FS = (const float*)(p.ws + OFF_FS);
  const unsigned short* Y = (const unsigned short*)(p.ws + OFF_Y);
  const int* TOPI = (const int*)(p.ws + OFF_TOPI);
  const int* PPOS = (const int*)(p.ws + OFF_S5E);
  float* OUT = LAYER == 0 ? (float*)(p.ws + OFF_X2) : p.out;
  for (int it = BIDX; it < NTOK / 4; it += gridDim.x) {
    const size_t tok = (size_t)it * 4 + wave;
    float v[16];
#pragma unroll
    for (int i = 0; i < 4; ++i) {
      const float4 a = ld4(X1 + tok * 1024 + lane * 4 + 256 * i), f = ld4(FS + tok * 1024 + lane * 4 + 256 * i);
      v[i * 4] = ALPHA_F * a.x + f.x; v[i * 4 + 1] = ALPHA_F * a.y + f.y; v[i * 4 + 2] = ALPHA_F * a.z + f.z; v[i * 4 + 3] = ALPHA_F * a.w + f.w;
    }
    size_t rows[8];
#pragma unroll
    for (int s = 0; s < 8; ++s) { const int e_ = TOPI[tok * 8 + s]; rows[s] = (size_t)em->rbase[e_] + PPOS[(size_t)e_ * NTOK + tok]; }
#pragma unroll
    for (int s0 = 0; s0 < 8; s0 += 4) {
      uint2 yy[4][4];
#pragma unroll
      for (int s = 0; s < 4; ++s)
#pragma unroll
        for (int i = 0; i < 4; ++i) yy[s][i] = *(const uint2*)(Y + rows[s0 + s] * 1024 + lane * 4 + 256 * i);
#pragma unroll
      for (int s = 0; s < 4; ++s)
#pragma unroll
        for (int i = 0; i < 4; ++i) {
          const uint2 y = yy[s][i];
          v[i * 4] += bf2f((unsigned short)(y.x & 0xFFFF)); v[i * 4 + 1] += bf2f((unsigned short)(y.x >> 16));
          v[i * 4 + 2] += bf2f((unsigned short)(y.y & 0xFFFF)); v[i * 4 + 3] += bf2f((unsigned short)(y.y >> 16));
        }
    }
    wave_ln(v, p.in[I_LN2_G] + LAYER * 1024, p.in[I_LN2_B] + LAYER * 1024, lane);
#pragma unroll
    for (int i = 0; i < 4; ++i) st4(OUT + tok * 1024 + lane * 4 + 256 * i, make_float4(v[i * 4], v[i * 4 + 1], v[i * 4 + 2], v[i * 4 + 3]));
    if (LAYER == 0) {
      unsigned short* X2B = (unsigned short*)(p.ws + OFF_X2B);
#pragma unroll
      for (int i = 0; i < 4; ++i) *(uint2*)(X2B + tok * 1024 + lane * 4 + 256 * i) = make_uint2(pk2(v[i * 4], v[i * 4 + 1]), pk2(v[i * 4 + 2], v[i * 4 + 3]));
    }
  }
}

DEV float shifted(const float* Hc, size_t tok, int col, const float* mu) {
  const float cur = Hc[tok * 1792 + col];
  const float prev = (tok % SEQ_LEN) == 0 ? 0.f : Hc[(tok - 1) * 1792 + col];
  return cur + (prev - cur) * mu[col];
}

#define RWP_T 32
#define P11_PREP_ITEMS (NTOK / RWP_T)
#define P11_KV_ITEMS (BATCH * 4 * RET_NC)
#define P11_SMEM (RWP_T * 128 * 4)
DEV void p11_prep(const Params& p, int item, char* smem) {
  const int tid = TIDX;
  const float* Hc = (const float*)(p.ws + OFF_H);
  const float* mu = p.in[I_RW_MU];
  float* sl = (float*)smem;
  __syncthreads();
  for (int w = tid; w < RWP_T * 128; w += NTHREADS) {
    const int tt = w >> 7, j = w & 127;
    const size_t tok = (size_t)item * RWP_T + tt;
    const float v = shifted(Hc, tok, 1536 + j, mu);
    sl[w] = j < 64 ? tanhf(v) : v;
    ((float*)(p.ws + OFF_GLO))[tok * 128 + j] = sigmoidf_(shifted(Hc, tok, 1664 + j, mu));
  }
  __syncthreads();
  float* RWW = (float*)(p.ws + OFF_RWW); float* RWK = (float*)(p.ws + OFF_RWK);
  float* RWKK = (float*)(p.ws + OFF_RWKK); float* RWA = (float*)(p.ws + OFF_RWA);
  float* RWR = p.out + (size_t)NTOK * 512; float* RWV = p.out;
  const float* w_up = p.in[I_RW_W_UP]; const float* a_up = p.in[I_RW_A_UP];
#pragma unroll
  for (int cc = 0; cc < 2; ++cc) {
    const int c = tid + 256 * cc;
    float aw[RWP_T], aa[RWP_T];
#pragma unroll
    for (int tt = 0; tt < RWP_T; ++tt) { aw[tt] = 0.f; aa[tt] = 0.f; }
    for (int j0 = 0; j0 < 64; j0 += 16) {
      float wu[16], au[16];
#pragma unroll
      for (int q = 0; q < 16; ++q) { wu[q] = w_up[(j0 + q) * 512 + c]; au[q] = a_up[(j0 + q) * 512 + c]; }
#pragma unroll
      for (int q4 = 0; q4 < 4; ++q4) {
#pragma unroll
        for (int tt = 0; tt < RWP_T; ++tt) {
          const float4 sw = ld4(sl + tt * 128 + j0 + q4 * 4), sa = ld4(sl + tt * 128 + 64 + j0 + q4 * 4);
          aw[tt] += sw.x * wu[q4 * 4] + sw.y * wu[q4 * 4 + 1] + sw.z * wu[q4 * 4 + 2] + sw.w * wu[q4 * 4 + 3];
          aa[tt] += sa.x * au[q4 * 4] + sa.y * au[q4 * 4 + 1] + sa.z * au[q4 * 4 + 2] + sa.w * au[q4 * 4 + 3];
        }
      }
    }
    const float w0 = p.in[I_RW_W0][c], a0 = p.in[I_RW_A0][c], kkc = p.in[I_RW_K_K][c], kac = p.in[I_RW_K_A][c];
#pragma unroll 4
    for (int tt = 0; tt < RWP_T; ++tt) {
      const size_t tok = (size_t)item * RWP_T + tt;
      const float lw = w0 + aw[tt];
      const float nl = -lw;
      const float sp = nl > 20.f ? nl : log1pf(expf(nl));
      const float wl = -sp - 0.5f;
      const float decay = expf(-expf(wl));
      const float a = 1.f / (1.f + expf(-(a0 + aa[tt])));
      const float rs = shifted(Hc, tok, c, mu);
      const float ks = shifted(Hc, tok, 512 + c, mu);
      const float vs = shifted(Hc, tok, 1024 + c, mu);
      float kk = ks * kkc;
      const float nrm = sqrtf(wave_sum(kk * kk));
      kk = kk / fmaxf(nrm, 1e-12f);
      RWW[tok * 512 + c] = decay;
      RWK[tok * 512 + c] = ks * (1.f + (a - 1.f) * kac);
      RWKK[tok * 512 + c] = kk;
      RWA[tok * 512 + c] = kk * a;
      RWR[tok * 512 + c] = rs;
      RWV[tok * 512 + c] = vs;
    }
  }
}
DEV float ret_log2gamma(int h) { return log2f(1.f - exp2f(-5.f - (float)h)); }
struct KvSmem { unsigned short vt[128][72]; unsigned short kt[64][72]; };
#define P11_KV_SMEM ((int)sizeof(KvSmem))
DEV void p11_kv(const Params& p, int item, char* smem) {
  KvSmem* sm = (KvSmem*)smem;
  const int c = item % RET_NC, h = (item / RET_NC) & 3, b = item / (RET_NC * 4);
  const int tid = TIDX, lane = tid & 63, wave = tid >> 6;
  const int r = lane & 31, hh = lane >> 5;
  const float* H2 = (const float*)(p.ws + OFF_H2);
  const float lg = ret_log2gamma(h);
  const size_t tok0 = (size_t)b * SEQ_LEN + c * 128;
  f32x16 acc[2];
#pragma unroll
  for (int nt = 0; nt < 2; ++nt)
#pragma unroll
    for (int i = 0; i < 16; ++i) acc[nt][i] = 0.f;
#pragma unroll 1
  for (int kt = 0; kt < 2; ++kt) {
    __syncthreads();
#pragma unroll
    for (int q = 0; q < 8; ++q) {
      const int f = tid + 256 * q;
      const int key = f >> 5, d4 = (f & 31) * 4;
      const float dec = exp2f((float)(127 - (kt * 64 + key)) * lg);
      const float4 v = ld4(H2 + (tok0 + kt * 64 + key) * 1536 + 512 + h * 128 + d4);
      sm->vt[d4][key] = f2bf(v.x * dec); sm->vt[d4 + 1][key] = f2bf(v.y * dec);
      sm->vt[d4 + 2][key] = f2bf(v.z * dec); sm->vt[d4 + 3][key] = f2bf(v.w * dec);
    }
#pragma unroll
    for (int q = 0; q < 4; ++q) {
      const int f = tid + 256 * q;
      const int key = f >> 4, d4 = (f & 15) * 4;
      const float4 v = ld4(H2 + (tok0 + kt * 64 + key) * 1536 + 256 + h * 64 + d4);
      sm->kt[d4][key] = f2bf(v.x); sm->kt[d4 + 1][key] = f2bf(v.y); sm->kt[d4 + 2][key] = f2bf(v.z); sm->kt[d4 + 3][key] = f2bf(v.w);
    }
    __syncthreads();
#pragma unroll
    for (int ks = 0; ks < 4; ++ks) {
      const bf16x8 a = *(const bf16x8*)&sm->vt[wave * 32 + r][ks * 16 + hh * 8];
#pragma unroll
      for (int nt = 0; nt < 2; ++nt) {
        const bf16x8 bb = *(const bf16x8*)&sm->kt[nt * 32 + r][ks * 16 + hh * 8];
        acc[nt] = __builtin_amdgcn_mfma_f32_32x32x16_bf16(a, bb, acc[nt], 0, 0, 0);
      }
    }
  }
  float* KV = (float*)(p.ws + OFF_RETKV) + (size_t)item * 64 * 128;
#pragma unroll
  for (int nt = 0; nt < 2; ++nt)
#pragma unroll
    for (int g4 = 0; g4 < 4; ++g4)
      st4(KV + (nt * 32 + r) * 128 + wave * 32 + 8 * g4 + 4 * hh,
          make_float4(acc[nt][4 * g4], acc[nt][4 * g4 + 1], acc[nt][4 * g4 + 2], acc[nt][4 * g4 + 3]));
}
DEV void phase_p11(const Params& p, char* smem) {
  {
    unsigned* RKF = (unsigned*)(p.ws + OFF_RKF);
    for (int i = BIDX * NTHREADS + TIDX; i < BATCH * 8 * (SEQ_LEN / 32); i += gridDim.x * NTHREADS) RKF[i] = 0u;
  }
  const int total = P11_PREP_ITEMS + P11_KV_ITEMS;
  for (int it = BIDX; it < total; it += gridDim.x) {
    if (it < P11_KV_ITEMS) p11_kv(p, it, smem);
    else p11_prep(p, it - P11_KV_ITEMS, smem);
  }
}

#define RK_T 32
#define RK_NCH (SEQ_LEN / RK_T)
#define RK_NCHT (BATCH * 8 * RK_NCH)
#define OFF_RKPT OFF_H
#define OFF_RKKT (OFF_RKPT + (size_t)RK_NCHT * 64 * 64 * 2)
#define OFF_RKVT (OFF_RKKT + (size_t)RK_NCHT * 64 * 32 * 2)
#define OFF_RKRT (OFF_RKVT + (size_t)RK_NCHT * 64 * 32 * 2)
#define OFF_RKAT (OFF_RKRT + (size_t)RK_NCHT * 32 * 64 * 2)
#define OFF_RKEND (OFF_RKAT + (size_t)RK_NCHT * 32 * 32 * 2)
static_assert(OFF_RKEND <= OFF_H2, "rk buffers must fit in the H1 region");
#define RKPRE_SMEM ((4 * 32 * 64 + 32 * 64) * 4)

DEV unsigned short* rksc_row(char* ws, int b, int h, int c, int i) {
  return (unsigned short*)(ws + OFF_RWW) + (((size_t)b * SEQ_LEN + (size_t)c * RK_T + (i >> 1)) * 512 + h * 64) * 2 + (i & 1) * 64;
}
#if RK_MERGED
DEV void st_wt_u16(unsigned short* q, unsigned short v) { asm volatile("global_store_short %0, %1, off sc1" :: "v"(q), "v"((unsigned)v) : "memory"); }
typedef unsigned u32x4_t __attribute__((ext_vector_type(4)));
DEV void st_wt_b128(void* q, uint4 v) { const u32x4_t w = {v.x, v.y, v.z, v.w}; asm volatile("global_store_dwordx4 %0, %1, off sc1" :: "v"(q), "v"(w) : "memory"); }
#else
DEV void st_wt_u16(unsigned short* q, unsigned short v) { *q = v; }
DEV void st_wt_b128(void* q, uint4 v) { *(uint4*)q = v; }
#endif
DEV void rk_precompute(const Params& p, int ch, char* smem) {
  const int c = ch % RK_NCH, bh = ch / RK_NCH, h = bh & 7, b = bh >> 3;
  const int tid = TIDX, lane = tid & 63, wave = tid >> 6;
  const size_t tok0 = (size_t)b * SEQ_LEN + (size_t)c * RK_T;
  const float* RWW = (const float*)(p.ws + OFF_RWW); const float* RWK = (const float*)(p.ws + OFF_RWK);
  const float* RWKK = (const float*)(p.ws + OFF_RWKK); const float* RWA = (const float*)(p.ws + OFF_RWA);
  const float* RWR = p.out + (size_t)NTOK * 512; const float* RWV = p.out;
  float* sW = (float*)smem;
  float* sNK = sW + 32 * 64;
  float* sKA = sNK + 32 * 64;
  float* sR = sKA + 32 * 64;
  float* sV = sR + 32 * 64;
  __syncthreads();
  for (int w = tid; w < 32 * 16; w += NTHREADS) {
    const int t = w >> 4, c4 = (w & 15) * 4;
    const size_t o = (tok0 + t) * 512 + h * 64 + c4;
    st4(sW + t * 64 + c4, ld4(RWW + o));
    const float4 kk = ld4(RWKK + o);
    st4(sNK + t * 64 + c4, make_float4(-kk.x, -kk.y, -kk.z, -kk.w));
    st4(sKA + t * 64 + c4, ld4(RWA + o));
    st4(sR + t * 64 + c4, ld4(RWR + o));
    st4(sV + t * 64 + c4, ld4(RWV + o));
  }
  __syncthreads();
  const int wrole = (wave + ((BIDX >= (gridDim.x >> 1)) ? 2 : 0)) & 3;
  if (wrole == 0) {
    float z[64];
#pragma unroll
    for (int j = 0; j < 64; ++j) z[j] = (j == lane) ? 1.f : 0.f;
    for (int t = 0; t < RK_T; ++t) {
      float cacc = 0.f;
#pragma unroll
      for (int j4 = 0; j4 < 16; ++j4) {
        const float4 u = ld4(sNK + t * 64 + j4 * 4);
        cacc += z[j4 * 4] * u.x + z[j4 * 4 + 1] * u.y + z[j4 * 4 + 2] * u.z + z[j4 * 4 + 3] * u.w;
      }
#pragma unroll
      for (int j4 = 0; j4 < 16; ++j4) {
        const float4 w = ld4(sW + t * 64 + j4 * 4), v = ld4(sKA + t * 64 + j4 * 4);
        z[j4 * 4] = z[j4 * 4] * w.x + cacc * v.x; z[j4 * 4 + 1] = z[j4 * 4 + 1] * w.y + cacc * v.y;
        z[j4 * 4 + 2] = z[j4 * 4 + 2] * w.z + cacc * v.z; z[j4 * 4 + 3] = z[j4 * 4 + 3] * w.w + cacc * v.w;
      }
    }
    unsigned short* PT = (unsigned short*)(p.ws + OFF_RKPT) + (size_t)ch * 64 * 64;
#pragma unroll
    for (int j = 0; j < 64; ++j) st_wt_u16(PT + j * 64 + lane, f2bf(z[j]));
  } else if (wrole == 1) {
    const bool isA = lane < 32;
    const int me = lane & 31;
    float q[64];
    {
      const float* src = (isA ? RWK : RWR) + (tok0 + me) * 512 + h * 64;
#pragma unroll
      for (int j4 = 0; j4 < 16; ++j4) { const float4 v = ld4(src + j4 * 4); q[j4 * 4] = v.x; q[j4 * 4 + 1] = v.y; q[j4 * 4 + 2] = v.z; q[j4 * 4 + 3] = v.w; }
    }
    const float* Ub = isA ? sNK : sKA;
    const float* Vb = isA ? sKA : sNK;
    unsigned short* AT = (unsigned short*)(p.ws + OFF_RKAT) + (size_t)ch * 32 * 32;
    for (int u = 0; u < RK_T; ++u) {
      const int tt = isA ? u : RK_T - 1 - u;
      const bool upd = isA ? (u > me) : (tt <= me);
      if (upd) {
        float cacc = 0.f;
#pragma unroll
        for (int j4 = 0; j4 < 16; ++j4) {
          const float4 uu = ld4(Ub + tt * 64 + j4 * 4);
          cacc += q[j4 * 4] * uu.x + q[j4 * 4 + 1] * uu.y + q[j4 * 4 + 2] * uu.z + q[j4 * 4 + 3] * uu.w;
        }
#pragma unroll
        for (int j4 = 0; j4 < 16; ++j4) {
          const float4 w = ld4(sW + tt * 64 + j4 * 4), v = ld4(Vb + tt * 64 + j4 * 4);
          q[j4 * 4] = q[j4 * 4] * w.x + cacc * v.x; q[j4 * 4 + 1] = q[j4 * 4 + 1] * w.y + cacc * v.y;
          q[j4 * 4 + 2] = q[j4 * 4 + 2] * w.z + cacc * v.z; q[j4 * 4 + 3] = q[j4 * 4 + 3] * w.w + cacc * v.w;
        }
      }
      if (isA) {
        float av = 0.f;
        if (u >= me) {
#pragma unroll
          for (int j4 = 0; j4 < 16; ++j4) {
            const float4 rr = ld4(sR + u * 64 + j4 * 4);
            av += q[j4 * 4] * rr.x + q[j4 * 4 + 1] * rr.y + q[j4 * 4 + 2] * rr.z + q[j4 * 4 + 3] * rr.w;
          }
        }
        AT[u * 32 + me] = f2bf(av);
      }
    }
    if (isA) {
      unsigned short* KT = (unsigned short*)(p.ws + OFF_RKKT) + (size_t)ch * 64 * 32;
#pragma unroll
      for (int j = 0; j < 64; ++j) st_wt_u16(KT + j * 32 + me, f2bf(q[j]));
    } else {
      unsigned short* RT = (unsigned short*)(p.ws + OFF_RKRT) + ((size_t)ch * 32 + me) * 64;
#pragma unroll
      for (int j8 = 0; j8 < 8; ++j8)
        *(uint4*)(RT + j8 * 8) = make_uint4(pk2(q[j8 * 8], q[j8 * 8 + 1]), pk2(q[j8 * 8 + 2], q[j8 * 8 + 3]), pk2(q[j8 * 8 + 4], q[j8 * 8 + 5]), pk2(q[j8 * 8 + 6], q[j8 * 8 + 7]));
    }
  } else if (wrole == 2) {
    unsigned short* VT = (unsigned short*)(p.ws + OFF_RKVT) + (size_t)ch * 64 * 32;
#pragma unroll
    for (int t8 = 0; t8 < 4; ++t8) {
      float v[8];
#pragma unroll
      for (int q8 = 0; q8 < 8; ++q8) v[q8] = sV[(t8 * 8 + q8) * 64 + lane];
      st_wt_b128(VT + lane * 32 + t8 * 8, make_uint4(pk2(v[0], v[1]), pk2(v[2], v[3]), pk2(v[4], v[5]), pk2(v[6], v[7])));
    }
  }
#if RK_MERGED
  asm volatile("s_waitcnt vmcnt(0)" ::: "memory");
  __syncthreads();
  if (tid == 0) __hip_atomic_store((unsigned*)(p.ws + OFF_RKF) + ch, 1u, __ATOMIC_RELAXED, __HIP_MEMORY_SCOPE_AGENT);
#endif
}
DEV void phase_retpfx(const Params& p, char* smem);
DEV void phase_rkpre(const Params& p, char* smem) {
  phase_retpfx(p, smem);
  for (int it = BIDX; it < RK_NCHT; it += gridDim.x) rk_precompute(p, (it % (BATCH * 8)) * RK_NCH + it / (BATCH * 8), smem);
}

DEV bf16x8 ld_frag2(const unsigned short* p0, const unsigned short* p1) {
  const uint2 lo = *(const uint2*)p0, hi = *(const uint2*)p1;
  union { uint4 u; bf16x8 v; } x;
  x.u = make_uint4(lo.x, lo.y, hi.x, hi.y);
  return x.v;
}
DEV bf16x8 ld_frag(const unsigned short* p0) {
  union { uint4 u; bf16x8 v; } x;
  x.u = *(const uint4*)p0;
  return x.v;
}
DEV unsigned rk_flag_ld(const unsigned* f) {
#if RK_MERGED
  return __hip_atomic_load(f, __ATOMIC_RELAXED, __HIP_MEMORY_SCOPE_AGENT);
#else
  return 1u;
#endif
}
DEV void rk_flag_wait(const unsigned* f, unsigned flv) {
#if RK_MERGED
  asm volatile("" : "+v"(flv));
  unsigned fl = (unsigned)__builtin_amdgcn_readfirstlane((int)flv);
  unsigned sp = 0;
  while (fl == 0u) {
    __builtin_amdgcn_s_sleep(1);
    fl = (unsigned)__builtin_amdgcn_readfirstlane((int)__hip_atomic_load(f, __ATOMIC_RELAXED, __HIP_MEMORY_SCOPE_AGENT));
    if (++sp > (1u << 21)) break;
  }
  asm volatile("buffer_inv sc1" ::: "memory");
#endif
}
#define RK_PREFETCH(S, c_)                                                                                                      \
  {                                                                                                                             \
    const size_t chp_ = (size_t)bh * RK_NCH + (c_);                                                                             \
    _Pragma("unroll") for (int jt = 0; jt < 2; ++jt) _Pragma("unroll") for (int kb = 0; kb < 2; ++kb)                          \
        _Pragma("unroll") for (int s_ = 0; s_ < 2; ++s_) {                                                                      \
      const unsigned short* q0 = PTb + (chp_ * 64 + jt * 32 + r) * 64 + kb * 32 + 16 * s_ + 4 * hh;                             \
      pa##S[jt][kb][s_] = ld_frag2(q0, q0 + 8);                                                                                 \
    }                                                                                                                           \
    _Pragma("unroll") for (int jt = 0; jt < 2; ++jt) _Pragma("unroll") for (int ks = 0; ks < 2; ++ks)                          \
        ka##S[jt][ks] = ld_frag(KTb + (chp_ * 64 + jt * 32 + r) * 32 + 16 * ks + 8 * hh);                                       \
    _Pragma("unroll") for (int ks = 0; ks < 2; ++ks) vb##S[ks] = ld_frag(VTb + (chp_ * 64 + it * 32 + r) * 32 + 16 * ks + 8 * hh); \
  }
#define RK_STEP(S, c_)                                                                                                          \
  {                                                                                                                             \
    unsigned short* scr_ = rksc_row(p.ws, bh >> 3, bh & 7, (c_), it * 32 + r);                                                  \
    _Pragma("unroll") for (int kb = 0; kb < 2; ++kb) _Pragma("unroll") for (int g4 = 0; g4 < 4; ++g4)                          \
        *(uint2*)(scr_ + kb * 32 + 8 * g4 + 4 * hh) =                                                                           \
            make_uint2(pk2(X[kb][4 * g4], X[kb][4 * g4 + 1]), pk2(X[kb][4 * g4 + 2], X[kb][4 * g4 + 3]));                       \
    bf16x8 bh_[2][2], bl_[2][2];                                                                                                \
    _Pragma("unroll") for (int kb = 0; kb < 2; ++kb) _Pragma("unroll") for (int s_ = 0; s_ < 2; ++s_) {                        \
      union { uint4 u; bf16x8 v; } hi, lo;                                                                                      \
      unsigned hw[4], lw[4];                                                                                                    \
      _Pragma("unroll") for (int q2 = 0; q2 < 4; ++q2) {                                                                        \
        const float x0 = X[kb][8 * s_ + 2 * q2], x1 = X[kb][8 * s_ + 2 * q2 + 1];                                               \
        const unsigned hp = pk2(x0, x1);                                                                                        \
        hw[q2] = hp;                                                                                                            \
        lw[q2] = pk2(x0 - bf2f((unsigned short)(hp & 0xFFFF)), x1 - bf2f((unsigned short)(hp >> 16)));                          \
      }                                                                                                                         \
      hi.u = make_uint4(hw[0], hw[1], hw[2], hw[3]); lo.u = make_uint4(lw[0], lw[1], lw[2], lw[3]);                             \
      bh_[kb][s_] = hi.v; bl_[kb][s_] = lo.v;                                                                                   \
    }                                                                                                                           \
    f32x16 acc[2];                                                                                                              \
    _Pragma("unroll") for (int jt = 0; jt < 2; ++jt) {                                                                          \
      _Pragma("unroll") for (int i = 0; i < 16; ++i) acc[jt][i] = 0.f;                                                          \
      _Pragma("unroll") for (int kb = 0; kb < 2; ++kb) _Pragma("unroll") for (int s_ = 0; s_ < 2; ++s_) {                      \
        acc[jt] = __builtin_amdgcn_mfma_f32_32x32x16_bf16(pa##S[jt][kb][s_], bh_[kb][s_], acc[jt], 0, 0, 0);                    \
        acc[jt] = __builtin_amdgcn_mfma_f32_32x32x16_bf16(pa##S[jt][kb][s_], bl_[kb][s_], acc[jt], 0, 0, 0);                    \
      }                                                                                                                         \
      _Pragma("unroll") for (int ks = 0; ks < 2; ++ks)                                                                          \
          acc[jt] = __builtin_amdgcn_mfma_f32_32x32x16_bf16(ka##S[jt][ks], vb##S[ks], acc[jt], 0, 0, 0);                        \
    }                                                                                                                           \
    if ((c_) + 2 < RK_NCH) {                                                                                                    \
      rk_flag_wait(RKFb + (c_) + 2, fl##S);                                                                                     \
      fl##S = rk_flag_ld(RKFb + ((c_) + 4 < RK_NCH ? (c_) + 4 : RK_NCH - 1));          \
      RK_PREFETCH(S, (c_) + 2);                                                                                                 \
    }                                                                                                                           \
    X[0] = acc[0]; X[1] = acc[1];                                                                                               \
  }
DEV void rk_chain(const Params& p, int bh) {
  const int tid = TIDX, lane = tid & 63, wave = tid >> 6;
  if (wave >= 2) return;
  const int r = lane & 31, hh = lane >> 5, it = wave;
  const unsigned short* PTb = (const unsigned short*)(p.ws + OFF_RKPT);
  const unsigned short* KTb = (const unsigned short*)(p.ws + OFF_RKKT);
  const unsigned short* VTb = (const unsigned short*)(p.ws + OFF_RKVT);
  const unsigned* RKFb = (const unsigned*)(p.ws + OFF_RKF) + (size_t)bh * RK_NCH;
  f32x16 X[2];
#pragma unroll
  for (int kb = 0; kb < 2; ++kb)
#pragma unroll
    for (int i = 0; i < 16; ++i) X[kb][i] = 0.f;
  bf16x8 paA[2][2][2], kaA[2][2], vbA[2], paB[2][2][2], kaB[2][2], vbB[2];
  rk_flag_wait(RKFb, rk_flag_ld(RKFb));
  RK_PREFETCH(A, 0);
  rk_flag_wait(RKFb + 1, rk_flag_ld(RKFb + 1));
  RK_PREFETCH(B, 1);
  unsigned flA = rk_flag_ld(RKFb + 2), flB = rk_flag_ld(RKFb + 3);
  for (int c = 0; c < RK_NCH; c += 2) {
    RK_STEP(A, c);
    if (c + 1 < RK_NCH) RK_STEP(B, c + 1);
  }
}
DEV void rk_output(const Params& p, int item) {
  const int tid = TIDX, lane = tid & 63, wave = tid >> 6;
  const int ch = item * 4 + wave;
  const int c = ch % RK_NCH, bhh = ch / RK_NCH, h = bhh & 7, b = bhh >> 3;
  const int r = lane & 31, hh = lane >> 5;
  const unsigned short* RT = (const unsigned short*)(p.ws + OFF_RKRT) + (size_t)ch * 32 * 64;
  const unsigned short* AT = (const unsigned short*)(p.ws + OFF_RKAT) + (size_t)ch * 32 * 32;
  const unsigned short* VT = (const unsigned short*)(p.ws + OFF_RKVT) + (size_t)ch * 64 * 32;
  f32x16 acc[2];
#pragma unroll
  for (int i2 = 0; i2 < 2; ++i2)
#pragma unroll
    for (int i = 0; i < 16; ++i) acc[i2][i] = 0.f;
#pragma unroll
  for (int ks = 0; ks < 4; ++ks) {
    const bf16x8 a = ld_frag(RT + r * 64 + 16 * ks + 8 * hh);
#pragma unroll
    for (int i2 = 0; i2 < 2; ++i2) acc[i2] = __builtin_amdgcn_mfma_f32_32x32x16_bf16(a, ld_frag(rksc_row(p.ws, b, h, c, i2 * 32 + r) + 16 * ks + 8 * hh), acc[i2], 0, 0, 0);
  }
#pragma unroll
  for (int ks = 0; ks < 2; ++ks) {
    const bf16x8 a = ld_frag(AT + r * 32 + 16 * ks + 8 * hh);
#pragma unroll
    for (int i2 = 0; i2 < 2; ++i2) acc[i2] = __builtin_amdgcn_mfma_f32_32x32x16_bf16(a, ld_frag(VT + (i2 * 32 + r) * 32 + 16 * ks + 8 * hh), acc[i2], 0, 0, 0);
  }
  float* Yo = (float*)(p.ws + OFF_MIX);
  const size_t tok0 = (size_t)b * SEQ_LEN + (size_t)c * RK_T;
#pragma unroll
  for (int i2 = 0; i2 < 2; ++i2)
#pragma unroll
    for (int i = 0; i < 16; ++i) {
      const int t = (i & 3) + 8 * (i >> 2) + 4 * hh;
      Yo[(tok0 + t) * 1024 + h * 64 + i2 * 32 + r] = acc[i2][i];
    }
}
#define OFF_RWG OFF_RWKK
DEV void phase_rkout(const Params& p, char* smem) {
  {
    const float* GLO = (const float*)(p.ws + OFF_GLO);
    const float* g_up = p.in[I_RW_G_UP];
    float* G = (float*)(p.ws + OFF_RWG);
    for (int t = BIDX; t < (NTOK / GEMM_BM) * 4; t += gridDim.x) {
      const int m0 = (t >> 2) * GEMM_BM, n0 = (t & 3) * 128;
      gemm_tile<false>(
          [&](int r) { return (const void*)(GLO + (size_t)(m0 + r) * 128); },
          [&](int c) { return g_up + n0 + c; }, 512, 128,
          [&](int row, int col, float v0, float v1) {
            const size_t o = (size_t)(m0 + row) * 512 + n0 + col;
            G[o] = v0; G[o + 32] = v1;
          },
          smem);
    }
  }
  for (int it = BIDX; it < RK_NCHT / 4; it += gridDim.x) rk_output(p, it);
}

#define P12_SCAN_ITEMS (BATCH * 8 * 4)
#define P12_RET_ITEMS (BATCH * 4 * RET_NC)
#define P12_SCAN_SMEM ((2 * (16 * 5 * 64 + 16 * 16) + 16 * 16) * 4)
#define P12_RET_SMEM ((64 * 72 + 2 * 64 * 68) * 2)
#define P12_SMEM (P12_SCAN_SMEM > P12_RET_SMEM ? P12_SCAN_SMEM : P12_RET_SMEM)
DEV float sum16(float v) {
#ifdef CPU_EMU
  return emu_sum16(v);
#else
  int x;
  x = __builtin_amdgcn_update_dpp(0, __builtin_bit_cast(int, v), 0xB1, 0xF, 0xF, false); v += __builtin_bit_cast(float, x);
  x = __builtin_amdgcn_update_dpp(0, __builtin_bit_cast(int, v), 0x4E, 0xF, 0xF, false); v += __builtin_bit_cast(float, x);
  x = __builtin_amdgcn_update_dpp(0, __builtin_bit_cast(int, v), 0x141, 0xF, 0xF, false); v += __builtin_bit_cast(float, x);
  x = __builtin_amdgcn_update_dpp(0, __builtin_bit_cast(int, v), 0x140, 0xF, 0xF, false); v += __builtin_bit_cast(float, x);
  return v;
#endif
}
DEV void p12_scan(const Params& p, int item, char* smem) {
  const int rq = item & 3, h = (item >> 2) & 7, b = item >> 5;
  const int tid = TIDX, rl = tid >> 4, cg = tid & 15;
  const float* ARR[5] = {(const float*)(p.ws + OFF_RWW), (const float*)(p.ws + OFF_RWK), (const float*)(p.ws + OFF_RWKK),
                         (const float*)(p.ws + OFF_RWA), p.out + (size_t)NTOK * 512};
  const float* RWV = p.out;
  float* Yo = (float*)(p.ws + OFF_MIX);
  float* buf = (float*)smem;
  float* vbuf = buf + 2 * 16 * 5 * 64;
  float* ybuf = vbuf + 2 * 16 * 16;
  float S[4] = {0.f, 0.f, 0.f, 0.f};
  float4 rg[5]; float rv;
  const int lstep = tid >> 4, lc4 = tid & 15;
  auto gload = [&](int c) {
    const size_t o = ((size_t)b * SEQ_LEN + c * 16 + lstep) * 512 + h * 64;
#pragma unroll
    for (int a = 0; a < 5; ++a) rg[a] = ld4(ARR[a] + o + lc4 * 4);
    rv = RWV[o + rq * 16 + lc4];
  };
  auto sstore = [&](int bi) {
#pragma unroll
    for (int a = 0; a < 5; ++a) st4(buf + ((bi * 16 + lstep) * 5 + a) * 64 + lc4 * 4, rg[a]);
    vbuf[(bi * 16 + lstep) * 16 + lc4] = rv;
  };
  __syncthreads();
  gload(0);
  sstore(0);
  __syncthreads();
  const int NCH = SEQ_LEN / 16;
  for (int c = 0; c < NCH; ++c) {
    if (c + 1 < NCH) gload(c + 1);
    const float* cb = buf + (c & 1) * 16 * 5 * 64;
    const float* cv = vbuf + (c & 1) * 16 * 16;
    float4 cw = ld4(cb + 0 * 64 + cg * 4), ck = ld4(cb + 1 * 64 + cg * 4), ckk = ld4(cb + 2 * 64 + cg * 4),
           cka = ld4(cb + 3 * 64 + cg * 4), cr = ld4(cb + 4 * 64 + cg * 4);
    float cvv = cv[rl];
#pragma unroll
    for (int s = 0; s < 16; ++s) {
      const float4 w = cw, k = ck, kk = ckk, ka = cka, r = cr;
      const float v = cvv;
      if (s < 15) {
        cw = ld4(cb + ((s + 1) * 5 + 0) * 64 + cg * 4); ck = ld4(cb + ((s + 1) * 5 + 1) * 64 + cg * 4);
        ckk = ld4(cb + ((s + 1) * 5 + 2) * 64 + cg * 4); cka = ld4(cb + ((s + 1) * 5 + 3) * 64 + cg * 4);
        cr = ld4(cb + ((s + 1) * 5 + 4) * 64 + cg * 4); cvv = cv[(s + 1) * 16 + rl];
      }
      float sa = (S[0] * kk.x + S[1] * kk.y) + (S[2] * kk.z + S[3] * kk.w);
      sa = -sum16(sa);
      S[0] = S[0] * w.x + (sa * ka.x + v * k.x);
      S[1] = S[1] * w.y + (sa * ka.y + v * k.y);
      S[2] = S[2] * w.z + (sa * ka.z + v * k.z);
      S[3] = S[3] * w.w + (sa * ka.w + v * k.w);
      float y = (S[0] * r.x + S[1] * r.y) + (S[2] * r.z + S[3] * r.w);
      y = sum16(y);
      if (cg == 0) ybuf[s * 16 + rl] = y;
      asm volatile("" ::: "memory");
    }
    __syncthreads();
    if (c + 1 < NCH) sstore((c + 1) & 1);
    Yo[((size_t)b * SEQ_LEN + c * 16 + lstep) * 1024 + h * 64 + rq * 16 + lc4] = ybuf[lstep * 16 + lc4];
    __syncthreads();
  }
}
struct RetSmem { unsigned short k[64][72]; unsigned short vt[2][64][68]; };
#define RETPFX_ITEMS (BATCH * 4 * 64 * 128 / NTHREADS)
DEV void ret_prefix(const Params& p, int item) {
  const int gi = item * NTHREADS + TIDX;
  const int bh4 = gi >> 13, idx = gi & 8191;
  const float G = exp2f(128.f * ret_log2gamma(bh4 & 3));
  float* KV = (float*)(p.ws + OFF_RETKV) + (size_t)bh4 * RET_NC * 8192 + idx;
  float st = 0.f;
  int c = 0;
  for (; c + 8 <= RET_NC; c += 8) {
    float e[8];
#pragma unroll
    for (int q = 0; q < 8; ++q) e[q] = KV[(size_t)(c + q) * 8192];
#pragma unroll
    for (int q = 0; q < 8; ++q) { KV[(size_t)(c + q) * 8192] = st; st = st * G + e[q]; }
  }
  for (; c < RET_NC; ++c) { const float e = KV[(size_t)c * 8192]; KV[(size_t)c * 8192] = st; st = st * G + e; }
}
DEV void phase_retpfx(const Params& p, char* smem) {
  for (int it = BIDX; it < RETPFX_ITEMS; it += gridDim.x) ret_prefix(p, it);
}
DEV void p12_ret(const Params& p, int item, char* smem) {
  RetSmem* sm = (RetSmem*)smem;
  const int c = item % RET_NC, h = (item / RET_NC) & 3, b = item / (RET_NC * 4);
  const int tid = TIDX, lane = tid & 63, wave = tid >> 6;
  const int cidx = lane & 31, hh = lane >> 5;
  const int qi = wave * 32 + cidx;
  const float* H2 = (const float*)(p.ws + OFF_H2);
  const float lg = ret_log2gamma(h);
  const size_t tok0 = (size_t)b * SEQ_LEN + c * 128;
  bf16x8 qf[4], qfs[4];
  {
    const float* qr = H2 + (tok0 + qi) * 1536 + h * 64;
    const float qs = exp2f((float)(qi + 1) * lg);
#pragma unroll
    for (int ks = 0; ks < 4; ++ks) {
      const float4 a0 = ld4(qr + ks * 16 + hh * 8), a1 = ld4(qr + ks * 16 + hh * 8 + 4);
      const float v[8] = {a0.x, a0.y, a0.z, a0.w, a1.x, a1.y, a1.z, a1.w};
#pragma unroll
      for (int j = 0; j < 8; ++j) { qf[ks][j] = (short)f2bf(v[j]); qfs[ks][j] = (short)f2bf(v[j] * qs); }
    }
  }
  f32x16 o[4], s[2];
#pragma unroll
  for (int mt = 0; mt < 4; ++mt)
#pragma unroll
    for (int i = 0; i < 16; ++i) o[mt][i] = 0.f;
  {
    const float* KV0 = (const float*)(p.ws + OFF_RETKV) + (size_t)((b * 4 + h) * RET_NC) * 64 * 128;
#pragma unroll
    for (int eh = 0; eh < 2; ++eh) {
      __syncthreads();
      {
        const int el = tid & 63, d0 = tid >> 6;
        float stv[16];
#pragma unroll
        for (int i = 0; i < 16; ++i) stv[i] = KV0[(size_t)c * 64 * 128 + (d0 + 4 * i) * 128 + eh * 64 + el];
#pragma unroll
        for (int i = 0; i < 16; ++i) sm->k[el][d0 + 4 * i] = f2bf(stv[i]);
      }
      __syncthreads();
      qk_tile(sm->k, qfs, s, lane);
#pragma unroll
      for (int i = 0; i < 16; ++i) { o[eh * 2][i] += s[0][i]; o[eh * 2 + 1][i] += s[1][i]; }
    }
  }
#pragma unroll 1
  for (int kt = 0; kt < 2; ++kt) {
    __syncthreads();
    {
      const int row = tid >> 2, seg = tid & 3;
      const float* kr = H2 + (tok0 + kt * 64 + row) * 1536 + 256 + h * 64 + seg * 16;
      const float4 a0 = ld4(kr), a1 = ld4(kr + 4), a2 = ld4(kr + 8), a3 = ld4(kr + 12);
      *(uint4*)&sm->k[row][seg * 16] = make_uint4(pk2(a0.x, a0.y), pk2(a0.z, a0.w), pk2(a1.x, a1.y), pk2(a1.z, a1.w));
      *(uint4*)&sm->k[row][seg * 16 + 8] = make_uint4(pk2(a2.x, a2.y), pk2(a2.z, a2.w), pk2(a3.x, a3.y), pk2(a3.z, a3.w));
#pragma unroll
      for (int q = 0; q < 8; ++q) {
        const int f = tid + 256 * q;
        const int key = f >> 5, d4 = (f & 31) * 4;
        const float4 v = ld4(H2 + (tok0 + kt * 64 + key) * 1536 + 512 + h * 128 + d4);
        unsigned short(*vt)[68] = sm->vt[d4 >> 6];
        const int dl = d4 & 63;
        vt[dl][key] = f2bf(v.x); vt[dl + 1][key] = f2bf(v.y); vt[dl + 2][key] = f2bf(v.z); vt[dl + 3][key] = f2bf(v.w);
      }
    }
    __syncthreads();
    if (kt * 64 <= wave * 32 + 31) {
      qk_tile(sm->k, qf, s, lane);
#pragma unroll
      for (int ks2 = 0; ks2 < 2; ++ks2)
#pragma unroll
        for (int i = 0; i < 16; ++i) {
          const int kj = kt * 64 + ks2 * 32 + (i & 3) + 8 * (i >> 2) + 4 * hh;
          s[ks2][i] = kj <= qi ? s[ks2][i] * exp2f((float)(qi - kj) * lg) : 0.f;
        }
      pv_tile(sm->vt[0], s, *(f32x16(*)[2])&o[0], lane);
      pv_tile(sm->vt[1], s, *(f32x16(*)[2])&o[2], lane);
    }
  }
  float s1 = 0.f;
#pragma unroll
  for (int mt = 0; mt < 4; ++mt)
#pragma unroll
    for (int i = 0; i < 16; ++i) s1 += o[mt][i];
  s1 += __shfl_xor(s1, 32);
  const float mu = s1 * (1.f / 128.f);
  float s2 = 0.f;
#pragma unroll
  for (int mt = 0; mt < 4; ++mt)
#pragma unroll
    for (int i = 0; i < 16; ++i) { const float d = o[mt][i] - mu; s2 += d * d; }
  s2 += __shfl_xor(s2, 32);
  const float rstd = rsqrtf(s2 * (1.f / 128.f) + 1e-5f);
  float* MIX = (float*)(p.ws + OFF_MIX);
  const float* gate = H2 + (tok0 + qi) * 1536 + 1024 + h * 128;
  float* dst = MIX + (tok0 + qi) * 1024 + 512 + h * 128;
  const float* lgam = p.in[I_RET_LN_G] + h * 128;
  const float* lbet = p.in[I_RET_LN_B] + h * 128;
#pragma unroll
  for (int mt = 0; mt < 4; ++mt)
#pragma unroll
    for (int g4 = 0; g4 < 4; ++g4) {
      const int dv = mt * 32 + 8 * g4 + 4 * hh;
      const float4 gv = ld4(lgam + dv), bv = ld4(lbet + dv), gt = ld4(gate + dv);
      float4 ov;
      ov.x = siluf_(gt.x) * ((o[mt][4 * g4] - mu) * rstd * gv.x + bv.x);
      ov.y = siluf_(gt.y) * ((o[mt][4 * g4 + 1] - mu) * rstd * gv.y + bv.y);
      ov.z = siluf_(gt.z) * ((o[mt][4 * g4 + 2] - mu) * rstd * gv.z + bv.z);
      ov.w = siluf_(gt.w) * ((o[mt][4 * g4 + 3] - mu) * rstd * gv.w + bv.w);
      st4(dst + dv, ov);
    }
}
DEV void phase_p12(const Params& p, char* smem) {
  const int G = gridDim.x;
  const int bid = BIDX;
  if (bid < BATCH * 8 && G > BATCH * 8) {
    rk_chain(p, bid);
  } else if (G >= 8 * BATCH * 8) {
    const int Gh = G >> 1, NC = BATCH * 8;
    if (bid >= Gh && bid < Gh + NC) return;
    const int w = bid - NC - (bid >= Gh ? NC : 0);
#if RK_MERGED
    if ((G & 15) == 0 && BATCH * 8 == 16) {
      const int x = bid & 7, m = bid >> 3;
      const int rank = m - 2 - (m >= (Gh >> 3) ? 2 : 0), nprod = (G >> 3) - 4;
      for (int k = rank; k < 2 * RK_NCH; k += nprod) rk_precompute(p, (x + 8 * (k & 1)) * RK_NCH + (k >> 1), smem);
    } else {
      for (int it = w; it < RK_NCHT; it += G - 2 * NC) rk_precompute(p, (it % NC) * RK_NCH + it / NC, smem);
    }
#endif
    for (int it = w; it < P12_RET_ITEMS; it += G - 2 * NC) p12_ret(p, it, smem);
  } else if (G > BATCH * 8) {
    for (int it = bid - BATCH * 8; it < P12_RET_ITEMS; it += G - BATCH * 8) p12_ret(p, it, smem);
  } else {
    for (int it = bid; it < BATCH * 8 + P12_RET_ITEMS; it += G) {
      if (it < BATCH * 8) rk_chain(p, it);
      else p12_ret(p, it - BATCH * 8, smem);
    }
  }
}

#define P13_SMEM (RWP_T * 128 * 4)
DEV void phase_p13(const Params& p, char* smem) {
  const int tid = TIDX;
  const float* Hc = (const float*)(p.ws + OFF_H);
  const float* mu = p.in[I_RW_MU];
  const float* GLO = (const float*)(p.ws + OFF_GLO);
  float* sl = (float*)smem;
  float* MIX = (float*)(p.ws + OFF_MIX);
  const float* RWK = (const float*)(p.ws + OFF_RWK); const float* RWR = p.out + (size_t)NTOK * 512; const float* RWV = p.out;
  const float* G = (const float*)(p.ws + OFF_RWG);
  for (int it = BIDX; it < NTOK / RWP_T; it += gridDim.x) {
#pragma unroll
    for (int cc = 0; cc < 2; ++cc) {
      const int c = tid + 256 * cc;
      const float lng = p.in[I_RW_LN_G][c], lnb = p.in[I_RW_LN_B][c], rk = p.in[I_RW_R_K][c];
#pragma unroll 4
      for (int tt = 0; tt < RWP_T; ++tt) {
        const size_t tok = (size_t)it * RWP_T + tt;
        const float y = MIX[tok * 1024 + c];
        const float m = wave_sum(y) * (1.f / 64.f);
        const float d = y - m;
        const float var = wave_sum(d * d) * (1.f / 64.f);
        const float yn = d * rsqrtf(var + 64e-5f) * lng + lnb;
        const float r = RWR[tok * 512 + c], k = RWK[tok * 512 + c], v = RWV[tok * 512 + c];
        const float bonus = wave_sum(r * k * rk) * v;
        MIX[tok * 1024 + c] = (yn + bonus) * G[tok * 512 + c];
      }
    }
  }
}

#define NPHASES 20
#define SMEM_BYTES 53248
DEV void run_phase(const Params& p, int ph, char* smem) {
  switch (ph) {
    case 0: phase_gemm_in<0>(p, smem); break;
    case 1: phase_p1(p, smem); break;
    case 2: phase_p2(p, smem); break;
    case 3: phase_glu(p, smem); break;
    case 4: phase_outproj<0>(p, smem); break;
    case 5: phase_ln_router<0>(p, smem); break;
    case 6: phase_lists_shup<0>(p, smem); break;
    case 7: phase_routed_up<0>(p, smem); break;
    case 8: phase_down<0>(p, smem); break;
    case 9: phase_combine<0>(p, smem); break;
    case 10: phase_gemm_in<1>(p, smem); break;
    case 11: phase_p11(p, smem); break;
    case 12: phase_p12(p, smem); break;
    case 13: phase_p13(p, smem); break;
    case 14: phase_outproj<1>(p, smem); break;
    case 15: phase_ln_router<1>(p, smem); break;
    case 16: phase_lists_shup<1>(p, smem); break;
    case 17: phase_routed_up<1>(p, smem); break;
    case 18: phase_down<1>(p, smem); break;
    case 19: phase_combine<1>(p, smem); break;
    case 20: phase_p1b(p, smem); break;
    case 21: phase_rkpre(p, smem); break;
    case 22: phase_rkout(p, smem); break;
    case 24: phase_retpfx(p, smem); break;
  }
}
static_assert(P1_SMEM <= SMEM_BYTES, "smem");
static_assert(P1_PREP_SMEM <= SMEM_BYTES, "smem");
static_assert(P2_SMEM <= SMEM_BYTES, "smem");
static_assert(P5_SMEM <= SMEM_BYTES, "smem");
static_assert(P7_SMEM <= SMEM_BYTES, "smem");
static_assert(P12_SMEM <= SMEM_BYTES, "smem");
static_assert(RKPRE_SMEM <= SMEM_BYTES, "smem");
static_assert(OFF_HS + (size_t)NTOK * 256 * 2 <= OFF_X1, "layout");

#ifndef CPU_EMU
template <int PH>
__global__ void __launch_bounds__(NTHREADS) phase_kernel(Params p) {
  __shared__ __attribute__((aligned(16))) char smem[SMEM_BYTES];
  run_phase(p, PH, smem);
}
template <int PH>
static void launch_phases(const Params& p, hipStream_t stream) {
  phase_kernel<PH><<<dim3(1024), dim3(NTHREADS), 0, stream>>>(p);
  if constexpr (PH + 1 < NPHASES) launch_phases<PH + 1>(p, stream);
}
#if MEGA
#define XB_TMO      128
#define XB_XCNT(j)  (256  + 64 * (j))
#define XB_XSUB(j)  (1280 + 64 * (j))
#define XB_XGEN(j)  (2304 + 64 * (j))
#define XB_TOP      3328
#define XB_TOPGEN   3392
#define XCD_BAR_WORDS 3456
#define XB_SPIN_CAP (1u << 18)
#define LAS __attribute__((address_space(3)))

__device__ __forceinline__ unsigned xb_ld(unsigned* p)              { return __hip_atomic_load(p, __ATOMIC_RELAXED, __HIP_MEMORY_SCOPE_AGENT); }
__device__ __forceinline__ unsigned xb_add(unsigned* p, unsigned v) { return __hip_atomic_fetch_add(p, v, __ATOMIC_RELAXED, __HIP_MEMORY_SCOPE_AGENT); }
__device__ __forceinline__ unsigned xb_xcc_id() { return (unsigned)__builtin_amdgcn_s_getreg((3 << 11) | 20) & 0xFu; }
#define XB_SPIN(cond, bar) do { unsigned _sp = 0; while (cond) { __builtin_amdgcn_s_sleep(1); \
    if ((++_sp & 255u) == 0u) { if (xb_ld(&(bar)[XB_TMO])) break; if (_sp > XB_SPIN_CAP) { atomicAdd(&(bar)[XB_TMO], 1u); break; } } } } while (0)

struct XcdBarrier {
    unsigned* bar; unsigned x;
    volatile LAS unsigned* st;
};

__device__ __forceinline__ XcdBarrier xcd_barrier_post(unsigned* bar, volatile LAS unsigned* st) {
    XcdBarrier b; b.bar = bar; b.x = xb_xcc_id(); b.st = st;
    if (threadIdx.x == 0) (void)xb_add(&bar[XB_XCNT(b.x)], 1u);
    return b;
}
__device__ __forceinline__ void xcd_barrier_complete(unsigned* bar, unsigned x, unsigned& nloc, unsigned& nx) {
    const unsigned G = gridDim.x * gridDim.y * gridDim.z;
    unsigned sum, cnt, mine, sp = 0u;
    for (;;) {
        sum = 0u; cnt = 0u; mine = 0u;
#pragma unroll
        for (unsigned j = 0; j < 16; ++j) { const unsigned c = xb_ld(&bar[XB_XCNT(j)]); sum += c; cnt += (c > 0u) ? 1u : 0u; mine = (j == x) ? c : mine; }
        if (sum == G) break;
        __builtin_amdgcn_s_sleep(1);
        if ((++sp & 255u) == 0u) { if (xb_ld(&bar[XB_TMO])) break; if (sp > XB_SPIN_CAP) { atomicAdd(&bar[XB_TMO], 1u); break; } }
    }
    nloc = mine > 0u ? mine : 1u; nx = cnt > 0u ? cnt : 1u;
}

__device__ __forceinline__ void xcd_barrier(const XcdBarrier& b) {
    asm volatile("s_waitcnt vmcnt(0)" ::: "memory");
    __syncthreads();
    if (threadIdx.x == 0) {
        unsigned* bar = b.bar;
        __builtin_amdgcn_s_waitcnt(0);
        unsigned nloc = b.st[0], nx = b.st[1];
        if (nloc == 0u) { xcd_barrier_complete(bar, b.x, nloc, nx); b.st[0] = nloc; b.st[1] = nx; }
        const unsigned old = xb_add(&bar[XB_XSUB(b.x)], 1u);
        const unsigned gen = old / nloc;
        if (old + 1u == (gen + 1u) * nloc) {
            __builtin_amdgcn_fence(__ATOMIC_RELEASE, "agent");
            asm volatile("s_waitcnt vmcnt(0)" ::: "memory");
            const unsigned og = xb_add(&bar[XB_TOP], 1u);
            const unsigned tg = og / nx;
            if (og + 1u == (tg + 1u) * nx) xb_add(&bar[XB_TOPGEN], 1u);
            else XB_SPIN(xb_ld(&bar[XB_TOPGEN]) == tg, bar);
            __builtin_amdgcn_fence(__ATOMIC_ACQUIRE, "agent");
            xb_add(&bar[XB_XGEN(b.x)], 1u);
            asm volatile("s_waitcnt vmcnt(0)" ::: "memory");
        } else {
            XB_SPIN(xb_ld(&bar[XB_XGEN(b.x)]) == gen, bar);
            __builtin_amdgcn_fence(__ATOMIC_ACQUIRE, "agent");
            asm volatile("s_waitcnt vmcnt(0)" ::: "memory");
        }
    }
    __syncthreads();
}


__global__ void __launch_bounds__(NTHREADS, 2) mega_kernel(Params p) {
  __shared__ __attribute__((aligned(16))) char smem[SMEM_BYTES];
  unsigned* bar = (unsigned*)(p.ws + OFF_BAR);
  __shared__ uint4 xb_words;
  if (threadIdx.x == 0) xb_words = make_uint4(0u, 0u, 0u, 0u);
  __syncthreads();
  XcdBarrier xb = xcd_barrier_post(bar, (volatile LAS unsigned*)&xb_words);
  if (p.ws == nullptr) cg::this_grid().sync();
  typedef const __attribute__((address_space(4))) Params* KParams;
#define PH_(n) { KParams kp = (KParams)__builtin_amdgcn_kernarg_segment_ptr(); asm volatile("" : "+s"(kp)); const Params lp = *(const Params*)kp; run_phase(lp, n, smem); } xcd_barrier(xb);
  PH_(0) PH_(1) PH_(20) PH_(2) PH_(3) PH_(4) PH_(5) PH_(6) PH_(7) PH_(8) PH_(9)
  PH_(10) PH_(11) PH_(24) PH_(12) PH_(22) PH_(13) PH_(14) PH_(15) PH_(16) PH_(17) PH_(18)
  { KParams kp = (KParams)__builtin_amdgcn_kernarg_segment_ptr(); asm volatile("" : "+s"(kp)); const Params lp = *(const Params*)kp; run_phase(lp, 19, smem); }
}

#endif

extern "C" void kernel_launch(void* const* d_in, const int* in_sizes, int n_in, void* d_out, int out_size, void* d_ws, size_t ws_size,
                              hipStream_t stream) {
  Params p;
  for (int i = 0; i < N_INPUTS; ++i) p.in[i] = (const float*)d_in[i];
  p.out = (float*)d_out;
  p.ws = (char*)d_ws;
#if MEGA
  static int grid_blocks = 0;
  if (!grid_blocks) {
    int dev = 0, cus = 0, per_cu = 0;
    hipGetDevice(&dev);
    hipDeviceGetAttribute(&cus, hipDeviceAttributeMultiprocessorCount, dev);
    hipOccupancyMaxActiveBlocksPerMultiprocessor(&per_cu, mega_kernel, NTHREADS, 0);
    if (per_cu > 2) per_cu = 2;
    grid_blocks = cus * per_cu;
  }
  hipMemsetAsync((char*)d_ws + OFF_BAR, 0, 16384, stream);
  void* args[] = {&p};
  hipError_t e = hipLaunchCooperativeKernel((void*)mega_kernel, dim3(grid_blocks), dim3(NTHREADS), args, 0, stream);
  if (e != hipSuccess) fprintf(stderr, "cooperative launch failed: %s (grid %d)\n", hipGetErrorString(e), grid_blocks);
#else
  launch_phases<0>(p, stream);
#endif
}
#endif
```

```cpp
#ifdef CPU_EMU
#include "emu.h"
#else
#include <hip/hip_runtime.h>
#include <hip/hip_cooperative_groups.h>
#include <cstdio>
namespace cg = cooperative_groups;
#endif
#include <stdint.h>

#ifndef BATCH
#define BATCH 2
#endif
#ifndef SEQ_LEN
#define SEQ_LEN 8192
#endif
#ifndef MEGA
#define MEGA 1
#endif
#if MEGA && !defined(CPU_EMU)
#define RK_MERGED 1
#else
#define RK_MERGED 0
#endif

#define DEV __device__ __forceinline__
#ifdef CPU_EMU
#define TIDX ((int)threadIdx.x)
#define BIDX ((int)blockIdx.x)
#else
__device__ __forceinline__ int tidx_() { int t = __builtin_amdgcn_workitem_id_x(); asm volatile("" : "+v"(t)); return t; }
__device__ __forceinline__ int bidx_() { int b = __builtin_amdgcn_workgroup_id_x(); asm volatile("" : "+s"(b)); return b; }
#define TIDX tidx_()
#define BIDX bidx_()
#endif
#define NTOK (BATCH * SEQ_LEN)
#define DM 1024
#define AB_IN 1816
#define AB_LD 1824
#define CD_IN 3328
#define NCMP ((SEQ_LEN - 32) / 16 + 1)
#define NBLK (SEQ_LEN / 64)
#define NB_CMP ((NCMP + 63) / 64)
#define S5_NC (SEQ_LEN / 64)
#define RET_NC (SEQ_LEN / 128)
#define ALPHA_F 1.4142135623730951f
#define NTHREADS 256

enum { I_X = 0, I_AB_W_IN, I_AB_W_OUT, I_S5_LAM_RE, I_S5_LAM_IM, I_S5_LOG_DT, I_S5_B_RE, I_S5_B_IM, I_S5_C_RE, I_S5_C_IM,
       I_S5_D, I_S5_W_GLU, I_S5_B_GLU, I_PE_K, I_PE_V, I_CK_W1, I_CK_B1, I_CK_W2, I_CV_W1, I_CV_B1, I_CV_W2,
       I_CD_W_IN, I_CD_W_OUT, I_RW_MU, I_RW_W0, I_RW_W_UP, I_RW_A0, I_RW_A_UP, I_RW_G_UP, I_RW_K_K, I_RW_K_A, I_RW_R_K,
       I_RW_LN_G, I_RW_LN_B, I_RET_LN_G, I_RET_LN_B, I_LN1_G, I_LN1_B, I_LN2_G, I_LN2_B, I_ROUTER, I_MOE_BIAS,
       I_MOE_W1, I_MOE_W3, I_MOE_W2, I_SH_W1, I_SH_W3, I_SH_W2, N_INPUTS };

struct Params {
  const float* in[N_INPUTS];
  float* out;
  char* ws;
};

#define MiB_TOK ((size_t)NTOK * 1024 * 4)
#define OFF_H 0
#define OFF_H2 ((size_t)NTOK * 1792 * 4)
#define OFF_MIX ((size_t)NTOK * 3328 * 4)
#define OFF_X1 (OFF_MIX + MiB_TOK)
#define OFF_X2 (OFF_X1 + MiB_TOK)
#define OFF_R4 (OFF_X2 + MiB_TOK)
#define OFF_R5 (OFF_R4 + MiB_TOK)
#define OFF_Y OFF_H
#define OFF_HS (OFF_H + 4 * MiB_TOK)
#define OFF_FS OFF_X2
#define OFF_HR OFF_R4
#define OFF_X2B OFF_R4
#define OFF_TOPI (OFF_R5)
#define OFF_TOPG (OFF_TOPI + (size_t)NTOK * 8 * 4)
#define OFF_POSOF (OFF_TOPG + (size_t)NTOK * 8 * 4)
#define OFF_CNT (OFF_POSOF + (size_t)NTOK * 8 * 4)
#define OFF_LTOK (OFF_CNT + 8192)
#define OFF_LGATE (OFF_LTOK + (size_t)64 * NTOK * 4)
#define OFF_S5E (OFF_LGATE + (size_t)64 * NTOK * 4)
#define OFF_KCMP (OFF_S5E + (size_t)BATCH * S5_NC * 32 * 64 * 8)
#define OFF_VCMP (OFF_KCMP + (size_t)BATCH * NCMP * 2 * 64 * 4)
#define OFF_RETKV (OFF_VCMP + (size_t)BATCH * NCMP * 2 * 64 * 4)
#define OFF_BAR (OFF_RETKV + (size_t)BATCH * 4 * RET_NC * 64 * 128 * 4)
#define OFF_CMPHID (OFF_BAR + 16384)
#define OFF_CMPC1 (OFF_CMPHID + (size_t)2 * BATCH * 2 * NB_CMP * 64 * 128 * 4)
#define OFF_GLO OFF_LTOK
#define OFF_RKF (OFF_CMPC1 + 8192)
#define OFF_END (OFF_RKF + 16384)
#define OFF_YGELU OFF_X1
#define OFF_RWW OFF_X1
#define OFF_RWK (OFF_X1 + (size_t)NTOK * 512 * 4)
#define OFF_RWKK OFF_R4
#define OFF_RWA (OFF_R4 + (size_t)NTOK * 512 * 4)

typedef short bf16x8 __attribute__((ext_vector_type(8)));
typedef float f32x16 __attribute__((ext_vector_type(16)));

#ifdef CPU_EMU
#define WAVE_SYNC() emu_wave_bar()
#else
#define WAVE_SYNC() __builtin_amdgcn_wave_barrier()
#endif

DEV float sigmoidf_(float x) { return 1.f / (1.f + __expf(-x)); }
DEV float siluf_(float x) { return x * sigmoidf_(x); }
DEV float geluf_(float x) { float u = 0.7978845608028654f * (x + 0.044715f * x * x * x); return 0.5f * x * (1.f + tanhf(u)); }
DEV unsigned short f2bf(float f) {
  unsigned u = __builtin_bit_cast(unsigned, f);
  u += 0x7FFFu + ((u >> 16) & 1u);
  return (unsigned short)(u >> 16);
}
DEV float bf2f(unsigned short h) { return __builtin_bit_cast(float, ((unsigned)h) << 16); }
DEV float wave_sum(float v) {
#pragma unroll
  for (int m = 32; m >= 1; m >>= 1) v += __shfl_xor(v, m);
  return v;
}
DEV float wave_max(float v) {
#pragma unroll
  for (int m = 32; m >= 1; m >>= 1) v = fmaxf(v, __shfl_xor(v, m));
  return v;
}
DEV float4 ld4(const float* p) { return *(const float4*)p; }
#ifdef CPU_EMU
DEV float fexp2(float x) { return exp2f(x); }
#else
DEV float fexp2(float x) { return __builtin_amdgcn_exp2f(x); }
#endif
DEV void fast_sincos(float x, float* sn, float* cs) {
  const float k = rintf(x * 0.15915494309189535f);
  float r = fmaf(-k, 6.28125f, x);
  r = fmaf(-k, 1.9353071795864769e-3f, r);
  *sn = __sinf(r); *cs = __cosf(r);
}
DEV void st4(float* p, float4 v) { *(float4*)p = v; }

#define GEMM_BM 128
#define GEMM_MI (GEMM_BM / 64)
#define GEMM_SMEM_BYTES ((GEMM_BM + 128) * 72 * 2)
#ifdef CPU_EMU
DEV unsigned pk2(float a, float b) { return (unsigned)f2bf(a) | ((unsigned)f2bf(b) << 16); }
#else
typedef __bf16 hbf16x2 __attribute__((ext_vector_type(2)));
typedef float hf32x2 __attribute__((ext_vector_type(2)));
DEV unsigned pk2(float a, float b) {
  hf32x2 f = {a, b};
  return __builtin_bit_cast(unsigned, __builtin_convertvector(f, hbf16x2));
}
#endif
template <bool ABF, class AROW, class BPTR, class EPI>
DEV void gemm_tile(AROW arow, BPTR bptr, int ldb, int K, EPI epi, char* smem_raw, int akstep = 64) {
  unsigned short(*sA)[72] = (unsigned short(*)[72])smem_raw;
  unsigned short(*sB)[72] = (unsigned short(*)[72])(smem_raw + GEMM_BM * 72 * 2);
  const int tid = TIDX, lane = tid & 63, wave = tid >> 6;
  const int wm = wave >> 1, wn = wave & 1;
#if defined(CPU_EMU) && !defined(EMU_REAL_GEMM)
  for (int mi = 0; mi < GEMM_MI; ++mi)
    for (int r = 0; r < 16; ++r) {
      const int row = wm * (GEMM_BM / 2) + mi * 32 + (r & 3) + 8 * (r >> 2) + 4 * (lane >> 5);
      const int col = wn * 64 + (lane & 31);
      const void* arp = arow(row);
      float v[2] = {0.f, 0.f};
      for (int ni = 0; ni < 2; ++ni) {
        const int cc = col + ni * 32;
        const float* bq = bptr(cc & ~3);
        if (!arp || !bq) continue;
        bq += cc & 3;
        float a = 0.f;
        for (int k = 0; k < K; ++k) {
          const size_t ka = (size_t)(k >> 6) * akstep + (k & 63);
          const float av = ABF ? bf2f(((const unsigned short*)arp)[ka]) : bf2f(f2bf(((const float*)arp)[ka]));
          a += av * bf2f(f2bf(bq[(size_t)k * ldb]));
        }
        v[ni] = a;
      }
      epi(row, col, v[0], v[1]);
    }
  return;
#endif
  const float* ap[4 * GEMM_MI];
  const unsigned short* aph[2 * GEMM_MI];
  if (ABF) {
#pragma unroll
    for (int i = 0; i < 2 * GEMM_MI; ++i) aph[i] = (const unsigned short*)arow((tid >> 3) + 32 * i);
  } else {
#pragma unroll
    for (int i = 0; i < 4 * GEMM_MI; ++i) ap[i] = (const float*)arow((tid >> 4) + 16 * i);
  }
  const float* bp = bptr((tid & 31) * 4);
  const int kgrp = tid >> 5;
  float4 ra0[4 * GEMM_MI], ra1[4 * GEMM_MI];
  uint4 rah0[2 * GEMM_MI], rah1[2 * GEMM_MI];
  float4 rb0[8], rb1[8];
#define GEMM_GLOAD(S, k0_)                                                                                                          \
  {                                                                                                                                 \
    if (ABF) {                                                                                                                      \
      _Pragma("unroll") for (int i = 0; i < 2 * GEMM_MI; ++i) rah##S[i] =                                                           \
          aph[i] ? *(const uint4*)(aph[i] + (size_t)((k0_) >> 6) * akstep + (tid & 7) * 8) : make_uint4(0, 0, 0, 0);                \
    } else {                                                                                                                        \
      _Pragma("unroll") for (int i = 0; i < 4 * GEMM_MI; ++i) ra##S[i] =                                                            \
          ap[i] ? ld4(ap[i] + (size_t)((k0_) >> 6) * akstep + (tid & 15) * 4) : make_float4(0.f, 0.f, 0.f, 0.f);                    \
    }                                                                                                                               \
    _Pragma("unroll") for (int j = 0; j < 8; ++j) rb##S[j] =                                                                        \
        bp ? ld4(bp + (size_t)((k0_) + kgrp * 8 + j) * ldb) : make_float4(0.f, 0.f, 0.f, 0.f);                                      \
  }
#define GEMM_SSTORE(S)                                                                                                              \
  {                                                                                                                                 \
    if (ABF) {                                                                                                                      \
      _Pragma("unroll") for (int i = 0; i < 2 * GEMM_MI; ++i) *(uint4*)&sA[(tid >> 3) + 32 * i][(tid & 7) * 8] = rah##S[i];         \
    } else {                                                                                                                        \
      _Pragma("unroll") for (int i = 0; i < 4 * GEMM_MI; ++i) *(uint2*)&sA[(tid >> 4) + 16 * i][(tid & 15) * 4] =                   \
          make_uint2(pk2(ra##S[i].x, ra##S[i].y), pk2(ra##S[i].z, ra##S[i].w));                                                     \
    }                                                                                                                               \
    const int nb = (tid & 31) * 4;                                                                                                  \
    *(uint4*)&sB[nb + 0][kgrp * 8] = make_uint4(pk2(rb##S[0].x, rb##S[1].x), pk2(rb##S[2].x, rb##S[3].x), pk2(rb##S[4].x, rb##S[5].x), pk2(rb##S[6].x, rb##S[7].x)); \
    *(uint4*)&sB[nb + 1][kgrp * 8] = make_uint4(pk2(rb##S[0].y, rb##S[1].y), pk2(rb##S[2].y, rb##S[3].y), pk2(rb##S[4].y, rb##S[5].y), pk2(rb##S[6].y, rb##S[7].y)); \
    *(uint4*)&sB[nb + 2][kgrp * 8] = make_uint4(pk2(rb##S[0].z, rb##S[1].z), pk2(rb##S[2].z, rb##S[3].z), pk2(rb##S[4].z, rb##S[5].z), pk2(rb##S[6].z, rb##S[7].z)); \
    *(uint4*)&sB[nb + 3][kgrp * 8] = make_uint4(pk2(rb##S[0].w, rb##S[1].w), pk2(rb##S[2].w, rb##S[3].w), pk2(rb##S[4].w, rb##S[5].w), pk2(rb##S[6].w, rb##S[7].w)); \
  }
  f32x16 acc[GEMM_MI][2];
#pragma unroll
  for (int mi = 0; mi < GEMM_MI; ++mi)
#pragma unroll
    for (int ni = 0; ni < 2; ++ni)
#pragma unroll
      for (int r = 0; r < 16; ++r) acc[mi][ni][r] = 0.f;
  auto compute = [&]() {
#pragma unroll
    for (int ks = 0; ks < 4; ++ks) {
      bf16x8 af[GEMM_MI], bfr[2];
#pragma unroll
      for (int mi = 0; mi < GEMM_MI; ++mi) af[mi] = *(const bf16x8*)&sA[wm * (GEMM_BM / 2) + mi * 32 + (lane & 31)][ks * 16 + (lane >> 5) * 8];
#pragma unroll
      for (int ni = 0; ni < 2; ++ni) bfr[ni] = *(const bf16x8*)&sB[wn * 64 + ni * 32 + (lane & 31)][ks * 16 + (lane >> 5) * 8];
#pragma unroll
      for (int mi = 0; mi < GEMM_MI; ++mi)
#pragma unroll
        for (int ni = 0; ni < 2; ++ni) acc[mi][ni] = __builtin_amdgcn_mfma_f32_32x32x16_bf16(af[mi], bfr[ni], acc[mi][ni], 0, 0, 0);
    }
  };
  if (ABF) {
    GEMM_GLOAD(0, 0);
    GEMM_GLOAD(1, 64);
    for (int k0 = 0; k0 < K; k0 += 128) {
      __syncthreads();
      GEMM_SSTORE(0);
      __syncthreads();
      if (k0 + 128 < K) GEMM_GLOAD(0, k0 + 128);
      compute();
      __syncthreads();
      GEMM_SSTORE(1);
      __syncthreads();
      if (k0 + 192 < K) GEMM_GLOAD(1, k0 + 192);
      compute();
    }
  } else {
    GEMM_GLOAD(0, 0);
    for (int k0 = 0; k0 < K; k0 += 64) {
      __syncthreads();
      GEMM_SSTORE(0);
      __syncthreads();
      if (k0 + 64 < K) GEMM_GLOAD(0, k0 + 64);
      compute();
    }
  }
#pragma unroll
  for (int mi = 0; mi < GEMM_MI; ++mi)
#pragma unroll
    for (int r = 0; r < 16; ++r) {
      int row = wm * (GEMM_BM / 2) + mi * 32 + (r & 3) + 8 * (r >> 2) + 4 * (lane >> 5);
      int col = wn * 64 + (lane & 31);
      epi(row, col, acc[mi][0][r], acc[mi][1][r]);
    }
}

template <int LAYER>
DEV void phase_gemm_in(const Params& p, char* smem) {
  const int N = LAYER == 0 ? AB_IN : CD_IN;
  const float* A = LAYER == 0 ? p.in[I_X] : (const float*)(p.ws + OFF_X2);
  const float* B = LAYER == 0 ? p.in[I_AB_W_IN] : p.in[I_CD_W_IN];
  float* C = (float*)(p.ws + OFF_H);
  const int NT = (N + 127) / 128, MT = NTOK / GEMM_BM;
  const int xcd_ = BIDX & 7, lb_ = BIDX >> 3, nb_ = gridDim.x >> 3;
  for (int j_ = lb_; j_ < (MT / 8) * NT; j_ += nb_) {
    const int it = (xcd_ + 8 * (j_ / NT)) * NT + (j_ % NT);
    const int tm = it / NT, tn = it % NT;
    const int m0 = tm * GEMM_BM, n0 = tn * 128;
    gemm_tile<LAYER == 1>(
        [&](int r) { return LAYER == 1 ? (const void*)((const unsigned short*)(p.ws + OFF_X2B) + (size_t)(m0 + r) * DM) : (const void*)(A + (size_t)(m0 + r) * DM); },
        [&](int c) { return (n0 + c < N) ? (B + n0 + c) : (const float*)nullptr; }, N, DM,
        [&](int row, int col, float v0, float v1) {
          const int gm = m0 + row, gc = n0 + col;
          if (LAYER == 1 && gc >= 1792 && gc < 2304) {
            const int i = gc & 63;
            const float pos = (float)(gm % SEQ_LEN);
            const float inv = __expf(-(float)i * (9.210340371976184f / 32.f));
            float sn, cs;
            fast_sincos(pos * inv, &sn, &cs);
            float o0 = v0 * cs - v1 * sn, o1 = v1 * cs + v0 * sn;
            if (gc >= 2048) { o0 *= 0.125f; o1 *= 0.125f; }
            v0 = o0; v1 = o1;
          }
          if (LAYER == 1) {
            float* dstp = gc < 1792 ? C + (size_t)gm * 1792 + gc : (float*)(p.ws + OFF_H2) + (size_t)gm * 1536 + (gc - 1792);
            dstp[0] = v0; dstp[32] = v1;
          } else {
            if (gc < N) C[(size_t)gm * AB_LD + gc] = v0;
            if (gc + 32 < N) C[(size_t)gm * AB_LD + gc + 32] = v1;
          }
        },
        smem);
  }
}

struct S5Const { float lb_re, lb_im; };
DEV void s5_consts(const Params& p, int g, int pp, float& lb_re, float& lb_im, float (&bbr)[16], float (&bbi)[16]) {
  const float dt = expf(p.in[I_S5_LOG_DT][g]);
  const float lr = p.in[I_S5_LAM_RE][g * 64 + pp], li = p.in[I_S5_LAM_IM][g * 64 + pp];
  const float mag = expf(lr * dt);
  float sn, cs;
  sincosf(li * dt, &sn, &cs);
  lb_re = mag * cs; lb_im = mag * sn;
  const float den = lr * lr + li * li;
  const float f_re = ((lb_re - 1.f) * lr + lb_im * li) / den;
  const float f_im = (lb_im * lr - (lb_re - 1.f) * li) / den;
  const float* br = p.in[I_S5_B_RE] + (size_t)(g * 64 + pp) * 16;
  const float* bi = p.in[I_S5_B_IM] + (size_t)(g * 64 + pp) * 16;
#pragma unroll
  for (int h = 0; h < 16; ++h) {
    bbr[h] = f_re * br[h] - f_im * bi[h];
    bbi[h] = f_re * bi[h] + f_im * br[h];
  }
}

#define OFF_QB OFF_X2
#define OFF_KSB (OFF_QB + (size_t)NTOK * 512 * 2)
#define OFF_KWB (OFF_KSB + (size_t)NTOK * 128 * 2)
#define OFF_VST (OFF_KWB + (size_t)NTOK * 128 * 2)
#define OFF_VWT (OFF_VST + (size_t)NTOK * 128 * 2)
#define OFF_KCB (OFF_VWT + (size_t)NTOK * 128 * 2)
#define OFF_VCT (OFF_KCB + (size_t)BATCH * 2 * NB_CMP * 64 * 64 * 2)
#define NSA_QSCALE (0.125f * 1.4426950408889634f)

#define P1_S5A_ITEMS (BATCH * 32 * S5_NC / 4)
#define P1_CMP_ITEMS (2 * BATCH * 2 * NB_CMP)
DEV void p1_s5a(const Params& p, int item, char* smem) {
  const int lane = TIDX & 63, wave = TIDX >> 6;
  const int idx = item * 4 + wave;
  const int g = idx & 31, c = (idx >> 5) % S5_NC, b = idx / (32 * S5_NC);
  float lb_re, lb_im, bbr[16], bbi[16];
  s5_consts(p, g, lane, lb_re, lb_im, bbr, bbi);
  const float* H = (const float*)(p.ws + OFF_H);
  float sr = 0.f, si = 0.f;
  float* su = (float*)smem + wave * 64 * 16;
  __syncthreads();
  {
    const float* ur = H + (size_t)(b * SEQ_LEN + c * 64 + lane) * AB_LD + g * 16;
#pragma unroll
    for (int q = 0; q < 4; ++q) st4(su + lane * 16 + q * 4, ld4(ur + q * 4));
  }
  WAVE_SYNC();
  for (int tt = 0; tt < 64; ++tt) {
    const float* u = su + tt * 16;
    float dr = 0.f, di = 0.f;
#pragma unroll
    for (int h4 = 0; h4 < 4; ++h4) {
      const float4 uv = ld4(u + h4 * 4);
      dr += uv.x * bbr[h4 * 4] + uv.y * bbr[h4 * 4 + 1] + uv.z * bbr[h4 * 4 + 2] + uv.w * bbr[h4 * 4 + 3];
      di += uv.x * bbi[h4 * 4] + uv.y * bbi[h4 * 4 + 1] + uv.z * bbi[h4 * 4 + 2] + uv.w * bbi[h4 * 4 + 3];
    }
    const float nr = lb_re * sr - lb_im * si + dr;
    const float ni = lb_re * si + lb_im * sr + di;
    sr = nr; si = ni;
  }
  float2* E = (float2*)(p.ws + OFF_S5E);
  E[((size_t)(b * S5_NC + c) * 32 + g) * 64 + lane] = make_float2(sr, si);
}
#define P1_CMPG_MT ((NCMP + GEMM_BM - 1) / GEMM_BM)
#define P1_CMPG_ITEMS (2 * BATCH * 2 * P1_CMPG_MT)
DEV void p1_cmpgemm(const Params& p, int item, char* smem) {
  const int mt = item % P1_CMPG_MT;
  int r = item / P1_CMPG_MT;
  const int g = r & 1; r >>= 1;
  const int b = r % BATCH; const int which = r / BATCH;
  const float* H = (const float*)(p.ws + OFF_H);
  const float* w1 = which ? p.in[I_CV_W1] : p.in[I_CK_W1];
  const int colbase = (which ? 1152 : 1024) + g * 64;
  float* HID = (float*)(p.ws + OFF_CMPHID) + ((size_t)(which * BATCH + b) * 2 + g) * NB_CMP * 64 * 128;
  const int n0 = mt * GEMM_BM;
  gemm_tile<false>(
      [&](int rr) { return (n0 + rr < NCMP) ? (const void*)(H + ((size_t)b * SEQ_LEN + 16 * (n0 + rr)) * AB_LD + colbase) : (const void*)nullptr; },
      [&](int c) { return w1 + c; }, 128, 2048,
      [&](int row, int col, float v0, float v1) {
        if (n0 + row < NCMP) { HID[(size_t)(n0 + row) * 128 + col] = v0; HID[(size_t)(n0 + row) * 128 + col + 32] = v1; }
      },
      smem, AB_LD);
}
#define P1_CMPC1_ITEMS 16
DEV void p1_cmpc1(const Params& p, int item, char* smem) {
  const int which = item >> 3, sl = item & 7;
  const float* pe = which ? p.in[I_PE_V] : p.in[I_PE_K];
  const float* w1 = which ? p.in[I_CV_W1] : p.in[I_CK_W1];
  float* sPart = (float*)smem;
  const int tid = TIDX, hid = tid & 127, kh = tid >> 7;
  float a = 0.f;
  const int k0 = sl * 256 + kh * 128;
#pragma unroll 16
  for (int k = k0; k < k0 + 128; ++k) a += pe[k] * w1[(size_t)k * 128 + hid];
  __syncthreads();
  sPart[tid] = a;
  __syncthreads();
  if (tid < 128) ((float*)(p.ws + OFF_CMPC1))[(which * 8 + sl) * 128 + tid] = sPart[tid] + sPart[tid + 128];
  __syncthreads();
}
DEV void p1_compress(const Params& p, int item, char* smem) {
  const int tile = item % NB_CMP;
  int r = item / NB_CMP;
  const int g = r & 1; r >>= 1;
  const int b = r % BATCH; const int which = r / BATCH;
  const float* b1 = which ? p.in[I_CV_B1] : p.in[I_CK_B1];
  const float* w2 = which ? p.in[I_CV_W2] : p.in[I_CK_W2];
  const float* C1P = (const float*)(p.ws + OFF_CMPC1) + which * 8 * 128;
  const float* HID = (const float*)(p.ws + OFF_CMPHID) + ((size_t)(which * BATCH + b) * 2 + g) * NB_CMP * 64 * 128;
  float* sOut = (float*)smem;
  float* sHid = sOut + 8 * 64;
  float* sAll = sHid + 8 * 128;
  float* sC1 = sAll + 64 * 65;
  const int tid = TIDX;
  __syncthreads();
  if (tid < 128) {
    const float* q = C1P + tid;
    sC1[tid] = (((((((q[0] + q[128]) + q[256]) + q[384]) + q[512]) + q[640]) + q[768]) + q[896]) + b1[tid];
  }
  float* dst = (float*)(p.ws + (which ? OFF_VCMP : OFF_KCMP));
#pragma unroll 1
  for (int r8 = 0; r8 < 8; ++r8) {
    const int n0 = tile * 64 + r8 * 8;
    __syncthreads();
    for (int w = tid; w < 8 * 128; w += NTHREADS) {
      const int rr = w >> 7, hid = w & 127;
      const int n = n0 + rr;
      sHid[w] = n < NCMP ? geluf_(HID[(size_t)n * 128 + hid] + sC1[hid]) : 0.f;
    }
    __syncthreads();
    for (int w = tid; w < 8 * 64; w += NTHREADS) {
      const int rr = w >> 6, d = w & 63;
      float a = 0.f;
      for (int hid = 0; hid < 128; ++hid) a += sHid[rr * 128 + hid] * w2[hid * 64 + d];
      sOut[w] = a;
    }
    __syncthreads();
    for (int w = tid; w < 8 * 64; w += NTHREADS) {
      const int rr = w >> 6, d = w & 63;
      const int n = n0 + rr;
      float v = sOut[w];
      if (which == 0 && d < 16) {
        const int i = d & 7;
        const float pos = (float)(n * 16 + 31);
        const float inv = __expf(-(float)i * (13.122363377404328f / 8.f));
        float sn, cs;
        sincosf(pos * inv, &sn, &cs);
        const float x1 = sOut[rr * 64 + i], x2 = sOut[rr * 64 + i + 8];
        v = d < 8 ? x1 * cs - x2 * sn : x2 * cs + x1 * sn;
      }
      if (n >= NCMP) v = 0.f;
      sAll[(r8 * 8 + rr) * 65 + d] = v;
      if (n < NCMP) dst[((size_t)(b * NCMP + n) * 2 + g) * 64 + d] = v;
    }
  }
  __syncthreads();
  if (which == 0) {
    unsigned short* KCB = (unsigned short*)(p.ws + OFF_KCB) + (((size_t)b * 2 + g) * NB_CMP * 64 + tile * 64) * 64;
    for (int w = tid; w < 64 * 8; w += NTHREADS) {
      const int nl = w >> 3, o = w & 7;
      float v[8];
#pragma unroll
      for (int q = 0; q < 8; ++q) v[q] = sAll[nl * 65 + o * 8 + q];
      *(uint4*)(KCB + nl * 64 + o * 8) = make_uint4(pk2(v[0], v[1]), pk2(v[2], v[3]), pk2(v[4], v[5]), pk2(v[6], v[7]));
    }
  } else {
    unsigned short* VCT = (unsigned short*)(p.ws + OFF_VCT) + (((size_t)b * 2 + g) * NB_CMP + tile) * 64 * 64;
    for (int w = tid; w < 64 * 8; w += NTHREADS) {
      const int d = w >> 3, o = w & 7;
      float v[8];
#pragma unroll
      for (int q = 0; q < 8; ++q) v[q] = sAll[(o * 8 + q) * 65 + d];
      *(uint4*)(VCT + d * 64 + o * 8) = make_uint4(pk2(v[0], v[1]), pk2(v[2], v[3]), pk2(v[4], v[5]), pk2(v[6], v[7]));
    }
  }
}
DEV uint4 pack8(const float* v) {
  uint4 r;
  r.x = (unsigned)f2bf(v[0]) | ((unsigned)f2bf(v[1]) << 16);
  r.y = (unsigned)f2bf(v[2]) | ((unsigned)f2bf(v[3]) << 16);
  r.z = (unsigned)f2bf(v[4]) | ((unsigned)f2bf(v[5]) << 16);
  r.w = (unsigned)f2bf(v[6]) | ((unsigned)f2bf(v[7]) << 16);
  return r;
}
#define P1_PREP_ITEMS (NTOK / 64)
#define P1_PREP_SMEM ((64 * 8 * 2 + 64 * 128) * 4)
DEV void p1_prep(const Params& p, int item, char* smem) {
  const int tid = TIDX;
  const int b = item / NBLK, blk = item % NBLK;
  const float* H = (const float*)(p.ws + OFF_H);
  float* sCS = (float*)smem;
  float* sV = sCS + 64 * 8 * 2;
  const size_t tok0 = (size_t)b * SEQ_LEN + blk * 64;
  __syncthreads();
  for (int w = tid; w < 64 * 8; w += NTHREADS) {
    const int tk = w >> 3, i = w & 7;
    const float pos = (float)(blk * 64 + tk);
    const float inv = __expf(-(float)i * (13.122363377404328f / 8.f));
    float sn, cs;
    sincosf(pos * inv, &sn, &cs);
    sCS[w * 2] = cs; sCS[w * 2 + 1] = sn;
  }
  __syncthreads();
  unsigned short* QB = (unsigned short*)(p.ws + OFF_QB);
  unsigned short* KSB = (unsigned short*)(p.ws + OFF_KSB);
  unsigned short* KWB = (unsigned short*)(p.ws + OFF_KWB);
  for (int w = tid; w < 64 * 12 * 8; w += NTHREADS) {
    const int o = w & 7, hd = (w >> 3) % 12, tk = w / 96;
    const int col = hd < 8 ? 512 + hd * 64 : (hd < 10 ? 1280 + (hd - 8) * 64 : 1536 + (hd - 10) * 64);
    const float* x = H + (tok0 + tk) * AB_LD + col;
    float v[8];
    const float4 a0 = ld4(x + o * 8), a1 = ld4(x + o * 8 + 4);
    v[0] = a0.x; v[1] = a0.y; v[2] = a0.z; v[3] = a0.w; v[4] = a1.x; v[5] = a1.y; v[6] = a1.z; v[7] = a1.w;
    if (o < 2) {
      const float4 c0 = ld4(x + (1 - o) * 8), c1 = ld4(x + (1 - o) * 8 + 4);
      const float u[8] = {c0.x, c0.y, c0.z, c0.w, c1.x, c1.y, c1.z, c1.w};
#pragma unroll
      for (int i = 0; i < 8; ++i) {
        const float cs = sCS[(tk * 8 + i) * 2], sn = sCS[(tk * 8 + i) * 2 + 1];
        v[i] = o == 0 ? v[i] * cs - u[i] * sn : v[i] * cs + u[i] * sn;
      }
    }
    if (hd < 8) {
#pragma unroll
      for (int i = 0; i < 8; ++i) v[i] *= NSA_QSCALE;
      *(uint4*)(QB + ((tok0 + tk) * 8 + hd) * 64 + o * 8) = pack8(v);
    } else {
      const int g = (hd - 8) & 1;
      unsigned short* dst = (hd < 10 ? KSB : KWB) + (((size_t)b * 2 + g) * SEQ_LEN + blk * 64 + tk) * 64 + o * 8;
      *(uint4*)dst = pack8(v);
    }
  }
#pragma unroll 1
  for (int which = 0; which < 2; ++which) {
    const int col = which ? 1664 : 1408;
    __syncthreads();
    for (int w = tid; w < 64 * 32; w += NTHREADS) {
      const int tk = w >> 5, c4 = (w & 31) * 4;
      st4(sV + tk * 128 + c4, ld4(H + (tok0 + tk) * AB_LD + col + c4));
    }
    __syncthreads();
    unsigned short* VT = (unsigned short*)(p.ws + (which ? OFF_VWT : OFF_VST));
    for (int w = tid; w < 2 * 64 * 8; w += NTHREADS) {
      const int ko = w & 7, d = (w >> 3) & 63, g = w >> 9;
      float v[8];
#pragma unroll
      for (int i = 0; i < 8; ++i) v[i] = sV[(ko * 8 + i) * 128 + g * 64 + d];
      *(uint4*)(VT + ((((size_t)b * 2 + g) * NBLK + blk) * 64 + d) * 64 + ko * 8) = pack8(v);
    }
  }
}

struct NsaSmem {
  unsigned short k[64][72];
  unsigned short vt[64][68];
  float imp[32][128];
  unsigned selmask[32][4];
  unsigned unionm[4];
  float keyb[4][128];
};
#define P2_NSA_SMEM ((int)sizeof(NsaSmem))
#define NSA_QT (SEQ_LEN / 32)
#define P2_NSA_ITEMS (BATCH * 2 * NSA_QT)

struct TileRegs { uint4 k0, k1, v0, v1; };
DEV void tile_gload(TileRegs& r, const unsigned short* Kg, const unsigned short* Vg, int tid) {
  const int row = tid >> 2, seg = tid & 3;
  r.k0 = *(const uint4*)(Kg + row * 64 + seg * 16);
  r.k1 = *(const uint4*)(Kg + row * 64 + seg * 16 + 8);
  if (Vg) {
    r.v0 = *(const uint4*)(Vg + row * 64 + seg * 16);
    r.v1 = *(const uint4*)(Vg + row * 64 + seg * 16 + 8);
  }
}
DEV void tile_sstore(NsaSmem* sm, const TileRegs& r, bool withV, int tid) {
  const int row = tid >> 2, seg = tid & 3;
  *(uint4*)&sm->k[row][seg * 16] = r.k0;
  *(uint4*)&sm->k[row][seg * 16 + 8] = r.k1;
  if (withV) {
    *(uint2*)&sm->vt[row][seg * 16] = make_uint2(r.v0.x, r.v0.y);
    *(uint2*)&sm->vt[row][seg * 16 + 4] = make_uint2(r.v0.z, r.v0.w);
    *(uint2*)&sm->vt[row][seg * 16 + 8] = make_uint2(r.v1.x, r.v1.y);
    *(uint2*)&sm->vt[row][seg * 16 + 12] = make_uint2(r.v1.z, r.v1.w);
  }
}
DEV void qk_tile(const unsigned short (*ksm)[72], const bf16x8 (&qf)[4], f32x16 (&s)[2], int lane) {
  const int r = lane & 31, hh = lane >> 5;
#pragma unroll
  for (int ks2 = 0; ks2 < 2; ++ks2) {
#pragma unroll
    for (int i = 0; i < 16; ++i) s[ks2][i] = 0.f;
#pragma unroll
    for (int ks = 0; ks < 4; ++ks) {
      const bf16x8 a = *(const bf16x8*)&ksm[ks2 * 32 + r][ks * 16 + hh * 8];
      s[ks2] = __builtin_amdgcn_mfma_f32_32x32x16_bf16(a, qf[ks], s[ks2], 0, 0, 0);
    }
  }
}
DEV void pv_tile(const unsigned short (*vsm)[68], const f32x16 (&pr)[2], f32x16 (&o)[2], int lane) {
  const int r = lane & 31, hh = lane >> 5;
#pragma unroll
  for (int ks2 = 0; ks2 < 2; ++ks2)
#pragma unroll
    for (int s = 0; s < 2; ++s) {
      union { uint4 u; bf16x8 v; } pfu;
      pfu.u = make_uint4(pk2(pr[ks2][8 * s], pr[ks2][8 * s + 1]), pk2(pr[ks2][8 * s + 2], pr[ks2][8 * s + 3]),
                         pk2(pr[ks2][8 * s + 4], pr[ks2][8 * s + 5]), pk2(pr[ks2][8 * s + 6], pr[ks2][8 * s + 7]));
      const bf16x8 pf = pfu.v;
#pragma unroll
      for (int mt = 0; mt < 2; ++mt) {
        const uint2 lo = *(const uint2*)&vsm[mt * 32 + r][ks2 * 32 + 16 * s + 4 * hh];
        const uint2 hi = *(const uint2*)&vsm[mt * 32 + r][ks2 * 32 + 16 * s + 8 + 4 * hh];
        union { uint4 u; bf16x8 v; } au;
        au.u = make_uint4(lo.x, lo.y, hi.x, hi.y);
        const bf16x8 a = au.v;
        o[mt] = __builtin_amdgcn_mfma_f32_32x32x16_bf16(a, pf, o[mt], 0, 0, 0);
      }
    }
}
DEV float quad_sum(float v) {
#ifdef CPU_EMU
  v += __shfl_xor(v, 1); v += __shfl_xor(v, 2); return v;
#else
  int x;
  x = __builtin_amdgcn_update_dpp(0, __builtin_bit_cast(int, v), 0xB1, 0xF, 0xF, false); v += __builtin_bit_cast(float, x);
  x = __builtin_amdgcn_update_dpp(0, __builtin_bit_cast(int, v), 0x4E, 0xF, 0xF, false); v += __builtin_bit_cast(float, x);
  return v;
#endif
}
DEV void softmax_step(f32x16 (&s)[2], float& m, float& l, f32x16 (&o)[2]) {
  float tmax = -INFINITY;
#pragma unroll
  for (int ks2 = 0; ks2 < 2; ++ks2)
#pragma unroll
    for (int i = 0; i < 16; ++i) tmax = fmaxf(tmax, s[ks2][i]);
  tmax = fmaxf(tmax, __shfl_xor(tmax, 32));
  const float mnew = fmaxf(m, tmax);
  const float msafe = mnew == -INFINITY ? 0.f : mnew;
  const float alpha = fexp2(m - msafe);
  float ps = 0.f;
#pragma unroll
  for (int ks2 = 0; ks2 < 2; ++ks2)
#pragma unroll
    for (int i = 0; i < 16; ++i) { s[ks2][i] = fexp2(s[ks2][i] - msafe); ps += s[ks2][i]; }
  l = l * alpha + ps;
#pragma unroll
  for (int mt = 0; mt < 2; ++mt)
#pragma unroll
    for (int i = 0; i < 16; ++i) o[mt][i] *= alpha;
  m = mnew;
}
DEV bool testbit4(unsigned w0, unsigned w1, unsigned w2, unsigned w3, int j) {
  const unsigned lo = j & 32 ? w1 : w0, hi = j & 32 ? w3 : w2;
  const unsigned x = j & 64 ? hi : lo;
  return (x >> (j & 31)) & 1u;
}

DEV void p2_nsa(const Params& p, int item, char* smem) {
  NsaSmem* sm = (NsaSmem*)smem;
  const int tid = TIDX, lane = tid & 63, wave = tid >> 6;
  const int bg = item & 3, b = bg >> 1, g = bg & 1;
  const int qt = NSA_QT - 1 - (item >> 2);
  const int t0 = qt * 32;
  const int c = lane & 31, hh = lane >> 5, tl = c >> 2, h = c & 3;
  const int trow = wave * 8 + tl;
  const int tq = t0 + trow;
  const size_t tok = (size_t)b * SEQ_LEN + tq;
  const int hd = g * 4 + h;
  const float* H = (const float*)(p.ws + OFF_H);
  const unsigned short* QB = (const unsigned short*)(p.ws + OFF_QB);
  const unsigned short* KSB = (const unsigned short*)(p.ws + OFF_KSB) + ((size_t)b * 2 + g) * SEQ_LEN * 64;
  const unsigned short* KWB = (const unsigned short*)(p.ws + OFF_KWB) + ((size_t)b * 2 + g) * SEQ_LEN * 64;
  const unsigned short* VST = (const unsigned short*)(p.ws + OFF_VST) + ((size_t)b * 2 + g) * NBLK * 4096;
  const unsigned short* VWT = (const unsigned short*)(p.ws + OFF_VWT) + ((size_t)b * 2 + g) * NBLK * 4096;
  const unsigned short* KCB = (const unsigned short*)(p.ws + OFF_KCB) + ((size_t)b * 2 + g) * NB_CMP * 4096;
  const unsigned short* VCT = (const unsigned short*)(p.ws + OFF_VCT) + ((size_t)b * 2 + g) * NB_CMP * 4096;
  bf16x8 qf[4];
  {
    const unsigned short* qrow = QB + (tok * 8 + hd) * 64;
#pragma unroll
    for (int ks = 0; ks < 4; ++ks) qf[ks] = *(const bf16x8*)(qrow + ks * 16 + hh * 8);
  }
  const float g0 = sigmoidf_(H[tok * AB_LD + 1792 + hd * 3 + 0]);
  const float g1 = sigmoidf_(H[tok * AB_LD + 1792 + hd * 3 + 1]);
  const float g2 = sigmoidf_(H[tok * AB_LD + 1792 + hd * 3 + 2]);
  f32x16 o[2], s[2];
#pragma unroll
  for (int mt = 0; mt < 2; ++mt)
#pragma unroll
    for (int i = 0; i < 16; ++i) o[mt][i] = 0.f;
  float* mixrow = (float*)(p.ws + OFF_MIX) + tok * 1024 + 512 + hd * 64 + 4 * hh;
  __syncthreads();
  for (int w = tid; w < 32 * 128; w += NTHREADS) (&sm->imp[0][0])[w] = 0.f;
  TileRegs tr;
  tr.k0 = tr.k1 = tr.v0 = tr.v1 = make_uint4(0, 0, 0, 0);
  const int nval = tq >= 31 ? (tq - 31) / 16 + 1 : 0;
  const int nvmax = (t0 + 31 - 31) / 16 + 1;
  const int ktn = (nvmax + 63) / 64;
  float m = -INFINITY, l = 0.f;
  tile_gload(tr, KCB, nullptr, tid);
  for (int kt = 0; kt < ktn; ++kt) {
    __syncthreads();
    tile_sstore(sm, tr, false, tid);
    __syncthreads();
    if (kt + 1 < ktn) tile_gload(tr, KCB + (size_t)(kt + 1) * 4096, nullptr, tid);
    qk_tile(sm->k, qf, s, lane);
    float tmax = -INFINITY;
#pragma unroll
    for (int ks2 = 0; ks2 < 2; ++ks2)
#pragma unroll
      for (int i = 0; i < 16; ++i) {
        const int n = kt * 64 + ks2 * 32 + (i & 3) + 8 * (i >> 2) + 4 * hh;
        s[ks2][i] = n < nval ? s[ks2][i] : -INFINITY;
        tmax = fmaxf(tmax, s[ks2][i]);
      }
    tmax = fmaxf(tmax, __shfl_xor(tmax, 32));
    const float mnew = fmaxf(m, tmax);
    const float msafe = mnew == -INFINITY ? 0.f : mnew;
    float ps = 0.f;
#pragma unroll
    for (int ks2 = 0; ks2 < 2; ++ks2)
#pragma unroll
      for (int i = 0; i < 16; ++i) ps += fexp2(s[ks2][i] - msafe);
    l = l * fexp2(m - msafe) + ps;
    m = mnew;
  }
  {
    const float ltot = l + __shfl_xor(l, 32);
    const float invl = ltot > 0.f ? 1.f / ltot : 0.f;
    const float msafe = m == -INFINITY ? 0.f : m;
    tile_gload(tr, KCB, VCT, tid);
    for (int kt = 0; kt < ktn; ++kt) {
      __syncthreads();
      tile_sstore(sm, tr, true, tid);
      __syncthreads();
      if (kt + 1 < ktn) tile_gload(tr, KCB + (size_t)(kt + 1) * 4096, VCT + (size_t)(kt + 1) * 4096, tid);
      qk_tile(sm->k, qf, s, lane);
#pragma unroll
      for (int ks2 = 0; ks2 < 2; ++ks2)
#pragma unroll
        for (int i = 0; i < 16; ++i) {
          const int n = kt * 64 + ks2 * 32 + (i & 3) + 8 * (i >> 2) + 4 * hh;
          s[ks2][i] = n < nval ? fexp2(s[ks2][i] - msafe) * invl : 0.f;
        }
#pragma unroll
      for (int ks2 = 0; ks2 < 2; ++ks2)
#pragma unroll
        for (int g4 = 0; g4 < 4; ++g4) {
          float A = 2.f * (s[ks2][4 * g4] + s[ks2][4 * g4 + 1] + s[ks2][4 * g4 + 2]) + s[ks2][4 * g4 + 3];
          float Bv = s[ks2][4 * g4 + 3];
          A = quad_sum(A); Bv = quad_sum(Bv);
          const int j = kt * 16 + ks2 * 8 + 2 * g4 + hh;
          if (h == 0 && j < NBLK) sm->imp[trow][j] += A;
          WAVE_SYNC();
          if (h == 0 && j + 1 < NBLK) sm->imp[trow][j + 1] += Bv;
          WAVE_SYNC();
        }
      pv_tile(sm->vt, s, o, lane);
    }
#pragma unroll
    for (int mt = 0; mt < 2; ++mt)
#pragma unroll
      for (int g4 = 0; g4 < 4; ++g4) {
        st4(mixrow + mt * 32 + 8 * g4, make_float4(o[mt][4 * g4] * g0, o[mt][4 * g4 + 1] * g0, o[mt][4 * g4 + 2] * g0, o[mt][4 * g4 + 3] * g0));
        o[mt][4 * g4] = 0.f; o[mt][4 * g4 + 1] = 0.f; o[mt][4 * g4 + 2] = 0.f; o[mt][4 * g4 + 3] = 0.f;
      }
  }
  WAVE_SYNC();
  for (int t8 = 0; t8 < 8; ++t8) {
    const int row = wave * 8 + t8, tt = t0 + row, cur = tt >> 6;
    float kv[2]; bool valid[2];
#pragma unroll
    for (int c2 = 0; c2 < 2; ++c2) {
      const int j = lane + 64 * c2;
      valid[c2] = j < NBLK && j <= cur;
      const bool forced = (j == 0) | (j == cur) | (j == cur - 1);
      kv[c2] = valid[c2] ? (forced ? 1e6f : sm->imp[row][j < NBLK ? j : 0]) : -1.f;
      sm->keyb[wave][j] = kv[c2];
    }
    WAVE_SYNC();
    int rank0 = 0, rank1 = 0;
    const int jlim = cur < NBLK - 1 ? cur : NBLK - 1;
    for (int jj = 0; jj <= jlim; ++jj) {
      const float ov = sm->keyb[wave][jj];
      rank0 += (ov > kv[0] || (ov == kv[0] && jj < lane)) ? 1 : 0;
      rank1 += (ov > kv[1] || (ov == kv[1] && jj < lane + 64)) ? 1 : 0;
    }
    const unsigned long long m0 = __ballot(valid[0] && rank0 < 16);
    const unsigned long long m1 = __ballot(valid[1] && rank1 < 16);
    if (lane == 0) {
      sm->selmask[row][0] = (unsigned)m0; sm->selmask[row][1] = (unsigned)(m0 >> 32);
      sm->selmask[row][2] = (unsigned)m1; sm->selmask[row][3] = (unsigned)(m1 >> 32);
    }
    WAVE_SYNC();
  }
  __syncthreads();
  if (tid < 4) {
    unsigned u = 0;
    for (int r = 0; r < 32; ++r) u |= sm->selmask[r][tid];
    sm->unionm[tid] = u;
  }
  __syncthreads();
  const unsigned um0 = sm->unionm[0], um1 = sm->unionm[1], um2 = sm->unionm[2], um3 = sm->unionm[3];
  const unsigned my0 = sm->selmask[trow][0], my1 = sm->selmask[trow][1], my2 = sm->selmask[trow][2], my3 = sm->selmask[trow][3];
  {
    const int jmax = (t0 + 31) >> 6;
    int j = 0;
    while (j <= jmax && !testbit4(um0, um1, um2, um3, j)) ++j;
    m = -INFINITY; l = 0.f;
    if (j <= jmax) tile_gload(tr, KSB + (size_t)j * 4096, VST + (size_t)j * 4096, tid);
    while (j <= jmax) {
      __syncthreads();
      tile_sstore(sm, tr, true, tid);
      __syncthreads();
      int jn = j + 1;
      while (jn <= jmax && !testbit4(um0, um1, um2, um3, jn)) ++jn;
      if (jn <= jmax) tile_gload(tr, KSB + (size_t)jn * 4096, VST + (size_t)jn * 4096, tid);
      const bool mine = testbit4(my0, my1, my2, my3, j);
      if (__ballot(mine) != 0ull) {
        qk_tile(sm->k, qf, s, lane);
#pragma unroll
        for (int ks2 = 0; ks2 < 2; ++ks2)
#pragma unroll
          for (int i = 0; i < 16; ++i) {
            const int kp = j * 64 + ks2 * 32 + (i & 3) + 8 * (i >> 2) + 4 * hh;
            s[ks2][i] = (mine && kp <= tq) ? s[ks2][i] : -INFINITY;
          }
        softmax_step(s, m, l, o);
        pv_tile(sm->vt, s, o, lane);
      }
      j = jn;
    }
    const float ltot = l + __shfl_xor(l, 32);
    const float sc = ltot > 0.f ? g1 / ltot : 0.f;
#pragma unroll
    for (int mt = 0; mt < 2; ++mt)
#pragma unroll
      for (int g4 = 0; g4 < 4; ++g4) {
        float4 a = ld4(mixrow + mt * 32 + 8 * g4);
        a.x += o[mt][4 * g4] * sc; a.y += o[mt][4 * g4 + 1] * sc; a.z += o[mt][4 * g4 + 2] * sc; a.w += o[mt][4 * g4 + 3] * sc;
        st4(mixrow + mt * 32 + 8 * g4, a);
        o[mt][4 * g4] = 0.f; o[mt][4 * g4 + 1] = 0.f; o[mt][4 * g4 + 2] = 0.f; o[mt][4 * g4 + 3] = 0.f;
      }
  }
  {
    const int jlo = t0 - 511 > 0 ? (t0 - 511) >> 6 : 0, jhi = (t0 + 31) >> 6;
    const int wq0 = t0 + wave * 8;
    m = -INFINITY; l = 0.f;
    tile_gload(tr, KWB + (size_t)jlo * 4096, VWT + (size_t)jlo * 4096, tid);
    for (int j = jlo; j <= jhi; ++j) {
      __syncthreads();
      tile_sstore(sm, tr, true, tid);
      __syncthreads();
      if (j + 1 <= jhi) tile_gload(tr, KWB + (size_t)(j + 1) * 4096, VWT + (size_t)(j + 1) * 4096, tid);
      if (j * 64 <= wq0 + 7 && j * 64 + 63 > wq0 - 512) {
        qk_tile(sm->k, qf, s, lane);
#pragma unroll
        for (int ks2 = 0; ks2 < 2; ++ks2)
#pragma unroll
          for (int i = 0; i < 16; ++i) {
            const int kp = j * 64 + ks2 * 32 + (i & 3) + 8 * (i >> 2) + 4 * hh;
            s[ks2][i] = (kp <= tq && kp > tq - 512) ? s[ks2][i] : -INFINITY;
          }
        softmax_step(s, m, l, o);
        pv_tile(sm->vt, s, o, lane);
      }
    }
    const float ltot = l + __shfl_xor(l, 32);
    const float sc = ltot > 0.f ? g2 / ltot : 0.f;
#pragma unroll
    for (int mt = 0; mt < 2; ++mt)
#pragma unroll
      for (int g4 = 0; g4 < 4; ++g4) {
        float4 a = ld4(mixrow + mt * 32 + 8 * g4);
        a.x += o[mt][4 * g4] * sc; a.y += o[mt][4 * g4 + 1] * sc; a.z += o[mt][4 * g4 + 2] * sc; a.w += o[mt][4 * g4 + 3] * sc;
        st4(mixrow + mt * 32 + 8 * g4, a);
        o[mt][4 * g4] = 0.f; o[mt][4 * g4 + 1] = 0.f; o[mt][4 * g4 + 2] = 0.f; o[mt][4 * g4 + 3] = 0.f;
      }
  }
}

#define P1_SMEM ((8 * 64 + 8 * 128 + 64 * 65 + 128) * 4)
DEV void phase_p1(const Params& p, char* smem) {
  const int total = P1_CMPG_ITEMS + P1_CMPC1_ITEMS + P1_PREP_ITEMS;
  for (int it = BIDX; it < total; it += gridDim.x) {
    if (it < P1_CMPG_ITEMS) p1_cmpgemm(p, it, smem);
    else if (it < P1_CMPG_ITEMS + P1_CMPC1_ITEMS) p1_cmpc1(p, it - P1_CMPG_ITEMS, smem);
    else p1_prep(p, it - P1_CMPG_ITEMS - P1_CMPC1_ITEMS, smem);
  }
  {
    const int Gh = (int)gridDim.x / 2, bid_ = BIDX;
    if (bid_ < Gh) for (int it = bid_; it < P1_S5A_ITEMS; it += Gh) p1_s5a(p, it, smem);
  }
}
DEV void phase_p1b(const Params& p, char* smem) {
  for (int it = BIDX; it < P1_CMP_ITEMS; it += gridDim.x) p1_compress(p, it, smem);
}

#define P2_S5C_ITEMS (BATCH * 32 * S5_NC / 4)
#define S5C_ROW 132
#define P2_S5C_SMEM (4 * 16 * S5C_ROW * 4 + 4 * 64 * 16 * 4)
DEV void p2_s5c(const Params& p, int item, char* smem) {
  const int lane = TIDX & 63, wave = TIDX >> 6;
  const int idx = item * 4 + wave;
  const int g = idx & 31, c = (idx >> 5) % S5_NC, b = idx / (32 * S5_NC);
  float lb_re, lb_im, bbr[16], bbi[16];
  s5_consts(p, g, lane, lb_re, lb_im, bbr, bbi);
  float ar = lb_re, ai = lb_im;
#pragma unroll
  for (int s = 0; s < 6; ++s) { const float nr = ar * ar - ai * ai, ni = 2.f * ar * ai; ar = nr; ai = ni; }
  const float2* E = (const float2*)(p.ws + OFF_S5E);
  float sr = 0.f, si = 0.f;
  {
    int cc = 0;
    for (; cc + 8 <= c; cc += 8) {
      float2 e[8];
#pragma unroll
      for (int q = 0; q < 8; ++q) e[q] = E[((size_t)(b * S5_NC + cc + q) * 32 + g) * 64 + lane];
#pragma unroll
      for (int q = 0; q < 8; ++q) {
        const float nr = ar * sr - ai * si + e[q].x, ni = ar * si + ai * sr + e[q].y;
        sr = nr; si = ni;
      }
    }
    for (; cc < c; ++cc) {
      const float2 e = E[((size_t)(b * S5_NC + cc) * 32 + g) * 64 + lane];
      const float nr = ar * sr - ai * si + e.x, ni = ar * si + ai * sr + e.y;
      sr = nr; si = ni;
    }
  }
  __syncthreads();
  const float* H = (const float*)(p.ws + OFF_H);
  float* sS = (float*)smem + wave * 16 * S5C_ROW;
  float* su = (float*)smem + 4 * 16 * S5C_ROW + wave * 64 * 16;
  {
    const float* ur = H + (size_t)(b * SEQ_LEN + c * 64 + lane) * AB_LD + g * 16;
#pragma unroll
    for (int q = 0; q < 4; ++q) st4(su + lane * 16 + q * 4, ld4(ur + q * 4));
  }
  __syncthreads();
  const float* cre = p.in[I_S5_C_RE] + (size_t)g * 16 * 64;
  const float* cim = p.in[I_S5_C_IM] + (size_t)g * 16 * 64;
  float* YG = (float*)(p.ws + OFF_YGELU);
  for (int sc = 0; sc < 4; ++sc) {
    for (int tt = 0; tt < 16; ++tt) {
      const float* u = su + (sc * 16 + tt) * 16;
      float dr = 0.f, di = 0.f;
#pragma unroll
      for (int h4 = 0; h4 < 4; ++h4) {
        const float4 uv = ld4(u + h4 * 4);
        dr += uv.x * bbr[h4 * 4] + uv.y * bbr[h4 * 4 + 1] + uv.z * bbr[h4 * 4 + 2] + uv.w * bbr[h4 * 4 + 3];
        di += uv.x * bbi[h4 * 4] + uv.y * bbi[h4 * 4 + 1] + uv.z * bbi[h4 * 4 + 2] + uv.w * bbi[h4 * 4 + 3];
      }
      const float nr = lb_re * sr - lb_im * si + dr, ni = lb_re * si + lb_im * sr + di;
      sr = nr; si = ni;
      sS[tt * S5C_ROW + lane] = sr;
      sS[tt * S5C_ROW + 64 + lane] = si;
    }
    __syncthreads();
    {
      const int tt = lane >> 2, hq = lane & 3;
      float y[4] = {0.f, 0.f, 0.f, 0.f};
#pragma unroll 2
      for (int k = 0; k < 64; k += 4) {
        const float4 vr = ld4(sS + tt * S5C_ROW + k), vi = ld4(sS + tt * S5C_ROW + 64 + k);
#pragma unroll
        for (int hh = 0; hh < 4; ++hh) {
          const float4 cr = ld4(cre + (hq * 4 + hh) * 64 + k), ci = ld4(cim + (hq * 4 + hh) * 64 + k);
          y[hh] += vr.x * cr.x + vr.y * cr.y + vr.z * cr.z + vr.w * cr.w - (vi.x * ci.x + vi.y * ci.y + vi.z * ci.z + vi.w * ci.w);
        }
      }
      const size_t tok = (size_t)(b * SEQ_LEN + c * 64 + sc * 16 + tt);
      const int ch = g * 16 + hq * 4;
      const float4 uv = ld4(H + tok * AB_LD + ch);
      const float4 dv = ld4(p.in[I_S5_D] + ch);
      float4 o;
      o.x = geluf_(y[0] + dv.x * uv.x); o.y = geluf_(y[1] + dv.y * uv.y);
      o.z = geluf_(y[2] + dv.z * uv.z); o.w = geluf_(y[3] + dv.w * uv.w);
      st4(YG + tok * 512 + ch, o);
    }
    __syncthreads();
  }
}

#define P2_SMEM (P2_S5C_SMEM > P2_NSA_SMEM ? P2_S5C_SMEM : P2_NSA_SMEM)
DEV void phase_p2(const Params& p, char* smem) {
  const int G = gridDim.x;
  const int total = P2_NSA_ITEMS + P2_S5C_ITEMS;
  for (int r = 0;; ++r) {
    const int it = r * G + ((r & 1) ? (G - 1 - (int)BIDX) : (int)BIDX);
    if (r * G >= total) break;
    if (it >= total) continue;
    if (it < P2_NSA_ITEMS) p2_nsa(p, it, smem);
    else p2_s5c(p, it - P2_NSA_ITEMS, smem);
  }
}

DEV void phase_glu(const Params& p, char* smem) {
  const float* A = (const float*)(p.ws + OFF_YGELU);
  const float* B = p.in[I_S5_W_GLU];
  const float* bias = p.in[I_S5_B_GLU];
  float* MIX = (float*)(p.ws + OFF_MIX);
  const int NT = 4, MT = NTOK / GEMM_BM;
  const int xcd_ = BIDX & 7, lb_ = BIDX >> 3, nb_ = gridDim.x >> 3;
  for (int j_ = lb_; j_ < (MT / 8) * NT; j_ += nb_) {
    const int it = (xcd_ + 8 * (j_ / NT)) * NT + (j_ % NT);
    const int m0 = (it / NT) * GEMM_BM, n0 = (it % NT) * 128;
    gemm_tile<false>(
        [&](int r) { return (const void*)(A + (size_t)(m0 + r) * 512); },
        [&](int c) { return B + n0 + c; }, 512, 512,
        [&](int row, int col, float v0, float v1) {
          const size_t gm = m0 + row; const int gc = n0 + col;
          const float y0 = A[gm * 512 + gc], y1 = A[gm * 512 + gc + 32];
          MIX[gm * 1024 + gc] = y0 * sigmoidf_(v0 + bias[gc]);
          MIX[gm * 1024 + gc + 32] = y1 * sigmoidf_(v1 + bias[gc + 32]);
        },
        smem);
  }
}

template <int LAYER>
DEV void phase_outproj(const Params& p, char* smem) {
  const float* A = (const float*)(p.ws + OFF_MIX);
  const float* B = LAYER == 0 ? p.in[I_AB_W_OUT] : p.in[I_CD_W_OUT];
  const float* xin = LAYER == 0 ? p.in[I_X] : (const float*)(p.ws + OFF_X2);
  float* PRE = (float*)(p.ws + OFF_H);
  const int NT = 8, MT = NTOK / GEMM_BM;
  const int xcd_ = BIDX & 7, lb_ = BIDX >> 3, nb_ = gridDim.x >> 3;
  for (int j_ = lb_; j_ < (MT / 8) * NT; j_ += nb_) {
    const int it = (xcd_ + 8 * (j_ / NT)) * NT + (j_ % NT);
    const int m0 = (it / NT) * GEMM_BM, n0 = (it % NT) * 128;
    gemm_tile<false>(
        [&](int r) { return (const void*)(A + (size_t)(m0 + r) * 1024); },
        [&](int c) { return B + n0 + c; }, 1024, 1024,
        [&](int row, int col, float v0, float v1) {
          const size_t o = (size_t)(m0 + row) * 1024 + n0 + col;
          PRE[o] = ALPHA_F * xin[o] + v0;
          PRE[o + 32] = ALPHA_F * xin[o + 32] + v1;
        },
        smem);
  }
}

DEV void wave_ln(float (&v)[16], const float* gam, const float* bet, int lane) {
  float s = 0.f;
#pragma unroll
  for (int i = 0; i < 16; ++i) s += v[i];
  const float mu = wave_sum(s) * (1.f / 1024.f);
  float q = 0.f;
#pragma unroll
  for (int i = 0; i < 16; ++i) { const float d = v[i] - mu; q += d * d; }
  const float rstd = rsqrtf(wave_sum(q) * (1.f / 1024.f) + 1e-5f);
#pragma unroll
  for (int i = 0; i < 4; ++i) {
    const float4 gv = ld4(gam + lane * 4 + 256 * i), bv = ld4(bet + lane * 4 + 256 * i);
    v[i * 4 + 0] = (v[i * 4 + 0] - mu) * rstd * gv.x + bv.x;
    v[i * 4 + 1] = (v[i * 4 + 1] - mu) * rstd * gv.y + bv.y;
    v[i * 4 + 2] = (v[i * 4 + 2] - mu) * rstd * gv.z + bv.z;
    v[i * 4 + 3] = (v[i * 4 + 3] - mu) * rstd * gv.w + bv.w;
  }
}

#define LNR_T 4
#define P5_SMEM ((4 * LNR_T * 512 + 4 * 4 * LNR_T * 64 + 4 * 64) * 4)
template <int LAYER>
DEV void phase_ln_router(const Params& p, char* smem) {
  const int lane = TIDX & 63, wave = TIDX >> 6;
  const float* PRE = (const float*)(p.ws + OFF_H);
  float* X1 = (float*)(p.ws + OFF_X1);
  const float* router = p.in[I_ROUTER] + (size_t)LAYER * 1024 * 64;
  const float* bias = p.in[I_MOE_BIAS] + LAYER * 64;
  int* TOPI = (int*)(p.ws + OFF_TOPI);
  float* TOPG = (float*)(p.ws + OFF_TOPG);
  float* xh = (float*)smem;
  float* part = xh + 4 * LNR_T * 512;
  float* ms = part + 4 * 4 * LNR_T * 64 + wave * 64;
  unsigned short* X1B = (unsigned short*)p.out;
  for (int it = BIDX; it < NTOK / (4 * LNR_T); it += gridDim.x) {
    const size_t tokb = (size_t)it * (4 * LNR_T) + wave * LNR_T;
    float v[LNR_T][16];
#pragma unroll
    for (int t = 0; t < LNR_T; ++t) {
      const size_t tok = tokb + t;
#pragma unroll
      for (int i = 0; i < 4; ++i) {
        const float4 a = ld4(PRE + tok * 1024 + lane * 4 + 256 * i);
        v[t][i * 4] = a.x; v[t][i * 4 + 1] = a.y; v[t][i * 4 + 2] = a.z; v[t][i * 4 + 3] = a.w;
      }
      wave_ln(v[t], p.in[I_LN1_G] + LAYER * 1024, p.in[I_LN1_B] + LAYER * 1024, lane);
#pragma unroll
      for (int i = 0; i < 4; ++i) {
        const float4 a = make_float4(v[t][i * 4], v[t][i * 4 + 1], v[t][i * 4 + 2], v[t][i * 4 + 3]);
        st4(X1 + tok * 1024 + lane * 4 + 256 * i, a);
        *(uint2*)(X1B + tok * 1024 + lane * 4 + 256 * i) = make_uint2(pk2(a.x, a.y), pk2(a.z, a.w));
      }
    }
    {
      float pl[4 * LNR_T];
#pragma unroll
      for (int t = 0; t < 4 * LNR_T; ++t) pl[t] = 0.f;
#pragma unroll
      for (int hf = 0; hf < 2; ++hf) {
        __syncthreads();
#pragma unroll
        for (int t = 0; t < LNR_T; ++t)
#pragma unroll
          for (int i2 = 0; i2 < 2; ++i2) {
            const int i = 2 * hf + i2;
            st4(xh + (wave * LNR_T + t) * 512 + lane * 4 + 256 * i2, make_float4(v[t][i * 4], v[t][i * 4 + 1], v[t][i * 4 + 2], v[t][i * 4 + 3]));
          }
        __syncthreads();
#pragma unroll 2
        for (int kk = wave * 128; kk < wave * 128 + 128; kk += 4) {
          const int k = hf * 512 + kk;
          const float r0 = router[(size_t)k * 64 + lane], r1 = router[(size_t)(k + 1) * 64 + lane],
                      r2 = router[(size_t)(k + 2) * 64 + lane], r3 = router[(size_t)(k + 3) * 64 + lane];
#pragma unroll
          for (int t = 0; t < 4 * LNR_T; ++t) {
            const float4 xv = ld4(xh + t * 512 + kk);
            pl[t] += xv.x * r0 + xv.y * r1 + xv.z * r2 + xv.w * r3;
          }
        }
      }
#pragma unroll
      for (int t = 0; t < 4 * LNR_T; ++t) part[(wave * 4 * LNR_T + t) * 64 + lane] = pl[t];
    }
    __syncthreads();
    float lg[LNR_T];
#pragma unroll
    for (int t = 0; t < LNR_T; ++t) {
      const int tg = wave * LNR_T + t;
      lg[t] = ((part[(0 * 4 * LNR_T + tg) * 64 + lane] + part[(1 * 4 * LNR_T + tg) * 64 + lane]) + part[(2 * 4 * LNR_T + tg) * 64 + lane]) +
              part[(3 * 4 * LNR_T + tg) * 64 + lane];
    }
#pragma unroll
    for (int t = 0; t < LNR_T; ++t) {
      const size_t tok = tokb + t;
      const float score = 1.f / (1.f + expf(-lg[t]));
      const float biased = score + bias[lane];
      float m1 = biased; int a1 = lane;
#pragma unroll
      for (int mm = 1; mm <= 4; mm <<= 1) {
        const float ov = __shfl_xor(m1, mm); const int oa = __shfl_xor(a1, mm);
        if (ov > m1 || (ov == m1 && oa < a1)) { m1 = ov; a1 = oa; }
      }
      float m2 = lane == a1 ? -INFINITY : biased;
#pragma unroll
      for (int mm = 1; mm <= 4; mm <<= 1) m2 = fmaxf(m2, __shfl_xor(m2, mm));
      const float gs = m1 + m2;
      const int mygrp = lane >> 3;
      int rank = 0;
#pragma unroll
      for (int gg = 0; gg < 8; ++gg) {
        const float og = __shfl(gs, gg * 8);
        rank += (og > gs || (og == gs && gg < mygrp)) ? 1 : 0;
      }
      const float masked = rank < 4 ? biased : -INFINITY;
      WAVE_SYNC();
      ms[lane] = masked;
      WAVE_SYNC();
      int erank = 0;
      for (int e = 0; e < 64; ++e) {
        const float ov = ms[e];
        erank += (ov > masked || (ov == masked && e < lane)) ? 1 : 0;
      }
      const bool selected = erank < 8;
      const float gsum = wave_sum(selected ? score : 0.f);
      if (selected) {
        TOPI[tok * 8 + erank] = lane;
        TOPG[tok * 8 + erank] = score / gsum * 2.5f;
      }
    }
  }
}

#define P6_SMEM GEMM_SMEM_BYTES
template <int LAYER>
DEV void phase_lists_shup(const Params& p, char* smem) {
  const int tid = TIDX, lane = tid & 63, wave = tid >> 6;
  const int* TOPI = (const int*)(p.ws + OFF_TOPI);
  const float* TOPG = (const float*)(p.ws + OFF_TOPG);
  int* PPOS = (int*)(p.ws + OFF_S5E);
  int* CNT = (int*)(p.ws + OFF_CNT);
  int* LTOK = (int*)(p.ws + OFF_LTOK);
  float* LGATE = (float*)(p.ws + OFF_LGATE);
  const unsigned short* X1B = (const unsigned short*)p.out;
  unsigned short* HS = (unsigned short*)(p.ws + OFF_HS);
  const float* W1 = p.in[I_SH_W1] + (size_t)LAYER * 1024 * 256;
  const float* W3 = p.in[I_SH_W3] + (size_t)LAYER * 1024 * 256;
  const int MT = NTOK / GEMM_BM;
  int* swave = (int*)smem;
  for (int it = BIDX; it < 64; it += gridDim.x) {
    const int e = it;
    int base = 0;
    for (int t0 = 0; t0 < NTOK; t0 += 4 * NTHREADS) {
      const int tok4 = t0 + 4 * tid;
      int slot[4];
      unsigned long long bal[4];
#pragma unroll
      for (int j = 0; j < 4; ++j) {
        const int4 a = *(const int4*)(TOPI + (size_t)(tok4 + j) * 8), b = *(const int4*)(TOPI + (size_t)(tok4 + j) * 8 + 4);
        int sl = -1;
        sl = a.x == e ? 0 : sl; sl = a.y == e ? 1 : sl; sl = a.z == e ? 2 : sl; sl = a.w == e ? 3 : sl;
        sl = b.x == e ? 4 : sl; sl = b.y == e ? 5 : sl; sl = b.z == e ? 6 : sl; sl = b.w == e ? 7 : sl;
        slot[j] = sl;
        bal[j] = __ballot(sl >= 0);
      }
      const unsigned long long lower = (1ull << lane) - 1ull;
      int pre = 0, wtot = 0;
#pragma unroll
      for (int j = 0; j < 4; ++j) { pre += __popcll(bal[j] & lower); wtot += __popcll(bal[j]); }
      __syncthreads();
      if (lane == 0) swave[wave] = wtot;
      __syncthreads();
      int woff = 0, tot = 0;
#pragma unroll
      for (int w = 0; w < 4; ++w) { const int c = swave[w]; if (w < wave) woff += c; tot += c; }
      int pos = base + woff + pre;
#pragma unroll
      for (int j = 0; j < 4; ++j) {
        if (slot[j] >= 0) {
          const int tok = tok4 + j;
          LTOK[(size_t)e * NTOK + pos] = tok;
          LGATE[(size_t)e * NTOK + pos] = TOPG[(size_t)tok * 8 + slot[j]];
          PPOS[(size_t)e * NTOK + tok] = pos;
          ++pos;
        }
      }
      base += tot;
    }
    if (tid == 0) CNT[e * 32] = base;
    __syncthreads();
  }
  {
    const int NT = 4;
    const int xcd_ = BIDX & 7, lb_ = BIDX >> 3, nb_ = gridDim.x >> 3;
    for (int j_ = lb_; j_ < (MT / 8) * NT; j_ += nb_) {
      const int m0 = (xcd_ + 8 * (j_ / NT)) * GEMM_BM, ct = j_ % NT;
      gemm_tile<true>(
          [&](int r) { return (const void*)(X1B + (size_t)(m0 + r) * 1024); },
          [&](int c) { return (((c >> 5) & 1) ? W3 : W1) + ct * 64 + (c >> 6) * 32 + (c & 31); }, 256, 1024,
          [&](int row, int col, float v0, float v1) {
            const int lc = ct * 64 + (col >> 6) * 32 + (col & 31);
            HS[(size_t)(m0 + row) * 256 + lc] = f2bf(siluf_(v0) * v1);
          },
          smem);
    }
  }
}

struct ExpMap { int tstart[65]; int rbase[65]; int ltile[9]; };
DEV void build_expmap(const Params& p, ExpMap* em) {
  __syncthreads();
  if (TIDX == 0) {
    const int* CNT = (const int*)(p.ws + OFF_CNT);
    int ts = 0, rb = 0;
    for (int e = 0; e < 64; ++e) {
      em->tstart[e] = ts; em->rbase[e] = rb;
      const int c = CNT[e * 32];
      ts += (c + GEMM_BM - 1) / GEMM_BM; rb += c;
    }
    em->tstart[64] = ts; em->rbase[64] = rb;
    const int x = BIDX & 7;
    int lt = 0;
    for (int k = 0; k < 8; ++k) { em->ltile[k] = lt; lt += em->tstart[x + 8 * k + 1] - em->tstart[x + 8 * k]; }
    em->ltile[8] = lt;
  }
  __syncthreads();
}
DEV void map_expert_tile(const ExpMap* em, int j, int CT, int& e, int& rt, int& ct) {
  const int jr = j / CT; ct = j % CT;
  int k = 0;
  for (int q = 1; q < 8; ++q) if (em->ltile[q] <= jr) k = q;
  e = (BIDX & 7) + 8 * k; rt = jr - em->ltile[k];
}
#define P7_SMEM (GEMM_SMEM_BYTES + 1024)
template <int LAYER>
DEV void phase_routed_up(const Params& p, char* smem) {
  ExpMap* em = (ExpMap*)(smem + GEMM_SMEM_BYTES);
  build_expmap(p, em);
  const int* CNT = (const int*)(p.ws + OFF_CNT);
  const int* LTOK = (const int*)(p.ws + OFF_LTOK);
  const unsigned short* X1B = (const unsigned short*)p.out;
  unsigned short* HR = (unsigned short*)(p.ws + OFF_HR);
  const int lb_ = BIDX >> 3, nb_ = gridDim.x >> 3;
  for (int j_ = lb_; j_ < em->ltile[8] * 4; j_ += nb_) {
    int e, rtl, ct;
    map_expert_tile(em, j_, 4, e, rtl, ct);
    const int r0 = rtl * GEMM_BM;
    const int cnt = CNT[e * 32], rbase = em->rbase[e];
    const float* W1 = p.in[I_MOE_W1] + ((size_t)LAYER * 64 + e) * 1024 * 256;
    const float* W3 = p.in[I_MOE_W3] + ((size_t)LAYER * 64 + e) * 1024 * 256;
    gemm_tile<true>(
        [&](int r) { return (r0 + r < cnt) ? (const void*)(X1B + (size_t)LTOK[(size_t)e * NTOK + r0 + r] * 1024) : (const void*)nullptr; },
        [&](int c) { return (((c >> 5) & 1) ? W3 : W1) + ct * 64 + (c >> 6) * 32 + (c & 31); }, 256, 1024,
        [&](int row, int col, float v0, float v1) {
          if (r0 + row < cnt) {
            const int lc = ct * 64 + (col >> 6) * 32 + (col & 31);
            HR[(size_t)(rbase + r0 + row) * 256 + lc] = f2bf(siluf_(v0) * v1);
          }
        },
        smem);
  }
}

template <int LAYER>
DEV void phase_down(const Params& p, char* smem) {
  ExpMap* em = (ExpMap*)(smem + GEMM_SMEM_BYTES);
  build_expmap(p, em);
  const int* CNT = (const int*)(p.ws + OFF_CNT);
  const float* LGATE = (const float*)(p.ws + OFF_LGATE);
  const unsigned short* HR = (const unsigned short*)(p.ws + OFF_HR);
  const unsigned short* HS = (const unsigned short*)(p.ws + OFF_HS);
  unsigned short* Y = (unsigned short*)(p.ws + OFF_Y);
  float* FS = (float*)(p.ws + OFF_FS);
  const int xcd_ = BIDX & 7, lb_ = BIDX >> 3, nb_ = gridDim.x >> 3;
  for (int j_ = lb_; j_ < em->ltile[8] * 8; j_ += nb_) {
    int e, rtl, ct;
    map_expert_tile(em, j_, 8, e, rtl, ct);
    const int r0 = rtl * GEMM_BM;
    const int cnt = CNT[e * 32], rbase = em->rbase[e];
    const float* W2 = p.in[I_MOE_W2] + ((size_t)LAYER * 64 + e) * 256 * 1024;
    const int n0 = ct * 128;
    gemm_tile<true>(
        [&](int r) { return (r0 + r < cnt) ? (const void*)(HR + (size_t)(rbase + r0 + r) * 256) : (const void*)nullptr; },
        [&](int c) { return W2 + n0 + c; }, 1024, 256,
        [&](int row, int col, float v0, float v1) {
          if (r0 + row < cnt) {
            const float gt = LGATE[(size_t)e * NTOK + r0 + row];
            const size_t o = (size_t)(rbase + r0 + row) * 1024 + n0 + col;
            Y[o] = f2bf(v0 * gt); Y[o + 32] = f2bf(v1 * gt);
          }
        },
        smem);
  }
  {
    const int MT = NTOK / GEMM_BM, NT = 8;
    const float* W2 = p.in[I_SH_W2] + (size_t)LAYER * 256 * 1024;
    for (int j_ = lb_; j_ < (MT / 8) * NT; j_ += nb_) {
      const int m0 = (xcd_ + 8 * (j_ / NT)) * GEMM_BM, n0 = (j_ % NT) * 128;
      gemm_tile<true>(
          [&](int r) { return (const void*)(HS + (size_t)(m0 + r) * 256); },
          [&](int c) { return W2 + n0 + c; }, 1024, 256,
          [&](int row, int col, float v0, float v1) {
            const size_t o = (size_t)(m0 + row) * 1024 + n0 + col;
            FS[o] = v0; FS[o + 32] = v1;
          },
          smem);
    }
  }
}

template <int LAYER>
DEV void phase_combine(const Params& p, char* smem) {
  ExpMap* em = (ExpMap*)smem;
  build_expmap(p, em);
  const int lane = TIDX & 63, wave = TIDX >> 6;
  const float* X1 = (const float*)(p.ws + OFF_X1);
  const float* FS = (const float*)(p.ws + OFF_FS);
  const unsigned short* Y = (const unsigned short*)(p.ws + OFF_Y);
  const int* TOPI = (const int*)(p.ws + OFF_TOPI);
  const int* PPOS = (const int*)(p.ws + OFF_S5E);
  float* OUT = LAYER == 0 ? (float*)(p.ws + OFF_X2) : p.out;
  for (int it = BIDX; it < NTOK / 4; it += gridDim.x) {
    const size_t tok = (size_t)it * 4 + wave;
    float v[16];
#pragma unroll
    for (int i = 0; i < 4; ++i) {
      const float4 a = ld4(X1 + tok * 1024 + lane * 4 + 256 * i), f = ld4(FS + tok * 1024 + lane * 4 + 256 * i);
      v[i * 4] = ALPHA_F * a.x + f.x; v[i * 4 + 1] = ALPHA_F * a.y + f.y; v[i * 4 + 2] = ALPHA_F * a.z + f.z; v[i * 4 + 3] = ALPHA_F * a.w + f.w;
    }
    size_t rows[8];
#pragma unroll
    for (int s = 0; s < 8; ++s) { const int e_ = TOPI[tok * 8 + s]; rows[s] = (size_t)em->rbase[e_] + PPOS[(size_t)e_ * NTOK + tok]; }
#pragma unroll
    for (int s0 = 0; s0 < 8; s0 += 4) {
      uint2 yy[4][4];
#pragma unroll
      for (int s = 0; s < 4; ++s)
#pragma unroll
        for (int i = 0; i < 4; ++i) yy[s][i] = *(const uint2*)(Y + rows[s0 + s] * 1024 + lane * 4 + 256 * i);
#pragma unroll
      for (int s = 0; s < 4; ++s)
#pragma unroll
        for (int i = 0; i < 4; ++i) {
          const uint2 y = yy[s][i];
          v[i * 4] += bf2f((unsigned short)(y.x & 0xFFFF)); v[i * 4 + 1] += bf2f((unsigned short)(y.x >> 16));
          v[i * 4 + 2] += bf2f((unsigned short)(y.y & 0xFFFF)); v[i * 4 + 3] += bf2f((unsigned short)(y.y >> 16));
        }
    }
    wave_ln(v, p.in[I_LN2_G] + LAYER * 1024, p.in[I_LN2_B] + LAYER * 1024, lane);
#pragma unroll
    for (int i = 0; i < 4; ++i) st4(OUT + tok * 1024 + lane * 4 + 256 * i, make_float4(v[i * 4], v[i * 4 + 1], v[i * 4 + 2], v[i * 4 + 3]));
    if (LAYER == 0) {
      unsigned short* X2B = (unsigned short*)(p.ws + OFF_X2B);
#pragma unroll
      for (int i = 0; i < 4; ++i) *(uint2*)(X2B + tok * 1024 + lane * 4 + 256 * i) = make_uint2(pk2(v[i * 4], v[i * 4 + 1]), pk2(v[i * 4 + 2], v[i * 4 + 3]));
    }
  }
}

DEV float shifted(const float* Hc, size_t tok, int col, const float* mu) {
  const float cur = Hc[tok * 1792 + col];
  const float prev = (tok % SEQ_LEN) == 0 ? 0.f : Hc[(tok - 1) * 1792 + col];
  return cur + (prev - cur) * mu[col];
}

#define RWP_T 32
#define P11_PREP_ITEMS (NTOK / RWP_T)
#define P11_KV_ITEMS (BATCH * 4 * RET_NC)
#define P11_SMEM (RWP_T * 128 * 4)
DEV void p11_prep(const Params& p, int item, char* smem) {
  const int tid = TIDX;
  const float* Hc = (const float*)(p.ws + OFF_H);
  const float* mu = p.in[I_RW_MU];
  float* sl = (float*)smem;
  __syncthreads();
  for (int w = tid; w < RWP_T * 128; w += NTHREADS) {
    const int tt = w >> 7, j = w & 127;
    const size_t tok = (size_t)item * RWP_T + tt;
    const float v = shifted(Hc, tok, 1536 + j, mu);
    sl[w] = j < 64 ? tanhf(v) : v;
    ((float*)(p.ws + OFF_GLO))[tok * 128 + j] = sigmoidf_(shifted(Hc, tok, 1664 + j, mu));
  }
  __syncthreads();
  float* RWW = (float*)(p.ws + OFF_RWW); float* RWK = (float*)(p.ws + OFF_RWK);
  float* RWKK = (float*)(p.ws + OFF_RWKK); float* RWA = (float*)(p.ws + OFF_RWA);
  float* RWR = p.out + (size_t)NTOK * 512; float* RWV = p.out;
  const float* w_up = p.in[I_RW_W_UP]; const float* a_up = p.in[I_RW_A_UP];
#pragma unroll
  for (int cc = 0; cc < 2; ++cc) {
    const int c = tid + 256 * cc;
    float aw[RWP_T], aa[RWP_T];
#pragma unroll
    for (int tt = 0; tt < RWP_T; ++tt) { aw[tt] = 0.f; aa[tt] = 0.f; }
    for (int j0 = 0; j0 < 64; j0 += 16) {
      float wu[16], au[16];
#pragma unroll
      for (int q = 0; q < 16; ++q) { wu[q] = w_up[(j0 + q) * 512 + c]; au[q] = a_up[(j0 + q) * 512 + c]; }
#pragma unroll
      for (int q4 = 0; q4 < 4; ++q4) {
#pragma unroll
        for (int tt = 0; tt < RWP_T; ++tt) {
          const float4 sw = ld4(sl + tt * 128 + j0 + q4 * 4), sa = ld4(sl + tt * 128 + 64 + j0 + q4 * 4);
          aw[tt] += sw.x * wu[q4 * 4] + sw.y * wu[q4 * 4 + 1] + sw.z * wu[q4 * 4 + 2] + sw.w * wu[q4 * 4 + 3];
          aa[tt] += sa.x * au[q4 * 4] + sa.y * au[q4 * 4 + 1] + sa.z * au[q4 * 4 + 2] + sa.w * au[q4 * 4 + 3];
        }
      }
    }
    const float w0 = p.in[I_RW_W0][c], a0 = p.in[I_RW_A0][c], kkc = p.in[I_RW_K_K][c], kac = p.in[I_RW_K_A][c];
#pragma unroll 4
    for (int tt = 0; tt < RWP_T; ++tt) {
      const size_t tok = (size_t)item * RWP_T + tt;
      const float lw = w0 + aw[tt];
      const float nl = -lw;
      const float sp = nl > 20.f ? nl : log1pf(expf(nl));
      const float wl = -sp - 0.5f;
      const float decay = expf(-expf(wl));
      const float a = 1.f / (1.f + expf(-(a0 + aa[tt])));
      const float rs = shifted(Hc, tok, c, mu);
      const float ks = shifted(Hc, tok, 512 + c, mu);
      const float vs = shifted(Hc, tok, 1024 + c, mu);
      float kk = ks * kkc;
      const float nrm = sqrtf(wave_sum(kk * kk));
      kk = kk / fmaxf(nrm, 1e-12f);
      RWW[tok * 512 + c] = decay;
      RWK[tok * 512 + c] = ks * (1.f + (a - 1.f) * kac);
      RWKK[tok * 512 + c] = kk;
      RWA[tok * 512 + c] = kk * a;
      RWR[tok * 512 + c] = rs;
      RWV[tok * 512 + c] = vs;
    }
  }
}
DEV float ret_log2gamma(int h) { return log2f(1.f - exp2f(-5.f - (float)h)); }
struct KvSmem { unsigned short vt[128][72]; unsigned short kt[64][72]; };
#define P11_KV_SMEM ((int)sizeof(KvSmem))
DEV void p11_kv(const Params& p, int item, char* smem) {
  KvSmem* sm = (KvSmem*)smem;
  const int c = item % RET_NC, h = (item / RET_NC) & 3, b = item / (RET_NC * 4);
  const int tid = TIDX, lane = tid & 63, wave = tid >> 6;
  const int r = lane & 31, hh = lane >> 5;
  const float* H2 = (const float*)(p.ws + OFF_H2);
  const float lg = ret_log2gamma(h);
  const size_t tok0 = (size_t)b * SEQ_LEN + c * 128;
  f32x16 acc[2];
#pragma unroll
  for (int nt = 0; nt < 2; ++nt)
#pragma unroll
    for (int i = 0; i < 16; ++i) acc[nt][i] = 0.f;
#pragma unroll 1
  for (int kt = 0; kt < 2; ++kt) {
    __syncthreads();
#pragma unroll
    for (int q = 0; q < 8; ++q) {
      const int f = tid + 256 * q;
      const int key = f >> 5, d4 = (f & 31) * 4;
      const float dec = exp2f((float)(127 - (kt * 64 + key)) * lg);
      const float4 v = ld4(H2 + (tok0 + kt * 64 + key) * 1536 + 512 + h * 128 + d4);
      sm->vt[d4][key] = f2bf(v.x * dec); sm->vt[d4 + 1][key] = f2bf(v.y * dec);
      sm->vt[d4 + 2][key] = f2bf(v.z * dec); sm->vt[d4 + 3][key] = f2bf(v.w * dec);
    }
#pragma unroll
    for (int q = 0; q < 4; ++q) {
      const int f = tid + 256 * q;
      const int key = f >> 4, d4 = (f & 15) * 4;
      const float4 v = ld4(H2 + (tok0 + kt * 64 + key) * 1536 + 256 + h * 64 + d4);
      sm->kt[d4][key] = f2bf(v.x); sm->kt[d4 + 1][key] = f2bf(v.y); sm->kt[d4 + 2][key] = f2bf(v.z); sm->kt[d4 + 3][key] = f2bf(v.w);
    }
    __syncthreads();
#pragma unroll
    for (int ks = 0; ks < 4; ++ks) {
      const bf16x8 a = *(const bf16x8*)&sm->vt[wave * 32 + r][ks * 16 + hh * 8];
#pragma unroll
      for (int nt = 0; nt < 2; ++nt) {
        const bf16x8 bb = *(const bf16x8*)&sm->kt[nt * 32 + r][ks * 16 + hh * 8];
        acc[nt] = __builtin_amdgcn_mfma_f32_32x32x16_bf16(a, bb, acc[nt], 0, 0, 0);
      }
    }
  }
  float* KV = (float*)(p.ws + OFF_RETKV) + (size_t)item * 64 * 128;
#pragma unroll
  for (int nt = 0; nt < 2; ++nt)
#pragma unroll
    for (int g4 = 0; g4 < 4; ++g4)
      st4(KV + (nt * 32 + r) * 128 + wave * 32 + 8 * g4 + 4 * hh,
          make_float4(acc[nt][4 * g4], acc[nt][4 * g4 + 1], acc[nt][4 * g4 + 2], acc[nt][4 * g4 + 3]));
}
DEV void phase_p11(const Params& p, char* smem) {
  {
    unsigned* RKF = (unsigned*)(p.ws + OFF_RKF);
    for (int i = BIDX * NTHREADS + TIDX; i < BATCH * 8 * (SEQ_LEN / 32); i += gridDim.x * NTHREADS) RKF[i] = 0u;
  }
  const int total = P11_PREP_ITEMS + P11_KV_ITEMS;
  for (int it = BIDX; it < total; it += gridDim.x) {
    if (it < P11_KV_ITEMS) p11_kv(p, it, smem);
    else p11_prep(p, it - P11_KV_ITEMS, smem);
  }
}

#define RK_T 32
#define RK_NCH (SEQ_LEN / RK_T)
#define RK_NCHT (BATCH * 8 * RK_NCH)
#define OFF_RKPT OFF_H
#define OFF_RKKT (OFF_RKPT + (size_t)RK_NCHT * 64 * 64 * 2)
#define OFF_RKVT (OFF_RKKT + (size_t)RK_NCHT * 64 * 32 * 2)
#define OFF_RKRT (OFF_RKVT + (size_t)RK_NCHT * 64 * 32 * 2)
#define OFF_RKAT (OFF_RKRT + (size_t)RK_NCHT * 32 * 64 * 2)
#define OFF_RKEND (OFF_RKAT + (size_t)RK_NCHT * 32 * 32 * 2)
static_assert(OFF_RKEND <= OFF_H2, "rk buffers must fit in the H1 region");
#define RKPRE_SMEM ((4 * 32 * 64 + 32 * 64) * 4)

DEV unsigned short* rksc_row(char* ws, int b, int h, int c, int i) {
  return (unsigned short*)(ws + OFF_RWW) + (((size_t)b * SEQ_LEN + (size_t)c * RK_T + (i >> 1)) * 512 + h * 64) * 2 + (i & 1) * 64;
}
#if RK_MERGED
DEV void st_wt_u16(unsigned short* q, unsigned short v) { asm volatile("global_store_short %0, %1, off sc1" :: "v"(q), "v"((unsigned)v) : "memory"); }
typedef unsigned u32x4_t __attribute__((ext_vector_type(4)));
DEV void st_wt_b128(void* q, uint4 v) { const u32x4_t w = {v.x, v.y, v.z, v.w}; asm volatile("global_store_dwordx4 %0, %1, off sc1" :: "v"(q), "v"(w) : "memory"); }
#else
DEV void st_wt_u16(unsigned short* q, unsigned short v) { *q = v; }
DEV void st_wt_b128(void* q, uint4 v) { *(uint4*)q = v; }
#endif
DEV void rk_precompute(const Params& p, int ch, char* smem) {
  const int c = ch % RK_NCH, bh = ch / RK_NCH, h = bh & 7, b = bh >> 3;
  const int tid = TIDX, lane = tid & 63, wave = tid >> 6;
  const size_t tok0 = (size_t)b * SEQ_LEN + (size_t)c * RK_T;
  const float* RWW = (const float*)(p.ws + OFF_RWW); const float* RWK = (const float*)(p.ws + OFF_RWK);
  const float* RWKK = (const float*)(p.ws + OFF_RWKK); const float* RWA = (const float*)(p.ws + OFF_RWA);
  const float* RWR = p.out + (size_t)NTOK * 512; const float* RWV = p.out;
  float* sW = (float*)smem;
  float* sNK = sW + 32 * 64;
  float* sKA = sNK + 32 * 64;
  float* sR = sKA + 32 * 64;
  float* sV = sR + 32 * 64;
  __syncthreads();
  for (int w = tid; w < 32 * 16; w += NTHREADS) {
    const int t = w >> 4, c4 = (w & 15) * 4;
    const size_t o = (tok0 + t) * 512 + h * 64 + c4;
    st4(sW + t * 64 + c4, ld4(RWW + o));
    const float4 kk = ld4(RWKK + o);
    st4(sNK + t * 64 + c4, make_float4(-kk.x, -kk.y, -kk.z, -kk.w));
    st4(sKA + t * 64 + c4, ld4(RWA + o));
    st4(sR + t * 64 + c4, ld4(RWR + o));
    st4(sV + t * 64 + c4, ld4(RWV + o));
  }
  __syncthreads();
  const int wrole = (wave + ((BIDX >= (gridDim.x >> 1)) ? 2 : 0)) & 3;
  if (wrole == 0) {
    float z[64];
#pragma unroll
    for (int j = 0; j < 64; ++j) z[j] = (j == lane) ? 1.f : 0.f;
    for (int t = 0; t < RK_T; ++t) {
      float cacc = 0.f;
#pragma unroll
      for (int j4 = 0; j4 < 16; ++j4) {
        const float4 u = ld4(sNK + t * 64 + j4 * 4);
        cacc += z[j4 * 4] * u.x + z[j4 * 4 + 1] * u.y + z[j4 * 4 + 2] * u.z + z[j4 * 4 + 3] * u.w;
      }
#pragma unroll
      for (int j4 = 0; j4 < 16; ++j4) {
        const float4 w = ld4(sW + t * 64 + j4 * 4), v = ld4(sKA + t * 64 + j4 * 4);
        z[j4 * 4] = z[j4 * 4] * w.x + cacc * v.x; z[j4 * 4 + 1] = z[j4 * 4 + 1] * w.y + cacc * v.y;
        z[j4 * 4 + 2] = z[j4 * 4 + 2] * w.z + cacc * v.z; z[j4 * 4 + 3] = z[j4 * 4 + 3] * w.w + cacc * v.w;
      }
    }
    unsigned short* PT = (unsigned short*)(p.ws + OFF_RKPT) + (size_t)ch * 64 * 64;
#pragma unroll
    for (int j = 0; j < 64; ++j) st_wt_u16(PT + j * 64 + lane, f2bf(z[j]));
  } else if (wrole == 1) {
    const bool isA = lane < 32;
    const int me = lane & 31;
    float q[64];
    {
      const float* src = (isA ? RWK : RWR) + (tok0 + me) * 512 + h * 64;
#pragma unroll
      for (int j4 = 0; j4 < 16; ++j4) { const float4 v = ld4(src + j4 * 4); q[j4 * 4] = v.x; q[j4 * 4 + 1] = v.y; q[j4 * 4 + 2] = v.z; q[j4 * 4 + 3] = v.w; }
    }
    const float* Ub = isA ? sNK : sKA;
    const float* Vb = isA ? sKA : sNK;
    unsigned short* AT = (unsigned short*)(p.ws + OFF_RKAT) + (size_t)ch * 32 * 32;
    for (int u = 0; u < RK_T; ++u) {
      const int tt = isA ? u : RK_T - 1 - u;
      const bool upd = isA ? (u > me) : (tt <= me);
      if (upd) {
        float cacc = 0.f;
#pragma unroll
        for (int j4 = 0; j4 < 16; ++j4) {
          const float4 uu = ld4(Ub + tt * 64 + j4 * 4);
          cacc += q[j4 * 4] * uu.x + q[j4 * 4 + 1] * uu.y + q[j4 * 4 + 2] * uu.z + q[j4 * 4 + 3] * uu.w;
        }
#pragma unroll
        for (int j4 = 0; j4 < 16; ++j4) {
          const float4 w = ld4(sW + tt * 64 + j4 * 4), v = ld4(Vb + tt * 64 + j4 * 4);
          q[j4 * 4] = q[j4 * 4] * w.x + cacc * v.x; q[j4 * 4 + 1] = q[j4 * 4 + 1] * w.y + cacc * v.y;
          q[j4 * 4 + 2] = q[j4 * 4 + 2] * w.z + cacc * v.z; q[j4 * 4 + 3] = q[j4 * 4 + 3] * w.w + cacc * v.w;
        }
      }
      if (isA) {
        float av = 0.f;
        if (u >= me) {
#pragma unroll
          for (int j4 = 0; j4 < 16; ++j4) {
            const float4 rr = ld4(sR + u * 64 + j4 * 4);
            av += q[j4 * 4] * rr.x + q[j4 * 4 + 1] * rr.y + q[j4 * 4 + 2] * rr.z + q[j4 * 4 + 3] * rr.w;
          }
        }
        AT[u * 32 + me] = f2bf(av);
      }
    }
    if (isA) {
      unsigned short* KT = (unsigned short*)(p.ws + OFF_RKKT) + (size_t)ch * 64 * 32;
#pragma unroll
      for (int j = 0; j < 64; ++j) st_wt_u16(KT + j * 32 + me, f2bf(q[j]));
    } else {
      unsigned short* RT = (unsigned short*)(p.ws + OFF_RKRT) + ((size_t)ch * 32 + me) * 64;
#pragma unroll
      for (int j8 = 0; j8 < 8; ++j8)
        *(uint4*)(RT + j8 * 8) = make_uint4(pk2(q[j8 * 8], q[j8 * 8 + 1]), pk2(q[j8 * 8 + 2], q[j8 * 8 + 3]), pk2(q[j8 * 8 + 4], q[j8 * 8 + 5]), pk2(q[j8 * 8 + 6], q[j8 * 8 + 7]));
    }
  } else if (wrole == 2) {
    unsigned short* VT = (unsigned short*)(p.ws + OFF_RKVT) + (size_t)ch * 64 * 32;
#pragma unroll
    for (int t8 = 0; t8 < 4; ++t8) {
      float v[8];
#pragma unroll
      for (int q8 = 0; q8 < 8; ++q8) v[q8] = sV[(t8 * 8 + q8) * 64 + lane];
      st_wt_b128(VT + lane * 32 + t8 * 8, make_uint4(pk2(v[0], v[1]), pk2(v[2], v[3]), pk2(v[4], v[5]), pk2(v[6], v[7])));
    }
  }
#if RK_MERGED
  asm volatile("s_waitcnt vmcnt(0)" ::: "memory");
  __syncthreads();
  if (tid == 0) __hip_atomic_store((unsigned*)(p.ws + OFF_RKF) + ch, 1u, __ATOMIC_RELAXED, __HIP_MEMORY_SCOPE_AGENT);
#endif
}
DEV void phase_retpfx(const Params& p, char* smem);
DEV void phase_rkpre(const Params& p, char* smem) {
  phase_retpfx(p, smem);
  for (int it = BIDX; it < RK_NCHT; it += gridDim.x) rk_precompute(p, (it % (BATCH * 8)) * RK_NCH + it / (BATCH * 8), smem);
}

DEV bf16x8 ld_frag2(const unsigned short* p0, const unsigned short* p1) {
  const uint2 lo = *(const uint2*)p0, hi = *(const uint2*)p1;
  union { uint4 u; bf16x8 v; } x;
  x.u = make_uint4(lo.x, lo.y, hi.x, hi.y);
  return x.v;
}
DEV bf16x8 ld_frag(const unsigned short* p0) {
  union { uint4 u; bf16x8 v; } x;
  x.u = *(const uint4*)p0;
  return x.v;
}
DEV unsigned rk_flag_ld(const unsigned* f) {
#if RK_MERGED
  return __hip_atomic_load(f, __ATOMIC_RELAXED, __HIP_MEMORY_SCOPE_AGENT);
#else
  return 1u;
#endif
}
DEV void rk_flag_wait(const unsigned* f, unsigned flv) {
#if RK_MERGED
  asm volatile("" : "+v"(flv));
  unsigned fl = (unsigned)__builtin_amdgcn_readfirstlane((int)flv);
  unsigned sp = 0;
  while (fl == 0u) {
    __builtin_amdgcn_s_sleep(1);
    fl = (unsigned)__builtin_amdgcn_readfirstlane((int)__hip_atomic_load(f, __ATOMIC_RELAXED, __HIP_MEMORY_SCOPE_AGENT));
    if (++sp > (1u << 21)) break;
  }
  asm volatile("buffer_inv sc1" ::: "memory");
#endif
}
#define RK_PREFETCH(S, c_)                                                                                                      \
  {                                                                                                                             \
    const size_t chp_ = (size_t)bh * RK_NCH + (c_);                                                                             \
    _Pragma("unroll") for (int jt = 0; jt < 2; ++jt) _Pragma("unroll") for (int kb = 0; kb < 2; ++kb)                          \
        _Pragma("unroll") for (int s_ = 0; s_ < 2; ++s_) {                                                                      \
      const unsigned short* q0 = PTb + (chp_ * 64 + jt * 32 + r) * 64 + kb * 32 + 16 * s_ + 4 * hh;                             \
      pa##S[jt][kb][s_] = ld_frag2(q0, q0 + 8);                                                                                 \
    }                                                                                                                           \
    _Pragma("unroll") for (int jt = 0; jt < 2; ++jt) _Pragma("unroll") for (int ks = 0; ks < 2; ++ks)                          \
        ka##S[jt][ks] = ld_frag(KTb + (chp_ * 64 + jt * 32 + r) * 32 + 16 * ks + 8 * hh);                                       \
    _Pragma("unroll") for (int ks = 0; ks < 2; ++ks) vb##S[ks] = ld_frag(VTb + (chp_ * 64 + it * 32 + r) * 32 + 16 * ks + 8 * hh); \
  }
#define RK_STEP(S, c_)                                                                                                          \
  {                                                                                                                             \
    unsigned short* scr_ = rksc_row(p.ws, bh >> 3, bh & 7, (c_), it * 32 + r);                                                  \
    _Pragma("unroll") for (int kb = 0; kb < 2; ++kb) _Pragma("unroll") for (int g4 = 0; g4 < 4; ++g4)                          \
        *(uint2*)(scr_ + kb * 32 + 8 * g4 + 4 * hh) =                                                                           \
            make_uint2(pk2(X[kb][4 * g4], X[kb][4 * g4 + 1]), pk2(X[kb][4 * g4 + 2], X[kb][4 * g4 + 3]));                       \
    bf16x8 bh_[2][2], bl_[2][2];                                                                                                \
    _Pragma("unroll") for (int kb = 0; kb < 2; ++kb) _Pragma("unroll") for (int s_ = 0; s_ < 2; ++s_) {                        \
      union { uint4 u; bf16x8 v; } hi, lo;                                                                                      \
      unsigned hw[4], lw[4];                                                                                                    \
      _Pragma("unroll") for (int q2 = 0; q2 < 4; ++q2) {                                                                        \
        const float x0 = X[kb][8 * s_ + 2 * q2], x1 = X[kb][8 * s_ + 2 * q2 + 1];                                               \
        const unsigned hp = pk2(x0, x1);                                                                                        \
        hw[q2] = hp;                                                                                                            \
        lw[q2] = pk2(x0 - bf2f((unsigned short)(hp & 0xFFFF)), x1 - bf2f((unsigned short)(hp >> 16)));                          \
      }                                                                                                                         \
      hi.u = make_uint4(hw[0], hw[1], hw[2], hw[3]); lo.u = make_uint4(lw[0], lw[1], lw[2], lw[3]);                             \
      bh_[kb][s_] = hi.v; bl_[kb][s_] = lo.v;                                                                                   \
    }                                                                                                                           \
    f32x16 acc[2];                                                                                                              \
    _Pragma("unroll") for (int jt = 0; jt < 2; ++jt) {                                                                          \
      _Pragma("unroll") for (int i = 0; i < 16; ++i) acc[jt][i] = 0.f;                                                          \
      _Pragma("unroll") for (int kb = 0; kb < 2; ++kb) _Pragma("unroll") for (int s_ = 0; s_ < 2; ++s_) {                      \
        acc[jt] = __builtin_amdgcn_mfma_f32_32x32x16_bf16(pa##S[jt][kb][s_], bh_[kb][s_], acc[jt], 0, 0, 0);                    \
        acc[jt] = __builtin_amdgcn_mfma_f32_32x32x16_bf16(pa##S[jt][kb][s_], bl_[kb][s_], acc[jt], 0, 0, 0);                    \
      }                                                                                                                         \
      _Pragma("unroll") for (int ks = 0; ks < 2; ++ks)                                                                          \
          acc[jt] = __builtin_amdgcn_mfma_f32_32x32x16_bf16(ka##S[jt][ks], vb##S[ks], acc[jt], 0, 0, 0);                        \
    }                                                                                                                           \
    if ((c_) + 2 < RK_NCH) {                                                                                                    \
      rk_flag_wait(RKFb + (c_) + 2, fl##S);                                                                                     \
      fl##S = rk_flag_ld(RKFb + ((c_) + 4 < RK_NCH ? (c_) + 4 : RK_NCH - 1));          \
      RK_PREFETCH(S, (c_) + 2);                                                                                                 \
    }                                                                                                                           \
    X[0] = acc[0]; X[1] = acc[1];                                                                                               \
  }
DEV void rk_chain(const Params& p, int bh) {
  const int tid = TIDX, lane = tid & 63, wave = tid >> 6;
  if (wave >= 2) return;
  const int r = lane & 31, hh = lane >> 5, it = wave;
  const unsigned short* PTb = (const unsigned short*)(p.ws + OFF_RKPT);
  const unsigned short* KTb = (const unsigned short*)(p.ws + OFF_RKKT);
  const unsigned short* VTb = (const unsigned short*)(p.ws + OFF_RKVT);
  const unsigned* RKFb = (const unsigned*)(p.ws + OFF_RKF) + (size_t)bh * RK_NCH;
  f32x16 X[2];
#pragma unroll
  for (int kb = 0; kb < 2; ++kb)
#pragma unroll
    for (int i = 0; i < 16; ++i) X[kb][i] = 0.f;
  bf16x8 paA[2][2][2], kaA[2][2], vbA[2], paB[2][2][2], kaB[2][2], vbB[2];
  rk_flag_wait(RKFb, rk_flag_ld(RKFb));
  RK_PREFETCH(A, 0);
  rk_flag_wait(RKFb + 1, rk_flag_ld(RKFb + 1));
  RK_PREFETCH(B, 1);
  unsigned flA = rk_flag_ld(RKFb + 2), flB = rk_flag_ld(RKFb + 3);
  for (int c = 0; c < RK_NCH; c += 2) {
    RK_STEP(A, c);
    if (c + 1 < RK_NCH) RK_STEP(B, c + 1);
  }
}
DEV void rk_output(const Params& p, int item) {
  const int tid = TIDX, lane = tid & 63, wave = tid >> 6;
  const int ch = item * 4 + wave;
  const int c = ch % RK_NCH, bhh = ch / RK_NCH, h = bhh & 7, b = bhh >> 3;
  const int r = lane & 31, hh = lane >> 5;
  const unsigned short* RT = (const unsigned short*)(p.ws + OFF_RKRT) + (size_t)ch * 32 * 64;
  const unsigned short* AT = (const unsigned short*)(p.ws + OFF_RKAT) + (size_t)ch * 32 * 32;
  const unsigned short* VT = (const unsigned short*)(p.ws + OFF_RKVT) + (size_t)ch * 64 * 32;
  f32x16 acc[2];
#pragma unroll
  for (int i2 = 0; i2 < 2; ++i2)
#pragma unroll
    for (int i = 0; i < 16; ++i) acc[i2][i] = 0.f;
#pragma unroll
  for (int ks = 0; ks < 4; ++ks) {
    const bf16x8 a = ld_frag(RT + r * 64 + 16 * ks + 8 * hh);
#pragma unroll
    for (int i2 = 0; i2 < 2; ++i2) acc[i2] = __builtin_amdgcn_mfma_f32_32x32x16_bf16(a, ld_frag(rksc_row(p.ws, b, h, c, i2 * 32 + r) + 16 * ks + 8 * hh), acc[i2], 0, 0, 0);
  }
#pragma unroll
  for (int ks = 0; ks < 2; ++ks) {
    const bf16x8 a = ld_frag(AT + r * 32 + 16 * ks + 8 * hh);
#pragma unroll
    for (int i2 = 0; i2 < 2; ++i2) acc[i2] = __builtin_amdgcn_mfma_f32_32x32x16_bf16(a, ld_frag(VT + (i2 * 32 + r) * 32 + 16 * ks + 8 * hh), acc[i2], 0, 0, 0);
  }
  float* Yo = (float*)(p.ws + OFF_MIX);
  const size_t tok0 = (size_t)b * SEQ_LEN + (size_t)c * RK_T;
#pragma unroll
  for (int i2 = 0; i2 < 2; ++i2)
#pragma unroll
    for (int i = 0; i < 16; ++i) {
      const int t = (i & 3) + 8 * (i >> 2) + 4 * hh;
      Yo[(tok0 + t) * 1024 + h * 64 + i2 * 32 + r] = acc[i2][i];
    }
}
#define OFF_RWG OFF_RWKK
DEV void phase_rkout(const Params& p, char* smem) {
  {
    const float* GLO = (const float*)(p.ws + OFF_GLO);
    const float* g_up = p.in[I_RW_G_UP];
    float* G = (float*)(p.ws + OFF_RWG);
    for (int t = BIDX; t < (NTOK / GEMM_BM) * 4; t += gridDim.x) {
      const int m0 = (t >> 2) * GEMM_BM, n0 = (t & 3) * 128;
      gemm_tile<false>(
          [&](int r) { return (const void*)(GLO + (size_t)(m0 + r) * 128); },
          [&](int c) { return g_up + n0 + c; }, 512, 128,
          [&](int row, int col, float v0, float v1) {
            const size_t o = (size_t)(m0 + row) * 512 + n0 + col;
            G[o] = v0; G[o + 32] = v1;
          },
          smem);
    }
  }
  for (int it = BIDX; it < RK_NCHT / 4; it += gridDim.x) rk_output(p, it);
}

#define P12_SCAN_ITEMS (BATCH * 8 * 4)
#define P12_RET_ITEMS (BATCH * 4 * RET_NC)
#define P12_SCAN_SMEM ((2 * (16 * 5 * 64 + 16 * 16) + 16 * 16) * 4)
#define P12_RET_SMEM ((64 * 72 + 2 * 64 * 68) * 2)
#define P12_SMEM (P12_SCAN_SMEM > P12_RET_SMEM ? P12_SCAN_SMEM : P12_RET_SMEM)
DEV float sum16(float v) {
#ifdef CPU_EMU
  return emu_sum16(v);
#else
  int x;
  x = __builtin_amdgcn_update_dpp(0, __builtin_bit_cast(int, v), 0xB1, 0xF, 0xF, false); v += __builtin_bit_cast(float, x);
  x = __builtin_amdgcn_update_dpp(0, __builtin_bit_cast(int, v), 0x4E, 0xF, 0xF, false); v += __builtin_bit_cast(float, x);
  x = __builtin_amdgcn_update_dpp(0, __builtin_bit_cast(int, v), 0x141, 0xF, 0xF, false); v += __builtin_bit_cast(float, x);
  x = __builtin_amdgcn_update_dpp(0, __builtin_bit_cast(int, v), 0x140, 0xF, 0xF, false); v += __builtin_bit_cast(float, x);
  return v;
#endif
}
DEV void p12_scan(const Params& p, int item, char* smem) {
  const int rq = item & 3, h = (item >> 2) & 7, b = item >> 5;
  const int tid = TIDX, rl = tid >> 4, cg = tid & 15;
  const float* ARR[5] = {(const float*)(p.ws + OFF_RWW), (const float*)(p.ws + OFF_RWK), (const float*)(p.ws + OFF_RWKK),
                         (const float*)(p.ws + OFF_RWA), p.out + (size_t)NTOK * 512};
  const float* RWV = p.out;
  float* Yo = (float*)(p.ws + OFF_MIX);
  float* buf = (float*)smem;
  float* vbuf = buf + 2 * 16 * 5 * 64;
  float* ybuf = vbuf + 2 * 16 * 16;
  float S[4] = {0.f, 0.f, 0.f, 0.f};
  float4 rg[5]; float rv;
  const int lstep = tid >> 4, lc4 = tid & 15;
  auto gload = [&](int c) {
    const size_t o = ((size_t)b * SEQ_LEN + c * 16 + lstep) * 512 + h * 64;
#pragma unroll
    for (int a = 0; a < 5; ++a) rg[a] = ld4(ARR[a] + o + lc4 * 4);
    rv = RWV[o + rq * 16 + lc4];
  };
  auto sstore = [&](int bi) {
#pragma unroll
    for (int a = 0; a < 5; ++a) st4(buf + ((bi * 16 + lstep) * 5 + a) * 64 + lc4 * 4, rg[a]);
    vbuf[(bi * 16 + lstep) * 16 + lc4] = rv;
  };
  __syncthreads();
  gload(0);
  sstore(0);
  __syncthreads();
  const int NCH = SEQ_LEN / 16;
  for (int c = 0; c < NCH; ++c) {
    if (c + 1 < NCH) gload(c + 1);
    const float* cb = buf + (c & 1) * 16 * 5 * 64;
    const float* cv = vbuf + (c & 1) * 16 * 16;
    float4 cw = ld4(cb + 0 * 64 + cg * 4), ck = ld4(cb + 1 * 64 + cg * 4), ckk = ld4(cb + 2 * 64 + cg * 4),
           cka = ld4(cb + 3 * 64 + cg * 4), cr = ld4(cb + 4 * 64 + cg * 4);
    float cvv = cv[rl];
#pragma unroll
    for (int s = 0; s < 16; ++s) {
      const float4 w = cw, k = ck, kk = ckk, ka = cka, r = cr;
      const float v = cvv;
      if (s < 15) {
        cw = ld4(cb + ((s + 1) * 5 + 0) * 64 + cg * 4); ck = ld4(cb + ((s + 1) * 5 + 1) * 64 + cg * 4);
        ckk = ld4(cb + ((s + 1) * 5 + 2) * 64 + cg * 4); cka = ld4(cb + ((s + 1) * 5 + 3) * 64 + cg * 4);
        cr = ld4(cb + ((s + 1) * 5 + 4) * 64 + cg * 4); cvv = cv[(s + 1) * 16 + rl];
      }
      float sa = (S[0] * kk.x + S[1] * kk.y) + (S[2] * kk.z + S[3] * kk.w);
      sa = -sum16(sa);
      S[0] = S[0] * w.x + (sa * ka.x + v * k.x);
      S[1] = S[1] * w.y + (sa * ka.y + v * k.y);
      S[2] = S[2] * w.z + (sa * ka.z + v * k.z);
      S[3] = S[3] * w.w + (sa * ka.w + v * k.w);
      float y = (S[0] * r.x + S[1] * r.y) + (S[2] * r.z + S[3] * r.w);
      y = sum16(y);
      if (cg == 0) ybuf[s * 16 + rl] = y;
      asm volatile("" ::: "memory");
    }
    __syncthreads();
    if (c + 1 < NCH) sstore((c + 1) & 1);
    Yo[((size_t)b * SEQ_LEN + c * 16 + lstep) * 1024 + h * 64 + rq * 16 + lc4] = ybuf[lstep * 16 + lc4];
    __syncthreads();
  }
}
struct RetSmem { unsigned short k[64][72]; unsigned short vt[2][64][68]; };
#define RETPFX_ITEMS (BATCH * 4 * 64 * 128 / NTHREADS)
DEV void ret_prefix(const Params& p, int item) {
  const int gi = item * NTHREADS + TIDX;
  const int bh4 = gi >> 13, idx = gi & 8191;
  const float G = exp2f(128.f * ret_log2gamma(bh4 & 3));
  float* KV = (float*)(p.ws + OFF_RETKV) + (size_t)bh4 * RET_NC * 8192 + idx;
  float st = 0.f;
  int c = 0;
  for (; c + 8 <= RET_NC; c += 8) {
    float e[8];
#pragma unroll
    for (int q = 0; q < 8; ++q) e[q] = KV[(size_t)(c + q) * 8192];
#pragma unroll
    for (int q = 0; q < 8; ++q) { KV[(size_t)(c + q) * 8192] = st; st = st * G + e[q]; }
  }
  for (; c < RET_NC; ++c) { const float e = KV[(size_t)c * 8192]; KV[(size_t)c * 8192] = st; st = st * G + e; }
}
DEV void phase_retpfx(const Params& p, char* smem) {
  for (int it = BIDX; it < RETPFX_ITEMS; it += gridDim.x) ret_prefix(p, it);
}
DEV void p12_ret(const Params& p, int item, char* smem) {
  RetSmem* sm = (RetSmem*)smem;
  const int c = item % RET_NC, h = (item / RET_NC) & 3, b = item / (RET_NC * 4);
  const int tid = TIDX, lane = tid & 63, wave = tid >> 6;
  const int cidx = lane & 31, hh = lane >> 5;
  const int qi = wave * 32 + cidx;
  const float* H2 = (const float*)(p.ws + OFF_H2);
  const float lg = ret_log2gamma(h);
  const size_t tok0 = (size_t)b * SEQ_LEN + c * 128;
  bf16x8 qf[4], qfs[4];
  {
    const float* qr = H2 + (tok0 + qi) * 1536 + h * 64;
    const float qs = exp2f((float)(qi + 1) * lg);
#pragma unroll
    for (int ks = 0; ks < 4; ++ks) {
      const float4 a0 = ld4(qr + ks * 16 + hh * 8), a1 = ld4(qr + ks * 16 + hh * 8 + 4);
      const float v[8] = {a0.x, a0.y, a0.z, a0.w, a1.x, a1.y, a1.z, a1.w};
#pragma unroll
      for (int j = 0; j < 8; ++j) { qf[ks][j] = (short)f2bf(v[j]); qfs[ks][j] = (short)f2bf(v[j] * qs); }
    }
  }
  f32x16 o[4], s[2];
#pragma unroll
  for (int mt = 0; mt < 4; ++mt)
#pragma unroll
    for (int i = 0; i < 16; ++i) o[mt][i] = 0.f;
  {
    const float* KV0 = (const float*)(p.ws + OFF_RETKV) + (size_t)((b * 4 + h) * RET_NC) * 64 * 128;
#pragma unroll
    for (int eh = 0; eh < 2; ++eh) {
      __syncthreads();
      {
        const int el = tid & 63, d0 = tid >> 6;
        float stv[16];
#pragma unroll
        for (int i = 0; i < 16; ++i) stv[i] = KV0[(size_t)c * 64 * 128 + (d0 + 4 * i) * 128 + eh * 64 + el];
#pragma unroll
        for (int i = 0; i < 16; ++i) sm->k[el][d0 + 4 * i] = f2bf(stv[i]);
      }
      __syncthreads();
      qk_tile(sm->k, qfs, s, lane);
#pragma unroll
      for (int i = 0; i < 16; ++i) { o[eh * 2][i] += s[0][i]; o[eh * 2 + 1][i] += s[1][i]; }
    }
  }
#pragma unroll 1
  for (int kt = 0; kt < 2; ++kt) {
    __syncthreads();
    {
      const int row = tid >> 2, seg = tid & 3;
      const float* kr = H2 + (tok0 + kt * 64 + row) * 1536 + 256 + h * 64 + seg * 16;
      const float4 a0 = ld4(kr), a1 = ld4(kr + 4), a2 = ld4(kr + 8), a3 = ld4(kr + 12);
      *(uint4*)&sm->k[row][seg * 16] = make_uint4(pk2(a0.x, a0.y), pk2(a0.z, a0.w), pk2(a1.x, a1.y), pk2(a1.z, a1.w));
      *(uint4*)&sm->k[row][seg * 16 + 8] = make_uint4(pk2(a2.x, a2.y), pk2(a2.z, a2.w), pk2(a3.x, a3.y), pk2(a3.z, a3.w));
#pragma unroll
      for (int q = 0; q < 8; ++q) {
        const int f = tid + 256 * q;
        const int key = f >> 5, d4 = (f & 31) * 4;
        const float4 v = ld4(H2 + (tok0 + kt * 64 + key) * 1536 + 512 + h * 128 + d4);
        unsigned short(*vt)[68] = sm->vt[d4 >> 6];
        const int dl = d4 & 63;
        vt[dl][key] = f2bf(v.x); vt[dl + 1][key] = f2bf(v.y); vt[dl + 2][key] = f2bf(v.z); vt[dl + 3][key] = f2bf(v.w);
      }
    }
    __syncthreads();
    if (kt * 64 <= wave * 32 + 31) {
      qk_tile(sm->k, qf, s, lane);
#pragma unroll
      for (int ks2 = 0; ks2 < 2; ++ks2)
#pragma unroll
        for (int i = 0; i < 16; ++i) {
          const int kj = kt * 64 + ks2 * 32 + (i & 3) + 8 * (i >> 2) + 4 * hh;
          s[ks2][i] = kj <= qi ? s[ks2][i] * exp2f((float)(qi - kj) * lg) : 0.f;
        }
      pv_tile(sm->vt[0], s, *(f32x16(*)[2])&o[0], lane);
      pv_tile(sm->vt[1], s, *(f32x16(*)[2])&o[2], lane);
    }
  }
  float s1 = 0.f;
#pragma unroll
  for (int mt = 0; mt < 4; ++mt)
#pragma unroll
    for (int i = 0; i < 16; ++i) s1 += o[mt][i];
  s1 += __shfl_xor(s1, 32);
  const float mu = s1 * (1.f / 128.f);
  float s2 = 0.f;
#pragma unroll
  for (int mt = 0; mt < 4; ++mt)
#pragma unroll
    for (int i = 0; i < 16; ++i) { const float d = o[mt][i] - mu; s2 += d * d; }
  s2 += __shfl_xor(s2, 32);
  const float rstd = rsqrtf(s2 * (1.f / 128.f) + 1e-5f);
  float* MIX = (float*)(p.ws + OFF_MIX);
  const float* gate = H2 + (tok0 + qi) * 1536 + 1024 + h * 128;
  float* dst = MIX + (tok0 + qi) * 1024 + 512 + h * 128;
  const float* lgam = p.in[I_RET_LN_G] + h * 128;
  const float* lbet = p.in[I_RET_LN_B] + h * 128;
#pragma unroll
  for (int mt = 0; mt < 4; ++mt)
#pragma unroll
    for (int g4 = 0; g4 < 4; ++g4) {
      const int dv = mt * 32 + 8 * g4 + 4 * hh;
      const float4 gv = ld4(lgam + dv), bv = ld4(lbet + dv), gt = ld4(gate + dv);
      float4 ov;
      ov.x = siluf_(gt.x) * ((o[mt][4 * g4] - mu) * rstd * gv.x + bv.x);
      ov.y = siluf_(gt.y) * ((o[mt][4 * g4 + 1] - mu) * rstd * gv.y + bv.y);
      ov.z = siluf_(gt.z) * ((o[mt][4 * g4 + 2] - mu) * rstd * gv.z + bv.z);
      ov.w = siluf_(gt.w) * ((o[mt][4 * g4 + 3] - mu) * rstd * gv.w + bv.w);
      st4(dst + dv, ov);
    }
}
DEV void phase_p12(const Params& p, char* smem) {
  const int G = gridDim.x;
  const int bid = BIDX;
  if (bid < BATCH * 8 && G > BATCH * 8) {
    rk_chain(p, bid);
  } else if (G >= 8 * BATCH * 8) {
    const int Gh = G >> 1, NC = BATCH * 8;
    if (bid >= Gh && bid < Gh + NC) return;
    const int w = bid - NC - (bid >= Gh ? NC : 0);
#if RK_MERGED
    if ((G & 15) == 0 && BATCH * 8 == 16) {
      const int x = bid & 7, m = bid >> 3;
      const int rank = m - 2 - (m >= (Gh >> 3) ? 2 : 0), nprod = (G >> 3) - 4;
      for (int k = rank; k < 2 * RK_NCH; k += nprod) rk_precompute(p, (x + 8 * (k & 1)) * RK_NCH + (k >> 1), smem);
    } else {
      for (int it = w; it < RK_NCHT; it += G - 2 * NC) rk_precompute(p, (it % NC) * RK_NCH + it / NC, smem);
    }
#endif
    for (int it = w; it < P12_RET_ITEMS; it += G - 2 * NC) p12_ret(p, it, smem);
  } else if (G > BATCH * 8) {
    for (int it = bid - BATCH * 8; it < P12_RET_ITEMS; it += G - BATCH * 8) p12_ret(p, it, smem);
  } else {
    for (int it = bid; it < BATCH * 8 + P12_RET_ITEMS; it += G) {
      if (it < BATCH * 8) rk_chain(p, it);
      else p12_ret(p, it - BATCH * 8, smem);
    }
  }
}

#define P13_SMEM (RWP_T * 128 * 4)
DEV void phase_p13(const Params& p, char* smem) {
  const int tid = TIDX;
  const float* Hc = (const float*)(p.ws + OFF_H);
  const float* mu = p.in[I_RW_MU];
  const float* GLO = (const float*)(p.ws + OFF_GLO);
  float* sl = (float*)smem;
  float* MIX = (float*)(p.ws + OFF_MIX);
  const float* RWK = (const float*)(p.ws + OFF_RWK); const float* RWR = p.out + (size_t)NTOK * 512; const float* RWV = p.out;
  const float* G = (const float*)(p.ws + OFF_RWG);
  for (int it = BIDX; it < NTOK / RWP_T; it += gridDim.x) {
#pragma unroll
    for (int cc = 0; cc < 2; ++cc) {
      const int c = tid + 256 * cc;
      const float lng = p.in[I_RW_LN_G][c], lnb = p.in[I_RW_LN_B][c], rk = p.in[I_RW_R_K][c];
#pragma unroll 4
      for (int tt = 0; tt < RWP_T; ++tt) {
        const size_t tok = (size_t)it * RWP_T + tt;
        const float y = MIX[tok * 1024 + c];
        const float m = wave_sum(y) * (1.f / 64.f);
        const float d = y - m;
        const float var = wave_sum(d * d) * (1.f / 64.f);
        const float yn = d * rsqrtf(var + 64e-5f) * lng + lnb;
        const float r = RWR[tok * 512 + c], k = RWK[tok * 512 + c], v = RWV[tok * 512 + c];
        const float bonus = wave_sum(r * k * rk) * v;
        MIX[tok * 1024 + c] = (yn + bonus) * G[tok * 512 + c];
      }
    }
  }
}

#define NPHASES 20
#define SMEM_BYTES 53248
DEV void run_phase(const Params& p, int ph, char* smem) {
  switch (ph) {
    case 0: phase_gemm_in<0>(p, smem); break;
    case 1: phase_p1(p, smem); break;
    case 2: phase_p2(p, smem); break;
    case 3: phase_glu(p, smem); break;
    case 4: phase_outproj<0>(p, smem); break;
    case 5: phase_ln_router<0>(p, smem); break;
    case 6: phase_lists_shup<0>(p, smem); break;
    case 7: phase_routed_up<0>(p, smem); break;
    case 8: phase_down<0>(p, smem); break;
    case 9: phase_combine<0>(p, smem); break;
    case 10: phase_gemm_in<1>(p, smem); break;
    case 11: phase_p11(p, smem); break;
    case 12: phase_p12(p, smem); break;
    case 13: phase_p13(p, smem); break;
    case 14: phase_outproj<1>(p, smem); break;
    case 15: phase_ln_router<1>(p, smem); break;
    case 16: phase_lists_shup<1>(p, smem); break;
    case 17: phase_routed_up<1>(p, smem); break;
    case 18: phase_down<1>(p, smem); break;
    case 19: phase_combine<1>(p, smem); break;
    case 20: phase_p1b(p, smem); break;
    case 21: phase_rkpre(p, smem); break;
    case 22: phase_rkout(p, smem); break;
    case 24: phase_retpfx(p, smem); break;
  }
}
static_assert(P1_SMEM <= SMEM_BYTES, "smem");
static_assert(P1_PREP_SMEM <= SMEM_BYTES, "smem");
static_assert(P2_SMEM <= SMEM_BYTES, "smem");
static_assert(P5_SMEM <= SMEM_BYTES, "smem");
static_assert(P7_SMEM <= SMEM_BYTES, "smem");
static_assert(P12_SMEM <= SMEM_BYTES, "smem");
static_assert(RKPRE_SMEM <= SMEM_BYTES, "smem");
static_assert(OFF_HS + (size_t)NTOK * 256 * 2 <= OFF_X1, "layout");

#ifndef CPU_EMU
template <int PH>
__global__ void __launch_bounds__(NTHREADS) phase_kernel(Params p) {
  __shared__ __attribute__((aligned(16))) char smem[SMEM_BYTES];
  run_phase(p, PH, smem);
}
template <int PH>
static void launch_phases(const Params& p, hipStream_t stream) {
  phase_kernel<PH><<<dim3(1024), dim3(NTHREADS), 0, stream>>>(p);
  if constexpr (PH + 1 < NPHASES) launch_phases<PH + 1>(p, stream);
}
#if MEGA
#define XB_TMO      128
#define XB_XCNT(j)  (256  + 64 * (j))
#define XB_XSUB(j)  (1280 + 64 * (j))
#define XB_XGEN(j)  (2304 + 64 * (j))
#define XB_TOP      3328
#define XB_TOPGEN   3392
#define XCD_BAR_WORDS 3456
#define XB_SPIN_CAP (1u << 18)
#define LAS __attribute__((address_space(3)))

__device__ __forceinline__ unsigned xb_ld(unsigned* p)              { return __hip_atomic_load(p, __ATOMIC_RELAXED, __HIP_MEMORY_SCOPE_AGENT); }
__device__ __forceinline__ unsigned xb_add(unsigned* p, unsigned v) { return __hip_atomic_fetch_add(p, v, __ATOMIC_RELAXED, __HIP_MEMORY_SCOPE_AGENT); }
__device__ __forceinline__ unsigned xb_xcc_id() { return (unsigned)__builtin_amdgcn_s_getreg((3 << 11) | 20) & 0xFu; }
#define XB_SPIN(cond, bar) do { unsigned _sp = 0; while (cond) { __builtin_amdgcn_s_sleep(1); \
    if ((++_sp & 255u) == 0u) { if (xb_ld(&(bar)[XB_TMO])) break; if (_sp > XB_SPIN_CAP) { atomicAdd(&(bar)[XB_TMO], 1u); break; } } } } while (0)

struct XcdBarrier {
    unsigned* bar; unsigned x;
    volatile LAS unsigned* st;
};

__device__ __forceinline__ XcdBarrier xcd_barrier_post(unsigned* bar, volatile LAS unsigned* st) {
    XcdBarrier b; b.bar = bar; b.x = xb_xcc_id(); b.st = st;
    if (threadIdx.x == 0) (void)xb_add(&bar[XB_XCNT(b.x)], 1u);
    return b;
}
__device__ __forceinline__ void xcd_barrier_complete(unsigned* bar, unsigned x, unsigned& nloc, unsigned& nx) {
    const unsigned G = gridDim.x * gridDim.y * gridDim.z;
    unsigned sum, cnt, mine, sp = 0u;
    for (;;) {
        sum = 0u; cnt = 0u; mine = 0u;
#pragma unroll
        for (unsigned j = 0; j < 16; ++j) { const unsigned c = xb_ld(&bar[XB_XCNT(j)]); sum += c; cnt += (c > 0u) ? 1u : 0u; mine = (j == x) ? c : mine; }
        if (sum == G) break;
        __builtin_amdgcn_s_sleep(1);
        if ((++sp & 255u) == 0u) { if (xb_ld(&bar[XB_TMO])) break; if (sp > XB_SPIN_CAP) { atomicAdd(&bar[XB_TMO], 1u); break; } }
    }
    nloc = mine > 0u ? mine : 1u; nx = cnt > 0u ? cnt : 1u;
}

__device__ __forceinline__ void xcd_barrier(const XcdBarrier& b) {
    asm volatile("s_waitcnt vmcnt(0)" ::: "memory");
    __syncthreads();
    if (threadIdx.x == 0) {
        unsigned* bar = b.bar;
        __builtin_amdgcn_s_waitcnt(0);
        unsigned nloc = b.st[0], nx = b.st[1];
        if (nloc == 0u) { xcd_barrier_complete(bar, b.x, nloc, nx); b.st[0] = nloc; b.st[1] = nx; }
        const unsigned old = xb_add(&bar[XB_XSUB(b.x)], 1u);
        const unsigned gen = old / nloc;
        if (old + 1u == (gen + 1u) * nloc) {
            __builtin_amdgcn_fence(__ATOMIC_RELEASE, "agent");
            asm volatile("s_waitcnt vmcnt(0)" ::: "memory");
            const unsigned og = xb_add(&bar[XB_TOP], 1u);
            const unsigned tg = og / nx;
            if (og + 1u == (tg + 1u) * nx) xb_add(&bar[XB_TOPGEN], 1u);
            else XB_SPIN(xb_ld(&bar[XB_TOPGEN]) == tg, bar);
            __builtin_amdgcn_fence(__ATOMIC_ACQUIRE, "agent");
            xb_add(&bar[XB_XGEN(b.x)], 1u);
            asm volatile("s_waitcnt vmcnt(0)" ::: "memory");
        } else {
            XB_SPIN(xb_ld(&bar[XB_XGEN(b.x)]) == gen, bar);
            __builtin_amdgcn_fence(__ATOMIC_ACQUIRE, "agent");
            asm volatile("s_waitcnt vmcnt(0)" ::: "memory");
        }
    }
    __syncthreads();
}


__global__ void __launch_bounds__(NTHREADS, 2) mega_kernel(Params p) {
  __shared__ __attribute__((aligned(16))) char smem[SMEM_BYTES];
  unsigned* bar = (unsigned*)(p.ws + OFF_BAR);
  __shared__ uint4 xb_words;
  if (threadIdx.x == 0) xb_words = make_uint4(0u, 0u, 0u, 0u);
  __syncthreads();
  XcdBarrier xb = xcd_barrier_post(bar, (volatile LAS unsigned*)&xb_words);
  if (p.ws == nullptr) cg::this_grid().sync();
  typedef const __attribute__((address_space(4))) Params* KParams;
#define PH_(n) { KParams kp = (KParams)__builtin_amdgcn_kernarg_segment_ptr(); asm volatile("" : "+s"(kp)); const Params lp = *(const Params*)kp; run_phase(lp, n, smem); } xcd_barrier(xb);
  PH_(0) PH_(1) PH_(20) PH_(2) PH_(3) PH_(4) PH_(5) PH_(6) PH_(7) PH_(8) PH_(9)
  PH_(10) PH_(11) PH_(24) PH_(12) PH_(22) PH_(13) PH_(14) PH_(15) PH_(16) PH_(17) PH_(18)
  { KParams kp = (KParams)__builtin_amdgcn_kernarg_segment_ptr(); asm volatile("" : "+s"(kp)); const Params lp = *(const Params*)kp; run_phase(lp, 19, smem); }
}

#endif

extern "C" void kernel_launch(void* const* d_in, const int* in_sizes, int n_in, void* d_out, int out_size, void* d_ws, size_t ws_size,
                              hipStream_t stream) {
  Params p;
  for (int i = 0; i < N_INPUTS; ++i) p.in[i] = (const float*)d_in[i];
  p.out = (float*)d_out;
  p.ws = (char*)d_ws;
#if MEGA
  static int grid_blocks = 0;
  if (!grid_blocks) {
    int dev = 0, cus = 0, per_cu = 0;
    hipGetDevice(&dev);
    hipDeviceGetAttribute(&cus, hipDeviceAttributeMultiprocessorCount, dev);
    hipOccupancyMaxActiveBlocksPerMultiprocessor(&per_cu, mega_kernel, NTHREADS, 0);
    if (per_cu > 2) per_cu = 2;
    grid_blocks = cus * per_cu;
  }
  hipMemsetAsync((char*)d_ws + OFF_BAR, 0, 16384, stream);
  void* args[] = {&p};
  hipError_t e = hipLaunchCooperativeKernel((void*)mega_kernel, dim3(grid_blocks), dim3(NTHREADS), args, 0, stream);
  if (e != hipSuccess) fprintf(stderr, "cooperative launch failed: %s (grid %d)\n", hipGetErrorString(e), grid_blocks);
#else
  launch_phases<0>(p, stream);
#endif
}
#endif
```

```cpp
#ifdef CPU_EMU
#include "emu.h"
#else
#include <hip/hip_runtime.h>
#include <hip/hip_cooperative_groups.h>
#include <cstdio>
namespace cg = cooperative_groups;
#endif
#include <stdint.h>

#ifndef BATCH
#define BATCH 2
#endif
#ifndef SEQ_LEN
#define SEQ_LEN 8192
#endif
#ifndef MEGA
#define MEGA 1
#endif
#if MEGA && !defined(CPU_EMU)
#define RK_MERGED 1
#else
#define RK_MERGED 0
#endif

#define DEV __device__ __forceinline__
#ifdef CPU_EMU
#define TIDX ((int)threadIdx.x)
#define BIDX ((int)blockIdx.x)
#else
__device__ __forceinline__ int tidx_() { int t = __builtin_amdgcn_workitem_id_x(); asm volatile("" : "+v"(t)); return t; }
__device__ __forceinline__ int bidx_() { int b = __builtin_amdgcn_workgroup_id_x(); asm volatile("" : "+s"(b)); return b; }
#define TIDX tidx_()
#define BIDX bidx_()
#endif
#define NTOK (BATCH * SEQ_LEN)
#define DM 1024
#define AB_IN 1816
#define AB_LD 1824
#define CD_IN 3328
#define NCMP ((SEQ_LEN - 32) / 16 + 1)
#define NBLK (SEQ_LEN / 64)
#define NB_CMP ((NCMP + 63) / 64)
#define S5_NC (SEQ_LEN / 64)
#define RET_NC (SEQ_LEN / 128)
#define ALPHA_F 1.4142135623730951f
#define NTHREADS 256

enum { I_X = 0, I_AB_W_IN, I_AB_W_OUT, I_S5_LAM_RE, I_S5_LAM_IM, I_S5_LOG_DT, I_S5_B_RE, I_S5_B_IM, I_S5_C_RE, I_S5_C_IM,
       I_S5_D, I_S5_W_GLU, I_S5_B_GLU, I_PE_K, I_PE_V, I_CK_W1, I_CK_B1, I_CK_W2, I_CV_W1, I_CV_B1, I_CV_W2,
       I_CD_W_IN, I_CD_W_OUT, I_RW_MU, I_RW_W0, I_RW_W_UP, I_RW_A0, I_RW_A_UP, I_RW_G_UP, I_RW_K_K, I_RW_K_A, I_RW_R_K,
       I_RW_LN_G, I_RW_LN_B, I_RET_LN_G, I_RET_LN_B, I_LN1_G, I_LN1_B, I_LN2_G, I_LN2_B, I_ROUTER, I_MOE_BIAS,
       I_MOE_W1, I_MOE_W3, I_MOE_W2, I_SH_W1, I_SH_W3, I_SH_W2, N_INPUTS };

struct Params {
  const float* in[N_INPUTS];
  float* out;
  char* ws;
};

#define MiB_TOK ((size_t)NTOK * 1024 * 4)
#define OFF_H 0
#define OFF_H2 ((size_t)NTOK * 1792 * 4)
#define OFF_MIX ((size_t)NTOK * 3328 * 4)
#define OFF_X1 (OFF_MIX + MiB_TOK)
#define OFF_X2 (OFF_X1 + MiB_TOK)
#define OFF_R4 (OFF_X2 + MiB_TOK)
#define OFF_R5 (OFF_R4 + MiB_TOK)
#define OFF_Y OFF_H
#define OFF_HS (OFF_H + 4 * MiB_TOK)
#define OFF_FS OFF_X2
#define OFF_HR OFF_R4
#define OFF_X2B OFF_R4
#define OFF_TOPI (OFF_R5)
#define OFF_TOPG (OFF_TOPI + (size_t)NTOK * 8 * 4)
#define OFF_POSOF (OFF_TOPG + (size_t)NTOK * 8 * 4)
#define OFF_CNT (OFF_POSOF + (size_t)NTOK * 8 * 4)
#define OFF_LTOK (OFF_CNT + 8192)
#define OFF_LGATE (OFF_LTOK + (size_t)64 * NTOK * 4)
#define OFF_S5E (OFF_LGATE + (size_t)64 * NTOK * 4)
#define OFF_KCMP (OFF_S5E + (size_t)BATCH * S5_NC * 32 * 64 * 8)
#define OFF_VCMP (OFF_KCMP + (size_t)BATCH * NCMP * 2 * 64 * 4)
#define OFF_RETKV (OFF_VCMP + (size_t)BATCH * NCMP * 2 * 64 * 4)
#define OFF_BAR (OFF_RETKV + (size_t)BATCH * 4 * RET_NC * 64 * 128 * 4)
#define OFF_CMPHID (OFF_BAR + 16384)
#define OFF_CMPC1 (OFF_CMPHID + (size_t)2 * BATCH * 2 * NB_CMP * 64 * 128 * 4)
#define OFF_GLO OFF_LTOK
#define OFF_RKF (OFF_CMPC1 + 8192)
#define OFF_END (OFF_RKF + 16384)
#define OFF_YGELU OFF_X1
#define OFF_RWW OFF_X1
#define OFF_RWK (OFF_X1 + (size_t)NTOK * 512 * 4)
#define OFF_RWKK OFF_R4
#define OFF_RWA (OFF_R4 + (size_t)NTOK * 512 * 4)

typedef short bf16x8 __attribute__((ext_vector_type(8)));
typedef float f32x16 __attribute__((ext_vector_type(16)));

#ifdef CPU_EMU
#define WAVE_SYNC() emu_wave_bar()
#else
#define WAVE_SYNC() __builtin_amdgcn_wave_barrier()
#endif

DEV float sigmoidf_(float x) { return 1.f / (1.f + __expf(-x)); }
DEV float siluf_(float x) { return x * sigmoidf_(x); }
DEV float geluf_(float x) { float u = 0.7978845608028654f * (x + 0.044715f * x * x * x); return 0.5f * x * (1.f + tanhf(u)); }
DEV unsigned short f2bf(float f) {
  unsigned u = __builtin_bit_cast(unsigned, f);
  u += 0x7FFFu + ((u >> 16) & 1u);
  return (unsigned short)(u >> 16);
}
DEV float bf2f(unsigned short h) { return __builtin_bit_cast(float, ((unsigned)h) << 16); }
DEV float wave_sum(float v) {
#pragma unroll
  for (int m = 32; m >= 1; m >>= 1) v += __shfl_xor(v, m);
  return v;
}
DEV float wave_max(float v) {
#pragma unroll
  for (int m = 32; m >= 1; m >>= 1) v = fmaxf(v, __shfl_xor(v, m));
  return v;
}
DEV float4 ld4(const float* p) { return *(const float4*)p; }
#ifdef CPU_EMU
DEV float fexp2(float x) { return exp2f(x); }
#else
DEV float fexp2(float x) { return __builtin_amdgcn_exp2f(x); }
#endif
DEV void fast_sincos(float x, float* sn, float* cs) {
  const float k = rintf(x * 0.15915494309189535f);
  float r = fmaf(-k, 6.28125f, x);
  r = fmaf(-k, 1.9353071795864769e-3f, r);
  *sn = __sinf(r); *cs = __cosf(r);
}
DEV void st4(float* p, float4 v) { *(float4*)p = v; }

#define GEMM_BM 128
#define GEMM_MI (GEMM_BM / 64)
#define GEMM_SMEM_BYTES ((GEMM_BM + 128) * 72 * 2)
#ifdef CPU_EMU
DEV unsigned pk2(float a, float b) { return (unsigned)f2bf(a) | ((unsigned)f2bf(b) << 16); }
#else
typedef __bf16 hbf16x2 __attribute__((ext_vector_type(2)));
typedef float hf32x2 __attribute__((ext_vector_type(2)));
DEV unsigned pk2(float a, float b) {
  hf32x2 f = {a, b};
  return __builtin_bit_cast(unsigned, __builtin_convertvector(f, hbf16x2));
}
#endif
template <bool ABF, class AROW, class BPTR, class EPI>
DEV void gemm_tile(AROW arow, BPTR bptr, int ldb, int K, EPI epi, char* smem_raw, int akstep = 64) {
  unsigned short(*sA)[72] = (unsigned short(*)[72])smem_raw;
  unsigned short(*sB)[72] = (unsigned short(*)[72])(smem_raw + GEMM_BM * 72 * 2);
  const int tid = TIDX, lane = tid & 63, wave = tid >> 6;
  const int wm = wave >> 1, wn = wave & 1;
#if defined(CPU_EMU) && !defined(EMU_REAL_GEMM)
  for (int mi = 0; mi < GEMM_MI; ++mi)
    for (int r = 0; r < 16; ++r) {
      const int row = wm * (GEMM_BM / 2) + mi * 32 + (r & 3) + 8 * (r >> 2) + 4 * (lane >> 5);
      const int col = wn * 64 + (lane & 31);
      const void* arp = arow(row);
      float v[2] = {0.f, 0.f};
      for (int ni = 0; ni < 2; ++ni) {
        const int cc = col + ni * 32;
        const float* bq = bptr(cc & ~3);
        if (!arp || !bq) continue;
        bq += cc & 3;
        float a = 0.f;
        for (int k = 0; k < K; ++k) {
          const size_t ka = (size_t)(k >> 6) * akstep + (k & 63);
          const float av = ABF ? bf2f(((const unsigned short*)arp)[ka]) : bf2f(f2bf(((const float*)arp)[ka]));
          a += av * bf2f(f2bf(bq[(size_t)k * ldb]));
        }
        v[ni] = a;
      }
      epi(row, col, v[0], v[1]);
    }
  return;
#endif
  const float* ap[4 * GEMM_MI];
  const unsigned short* aph[2 * GEMM_MI];
  if (ABF) {
#pragma unroll
    for (int i = 0; i < 2 * GEMM_MI; ++i) aph[i] = (const unsigned short*)arow((tid >> 3) + 32 * i);
  } else {
#pragma unroll
    for (int i = 0; i < 4 * GEMM_MI; ++i) ap[i] = (const float*)arow((tid >> 4) + 16 * i);
  }
  const float* bp = bptr((tid & 31) * 4);
  const int kgrp = tid >> 5;
  float4 ra0[4 * GEMM_MI], ra1[4 * GEMM_MI];
  uint4 rah0[2 * GEMM_MI], rah1[2 * GEMM_MI];
  float4 rb0[8], rb1[8];
#define GEMM_GLOAD(S, k0_)                                                                                                          \
  {                                                                                                                                 \
    if (ABF) {                                                                                                                      \
      _Pragma("unroll") for (int i = 0; i < 2 * GEMM_MI; ++i) rah##S[i] =                                                           \
          aph[i] ? *(const uint4*)(aph[i] + (size_t)((k0_) >> 6) * akstep + (tid & 7) * 8) : make_uint4(0, 0, 0, 0);                \
    } else {                                                                                                                        \
      _Pragma("unroll") for (int i = 0; i < 4 * GEMM_MI; ++i) ra##S[i] =                                                            \
          ap[i] ? ld4(ap[i] + (size_t)((k0_) >> 6) * akstep + (tid & 15) * 4) : make_float4(0.f, 0.f, 0.f, 0.f);                    \
    }                                                                                                                               \
    _Pragma("unroll") for (int j = 0; j < 8; ++j) rb##S[j] =                                                                        \
        bp ? ld4(bp + (size_t)((k0_) + kgrp * 8 + j) * ldb) : make_float4(0.f, 0.f, 0.f, 0.f);                                      \
  }
#define GEMM_SSTORE(S)                                                                                                              \
  {                                                                                                                                 \
    if (ABF) {                                                                                                                      \
      _Pragma("unroll") for (int i = 0; i < 2 * GEMM_MI; ++i) *(uint4*)&sA[(tid >> 3) + 32 * i][(tid & 7) * 8] = rah##S[i];         \
    } else {                                                                                                                        \
      _Pragma("unroll") for (int i = 0; i < 4 * GEMM_MI; ++i) *(uint2*)&sA[(tid >> 4) + 16 * i][(tid & 15) * 4] =                   \
          make_uint2(pk2(ra##S[i].x, ra##S[i].y), pk2(ra##S[i].z, ra##S[i].w));                                                     \
    }                                                                                                                               \
    const int nb = (tid & 31) * 4;                                                                                                  \
    *(uint4*)&sB[nb + 0][kgrp * 8] = make_uint4(pk2(rb##S[0].x, rb##S[1].x), pk2(rb##S[2].x, rb##S[3].x), pk2(rb##S[4].x, rb##S[5].x), pk2(rb##S[6].x, rb##S[7].x)); \
    *(uint4*)&sB[nb + 1][kgrp * 8] = make_uint4(pk2(rb##S[0].y, rb##S[1].y), pk2(rb##S[2].y, rb##S[3].y), pk2(rb##S[4].y, rb##S[5].y), pk2(rb##S[6].y, rb##S[7].y)); \
    *(uint4*)&sB[nb + 2][kgrp * 8] = make_uint4(pk2(rb##S[0].z, rb##S[1].z), pk2(rb##S[2].z, rb##S[3].z), pk2(rb##S[4].z, rb##S[5].z), pk2(rb##S[6].z, rb##S[7].z)); \
    *(uint4*)&sB[nb + 3][kgrp * 8] = make_uint4(pk2(rb##S[0].w, rb##S[1].w), pk2(rb##S[2].w, rb##S[3].w), pk2(rb##S[4].w, rb##S[5].w), pk2(rb##S[6].w, rb##S[7].w)); \
  }
  f32x16 acc[GEMM_MI][2];
#pragma unroll
  for (int mi = 0; mi < GEMM_MI; ++mi)
#pragma unroll
    for (int ni = 0; ni < 2; ++ni)
#pragma unroll
      for (int r = 0; r < 16; ++r) acc[mi][ni][r] = 0.f;
  auto compute = [&]() {
#pragma unroll
    for (int ks = 0; ks < 4; ++ks) {
      bf16x8 af[GEMM_MI], bfr[2];
#pragma unroll
      for (int mi = 0; mi < GEMM_MI; ++mi) af[mi] = *(const bf16x8*)&sA[wm * (GEMM_BM / 2) + mi * 32 + (lane & 31)][ks * 16 + (lane >> 5) * 8];
#pragma unroll
      for (int ni = 0; ni < 2; ++ni) bfr[ni] = *(const bf16x8*)&sB[wn * 64 + ni * 32 + (lane & 31)][ks * 16 + (lane >> 5) * 8];
#pragma unroll
      for (int mi = 0; mi < GEMM_MI; ++mi)
#pragma unroll
        for (int ni = 0; ni < 2; ++ni) acc[mi][ni] = __builtin_amdgcn_mfma_f32_32x32x16_bf16(af[mi], bfr[ni], acc[mi][ni], 0, 0, 0);
    }
  };
  if (ABF) {
    GEMM_GLOAD(0, 0);
    GEMM_GLOAD(1, 64);
    for (int k0 = 0; k0 < K; k0 += 128) {
      __syncthreads();
      GEMM_SSTORE(0);
      __syncthreads();
      if (k0 + 128 < K) GEMM_GLOAD(0, k0 + 128);
      compute();
      __syncthreads();
      GEMM_SSTORE(1);
      __syncthreads();
      if (k0 + 192 < K) GEMM_GLOAD(1, k0 + 192);
      compute();
    }
  } else {
    GEMM_GLOAD(0, 0);
    for (int k0 = 0; k0 < K; k0 += 64) {
      __syncthreads();
      GEMM_SSTORE(0);
      __syncthreads();
      if (k0 + 64 < K) GEMM_GLOAD(0, k0 + 64);
      compute();
    }
  }
#pragma unroll
  for (int mi = 0; mi < GEMM_MI; ++mi)
#pragma unroll
    for (int r = 0; r < 16; ++r) {
      int row = wm * (GEMM_BM / 2) + mi * 32 + (r & 3) + 8 * (r >> 2) + 4 * (lane >> 5);
      int col = wn * 64 + (lane & 31);
      epi(row, col, acc[mi][0][r], acc[mi][1][r]);
    }
}

template <int LAYER>
DEV void phase_gemm_in(const Params& p, char* smem) {
  const int N = LAYER == 0 ? AB_IN : CD_IN;
  const float* A = LAYER == 0 ? p.in[I_X] : (const float*)(p.ws + OFF_X2);
  const float* B = LAYER == 0 ? p.in[I_AB_W_IN] : p.in[I_CD_W_IN];
  float* C = (float*)(p.ws + OFF_H);
  const int NT = (N + 127) / 128, MT = NTOK / GEMM_BM;
  const int xcd_ = BIDX & 7, lb_ = BIDX >> 3, nb_ = gridDim.x >> 3;
  for (int j_ = lb_; j_ < (MT / 8) * NT; j_ += nb_) {
    const int it = (xcd_ + 8 * (j_ / NT)) * NT + (j_ % NT);
    const int tm = it / NT, tn = it % NT;
    const int m0 = tm * GEMM_BM, n0 = tn * 128;
    gemm_tile<LAYER == 1>(
        [&](int r) { return LAYER == 1 ? (const void*)((const unsigned short*)(p.ws + OFF_X2B) + (size_t)(m0 + r) * DM) : (const void*)(A + (size_t)(m0 + r) * DM); },
        [&](int c) { return (n0 + c < N) ? (B + n0 + c) : (const float*)nullptr; }, N, DM,
        [&](int row, int col, float v0, float v1) {
          const int gm = m0 + row, gc = n0 + col;
          if (LAYER == 1 && gc >= 1792 && gc < 2304) {
            const int i = gc & 63;
            const float pos = (float)(gm % SEQ_LEN);
            const float inv = __expf(-(float)i * (9.210340371976184f / 32.f));
            float sn, cs;
            fast_sincos(pos * inv, &sn, &cs);
            float o0 = v0 * cs - v1 * sn, o1 = v1 * cs + v0 * sn;
            if (gc >= 2048) { o0 *= 0.125f; o1 *= 0.125f; }
            v0 = o0; v1 = o1;
          }
          if (LAYER == 1) {
            float* dstp = gc < 1792 ? C + (size_t)gm * 1792 + gc : (float*)(p.ws + OFF_H2) + (size_t)gm * 1536 + (gc - 1792);
            dstp[0] = v0; dstp[32] = v1;
          } else {
            if (gc < N) C[(size_t)gm * AB_LD + gc] = v0;
            if (gc + 32 < N) C[(size_t)gm * AB_LD + gc + 32] = v1;
          }
        },
        smem);
  }
}

struct S5Const { float lb_re, lb_im; };
DEV void s5_consts(const Params& p, int g, int pp, float& lb_re, float& lb_im, float (&bbr)[16], float (&bbi)[16]) {
  const float dt = expf(p.in[I_S5_LOG_DT][g]);
  const float lr = p.in[I_S5_LAM_RE][g * 64 + pp], li = p.in[I_S5_LAM_IM][g * 64 + pp];
  const float mag = expf(lr * dt);
  float sn, cs;
  sincosf(li * dt, &sn, &cs);
  lb_re = mag * cs; lb_im = mag * sn;
  const float den = lr * lr + li * li;
  const float f_re = ((lb_re - 1.f) * lr + lb_im * li) / den;
  const float f_im = (lb_im * lr - (lb_re - 1.f) * li) / den;
  const float* br = p.in[I_S5_B_RE] + (size_t)(g * 64 + pp) * 16;
  const float* bi = p.in[I_S5_B_IM] + (size_t)(g * 64 + pp) * 16;
#pragma unroll
  for (int h = 0; h < 16; ++h) {
    bbr[h] = f_re * br[h] - f_im * bi[h];
    bbi[h] = f_re * bi[h] + f_im * br[h];
  }
}

#define OFF_QB OFF_X2
#define OFF_KSB (OFF_QB + (size_t)NTOK * 512 * 2)
#define OFF_KWB (OFF_KSB + (size_t)NTOK * 128 * 2)
#define OFF_VST (OFF_KWB + (size_t)NTOK * 128 * 2)
#define OFF_VWT (OFF_VST + (size_t)NTOK * 128 * 2)
#define OFF_KCB (OFF_VWT + (size_t)NTOK * 128 * 2)
#define OFF_VCT (OFF_KCB + (size_t)BATCH * 2 * NB_CMP * 64 * 64 * 2)
#define NSA_QSCALE (0.125f * 1.4426950408889634f)

#define P1_S5A_ITEMS (BATCH * 32 * S5_NC / 4)
#define P1_CMP_ITEMS (2 * BATCH * 2 * NB_CMP)
DEV void p1_s5a(const Params& p, int item, char* smem) {
  const int lane = TIDX & 63, wave = TIDX >> 6;
  const int idx = item * 4 + wave;
  const int g = idx & 31, c = (idx >> 5) % S5_NC, b = idx / (32 * S5_NC);
  float lb_re, lb_im, bbr[16], bbi[16];
  s5_consts(p, g, lane, lb_re, lb_im, bbr, bbi);
  const float* H = (const float*)(p.ws + OFF_H);
  float sr = 0.f, si = 0.f;
  float* su = (float*)smem + wave * 64 * 16;
  __syncthreads();
  {
    const float* ur = H + (size_t)(b * SEQ_LEN + c * 64 + lane) * AB_LD + g * 16;
#pragma unroll
    for (int q = 0; q < 4; ++q) st4(su + lane * 16 + q * 4, ld4(ur + q * 4));
  }
  WAVE_SYNC();
  for (int tt = 0; tt < 64; ++tt) {
    const float* u = su + tt * 16;
    float dr = 0.f, di = 0.f;
#pragma unroll
    for (int h4 = 0; h4 < 4; ++h4) {
      const float4 uv = ld4(u + h4 * 4);
      dr += uv.x * bbr[h4 * 4] + uv.y * bbr[h4 * 4 + 1] + uv.z * bbr[h4 * 4 + 2] + uv.w * bbr[h4 * 4 + 3];
      di += uv.x * bbi[h4 * 4] + uv.y * bbi[h4 * 4 + 1] + uv.z * bbi[h4 * 4 + 2] + uv.w * bbi[h4 * 4 + 3];
    }
    const float nr = lb_re * sr - lb_im * si + dr;
    const float ni = lb_re * si + lb_im * sr + di;
    sr = nr; si = ni;
  }
  float2* E = (float2*)(p.ws + OFF_S5E);
  E[((size_t)(b * S5_NC + c) * 32 + g) * 64 + lane] = make_float2(sr, si);
}
#define P1_CMPG_MT ((NCMP + GEMM_BM - 1) / GEMM_BM)
#define P1_CMPG_ITEMS (2 * BATCH * 2 * P1_CMPG_MT)
DEV void p1_cmpgemm(const Params& p, int item, char* smem) {
  const int mt = item % P1_CMPG_MT;
  int r = item / P1_CMPG_MT;
  const int g = r & 1; r >>= 1;
  const int b = r % BATCH; const int which = r / BATCH;
  const float* H = (const float*)(p.ws + OFF_H);
  const float* w1 = which ? p.in[I_CV_W1] : p.in[I_CK_W1];
  const int colbase = (which ? 1152 : 1024) + g * 64;
  float* HID = (float*)(p.ws + OFF_CMPHID) + ((size_t)(which * BATCH + b) * 2 + g) * NB_CMP * 64 * 128;
  const int n0 = mt * GEMM_BM;
  gemm_tile<false>(
      [&](int rr) { return (n0 + rr < NCMP) ? (const void*)(H + ((size_t)b * SEQ_LEN + 16 * (n0 + rr)) * AB_LD + colbase) : (const void*)nullptr; },
      [&](int c) { return w1 + c; }, 128, 2048,
      [&](int row, int col, float v0, float v1) {
        if (n0 + row < NCMP) { HID[(size_t)(n0 + row) * 128 + col] = v0; HID[(size_t)(n0 + row) * 128 + col + 32] = v1; }
      },
      smem, AB_LD);
}
#define P1_CMPC1_ITEMS 16
DEV void p1_cmpc1(const Params& p, int item, char* smem) {
  const int which = item >> 3, sl = item & 7;
  const float* pe = which ? p.in[I_PE_V] : p.in[I_PE_K];
  const float* w1 = which ? p.in[I_CV_W1] : p.in[I_CK_W1];
  float* sPart = (float*)smem;
  const int tid = TIDX, hid = tid & 127, kh = tid >> 7;
  float a = 0.f;
  const int k0 = sl * 256 + kh * 128;
#pragma unroll 16
  for (int k = k0; k < k0 + 128; ++k) a += pe[k] * w1[(size_t)k * 128 + hid];
  __syncthreads();
  sPart[tid] = a;
  __syncthreads();
  if (tid < 128) ((float*)(p.ws + OFF_CMPC1))[(which * 8 + sl) * 128 + tid] = sPart[tid] + sPart[tid + 128];
  __syncthreads();
}
DEV void p1_compress(const Params& p, int item, char* smem) {
  const int tile = item % NB_CMP;
  int r = item / NB_CMP;
  const int g = r & 1; r >>= 1;
  const int b = r % BATCH; const int which = r / BATCH;
  const float* b1 = which ? p.in[I_CV_B1] : p.in[I_CK_B1];
  const float* w2 = which ? p.in[I_CV_W2] : p.in[I_CK_W2];
  const float* C1P = (const float*)(p.ws + OFF_CMPC1) + which * 8 * 128;
  const float* HID = (const float*)(p.ws + OFF_CMPHID) + ((size_t)(which * BATCH + b) * 2 + g) * NB_CMP * 64 * 128;
  float* sOut = (float*)smem;
  float* sHid = sOut + 8 * 64;
  float* sAll = sHid + 8 * 128;
  float* sC1 = sAll + 64 * 65;
  const int tid = TIDX;
  __syncthreads();
  if (tid < 128) {
    const float* q = C1P + tid;
    sC1[tid] = (((((((q[0] + q[128]) + q[256]) + q[384]) + q[512]) + q[640]) + q[768]) + q[896]) + b1[tid];
  }
  float* dst = (float*)(p.ws + (which ? OFF_VCMP : OFF_KCMP));
#pragma unroll 1
  for (int r8 = 0; r8 < 8; ++r8) {
    const int n0 = tile * 64 + r8 * 8;
    __syncthreads();
    for (int w = tid; w < 8 * 128; w += NTHREADS) {
      const int rr = w >> 7, hid = w & 127;
      const int n = n0 + rr;
      sHid[w] = n < NCMP ? geluf_(HID[(size_t)n * 128 + hid] + sC1[hid]) : 0.f;
    }
    __syncthreads();
    for (int w = tid; w < 8 * 64; w += NTHREADS) {
      const int rr = w >> 6, d = w & 63;
      float a = 0.f;
      for (int hid = 0; hid < 128; ++hid) a += sHid[rr * 128 + hid] * w2[hid * 64 + d];
      sOut[w] = a;
    }
    __syncthreads();
    for (int w = tid; w < 8 * 64; w += NTHREADS) {
      const int rr = w >> 6, d = w & 63;
      const int n = n0 + rr;
      float v = sOut[w];
      if (which == 0 && d < 16) {
        const int i = d & 7;
        const float pos = (float)(n * 16 + 31);
        const float inv = __expf(-(float)i * (13.122363377404328f / 8.f));
        float sn, cs;
        sincosf(pos * inv, &sn, &cs);
        const float x1 = sOut[rr * 64 + i], x2 = sOut[rr * 64 + i + 8];
        v = d < 8 ? x1 * cs - x2 * sn : x2 * cs + x1 * sn;
      }
      if (n >= NCMP) v = 0.f;
      sAll[(r8 * 8 + rr) * 65 + d] = v;
      if (n < NCMP) dst[((size_t)(b * NCMP + n) * 2 + g) * 64 + d] = v;
    }
  }
  __syncthreads();
  if (which == 0) {
    unsigned short* KCB = (unsigned short*)(p.ws + OFF_KCB) + (((size_t)b * 2 + g) * NB_CMP * 64 + tile * 64) * 64;
    for (int w = tid; w < 64 * 8; w += NTHREADS) {
      const int nl = w >> 3, o = w & 7;
      float v[8];
#pragma unroll
      for (int q = 0; q < 8; ++q) v[q] = sAll[nl * 65 + o * 8 + q];
      *(uint4*)(KCB + nl * 64 + o * 8) = make_uint4(pk2(v[0], v[1]), pk2(v[2], v[3]), pk2(v[4], v[5]), pk2(v[6], v[7]));
    }
  } else {
    unsigned short* VCT = (unsigned short*)(p.ws + OFF_VCT) + (((size_t)b * 2 + g) * NB_CMP + tile) * 64 * 64;
    for (int w = tid; w < 64 * 8; w += NTHREADS) {
      const int d = w >> 3, o = w & 7;
      float v[8];
#pragma unroll
      for (int q = 0; q < 8; ++q) v[q] = sAll[(o * 8 + q) * 65 + d];
      *(uint4*)(VCT + d * 64 + o * 8) = make_uint4(pk2(v[0], v[1]), pk2(v[2], v[3]), pk2(v[4], v[5]), pk2(v[6], v[7]));
    }
  }
}
DEV uint4 pack8(const float* v) {
  uint4 r;
  r.x = (unsigned)f2bf(v[0]) | ((unsigned)f2bf(v[1]) << 16);
  r.y = (unsigned)f2bf(v[2]) | ((unsigned)f2bf(v[3]) << 16);
  r.z = (unsigned)f2bf(v[4]) | ((unsigned)f2bf(v[5]) << 16);
  r.w = (unsigned)f2bf(v[6]) | ((unsigned)f2bf(v[7]) << 16);
  return r;
}
#define P1_PREP_ITEMS (NTOK / 64)
#define P1_PREP_SMEM ((64 * 8 * 2 + 64 * 128) * 4)
DEV void p1_prep(const Params& p, int item, char* smem) {
  const int tid = TIDX;
  const int b = item / NBLK, blk = item % NBLK;
  const float* H = (const float*)(p.ws + OFF_H);
  float* sCS = (float*)smem;
  float* sV = sCS + 64 * 8 * 2;
  const size_t tok0 = (size_t)b * SEQ_LEN + blk * 64;
  __syncthreads();
  for (int w = tid; w < 64 * 8; w += NTHREADS) {
    const int tk = w >> 3, i = w & 7;
    const float pos = (float)(blk * 64 + tk);
    const float inv = __expf(-(float)i * (13.122363377404328f / 8.f));
    float sn, cs;
    sincosf(pos * inv, &sn, &cs);
    sCS[w * 2] = cs; sCS[w * 2 + 1] = sn;
  }
  __syncthreads();
  unsigned short* QB = (unsigned short*)(p.ws + OFF_QB);
  unsigned short* KSB = (unsigned short*)(p.ws + OFF_KSB);
  unsigned short* KWB = (unsigned short*)(p.ws + OFF_KWB);
  for (int w = tid; w < 64 * 12 * 8; w += NTHREADS) {
    const int o = w & 7, hd = (w >> 3) % 12, tk = w / 96;
    const int col = hd < 8 ? 512 + hd * 64 : (hd < 10 ? 1280 + (hd - 8) * 64 : 1536 + (hd - 10) * 64);
    const float* x = H + (tok0 + tk) * AB_LD + col;
    float v[8];
    const float4 a0 = ld4(x + o * 8), a1 = ld4(x + o * 8 + 4);
    v[0] = a0.x; v[1] = a0.y; v[2] = a0.z; v[3] = a0.w; v[4] = a1.x; v[5] = a1.y; v[6] = a1.z; v[7] = a1.w;
    if (o < 2) {
      const float4 c0 = ld4(x + (1 - o) * 8), c1 = ld4(x + (1 - o) * 8 + 4);
      const float u[8] = {c0.x, c0.y, c0.z, c0.w, c1.x, c1.y, c1.z, c1.w};
#pragma unroll
      for (int i = 0; i < 8; ++i) {
        const float cs = sCS[(tk * 8 + i) * 2], sn = sCS[(tk * 8 + i) * 2 + 1];
        v[i] = o == 0 ? v[i] * cs - u[i] * sn : v[i] * cs + u[i] * sn;
      }
    }
    if (hd < 8) {
#pragma unroll
      for (int i = 0; i < 8; ++i) v[i] *= NSA_QSCALE;
      *(uint4*)(QB + ((tok0 + tk) * 8 + hd) * 64 + o * 8) = pack8(v);
    } else {
      const int g = (hd - 8) & 1;
      unsigned short* dst = (hd < 10 ? KSB : KWB) + (((size_t)b * 2 + g) * SEQ_LEN + blk * 64 + tk) * 64 + o * 8;
      *(uint4*)dst = pack8(v);
    }
  }
#pragma unroll 1
  for (int which = 0; which < 2; ++which) {
    const int col = which ? 1664 : 1408;
    __syncthreads();
    for (int w = tid; w < 64 * 32; w += NTHREADS) {
      const int tk = w >> 5, c4 = (w & 31) * 4;
      st4(sV + tk * 128 + c4, ld4(H + (tok0 + tk) * AB_LD + col + c4));
    }
    __syncthreads();
    unsigned short* VT = (unsigned short*)(p.ws + (which ? OFF_VWT : OFF_VST));
    for (int w = tid; w < 2 * 64 * 8; w += NTHREADS) {
      const int ko = w & 7, d = (w >> 3) & 63, g = w >> 9;
      float v[8];
#pragma unroll
      for (int i = 0; i < 8; ++i) v[i] = sV[(ko * 8 + i) * 128 + g * 64 + d];
      *(uint4*)(VT + ((((size_t)b * 2 + g) * NBLK + blk) * 64 + d) * 64 + ko * 8) = pack8(v);
    }
  }
}

struct NsaSmem {
  unsigned short k[64][72];
  unsigned short vt[64][68];
  float imp[32][128];
  unsigned selmask[32][4];
  unsigned unionm[4];
  float keyb[4][128];
};
#define P2_NSA_SMEM ((int)sizeof(NsaSmem))
#define NSA_QT (SEQ_LEN / 32)
#define P2_NSA_ITEMS (BATCH * 2 * NSA_QT)

struct TileRegs { uint4 k0, k1, v0, v1; };
DEV void tile_gload(TileRegs& r, const unsigned short* Kg, const unsigned short* Vg, int tid) {
  const int row = tid >> 2, seg = tid & 3;
  r.k0 = *(const uint4*)(Kg + row * 64 + seg * 16);
  r.k1 = *(const uint4*)(Kg + row * 64 + seg * 16 + 8);
  if (Vg) {
    r.v0 = *(const uint4*)(Vg + row * 64 + seg * 16);
    r.v1 = *(const uint4*)(Vg + row * 64 + seg * 16 + 8);
  }
}
DEV void tile_sstore(NsaSmem* sm, const TileRegs& r, bool withV, int tid) {
  const int row = tid >> 2, seg = tid & 3;
  *(uint4*)&sm->k[row][seg * 16] = r.k0;
  *(uint4*)&sm->k[row][seg * 16 + 8] = r.k1;
  if (withV) {
    *(uint2*)&sm->vt[row][seg * 16] = make_uint2(r.v0.x, r.v0.y);
    *(uint2*)&sm->vt[row][seg * 16 + 4] = make_uint2(r.v0.z, r.v0.w);
    *(uint2*)&sm->vt[row][seg * 16 + 8] = make_uint2(r.v1.x, r.v1.y);
    *(uint2*)&sm->vt[row][seg * 16 + 12] = make_uint2(r.v1.z, r.v1.w);
  }
}
DEV void qk_tile(const unsigned short (*ksm)[72], const bf16x8 (&qf)[4], f32x16 (&s)[2], int lane) {
  const int r = lane & 31, hh = lane >> 5;
#pragma unroll
  for (int ks2 = 0; ks2 < 2; ++ks2) {
#pragma unroll
    for (int i = 0; i < 16; ++i) s[ks2][i] = 0.f;
#pragma unroll
    for (int ks = 0; ks < 4; ++ks) {
      const bf16x8 a = *(const bf16x8*)&ksm[ks2 * 32 + r][ks * 16 + hh * 8];
      s[ks2] = __builtin_amdgcn_mfma_f32_32x32x16_bf16(a, qf[ks], s[ks2], 0, 0, 0);
    }
  }
}
DEV void pv_tile(const unsigned short (*vsm)[68], const f32x16 (&pr)[2], f32x16 (&o)[2], int lane) {
  const int r = lane & 31, hh = lane >> 5;
#pragma unroll
  for (int ks2 = 0; ks2 < 2; ++ks2)
#pragma unroll
    for (int s = 0; s < 2; ++s) {
      union { uint4 u; bf16x8 v; } pfu;
      pfu.u = make_uint4(pk2(pr[ks2][8 * s], pr[ks2][8 * s + 1]), pk2(pr[ks2][8 * s + 2], pr[ks2][8 * s + 3]),
                         pk2(pr[ks2][8 * s + 4], pr[ks2][8 * s + 5]), pk2(pr[ks2][8 * s + 6], pr[ks2][8 * s + 7]));
      const bf16x8 pf = pfu.v;
#pragma unroll
      for (int mt = 0; mt < 2; ++mt) {
        const uint2 lo = *(const uint2*)&vsm[mt * 32 + r][ks2 * 32 + 16 * s + 4 * hh];
        const uint2 hi = *(const uint2*)&vsm[mt * 32 + r][ks2 * 32 + 16 * s + 8 + 4 * hh];
        union { uint4 u; bf16x8 v; } au;
        au.u = make_uint4(lo.x, lo.y, hi.x, hi.y);
        const bf16x8 a = au.v;
        o[mt] = __builtin_amdgcn_mfma_f32_32x32x16_bf16(a, pf, o[mt], 0, 0, 0);
      }
    }
}
DEV float quad_sum(float v) {
#ifdef CPU_EMU
  v += __shfl_xor(v, 1); v += __shfl_xor(v, 2); return v;
#else
  int x;
  x = __builtin_amdgcn_update_dpp(0, __builtin_bit_cast(int, v), 0xB1, 0xF, 0xF, false); v += __builtin_bit_cast(float, x);
  x = __builtin_amdgcn_update_dpp(0, __builtin_bit_cast(int, v), 0x4E, 0xF, 0xF, false); v += __builtin_bit_cast(float, x);
  return v;
#endif
}
DEV void softmax_step(f32x16 (&s)[2], float& m, float& l, f32x16 (&o)[2]) {
  float tmax = -INFINITY;
#pragma unroll
  for (int ks2 = 0; ks2 < 2; ++ks2)
#pragma unroll
    for (int i = 0; i < 16; ++i) tmax = fmaxf(tmax, s[ks2][i]);
  tmax = fmaxf(tmax, __shfl_xor(tmax, 32));
  const float mnew = fmaxf(m, tmax);
  const float msafe = mnew == -INFINITY ? 0.f : mnew;
  const float alpha = fexp2(m - msafe);
  float ps = 0.f;
#pragma unroll
  for (int ks2 = 0; ks2 < 2; ++ks2)
#pragma unroll
    for (int i = 0; i < 16; ++i) { s[ks2][i] = fexp2(s[ks2][i] - msafe); ps += s[ks2][i]; }
  l = l * alpha + ps;
#pragma unroll
  for (int mt = 0; mt < 2; ++mt)
#pragma unroll
    for (int i = 0; i < 16; ++i) o[mt][i] *= alpha;
  m = mnew;
}
DEV bool testbit4(unsigned w0, unsigned w1, unsigned w2, unsigned w3, int j) {
  const unsigned lo = j & 32 ? w1 : w0, hi = j & 32 ? w3 : w2;
  const unsigned x = j & 64 ? hi : lo;
  return (x >> (j & 31)) & 1u;
}

DEV void p2_nsa(const Params& p, int item, char* smem) {
  NsaSmem* sm = (NsaSmem*)smem;
  const int tid = TIDX, lane = tid & 63, wave = tid >> 6;
  const int bg = item & 3, b = bg >> 1, g = bg & 1;
  const int qt = NSA_QT - 1 - (item >> 2);
  const int t0 = qt * 32;
  const int c = lane & 31, hh = lane >> 5, tl = c >> 2, h = c & 3;
  const int trow = wave * 8 + tl;
  const int tq = t0 + trow;
  const size_t tok = (size_t)b * SEQ_LEN + tq;
  const int hd = g * 4 + h;
  const float* H = (const float*)(p.ws + OFF_H);
  const unsigned short* QB = (const unsigned short*)(p.ws + OFF_QB);
  const unsigned short* KSB = (const unsigned short*)(p.ws + OFF_KSB) + ((size_t)b * 2 + g) * SEQ_LEN * 64;
  const unsigned short* KWB = (const unsigned short*)(p.ws + OFF_KWB) + ((size_t)b * 2 + g) * SEQ_LEN * 64;
  const unsigned short* VST = (const unsigned short*)(p.ws + OFF_VST) + ((size_t)b * 2 + g) * NBLK * 4096;
  const unsigned short* VWT = (const unsigned short*)(p.ws + OFF_VWT) + ((size_t)b * 2 + g) * NBLK * 4096;
  const unsigned short* KCB = (const unsigned short*)(p.ws + OFF_KCB) + ((size_t)b * 2 + g) * NB_CMP * 4096;
  const unsigned short* VCT = (const unsigned short*)(p.ws + OFF_VCT) + ((size_t)b * 2 + g) * NB_CMP * 4096;
  bf16x8 qf[4];
  {
    const unsigned short* qrow = QB + (tok * 8 + hd) * 64;
#pragma unroll
    for (int ks = 0; ks < 4; ++ks) qf[ks] = *(const bf16x8*)(qrow + ks * 16 + hh * 8);
  }
  const float g0 = sigmoidf_(H[tok * AB_LD + 1792 + hd * 3 + 0]);
  const float g1 = sigmoidf_(H[tok * AB_LD + 1792 + hd * 3 + 1]);
  const float g2 = sigmoidf_(H[tok * AB_LD + 1792 + hd * 3 + 2]);
  f32x16 o[2], s[2];
#pragma unroll
  for (int mt = 0; mt < 2; ++mt)
#pragma unroll
    for (int i = 0; i < 16; ++i) o[mt][i] = 0.f;
  float* mixrow = (float*)(p.ws + OFF_MIX) + tok * 1024 + 512 + hd * 64 + 4 * hh;
  __syncthreads();
  for (int w = tid; w < 32 * 128; w += NTHREADS) (&sm->imp[0][0])[w] = 0.f;
  TileRegs tr;
  tr.k0 = tr.k1 = tr.v0 = tr.v1 = make_uint4(0, 0, 0, 0);
  const int nval = tq >= 31 ? (tq - 31) / 16 + 1 : 0;
  const int nvmax = (t0 + 31 - 31) / 16 + 1;
  const int ktn = (nvmax + 63) / 64;
  float m = -INFINITY, l = 0.f;
  tile_gload(tr, KCB, nullptr, tid);
  for (int kt = 0; kt < ktn; ++kt) {
    __syncthreads();
    tile_sstore(sm, tr, false, tid);
    __syncthreads();
    if (kt + 1 < ktn) tile_gload(tr, KCB + (size_t)(kt + 1) * 4096, nullptr, tid);
    qk_tile(sm->k, qf, s, lane);
    float tmax = -INFINITY;
#pragma unroll
    for (int ks2 = 0; ks2 < 2; ++ks2)
#pragma unroll
      for (int i = 0; i < 16; ++i) {
        const int n = kt * 64 + ks2 * 32 + (i & 3) + 8 * (i >> 2) + 4 * hh;
        s[ks2][i] = n < nval ? s[ks2][i] : -INFINITY;
        tmax = fmaxf(tmax, s[ks2][i]);
      }
    tmax = fmaxf(tmax, __shfl_xor(tmax, 32));
    const float mnew = fmaxf(m, tmax);
    const float msafe = mnew == -INFINITY ? 0.f : mnew;
    float ps = 0.f;
#pragma unroll
    for (int ks2 = 0; ks2 < 2; ++ks2)
#pragma unroll
      for (int i = 0; i < 16; ++i) ps += fexp2(s[ks2][i] - msafe);
    l = l * fexp2(m - msafe) + ps;
    m = mnew;
  }
  {
    const float ltot = l + __shfl_xor(l, 32);
    const float invl = ltot > 0.f ? 1.f / ltot : 0.f;
    const float msafe = m == -INFINITY ? 0.f : m;
    tile_gload(tr, KCB, VCT, tid);
    for (int kt = 0; kt < ktn; ++kt) {
      __syncthreads();
      tile_sstore(sm, tr, true, tid);
      __syncthreads();
      if (kt + 1 < ktn) tile_gload(tr, KCB + (size_t)(kt + 1) * 4096, VCT + (size_t)(kt + 1) * 4096, tid);
      qk_tile(sm->k, qf, s, lane);
#pragma unroll
      for (int ks2 = 0; ks2 < 2; ++ks2)
#pragma unroll
        for (int i = 0; i < 16; ++i) {
          const int n = kt * 64 + ks2 * 32 + (i & 3) + 8 * (i >> 2) + 4 * hh;
          s[ks2][i] = n < nval ? fexp2(s[ks2][i] - msafe) * invl : 0.f;
        }
#pragma unroll
      for (int ks2 = 0; ks2 < 2; ++ks2)
#pragma unroll
        for (int g4 = 0; g4 < 4; ++g4) {
          float A = 2.f * (s[ks2][4 * g4] + s[ks2][4 * g4 + 1] + s[ks2][4 * g4 + 2]) + s[ks2][4 * g4 + 3];
          float Bv = s[ks2][4 * g4 + 3];
          A = quad_sum(A); Bv = quad_sum(Bv);
          const int j = kt * 16 + ks2 * 8 + 2 * g4 + hh;
          if (h == 0 && j < NBLK) sm->imp[trow][j] += A;
          WAVE_SYNC();
          if (h == 0 && j + 1 < NBLK) sm->imp[trow][j + 1] += Bv;
          WAVE_SYNC();
        }
      pv_tile(sm->vt, s, o, lane);
    }
#pragma unroll
    for (int mt = 0; mt < 2; ++mt)
#pragma unroll
      for (int g4 = 0; g4 < 4; ++g4) {
        st4(mixrow + mt * 32 + 8 * g4, make_float4(o[mt][4 * g4] * g0, o[mt][4 * g4 + 1] * g0, o[mt][4 * g4 + 2] * g0, o[mt][4 * g4 + 3] * g0));
        o[mt][4 * g4] = 0.f; o[mt][4 * g4 + 1] = 0.f; o[mt][4 * g4 + 2] = 0.f; o[mt][4 * g4 + 3] = 0.f;
      }
  }
  WAVE_SYNC();
  for (int t8 = 0; t8 < 8; ++t8) {
    const int row = wave * 8 + t8, tt = t0 + row, cur = tt >> 6;
    float kv[2]; bool valid[2];
#pragma unroll
    for (int c2 = 0; c2 < 2; ++c2) {
      const int j = lane + 64 * c2;
      valid[c2] = j < NBLK && j <= cur;
      const bool forced = (j == 0) | (j == cur) | (j == cur - 1);
      kv[c2] = valid[c2] ? (forced ? 1e6f : sm->imp[row][j < NBLK ? j : 0]) : -1.f;
      sm->keyb[wave][j] = kv[c2];
    }
    WAVE_SYNC();
    int rank0 = 0, rank1 = 0;
    const int jlim = cur < NBLK - 1 ? cur : NBLK - 1;
    for (int jj = 0; jj <= jlim; ++jj) {
      const float ov = sm->keyb[wave][jj];
      rank0 += (ov > kv[0] || (ov == kv[0] && jj < lane)) ? 1 : 0;
      rank1 += (ov > kv[1] || (ov == kv[1] && jj < lane + 64)) ? 1 : 0;
    }
    const unsigned long long m0 = __ballot(valid[0] && rank0 < 16);
    const unsigned long long m1 = __ballot(valid[1] && rank1 < 16);
    if (lane == 0) {
      sm->selmask[row][0] = (unsigned)m0; sm->selmask[row][1] = (unsigned)(m0 >> 32);
      sm->selmask[row][2] = (unsigned)m1; sm->selmask[row][3] = (unsigned)(m1 >> 32);
    }
    WAVE_SYNC();
  }
  __syncthreads();
  if (tid < 4) {
    unsigned u = 0;
    for (int r = 0; r < 32; ++r) u |= sm->selmask[r][tid];
    sm->unionm[tid] = u;
  }
  __syncthreads();
  const unsigned um0 = sm->unionm[0], um1 = sm->unionm[1], um2 = sm->unionm[2], um3 = sm->unionm[3];
  const unsigned my0 = sm->selmask[trow][0], my1 = sm->selmask[trow][1], my2 = sm->selmask[trow][2], my3 = sm->selmask[trow][3];
  {
    const int jmax = (t0 + 31) >> 6;
    int j = 0;
    while (j <= jmax && !testbit4(um0, um1, um2, um3, j)) ++j;
    m = -INFINITY; l = 0.f;
    if (j <= jmax) tile_gload(tr, KSB + (size_t)j * 4096, VST + (size_t)j * 4096, tid);
    while (j <= jmax) {
      __syncthreads();
      tile_sstore(sm, tr, true, tid);
      __syncthreads();
      int jn = j + 1;
      while (jn <= jmax && !testbit4(um0, um1, um2, um3, jn)) ++jn;
      if (jn <= jmax) tile_gload(tr, KSB + (size_t)jn * 4096, VST + (size_t)jn * 4096, tid);
      const bool mine = testbit4(my0, my1, my2, my3, j);
      if (__ballot(mine) != 0ull) {
        qk_tile(sm->k, qf, s, lane);
#pragma unroll
        for (int ks2 = 0; ks2 < 2; ++ks2)
#pragma unroll
          for (int i = 0; i < 16; ++i) {
            const int kp = j * 64 + ks2 * 32 + (i & 3) + 8 * (i >> 2) + 4 * hh;
            s[ks2][i] = (mine && kp <= tq) ? s[ks2][i] : -INFINITY;
          }
        softmax_step(s, m, l, o);
        pv_tile(sm->vt, s, o, lane);
      }
      j = jn;
    }
    const float ltot = l + __shfl_xor(l, 32);
    const float sc = ltot > 0.f ? g1 / ltot : 0.f;
#pragma unroll
    for (int mt = 0; mt < 2; ++mt)
#pragma unroll
      for (int g4 = 0; g4 < 4; ++g4) {
        float4 a = ld4(mixrow + mt * 32 + 8 * g4);
        a.x += o[mt][4 * g4] * sc; a.y += o[mt][4 * g4 + 1] * sc; a.z += o[mt][4 * g4 + 2] * sc; a.w += o[mt][4 * g4 + 3] * sc;
        st4(mixrow + mt * 32 + 8 * g4, a);
        o[mt][4 * g4] = 0.f; o[mt][4 * g4 + 1] = 0.f; o[mt][4 * g4 + 2] = 0.f; o[mt][4 * g4 + 3] = 0.f;
      }
  }
  {
    const int jlo = t0 - 511 > 0 ? (t0 - 511) >> 6 : 0, jhi = (t0 + 31) >> 6;
    const int wq0 = t0 + wave * 8;
    m = -INFINITY; l = 0.f;
    tile_gload(tr, KWB + (size_t)jlo * 4096, VWT + (size_t)jlo * 4096, tid);
    for (int j = jlo; j <= jhi; ++j) {
      __syncthreads();
      tile_sstore(sm, tr, true, tid);
      __syncthreads();
      if (j + 1 <= jhi) tile_gload(tr, KWB + (size_t)(j + 1) * 4096, VWT + (size_t)(j + 1) * 4096, tid);
      if (j * 64 <= wq0 + 7 && j * 64 + 63 > wq0 - 512) {
        qk_tile(sm->k, qf, s, lane);
#pragma unroll
        for (int ks2 = 0; ks2 < 2; ++ks2)
#pragma unroll
          for (int i = 0; i < 16; ++i) {
            const int kp = j * 64 + ks2 * 32 + (i & 3) + 8 * (i >> 2) + 4 * hh;
            s[ks2][i] = (kp <= tq && kp > tq - 512) ? s[ks2][i] : -INFINITY;
          }
        softmax_step(s, m, l, o);
        pv_tile(sm->vt, s, o, lane);
      }
    }
    const float ltot = l + __shfl_xor(l, 32);
    const float sc = ltot > 0.f ? g2 / ltot : 0.f;
#pragma unroll
    for (int mt = 0; mt < 2; ++mt)
#pragma unroll
      for (int g4 = 0; g4 < 4; ++g4) {
        float4 a = ld4(mixrow + mt * 32 + 8 * g4);
        a.x += o[mt][4 * g4] * sc; a.y += o[mt][4 * g4 + 1] * sc; a.z += o[mt][4 * g4 + 2] * sc; a.w += o[mt][4 * g4 + 3] * sc;
        st4(mixrow + mt * 32 + 8 * g4, a);
        o[mt][4 * g4] = 0.f; o[mt][4 * g4 + 1] = 0.f; o[mt][4 * g4 + 2] = 0.f; o[mt][4 * g4 + 3] = 0.f;
      }
  }
}

#define P1_SMEM ((8 * 64 + 8 * 128 + 64 * 65 + 128) * 4)
DEV void phase_p1(const Params& p, char* smem) {
  const int total = P1_CMPG_ITEMS + P1_CMPC1_ITEMS + P1_PREP_ITEMS;
  for (int it = BIDX; it < total; it += gridDim.x) {
    if (it < P1_CMPG_ITEMS) p1_cmpgemm(p, it, smem);
    else if (it < P1_CMPG_ITEMS + P1_CMPC1_ITEMS) p1_cmpc1(p, it - P1_CMPG_ITEMS, smem);
    else p1_prep(p, it - P1_CMPG_ITEMS - P1_CMPC1_ITEMS, smem);
  }
  {
    const int Gh = (int)gridDim.x / 2, bid_ = BIDX;
    if (bid_ < Gh) for (int it = bid_; it < P1_S5A_ITEMS; it += Gh) p1_s5a(p, it, smem);
  }
}
#define S5PFX_ITEMS (BATCH * 32 * 64 / NTHREADS)
DEV void s5_prefix(const Params& p, int item) {
  const int gi = item * NTHREADS + TIDX;
  const int lane = gi & 63, g = (gi >> 6) & 31, b = gi >> 11;
  float lb_re, lb_im, bbr[16], bbi[16];
  s5_consts(p, g, lane, lb_re, lb_im, bbr, bbi);
  float ar = lb_re, ai = lb_im;
#pragma unroll
  for (int s = 0; s < 6; ++s) { const float nr = ar * ar - ai * ai, ni = 2.f * ar * ai; ar = nr; ai = ni; }
  float2* E = (float2*)(p.ws + OFF_S5E) + ((size_t)b * S5_NC * 32 + g) * 64 + lane;
  float sr = 0.f, si = 0.f;
  for (int c = 0; c < S5_NC; c += 8) {
    float2 e[8];
#pragma unroll
    for (int q = 0; q < 8; ++q) e[q] = E[(size_t)(c + q) * 32 * 64];
#pragma unroll
    for (int q = 0; q < 8; ++q) {
      E[(size_t)(c + q) * 32 * 64] = make_float2(sr, si);
      const float nr = ar * sr - ai * si + e[q].x, ni = ar * si + ai * sr + e[q].y;
      sr = nr; si = ni;
    }
  }
}
DEV void phase_p1b(const Params& p, char* smem) {
  for (int it = BIDX; it < P1_CMP_ITEMS; it += gridDim.x) p1_compress(p, it, smem);
  for (int it = (int)gridDim.x - 1 - (int)BIDX; it < S5PFX_ITEMS; it += gridDim.x) s5_prefix(p, it);
}

#define P2_S5C_ITEMS (BATCH * 32 * S5_NC / 4)
#define S5C_ROW 132
#define P2_S5C_SMEM ((4 * 16 * S5C_ROW + 2 * 16 * 64 + 4 * 16 * 16) * 4)
DEV void p2_s5c(const Params& p, int item, char* smem) {
  const int lane = TIDX & 63, wave = TIDX >> 6, tid = TIDX;
  const int g = item & 31, c = ((item >> 5) % (S5_NC / 4)) * 4 + wave, b = item / (32 * (S5_NC / 4));
  float lb_re, lb_im, bbr[16], bbi[16];
  s5_consts(p, g, lane, lb_re, lb_im, bbr, bbi);
  const float2* E = (const float2*)(p.ws + OFF_S5E);
  const float2 e0 = E[((size_t)(b * S5_NC + c) * 32 + g) * 64 + lane];
  float sr = e0.x, si = e0.y;
  const float* H = (const float*)(p.ws + OFF_H);
  float* sS = (float*)smem + wave * 16 * S5C_ROW;
  float* sCre = (float*)smem + 4 * 16 * S5C_ROW;
  float* sCim = sCre + 16 * 64;
  float* su = sCim + 16 * 64 + wave * 16 * 16;
  __syncthreads();
  {
    const float* cre = p.in[I_S5_C_RE] + (size_t)g * 16 * 64;
    const float* cim = p.in[I_S5_C_IM] + (size_t)g * 16 * 64;
    st4(sCre + tid * 4, ld4(cre + tid * 4));
    st4(sCim + tid * 4, ld4(cim + tid * 4));
  }
  float* YG = (float*)(p.ws + OFF_YGELU);
  for (int sc = 0; sc < 4; ++sc) {
    {
      const float* ur = H + (size_t)(b * SEQ_LEN + c * 64 + sc * 16 + (lane >> 2)) * AB_LD + g * 16 + (lane & 3) * 4;
      st4(su + (lane >> 2) * 16 + (lane & 3) * 4, ld4(ur));
    }
    WAVE_SYNC();
    for (int tt = 0; tt < 16; ++tt) {
      const float* u = su + tt * 16;
      float dr = 0.f, di = 0.f;
#pragma unroll
      for (int h4 = 0; h4 < 4; ++h4) {
        const float4 uv = ld4(u + h4 * 4);
        dr += uv.x * bbr[h4 * 4] + uv.y * bbr[h4 * 4 + 1] + uv.z * bbr[h4 * 4 + 2] + uv.w * bbr[h4 * 4 + 3];
        di += uv.x * bbi[h4 * 4] + uv.y * bbi[h4 * 4 + 1] + uv.z * bbi[h4 * 4 + 2] + uv.w * bbi[h4 * 4 + 3];
      }
      const float nr = lb_re * sr - lb_im * si + dr, ni = lb_re * si + lb_im * sr + di;
      sr = nr; si = ni;
      sS[tt * S5C_ROW + lane] = sr;
      sS[tt * S5C_ROW + 64 + lane] = si;
    }
    __syncthreads();
    {
      const int tt = lane >> 2, hq = lane & 3;
      float y[4] = {0.f, 0.f, 0.f, 0.f};
#pragma unroll 2
      for (int k = 0; k < 64; k += 4) {
        const float4 vr = ld4(sS + tt * S5C_ROW + k), vi = ld4(sS + tt * S5C_ROW + 64 + k);
#pragma unroll
        for (int hh = 0; hh < 4; ++hh) {
          const float4 cr = ld4(sCre + (hq * 4 + hh) * 64 + k), ci = ld4(sCim + (hq * 4 + hh) * 64 + k);
          y[hh] += vr.x * cr.x + vr.y * cr.y + vr.z * cr.z + vr.w * cr.w - (vi.x * ci.x + vi.y * ci.y + vi.z * ci.z + vi.w * ci.w);
        }
      }
      const size_t tok = (size_t)(b * SEQ_LEN + c * 64 + sc * 16 + tt);
      const int ch = g * 16 + hq * 4;
      const float4 uv = ld4(H + tok * AB_LD + ch);
      const float4 dv = ld4(p.in[I_S5_D] + ch);
      float4 o;
      o.x = geluf_(y[0] + dv.x * uv.x); o.y = geluf_(y[1] + dv.y * uv.y);
      o.z = geluf_(y[2] + dv.z * uv.z); o.w = geluf_(y[3] + dv.w * uv.w);
      st4(YG + tok * 512 + ch, o);
    }
    __syncthreads();
  }
}

#define P2_SMEM (P2_S5C_SMEM > P2_NSA_SMEM ? P2_S5C_SMEM : P2_NSA_SMEM)
DEV void phase_p2(const Params& p, char* smem) {
  const int G = gridDim.x;
  const int total = P2_NSA_ITEMS + P2_S5C_ITEMS;
  for (int r = 0;; ++r) {
    const int it = r * G + ((r & 1) ? (G - 1 - (int)BIDX) : (int)BIDX);
    if (r * G >= total) break;
    if (it >= total) continue;
    if (it < P2_NSA_ITEMS) p2_nsa(p, it, smem);
    else p2_s5c(p, it - P2_NSA_ITEMS, smem);
  }
}

DEV void phase_glu(const Params& p, char* smem) {
  const float* A = (const float*)(p.ws + OFF_YGELU);
  const float* B = p.in[I_S5_W_GLU];
  const float* bias = p.in[I_S5_B_GLU];
  float* MIX = (float*)(p.ws + OFF_MIX);
  const int NT = 4, MT = NTOK / GEMM_BM;
  const int xcd_ = BIDX & 7, lb_ = BIDX >> 3, nb_ = gridDim.x >> 3;
  for (int j_ = lb_; j_ < (MT / 8) * NT; j_ += nb_) {
    const int it = (xcd_ + 8 * (j_ / NT)) * NT + (j_ % NT);
    const int m0 = (it / NT) * GEMM_BM, n0 = (it % NT) * 128;
    gemm_tile<false>(
        [&](int r) { return (const void*)(A + (size_t)(m0 + r) * 512); },
        [&](int c) { return B + n0 + c; }, 512, 512,
        [&](int row, int col, float v0, float v1) {
          const size_t gm = m0 + row; const int gc = n0 + col;
          const float y0 = A[gm * 512 + gc], y1 = A[gm * 512 + gc + 32];
          MIX[gm * 1024 + gc] = y0 * sigmoidf_(v0 + bias[gc]);
          MIX[gm * 1024 + gc + 32] = y1 * sigmoidf_(v1 + bias[gc + 32]);
        },
        smem);
  }
}

template <int LAYER>
DEV void phase_outproj(const Params& p, char* smem) {
  const float* A = (const float*)(p.ws + OFF_MIX);
  const float* B = LAYER == 0 ? p.in[I_AB_W_OUT] : p.in[I_CD_W_OUT];
  const float* xin = LAYER == 0 ? p.in[I_X] : (const float*)(p.ws + OFF_X2);
  float* PRE = (float*)(p.ws + OFF_H);
  const int NT = 8, MT = NTOK / GEMM_BM;
  const int xcd_ = BIDX & 7, lb_ = BIDX >> 3, nb_ = gridDim.x >> 3;
  for (int j_ = lb_; j_ < (MT / 8) * NT; j_ += nb_) {
    const int it = (xcd_ + 8 * (j_ / NT)) * NT + (j_ % NT);
    const int m0 = (it / NT) * GEMM_BM, n0 = (it % NT) * 128;
    gemm_tile<false>(
        [&](int r) { return (const void*)(A + (size_t)(m0 + r) * 1024); },
        [&](int c) { return B + n0 + c; }, 1024, 1024,
        [&](int row, int col, float v0, float v1) {
          const size_t o = (size_t)(m0 + row) * 1024 + n0 + col;
          PRE[o] = ALPHA_F * xin[o] + v0;
          PRE[o + 32] = ALPHA_F * xin[o + 32] + v1;
        },
        smem);
  }
}

DEV void wave_ln(float (&v)[16], const float* gam, const float* bet, int lane) {
  float s = 0.f;
#pragma unroll
  for (int i = 0; i < 16; ++i) s += v[i];
  const float mu = wave_sum(s) * (1.f / 1024.f);
  float q = 0.f;
#pragma unroll
  for (int i = 0; i < 16; ++i) { const float d = v[i] - mu; q += d * d; }
  const float rstd = rsqrtf(wave_sum(q) * (1.f / 1024.f) + 1e-5f);
#pragma unroll
  for (int i = 0; i < 4; ++i) {
    const float4 gv = ld4(gam + lane * 4 + 256 * i), bv = ld4(bet + lane * 4 + 256 * i);
    v[i * 4 + 0] = (v[i * 4 + 0] - mu) * rstd * gv.x + bv.x;
    v[i * 4 + 1] = (v[i * 4 + 1] - mu) * rstd * gv.y + bv.y;
    v[i * 4 + 2] = (v[i * 4 + 2] - mu) * rstd * gv.z + bv.z;
    v[i * 4 + 3] = (v[i * 4 + 3] - mu) * rstd * gv.w + bv.w;
  }
}

#define LNR_T 4
#define P5_SMEM ((4 * LNR_T * 512 + 4 * 4 * LNR_T * 64 + 4 * 64) * 4)
template <int LAYER>
DEV void phase_ln_router(const Params& p, char* smem) {
  const int lane = TIDX & 63, wave = TIDX >> 6;
  const float* PRE = (const float*)(p.ws + OFF_H);
  float* X1 = (float*)(p.ws + OFF_X1);
  const float* router = p.in[I_ROUTER] + (size_t)LAYER * 1024 * 64;
  const float* bias = p.in[I_MOE_BIAS] + LAYER * 64;
  int* TOPI = (int*)(p.ws + OFF_TOPI);
  float* TOPG = (float*)(p.ws + OFF_TOPG);
  float* xh = (float*)smem;
  float* part = xh + 4 * LNR_T * 512;
  float* ms = part + 4 * 4 * LNR_T * 64 + wave * 64;
  unsigned short* X1B = (unsigned short*)p.out;
  for (int it = BIDX; it < NTOK / (4 * LNR_T); it += gridDim.x) {
    const size_t tokb = (size_t)it * (4 * LNR_T) + wave * LNR_T;
    float v[LNR_T][16];
#pragma unroll
    for (int t = 0; t < LNR_T; ++t) {
      const size_t tok = tokb + t;
#pragma unroll
      for (int i = 0; i < 4; ++i) {
        const float4 a = ld4(PRE + tok * 1024 + lane * 4 + 256 * i);
        v[t][i * 4] = a.x; v[t][i * 4 + 1] = a.y; v[t][i * 4 + 2] = a.z; v[t][i * 4 + 3] = a.w;
      }
      wave_ln(v[t], p.in[I_LN1_G] + LAYER * 1024, p.in[I_LN1_B] + LAYER * 1024, lane);
#pragma unroll
      for (int i = 0; i < 4; ++i) {
        const float4 a = make_float4(v[t][i * 4], v[t][i * 4 + 1], v[t][i * 4 + 2], v[t][i * 4 + 3]);
        st4(X1 + tok * 1024 + lane * 4 + 256 * i, a);
        *(uint2*)(X1B + tok * 1024 + lane * 4 + 256 * i) = make_uint2(pk2(a.x, a.y), pk2(a.z, a.w));
      }
    }
    {
      float pl[4 * LNR_T];
#pragma unroll
      for (int t = 0; t < 4 * LNR_T; ++t) pl[t] = 0.f;
#pragma unroll
      for (int hf = 0; hf < 2; ++hf) {
        __syncthreads();
#pragma unroll
        for (int t = 0; t < LNR_T; ++t)
#pragma unroll
          for (int i2 = 0; i2 < 2; ++i2) {
            const int i = 2 * hf + i2;
            st4(xh + (wave * LNR_T + t) * 512 + lane * 4 + 256 * i2, make_float4(v[t][i * 4], v[t][i * 4 + 1], v[t][i * 4 + 2], v[t][i * 4 + 3]));
          }
        __syncthreads();
#pragma unroll 2
        for (int kk = wave * 128; kk < wave * 128 + 128; kk += 4) {
          const int k = hf * 512 + kk;
          const float r0 = router[(size_t)k * 64 + lane], r1 = router[(size_t)(k + 1) * 64 + lane],
                      r2 = router[(size_t)(k + 2) * 64 + lane], r3 = router[(size_t)(k + 3) * 64 + lane];
#pragma unroll
          for (int t = 0; t < 4 * LNR_T; ++t) {
            const float4 xv = ld4(xh + t * 512 + kk);
            pl[t] += xv.x * r0 + xv.y * r1 + xv.z * r2 + xv.w * r3;
          }
        }
      }
#pragma unroll
      for (int t = 0; t < 4 * LNR_T; ++t) part[(wave * 4 * LNR_T + t) * 64 + lane] = pl[t];
    }
    __syncthreads();
    float lg[LNR_T];
#pragma unroll
    for (int t = 0; t < LNR_T; ++t) {
      const int tg = wave * LNR_T + t;
      lg[t] = ((part[(0 * 4 * LNR_T + tg) * 64 + lane] + part[(1 * 4 * LNR_T + tg) * 64 + lane]) + part[(2 * 4 * LNR_T + tg) * 64 + lane]) +
              part[(3 * 4 * LNR_T + tg) * 64 + lane];
    }
#pragma unroll
    for (int t = 0; t < LNR_T; ++t) {
      const size_t tok = tokb + t;
      const float score = 1.f / (1.f + expf(-lg[t]));
      const float biased = score + bias[lane];
      float m1 = biased; int a1 = lane;
#pragma unroll
      for (int mm = 1; mm <= 4; mm <<= 1) {
        const float ov = __shfl_xor(m1, mm); const int oa = __shfl_xor(a1, mm);
        if (ov > m1 || (ov == m1 && oa < a1)) { m1 = ov; a1 = oa; }
      }
      float m2 = lane == a1 ? -INFINITY : biased;
#pragma unroll
      for (int mm = 1; mm <= 4; mm <<= 1) m2 = fmaxf(m2, __shfl_xor(m2, mm));
      const float gs = m1 + m2;
      const int mygrp = lane >> 3;
      int rank = 0;
#pragma unroll
      for (int gg = 0; gg < 8; ++gg) {
        const float og = __shfl(gs, gg * 8);
        rank += (og > gs || (og == gs && gg < mygrp)) ? 1 : 0;
      }
      const float masked = rank < 4 ? biased : -INFINITY;
      WAVE_SYNC();
      ms[lane] = masked;
      WAVE_SYNC();
      int erank = 0;
      for (int e = 0; e < 64; ++e) {
        const float ov = ms[e];
        erank += (ov > masked || (ov == masked && e < lane)) ? 1 : 0;
      }
      const bool selected = erank < 8;
      const float gsum = wave_sum(selected ? score : 0.f);
      if (selected) {
        TOPI[tok * 8 + erank] = lane;
        TOPG[tok * 8 + erank] = score / gsum * 2.5f;
      }
    }
  }
}

#define P6_SMEM GEMM_SMEM_BYTES
template <int LAYER>
DEV void phase_lists_shup(const Params& p, char* smem) {
  const int tid = TIDX, lane = tid & 63, wave = tid >> 6;
  const int* TOPI = (const int*)(p.ws + OFF_TOPI);
  const float* TOPG = (const float*)(p.ws + OFF_TOPG);
  int* PPOS = (int*)(p.ws + OFF_S5E);
  int* CNT = (int*)(p.ws + OFF_CNT);
  int* LTOK = (int*)(p.ws + OFF_LTOK);
  float* LGATE = (float*)(p.ws + OFF_LGATE);
  const unsigned short* X1B = (const unsigned short*)p.out;
  unsigned short* HS = (unsigned short*)(p.ws + OFF_HS);
  const float* W1 = p.in[I_SH_W1] + (size_t)LAYER * 1024 * 256;
  const float* W3 = p.in[I_SH_W3] + (size_t)LAYER * 1024 * 256;
  const int MT = NTOK / GEMM_BM;
  int* swave = (int*)smem;
  for (int it = BIDX; it < 64; it += gridDim.x) {
    const int e = it;
    int base = 0;
    for (int t0 = 0; t0 < NTOK; t0 += 4 * NTHREADS) {
      const int tok4 = t0 + 4 * tid;
      int slot[4];
      unsigned long long bal[4];
#pragma unroll
      for (int j = 0; j < 4; ++j) {
        const int4 a = *(const int4*)(TOPI + (size_t)(tok4 + j) * 8), b = *(const int4*)(TOPI + (size_t)(tok4 + j) * 8 + 4);
        int sl = -1;
        sl = a.x == e ? 0 : sl; sl = a.y == e ? 1 : sl; sl = a.z == e ? 2 : sl; sl = a.w == e ? 3 : sl;
        sl = b.x == e ? 4 : sl; sl = b.y == e ? 5 : sl; sl = b.z == e ? 6 : sl; sl = b.w == e ? 7 : sl;
        slot[j] = sl;
        bal[j] = __ballot(sl >= 0);
      }
      const unsigned long long lower = (1ull << lane) - 1ull;
      int pre = 0, wtot = 0;
#pragma unroll
      for (int j = 0; j < 4; ++j) { pre += __popcll(bal[j] & lower); wtot += __popcll(bal[j]); }
      __syncthreads();
      if (lane == 0) swave[wave] = wtot;
      __syncthreads();
      int woff = 0, tot = 0;
#pragma unroll
      for (int w = 0; w < 4; ++w) { const int c = swave[w]; if (w < wave) woff += c; tot += c; }
      int pos = base + woff + pre;
#pragma unroll
      for (int j = 0; j < 4; ++j) {
        if (slot[j] >= 0) {
          const int tok = tok4 + j;
          LTOK[(size_t)e * NTOK + pos] = tok;
          LGATE[(size_t)e * NTOK + pos] = TOPG[(size_t)tok * 8 + slot[j]];
          PPOS[(size_t)e * NTOK + tok] = pos;
          ++pos;
        }
      }
      base += tot;
    }
    if (tid == 0) CNT[e * 32] = base;
    __syncthreads();
  }
  {
    const int NT = 4;
    const int xcd_ = BIDX & 7, lb_ = BIDX >> 3, nb_ = gridDim.x >> 3;
    for (int j_ = lb_; j_ < (MT / 8) * NT; j_ += nb_) {
      const int m0 = (xcd_ + 8 * (j_ / NT)) * GEMM_BM, ct = j_ % NT;
      gemm_tile<true>(
          [&](int r) { return (const void*)(X1B + (size_t)(m0 + r) * 1024); },
          [&](int c) { return (((c >> 5) & 1) ? W3 : W1) + ct * 64 + (c >> 6) * 32 + (c & 31); }, 256, 1024,
          [&](int row, int col, float v0, float v1) {
            const int lc = ct * 64 + (col >> 6) * 32 + (col & 31);
            HS[(size_t)(m0 + row) * 256 + lc] = f2bf(siluf_(v0) * v1);
          },
          smem);
    }
  }
}

struct ExpMap { int tstart[65]; int rbase[65]; int ltile[9]; };
DEV void build_expmap(const Params& p, ExpMap* em) {
  __syncthreads();
  if (TIDX == 0) {
    const int* CNT = (const int*)(p.ws + OFF_CNT);
    int ts = 0, rb = 0;
    for (int e = 0; e < 64; ++e) {
      em->tstart[e] = ts; em->rbase[e] = rb;
      const int c = CNT[e * 32];
      ts += (c + GEMM_BM - 1) / GEMM_BM; rb += c;
    }
    em->tstart[64] = ts; em->rbase[64] = rb;
    const int x = BIDX & 7;
    int lt = 0;
    for (int k = 0; k < 8; ++k) { em->ltile[k] = lt; lt += em->tstart[x + 8 * k + 1] - em->tstart[x + 8 * k]; }
    em->ltile[8] = lt;
  }
  __syncthreads();
}
DEV void map_expert_tile(const ExpMap* em, int j, int CT, int& e, int& rt, int& ct) {
  const int jr = j / CT; ct = j % CT;
  int k = 0;
  for (int q = 1; q < 8; ++q) if (em->ltile[q] <= jr) k = q;
  e = (BIDX & 7) + 8 * k; rt = jr - em->ltile[k];
}
#define P7_SMEM (GEMM_SMEM_BYTES + 1024)
template <int LAYER>
DEV void phase_routed_up(const Params& p, char* smem) {
  ExpMap* em = (ExpMap*)(smem + GEMM_SMEM_BYTES);
  build_expmap(p, em);
  const int* CNT = (const int*)(p.ws + OFF_CNT);
  const int* LTOK = (const int*)(p.ws + OFF_LTOK);
  const unsigned short* X1B = (const unsigned short*)p.out;
  unsigned short* HR = (unsigned short*)(p.ws + OFF_HR);
  const int lb_ = BIDX >> 3, nb_ = gridDim.x >> 3;
  for (int j_ = lb_; j_ < em->ltile[8] * 4; j_ += nb_) {
    int e, rtl, ct;
    map_expert_tile(em, j_, 4, e, rtl, ct);
    const int r0 = rtl * GEMM_BM;
    const int cnt = CNT[e * 32], rbase = em->rbase[e];
    const float* W1 = p.in[I_MOE_W1] + ((size_t)LAYER * 64 + e) * 1024 * 256;
    const float* W3 = p.in[I_MOE_W3] + ((size_t)LAYER * 64 + e) * 1024 * 256;
    gemm_tile<true>(
        [&](int r) { return (r0 + r < cnt) ? (const void*)(X1B + (size_t)LTOK[(size_t)e * NTOK + r0 + r] * 1024) : (const void*)nullptr; },
        [&](int c) { return (((c >> 5) & 1) ? W3 : W1) + ct * 64 + (c >> 6) * 32 + (c & 31); }, 256, 1024,
        [&](int row, int col, float v0, float v1) {
          if (r0 + row < cnt) {
            const int lc = ct * 64 + (col >> 6) * 32 + (col & 31);
            HR[(size_t)(rbase + r0 + row) * 256 + lc] = f2bf(siluf_(v0) * v1);
          }
        },
        smem);
  }
}

template <int LAYER>
DEV void phase_down(const Params& p, char* smem) {
  ExpMap* em = (ExpMap*)(smem + GEMM_SMEM_BYTES);
  build_expmap(p, em);
  const int* CNT = (const int*)(p.ws + OFF_CNT);
  const float* LGATE = (const float*)(p.ws + OFF_LGATE);
  const unsigned short* HR = (const unsigned short*)(p.ws + OFF_HR);
  const unsigned short* HS = (const unsigned short*)(p.ws + OFF_HS);
  unsigned short* Y = (unsigned short*)(p.ws + OFF_Y);
  float* FS = (float*)(p.ws + OFF_FS);
  const int xcd_ = BIDX & 7, lb_ = BIDX >> 3, nb_ = gridDim.x >> 3;
  for (int j_ = lb_; j_ < em->ltile[8] * 8; j_ += nb_) {
    int e, rtl, ct;
    map_expert_tile(em, j_, 8, e, rtl, ct);
    const int r0 = rtl * GEMM_BM;
    const int cnt = CNT[e * 32], rbase = em->rbase[e];
    const float* W2 = p.in[I_MOE_W2] + ((size_t)LAYER * 64 + e) * 256 * 1024;
    const int n0 = ct * 128;
    gemm_tile<true>(
        [&](int r) { return (r0 + r < cnt) ? (const void*)(HR + (size_t)(rbase + r0 + r) * 256) : (const void*)nullptr; },
        [&](int c) { return W2 + n0 + c; }, 1024, 256,
        [&](int row, int col, float v0, float v1) {
          if (r0 + row < cnt) {
            const float gt = LGATE[(size_t)e * NTOK + r0 + row];
            const size_t o = (size_t)(rbase + r0 + row) * 1024 + n0 + col;
            Y[o] = f2bf(v0 * gt); Y[o + 32] = f2bf(v1 * gt);
          }
        },
        smem);
  }
  {
    const int MT = NTOK / GEMM_BM, NT = 8;
    const float* W2 = p.in[I_SH_W2] + (size_t)LAYER * 256 * 1024;
    for (int j_ = lb_; j_ < (MT / 8) * NT; j_ += nb_) {
      const int m0 = (xcd_ + 8 * (j_ / NT)) * GEMM_BM, n0 = (j_ % NT) * 128;
      gemm_tile<true>(
          [&](int r) { return (const void*)(HS + (size_t)(m0 + r) * 256); },
          [&](int c) { return W2 + n0 + c; }, 1024, 256,
          [&](int row, int col, float v0, float v1) {
            const size_t o = (size_t)(m0 + row) * 1024 + n0 + col;
            FS[o] = v0; FS[o + 32] = v1;
          },
          smem);
    }
  }
}

template <int LAYER>
DEV void phase_combine(const Params& p, char* smem) {
  ExpMap* em = (ExpMap*)smem;
  build_expmap(p, em);
  const int lane = TIDX & 63, wave = TIDX >> 6;
  const float* X1 = (const float*)(p.ws + OFF_X1);
  const float* FS = (const float*)(p.ws + OFF_FS);
  const unsigned short* Y = (const unsigned short*)(p.ws + OFF_Y);
  const int* TOPI = (const int*)(p.ws + OFF_TOPI);
  const int* PPOS = (const int*)(p.ws + OFF_S5E);
  float* OUT = LAYER == 0 ? (float*)(p.ws + OFF_X2) : p.out;
  for (int it = BIDX; it < NTOK / 4; it += gridDim.x) {
    const size_t tok = (size_t)it * 4 + wave;
    float v[16];
#pragma unroll
    for (int i = 0; i < 4; ++i) {
      const float4 a = ld4(X1 + tok * 1024 + lane * 4 + 256 * i), f = ld4(FS + tok * 1024 + lane * 4 + 256 * i);
      v[i * 4] = ALPHA_F * a.x + f.x; v[i * 4 + 1] = ALPHA_F * a.y + f.y; v[i * 4 + 2] = ALPHA_F * a.z + f.z; v[i * 4 + 3] = ALPHA_F * a.w + f.w;
    }
    size_t rows[8];
#pragma unroll
    for (int s = 0; s < 8; ++s) { const int e_ = TOPI[tok * 8 + s]; rows[s] = (size_t)em->rbase[e_] + PPOS[(size_t)e_ * NTOK + tok]; }
#pragma unroll
    for (int s0 = 0; s0 < 8; s0 += 4) {
      uint2 yy[4][4];
#pragma unroll
      for (int s = 0; s < 4; ++s)
#pragma unroll
        for (int i = 0; i < 4; ++i) yy[s][i] = *(const uint2*)(Y + rows[s0 + s] * 1024 + lane * 4 + 256 * i);
#pragma unroll
      for (int s = 0; s < 4; ++s)
#pragma unroll
        for (int i = 0; i < 4; ++i) {
          const uint2 y = yy[s][i];
          v[i * 4] += bf2f((unsigned short)(y.x & 0xFFFF)); v[i * 4 + 1] += bf2f((unsigned short)(y.x >> 16));
          v[i * 4 + 2] += bf2f((unsigned short)(y.y & 0xFFFF)); v[i * 4 + 3] += bf2f((unsigned short)(y.y >> 16));
        }
    }
    wave_ln(v, p.in[I_LN2_G] + LAYER * 1024, p.in[I_LN2_B] + LAYER * 1024, lane);
#pragma unroll
    for (int i = 0; i < 4; ++i) st4(OUT + tok * 1024 + lane * 4 + 256 * i, make_float4(v[i * 4], v[i * 4 + 1], v[i * 4 + 2], v[i * 4 + 3]));
    if (LAYER == 0) {
      unsigned short* X2B = (unsigned short*)(p.ws + OFF_X2B);
#pragma unroll
      for (int i = 0; i < 4; ++i) *(uint2*)(X2B + tok * 1024 + lane * 4 + 256 * i) = make_uint2(pk2(v[i * 4], v[i * 4 + 1]), pk2(v[i * 4 + 2], v[i * 4 + 3]));
    }
  }
}

DEV float shifted(const float* Hc, size_t tok, int col, const float* mu) {
  const float cur = Hc[tok * 1792 + col];
  const float prev = (tok % SEQ_LEN) == 0 ? 0.f : Hc[(tok - 1) * 1792 + col];
  return cur + (prev - cur) * mu[col];
}

#define RWP_T 32
#define P11_PREP_ITEMS (NTOK / RWP_T)
#define P11_KV_ITEMS (BATCH * 4 * RET_NC)
#define P11_SMEM (RWP_T * 128 * 4)
DEV void p11_prep(const Params& p, int item, char* smem) {
  const int tid = TIDX;
  const float* Hc = (const float*)(p.ws + OFF_H);
  const float* mu = p.in[I_RW_MU];
  float* sl = (float*)smem;
  __syncthreads();
  for (int w = tid; w < RWP_T * 128; w += NTHREADS) {
    const int tt = w >> 7, j = w & 127;
    const size_t tok = (size_t)item * RWP_T + tt;
    const float v = shifted(Hc, tok, 1536 + j, mu);
    sl[w] = j < 64 ? tanhf(v) : v;
    ((float*)(p.ws + OFF_GLO))[tok * 128 + j] = sigmoidf_(shifted(Hc, tok, 1664 + j, mu));
  }
  __syncthreads();
  float* RWW = (float*)(p.ws + OFF_RWW); float* RWK = (float*)(p.ws + OFF_RWK);
  float* RWKK = (float*)(p.ws + OFF_RWKK); float* RWA = (float*)(p.ws + OFF_RWA);
  float* RWR = p.out + (size_t)NTOK * 512; float* RWV = p.out;
  const float* w_up = p.in[I_RW_W_UP]; const float* a_up = p.in[I_RW_A_UP];
#pragma unroll
  for (int cc = 0; cc < 2; ++cc) {
    const int c = tid + 256 * cc;
    float aw[RWP_T], aa[RWP_T];
#pragma unroll
    for (int tt = 0; tt < RWP_T; ++tt) { aw[tt] = 0.f; aa[tt] = 0.f; }
    for (int j0 = 0; j0 < 64; j0 += 16) {
      float wu[16], au[16];
#pragma unroll
      for (int q = 0; q < 16; ++q) { wu[q] = w_up[(j0 + q) * 512 + c]; au[q] = a_up[(j0 + q) * 512 + c]; }
#pragma unroll
      for (int q4 = 0; q4 < 4; ++q4) {
#pragma unroll
        for (int tt = 0; tt < RWP_T; ++tt) {
          const float4 sw = ld4(sl + tt * 128 + j0 + q4 * 4), sa = ld4(sl + tt * 128 + 64 + j0 + q4 * 4);
          aw[tt] += sw.x * wu[q4 * 4] + sw.y * wu[q4 * 4 + 1] + sw.z * wu[q4 * 4 + 2] + sw.w * wu[q4 * 4 + 3];
          aa[tt] += sa.x * au[q4 * 4] + sa.y * au[q4 * 4 + 1] + sa.z * au[q4 * 4 + 2] + sa.w * au[q4 * 4 + 3];
        }
      }
    }
    const float w0 = p.in[I_RW_W0][c], a0 = p.in[I_RW_A0][c], kkc = p.in[I_RW_K_K][c], kac = p.in[I_RW_K_A][c];
#pragma unroll 4
    for (int tt = 0; tt < RWP_T; ++tt) {
      const size_t tok = (size_t)item * RWP_T + tt;
      const float lw = w0 + aw[tt];
      const float nl = -lw;
      const float sp = nl > 20.f ? nl : log1pf(expf(nl));
      const float wl = -sp - 0.5f;
      const float decay = expf(-expf(wl));
      const float a = 1.f / (1.f + expf(-(a0 + aa[tt])));
      const float rs = shifted(Hc, tok, c, mu);
      const float ks = shifted(Hc, tok, 512 + c, mu);
      const float vs = shifted(Hc, tok, 1024 + c, mu);
      float kk = ks * kkc;
      const float nrm = sqrtf(wave_sum(kk * kk));
      kk = kk / fmaxf(nrm, 1e-12f);
      RWW[tok * 512 + c] = decay;
      RWK[tok * 512 + c] = ks * (1.f + (a - 1.f) * kac);
      RWKK[tok * 512 + c] = kk;
      RWA[tok * 512 + c] = kk * a;
      RWR[tok * 512 + c] = rs;
      RWV[tok * 512 + c] = vs;
    }
  }
}
DEV float ret_log2gamma(int h) { return log2f(1.f - exp2f(-5.f - (float)h)); }
struct KvSmem { unsigned short vt[128][72]; unsigned short kt[64][72]; };
#define P11_KV_SMEM ((int)sizeof(KvSmem))
DEV void p11_kv(const Params& p, int item, char* smem) {
  KvSmem* sm = (KvSmem*)smem;
  const int c = item % RET_NC, h = (item / RET_NC) & 3, b = item / (RET_NC * 4);
  const int tid = TIDX, lane = tid & 63, wave = tid >> 6;
  const int r = lane & 31, hh = lane >> 5;
  const float* H2 = (const float*)(p.ws + OFF_H2);
  const float lg = ret_log2gamma(h);
  const size_t tok0 = (size_t)b * SEQ_LEN + c * 128;
  f32x16 acc[2];
#pragma unroll
  for (int nt = 0; nt < 2; ++nt)
#pragma unroll
    for (int i = 0; i < 16; ++i) acc[nt][i] = 0.f;
#pragma unroll 1
  for (int kt = 0; kt < 2; ++kt) {
    __syncthreads();
#pragma unroll
    for (int q = 0; q < 8; ++q) {
      const int f = tid + 256 * q;
      const int key = f >> 5, d4 = (f & 31) * 4;
      const float dec = exp2f((float)(127 - (kt * 64 + key)) * lg);
      const float4 v = ld4(H2 + (tok0 + kt * 64 + key) * 1536 + 512 + h * 128 + d4);
      sm->vt[d4][key] = f2bf(v.x * dec); sm->vt[d4 + 1][key] = f2bf(v.y * dec);
      sm->vt[d4 + 2][key] = f2bf(v.z * dec); sm->vt[d4 + 3][key] = f2bf(v.w * dec);
    }
#pragma unroll
    for (int q = 0; q < 4; ++q) {
      const int f = tid + 256 * q;
      const int key = f >> 4, d4 = (f & 15) * 4;
      const float4 v = ld4(H2 + (tok0 + kt * 64 + key) * 1536 + 256 + h * 64 + d4);
      sm->kt[d4][key] = f2bf(v.x); sm->kt[d4 + 1][key] = f2bf(v.y); sm->kt[d4 + 2][key] = f2bf(v.z); sm->kt[d4 + 3][key] = f2bf(v.w);
    }
    __syncthreads();
#pragma unroll
    for (int ks = 0; ks < 4; ++ks) {
      const bf16x8 a = *(const bf16x8*)&sm->vt[wave * 32 + r][ks * 16 + hh * 8];
#pragma unroll
      for (int nt = 0; nt < 2; ++nt) {
        const bf16x8 bb = *(const bf16x8*)&sm->kt[nt * 32 + r][ks * 16 + hh * 8];
        acc[nt] = __builtin_amdgcn_mfma_f32_32x32x16_bf16(a, bb, acc[nt], 0, 0, 0);
      }
    }
  }
  float* KV = (float*)(p.ws + OFF_RETKV) + (size_t)item * 64 * 128;
#pragma unroll
  for (int nt = 0; nt < 2; ++nt)
#pragma unroll
    for (int g4 = 0; g4 < 4; ++g4)
      st4(KV + (nt * 32 + r) * 128 + wave * 32 + 8 * g4 + 4 * hh,
          make_float4(acc[nt][4 * g4], acc[nt][4 * g4 + 1], acc[nt][4 * g4 + 2], acc[nt][4 * g4 + 3]));
}
DEV void phase_p11(const Params& p, char* smem) {
  {
    unsigned* RKF = (unsigned*)(p.ws + OFF_RKF);
    for (int i = BIDX * NTHREADS + TIDX; i < BATCH * 8 * (SEQ_LEN / 32); i += gridDim.x * NTHREADS) RKF[i] = 0u;
  }
  const int total = P11_PREP_ITEMS + P11_KV_ITEMS;
  for (int it = BIDX; it < total; it += gridDim.x) {
    if (it < P11_KV_ITEMS) p11_kv(p, it, smem);
    else p11_prep(p, it - P11_KV_ITEMS, smem);
  }
}

#define RK_T 32
#define RK_NCH (SEQ_LEN / RK_T)
#define RK_NCHT (BATCH * 8 * RK_NCH)
#define OFF_RKPT OFF_H
#define OFF_RKKT (OFF_RKPT + (size_t)RK_NCHT * 64 * 64 * 2)
#define OFF_RKVT (OFF_RKKT + (size_t)RK_NCHT * 64 * 32 * 2)
#define OFF_RKRT (OFF_RKVT + (size_t)RK_NCHT * 64 * 32 * 2)
#define OFF_RKAT (OFF_RKRT + (size_t)RK_NCHT * 32 * 64 * 2)
#define OFF_RKEND (OFF_RKAT + (size_t)RK_NCHT * 32 * 32 * 2)
static_assert(OFF_RKEND <= OFF_H2, "rk buffers must fit in the H1 region");
#define RKPRE_SMEM ((4 * 32 * 64 + 32 * 64) * 4)

DEV unsigned short* rksc_row(char* ws, int b, int h, int c, int i) {
  return (unsigned short*)(ws + OFF_RWW) + (((size_t)b * SEQ_LEN + (size_t)c * RK_T + (i >> 1)) * 512 + h * 64) * 2 + (i & 1) * 64;
}
#if RK_MERGED
DEV void st_wt_u16(unsigned short* q, unsigned short v) { asm volatile("global_store_short %0, %1, off sc1" :: "v"(q), "v"((unsigned)v) : "memory"); }
typedef unsigned u32x4_t __attribute__((ext_vector_type(4)));
DEV void st_wt_b128(void* q, uint4 v) { const u32x4_t w = {v.x, v.y, v.z, v.w}; asm volatile("global_store_dwordx4 %0, %1, off sc1" :: "v"(q), "v"(w) : "memory"); }
#else
DEV void st_wt_u16(unsigned short* q, unsigned short v) { *q = v; }
DEV void st_wt_b128(void* q, uint4 v) { *(uint4*)q = v; }
#endif
DEV void rk_precompute(const Params& p, int ch, char* smem) {
  const int c = ch % RK_NCH, bh = ch / RK_NCH, h = bh & 7, b = bh >> 3;
  const int tid = TIDX, lane = tid & 63, wave = tid >> 6;
  const size_t tok0 = (size_t)b * SEQ_LEN + (size_t)c * RK_T;
  const float* RWW = (const float*)(p.ws + OFF_RWW); const float* RWK = (const float*)(p.ws + OFF_RWK);
  const float* RWKK = (const float*)(p.ws + OFF_RWKK); const float* RWA = (const float*)(p.ws + OFF_RWA);
  const float* RWR = p.out + (size_t)NTOK * 512; const float* RWV = p.out;
  float* sW = (float*)smem;
  float* sNK = sW + 32 * 64;
  float* sKA = sNK + 32 * 64;
  float* sR = sKA + 32 * 64;
  float* sV = sR + 32 * 64;
  __syncthreads();
  for (int w = tid; w < 32 * 16; w += NTHREADS) {
    const int t = w >> 4, c4 = (w & 15) * 4;
    const size_t o = (tok0 + t) * 512 + h * 64 + c4;
    st4(sW + t * 64 + c4, ld4(RWW + o));
    const float4 kk = ld4(RWKK + o);
    st4(sNK + t * 64 + c4, make_float4(-kk.x, -kk.y, -kk.z, -kk.w));
    st4(sKA + t * 64 + c4, ld4(RWA + o));
    st4(sR + t * 64 + c4, ld4(RWR + o));
    st4(sV + t * 64 + c4, ld4(RWV + o));
  }
  __syncthreads();
  const int wrole = (wave + ((BIDX >= (gridDim.x >> 1)) ? 2 : 0)) & 3;
  if (wrole == 0) {
    float z[64];
#pragma unroll
    for (int j = 0; j < 64; ++j) z[j] = (j == lane) ? 1.f : 0.f;
    for (int t = 0; t < RK_T; ++t) {
      float cacc = 0.f;
#pragma unroll
      for (int j4 = 0; j4 < 16; ++j4) {
        const float4 u = ld4(sNK + t * 64 + j4 * 4);
        cacc += z[j4 * 4] * u.x + z[j4 * 4 + 1] * u.y + z[j4 * 4 + 2] * u.z + z[j4 * 4 + 3] * u.w;
      }
#pragma unroll
      for (int j4 = 0; j4 < 16; ++j4) {
        const float4 w = ld4(sW + t * 64 + j4 * 4), v = ld4(sKA + t * 64 + j4 * 4);
        z[j4 * 4] = z[j4 * 4] * w.x + cacc * v.x; z[j4 * 4 + 1] = z[j4 * 4 + 1] * w.y + cacc * v.y;
        z[j4 * 4 + 2] = z[j4 * 4 + 2] * w.z + cacc * v.z; z[j4 * 4 + 3] = z[j4 * 4 + 3] * w.w + cacc * v.w;
      }
    }
    unsigned short* PT = (unsigned short*)(p.ws + OFF_RKPT) + (size_t)ch * 64 * 64;
#pragma unroll
    for (int j = 0; j < 64; ++j) st_wt_u16(PT + j * 64 + lane, f2bf(z[j]));
  } else if (wrole == 1) {
    const bool isA = lane < 32;
    const int me = lane & 31;
    float q[64];
    {
      const float* src = (isA ? RWK : RWR) + (tok0 + me) * 512 + h * 64;
#pragma unroll
      for (int j4 = 0; j4 < 16; ++j4) { const float4 v = ld4(src + j4 * 4); q[j4 * 4] = v.x; q[j4 * 4 + 1] = v.y; q[j4 * 4 + 2] = v.z; q[j4 * 4 + 3] = v.w; }
    }
    const float* Ub = isA ? sNK : sKA;
    const float* Vb = isA ? sKA : sNK;
    unsigned short* AT = (unsigned short*)(p.ws + OFF_RKAT) + (size_t)ch * 32 * 32;
    for (int u = 0; u < RK_T; ++u) {
      const int tt = isA ? u : RK_T - 1 - u;
      const bool upd = isA ? (u > me) : (tt <= me);
      if (upd) {
        float cacc = 0.f;
#pragma unroll
        for (int j4 = 0; j4 < 16; ++j4) {
          const float4 uu = ld4(Ub + tt * 64 + j4 * 4);
          cacc += q[j4 * 4] * uu.x + q[j4 * 4 + 1] * uu.y + q[j4 * 4 + 2] * uu.z + q[j4 * 4 + 3] * uu.w;
        }
#pragma unroll
        for (int j4 = 0; j4 < 16; ++j4) {
          const float4 w = ld4(sW + tt * 64 + j4 * 4), v = ld4(Vb + tt * 64 + j4 * 4);
          q[j4 * 4] = q[j4 * 4] * w.x + cacc * v.x; q[j4 * 4 + 1] = q[j4 * 4 + 1] * w.y + cacc * v.y;
          q[j4 * 4 + 2] = q[j4 * 4 + 2] * w.z + cacc * v.z; q[j4 * 4 + 3] = q[j4 * 4 + 3] * w.w + cacc * v.w;
        }
      }
      if (isA) {
        float av = 0.f;
        if (u >= me) {
#pragma unroll
          for (int j4 = 0; j4 < 16; ++j4) {
            const float4 rr = ld4(sR + u * 64 + j4 * 4);
            av += q[j4 * 4] * rr.x + q[j4 * 4 + 1] * rr.y + q[j4 * 4 + 2] * rr.z + q[j4 * 4 + 3] * rr.w;
          }
        }
        AT[u * 32 + me] = f2bf(av);
      }
    }
    if (isA) {
      unsigned short* KT = (unsigned short*)(p.ws + OFF_RKKT) + (size_t)ch * 64 * 32;
#pragma unroll
      for (int j = 0; j < 64; ++j) st_wt_u16(KT + j * 32 + me, f2bf(q[j]));
    } else {
      unsigned short* RT = (unsigned short*)(p.ws + OFF_RKRT) + ((size_t)ch * 32 + me) * 64;
#pragma unroll
      for (int j8 = 0; j8 < 8; ++j8)
        *(uint4*)(RT + j8 * 8) = make_uint4(pk2(q[j8 * 8], q[j8 * 8 + 1]), pk2(q[j8 * 8 + 2], q[j8 * 8 + 3]), pk2(q[j8 * 8 + 4], q[j8 * 8 + 5]), pk2(q[j8 * 8 + 6], q[j8 * 8 + 7]));
    }
  } else if (wrole == 2) {
    unsigned short* VT = (unsigned short*)(p.ws + OFF_RKVT) + (size_t)ch * 64 * 32;
#pragma unroll
    for (int t8 = 0; t8 < 4; ++t8) {
      float v[8];
#pragma unroll
      for (int q8 = 0; q8 < 8; ++q8) v[q8] = sV[(t8 * 8 + q8) * 64 + lane];
      st_wt_b128(VT + lane * 32 + t8 * 8, make_uint4(pk2(v[0], v[1]), pk2(v[2], v[3]), pk2(v[4], v[5]), pk2(v[6], v[7])));
    }
  }
#if RK_MERGED
  asm volatile("s_waitcnt vmcnt(0)" ::: "memory");
  __syncthreads();
  if (tid == 0) __hip_atomic_store((unsigned*)(p.ws + OFF_RKF) + ch, 1u, __ATOMIC_RELAXED, __HIP_MEMORY_SCOPE_AGENT);
#endif
}
DEV void phase_retpfx(const Params& p, char* smem);
DEV void phase_rkpre(const Params& p, char* smem) {
  phase_retpfx(p, smem);
  for (int it = BIDX; it < RK_NCHT; it += gridDim.x) rk_precompute(p, (it % (BATCH * 8)) * RK_NCH + it / (BATCH * 8), smem);
}

DEV bf16x8 ld_frag2(const unsigned short* p0, const unsigned short* p1) {
  const uint2 lo = *(const uint2*)p0, hi = *(const uint2*)p1;
  union { uint4 u; bf16x8 v; } x;
  x.u = make_uint4(lo.x, lo.y, hi.x, hi.y);
  return x.v;
}
DEV bf16x8 ld_frag(const unsigned short* p0) {
  union { uint4 u; bf16x8 v; } x;
  x.u = *(const uint4*)p0;
  return x.v;
}
DEV unsigned rk_flag_ld(const unsigned* f) {
#if RK_MERGED
  return __hip_atomic_load(f, __ATOMIC_RELAXED, __HIP_MEMORY_SCOPE_AGENT);
#else
  return 1u;
#endif
}
DEV void rk_flag_wait(const unsigned* f, unsigned flv) {
#if RK_MERGED
  asm volatile("" : "+v"(flv));
  unsigned fl = (unsigned)__builtin_amdgcn_readfirstlane((int)flv);
  unsigned sp = 0;
  while (fl == 0u) {
    __builtin_amdgcn_s_sleep(1);
    fl = (unsigned)__builtin_amdgcn_readfirstlane((int)__hip_atomic_load(f, __ATOMIC_RELAXED, __HIP_MEMORY_SCOPE_AGENT));
    if (++sp > (1u << 21)) break;
  }
  asm volatile("buffer_inv sc1" ::: "memory");
#endif
}
#define RK_PREFETCH(S, c_)                                                                                                      \
  {                                                                                                                             \
    const size_t chp_ = (size_t)bh * RK_NCH + (c_);                                                                             \
    _Pragma("unroll") for (int jt = 0; jt < 2; ++jt) _Pragma("unroll") for (int kb = 0; kb < 2; ++kb)                          \
        _Pragma("unroll") for (int s_ = 0; s_ < 2; ++s_) {                                                                      \
      const unsigned short* q0 = PTb + (chp_ * 64 + jt * 32 + r) * 64 + kb * 32 + 16 * s_ + 4 * hh;                             \
      pa##S[jt][kb][s_] = ld_frag2(q0, q0 + 8);                                                                                 \
    }                                                                                                                           \
    _Pragma("unroll") for (int jt = 0; jt < 2; ++jt) _Pragma("unroll") for (int ks = 0; ks < 2; ++ks)                          \
        ka##S[jt][ks] = ld_frag(KTb + (chp_ * 64 + jt * 32 + r) * 32 + 16 * ks + 8 * hh);                                       \
    _Pragma("unroll") for (int ks = 0; ks < 2; ++ks) vb##S[ks] = ld_frag(VTb + (chp_ * 64 + it * 32 + r) * 32 + 16 * ks + 8 * hh); \
  }
#define RK_STEP(S, c_)                                                                                                          \
  {                                                                                                                             \
    unsigned short* scr_ = rksc_row(p.ws, bh >> 3, bh & 7, (c_), it * 32 + r);                                                  \
    _Pragma("unroll") for (int kb = 0; kb < 2; ++kb) _Pragma("unroll") for (int g4 = 0; g4 < 4; ++g4)                          \
        *(uint2*)(scr_ + kb * 32 + 8 * g4 + 4 * hh) =                                                                           \
            make_uint2(pk2(X[kb][4 * g4], X[kb][4 * g4 + 1]), pk2(X[kb][4 * g4 + 2], X[kb][4 * g4 + 3]));                       \
    bf16x8 bh_[2][2], bl_[2][2];                                                                                                \
    _Pragma("unroll") for (int kb = 0; kb < 2; ++kb) _Pragma("unroll") for (int s_ = 0; s_ < 2; ++s_) {                        \
      union { uint4 u; bf16x8 v; } hi, lo;                                                                                      \
      unsigned hw[4], lw[4];                                                                                                    \
      _Pragma("unroll") for (int q2 = 0; q2 < 4; ++q2) {                                                                        \
        const float x0 = X[kb][8 * s_ + 2 * q2], x1 = X[kb][8 * s_ + 2 * q2 + 1];                                               \
        const unsigned hp = pk2(x0, x1);                                                                                        \
        hw[q2] = hp;                                                                                                            \
        lw[q2] = pk2(x0 - bf2f((unsigned short)(hp & 0xFFFF)), x1 - bf2f((unsigned short)(hp >> 16)));                          \
      }                                                                                                                         \
      hi.u = make_uint4(hw[0], hw[1], hw[2], hw[3]); lo.u = make_uint4(lw[0], lw[1], lw[2], lw[3]);                             \
      bh_[kb][s_] = hi.v; bl_[kb][s_] = lo.v;                                                                                   \
    }                                                                                                                           \
    f32x16 acc[2];                                                                                                              \
    _Pragma("unroll") for (int jt = 0; jt < 2; ++jt) {                                                                          \
      _Pragma("unroll") for (int i = 0; i < 16; ++i) acc[jt][i] = 0.f;                                                          \
      _Pragma("unroll") for (int kb = 0; kb < 2; ++kb) _Pragma("unroll") for (int s_ = 0; s_ < 2; ++s_) {                      \
        acc[jt] = __builtin_amdgcn_mfma_f32_32x32x16_bf16(pa##S[jt][kb][s_], bh_[kb][s_], acc[jt], 0, 0, 0);                    \
        acc[jt] = __builtin_amdgcn_mfma_f32_32x32x16_bf16(pa##S[jt][kb][s_], bl_[kb][s_], acc[jt], 0, 0, 0);                    \
      }                                                                                                                         \
      _Pragma("unroll") for (int ks = 0; ks < 2; ++ks)                                                                          \
          acc[jt] = __builtin_amdgcn_mfma_f32_32x32x16_bf16(ka##S[jt][ks], vb##S[ks], acc[jt], 0, 0, 0);                        \
    }                                                                                                                           \
    if ((c_) + 2 < RK_NCH) {                                                                                                    \
      rk_flag_wait(RKFb + (c_) + 2, fl##S);                                                                                     \
      fl##S = rk_flag_ld(RKFb + ((c_) + 4 < RK_NCH ? (c_) + 4 : RK_NCH - 1));          \
      RK_PREFETCH(S, (c_) + 2);                                                                                                 \
    }                                                                                                                           \
    X[0] = acc[0]; X[1] = acc[1];                                                                                               \
  }
DEV void rk_chain(const Params& p, int bh) {
  const int tid = TIDX, lane = tid & 63, wave = tid >> 6;
  if (wave >= 2) return;
  const int r = lane & 31, hh = lane >> 5, it = wave;
  const unsigned short* PTb = (const unsigned short*)(p.ws + OFF_RKPT);
  const unsigned short* KTb = (const unsigned short*)(p.ws + OFF_RKKT);
  const unsigned short* VTb = (const unsigned short*)(p.ws + OFF_RKVT);
  const unsigned* RKFb = (const unsigned*)(p.ws + OFF_RKF) + (size_t)bh * RK_NCH;
  f32x16 X[2];
#pragma unroll
  for (int kb = 0; kb < 2; ++kb)
#pragma unroll
    for (int i = 0; i < 16; ++i) X[kb][i] = 0.f;
  bf16x8 paA[2][2][2], kaA[2][2], vbA[2], paB[2][2][2], kaB[2][2], vbB[2];
  rk_flag_wait(RKFb, rk_flag_ld(RKFb));
  RK_PREFETCH(A, 0);
  rk_flag_wait(RKFb + 1, rk_flag_ld(RKFb + 1));
  RK_PREFETCH(B, 1);
  unsigned flA = rk_flag_ld(RKFb + 2), flB = rk_flag_ld(RKFb + 3);
  for (int c = 0; c < RK_NCH; c += 2) {
    RK_STEP(A, c);
    if (c + 1 < RK_NCH) RK_STEP(B, c + 1);
  }
}
DEV void rk_output(const Params& p, int item) {
  const int tid = TIDX, lane = tid & 63, wave = tid >> 6;
  const int ch = item * 4 + wave;
  const int c = ch % RK_NCH, bhh = ch / RK_NCH, h = bhh & 7, b = bhh >> 3;
  const int r = lane & 31, hh = lane >> 5;
  const unsigned short* RT = (const unsigned short*)(p.ws + OFF_RKRT) + (size_t)ch * 32 * 64;
  const unsigned short* AT = (const unsigned short*)(p.ws + OFF_RKAT) + (size_t)ch * 32 * 32;
  const unsigned short* VT = (const unsigned short*)(p.ws + OFF_RKVT) + (size_t)ch * 64 * 32;
  f32x16 acc[2];
#pragma unroll
  for (int i2 = 0; i2 < 2; ++i2)
#pragma unroll
    for (int i = 0; i < 16; ++i) acc[i2][i] = 0.f;
#pragma unroll
  for (int ks = 0; ks < 4; ++ks) {
    const bf16x8 a = ld_frag(RT + r * 64 + 16 * ks + 8 * hh);
#pragma unroll
    for (int i2 = 0; i2 < 2; ++i2) acc[i2] = __builtin_amdgcn_mfma_f32_32x32x16_bf16(a, ld_frag(rksc_row(p.ws, b, h, c, i2 * 32 + r) + 16 * ks + 8 * hh), acc[i2], 0, 0, 0);
  }
#pragma unroll
  for (int ks = 0; ks < 2; ++ks) {
    const bf16x8 a = ld_frag(AT + r * 32 + 16 * ks + 8 * hh);
#pragma unroll
    for (int i2 = 0; i2 < 2; ++i2) acc[i2] = __builtin_amdgcn_mfma_f32_32x32x16_bf16(a, ld_frag(VT + (i2 * 32 + r) * 32 + 16 * ks + 8 * hh), acc[i2], 0, 0, 0);
  }
  float* Yo = (float*)(p.ws + OFF_MIX);
  const size_t tok0 = (size_t)b * SEQ_LEN + (size_t)c * RK_T;
#pragma unroll
  for (int i2 = 0; i2 < 2; ++i2)
#pragma unroll
    for (int i = 0; i < 16; ++i) {
      const int t = (i & 3) + 8 * (i >> 2) + 4 * hh;
      Yo[(tok0 + t) * 1024 + h * 64 + i2 * 32 + r] = acc[i2][i];
    }
}
#define OFF_RWG OFF_RWKK
DEV void phase_rkout(const Params& p, char* smem) {
  {
    const float* GLO = (const float*)(p.ws + OFF_GLO);
    const float* g_up = p.in[I_RW_G_UP];
    float* G = (float*)(p.ws + OFF_RWG);
    for (int t = BIDX; t < (NTOK / GEMM_BM) * 4; t += gridDim.x) {
      const int m0 = (t >> 2) * GEMM_BM, n0 = (t & 3) * 128;
      gemm_tile<false>(
          [&](int r) { return (const void*)(GLO + (size_t)(m0 + r) * 128); },
          [&](int c) { return g_up + n0 + c; }, 512, 128,
          [&](int row, int col, float v0, float v1) {
            const size_t o = (size_t)(m0 + row) * 512 + n0 + col;
            G[o] = v0; G[o + 32] = v1;
          },
          smem);
    }
  }
  for (int it = BIDX; it < RK_NCHT / 4; it += gridDim.x) rk_output(p, it);
}

#define P12_SCAN_ITEMS (BATCH * 8 * 4)
#define P12_RET_ITEMS (BATCH * 4 * RET_NC)
#define P12_SCAN_SMEM ((2 * (16 * 5 * 64 + 16 * 16) + 16 * 16) * 4)
#define P12_RET_SMEM ((64 * 72 + 2 * 64 * 68) * 2)
#define P12_SMEM (P12_SCAN_SMEM > P12_RET_SMEM ? P12_SCAN_SMEM : P12_RET_SMEM)
DEV float sum16(float v) {
#ifdef CPU_EMU
  return emu_sum16(v);
#else
  int x;
  x = __builtin_amdgcn_update_dpp(0, __builtin_bit_cast(int, v), 0xB1, 0xF, 0xF, false); v += __builtin_bit_cast(float, x);
  x = __builtin_amdgcn_update_dpp(0, __builtin_bit_cast(int, v), 0x4E, 0xF, 0xF, false); v += __builtin_bit_cast(float, x);
  x = __builtin_amdgcn_update_dpp(0, __builtin_bit_cast(int, v), 0x141, 0xF, 0xF, false); v += __builtin_bit_cast(float, x);
  x = __builtin_amdgcn_update_dpp(0, __builtin_bit_cast(int, v), 0x140, 0xF, 0xF, false); v += __builtin_bit_cast(float, x);
  return v;
#endif
}
DEV void p12_scan(const Params& p, int item, char* smem) {
  const int rq = item & 3, h = (item >> 2) & 7, b = item >> 5;
  const int tid = TIDX, rl = tid >> 4, cg = tid & 15;
  const float* ARR[5] = {(const float*)(p.ws + OFF_RWW), (const float*)(p.ws + OFF_RWK), (const float*)(p.ws + OFF_RWKK),
                         (const float*)(p.ws + OFF_RWA), p.out + (size_t)NTOK * 512};
  const float* RWV = p.out;
  float* Yo = (float*)(p.ws + OFF_MIX);
  float* buf = (float*)smem;
  float* vbuf = buf + 2 * 16 * 5 * 64;
  float* ybuf = vbuf + 2 * 16 * 16;
  float S[4] = {0.f, 0.f, 0.f, 0.f};
  float4 rg[5]; float rv;
  const int lstep = tid >> 4, lc4 = tid & 15;
  auto gload = [&](int c) {
    const size_t o = ((size_t)b * SEQ_LEN + c * 16 + lstep) * 512 + h * 64;
#pragma unroll
    for (int a = 0; a < 5; ++a) rg[a] = ld4(ARR[a] + o + lc4 * 4);
    rv = RWV[o + rq * 16 + lc4];
  };
  auto sstore = [&](int bi) {
#pragma unroll
    for (int a = 0; a < 5; ++a) st4(buf + ((bi * 16 + lstep) * 5 + a) * 64 + lc4 * 4, rg[a]);
    vbuf[(bi * 16 + lstep) * 16 + lc4] = rv;
  };
  __syncthreads();
  gload(0);
  sstore(0);
  __syncthreads();
  const int NCH = SEQ_LEN / 16;
  for (int c = 0; c < NCH; ++c) {
    if (c + 1 < NCH) gload(c + 1);
    const float* cb = buf + (c & 1) * 16 * 5 * 64;
    const float* cv = vbuf + (c & 1) * 16 * 16;
    float4 cw = ld4(cb + 0 * 64 + cg * 4), ck = ld4(cb + 1 * 64 + cg * 4), ckk = ld4(cb + 2 * 64 + cg * 4),
           cka = ld4(cb + 3 * 64 + cg * 4), cr = ld4(cb + 4 * 64 + cg * 4);
    float cvv = cv[rl];
#pragma unroll
    for (int s = 0; s < 16; ++s) {
      const float4 w = cw, k = ck, kk = ckk, ka = cka, r = cr;
      const float v = cvv;
      if (s < 15) {
        cw = ld4(cb + ((s + 1) * 5 + 0) * 64 + cg * 4); ck = ld4(cb + ((s + 1) * 5 + 1) * 64 + cg * 4);
        ckk = ld4(cb + ((s + 1) * 5 + 2) * 64 + cg * 4); cka = ld4(cb + ((s + 1) * 5 + 3) * 64 + cg * 4);
        cr = ld4(cb + ((s + 1) * 5 + 4) * 64 + cg * 4); cvv = cv[(s + 1) * 16 + rl];
      }
      float sa = (S[0] * kk.x + S[1] * kk.y) + (S[2] * kk.z + S[3] * kk.w);
      sa = -sum16(sa);
      S[0] = S[0] * w.x + (sa * ka.x + v * k.x);
      S[1] = S[1] * w.y + (sa * ka.y + v * k.y);
      S[2] = S[2] * w.z + (sa * ka.z + v * k.z);
      S[3] = S[3] * w.w + (sa * ka.w + v * k.w);
      float y = (S[0] * r.x + S[1] * r.y) + (S[2] * r.z + S[3] * r.w);
      y = sum16(y);
      if (cg == 0) ybuf[s * 16 + rl] = y;
      asm volatile("" ::: "memory");
    }
    __syncthreads();
    if (c + 1 < NCH) sstore((c + 1) & 1);
    Yo[((size_t)b * SEQ_LEN + c * 16 + lstep) * 1024 + h * 64 + rq * 16 + lc4] = ybuf[lstep * 16 + lc4];
    __syncthreads();
  }
}
struct RetSmem { unsigned short k[64][72]; unsigned short vt[2][64][68]; };
#define RETPFX_ITEMS (BATCH * 4 * 64 * 128 / NTHREADS)
DEV void ret_prefix(const Params& p, int item) {
  const int gi = item * NTHREADS + TIDX;
  const int bh4 = gi >> 13, idx = gi & 8191;
  const float G = exp2f(128.f * ret_log2gamma(bh4 & 3));
  float* KV = (float*)(p.ws + OFF_RETKV) + (size_t)bh4 * RET_NC * 8192 + idx;
  float st = 0.f;
  int c = 0;
  for (; c + 8 <= RET_NC; c += 8) {
    float e[8];
#pragma unroll
    for (int q = 0; q < 8; ++q) e[q] = KV[(size_t)(c + q) * 8192];
#pragma unroll
    for (int q = 0; q < 8; ++q) { KV[(size_t)(c + q) * 8192] = st; st = st * G + e[q]; }
  }
  for (; c < RET_NC; ++c) { const float e = KV[(size_t)c * 8192]; KV[(size_t)c * 8192] = st; st = st * G + e; }
}
DEV void phase_retpfx(const Params& p, char* smem) {
  for (int it = BIDX; it < RETPFX_ITEMS; it += gridDim.x) ret_prefix(p, it);
}
DEV void p12_ret(const Params& p, int item, char* smem) {
  RetSmem* sm = (RetSmem*)smem;
  const int c = item % RET_NC, h = (item / RET_NC) & 3, b = item / (RET_NC * 4);
  const int tid = TIDX, lane = tid & 63, wave = tid >> 6;
  const int cidx = lane & 31, hh = lane >> 5;
  const int qi = wave * 32 + cidx;
  const float* H2 = (const float*)(p.ws + OFF_H2);
  const float lg = ret_log2gamma(h);
  const size_t tok0 = (size_t)b * SEQ_LEN + c * 128;
  bf16x8 qf[4], qfs[4];
  {
    const float* qr = H2 + (tok0 + qi) * 1536 + h * 64;
    const float qs = exp2f((float)(qi + 1) * lg);
#pragma unroll
    for (int ks = 0; ks < 4; ++ks) {
      const float4 a0 = ld4(qr + ks * 16 + hh * 8), a1 = ld4(qr + ks * 16 + hh * 8 + 4);
      const float v[8] = {a0.x, a0.y, a0.z, a0.w, a1.x, a1.y, a1.z, a1.w};
#pragma unroll
      for (int j = 0; j < 8; ++j) { qf[ks][j] = (short)f2bf(v[j]); qfs[ks][j] = (short)f2bf(v[j] * qs); }
    }
  }
  f32x16 o[4], s[2];
#pragma unroll
  for (int mt = 0; mt < 4; ++mt)
#pragma unroll
    for (int i = 0; i < 16; ++i) o[mt][i] = 0.f;
  {
    const float* KV0 = (const float*)(p.ws + OFF_RETKV) + (size_t)((b * 4 + h) * RET_NC) * 64 * 128;
#pragma unroll
    for (int eh = 0; eh < 2; ++eh) {
      __syncthreads();
      {
        const int el = tid & 63, d0 = tid >> 6;
        float stv[16];
#pragma unroll
        for (int i = 0; i < 16; ++i) stv[i] = KV0[(size_t)c * 64 * 128 + (d0 + 4 * i) * 128 + eh * 64 + el];
#pragma unroll
        for (int i = 0; i < 16; ++i) sm->k[el][d0 + 4 * i] = f2bf(stv[i]);
      }
      __syncthreads();
      qk_tile(sm->k, qfs, s, lane);
#pragma unroll
      for (int i = 0; i < 16; ++i) { o[eh * 2][i] += s[0][i]; o[eh * 2 + 1][i] += s[1][i]; }
    }
  }
#pragma unroll 1
  for (int kt = 0; kt < 2; ++kt) {
    __syncthreads();
    {
      const int row = tid >> 2, seg = tid & 3;
      const float* kr = H2 + (tok0 + kt * 64 + row) * 1536 + 256 + h * 64 + seg * 16;
      const float4 a0 = ld4(kr), a1 = ld4(kr + 4), a2 = ld4(kr + 8), a3 = ld4(kr + 12);
      *(uint4*)&sm->k[row][seg * 16] = make_uint4(pk2(a0.x, a0.y), pk2(a0.z, a0.w), pk2(a1.x, a1.y), pk2(a1.z, a1.w));
      *(uint4*)&sm->k[row][seg * 16 + 8] = make_uint4(pk2(a2.x, a2.y), pk2(a2.z, a2.w), pk2(a3.x, a3.y), pk2(a3.z, a3.w));
#pragma unroll
      for (int q = 0; q < 8; ++q) {
        const int f = tid + 256 * q;
        const int key = f >> 5, d4 = (f & 31) * 4;
        const float4 v = ld4(H2 + (tok0 + kt * 64 + key) * 1536 + 512 + h * 128 + d4);
        unsigned short(*vt)[68] = sm->vt[d4 >> 6];
        const int dl = d4 & 63;
        vt[dl][key] = f2bf(v.x); vt[dl + 1][key] = f2bf(v.y); vt[dl + 2][key] = f2bf(v.z); vt[dl + 3][key] = f2bf(v.w);
      }
    }
    __syncthreads();
    if (kt * 64 <= wave * 32 + 31) {
      qk_tile(sm->k, qf, s, lane);
#pragma unroll
      for (int ks2 = 0; ks2 < 2; ++ks2)
#pragma unroll
        for (int i = 0; i < 16; ++i) {
          const int kj = kt * 64 + ks2 * 32 + (i & 3) + 8 * (i >> 2) + 4 * hh;
          s[ks2][i] = kj <= qi ? s[ks2][i] * exp2f((float)(qi - kj) * lg) : 0.f;
        }
      pv_tile(sm->vt[0], s, *(f32x16(*)[2])&o[0], lane);
      pv_tile(sm->vt[1], s, *(f32x16(*)[2])&o[2], lane);
    }
  }
  float s1 = 0.f;
#pragma unroll
  for (int mt = 0; mt < 4; ++mt)
#pragma unroll
    for (int i = 0; i < 16; ++i) s1 += o[mt][i];
  s1 += __shfl_xor(s1, 32);
  const float mu = s1 * (1.f / 128.f);
  float s2 = 0.f;
#pragma unroll
  for (int mt = 0; mt < 4; ++mt)
#pragma unroll
    for (int i = 0; i < 16; ++i) { const float d = o[mt][i] - mu; s2 += d * d; }
  s2 += __shfl_xor(s2, 32);
  const float rstd = rsqrtf(s2 * (1.f / 128.f) + 1e-5f);
  float* MIX = (float*)(p.ws + OFF_MIX);
  const float* gate = H2 + (tok0 + qi) * 1536 + 1024 + h * 128;
  float* dst = MIX + (tok0 + qi) * 1024 + 512 + h * 128;
  const float* lgam = p.in[I_RET_LN_G] + h * 128;
  const float* lbet = p.in[I_RET_LN_B] + h * 128;
#pragma unroll
  for (int mt = 0; mt < 4; ++mt)
#pragma unroll
    for (int g4 = 0; g4 < 4; ++g4) {
      const int dv = mt * 32 + 8 * g4 + 4 * hh;
      const float4 gv = ld4(lgam + dv), bv = ld4(lbet + dv), gt = ld4(gate + dv);
      float4 ov;
      ov.x = siluf_(gt.x) * ((o[mt][4 * g4] - mu) * rstd * gv.x + bv.x);
      ov.y = siluf_(gt.y) * ((o[mt][4 * g4 + 1] - mu) * rstd * gv.y + bv.y);
      ov.z = siluf_(gt.z) * ((o[mt][4 * g4 + 2] - mu) * rstd * gv.z + bv.z);
      ov.w = siluf_(gt.w) * ((o[mt][4 * g4 + 3] - mu) * rstd * gv.w + bv.w);
      st4(dst + dv, ov);
    }
}
DEV void phase_p12(const Params& p, char* smem) {
  const int G = gridDim.x;
  const int bid = BIDX;
  if (bid < BATCH * 8 && G > BATCH * 8) {
    rk_chain(p, bid);
  } else if (G >= 8 * BATCH * 8) {
    const int Gh = G >> 1, NC = BATCH * 8;
    if (bid >= Gh && bid < Gh + NC) return;
    const int w = bid - NC - (bid >= Gh ? NC : 0);
#if RK_MERGED
    if ((G & 15) == 0 && BATCH * 8 == 16) {
      const int x = bid & 7, m = bid >> 3;
      const int rank = m - 2 - (m >= (Gh >> 3) ? 2 : 0), nprod = (G >> 3) - 4;
      for (int k = rank; k < 2 * RK_NCH; k += nprod) rk_precompute(p, (x + 8 * (k & 1)) * RK_NCH + (k >> 1), smem);
    } else {
      for (int it = w; it < RK_NCHT; it += G - 2 * NC) rk_precompute(p, (it % NC) * RK_NCH + it / NC, smem);
    }
#endif
    for (int it = w; it < P12_RET_ITEMS; it += G - 2 * NC) p12_ret(p, it, smem);
  } else if (G > BATCH * 8) {
    for (int it = bid - BATCH * 8; it < P12_RET_ITEMS; it += G - BATCH * 8) p12_ret(p, it, smem);
  } else {
    for (int it = bid; it < BATCH * 8 + P12_RET_ITEMS; it += G) {
      if (it < BATCH * 8) rk_chain(p, it);
      else p12_ret(p, it - BATCH * 8, smem);
    }
  }
}

#define P13_SMEM (RWP_T * 128 * 4)
DEV void phase_p13(const Params& p, char* smem) {
  const int tid = TIDX;
  const float* Hc = (const float*)(p.ws + OFF_H);
  const float* mu = p.in[I_RW_MU];
  const float* GLO = (const float*)(p.ws + OFF_GLO);
  float* sl = (float*)smem;
  float* MIX = (float*)(p.ws + OFF_MIX);
  const float* RWK = (const float*)(p.ws + OFF_RWK); const float* RWR = p.out + (size_t)NTOK * 512; const float* RWV = p.out;
  const float* G = (const float*)(p.ws + OFF_RWG);
  for (int it = BIDX; it < NTOK / RWP_T; it += gridDim.x) {
#pragma unroll
    for (int cc = 0; cc < 2; ++cc) {
      const int c = tid + 256 * cc;
      const float lng = p.in[I_RW_LN_G][c], lnb = p.in[I_RW_LN_B][c], rk = p.in[I_RW_R_K][c];
#pragma unroll 4
      for (int tt = 0; tt < RWP_T; ++tt) {
        const size_t tok = (size_t)it * RWP_T + tt;
        const float y = MIX[tok * 1024 + c];
        const float m = wave_sum(y) * (1.f / 64.f);
        const float d = y - m;
        const float var = wave_sum(d * d) * (1.f / 64.f);
        const float yn = d * rsqrtf(var + 64e-5f) * lng + lnb;
        const float r = RWR[tok * 512 + c], k = RWK[tok * 512 + c], v = RWV[tok * 512 + c];
        const float bonus = wave_sum(r * k * rk) * v;
        MIX[tok * 1024 + c] = (yn + bonus) * G[tok * 512 + c];
      }
    }
  }
}

#define NPHASES 20
#define SMEM_BYTES 53248
DEV void run_phase(const Params& p, int ph, char* smem) {
  switch (ph) {
    case 0: phase_gemm_in<0>(p, smem); break;
    case 1: phase_p1(p, smem); break;
    case 2: phase_p2(p, smem); break;
    case 3: phase_glu(p, smem); break;
    case 4: phase_outproj<0>(p, smem); break;
    case 5: phase_ln_router<0>(p, smem); break;
    case 6: phase_lists_shup<0>(p, smem); break;
    case 7: phase_routed_up<0>(p, smem); break;
    case 8: phase_down<0>(p, smem); break;
    case 9: phase_combine<0>(p, smem); break;
    case 10: phase_gemm_in<1>(p, smem); break;
    case 11: phase_p11(p, smem); break;
    case 12: phase_p12(p, smem); break;
    case 13: phase_p13(p, smem); break;
    case 14: phase_outproj<1>(p, smem); break;
    case 15: phase_ln_router<1>(p, smem); break;
    case 16: phase_lists_shup<1>(p, smem); break;
    case 17: phase_routed_up<1>(p, smem); break;
    case 18: phase_down<1>(p, smem); break;
    case 19: phase_combine<1>(p, smem); break;
    case 20: phase_p1b(p, smem); break;
    case 21: phase_rkpre(p, smem); break;
    case 22: phase_rkout(p, smem); break;
    case 24: phase_retpfx(p, smem); break;
  }
}
static_assert(P1_SMEM <= SMEM_BYTES, "smem");
static_assert(P1_PREP_SMEM <= SMEM_BYTES, "smem");
static_assert(P2_SMEM <= SMEM_BYTES, "smem");
static_assert(P5_SMEM <= SMEM_BYTES, "smem");
static_assert(P7_SMEM <= SMEM_BYTES, "smem");
static_assert(P12_SMEM <= SMEM_BYTES, "smem");
static_assert(RKPRE_SMEM <= SMEM_BYTES, "smem");
static_assert(OFF_HS + (size_t)NTOK * 256 * 2 <= OFF_X1, "layout");

#ifndef CPU_EMU
template <int PH>
__global__ void __launch_bounds__(NTHREADS) phase_kernel(Params p) {
  __shared__ __attribute__((aligned(16))) char smem[SMEM_BYTES];
  run_phase(p, PH, smem);
}
template <int PH>
static void launch_phases(const Params& p, hipStream_t stream) {
  phase_kernel<PH><<<dim3(1024), dim3(NTHREADS), 0, stream>>>(p);
  if constexpr (PH + 1 < NPHASES) launch_phases<PH + 1>(p, stream);
}
#if MEGA
#define XB_TMO      128
#define XB_XCNT(j)  (256  + 64 * (j))
#define XB_XSUB(j)  (1280 + 64 * (j))
#define XB_XGEN(j)  (2304 + 64 * (j))
#define XB_TOP      3328
#define XB_TOPGEN   3392
#define XCD_BAR_WORDS 3456
#define XB_SPIN_CAP (1u << 18)
#define LAS __attribute__((address_space(3)))

__device__ __forceinline__ unsigned xb_ld(unsigned* p)              { return __hip_atomic_load(p, __ATOMIC_RELAXED, __HIP_MEMORY_SCOPE_AGENT); }
__device__ __forceinline__ unsigned xb_add(unsigned* p, unsigned v) { return __hip_atomic_fetch_add(p, v, __ATOMIC_RELAXED, __HIP_MEMORY_SCOPE_AGENT); }
__device__ __forceinline__ unsigned xb_xcc_id() { return (unsigned)__builtin_amdgcn_s_getreg((3 << 11) | 20) & 0xFu; }
#define XB_SPIN(cond, bar) do { unsigned _sp = 0; while (cond) { __builtin_amdgcn_s_sleep(1); \
    if ((++_sp & 255u) == 0u) { if (xb_ld(&(bar)[XB_TMO])) break; if (_sp > XB_SPIN_CAP) { atomicAdd(&(bar)[XB_TMO], 1u); break; } } } } while (0)

struct XcdBarrier {
    unsigned* bar; unsigned x;
    volatile LAS unsigned* st;
};

__device__ __forceinline__ XcdBarrier xcd_barrier_post(unsigned* bar, volatile LAS unsigned* st) {
    XcdBarrier b; b.bar = bar; b.x = xb_xcc_id(); b.st = st;
    if (threadIdx.x == 0) (void)xb_add(&bar[XB_XCNT(b.x)], 1u);
    return b;
}
__device__ __forceinline__ void xcd_barrier_complete(unsigned* bar, unsigned x, unsigned& nloc, unsigned& nx) {
    const unsigned G = gridDim.x * gridDim.y * gridDim.z;
    unsigned sum, cnt, mine, sp = 0u;
    for (;;) {
        sum = 0u; cnt = 0u; mine = 0u;
#pragma unroll
        for (unsigned j = 0; j < 16; ++j) { const unsigned c = xb_ld(&bar[XB_XCNT(j)]); sum += c; cnt += (c > 0u) ? 1u : 0u; mine = (j == x) ? c : mine; }
        if (sum == G) break;
        __builtin_amdgcn_s_sleep(1);
        if ((++sp & 255u) == 0u) { if (xb_ld(&bar[XB_TMO])) break; if (sp > XB_SPIN_CAP) { atomicAdd(&bar[XB_TMO], 1u); break; } }
    }
    nloc = mine > 0u ? mine : 1u; nx = cnt > 0u ? cnt : 1u;
}

__device__ __forceinline__ void xcd_barrier(const XcdBarrier& b) {
    asm volatile("s_waitcnt vmcnt(0)" ::: "memory");
    __syncthreads();
    if (threadIdx.x == 0) {
        unsigned* bar = b.bar;
        __builtin_amdgcn_s_waitcnt(0);
        unsigned nloc = b.st[0], nx = b.st[1];
        if (nloc == 0u) { xcd_barrier_complete(bar, b.x, nloc, nx); b.st[0] = nloc; b.st[1] = nx; }
        const unsigned old = xb_add(&bar[XB_XSUB(b.x)], 1u);
        const unsigned gen = old / nloc;
        if (old + 1u == (gen + 1u) * nloc) {
            __builtin_amdgcn_fence(__ATOMIC_RELEASE, "agent");
            asm volatile("s_waitcnt vmcnt(0)" ::: "memory");
            const unsigned og = xb_add(&bar[XB_TOP], 1u);
            const unsigned tg = og / nx;
            if (og + 1u == (tg + 1u) * nx) xb_add(&bar[XB_TOPGEN], 1u);
            else XB_SPIN(xb_ld(&bar[XB_TOPGEN]) == tg, bar);
            __builtin_amdgcn_fence(__ATOMIC_ACQUIRE, "agent");
            xb_add(&bar[XB_XGEN(b.x)], 1u);
            asm volatile("s_waitcnt vmcnt(0)" ::: "memory");
        } else {
            XB_SPIN(xb_ld(&bar[XB_XGEN(b.x)]) == gen, bar);
            __builtin_amdgcn_fence(__ATOMIC_ACQUIRE, "agent");
            asm volatile("s_waitcnt vmcnt(0)" ::: "memory");
        }
    }
    __syncthreads();
}


__global__ void __launch_bounds__(NTHREADS, 2) mega_kernel(Params p) {
  __shared__ __attribute__((aligned(16))) char smem[SMEM_BYTES];
  unsigned* bar = (unsigned*)(p.ws + OFF_BAR);
  __shared__ uint4 xb_words;
  if (threadIdx.x == 0) xb_words = make_uint4(0u, 0u, 0u, 0u);
  __syncthreads();
  XcdBarrier xb = xcd_barrier_post(bar, (volatile LAS unsigned*)&xb_words);
  if (p.ws == nullptr) cg::this_grid().sync();
  typedef const __attribute__((address_space(4))) Params* KParams;
#define PH_(n) { KParams kp = (KParams)__builtin_amdgcn_kernarg_segment_ptr(); asm volatile("" : "+s"(kp)); const Params lp = *(const Params*)kp; run_phase(lp, n, smem); } xcd_barrier(xb);
  PH_(0) PH_(1) PH_(20) PH_(2) PH_(3) PH_(4) PH_(5) PH_(6) PH_(7) PH_(8) PH_(9)
  PH_(10) PH_(11) PH_(24) PH_(12) PH_(22) PH_(13) PH_(14) PH_(15) PH_(16) PH_(17) PH_(18)
  { KParams kp = (KParams)__builtin_amdgcn_kernarg_segment_ptr(); asm volatile("" : "+s"(kp)); const Params lp = *(const Params*)kp; run_phase(lp, 19, smem); }
}

#endif

extern "C" void kernel_launch(void* const* d_in, const int* in_sizes, int n_in, void* d_out, int out_size, void* d_ws, size_t ws_size,
                              hipStream_t stream) {
  Params p;
  for (int i = 0; i < N_INPUTS; ++i) p.in[i] = (const float*)d_in[i];
  p.out = (float*)d_out;
  p.ws = (char*)d_ws;
#if MEGA
  static int grid_blocks = 0;
  if (!grid_blocks) {
    int dev = 0, cus = 0, per_cu = 0;
    hipGetDevice(&dev);
    hipDeviceGetAttribute(&cus, hipDeviceAttributeMultiprocessorCount, dev);
    hipOccupancyMaxActiveBlocksPerMultiprocessor(&per_cu, mega_kernel, NTHREADS, 0);
    if (per_cu > 2) per_cu = 2;
    grid_blocks = cus * per_cu;
  }
  hipMemsetAsync((char*)d_ws + OFF_BAR, 0, 16384, stream);
  void* args[] = {&p};
  hipError_t e = hipLaunchCooperativeKernel((void*)mega_kernel, dim3(grid_blocks), dim3(NTHREADS), args, 0, stream);
  if (e != hipSuccess) fprintf(stderr, "cooperative launch failed: %s (grid %d)\n", hipGetErrorString(e), grid_blocks);
#else
  launch_phases<0>(p, stream);
#endif
}
#endif
```

```cpp
#ifdef CPU_EMU
#include "emu.h"
#else
#include <hip/hip_runtime.h>
#include <hip/hip_cooperative_groups.h>
#include <cstdio>
namespace cg = cooperative_groups;
#endif
#include <stdint.h>

#ifndef BATCH
#define BATCH 2
#endif
#ifndef SEQ_LEN
#define SEQ_LEN 8192
#endif
#ifndef MEGA
#define MEGA 1
#endif
#if MEGA && !defined(CPU_EMU)
#define RK_MERGED 1
#else
#define RK_MERGED 0
#endif

#define DEV __device__ __forceinline__
#ifdef CPU_EMU
#define TIDX ((int)threadIdx.x)
#define BIDX ((int)blockIdx.x)
#else
__device__ __forceinline__ int tidx_() { int t = __builtin_amdgcn_workitem_id_x(); asm volatile("" : "+v"(t)); return t; }
__device__ __forceinline__ int bidx_() { int b = __builtin_amdgcn_workgroup_id_x(); asm volatile("" : "+s"(b)); return b; }
#define TIDX tidx_()
#define BIDX bidx_()
#endif
#define NTOK (BATCH * SEQ_LEN)
#define DM 1024
#define AB_IN 1816
#define AB_LD 1824
#define CD_IN 3328
#define NCMP ((SEQ_LEN - 32) / 16 + 1)
#define NBLK (SEQ_LEN / 64)
#define NB_CMP ((NCMP + 63) / 64)
#define S5_NC (SEQ_LEN / 64)
#define RET_NC (SEQ_LEN / 128)
#define ALPHA_F 1.4142135623730951f
#define NTHREADS 256

enum { I_X = 0, I_AB_W_IN, I_AB_W_OUT, I_S5_LAM_RE, I_S5_LAM_IM, I_S5_LOG_DT, I_S5_B_RE, I_S5_B_IM, I_S5_C_RE, I_S5_C_IM,
       I_S5_D, I_S5_W_GLU, I_S5_B_GLU, I_PE_K, I_PE_V, I_CK_W1, I_CK_B1, I_CK_W2, I_CV_W1, I_CV_B1, I_CV_W2,
       I_CD_W_IN, I_CD_W_OUT, I_RW_MU, I_RW_W0, I_RW_W_UP, I_RW_A0, I_RW_A_UP, I_RW_G_UP, I_RW_K_K, I_RW_K_A, I_RW_R_K,
       I_RW_LN_G, I_RW_LN_B, I_RET_LN_G, I_RET_LN_B, I_LN1_G, I_LN1_B, I_LN2_G, I_LN2_B, I_ROUTER, I_MOE_BIAS,
       I_MOE_W1, I_MOE_W3, I_MOE_W2, I_SH_W1, I_SH_W3, I_SH_W2, N_INPUTS };

struct Params {
  const float* in[N_INPUTS];
  float* out;
  char* ws;
};

#define MiB_TOK ((size_t)NTOK * 1024 * 4)
#define OFF_H 0
#define OFF_H2 ((size_t)NTOK * 1792 * 4)
#define OFF_MIX ((size_t)NTOK * 3328 * 4)
#define OFF_X1 (OFF_MIX + MiB_TOK)
#define OFF_X2 (OFF_X1 + MiB_TOK)
#define OFF_R4 (OFF_X2 + MiB_TOK)
#define OFF_R5 (OFF_R4 + MiB_TOK)
#define OFF_Y OFF_H
#define OFF_HS (OFF_H + 4 * MiB_TOK)
#define OFF_FS OFF_X2
#define OFF_HR OFF_R4
#define OFF_X2B OFF_R4
#define OFF_TOPI (OFF_R5)
#define OFF_TOPG (OFF_TOPI + (size_t)NTOK * 8 * 4)
#define OFF_POSOF (OFF_TOPG + (size_t)NTOK * 8 * 4)
#define OFF_CNT (OFF_POSOF + (size_t)NTOK * 8 * 4)
#define OFF_LTOK (OFF_CNT + 8192)
#define OFF_LGATE (OFF_LTOK + (size_t)64 * NTOK * 4)
#define OFF_S5E (OFF_LGATE + (size_t)64 * NTOK * 4)
#define OFF_KCMP (OFF_S5E + (size_t)BATCH * S5_NC * 32 * 64 * 8)
#define OFF_VCMP (OFF_KCMP + (size_t)BATCH * NCMP * 2 * 64 * 4)
#define OFF_RETKV (OFF_VCMP + (size_t)BATCH * NCMP * 2 * 64 * 4)
#define OFF_BAR (OFF_RETKV + (size_t)BATCH * 4 * RET_NC * 64 * 128 * 4)
#define OFF_CMPHID (OFF_BAR + 16384)
#define OFF_CMPC1 (OFF_CMPHID + (size_t)2 * BATCH * 2 * NB_CMP * 64 * 128 * 4)
#define OFF_GLO OFF_LTOK
#define OFF_RKF (OFF_CMPC1 + 8192)
#define OFF_END (OFF_RKF + 16384)
#define OFF_YGELU OFF_X1
#define OFF_RWW OFF_X1
#define OFF_RWK (OFF_X1 + (size_t)NTOK * 512 * 4)
#define OFF_RWKK OFF_R4
#define OFF_RWA (OFF_R4 + (size_t)NTOK * 512 * 4)

typedef short bf16x8 __attribute__((ext_vector_type(8)));
typedef float f32x16 __attribute__((ext_vector_type(16)));

#ifdef CPU_EMU
#define WAVE_SYNC() emu_wave_bar()
#else
#define WAVE_SYNC() __builtin_amdgcn_wave_barrier()
#endif

DEV float sigmoidf_(float x) { return 1.f / (1.f + __expf(-x)); }
DEV float siluf_(float x) { return x * sigmoidf_(x); }
DEV float geluf_(float x) { float u = 0.7978845608028654f * (x + 0.044715f * x * x * x); return 0.5f * x * (1.f + tanhf(u)); }
DEV unsigned short f2bf(float f) {
  unsigned u = __builtin_bit_cast(unsigned, f);
  u += 0x7FFFu + ((u >> 16) & 1u);
  return (unsigned short)(u >> 16);
}
DEV float bf2f(unsigned short h) { return __builtin_bit_cast(float, ((unsigned)h) << 16); }
DEV float wave_sum(float v) {
#pragma unroll
  for (int m = 32; m >= 1; m >>= 1) v += __shfl_xor(v, m);
  return v;
}
DEV float wave_max(float v) {
#pragma unroll
  for (int m = 32; m >= 1; m >>= 1) v = fmaxf(v, __shfl_xor(v, m));
  return v;
}
DEV float4 ld4(const float* p) { return *(const float4*)p; }
#ifdef CPU_EMU
DEV float fexp2(float x) { return exp2f(x); }
#else
DEV float fexp2(float x) { return __builtin_amdgcn_exp2f(x); }
#endif
DEV void fast_sincos(float x, float* sn, float* cs) {
  const float k = rintf(x * 0.15915494309189535f);
  float r = fmaf(-k, 6.28125f, x);
  r = fmaf(-k, 1.9353071795864769e-3f, r);
  *sn = __sinf(r); *cs = __cosf(r);
}
DEV void st4(float* p, float4 v) { *(float4*)p = v; }

#define GEMM_BM 128
#define GEMM_MI (GEMM_BM / 64)
#define GEMM_SMEM_BYTES ((GEMM_BM + 128) * 72 * 2)
#ifdef CPU_EMU
DEV unsigned pk2(float a, float b) { return (unsigned)f2bf(a) | ((unsigned)f2bf(b) << 16); }
#else
typedef __bf16 hbf16x2 __attribute__((ext_vector_type(2)));
typedef float hf32x2 __attribute__((ext_vector_type(2)));
DEV unsigned pk2(float a, float b) {
  hf32x2 f = {a, b};
  return __builtin_bit_cast(unsigned, __builtin_convertvector(f, hbf16x2));
}
#endif
template <bool ABF, class AROW, class BPTR, class EPI>
DEV void gemm_tile(AROW arow, BPTR bptr, int ldb, int K, EPI epi, char* smem_raw, int akstep = 64) {
  unsigned short(*sA)[72] = (unsigned short(*)[72])smem_raw;
  unsigned short(*sB)[72] = (unsigned short(*)[72])(smem_raw + GEMM_BM * 72 * 2);
  const int tid = TIDX, lane = tid & 63, wave = tid >> 6;
  const int wm = wave >> 1, wn = wave & 1;
#if defined(CPU_EMU) && !defined(EMU_REAL_GEMM)
  for (int mi = 0; mi < GEMM_MI; ++mi)
    for (int r = 0; r < 16; ++r) {
      const int row = wm * (GEMM_BM / 2) + mi * 32 + (r & 3) + 8 * (r >> 2) + 4 * (lane >> 5);
      const int col = wn * 64 + (lane & 31);
      const void* arp = arow(row);
      float v[2] = {0.f, 0.f};
      for (int ni = 0; ni < 2; ++ni) {
        const int cc = col + ni * 32;
        const float* bq = bptr(cc & ~3);
        if (!arp || !bq) continue;
        bq += cc & 3;
        float a = 0.f;
        for (int k = 0; k < K; ++k) {
          const size_t ka = (size_t)(k >> 6) * akstep + (k & 63);
          const float av = ABF ? bf2f(((const unsigned short*)arp)[ka]) : bf2f(f2bf(((const float*)arp)[ka]));
          a += av * bf2f(f2bf(bq[(size_t)k * ldb]));
        }
        v[ni] = a;
      }
      epi(row, col, v[0], v[1]);
    }
  return;
#endif
  const float* ap[4 * GEMM_MI];
  const unsigned short* aph[2 * GEMM_MI];
  if (ABF) {
#pragma unroll
    for (int i = 0; i < 2 * GEMM_MI; ++i) aph[i] = (const unsigned short*)arow((tid >> 3) + 32 * i);
  } else {
#pragma unroll
    for (int i = 0; i < 4 * GEMM_MI; ++i) ap[i] = (const float*)arow((tid >> 4) + 16 * i);
  }
  const float* bp = bptr((tid & 31) * 4);
  const int kgrp = tid >> 5;
  float4 ra0[4 * GEMM_MI], ra1[4 * GEMM_MI];
  uint4 rah0[2 * GEMM_MI], rah1[2 * GEMM_MI];
  float4 rb0[8], rb1[8];
#define GEMM_GLOAD(S, k0_)                                                                                                          \
  {                                                                                                                                 \
    if (ABF) {                                                                                                                      \
      _Pragma("unroll") for (int i = 0; i < 2 * GEMM_MI; ++i) rah##S[i] =                                                           \
          aph[i] ? *(const uint4*)(aph[i] + (size_t)((k0_) >> 6) * akstep + (tid & 7) * 8) : make_uint4(0, 0, 0, 0);                \
    } else {                                                                                                                        \
      _Pragma("unroll") for (int i = 0; i < 4 * GEMM_MI; ++i) ra##S[i] =                                                            \
          ap[i] ? ld4(ap[i] + (size_t)((k0_) >> 6) * akstep + (tid & 15) * 4) : make_float4(0.f, 0.f, 0.f, 0.f);                    \
    }                                                                                                                               \
    _Pragma("unroll") for (int j = 0; j < 8; ++j) rb##S[j] =                                                                        \
        bp ? ld4(bp + (size_t)((k0_) + kgrp * 8 + j) * ldb) : make_float4(0.f, 0.f, 0.f, 0.f);                                      \
  }
#define GEMM_SSTORE(S)                                                                                                              \
  {                                                                                                                                 \
    if (ABF) {                                                                                                                      \
      _Pragma("unroll") for (int i = 0; i < 2 * GEMM_MI; ++i) *(uint4*)&sA[(tid >> 3) + 32 * i][(tid & 7) * 8] = rah##S[i];         \
    } else {                                                                                                                        \
      _Pragma("unroll") for (int i = 0; i < 4 * GEMM_MI; ++i) *(uint2*)&sA[(tid >> 4) + 16 * i][(tid & 15) * 4] =                   \
          make_uint2(pk2(ra##S[i].x, ra##S[i].y), pk2(ra##S[i].z, ra##S[i].w));                                                     \
    }                                                                                                                               \
    const int nb = (tid & 31) * 4;                                                                                                  \
    *(uint4*)&sB[nb + 0][kgrp * 8] = make_uint4(pk2(rb##S[0].x, rb##S[1].x), pk2(rb##S[2].x, rb##S[3].x), pk2(rb##S[4].x, rb##S[5].x), pk2(rb##S[6].x, rb##S[7].x)); \
    *(uint4*)&sB[nb + 1][kgrp * 8] = make_uint4(pk2(rb##S[0].y, rb##S[1].y), pk2(rb##S[2].y, rb##S[3].y), pk2(rb##S[4].y, rb##S[5].y), pk2(rb##S[6].y, rb##S[7].y)); \
    *(uint4*)&sB[nb + 2][kgrp * 8] = make_uint4(pk2(rb##S[0].z, rb##S[1].z), pk2(rb##S[2].z, rb##S[3].z), pk2(rb##S[4].z, rb##S[5].z), pk2(rb##S[6].z, rb##S[7].z)); \
    *(uint4*)&sB[nb + 3][kgrp * 8] = make_uint4(pk2(rb##S[0].w, rb##S[1].w), pk2(rb##S[2].w, rb##S[3].w), pk2(rb##S[4].w, rb##S[5].w), pk2(rb##S[6].w, rb##S[7].w)); \
  }
  f32x16 acc[GEMM_MI][2];
#pragma unroll
  for (int mi = 0; mi < GEMM_MI; ++mi)
#pragma unroll
    for (int ni = 0; ni < 2; ++ni)
#pragma unroll
      for (int r = 0; r < 16; ++r) acc[mi][ni][r] = 0.f;
  auto compute = [&]() {
#pragma unroll
    for (int ks = 0; ks < 4; ++ks) {
      bf16x8 af[GEMM_MI], bfr[2];
#pragma unroll
      for (int mi = 0; mi < GEMM_MI; ++mi) af[mi] = *(const bf16x8*)&sA[wm * (GEMM_BM / 2) + mi * 32 + (lane & 31)][ks * 16 + (lane >> 5) * 8];
#pragma unroll
      for (int ni = 0; ni < 2; ++ni) bfr[ni] = *(const bf16x8*)&sB[wn * 64 + ni * 32 + (lane & 31)][ks * 16 + (lane >> 5) * 8];
#pragma unroll
      for (int mi = 0; mi < GEMM_MI; ++mi)
#pragma unroll
        for (int ni = 0; ni < 2; ++ni) acc[mi][ni] = __builtin_amdgcn_mfma_f32_32x32x16_bf16(af[mi], bfr[ni], acc[mi][ni], 0, 0, 0);
    }
  };
  if (ABF) {
    GEMM_GLOAD(0, 0);
    GEMM_GLOAD(1, 64);
    for (int k0 = 0; k0 < K; k0 += 128) {
      __syncthreads();
      GEMM_SSTORE(0);
      __syncthreads();
      if (k0 + 128 < K) GEMM_GLOAD(0, k0 + 128);
      compute();
      __syncthreads();
      GEMM_SSTORE(1);
      __syncthreads();
      if (k0 + 192 < K) GEMM_GLOAD(1, k0 + 192);
      compute();
    }
  } else {
    GEMM_GLOAD(0, 0);
    for (int k0 = 0; k0 < K; k0 += 64) {
      __syncthreads();
      GEMM_SSTORE(0);
      __syncthreads();
      if (k0 + 64 < K) GEMM_GLOAD(0, k0 + 64);
      compute();
    }
  }
#pragma unroll
  for (int mi = 0; mi < GEMM_MI; ++mi)
#pragma unroll
    for (int r = 0; r < 16; ++r) {
      int row = wm * (GEMM_BM / 2) + mi * 32 + (r & 3) + 8 * (r >> 2) + 4 * (lane >> 5);
      int col = wn * 64 + (lane & 31);
      epi(row, col, acc[mi][0][r], acc[mi][1][r]);
    }
}

template <int LAYER>
DEV void phase_gemm_in(const Params& p, char* smem) {
  const int N = LAYER == 0 ? AB_IN : CD_IN;
  const float* A = LAYER == 0 ? p.in[I_X] : (const float*)(p.ws + OFF_X2);
  const float* B = LAYER == 0 ? p.in[I_AB_W_IN] : p.in[I_CD_W_IN];
  float* C = (float*)(p.ws + OFF_H);
  const int NT = (N + 127) / 128, MT = NTOK / GEMM_BM;
  const int xcd_ = BIDX & 7, lb_ = BIDX >> 3, nb_ = gridDim.x >> 3;
  for (int j_ = lb_; j_ < (MT / 8) * NT; j_ += nb_) {
    const int it = (xcd_ + 8 * (j_ / NT)) * NT + (j_ % NT);
    const int tm = it / NT, tn = it % NT;
    const int m0 = tm * GEMM_BM, n0 = tn * 128;
    gemm_tile<LAYER == 1>(
        [&](int r) { return LAYER == 1 ? (const void*)((const unsigned short*)(p.ws + OFF_X2B) + (size_t)(m0 + r) * DM) : (const void*)(A + (size_t)(m0 + r) * DM); },
        [&](int c) { return (n0 + c < N) ? (B + n0 + c) : (const float*)nullptr; }, N, DM,
        [&](int row, int col, float v0, float v1) {
          const int gm = m0 + row, gc = n0 + col;
          if (LAYER == 1 && gc >= 1792 && gc < 2304) {
            const int i = gc & 63;
            const float pos = (float)(gm % SEQ_LEN);
            const float inv = __expf(-(float)i * (9.210340371976184f / 32.f));
            float sn, cs;
            fast_sincos(pos * inv, &sn, &cs);
            float o0 = v0 * cs - v1 * sn, o1 = v1 * cs + v0 * sn;
            if (gc >= 2048) { o0 *= 0.125f; o1 *= 0.125f; }
            v0 = o0; v1 = o1;
          }
          if (LAYER == 1) {
            float* dstp = gc < 1792 ? C + (size_t)gm * 1792 + gc : (float*)(p.ws + OFF_H2) + (size_t)gm * 1536 + (gc - 1792);
            dstp[0] = v0; dstp[32] = v1;
          } else {
            if (gc < N) C[(size_t)gm * AB_LD + gc] = v0;
            if (gc + 32 < N) C[(size_t)gm * AB_LD + gc + 32] = v1;
          }
        },
        smem);
  }
}

struct S5Const { float lb_re, lb_im; };
DEV void s5_consts(const Params& p, int g, int pp, float& lb_re, float& lb_im, float (&bbr)[16], float (&bbi)[16]) {
  const float dt = expf(p.in[I_S5_LOG_DT][g]);
  const float lr = p.in[I_S5_LAM_RE][g * 64 + pp], li = p.in[I_S5_LAM_IM][g * 64 + pp];
  const float mag = expf(lr * dt);
  float sn, cs;
  sincosf(li * dt, &sn, &cs);
  lb_re = mag * cs; lb_im = mag * sn;
  const float den = lr * lr + li * li;
  const float f_re = ((lb_re - 1.f) * lr + lb_im * li) / den;
  const float f_im = (lb_im * lr - (lb_re - 1.f) * li) / den;
  const float* br = p.in[I_S5_B_RE] + (size_t)(g * 64 + pp) * 16;
  const float* bi = p.in[I_S5_B_IM] + (size_t)(g * 64 + pp) * 16;
#pragma unroll
  for (int h = 0; h < 16; ++h) {
    bbr[h] = f_re * br[h] - f_im * bi[h];
    bbi[h] = f_re * bi[h] + f_im * br[h];
  }
}

#define OFF_QB OFF_X2
#define OFF_KSB (OFF_QB + (size_t)NTOK * 512 * 2)
#define OFF_KWB (OFF_KSB + (size_t)NTOK * 128 * 2)
#define OFF_VST (OFF_KWB + (size_t)NTOK * 128 * 2)
#define OFF_VWT (OFF_VST + (size_t)NTOK * 128 * 2)
#define OFF_KCB (OFF_VWT + (size_t)NTOK * 128 * 2)
#define OFF_VCT (OFF_KCB + (size_t)BATCH * 2 * NB_CMP * 64 * 64 * 2)
#define NSA_QSCALE (0.125f * 1.4426950408889634f)

#define P1_S5A_ITEMS (BATCH * 32 * S5_NC / 4)
#define P1_CMP_ITEMS (2 * BATCH * 2 * NB_CMP)
DEV void p1_s5a(const Params& p, int item, char* smem) {
  const int lane = TIDX & 63, wave = TIDX >> 6;
  const int idx = item * 4 + wave;
  const int g = idx & 31, c = (idx >> 5) % S5_NC, b = idx / (32 * S5_NC);
  float lb_re, lb_im, bbr[16], bbi[16];
  s5_consts(p, g, lane, lb_re, lb_im, bbr, bbi);
  const float* H = (const float*)(p.ws + OFF_H);
  float sr = 0.f, si = 0.f;
  float* su = (float*)smem + wave * 64 * 16;
  __syncthreads();
  {
    const float* ur = H + (size_t)(b * SEQ_LEN + c * 64 + lane) * AB_LD + g * 16;
#pragma unroll
    for (int q = 0; q < 4; ++q) st4(su + lane * 16 + q * 4, ld4(ur + q * 4));
  }
  WAVE_SYNC();
  for (int tt = 0; tt < 64; ++tt) {
    const float* u = su + tt * 16;
    float dr = 0.f, di = 0.f;
#pragma unroll
    for (int h4 = 0; h4 < 4; ++h4) {
      const float4 uv = ld4(u + h4 * 4);
      dr += uv.x * bbr[h4 * 4] + uv.y * bbr[h4 * 4 + 1] + uv.z * bbr[h4 * 4 + 2] + uv.w * bbr[h4 * 4 + 3];
      di += uv.x * bbi[h4 * 4] + uv.y * bbi[h4 * 4 + 1] + uv.z * bbi[h4 * 4 + 2] + uv.w * bbi[h4 * 4 + 3];
    }
    const float nr = lb_re * sr - lb_im * si + dr;
    const float ni = lb_re * si + lb_im * sr + di;
    sr = nr; si = ni;
  }
  float2* E = (float2*)(p.ws + OFF_S5E);
  E[((size_t)(b * S5_NC + c) * 32 + g) * 64 + lane] = make_float2(sr, si);
}
#define P1_CMPG_MT ((NCMP + GEMM_BM - 1) / GEMM_BM)
#define P1_CMPG_ITEMS (2 * BATCH * 2 * P1_CMPG_MT)
DEV void p1_cmpgemm(const Params& p, int item, char* smem) {
  const int mt = item % P1_CMPG_MT;
  int r = item / P1_CMPG_MT;
  const int g = r & 1; r >>= 1;
  const int b = r % BATCH; const int which = r / BATCH;
  const float* H = (const float*)(p.ws + OFF_H);
  const float* w1 = which ? p.in[I_CV_W1] : p.in[I_CK_W1];
  const int colbase = (which ? 1152 : 1024) + g * 64;
  float* HID = (float*)(p.ws + OFF_CMPHID) + ((size_t)(which * BATCH + b) * 2 + g) * NB_CMP * 64 * 128;
  const int n0 = mt * GEMM_BM;
  gemm_tile<false>(
      [&](int rr) { return (n0 + rr < NCMP) ? (const void*)(H + ((size_t)b * SEQ_LEN + 16 * (n0 + rr)) * AB_LD + colbase) : (const void*)nullptr; },
      [&](int c) { return w1 + c; }, 128, 2048,
      [&](int row, int col, float v0, float v1) {
        if (n0 + row < NCMP) { HID[(size_t)(n0 + row) * 128 + col] = v0; HID[(size_t)(n0 + row) * 128 + col + 32] = v1; }
      },
      smem, AB_LD);
}
#define P1_CMPC1_ITEMS 16
DEV void p1_cmpc1(const Params& p, int item, char* smem) {
  const int which = item >> 3, sl = item & 7;
  const float* pe = which ? p.in[I_PE_V] : p.in[I_PE_K];
  const float* w1 = which ? p.in[I_CV_W1] : p.in[I_CK_W1];
  float* sPart = (float*)smem;
  const int tid = TIDX, hid = tid & 127, kh = tid >> 7;
  float a = 0.f;
  const int k0 = sl * 256 + kh * 128;
#pragma unroll 16
  for (int k = k0; k < k0 + 128; ++k) a += pe[k] * w1[(size_t)k * 128 + hid];
  __syncthreads();
  sPart[tid] = a;
  __syncthreads();
  if (tid < 128) ((float*)(p.ws + OFF_CMPC1))[(which * 8 + sl) * 128 + tid] = sPart[tid] + sPart[tid + 128];
  __syncthreads();
}
DEV void p1_compress(const Params& p, int item, char* smem) {
  const int tile = item % NB_CMP;
  int r = item / NB_CMP;
  const int g = r & 1; r >>= 1;
  const int b = r % BATCH; const int which = r / BATCH;
  const float* b1 = which ? p.in[I_CV_B1] : p.in[I_CK_B1];
  const float* w2 = which ? p.in[I_CV_W2] : p.in[I_CK_W2];
  const float* C1P = (const float*)(p.ws + OFF_CMPC1) + which * 8 * 128;
  const float* HID = (const float*)(p.ws + OFF_CMPHID) + ((size_t)(which * BATCH + b) * 2 + g) * NB_CMP * 64 * 128;
  float* sOut = (float*)smem;
  float* sHid = sOut + 8 * 64;
  float* sAll = sHid + 8 * 128;
  float* sC1 = sAll + 64 * 65;
  const int tid = TIDX;
  __syncthreads();
  if (tid < 128) {
    const float* q = C1P + tid;
    sC1[tid] = (((((((q[0] + q[128]) + q[256]) + q[384]) + q[512]) + q[640]) + q[768]) + q[896]) + b1[tid];
  }
  float* dst = (float*)(p.ws + (which ? OFF_VCMP : OFF_KCMP));
#pragma unroll 1
  for (int r8 = 0; r8 < 8; ++r8) {
    const int n0 = tile * 64 + r8 * 8;
    __syncthreads();
    for (int w = tid; w < 8 * 128; w += NTHREADS) {
      const int rr = w >> 7, hid = w & 127;
      const int n = n0 + rr;
      sHid[w] = n < NCMP ? geluf_(HID[(size_t)n * 128 + hid] + sC1[hid]) : 0.f;
    }
    __syncthreads();
    for (int w = tid; w < 8 * 64; w += NTHREADS) {
      const int rr = w >> 6, d = w & 63;
      float a = 0.f;
      for (int hid = 0; hid < 128; ++hid) a += sHid[rr * 128 + hid] * w2[hid * 64 + d];
      sOut[w] = a;
    }
    __syncthreads();
    for (int w = tid; w < 8 * 64; w += NTHREADS) {
      const int rr = w >> 6, d = w & 63;
      const int n = n0 + rr;
      float v = sOut[w];
      if (which == 0 && d < 16) {
        const int i = d & 7;
        const float pos = (float)(n * 16 + 31);
        const float inv = __expf(-(float)i * (13.122363377404328f / 8.f));
        float sn, cs;
        sincosf(pos * inv, &sn, &cs);
        const float x1 = sOut[rr * 64 + i], x2 = sOut[rr * 64 + i + 8];
        v = d < 8 ? x1 * cs - x2 * sn : x2 * cs + x1 * sn;
      }
      if (n >= NCMP) v = 0.f;
      sAll[(r8 * 8 + rr) * 65 + d] = v;
      if (n < NCMP) dst[((size_t)(b * NCMP + n) * 2 + g) * 64 + d] = v;
    }
  }
  __syncthreads();
  if (which == 0) {
    unsigned short* KCB = (unsigned short*)(p.ws + OFF_KCB) + (((size_t)b * 2 + g) * NB_CMP * 64 + tile * 64) * 64;
    for (int w = tid; w < 64 * 8; w += NTHREADS) {
      const int nl = w >> 3, o = w & 7;
      float v[8];
#pragma unroll
      for (int q = 0; q < 8; ++q) v[q] = sAll[nl * 65 + o * 8 + q];
      *(uint4*)(KCB + nl * 64 + o * 8) = make_uint4(pk2(v[0], v[1]), pk2(v[2], v[3]), pk2(v[4], v[5]), pk2(v[6], v[7]));
    }
  } else {
    unsigned short* VCT = (unsigned short*)(p.ws + OFF_VCT) + (((size_t)b * 2 + g) * NB_CMP + tile) * 64 * 64;
    for (int w = tid; w < 64 * 8; w += NTHREADS) {
      const int d = w >> 3, o = w & 7;
      float v[8];
#pragma unroll
      for (int q = 0; q < 8; ++q) v[q] = sAll[(o * 8 + q) * 65 + d];
      *(uint4*)(VCT + d * 64 + o * 8) = make_uint4(pk2(v[0], v[1]), pk2(v[2], v[3]), pk2(v[4], v[5]), pk2(v[6], v[7]));
    }
  }
}
DEV uint4 pack8(const float* v) {
  uint4 r;
  r.x = (unsigned)f2bf(v[0]) | ((unsigned)f2bf(v[1]) << 16);
  r.y = (unsigned)f2bf(v[2]) | ((unsigned)f2bf(v[3]) << 16);
  r.z = (unsigned)f2bf(v[4]) | ((unsigned)f2bf(v[5]) << 16);
  r.w = (unsigned)f2bf(v[6]) | ((unsigned)f2bf(v[7]) << 16);
  return r;
}
#define P1_PREP_ITEMS (NTOK / 64)
#define P1_PREP_SMEM ((64 * 8 * 2 + 64 * 128) * 4)
DEV void p1_prep(const Params& p, int item, char* smem) {
  const int tid = TIDX;
  const int b = item / NBLK, blk = item % NBLK;
  const float* H = (const float*)(p.ws + OFF_H);
  float* sCS = (float*)smem;
  float* sV = sCS + 64 * 8 * 2;
  const size_t tok0 = (size_t)b * SEQ_LEN + blk * 64;
  __syncthreads();
  for (int w = tid; w < 64 * 8; w += NTHREADS) {
    const int tk = w >> 3, i = w & 7;
    const float pos = (float)(blk * 64 + tk);
    const float inv = __expf(-(float)i * (13.122363377404328f / 8.f));
    float sn, cs;
    sincosf(pos * inv, &sn, &cs);
    sCS[w * 2] = cs; sCS[w * 2 + 1] = sn;
  }
  __syncthreads();
  unsigned short* QB = (unsigned short*)(p.ws + OFF_QB);
  unsigned short* KSB = (unsigned short*)(p.ws + OFF_KSB);
  unsigned short* KWB = (unsigned short*)(p.ws + OFF_KWB);
  for (int w = tid; w < 64 * 12 * 8; w += NTHREADS) {
    const int o = w & 7, hd = (w >> 3) % 12, tk = w / 96;
    const int col = hd < 8 ? 512 + hd * 64 : (hd < 10 ? 1280 + (hd - 8) * 64 : 1536 + (hd - 10) * 64);
    const float* x = H + (tok0 + tk) * AB_LD + col;
    float v[8];
    const float4 a0 = ld4(x + o * 8), a1 = ld4(x + o * 8 + 4);
    v[0] = a0.x; v[1] = a0.y; v[2] = a0.z; v[3] = a0.w; v[4] = a1.x; v[5] = a1.y; v[6] = a1.z; v[7] = a1.w;
    if (o < 2) {
      const float4 c0 = ld4(x + (1 - o) * 8), c1 = ld4(x + (1 - o) * 8 + 4);
      const float u[8] = {c0.x, c0.y, c0.z, c0.w, c1.x, c1.y, c1.z, c1.w};
#pragma unroll
      for (int i = 0; i < 8; ++i) {
        const float cs = sCS[(tk * 8 + i) * 2], sn = sCS[(tk * 8 + i) * 2 + 1];
        v[i] = o == 0 ? v[i] * cs - u[i] * sn : v[i] * cs + u[i] * sn;
      }
    }
    if (hd < 8) {
#pragma unroll
      for (int i = 0; i < 8; ++i) v[i] *= NSA_QSCALE;
      *(uint4*)(QB + ((tok0 + tk) * 8 + hd) * 64 + o * 8) = pack8(v);
    } else {
      const int g = (hd - 8) & 1;
      unsigned short* dst = (hd < 10 ? KSB : KWB) + (((size_t)b * 2 + g) * SEQ_LEN + blk * 64 + tk) * 64 + o * 8;
      *(uint4*)dst = pack8(v);
    }
  }
#pragma unroll 1
  for (int which = 0; which < 2; ++which) {
    const int col = which ? 1664 : 1408;
    __syncthreads();
    for (int w = tid; w < 64 * 32; w += NTHREADS) {
      const int tk = w >> 5, c4 = (w & 31) * 4;
      st4(sV + tk * 128 + c4, ld4(H + (tok0 + tk) * AB_LD + col + c4));
    }
    __syncthreads();
    unsigned short* VT = (unsigned short*)(p.ws + (which ? OFF_VWT : OFF_VST));
    for (int w = tid; w < 2 * 64 * 8; w += NTHREADS) {
      const int ko = w & 7, d = (w >> 3) & 63, g = w >> 9;
      float v[8];
#pragma unroll
      for (int i = 0; i < 8; ++i) v[i] = sV[(ko * 8 + i) * 128 + g * 64 + d];
      *(uint4*)(VT + ((((size_t)b * 2 + g) * NBLK + blk) * 64 + d) * 64 + ko * 8) = pack8(v);
    }
  }
}

struct NsaSmem {
  unsigned short k[64][72];
  unsigned short vt[64][68];
  float imp[32][128];
  unsigned selmask[32][4];
  unsigned unionm[4];
  float keyb[4][128];
};
#define P2_NSA_SMEM ((int)sizeof(NsaSmem))
#define NSA_QT (SEQ_LEN / 32)
#define P2_NSA_ITEMS (BATCH * 2 * NSA_QT)

struct TileRegs { uint4 k0, k1, v0, v1; };
DEV void tile_gload(TileRegs& r, const unsigned short* Kg, const unsigned short* Vg, int tid) {
  const int row = tid >> 2, seg = tid & 3;
  r.k0 = *(const uint4*)(Kg + row * 64 + seg * 16);
  r.k1 = *(const uint4*)(Kg + row * 64 + seg * 16 + 8);
  if (Vg) {
    r.v0 = *(const uint4*)(Vg + row * 64 + seg * 16);
    r.v1 = *(const uint4*)(Vg + row * 64 + seg * 16 + 8);
  }
}
DEV void tile_sstore(NsaSmem* sm, const TileRegs& r, bool withV, int tid) {
  const int row = tid >> 2, seg = tid & 3;
  *(uint4*)&sm->k[row][seg * 16] = r.k0;
  *(uint4*)&sm->k[row][seg * 16 + 8] = r.k1;
  if (withV) {
    *(uint2*)&sm->vt[row][seg * 16] = make_uint2(r.v0.x, r.v0.y);
    *(uint2*)&sm->vt[row][seg * 16 + 4] = make_uint2(r.v0.z, r.v0.w);
    *(uint2*)&sm->vt[row][seg * 16 + 8] = make_uint2(r.v1.x, r.v1.y);
    *(uint2*)&sm->vt[row][seg * 16 + 12] = make_uint2(r.v1.z, r.v1.w);
  }
}
DEV void qk_tile(const unsigned short (*ksm)[72], const bf16x8 (&qf)[4], f32x16 (&s)[2], int lane) {
  const int r = lane & 31, hh = lane >> 5;
#pragma unroll
  for (int ks2 = 0; ks2 < 2; ++ks2) {
#pragma unroll
    for (int i = 0; i < 16; ++i) s[ks2][i] = 0.f;
#pragma unroll
    for (int ks = 0; ks < 4; ++ks) {
      const bf16x8 a = *(const bf16x8*)&ksm[ks2 * 32 + r][ks * 16 + hh * 8];
      s[ks2] = __builtin_amdgcn_mfma_f32_32x32x16_bf16(a, qf[ks], s[ks2], 0, 0, 0);
    }
  }
}
DEV void pv_tile(const unsigned short (*vsm)[68], const f32x16 (&pr)[2], f32x16 (&o)[2], int lane) {
  const int r = lane & 31, hh = lane >> 5;
#pragma unroll
  for (int ks2 = 0; ks2 < 2; ++ks2)
#pragma unroll
    for (int s = 0; s < 2; ++s) {
      union { uint4 u; bf16x8 v; } pfu;
      pfu.u = make_uint4(pk2(pr[ks2][8 * s], pr[ks2][8 * s + 1]), pk2(pr[ks2][8 * s + 2], pr[ks2][8 * s + 3]),
                         pk2(pr[ks2][8 * s + 4], pr[ks2][8 * s + 5]), pk2(pr[ks2][8 * s + 6], pr[ks2][8 * s + 7]));
      const bf16x8 pf = pfu.v;
#pragma unroll
      for (int mt = 0; mt < 2; ++mt) {
        const uint2 lo = *(const uint2*)&vsm[mt * 32 + r][ks2 * 32 + 16 * s + 4 * hh];
        const uint2 hi = *(const uint2*)&vsm[mt * 32 + r][ks2 * 32 + 16 * s + 8 + 4 * hh];
        union { uint4 u; bf16x8 v; } au;
        au.u = make_uint4(lo.x, lo.y, hi.x, hi.y);
        const bf16x8 a = au.v;
        o[mt] = __builtin_amdgcn_mfma_f32_32x32x16_bf16(a, pf, o[mt], 0, 0, 0);
      }
    }
}
DEV float quad_sum(float v) {
#ifdef CPU_EMU
  v += __shfl_xor(v, 1); v += __shfl_xor(v, 2); return v;
#else
  int x;
  x = __builtin_amdgcn_update_dpp(0, __builtin_bit_cast(int, v), 0xB1, 0xF, 0xF, false); v += __builtin_bit_cast(float, x);
  x = __builtin_amdgcn_update_dpp(0, __builtin_bit_cast(int, v), 0x4E, 0xF, 0xF, false); v += __builtin_bit_cast(float, x);
  return v;
#endif
}
DEV void softmax_step(f32x16 (&s)[2], float& m, float& l, f32x16 (&o)[2]) {
  float tmax = -INFINITY;
#pragma unroll
  for (int ks2 = 0; ks2 < 2; ++ks2)
#pragma unroll
    for (int i = 0; i < 16; ++i) tmax = fmaxf(tmax, s[ks2][i]);
  tmax = fmaxf(tmax, __shfl_xor(tmax, 32));
  const float mnew = fmaxf(m, tmax);
  const float msafe = mnew == -INFINITY ? 0.f : mnew;
  const float alpha = fexp2(m - msafe);
  float ps = 0.f;
#pragma unroll
  for (int ks2 = 0; ks2 < 2; ++ks2)
#pragma unroll
    for (int i = 0; i < 16; ++i) { s[ks2][i] = fexp2(s[ks2][i] - msafe); ps += s[ks2][i]; }
  l = l * alpha + ps;
#pragma unroll
  for (int mt = 0; mt < 2; ++mt)
#pragma unroll
    for (int i = 0; i < 16; ++i) o[mt][i] *= alpha;
  m = mnew;
}
DEV bool testbit4(unsigned w0, unsigned w1, unsigned w2, unsigned w3, int j) {
  const unsigned lo = j & 32 ? w1 : w0, hi = j & 32 ? w3 : w2;
  const unsigned x = j & 64 ? hi : lo;
  return (x >> (j & 31)) & 1u;
}

DEV void p2_nsa(const Params& p, int item, char* smem) {
  NsaSmem* sm = (NsaSmem*)smem;
  const int tid = TIDX, lane = tid & 63, wave = tid >> 6;
  const int bg = item & 3, b = bg >> 1, g = bg & 1;
  const int qt = NSA_QT - 1 - (item >> 2);
  const int t0 = qt * 32;
  const int c = lane & 31, hh = lane >> 5, tl = c >> 2, h = c & 3;
  const int trow = wave * 8 + tl;
  const int tq = t0 + trow;
  const size_t tok = (size_t)b * SEQ_LEN + tq;
  const int hd = g * 4 + h;
  const float* H = (const float*)(p.ws + OFF_H);
  const unsigned short* QB = (const unsigned short*)(p.ws + OFF_QB);
  const unsigned short* KSB = (const unsigned short*)(p.ws + OFF_KSB) + ((size_t)b * 2 + g) * SEQ_LEN * 64;
  const unsigned short* KWB = (const unsigned short*)(p.ws + OFF_KWB) + ((size_t)b * 2 + g) * SEQ_LEN * 64;
  const unsigned short* VST = (const unsigned short*)(p.ws + OFF_VST) + ((size_t)b * 2 + g) * NBLK * 4096;
  const unsigned short* VWT = (const unsigned short*)(p.ws + OFF_VWT) + ((size_t)b * 2 + g) * NBLK * 4096;
  const unsigned short* KCB = (const unsigned short*)(p.ws + OFF_KCB) + ((size_t)b * 2 + g) * NB_CMP * 4096;
  const unsigned short* VCT = (const unsigned short*)(p.ws + OFF_VCT) + ((size_t)b * 2 + g) * NB_CMP * 4096;
  bf16x8 qf[4];
  {
    const unsigned short* qrow = QB + (tok * 8 + hd) * 64;
#pragma unroll
    for (int ks = 0; ks < 4; ++ks) qf[ks] = *(const bf16x8*)(qrow + ks * 16 + hh * 8);
  }
  const float g0 = sigmoidf_(H[tok * AB_LD + 1792 + hd * 3 + 0]);
  const float g1 = sigmoidf_(H[tok * AB_LD + 1792 + hd * 3 + 1]);
  const float g2 = sigmoidf_(H[tok * AB_LD + 1792 + hd * 3 + 2]);
  f32x16 o[2], s[2];
#pragma unroll
  for (int mt = 0; mt < 2; ++mt)
#pragma unroll
    for (int i = 0; i < 16; ++i) o[mt][i] = 0.f;
  float* mixrow = (float*)(p.ws + OFF_MIX) + tok * 1024 + 512 + hd * 64 + 4 * hh;
  __syncthreads();
  for (int w = tid; w < 32 * 128; w += NTHREADS) (&sm->imp[0][0])[w] = 0.f;
  TileRegs tr;
  tr.k0 = tr.k1 = tr.v0 = tr.v1 = make_uint4(0, 0, 0, 0);
  const int nval = tq >= 31 ? (tq - 31) / 16 + 1 : 0;
  const int nvmax = (t0 + 31 - 31) / 16 + 1;
  const int ktn = (nvmax + 63) / 64;
  float m = -INFINITY, l = 0.f;
  tile_gload(tr, KCB, nullptr, tid);
  for (int kt = 0; kt < ktn; ++kt) {
    __syncthreads();
    tile_sstore(sm, tr, false, tid);
    __syncthreads();
    if (kt + 1 < ktn) tile_gload(tr, KCB + (size_t)(kt + 1) * 4096, nullptr, tid);
    qk_tile(sm->k, qf, s, lane);
    float tmax = -INFINITY;
#pragma unroll
    for (int ks2 = 0; ks2 < 2; ++ks2)
#pragma unroll
      for (int i = 0; i < 16; ++i) {
        const int n = kt * 64 + ks2 * 32 + (i & 3) + 8 * (i >> 2) + 4 * hh;
        s[ks2][i] = n < nval ? s[ks2][i] : -INFINITY;
        tmax = fmaxf(tmax, s[ks2][i]);
      }
    tmax = fmaxf(tmax, __shfl_xor(tmax, 32));
    const float mnew = fmaxf(m, tmax);
    const float msafe = mnew == -INFINITY ? 0.f : mnew;
    float ps = 0.f;
#pragma unroll
    for (int ks2 = 0; ks2 < 2; ++ks2)
#pragma unroll
      for (int i = 0; i < 16; ++i) ps += fexp2(s[ks2][i] - msafe);
    l = l * fexp2(m - msafe) + ps;
    m = mnew;
  }
  {
    const float ltot = l + __shfl_xor(l, 32);
    const float invl = ltot > 0.f ? 1.f / ltot : 0.f;
    const float msafe = m == -INFINITY ? 0.f : m;
    tile_gload(tr, KCB, VCT, tid);
    for (int kt = 0; kt < ktn; ++kt) {
      __syncthreads();
      tile_sstore(sm, tr, true, tid);
      __syncthreads();
      if (kt + 1 < ktn) tile_gload(tr, KCB + (size_t)(kt + 1) * 4096, VCT + (size_t)(kt + 1) * 4096, tid);
      qk_tile(sm->k, qf, s, lane);
#pragma unroll
      for (int ks2 = 0; ks2 < 2; ++ks2)
#pragma unroll
        for (int i = 0; i < 16; ++i) {
          const int n = kt * 64 + ks2 * 32 + (i & 3) + 8 * (i >> 2) + 4 * hh;
          s[ks2][i] = n < nval ? fexp2(s[ks2][i] - msafe) * invl : 0.f;
        }
#pragma unroll
      for (int ks2 = 0; ks2 < 2; ++ks2)
#pragma unroll
        for (int g4 = 0; g4 < 4; ++g4) {
          float A = 2.f * (s[ks2][4 * g4] + s[ks2][4 * g4 + 1] + s[ks2][4 * g4 + 2]) + s[ks2][4 * g4 + 3];
          float Bv = s[ks2][4 * g4 + 3];
          A = quad_sum(A); Bv = quad_sum(Bv);
          const int j = kt * 16 + ks2 * 8 + 2 * g4 + hh;
          if (h == 0 && j < NBLK) sm->imp[trow][j] += A;
          WAVE_SYNC();
          if (h == 0 && j + 1 < NBLK) sm->imp[trow][j + 1] += Bv;
          WAVE_SYNC();
        }
      pv_tile(sm->vt, s, o, lane);
    }
#pragma unroll
    for (int mt = 0; mt < 2; ++mt)
#pragma unroll
      for (int g4 = 0; g4 < 4; ++g4) {
        st4(mixrow + mt * 32 + 8 * g4, make_float4(o[mt][4 * g4] * g0, o[mt][4 * g4 + 1] * g0, o[mt][4 * g4 + 2] * g0, o[mt][4 * g4 + 3] * g0));
        o[mt][4 * g4] = 0.f; o[mt][4 * g4 + 1] = 0.f; o[mt][4 * g4 + 2] = 0.f; o[mt][4 * g4 + 3] = 0.f;
      }
  }
  WAVE_SYNC();
  for (int t8 = 0; t8 < 8; ++t8) {
    const int row = wave * 8 + t8, tt = t0 + row, cur = tt >> 6;
    float kv[2]; bool valid[2];
#pragma unroll
    for (int c2 = 0; c2 < 2; ++c2) {
      const int j = lane + 64 * c2;
      valid[c2] = j < NBLK && j <= cur;
      const bool forced = (j == 0) | (j == cur) | (j == cur - 1);
      kv[c2] = valid[c2] ? (forced ? 1e6f : sm->imp[row][j < NBLK ? j : 0]) : -1.f;
      sm->keyb[wave][j] = kv[c2];
    }
    WAVE_SYNC();
    int rank0 = 0, rank1 = 0;
    const int jlim = cur < NBLK - 1 ? cur : NBLK - 1;
    for (int jj = 0; jj <= jlim; ++jj) {
      const float ov = sm->keyb[wave][jj];
      rank0 += (ov > kv[0] || (ov == kv[0] && jj < lane)) ? 1 : 0;
      rank1 += (ov > kv[1] || (ov == kv[1] && jj < lane + 64)) ? 1 : 0;
    }
    const unsigned long long m0 = __ballot(valid[0] && rank0 < 16);
    const unsigned long long m1 = __ballot(valid[1] && rank1 < 16);
    if (lane == 0) {
      sm->selmask[row][0] = (unsigned)m0; sm->selmask[row][1] = (unsigned)(m0 >> 32);
      sm->selmask[row][2] = (unsigned)m1; sm->selmask[row][3] = (unsigned)(m1 >> 32);
    }
    WAVE_SYNC();
  }
  __syncthreads();
  if (tid < 4) {
    unsigned u = 0;
    for (int r = 0; r < 32; ++r) u |= sm->selmask[r][tid];
    sm->unionm[tid] = u;
  }
  __syncthreads();
  const unsigned um0 = sm->unionm[0], um1 = sm->unionm[1], um2 = sm->unionm[2], um3 = sm->unionm[3];
  const unsigned my0 = sm->selmask[trow][0], my1 = sm->selmask[trow][1], my2 = sm->selmask[trow][2], my3 = sm->selmask[trow][3];
  {
    const int jmax = (t0 + 31) >> 6;
    int j = 0;
    while (j <= jmax && !testbit4(um0, um1, um2, um3, j)) ++j;
    m = -INFINITY; l = 0.f;
    if (j <= jmax) tile_gload(tr, KSB + (size_t)j * 4096, VST + (size_t)j * 4096, tid);
    while (j <= jmax) {
      __syncthreads();
      tile_sstore(sm, tr, true, tid);
      __syncthreads();
      int jn = j + 1;
      while (jn <= jmax && !testbit4(um0, um1, um2, um3, jn)) ++jn;
      if (jn <= jmax) tile_gload(tr, KSB + (size_t)jn * 4096, VST + (size_t)jn * 4096, tid);
      const bool mine = testbit4(my0, my1, my2, my3, j);
      if (__ballot(mine) != 0ull) {
        qk_tile(sm->k, qf, s, lane);
#pragma unroll
        for (int ks2 = 0; ks2 < 2; ++ks2)
#pragma unroll
          for (int i = 0; i < 16; ++i) {
            const int kp = j * 64 + ks2 * 32 + (i & 3) + 8 * (i >> 2) + 4 * hh;
            s[ks2][i] = (mine && kp <= tq) ? s[ks2][i] : -INFINITY;
          }
        softmax_step(s, m, l, o);
        pv_tile(sm->vt, s, o, lane);
      }
      j = jn;
    }
    const float ltot = l + __shfl_xor(l, 32);
    const float sc = ltot > 0.f ? g1 / ltot : 0.f;
#pragma unroll
    for (int mt = 0; mt < 2; ++mt)
#pragma unroll
      for (int g4 = 0; g4 < 4; ++g4) {
        float4 a = ld4(mixrow + mt * 32 + 8 * g4);
        a.x += o[mt][4 * g4] * sc; a.y += o[mt][4 * g4 + 1] * sc; a.z += o[mt][4 * g4 + 2] * sc; a.w += o[mt][4 * g4 + 3] * sc;
        st4(mixrow + mt * 32 + 8 * g4, a);
        o[mt][4 * g4] = 0.f; o[mt][4 * g4 + 1] = 0.f; o[mt][4 * g4 + 2] = 0.f; o[mt][4 * g4 + 3] = 0.f;
      }
  }
  {
    const int jlo = t0 - 511 > 0 ? (t0 - 511) >> 6 : 0, jhi = (t0 + 31) >> 6;
    const int wq0 = t0 + wave * 8;
    m = -INFINITY; l = 0.f;
    tile_gload(tr, KWB + (size_t)jlo * 4096, VWT + (size_t)jlo * 4096, tid);
    for (int j = jlo; j <= jhi; ++j) {
      __syncthreads();
      tile_sstore(sm, tr, true, tid);
      __syncthreads();
      if (j + 1 <= jhi) tile_gload(tr, KWB + (size_t)(j + 1) * 4096, VWT + (size_t)(j + 1) * 4096, tid);
      if (j * 64 <= wq0 + 7 && j * 64 + 63 > wq0 - 512) {
        qk_tile(sm->k, qf, s, lane);
#pragma unroll
        for (int ks2 = 0; ks2 < 2; ++ks2)
#pragma unroll
          for (int i = 0; i < 16; ++i) {
            const int kp = j * 64 + ks2 * 32 + (i & 3) + 8 * (i >> 2) + 4 * hh;
            s[ks2][i] = (kp <= tq && kp > tq - 512) ? s[ks2][i] : -INFINITY;
          }
        softmax_step(s, m, l, o);
        pv_tile(sm->vt, s, o, lane);
      }
    }
    const float ltot = l + __shfl_xor(l, 32);
    const float sc = ltot > 0.f ? g2 / ltot : 0.f;
#pragma unroll
    for (int mt = 0; mt < 2; ++mt)
#pragma unroll
      for (int g4 = 0; g4 < 4; ++g4) {
        float4 a = ld4(mixrow + mt * 32 + 8 * g4);
        a.x += o[mt][4 * g4] * sc; a.y += o[mt][4 * g4 + 1] * sc; a.z += o[mt][4 * g4 + 2] * sc; a.w += o[mt][4 * g4 + 3] * sc;
        st4(mixrow + mt * 32 + 8 * g4, a);
        o[mt][4 * g4] = 0.f; o[mt][4 * g4 + 1] = 0.f; o[mt][4 * g4 + 2] = 0.f; o[mt][4 * g4 + 3] = 0.f;
      }
  }
}

#define P1_SMEM ((8 * 64 + 8 * 128 + 64 * 65 + 128) * 4)
DEV void phase_p1(const Params& p, char* smem) {
  const int total = P1_CMPG_ITEMS + P1_CMPC1_ITEMS + P1_PREP_ITEMS;
  for (int it = BIDX; it < total; it += gridDim.x) {
    if (it < P1_CMPG_ITEMS) p1_cmpgemm(p, it, smem);
    else if (it < P1_CMPG_ITEMS + P1_CMPC1_ITEMS) p1_cmpc1(p, it - P1_CMPG_ITEMS, smem);
    else p1_prep(p, it - P1_CMPG_ITEMS - P1_CMPC1_ITEMS, smem);
  }
  {
    const int Gh = (int)gridDim.x / 2, bid_ = BIDX;
    if (bid_ < Gh) for (int it = bid_; it < P1_S5A_ITEMS; it += Gh) p1_s5a(p, it, smem);
  }
}
#define S5PFX_ITEMS (BATCH * 32 * 64 / NTHREADS)
DEV void s5_prefix(const Params& p, int item) {
  const int gi = item * NTHREADS + TIDX;
  const int lane = gi & 63, g = (gi >> 6) & 31, b = gi >> 11;
  float lb_re, lb_im, bbr[16], bbi[16];
  s5_consts(p, g, lane, lb_re, lb_im, bbr, bbi);
  float ar = lb_re, ai = lb_im;
#pragma unroll
  for (int s = 0; s < 6; ++s) { const float nr = ar * ar - ai * ai, ni = 2.f * ar * ai; ar = nr; ai = ni; }
  float2* E = (float2*)(p.ws + OFF_S5E) + ((size_t)b * S5_NC * 32 + g) * 64 + lane;
  float sr = 0.f, si = 0.f;
  for (int c = 0; c < S5_NC; c += 8) {
    float2 e[8];
#pragma unroll
    for (int q = 0; q < 8; ++q) e[q] = E[(size_t)(c + q) * 32 * 64];
#pragma unroll
    for (int q = 0; q < 8; ++q) {
      E[(size_t)(c + q) * 32 * 64] = make_float2(sr, si);
      const float nr = ar * sr - ai * si + e[q].x, ni = ar * si + ai * sr + e[q].y;
      sr = nr; si = ni;
    }
  }
}
DEV void phase_p1b(const Params& p, char* smem) {
  for (int it = BIDX; it < P1_CMP_ITEMS; it += gridDim.x) p1_compress(p, it, smem);
  for (int it = (int)gridDim.x - 1 - (int)BIDX; it < S5PFX_ITEMS; it += gridDim.x) s5_prefix(p, it);
}

#define P2_S5C_ITEMS (BATCH * 32 * S5_NC / 4)
#define S5C_ROW 132
#define P2_S5C_SMEM ((4 * 16 * S5C_ROW + 2 * 16 * 64 + 4 * 16 * 16) * 4)
DEV bf16x8 pack_bf8(float4 a, float4 b) {
  union { uint4 u; bf16x8 v; } x;
  x.u = make_uint4(pk2(a.x, a.y), pk2(a.z, a.w), pk2(b.x, b.y), pk2(b.z, b.w));
  return x.v;
}
DEV void p2_s5c(const Params& p, int item, char* smem) {
  const int lane = TIDX & 63, wave = TIDX >> 6, tid = TIDX;
  const int g = item & 31, c = ((item >> 5) % (S5_NC / 4)) * 4 + wave, b = item / (32 * (S5_NC / 4));
  float lb_re, lb_im, bbr[16], bbi[16];
  s5_consts(p, g, lane, lb_re, lb_im, bbr, bbi);
  const float2* E = (const float2*)(p.ws + OFF_S5E);
  const float2 e0 = E[((size_t)(b * S5_NC + c) * 32 + g) * 64 + lane];
  float sr = e0.x, si = e0.y;
  const float* H = (const float*)(p.ws + OFF_H);
  float* sS = (float*)smem + wave * 16 * S5C_ROW;
  float* sCre = (float*)smem + 4 * 16 * S5C_ROW;
  float* sCim = sCre + 16 * 64;
  float* su = sCim + 16 * 64 + wave * 16 * 16;
  __syncthreads();
  {
    const float* cre = p.in[I_S5_C_RE] + (size_t)g * 16 * 64;
    const float* cim = p.in[I_S5_C_IM] + (size_t)g * 16 * 64;
    st4(sCre + tid * 4, ld4(cre + tid * 4));
    st4(sCim + tid * 4, ld4(cim + tid * 4));
  }
  __syncthreads();
  const int nn = lane & 15, hh = lane >> 5;
  bf16x8 bC[8];
#pragma unroll
  for (int ks = 0; ks < 8; ++ks) {
    const float* src = (ks < 4 ? sCre : sCim) + nn * 64 + 16 * (ks & 3) + 8 * hh;
    float4 c0 = ld4(src), c1 = ld4(src + 4);
    if (ks >= 4) { c0 = make_float4(-c0.x, -c0.y, -c0.z, -c0.w); c1 = make_float4(-c1.x, -c1.y, -c1.z, -c1.w); }
    bC[ks] = pack_bf8(c0, c1);
  }
  const float dch = p.in[I_S5_D][g * 16 + nn];
  float* YG = (float*)(p.ws + OFF_YGELU);
  for (int sc = 0; sc < 4; ++sc) {
    {
      const float* ur = H + (size_t)(b * SEQ_LEN + c * 64 + sc * 16 + (lane >> 2)) * AB_LD + g * 16 + (lane & 3) * 4;
      st4(su + (lane >> 2) * 16 + (lane & 3) * 4, ld4(ur));
    }
    WAVE_SYNC();
    for (int tt = 0; tt < 16; ++tt) {
      const float* u = su + tt * 16;
      float dr = 0.f, di = 0.f;
#pragma unroll
      for (int h4 = 0; h4 < 4; ++h4) {
        const float4 uv = ld4(u + h4 * 4);
        dr += uv.x * bbr[h4 * 4] + uv.y * bbr[h4 * 4 + 1] + uv.z * bbr[h4 * 4 + 2] + uv.w * bbr[h4 * 4 + 3];
        di += uv.x * bbi[h4 * 4] + uv.y * bbi[h4 * 4 + 1] + uv.z * bbi[h4 * 4 + 2] + uv.w * bbi[h4 * 4 + 3];
      }
      const float nr = lb_re * sr - lb_im * si + dr, ni = lb_re * si + lb_im * sr + di;
      sr = nr; si = ni;
      sS[tt * S5C_ROW + lane] = sr;
      sS[tt * S5C_ROW + 64 + lane] = si;
    }
    WAVE_SYNC();
    {
      f32x16 acc;
#pragma unroll
      for (int i = 0; i < 16; ++i) acc[i] = 0.f;
      const float* arow = sS + nn * S5C_ROW + 8 * hh;
#pragma unroll
      for (int ks = 0; ks < 8; ++ks) {
        const float* src = arow + 16 * ks;
        acc = __builtin_amdgcn_mfma_f32_32x32x16_bf16(pack_bf8(ld4(src), ld4(src + 4)), bC[ks], acc, 0, 0, 0);
      }
      if ((lane & 16) == 0) {
#pragma unroll
        for (int r8 = 0; r8 < 8; ++r8) {
          const int t = (r8 & 3) + 8 * (r8 >> 2) + 4 * hh;
          const size_t tok = (size_t)(b * SEQ_LEN + c * 64 + sc * 16 + t);
          YG[tok * 512 + g * 16 + nn] = geluf_(acc[r8] + dch * su[t * 16 + nn]);
        }
      }
    }
    WAVE_SYNC();
  }
}

#define P2_SMEM (P2_S5C_SMEM > P2_NSA_SMEM ? P2_S5C_SMEM : P2_NSA_SMEM)
DEV void phase_p2(const Params& p, char* smem) {
  const int G = gridDim.x;
  const int total = P2_NSA_ITEMS + P2_S5C_ITEMS;
  for (int r = 0;; ++r) {
    const int it = r * G + ((r & 1) ? (G - 1 - (int)BIDX) : (int)BIDX);
    if (r * G >= total) break;
    if (it >= total) continue;
    if (it < P2_NSA_ITEMS) p2_nsa(p, it, smem);
    else p2_s5c(p, it - P2_NSA_ITEMS, smem);
  }
}

DEV void phase_glu(const Params& p, char* smem) {
  const float* A = (const float*)(p.ws + OFF_YGELU);
  const float* B = p.in[I_S5_W_GLU];
  const float* bias = p.in[I_S5_B_GLU];
  float* MIX = (float*)(p.ws + OFF_MIX);
  const int NT = 4, MT = NTOK / GEMM_BM;
  const int xcd_ = BIDX & 7, lb_ = BIDX >> 3, nb_ = gridDim.x >> 3;
  for (int j_ = lb_; j_ < (MT / 8) * NT; j_ += nb_) {
    const int it = (xcd_ + 8 * (j_ / NT)) * NT + (j_ % NT);
    const int m0 = (it / NT) * GEMM_BM, n0 = (it % NT) * 128;
    gemm_tile<false>(
        [&](int r) { return (const void*)(A + (size_t)(m0 + r) * 512); },
        [&](int c) { return B + n0 + c; }, 512, 512,
        [&](int row, int col, float v0, float v1) {
          const size_t gm = m0 + row; const int gc = n0 + col;
          const float y0 = A[gm * 512 + gc], y1 = A[gm * 512 + gc + 32];
          MIX[gm * 1024 + gc] = y0 * sigmoidf_(v0 + bias[gc]);
          MIX[gm * 1024 + gc + 32] = y1 * sigmoidf_(v1 + bias[gc + 32]);
        },
        smem);
  }
}

template <int LAYER>
DEV void phase_outproj(const Params& p, char* smem) {
  const float* A = (const float*)(p.ws + OFF_MIX);
  const float* B = LAYER == 0 ? p.in[I_AB_W_OUT] : p.in[I_CD_W_OUT];
  const float* xin = LAYER == 0 ? p.in[I_X] : (const float*)(p.ws + OFF_X2);
  float* PRE = (float*)(p.ws + OFF_H);
  const int NT = 8, MT = NTOK / GEMM_BM;
  const int xcd_ = BIDX & 7, lb_ = BIDX >> 3, nb_ = gridDim.x >> 3;
  for (int j_ = lb_; j_ < (MT / 8) * NT; j_ += nb_) {
    const int it = (xcd_ + 8 * (j_ / NT)) * NT + (j_ % NT);
    const int m0 = (it / NT) * GEMM_BM, n0 = (it % NT) * 128;
    gemm_tile<false>(
        [&](int r) { return (const void*)(A + (size_t)(m0 + r) * 1024); },
        [&](int c) { return B + n0 + c; }, 1024, 1024,
        [&](int row, int col, float v0, float v1) {
          const size_t o = (size_t)(m0 + row) * 1024 + n0 + col;
          PRE[o] = ALPHA_F * xin[o] + v0;
          PRE[o + 32] = ALPHA_F * xin[o + 32] + v1;
        },
        smem);
  }
}

DEV void wave_ln(float (&v)[16], const float* gam, const float* bet, int lane) {
  float s = 0.f;
#pragma unroll
  for (int i = 0; i < 16; ++i) s += v[i];
  const float mu = wave_sum(s) * (1.f / 1024.f);
  float q = 0.f;
#pragma unroll
  for (int i = 0; i < 16; ++i) { const float d = v[i] - mu; q += d * d; }
  const float rstd = rsqrtf(wave_sum(q) * (1.f / 1024.f) + 1e-5f);
#pragma unroll
  for (int i = 0; i < 4; ++i) {
    const float4 gv = ld4(gam + lane * 4 + 256 * i), bv = ld4(bet + lane * 4 + 256 * i);
    v[i * 4 + 0] = (v[i * 4 + 0] - mu) * rstd * gv.x + bv.x;
    v[i * 4 + 1] = (v[i * 4 + 1] - mu) * rstd * gv.y + bv.y;
    v[i * 4 + 2] = (v[i * 4 + 2] - mu) * rstd * gv.z + bv.z;
    v[i * 4 + 3] = (v[i * 4 + 3] - mu) * rstd * gv.w + bv.w;
  }
}

#define LNR_T 4
#define P5_SMEM ((4 * LNR_T * 512 + 4 * 4 * LNR_T * 64 + 4 * 64) * 4)
template <int LAYER>
DEV void phase_ln_router(const Params& p, char* smem) {
  const int lane = TIDX & 63, wave = TIDX >> 6;
  const float* PRE = (const float*)(p.ws + OFF_H);
  float* X1 = (float*)(p.ws + OFF_X1);
  const float* router = p.in[I_ROUTER] + (size_t)LAYER * 1024 * 64;
  const float* bias = p.in[I_MOE_BIAS] + LAYER * 64;
  int* TOPI = (int*)(p.ws + OFF_TOPI);
  float* TOPG = (float*)(p.ws + OFF_TOPG);
  float* xh = (float*)smem;
  float* part = xh + 4 * LNR_T * 512;
  float* ms = part + 4 * 4 * LNR_T * 64 + wave * 64;
  unsigned short* X1B = (unsigned short*)p.out;
  for (int it = BIDX; it < NTOK / (4 * LNR_T); it += gridDim.x) {
    const size_t tokb = (size_t)it * (4 * LNR_T) + wave * LNR_T;
    float v[LNR_T][16];
#pragma unroll
    for (int t = 0; t < LNR_T; ++t) {
      const size_t tok = tokb + t;
#pragma unroll
      for (int i = 0; i < 4; ++i) {
        const float4 a = ld4(PRE + tok * 1024 + lane * 4 + 256 * i);
        v[t][i * 4] = a.x; v[t][i * 4 + 1] = a.y; v[t][i * 4 + 2] = a.z; v[t][i * 4 + 3] = a.w;
      }
      wave_ln(v[t], p.in[I_LN1_G] + LAYER * 1024, p.in[I_LN1_B] + LAYER * 1024, lane);
#pragma unroll
      for (int i = 0; i < 4; ++i) {
        const float4 a = make_float4(v[t][i * 4], v[t][i * 4 + 1], v[t][i * 4 + 2], v[t][i * 4 + 3]);
        st4(X1 + tok * 1024 + lane * 4 + 256 * i, a);
        *(uint2*)(X1B + tok * 1024 + lane * 4 + 256 * i) = make_uint2(pk2(a.x, a.y), pk2(a.z, a.w));
      }
    }
    {
      float pl[4 * LNR_T];
#pragma unroll
      for (int t = 0; t < 4 * LNR_T; ++t) pl[t] = 0.f;
#pragma unroll
      for (int hf = 0; hf < 2; ++hf) {
        __syncthreads();
#pragma unroll
        for (int t = 0; t < LNR_T; ++t)
#pragma unroll
          for (int i2 = 0; i2 < 2; ++i2) {
            const int i = 2 * hf + i2;
            st4(xh + (wave * LNR_T + t) * 512 + lane * 4 + 256 * i2, make_float4(v[t][i * 4], v[t][i * 4 + 1], v[t][i * 4 + 2], v[t][i * 4 + 3]));
          }
        __syncthreads();
#pragma unroll 2
        for (int kk = wave * 128; kk < wave * 128 + 128; kk += 4) {
          const int k = hf * 512 + kk;
          const float r0 = router[(size_t)k * 64 + lane], r1 = router[(size_t)(k + 1) * 64 + lane],
                      r2 = router[(size_t)(k + 2) * 64 + lane], r3 = router[(size_t)(k + 3) * 64 + lane];
#pragma unroll
          for (int t = 0; t < 4 * LNR_T; ++t) {
            const float4 xv = ld4(xh + t * 512 + kk);
            pl[t] += xv.x * r0 + xv.y * r1 + xv.z * r2 + xv.w * r3;
          }
        }
      }
#pragma unroll
      for (int t = 0; t < 4 * LNR_T; ++t) part[(wave * 4 * LNR_T + t) * 64 + lane] = pl[t];
    }
    __syncthreads();
    float lg[LNR_T];
#pragma unroll
    for (int t = 0; t < LNR_T; ++t) {
      const int tg = wave * LNR_T + t;
      lg[t] = ((part[(0 * 4 * LNR_T + tg) * 64 + lane] + part[(1 * 4 * LNR_T + tg) * 64 + lane]) + part[(2 * 4 * LNR_T + tg) * 64 + lane]) +
              part[(3 * 4 * LNR_T + tg) * 64 + lane];
    }
#pragma unroll
    for (int t = 0; t < LNR_T; ++t) {
      const size_t tok = tokb + t;
      const float score = 1.f / (1.f + expf(-lg[t]));
      const float biased = score + bias[lane];
      float m1 = biased; int a1 = lane;
#pragma unroll
      for (int mm = 1; mm <= 4; mm <<= 1) {
        const float ov = __shfl_xor(m1, mm); const int oa = __shfl_xor(a1, mm);
        if (ov > m1 || (ov == m1 && oa < a1)) { m1 = ov; a1 = oa; }
      }
      float m2 = lane == a1 ? -INFINITY : biased;
#pragma unroll
      for (int mm = 1; mm <= 4; mm <<= 1) m2 = fmaxf(m2, __shfl_xor(m2, mm));
      const float gs = m1 + m2;
      const int mygrp = lane >> 3;
      int rank = 0;
#pragma unroll
      for (int gg = 0; gg < 8; ++gg) {
        const float og = __shfl(gs, gg * 8);
        rank += (og > gs || (og == gs && gg < mygrp)) ? 1 : 0;
      }
      const float masked = rank < 4 ? biased : -INFINITY;
      WAVE_SYNC();
      ms[lane] = masked;
      WAVE_SYNC();
      int erank = 0;
      for (int e = 0; e < 64; ++e) {
        const float ov = ms[e];
        erank += (ov > masked || (ov == masked && e < lane)) ? 1 : 0;
      }
      const bool selected = erank < 8;
      const float gsum = wave_sum(selected ? score : 0.f);
      if (selected) {
        TOPI[tok * 8 + erank] = lane;
        TOPG[tok * 8 + erank] = score / gsum * 2.5f;
      }
    }
  }
}

#define P6_SMEM GEMM_SMEM_BYTES
template <int LAYER>
DEV void phase_lists_shup(const Params& p, char* smem) {
  const int tid = TIDX, lane = tid & 63, wave = tid >> 6;
  const int* TOPI = (const int*)(p.ws + OFF_TOPI);
  const float* TOPG = (const float*)(p.ws + OFF_TOPG);
  int* PPOS = (int*)(p.ws + OFF_S5E);
  int* CNT = (int*)(p.ws + OFF_CNT);
  int* LTOK = (int*)(p.ws + OFF_LTOK);
  float* LGATE = (float*)(p.ws + OFF_LGATE);
  const unsigned short* X1B = (const unsigned short*)p.out;
  unsigned short* HS = (unsigned short*)(p.ws + OFF_HS);
  const float* W1 = p.in[I_SH_W1] + (size_t)LAYER * 1024 * 256;
  const float* W3 = p.in[I_SH_W3] + (size_t)LAYER * 1024 * 256;
  const int MT = NTOK / GEMM_BM;
  int* swave = (int*)smem;
  for (int it = BIDX; it < 64; it += gridDim.x) {
    const int e = it;
    int base = 0;
    for (int t0 = 0; t0 < NTOK; t0 += 4 * NTHREADS) {
      const int tok4 = t0 + 4 * tid;
      int slot[4];
      unsigned long long bal[4];
#pragma unroll
      for (int j = 0; j < 4; ++j) {
        const int4 a = *(const int4*)(TOPI + (size_t)(tok4 + j) * 8), b = *(const int4*)(TOPI + (size_t)(tok4 + j) * 8 + 4);
        int sl = -1;
        sl = a.x == e ? 0 : sl; sl = a.y == e ? 1 : sl; sl = a.z == e ? 2 : sl; sl = a.w == e ? 3 : sl;
        sl = b.x == e ? 4 : sl; sl = b.y == e ? 5 : sl; sl = b.z == e ? 6 : sl; sl = b.w == e ? 7 : sl;
        slot[j] = sl;
        bal[j] = __ballot(sl >= 0);
      }
      const unsigned long long lower = (1ull << lane) - 1ull;
      int pre = 0, wtot = 0;
#pragma unroll
      for (int j = 0; j < 4; ++j) { pre += __popcll(bal[j] & lower); wtot += __popcll(bal[j]); }
      __syncthreads();
      if (lane == 0) swave[wave] = wtot;
      __syncthreads();
      int woff = 0, tot = 0;
#pragma unroll
      for (int w = 0; w < 4; ++w) { const int c = swave[w]; if (w < wave) woff += c; tot += c; }
      int pos = base + woff + pre;
#pragma unroll
      for (int j = 0; j < 4; ++j) {
        if (slot[j] >= 0) {
          const int tok = tok4 + j;
          LTOK[(size_t)e * NTOK + pos] = tok;
          LGATE[(size_t)e * NTOK + pos] = TOPG[(size_t)tok * 8 + slot[j]];
          PPOS[(size_t)e * NTOK + tok] = pos;
          ++pos;
        }
      }
      base += tot;
    }
    if (tid == 0) CNT[e * 32] = base;
    __syncthreads();
  }
  {
    const int NT = 4;
    const int xcd_ = BIDX & 7, lb_ = BIDX >> 3, nb_ = gridDim.x >> 3;
    for (int j_ = lb_; j_ < (MT / 8) * NT; j_ += nb_) {
      const int m0 = (xcd_ + 8 * (j_ / NT)) * GEMM_BM, ct = j_ % NT;
      gemm_tile<true>(
          [&](int r) { return (const void*)(X1B + (size_t)(m0 + r) * 1024); },
          [&](int c) { return (((c >> 5) & 1) ? W3 : W1) + ct * 64 + (c >> 6) * 32 + (c & 31); }, 256, 1024,
          [&](int row, int col, float v0, float v1) {
            const int lc = ct * 64 + (col >> 6) * 32 + (col & 31);
            HS[(size_t)(m0 + row) * 256 + lc] = f2bf(siluf_(v0) * v1);
          },
          smem);
    }
  }
}

struct ExpMap { int tstart[65]; int rbase[65]; int ltile[9]; };
DEV void build_expmap(const Params& p, ExpMap* em) {
  __syncthreads();
  if (TIDX == 0) {
    const int* CNT = (const int*)(p.ws + OFF_CNT);
    int ts = 0, rb = 0;
    for (int e = 0; e < 64; ++e) {
      em->tstart[e] = ts; em->rbase[e] = rb;
      const int c = CNT[e * 32];
      ts += (c + GEMM_BM - 1) / GEMM_BM; rb += c;
    }
    em->tstart[64] = ts; em->rbase[64] = rb;
    const int x = BIDX & 7;
    int lt = 0;
    for (int k = 0; k < 8; ++k) { em->ltile[k] = lt; lt += em->tstart[x + 8 * k + 1] - em->tstart[x + 8 * k]; }
    em->ltile[8] = lt;
  }
  __syncthreads();
}
DEV void map_expert_tile(const ExpMap* em, int j, int CT, int& e, int& rt, int& ct) {
  const int jr = j / CT; ct = j % CT;
  int k = 0;
  for (int q = 1; q < 8; ++q) if (em->ltile[q] <= jr) k = q;
  e = (BIDX & 7) + 8 * k; rt = jr - em->ltile[k];
}
#define P7_SMEM (GEMM_SMEM_BYTES + 1024)
template <int LAYER>
DEV void phase_routed_up(const Params& p, char* smem) {
  ExpMap* em = (ExpMap*)(smem + GEMM_SMEM_BYTES);
  build_expmap(p, em);
  const int* CNT = (const int*)(p.ws + OFF_CNT);
  const int* LTOK = (const int*)(p.ws + OFF_LTOK);
  const unsigned short* X1B = (const unsigned short*)p.out;
  unsigned short* HR = (unsigned short*)(p.ws + OFF_HR);
  const int lb_ = BIDX >> 3, nb_ = gridDim.x >> 3;
  for (int j_ = lb_; j_ < em->ltile[8] * 4; j_ += nb_) {
    int e, rtl, ct;
    map_expert_tile(em, j_, 4, e, rtl, ct);
    const int r0 = rtl * GEMM_BM;
    const int cnt = CNT[e * 32], rbase = em->rbase[e];
    const float* W1 = p.in[I_MOE_W1] + ((size_t)LAYER * 64 + e) * 1024 * 256;
    const float* W3 = p.in[I_MOE_W3] + ((size_t)LAYER * 64 + e) * 1024 * 256;
    gemm_tile<true>(
        [&](int r) { return (r0 + r < cnt) ? (const void*)(X1B + (size_t)LTOK[(size_t)e * NTOK + r0 + r] * 1024) : (const void*)nullptr; },
        [&](int c) { return (((c >> 5) & 1) ? W3 : W1) + ct * 64 + (c >> 6) * 32 + (c & 31); }, 256, 1024,
        [&](int row, int col, float v0, float v1) {
          if (r0 + row < cnt) {
            const int lc = ct * 64 + (col >> 6) * 32 + (col & 31);
            HR[(size_t)(rbase + r0 + row) * 256 + lc] = f2bf(siluf_(v0) * v1);
          }
        },
        smem);
  }
}

template <int LAYER>
DEV void phase_down(const Params& p, char* smem) {
  ExpMap* em = (ExpMap*)(smem + GEMM_SMEM_BYTES);
  build_expmap(p, em);
  const int* CNT = (const int*)(p.ws + OFF_CNT);
  const float* LGATE = (const float*)(p.ws + OFF_LGATE);
  const unsigned short* HR = (const unsigned short*)(p.ws + OFF_HR);
  const unsigned short* HS = (const unsigned short*)(p.ws + OFF_HS);
  unsigned short* Y = (unsigned short*)(p.ws + OFF_Y);
  float* FS = (float*)(p.ws + OFF_FS);
  const int xcd_ = BIDX & 7, lb_ = BIDX >> 3, nb_ = gridDim.x >> 3;
  for (int j_ = lb_; j_ < em->ltile[8] * 8; j_ += nb_) {
    int e, rtl, ct;
    map_expert_tile(em, j_, 8, e, rtl, ct);
    const int r0 = rtl * GEMM_BM;
    const int cnt = CNT[e * 32], rbase = em->rbase[e];
    const float* W2 = p.in[I_MOE_W2] + ((size_t)LAYER * 64 + e) * 256 * 1024;
    const int n0 = ct * 128;
    gemm_tile<true>(
        [&](int r) { return (r0 + r < cnt) ? (const void*)(HR + (size_t)(rbase + r0 + r) * 256) : (const void*)nullptr; },
        [&](int c) { return W2 + n0 + c; }, 1024, 256,
        [&](int row, int col, float v0, float v1) {
          if (r0 + row < cnt) {
            const float gt = LGATE[(size_t)e * NTOK + r0 + row];
            const size_t o = (size_t)(rbase + r0 + row) * 1024 + n0 + col;
            Y[o] = f2bf(v0 * gt); Y[o + 32] = f2bf(v1 * gt);
          }
        },
        smem);
  }
  {
    const int MT = NTOK / GEMM_BM, NT = 8;
    const float* W2 = p.in[I_SH_W2] + (size_t)LAYER * 256 * 1024;
    for (int j_ = lb_; j_ < (MT / 8) * NT; j_ += nb_) {
      const int m0 = (xcd_ + 8 * (j_ / NT)) * GEMM_BM, n0 = (j_ % NT) * 128;
      gemm_tile<true>(
          [&](int r) { return (const void*)(HS + (size_t)(m0 + r) * 256); },
          [&](int c) { return W2 + n0 + c; }, 1024, 256,
          [&](int row, int col, float v0, float v1) {
            const size_t o = (size_t)(m0 + row) * 1024 + n0 + col;
            FS[o] = v0; FS[o + 32] = v1;
          },
          smem);
    }
  }
}

template <int LAYER>
DEV void phase_combine(const Params& p, char* smem) {
  ExpMap* em = (ExpMap*)smem;
  build_expmap(p, em);
  const int lane = TIDX & 63, wave = TIDX >> 6;
  const float* X1 = (const float*)(p.ws + OFF_X1);
  const float* FS = (const float*)(p.ws + OFF_FS);
  const unsigned short* Y = (const unsigned short*)(p.ws + OFF_Y);
  const int* TOPI = (const int*)(p.ws + OFF_TOPI);
  const int* PPOS = (const int*)(p.ws + OFF_S5E);
  float* OUT = LAYER == 0 ? (float*)(p.ws + OFF_X2) : p.out;
  for (int it = BIDX; it < NTOK / 4; it += gridDim.x) {
    const size_t tok = (size_t)it * 4 + wave;
    float v[16];
#pragma unroll
    for (int i = 0; i < 4; ++i) {
      const float4 a = ld4(X1 + tok * 1024 + lane * 4 + 256 * i), f = ld4(FS + tok * 1024 + lane * 4 + 256 * i);
      v[i * 4] = ALPHA_F * a.x + f.x; v[i * 4 + 1] = ALPHA_F * a.y + f.y; v[i * 4 + 2] = ALPHA_F * a.z + f.z; v[i * 4 + 3] = ALPHA_F * a.w + f.w;
    }
    size_t rows[8];
#pragma unroll
    for (int s = 0; s < 8; ++s) { const int e_ = TOPI[tok * 8 + s]; rows[s] = (size_t)em->rbase[e_] + PPOS[(size_t)e_ * NTOK + tok]; }
#pragma unroll
    for (int s0 = 0; s0 < 8; s0 += 4) {
      uint2 yy[4][4];
#pragma unroll
      for (int s = 0; s < 4; ++s)
#pragma unroll
        for (int i = 0; i < 4; ++i) yy[s][i] = *(const uint2*)(Y + rows[s0 + s] * 1024 + lane * 4 + 256 * i);
#pragma unroll
      for (int s = 0; s < 4; ++s)
#pragma unroll
        for (int i = 0; i < 4; ++i) {
          const uint2 y = yy[s][i];
          v[i * 4] += bf2f((unsigned short)(y.x & 0xFFFF)); v[i * 4 + 1] += bf2f((unsigned short)(y.x >> 16));
          v[i * 4 + 2] += bf2f((unsigned short)(y.y & 0xFFFF)); v[i * 4 + 3] += bf2f((unsigned short)(y.y >> 16));
        }
    }
    wave_ln(v, p.in[I_LN2_G] + LAYER * 1024, p.in[I_LN2_B] + LAYER * 1024, lane);
#pragma unroll
    for (int i = 0; i < 4; ++i) st4(OUT + tok * 1024 + lane * 4 + 256 * i, make_float4(v[i * 4], v[i * 4 + 1], v[i * 4 + 2], v[i * 4 + 3]));
    if (LAYER == 0) {
      unsigned short* X2B = (unsigned short*)(p.ws + OFF_X2B);
#pragma unroll
      for (int i = 0; i < 4; ++i) *(uint2*)(X2B + tok * 1024 + lane * 4 + 256 * i) = make_uint2(pk2(v[i * 4], v[i * 4 + 1]), pk2(v[i * 4 + 2], v[i * 4 + 3]));
    }
  }
}

DEV float shifted(const float* Hc, size_t tok, int col, const float* mu) {
  const float cur = Hc[tok * 1792 + col];
  const float prev = (tok % SEQ_LEN) == 0 ? 0.f : Hc[(tok - 1) * 1792 + col];
  return cur + (prev - cur) * mu[col];
}

#define RWP_T 32
#define P11_PREP_ITEMS (NTOK / RWP_T)
#define P11_KV_ITEMS (BATCH * 4 * RET_NC)
#define P11_SMEM (RWP_T * 128 * 4)
DEV void p11_prep(const Params& p, int item, char* smem) {
  const int tid = TIDX;
  const float* Hc = (const float*)(p.ws + OFF_H);
  const float* mu = p.in[I_RW_MU];
  float* sl = (float*)smem;
  __syncthreads();
  for (int w = tid; w < RWP_T * 128; w += NTHREADS) {
    const int tt = w >> 7, j = w & 127;
    const size_t tok = (size_t)item * RWP_T + tt;
    const float v = shifted(Hc, tok, 1536 + j, mu);
    sl[w] = j < 64 ? tanhf(v) : v;
    ((float*)(p.ws + OFF_GLO))[tok * 128 + j] = sigmoidf_(shifted(Hc, tok, 1664 + j, mu));
  }
  __syncthreads();
  float* RWW = (float*)(p.ws + OFF_RWW); float* RWK = (float*)(p.ws + OFF_RWK);
  float* RWKK = (float*)(p.ws + OFF_RWKK); float* RWA = (float*)(p.ws + OFF_RWA);
  float* RWR = p.out + (size_t)NTOK * 512; float* RWV = p.out;
  const float* w_up = p.in[I_RW_W_UP]; const float* a_up = p.in[I_RW_A_UP];
#pragma unroll
  for (int cc = 0; cc < 2; ++cc) {
    const int c = tid + 256 * cc;
    float aw[RWP_T], aa[RWP_T];
#pragma unroll
    for (int tt = 0; tt < RWP_T; ++tt) { aw[tt] = 0.f; aa[tt] = 0.f; }
    for (int j0 = 0; j0 < 64; j0 += 16) {
      float wu[16], au[16];
#pragma unroll
      for (int q = 0; q < 16; ++q) { wu[q] = w_up[(j0 + q) * 512 + c]; au[q] = a_up[(j0 + q) * 512 + c]; }
#pragma unroll
      for (int q4 = 0; q4 < 4; ++q4) {
#pragma unroll
        for (int tt = 0; tt < RWP_T; ++tt) {
          const float4 sw = ld4(sl + tt * 128 + j0 + q4 * 4), sa = ld4(sl + tt * 128 + 64 + j0 + q4 * 4);
          aw[tt] += sw.x * wu[q4 * 4] + sw.y * wu[q4 * 4 + 1] + sw.z * wu[q4 * 4 + 2] + sw.w * wu[q4 * 4 + 3];
          aa[tt] += sa.x * au[q4 * 4] + sa.y * au[q4 * 4 + 1] + sa.z * au[q4 * 4 + 2] + sa.w * au[q4 * 4 + 3];
        }
      }
    }
    const float w0 = p.in[I_RW_W0][c], a0 = p.in[I_RW_A0][c], kkc = p.in[I_RW_K_K][c], kac = p.in[I_RW_K_A][c];
#pragma unroll 4
    for (int tt = 0; tt < RWP_T; ++tt) {
      const size_t tok = (size_t)item * RWP_T + tt;
      const float lw = w0 + aw[tt];
      const float nl = -lw;
      const float sp = nl > 20.f ? nl : log1pf(expf(nl));
      const float wl = -sp - 0.5f;
      const float decay = expf(-expf(wl));
      const float a = 1.f / (1.f + expf(-(a0 + aa[tt])));
      const float rs = shifted(Hc, tok, c, mu);
      const float ks = shifted(Hc, tok, 512 + c, mu);
      const float vs = shifted(Hc, tok, 1024 + c, mu);
      float kk = ks * kkc;
      const float nrm = sqrtf(wave_sum(kk * kk));
      kk = kk / fmaxf(nrm, 1e-12f);
      RWW[tok * 512 + c] = decay;
      RWK[tok * 512 + c] = ks * (1.f + (a - 1.f) * kac);
      RWKK[tok * 512 + c] = kk;
      RWA[tok * 512 + c] = kk * a;
      RWR[tok * 512 + c] = rs;
      RWV[tok * 512 + c] = vs;
    }
  }
}
DEV float ret_log2gamma(int h) { return log2f(1.f - exp2f(-5.f - (float)h)); }
struct KvSmem { unsigned short vt[128][72]; unsigned short kt[64][72]; };
#define P11_KV_SMEM ((int)sizeof(KvSmem))
DEV void p11_kv(const Params& p, int item, char* smem) {
  KvSmem* sm = (KvSmem*)smem;
  const int c = item % RET_NC, h = (item / RET_NC) & 3, b = item / (RET_NC * 4);
  const int tid = TIDX, lane = tid & 63, wave = tid >> 6;
  const int r = lane & 31, hh = lane >> 5;
  const float* H2 = (const float*)(p.ws + OFF_H2);
  const float lg = ret_log2gamma(h);
  const size_t tok0 = (size_t)b * SEQ_LEN + c * 128;
  f32x16 acc[2];
#pragma unroll
  for (int nt = 0; nt < 2; ++nt)
#pragma unroll
    for (int i = 0; i < 16; ++i) acc[nt][i] = 0.f;
#pragma unroll 1
  for (int kt = 0; kt < 2; ++kt) {
    __syncthreads();
#pragma unroll
    for (int q = 0; q < 8; ++q) {
      const int f = tid + 256 * q;
      const int key = f >> 5, d4 = (f & 31) * 4;
      const float dec = exp2f((float)(127 - (kt * 64 + key)) * lg);
      const float4 v = ld4(H2 + (tok0 + kt * 64 + key) * 1536 + 512 + h * 128 + d4);
      sm->vt[d4][key] = f2bf(v.x * dec); sm->vt[d4 + 1][key] = f2bf(v.y * dec);
      sm->vt[d4 + 2][key] = f2bf(v.z * dec); sm->vt[d4 + 3][key] = f2bf(v.w * dec);
    }
#pragma unroll
    for (int q = 0; q < 4; ++q) {
      const int f = tid + 256 * q;
      const int key = f >> 4, d4 = (f & 15) * 4;
      const float4 v = ld4(H2 + (tok0 + kt * 64 + key) * 1536 + 256 + h * 64 + d4);
      sm->kt[d4][key] = f2bf(v.x); sm->kt[d4 + 1][key] = f2bf(v.y); sm->kt[d4 + 2][key] = f2bf(v.z); sm->kt[d4 + 3][key] = f2bf(v.w);
    }
    __syncthreads();
#pragma unroll
    for (int ks = 0; ks < 4; ++ks) {
      const bf16x8 a = *(const bf16x8*)&sm->vt[wave * 32 + r][ks * 16 + hh * 8];
#pragma unroll
      for (int nt = 0; nt < 2; ++nt) {
        const bf16x8 bb = *(const bf16x8*)&sm->kt[nt * 32 + r][ks * 16 + hh * 8];
        acc[nt] = __builtin_amdgcn_mfma_f32_32x32x16_bf16(a, bb, acc[nt], 0, 0, 0);
      }
    }
  }
  float* KV = (float*)(p.ws + OFF_RETKV) + (size_t)item * 64 * 128;
#pragma unroll
  for (int nt = 0; nt < 2; ++nt)
#pragma unroll
    for (int g4 = 0; g4 < 4; ++g4)
      st4(KV + (nt * 32 + r) * 128 + wave * 32 + 8 * g4 + 4 * hh,
          make_float4(acc[nt][4 * g4], acc[nt][4 * g4 + 1], acc[nt][4 * g4 + 2], acc[nt][4 * g4 + 3]));
}
DEV void phase_p11(const Params& p, char* smem) {
  {
    unsigned* RKF = (unsigned*)(p.ws + OFF_RKF);
    for (int i = BIDX * NTHREADS + TIDX; i < BATCH * 8 * (SEQ_LEN / 32); i += gridDim.x * NTHREADS) RKF[i] = 0u;
  }
  const int total = P11_PREP_ITEMS + P11_KV_ITEMS;
  for (int it = BIDX; it < total; it += gridDim.x) {
    if (it < P11_KV_ITEMS) p11_kv(p, it, smem);
    else p11_prep(p, it - P11_KV_ITEMS, smem);
  }
}

#define RK_T 32
#define RK_NCH (SEQ_LEN / RK_T)
#define RK_NCHT (BATCH * 8 * RK_NCH)
#define OFF_RKPT OFF_H
#define OFF_RKKT (OFF_RKPT + (size_t)RK_NCHT * 64 * 64 * 2)
#define OFF_RKVT (OFF_RKKT + (size_t)RK_NCHT * 64 * 32 * 2)
#define OFF_RKRT (OFF_RKVT + (size_t)RK_NCHT * 64 * 32 * 2)
#define OFF_RKAT (OFF_RKRT + (size_t)RK_NCHT * 32 * 64 * 2)
#define OFF_RKEND (OFF_RKAT + (size_t)RK_NCHT * 32 * 32 * 2)
static_assert(OFF_RKEND <= OFF_H2, "rk buffers must fit in the H1 region");
#define RKPRE_SMEM ((4 * 32 * 64 + 32 * 64) * 4)

DEV unsigned short* rksc_row(char* ws, int b, int h, int c, int i) {
  return (unsigned short*)(ws + OFF_RWW) + (((size_t)b * SEQ_LEN + (size_t)c * RK_T + (i >> 1)) * 512 + h * 64) * 2 + (i & 1) * 64;
}
#if RK_MERGED
DEV void st_wt_u16(unsigned short* q, unsigned short v) { asm volatile("global_store_short %0, %1, off sc1" :: "v"(q), "v"((unsigned)v) : "memory"); }
typedef unsigned u32x4_t __attribute__((ext_vector_type(4)));
DEV void st_wt_b128(void* q, uint4 v) { const u32x4_t w = {v.x, v.y, v.z, v.w}; asm volatile("global_store_dwordx4 %0, %1, off sc1" :: "v"(q), "v"(w) : "memory"); }
#else
DEV void st_wt_u16(unsigned short* q, unsigned short v) { *q = v; }
DEV void st_wt_b128(void* q, uint4 v) { *(uint4*)q = v; }
#endif
DEV void rk_precompute(const Params& p, int ch, char* smem) {
  const int c = ch % RK_NCH, bh = ch / RK_NCH, h = bh & 7, b = bh >> 3;
  const int tid = TIDX, lane = tid & 63, wave = tid >> 6;
  const size_t tok0 = (size_t)b * SEQ_LEN + (size_t)c * RK_T;
  const float* RWW = (const float*)(p.ws + OFF_RWW); const float* RWK = (const float*)(p.ws + OFF_RWK);
  const float* RWKK = (const float*)(p.ws + OFF_RWKK); const float* RWA = (const float*)(p.ws + OFF_RWA);
  const float* RWR = p.out + (size_t)NTOK * 512; const float* RWV = p.out;
  float* sW = (float*)smem;
  float* sNK = sW + 32 * 64;
  float* sKA = sNK + 32 * 64;
  float* sR = sKA + 32 * 64;
  float* sV = sR + 32 * 64;
  __syncthreads();
  for (int w = tid; w < 32 * 16; w += NTHREADS) {
    const int t = w >> 4, c4 = (w & 15) * 4;
    const size_t o = (tok0 + t) * 512 + h * 64 + c4;
    st4(sW + t * 64 + c4, ld4(RWW + o));
    const float4 kk = ld4(RWKK + o);
    st4(sNK + t * 64 + c4, make_float4(-kk.x, -kk.y, -kk.z, -kk.w));
    st4(sKA + t * 64 + c4, ld4(RWA + o));
    st4(sR + t * 64 + c4, ld4(RWR + o));
    st4(sV + t * 64 + c4, ld4(RWV + o));
  }
  __syncthreads();
  const int wrole = (wave + ((BIDX >= (gridDim.x >> 1)) ? 2 : 0)) & 3;
  if (wrole == 0) {
    float z[64];
#pragma unroll
    for (int j = 0; j < 64; ++j) z[j] = (j == lane) ? 1.f : 0.f;
    for (int t = 0; t < RK_T; ++t) {
      float cacc = 0.f;
#pragma unroll
      for (int j4 = 0; j4 < 16; ++j4) {
        const float4 u = ld4(sNK + t * 64 + j4 * 4);
        cacc += z[j4 * 4] * u.x + z[j4 * 4 + 1] * u.y + z[j4 * 4 + 2] * u.z + z[j4 * 4 + 3] * u.w;
      }
#pragma unroll
      for (int j4 = 0; j4 < 16; ++j4) {
        const float4 w = ld4(sW + t * 64 + j4 * 4), v = ld4(sKA + t * 64 + j4 * 4);
        z[j4 * 4] = z[j4 * 4] * w.x + cacc * v.x; z[j4 * 4 + 1] = z[j4 * 4 + 1] * w.y + cacc * v.y;
        z[j4 * 4 + 2] = z[j4 * 4 + 2] * w.z + cacc * v.z; z[j4 * 4 + 3] = z[j4 * 4 + 3] * w.w + cacc * v.w;
      }
    }
    unsigned short* PT = (unsigned short*)(p.ws + OFF_RKPT) + (size_t)ch * 64 * 64;
#pragma unroll
    for (int j = 0; j < 64; ++j) st_wt_u16(PT + j * 64 + lane, f2bf(z[j]));
  } else if (wrole == 1) {
    const bool isA = lane < 32;
    const int me = lane & 31;
    float q[64];
    {
      const float* src = (isA ? RWK : RWR) + (tok0 + me) * 512 + h * 64;
#pragma unroll
      for (int j4 = 0; j4 < 16; ++j4) { const float4 v = ld4(src + j4 * 4); q[j4 * 4] = v.x; q[j4 * 4 + 1] = v.y; q[j4 * 4 + 2] = v.z; q[j4 * 4 + 3] = v.w; }
    }
    const float* Ub = isA ? sNK : sKA;
    const float* Vb = isA ? sKA : sNK;
    unsigned short* AT = (unsigned short*)(p.ws + OFF_RKAT) + (size_t)ch * 32 * 32;
    for (int u = 0; u < RK_T; ++u) {
      const int tt = isA ? u : RK_T - 1 - u;
      const bool upd = isA ? (u > me) : (tt <= me);
      if (upd) {
        float cacc = 0.f;
#pragma unroll
        for (int j4 = 0; j4 < 16; ++j4) {
          const float4 uu = ld4(Ub + tt * 64 + j4 * 4);
          cacc += q[j4 * 4] * uu.x + q[j4 * 4 + 1] * uu.y + q[j4 * 4 + 2] * uu.z + q[j4 * 4 + 3] * uu.w;
        }
#pragma unroll
        for (int j4 = 0; j4 < 16; ++j4) {
          const float4 w = ld4(sW + tt * 64 + j4 * 4), v = ld4(Vb + tt * 64 + j4 * 4);
          q[j4 * 4] = q[j4 * 4] * w.x + cacc * v.x; q[j4 * 4 + 1] = q[j4 * 4 + 1] * w.y + cacc * v.y;
          q[j4 * 4 + 2] = q[j4 * 4 + 2] * w.z + cacc * v.z; q[j4 * 4 + 3] = q[j4 * 4 + 3] * w.w + cacc * v.w;
        }
      }
      if (isA) {
        float av = 0.f;
        if (u >= me) {
#pragma unroll
          for (int j4 = 0; j4 < 16; ++j4) {
            const float4 rr = ld4(sR + u * 64 + j4 * 4);
            av += q[j4 * 4] * rr.x + q[j4 * 4 + 1] * rr.y + q[j4 * 4 + 2] * rr.z + q[j4 * 4 + 3] * rr.w;
          }
        }
        AT[u * 32 + me] = f2bf(av);
      }
    }
    if (isA) {
      unsigned short* KT = (unsigned short*)(p.ws + OFF_RKKT) + (size_t)ch * 64 * 32;
#pragma unroll
      for (int j = 0; j < 64; ++j) st_wt_u16(KT + j * 32 + me, f2bf(q[j]));
    } else {
      unsigned short* RT = (unsigned short*)(p.ws + OFF_RKRT) + ((size_t)ch * 32 + me) * 64;
#pragma unroll
      for (int j8 = 0; j8 < 8; ++j8)
        *(uint4*)(RT + j8 * 8) = make_uint4(pk2(q[j8 * 8], q[j8 * 8 + 1]), pk2(q[j8 * 8 + 2], q[j8 * 8 + 3]), pk2(q[j8 * 8 + 4], q[j8 * 8 + 5]), pk2(q[j8 * 8 + 6], q[j8 * 8 + 7]));
    }
  } else if (wrole == 2) {
    unsigned short* VT = (unsigned short*)(p.ws + OFF_RKVT) + (size_t)ch * 64 * 32;
#pragma unroll
    for (int t8 = 0; t8 < 4; ++t8) {
      float v[8];
#pragma unroll
      for (int q8 = 0; q8 < 8; ++q8) v[q8] = sV[(t8 * 8 + q8) * 64 + lane];
      st_wt_b128(VT + lane * 32 + t8 * 8, make_uint4(pk2(v[0], v[1]), pk2(v[2], v[3]), pk2(v[4], v[5]), pk2(v[6], v[7])));
    }
  }
#if RK_MERGED
  asm volatile("s_waitcnt vmcnt(0)" ::: "memory");
  __syncthreads();
  if (tid == 0) __hip_atomic_store((unsigned*)(p.ws + OFF_RKF) + ch, 1u, __ATOMIC_RELAXED, __HIP_MEMORY_SCOPE_AGENT);
#endif
}
DEV void phase_retpfx(const Params& p, char* smem);
DEV void phase_rkpre(const Params& p, char* smem) {
  phase_retpfx(p, smem);
  for (int it = BIDX; it < RK_NCHT; it += gridDim.x) rk_precompute(p, (it % (BATCH * 8)) * RK_NCH + it / (BATCH * 8), smem);
}

DEV bf16x8 ld_frag2(const unsigned short* p0, const unsigned short* p1) {
  const uint2 lo = *(const uint2*)p0, hi = *(const uint2*)p1;
  union { uint4 u; bf16x8 v; } x;
  x.u = make_uint4(lo.x, lo.y, hi.x, hi.y);
  return x.v;
}
DEV bf16x8 ld_frag(const unsigned short* p0) {
  union { uint4 u; bf16x8 v; } x;
  x.u = *(const uint4*)p0;
  return x.v;
}
DEV unsigned rk_flag_ld(const unsigned* f) {
#if RK_MERGED
  return __hip_atomic_load(f, __ATOMIC_RELAXED, __HIP_MEMORY_SCOPE_AGENT);
#else
  return 1u;
#endif
}
DEV void rk_flag_wait(const unsigned* f, unsigned flv) {
#if RK_MERGED
  asm volatile("" : "+v"(flv));
  unsigned fl = (unsigned)__builtin_amdgcn_readfirstlane((int)flv);
  unsigned sp = 0;
  while (fl == 0u) {
    __builtin_amdgcn_s_sleep(1);
    fl = (unsigned)__builtin_amdgcn_readfirstlane((int)__hip_atomic_load(f, __ATOMIC_RELAXED, __HIP_MEMORY_SCOPE_AGENT));
    if (++sp > (1u << 21)) break;
  }
  asm volatile("buffer_inv sc1" ::: "memory");
#endif
}
#define RK_PREFETCH(S, c_)                                                                                                      \
  {                                                                                                                             \
    const size_t chp_ = (size_t)bh * RK_NCH + (c_);                                                                             \
    _Pragma("unroll") for (int jt = 0; jt < 2; ++jt) _Pragma("unroll") for (int kb = 0; kb < 2; ++kb)                          \
        _Pragma("unroll") for (int s_ = 0; s_ < 2; ++s_) {                                                                      \
      const unsigned short* q0 = PTb + (chp_ * 64 + jt * 32 + r) * 64 + kb * 32 + 16 * s_ + 4 * hh;                             \
      pa##S[jt][kb][s_] = ld_frag2(q0, q0 + 8);                                                                                 \
    }                                                                                                                           \
    _Pragma("unroll") for (int jt = 0; jt < 2; ++jt) _Pragma("unroll") for (int ks = 0; ks < 2; ++ks)                          \
        ka##S[jt][ks] = ld_frag(KTb + (chp_ * 64 + jt * 32 + r) * 32 + 16 * ks + 8 * hh);                                       \
    _Pragma("unroll") for (int ks = 0; ks < 2; ++ks) vb##S[ks] = ld_frag(VTb + (chp_ * 64 + it * 32 + r) * 32 + 16 * ks + 8 * hh); \
  }
#define RK_STEP(S, c_)                                                                                                          \
  {                                                                                                                             \
    unsigned short* scr_ = rksc_row(p.ws, bh >> 3, bh & 7, (c_), it * 32 + r);                                                  \
    _Pragma("unroll") for (int kb = 0; kb < 2; ++kb) _Pragma("unroll") for (int g4 = 0; g4 < 4; ++g4)                          \
        *(uint2*)(scr_ + kb * 32 + 8 * g4 + 4 * hh) =                                                                           \
            make_uint2(pk2(X[kb][4 * g4], X[kb][4 * g4 + 1]), pk2(X[kb][4 * g4 + 2], X[kb][4 * g4 + 3]));                       \
    bf16x8 bh_[2][2], bl_[2][2];                                                                                                \
    _Pragma("unroll") for (int kb = 0; kb < 2; ++kb) _Pragma("unroll") for (int s_ = 0; s_ < 2; ++s_) {                        \
      union { uint4 u; bf16x8 v; } hi, lo;                                                                                      \
      unsigned hw[4], lw[4];                                                                                                    \
      _Pragma("unroll") for (int q2 = 0; q2 < 4; ++q2) {                                                                        \
        const float x0 = X[kb][8 * s_ + 2 * q2], x1 = X[kb][8 * s_ + 2 * q2 + 1];                                               \
        const unsigned hp = pk2(x0, x1);                                                                                        \
        hw[q2] = hp;                                                                                                            \
        lw[q2] = pk2(x0 - bf2f((unsigned short)(hp & 0xFFFF)), x1 - bf2f((unsigned short)(hp >> 16)));                          \
      }                                                                                                                         \
      hi.u = make_uint4(hw[0], hw[1], hw[2], hw[3]); lo.u = make_uint4(lw[0], lw[1], lw[2], lw[3]);                             \
      bh_[kb][s_] = hi.v; bl_[kb][s_] = lo.v;                                                                                   \
    }                                                                                                                           \
    f32x16 acc[2];                                                                                                              \
    _Pragma("unroll") for (int jt = 0; jt < 2; ++jt) {                                                                          \
      _Pragma("unroll") for (int i = 0; i < 16; ++i) acc[jt][i] = 0.f;                                                          \
      _Pragma("unroll") for (int kb = 0; kb < 2; ++kb) _Pragma("unroll") for (int s_ = 0; s_ < 2; ++s_) {                      \
        acc[jt] = __builtin_amdgcn_mfma_f32_32x32x16_bf16(pa##S[jt][kb][s_], bh_[kb][s_], acc[jt], 0, 0, 0);                    \
        acc[jt] = __builtin_amdgcn_mfma_f32_32x32x16_bf16(pa##S[jt][kb][s_], bl_[kb][s_], acc[jt], 0, 0, 0);                    \
      }                                                                                                                         \
      _Pragma("unroll") for (int ks = 0; ks < 2; ++ks)                                                                          \
          acc[jt] = __builtin_amdgcn_mfma_f32_32x32x16_bf16(ka##S[jt][ks], vb##S[ks], acc[jt], 0, 0, 0);                        \
    }                                                                                                                           \
    if ((c_) + 2 < RK_NCH) {                                                                                                    \
      rk_flag_wait(RKFb + (c_) + 2, fl##S);                                                                                     \
      fl##S = rk_flag_ld(RKFb + ((c_) + 4 < RK_NCH ? (c_) + 4 : RK_NCH - 1));          \
      RK_PREFETCH(S, (c_) + 2);                                                                                                 \
    }                                                                                                                           \
    X[0] = acc[0]; X[1] = acc[1];                                                                                               \
  }
DEV void rk_chain(const Params& p, int bh) {
  const int tid = TIDX, lane = tid & 63, wave = tid >> 6;
  if (wave >= 2) return;
  const int r = lane & 31, hh = lane >> 5, it = wave;
  const unsigned short* PTb = (const unsigned short*)(p.ws + OFF_RKPT);
  const unsigned short* KTb = (const unsigned short*)(p.ws + OFF_RKKT);
  const unsigned short* VTb = (const unsigned short*)(p.ws + OFF_RKVT);
  const unsigned* RKFb = (const unsigned*)(p.ws + OFF_RKF) + (size_t)bh * RK_NCH;
  f32x16 X[2];
#pragma unroll
  for (int kb = 0; kb < 2; ++kb)
#pragma unroll
    for (int i = 0; i < 16; ++i) X[kb][i] = 0.f;
  bf16x8 paA[2][2][2], kaA[2][2], vbA[2], paB[2][2][2], kaB[2][2], vbB[2];
  rk_flag_wait(RKFb, rk_flag_ld(RKFb));
  RK_PREFETCH(A, 0);
  rk_flag_wait(RKFb + 1, rk_flag_ld(RKFb + 1));
  RK_PREFETCH(B, 1);
  unsigned flA = rk_flag_ld(RKFb + 2), flB = rk_flag_ld(RKFb + 3);
  for (int c = 0; c < RK_NCH; c += 2) {
    RK_STEP(A, c);
    if (c + 1 < RK_NCH) RK_STEP(B, c + 1);
  }
}
DEV void rk_output(const Params& p, int item) {
  const int tid = TIDX, lane = tid & 63, wave = tid >> 6;
  const int ch = item * 4 + wave;
  const int c = ch % RK_NCH, bhh = ch / RK_NCH, h = bhh & 7, b = bhh >> 3;
  const int r = lane & 31, hh = lane >> 5;
  const unsigned short* RT = (const unsigned short*)(p.ws + OFF_RKRT) + (size_t)ch * 32 * 64;
  const unsigned short* AT = (const unsigned short*)(p.ws + OFF_RKAT) + (size_t)ch * 32 * 32;
  const unsigned short* VT = (const unsigned short*)(p.ws + OFF_RKVT) + (size_t)ch * 64 * 32;
  f32x16 acc[2];
#pragma unroll
  for (int i2 = 0; i2 < 2; ++i2)
#pragma unroll
    for (int i = 0; i < 16; ++i) acc[i2][i] = 0.f;
#pragma unroll
  for (int ks = 0; ks < 4; ++ks) {
    const bf16x8 a = ld_frag(RT + r * 64 + 16 * ks + 8 * hh);
#pragma unroll
    for (int i2 = 0; i2 < 2; ++i2) acc[i2] = __builtin_amdgcn_mfma_f32_32x32x16_bf16(a, ld_frag(rksc_row(p.ws, b, h, c, i2 * 32 + r) + 16 * ks + 8 * hh), acc[i2], 0, 0, 0);
  }
#pragma unroll
  for (int ks = 0; ks < 2; ++ks) {
    const bf16x8 a = ld_frag(AT + r * 32 + 16 * ks + 8 * hh);
#pragma unroll
    for (int i2 = 0; i2 < 2; ++i2) acc[i2] = __builtin_amdgcn_mfma_f32_32x32x16_bf16(a, ld_frag(VT + (i2 * 32 + r) * 32 + 16 * ks + 8 * hh), acc[i2], 0, 0, 0);
  }
  float* Yo = (float*)(p.ws + OFF_MIX);
  const size_t tok0 = (size_t)b * SEQ_LEN + (size_t)c * RK_T;
#pragma unroll
  for (int i2 = 0; i2 < 2; ++i2)
#pragma unroll
    for (int i = 0; i < 16; ++i) {
      const int t = (i & 3) + 8 * (i >> 2) + 4 * hh;
      Yo[(tok0 + t) * 1024 + h * 64 + i2 * 32 + r] = acc[i2][i];
    }
}
#define OFF_RWG OFF_RWKK
DEV void phase_rkout(const Params& p, char* smem) {
  {
    const float* GLO = (const float*)(p.ws + OFF_GLO);
    const float* g_up = p.in[I_RW_G_UP];
    float* G = (float*)(p.ws + OFF_RWG);
    for (int t = BIDX; t < (NTOK / GEMM_BM) * 4; t += gridDim.x) {
      const int m0 = (t >> 2) * GEMM_BM, n0 = (t & 3) * 128;
      gemm_tile<false>(
          [&](int r) { return (const void*)(GLO + (size_t)(m0 + r) * 128); },
          [&](int c) { return g_up + n0 + c; }, 512, 128,
          [&](int row, int col, float v0, float v1) {
            const size_t o = (size_t)(m0 + row) * 512 + n0 + col;
            G[o] = v0; G[o + 32] = v1;
          },
          smem);
    }
  }
  for (int it = BIDX; it < RK_NCHT / 4; it += gridDim.x) rk_output(p, it);
}

#define P12_SCAN_ITEMS (BATCH * 8 * 4)
#define P12_RET_ITEMS (BATCH * 4 * RET_NC)
#define P12_SCAN_SMEM ((2 * (16 * 5 * 64 + 16 * 16) + 16 * 16) * 4)
#define P12_RET_SMEM ((64 * 72 + 2 * 64 * 68) * 2)
#define P12_SMEM (P12_SCAN_SMEM > P12_RET_SMEM ? P12_SCAN_SMEM : P12_RET_SMEM)
DEV float sum16(float v) {
#ifdef CPU_EMU
  return emu_sum16(v);
#else
  int x;
  x = __builtin_amdgcn_update_dpp(0, __builtin_bit_cast(int, v), 0xB1, 0xF, 0xF, false); v += __builtin_bit_cast(float, x);
  x = __builtin_amdgcn_update_dpp(0, __builtin_bit_cast(int, v), 0x4E, 0xF, 0xF, false); v += __builtin_bit_cast(float, x);
  x = __builtin_amdgcn_update_dpp(0, __builtin_bit_cast(int, v), 0x141, 0xF, 0xF, false); v += __builtin_bit_cast(float, x);
  x = __builtin_amdgcn_update_dpp(0, __builtin_bit_cast(int, v), 0x140, 0xF, 0xF, false); v += __builtin_bit_cast(float, x);
  return v;
#endif
}
DEV void p12_scan(const Params& p, int item, char* smem) {
  const int rq = item & 3, h = (item >> 2) & 7, b = item >> 5;
  const int tid = TIDX, rl = tid >> 4, cg = tid & 15;
  const float* ARR[5] = {(const float*)(p.ws + OFF_RWW), (const float*)(p.ws + OFF_RWK), (const float*)(p.ws + OFF_RWKK),
                         (const float*)(p.ws + OFF_RWA), p.out + (size_t)NTOK * 512};
  const float* RWV = p.out;
  float* Yo = (float*)(p.ws + OFF_MIX);
  float* buf = (float*)smem;
  float* vbuf = buf + 2 * 16 * 5 * 64;
  float* ybuf = vbuf + 2 * 16 * 16;
  float S[4] = {0.f, 0.f, 0.f, 0.f};
  float4 rg[5]; float rv;
  const int lstep = tid >> 4, lc4 = tid & 15;
  auto gload = [&](int c) {
    const size_t o = ((size_t)b * SEQ_LEN + c * 16 + lstep) * 512 + h * 64;
#pragma unroll
    for (int a = 0; a < 5; ++a) rg[a] = ld4(ARR[a] + o + lc4 * 4);
    rv = RWV[o + rq * 16 + lc4];
  };
  auto sstore = [&](int bi) {
#pragma unroll
    for (int a = 0; a < 5; ++a) st4(buf + ((bi * 16 + lstep) * 5 + a) * 64 + lc4 * 4, rg[a]);
    vbuf[(bi * 16 + lstep) * 16 + lc4] = rv;
  };
  __syncthreads();
  gload(0);
  sstore(0);
  __syncthreads();
  const int NCH = SEQ_LEN / 16;
  for (int c = 0; c < NCH; ++c) {
    if (c + 1 < NCH) gload(c + 1);
    const float* cb = buf + (c & 1) * 16 * 5 * 64;
    const float* cv = vbuf + (c & 1) * 16 * 16;
    float4 cw = ld4(cb + 0 * 64 + cg * 4), ck = ld4(cb + 1 * 64 + cg * 4), ckk = ld4(cb + 2 * 64 + cg * 4),
           cka = ld4(cb + 3 * 64 + cg * 4), cr = ld4(cb + 4 * 64 + cg * 4);
    float cvv = cv[rl];
#pragma unroll
    for (int s = 0; s < 16; ++s) {
      const float4 w = cw, k = ck, kk = ckk, ka = cka, r = cr;
      const float v = cvv;
      if (s < 15) {
        cw = ld4(cb + ((s + 1) * 5 + 0) * 64 + cg * 4); ck = ld4(cb + ((s + 1) * 5 + 1) * 64 + cg * 4);
        ckk = ld4(cb + ((s + 1) * 5 + 2) * 64 + cg * 4); cka = ld4(cb + ((s + 1) * 5 + 3) * 64 + cg * 4);
        cr = ld4(cb + ((s + 1) * 5 + 4) * 64 + cg * 4); cvv = cv[(s + 1) * 16 + rl];
      }
      float sa = (S[0] * kk.x + S[1] * kk.y) + (S[2] * kk.z + S[3] * kk.w);
      sa = -sum16(sa);
      S[0] = S[0] * w.x + (sa * ka.x + v * k.x);
      S[1] = S[1] * w.y + (sa * ka.y + v * k.y);
      S[2] = S[2] * w.z + (sa * ka.z + v * k.z);
      S[3] = S[3] * w.w + (sa * ka.w + v * k.w);
      float y = (S[0] * r.x + S[1] * r.y) + (S[2] * r.z + S[3] * r.w);
      y = sum16(y);
      if (cg == 0) ybuf[s * 16 + rl] = y;
      asm volatile("" ::: "memory");
    }
    __syncthreads();
    if (c + 1 < NCH) sstore((c + 1) & 1);
    Yo[((size_t)b * SEQ_LEN + c * 16 + lstep) * 1024 + h * 64 + rq * 16 + lc4] = ybuf[lstep * 16 + lc4];
    __syncthreads();
  }
}
struct RetSmem { unsigned short k[64][72]; unsigned short vt[2][64][68]; };
#define RETPFX_ITEMS (BATCH * 4 * 64 * 128 / NTHREADS)
DEV void ret_prefix(const Params& p, int item) {
  const int gi = item * NTHREADS + TIDX;
  const int bh4 = gi >> 13, idx = gi & 8191;
  const float G = exp2f(128.f * ret_log2gamma(bh4 & 3));
  float* KV = (float*)(p.ws + OFF_RETKV) + (size_t)bh4 * RET_NC * 8192 + idx;
  float st = 0.f;
  int c = 0;
  for (; c + 8 <= RET_NC; c += 8) {
    float e[8];
#pragma unroll
    for (int q = 0; q < 8; ++q) e[q] = KV[(size_t)(c + q) * 8192];
#pragma unroll
    for (int q = 0; q < 8; ++q) { KV[(size_t)(c + q) * 8192] = st; st = st * G + e[q]; }
  }
  for (; c < RET_NC; ++c) { const float e = KV[(size_t)c * 8192]; KV[(size_t)c * 8192] = st; st = st * G + e; }
}
DEV void phase_retpfx(const Params& p, char* smem) {
  for (int it = BIDX; it < RETPFX_ITEMS; it += gridDim.x) ret_prefix(p, it);
}
DEV void p12_ret(const Params& p, int item, char* smem) {
  RetSmem* sm = (RetSmem*)smem;
  const int c = item % RET_NC, h = (item / RET_NC) & 3, b = item / (RET_NC * 4);
  const int tid = TIDX, lane = tid & 63, wave = tid >> 6;
  const int cidx = lane & 31, hh = lane >> 5;
  const int qi = wave * 32 + cidx;
  const float* H2 = (const float*)(p.ws + OFF_H2);
  const float lg = ret_log2gamma(h);
  const size_t tok0 = (size_t)b * SEQ_LEN + c * 128;
  bf16x8 qf[4], qfs[4];
  {
    const float* qr = H2 + (tok0 + qi) * 1536 + h * 64;
    const float qs = exp2f((float)(qi + 1) * lg);
#pragma unroll
    for (int ks = 0; ks < 4; ++ks) {
      const float4 a0 = ld4(qr + ks * 16 + hh * 8), a1 = ld4(qr + ks * 16 + hh * 8 + 4);
      const float v[8] = {a0.x, a0.y, a0.z, a0.w, a1.x, a1.y, a1.z, a1.w};
#pragma unroll
      for (int j = 0; j < 8; ++j) { qf[ks][j] = (short)f2bf(v[j]); qfs[ks][j] = (short)f2bf(v[j] * qs); }
    }
  }
  f32x16 o[4], s[2];
#pragma unroll
  for (int mt = 0; mt < 4; ++mt)
#pragma unroll
    for (int i = 0; i < 16; ++i) o[mt][i] = 0.f;
  {
    const float* KV0 = (const float*)(p.ws + OFF_RETKV) + (size_t)((b * 4 + h) * RET_NC) * 64 * 128;
#pragma unroll
    for (int eh = 0; eh < 2; ++eh) {
      __syncthreads();
      {
        const int el = tid & 63, d0 = tid >> 6;
        float stv[16];
#pragma unroll
        for (int i = 0; i < 16; ++i) stv[i] = KV0[(size_t)c * 64 * 128 + (d0 + 4 * i) * 128 + eh * 64 + el];
#pragma unroll
        for (int i = 0; i < 16; ++i) sm->k[el][d0 + 4 * i] = f2bf(stv[i]);
      }
      __syncthreads();
      qk_tile(sm->k, qfs, s, lane);
#pragma unroll
      for (int i = 0; i < 16; ++i) { o[eh * 2][i] += s[0][i]; o[eh * 2 + 1][i] += s[1][i]; }
    }
  }
#pragma unroll 1
  for (int kt = 0; kt < 2; ++kt) {
    __syncthreads();
    {
      const int row = tid >> 2, seg = tid & 3;
      const float* kr = H2 + (tok0 + kt * 64 + row) * 1536 + 256 + h * 64 + seg * 16;
      const float4 a0 = ld4(kr), a1 = ld4(kr + 4), a2 = ld4(kr + 8), a3 = ld4(kr + 12);
      *(uint4*)&sm->k[row][seg * 16] = make_uint4(pk2(a0.x, a0.y), pk2(a0.z, a0.w), pk2(a1.x, a1.y), pk2(a1.z, a1.w));
      *(uint4*)&sm->k[row][seg * 16 + 8] = make_uint4(pk2(a2.x, a2.y), pk2(a2.z, a2.w), pk2(a3.x, a3.y), pk2(a3.z, a3.w));
#pragma unroll
      for (int q = 0; q < 8; ++q) {
        const int f = tid + 256 * q;
        const int key = f >> 5, d4 = (f & 31) * 4;
        const float4 v = ld4(H2 + (tok0 + kt * 64 + key) * 1536 + 512 + h * 128 + d4);
        unsigned short(*vt)[68] = sm->vt[d4 >> 6];
        const int dl = d4 & 63;
        vt[dl][key] = f2bf(v.x); vt[dl + 1][key] = f2bf(v.y); vt[dl + 2][key] = f2bf(v.z); vt[dl + 3][key] = f2bf(v.w);
      }
    }
    __syncthreads();
    if (kt * 64 <= wave * 32 + 31) {
      qk_tile(sm->k, qf, s, lane);
#pragma unroll
      for (int ks2 = 0; ks2 < 2; ++ks2)
#pragma unroll
        for (int i = 0; i < 16; ++i) {
          const int kj = kt * 64 + ks2 * 32 + (i & 3) + 8 * (i >> 2) + 4 * hh;
          s[ks2][i] = kj <= qi ? s[ks2][i] * exp2f((float)(qi - kj) * lg) : 0.f;
        }
      pv_tile(sm->vt[0], s, *(f32x16(*)[2])&o[0], lane);
      pv_tile(sm->vt[1], s, *(f32x16(*)[2])&o[2], lane);
    }
  }
  float s1 = 0.f;
#pragma unroll
  for (int mt = 0; mt < 4; ++mt)
#pragma unroll
    for (int i = 0; i < 16; ++i) s1 += o[mt][i];
  s1 += __shfl_xor(s1, 32);
  const float mu = s1 * (1.f / 128.f);
  float s2 = 0.f;
#pragma unroll
  for (int mt = 0; mt < 4; ++mt)
#pragma unroll
    for (int i = 0; i < 16; ++i) { const float d = o[mt][i] - mu; s2 += d * d; }
  s2 += __shfl_xor(s2, 32);
  const float rstd = rsqrtf(s2 * (1.f / 128.f) + 1e-5f);
  float* MIX = (float*)(p.ws + OFF_MIX);
  const float* gate = H2 + (tok0 + qi) * 1536 + 1024 + h * 128;
  float* dst = MIX + (tok0 + qi) * 1024 + 512 + h * 128;
  const float* lgam = p.in[I_RET_LN_G] + h * 128;
  const float* lbet = p.in[I_RET_LN_B] + h * 128;
#pragma unroll
  for (int mt = 0; mt < 4; ++mt)
#pragma unroll
    for (int g4 = 0; g4 < 4; ++g4) {
      const int dv = mt * 32 + 8 * g4 + 4 * hh;
      const float4 gv = ld4(lgam + dv), bv = ld4(lbet + dv), gt = ld4(gate + dv);
      float4 ov;
      ov.x = siluf_(gt.x) * ((o[mt][4 * g4] - mu) * rstd * gv.x + bv.x);
      ov.y = siluf_(gt.y) * ((o[mt][4 * g4 + 1] - mu) * rstd * gv.y + bv.y);
      ov.z = siluf_(gt.z) * ((o[mt][4 * g4 + 2] - mu) * rstd * gv.z + bv.z);
      ov.w = siluf_(gt.w) * ((o[mt][4 * g4 + 3] - mu) * rstd * gv.w + bv.w);
      st4(dst + dv, ov);
    }
}
DEV void phase_p12(const Params& p, char* smem) {
  const int G = gridDim.x;
  const int bid = BIDX;
  if (bid < BATCH * 8 && G > BATCH * 8) {
    rk_chain(p, bid);
  } else if (G >= 8 * BATCH * 8) {
    const int Gh = G >> 1, NC = BATCH * 8;
    if (bid >= Gh && bid < Gh + NC) return;
    const int w = bid - NC - (bid >= Gh ? NC : 0);
#if RK_MERGED
    if ((G & 15) == 0 && BATCH * 8 == 16) {
      const int x = bid & 7, m = bid >> 3;
      const int rank = m - 2 - (m >= (Gh >> 3) ? 2 : 0), nprod = (G >> 3) - 4;
      for (int k = rank; k < 2 * RK_NCH; k += nprod) rk_precompute(p, (x + 8 * (k & 1)) * RK_NCH + (k >> 1), smem);
    } else {
      for (int it = w; it < RK_NCHT; it += G - 2 * NC) rk_precompute(p, (it % NC) * RK_NCH + it / NC, smem);
    }
#endif
    for (int it = w; it < P12_RET_ITEMS; it += G - 2 * NC) p12_ret(p, it, smem);
  } else if (G > BATCH * 8) {
    for (int it = bid - BATCH * 8; it < P12_RET_ITEMS; it += G - BATCH * 8) p12_ret(p, it, smem);
  } else {
    for (int it = bid; it < BATCH * 8 + P12_RET_ITEMS; it += G) {
      if (it < BATCH * 8) rk_chain(p, it);
      else p12_ret(p, it - BATCH * 8, smem);
    }
  }
}

#define P13_SMEM (RWP_T * 128 * 4)
DEV void phase_p13(const Params& p, char* smem) {
  const int tid = TIDX;
  const float* Hc = (const float*)(p.ws + OFF_H);
  const float* mu = p.in[I_RW_MU];
  const float* GLO = (const float*)(p.ws + OFF_GLO);
  float* sl = (float*)smem;
  float* MIX = (float*)(p.ws + OFF_MIX);
  const float* RWK = (const float*)(p.ws + OFF_RWK); const float* RWR = p.out + (size_t)NTOK * 512; const float* RWV = p.out;
  const float* G = (const float*)(p.ws + OFF_RWG);
  for (int it = BIDX; it < NTOK / RWP_T; it += gridDim.x) {
#pragma unroll
    for (int cc = 0; cc < 2; ++cc) {
      const int c = tid + 256 * cc;
      const float lng = p.in[I_RW_LN_G][c], lnb = p.in[I_RW_LN_B][c], rk = p.in[I_RW_R_K][c];
#pragma unroll 4
      for (int tt = 0; tt < RWP_T; ++tt) {
        const size_t tok = (size_t)it * RWP_T + tt;
        const float y = MIX[tok * 1024 + c];
        const float m = wave_sum(y) * (1.f / 64.f);
        const float d = y - m;
        const float var = wave_sum(d * d) * (1.f / 64.f);
        const float yn = d * rsqrtf(var + 64e-5f) * lng + lnb;
        const float r = RWR[tok * 512 + c], k = RWK[tok * 512 + c], v = RWV[tok * 512 + c];
        const float bonus = wave_sum(r * k * rk) * v;
        MIX[tok * 1024 + c] = (yn + bonus) * G[tok * 512 + c];
      }
    }
  }
}

#define NPHASES 20
#define SMEM_BYTES 53248
DEV void run_phase(const Params& p, int ph, char* smem) {
  switch (ph) {
    case 0: phase_gemm_in<0>(p, smem); break;
    case 1: phase_p1(p, smem); break;
    case 2: phase_p2(p, smem); break;
    case 3: phase_glu(p, smem); break;
    case 4: phase_outproj<0>(p, smem); break;
    case 5: phase_ln_router<0>(p, smem); break;
    case 6: phase_lists_shup<0>(p, smem); break;
    case 7: phase_routed_up<0>(p, smem); break;
    case 8: phase_down<0>(p, smem); break;
    case 9: phase_combine<0>(p, smem); break;
    case 10: phase_gemm_in<1>(p, smem); break;
    case 11: phase_p11(p, smem); break;
    case 12: phase_p12(p, smem); break;
    case 13: phase_p13(p, smem); break;
    case 14: phase_outproj<1>(p, smem); break;
    case 15: phase_ln_router<1>(p, smem); break;
    case 16: phase_lists_shup<1>(p, smem); break;
    case 17: phase_routed_up<1>(p, smem); break;
    case 18: phase_down<1>(p, smem); break;
    case 19: phase_combine<1>(p, smem); break;
    case 20: phase_p1b(p, smem); break;
    case 21: phase_rkpre(p, smem); break;
    case 22: phase_rkout(p, smem); break;
    case 24: phase_retpfx(p, smem); break;
  }
}
static_assert(P1_SMEM <= SMEM_BYTES, "smem");
static_assert(P1_PREP_SMEM <= SMEM_BYTES, "smem");
static_assert(P2_SMEM <= SMEM_BYTES, "smem");
static_assert(P5_SMEM <= SMEM_BYTES, "smem");
static_assert(P7_SMEM <= SMEM_BYTES, "smem");
static_assert(P12_SMEM <= SMEM_BYTES, "smem");
static_assert(RKPRE_SMEM <= SMEM_BYTES, "smem");
static_assert(OFF_HS + (size_t)NTOK * 256 * 2 <= OFF_X1, "layout");

#ifndef CPU_EMU
template <int PH>
__global__ void __launch_bounds__(NTHREADS) phase_kernel(Params p) {
  __shared__ __attribute__((aligned(16))) char smem[SMEM_BYTES];
  run_phase(p, PH, smem);
}
template <int PH>
static void launch_phases(const Params& p, hipStream_t stream) {
  phase_kernel<PH><<<dim3(1024), dim3(NTHREADS), 0, stream>>>(p);
  if constexpr (PH + 1 < NPHASES) launch_phases<PH + 1>(p, stream);
}
#if MEGA
#define XB_TMO      128
#define XB_XCNT(j)  (256  + 64 * (j))
#define XB_XSUB(j)  (1280 + 64 * (j))
#define XB_XGEN(j)  (2304 + 64 * (j))
#define XB_TOP      3328
#define XB_TOPGEN   3392
#define XCD_BAR_WORDS 3456
#define XB_SPIN_CAP (1u << 18)
#define LAS __attribute__((address_space(3)))

__device__ __forceinline__ unsigned xb_ld(unsigned* p)              { return __hip_atomic_load(p, __ATOMIC_RELAXED, __HIP_MEMORY_SCOPE_AGENT); }
__device__ __forceinline__ unsigned xb_add(unsigned* p, unsigned v) { return __hip_atomic_fetch_add(p, v, __ATOMIC_RELAXED, __HIP_MEMORY_SCOPE_AGENT); }
__device__ __forceinline__ unsigned xb_xcc_id() { return (unsigned)__builtin_amdgcn_s_getreg((3 << 11) | 20) & 0xFu; }
#define XB_SPIN(cond, bar) do { unsigned _sp = 0; while (cond) { __builtin_amdgcn_s_sleep(1); \
    if ((++_sp & 255u) == 0u) { if (xb_ld(&(bar)[XB_TMO])) break; if (_sp > XB_SPIN_CAP) { atomicAdd(&(bar)[XB_TMO], 1u); break; } } } } while (0)

struct XcdBarrier {
    unsigned* bar; unsigned x;
    volatile LAS unsigned* st;
};

__device__ __forceinline__ XcdBarrier xcd_barrier_post(unsigned* bar, volatile LAS unsigned* st) {
    XcdBarrier b; b.bar = bar; b.x = xb_xcc_id(); b.st = st;
    if (threadIdx.x == 0) (void)xb_add(&bar[XB_XCNT(b.x)], 1u);
    return b;
}
__device__ __forceinline__ void xcd_barrier_complete(unsigned* bar, unsigned x, unsigned& nloc, unsigned& nx) {
    const unsigned G = gridDim.x * gridDim.y * gridDim.z;
    unsigned sum, cnt, mine, sp = 0u;
    for (;;) {
        sum = 0u; cnt = 0u; mine = 0u;
#pragma unroll
        for (unsigned j = 0; j < 16; ++j) { const unsigned c = xb_ld(&bar[XB_XCNT(j)]); sum += c; cnt += (c > 0u) ? 1u : 0u; mine = (j == x) ? c : mine; }
        if (sum == G) break;
        __builtin_amdgcn_s_sleep(1);
        if ((++sp & 255u) == 0u) { if (xb_ld(&bar[XB_TMO])) break; if (sp > XB_SPIN_CAP) { atomicAdd(&bar[XB_TMO], 1u); break; } }
    }
    nloc = mine > 0u ? mine : 1u; nx = cnt > 0u ? cnt : 1u;
}

__device__ __forceinline__ void xcd_barrier(const XcdBarrier& b) {
    asm volatile("s_waitcnt vmcnt(0)" ::: "memory");
    __syncthreads();
    if (threadIdx.x == 0) {
        unsigned* bar = b.bar;
        __builtin_amdgcn_s_waitcnt(0);
        unsigned nloc = b.st[0], nx = b.st[1];
        if (nloc == 0u) { xcd_barrier_complete(bar, b.x, nloc, nx); b.st[0] = nloc; b.st[1] = nx; }
        const unsigned old = xb_add(&bar[XB_XSUB(b.x)], 1u);
        const unsigned gen = old / nloc;
        if (old + 1u == (gen + 1u) * nloc) {
            __builtin_amdgcn_fence(__ATOMIC_RELEASE, "agent");
            asm volatile("s_waitcnt vmcnt(0)" ::: "memory");
            const unsigned og = xb_add(&bar[XB_TOP], 1u);
            const unsigned tg = og / nx;
            if (og + 1u == (tg + 1u) * nx) xb_add(&bar[XB_TOPGEN], 1u);
            else XB_SPIN(xb_ld(&bar[XB_TOPGEN]) == tg, bar);
            __builtin_amdgcn_fence(__ATOMIC_ACQUIRE, "agent");
            xb_add(&bar[XB_XGEN(b.x)], 1u);
            asm volatile("s_waitcnt vmcnt(0)" ::: "memory");
        } else {
            XB_SPIN(xb_ld(&bar[XB_XGEN(b.x)]) == gen, bar);
            __builtin_amdgcn_fence(__ATOMIC_ACQUIRE, "agent");
            asm volatile("s_waitcnt vmcnt(0)" ::: "memory");
        }
    }
    __syncthreads();
}


__global__ void __launch_bounds__(NTHREADS, 2) mega_kernel(Params p) {
  __shared__ __attribute__((aligned(16))) char smem[SMEM_BYTES];
  unsigned* bar = (unsigned*)(p.ws + OFF_BAR);
  __shared__ uint4 xb_words;
  if (threadIdx.x == 0) xb_words = make_uint4(0u, 0u, 0u, 0u);
  __syncthreads();
  XcdBarrier xb = xcd_barrier_post(bar, (volatile LAS unsigned*)&xb_words);
  if (p.ws == nullptr) cg::this_grid().sync();
  typedef const __attribute__((address_space(4))) Params* KParams;
#define PH_(n) { KParams kp = (KParams)__builtin_amdgcn_kernarg_segment_ptr(); asm volatile("" : "+s"(kp)); const Params lp = *(const Params*)kp; run_phase(lp, n, smem); } xcd_barrier(xb);
  PH_(0) PH_(1) PH_(20) PH_(2) PH_(3) PH_(4) PH_(5) PH_(6) PH_(7) PH_(8) PH_(9)
  PH_(10) PH_(11) PH_(24) PH_(12) PH_(22) PH_(13) PH_(14) PH_(15) PH_(16) PH_(17) PH_(18)
  { KParams kp = (KParams)__builtin_amdgcn_kernarg_segment_ptr(); asm volatile("" : "+s"(kp)); const Params lp = *(const Params*)kp; run_phase(lp, 19, smem); }
}

#endif

extern "C" void kernel_launch(void* const* d_in, const int* in_sizes, int n_in, void* d_out, int out_size, void* d_ws, size_t ws_size,
                              hipStream_t stream) {
  Params p;
  for (int i = 0; i < N_INPUTS; ++i) p.in[i] = (const float*)d_in[i];
  p.out = (float*)d_out;
  p.ws = (char*)d_ws;
#if MEGA
  static int grid_blocks = 0;
  if (!grid_blocks) {
    int dev = 0, cus = 0, per_cu = 0;
    hipGetDevice(&dev);
    hipDeviceGetAttribute(&cus, hipDeviceAttributeMultiprocessorCount, dev);
    hipOccupancyMaxActiveBlocksPerMultiprocessor(&per_cu, mega_kernel, NTHREADS, 0);
    if (per_cu > 2) per_cu = 2;
    grid_blocks = cus * per_cu;
  }
  hipMemsetAsync((char*)d_ws + OFF_BAR, 0, 16384, stream);
  void* args[] = {&p};
  hipError_t e = hipLaunchCooperativeKernel((void*)mega_kernel, dim3(grid_blocks), dim3(NTHREADS), args, 0, stream);
  if (e != hipSuccess) fprintf(stderr, "cooperative launch failed: %s (grid %d)\n", hipGetErrorString(e), grid_blocks);
#else
  launch_phases<0>(p, stream);
#endif
}
#endif
```

```cpp
#ifdef CPU_EMU
#include "emu.h"
#else
#include <hip/hip_runtime.h>
#include <hip/hip_cooperative_groups.h>
#include <cstdio>
namespace cg = cooperative_groups;
#endif
#include <stdint.h>

#ifndef BATCH
#define BATCH 2
#endif
#ifndef SEQ_LEN
#define SEQ_LEN 8192
#endif
#ifndef MEGA
#define MEGA 1
#endif
#if MEGA && !defined(CPU_EMU)
#define RK_MERGED 1
#else
#define RK_MERGED 0
#endif

#define DEV __device__ __forceinline__
#ifdef CPU_EMU
#define TIDX ((int)threadIdx.x)
#define BIDX ((int)blockIdx.x)
#else
__device__ __forceinline__ int tidx_() { int t = __builtin_amdgcn_workitem_id_x(); asm volatile("" : "+v"(t)); return t; }
__device__ __forceinline__ int bidx_() { int b = __builtin_amdgcn_workgroup_id_x(); asm volatile("" : "+s"(b)); return b; }
#define TIDX tidx_()
#define BIDX bidx_()
#endif
#define NTOK (BATCH * SEQ_LEN)
#define DM 1024
#define AB_IN 1816
#define AB_LD 1824
#define CD_IN 3328
#define NCMP ((SEQ_LEN - 32) / 16 + 1)
#define NBLK (SEQ_LEN / 64)
#define NB_CMP ((NCMP + 63) / 64)
#define S5_NC (SEQ_LEN / 64)
#define RET_NC (SEQ_LEN / 128)
#define ALPHA_F 1.4142135623730951f
#define NTHREADS 256

enum { I_X = 0, I_AB_W_IN, I_AB_W_OUT, I_S5_LAM_RE, I_S5_LAM_IM, I_S5_LOG_DT, I_S5_B_RE, I_S5_B_IM, I_S5_C_RE, I_S5_C_IM,
       I_S5_D, I_S5_W_GLU, I_S5_B_GLU, I_PE_K, I_PE_V, I_CK_W1, I_CK_B1, I_CK_W2, I_CV_W1, I_CV_B1, I_CV_W2,
       I_CD_W_IN, I_CD_W_OUT, I_RW_MU, I_RW_W0, I_RW_W_UP, I_RW_A0, I_RW_A_UP, I_RW_G_UP, I_RW_K_K, I_RW_K_A, I_RW_R_K,
       I_RW_LN_G, I_RW_LN_B, I_RET_LN_G, I_RET_LN_B, I_LN1_G, I_LN1_B, I_LN2_G, I_LN2_B, I_ROUTER, I_MOE_BIAS,
       I_MOE_W1, I_MOE_W3, I_MOE_W2, I_SH_W1, I_SH_W3, I_SH_W2, N_INPUTS };

struct Params {
  const float* in[N_INPUTS];
  float* out;
  char* ws;
};

#define MiB_TOK ((size_t)NTOK * 1024 * 4)
#define OFF_H 0
#define OFF_H2 ((size_t)NTOK * 1792 * 4)
#define OFF_MIX ((size_t)NTOK * 3328 * 4)
#define OFF_X1 (OFF_MIX + MiB_TOK)
#define OFF_X2 (OFF_X1 + MiB_TOK)
#define OFF_R4 (OFF_X2 + MiB_TOK)
#define OFF_R5 (OFF_R4 + MiB_TOK)
#define OFF_Y OFF_H
#define OFF_HS (OFF_H + 4 * MiB_TOK)
#define OFF_FS OFF_X2
#define OFF_HR OFF_R4
#define OFF_X2B OFF_R4
#define OFF_TOPI (OFF_R5)
#define OFF_TOPG (OFF_TOPI + (size_t)NTOK * 8 * 4)
#define OFF_POSOF (OFF_TOPG + (size_t)NTOK * 8 * 4)
#define OFF_CNT (OFF_POSOF + (size_t)NTOK * 8 * 4)
#define OFF_LTOK (OFF_CNT + 8192)
#define OFF_LGATE (OFF_LTOK + (size_t)64 * NTOK * 4)
#define OFF_S5E (OFF_LGATE + (size_t)64 * NTOK * 4)
#define OFF_KCMP (OFF_S5E + (size_t)BATCH * S5_NC * 32 * 64 * 8)
#define OFF_VCMP (OFF_KCMP + (size_t)BATCH * NCMP * 2 * 64 * 4)
#define OFF_RETKV (OFF_VCMP + (size_t)BATCH * NCMP * 2 * 64 * 4)
#define OFF_BAR (OFF_RETKV + (size_t)BATCH * 4 * RET_NC * 64 * 128 * 4)
#define OFF_CMPHID (OFF_BAR + 16384)
#define OFF_CMPC1 (OFF_CMPHID + (size_t)2 * BATCH * 2 * NB_CMP * 64 * 128 * 4)
#define OFF_GLO OFF_LTOK
#define OFF_RKF (OFF_CMPC1 + 8192)
#define OFF_END (OFF_RKF + 16384)
#define OFF_YGELU OFF_X1
#define OFF_RWW OFF_X1
#define OFF_RWK (OFF_X1 + (size_t)NTOK * 512 * 4)
#define OFF_RWKK OFF_R4
#define OFF_RWA (OFF_R4 + (size_t)NTOK * 512 * 4)

typedef short bf16x8 __attribute__((ext_vector_type(8)));
typedef float f32x16 __attribute__((ext_vector_type(16)));

#ifdef CPU_EMU
#define WAVE_SYNC() emu_wave_bar()
#else
#define WAVE_SYNC() __builtin_amdgcn_wave_barrier()
#endif

DEV float sigmoidf_(float x) { return 1.f / (1.f + __expf(-x)); }
DEV float siluf_(float x) { return x * sigmoidf_(x); }
DEV float geluf_(float x) { float u = 0.7978845608028654f * (x + 0.044715f * x * x * x); return 0.5f * x * (1.f + tanhf(u)); }
DEV unsigned short f2bf(float f) {
  unsigned u = __builtin_bit_cast(unsigned, f);
  u += 0x7FFFu + ((u >> 16) & 1u);
  return (unsigned short)(u >> 16);
}
DEV float bf2f(unsigned short h) { return __builtin_bit_cast(float, ((unsigned)h) << 16); }
DEV float wave_sum(float v) {
#pragma unroll
  for (int m = 32; m >= 1; m >>= 1) v += __shfl_xor(v, m);
  return v;
}
DEV float wave_max(float v) {
#pragma unroll
  for (int m = 32; m >= 1; m >>= 1) v = fmaxf(v, __shfl_xor(v, m));
  return v;
}
DEV float4 ld4(const float* p) { return *(const float4*)p; }
#ifdef CPU_EMU
DEV float fexp2(float x) { return exp2f(x); }
#else
DEV float fexp2(float x) { return __builtin_amdgcn_exp2f(x); }
#endif
DEV void fast_sincos(float x, float* sn, float* cs) {
  const float k = rintf(x * 0.15915494309189535f);
  float r = fmaf(-k, 6.28125f, x);
  r = fmaf(-k, 1.9353071795864769e-3f, r);
  *sn = __sinf(r); *cs = __cosf(r);
}
DEV void st4(float* p, float4 v) { *(float4*)p = v; }

#define GEMM_BM 128
#define GEMM_MI (GEMM_BM / 64)
#define GEMM_SMEM_BYTES ((GEMM_BM + 128) * 72 * 2)
#ifdef CPU_EMU
DEV unsigned pk2(float a, float b) { return (unsigned)f2bf(a) | ((unsigned)f2bf(b) << 16); }
#else
typedef __bf16 hbf16x2 __attribute__((ext_vector_type(2)));
typedef float hf32x2 __attribute__((ext_vector_type(2)));
DEV unsigned pk2(float a, float b) {
  hf32x2 f = {a, b};
  return __builtin_bit_cast(unsigned, __builtin_convertvector(f, hbf16x2));
}
#endif
template <bool ABF, class AROW, class BPTR, class EPI>
DEV void gemm_tile(AROW arow, BPTR bptr, int ldb, int K, EPI epi, char* smem_raw, int akstep = 64) {
  unsigned short(*sA)[72] = (unsigned short(*)[72])smem_raw;
  unsigned short(*sB)[72] = (unsigned short(*)[72])(smem_raw + GEMM_BM * 72 * 2);
  const int tid = TIDX, lane = tid & 63, wave = tid >> 6;
  const int wm = wave >> 1, wn = wave & 1;
#if defined(CPU_EMU) && !defined(EMU_REAL_GEMM)
  for (int mi = 0; mi < GEMM_MI; ++mi)
    for (int r = 0; r < 16; ++r) {
      const int row = wm * (GEMM_BM / 2) + mi * 32 + (r & 3) + 8 * (r >> 2) + 4 * (lane >> 5);
      const int col = wn * 64 + (lane & 31);
      const void* arp = arow(row);
      float v[2] = {0.f, 0.f};
      for (int ni = 0; ni < 2; ++ni) {
        const int cc = col + ni * 32;
        const float* bq = bptr(cc & ~3);
        if (!arp || !bq) continue;
        bq += cc & 3;
        float a = 0.f;
        for (int k = 0; k < K; ++k) {
          const size_t ka = (size_t)(k >> 6) * akstep + (k & 63);
          const float av = ABF ? bf2f(((const unsigned short*)arp)[ka]) : bf2f(f2bf(((const float*)arp)[ka]));
          a += av * bf2f(f2bf(bq[(size_t)k * ldb]));
        }
        v[ni] = a;
      }
      epi(row, col, v[0], v[1]);
    }
  return;
#endif
  const float* ap[4 * GEMM_MI];
  const unsigned short* aph[2 * GEMM_MI];
  if (ABF) {
#pragma unroll
    for (int i = 0; i < 2 * GEMM_MI; ++i) aph[i] = (const unsigned short*)arow((tid >> 3) + 32 * i);
  } else {
#pragma unroll
    for (int i = 0; i < 4 * GEMM_MI; ++i) ap[i] = (const float*)arow((tid >> 4) + 16 * i);
  }
  const float* bp = bptr((tid & 31) * 4);
  const int kgrp = tid >> 5;
  float4 ra0[4 * GEMM_MI], ra1[4 * GEMM_MI];
  uint4 rah0[2 * GEMM_MI], rah1[2 * GEMM_MI];
  float4 rb0[8], rb1[8];
#define GEMM_GLOAD(S, k0_)                                                                                                          \
  {                                                                                                                                 \
    if (ABF) {                                                                                                                      \
      _Pragma("unroll") for (int i = 0; i < 2 * GEMM_MI; ++i) rah##S[i] =                                                           \
          aph[i] ? *(const uint4*)(aph[i] + (size_t)((k0_) >> 6) * akstep + (tid & 7) * 8) : make_uint4(0, 0, 0, 0);                \
    } else {                                                                                                                        \
      _Pragma("unroll") for (int i = 0; i < 4 * GEMM_MI; ++i) ra##S[i] =                                                            \
          ap[i] ? ld4(ap[i] + (size_t)((k0_) >> 6) * akstep + (tid & 15) * 4) : make_float4(0.f, 0.f, 0.f, 0.f);                    \
    }                                                                                                                               \
    _Pragma("unroll") for (int j = 0; j < 8; ++j) rb##S[j] =                                                                        \
        bp ? ld4(bp + (size_t)((k0_) + kgrp * 8 + j) * ldb) : make_float4(0.f, 0.f, 0.f, 0.f);                                      \
  }
#define GEMM_SSTORE(S)                                                                                                              \
  {                                                                                                                                 \
    if (ABF) {                                                                                                                      \
      _Pragma("unroll") for (int i = 0; i < 2 * GEMM_MI; ++i) *(uint4*)&sA[(tid >> 3) + 32 * i][(tid & 7) * 8] = rah##S[i];         \
    } else {                                                                                                                        \
      _Pragma("unroll") for (int i = 0; i < 4 * GEMM_MI; ++i) *(uint2*)&sA[(tid >> 4) + 16 * i][(tid & 15) * 4] =                   \
          make_uint2(pk2(ra##S[i].x, ra##S[i].y), pk2(ra##S[i].z, ra##S[i].w));                                                     \
    }                                                                                                                               \
    const int nb = (tid & 31) * 4;                                                                                                  \
    *(uint4*)&sB[nb + 0][kgrp * 8] = make_uint4(pk2(rb##S[0].x, rb##S[1].x), pk2(rb##S[2].x, rb##S[3].x), pk2(rb##S[4].x, rb##S[5].x), pk2(rb##S[6].x, rb##S[7].x)); \
    *(uint4*)&sB[nb + 1][kgrp * 8] = make_uint4(pk2(rb##S[0].y, rb##S[1].y), pk2(rb##S[2].y, rb##S[3].y), pk2(rb##S[4].y, rb##S[5].y), pk2(rb##S[6].y, rb##S[7].y)); \
    *(uint4*)&sB[nb + 2][kgrp * 8] = make_uint4(pk2(rb##S[0].z, rb##S[1].z), pk2(rb##S[2].z, rb##S[3].z), pk2(rb##S[4].z, rb##S[5].z), pk2(rb##S[6].z, rb##S[7].z)); \
    *(uint4*)&sB[nb + 3][kgrp * 8] = make_uint4(pk2(rb##S[0].w, rb##S[1].w), pk2(rb##S[2].w, rb##S[3].w), pk2(rb##S[4].w, rb##S[5].w), pk2(rb##S[6].w, rb##S[7].w)); \
  }
  f32x16 acc[GEMM_MI][2];
#pragma unroll
  for (int mi = 0; mi < GEMM_MI; ++mi)
#pragma unroll
    for (int ni = 0; ni < 2; ++ni)
#pragma unroll
      for (int r = 0; r < 16; ++r) acc[mi][ni][r] = 0.f;
  auto compute = [&]() {
#pragma unroll
    for (int ks = 0; ks < 4; ++ks) {
      bf16x8 af[GEMM_MI], bfr[2];
#pragma unroll
      for (int mi = 0; mi < GEMM_MI; ++mi) af[mi] = *(const bf16x8*)&sA[wm * (GEMM_BM / 2) + mi * 32 + (lane & 31)][ks * 16 + (lane >> 5) * 8];
#pragma unroll
      for (int ni = 0; ni < 2; ++ni) bfr[ni] = *(const bf16x8*)&sB[wn * 64 + ni * 32 + (lane & 31)][ks * 16 + (lane >> 5) * 8];
#pragma unroll
      for (int mi = 0; mi < GEMM_MI; ++mi)
#pragma unroll
        for (int ni = 0; ni < 2; ++ni) acc[mi][ni] = __builtin_amdgcn_mfma_f32_32x32x16_bf16(af[mi], bfr[ni], acc[mi][ni], 0, 0, 0);
    }
  };
  if (ABF) {
    GEMM_GLOAD(0, 0);
    GEMM_GLOAD(1, 64);
    for (int k0 = 0; k0 < K; k0 += 128) {
      __syncthreads();
      GEMM_SSTORE(0);
      __syncthreads();
      if (k0 + 128 < K) GEMM_GLOAD(0, k0 + 128);
      compute();
      __syncthreads();
      GEMM_SSTORE(1);
      __syncthreads();
      if (k0 + 192 < K) GEMM_GLOAD(1, k0 + 192);
      compute();
    }
  } else {
    GEMM_GLOAD(0, 0);
    for (int k0 = 0; k0 < K; k0 += 64) {
      __syncthreads();
      GEMM_SSTORE(0);
      __syncthreads();
      if (k0 + 64 < K) GEMM_GLOAD(0, k0 + 64);
      compute();
    }
  }
#pragma unroll
  for (int mi = 0; mi < GEMM_MI; ++mi)
#pragma unroll
    for (int r = 0; r < 16; ++r) {
      int row = wm * (GEMM_BM / 2) + mi * 32 + (r & 3) + 8 * (r >> 2) + 4 * (lane >> 5);
      int col = wn * 64 + (lane & 31);
      epi(row, col, acc[mi][0][r], acc[mi][1][r]);
    }
}

template <int LAYER>
DEV void phase_gemm_in(const Params& p, char* smem) {
  const int N = LAYER == 0 ? AB_IN : CD_IN;
  const float* A = LAYER == 0 ? p.in[I_X] : (const float*)(p.ws + OFF_X2);
  const float* B = LAYER == 0 ? p.in[I_AB_W_IN] : p.in[I_CD_W_IN];
  float* C = (float*)(p.ws + OFF_H);
  const int NT = (N + 127) / 128, MT = NTOK / GEMM_BM;
  const int xcd_ = BIDX & 7, lb_ = BIDX >> 3, nb_ = gridDim.x >> 3;
  for (int j_ = lb_; j_ < (MT / 8) * NT; j_ += nb_) {
    const int it = (xcd_ + 8 * (j_ / NT)) * NT + (j_ % NT);
    const int tm = it / NT, tn = it % NT;
    const int m0 = tm * GEMM_BM, n0 = tn * 128;
    gemm_tile<LAYER == 1>(
        [&](int r) { return LAYER == 1 ? (const void*)((const unsigned short*)(p.ws + OFF_X2B) + (size_t)(m0 + r) * DM) : (const void*)(A + (size_t)(m0 + r) * DM); },
        [&](int c) { return (n0 + c < N) ? (B + n0 + c) : (const float*)nullptr; }, N, DM,
        [&](int row, int col, float v0, float v1) {
          const int gm = m0 + row, gc = n0 + col;
          if (LAYER == 1 && gc >= 1792 && gc < 2304) {
            const int i = gc & 63;
            const float pos = (float)(gm % SEQ_LEN);
            const float inv = __expf(-(float)i * (9.210340371976184f / 32.f));
            float sn, cs;
            fast_sincos(pos * inv, &sn, &cs);
            float o0 = v0 * cs - v1 * sn, o1 = v1 * cs + v0 * sn;
            if (gc >= 2048) { o0 *= 0.125f; o1 *= 0.125f; }
            v0 = o0; v1 = o1;
          }
          if (LAYER == 1) {
            float* dstp = gc < 1792 ? C + (size_t)gm * 1792 + gc : (float*)(p.ws + OFF_H2) + (size_t)gm * 1536 + (gc - 1792);
            dstp[0] = v0; dstp[32] = v1;
          } else {
            if (gc < N) C[(size_t)gm * AB_LD + gc] = v0;
            if (gc + 32 < N) C[(size_t)gm * AB_LD + gc + 32] = v1;
          }
        },
        smem);
  }
}

struct S5Const { float lb_re, lb_im; };
DEV void s5_consts(const Params& p, int g, int pp, float& lb_re, float& lb_im, float (&bbr)[16], float (&bbi)[16]) {
  const float dt = expf(p.in[I_S5_LOG_DT][g]);
  const float lr = p.in[I_S5_LAM_RE][g * 64 + pp], li = p.in[I_S5_LAM_IM][g * 64 + pp];
  const float mag = expf(lr * dt);
  float sn, cs;
  sincosf(li * dt, &sn, &cs);
  lb_re = mag * cs; lb_im = mag * sn;
  const float den = lr * lr + li * li;
  const float f_re = ((lb_re - 1.f) * lr + lb_im * li) / den;
  const float f_im = (lb_im * lr - (lb_re - 1.f) * li) / den;
  const float* br = p.in[I_S5_B_RE] + (size_t)(g * 64 + pp) * 16;
  const float* bi = p.in[I_S5_B_IM] + (size_t)(g * 64 + pp) * 16;
#pragma unroll
  for (int h = 0; h < 16; ++h) {
    bbr[h] = f_re * br[h] - f_im * bi[h];
    bbi[h] = f_re * bi[h] + f_im * br[h];
  }
}

#define OFF_QB OFF_X2
#define OFF_KSB (OFF_QB + (size_t)NTOK * 512 * 2)
#define OFF_KWB (OFF_KSB + (size_t)NTOK * 128 * 2)
#define OFF_VST (OFF_KWB + (size_t)NTOK * 128 * 2)
#define OFF_VWT (OFF_VST + (size_t)NTOK * 128 * 2)
#define OFF_KCB (OFF_VWT + (size_t)NTOK * 128 * 2)
#define OFF_VCT (OFF_KCB + (size_t)BATCH * 2 * NB_CMP * 64 * 64 * 2)
#define NSA_QSCALE (0.125f * 1.4426950408889634f)

#define P1_S5A_ITEMS (BATCH * 32 * S5_NC / 4)
#define P1_CMP_ITEMS (2 * BATCH * 2 * NB_CMP)
#define S5C_ROW 132
DEV bf16x8 pack_bf8(float4 a, float4 b) {
  union { uint4 u; bf16x8 v; } x;
  x.u = make_uint4(pk2(a.x, a.y), pk2(a.z, a.w), pk2(b.x, b.y), pk2(b.z, b.w));
  return x.v;
}
DEV void s5_bfrags(const Params& p, int g, int lane, bf16x8 (&bB)[4]) {
  const int hh = lane >> 5;
#pragma unroll
  for (int ct = 0; ct < 2; ++ct) {
    float lr, li, br_[16], bi_[16];
    s5_consts(p, g, 32 * ct + (lane & 31), lr, li, br_, bi_);
    bB[ct] = pack_bf8(make_float4(hh ? br_[8] : br_[0], hh ? br_[9] : br_[1], hh ? br_[10] : br_[2], hh ? br_[11] : br_[3]),
                      make_float4(hh ? br_[12] : br_[4], hh ? br_[13] : br_[5], hh ? br_[14] : br_[6], hh ? br_[15] : br_[7]));
    bB[2 + ct] = pack_bf8(make_float4(hh ? bi_[8] : bi_[0], hh ? bi_[9] : bi_[1], hh ? bi_[10] : bi_[2], hh ? bi_[11] : bi_[3]),
                          make_float4(hh ? bi_[12] : bi_[4], hh ? bi_[13] : bi_[5], hh ? bi_[14] : bi_[6], hh ? bi_[15] : bi_[7]));
  }
}
DEV void s5_subchunk(const float* su, float* sS, const bf16x8 (&bB)[4], float lb_re, float lb_im, float& sr, float& si, int lane) {
  {
    const int r = lane & 15, hh = lane >> 5, n = lane & 31;
    const bf16x8 a = pack_bf8(ld4(su + r * 16 + 8 * hh), ld4(su + r * 16 + 8 * hh + 4));
#pragma unroll
    for (int j = 0; j < 4; ++j) {
      f32x16 acc;
#pragma unroll
      for (int i = 0; i < 16; ++i) acc[i] = 0.f;
      acc = __builtin_amdgcn_mfma_f32_32x32x16_bf16(a, bB[j], acc, 0, 0, 0);
      const int col = (j >> 1) * 64 + (j & 1) * 32 + n;
#pragma unroll
      for (int r8 = 0; r8 < 8; ++r8) sS[((r8 & 3) + 8 * (r8 >> 2) + 4 * hh) * S5C_ROW + col] = acc[r8];
    }
  }
  WAVE_SYNC();
  for (int tt = 0; tt < 16; ++tt) {
    const float dr = sS[tt * S5C_ROW + lane], di = sS[tt * S5C_ROW + 64 + lane];
    const float nr = lb_re * sr - lb_im * si + dr, ni = lb_re * si + lb_im * sr + di;
    sr = nr; si = ni;
    sS[tt * S5C_ROW + lane] = sr;
    sS[tt * S5C_ROW + 64 + lane] = si;
  }
}
DEV void p1_s5a(const Params& p, int item, char* smem) {
  const int lane = TIDX & 63, wave = TIDX >> 6;
  const int idx = item * 4 + wave;
  const int g = idx & 31, c = (idx >> 5) % S5_NC, b = idx / (32 * S5_NC);
  float lb_re, lb_im;
  {
    float bbr[16], bbi[16];
    s5_consts(p, g, lane, lb_re, lb_im, bbr, bbi);
  }
  bf16x8 bB[4];
  s5_bfrags(p, g, lane, bB);
  const float* H = (const float*)(p.ws + OFF_H);
  float sr = 0.f, si = 0.f;
  float* sS = (float*)smem + wave * 16 * S5C_ROW;
  float* su = (float*)smem + 4 * 16 * S5C_ROW + wave * 16 * 16;
  __syncthreads();
  for (int sc = 0; sc < 4; ++sc) {
    {
      const float* ur = H + (size_t)(b * SEQ_LEN + c * 64 + sc * 16 + (lane >> 2)) * AB_LD + g * 16 + (lane & 3) * 4;
      st4(su + (lane >> 2) * 16 + (lane & 3) * 4, ld4(ur));
    }
    WAVE_SYNC();
    s5_subchunk(su, sS, bB, lb_re, lb_im, sr, si, lane);
    WAVE_SYNC();
  }
  float2* E = (float2*)(p.ws + OFF_S5E);
  E[((size_t)(b * S5_NC + c) * 32 + g) * 64 + lane] = make_float2(sr, si);
}
#define P1_CMPG_MT ((NCMP + GEMM_BM - 1) / GEMM_BM)
#define P1_CMPG_ITEMS (2 * BATCH * 2 * P1_CMPG_MT)
DEV void p1_cmpgemm(const Params& p, int item, char* smem) {
  const int mt = item % P1_CMPG_MT;
  int r = item / P1_CMPG_MT;
  const int g = r & 1; r >>= 1;
  const int b = r % BATCH; const int which = r / BATCH;
  const float* H = (const float*)(p.ws + OFF_H);
  const float* w1 = which ? p.in[I_CV_W1] : p.in[I_CK_W1];
  const int colbase = (which ? 1152 : 1024) + g * 64;
  float* HID = (float*)(p.ws + OFF_CMPHID) + ((size_t)(which * BATCH + b) * 2 + g) * NB_CMP * 64 * 128;
  const int n0 = mt * GEMM_BM;
  gemm_tile<false>(
      [&](int rr) { return (n0 + rr < NCMP) ? (const void*)(H + ((size_t)b * SEQ_LEN + 16 * (n0 + rr)) * AB_LD + colbase) : (const void*)nullptr; },
      [&](int c) { return w1 + c; }, 128, 2048,
      [&](int row, int col, float v0, float v1) {
        if (n0 + row < NCMP) { HID[(size_t)(n0 + row) * 128 + col] = v0; HID[(size_t)(n0 + row) * 128 + col + 32] = v1; }
      },
      smem, AB_LD);
}
#define P1_CMPC1_ITEMS 16
DEV void p1_cmpc1(const Params& p, int item, char* smem) {
  const int which = item >> 3, sl = item & 7;
  const float* pe = which ? p.in[I_PE_V] : p.in[I_PE_K];
  const float* w1 = which ? p.in[I_CV_W1] : p.in[I_CK_W1];
  float* sPart = (float*)smem;
  const int tid = TIDX, hid = tid & 127, kh = tid >> 7;
  float a = 0.f;
  const int k0 = sl * 256 + kh * 128;
#pragma unroll 16
  for (int k = k0; k < k0 + 128; ++k) a += pe[k] * w1[(size_t)k * 128 + hid];
  __syncthreads();
  sPart[tid] = a;
  __syncthreads();
  if (tid < 128) ((float*)(p.ws + OFF_CMPC1))[(which * 8 + sl) * 128 + tid] = sPart[tid] + sPart[tid + 128];
  __syncthreads();
}
DEV void p1_compress(const Params& p, int item, char* smem) {
  const int tile = item % NB_CMP;
  int r = item / NB_CMP;
  const int g = r & 1; r >>= 1;
  const int b = r % BATCH; const int which = r / BATCH;
  const float* b1 = which ? p.in[I_CV_B1] : p.in[I_CK_B1];
  const float* w2 = which ? p.in[I_CV_W2] : p.in[I_CK_W2];
  const float* C1P = (const float*)(p.ws + OFF_CMPC1) + which * 8 * 128;
  const float* HID = (const float*)(p.ws + OFF_CMPHID) + ((size_t)(which * BATCH + b) * 2 + g) * NB_CMP * 64 * 128;
  float* sOut = (float*)smem;
  float* sHid = sOut + 8 * 64;
  float* sAll = sHid + 8 * 128;
  float* sC1 = sAll + 64 * 65;
  const int tid = TIDX;
  __syncthreads();
  if (tid < 128) {
    const float* q = C1P + tid;
    sC1[tid] = (((((((q[0] + q[128]) + q[256]) + q[384]) + q[512]) + q[640]) + q[768]) + q[896]) + b1[tid];
  }
  float* dst = (float*)(p.ws + (which ? OFF_VCMP : OFF_KCMP));
#pragma unroll 1
  for (int r8 = 0; r8 < 8; ++r8) {
    const int n0 = tile * 64 + r8 * 8;
    __syncthreads();
    for (int w = tid; w < 8 * 128; w += NTHREADS) {
      const int rr = w >> 7, hid = w & 127;
      const int n = n0 + rr;
      sHid[w] = n < NCMP ? geluf_(HID[(size_t)n * 128 + hid] + sC1[hid]) : 0.f;
    }
    __syncthreads();
    for (int w = tid; w < 8 * 64; w += NTHREADS) {
      const int rr = w >> 6, d = w & 63;
      float a = 0.f;
      for (int hid = 0; hid < 128; ++hid) a += sHid[rr * 128 + hid] * w2[hid * 64 + d];
      sOut[w] = a;
    }
    __syncthreads();
    for (int w = tid; w < 8 * 64; w += NTHREADS) {
      const int rr = w >> 6, d = w & 63;
      const int n = n0 + rr;
      float v = sOut[w];
      if (which == 0 && d < 16) {
        const int i = d & 7;
        const float pos = (float)(n * 16 + 31);
        const float inv = __expf(-(float)i * (13.122363377404328f / 8.f));
        float sn, cs;
        sincosf(pos * inv, &sn, &cs);
        const float x1 = sOut[rr * 64 + i], x2 = sOut[rr * 64 + i + 8];
        v = d < 8 ? x1 * cs - x2 * sn : x2 * cs + x1 * sn;
      }
      if (n >= NCMP) v = 0.f;
      sAll[(r8 * 8 + rr) * 65 + d] = v;
      if (n < NCMP) dst[((size_t)(b * NCMP + n) * 2 + g) * 64 + d] = v;
    }
  }
  __syncthreads();
  if (which == 0) {
    unsigned short* KCB = (unsigned short*)(p.ws + OFF_KCB) + (((size_t)b * 2 + g) * NB_CMP * 64 + tile * 64) * 64;
    for (int w = tid; w < 64 * 8; w += NTHREADS) {
      const int nl = w >> 3, o = w & 7;
      float v[8];
#pragma unroll
      for (int q = 0; q < 8; ++q) v[q] = sAll[nl * 65 + o * 8 + q];
      *(uint4*)(KCB + nl * 64 + o * 8) = make_uint4(pk2(v[0], v[1]), pk2(v[2], v[3]), pk2(v[4], v[5]), pk2(v[6], v[7]));
    }
  } else {
    unsigned short* VCT = (unsigned short*)(p.ws + OFF_VCT) + (((size_t)b * 2 + g) * NB_CMP + tile) * 64 * 64;
    for (int w = tid; w < 64 * 8; w += NTHREADS) {
      const int d = w >> 3, o = w & 7;
      float v[8];
#pragma unroll
      for (int q = 0; q < 8; ++q) v[q] = sAll[(o * 8 + q) * 65 + d];
      *(uint4*)(VCT + d * 64 + o * 8) = make_uint4(pk2(v[0], v[1]), pk2(v[2], v[3]), pk2(v[4], v[5]), pk2(v[6], v[7]));
    }
  }
}
DEV uint4 pack8(const float* v) {
  uint4 r;
  r.x = (unsigned)f2bf(v[0]) | ((unsigned)f2bf(v[1]) << 16);
  r.y = (unsigned)f2bf(v[2]) | ((unsigned)f2bf(v[3]) << 16);
  r.z = (unsigned)f2bf(v[4]) | ((unsigned)f2bf(v[5]) << 16);
  r.w = (unsigned)f2bf(v[6]) | ((unsigned)f2bf(v[7]) << 16);
  return r;
}
#define P1_PREP_ITEMS (NTOK / 64)
#define P1_PREP_SMEM ((64 * 8 * 2 + 64 * 128) * 4)
DEV void p1_prep(const Params& p, int item, char* smem) {
  const int tid = TIDX;
  const int b = item / NBLK, blk = item % NBLK;
  const float* H = (const float*)(p.ws + OFF_H);
  float* sCS = (float*)smem;
  float* sV = sCS + 64 * 8 * 2;
  const size_t tok0 = (size_t)b * SEQ_LEN + blk * 64;
  __syncthreads();
  for (int w = tid; w < 64 * 8; w += NTHREADS) {
    const int tk = w >> 3, i = w & 7;
    const float pos = (float)(blk * 64 + tk);
    const float inv = __expf(-(float)i * (13.122363377404328f / 8.f));
    float sn, cs;
    sincosf(pos * inv, &sn, &cs);
    sCS[w * 2] = cs; sCS[w * 2 + 1] = sn;
  }
  __syncthreads();
  unsigned short* QB = (unsigned short*)(p.ws + OFF_QB);
  unsigned short* KSB = (unsigned short*)(p.ws + OFF_KSB);
  unsigned short* KWB = (unsigned short*)(p.ws + OFF_KWB);
  for (int w = tid; w < 64 * 12 * 8; w += NTHREADS) {
    const int o = w & 7, hd = (w >> 3) % 12, tk = w / 96;
    const int col = hd < 8 ? 512 + hd * 64 : (hd < 10 ? 1280 + (hd - 8) * 64 : 1536 + (hd - 10) * 64);
    const float* x = H + (tok0 + tk) * AB_LD + col;
    float v[8];
    const float4 a0 = ld4(x + o * 8), a1 = ld4(x + o * 8 + 4);
    v[0] = a0.x; v[1] = a0.y; v[2] = a0.z; v[3] = a0.w; v[4] = a1.x; v[5] = a1.y; v[6] = a1.z; v[7] = a1.w;
    if (o < 2) {
      const float4 c0 = ld4(x + (1 - o) * 8), c1 = ld4(x + (1 - o) * 8 + 4);
      const float u[8] = {c0.x, c0.y, c0.z, c0.w, c1.x, c1.y, c1.z, c1.w};
#pragma unroll
      for (int i = 0; i < 8; ++i) {
        const float cs = sCS[(tk * 8 + i) * 2], sn = sCS[(tk * 8 + i) * 2 + 1];
        v[i] = o == 0 ? v[i] * cs - u[i] * sn : v[i] * cs + u[i] * sn;
      }
    }
    if (hd < 8) {
#pragma unroll
      for (int i = 0; i < 8; ++i) v[i] *= NSA_QSCALE;
      *(uint4*)(QB + ((tok0 + tk) * 8 + hd) * 64 + o * 8) = pack8(v);
    } else {
      const int g = (hd - 8) & 1;
      unsigned short* dst = (hd < 10 ? KSB : KWB) + (((size_t)b * 2 + g) * SEQ_LEN + blk * 64 + tk) * 64 + o * 8;
      *(uint4*)dst = pack8(v);
    }
  }
#pragma unroll 1
  for (int which = 0; which < 2; ++which) {
    const int col = which ? 1664 : 1408;
    __syncthreads();
    for (int w = tid; w < 64 * 32; w += NTHREADS) {
      const int tk = w >> 5, c4 = (w & 31) * 4;
      st4(sV + tk * 128 + c4, ld4(H + (tok0 + tk) * AB_LD + col + c4));
    }
    __syncthreads();
    unsigned short* VT = (unsigned short*)(p.ws + (which ? OFF_VWT : OFF_VST));
    for (int w = tid; w < 2 * 64 * 8; w += NTHREADS) {
      const int ko = w & 7, d = (w >> 3) & 63, g = w >> 9;
      float v[8];
#pragma unroll
      for (int i = 0; i < 8; ++i) v[i] = sV[(ko * 8 + i) * 128 + g * 64 + d];
      *(uint4*)(VT + ((((size_t)b * 2 + g) * NBLK + blk) * 64 + d) * 64 + ko * 8) = pack8(v);
    }
  }
}

struct NsaSmem {
  unsigned short k[64][72];
  unsigned short vt[64][68];
  float imp[32][128];
  unsigned selmask[32][4];
  unsigned unionm[4];
  float keyb[4][128];
};
#define P2_NSA_SMEM ((int)sizeof(NsaSmem))
#define NSA_QT (SEQ_LEN / 32)
#define P2_NSA_ITEMS (BATCH * 2 * NSA_QT)

struct TileRegs { uint4 k0, k1, v0, v1; };
DEV void tile_gload(TileRegs& r, const unsigned short* Kg, const unsigned short* Vg, int tid) {
  const int row = tid >> 2, seg = tid & 3;
  r.k0 = *(const uint4*)(Kg + row * 64 + seg * 16);
  r.k1 = *(const uint4*)(Kg + row * 64 + seg * 16 + 8);
  if (Vg) {
    r.v0 = *(const uint4*)(Vg + row * 64 + seg * 16);
    r.v1 = *(const uint4*)(Vg + row * 64 + seg * 16 + 8);
  }
}
DEV void tile_sstore(NsaSmem* sm, const TileRegs& r, bool withV, int tid) {
  const int row = tid >> 2, seg = tid & 3;
  *(uint4*)&sm->k[row][seg * 16] = r.k0;
  *(uint4*)&sm->k[row][seg * 16 + 8] = r.k1;
  if (withV) {
    *(uint2*)&sm->vt[row][seg * 16] = make_uint2(r.v0.x, r.v0.y);
    *(uint2*)&sm->vt[row][seg * 16 + 4] = make_uint2(r.v0.z, r.v0.w);
    *(uint2*)&sm->vt[row][seg * 16 + 8] = make_uint2(r.v1.x, r.v1.y);
    *(uint2*)&sm->vt[row][seg * 16 + 12] = make_uint2(r.v1.z, r.v1.w);
  }
}
DEV void qk_tile(const unsigned short (*ksm)[72], const bf16x8 (&qf)[4], f32x16 (&s)[2], int lane) {
  const int r = lane & 31, hh = lane >> 5;
#pragma unroll
  for (int ks2 = 0; ks2 < 2; ++ks2) {
#pragma unroll
    for (int i = 0; i < 16; ++i) s[ks2][i] = 0.f;
#pragma unroll
    for (int ks = 0; ks < 4; ++ks) {
      const bf16x8 a = *(const bf16x8*)&ksm[ks2 * 32 + r][ks * 16 + hh * 8];
      s[ks2] = __builtin_amdgcn_mfma_f32_32x32x16_bf16(a, qf[ks], s[ks2], 0, 0, 0);
    }
  }
}
DEV void pv_tile(const unsigned short (*vsm)[68], const f32x16 (&pr)[2], f32x16 (&o)[2], int lane) {
  const int r = lane & 31, hh = lane >> 5;
#pragma unroll
  for (int ks2 = 0; ks2 < 2; ++ks2)
#pragma unroll
    for (int s = 0; s < 2; ++s) {
      union { uint4 u; bf16x8 v; } pfu;
      pfu.u = make_uint4(pk2(pr[ks2][8 * s], pr[ks2][8 * s + 1]), pk2(pr[ks2][8 * s + 2], pr[ks2][8 * s + 3]),
                         pk2(pr[ks2][8 * s + 4], pr[ks2][8 * s + 5]), pk2(pr[ks2][8 * s + 6], pr[ks2][8 * s + 7]));
      const bf16x8 pf = pfu.v;
#pragma unroll
      for (int mt = 0; mt < 2; ++mt) {
        const uint2 lo = *(const uint2*)&vsm[mt * 32 + r][ks2 * 32 + 16 * s + 4 * hh];
        const uint2 hi = *(const uint2*)&vsm[mt * 32 + r][ks2 * 32 + 16 * s + 8 + 4 * hh];
        union { uint4 u; bf16x8 v; } au;
        au.u = make_uint4(lo.x, lo.y, hi.x, hi.y);
        const bf16x8 a = au.v;
        o[mt] = __builtin_amdgcn_mfma_f32_32x32x16_bf16(a, pf, o[mt], 0, 0, 0);
      }
    }
}
DEV float quad_sum(float v) {
#ifdef CPU_EMU
  v += __shfl_xor(v, 1); v += __shfl_xor(v, 2); return v;
#else
  int x;
  x = __builtin_amdgcn_update_dpp(0, __builtin_bit_cast(int, v), 0xB1, 0xF, 0xF, false); v += __builtin_bit_cast(float, x);
  x = __builtin_amdgcn_update_dpp(0, __builtin_bit_cast(int, v), 0x4E, 0xF, 0xF, false); v += __builtin_bit_cast(float, x);
  return v;
#endif
}
DEV void softmax_step(f32x16 (&s)[2], float& m, float& l, f32x16 (&o)[2]) {
  float tmax = -INFINITY;
#pragma unroll
  for (int ks2 = 0; ks2 < 2; ++ks2)
#pragma unroll
    for (int i = 0; i < 16; ++i) tmax = fmaxf(tmax, s[ks2][i]);
  tmax = fmaxf(tmax, __shfl_xor(tmax, 32));
  const float mnew = fmaxf(m, tmax);
  const float msafe = mnew == -INFINITY ? 0.f : mnew;
  const float alpha = fexp2(m - msafe);
  float ps = 0.f;
#pragma unroll
  for (int ks2 = 0; ks2 < 2; ++ks2)
#pragma unroll
    for (int i = 0; i < 16; ++i) { s[ks2][i] = fexp2(s[ks2][i] - msafe); ps += s[ks2][i]; }
  l = l * alpha + ps;
#pragma unroll
  for (int mt = 0; mt < 2; ++mt)
#pragma unroll
    for (int i = 0; i < 16; ++i) o[mt][i] *= alpha;
  m = mnew;
}
DEV bool testbit4(unsigned w0, unsigned w1, unsigned w2, unsigned w3, int j) {
  const unsigned lo = j & 32 ? w1 : w0, hi = j & 32 ? w3 : w2;
  const unsigned x = j & 64 ? hi : lo;
  return (x >> (j & 31)) & 1u;
}

DEV void p2_nsa(const Params& p, int item, char* smem) {
  NsaSmem* sm = (NsaSmem*)smem;
  const int tid = TIDX, lane = tid & 63, wave = tid >> 6;
  const int bg = item & 3, b = bg >> 1, g = bg & 1;
  const int qt = NSA_QT - 1 - (item >> 2);
  const int t0 = qt * 32;
  const int c = lane & 31, hh = lane >> 5, tl = c >> 2, h = c & 3;
  const int trow = wave * 8 + tl;
  const int tq = t0 + trow;
  const size_t tok = (size_t)b * SEQ_LEN + tq;
  const int hd = g * 4 + h;
  const float* H = (const float*)(p.ws + OFF_H);
  const unsigned short* QB = (const unsigned short*)(p.ws + OFF_QB);
  const unsigned short* KSB = (const unsigned short*)(p.ws + OFF_KSB) + ((size_t)b * 2 + g) * SEQ_LEN * 64;
  const unsigned short* KWB = (const unsigned short*)(p.ws + OFF_KWB) + ((size_t)b * 2 + g) * SEQ_LEN * 64;
  const unsigned short* VST = (const unsigned short*)(p.ws + OFF_VST) + ((size_t)b * 2 + g) * NBLK * 4096;
  const unsigned short* VWT = (const unsigned short*)(p.ws + OFF_VWT) + ((size_t)b * 2 + g) * NBLK * 4096;
  const unsigned short* KCB = (const unsigned short*)(p.ws + OFF_KCB) + ((size_t)b * 2 + g) * NB_CMP * 4096;
  const unsigned short* VCT = (const unsigned short*)(p.ws + OFF_VCT) + ((size_t)b * 2 + g) * NB_CMP * 4096;
  bf16x8 qf[4];
  {
    const unsigned short* qrow = QB + (tok * 8 + hd) * 64;
#pragma unroll
    for (int ks = 0; ks < 4; ++ks) qf[ks] = *(const bf16x8*)(qrow + ks * 16 + hh * 8);
  }
  const float g0 = sigmoidf_(H[tok * AB_LD + 1792 + hd * 3 + 0]);
  const float g1 = sigmoidf_(H[tok * AB_LD + 1792 + hd * 3 + 1]);
  const float g2 = sigmoidf_(H[tok * AB_LD + 1792 + hd * 3 + 2]);
  f32x16 o[2], s[2];
#pragma unroll
  for (int mt = 0; mt < 2; ++mt)
#pragma unroll
    for (int i = 0; i < 16; ++i) o[mt][i] = 0.f;
  float* mixrow = (float*)(p.ws + OFF_MIX) + tok * 1024 + 512 + hd * 64 + 4 * hh;
  __syncthreads();
  for (int w = tid; w < 32 * 128; w += NTHREADS) (&sm->imp[0][0])[w] = 0.f;
  TileRegs tr;
  tr.k0 = tr.k1 = tr.v0 = tr.v1 = make_uint4(0, 0, 0, 0);
  const int nval = tq >= 31 ? (tq - 31) / 16 + 1 : 0;
  const int nvmax = (t0 + 31 - 31) / 16 + 1;
  const int ktn = (nvmax + 63) / 64;
  float m = -INFINITY, l = 0.f;
  tile_gload(tr, KCB, nullptr, tid);
  for (int kt = 0; kt < ktn; ++kt) {
    __syncthreads();
    tile_sstore(sm, tr, false, tid);
    __syncthreads();
    if (kt + 1 < ktn) tile_gload(tr, KCB + (size_t)(kt + 1) * 4096, nullptr, tid);
    qk_tile(sm->k, qf, s, lane);
    float tmax = -INFINITY;
#pragma unroll
    for (int ks2 = 0; ks2 < 2; ++ks2)
#pragma unroll
      for (int i = 0; i < 16; ++i) {
        const int n = kt * 64 + ks2 * 32 + (i & 3) + 8 * (i >> 2) + 4 * hh;
        s[ks2][i] = n < nval ? s[ks2][i] : -INFINITY;
        tmax = fmaxf(tmax, s[ks2][i]);
      }
    tmax = fmaxf(tmax, __shfl_xor(tmax, 32));
    const float mnew = fmaxf(m, tmax);
    const float msafe = mnew == -INFINITY ? 0.f : mnew;
    float ps = 0.f;
#pragma unroll
    for (int ks2 = 0; ks2 < 2; ++ks2)
#pragma unroll
      for (int i = 0; i < 16; ++i) ps += fexp2(s[ks2][i] - msafe);
    l = l * fexp2(m - msafe) + ps;
    m = mnew;
  }
  {
    const float ltot = l + __shfl_xor(l, 32);
    const float invl = ltot > 0.f ? 1.f / ltot : 0.f;
    const float msafe = m == -INFINITY ? 0.f : m;
    tile_gload(tr, KCB, VCT, tid);
    for (int kt = 0; kt < ktn; ++kt) {
      __syncthreads();
      tile_sstore(sm, tr, true, tid);
      __syncthreads();
      if (kt + 1 < ktn) tile_gload(tr, KCB + (size_t)(kt + 1) * 4096, VCT + (size_t)(kt + 1) * 4096, tid);
      qk_tile(sm->k, qf, s, lane);
#pragma unroll
      for (int ks2 = 0; ks2 < 2; ++ks2)
#pragma unroll
        for (int i = 0; i < 16; ++i) {
          const int n = kt * 64 + ks2 * 32 + (i & 3) + 8 * (i >> 2) + 4 * hh;
          s[ks2][i] = n < nval ? fexp2(s[ks2][i] - msafe) * invl : 0.f;
        }
#pragma unroll
      for (int ks2 = 0; ks2 < 2; ++ks2)
#pragma unroll
        for (int g4 = 0; g4 < 4; ++g4) {
          float A = 2.f * (s[ks2][4 * g4] + s[ks2][4 * g4 + 1] + s[ks2][4 * g4 + 2]) + s[ks2][4 * g4 + 3];
          float Bv = s[ks2][4 * g4 + 3];
          A = quad_sum(A); Bv = quad_sum(Bv);
          const int j = kt * 16 + ks2 * 8 + 2 * g4 + hh;
          if (h == 0 && j < NBLK) sm->imp[trow][j] += A;
          WAVE_SYNC();
          if (h == 0 && j + 1 < NBLK) sm->imp[trow][j + 1] += Bv;
          WAVE_SYNC();
        }
      pv_tile(sm->vt, s, o, lane);
    }
#pragma unroll
    for (int mt = 0; mt < 2; ++mt)
#pragma unroll
      for (int g4 = 0; g4 < 4; ++g4) {
        st4(mixrow + mt * 32 + 8 * g4, make_float4(o[mt][4 * g4] * g0, o[mt][4 * g4 + 1] * g0, o[mt][4 * g4 + 2] * g0, o[mt][4 * g4 + 3] * g0));
        o[mt][4 * g4] = 0.f; o[mt][4 * g4 + 1] = 0.f; o[mt][4 * g4 + 2] = 0.f; o[mt][4 * g4 + 3] = 0.f;
      }
  }
  WAVE_SYNC();
  for (int t8 = 0; t8 < 8; ++t8) {
    const int row = wave * 8 + t8, tt = t0 + row, cur = tt >> 6;
    float kv[2]; bool valid[2];
#pragma unroll
    for (int c2 = 0; c2 < 2; ++c2) {
      const int j = lane + 64 * c2;
      valid[c2] = j < NBLK && j <= cur;
      const bool forced = (j == 0) | (j == cur) | (j == cur - 1);
      kv[c2] = valid[c2] ? (forced ? 1e6f : sm->imp[row][j < NBLK ? j : 0]) : -1.f;
      sm->keyb[wave][j] = kv[c2];
    }
    WAVE_SYNC();
    int rank0 = 0, rank1 = 0;
    const int jlim = cur < NBLK - 1 ? cur : NBLK - 1;
    for (int jj = 0; jj <= jlim; ++jj) {
      const float ov = sm->keyb[wave][jj];
      rank0 += (ov > kv[0] || (ov == kv[0] && jj < lane)) ? 1 : 0;
      rank1 += (ov > kv[1] || (ov == kv[1] && jj < lane + 64)) ? 1 : 0;
    }
    const unsigned long long m0 = __ballot(valid[0] && rank0 < 16);
    const unsigned long long m1 = __ballot(valid[1] && rank1 < 16);
    if (lane == 0) {
      sm->selmask[row][0] = (unsigned)m0; sm->selmask[row][1] = (unsigned)(m0 >> 32);
      sm->selmask[row][2] = (unsigned)m1; sm->selmask[row][3] = (unsigned)(m1 >> 32);
    }
    WAVE_SYNC();
  }
  __syncthreads();
  if (tid < 4) {
    unsigned u = 0;
    for (int r = 0; r < 32; ++r) u |= sm->selmask[r][tid];
    sm->unionm[tid] = u;
  }
  __syncthreads();
  const unsigned um0 = sm->unionm[0], um1 = sm->unionm[1], um2 = sm->unionm[2], um3 = sm->unionm[3];
  const unsigned my0 = sm->selmask[trow][0], my1 = sm->selmask[trow][1], my2 = sm->selmask[trow][2], my3 = sm->selmask[trow][3];
  {
    const int jmax = (t0 + 31) >> 6;
    int j = 0;
    while (j <= jmax && !testbit4(um0, um1, um2, um3, j)) ++j;
    m = -INFINITY; l = 0.f;
    if (j <= jmax) tile_gload(tr, KSB + (size_t)j * 4096, VST + (size_t)j * 4096, tid);
    while (j <= jmax) {
      __syncthreads();
      tile_sstore(sm, tr, true, tid);
      __syncthreads();
      int jn = j + 1;
      while (jn <= jmax && !testbit4(um0, um1, um2, um3, jn)) ++jn;
      if (jn <= jmax) tile_gload(tr, KSB + (size_t)jn * 4096, VST + (size_t)jn * 4096, tid);
      const bool mine = testbit4(my0, my1, my2, my3, j);
      if (__ballot(mine) != 0ull) {
        qk_tile(sm->k, qf, s, lane);
#pragma unroll
        for (int ks2 = 0; ks2 < 2; ++ks2)
#pragma unroll
          for (int i = 0; i < 16; ++i) {
            const int kp = j * 64 + ks2 * 32 + (i & 3) + 8 * (i >> 2) + 4 * hh;
            s[ks2][i] = (mine && kp <= tq) ? s[ks2][i] : -INFINITY;
          }
        softmax_step(s, m, l, o);
        pv_tile(sm->vt, s, o, lane);
      }
      j = jn;
    }
    const float ltot = l + __shfl_xor(l, 32);
    const float sc = ltot > 0.f ? g1 / ltot : 0.f;
#pragma unroll
    for (int mt = 0; mt < 2; ++mt)
#pragma unroll
      for (int g4 = 0; g4 < 4; ++g4) {
        float4 a = ld4(mixrow + mt * 32 + 8 * g4);
        a.x += o[mt][4 * g4] * sc; a.y += o[mt][4 * g4 + 1] * sc; a.z += o[mt][4 * g4 + 2] * sc; a.w += o[mt][4 * g4 + 3] * sc;
        st4(mixrow + mt * 32 + 8 * g4, a);
        o[mt][4 * g4] = 0.f; o[mt][4 * g4 + 1] = 0.f; o[mt][4 * g4 + 2] = 0.f; o[mt][4 * g4 + 3] = 0.f;
      }
  }
  {
    const int jlo = t0 - 511 > 0 ? (t0 - 511) >> 6 : 0, jhi = (t0 + 31) >> 6;
    const int wq0 = t0 + wave * 8;
    m = -INFINITY; l = 0.f;
    tile_gload(tr, KWB + (size_t)jlo * 4096, VWT + (size_t)jlo * 4096, tid);
    for (int j = jlo; j <= jhi; ++j) {
      __syncthreads();
      tile_sstore(sm, tr, true, tid);
      __syncthreads();
      if (j + 1 <= jhi) tile_gload(tr, KWB + (size_t)(j + 1) * 4096, VWT + (size_t)(j + 1) * 4096, tid);
      if (j * 64 <= wq0 + 7 && j * 64 + 63 > wq0 - 512) {
        qk_tile(sm->k, qf, s, lane);
#pragma unroll
        for (int ks2 = 0; ks2 < 2; ++ks2)
#pragma unroll
          for (int i = 0; i < 16; ++i) {
            const int kp = j * 64 + ks2 * 32 + (i & 3) + 8 * (i >> 2) + 4 * hh;
            s[ks2][i] = (kp <= tq && kp > tq - 512) ? s[ks2][i] : -INFINITY;
          }
        softmax_step(s, m, l, o);
        pv_tile(sm->vt, s, o, lane);
      }
    }
    const float ltot = l + __shfl_xor(l, 32);
    const float sc = ltot > 0.f ? g2 / ltot : 0.f;
#pragma unroll
    for (int mt = 0; mt < 2; ++mt)
#pragma unroll
      for (int g4 = 0; g4 < 4; ++g4) {
        float4 a = ld4(mixrow + mt * 32 + 8 * g4);
        a.x += o[mt][4 * g4] * sc; a.y += o[mt][4 * g4 + 1] * sc; a.z += o[mt][4 * g4 + 2] * sc; a.w += o[mt][4 * g4 + 3] * sc;
        st4(mixrow + mt * 32 + 8 * g4, a);
        o[mt][4 * g4] = 0.f; o[mt][4 * g4 + 1] = 0.f; o[mt][4 * g4 + 2] = 0.f; o[mt][4 * g4 + 3] = 0.f;
      }
  }
}

#define P1_SMEM ((8 * 64 + 8 * 128 + 64 * 65 + 128) * 4)
DEV void phase_p1(const Params& p, char* smem) {
  const int total = P1_CMPG_ITEMS + P1_CMPC1_ITEMS + P1_PREP_ITEMS;
  for (int it = BIDX; it < total; it += gridDim.x) {
    if (it < P1_CMPG_ITEMS) p1_cmpgemm(p, it, smem);
    else if (it < P1_CMPG_ITEMS + P1_CMPC1_ITEMS) p1_cmpc1(p, it - P1_CMPG_ITEMS, smem);
    else p1_prep(p, it - P1_CMPG_ITEMS - P1_CMPC1_ITEMS, smem);
  }
  {
    const int Gh = (int)gridDim.x / 2, bid_ = BIDX;
    if (bid_ < Gh) for (int it = bid_; it < P1_S5A_ITEMS; it += Gh) p1_s5a(p, it, smem);
  }
}
#define S5PFX_ITEMS (BATCH * 32 * 64 / NTHREADS)
DEV void s5_prefix(const Params& p, int item) {
  const int gi = item * NTHREADS + TIDX;
  const int lane = gi & 63, g = (gi >> 6) & 31, b = gi >> 11;
  float lb_re, lb_im, bbr[16], bbi[16];
  s5_consts(p, g, lane, lb_re, lb_im, bbr, bbi);
  float ar = lb_re, ai = lb_im;
#pragma unroll
  for (int s = 0; s < 6; ++s) { const float nr = ar * ar - ai * ai, ni = 2.f * ar * ai; ar = nr; ai = ni; }
  float2* E = (float2*)(p.ws + OFF_S5E) + ((size_t)b * S5_NC * 32 + g) * 64 + lane;
  float sr = 0.f, si = 0.f;
  for (int c = 0; c < S5_NC; c += 8) {
    float2 e[8];
#pragma unroll
    for (int q = 0; q < 8; ++q) e[q] = E[(size_t)(c + q) * 32 * 64];
#pragma unroll
    for (int q = 0; q < 8; ++q) {
      E[(size_t)(c + q) * 32 * 64] = make_float2(sr, si);
      const float nr = ar * sr - ai * si + e[q].x, ni = ar * si + ai * sr + e[q].y;
      sr = nr; si = ni;
    }
  }
}
DEV void phase_p1b(const Params& p, char* smem) {
  for (int it = BIDX; it < P1_CMP_ITEMS; it += gridDim.x) p1_compress(p, it, smem);
  for (int it = (int)gridDim.x - 1 - (int)BIDX; it < S5PFX_ITEMS; it += gridDim.x) s5_prefix(p, it);
}

#define P2_S5C_ITEMS (BATCH * 32 * S5_NC / 4)
#define P2_S5C_SMEM ((4 * 16 * S5C_ROW + 2 * 16 * 64 + 4 * 16 * 16) * 4)
DEV void p2_s5c(const Params& p, int item, char* smem) {
  const int lane = TIDX & 63, wave = TIDX >> 6, tid = TIDX;
  const int g = item & 31, c = ((item >> 5) % (S5_NC / 4)) * 4 + wave, b = item / (32 * (S5_NC / 4));
  float lb_re, lb_im;
  {
    float bbr[16], bbi[16];
    s5_consts(p, g, lane, lb_re, lb_im, bbr, bbi);
  }
  bf16x8 bB[4];
  s5_bfrags(p, g, lane, bB);
  const float2* E = (const float2*)(p.ws + OFF_S5E);
  const float2 e0 = E[((size_t)(b * S5_NC + c) * 32 + g) * 64 + lane];
  float sr = e0.x, si = e0.y;
  const float* H = (const float*)(p.ws + OFF_H);
  float* sS = (float*)smem + wave * 16 * S5C_ROW;
  float* sCre = (float*)smem + 4 * 16 * S5C_ROW;
  float* sCim = sCre + 16 * 64;
  float* su = sCim + 16 * 64 + wave * 16 * 16;
  __syncthreads();
  {
    const float* cre = p.in[I_S5_C_RE] + (size_t)g * 16 * 64;
    const float* cim = p.in[I_S5_C_IM] + (size_t)g * 16 * 64;
    st4(sCre + tid * 4, ld4(cre + tid * 4));
    st4(sCim + tid * 4, ld4(cim + tid * 4));
  }
  __syncthreads();
  const int nn = lane & 15, hh = lane >> 5;
  bf16x8 bC[8];
#pragma unroll
  for (int ks = 0; ks < 8; ++ks) {
    const float* src = (ks < 4 ? sCre : sCim) + nn * 64 + 16 * (ks & 3) + 8 * hh;
    float4 c0 = ld4(src), c1 = ld4(src + 4);
    if (ks >= 4) { c0 = make_float4(-c0.x, -c0.y, -c0.z, -c0.w); c1 = make_float4(-c1.x, -c1.y, -c1.z, -c1.w); }
    bC[ks] = pack_bf8(c0, c1);
  }
  const float dch = p.in[I_S5_D][g * 16 + nn];
  float* YG = (float*)(p.ws + OFF_YGELU);
  for (int sc = 0; sc < 4; ++sc) {
    {
      const float* ur = H + (size_t)(b * SEQ_LEN + c * 64 + sc * 16 + (lane >> 2)) * AB_LD + g * 16 + (lane & 3) * 4;
      st4(su + (lane >> 2) * 16 + (lane & 3) * 4, ld4(ur));
    }
    WAVE_SYNC();
    s5_subchunk(su, sS, bB, lb_re, lb_im, sr, si, lane);
    WAVE_SYNC();
    {
      f32x16 acc;
#pragma unroll
      for (int i = 0; i < 16; ++i) acc[i] = 0.f;
      const float* arow = sS + nn * S5C_ROW + 8 * hh;
#pragma unroll
      for (int ks = 0; ks < 8; ++ks) {
        const float* src = arow + 16 * ks;
        acc = __builtin_amdgcn_mfma_f32_32x32x16_bf16(pack_bf8(ld4(src), ld4(src + 4)), bC[ks], acc, 0, 0, 0);
      }
      if ((lane & 16) == 0) {
#pragma unroll
        for (int r8 = 0; r8 < 8; ++r8) {
          const int t = (r8 & 3) + 8 * (r8 >> 2) + 4 * hh;
          const size_t tok = (size_t)(b * SEQ_LEN + c * 64 + sc * 16 + t);
          YG[tok * 512 + g * 16 + nn] = geluf_(acc[r8] + dch * su[t * 16 + nn]);
        }
      }
    }
    WAVE_SYNC();
  }
}

#define P2_SMEM (P2_S5C_SMEM > P2_NSA_SMEM ? P2_S5C_SMEM : P2_NSA_SMEM)
DEV void phase_p2(const Params& p, char* smem) {
  const int G = gridDim.x;
  const int total = P2_NSA_ITEMS + P2_S5C_ITEMS;
  for (int r = 0;; ++r) {
    const int it = r * G + ((r & 1) ? (G - 1 - (int)BIDX) : (int)BIDX);
    if (r * G >= total) break;
    if (it >= total) continue;
    if (it < P2_NSA_ITEMS) p2_nsa(p, it, smem);
    else p2_s5c(p, it - P2_NSA_ITEMS, smem);
  }
}

DEV void phase_glu(const Params& p, char* smem) {
  const float* A = (const float*)(p.ws + OFF_YGELU);
  const float* B = p.in[I_S5_W_GLU];
  const float* bias = p.in[I_S5_B_GLU];
  float* MIX = (float*)(p.ws + OFF_MIX);
  const int NT = 4, MT = NTOK / GEMM_BM;
  const int xcd_ = BIDX & 7, lb_ = BIDX >> 3, nb_ = gridDim.x >> 3;
  for (int j_ = lb_; j_ < (MT / 8) * NT; j_ += nb_) {
    const int it = (xcd_ + 8 * (j_ / NT)) * NT + (j_ % NT);
    const int m0 = (it / NT) * GEMM_BM, n0 = (it % NT) * 128;
    gemm_tile<false>(
        [&](int r) { return (const void*)(A + (size_t)(m0 + r) * 512); },
        [&](int c) { return B + n0 + c; }, 512, 512,
        [&](int row, int col, float v0, float v1) {
          const size_t gm = m0 + row; const int gc = n0 + col;
          const float y0 = A[gm * 512 + gc], y1 = A[gm * 512 + gc + 32];
          MIX[gm * 1024 + gc] = y0 * sigmoidf_(v0 + bias[gc]);
          MIX[gm * 1024 + gc + 32] = y1 * sigmoidf_(v1 + bias[gc + 32]);
        },
        smem);
  }
}

template <int LAYER>
DEV void phase_outproj(const Params& p, char* smem) {
  const float* A = (const float*)(p.ws + OFF_MIX);
  const float* B = LAYER == 0 ? p.in[I_AB_W_OUT] : p.in[I_CD_W_OUT];
  const float* xin = LAYER == 0 ? p.in[I_X] : (const float*)(p.ws + OFF_X2);
  float* PRE = (float*)(p.ws + OFF_H);
  const int NT = 8, MT = NTOK / GEMM_BM;
  const int xcd_ = BIDX & 7, lb_ = BIDX >> 3, nb_ = gridDim.x >> 3;
  for (int j_ = lb_; j_ < (MT / 8) * NT; j_ += nb_) {
    const int it = (xcd_ + 8 * (j_ / NT)) * NT + (j_ % NT);
    const int m0 = (it / NT) * GEMM_BM, n0 = (it % NT) * 128;
    gemm_tile<false>(
        [&](int r) { return (const void*)(A + (size_t)(m0 + r) * 1024); },
        [&](int c) { return B + n0 + c; }, 1024, 1024,
        [&](int row, int col, float v0, float v1) {
          const size_t o = (size_t)(m0 + row) * 1024 + n0 + col;
          PRE[o] = ALPHA_F * xin[o] + v0;
          PRE[o + 32] = ALPHA_F * xin[o + 32] + v1;
        },
        smem);
  }
}

DEV void wave_ln(float (&v)[16], const float* gam, const float* bet, int lane) {
  float s = 0.f;
#pragma unroll
  for (int i = 0; i < 16; ++i) s += v[i];
  const float mu = wave_sum(s) * (1.f / 1024.f);
  float q = 0.f;
#pragma unroll
  for (int i = 0; i < 16; ++i) { const float d = v[i] - mu; q += d * d; }
  const float rstd = rsqrtf(wave_sum(q) * (1.f / 1024.f) + 1e-5f);
#pragma unroll
  for (int i = 0; i < 4; ++i) {
    const float4 gv = ld4(gam + lane * 4 + 256 * i), bv = ld4(bet + lane * 4 + 256 * i);
    v[i * 4 + 0] = (v[i * 4 + 0] - mu) * rstd * gv.x + bv.x;
    v[i * 4 + 1] = (v[i * 4 + 1] - mu) * rstd * gv.y + bv.y;
    v[i * 4 + 2] = (v[i * 4 + 2] - mu) * rstd * gv.z + bv.z;
    v[i * 4 + 3] = (v[i * 4 + 3] - mu) * rstd * gv.w + bv.w;
  }
}

#define LNR_T 4
#define P5_SMEM ((4 * LNR_T * 512 + 4 * 4 * LNR_T * 64 + 4 * 64) * 4)
template <int LAYER>
DEV void phase_ln_router(const Params& p, char* smem) {
  const int lane = TIDX & 63, wave = TIDX >> 6;
  const float* PRE = (const float*)(p.ws + OFF_H);
  float* X1 = (float*)(p.ws + OFF_X1);
  const float* router = p.in[I_ROUTER] + (size_t)LAYER * 1024 * 64;
  const float* bias = p.in[I_MOE_BIAS] + LAYER * 64;
  int* TOPI = (int*)(p.ws + OFF_TOPI);
  float* TOPG = (float*)(p.ws + OFF_TOPG);
  float* xh = (float*)smem;
  float* part = xh + 4 * LNR_T * 512;
  float* ms = part + 4 * 4 * LNR_T * 64 + wave * 64;
  unsigned short* X1B = (unsigned short*)p.out;
  for (int it = BIDX; it < NTOK / (4 * LNR_T); it += gridDim.x) {
    const size_t tokb = (size_t)it * (4 * LNR_T) + wave * LNR_T;
    float v[LNR_T][16];
#pragma unroll
    for (int t = 0; t < LNR_T; ++t) {
      const size_t tok = tokb + t;
#pragma unroll
      for (int i = 0; i < 4; ++i) {
        const float4 a = ld4(PRE + tok * 1024 + lane * 4 + 256 * i);
        v[t][i * 4] = a.x; v[t][i * 4 + 1] = a.y; v[t][i * 4 + 2] = a.z; v[t][i * 4 + 3] = a.w;
      }
      wave_ln(v[t], p.in[I_LN1_G] + LAYER * 1024, p.in[I_LN1_B] + LAYER * 1024, lane);
#pragma unroll
      for (int i = 0; i < 4; ++i) {
        const float4 a = make_float4(v[t][i * 4], v[t][i * 4 + 1], v[t][i * 4 + 2], v[t][i * 4 + 3]);
        st4(X1 + tok * 1024 + lane * 4 + 256 * i, a);
        *(uint2*)(X1B + tok * 1024 + lane * 4 + 256 * i) = make_uint2(pk2(a.x, a.y), pk2(a.z, a.w));
      }
    }
    {
      float pl[4 * LNR_T];
#pragma unroll
      for (int t = 0; t < 4 * LNR_T; ++t) pl[t] = 0.f;
#pragma unroll
      for (int hf = 0; hf < 2; ++hf) {
        __syncthreads();
#pragma unroll
        for (int t = 0; t < LNR_T; ++t)
#pragma unroll
          for (int i2 = 0; i2 < 2; ++i2) {
            const int i = 2 * hf + i2;
            st4(xh + (wave * LNR_T + t) * 512 + lane * 4 + 256 * i2, make_float4(v[t][i * 4], v[t][i * 4 + 1], v[t][i * 4 + 2], v[t][i * 4 + 3]));
          }
        __syncthreads();
#pragma unroll 2
        for (int kk = wave * 128; kk < wave * 128 + 128; kk += 4) {
          const int k = hf * 512 + kk;
          const float r0 = router[(size_t)k * 64 + lane], r1 = router[(size_t)(k + 1) * 64 + lane],
                      r2 = router[(size_t)(k + 2) * 64 + lane], r3 = router[(size_t)(k + 3) * 64 + lane];
#pragma unroll
          for (int t = 0; t < 4 * LNR_T; ++t) {
            const float4 xv = ld4(xh + t * 512 + kk);
            pl[t] += xv.x * r0 + xv.y * r1 + xv.z * r2 + xv.w * r3;
          }
        }
      }
#pragma unroll
      for (int t = 0; t < 4 * LNR_T; ++t) part[(wave * 4 * LNR_T + t) * 64 + lane] = pl[t];
    }
    __syncthreads();
    float lg[LNR_T];
#pragma unroll
    for (int t = 0; t < LNR_T; ++t) {
      const int tg = wave * LNR_T + t;
      lg[t] = ((part[(0 * 4 * LNR_T + tg) * 64 + lane] + part[(1 * 4 * LNR_T + tg) * 64 + lane]) + part[(2 * 4 * LNR_T + tg) * 64 + lane]) +
              part[(3 * 4 * LNR_T + tg) * 64 + lane];
    }
#pragma unroll
    for (int t = 0; t < LNR_T; ++t) {
      const size_t tok = tokb + t;
      const float score = 1.f / (1.f + expf(-lg[t]));
      const float biased = score + bias[lane];
      float m1 = biased; int a1 = lane;
#pragma unroll
      for (int mm = 1; mm <= 4; mm <<= 1) {
        const float ov = __shfl_xor(m1, mm); const int oa = __shfl_xor(a1, mm);
        if (ov > m1 || (ov == m1 && oa < a1)) { m1 = ov; a1 = oa; }
      }
      float m2 = lane == a1 ? -INFINITY : biased;
#pragma unroll
      for (int mm = 1; mm <= 4; mm <<= 1) m2 = fmaxf(m2, __shfl_xor(m2, mm));
      const float gs = m1 + m2;
      const int mygrp = lane >> 3;
      int rank = 0;
#pragma unroll
      for (int gg = 0; gg < 8; ++gg) {
        const float og = __shfl(gs, gg * 8);
        rank += (og > gs || (og == gs && gg < mygrp)) ? 1 : 0;
      }
      const float masked = rank < 4 ? biased : -INFINITY;
      WAVE_SYNC();
      ms[lane] = masked;
      WAVE_SYNC();
      int erank = 0;
      for (int e = 0; e < 64; ++e) {
        const float ov = ms[e];
        erank += (ov > masked || (ov == masked && e < lane)) ? 1 : 0;
      }
      const bool selected = erank < 8;
      const float gsum = wave_sum(selected ? score : 0.f);
      if (selected) {
        TOPI[tok * 8 + erank] = lane;
        TOPG[tok * 8 + erank] = score / gsum * 2.5f;
      }
    }
  }
}

#define P6_SMEM GEMM_SMEM_BYTES
template <int LAYER>
DEV void phase_lists_shup(const Params& p, char* smem) {
  const int tid = TIDX, lane = tid & 63, wave = tid >> 6;
  const int* TOPI = (const int*)(p.ws + OFF_TOPI);
  const float* TOPG = (const float*)(p.ws + OFF_TOPG);
  int* PPOS = (int*)(p.ws + OFF_S5E);
  int* CNT = (int*)(p.ws + OFF_CNT);
  int* LTOK = (int*)(p.ws + OFF_LTOK);
  float* LGATE = (float*)(p.ws + OFF_LGATE);
  const unsigned short* X1B = (const unsigned short*)p.out;
  unsigned short* HS = (unsigned short*)(p.ws + OFF_HS);
  const float* W1 = p.in[I_SH_W1] + (size_t)LAYER * 1024 * 256;
  const float* W3 = p.in[I_SH_W3] + (size_t)LAYER * 1024 * 256;
  const int MT = NTOK / GEMM_BM;
  int* swave = (int*)smem;
  for (int it = BIDX; it < 64; it += gridDim.x) {
    const int e = it;
    int base = 0;
    for (int t0 = 0; t0 < NTOK; t0 += 4 * NTHREADS) {
      const int tok4 = t0 + 4 * tid;
      int slot[4];
      unsigned long long bal[4];
#pragma unroll
      for (int j = 0; j < 4; ++j) {
        const int4 a = *(const int4*)(TOPI + (size_t)(tok4 + j) * 8), b = *(const int4*)(TOPI + (size_t)(tok4 + j) * 8 + 4);
        int sl = -1;
        sl = a.x == e ? 0 : sl; sl = a.y == e ? 1 : sl; sl = a.z == e ? 2 : sl; sl = a.w == e ? 3 : sl;
        sl = b.x == e ? 4 : sl; sl = b.y == e ? 5 : sl; sl = b.z == e ? 6 : sl; sl = b.w == e ? 7 : sl;
        slot[j] = sl;
        bal[j] = __ballot(sl >= 0);
      }
      const unsigned long long lower = (1ull << lane) - 1ull;
      int pre = 0, wtot = 0;
#pragma unroll
      for (int j = 0; j < 4; ++j) { pre += __popcll(bal[j] & lower); wtot += __popcll(bal[j]); }
      __syncthreads();
      if (lane == 0) swave[wave] = wtot;
      __syncthreads();
      int woff = 0, tot = 0;
#pragma unroll
      for (int w = 0; w < 4; ++w) { const int c = swave[w]; if (w < wave) woff += c; tot += c; }
      int pos = base + woff + pre;
#pragma unroll
      for (int j = 0; j < 4; ++j) {
        if (slot[j] >= 0) {
          const int tok = tok4 + j;
          LTOK[(size_t)e * NTOK + pos] = tok;
          LGATE[(size_t)e * NTOK + pos] = TOPG[(size_t)tok * 8 + slot[j]];
          PPOS[(size_t)e * NTOK + tok] = pos;
          ++pos;
        }
      }
      base += tot;
    }
    if (tid == 0) CNT[e * 32] = base;
    __syncthreads();
  }
  {
    const int NT = 4;
    const int xcd_ = BIDX & 7, lb_ = BIDX >> 3, nb_ = gridDim.x >> 3;
    for (int j_ = lb_; j_ < (MT / 8) * NT; j_ += nb_) {
      const int m0 = (xcd_ + 8 * (j_ / NT)) * GEMM_BM, ct = j_ % NT;
      gemm_tile<true>(
          [&](int r) { return (const void*)(X1B + (size_t)(m0 + r) * 1024); },
          [&](int c) { return (((c >> 5) & 1) ? W3 : W1) + ct * 64 + (c >> 6) * 32 + (c & 31); }, 256, 1024,
          [&](int row, int col, float v0, float v1) {
            const int lc = ct * 64 + (col >> 6) * 32 + (col & 31);
            HS[(size_t)(m0 + row) * 256 + lc] = f2bf(siluf_(v0) * v1);
          },
          smem);
    }
  }
}

struct ExpMap { int tstart[65]; int rbase[65]; int ltile[9]; };
DEV void build_expmap(const Params& p, ExpMap* em) {
  __syncthreads();
  if (TIDX == 0) {
    const int* CNT = (const int*)(p.ws + OFF_CNT);
    int ts = 0, rb = 0;
    for (int e = 0; e < 64; ++e) {
      em->tstart[e] = ts; em->rbase[e] = rb;
      const int c = CNT[e * 32];
      ts += (c + GEMM_BM - 1) / GEMM_BM; rb += c;
    }
    em->tstart[64] = ts; em->rbase[64] = rb;
    const int x = BIDX & 7;
    int lt = 0;
    for (int k = 0; k < 8; ++k) { em->ltile[k] = lt; lt += em->tstart[x + 8 * k + 1] - em->tstart[x + 8 * k]; }
    em->ltile[8] = lt;
  }
  __syncthreads();
}
DEV void map_expert_tile(const ExpMap* em, int j, int CT, int& e, int& rt, int& ct) {
  const int jr = j / CT; ct = j % CT;
  int k = 0;
  for (int q = 1; q < 8; ++q) if (em->ltile[q] <= jr) k = q;
  e = (BIDX & 7) + 8 * k; rt = jr - em->ltile[k];
}
#define P7_SMEM (GEMM_SMEM_BYTES + 1024)
template <int LAYER>
DEV void phase_routed_up(const Params& p, char* smem) {
  ExpMap* em = (ExpMap*)(smem + GEMM_SMEM_BYTES);
  build_expmap(p, em);
  const int* CNT = (const int*)(p.ws + OFF_CNT);
  const int* LTOK = (const int*)(p.ws + OFF_LTOK);
  const unsigned short* X1B = (const unsigned short*)p.out;
  unsigned short* HR = (unsigned short*)(p.ws + OFF_HR);
  const int lb_ = BIDX >> 3, nb_ = gridDim.x >> 3;
  for (int j_ = lb_; j_ < em->ltile[8] * 4; j_ += nb_) {
    int e, rtl, ct;
    map_expert_tile(em, j_, 4, e, rtl, ct);
    const int r0 = rtl * GEMM_BM;
    const int cnt = CNT[e * 32], rbase = em->rbase[e];
    const float* W1 = p.in[I_MOE_W1] + ((size_t)LAYER * 64 + e) * 1024 * 256;
    const float* W3 = p.in[I_MOE_W3] + ((size_t)LAYER * 64 + e) * 1024 * 256;
    gemm_tile<true>(
        [&](int r) { return (r0 + r < cnt) ? (const void*)(X1B + (size_t)LTOK[(size_t)e * NTOK + r0 + r] * 1024) : (const void*)nullptr; },
        [&](int c) { return (((c >> 5) & 1) ? W3 : W1) + ct * 64 + (c >> 6) * 32 + (c & 31); }, 256, 1024,
        [&](int row, int col, float v0, float v1) {
          if (r0 + row < cnt) {
            const int lc = ct * 64 + (col >> 6) * 32 + (col & 31);
            HR[(size_t)(rbase + r0 + row) * 256 + lc] = f2bf(siluf_(v0) * v1);
          }
        },
        smem);
  }
}

template <int LAYER>
DEV void phase_down(const Params& p, char* smem) {
  ExpMap* em = (ExpMap*)(smem + GEMM_SMEM_BYTES);
  build_expmap(p, em);
  const int* CNT = (const int*)(p.ws + OFF_CNT);
  const float* LGATE = (const float*)(p.ws + OFF_LGATE);
  const unsigned short* HR = (const unsigned short*)(p.ws + OFF_HR);
  const unsigned short* HS = (const unsigned short*)(p.ws + OFF_HS);
  unsigned short* Y = (unsigned short*)(p.ws + OFF_Y);
  float* FS = (float*)(p.ws + OFF_FS);
  const int xcd_ = BIDX & 7, lb_ = BIDX >> 3, nb_ = gridDim.x >> 3;
  for (int j_ = lb_; j_ < em->ltile[8] * 8; j_ += nb_) {
    int e, rtl, ct;
    map_expert_tile(em, j_, 8, e, rtl, ct);
    const int r0 = rtl * GEMM_BM;
    const int cnt = CNT[e * 32], rbase = em->rbase[e];
    const float* W2 = p.in[I_MOE_W2] + ((size_t)LAYER * 64 + e) * 256 * 1024;
    const int n0 = ct * 128;
    gemm_tile<true>(
        [&](int r) { return (r0 + r < cnt) ? (const void*)(HR + (size_t)(rbase + r0 + r) * 256) : (const void*)nullptr; },
        [&](int c) { return W2 + n0 + c; }, 1024, 256,
        [&](int row, int col, float v0, float v1) {
          if (r0 + row < cnt) {
            const float gt = LGATE[(size_t)e * NTOK + r0 + row];
            const size_t o = (size_t)(rbase + r0 + row) * 1024 + n0 + col;
            Y[o] = f2bf(v0 * gt); Y[o + 32] = f2bf(v1 * gt);
          }
        },
        smem);
  }
  {
    const int MT = NTOK / GEMM_BM, NT = 8;
    const float* W2 = p.in[I_SH_W2] + (size_t)LAYER * 256 * 1024;
    for (int j_ = lb_; j_ < (MT / 8) * NT; j_ += nb_) {
      const int m0 = (xcd_ + 8 * (j_ / NT)) * GEMM_BM, n0 = (j_ % NT) * 128;
      gemm_tile<true>(
          [&](int r) { return (const void*)(HS + (size_t)(m0 + r) * 256); },
          [&](int c) { return W2 + n0 + c; }, 1024, 256,
          [&](int row, int col, float v0, float v1) {
            const size_t o = (size_t)(m0 + row) * 1024 + n0 + col;
            FS[o] = v0; FS[o + 32] = v1;
          },
          smem);
    }
  }
}

template <int LAYER>
DEV void phase_combine(const Params& p, char* smem) {
  ExpMap* em = (ExpMap*)smem;
  build_expmap(p, em);
  const int lane = TIDX & 63, wave = TIDX >> 6;
  const float* X1 = (const float*)(p.ws + OFF_X1);
  const float* FS = (const float*)(p.ws + OFF_FS);
  const unsigned short* Y = (const unsigned short*)(p.ws + OFF_Y);
  const int* TOPI = (const int*)(p.ws + OFF_TOPI);
  const int* PPOS = (const int*)(p.ws + OFF_S5E);
  float* OUT = LAYER == 0 ? (float*)(p.ws + OFF_X2) : p.out;
  for (int it = BIDX; it < NTOK / 4; it += gridDim.x) {
    const size_t tok = (size_t)it * 4 + wave;
    float v[16];
#pragma unroll
    for (int i = 0; i < 4; ++i) {
      const float4 a = ld4(X1 + tok * 1024 + lane * 4 + 256 * i), f = ld4(FS + tok * 1024 + lane * 4 + 256 * i);
      v[i * 4] = ALPHA_F * a.x + f.x; v[i * 4 + 1] = ALPHA_F * a.y + f.y; v[i * 4 + 2] = ALPHA_F * a.z + f.z; v[i * 4 + 3] = ALPHA_F * a.w + f.w;
    }
    size_t rows[8];
#pragma unroll
    for (int s = 0; s < 8; ++s) { const int e_ = TOPI[tok * 8 + s]; rows[s] = (size_t)em->rbase[e_] + PPOS[(size_t)e_ * NTOK + tok]; }
#pragma unroll
    for (int s0 = 0; s0 < 8; s0 += 4) {
      uint2 yy[4][4];
#pragma unroll
      for (int s = 0; s < 4; ++s)
#pragma unroll
        for (int i = 0; i < 4; ++i) yy[s][i] = *(const uint2*)(Y + rows[s0 + s] * 1024 + lane * 4 + 256 * i);
#pragma unroll
      for (int s = 0; s < 4; ++s)
#pragma unroll
        for (int i = 0; i < 4; ++i) {
          const uint2 y = yy[s][i];
          v[i * 4] += bf2f((unsigned short)(y.x & 0xFFFF)); v[i * 4 + 1] += bf2f((unsigned short)(y.x >> 16));
          v[i * 4 + 2] += bf2f((unsigned short)(y.y & 0xFFFF)); v[i * 4 + 3] += bf2f((unsigned short)(y.y >> 16));
        }
    }
    wave_ln(v, p.in[I_LN2_G] + LAYER * 1024, p.in[I_LN2_B] + LAYER * 1024, lane);
#pragma unroll
    for (int i = 0; i < 4; ++i) st4(OUT + tok * 1024 + lane * 4 + 256 * i, make_float4(v[i * 4], v[i * 4 + 1], v[i * 4 + 2], v[i * 4 + 3]));
    if (LAYER == 0) {
      unsigned short* X2B = (unsigned short*)(p.ws + OFF_X2B);
#pragma unroll
      for (int i = 0; i < 4; ++i) *(uint2*)(X2B + tok * 1024 + lane * 4 + 256 * i) = make_uint2(pk2(v[i * 4], v[i * 4 + 1]), pk2(v[i * 4 + 2], v[i * 4 + 3]));
    }
  }
}

DEV float shifted(const float* Hc, size_t tok, int col, const float* mu) {
  const float cur = Hc[tok * 1792 + col];
  const float prev = (tok % SEQ_LEN) == 0 ? 0.f : Hc[(tok - 1) * 1792 + col];
  return cur + (prev - cur) * mu[col];
}

#define RWP_T 32
#define P11_PREP_ITEMS (NTOK / RWP_T)
#define P11_KV_ITEMS (BATCH * 4 * RET_NC)
#define P11_SMEM (RWP_T * 128 * 4)
DEV void p11_prep(const Params& p, int item, char* smem) {
  const int tid = TIDX;
  const float* Hc = (const float*)(p.ws + OFF_H);
  const float* mu = p.in[I_RW_MU];
  float* sl = (float*)smem;
  __syncthreads();
  for (int w = tid; w < RWP_T * 128; w += NTHREADS) {
    const int tt = w >> 7, j = w & 127;
    const size_t tok = (size_t)item * RWP_T + tt;
    const float v = shifted(Hc, tok, 1536 + j, mu);
    sl[w] = j < 64 ? tanhf(v) : v;
    ((float*)(p.ws + OFF_GLO))[tok * 128 + j] = sigmoidf_(shifted(Hc, tok, 1664 + j, mu));
  }
  __syncthreads();
  float* RWW = (float*)(p.ws + OFF_RWW); float* RWK = (float*)(p.ws + OFF_RWK);
  float* RWKK = (float*)(p.ws + OFF_RWKK); float* RWA = (float*)(p.ws + OFF_RWA);
  float* RWR = p.out + (size_t)NTOK * 512; float* RWV = p.out;
  const float* w_up = p.in[I_RW_W_UP]; const float* a_up = p.in[I_RW_A_UP];
#pragma unroll
  for (int cc = 0; cc < 2; ++cc) {
    const int c = tid + 256 * cc;
    float aw[RWP_T], aa[RWP_T];
#pragma unroll
    for (int tt = 0; tt < RWP_T; ++tt) { aw[tt] = 0.f; aa[tt] = 0.f; }
    for (int j0 = 0; j0 < 64; j0 += 16) {
      float wu[16], au[16];
#pragma unroll
      for (int q = 0; q < 16; ++q) { wu[q] = w_up[(j0 + q) * 512 + c]; au[q] = a_up[(j0 + q) * 512 + c]; }
#pragma unroll
      for (int q4 = 0; q4 < 4; ++q4) {
#pragma unroll
        for (int tt = 0; tt < RWP_T; ++tt) {
          const float4 sw = ld4(sl + tt * 128 + j0 + q4 * 4), sa = ld4(sl + tt * 128 + 64 + j0 + q4 * 4);
          aw[tt] += sw.x * wu[q4 * 4] + sw.y * wu[q4 * 4 + 1] + sw.z * wu[q4 * 4 + 2] + sw.w * wu[q4 * 4 + 3];
          aa[tt] += sa.x * au[q4 * 4] + sa.y * au[q4 * 4 + 1] + sa.z * au[q4 * 4 + 2] + sa.w * au[q4 * 4 + 3];
        }
      }
    }
    const float w0 = p.in[I_RW_W0][c], a0 = p.in[I_RW_A0][c], kkc = p.in[I_RW_K_K][c], kac = p.in[I_RW_K_A][c];
#pragma unroll 4
    for (int tt = 0; tt < RWP_T; ++tt) {
      const size_t tok = (size_t)item * RWP_T + tt;
      const float lw = w0 + aw[tt];
      const float nl = -lw;
      const float sp = nl > 20.f ? nl : log1pf(expf(nl));
      const float wl = -sp - 0.5f;
      const float decay = expf(-expf(wl));
      const float a = 1.f / (1.f + expf(-(a0 + aa[tt])));
      const float rs = shifted(Hc, tok, c, mu);
      const float ks = shifted(Hc, tok, 512 + c, mu);
      const float vs = shifted(Hc, tok, 1024 + c, mu);
      float kk = ks * kkc;
      const float nrm = sqrtf(wave_sum(kk * kk));
      kk = kk / fmaxf(nrm, 1e-12f);
      RWW[tok * 512 + c] = decay;
      RWK[tok * 512 + c] = ks * (1.f + (a - 1.f) * kac);
      RWKK[tok * 512 + c] = kk;
      RWA[tok * 512 + c] = kk * a;
      RWR[tok * 512 + c] = rs;
      RWV[tok * 512 + c] = vs;
    }
  }
}
DEV float ret_log2gamma(int h) { return log2f(1.f - exp2f(-5.f - (float)h)); }
struct KvSmem { unsigned short vt[128][72]; unsigned short kt[64][72]; };
#define P11_KV_SMEM ((int)sizeof(KvSmem))
DEV void p11_kv(const Params& p, int item, char* smem) {
  KvSmem* sm = (KvSmem*)smem;
  const int c = item % RET_NC, h = (item / RET_NC) & 3, b = item / (RET_NC * 4);
  const int tid = TIDX, lane = tid & 63, wave = tid >> 6;
  const int r = lane & 31, hh = lane >> 5;
  const float* H2 = (const float*)(p.ws + OFF_H2);
  const float lg = ret_log2gamma(h);
  const size_t tok0 = (size_t)b * SEQ_LEN + c * 128;
  f32x16 acc[2];
#pragma unroll
  for (int nt = 0; nt < 2; ++nt)
#pragma unroll
    for (int i = 0; i < 16; ++i) acc[nt][i] = 0.f;
#pragma unroll 1
  for (int kt = 0; kt < 2; ++kt) {
    __syncthreads();
#pragma unroll
    for (int q = 0; q < 8; ++q) {
      const int f = tid + 256 * q;
      const int key = f >> 5, d4 = (f & 31) * 4;
      const float dec = exp2f((float)(127 - (kt * 64 + key)) * lg);
      const float4 v = ld4(H2 + (tok0 + kt * 64 + key) * 1536 + 512 + h * 128 + d4);
      sm->vt[d4][key] = f2bf(v.x * dec); sm->vt[d4 + 1][key] = f2bf(v.y * dec);
      sm->vt[d4 + 2][key] = f2bf(v.z * dec); sm->vt[d4 + 3][key] = f2bf(v.w * dec);
    }
#pragma unroll
    for (int q = 0; q < 4; ++q) {
      const int f = tid + 256 * q;
      const int key = f >> 4, d4 = (f & 15) * 4;
      const float4 v = ld4(H2 + (tok0 + kt * 64 + key) * 1536 + 256 + h * 64 + d4);
      sm->kt[d4][key] = f2bf(v.x); sm->kt[d4 + 1][key] = f2bf(v.y); sm->kt[d4 + 2][key] = f2bf(v.z); sm->kt[d4 + 3][key] = f2bf(v.w);
    }
    __syncthreads();
#pragma unroll
    for (int ks = 0; ks < 4; ++ks) {
      const bf16x8 a = *(const bf16x8*)&sm->vt[wave * 32 + r][ks * 16 + hh * 8];
#pragma unroll
      for (int nt = 0; nt < 2; ++nt) {
        const bf16x8 bb = *(const bf16x8*)&sm->kt[nt * 32 + r][ks * 16 + hh * 8];
        acc[nt] = __builtin_amdgcn_mfma_f32_32x32x16_bf16(a, bb, acc[nt], 0, 0, 0);
      }
    }
  }
  float* KV = (float*)(p.ws + OFF_RETKV) + (size_t)item * 64 * 128;
#pragma unroll
  for (int nt = 0; nt < 2; ++nt)
#pragma unroll
    for (int g4 = 0; g4 < 4; ++g4)
      st4(KV + (nt * 32 + r) * 128 + wave * 32 + 8 * g4 + 4 * hh,
          make_float4(acc[nt][4 * g4], acc[nt][4 * g4 + 1], acc[nt][4 * g4 + 2], acc[nt][4 * g4 + 3]));
}
DEV void phase_p11(const Params& p, char* smem) {
  {
    unsigned* RKF = (unsigned*)(p.ws + OFF_RKF);
    for (int i = BIDX * NTHREADS + TIDX; i < BATCH * 8 * (SEQ_LEN / 32); i += gridDim.x * NTHREADS) RKF[i] = 0u;
  }
  const int total = P11_PREP_ITEMS + P11_KV_ITEMS;
  for (int it = BIDX; it < total; it += gridDim.x) {
    if (it < P11_KV_ITEMS) p11_kv(p, it, smem);
    else p11_prep(p, it - P11_KV_ITEMS, smem);
  }
}

#define RK_T 32
#define RK_NCH (SEQ_LEN / RK_T)
#define RK_NCHT (BATCH * 8 * RK_NCH)
#define OFF_RKPT OFF_H
#define OFF_RKKT (OFF_RKPT + (size_t)RK_NCHT * 64 * 64 * 2)
#define OFF_RKVT (OFF_RKKT + (size_t)RK_NCHT * 64 * 32 * 2)
#define OFF_RKRT (OFF_RKVT + (size_t)RK_NCHT * 64 * 32 * 2)
#define OFF_RKAT (OFF_RKRT + (size_t)RK_NCHT * 32 * 64 * 2)
#define OFF_RKEND (OFF_RKAT + (size_t)RK_NCHT * 32 * 32 * 2)
static_assert(OFF_RKEND <= OFF_H2, "rk buffers must fit in the H1 region");
#define RKPRE_SMEM ((4 * 32 * 64 + 32 * 64) * 4)

DEV unsigned short* rksc_row(char* ws, int b, int h, int c, int i) {
  return (unsigned short*)(ws + OFF_RWW) + (((size_t)b * SEQ_LEN + (size_t)c * RK_T + (i >> 1)) * 512 + h * 64) * 2 + (i & 1) * 64;
}
#if RK_MERGED
DEV void st_wt_u16(unsigned short* q, unsigned short v) { asm volatile("global_store_short %0, %1, off sc1" :: "v"(q), "v"((unsigned)v) : "memory"); }
typedef unsigned u32x4_t __attribute__((ext_vector_type(4)));
DEV void st_wt_b128(void* q, uint4 v) { const u32x4_t w = {v.x, v.y, v.z, v.w}; asm volatile("global_store_dwordx4 %0, %1, off sc1" :: "v"(q), "v"(w) : "memory"); }
#else
DEV void st_wt_u16(unsigned short* q, unsigned short v) { *q = v; }
DEV void st_wt_b128(void* q, uint4 v) { *(uint4*)q = v; }
#endif
DEV void rk_precompute(const Params& p, int ch, char* smem) {
  const int c = ch % RK_NCH, bh = ch / RK_NCH, h = bh & 7, b = bh >> 3;
  const int tid = TIDX, lane = tid & 63, wave = tid >> 6;
  const size_t tok0 = (size_t)b * SEQ_LEN + (size_t)c * RK_T;
  const float* RWW = (const float*)(p.ws + OFF_RWW); const float* RWK = (const float*)(p.ws + OFF_RWK);
  const float* RWKK = (const float*)(p.ws + OFF_RWKK); const float* RWA = (const float*)(p.ws + OFF_RWA);
  const float* RWR = p.out + (size_t)NTOK * 512; const float* RWV = p.out;
  float* sW = (float*)smem;
  float* sNK = sW + 32 * 64;
  float* sKA = sNK + 32 * 64;
  float* sR = sKA + 32 * 64;
  float* sV = sR + 32 * 64;
  __syncthreads();
  for (int w = tid; w < 32 * 16; w += NTHREADS) {
    const int t = w >> 4, c4 = (w & 15) * 4;
    const size_t o = (tok0 + t) * 512 + h * 64 + c4;
    st4(sW + t * 64 + c4, ld4(RWW + o));
    const float4 kk = ld4(RWKK + o);
    st4(sNK + t * 64 + c4, make_float4(-kk.x, -kk.y, -kk.z, -kk.w));
    st4(sKA + t * 64 + c4, ld4(RWA + o));
    st4(sR + t * 64 + c4, ld4(RWR + o));
    st4(sV + t * 64 + c4, ld4(RWV + o));
  }
  __syncthreads();
  const int wrole = (wave + ((BIDX >= (gridDim.x >> 1)) ? 2 : 0)) & 3;
  if (wrole == 0) {
    float z[64];
#pragma unroll
    for (int j = 0; j < 64; ++j) z[j] = (j == lane) ? 1.f : 0.f;
    for (int t = 0; t < RK_T; ++t) {
      float cacc = 0.f;
#pragma unroll
      for (int j4 = 0; j4 < 16; ++j4) {
        const float4 u = ld4(sNK + t * 64 + j4 * 4);
        cacc += z[j4 * 4] * u.x + z[j4 * 4 + 1] * u.y + z[j4 * 4 + 2] * u.z + z[j4 * 4 + 3] * u.w;
      }
#pragma unroll
      for (int j4 = 0; j4 < 16; ++j4) {
        const float4 w = ld4(sW + t * 64 + j4 * 4), v = ld4(sKA + t * 64 + j4 * 4);
        z[j4 * 4] = z[j4 * 4] * w.x + cacc * v.x; z[j4 * 4 + 1] = z[j4 * 4 + 1] * w.y + cacc * v.y;
        z[j4 * 4 + 2] = z[j4 * 4 + 2] * w.z + cacc * v.z; z[j4 * 4 + 3] = z[j4 * 4 + 3] * w.w + cacc * v.w;
      }
    }
    unsigned short* PT = (unsigned short*)(p.ws + OFF_RKPT) + (size_t)ch * 64 * 64;
#pragma unroll
    for (int j = 0; j < 64; ++j) st_wt_u16(PT + j * 64 + lane, f2bf(z[j]));
  } else if (wrole == 1) {
    const bool isA = lane < 32;
    const int me = lane & 31;
    float q[64];
    {
      const float* src = (isA ? RWK : RWR) + (tok0 + me) * 512 + h * 64;
#pragma unroll
      for (int j4 = 0; j4 < 16; ++j4) { const float4 v = ld4(src + j4 * 4); q[j4 * 4] = v.x; q[j4 * 4 + 1] = v.y; q[j4 * 4 + 2] = v.z; q[j4 * 4 + 3] = v.w; }
    }
    const float* Ub = isA ? sNK : sKA;
    const float* Vb = isA ? sKA : sNK;
    unsigned short* AT = (unsigned short*)(p.ws + OFF_RKAT) + (size_t)ch * 32 * 32;
    for (int u = 0; u < RK_T; ++u) {
      const int tt = isA ? u : RK_T - 1 - u;
      const bool upd = isA ? (u > me) : (tt <= me);
      if (upd) {
        float cacc = 0.f;
#pragma unroll
        for (int j4 = 0; j4 < 16; ++j4) {
          const float4 uu = ld4(Ub + tt * 64 + j4 * 4);
          cacc += q[j4 * 4] * uu.x + q[j4 * 4 + 1] * uu.y + q[j4 * 4 + 2] * uu.z + q[j4 * 4 + 3] * uu.w;
        }
#pragma unroll
        for (int j4 = 0; j4 < 16; ++j4) {
          const float4 w = ld4(sW + tt * 64 + j4 * 4), v = ld4(Vb + tt * 64 + j4 * 4);
          q[j4 * 4] = q[j4 * 4] * w.x + cacc * v.x; q[j4 * 4 + 1] = q[j4 * 4 + 1] * w.y + cacc * v.y;
          q[j4 * 4 + 2] = q[j4 * 4 + 2] * w.z + cacc * v.z; q[j4 * 4 + 3] = q[j4 * 4 + 3] * w.w + cacc * v.w;
        }
      }
      if (isA) {
        float av = 0.f;
        if (u >= me) {
#pragma unroll
          for (int j4 = 0; j4 < 16; ++j4) {
            const float4 rr = ld4(sR + u * 64 + j4 * 4);
            av += q[j4 * 4] * rr.x + q[j4 * 4 + 1] * rr.y + q[j4 * 4 + 2] * rr.z + q[j4 * 4 + 3] * rr.w;
          }
        }
        AT[u * 32 + me] = f2bf(av);
      }
    }
    if (isA) {
      unsigned short* KT = (unsigned short*)(p.ws + OFF_RKKT) + (size_t)ch * 64 * 32;
#pragma unroll
      for (int j = 0; j < 64; ++j) st_wt_u16(KT + j * 32 + me, f2bf(q[j]));
    } else {
      unsigned short* RT = (unsigned short*)(p.ws + OFF_RKRT) + ((size_t)ch * 32 + me) * 64;
#pragma unroll
      for (int j8 = 0; j8 < 8; ++j8)
        *(uint4*)(RT + j8 * 8) = make_uint4(pk2(q[j8 * 8], q[j8 * 8 + 1]), pk2(q[j8 * 8 + 2], q[j8 * 8 + 3]), pk2(q[j8 * 8 + 4], q[j8 * 8 + 5]), pk2(q[j8 * 8 + 6], q[j8 * 8 + 7]));
    }
  } else if (wrole == 2) {
    unsigned short* VT = (unsigned short*)(p.ws + OFF_RKVT) + (size_t)ch * 64 * 32;
#pragma unroll
    for (int t8 = 0; t8 < 4; ++t8) {
      float v[8];
#pragma unroll
      for (int q8 = 0; q8 < 8; ++q8) v[q8] = sV[(t8 * 8 + q8) * 64 + lane];
      st_wt_b128(VT + lane * 32 + t8 * 8, make_uint4(pk2(v[0], v[1]), pk2(v[2], v[3]), pk2(v[4], v[5]), pk2(v[6], v[7])));
    }
  }
#if RK_MERGED
  asm volatile("s_waitcnt vmcnt(0)" ::: "memory");
  __syncthreads();
  if (tid == 0) __hip_atomic_store((unsigned*)(p.ws + OFF_RKF) + ch, 1u, __ATOMIC_RELAXED, __HIP_MEMORY_SCOPE_AGENT);
#endif
}
DEV void phase_retpfx(const Params& p, char* smem);
DEV void phase_rkpre(const Params& p, char* smem) {
  phase_retpfx(p, smem);
  for (int it = BIDX; it < RK_NCHT; it += gridDim.x) rk_precompute(p, (it % (BATCH * 8)) * RK_NCH + it / (BATCH * 8), smem);
}

DEV bf16x8 ld_frag2(const unsigned short* p0, const unsigned short* p1) {
  const uint2 lo = *(const uint2*)p0, hi = *(const uint2*)p1;
  union { uint4 u; bf16x8 v; } x;
  x.u = make_uint4(lo.x, lo.y, hi.x, hi.y);
  return x.v;
}
DEV bf16x8 ld_frag(const unsigned short* p0) {
  union { uint4 u; bf16x8 v; } x;
  x.u = *(const uint4*)p0;
  return x.v;
}
DEV unsigned rk_flag_ld(const unsigned* f) {
#if RK_MERGED
  return __hip_atomic_load(f, __ATOMIC_RELAXED, __HIP_MEMORY_SCOPE_AGENT);
#else
  return 1u;
#endif
}
DEV void rk_flag_wait(const unsigned* f, unsigned flv) {
#if RK_MERGED
  asm volatile("" : "+v"(flv));
  unsigned fl = (unsigned)__builtin_amdgcn_readfirstlane((int)flv);
  unsigned sp = 0;
  while (fl == 0u) {
    __builtin_amdgcn_s_sleep(1);
    fl = (unsigned)__builtin_amdgcn_readfirstlane((int)__hip_atomic_load(f, __ATOMIC_RELAXED, __HIP_MEMORY_SCOPE_AGENT));
    if (++sp > (1u << 21)) break;
  }
  asm volatile("buffer_inv sc1" ::: "memory");
#endif
}
#define RK_PREFETCH(S, c_)                                                                                                      \
  {                                                                                                                             \
    const size_t chp_ = (size_t)bh * RK_NCH + (c_);                                                                             \
    _Pragma("unroll") for (int jt = 0; jt < 2; ++jt) _Pragma("unroll") for (int kb = 0; kb < 2; ++kb)                          \
        _Pragma("unroll") for (int s_ = 0; s_ < 2; ++s_) {                                                                      \
      const unsigned short* q0 = PTb + (chp_ * 64 + jt * 32 + r) * 64 + kb * 32 + 16 * s_ + 4 * hh;                             \
      pa##S[jt][kb][s_] = ld_frag2(q0, q0 + 8);                                                                                 \
    }                                                                                                                           \
    _Pragma("unroll") for (int jt = 0; jt < 2; ++jt) _Pragma("unroll") for (int ks = 0; ks < 2; ++ks)                          \
        ka##S[jt][ks] = ld_frag(KTb + (chp_ * 64 + jt * 32 + r) * 32 + 16 * ks + 8 * hh);                                       \
    _Pragma("unroll") for (int ks = 0; ks < 2; ++ks) vb##S[ks] = ld_frag(VTb + (chp_ * 64 + it * 32 + r) * 32 + 16 * ks + 8 * hh); \
  }
#define RK_STEP(S, c_)                                                                                                          \
  {                                                                                                                             \
    unsigned short* scr_ = rksc_row(p.ws, bh >> 3, bh & 7, (c_), it * 32 + r);                                                  \
    _Pragma("unroll") for (int kb = 0; kb < 2; ++kb) _Pragma("unroll") for (int g4 = 0; g4 < 4; ++g4)                          \
        *(uint2*)(scr_ + kb * 32 + 8 * g4 + 4 * hh) =                                                                           \
            make_uint2(pk2(X[kb][4 * g4], X[kb][4 * g4 + 1]), pk2(X[kb][4 * g4 + 2], X[kb][4 * g4 + 3]));                       \
    bf16x8 bh_[2][2], bl_[2][2];                                                                                                \
    _Pragma("unroll") for (int kb = 0; kb < 2; ++kb) _Pragma("unroll") for (int s_ = 0; s_ < 2; ++s_) {                        \
      union { uint4 u; bf16x8 v; } hi, lo;                                                                                      \
      unsigned hw[4], lw[4];                                                                                                    \
      _Pragma("unroll") for (int q2 = 0; q2 < 4; ++q2) {                                                                        \
        const float x0 = X[kb][8 * s_ + 2 * q2], x1 = X[kb][8 * s_ + 2 * q2 + 1];                                               \
        const unsigned hp = pk2(x0, x1);                                                                                        \
        hw[q2] = hp;                                                                                                            \
        lw[q2] = pk2(x0 - bf2f((unsigned short)(hp & 0xFFFF)), x1 - bf2f((unsigned short)(hp >> 16)));                          \
      }                                                                                                                         \
      hi.u = make_uint4(hw[0], hw[1], hw[2], hw[3]); lo.u = make_uint4(lw[0], lw[1], lw[2], lw[3]);                             \
      bh_[kb][s_] = hi.v; bl_[kb][s_] = lo.v;                                                                                   \
    }                                                                                                                           \
    f32x16 acc[2];                                                                                                              \
    _Pragma("unroll") for (int jt = 0; jt < 2; ++jt) {                                                                          \
      _Pragma("unroll") for (int i = 0; i < 16; ++i) acc[jt][i] = 0.f;                                                          \
      _Pragma("unroll") for (int kb = 0; kb < 2; ++kb) _Pragma("unroll") for (int s_ = 0; s_ < 2; ++s_) {                      \
        acc[jt] = __builtin_amdgcn_mfma_f32_32x32x16_bf16(pa##S[jt][kb][s_], bh_[kb][s_], acc[jt], 0, 0, 0);                    \
        acc[jt] = __builtin_amdgcn_mfma_f32_32x32x16_bf16(pa##S[jt][kb][s_], bl_[kb][s_], acc[jt], 0, 0, 0);                    \
      }                                                                                                                         \
      _Pragma("unroll") for (int ks = 0; ks < 2; ++ks)                                                                          \
          acc[jt] = __builtin_amdgcn_mfma_f32_32x32x16_bf16(ka##S[jt][ks], vb##S[ks], acc[jt], 0, 0, 0);                        \
    }                                                                                                                           \
    if ((c_) + 2 < RK_NCH) {                                                                                                    \
      rk_flag_wait(RKFb + (c_) + 2, fl##S);                                                                                     \
      fl##S = rk_flag_ld(RKFb + ((c_) + 4 < RK_NCH ? (c_) + 4 : RK_NCH - 1));          \
      RK_PREFETCH(S, (c_) + 2);                                                                                                 \
    }                                                                                                                           \
    X[0] = acc[0]; X[1] = acc[1];                                                                                               \
  }
DEV void rk_chain(const Params& p, int bh) {
  const int tid = TIDX, lane = tid & 63, wave = tid >> 6;
  if (wave >= 2) return;
  const int r = lane & 31, hh = lane >> 5, it = wave;
  const unsigned short* PTb = (const unsigned short*)(p.ws + OFF_RKPT);
  const unsigned short* KTb = (const unsigned short*)(p.ws + OFF_RKKT);
  const unsigned short* VTb = (const unsigned short*)(p.ws + OFF_RKVT);
  const unsigned* RKFb = (const unsigned*)(p.ws + OFF_RKF) + (size_t)bh * RK_NCH;
  f32x16 X[2];
#pragma unroll
  for (int kb = 0; kb < 2; ++kb)
#pragma unroll
    for (int i = 0; i < 16; ++i) X[kb][i] = 0.f;
  bf16x8 paA[2][2][2], kaA[2][2], vbA[2], paB[2][2][2], kaB[2][2], vbB[2];
  rk_flag_wait(RKFb, rk_flag_ld(RKFb));
  RK_PREFETCH(A, 0);
  rk_flag_wait(RKFb + 1, rk_flag_ld(RKFb + 1));
  RK_PREFETCH(B, 1);
  unsigned flA = rk_flag_ld(RKFb + 2), flB = rk_flag_ld(RKFb + 3);
  for (int c = 0; c < RK_NCH; c += 2) {
    RK_STEP(A, c);
    if (c + 1 < RK_NCH) RK_STEP(B, c + 1);
  }
}
DEV void rk_output(const Params& p, int item) {
  const int tid = TIDX, lane = tid & 63, wave = tid >> 6;
  const int ch = item * 4 + wave;
  const int c = ch % RK_NCH, bhh = ch / RK_NCH, h = bhh & 7, b = bhh >> 3;
  const int r = lane & 31, hh = lane >> 5;
  const unsigned short* RT = (const unsigned short*)(p.ws + OFF_RKRT) + (size_t)ch * 32 * 64;
  const unsigned short* AT = (const unsigned short*)(p.ws + OFF_RKAT) + (size_t)ch * 32 * 32;
  const unsigned short* VT = (const unsigned short*)(p.ws + OFF_RKVT) + (size_t)ch * 64 * 32;
  f32x16 acc[2];
#pragma unroll
  for (int i2 = 0; i2 < 2; ++i2)
#pragma unroll
    for (int i = 0; i < 16; ++i) acc[i2][i] = 0.f;
#pragma unroll
  for (int ks = 0; ks < 4; ++ks) {
    const bf16x8 a = ld_frag(RT + r * 64 + 16 * ks + 8 * hh);
#pragma unroll
    for (int i2 = 0; i2 < 2; ++i2) acc[i2] = __builtin_amdgcn_mfma_f32_32x32x16_bf16(a, ld_frag(rksc_row(p.ws, b, h, c, i2 * 32 + r) + 16 * ks + 8 * hh), acc[i2], 0, 0, 0);
  }
#pragma unroll
  for (int ks = 0; ks < 2; ++ks) {
    const bf16x8 a = ld_frag(AT + r * 32 + 16 * ks + 8 * hh);
#pragma unroll
    for (int i2 = 0; i2 < 2; ++i2) acc[i2] = __builtin_amdgcn_mfma_f32_32x32x16_bf16(a, ld_frag(VT + (i2 * 32 + r) * 32 + 16 * ks + 8 * hh), acc[i2], 0, 0, 0);
  }
  float* Yo = (float*)(p.ws + OFF_MIX);
  const size_t tok0 = (size_t)b * SEQ_LEN + (size_t)c * RK_T;
#pragma unroll
  for (int i2 = 0; i2 < 2; ++i2)
#pragma unroll
    for (int i = 0; i < 16; ++i) {
      const int t = (i & 3) + 8 * (i >> 2) + 4 * hh;
      Yo[(tok0 + t) * 1024 + h * 64 + i2 * 32 + r] = acc[i2][i];
    }
}
#define OFF_RWG OFF_RWKK
DEV void phase_rkout(const Params& p, char* smem) {
  {
    const float* GLO = (const float*)(p.ws + OFF_GLO);
    const float* g_up = p.in[I_RW_G_UP];
    float* G = (float*)(p.ws + OFF_RWG);
    for (int t = BIDX; t < (NTOK / GEMM_BM) * 4; t += gridDim.x) {
      const int m0 = (t >> 2) * GEMM_BM, n0 = (t & 3) * 128;
      gemm_tile<false>(
          [&](int r) { return (const void*)(GLO + (size_t)(m0 + r) * 128); },
          [&](int c) { return g_up + n0 + c; }, 512, 128,
          [&](int row, int col, float v0, float v1) {
            const size_t o = (size_t)(m0 + row) * 512 + n0 + col;
            G[o] = v0; G[o + 32] = v1;
          },
          smem);
    }
  }
  for (int it = BIDX; it < RK_NCHT / 4; it += gridDim.x) rk_output(p, it);
}

#define P12_SCAN_ITEMS (BATCH * 8 * 4)
#define P12_RET_ITEMS (BATCH * 4 * RET_NC)
#define P12_SCAN_SMEM ((2 * (16 * 5 * 64 + 16 * 16) + 16 * 16) * 4)
#define P12_RET_SMEM ((64 * 72 + 2 * 64 * 68) * 2)
#define P12_SMEM (P12_SCAN_SMEM > P12_RET_SMEM ? P12_SCAN_SMEM : P12_RET_SMEM)
DEV float sum16(float v) {
#ifdef CPU_EMU
  return emu_sum16(v);
#else
  int x;
  x = __builtin_amdgcn_update_dpp(0, __builtin_bit_cast(int, v), 0xB1, 0xF, 0xF, false); v += __builtin_bit_cast(float, x);
  x = __builtin_amdgcn_update_dpp(0, __builtin_bit_cast(int, v), 0x4E, 0xF, 0xF, false); v += __builtin_bit_cast(float, x);
  x = __builtin_amdgcn_update_dpp(0, __builtin_bit_cast(int, v), 0x141, 0xF, 0xF, false); v += __builtin_bit_cast(float, x);
  x = __builtin_amdgcn_update_dpp(0, __builtin_bit_cast(int, v), 0x140, 0xF, 0xF, false); v += __builtin_bit_cast(float, x);
  return v;
#endif
}
DEV void p12_scan(const Params& p, int item, char* smem) {
  const int rq = item & 3, h = (item >> 2) & 7, b = item >> 5;
  const int tid = TIDX, rl = tid >> 4, cg = tid & 15;
  const float* ARR[5] = {(const float*)(p.ws + OFF_RWW), (const float*)(p.ws + OFF_RWK), (const float*)(p.ws + OFF_RWKK),
                         (const float*)(p.ws + OFF_RWA), p.out + (size_t)NTOK * 512};
  const float* RWV = p.out;
  float* Yo = (float*)(p.ws + OFF_MIX);
  float* buf = (float*)smem;
  float* vbuf = buf + 2 * 16 * 5 * 64;
  float* ybuf = vbuf + 2 * 16 * 16;
  float S[4] = {0.f, 0.f, 0.f, 0.f};
  float4 rg[5]; float rv;
  const int lstep = tid >> 4, lc4 = tid & 15;
  auto gload = [&](int c) {
    const size_t o = ((size_t)b * SEQ_LEN + c * 16 + lstep) * 512 + h * 64;
#pragma unroll
    for (int a = 0; a < 5; ++a) rg[a] = ld4(ARR[a] + o + lc4 * 4);
    rv = RWV[o + rq * 16 + lc4];
  };
  auto sstore = [&](int bi) {
#pragma unroll
    for (int a = 0; a < 5; ++a) st4(buf + ((bi * 16 + lstep) * 5 + a) * 64 + lc4 * 4, rg[a]);
    vbuf[(bi * 16 + lstep) * 16 + lc4] = rv;
  };
  __syncthreads();
  gload(0);
  sstore(0);
  __syncthreads();
  const int NCH = SEQ_LEN / 16;
  for (int c = 0; c < NCH; ++c) {
    if (c + 1 < NCH) gload(c + 1);
    const float* cb = buf + (c & 1) * 16 * 5 * 64;
    const float* cv = vbuf + (c & 1) * 16 * 16;
    float4 cw = ld4(cb + 0 * 64 + cg * 4), ck = ld4(cb + 1 * 64 + cg * 4), ckk = ld4(cb + 2 * 64 + cg * 4),
           cka = ld4(cb + 3 * 64 + cg * 4), cr = ld4(cb + 4 * 64 + cg * 4);
    float cvv = cv[rl];
#pragma unroll
    for (int s = 0; s < 16; ++s) {
      const float4 w = cw, k = ck, kk = ckk, ka = cka, r = cr;
      const float v = cvv;
      if (s < 15) {
        cw = ld4(cb + ((s + 1) * 5 + 0) * 64 + cg * 4); ck = ld4(cb + ((s + 1) * 5 + 1) * 64 + cg * 4);
        ckk = ld4(cb + ((s + 1) * 5 + 2) * 64 + cg * 4); cka = ld4(cb + ((s + 1) * 5 + 3) * 64 + cg * 4);
        cr = ld4(cb + ((s + 1) * 5 + 4) * 64 + cg * 4); cvv = cv[(s + 1) * 16 + rl];
      }
      float sa = (S[0] * kk.x + S[1] * kk.y) + (S[2] * kk.z + S[3] * kk.w);
      sa = -sum16(sa);
      S[0] = S[0] * w.x + (sa * ka.x + v * k.x);
      S[1] = S[1] * w.y + (sa * ka.y + v * k.y);
      S[2] = S[2] * w.z + (sa * ka.z + v * k.z);
      S[3] = S[3] * w.w + (sa * ka.w + v * k.w);
      float y = (S[0] * r.x + S[1] * r.y) + (S[2] * r.z + S[3] * r.w);
      y = sum16(y);
      if (cg == 0) ybuf[s * 16 + rl] = y;
      asm volatile("" ::: "memory");
    }
    __syncthreads();
    if (c + 1 < NCH) sstore((c + 1) & 1);
    Yo[((size_t)b * SEQ_LEN + c * 16 + lstep) * 1024 + h * 64 + rq * 16 + lc4] = ybuf[lstep * 16 + lc4];
    __syncthreads();
  }
}
struct RetSmem { unsigned short k[64][72]; unsigned short vt[2][64][68]; };
#define RETPFX_ITEMS (BATCH * 4 * 64 * 128 / NTHREADS)
DEV void ret_prefix(const Params& p, int item) {
  const int gi = item * NTHREADS + TIDX;
  const int bh4 = gi >> 13, idx = gi & 8191;
  const float G = exp2f(128.f * ret_log2gamma(bh4 & 3));
  float* KV = (float*)(p.ws + OFF_RETKV) + (size_t)bh4 * RET_NC * 8192 + idx;
  float st = 0.f;
  int c = 0;
  for (; c + 8 <= RET_NC; c += 8) {
    float e[8];
#pragma unroll
    for (int q = 0; q < 8; ++q) e[q] = KV[(size_t)(c + q) * 8192];
#pragma unroll
    for (int q = 0; q < 8; ++q) { KV[(size_t)(c + q) * 8192] = st; st = st * G + e[q]; }
  }
  for (; c < RET_NC; ++c) { const float e = KV[(size_t)c * 8192]; KV[(size_t)c * 8192] = st; st = st * G + e; }
}
DEV void phase_retpfx(const Params& p, char* smem) {
  for (int it = BIDX; it < RETPFX_ITEMS; it += gridDim.x) ret_prefix(p, it);
}
DEV void p12_ret(const Params& p, int item, char* smem) {
  RetSmem* sm = (RetSmem*)smem;
  const int c = item % RET_NC, h = (item / RET_NC) & 3, b = item / (RET_NC * 4);
  const int tid = TIDX, lane = tid & 63, wave = tid >> 6;
  const int cidx = lane & 31, hh = lane >> 5;
  const int qi = wave * 32 + cidx;
  const float* H2 = (const float*)(p.ws + OFF_H2);
  const float lg = ret_log2gamma(h);
  const size_t tok0 = (size_t)b * SEQ_LEN + c * 128;
  bf16x8 qf[4], qfs[4];
  {
    const float* qr = H2 + (tok0 + qi) * 1536 + h * 64;
    const float qs = exp2f((float)(qi + 1) * lg);
#pragma unroll
    for (int ks = 0; ks < 4; ++ks) {
      const float4 a0 = ld4(qr + ks * 16 + hh * 8), a1 = ld4(qr + ks * 16 + hh * 8 + 4);
      const float v[8] = {a0.x, a0.y, a0.z, a0.w, a1.x, a1.y, a1.z, a1.w};
#pragma unroll
      for (int j = 0; j < 8; ++j) { qf[ks][j] = (short)f2bf(v[j]); qfs[ks][j] = (short)f2bf(v[j] * qs); }
    }
  }
  f32x16 o[4], s[2];
#pragma unroll
  for (int mt = 0; mt < 4; ++mt)
#pragma unroll
    for (int i = 0; i < 16; ++i) o[mt][i] = 0.f;
  {
    const float* KV0 = (const float*)(p.ws + OFF_RETKV) + (size_t)((b * 4 + h) * RET_NC) * 64 * 128;
#pragma unroll
    for (int eh = 0; eh < 2; ++eh) {
      __syncthreads();
      {
        const int el = tid & 63, d0 = tid >> 6;
        float stv[16];
#pragma unroll
        for (int i = 0; i < 16; ++i) stv[i] = KV0[(size_t)c * 64 * 128 + (d0 + 4 * i) * 128 + eh * 64 + el];
#pragma unroll
        for (int i = 0; i < 16; ++i) sm->k[el][d0 + 4 * i] = f2bf(stv[i]);
      }
      __syncthreads();
      qk_tile(sm->k, qfs, s, lane);
#pragma unroll
      for (int i = 0; i < 16; ++i) { o[eh * 2][i] += s[0][i]; o[eh * 2 + 1][i] += s[1][i]; }
    }
  }
#pragma unroll 1
  for (int kt = 0; kt < 2; ++kt) {
    __syncthreads();
    {
      const int row = tid >> 2, seg = tid & 3;
      const float* kr = H2 + (tok0 + kt * 64 + row) * 1536 + 256 + h * 64 + seg * 16;
      const float4 a0 = ld4(kr), a1 = ld4(kr + 4), a2 = ld4(kr + 8), a3 = ld4(kr + 12);
      *(uint4*)&sm->k[row][seg * 16] = make_uint4(pk2(a0.x, a0.y), pk2(a0.z, a0.w), pk2(a1.x, a1.y), pk2(a1.z, a1.w));
      *(uint4*)&sm->k[row][seg * 16 + 8] = make_uint4(pk2(a2.x, a2.y), pk2(a2.z, a2.w), pk2(a3.x, a3.y), pk2(a3.z, a3.w));
#pragma unroll
      for (int q = 0; q < 8; ++q) {
        const int f = tid + 256 * q;
        const int key = f >> 5, d4 = (f & 31) * 4;
        const float4 v = ld4(H2 + (tok0 + kt * 64 + key) * 1536 + 512 + h * 128 + d4);
        unsigned short(*vt)[68] = sm->vt[d4 >> 6];
        const int dl = d4 & 63;
        vt[dl][key] = f2bf(v.x); vt[dl + 1][key] = f2bf(v.y); vt[dl + 2][key] = f2bf(v.z); vt[dl + 3][key] = f2bf(v.w);
      }
    }
    __syncthreads();
    if (kt * 64 <= wave * 32 + 31) {
      qk_tile(sm->k, qf, s, lane);
#pragma unroll
      for (int ks2 = 0; ks2 < 2; ++ks2)
#pragma unroll
        for (int i = 0; i < 16; ++i) {
          const int kj = kt * 64 + ks2 * 32 + (i & 3) + 8 * (i >> 2) + 4 * hh;
          s[ks2][i] = kj <= qi ? s[ks2][i] * exp2f((float)(qi - kj) * lg) : 0.f;
        }
      pv_tile(sm->vt[0], s, *(f32x16(*)[2])&o[0], lane);
      pv_tile(sm->vt[1], s, *(f32x16(*)[2])&o[2], lane);
    }
  }
  float s1 = 0.f;
#pragma unroll
  for (int mt = 0; mt < 4; ++mt)
#pragma unroll
    for (int i = 0; i < 16; ++i) s1 += o[mt][i];
  s1 += __shfl_xor(s1, 32);
  const float mu = s1 * (1.f / 128.f);
  float s2 = 0.f;
#pragma unroll
  for (int mt = 0; mt < 4; ++mt)
#pragma unroll
    for (int i = 0; i < 16; ++i) { const float d = o[mt][i] - mu; s2 += d * d; }
  s2 += __shfl_xor(s2, 32);
  const float rstd = rsqrtf(s2 * (1.f / 128.f) + 1e-5f);
  float* MIX = (float*)(p.ws + OFF_MIX);
  const float* gate = H2 + (tok0 + qi) * 1536 + 1024 + h * 128;
  float* dst = MIX + (tok0 + qi) * 1024 + 512 + h * 128;
  const float* lgam = p.in[I_RET_LN_G] + h * 128;
  const float* lbet = p.in[I_RET_LN_B] + h * 128;
#pragma unroll
  for (int mt = 0; mt < 4; ++mt)
#pragma unroll
    for (int g4 = 0; g4 < 4; ++g4) {
      const int dv = mt * 32 + 8 * g4 + 4 * hh;
      const float4 gv = ld4(lgam + dv), bv = ld4(lbet + dv), gt = ld4(gate + dv);
      float4 ov;
      ov.x = siluf_(gt.x) * ((o[mt][4 * g4] - mu) * rstd * gv.x + bv.x);
      ov.y = siluf_(gt.y) * ((o[mt][4 * g4 + 1] - mu) * rstd * gv.y + bv.y);
      ov.z = siluf_(gt.z) * ((o[mt][4 * g4 + 2] - mu) * rstd * gv.z + bv.z);
      ov.w = siluf_(gt.w) * ((o[mt][4 * g4 + 3] - mu) * rstd * gv.w + bv.w);
      st4(dst + dv, ov);
    }
}
DEV void phase_p12(const Params& p, char* smem) {
  const int G = gridDim.x;
  const int bid = BIDX;
  if (bid < BATCH * 8 && G > BATCH * 8) {
    rk_chain(p, bid);
  } else if (G >= 8 * BATCH * 8) {
    const int Gh = G >> 1, NC = BATCH * 8;
    if (bid >= Gh && bid < Gh + NC) return;
    const int w = bid - NC - (bid >= Gh ? NC : 0);
#if RK_MERGED
    if ((G & 15) == 0 && BATCH * 8 == 16) {
      const int x = bid & 7, m = bid >> 3;
      const int rank = m - 2 - (m >= (Gh >> 3) ? 2 : 0), nprod = (G >> 3) - 4;
      for (int k = rank; k < 2 * RK_NCH; k += nprod) rk_precompute(p, (x + 8 * (k & 1)) * RK_NCH + (k >> 1), smem);
    } else {
      for (int it = w; it < RK_NCHT; it += G - 2 * NC) rk_precompute(p, (it % NC) * RK_NCH + it / NC, smem);
    }
#endif
    for (int it = w; it < P12_RET_ITEMS; it += G - 2 * NC) p12_ret(p, it, smem);
  } else if (G > BATCH * 8) {
    for (int it = bid - BATCH * 8; it < P12_RET_ITEMS; it += G - BATCH * 8) p12_ret(p, it, smem);
  } else {
    for (int it = bid; it < BATCH * 8 + P12_RET_ITEMS; it += G) {
      if (it < BATCH * 8) rk_chain(p, it);
      else p12_ret(p, it - BATCH * 8, smem);
    }
  }
}

#define P13_SMEM (RWP_T * 128 * 4)
DEV void phase_p13(const Params& p, char* smem) {
  const int tid = TIDX;
  const float* Hc = (const float*)(p.ws + OFF_H);
  const float* mu = p.in[I_RW_MU];
  const float* GLO = (const float*)(p.ws + OFF_GLO);
  float* sl = (float*)smem;
  float* MIX = (float*)(p.ws + OFF_MIX);
  const float* RWK = (const float*)(p.ws + OFF_RWK); const float* RWR = p.out + (size_t)NTOK * 512; const float* RWV = p.out;
  const float* G = (const float*)(p.ws + OFF_RWG);
  for (int it = BIDX; it < NTOK / RWP_T; it += gridDim.x) {
#pragma unroll
    for (int cc = 0; cc < 2; ++cc) {
      const int c = tid + 256 * cc;
      const float lng = p.in[I_RW_LN_G][c], lnb = p.in[I_RW_LN_B][c], rk = p.in[I_RW_R_K][c];
#pragma unroll 4
      for (int tt = 0; tt < RWP_T; ++tt) {
        const size_t tok = (size_t)it * RWP_T + tt;
        const float y = MIX[tok * 1024 + c];
        const float m = wave_sum(y) * (1.f / 64.f);
        const float d = y - m;
        const float var = wave_sum(d * d) * (1.f / 64.f);
        const float yn = d * rsqrtf(var + 64e-5f) * lng + lnb;
        const float r = RWR[tok * 512 + c], k = RWK[tok * 512 + c], v = RWV[tok * 512 + c];
        const float bonus = wave_sum(r * k * rk) * v;
        MIX[tok * 1024 + c] = (yn + bonus) * G[tok * 512 + c];
      }
    }
  }
}

#define NPHASES 20
#define SMEM_BYTES 53248
DEV void run_phase(const Params& p, int ph, char* smem) {
  switch (ph) {
    case 0: phase_gemm_in<0>(p, smem); break;
    case 1: phase_p1(p, smem); break;
    case 2: phase_p2(p, smem); break;
    case 3: phase_glu(p, smem); break;
    case 4: phase_outproj<0>(p, smem); break;
    case 5: phase_ln_router<0>(p, smem); break;
    case 6: phase_lists_shup<0>(p, smem); break;
    case 7: phase_routed_up<0>(p, smem); break;
    case 8: phase_down<0>(p, smem); break;
    case 9: phase_combine<0>(p, smem); break;
    case 10: phase_gemm_in<1>(p, smem); break;
    case 11: phase_p11(p, smem); break;
    case 12: phase_p12(p, smem); break;
    case 13: phase_p13(p, smem); break;
    case 14: phase_outproj<1>(p, smem); break;
    case 15: phase_ln_router<1>(p, smem); break;
    case 16: phase_lists_shup<1>(p, smem); break;
    case 17: phase_routed_up<1>(p, smem); break;
    case 18: phase_down<1>(p, smem); break;
    case 19: phase_combine<1>(p, smem); break;
    case 20: phase_p1b(p, smem); break;
    case 21: phase_rkpre(p, smem); break;
    case 22: phase_rkout(p, smem); break;
    case 24: phase_retpfx(p, smem); break;
  }
}
static_assert(P1_SMEM <= SMEM_BYTES, "smem");
static_assert(P1_PREP_SMEM <= SMEM_BYTES, "smem");
static_assert(P2_SMEM <= SMEM_BYTES, "smem");
static_assert(P5_SMEM <= SMEM_BYTES, "smem");
static_assert(P7_SMEM <= SMEM_BYTES, "smem");
static_assert(P12_SMEM <= SMEM_BYTES, "smem");
static_assert(RKPRE_SMEM <= SMEM_BYTES, "smem");
static_assert(OFF_HS + (size_t)NTOK * 256 * 2 <= OFF_X1, "layout");

#ifndef CPU_EMU
template <int PH>
__global__ void __launch_bounds__(NTHREADS) phase_kernel(Params p) {
  __shared__ __attribute__((aligned(16))) char smem[SMEM_BYTES];
  run_phase(p, PH, smem);
}
template <int PH>
static void launch_phases(const Params& p, hipStream_t stream) {
  phase_kernel<PH><<<dim3(1024), dim3(NTHREADS), 0, stream>>>(p);
  if constexpr (PH + 1 < NPHASES) launch_phases<PH + 1>(p, stream);
}
#if MEGA
#define XB_TMO      128
#define XB_XCNT(j)  (256  + 64 * (j))
#define XB_XSUB(j)  (1280 + 64 * (j))
#define XB_XGEN(j)  (2304 + 64 * (j))
#define XB_TOP      3328
#define XB_TOPGEN   3392
#define XCD_BAR_WORDS 3456
#define XB_SPIN_CAP (1u << 18)
#define LAS __attribute__((address_space(3)))

__device__ __forceinline__ unsigned xb_ld(unsigned* p)              { return __hip_atomic_load(p, __ATOMIC_RELAXED, __HIP_MEMORY_SCOPE_AGENT); }
__device__ __forceinline__ unsigned xb_add(unsigned* p, unsigned v) { return __hip_atomic_fetch_add(p, v, __ATOMIC_RELAXED, __HIP_MEMORY_SCOPE_AGENT); }
__device__ __forceinline__ unsigned xb_xcc_id() { return (unsigned)__builtin_amdgcn_s_getreg((3 << 11) | 20) & 0xFu; }
#define XB_SPIN(cond, bar) do { unsigned _sp = 0; while (cond) { __builtin_amdgcn_s_sleep(1); \
    if ((++_sp & 255u) == 0u) { if (xb_ld(&(bar)[XB_TMO])) break; if (_sp > XB_SPIN_CAP) { atomicAdd(&(bar)[XB_TMO], 1u); break; } } } } while (0)

struct XcdBarrier {
    unsigned* bar; unsigned x;
    volatile LAS unsigned* st;
};

__device__ __forceinline__ XcdBarrier xcd_barrier_post(unsigned* bar, volatile LAS unsigned* st) {
    XcdBarrier b; b.bar = bar; b.x = xb_xcc_id(); b.st = st;
    if (threadIdx.x == 0) (void)xb_add(&bar[XB_XCNT(b.x)], 1u);
    return b;
}
__device__ __forceinline__ void xcd_barrier_complete(unsigned* bar, unsigned x, unsigned& nloc, unsigned& nx) {
    const unsigned G = gridDim.x * gridDim.y * gridDim.z;
    unsigned sum, cnt, mine, sp = 0u;
    for (;;) {
        sum = 0u; cnt = 0u; mine = 0u;
#pragma unroll
        for (unsigned j = 0; j < 16; ++j) { const unsigned c = xb_ld(&bar[XB_XCNT(j)]); sum += c; cnt += (c > 0u) ? 1u : 0u; mine = (j == x) ? c : mine; }
        if (sum == G) break;
        __builtin_amdgcn_s_sleep(1);
        if ((++sp & 255u) == 0u) { if (xb_ld(&bar[XB_TMO])) break; if (sp > XB_SPIN_CAP) { atomicAdd(&bar[XB_TMO], 1u); break; } }
    }
    nloc = mine > 0u ? mine : 1u; nx = cnt > 0u ? cnt : 1u;
}

__device__ __forceinline__ void xcd_barrier(const XcdBarrier& b) {
    asm volatile("s_waitcnt vmcnt(0)" ::: "memory");
    __syncthreads();
    if (threadIdx.x == 0) {
        unsigned* bar = b.bar;
        __builtin_amdgcn_s_waitcnt(0);
        unsigned nloc = b.st[0], nx = b.st[1];
        if (nloc == 0u) { xcd_barrier_complete(bar, b.x, nloc, nx); b.st[0] = nloc; b.st[1] = nx; }
        const unsigned old = xb_add(&bar[XB_XSUB(b.x)], 1u);
        const unsigned gen = old / nloc;
        if (old + 1u == (gen + 1u) * nloc) {
            __builtin_amdgcn_fence(__ATOMIC_RELEASE, "agent");
            asm volatile("s_waitcnt vmcnt(0)" ::: "memory");
            const unsigned og = xb_add(&bar[XB_TOP], 1u);
            const unsigned tg = og / nx;
            if (og + 1u == (tg + 1u) * nx) xb_add(&bar[XB_TOPGEN], 1u);
            else XB_SPIN(xb_ld(&bar[XB_TOPGEN]) == tg, bar);
            __builtin_amdgcn_fence(__ATOMIC_ACQUIRE, "agent");
            xb_add(&bar[XB_XGEN(b.x)], 1u);
            asm volatile("s_waitcnt vmcnt(0)" ::: "memory");
        } else {
            XB_SPIN(xb_ld(&bar[XB_XGEN(b.x)]) == gen, bar);
            __builtin_amdgcn_fence(__ATOMIC_ACQUIRE, "agent");
            asm volatile("s_waitcnt vmcnt(0)" ::: "memory");
        }
    }
    __syncthreads();
}


__global__ void __launch_bounds__(NTHREADS, 2) mega_kernel(Params p) {
  __shared__ __attribute__((aligned(16))) char smem[SMEM_BYTES];
  unsigned* bar = (unsigned*)(p.ws + OFF_BAR);
  __shared__ uint4 xb_words;
  if (threadIdx.x == 0) xb_words = make_uint4(0u, 0u, 0u, 0u);
  __syncthreads();
  XcdBarrier xb = xcd_barrier_post(bar, (volatile LAS unsigned*)&xb_words);
  if (p.ws == nullptr) cg::this_grid().sync();
  typedef const __attribute__((address_space(4))) Params* KParams;
#define PH_(n) { KParams kp = (KParams)__builtin_amdgcn_kernarg_segment_ptr(); asm volatile("" : "+s"(kp)); const Params lp = *(const Params*)kp; run_phase(lp, n, smem); } xcd_barrier(xb);
  PH_(0) PH_(1) PH_(20) PH_(2) PH_(3) PH_(4) PH_(5) PH_(6) PH_(7) PH_(8) PH_(9)
  PH_(10) PH_(11) PH_(24) PH_(12) PH_(22) PH_(13) PH_(14) PH_(15) PH_(16) PH_(17) PH_(18)
  { KParams kp = (KParams)__builtin_amdgcn_kernarg_segment_ptr(); asm volatile("" : "+s"(kp)); const Params lp = *(const Params*)kp; run_phase(lp, 19, smem); }
}

#endif

extern "C" void kernel_launch(void* const* d_in, const int* in_sizes, int n_in, void* d_out, int out_size, void* d_ws, size_t ws_size,
                              hipStream_t stream) {
  Params p;
  for (int i = 0; i < N_INPUTS; ++i) p.in[i] = (const float*)d_in[i];
  p.out = (float*)d_out;
  p.ws = (char*)d_ws;
#if MEGA
  static int grid_blocks = 0;
  if (!grid_blocks) {
    int dev = 0, cus = 0, per_cu = 0;
    hipGetDevice(&dev);
    hipDeviceGetAttribute(&cus, hipDeviceAttributeMultiprocessorCount, dev);
    hipOccupancyMaxActiveBlocksPerMultiprocessor(&per_cu, mega_kernel, NTHREADS, 0);
    if (per_cu > 2) per_cu = 2;
    grid_blocks = cus * per_cu;
  }
  hipMemsetAsync((char*)d_ws + OFF_BAR, 0, 16384, stream);
  void* args[] = {&p};
  hipError_t e = hipLaunchCooperativeKernel((void*)mega_kernel, dim3(grid_blocks), dim3(NTHREADS), args, 0, stream);
  if (e != hipSuccess) fprintf(stderr, "cooperative launch failed: %s (grid %d)\n", hipGetErrorString(e), grid_blocks);
#else
  launch_phases<0>(p, stream);
#endif
}
#endif
```

```cpp
#ifdef CPU_EMU
#include "emu.h"
#else
#include <hip/hip_runtime.h>
#include <hip/hip_cooperative_groups.h>
#include <cstdio>
namespace cg = cooperative_groups;
#endif
#include <stdint.h>

#ifndef BATCH
#define BATCH 2
#endif
#ifndef SEQ_LEN
#define SEQ_LEN 8192
#endif
#ifndef MEGA
#define MEGA 1
#endif
#if MEGA && !defined(CPU_EMU)
#define RK_MERGED 1
#else
#define RK_MERGED 0
#endif

#define DEV __device__ __forceinline__
#ifdef CPU_EMU
#define TIDX ((int)threadIdx.x)
#define BIDX ((int)blockIdx.x)
#else
__device__ __forceinline__ int tidx_() { int t = __builtin_amdgcn_workitem_id_x(); asm volatile("" : "+v"(t)); return t; }
__device__ __forceinline__ int bidx_() { int b = __builtin_amdgcn_workgroup_id_x(); asm volatile("" : "+s"(b)); return b; }
#define TIDX tidx_()
#define BIDX bidx_()
#endif
#define NTOK (BATCH * SEQ_LEN)
#define DM 1024
#define AB_IN 1816
#define AB_LD 1824
#define CD_IN 3328
#define NCMP ((SEQ_LEN - 32) / 16 + 1)
#define NBLK (SEQ_LEN / 64)
#define NB_CMP ((NCMP + 63) / 64)
#define S5_NC (SEQ_LEN / 64)
#define RET_NC (SEQ_LEN / 128)
#define ALPHA_F 1.4142135623730951f
#define NTHREADS 256

enum { I_X = 0, I_AB_W_IN, I_AB_W_OUT, I_S5_LAM_RE, I_S5_LAM_IM, I_S5_LOG_DT, I_S5_B_RE, I_S5_B_IM, I_S5_C_RE, I_S5_C_IM,
       I_S5_D, I_S5_W_GLU, I_S5_B_GLU, I_PE_K, I_PE_V, I_CK_W1, I_CK_B1, I_CK_W2, I_CV_W1, I_CV_B1, I_CV_W2,
       I_CD_W_IN, I_CD_W_OUT, I_RW_MU, I_RW_W0, I_RW_W_UP, I_RW_A0, I_RW_A_UP, I_RW_G_UP, I_RW_K_K, I_RW_K_A, I_RW_R_K,
       I_RW_LN_G, I_RW_LN_B, I_RET_LN_G, I_RET_LN_B, I_LN1_G, I_LN1_B, I_LN2_G, I_LN2_B, I_ROUTER, I_MOE_BIAS,
       I_MOE_W1, I_MOE_W3, I_MOE_W2, I_SH_W1, I_SH_W3, I_SH_W2, N_INPUTS };

struct Params {
  const float* in[N_INPUTS];
  float* out;
  char* ws;
};

#define MiB_TOK ((size_t)NTOK * 1024 * 4)
#define OFF_H 0
#define OFF_H2 ((size_t)NTOK * 1792 * 4)
#define OFF_MIX ((size_t)NTOK * 3328 * 4)
#define OFF_X1 (OFF_MIX + MiB_TOK)
#define OFF_X2 (OFF_X1 + MiB_TOK)
#define OFF_R4 (OFF_X2 + MiB_TOK)
#define OFF_R5 (OFF_R4 + MiB_TOK)
#define OFF_Y OFF_H
#define OFF_HS (OFF_H + 4 * MiB_TOK)
#define OFF_FS OFF_X2
#define OFF_HR OFF_R4
#define OFF_X2B OFF_R4
#define OFF_TOPI (OFF_R5)
#define OFF_TOPG (OFF_TOPI + (size_t)NTOK * 8 * 4)
#define OFF_POSOF (OFF_TOPG + (size_t)NTOK * 8 * 4)
#define OFF_CNT (OFF_POSOF + (size_t)NTOK * 8 * 4)
#define OFF_LTOK (OFF_CNT + 8192)
#define OFF_LGATE (OFF_LTOK + (size_t)64 * NTOK * 4)
#define OFF_S5E (OFF_LGATE + (size_t)64 * NTOK * 4)
#define OFF_KCMP (OFF_S5E + (size_t)BATCH * S5_NC * 32 * 64 * 8)
#define OFF_VCMP (OFF_KCMP + (size_t)BATCH * NCMP * 2 * 64 * 4)
#define OFF_RETKV (OFF_VCMP + (size_t)BATCH * NCMP * 2 * 64 * 4)
#define OFF_BAR (OFF_RETKV + (size_t)BATCH * 4 * RET_NC * 64 * 128 * 4)
#define OFF_CMPHID (OFF_BAR + 16384)
#define OFF_CMPC1 (OFF_CMPHID + (size_t)2 * BATCH * 2 * NB_CMP * 64 * 128 * 4)
#define OFF_GLO OFF_LTOK
#define OFF_RKF (OFF_CMPC1 + 8192)
#define OFF_END (OFF_RKF + 16384)
#define OFF_YGELU OFF_X1
#define OFF_RWW OFF_X1
#define OFF_RWK (OFF_X1 + (size_t)NTOK * 512 * 4)
#define OFF_RWKK OFF_R4
#define OFF_RWA (OFF_R4 + (size_t)NTOK * 512 * 4)

typedef short bf16x8 __attribute__((ext_vector_type(8)));
typedef float f32x16 __attribute__((ext_vector_type(16)));

#ifdef CPU_EMU
#define WAVE_SYNC() emu_wave_bar()
#else
#define WAVE_SYNC() __builtin_amdgcn_wave_barrier()
#endif

DEV float sigmoidf_(float x) { return 1.f / (1.f + __expf(-x)); }
DEV float siluf_(float x) { return x * sigmoidf_(x); }
DEV float geluf_(float x) { float u = 0.7978845608028654f * (x + 0.044715f * x * x * x); return 0.5f * x * (1.f + tanhf(u)); }
DEV unsigned short f2bf(float f) {
  unsigned u = __builtin_bit_cast(unsigned, f);
  u += 0x7FFFu + ((u >> 16) & 1u);
  return (unsigned short)(u >> 16);
}
DEV float bf2f(unsigned short h) { return __builtin_bit_cast(float, ((unsigned)h) << 16); }
DEV float wave_sum(float v) {
#pragma unroll
  for (int m = 32; m >= 1; m >>= 1) v += __shfl_xor(v, m);
  return v;
}
DEV float wave_max(float v) {
#pragma unroll
  for (int m = 32; m >= 1; m >>= 1) v = fmaxf(v, __shfl_xor(v, m));
  return v;
}
DEV float4 ld4(const float* p) { return *(const float4*)p; }
#ifdef CPU_EMU
DEV float fexp2(float x) { return exp2f(x); }
#else
DEV float fexp2(float x) { return __builtin_amdgcn_exp2f(x); }
#endif
DEV void fast_sincos(float x, float* sn, float* cs) {
  const float k = rintf(x * 0.15915494309189535f);
  float r = fmaf(-k, 6.28125f, x);
  r = fmaf(-k, 1.9353071795864769e-3f, r);
  *sn = __sinf(r); *cs = __cosf(r);
}
DEV void st4(float* p, float4 v) { *(float4*)p = v; }

#define GEMM_BM 128
#define GEMM_MI (GEMM_BM / 64)
#define GEMM_SMEM_BYTES ((GEMM_BM + 128) * 72 * 2)
#ifdef CPU_EMU
DEV unsigned pk2(float a, float b) { return (unsigned)f2bf(a) | ((unsigned)f2bf(b) << 16); }
#else
typedef __bf16 hbf16x2 __attribute__((ext_vector_type(2)));
typedef float hf32x2 __attribute__((ext_vector_type(2)));
DEV unsigned pk2(float a, float b) {
  hf32x2 f = {a, b};
  return __builtin_bit_cast(unsigned, __builtin_convertvector(f, hbf16x2));
}
#endif
template <bool ABF, class AROW, class BPTR, class EPI>
DEV void gemm_tile(AROW arow, BPTR bptr, int ldb, int K, EPI epi, char* smem_raw, int akstep = 64) {
  unsigned short(*sA)[72] = (unsigned short(*)[72])smem_raw;
  unsigned short(*sB)[72] = (unsigned short(*)[72])(smem_raw + GEMM_BM * 72 * 2);
  const int tid = TIDX, lane = tid & 63, wave = tid >> 6;
  const int wm = wave >> 1, wn = wave & 1;
#if defined(CPU_EMU) && !defined(EMU_REAL_GEMM)
  for (int mi = 0; mi < GEMM_MI; ++mi)
    for (int r = 0; r < 16; ++r) {
      const int row = wm * (GEMM_BM / 2) + mi * 32 + (r & 3) + 8 * (r >> 2) + 4 * (lane >> 5);
      const int col = wn * 64 + (lane & 31);
      const void* arp = arow(row);
      float v[2] = {0.f, 0.f};
      for (int ni = 0; ni < 2; ++ni) {
        const int cc = col + ni * 32;
        const float* bq = bptr(cc & ~3);
        if (!arp || !bq) continue;
        bq += cc & 3;
        float a = 0.f;
        for (int k = 0; k < K; ++k) {
          const size_t ka = (size_t)(k >> 6) * akstep + (k & 63);
          const float av = ABF ? bf2f(((const unsigned short*)arp)[ka]) : bf2f(f2bf(((const float*)arp)[ka]));
          a += av * bf2f(f2bf(bq[(size_t)k * ldb]));
        }
        v[ni] = a;
      }
      epi(row, col, v[0], v[1]);
    }
  return;
#endif
  const float* ap[4 * GEMM_MI];
  const unsigned short* aph[2 * GEMM_MI];
  if (ABF) {
#pragma unroll
    for (int i = 0; i < 2 * GEMM_MI; ++i) aph[i] = (const unsigned short*)arow((tid >> 3) + 32 * i);
  } else {
#pragma unroll
    for (int i = 0; i < 4 * GEMM_MI; ++i) ap[i] = (const float*)arow((tid >> 4) + 16 * i);
  }
  const float* bp = bptr((tid & 31) * 4);
  const int kgrp = tid >> 5;
  float4 ra0[4 * GEMM_MI], ra1[4 * GEMM_MI];
  uint4 rah0[2 * GEMM_MI], rah1[2 * GEMM_MI];
  float4 rb0[8], rb1[8];
#define GEMM_GLOAD(S, k0_)                                                                                                          \
  {                                                                                                                                 \
    if (ABF) {                                                                                                                      \
      _Pragma("unroll") for (int i = 0; i < 2 * GEMM_MI; ++i) rah##S[i] =                                                           \
          aph[i] ? *(const uint4*)(aph[i] + (size_t)((k0_) >> 6) * akstep + (tid & 7) * 8) : make_uint4(0, 0, 0, 0);                \
    } else {                                                                                                                        \
      _Pragma("unroll") for (int i = 0; i < 4 * GEMM_MI; ++i) ra##S[i] =                                                            \
          ap[i] ? ld4(ap[i] + (size_t)((k0_) >> 6) * akstep + (tid & 15) * 4) : make_float4(0.f, 0.f, 0.f, 0.f);                    \
    }                                                                                                                               \
    _Pragma("unroll") for (int j = 0; j < 8; ++j) rb##S[j] =                                                                        \
        bp ? ld4(bp + (size_t)((k0_) + kgrp * 8 + j) * ldb) : make_float4(0.f, 0.f, 0.f, 0.f);                                      \
  }
#define GEMM_SSTORE(S)                                                                                                              \
  {                                                                                                                                 \
    if (ABF) {                                                                                                                      \
      _Pragma("unroll") for (int i = 0; i < 2 * GEMM_MI; ++i) *(uint4*)&sA[(tid >> 3) + 32 * i][(tid & 7) * 8] = rah##S[i];         \
    } else {                                                                                                                        \
      _Pragma("unroll") for (int i = 0; i < 4 * GEMM_MI; ++i) *(uint2*)&sA[(tid >> 4) + 16 * i][(tid & 15) * 4] =                   \
          make_uint2(pk2(ra##S[i].x, ra##S[i].y), pk2(ra##S[i].z, ra##S[i].w));                                                     \
    }                                                                                                                               \
    const int nb = (tid & 31) * 4;                                                                                                  \
    *(uint4*)&sB[nb + 0][kgrp * 8] = make_uint4(pk2(rb##S[0].x, rb##S[1].x), pk2(rb##S[2].x, rb##S[3].x), pk2(rb##S[4].x, rb##S[5].x), pk2(rb##S[6].x, rb##S[7].x)); \
    *(uint4*)&sB[nb + 1][kgrp * 8] = make_uint4(pk2(rb##S[0].y, rb##S[1].y), pk2(rb##S[2].y, rb##S[3].y), pk2(rb##S[4].y, rb##S[5].y), pk2(rb##S[6].y, rb##S[7].y)); \
    *(uint4*)&sB[nb + 2][kgrp * 8] = make_uint4(pk2(rb##S[0].z, rb##S[1].z), pk2(rb##S[2].z, rb##S[3].z), pk2(rb##S[4].z, rb##S[5].z), pk2(rb##S[6].z, rb##S[7].z)); \
    *(uint4*)&sB[nb + 3][kgrp * 8] = make_uint4(pk2(rb##S[0].w, rb##S[1].w), pk2(rb##S[2].w, rb##S[3].w), pk2(rb##S[4].w, rb##S[5].w), pk2(rb##S[6].w, rb##S[7].w)); \
  }
  f32x16 acc[GEMM_MI][2];
#pragma unroll
  for (int mi = 0; mi < GEMM_MI; ++mi)
#pragma unroll
    for (int ni = 0; ni < 2; ++ni)
#pragma unroll
      for (int r = 0; r < 16; ++r) acc[mi][ni][r] = 0.f;
  auto compute = [&]() {
#pragma unroll
    for (int ks = 0; ks < 4; ++ks) {
      bf16x8 af[GEMM_MI], bfr[2];
#pragma unroll
      for (int mi = 0; mi < GEMM_MI; ++mi) af[mi] = *(const bf16x8*)&sA[wm * (GEMM_BM / 2) + mi * 32 + (lane & 31)][ks * 16 + (lane >> 5) * 8];
#pragma unroll
      for (int ni = 0; ni < 2; ++ni) bfr[ni] = *(const bf16x8*)&sB[wn * 64 + ni * 32 + (lane & 31)][ks * 16 + (lane >> 5) * 8];
#pragma unroll
      for (int mi = 0; mi < GEMM_MI; ++mi)
#pragma unroll
        for (int ni = 0; ni < 2; ++ni) acc[mi][ni] = __builtin_amdgcn_mfma_f32_32x32x16_bf16(af[mi], bfr[ni], acc[mi][ni], 0, 0, 0);
    }
  };
  if (ABF) {
    GEMM_GLOAD(0, 0);
    GEMM_GLOAD(1, 64);
    for (int k0 = 0; k0 < K; k0 += 128) {
      __syncthreads();
      GEMM_SSTORE(0);
      __syncthreads();
      if (k0 + 128 < K) GEMM_GLOAD(0, k0 + 128);
      compute();
      __syncthreads();
      GEMM_SSTORE(1);
      __syncthreads();
      if (k0 + 192 < K) GEMM_GLOAD(1, k0 + 192);
      compute();
    }
  } else {
    GEMM_GLOAD(0, 0);
    for (int k0 = 0; k0 < K; k0 += 64) {
      __syncthreads();
      GEMM_SSTORE(0);
      __syncthreads();
      if (k0 + 64 < K) GEMM_GLOAD(0, k0 + 64);
      compute();
    }
  }
#pragma unroll
  for (int mi = 0; mi < GEMM_MI; ++mi)
#pragma unroll
    for (int r = 0; r < 16; ++r) {
      int row = wm * (GEMM_BM / 2) + mi * 32 + (r & 3) + 8 * (r >> 2) + 4 * (lane >> 5);
      int col = wn * 64 + (lane & 31);
      epi(row, col, acc[mi][0][r], acc[mi][1][r]);
    }
}

template <int LAYER>
DEV void phase_gemm_in(const Params& p, char* smem) {
  const int N = LAYER == 0 ? AB_IN : CD_IN;
  const float* A = LAYER == 0 ? p.in[I_X] : (const float*)(p.ws + OFF_X2);
  const float* B = LAYER == 0 ? p.in[I_AB_W_IN] : p.in[I_CD_W_IN];
  float* C = (float*)(p.ws + OFF_H);
  const int NT = (N + 127) / 128, MT = NTOK / GEMM_BM;
  const int xcd_ = BIDX & 7, lb_ = BIDX >> 3, nb_ = gridDim.x >> 3;
  for (int j_ = lb_; j_ < (MT / 8) * NT; j_ += nb_) {
    const int it = (xcd_ + 8 * (j_ / NT)) * NT + (j_ % NT);
    const int tm = it / NT, tn = it % NT;
    const int m0 = tm * GEMM_BM, n0 = tn * 128;
    gemm_tile<LAYER == 1>(
        [&](int r) { return LAYER == 1 ? (const void*)((const unsigned short*)(p.ws + OFF_X2B) + (size_t)(m0 + r) * DM) : (const void*)(A + (size_t)(m0 + r) * DM); },
        [&](int c) { return (n0 + c < N) ? (B + n0 + c) : (const float*)nullptr; }, N, DM,
        [&](int row, int col, float v0, float v1) {
          const int gm = m0 + row, gc = n0 + col;
          if (LAYER == 1 && gc >= 1792 && gc < 2304) {
            const int i = gc & 63;
            const float pos = (float)(gm % SEQ_LEN);
            const float inv = __expf(-(float)i * (9.210340371976184f / 32.f));
            float sn, cs;
            fast_sincos(pos * inv, &sn, &cs);
            float o0 = v0 * cs - v1 * sn, o1 = v1 * cs + v0 * sn;
            if (gc >= 2048) { o0 *= 0.125f; o1 *= 0.125f; }
            v0 = o0; v1 = o1;
          }
          if (LAYER == 1) {
            float* dstp = gc < 1792 ? C + (size_t)gm * 1792 + gc : (float*)(p.ws + OFF_H2) + (size_t)gm * 1536 + (gc - 1792);
            dstp[0] = v0; dstp[32] = v1;
          } else {
            if (gc < N) C[(size_t)gm * AB_LD + gc] = v0;
            if (gc + 32 < N) C[(size_t)gm * AB_LD + gc + 32] = v1;
          }
        },
        smem);
  }
}

struct S5Const { float lb_re, lb_im; };
DEV void s5_consts(const Params& p, int g, int pp, float& lb_re, float& lb_im, float (&bbr)[16], float (&bbi)[16]) {
  const float dt = expf(p.in[I_S5_LOG_DT][g]);
  const float lr = p.in[I_S5_LAM_RE][g * 64 + pp], li = p.in[I_S5_LAM_IM][g * 64 + pp];
  const float mag = expf(lr * dt);
  float sn, cs;
  sincosf(li * dt, &sn, &cs);
  lb_re = mag * cs; lb_im = mag * sn;
  const float den = lr * lr + li * li;
  const float f_re = ((lb_re - 1.f) * lr + lb_im * li) / den;
  const float f_im = (lb_im * lr - (lb_re - 1.f) * li) / den;
  const float* br = p.in[I_S5_B_RE] + (size_t)(g * 64 + pp) * 16;
  const float* bi = p.in[I_S5_B_IM] + (size_t)(g * 64 + pp) * 16;
#pragma unroll
  for (int h = 0; h < 16; ++h) {
    bbr[h] = f_re * br[h] - f_im * bi[h];
    bbi[h] = f_re * bi[h] + f_im * br[h];
  }
}

#define OFF_QB OFF_X2
#define OFF_KSB (OFF_QB + (size_t)NTOK * 512 * 2)
#define OFF_KWB (OFF_KSB + (size_t)NTOK * 128 * 2)
#define OFF_VST (OFF_KWB + (size_t)NTOK * 128 * 2)
#define OFF_VWT (OFF_VST + (size_t)NTOK * 128 * 2)
#define OFF_KCB (OFF_VWT + (size_t)NTOK * 128 * 2)
#define OFF_VCT (OFF_KCB + (size_t)BATCH * 2 * NB_CMP * 64 * 64 * 2)
#define NSA_QSCALE (0.125f * 1.4426950408889634f)

#define P1_S5A_ITEMS (BATCH * 32 * S5_NC / 4)
#define P1_CMP_ITEMS (2 * BATCH * 2 * NB_CMP)
#define S5C_ROW 132
DEV bf16x8 pack_bf8(float4 a, float4 b) {
  union { uint4 u; bf16x8 v; } x;
  x.u = make_uint4(pk2(a.x, a.y), pk2(a.z, a.w), pk2(b.x, b.y), pk2(b.z, b.w));
  return x.v;
}
DEV void s5_bfrags(const Params& p, int g, int lane, bf16x8 (&bB)[4]) {
  const int hh = lane >> 5;
#pragma unroll
  for (int ct = 0; ct < 2; ++ct) {
    float lr, li, br_[16], bi_[16];
    s5_consts(p, g, 32 * ct + (lane & 31), lr, li, br_, bi_);
    bB[ct] = pack_bf8(make_float4(hh ? br_[8] : br_[0], hh ? br_[9] : br_[1], hh ? br_[10] : br_[2], hh ? br_[11] : br_[3]),
                      make_float4(hh ? br_[12] : br_[4], hh ? br_[13] : br_[5], hh ? br_[14] : br_[6], hh ? br_[15] : br_[7]));
    bB[2 + ct] = pack_bf8(make_float4(hh ? bi_[8] : bi_[0], hh ? bi_[9] : bi_[1], hh ? bi_[10] : bi_[2], hh ? bi_[11] : bi_[3]),
                          make_float4(hh ? bi_[12] : bi_[4], hh ? bi_[13] : bi_[5], hh ? bi_[14] : bi_[6], hh ? bi_[15] : bi_[7]));
  }
}
DEV void s5_subchunk(const float* su, float* sS, const bf16x8 (&bB)[4], float lb_re, float lb_im, float& sr, float& si, int lane) {
  {
    const int r = lane & 15, hh = lane >> 5, n = lane & 31;
    const bf16x8 a = pack_bf8(ld4(su + r * 16 + 8 * hh), ld4(su + r * 16 + 8 * hh + 4));
#pragma unroll
    for (int j = 0; j < 4; ++j) {
      f32x16 acc;
#pragma unroll
      for (int i = 0; i < 16; ++i) acc[i] = 0.f;
      acc = __builtin_amdgcn_mfma_f32_32x32x16_bf16(a, bB[j], acc, 0, 0, 0);
      const int col = (j >> 1) * 64 + (j & 1) * 32 + n;
#pragma unroll
      for (int r8 = 0; r8 < 8; ++r8) sS[((r8 & 3) + 8 * (r8 >> 2) + 4 * hh) * S5C_ROW + col] = acc[r8];
    }
  }
  WAVE_SYNC();
  for (int tt = 0; tt < 16; ++tt) {
    const float dr = sS[tt * S5C_ROW + lane], di = sS[tt * S5C_ROW + 64 + lane];
    const float nr = lb_re * sr - lb_im * si + dr, ni = lb_re * si + lb_im * sr + di;
    sr = nr; si = ni;
    sS[tt * S5C_ROW + lane] = sr;
    sS[tt * S5C_ROW + 64 + lane] = si;
  }
}
DEV void p1_s5a(const Params& p, int item, char* smem) {
  const int lane = TIDX & 63, wave = TIDX >> 6;
  const int idx = item * 4 + wave;
  const int g = idx & 31, c = (idx >> 5) % S5_NC, b = idx / (32 * S5_NC);
  float lb_re, lb_im;
  {
    float bbr[16], bbi[16];
    s5_consts(p, g, lane, lb_re, lb_im, bbr, bbi);
  }
  bf16x8 bB[4];
  s5_bfrags(p, g, lane, bB);
  const float* H = (const float*)(p.ws + OFF_H);
  float sr = 0.f, si = 0.f;
  float* sS = (float*)smem + wave * 16 * S5C_ROW;
  float* su = (float*)smem + 4 * 16 * S5C_ROW + wave * 16 * 16;
  __syncthreads();
  for (int sc = 0; sc < 4; ++sc) {
    {
      const float* ur = H + (size_t)(b * SEQ_LEN + c * 64 + sc * 16 + (lane >> 2)) * AB_LD + g * 16 + (lane & 3) * 4;
      st4(su + (lane >> 2) * 16 + (lane & 3) * 4, ld4(ur));
    }
    WAVE_SYNC();
    s5_subchunk(su, sS, bB, lb_re, lb_im, sr, si, lane);
    WAVE_SYNC();
  }
  float2* E = (float2*)(p.ws + OFF_S5E);
  E[((size_t)(b * S5_NC + c) * 32 + g) * 64 + lane] = make_float2(sr, si);
}
#define P1_CMPG_MT ((NCMP + GEMM_BM - 1) / GEMM_BM)
#define P1_CMPG_ITEMS (2 * BATCH * 2 * P1_CMPG_MT)
DEV void p1_cmpgemm(const Params& p, int item, char* smem) {
  const int mt = item % P1_CMPG_MT;
  int r = item / P1_CMPG_MT;
  const int g = r & 1; r >>= 1;
  const int b = r % BATCH; const int which = r / BATCH;
  const float* H = (const float*)(p.ws + OFF_H);
  const float* w1 = which ? p.in[I_CV_W1] : p.in[I_CK_W1];
  const int colbase = (which ? 1152 : 1024) + g * 64;
  float* HID = (float*)(p.ws + OFF_CMPHID) + ((size_t)(which * BATCH + b) * 2 + g) * NB_CMP * 64 * 128;
  const int n0 = mt * GEMM_BM;
  gemm_tile<false>(
      [&](int rr) { return (n0 + rr < NCMP) ? (const void*)(H + ((size_t)b * SEQ_LEN + 16 * (n0 + rr)) * AB_LD + colbase) : (const void*)nullptr; },
      [&](int c) { return w1 + c; }, 128, 2048,
      [&](int row, int col, float v0, float v1) {
        if (n0 + row < NCMP) { HID[(size_t)(n0 + row) * 128 + col] = v0; HID[(size_t)(n0 + row) * 128 + col + 32] = v1; }
      },
      smem, AB_LD);
}
#define P1_CMPC1_ITEMS 16
DEV void p1_cmpc1(const Params& p, int item, char* smem) {
  const int which = item >> 3, sl = item & 7;
  const float* pe = which ? p.in[I_PE_V] : p.in[I_PE_K];
  const float* w1 = which ? p.in[I_CV_W1] : p.in[I_CK_W1];
  float* sPart = (float*)smem;
  const int tid = TIDX, hid = tid & 127, kh = tid >> 7;
  float a = 0.f;
  const int k0 = sl * 256 + kh * 128;
#pragma unroll 16
  for (int k = k0; k < k0 + 128; ++k) a += pe[k] * w1[(size_t)k * 128 + hid];
  __syncthreads();
  sPart[tid] = a;
  __syncthreads();
  if (tid < 128) ((float*)(p.ws + OFF_CMPC1))[(which * 8 + sl) * 128 + tid] = sPart[tid] + sPart[tid + 128];
  __syncthreads();
}
DEV void p1_compress(const Params& p, int item, char* smem) {
  const int tile = item % NB_CMP;
  int r = item / NB_CMP;
  const int g = r & 1; r >>= 1;
  const int b = r % BATCH; const int which = r / BATCH;
  const float* b1 = which ? p.in[I_CV_B1] : p.in[I_CK_B1];
  const float* w2 = which ? p.in[I_CV_W2] : p.in[I_CK_W2];
  const float* C1P = (const float*)(p.ws + OFF_CMPC1) + which * 8 * 128;
  const float* HID = (const float*)(p.ws + OFF_CMPHID) + ((size_t)(which * BATCH + b) * 2 + g) * NB_CMP * 64 * 128;
  float* sOut = (float*)smem;
  float* sHid = sOut + 8 * 64;
  float* sAll = sHid + 8 * 128;
  float* sC1 = sAll + 64 * 65;
  const int tid = TIDX;
  __syncthreads();
  if (tid < 128) {
    const float* q = C1P + tid;
    sC1[tid] = (((((((q[0] + q[128]) + q[256]) + q[384]) + q[512]) + q[640]) + q[768]) + q[896]) + b1[tid];
  }
  float* dst = (float*)(p.ws + (which ? OFF_VCMP : OFF_KCMP));
#pragma unroll 1
  for (int r8 = 0; r8 < 8; ++r8) {
    const int n0 = tile * 64 + r8 * 8;
    __syncthreads();
    for (int w = tid; w < 8 * 128; w += NTHREADS) {
      const int rr = w >> 7, hid = w & 127;
      const int n = n0 + rr;
      sHid[w] = n < NCMP ? geluf_(HID[(size_t)n * 128 + hid] + sC1[hid]) : 0.f;
    }
    __syncthreads();
    for (int w = tid; w < 8 * 64; w += NTHREADS) {
      const int rr = w >> 6, d = w & 63;
      float a = 0.f;
      for (int hid = 0; hid < 128; ++hid) a += sHid[rr * 128 + hid] * w2[hid * 64 + d];
      sOut[w] = a;
    }
    __syncthreads();
    for (int w = tid; w < 8 * 64; w += NTHREADS) {
      const int rr = w >> 6, d = w & 63;
      const int n = n0 + rr;
      float v = sOut[w];
      if (which == 0 && d < 16) {
        const int i = d & 7;
        const float pos = (float)(n * 16 + 31);
        const float inv = __expf(-(float)i * (13.122363377404328f / 8.f));
        float sn, cs;
        sincosf(pos * inv, &sn, &cs);
        const float x1 = sOut[rr * 64 + i], x2 = sOut[rr * 64 + i + 8];
        v = d < 8 ? x1 * cs - x2 * sn : x2 * cs + x1 * sn;
      }
      if (n >= NCMP) v = 0.f;
      sAll[(r8 * 8 + rr) * 65 + d] = v;
      if (n < NCMP) dst[((size_t)(b * NCMP + n) * 2 + g) * 64 + d] = v;
    }
  }
  __syncthreads();
  if (which == 0) {
    unsigned short* KCB = (unsigned short*)(p.ws + OFF_KCB) + (((size_t)b * 2 + g) * NB_CMP * 64 + tile * 64) * 64;
    for (int w = tid; w < 64 * 8; w += NTHREADS) {
      const int nl = w >> 3, o = w & 7;
      float v[8];
#pragma unroll
      for (int q = 0; q < 8; ++q) v[q] = sAll[nl * 65 + o * 8 + q];
      *(uint4*)(KCB + nl * 64 + o * 8) = make_uint4(pk2(v[0], v[1]), pk2(v[2], v[3]), pk2(v[4], v[5]), pk2(v[6], v[7]));
    }
  } else {
    unsigned short* VCT = (unsigned short*)(p.ws + OFF_VCT) + (((size_t)b * 2 + g) * NB_CMP + tile) * 64 * 64;
    for (int w = tid; w < 64 * 8; w += NTHREADS) {
      const int d = w >> 3, o = w & 7;
      float v[8];
#pragma unroll
      for (int q = 0; q < 8; ++q) v[q] = sAll[(o * 8 + q) * 65 + d];
      *(uint4*)(VCT + d * 64 + o * 8) = make_uint4(pk2(v[0], v[1]), pk2(v[2], v[3]), pk2(v[4], v[5]), pk2(v[6], v[7]));
    }
  }
}
DEV uint4 pack8(const float* v) {
  uint4 r;
  r.x = (unsigned)f2bf(v[0]) | ((unsigned)f2bf(v[1]) << 16);
  r.y = (unsigned)f2bf(v[2]) | ((unsigned)f2bf(v[3]) << 16);
  r.z = (unsigned)f2bf(v[4]) | ((unsigned)f2bf(v[5]) << 16);
  r.w = (unsigned)f2bf(v[6]) | ((unsigned)f2bf(v[7]) << 16);
  return r;
}
#define P1_PREP_ITEMS (NTOK / 64)
#define P1_PREP_SMEM ((64 * 8 * 2 + 64 * 128) * 4)
DEV void p1_prep(const Params& p, int item, char* smem) {
  const int tid = TIDX;
  const int b = item / NBLK, blk = item % NBLK;
  const float* H = (const float*)(p.ws + OFF_H);
  float* sCS = (float*)smem;
  float* sV = sCS + 64 * 8 * 2;
  const size_t tok0 = (size_t)b * SEQ_LEN + blk * 64;
  __syncthreads();
  for (int w = tid; w < 64 * 8; w += NTHREADS) {
    const int tk = w >> 3, i = w & 7;
    const float pos = (float)(blk * 64 + tk);
    const float inv = __expf(-(float)i * (13.122363377404328f / 8.f));
    float sn, cs;
    sincosf(pos * inv, &sn, &cs);
    sCS[w * 2] = cs; sCS[w * 2 + 1] = sn;
  }
  __syncthreads();
  unsigned short* QB = (unsigned short*)(p.ws + OFF_QB);
  unsigned short* KSB = (unsigned short*)(p.ws + OFF_KSB);
  unsigned short* KWB = (unsigned short*)(p.ws + OFF_KWB);
  for (int w = tid; w < 64 * 12 * 8; w += NTHREADS) {
    const int o = w & 7, hd = (w >> 3) % 12, tk = w / 96;
    const int col = hd < 8 ? 512 + hd * 64 : (hd < 10 ? 1280 + (hd - 8) * 64 : 1536 + (hd - 10) * 64);
    const float* x = H + (tok0 + tk) * AB_LD + col;
    float v[8];
    const float4 a0 = ld4(x + o * 8), a1 = ld4(x + o * 8 + 4);
    v[0] = a0.x; v[1] = a0.y; v[2] = a0.z; v[3] = a0.w; v[4] = a1.x; v[5] = a1.y; v[6] = a1.z; v[7] = a1.w;
    if (o < 2) {
      const float4 c0 = ld4(x + (1 - o) * 8), c1 = ld4(x + (1 - o) * 8 + 4);
      const float u[8] = {c0.x, c0.y, c0.z, c0.w, c1.x, c1.y, c1.z, c1.w};
#pragma unroll
      for (int i = 0; i < 8; ++i) {
        const float cs = sCS[(tk * 8 + i) * 2], sn = sCS[(tk * 8 + i) * 2 + 1];
        v[i] = o == 0 ? v[i] * cs - u[i] * sn : v[i] * cs + u[i] * sn;
      }
    }
    if (hd < 8) {
#pragma unroll
      for (int i = 0; i < 8; ++i) v[i] *= NSA_QSCALE;
      *(uint4*)(QB + ((tok0 + tk) * 8 + hd) * 64 + o * 8) = pack8(v);
    } else {
      const int g = (hd - 8) & 1;
      unsigned short* dst = (hd < 10 ? KSB : KWB) + (((size_t)b * 2 + g) * SEQ_LEN + blk * 64 + tk) * 64 + o * 8;
      *(uint4*)dst = pack8(v);
    }
  }
#pragma unroll 1
  for (int which = 0; which < 2; ++which) {
    const int col = which ? 1664 : 1408;
    __syncthreads();
    for (int w = tid; w < 64 * 32; w += NTHREADS) {
      const int tk = w >> 5, c4 = (w & 31) * 4;
      st4(sV + tk * 128 + c4, ld4(H + (tok0 + tk) * AB_LD + col + c4));
    }
    __syncthreads();
    unsigned short* VT = (unsigned short*)(p.ws + (which ? OFF_VWT : OFF_VST));
    for (int w = tid; w < 2 * 64 * 8; w += NTHREADS) {
      const int ko = w & 7, d = (w >> 3) & 63, g = w >> 9;
      float v[8];
#pragma unroll
      for (int i = 0; i < 8; ++i) v[i] = sV[(ko * 8 + i) * 128 + g * 64 + d];
      *(uint4*)(VT + ((((size_t)b * 2 + g) * NBLK + blk) * 64 + d) * 64 + ko * 8) = pack8(v);
    }
  }
}

struct NsaSmem {
  unsigned short k[64][72];
  unsigned short vt[64][68];
  float imp[32][128];
  unsigned selmask[32][4];
  unsigned unionm[4];
  float keyb[4][128];
};
#define P2_NSA_SMEM ((int)sizeof(NsaSmem))
#define NSA_QT (SEQ_LEN / 32)
#define P2_NSA_ITEMS (BATCH * 2 * NSA_QT)

struct TileRegs { uint4 k0, k1, v0, v1; };
DEV void tile_gload(TileRegs& r, const unsigned short* Kg, const unsigned short* Vg, int tid) {
  const int row = tid >> 2, seg = tid & 3;
  r.k0 = *(const uint4*)(Kg + row * 64 + seg * 16);
  r.k1 = *(const uint4*)(Kg + row * 64 + seg * 16 + 8);
  if (Vg) {
    r.v0 = *(const uint4*)(Vg + row * 64 + seg * 16);
    r.v1 = *(const uint4*)(Vg + row * 64 + seg * 16 + 8);
  }
}
DEV void tile_sstore(NsaSmem* sm, const TileRegs& r, bool withV, int tid) {
  const int row = tid >> 2, seg = tid & 3;
  *(uint4*)&sm->k[row][seg * 16] = r.k0;
  *(uint4*)&sm->k[row][seg * 16 + 8] = r.k1;
  if (withV) {
    *(uint2*)&sm->vt[row][seg * 16] = make_uint2(r.v0.x, r.v0.y);
    *(uint2*)&sm->vt[row][seg * 16 + 4] = make_uint2(r.v0.z, r.v0.w);
    *(uint2*)&sm->vt[row][seg * 16 + 8] = make_uint2(r.v1.x, r.v1.y);
    *(uint2*)&sm->vt[row][seg * 16 + 12] = make_uint2(r.v1.z, r.v1.w);
  }
}
DEV void qk_tile(const unsigned short (*ksm)[72], const bf16x8 (&qf)[4], f32x16 (&s)[2], int lane) {
  const int r = lane & 31, hh = lane >> 5;
#pragma unroll
  for (int ks2 = 0; ks2 < 2; ++ks2) {
#pragma unroll
    for (int i = 0; i < 16; ++i) s[ks2][i] = 0.f;
#pragma unroll
    for (int ks = 0; ks < 4; ++ks) {
      const bf16x8 a = *(const bf16x8*)&ksm[ks2 * 32 + r][ks * 16 + hh * 8];
      s[ks2] = __builtin_amdgcn_mfma_f32_32x32x16_bf16(a, qf[ks], s[ks2], 0, 0, 0);
    }
  }
}
DEV void pv_tile(const unsigned short (*vsm)[68], const f32x16 (&pr)[2], f32x16 (&o)[2], int lane) {
  const int r = lane & 31, hh = lane >> 5;
#pragma unroll
  for (int ks2 = 0; ks2 < 2; ++ks2)
#pragma unroll
    for (int s = 0; s < 2; ++s) {
      union { uint4 u; bf16x8 v; } pfu;
      pfu.u = make_uint4(pk2(pr[ks2][8 * s], pr[ks2][8 * s + 1]), pk2(pr[ks2][8 * s + 2], pr[ks2][8 * s + 3]),
                         pk2(pr[ks2][8 * s + 4], pr[ks2][8 * s + 5]), pk2(pr[ks2][8 * s + 6], pr[ks2][8 * s + 7]));
      const bf16x8 pf = pfu.v;
#pragma unroll
      for (int mt = 0; mt < 2; ++mt) {
        const uint2 lo = *(const uint2*)&vsm[mt * 32 + r][ks2 * 32 + 16 * s + 4 * hh];
        const uint2 hi = *(const uint2*)&vsm[mt * 32 + r][ks2 * 32 + 16 * s + 8 + 4 * hh];
        union { uint4 u; bf16x8 v; } au;
        au.u = make_uint4(lo.x, lo.y, hi.x, hi.y);
        const bf16x8 a = au.v;
        o[mt] = __builtin_amdgcn_mfma_f32_32x32x16_bf16(a, pf, o[mt], 0, 0, 0);
      }
    }
}
DEV float quad_sum(float v) {
#ifdef CPU_EMU
  v += __shfl_xor(v, 1); v += __shfl_xor(v, 2); return v;
#else
  int x;
  x = __builtin_amdgcn_update_dpp(0, __builtin_bit_cast(int, v), 0xB1, 0xF, 0xF, false); v += __builtin_bit_cast(float, x);
  x = __builtin_amdgcn_update_dpp(0, __builtin_bit_cast(int, v), 0x4E, 0xF, 0xF, false); v += __builtin_bit_cast(float, x);
  return v;
#endif
}
DEV void softmax_step(f32x16 (&s)[2], float& m, float& l, f32x16 (&o)[2]) {
  float tmax = -INFINITY;
#pragma unroll
  for (int ks2 = 0; ks2 < 2; ++ks2)
#pragma unroll
    for (int i = 0; i < 16; ++i) tmax = fmaxf(tmax, s[ks2][i]);
  tmax = fmaxf(tmax, __shfl_xor(tmax, 32));
  const float mnew = fmaxf(m, tmax);
  const float msafe = mnew == -INFINITY ? 0.f : mnew;
  const float alpha = fexp2(m - msafe);
  float ps = 0.f;
#pragma unroll
  for (int ks2 = 0; ks2 < 2; ++ks2)
#pragma unroll
    for (int i = 0; i < 16; ++i) { s[ks2][i] = fexp2(s[ks2][i] - msafe); ps += s[ks2][i]; }
  l = l * alpha + ps;
#pragma unroll
  for (int mt = 0; mt < 2; ++mt)
#pragma unroll
    for (int i = 0; i < 16; ++i) o[mt][i] *= alpha;
  m = mnew;
}
DEV bool testbit4(unsigned w0, unsigned w1, unsigned w2, unsigned w3, int j) {
  const unsigned lo = j & 32 ? w1 : w0, hi = j & 32 ? w3 : w2;
  const unsigned x = j & 64 ? hi : lo;
  return (x >> (j & 31)) & 1u;
}

DEV void p2_nsa(const Params& p, int item, char* smem) {
  NsaSmem* sm = (NsaSmem*)smem;
  const int tid = TIDX, lane = tid & 63, wave = tid >> 6;
  const int bg = item & 3, b = bg >> 1, g = bg & 1;
  const int qt = NSA_QT - 1 - (item >> 2);
  const int t0 = qt * 32;
  const int c = lane & 31, hh = lane >> 5, tl = c >> 2, h = c & 3;
  const int trow = wave * 8 + tl;
  const int tq = t0 + trow;
  const size_t tok = (size_t)b * SEQ_LEN + tq;
  const int hd = g * 4 + h;
  const float* H = (const float*)(p.ws + OFF_H);
  const unsigned short* QB = (const unsigned short*)(p.ws + OFF_QB);
  const unsigned short* KSB = (const unsigned short*)(p.ws + OFF_KSB) + ((size_t)b * 2 + g) * SEQ_LEN * 64;
  const unsigned short* KWB = (const unsigned short*)(p.ws + OFF_KWB) + ((size_t)b * 2 + g) * SEQ_LEN * 64;
  const unsigned short* VST = (const unsigned short*)(p.ws + OFF_VST) + ((size_t)b * 2 + g) * NBLK * 4096;
  const unsigned short* VWT = (const unsigned short*)(p.ws + OFF_VWT) + ((size_t)b * 2 + g) * NBLK * 4096;
  const unsigned short* KCB = (const unsigned short*)(p.ws + OFF_KCB) + ((size_t)b * 2 + g) * NB_CMP * 4096;
  const unsigned short* VCT = (const unsigned short*)(p.ws + OFF_VCT) + ((size_t)b * 2 + g) * NB_CMP * 4096;
  bf16x8 qf[4];
  {
    const unsigned short* qrow = QB + (tok * 8 + hd) * 64;
#pragma unroll
    for (int ks = 0; ks < 4; ++ks) qf[ks] = *(const bf16x8*)(qrow + ks * 16 + hh * 8);
  }
  const float g0 = sigmoidf_(H[tok * AB_LD + 1792 + hd * 3 + 0]);
  const float g1 = sigmoidf_(H[tok * AB_LD + 1792 + hd * 3 + 1]);
  const float g2 = sigmoidf_(H[tok * AB_LD + 1792 + hd * 3 + 2]);
  f32x16 o[2], s[2];
#pragma unroll
  for (int mt = 0; mt < 2; ++mt)
#pragma unroll
    for (int i = 0; i < 16; ++i) o[mt][i] = 0.f;
  float* mixrow = (float*)(p.ws + OFF_MIX) + tok * 1024 + 512 + hd * 64 + 4 * hh;
  __syncthreads();
  for (int w = tid; w < 32 * 128; w += NTHREADS) (&sm->imp[0][0])[w] = 0.f;
  TileRegs tr;
  tr.k0 = tr.k1 = tr.v0 = tr.v1 = make_uint4(0, 0, 0, 0);
  const int nval = tq >= 31 ? (tq - 31) / 16 + 1 : 0;
  const int nvmax = (t0 + 31 - 31) / 16 + 1;
  const int ktn = (nvmax + 63) / 64;
  float m = -INFINITY, l = 0.f;
  tile_gload(tr, KCB, nullptr, tid);
  for (int kt = 0; kt < ktn; ++kt) {
    __syncthreads();
    tile_sstore(sm, tr, false, tid);
    __syncthreads();
    if (kt + 1 < ktn) tile_gload(tr, KCB + (size_t)(kt + 1) * 4096, nullptr, tid);
    qk_tile(sm->k, qf, s, lane);
    float tmax = -INFINITY;
#pragma unroll
    for (int ks2 = 0; ks2 < 2; ++ks2)
#pragma unroll
      for (int i = 0; i < 16; ++i) {
        const int n = kt * 64 + ks2 * 32 + (i & 3) + 8 * (i >> 2) + 4 * hh;
        s[ks2][i] = n < nval ? s[ks2][i] : -INFINITY;
        tmax = fmaxf(tmax, s[ks2][i]);
      }
    tmax = fmaxf(tmax, __shfl_xor(tmax, 32));
    const float mnew = fmaxf(m, tmax);
    const float msafe = mnew == -INFINITY ? 0.f : mnew;
    float ps = 0.f;
#pragma unroll
    for (int ks2 = 0; ks2 < 2; ++ks2)
#pragma unroll
      for (int i = 0; i < 16; ++i) ps += fexp2(s[ks2][i] - msafe);
    l = l * fexp2(m - msafe) + ps;
    m = mnew;
  }
  {
    const float ltot = l + __shfl_xor(l, 32);
    const float invl = ltot > 0.f ? 1.f / ltot : 0.f;
    const float msafe = m == -INFINITY ? 0.f : m;
    tile_gload(tr, KCB, VCT, tid);
    for (int kt = 0; kt < ktn; ++kt) {
      __syncthreads();
      tile_sstore(sm, tr, true, tid);
      __syncthreads();
      if (kt + 1 < ktn) tile_gload(tr, KCB + (size_t)(kt + 1) * 4096, VCT + (size_t)(kt + 1) * 4096, tid);
      qk_tile(sm->k, qf, s, lane);
#pragma unroll
      for (int ks2 = 0; ks2 < 2; ++ks2)
#pragma unroll
        for (int i = 0; i < 16; ++i) {
          const int n = kt * 64 + ks2 * 32 + (i & 3) + 8 * (i >> 2) + 4 * hh;
          s[ks2][i] = n < nval ? fexp2(s[ks2][i] - msafe) * invl : 0.f;
        }
#pragma unroll
      for (int ks2 = 0; ks2 < 2; ++ks2)
#pragma unroll
        for (int g4 = 0; g4 < 4; ++g4) {
          float A = 2.f * (s[ks2][4 * g4] + s[ks2][4 * g4 + 1] + s[ks2][4 * g4 + 2]) + s[ks2][4 * g4 + 3];
          float Bv = s[ks2][4 * g4 + 3];
          A = quad_sum(A); Bv = quad_sum(Bv);
          const int j = kt * 16 + ks2 * 8 + 2 * g4 + hh;
          if (h == 0 && j < NBLK) sm->imp[trow][j] += A;
          WAVE_SYNC();
          if (h == 0 && j + 1 < NBLK) sm->imp[trow][j + 1] += Bv;
          WAVE_SYNC();
        }
      pv_tile(sm->vt, s, o, lane);
    }
#pragma unroll
    for (int mt = 0; mt < 2; ++mt)
#pragma unroll
      for (int g4 = 0; g4 < 4; ++g4) {
        st4(mixrow + mt * 32 + 8 * g4, make_float4(o[mt][4 * g4] * g0, o[mt][4 * g4 + 1] * g0, o[mt][4 * g4 + 2] * g0, o[mt][4 * g4 + 3] * g0));
        o[mt][4 * g4] = 0.f; o[mt][4 * g4 + 1] = 0.f; o[mt][4 * g4 + 2] = 0.f; o[mt][4 * g4 + 3] = 0.f;
      }
  }
  WAVE_SYNC();
  for (int t8 = 0; t8 < 8; ++t8) {
    const int row = wave * 8 + t8, tt = t0 + row, cur = tt >> 6;
    float kv[2]; bool valid[2];
#pragma unroll
    for (int c2 = 0; c2 < 2; ++c2) {
      const int j = lane + 64 * c2;
      valid[c2] = j < NBLK && j <= cur;
      const bool forced = (j == 0) | (j == cur) | (j == cur - 1);
      kv[c2] = valid[c2] ? (forced ? 1e6f : sm->imp[row][j < NBLK ? j : 0]) : -1.f;
      sm->keyb[wave][j] = kv[c2];
    }
    WAVE_SYNC();
    int rank0 = 0, rank1 = 0;
    const int jlim = cur < NBLK - 1 ? cur : NBLK - 1;
    for (int jj = 0; jj <= jlim; ++jj) {
      const float ov = sm->keyb[wave][jj];
      rank0 += (ov > kv[0] || (ov == kv[0] && jj < lane)) ? 1 : 0;
      rank1 += (ov > kv[1] || (ov == kv[1] && jj < lane + 64)) ? 1 : 0;
    }
    const unsigned long long m0 = __ballot(valid[0] && rank0 < 16);
    const unsigned long long m1 = __ballot(valid[1] && rank1 < 16);
    if (lane == 0) {
      sm->selmask[row][0] = (unsigned)m0; sm->selmask[row][1] = (unsigned)(m0 >> 32);
      sm->selmask[row][2] = (unsigned)m1; sm->selmask[row][3] = (unsigned)(m1 >> 32);
    }
    WAVE_SYNC();
  }
  __syncthreads();
  if (tid < 4) {
    unsigned u = 0;
    for (int r = 0; r < 32; ++r) u |= sm->selmask[r][tid];
    sm->unionm[tid] = u;
  }
  __syncthreads();
  const unsigned um0 = sm->unionm[0], um1 = sm->unionm[1], um2 = sm->unionm[2], um3 = sm->unionm[3];
  const unsigned my0 = sm->selmask[trow][0], my1 = sm->selmask[trow][1], my2 = sm->selmask[trow][2], my3 = sm->selmask[trow][3];
  {
    const int jmax = (t0 + 31) >> 6;
    int j = 0;
    while (j <= jmax && !testbit4(um0, um1, um2, um3, j)) ++j;
    m = -INFINITY; l = 0.f;
    if (j <= jmax) tile_gload(tr, KSB + (size_t)j * 4096, VST + (size_t)j * 4096, tid);
    while (j <= jmax) {
      __syncthreads();
      tile_sstore(sm, tr, true, tid);
      __syncthreads();
      int jn = j + 1;
      while (jn <= jmax && !testbit4(um0, um1, um2, um3, jn)) ++jn;
      if (jn <= jmax) tile_gload(tr, KSB + (size_t)jn * 4096, VST + (size_t)jn * 4096, tid);
      const bool mine = testbit4(my0, my1, my2, my3, j);
      if (__ballot(mine) != 0ull) {
        qk_tile(sm->k, qf, s, lane);
#pragma unroll
        for (int ks2 = 0; ks2 < 2; ++ks2)
#pragma unroll
          for (int i = 0; i < 16; ++i) {
            const int kp = j * 64 + ks2 * 32 + (i & 3) + 8 * (i >> 2) + 4 * hh;
            s[ks2][i] = (mine && kp <= tq) ? s[ks2][i] : -INFINITY;
          }
        softmax_step(s, m, l, o);
        pv_tile(sm->vt, s, o, lane);
      }
      j = jn;
    }
    const float ltot = l + __shfl_xor(l, 32);
    const float sc = ltot > 0.f ? g1 / ltot : 0.f;
#pragma unroll
    for (int mt = 0; mt < 2; ++mt)
#pragma unroll
      for (int g4 = 0; g4 < 4; ++g4) {
        float4 a = ld4(mixrow + mt * 32 + 8 * g4);
        a.x += o[mt][4 * g4] * sc; a.y += o[mt][4 * g4 + 1] * sc; a.z += o[mt][4 * g4 + 2] * sc; a.w += o[mt][4 * g4 + 3] * sc;
        st4(mixrow + mt * 32 + 8 * g4, a);
        o[mt][4 * g4] = 0.f; o[mt][4 * g4 + 1] = 0.f; o[mt][4 * g4 + 2] = 0.f; o[mt][4 * g4 + 3] = 0.f;
      }
  }
  {
    const int jlo = t0 - 511 > 0 ? (t0 - 511) >> 6 : 0, jhi = (t0 + 31) >> 6;
    const int wq0 = t0 + wave * 8;
    m = -INFINITY; l = 0.f;
    tile_gload(tr, KWB + (size_t)jlo * 4096, VWT + (size_t)jlo * 4096, tid);
    for (int j = jlo; j <= jhi; ++j) {
      __syncthreads();
      tile_sstore(sm, tr, true, tid);
      __syncthreads();
      if (j + 1 <= jhi) tile_gload(tr, KWB + (size_t)(j + 1) * 4096, VWT + (size_t)(j + 1) * 4096, tid);
      if (j * 64 <= wq0 + 7 && j * 64 + 63 > wq0 - 512) {
        qk_tile(sm->k, qf, s, lane);
#pragma unroll
        for (int ks2 = 0; ks2 < 2; ++ks2)
#pragma unroll
          for (int i = 0; i < 16; ++i) {
            const int kp = j * 64 + ks2 * 32 + (i & 3) + 8 * (i >> 2) + 4 * hh;
            s[ks2][i] = (kp <= tq && kp > tq - 512) ? s[ks2][i] : -INFINITY;
          }
        softmax_step(s, m, l, o);
        pv_tile(sm->vt, s, o, lane);
      }
    }
    const float ltot = l + __shfl_xor(l, 32);
    const float sc = ltot > 0.f ? g2 / ltot : 0.f;
#pragma unroll
    for (int mt = 0; mt < 2; ++mt)
#pragma unroll
      for (int g4 = 0; g4 < 4; ++g4) {
        float4 a = ld4(mixrow + mt * 32 + 8 * g4);
        a.x += o[mt][4 * g4] * sc; a.y += o[mt][4 * g4 + 1] * sc; a.z += o[mt][4 * g4 + 2] * sc; a.w += o[mt][4 * g4 + 3] * sc;
        st4(mixrow + mt * 32 + 8 * g4, a);
        o[mt][4 * g4] = 0.f; o[mt][4 * g4 + 1] = 0.f; o[mt][4 * g4 + 2] = 0.f; o[mt][4 * g4 + 3] = 0.f;
      }
  }
}

#define P1_SMEM ((8 * 64 + 8 * 128 + 64 * 65 + 128) * 4)
DEV void phase_p1(const Params& p, char* smem) {
  const int total = P1_CMPG_ITEMS + P1_CMPC1_ITEMS + P1_PREP_ITEMS;
  for (int it = BIDX; it < total; it += gridDim.x) {
    if (it < P1_CMPG_ITEMS) p1_cmpgemm(p, it, smem);
    else if (it < P1_CMPG_ITEMS + P1_CMPC1_ITEMS) p1_cmpc1(p, it - P1_CMPG_ITEMS, smem);
    else p1_prep(p, it - P1_CMPG_ITEMS - P1_CMPC1_ITEMS, smem);
  }
  {
    const int Gh = (int)gridDim.x / 2, bid_ = BIDX;
    if (bid_ < Gh) for (int it = bid_; it < P1_S5A_ITEMS; it += Gh) p1_s5a(p, it, smem);
  }
}
#define S5PFX_ITEMS (BATCH * 32 * 64 / NTHREADS)
DEV void s5_prefix(const Params& p, int item) {
  const int gi = item * NTHREADS + TIDX;
  const int lane = gi & 63, g = (gi >> 6) & 31, b = gi >> 11;
  float lb_re, lb_im, bbr[16], bbi[16];
  s5_consts(p, g, lane, lb_re, lb_im, bbr, bbi);
  float ar = lb_re, ai = lb_im;
#pragma unroll
  for (int s = 0; s < 6; ++s) { const float nr = ar * ar - ai * ai, ni = 2.f * ar * ai; ar = nr; ai = ni; }
  float2* E = (float2*)(p.ws + OFF_S5E) + ((size_t)b * S5_NC * 32 + g) * 64 + lane;
  float sr = 0.f, si = 0.f;
  for (int c = 0; c < S5_NC; c += 8) {
    float2 e[8];
#pragma unroll
    for (int q = 0; q < 8; ++q) e[q] = E[(size_t)(c + q) * 32 * 64];
#pragma unroll
    for (int q = 0; q < 8; ++q) {
      E[(size_t)(c + q) * 32 * 64] = make_float2(sr, si);
      const float nr = ar * sr - ai * si + e[q].x, ni = ar * si + ai * sr + e[q].y;
      sr = nr; si = ni;
    }
  }
}
DEV void phase_p1b(const Params& p, char* smem) {
  for (int it = BIDX; it < P1_CMP_ITEMS; it += gridDim.x) p1_compress(p, it, smem);
  for (int it = (int)gridDim.x - 1 - (int)BIDX; it < S5PFX_ITEMS; it += gridDim.x) s5_prefix(p, it);
}

#define P2_S5C_ITEMS (BATCH * 32 * S5_NC / 4)
#define P2_S5C_SMEM ((4 * 16 * S5C_ROW + 2 * 16 * 64 + 4 * 16 * 16) * 4)
DEV void p2_s5c(const Params& p, int item, char* smem) {
  const int lane = TIDX & 63, wave = TIDX >> 6, tid = TIDX;
  const int g = item & 31, c = ((item >> 5) % (S5_NC / 4)) * 4 + wave, b = item / (32 * (S5_NC / 4));
  float lb_re, lb_im;
  {
    float bbr[16], bbi[16];
    s5_consts(p, g, lane, lb_re, lb_im, bbr, bbi);
  }
  bf16x8 bB[4];
  s5_bfrags(p, g, lane, bB);
  const float2* E = (const float2*)(p.ws + OFF_S5E);
  const float2 e0 = E[((size_t)(b * S5_NC + c) * 32 + g) * 64 + lane];
  float sr = e0.x, si = e0.y;
  const float* H = (const float*)(p.ws + OFF_H);
  float* sS = (float*)smem + wave * 16 * S5C_ROW;
  float* sCre = (float*)smem + 4 * 16 * S5C_ROW;
  float* sCim = sCre + 16 * 64;
  float* su = sCim + 16 * 64 + wave * 16 * 16;
  __syncthreads();
  {
    const float* cre = p.in[I_S5_C_RE] + (size_t)g * 16 * 64;
    const float* cim = p.in[I_S5_C_IM] + (size_t)g * 16 * 64;
    st4(sCre + tid * 4, ld4(cre + tid * 4));
    st4(sCim + tid * 4, ld4(cim + tid * 4));
  }
  __syncthreads();
  const int nn = lane & 15, hh = lane >> 5;
  bf16x8 bC[8];
#pragma unroll
  for (int ks = 0; ks < 8; ++ks) {
    const float* src = (ks < 4 ? sCre : sCim) + nn * 64 + 16 * (ks & 3) + 8 * hh;
    float4 c0 = ld4(src), c1 = ld4(src + 4);
    if (ks >= 4) { c0 = make_float4(-c0.x, -c0.y, -c0.z, -c0.w); c1 = make_float4(-c1.x, -c1.y, -c1.z, -c1.w); }
    bC[ks] = pack_bf8(c0, c1);
  }
  const float dch = p.in[I_S5_D][g * 16 + nn];
  float* YG = (float*)(p.ws + OFF_YGELU);
  for (int sc = 0; sc < 4; ++sc) {
    {
      const float* ur = H + (size_t)(b * SEQ_LEN + c * 64 + sc * 16 + (lane >> 2)) * AB_LD + g * 16 + (lane & 3) * 4;
      st4(su + (lane >> 2) * 16 + (lane & 3) * 4, ld4(ur));
    }
    WAVE_SYNC();
    s5_subchunk(su, sS, bB, lb_re, lb_im, sr, si, lane);
    WAVE_SYNC();
    {
      f32x16 acc;
#pragma unroll
      for (int i = 0; i < 16; ++i) acc[i] = 0.f;
      const float* arow = sS + nn * S5C_ROW + 8 * hh;
#pragma unroll
      for (int ks = 0; ks < 8; ++ks) {
        const float* src = arow + 16 * ks;
        acc = __builtin_amdgcn_mfma_f32_32x32x16_bf16(pack_bf8(ld4(src), ld4(src + 4)), bC[ks], acc, 0, 0, 0);
      }
      if ((lane & 16) == 0) {
#pragma unroll
        for (int r8 = 0; r8 < 8; ++r8) {
          const int t = (r8 & 3) + 8 * (r8 >> 2) + 4 * hh;
          const size_t tok = (size_t)(b * SEQ_LEN + c * 64 + sc * 16 + t);
          YG[tok * 512 + g * 16 + nn] = geluf_(acc[r8] + dch * su[t * 16 + nn]);
        }
      }
    }
    WAVE_SYNC();
  }
}

#define P2_SMEM (P2_S5C_SMEM > P2_NSA_SMEM ? P2_S5C_SMEM : P2_NSA_SMEM)
DEV void phase_p2(const Params& p, char* smem) {
  const int G = gridDim.x;
  const int total = P2_NSA_ITEMS + P2_S5C_ITEMS;
  for (int r = 0;; ++r) {
    const int it = r * G + ((r & 1) ? (G - 1 - (int)BIDX) : (int)BIDX);
    if (r * G >= total) break;
    if (it >= total) continue;
    if (it < P2_NSA_ITEMS) p2_nsa(p, it, smem);
    else p2_s5c(p, it - P2_NSA_ITEMS, smem);
  }
}

DEV void phase_glu(const Params& p, char* smem) {
  const float* A = (const float*)(p.ws + OFF_YGELU);
  const float* B = p.in[I_S5_W_GLU];
  const float* bias = p.in[I_S5_B_GLU];
  float* MIX = (float*)(p.ws + OFF_MIX);
  const int NT = 4, MT = NTOK / GEMM_BM;
  const int xcd_ = BIDX & 7, lb_ = BIDX >> 3, nb_ = gridDim.x >> 3;
  for (int j_ = lb_; j_ < (MT / 8) * NT; j_ += nb_) {
    const int it = (xcd_ + 8 * (j_ / NT)) * NT + (j_ % NT);
    const int m0 = (it / NT) * GEMM_BM, n0 = (it % NT) * 128;
    gemm_tile<false>(
        [&](int r) { return (const void*)(A + (size_t)(m0 + r) * 512); },
        [&](int c) { return B + n0 + c; }, 512, 512,
        [&](int row, int col, float v0, float v1) {
          const size_t gm = m0 + row; const int gc = n0 + col;
          const float y0 = A[gm * 512 + gc], y1 = A[gm * 512 + gc + 32];
          MIX[gm * 1024 + gc] = y0 * sigmoidf_(v0 + bias[gc]);
          MIX[gm * 1024 + gc + 32] = y1 * sigmoidf_(v1 + bias[gc + 32]);
        },
        smem);
  }
}

template <int LAYER>
DEV void phase_outproj(const Params& p, char* smem) {
  const float* A = (const float*)(p.ws + OFF_MIX);
  const float* B = LAYER == 0 ? p.in[I_AB_W_OUT] : p.in[I_CD_W_OUT];
  const float* xin = LAYER == 0 ? p.in[I_X] : (const float*)(p.ws + OFF_X2);
  float* PRE = (float*)(p.ws + OFF_H);
  const int NT = 8, MT = NTOK / GEMM_BM;
  const int xcd_ = BIDX & 7, lb_ = BIDX >> 3, nb_ = gridDim.x >> 3;
  for (int j_ = lb_; j_ < (MT / 8) * NT; j_ += nb_) {
    const int it = (xcd_ + 8 * (j_ / NT)) * NT + (j_ % NT);
    const int m0 = (it / NT) * GEMM_BM, n0 = (it % NT) * 128;
    gemm_tile<false>(
        [&](int r) { return (const void*)(A + (size_t)(m0 + r) * 1024); },
        [&](int c) { return B + n0 + c; }, 1024, 1024,
        [&](int row, int col, float v0, float v1) {
          const size_t o = (size_t)(m0 + row) * 1024 + n0 + col;
          PRE[o] = ALPHA_F * xin[o] + v0;
          PRE[o + 32] = ALPHA_F * xin[o + 32] + v1;
        },
        smem);
  }
}

DEV void wave_ln(float (&v)[16], const float* gam, const float* bet, int lane) {
  float s = 0.f;
#pragma unroll
  for (int i = 0; i < 16; ++i) s += v[i];
  const float mu = wave_sum(s) * (1.f / 1024.f);
  float q = 0.f;
#pragma unroll
  for (int i = 0; i < 16; ++i) { const float d = v[i] - mu; q += d * d; }
  const float rstd = rsqrtf(wave_sum(q) * (1.f / 1024.f) + 1e-5f);
#pragma unroll
  for (int i = 0; i < 4; ++i) {
    const float4 gv = ld4(gam + lane * 4 + 256 * i), bv = ld4(bet + lane * 4 + 256 * i);
    v[i * 4 + 0] = (v[i * 4 + 0] - mu) * rstd * gv.x + bv.x;
    v[i * 4 + 1] = (v[i * 4 + 1] - mu) * rstd * gv.y + bv.y;
    v[i * 4 + 2] = (v[i * 4 + 2] - mu) * rstd * gv.z + bv.z;
    v[i * 4 + 3] = (v[i * 4 + 3] - mu) * rstd * gv.w + bv.w;
  }
}

#define LNR_T 4
#define P5_SMEM ((4 * LNR_T * 512 + 4 * 4 * LNR_T * 64 + 4 * 64) * 4)
template <int LAYER>
DEV void phase_ln_router(const Params& p, char* smem) {
  const int lane = TIDX & 63, wave = TIDX >> 6;
  const float* PRE = (const float*)(p.ws + OFF_H);
  float* X1 = (float*)(p.ws + OFF_X1);
  const float* router = p.in[I_ROUTER] + (size_t)LAYER * 1024 * 64;
  const float* bias = p.in[I_MOE_BIAS] + LAYER * 64;
  int* TOPI = (int*)(p.ws + OFF_TOPI);
  float* TOPG = (float*)(p.ws + OFF_TOPG);
  float* xh = (float*)smem;
  float* part = xh + 4 * LNR_T * 512;
  float* ms = part + 4 * 4 * LNR_T * 64 + wave * 64;
  unsigned short* X1B = (unsigned short*)p.out;
  for (int it = BIDX; it < NTOK / (4 * LNR_T); it += gridDim.x) {
    const size_t tokb = (size_t)it * (4 * LNR_T) + wave * LNR_T;
    float v[LNR_T][16];
#pragma unroll
    for (int t = 0; t < LNR_T; ++t) {
      const size_t tok = tokb + t;
#pragma unroll
      for (int i = 0; i < 4; ++i) {
        const float4 a = ld4(PRE + tok * 1024 + lane * 4 + 256 * i);
        v[t][i * 4] = a.x; v[t][i * 4 + 1] = a.y; v[t][i * 4 + 2] = a.z; v[t][i * 4 + 3] = a.w;
      }
      wave_ln(v[t], p.in[I_LN1_G] + LAYER * 1024, p.in[I_LN1_B] + LAYER * 1024, lane);
#pragma unroll
      for (int i = 0; i < 4; ++i) {
        const float4 a = make_float4(v[t][i * 4], v[t][i * 4 + 1], v[t][i * 4 + 2], v[t][i * 4 + 3]);
        st4(X1 + tok * 1024 + lane * 4 + 256 * i, a);
        *(uint2*)(X1B + tok * 1024 + lane * 4 + 256 * i) = make_uint2(pk2(a.x, a.y), pk2(a.z, a.w));
      }
    }
    {
      static_assert(LNR_T == 4, "the MFMA logits tile holds 16 tokens");
      const int hh = lane >> 5;
      f32x16 acc[2];
#pragma unroll
      for (int nt = 0; nt < 2; ++nt)
#pragma unroll
        for (int i = 0; i < 16; ++i) acc[nt][i] = 0.f;
#pragma unroll
      for (int hf = 0; hf < 2; ++hf) {
        __syncthreads();
#pragma unroll
        for (int t = 0; t < LNR_T; ++t)
#pragma unroll
          for (int i2 = 0; i2 < 2; ++i2) {
            const int i = 2 * hf + i2;
            st4(xh + (wave * LNR_T + t) * 512 + lane * 4 + 256 * i2, make_float4(v[t][i * 4], v[t][i * 4 + 1], v[t][i * 4 + 2], v[t][i * 4 + 3]));
          }
        __syncthreads();
#pragma unroll 2
        for (int kk = wave * 128; kk < wave * 128 + 128; kk += 16) {
          const int k = hf * 512 + kk;
          bf16x8 ahi, alo;
          {
            const float* xr = xh + (lane & 15) * 512 + kk + 8 * hh;
            const float4 x0 = ld4(xr), x1 = ld4(xr + 4);
            const unsigned h0 = pk2(x0.x, x0.y), h1 = pk2(x0.z, x0.w), h2 = pk2(x1.x, x1.y), h3 = pk2(x1.z, x1.w);
            union { uint4 u; bf16x8 v; } hi, lo;
            hi.u = make_uint4(h0, h1, h2, h3);
            lo.u = make_uint4(pk2(x0.x - bf2f((unsigned short)(h0 & 0xFFFF)), x0.y - bf2f((unsigned short)(h0 >> 16))),
                              pk2(x0.z - bf2f((unsigned short)(h1 & 0xFFFF)), x0.w - bf2f((unsigned short)(h1 >> 16))),
                              pk2(x1.x - bf2f((unsigned short)(h2 & 0xFFFF)), x1.y - bf2f((unsigned short)(h2 >> 16))),
                              pk2(x1.z - bf2f((unsigned short)(h3 & 0xFFFF)), x1.w - bf2f((unsigned short)(h3 >> 16))));
            ahi = hi.v; alo = lo.v;
          }
#pragma unroll
          for (int nt = 0; nt < 2; ++nt) {
            const float* rp = router + (size_t)(k + 8 * hh) * 64 + 32 * nt + (lane & 31);
            float rb[8];
#pragma unroll
            for (int j = 0; j < 8; ++j) rb[j] = rp[(size_t)j * 64];
            const unsigned h0 = pk2(rb[0], rb[1]), h1 = pk2(rb[2], rb[3]), h2 = pk2(rb[4], rb[5]), h3 = pk2(rb[6], rb[7]);
            union { uint4 u; bf16x8 v; } hi, lo;
            hi.u = make_uint4(h0, h1, h2, h3);
            lo.u = make_uint4(pk2(rb[0] - bf2f((unsigned short)(h0 & 0xFFFF)), rb[1] - bf2f((unsigned short)(h0 >> 16))),
                              pk2(rb[2] - bf2f((unsigned short)(h1 & 0xFFFF)), rb[3] - bf2f((unsigned short)(h1 >> 16))),
                              pk2(rb[4] - bf2f((unsigned short)(h2 & 0xFFFF)), rb[5] - bf2f((unsigned short)(h2 >> 16))),
                              pk2(rb[6] - bf2f((unsigned short)(h3 & 0xFFFF)), rb[7] - bf2f((unsigned short)(h3 >> 16))));
            acc[nt] = __builtin_amdgcn_mfma_f32_32x32x16_bf16(ahi, hi.v, acc[nt], 0, 0, 0);
            acc[nt] = __builtin_amdgcn_mfma_f32_32x32x16_bf16(ahi, lo.v, acc[nt], 0, 0, 0);
            acc[nt] = __builtin_amdgcn_mfma_f32_32x32x16_bf16(alo, hi.v, acc[nt], 0, 0, 0);
          }
        }
      }
#pragma unroll
      for (int nt = 0; nt < 2; ++nt)
#pragma unroll
        for (int r8 = 0; r8 < 8; ++r8)
          part[(wave * 4 * LNR_T + (r8 & 3) + 8 * (r8 >> 2) + 4 * hh) * 64 + 32 * nt + (lane & 31)] = acc[nt][r8];
    }
    __syncthreads();
    float lg[LNR_T];
#pragma unroll
    for (int t = 0; t < LNR_T; ++t) {
      const int tg = wave * LNR_T + t;
      lg[t] = ((part[(0 * 4 * LNR_T + tg) * 64 + lane] + part[(1 * 4 * LNR_T + tg) * 64 + lane]) + part[(2 * 4 * LNR_T + tg) * 64 + lane]) +
              part[(3 * 4 * LNR_T + tg) * 64 + lane];
    }
#pragma unroll
    for (int t = 0; t < LNR_T; ++t) {
      const size_t tok = tokb + t;
      const float score = 1.f / (1.f + expf(-lg[t]));
      const float biased = score + bias[lane];
      float m1 = biased; int a1 = lane;
#pragma unroll
      for (int mm = 1; mm <= 4; mm <<= 1) {
        const float ov = __shfl_xor(m1, mm); const int oa = __shfl_xor(a1, mm);
        if (ov > m1 || (ov == m1 && oa < a1)) { m1 = ov; a1 = oa; }
      }
      float m2 = lane == a1 ? -INFINITY : biased;
#pragma unroll
      for (int mm = 1; mm <= 4; mm <<= 1) m2 = fmaxf(m2, __shfl_xor(m2, mm));
      const float gs = m1 + m2;
      const int mygrp = lane >> 3;
      int rank = 0;
#pragma unroll
      for (int gg = 0; gg < 8; ++gg) {
        const float og = __shfl(gs, gg * 8);
        rank += (og > gs || (og == gs && gg < mygrp)) ? 1 : 0;
      }
      const float masked = rank < 4 ? biased : -INFINITY;
      WAVE_SYNC();
      ms[lane] = masked;
      WAVE_SYNC();
      int erank = 0;
      for (int e = 0; e < 64; ++e) {
        const float ov = ms[e];
        erank += (ov > masked || (ov == masked && e < lane)) ? 1 : 0;
      }
      const bool selected = erank < 8;
      const float gsum = wave_sum(selected ? score : 0.f);
      if (selected) {
        TOPI[tok * 8 + erank] = lane;
        TOPG[tok * 8 + erank] = score / gsum * 2.5f;
      }
    }
  }
}

#define P6_SMEM GEMM_SMEM_BYTES
template <int LAYER>
DEV void phase_lists_shup(const Params& p, char* smem) {
  const int tid = TIDX, lane = tid & 63, wave = tid >> 6;
  const int* TOPI = (const int*)(p.ws + OFF_TOPI);
  const float* TOPG = (const float*)(p.ws + OFF_TOPG);
  int* PPOS = (int*)(p.ws + OFF_S5E);
  int* CNT = (int*)(p.ws + OFF_CNT);
  int* LTOK = (int*)(p.ws + OFF_LTOK);
  float* LGATE = (float*)(p.ws + OFF_LGATE);
  const unsigned short* X1B = (const unsigned short*)p.out;
  unsigned short* HS = (unsigned short*)(p.ws + OFF_HS);
  const float* W1 = p.in[I_SH_W1] + (size_t)LAYER * 1024 * 256;
  const float* W3 = p.in[I_SH_W3] + (size_t)LAYER * 1024 * 256;
  const int MT = NTOK / GEMM_BM;
  int* swave = (int*)smem;
  for (int it = BIDX; it < 64; it += gridDim.x) {
    const int e = it;
    int base = 0;
    for (int t0 = 0; t0 < NTOK; t0 += 4 * NTHREADS) {
      const int tok4 = t0 + 4 * tid;
      int slot[4];
      unsigned long long bal[4];
#pragma unroll
      for (int j = 0; j < 4; ++j) {
        const int4 a = *(const int4*)(TOPI + (size_t)(tok4 + j) * 8), b = *(const int4*)(TOPI + (size_t)(tok4 + j) * 8 + 4);
        int sl = -1;
        sl = a.x == e ? 0 : sl; sl = a.y == e ? 1 : sl; sl = a.z == e ? 2 : sl; sl = a.w == e ? 3 : sl;
        sl = b.x == e ? 4 : sl; sl = b.y == e ? 5 : sl; sl = b.z == e ? 6 : sl; sl = b.w == e ? 7 : sl;
        slot[j] = sl;
        bal[j] = __ballot(sl >= 0);
      }
      const unsigned long long lower = (1ull << lane) - 1ull;
      int pre = 0, wtot = 0;
#pragma unroll
      for (int j = 0; j < 4; ++j) { pre += __popcll(bal[j] & lower); wtot += __popcll(bal[j]); }
      __syncthreads();
      if (lane == 0) swave[wave] = wtot;
      __syncthreads();
      int woff = 0, tot = 0;
#pragma unroll
      for (int w = 0; w < 4; ++w) { const int c = swave[w]; if (w < wave) woff += c; tot += c; }
      int pos = base + woff + pre;
#pragma unroll
      for (int j = 0; j < 4; ++j) {
        if (slot[j] >= 0) {
          const int tok = tok4 + j;
          LTOK[(size_t)e * NTOK + pos] = tok;
          LGATE[(size_t)e * NTOK + pos] = TOPG[(size_t)tok * 8 + slot[j]];
          PPOS[(size_t)e * NTOK + tok] = pos;
          ++pos;
        }
      }
      base += tot;
    }
    if (tid == 0) CNT[e * 32] = base;
    __syncthreads();
  }
  {
    const int NT = 4;
    const int xcd_ = BIDX & 7, lb_ = BIDX >> 3, nb_ = gridDim.x >> 3;
    for (int j_ = lb_; j_ < (MT / 8) * NT; j_ += nb_) {
      const int m0 = (xcd_ + 8 * (j_ / NT)) * GEMM_BM, ct = j_ % NT;
      gemm_tile<true>(
          [&](int r) { return (const void*)(X1B + (size_t)(m0 + r) * 1024); },
          [&](int c) { return (((c >> 5) & 1) ? W3 : W1) + ct * 64 + (c >> 6) * 32 + (c & 31); }, 256, 1024,
          [&](int row, int col, float v0, float v1) {
            const int lc = ct * 64 + (col >> 6) * 32 + (col & 31);
            HS[(size_t)(m0 + row) * 256 + lc] = f2bf(siluf_(v0) * v1);
          },
          smem);
    }
  }
}

struct ExpMap { int tstart[65]; int rbase[65]; int ltile[9]; };
DEV void build_expmap(const Params& p, ExpMap* em) {
  __syncthreads();
  if (TIDX == 0) {
    const int* CNT = (const int*)(p.ws + OFF_CNT);
    int ts = 0, rb = 0;
    for (int e = 0; e < 64; ++e) {
      em->tstart[e] = ts; em->rbase[e] = rb;
      const int c = CNT[e * 32];
      ts += (c + GEMM_BM - 1) / GEMM_BM; rb += c;
    }
    em->tstart[64] = ts; em->rbase[64] = rb;
    const int x = BIDX & 7;
    int lt = 0;
    for (int k = 0; k < 8; ++k) { em->ltile[k] = lt; lt += em->tstart[x + 8 * k + 1] - em->tstart[x + 8 * k]; }
    em->ltile[8] = lt;
  }
  __syncthreads();
}
DEV void map_expert_tile(const ExpMap* em, int j, int CT, int& e, int& rt, int& ct) {
  const int jr = j / CT; ct = j % CT;
  int k = 0;
  for (int q = 1; q < 8; ++q) if (em->ltile[q] <= jr) k = q;
  e = (BIDX & 7) + 8 * k; rt = jr - em->ltile[k];
}
#define P7_SMEM (GEMM_SMEM_BYTES + 1024)
template <int LAYER>
DEV void phase_routed_up(const Params& p, char* smem) {
  ExpMap* em = (ExpMap*)(smem + GEMM_SMEM_BYTES);
  build_expmap(p, em);
  const int* CNT = (const int*)(p.ws + OFF_CNT);
  const int* LTOK = (const int*)(p.ws + OFF_LTOK);
  const unsigned short* X1B = (const unsigned short*)p.out;
  unsigned short* HR = (unsigned short*)(p.ws + OFF_HR);
  const int lb_ = BIDX >> 3, nb_ = gridDim.x >> 3;
  for (int j_ = lb_; j_ < em->ltile[8] * 4; j_ += nb_) {
    int e, rtl, ct;
    map_expert_tile(em, j_, 4, e, rtl, ct);
    const int r0 = rtl * GEMM_BM;
    const int cnt = CNT[e * 32], rbase = em->rbase[e];
    const float* W1 = p.in[I_MOE_W1] + ((size_t)LAYER * 64 + e) * 1024 * 256;
    const float* W3 = p.in[I_MOE_W3] + ((size_t)LAYER * 64 + e) * 1024 * 256;
    gemm_tile<true>(
        [&](int r) { return (r0 + r < cnt) ? (const void*)(X1B + (size_t)LTOK[(size_t)e * NTOK + r0 + r] * 1024) : (const void*)nullptr; },
        [&](int c) { return (((c >> 5) & 1) ? W3 : W1) + ct * 64 + (c >> 6) * 32 + (c & 31); }, 256, 1024,
        [&](int row, int col, float v0, float v1) {
          if (r0 + row < cnt) {
            const int lc = ct * 64 + (col >> 6) * 32 + (col & 31);
            HR[(size_t)(rbase + r0 + row) * 256 + lc] = f2bf(siluf_(v0) * v1);
          }
        },
        smem);
  }
}

template <int LAYER>
DEV void phase_down(const Params& p, char* smem) {
  ExpMap* em = (ExpMap*)(smem + GEMM_SMEM_BYTES);
  build_expmap(p, em);
  const int* CNT = (const int*)(p.ws + OFF_CNT);
  const float* LGATE = (const float*)(p.ws + OFF_LGATE);
  const unsigned short* HR = (const unsigned short*)(p.ws + OFF_HR);
  const unsigned short* HS = (const unsigned short*)(p.ws + OFF_HS);
  unsigned short* Y = (unsigned short*)(p.ws + OFF_Y);
  float* FS = (float*)(p.ws + OFF_FS);
  const int xcd_ = BIDX & 7, lb_ = BIDX >> 3, nb_ = gridDim.x >> 3;
  for (int j_ = lb_; j_ < em->ltile[8] * 8; j_ += nb_) {
    int e, rtl, ct;
    map_expert_tile(em, j_, 8, e, rtl, ct);
    const int r0 = rtl * GEMM_BM;
    const int cnt = CNT[e * 32], rbase = em->rbase[e];
    const float* W2 = p.in[I_MOE_W2] + ((size_t)LAYER * 64 + e) * 256 * 1024;
    const int n0 = ct * 128;
    gemm_tile<true>(
        [&](int r) { return (r0 + r < cnt) ? (const void*)(HR + (size_t)(rbase + r0 + r) * 256) : (const void*)nullptr; },
        [&](int c) { return W2 + n0 + c; }, 1024, 256,
        [&](int row, int col, float v0, float v1) {
          if (r0 + row < cnt) {
            const float gt = LGATE[(size_t)e * NTOK + r0 + row];
            const size_t o = (size_t)(rbase + r0 + row) * 1024 + n0 + col;
            Y[o] = f2bf(v0 * gt); Y[o + 32] = f2bf(v1 * gt);
          }
        },
        smem);
  }
  {
    const int MT = NTOK / GEMM_BM, NT = 8;
    const float* W2 = p.in[I_SH_W2] + (size_t)LAYER * 256 * 1024;
    for (int j_ = lb_; j_ < (MT / 8) * NT; j_ += nb_) {
      const int m0 = (xcd_ + 8 * (j_ / NT)) * GEMM_BM, n0 = (j_ % NT) * 128;
      gemm_tile<true>(
          [&](int r) { return (const void*)(HS + (size_t)(m0 + r) * 256); },
          [&](int c) { return W2 + n0 + c; }, 1024, 256,
          [&](int row, int col, float v0, float v1) {
            const size_t o = (size_t)(m0 + row) * 1024 + n0 + col;
            FS[o] = v0; FS[o + 32] = v1;
          },
          smem);
    }
  }
}

template <int LAYER>
DEV void phase_combine(const Params& p, char* smem) {
  ExpMap* em = (ExpMap*)smem;
  build_expmap(p, em);
  const int lane = TIDX & 63, wave = TIDX >> 6;
  const float* X1 = (const float*)(p.ws + OFF_X1);
  const float* FS = (const float*)(p.ws + OFF_FS);
  const unsigned short* Y = (const unsigned short*)(p.ws + OFF_Y);
  const int* TOPI = (const int*)(p.ws + OFF_TOPI);
  const int* PPOS = (const int*)(p.ws + OFF_S5E);
  float* OUT = LAYER == 0 ? (float*)(p.ws + OFF_X2) : p.out;
  for (int it = BIDX; it < NTOK / 4; it += gridDim.x) {
    const size_t tok = (size_t)it * 4 + wave;
    float v[16];
#pragma unroll
    for (int i = 0; i < 4; ++i) {
      const float4 a = ld4(X1 + tok * 1024 + lane * 4 + 256 * i), f = ld4(FS + tok * 1024 + lane * 4 + 256 * i);
      v[i * 4] = ALPHA_F * a.x + f.x; v[i * 4 + 1] = ALPHA_F * a.y + f.y; v[i * 4 + 2] = ALPHA_F * a.z + f.z; v[i * 4 + 3] = ALPHA_F * a.w + f.w;
    }
    size_t rows[8];
#pragma unroll
    for (int s = 0; s < 8; ++s) { const int e_ = TOPI[tok * 8 + s]; rows[s] = (size_t)em->rbase[e_] + PPOS[(size_t)e_ * NTOK + tok]; }
#pragma unroll
    for (int s0 = 0; s0 < 8; s0 += 4) {
      uint2 yy[4][4];
#pragma unroll
      for (int s = 0; s < 4; ++s)
#pragma unroll
        for (int i = 0; i < 4; ++i) yy[s][i] = *(const uint2*)(Y + rows[s0 + s] * 1024 + lane * 4 + 256 * i);
#pragma unroll
      for (int s = 0; s < 4; ++s)
#pragma unroll
        for (int i = 0; i < 4; ++i) {
          const uint2 y = yy[s][i];
          v[i * 4] += bf2f((unsigned short)(y.x & 0xFFFF)); v[i * 4 + 1] += bf2f((unsigned short)(y.x >> 16));
          v[i * 4 + 2] += bf2f((unsigned short)(y.y & 0xFFFF)); v[i * 4 + 3] += bf2f((unsigned short)(y.y >> 16));
        }
    }
    wave_ln(v, p.in[I_LN2_G] + LAYER * 1024, p.in[I_LN2_B] + LAYER * 1024, lane);
#pragma unroll
    for (int i = 0; i < 4; ++i) st4(OUT + tok * 1024 + lane * 4 + 256 * i, make_float4(v[i * 4], v[i * 4 + 1], v[i * 4 + 2], v[i * 4 + 3]));
    if (LAYER == 0) {
      unsigned short* X2B = (unsigned short*)(p.ws + OFF_X2B);
#pragma unroll
      for (int i = 0; i < 4; ++i) *(uint2*)(X2B + tok * 1024 + lane * 4 + 256 * i) = make_uint2(pk2(v[i * 4], v[i * 4 + 1]), pk2(v[i * 4 + 2], v[i * 4 + 3]));
    }
  }
}

DEV float shifted(const float* Hc, size_t tok, int col, const float* mu) {
  const float cur = Hc[tok * 1792 + col];
  const float prev = (tok % SEQ_LEN) == 0 ? 0.f : Hc[(tok - 1) * 1792 + col];
  return cur + (prev - cur) * mu[col];
}

#define RWP_T 32
#define P11_PREP_ITEMS (NTOK / RWP_T)
#define P11_KV_ITEMS (BATCH * 4 * RET_NC)
#define P11_SMEM (RWP_T * 128 * 4)
DEV void p11_prep(const Params& p, int item, char* smem) {
  const int tid = TIDX;
  const float* Hc = (const float*)(p.ws + OFF_H);
  const float* mu = p.in[I_RW_MU];
  float* sl = (float*)smem;
  __syncthreads();
  for (int w = tid; w < RWP_T * 128; w += NTHREADS) {
    const int tt = w >> 7, j = w & 127;
    const size_t tok = (size_t)item * RWP_T + tt;
    const float v = shifted(Hc, tok, 1536 + j, mu);
    sl[w] = j < 64 ? tanhf(v) : v;
    ((float*)(p.ws + OFF_GLO))[tok * 128 + j] = sigmoidf_(shifted(Hc, tok, 1664 + j, mu));
  }
  __syncthreads();
  float* RWW = (float*)(p.ws + OFF_RWW); float* RWK = (float*)(p.ws + OFF_RWK);
  float* RWKK = (float*)(p.ws + OFF_RWKK); float* RWA = (float*)(p.ws + OFF_RWA);
  float* RWR = p.out + (size_t)NTOK * 512; float* RWV = p.out;
  const float* w_up = p.in[I_RW_W_UP]; const float* a_up = p.in[I_RW_A_UP];
#pragma unroll
  for (int cc = 0; cc < 2; ++cc) {
    const int c = tid + 256 * cc;
    float aw[RWP_T], aa[RWP_T];
#pragma unroll
    for (int tt = 0; tt < RWP_T; ++tt) { aw[tt] = 0.f; aa[tt] = 0.f; }
    for (int j0 = 0; j0 < 64; j0 += 16) {
      float wu[16], au[16];
#pragma unroll
      for (int q = 0; q < 16; ++q) { wu[q] = w_up[(j0 + q) * 512 + c]; au[q] = a_up[(j0 + q) * 512 + c]; }
#pragma unroll
      for (int q4 = 0; q4 < 4; ++q4) {
#pragma unroll
        for (int tt = 0; tt < RWP_T; ++tt) {
          const float4 sw = ld4(sl + tt * 128 + j0 + q4 * 4), sa = ld4(sl + tt * 128 + 64 + j0 + q4 * 4);
          aw[tt] += sw.x * wu[q4 * 4] + sw.y * wu[q4 * 4 + 1] + sw.z * wu[q4 * 4 + 2] + sw.w * wu[q4 * 4 + 3];
          aa[tt] += sa.x * au[q4 * 4] + sa.y * au[q4 * 4 + 1] + sa.z * au[q4 * 4 + 2] + sa.w * au[q4 * 4 + 3];
        }
      }
    }
    const float w0 = p.in[I_RW_W0][c], a0 = p.in[I_RW_A0][c], kkc = p.in[I_RW_K_K][c], kac = p.in[I_RW_K_A][c];
#pragma unroll 4
    for (int tt = 0; tt < RWP_T; ++tt) {
      const size_t tok = (size_t)item * RWP_T + tt;
      const float lw = w0 + aw[tt];
      const float nl = -lw;
      const float sp = nl > 20.f ? nl : log1pf(expf(nl));
      const float wl = -sp - 0.5f;
      const float decay = expf(-expf(wl));
      const float a = 1.f / (1.f + expf(-(a0 + aa[tt])));
      const float rs = shifted(Hc, tok, c, mu);
      const float ks = shifted(Hc, tok, 512 + c, mu);
      const float vs = shifted(Hc, tok, 1024 + c, mu);
      float kk = ks * kkc;
      const float nrm = sqrtf(wave_sum(kk * kk));
      kk = kk / fmaxf(nrm, 1e-12f);
      RWW[tok * 512 + c] = decay;
      RWK[tok * 512 + c] = ks * (1.f + (a - 1.f) * kac);
      RWKK[tok * 512 + c] = kk;
      RWA[tok * 512 + c] = kk * a;
      RWR[tok * 512 + c] = rs;
      RWV[tok * 512 + c] = vs;
    }
  }
}
DEV float ret_log2gamma(int h) { return log2f(1.f - exp2f(-5.f - (float)h)); }
struct KvSmem { unsigned short vt[128][72]; unsigned short kt[64][72]; };
#define P11_KV_SMEM ((int)sizeof(KvSmem))
DEV void p11_kv(const Params& p, int item, char* smem) {
  KvSmem* sm = (KvSmem*)smem;
  const int c = item % RET_NC, h = (item / RET_NC) & 3, b = item / (RET_NC * 4);
  const int tid = TIDX, lane = tid & 63, wave = tid >> 6;
  const int r = lane & 31, hh = lane >> 5;
  const float* H2 = (const float*)(p.ws + OFF_H2);
  const float lg = ret_log2gamma(h);
  const size_t tok0 = (size_t)b * SEQ_LEN + c * 128;
  f32x16 acc[2];
#pragma unroll
  for (int nt = 0; nt < 2; ++nt)
#pragma unroll
    for (int i = 0; i < 16; ++i) acc[nt][i] = 0.f;
#pragma unroll 1
  for (int kt = 0; kt < 2; ++kt) {
    __syncthreads();
#pragma unroll
    for (int q = 0; q < 8; ++q) {
      const int f = tid + 256 * q;
      const int key = f >> 5, d4 = (f & 31) * 4;
      const float dec = exp2f((float)(127 - (kt * 64 + key)) * lg);
      const float4 v = ld4(H2 + (tok0 + kt * 64 + key) * 1536 + 512 + h * 128 + d4);
      sm->vt[d4][key] = f2bf(v.x * dec); sm->vt[d4 + 1][key] = f2bf(v.y * dec);
      sm->vt[d4 + 2][key] = f2bf(v.z * dec); sm->vt[d4 + 3][key] = f2bf(v.w * dec);
    }
#pragma unroll
    for (int q = 0; q < 4; ++q) {
      const int f = tid + 256 * q;
      const int key = f >> 4, d4 = (f & 15) * 4;
      const float4 v = ld4(H2 + (tok0 + kt * 64 + key) * 1536 + 256 + h * 64 + d4);
      sm->kt[d4][key] = f2bf(v.x); sm->kt[d4 + 1][key] = f2bf(v.y); sm->kt[d4 + 2][key] = f2bf(v.z); sm->kt[d4 + 3][key] = f2bf(v.w);
    }
    __syncthreads();
#pragma unroll
    for (int ks = 0; ks < 4; ++ks) {
      const bf16x8 a = *(const bf16x8*)&sm->vt[wave * 32 + r][ks * 16 + hh * 8];
#pragma unroll
      for (int nt = 0; nt < 2; ++nt) {
        const bf16x8 bb = *(const bf16x8*)&sm->kt[nt * 32 + r][ks * 16 + hh * 8];
        acc[nt] = __builtin_amdgcn_mfma_f32_32x32x16_bf16(a, bb, acc[nt], 0, 0, 0);
      }
    }
  }
  float* KV = (float*)(p.ws + OFF_RETKV) + (size_t)item * 64 * 128;
#pragma unroll
  for (int nt = 0; nt < 2; ++nt)
#pragma unroll
    for (int g4 = 0; g4 < 4; ++g4)
      st4(KV + (nt * 32 + r) * 128 + wave * 32 + 8 * g4 + 4 * hh,
          make_float4(acc[nt][4 * g4], acc[nt][4 * g4 + 1], acc[nt][4 * g4 + 2], acc[nt][4 * g4 + 3]));
}
DEV void phase_p11(const Params& p, char* smem) {
  {
    unsigned* RKF = (unsigned*)(p.ws + OFF_RKF);
    for (int i = BIDX * NTHREADS + TIDX; i < BATCH * 8 * (SEQ_LEN / 32); i += gridDim.x * NTHREADS) RKF[i] = 0u;
  }
  const int total = P11_PREP_ITEMS + P11_KV_ITEMS;
  for (int it = BIDX; it < total; it += gridDim.x) {
    if (it < P11_KV_ITEMS) p11_kv(p, it, smem);
    else p11_prep(p, it - P11_KV_ITEMS, smem);
  }
}

#define RK_T 32
#define RK_NCH (SEQ_LEN / RK_T)
#define RK_NCHT (BATCH * 8 * RK_NCH)
#define OFF_RKPT OFF_H
#define OFF_RKKT (OFF_RKPT + (size_t)RK_NCHT * 64 * 64 * 2)
#define OFF_RKVT (OFF_RKKT + (size_t)RK_NCHT * 64 * 32 * 2)
#define OFF_RKRT (OFF_RKVT + (size_t)RK_NCHT * 64 * 32 * 2)
#define OFF_RKAT (OFF_RKRT + (size_t)RK_NCHT * 32 * 64 * 2)
#define OFF_RKEND (OFF_RKAT + (size_t)RK_NCHT * 32 * 32 * 2)
static_assert(OFF_RKEND <= OFF_H2, "rk buffers must fit in the H1 region");
#define RKPRE_SMEM ((4 * 32 * 64 + 32 * 64) * 4)

DEV unsigned short* rksc_row(char* ws, int b, int h, int c, int i) {
  return (unsigned short*)(ws + OFF_RWW) + (((size_t)b * SEQ_LEN + (size_t)c * RK_T + (i >> 1)) * 512 + h * 64) * 2 + (i & 1) * 64;
}
#if RK_MERGED
DEV void st_wt_u16(unsigned short* q, unsigned short v) { asm volatile("global_store_short %0, %1, off sc1" :: "v"(q), "v"((unsigned)v) : "memory"); }
typedef unsigned u32x4_t __attribute__((ext_vector_type(4)));
DEV void st_wt_b128(void* q, uint4 v) { const u32x4_t w = {v.x, v.y, v.z, v.w}; asm volatile("global_store_dwordx4 %0, %1, off sc1" :: "v"(q), "v"(w) : "memory"); }
#else
DEV void st_wt_u16(unsigned short* q, unsigned short v) { *q = v; }
DEV void st_wt_b128(void* q, uint4 v) { *(uint4*)q = v; }
#endif
DEV void rk_precompute(const Params& p, int ch, char* smem) {
  const int c = ch % RK_NCH, bh = ch / RK_NCH, h = bh & 7, b = bh >> 3;
  const int tid = TIDX, lane = tid & 63, wave = tid >> 6;
  const size_t tok0 = (size_t)b * SEQ_LEN + (size_t)c * RK_T;
  const float* RWW = (const float*)(p.ws + OFF_RWW); const float* RWK = (const float*)(p.ws + OFF_RWK);
  const float* RWKK = (const float*)(p.ws + OFF_RWKK); const float* RWA = (const float*)(p.ws + OFF_RWA);
  const float* RWR = p.out + (size_t)NTOK * 512; const float* RWV = p.out;
  float* sW = (float*)smem;
  float* sNK = sW + 32 * 64;
  float* sKA = sNK + 32 * 64;
  float* sR = sKA + 32 * 64;
  float* sV = sR + 32 * 64;
  __syncthreads();
  for (int w = tid; w < 32 * 16; w += NTHREADS) {
    const int t = w >> 4, c4 = (w & 15) * 4;
    const size_t o = (tok0 + t) * 512 + h * 64 + c4;
    st4(sW + t * 64 + c4, ld4(RWW + o));
    const float4 kk = ld4(RWKK + o);
    st4(sNK + t * 64 + c4, make_float4(-kk.x, -kk.y, -kk.z, -kk.w));
    st4(sKA + t * 64 + c4, ld4(RWA + o));
    st4(sR + t * 64 + c4, ld4(RWR + o));
    st4(sV + t * 64 + c4, ld4(RWV + o));
  }
  __syncthreads();
  const int wrole = (wave + ((BIDX >= (gridDim.x >> 1)) ? 2 : 0)) & 3;
  if (wrole == 0) {
    float z[64];
#pragma unroll
    for (int j = 0; j < 64; ++j) z[j] = (j == lane) ? 1.f : 0.f;
    for (int t = 0; t < RK_T; ++t) {
      float cacc = 0.f;
#pragma unroll
      for (int j4 = 0; j4 < 16; ++j4) {
        const float4 u = ld4(sNK + t * 64 + j4 * 4);
        cacc += z[j4 * 4] * u.x + z[j4 * 4 + 1] * u.y + z[j4 * 4 + 2] * u.z + z[j4 * 4 + 3] * u.w;
      }
#pragma unroll
      for (int j4 = 0; j4 < 16; ++j4) {
        const float4 w = ld4(sW + t * 64 + j4 * 4), v = ld4(sKA + t * 64 + j4 * 4);
        z[j4 * 4] = z[j4 * 4] * w.x + cacc * v.x; z[j4 * 4 + 1] = z[j4 * 4 + 1] * w.y + cacc * v.y;
        z[j4 * 4 + 2] = z[j4 * 4 + 2] * w.z + cacc * v.z; z[j4 * 4 + 3] = z[j4 * 4 + 3] * w.w + cacc * v.w;
      }
    }
    unsigned short* PT = (unsigned short*)(p.ws + OFF_RKPT) + (size_t)ch * 64 * 64;
#pragma unroll
    for (int j = 0; j < 64; ++j) st_wt_u16(PT + j * 64 + lane, f2bf(z[j]));
  } else if (wrole == 1) {
    const bool isA = lane < 32;
    const int me = lane & 31;
    float q[64];
    {
      const float* src = (isA ? RWK : RWR) + (tok0 + me) * 512 + h * 64;
#pragma unroll
      for (int j4 = 0; j4 < 16; ++j4) { const float4 v = ld4(src + j4 * 4); q[j4 * 4] = v.x; q[j4 * 4 + 1] = v.y; q[j4 * 4 + 2] = v.z; q[j4 * 4 + 3] = v.w; }
    }
    const float* Ub = isA ? sNK : sKA;
    const float* Vb = isA ? sKA : sNK;
    unsigned short* AT = (unsigned short*)(p.ws + OFF_RKAT) + (size_t)ch * 32 * 32;
    for (int u = 0; u < RK_T; ++u) {
      const int tt = isA ? u : RK_T - 1 - u;
      const bool upd = isA ? (u > me) : (tt <= me);
      if (upd) {
        float cacc = 0.f;
#pragma unroll
        for (int j4 = 0; j4 < 16; ++j4) {
          const float4 uu = ld4(Ub + tt * 64 + j4 * 4);
          cacc += q[j4 * 4] * uu.x + q[j4 * 4 + 1] * uu.y + q[j4 * 4 + 2] * uu.z + q[j4 * 4 + 3] * uu.w;
        }
#pragma unroll
        for (int j4 = 0; j4 < 16; ++j4) {
          const float4 w = ld4(sW + tt * 64 + j4 * 4), v = ld4(Vb + tt * 64 + j4 * 4);
          q[j4 * 4] = q[j4 * 4] * w.x + cacc * v.x; q[j4 * 4 + 1] = q[j4 * 4 + 1] * w.y + cacc * v.y;
          q[j4 * 4 + 2] = q[j4 * 4 + 2] * w.z + cacc * v.z; q[j4 * 4 + 3] = q[j4 * 4 + 3] * w.w + cacc * v.w;
        }
      }
      if (isA) {
        float av = 0.f;
        if (u >= me) {
#pragma unroll
          for (int j4 = 0; j4 < 16; ++j4) {
            const float4 rr = ld4(sR + u * 64 + j4 * 4);
            av += q[j4 * 4] * rr.x + q[j4 * 4 + 1] * rr.y + q[j4 * 4 + 2] * rr.z + q[j4 * 4 + 3] * rr.w;
          }
        }
        AT[u * 32 + me] = f2bf(av);
      }
    }
    if (isA) {
      unsigned short* KT = (unsigned short*)(p.ws + OFF_RKKT) + (size_t)ch * 64 * 32;
#pragma unroll
      for (int j = 0; j < 64; ++j) st_wt_u16(KT + j * 32 + me, f2bf(q[j]));
    } else {
      unsigned short* RT = (unsigned short*)(p.ws + OFF_RKRT) + ((size_t)ch * 32 + me) * 64;
#pragma unroll
      for (int j8 = 0; j8 < 8; ++j8)
        *(uint4*)(RT + j8 * 8) = make_uint4(pk2(q[j8 * 8], q[j8 * 8 + 1]), pk2(q[j8 * 8 + 2], q[j8 * 8 + 3]), pk2(q[j8 * 8 + 4], q[j8 * 8 + 5]), pk2(q[j8 * 8 + 6], q[j8 * 8 + 7]));
    }
  } else if (wrole == 2) {
    unsigned short* VT = (unsigned short*)(p.ws + OFF_RKVT) + (size_t)ch * 64 * 32;
#pragma unroll
    for (int t8 = 0; t8 < 4; ++t8) {
      float v[8];
#pragma unroll
      for (int q8 = 0; q8 < 8; ++q8) v[q8] = sV[(t8 * 8 + q8) * 64 + lane];
      st_wt_b128(VT + lane * 32 + t8 * 8, make_uint4(pk2(v[0], v[1]), pk2(v[2], v[3]), pk2(v[4], v[5]), pk2(v[6], v[7])));
    }
  }
#if RK_MERGED
  asm volatile("s_waitcnt vmcnt(0)" ::: "memory");
  __syncthreads();
  if (tid == 0) __hip_atomic_store((unsigned*)(p.ws + OFF_RKF) + ch, 1u, __ATOMIC_RELAXED, __HIP_MEMORY_SCOPE_AGENT);
#endif
}
DEV void phase_retpfx(const Params& p, char* smem);
DEV void phase_rkpre(const Params& p, char* smem) {
  phase_retpfx(p, smem);
  for (int it = BIDX; it < RK_NCHT; it += gridDim.x) rk_precompute(p, (it % (BATCH * 8)) * RK_NCH + it / (BATCH * 8), smem);
}

DEV bf16x8 ld_frag2(const unsigned short* p0, const unsigned short* p1) {
  const uint2 lo = *(const uint2*)p0, hi = *(const uint2*)p1;
  union { uint4 u; bf16x8 v; } x;
  x.u = make_uint4(lo.x, lo.y, hi.x, hi.y);
  return x.v;
}
DEV bf16x8 ld_frag(const unsigned short* p0) {
  union { uint4 u; bf16x8 v; } x;
  x.u = *(const uint4*)p0;
  return x.v;
}
DEV unsigned rk_flag_ld(const unsigned* f) {
#if RK_MERGED
  return __hip_atomic_load(f, __ATOMIC_RELAXED, __HIP_MEMORY_SCOPE_AGENT);
#else
  return 1u;
#endif
}
DEV void rk_flag_wait(const unsigned* f, unsigned flv) {
#if RK_MERGED
  asm volatile("" : "+v"(flv));
  unsigned fl = (unsigned)__builtin_amdgcn_readfirstlane((int)flv);
  unsigned sp = 0;
  while (fl == 0u) {
    __builtin_amdgcn_s_sleep(1);
    fl = (unsigned)__builtin_amdgcn_readfirstlane((int)__hip_atomic_load(f, __ATOMIC_RELAXED, __HIP_MEMORY_SCOPE_AGENT));
    if (++sp > (1u << 21)) break;
  }
  asm volatile("buffer_inv sc1" ::: "memory");
#endif
}
#define RK_PREFETCH(S, c_)                                                                                                      \
  {                                                                                                                             \
    const size_t chp_ = (size_t)bh * RK_NCH + (c_);                                                                             \
    _Pragma("unroll") for (int jt = 0; jt < 2; ++jt) _Pragma("unroll") for (int kb = 0; kb < 2; ++kb)                          \
        _Pragma("unroll") for (int s_ = 0; s_ < 2; ++s_) {                                                                      \
      const unsigned short* q0 = PTb + (chp_ * 64 + jt * 32 + r) * 64 + kb * 32 + 16 * s_ + 4 * hh;                             \
      pa##S[jt][kb][s_] = ld_frag2(q0, q0 + 8);                                                                                 \
    }                                                                                                                           \
    _Pragma("unroll") for (int jt = 0; jt < 2; ++jt) _Pragma("unroll") for (int ks = 0; ks < 2; ++ks)                          \
        ka##S[jt][ks] = ld_frag(KTb + (chp_ * 64 + jt * 32 + r) * 32 + 16 * ks + 8 * hh);                                       \
    _Pragma("unroll") for (int ks = 0; ks < 2; ++ks) vb##S[ks] = ld_frag(VTb + (chp_ * 64 + it * 32 + r) * 32 + 16 * ks + 8 * hh); \
  }
#define RK_STEP(S, c_)                                                                                                          \
  {                                                                                                                             \
    unsigned short* scr_ = rksc_row(p.ws, bh >> 3, bh & 7, (c_), it * 32 + r);                                                  \
    _Pragma("unroll") for (int kb = 0; kb < 2; ++kb) _Pragma("unroll") for (int g4 = 0; g4 < 4; ++g4)                          \
        *(uint2*)(scr_ + kb * 32 + 8 * g4 + 4 * hh) =                                                                           \
            make_uint2(pk2(X[kb][4 * g4], X[kb][4 * g4 + 1]), pk2(X[kb][4 * g4 + 2], X[kb][4 * g4 + 3]));                       \
    bf16x8 bh_[2][2], bl_[2][2];                                                                                                \
    _Pragma("unroll") for (int kb = 0; kb < 2; ++kb) _Pragma("unroll") for (int s_ = 0; s_ < 2; ++s_) {                        \
      union { uint4 u; bf16x8 v; } hi, lo;                                                                                      \
      unsigned hw[4], lw[4];                                                                                                    \
      _Pragma("unroll") for (int q2 = 0; q2 < 4; ++q2) {                                                                        \
        const float x0 = X[kb][8 * s_ + 2 * q2], x1 = X[kb][8 * s_ + 2 * q2 + 1];                                               \
        const unsigned hp = pk2(x0, x1);                                                                                        \
        hw[q2] = hp;                                                                                                            \
        lw[q2] = pk2(x0 - bf2f((unsigned short)(hp & 0xFFFF)), x1 - bf2f((unsigned short)(hp >> 16)));                          \
      }                                                                                                                         \
      hi.u = make_uint4(hw[0], hw[1], hw[2], hw[3]); lo.u = make_uint4(lw[0], lw[1], lw[2], lw[3]);                             \
      bh_[kb][s_] = hi.v; bl_[kb][s_] = lo.v;                                                                                   \
    }                                                                                                                           \
    f32x16 acc[2];                                                                                                              \
    _Pragma("unroll") for (int jt = 0; jt < 2; ++jt) {                                                                          \
      _Pragma("unroll") for (int i = 0; i < 16; ++i) acc[jt][i] = 0.f;                                                          \
      _Pragma("unroll") for (int kb = 0; kb < 2; ++kb) _Pragma("unroll") for (int s_ = 0; s_ < 2; ++s_) {                      \
        acc[jt] = __builtin_amdgcn_mfma_f32_32x32x16_bf16(pa##S[jt][kb][s_], bh_[kb][s_], acc[jt], 0, 0, 0);                    \
        acc[jt] = __builtin_amdgcn_mfma_f32_32x32x16_bf16(pa##S[jt][kb][s_], bl_[kb][s_], acc[jt], 0, 0, 0);                    \
      }                                                                                                                         \
      _Pragma("unroll") for (int ks = 0; ks < 2; ++ks)                                                                          \
          acc[jt] = __builtin_amdgcn_mfma_f32_32x32x16_bf16(ka##S[jt][ks], vb##S[ks], acc[jt], 0, 0, 0);                        \
    }                                                                                                                           \
    if ((c_) + 2 < RK_NCH) {                                                                                                    \
      rk_flag_wait(RKFb + (c_) + 2, fl##S);                                                                                     \
      fl##S = rk_flag_ld(RKFb + ((c_) + 4 < RK_NCH ? (c_) + 4 : RK_NCH - 1));          \
      RK_PREFETCH(S, (c_) + 2);                                                                                                 \
    }                                                                                                                           \
    X[0] = acc[0]; X[1] = acc[1];                                                                                               \
  }
DEV void rk_chain(const Params& p, int bh) {
  const int tid = TIDX, lane = tid & 63, wave = tid >> 6;
  if (wave >= 2) return;
  const int r = lane & 31, hh = lane >> 5, it = wave;
  const unsigned short* PTb = (const unsigned short*)(p.ws + OFF_RKPT);
  const unsigned short* KTb = (const unsigned short*)(p.ws + OFF_RKKT);
  const unsigned short* VTb = (const unsigned short*)(p.ws + OFF_RKVT);
  const unsigned* RKFb = (const unsigned*)(p.ws + OFF_RKF) + (size_t)bh * RK_NCH;
  f32x16 X[2];
#pragma unroll
  for (int kb = 0; kb < 2; ++kb)
#pragma unroll
    for (int i = 0; i < 16; ++i) X[kb][i] = 0.f;
  bf16x8 paA[2][2][2], kaA[2][2], vbA[2], paB[2][2][2], kaB[2][2], vbB[2];
  rk_flag_wait(RKFb, rk_flag_ld(RKFb));
  RK_PREFETCH(A, 0);
  rk_flag_wait(RKFb + 1, rk_flag_ld(RKFb + 1));
  RK_PREFETCH(B, 1);
  unsigned flA = rk_flag_ld(RKFb + 2), flB = rk_flag_ld(RKFb + 3);
  for (int c = 0; c < RK_NCH; c += 2) {
    RK_STEP(A, c);
    if (c + 1 < RK_NCH) RK_STEP(B, c + 1);
  }
}
DEV void rk_output(const Params& p, int item) {
  const int tid = TIDX, lane = tid & 63, wave = tid >> 6;
  const int ch = item * 4 + wave;
  const int c = ch % RK_NCH, bhh = ch / RK_NCH, h = bhh & 7, b = bhh >> 3;
  const int r = lane & 31, hh = lane >> 5;
  const unsigned short* RT = (const unsigned short*)(p.ws + OFF_RKRT) + (size_t)ch * 32 * 64;
  const unsigned short* AT = (const unsigned short*)(p.ws + OFF_RKAT) + (size_t)ch * 32 * 32;
  const unsigned short* VT = (const unsigned short*)(p.ws + OFF_RKVT) + (size_t)ch * 64 * 32;
  f32x16 acc[2];
#pragma unroll
  for (int i2 = 0; i2 < 2; ++i2)
#pragma unroll
    for (int i = 0; i < 16; ++i) acc[i2][i] = 0.f;
#pragma unroll
  for (int ks = 0; ks < 4; ++ks) {
    const bf16x8 a = ld_frag(RT + r * 64 + 16 * ks + 8 * hh);
#pragma unroll
    for (int i2 = 0; i2 < 2; ++i2) acc[i2] = __builtin_amdgcn_mfma_f32_32x32x16_bf16(a, ld_frag(rksc_row(p.ws, b, h, c, i2 * 32 + r) + 16 * ks + 8 * hh), acc[i2], 0, 0, 0);
  }
#pragma unroll
  for (int ks = 0; ks < 2; ++ks) {
    const bf16x8 a = ld_frag(AT + r * 32 + 16 * ks + 8 * hh);
#pragma unroll
    for (int i2 = 0; i2 < 2; ++i2) acc[i2] = __builtin_amdgcn_mfma_f32_32x32x16_bf16(a, ld_frag(VT + (i2 * 32 + r) * 32 + 16 * ks + 8 * hh), acc[i2], 0, 0, 0);
  }
  float* Yo = (float*)(p.ws + OFF_MIX);
  const size_t tok0 = (size_t)b * SEQ_LEN + (size_t)c * RK_T;
#pragma unroll
  for (int i2 = 0; i2 < 2; ++i2)
#pragma unroll
    for (int i = 0; i < 16; ++i) {
      const int t = (i & 3) + 8 * (i >> 2) + 4 * hh;
      Yo[(tok0 + t) * 1024 + h * 64 + i2 * 32 + r] = acc[i2][i];
    }
}
#define OFF_RWG OFF_RWKK
DEV void phase_rkout(const Params& p, char* smem) {
  {
    const float* GLO = (const float*)(p.ws + OFF_GLO);
    const float* g_up = p.in[I_RW_G_UP];
    float* G = (float*)(p.ws + OFF_RWG);
    for (int t = BIDX; t < (NTOK / GEMM_BM) * 4; t += gridDim.x) {
      const int m0 = (t >> 2) * GEMM_BM, n0 = (t & 3) * 128;
      gemm_tile<false>(
          [&](int r) { return (const void*)(GLO + (size_t)(m0 + r) * 128); },
          [&](int c) { return g_up + n0 + c; }, 512, 128,
          [&](int row, int col, float v0, float v1) {
            const size_t o = (size_t)(m0 + row) * 512 + n0 + col;
            G[o] = v0; G[o + 32] = v1;
          },
          smem);
    }
  }
  for (int it = BIDX; it < RK_NCHT / 4; it += gridDim.x) rk_output(p, it);
}

#define P12_SCAN_ITEMS (BATCH * 8 * 4)
#define P12_RET_ITEMS (BATCH * 4 * RET_NC)
#define P12_SCAN_SMEM ((2 * (16 * 5 * 64 + 16 * 16) + 16 * 16) * 4)
#define P12_RET_SMEM ((64 * 72 + 2 * 64 * 68) * 2)
#define P12_SMEM (P12_SCAN_SMEM > P12_RET_SMEM ? P12_SCAN_SMEM : P12_RET_SMEM)
DEV float sum16(float v) {
#ifdef CPU_EMU
  return emu_sum16(v);
#else
  int x;
  x = __builtin_amdgcn_update_dpp(0, __builtin_bit_cast(int, v), 0xB1, 0xF, 0xF, false); v += __builtin_bit_cast(float, x);
  x = __builtin_amdgcn_update_dpp(0, __builtin_bit_cast(int, v), 0x4E, 0xF, 0xF, false); v += __builtin_bit_cast(float, x);
  x = __builtin_amdgcn_update_dpp(0, __builtin_bit_cast(int, v), 0x141, 0xF, 0xF, false); v += __builtin_bit_cast(float, x);
  x = __builtin_amdgcn_update_dpp(0, __builtin_bit_cast(int, v), 0x140, 0xF, 0xF, false); v += __builtin_bit_cast(float, x);
  return v;
#endif
}
DEV void p12_scan(const Params& p, int item, char* smem) {
  const int rq = item & 3, h = (item >> 2) & 7, b = item >> 5;
  const int tid = TIDX, rl = tid >> 4, cg = tid & 15;
  const float* ARR[5] = {(const float*)(p.ws + OFF_RWW), (const float*)(p.ws + OFF_RWK), (const float*)(p.ws + OFF_RWKK),
                         (const float*)(p.ws + OFF_RWA), p.out + (size_t)NTOK * 512};
  const float* RWV = p.out;
  float* Yo = (float*)(p.ws + OFF_MIX);
  float* buf = (float*)smem;
  float* vbuf = buf + 2 * 16 * 5 * 64;
  float* ybuf = vbuf + 2 * 16 * 16;
  float S[4] = {0.f, 0.f, 0.f, 0.f};
  float4 rg[5]; float rv;
  const int lstep = tid >> 4, lc4 = tid & 15;
  auto gload = [&](int c) {
    const size_t o = ((size_t)b * SEQ_LEN + c * 16 + lstep) * 512 + h * 64;
#pragma unroll
    for (int a = 0; a < 5; ++a) rg[a] = ld4(ARR[a] + o + lc4 * 4);
    rv = RWV[o + rq * 16 + lc4];
  };
  auto sstore = [&](int bi) {
#pragma unroll
    for (int a = 0; a < 5; ++a) st4(buf + ((bi * 16 + lstep) * 5 + a) * 64 + lc4 * 4, rg[a]);
    vbuf[(bi * 16 + lstep) * 16 + lc4] = rv;
  };
  __syncthreads();
  gload(0);
  sstore(0);
  __syncthreads();
  const int NCH = SEQ_LEN / 16;
  for (int c = 0; c < NCH; ++c) {
    if (c + 1 < NCH) gload(c + 1);
    const float* cb = buf + (c & 1) * 16 * 5 * 64;
    const float* cv = vbuf + (c & 1) * 16 * 16;
    float4 cw = ld4(cb + 0 * 64 + cg * 4), ck = ld4(cb + 1 * 64 + cg * 4), ckk = ld4(cb + 2 * 64 + cg * 4),
           cka = ld4(cb + 3 * 64 + cg * 4), cr = ld4(cb + 4 * 64 + cg * 4);
    float cvv = cv[rl];
#pragma unroll
    for (int s = 0; s < 16; ++s) {
      const float4 w = cw, k = ck, kk = ckk, ka = cka, r = cr;
      const float v = cvv;
      if (s < 15) {
        cw = ld4(cb + ((s + 1) * 5 + 0) * 64 + cg * 4); ck = ld4(cb + ((s + 1) * 5 + 1) * 64 + cg * 4);
        ckk = ld4(cb + ((s + 1) * 5 + 2) * 64 + cg * 4); cka = ld4(cb + ((s + 1) * 5 + 3) * 64 + cg * 4);
        cr = ld4(cb + ((s + 1) * 5 + 4) * 64 + cg * 4); cvv = cv[(s + 1) * 16 + rl];
      }
      float sa = (S[0] * kk.x + S[1] * kk.y) + (S[2] * kk.z + S[3] * kk.w);
      sa = -sum16(sa);
      S[0] = S[0] * w.x + (sa * ka.x + v * k.x);
      S[1] = S[1] * w.y + (sa * ka.y + v * k.y);
      S[2] = S[2] * w.z + (sa * ka.z + v * k.z);
      S[3] = S[3] * w.w + (sa * ka.w + v * k.w);
      float y = (S[0] * r.x + S[1] * r.y) + (S[2] * r.z + S[3] * r.w);
      y = sum16(y);
      if (cg == 0) ybuf[s * 16 + rl] = y;
      asm volatile("" ::: "memory");
    }
    __syncthreads();
    if (c + 1 < NCH) sstore((c + 1) & 1);
    Yo[((size_t)b * SEQ_LEN + c * 16 + lstep) * 1024 + h * 64 + rq * 16 + lc4] = ybuf[lstep * 16 + lc4];
    __syncthreads();
  }
}
struct RetSmem { unsigned short k[64][72]; unsigned short vt[2][64][68]; };
#define RETPFX_ITEMS (BATCH * 4 * 64 * 128 / NTHREADS)
DEV void ret_prefix(const Params& p, int item) {
  const int gi = item * NTHREADS + TIDX;
  const int bh4 = gi >> 13, idx = gi & 8191;
  const float G = exp2f(128.f * ret_log2gamma(bh4 & 3));
  float* KV = (float*)(p.ws + OFF_RETKV) + (size_t)bh4 * RET_NC * 8192 + idx;
  float st = 0.f;
  int c = 0;
  for (; c + 8 <= RET_NC; c += 8) {
    float e[8];
#pragma unroll
    for (int q = 0; q < 8; ++q) e[q] = KV[(size_t)(c + q) * 8192];
#pragma unroll
    for (int q = 0; q < 8; ++q) { KV[(size_t)(c + q) * 8192] = st; st = st * G + e[q]; }
  }
  for (; c < RET_NC; ++c) { const float e = KV[(size_t)c * 8192]; KV[(size_t)c * 8192] = st; st = st * G + e; }
}
DEV void phase_retpfx(const Params& p, char* smem) {
  for (int it = BIDX; it < RETPFX_ITEMS; it += gridDim.x) ret_prefix(p, it);
}
DEV void p12_ret(const Params& p, int item, char* smem) {
  RetSmem* sm = (RetSmem*)smem;
  const int c = item % RET_NC, h = (item / RET_NC) & 3, b = item / (RET_NC * 4);
  const int tid = TIDX, lane = tid & 63, wave = tid >> 6;
  const int cidx = lane & 31, hh = lane >> 5;
  const int qi = wave * 32 + cidx;
  const float* H2 = (const float*)(p.ws + OFF_H2);
  const float lg = ret_log2gamma(h);
  const size_t tok0 = (size_t)b * SEQ_LEN + c * 128;
  bf16x8 qf[4], qfs[4];
  {
    const float* qr = H2 + (tok0 + qi) * 1536 + h * 64;
    const float qs = exp2f((float)(qi + 1) * lg);
#pragma unroll
    for (int ks = 0; ks < 4; ++ks) {
      const float4 a0 = ld4(qr + ks * 16 + hh * 8), a1 = ld4(qr + ks * 16 + hh * 8 + 4);
      const float v[8] = {a0.x, a0.y, a0.z, a0.w, a1.x, a1.y, a1.z, a1.w};
#pragma unroll
      for (int j = 0; j < 8; ++j) { qf[ks][j] = (short)f2bf(v[j]); qfs[ks][j] = (short)f2bf(v[j] * qs); }
    }
  }
  f32x16 o[4], s[2];
#pragma unroll
  for (int mt = 0; mt < 4; ++mt)
#pragma unroll
    for (int i = 0; i < 16; ++i) o[mt][i] = 0.f;
  {
    const float* KV0 = (const float*)(p.ws + OFF_RETKV) + (size_t)((b * 4 + h) * RET_NC) * 64 * 128;
#pragma unroll
    for (int eh = 0; eh < 2; ++eh) {
      __syncthreads();
      {
        const int el = tid & 63, d0 = tid >> 6;
        float stv[16];
#pragma unroll
        for (int i = 0; i < 16; ++i) stv[i] = KV0[(size_t)c * 64 * 128 + (d0 + 4 * i) * 128 + eh * 64 + el];
#pragma unroll
        for (int i = 0; i < 16; ++i) sm->k[el][d0 + 4 * i] = f2bf(stv[i]);
      }
      __syncthreads();
      qk_tile(sm->k, qfs, s, lane);
#pragma unroll
      for (int i = 0; i < 16; ++i) { o[eh * 2][i] += s[0][i]; o[eh * 2 + 1][i] += s[1][i]; }
    }
  }
#pragma unroll 1
  for (int kt = 0; kt < 2; ++kt) {
    __syncthreads();
    {
      const int row = tid >> 2, seg = tid & 3;
      const float* kr = H2 + (tok0 + kt * 64 + row) * 1536 + 256 + h * 64 + seg * 16;
      const float4 a0 = ld4(kr), a1 = ld4(kr + 4), a2 = ld4(kr + 8), a3 = ld4(kr + 12);
      *(uint4*)&sm->k[row][seg * 16] = make_uint4(pk2(a0.x, a0.y), pk2(a0.z, a0.w), pk2(a1.x, a1.y), pk2(a1.z, a1.w));
      *(uint4*)&sm->k[row][seg * 16 + 8] = make_uint4(pk2(a2.x, a2.y), pk2(a2.z, a2.w), pk2(a3.x, a3.y), pk2(a3.z, a3.w));
#pragma unroll
      for (int q = 0; q < 8; ++q) {
        const int f = tid + 256 * q;
        const int key = f >> 5, d4 = (f & 31) * 4;
        const float4 v = ld4(H2 + (tok0 + kt * 64 + key) * 1536 + 512 + h * 128 + d4);
        unsigned short(*vt)[68] = sm->vt[d4 >> 6];
        const int dl = d4 & 63;
        vt[dl][key] = f2bf(v.x); vt[dl + 1][key] = f2bf(v.y); vt[dl + 2][key] = f2bf(v.z); vt[dl + 3][key] = f2bf(v.w);
      }
    }
    __syncthreads();
    if (kt * 64 <= wave * 32 + 31) {
      qk_tile(sm->k, qf, s, lane);
#pragma unroll
      for (int ks2 = 0; ks2 < 2; ++ks2)
#pragma unroll
        for (int i = 0; i < 16; ++i) {
          const int kj = kt * 64 + ks2 * 32 + (i & 3) + 8 * (i >> 2) + 4 * hh;
          s[ks2][i] = kj <= qi ? s[ks2][i] * exp2f((float)(qi - kj) * lg) : 0.f;
        }
      pv_tile(sm->vt[0], s, *(f32x16(*)[2])&o[0], lane);
      pv_tile(sm->vt[1], s, *(f32x16(*)[2])&o[2], lane);
    }
  }
  float s1 = 0.f;
#pragma unroll
  for (int mt = 0; mt < 4; ++mt)
#pragma unroll
    for (int i = 0; i < 16; ++i) s1 += o[mt][i];
  s1 += __shfl_xor(s1, 32);
  const float mu = s1 * (1.f / 128.f);
  float s2 = 0.f;
#pragma unroll
  for (int mt = 0; mt < 4; ++mt)
#pragma unroll
    for (int i = 0; i < 16; ++i) { const float d = o[mt][i] - mu; s2 += d * d; }
  s2 += __shfl_xor(s2, 32);
  const float rstd = rsqrtf(s2 * (1.f / 128.f) + 1e-5f);
  float* MIX = (float*)(p.ws + OFF_MIX);
  const float* gate = H2 + (tok0 + qi) * 1536 + 1024 + h * 128;
  float* dst = MIX + (tok0 + qi) * 1024 + 512 + h * 128;
  const float* lgam = p.in[I_RET_LN_G] + h * 128;
  const float* lbet = p.in[I_RET_LN_B] + h * 128;
#pragma unroll
  for (int mt = 0; mt < 4; ++mt)
#pragma unroll
    for (int g4 = 0; g4 < 4; ++g4) {
      const int dv = mt * 32 + 8 * g4 + 4 * hh;
      const float4 gv = ld4(lgam + dv), bv = ld4(lbet + dv), gt = ld4(gate + dv);
      float4 ov;
      ov.x = siluf_(gt.x) * ((o[mt][4 * g4] - mu) * rstd * gv.x + bv.x);
      ov.y = siluf_(gt.y) * ((o[mt][4 * g4 + 1] - mu) * rstd * gv.y + bv.y);
      ov.z = siluf_(gt.z) * ((o[mt][4 * g4 + 2] - mu) * rstd * gv.z + bv.z);
      ov.w = siluf_(gt.w) * ((o[mt][4 * g4 + 3] - mu) * rstd * gv.w + bv.w);
      st4(dst + dv, ov);
    }
}
DEV void phase_p12(const Params& p, char* smem) {
  const int G = gridDim.x;
  const int bid = BIDX;
  if (bid < BATCH * 8 && G > BATCH * 8) {
    rk_chain(p, bid);
  } else if (G >= 8 * BATCH * 8) {
    const int Gh = G >> 1, NC = BATCH * 8;
    if (bid >= Gh && bid < Gh + NC) return;
    const int w = bid - NC - (bid >= Gh ? NC : 0);
#if RK_MERGED
    if ((G & 15) == 0 && BATCH * 8 == 16) {
      const int x = bid & 7, m = bid >> 3;
      const int rank = m - 2 - (m >= (Gh >> 3) ? 2 : 0), nprod = (G >> 3) - 4;
      for (int k = rank; k < 2 * RK_NCH; k += nprod) rk_precompute(p, (x + 8 * (k & 1)) * RK_NCH + (k >> 1), smem);
    } else {
      for (int it = w; it < RK_NCHT; it += G - 2 * NC) rk_precompute(p, (it % NC) * RK_NCH + it / NC, smem);
    }
#endif
    for (int it = w; it < P12_RET_ITEMS; it += G - 2 * NC) p12_ret(p, it, smem);
  } else if (G > BATCH * 8) {
    for (int it = bid - BATCH * 8; it < P12_RET_ITEMS; it += G - BATCH * 8) p12_ret(p, it, smem);
  } else {
    for (int it = bid; it < BATCH * 8 + P12_RET_ITEMS; it += G) {
      if (it < BATCH * 8) rk_chain(p, it);
      else p12_ret(p, it - BATCH * 8, smem);
    }
  }
}

#define P13_SMEM (RWP_T * 128 * 4)
DEV void phase_p13(const Params& p, char* smem) {
  const int tid = TIDX;
  const float* Hc = (const float*)(p.ws + OFF_H);
  const float* mu = p.in[I_RW_MU];
  const float* GLO = (const float*)(p.ws + OFF_GLO);
  float* sl = (float*)smem;
  float* MIX = (float*)(p.ws + OFF_MIX);
  const float* RWK = (const float*)(p.ws + OFF_RWK); const float* RWR = p.out + (size_t)NTOK * 512; const float* RWV = p.out;
  const float* G = (const float*)(p.ws + OFF_RWG);
  for (int it = BIDX; it < NTOK / RWP_T; it += gridDim.x) {
#pragma unroll
    for (int cc = 0; cc < 2; ++cc) {
      const int c = tid + 256 * cc;
      const float lng = p.in[I_RW_LN_G][c], lnb = p.in[I_RW_LN_B][c], rk = p.in[I_RW_R_K][c];
#pragma unroll 4
      for (int tt = 0; tt < RWP_T; ++tt) {
        const size_t tok = (size_t)it * RWP_T + tt;
        const float y = MIX[tok * 1024 + c];
        const float m = wave_sum(y) * (1.f / 64.f);
        const float d = y - m;
        const float var = wave_sum(d * d) * (1.f / 64.f);
        const float yn = d * rsqrtf(var + 64e-5f) * lng + lnb;
        const float r = RWR[tok * 512 + c], k = RWK[tok * 512 + c], v = RWV[tok * 512 + c];
        const float bonus = wave_sum(r * k * rk) * v;
        MIX[tok * 1024 + c] = (yn + bonus) * G[tok * 512 + c];
      }
    }
  }
}

#define NPHASES 20
#define SMEM_BYTES 53248
DEV void run_phase(const Params& p, int ph, char* smem) {
  switch (ph) {
    case 0: phase_gemm_in<0>(p, smem); break;
    case 1: phase_p1(p, smem); break;
    case 2: phase_p2(p, smem); break;
    case 3: phase_glu(p, smem); break;
    case 4: phase_outproj<0>(p, smem); break;
    case 5: phase_ln_router<0>(p, smem); break;
    case 6: phase_lists_shup<0>(p, smem); break;
    case 7: phase_routed_up<0>(p, smem); break;
    case 8: phase_down<0>(p, smem); break;
    case 9: phase_combine<0>(p, smem); break;
    case 10: phase_gemm_in<1>(p, smem); break;
    case 11: phase_p11(p, smem); break;
    case 12: phase_p12(p, smem); break;
    case 13: phase_p13(p, smem); break;
    case 14: phase_outproj<1>(p, smem); break;
    case 15: phase_ln_router<1>(p, smem); break;
    case 16: phase_lists_shup<1>(p, smem); break;
    case 17: phase_routed_up<1>(p, smem); break;
    case 18: phase_down<1>(p, smem); break;
    case 19: phase_combine<1>(p, smem); break;
    case 20: phase_p1b(p, smem); break;
    case 21: phase_rkpre(p, smem); break;
    case 22: phase_rkout(p, smem); break;
    case 24: phase_retpfx(p, smem); break;
  }
}
static_assert(P1_SMEM <= SMEM_BYTES, "smem");
static_assert(P1_PREP_SMEM <= SMEM_BYTES, "smem");
static_assert(P2_SMEM <= SMEM_BYTES, "smem");
static_assert(P5_SMEM <= SMEM_BYTES, "smem");
static_assert(P7_SMEM <= SMEM_BYTES, "smem");
static_assert(P12_SMEM <= SMEM_BYTES, "smem");
static_assert(RKPRE_SMEM <= SMEM_BYTES, "smem");
static_assert(OFF_HS + (size_t)NTOK * 256 * 2 <= OFF_X1, "layout");

#ifndef CPU_EMU
template <int PH>
__global__ void __launch_bounds__(NTHREADS) phase_kernel(Params p) {
  __shared__ __attribute__((aligned(16))) char smem[SMEM_BYTES];
  run_phase(p, PH, smem);
}
template <int PH>
static void launch_phases(const Params& p, hipStream_t stream) {
  phase_kernel<PH><<<dim3(1024), dim3(NTHREADS), 0, stream>>>(p);
  if constexpr (PH + 1 < NPHASES) launch_phases<PH + 1>(p, stream);
}
#if MEGA
#define XB_TMO      128
#define XB_XCNT(j)  (256  + 64 * (j))
#define XB_XSUB(j)  (1280 + 64 * (j))
#define XB_XGEN(j)  (2304 + 64 * (j))
#define XB_TOP      3328
#define XB_TOPGEN   3392
#define XCD_BAR_WORDS 3456
#define XB_SPIN_CAP (1u << 18)
#define LAS __attribute__((address_space(3)))

__device__ __forceinline__ unsigned xb_ld(unsigned* p)              { return __hip_atomic_load(p, __ATOMIC_RELAXED, __HIP_MEMORY_SCOPE_AGENT); }
__device__ __forceinline__ unsigned xb_add(unsigned* p, unsigned v) { return __hip_atomic_fetch_add(p, v, __ATOMIC_RELAXED, __HIP_MEMORY_SCOPE_AGENT); }
__device__ __forceinline__ unsigned xb_xcc_id() { return (unsigned)__builtin_amdgcn_s_getreg((3 << 11) | 20) & 0xFu; }
#define XB_SPIN(cond, bar) do { unsigned _sp = 0; while (cond) { __builtin_amdgcn_s_sleep(1); \
    if ((++_sp & 255u) == 0u) { if (xb_ld(&(bar)[XB_TMO])) break; if (_sp > XB_SPIN_CAP) { atomicAdd(&(bar)[XB_TMO], 1u); break; } } } } while (0)

struct XcdBarrier {
    unsigned* bar; unsigned x;
    volatile LAS unsigned* st;
};

__device__ __forceinline__ XcdBarrier xcd_barrier_post(unsigned* bar, volatile LAS unsigned* st) {
    XcdBarrier b; b.bar = bar; b.x = xb_xcc_id(); b.st = st;
    if (threadIdx.x == 0) (void)xb_add(&bar[XB_XCNT(b.x)], 1u);
    return b;
}
__device__ __forceinline__ void xcd_barrier_complete(unsigned* bar, unsigned x, unsigned& nloc, unsigned& nx) {
    const unsigned G = gridDim.x * gridDim.y * gridDim.z;
    unsigned sum, cnt, mine, sp = 0u;
    for (;;) {
        sum = 0u; cnt = 0u; mine = 0u;
#pragma unroll
        for (unsigned j = 0; j < 16; ++j) { const unsigned c = xb_ld(&bar[XB_XCNT(j)]); sum += c; cnt += (c > 0u) ? 1u : 0u; mine = (j == x) ? c : mine; }
        if (sum == G) break;
        __builtin_amdgcn_s_sleep(1);
        if ((++sp & 255u) == 0u) { if (xb_ld(&bar[XB_TMO])) break; if (sp > XB_SPIN_CAP) { atomicAdd(&bar[XB_TMO], 1u); break; } }
    }
    nloc = mine > 0u ? mine : 1u; nx = cnt > 0u ? cnt : 1u;
}

__device__ __forceinline__ void xcd_barrier(const XcdBarrier& b) {
    asm volatile("s_waitcnt vmcnt(0)" ::: "memory");
    __syncthreads();
    if (threadIdx.x == 0) {
        unsigned* bar = b.bar;
        __builtin_amdgcn_s_waitcnt(0);
        unsigned nloc = b.st[0], nx = b.st[1];
        if (nloc == 0u) { xcd_barrier_complete(bar, b.x, nloc, nx); b.st[0] = nloc; b.st[1] = nx; }
        const unsigned old = xb_add(&bar[XB_XSUB(b.x)], 1u);
        const unsigned gen = old / nloc;
        if (old + 1u == (gen + 1u) * nloc) {
            __builtin_amdgcn_fence(__ATOMIC_RELEASE, "agent");
            asm volatile("s_waitcnt vmcnt(0)" ::: "memory");
            const unsigned og = xb_add(&bar[XB_TOP], 1u);
            const unsigned tg = og / nx;
            if (og + 1u == (tg + 1u) * nx) xb_add(&bar[XB_TOPGEN], 1u);
            else XB_SPIN(xb_ld(&bar[XB_TOPGEN]) == tg, bar);
            __builtin_amdgcn_fence(__ATOMIC_ACQUIRE, "agent");
            xb_add(&bar[XB_XGEN(b.x)], 1u);
            asm volatile("s_waitcnt vmcnt(0)" ::: "memory");
        } else {
            XB_SPIN(xb_ld(&bar[XB_XGEN(b.x)]) == gen, bar);
            __builtin_amdgcn_fence(__ATOMIC_ACQUIRE, "agent");
            asm volatile("s_waitcnt vmcnt(0)" ::: "memory");
        }
    }
    __syncthreads();
}


__global__ void __launch_bounds__(NTHREADS, 2) mega_kernel(Params p) {
  __shared__ __attribute__((aligned(16))) char smem[SMEM_BYTES];
  unsigned* bar = (unsigned*)(p.ws + OFF_BAR);
  __shared__ uint4 xb_words;
  if (threadIdx.x == 0) xb_words = make_uint4(0u, 0u, 0u, 0u);
  __syncthreads();
  XcdBarrier xb = xcd_barrier_post(bar, (volatile LAS unsigned*)&xb_words);
  if (p.ws == nullptr) cg::this_grid().sync();
  typedef const __attribute__((address_space(4))) Params* KParams;
#define PH_(n) { KParams kp = (KParams)__builtin_amdgcn_kernarg_segment_ptr(); asm volatile("" : "+s"(kp)); const Params lp = *(const Params*)kp; run_phase(lp, n, smem); } xcd_barrier(xb);
  PH_(0) PH_(1) PH_(20) PH_(2) PH_(3) PH_(4) PH_(5) PH_(6) PH_(7) PH_(8) PH_(9)
  PH_(10) PH_(11) PH_(24) PH_(12) PH_(22) PH_(13) PH_(14) PH_(15) PH_(16) PH_(17) PH_(18)
  { KParams kp = (KParams)__builtin_amdgcn_kernarg_segment_ptr(); asm volatile("" : "+s"(kp)); const Params lp = *(const Params*)kp; run_phase(lp, 19, smem); }
}

#endif

extern "C" void kernel_launch(void* const* d_in, const int* in_sizes, int n_in, void* d_out, int out_size, void* d_ws, size_t ws_size,
                              hipStream_t stream) {
  Params p;
  for (int i = 0; i < N_INPUTS; ++i) p.in[i] = (const float*)d_in[i];
  p.out = (float*)d_out;
  p.ws = (char*)d_ws;
#if MEGA
  static int grid_blocks = 0;
  if (!grid_blocks) {
    int dev = 0, cus = 0, per_cu = 0;
    hipGetDevice(&dev);
    hipDeviceGetAttribute(&cus, hipDeviceAttributeMultiprocessorCount, dev);
    hipOccupancyMaxActiveBlocksPerMultiprocessor(&per_cu, mega_kernel, NTHREADS, 0);
    if (per_cu > 2) per_cu = 2;
    grid_blocks = cus * per_cu;
  }
  hipMemsetAsync((char*)d_ws + OFF_BAR, 0, 16384, stream);
  void* args[] = {&p};
  hipError_t e = hipLaunchCooperativeKernel((void*)mega_kernel, dim3(grid_blocks), dim3(NTHREADS), args, 0, stream);
  if (e != hipSuccess) fprintf(stderr, "cooperative launch failed: %s (grid %d)\n", hipGetErrorString(e), grid_blocks);
#else
  launch_phases<0>(p, stream);
#endif
}
#endif
```

```cpp
#ifdef CPU_EMU
#include "emu.h"
#else
#include <hip/hip_runtime.h>
#include <hip/hip_cooperative_groups.h>
#include <cstdio>
namespace cg = cooperative_groups;
#endif
#include <stdint.h>

#ifndef BATCH
#define BATCH 2
#endif
#ifndef SEQ_LEN
#define SEQ_LEN 8192
#endif
#ifndef MEGA
#define MEGA 1
#endif
#if MEGA && !defined(CPU_EMU)
#define RK_MERGED 1
#else
#define RK_MERGED 0
#endif

#define DEV __device__ __forceinline__
#ifdef CPU_EMU
#define TIDX ((int)threadIdx.x)
#define BIDX ((int)blockIdx.x)
#else
__device__ __forceinline__ int tidx_() { int t = __builtin_amdgcn_workitem_id_x(); asm volatile("" : "+v"(t)); return t; }
__device__ __forceinline__ int bidx_() { int b = __builtin_amdgcn_workgroup_id_x(); asm volatile("" : "+s"(b)); return b; }
#define TIDX tidx_()
#define BIDX bidx_()
#endif
#define NTOK (BATCH * SEQ_LEN)
#define DM 1024
#define AB_IN 1816
#define AB_LD 1824
#define CD_IN 3328
#define NCMP ((SEQ_LEN - 32) / 16 + 1)
#define NBLK (SEQ_LEN / 64)
#define NB_CMP ((NCMP + 63) / 64)
#define S5_NC (SEQ_LEN / 64)
#define RET_NC (SEQ_LEN / 128)
#define ALPHA_F 1.4142135623730951f
#define NTHREADS 256

enum { I_X = 0, I_AB_W_IN, I_AB_W_OUT, I_S5_LAM_RE, I_S5_LAM_IM, I_S5_LOG_DT, I_S5_B_RE, I_S5_B_IM, I_S5_C_RE, I_S5_C_IM,
       I_S5_D, I_S5_W_GLU, I_S5_B_GLU, I_PE_K, I_PE_V, I_CK_W1, I_CK_B1, I_CK_W2, I_CV_W1, I_CV_B1, I_CV_W2,
       I_CD_W_IN, I_CD_W_OUT, I_RW_MU, I_RW_W0, I_RW_W_UP, I_RW_A0, I_RW_A_UP, I_RW_G_UP, I_RW_K_K, I_RW_K_A, I_RW_R_K,
       I_RW_LN_G, I_RW_LN_B, I_RET_LN_G, I_RET_LN_B, I_LN1_G, I_LN1_B, I_LN2_G, I_LN2_B, I_ROUTER, I_MOE_BIAS,
       I_MOE_W1, I_MOE_W3, I_MOE_W2, I_SH_W1, I_SH_W3, I_SH_W2, N_INPUTS };

struct Params {
  const float* in[N_INPUTS];
  float* out;
  char* ws;
};

#define MiB_TOK ((size_t)NTOK * 1024 * 4)
#define OFF_H 0
#define OFF_H2 ((size_t)NTOK * 1792 * 4)
#define OFF_MIX ((size_t)NTOK * 3328 * 4)
#define OFF_X1 (OFF_MIX + MiB_TOK)
#define OFF_X2 (OFF_X1 + MiB_TOK)
#define OFF_R4 (OFF_X2 + MiB_TOK)
#define OFF_R5 (OFF_R4 + MiB_TOK)
#define OFF_Y OFF_H
#define OFF_HS (OFF_H + 4 * MiB_TOK)
#define OFF_FS OFF_X2
#define OFF_HR OFF_R4
#define OFF_X2B OFF_R4
#define OFF_TOPI (OFF_R5)
#define OFF_TOPG (OFF_TOPI + (size_t)NTOK * 8 * 4)
#define OFF_POSOF (OFF_TOPG + (size_t)NTOK * 8 * 4)
#define OFF_CNT (OFF_POSOF + (size_t)NTOK * 8 * 4)
#define OFF_LTOK (OFF_CNT + 8192)
#define OFF_LGATE (OFF_LTOK + (size_t)64 * NTOK * 4)
#define OFF_S5E (OFF_LGATE + (size_t)64 * NTOK * 4)
#define OFF_KCMP (OFF_S5E + (size_t)BATCH * S5_NC * 32 * 64 * 8)
#define OFF_VCMP (OFF_KCMP + (size_t)BATCH * NCMP * 2 * 64 * 4)
#define OFF_RETKV (OFF_VCMP + (size_t)BATCH * NCMP * 2 * 64 * 4)
#define OFF_BAR (OFF_RETKV + (size_t)BATCH * 4 * RET_NC * 64 * 128 * 4)
#define OFF_CMPHID (OFF_BAR + 16384)
#define OFF_CMPC1 (OFF_CMPHID + (size_t)2 * BATCH * 2 * NB_CMP * 64 * 128 * 4)
#define OFF_GLO OFF_LTOK
#define OFF_RKF (OFF_CMPC1 + 8192)
#define OFF_END (OFF_RKF + 16384)
#define OFF_YGELU OFF_X1
#define OFF_RWW OFF_X1
#define OFF_RWK (OFF_X1 + (size_t)NTOK * 512 * 4)
#define OFF_RWKK OFF_R4
#define OFF_RWA (OFF_R4 + (size_t)NTOK * 512 * 4)

typedef short bf16x8 __attribute__((ext_vector_type(8)));
typedef float f32x16 __attribute__((ext_vector_type(16)));

#ifdef CPU_EMU
#define WAVE_SYNC() emu_wave_bar()
#else
#define WAVE_SYNC() __builtin_amdgcn_wave_barrier()
#endif

DEV float sigmoidf_(float x) { return 1.f / (1.f + __expf(-x)); }
DEV float siluf_(float x) { return x * sigmoidf_(x); }
DEV float geluf_(float x) { float u = 0.7978845608028654f * (x + 0.044715f * x * x * x); return 0.5f * x * (1.f + tanhf(u)); }
DEV unsigned short f2bf(float f) {
  unsigned u = __builtin_bit_cast(unsigned, f);
  u += 0x7FFFu + ((u >> 16) & 1u);
  return (unsigned short)(u >> 16);
}
DEV float bf2f(unsigned short h) { return __builtin_bit_cast(float, ((unsigned)h) << 16); }
DEV float wave_sum(float v) {
#pragma unroll
  for (int m = 32; m >= 1; m >>= 1) v += __shfl_xor(v, m);
  return v;
}
DEV float wave_max(float v) {
#pragma unroll
  for (int m = 32; m >= 1; m >>= 1) v = fmaxf(v, __shfl_xor(v, m));
  return v;
}
DEV float4 ld4(const float* p) { return *(const float4*)p; }
#ifdef CPU_EMU
DEV float fexp2(float x) { return exp2f(x); }
#else
DEV float fexp2(float x) { return __builtin_amdgcn_exp2f(x); }
#endif
DEV void fast_sincos(float x, float* sn, float* cs) {
  const float k = rintf(x * 0.15915494309189535f);
  float r = fmaf(-k, 6.28125f, x);
  r = fmaf(-k, 1.9353071795864769e-3f, r);
  *sn = __sinf(r); *cs = __cosf(r);
}
DEV void st4(float* p, float4 v) { *(float4*)p = v; }

#define GEMM_BM 128
#define GEMM_MI (GEMM_BM / 64)
#define GEMM_SMEM_BYTES ((GEMM_BM + 128) * 72 * 2)
#ifdef CPU_EMU
DEV unsigned pk2(float a, float b) { return (unsigned)f2bf(a) | ((unsigned)f2bf(b) << 16); }
#else
typedef __bf16 hbf16x2 __attribute__((ext_vector_type(2)));
typedef float hf32x2 __attribute__((ext_vector_type(2)));
DEV unsigned pk2(float a, float b) {
  hf32x2 f = {a, b};
  return __builtin_bit_cast(unsigned, __builtin_convertvector(f, hbf16x2));
}
#endif
template <bool ABF, class AROW, class BPTR, class EPI>
DEV void gemm_tile(AROW arow, BPTR bptr, int ldb, int K, EPI epi, char* smem_raw, int akstep = 64) {
  unsigned short(*sA)[72] = (unsigned short(*)[72])smem_raw;
  unsigned short(*sB)[72] = (unsigned short(*)[72])(smem_raw + GEMM_BM * 72 * 2);
  const int tid = TIDX, lane = tid & 63, wave = tid >> 6;
  const int wm = wave >> 1, wn = wave & 1;
#if defined(CPU_EMU) && !defined(EMU_REAL_GEMM)
  for (int mi = 0; mi < GEMM_MI; ++mi)
    for (int r = 0; r < 16; ++r) {
      const int row = wm * (GEMM_BM / 2) + mi * 32 + (r & 3) + 8 * (r >> 2) + 4 * (lane >> 5);
      const int col = wn * 64 + (lane & 31);
      const void* arp = arow(row);
      float v[2] = {0.f, 0.f};
      for (int ni = 0; ni < 2; ++ni) {
        const int cc = col + ni * 32;
        const float* bq = bptr(cc & ~3);
        if (!arp || !bq) continue;
        bq += cc & 3;
        float a = 0.f;
        for (int k = 0; k < K; ++k) {
          const size_t ka = (size_t)(k >> 6) * akstep + (k & 63);
          const float av = ABF ? bf2f(((const unsigned short*)arp)[ka]) : bf2f(f2bf(((const float*)arp)[ka]));
          a += av * bf2f(f2bf(bq[(size_t)k * ldb]));
        }
        v[ni] = a;
      }
      epi(row, col, v[0], v[1]);
    }
  return;
#endif
  const float* ap[4 * GEMM_MI];
  const unsigned short* aph[2 * GEMM_MI];
  if (ABF) {
#pragma unroll
    for (int i = 0; i < 2 * GEMM_MI; ++i) aph[i] = (const unsigned short*)arow((tid >> 3) + 32 * i);
  } else {
#pragma unroll
    for (int i = 0; i < 4 * GEMM_MI; ++i) ap[i] = (const float*)arow((tid >> 4) + 16 * i);
  }
  const float* bp = bptr((tid & 31) * 4);
  const int kgrp = tid >> 5;
  float4 ra0[4 * GEMM_MI], ra1[4 * GEMM_MI];
  uint4 rah0[2 * GEMM_MI], rah1[2 * GEMM_MI];
  float4 rb0[8], rb1[8];
#define GEMM_GLOAD(S, k0_)                                                                                                          \
  {                                                                                                                                 \
    if (ABF) {                                                                                                                      \
      _Pragma("unroll") for (int i = 0; i < 2 * GEMM_MI; ++i) rah##S[i] =                                                           \
          aph[i] ? *(const uint4*)(aph[i] + (size_t)((k0_) >> 6) * akstep + (tid & 7) * 8) : make_uint4(0, 0, 0, 0);                \
    } else {                                                                                                                        \
      _Pragma("unroll") for (int i = 0; i < 4 * GEMM_MI; ++i) ra##S[i] =                                                            \
          ap[i] ? ld4(ap[i] + (size_t)((k0_) >> 6) * akstep + (tid & 15) * 4) : make_float4(0.f, 0.f, 0.f, 0.f);                    \
    }                                                                                                                               \
    _Pragma("unroll") for (int j = 0; j < 8; ++j) rb##S[j] =                                                                        \
        bp ? ld4(bp + (size_t)((k0_) + kgrp * 8 + j) * ldb) : make_float4(0.f, 0.f, 0.f, 0.f);                                      \
  }
#define GEMM_SSTORE(S)                                                                                                              \
  {                                                                                                                                 \
    if (ABF) {                                                                                                                      \
      _Pragma("unroll") for (int i = 0; i < 2 * GEMM_MI; ++i) *(uint4*)&sA[(tid >> 3) + 32 * i][(tid & 7) * 8] = rah##S[i];         \
    } else {                                                                                                                        \
      _Pragma("unroll") for (int i = 0; i < 4 * GEMM_MI; ++i) *(uint2*)&sA[(tid >> 4) + 16 * i][(tid & 15) * 4] =                   \
          make_uint2(pk2(ra##S[i].x, ra##S[i].y), pk2(ra##S[i].z, ra##S[i].w));                                                     \
    }                                                                                                                               \
    const int nb = (tid & 31) * 4;                                                                                                  \
    *(uint4*)&sB[nb + 0][kgrp * 8] = make_uint4(pk2(rb##S[0].x, rb##S[1].x), pk2(rb##S[2].x, rb##S[3].x), pk2(rb##S[4].x, rb##S[5].x), pk2(rb##S[6].x, rb##S[7].x)); \
    *(uint4*)&sB[nb + 1][kgrp * 8] = make_uint4(pk2(rb##S[0].y, rb##S[1].y), pk2(rb##S[2].y, rb##S[3].y), pk2(rb##S[4].y, rb##S[5].y), pk2(rb##S[6].y, rb##S[7].y)); \
    *(uint4*)&sB[nb + 2][kgrp * 8] = make_uint4(pk2(rb##S[0].z, rb##S[1].z), pk2(rb##S[2].z, rb##S[3].z), pk2(rb##S[4].z, rb##S[5].z), pk2(rb##S[6].z, rb##S[7].z)); \
    *(uint4*)&sB[nb + 3][kgrp * 8] = make_uint4(pk2(rb##S[0].w, rb##S[1].w), pk2(rb##S[2].w, rb##S[3].w), pk2(rb##S[4].w, rb##S[5].w), pk2(rb##S[6].w, rb##S[7].w)); \
  }
  f32x16 acc[GEMM_MI][2];
#pragma unroll
  for (int mi = 0; mi < GEMM_MI; ++mi)
#pragma unroll
    for (int ni = 0; ni < 2; ++ni)
#pragma unroll
      for (int r = 0; r < 16; ++r) acc[mi][ni][r] = 0.f;
  auto compute = [&]() {
#pragma unroll
    for (int ks = 0; ks < 4; ++ks) {
      bf16x8 af[GEMM_MI], bfr[2];
#pragma unroll
      for (int mi = 0; mi < GEMM_MI; ++mi) af[mi] = *(const bf16x8*)&sA[wm * (GEMM_BM / 2) + mi * 32 + (lane & 31)][ks * 16 + (lane >> 5) * 8];
#pragma unroll
      for (int ni = 0; ni < 2; ++ni) bfr[ni] = *(const bf16x8*)&sB[wn * 64 + ni * 32 + (lane & 31)][ks * 16 + (lane >> 5) * 8];
#pragma unroll
      for (int mi = 0; mi < GEMM_MI; ++mi)
#pragma unroll
        for (int ni = 0; ni < 2; ++ni) acc[mi][ni] = __builtin_amdgcn_mfma_f32_32x32x16_bf16(af[mi], bfr[ni], acc[mi][ni], 0, 0, 0);
    }
  };
  if (ABF) {
    GEMM_GLOAD(0, 0);
    GEMM_GLOAD(1, 64);
    for (int k0 = 0; k0 < K; k0 += 128) {
      __syncthreads();
      GEMM_SSTORE(0);
      __syncthreads();
      if (k0 + 128 < K) GEMM_GLOAD(0, k0 + 128);
      compute();
      __syncthreads();
      GEMM_SSTORE(1);
      __syncthreads();
      if (k0 + 192 < K) GEMM_GLOAD(1, k0 + 192);
      compute();
    }
  } else {
    GEMM_GLOAD(0, 0);
    for (int k0 = 0; k0 < K; k0 += 64) {
      __syncthreads();
      GEMM_SSTORE(0);
      __syncthreads();
      if (k0 + 64 < K) GEMM_GLOAD(0, k0 + 64);
      compute();
    }
  }
#pragma unroll
  for (int mi = 0; mi < GEMM_MI; ++mi)
#pragma unroll
    for (int r = 0; r < 16; ++r) {
      int row = wm * (GEMM_BM / 2) + mi * 32 + (r & 3) + 8 * (r >> 2) + 4 * (lane >> 5);
      int col = wn * 64 + (lane & 31);
      epi(row, col, acc[mi][0][r], acc[mi][1][r]);
    }
}

template <int LAYER>
DEV void phase_gemm_in(const Params& p, char* smem) {
  const int N = LAYER == 0 ? AB_IN : CD_IN;
  const float* A = LAYER == 0 ? p.in[I_X] : (const float*)(p.ws + OFF_X2);
  const float* B = LAYER == 0 ? p.in[I_AB_W_IN] : p.in[I_CD_W_IN];
  float* C = (float*)(p.ws + OFF_H);
  const int NT = (N + 127) / 128, MT = NTOK / GEMM_BM;
  const int xcd_ = BIDX & 7, lb_ = BIDX >> 3, nb_ = gridDim.x >> 3;
  for (int j_ = lb_; j_ < (MT / 8) * NT; j_ += nb_) {
    const int it = (xcd_ + 8 * (j_ / NT)) * NT + (j_ % NT);
    const int tm = it / NT, tn = it % NT;
    const int m0 = tm * GEMM_BM, n0 = tn * 128;
    gemm_tile<LAYER == 1>(
        [&](int r) { return LAYER == 1 ? (const void*)((const unsigned short*)(p.ws + OFF_X2B) + (size_t)(m0 + r) * DM) : (const void*)(A + (size_t)(m0 + r) * DM); },
        [&](int c) { return (n0 + c < N) ? (B + n0 + c) : (const float*)nullptr; }, N, DM,
        [&](int row, int col, float v0, float v1) {
          const int gm = m0 + row, gc = n0 + col;
          if (LAYER == 1 && gc >= 1792 && gc < 2304) {
            const int i = gc & 63;
            const float pos = (float)(gm % SEQ_LEN);
            const float inv = __expf(-(float)i * (9.210340371976184f / 32.f));
            float sn, cs;
            fast_sincos(pos * inv, &sn, &cs);
            float o0 = v0 * cs - v1 * sn, o1 = v1 * cs + v0 * sn;
            if (gc >= 2048) { o0 *= 0.125f; o1 *= 0.125f; }
            v0 = o0; v1 = o1;
          }
          if (LAYER == 1) {
            float* dstp = gc < 1792 ? C + (size_t)gm * 1792 + gc : (float*)(p.ws + OFF_H2) + (size_t)gm * 1536 + (gc - 1792);
            dstp[0] = v0; dstp[32] = v1;
          } else {
            if (gc < N) C[(size_t)gm * AB_LD + gc] = v0;
            if (gc + 32 < N) C[(size_t)gm * AB_LD + gc + 32] = v1;
          }
        },
        smem);
  }
}

struct S5Const { float lb_re, lb_im; };
DEV void s5_consts(const Params& p, int g, int pp, float& lb_re, float& lb_im, float (&bbr)[16], float (&bbi)[16]) {
  const float dt = expf(p.in[I_S5_LOG_DT][g]);
  const float lr = p.in[I_S5_LAM_RE][g * 64 + pp], li = p.in[I_S5_LAM_IM][g * 64 + pp];
  const float mag = expf(lr * dt);
  float sn, cs;
  sincosf(li * dt, &sn, &cs);
  lb_re = mag * cs; lb_im = mag * sn;
  const float den = lr * lr + li * li;
  const float f_re = ((lb_re - 1.f) * lr + lb_im * li) / den;
  const float f_im = (lb_im * lr - (lb_re - 1.f) * li) / den;
  const float* br = p.in[I_S5_B_RE] + (size_t)(g * 64 + pp) * 16;
  const float* bi = p.in[I_S5_B_IM] + (size_t)(g * 64 + pp) * 16;
#pragma unroll
  for (int h = 0; h < 16; ++h) {
    bbr[h] = f_re * br[h] - f_im * bi[h];
    bbi[h] = f_re * bi[h] + f_im * br[h];
  }
}

#define OFF_QB OFF_X2
#define OFF_KSB (OFF_QB + (size_t)NTOK * 512 * 2)
#define OFF_KWB (OFF_KSB + (size_t)NTOK * 128 * 2)
#define OFF_VST (OFF_KWB + (size_t)NTOK * 128 * 2)
#define OFF_VWT (OFF_VST + (size_t)NTOK * 128 * 2)
#define OFF_KCB (OFF_VWT + (size_t)NTOK * 128 * 2)
#define OFF_VCT (OFF_KCB + (size_t)BATCH * 2 * NB_CMP * 64 * 64 * 2)
#define NSA_QSCALE (0.125f * 1.4426950408889634f)

#define P1_S5A_ITEMS (BATCH * 32 * S5_NC / 4)
#define P1_CMP_ITEMS (2 * BATCH * 2 * NB_CMP)
#define S5C_ROW 132
DEV bf16x8 pack_bf8(float4 a, float4 b) {
  union { uint4 u; bf16x8 v; } x;
  x.u = make_uint4(pk2(a.x, a.y), pk2(a.z, a.w), pk2(b.x, b.y), pk2(b.z, b.w));
  return x.v;
}
DEV void s5_bfrags(const Params& p, int g, int lane, bf16x8 (&bB)[4]) {
  const int hh = lane >> 5;
#pragma unroll
  for (int ct = 0; ct < 2; ++ct) {
    float lr, li, br_[16], bi_[16];
    s5_consts(p, g, 32 * ct + (lane & 31), lr, li, br_, bi_);
    bB[ct] = pack_bf8(make_float4(hh ? br_[8] : br_[0], hh ? br_[9] : br_[1], hh ? br_[10] : br_[2], hh ? br_[11] : br_[3]),
                      make_float4(hh ? br_[12] : br_[4], hh ? br_[13] : br_[5], hh ? br_[14] : br_[6], hh ? br_[15] : br_[7]));
    bB[2 + ct] = pack_bf8(make_float4(hh ? bi_[8] : bi_[0], hh ? bi_[9] : bi_[1], hh ? bi_[10] : bi_[2], hh ? bi_[11] : bi_[3]),
                          make_float4(hh ? bi_[12] : bi_[4], hh ? bi_[13] : bi_[5], hh ? bi_[14] : bi_[6], hh ? bi_[15] : bi_[7]));
  }
}
DEV void s5_subchunk(const float* su, float* sS, const bf16x8 (&bB)[4], float lb_re, float lb_im, float& sr, float& si, int lane) {
  {
    const int r = lane & 15, hh = lane >> 5, n = lane & 31;
    const bf16x8 a = pack_bf8(ld4(su + r * 16 + 8 * hh), ld4(su + r * 16 + 8 * hh + 4));
#pragma unroll
    for (int j = 0; j < 4; ++j) {
      f32x16 acc;
#pragma unroll
      for (int i = 0; i < 16; ++i) acc[i] = 0.f;
      acc = __builtin_amdgcn_mfma_f32_32x32x16_bf16(a, bB[j], acc, 0, 0, 0);
      const int col = (j >> 1) * 64 + (j & 1) * 32 + n;
#pragma unroll
      for (int r8 = 0; r8 < 8; ++r8) sS[((r8 & 3) + 8 * (r8 >> 2) + 4 * hh) * S5C_ROW + col] = acc[r8];
    }
  }
  WAVE_SYNC();
  for (int tt = 0; tt < 16; ++tt) {
    const float dr = sS[tt * S5C_ROW + lane], di = sS[tt * S5C_ROW + 64 + lane];
    const float nr = lb_re * sr - lb_im * si + dr, ni = lb_re * si + lb_im * sr + di;
    sr = nr; si = ni;
    sS[tt * S5C_ROW + lane] = sr;
    sS[tt * S5C_ROW + 64 + lane] = si;
  }
}
DEV void p1_s5a(const Params& p, int item, char* smem) {
  const int lane = TIDX & 63, wave = TIDX >> 6;
  const int idx = item * 4 + wave;
  const int g = idx & 31, c = (idx >> 5) % S5_NC, b = idx / (32 * S5_NC);
  float lb_re, lb_im;
  {
    float bbr[16], bbi[16];
    s5_consts(p, g, lane, lb_re, lb_im, bbr, bbi);
  }
  bf16x8 bB[4];
  s5_bfrags(p, g, lane, bB);
  const float* H = (const float*)(p.ws + OFF_H);
  float sr = 0.f, si = 0.f;
  float* sS = (float*)smem + wave * 16 * S5C_ROW;
  float* su = (float*)smem + 4 * 16 * S5C_ROW + wave * 16 * 16;
  __syncthreads();
  for (int sc = 0; sc < 4; ++sc) {
    {
      const float* ur = H + (size_t)(b * SEQ_LEN + c * 64 + sc * 16 + (lane >> 2)) * AB_LD + g * 16 + (lane & 3) * 4;
      st4(su + (lane >> 2) * 16 + (lane & 3) * 4, ld4(ur));
    }
    WAVE_SYNC();
    s5_subchunk(su, sS, bB, lb_re, lb_im, sr, si, lane);
    WAVE_SYNC();
  }
  float2* E = (float2*)(p.ws + OFF_S5E);
  E[((size_t)(b * S5_NC + c) * 32 + g) * 64 + lane] = make_float2(sr, si);
}
#define P1_CMPG_MT ((NCMP + GEMM_BM - 1) / GEMM_BM)
#define P1_CMPG_ITEMS (2 * BATCH * 2 * P1_CMPG_MT)
DEV void p1_cmpgemm(const Params& p, int item, char* smem) {
  const int mt = item % P1_CMPG_MT;
  int r = item / P1_CMPG_MT;
  const int g = r & 1; r >>= 1;
  const int b = r % BATCH; const int which = r / BATCH;
  const float* H = (const float*)(p.ws + OFF_H);
  const float* w1 = which ? p.in[I_CV_W1] : p.in[I_CK_W1];
  const int colbase = (which ? 1152 : 1024) + g * 64;
  float* HID = (float*)(p.ws + OFF_CMPHID) + ((size_t)(which * BATCH + b) * 2 + g) * NB_CMP * 64 * 128;
  const int n0 = mt * GEMM_BM;
  gemm_tile<false>(
      [&](int rr) { return (n0 + rr < NCMP) ? (const void*)(H + ((size_t)b * SEQ_LEN + 16 * (n0 + rr)) * AB_LD + colbase) : (const void*)nullptr; },
      [&](int c) { return w1 + c; }, 128, 2048,
      [&](int row, int col, float v0, float v1) {
        if (n0 + row < NCMP) { HID[(size_t)(n0 + row) * 128 + col] = v0; HID[(size_t)(n0 + row) * 128 + col + 32] = v1; }
      },
      smem, AB_LD);
}
#define P1_CMPC1_ITEMS 16
DEV void p1_cmpc1(const Params& p, int item, char* smem) {
  const int which = item >> 3, sl = item & 7;
  const float* pe = which ? p.in[I_PE_V] : p.in[I_PE_K];
  const float* w1 = which ? p.in[I_CV_W1] : p.in[I_CK_W1];
  float* sPart = (float*)smem;
  const int tid = TIDX, hid = tid & 127, kh = tid >> 7;
  float a = 0.f;
  const int k0 = sl * 256 + kh * 128;
#pragma unroll 16
  for (int k = k0; k < k0 + 128; ++k) a += pe[k] * w1[(size_t)k * 128 + hid];
  __syncthreads();
  sPart[tid] = a;
  __syncthreads();
  if (tid < 128) ((float*)(p.ws + OFF_CMPC1))[(which * 8 + sl) * 128 + tid] = sPart[tid] + sPart[tid + 128];
  __syncthreads();
}
DEV void p1_compress(const Params& p, int item, char* smem) {
  const int tile = item % NB_CMP;
  int r = item / NB_CMP;
  const int g = r & 1; r >>= 1;
  const int b = r % BATCH; const int which = r / BATCH;
  const float* b1 = which ? p.in[I_CV_B1] : p.in[I_CK_B1];
  const float* w2 = which ? p.in[I_CV_W2] : p.in[I_CK_W2];
  const float* C1P = (const float*)(p.ws + OFF_CMPC1) + which * 8 * 128;
  const float* HID = (const float*)(p.ws + OFF_CMPHID) + ((size_t)(which * BATCH + b) * 2 + g) * NB_CMP * 64 * 128;
  float* sOut = (float*)smem;
  float* sHid = sOut + 8 * 64;
  float* sAll = sHid + 8 * 128;
  float* sC1 = sAll + 64 * 65;
  const int tid = TIDX;
  __syncthreads();
  if (tid < 128) {
    const float* q = C1P + tid;
    sC1[tid] = (((((((q[0] + q[128]) + q[256]) + q[384]) + q[512]) + q[640]) + q[768]) + q[896]) + b1[tid];
  }
  float* dst = (float*)(p.ws + (which ? OFF_VCMP : OFF_KCMP));
#pragma unroll 1
  for (int r8 = 0; r8 < 8; ++r8) {
    const int n0 = tile * 64 + r8 * 8;
    __syncthreads();
    for (int w = tid; w < 8 * 128; w += NTHREADS) {
      const int rr = w >> 7, hid = w & 127;
      const int n = n0 + rr;
      sHid[w] = n < NCMP ? geluf_(HID[(size_t)n * 128 + hid] + sC1[hid]) : 0.f;
    }
    __syncthreads();
    for (int w = tid; w < 8 * 64; w += NTHREADS) {
      const int rr = w >> 6, d = w & 63;
      float a = 0.f;
      for (int hid = 0; hid < 128; ++hid) a += sHid[rr * 128 + hid] * w2[hid * 64 + d];
      sOut[w] = a;
    }
    __syncthreads();
    for (int w = tid; w < 8 * 64; w += NTHREADS) {
      const int rr = w >> 6, d = w & 63;
      const int n = n0 + rr;
      float v = sOut[w];
      if (which == 0 && d < 16) {
        const int i = d & 7;
        const float pos = (float)(n * 16 + 31);
        const float inv = __expf(-(float)i * (13.122363377404328f / 8.f));
        float sn, cs;
        sincosf(pos * inv, &sn, &cs);
        const float x1 = sOut[rr * 64 + i], x2 = sOut[rr * 64 + i + 8];
        v = d < 8 ? x1 * cs - x2 * sn : x2 * cs + x1 * sn;
      }
      if (n >= NCMP) v = 0.f;
      sAll[(r8 * 8 + rr) * 65 + d] = v;
      if (n < NCMP) dst[((size_t)(b * NCMP + n) * 2 + g) * 64 + d] = v;
    }
  }
  __syncthreads();
  if (which == 0) {
    unsigned short* KCB = (unsigned short*)(p.ws + OFF_KCB) + (((size_t)b * 2 + g) * NB_CMP * 64 + tile * 64) * 64;
    for (int w = tid; w < 64 * 8; w += NTHREADS) {
      const int nl = w >> 3, o = w & 7;
      float v[8];
#pragma unroll
      for (int q = 0; q < 8; ++q) v[q] = sAll[nl * 65 + o * 8 + q];
      *(uint4*)(KCB + nl * 64 + o * 8) = make_uint4(pk2(v[0], v[1]), pk2(v[2], v[3]), pk2(v[4], v[5]), pk2(v[6], v[7]));
    }
  } else {
    unsigned short* VCT = (unsigned short*)(p.ws + OFF_VCT) + (((size_t)b * 2 + g) * NB_CMP + tile) * 64 * 64;
    for (int w = tid; w < 64 * 8; w += NTHREADS) {
      const int d = w >> 3, o = w & 7;
      float v[8];
#pragma unroll
      for (int q = 0; q < 8; ++q) v[q] = sAll[(o * 8 + q) * 65 + d];
      *(uint4*)(VCT + d * 64 + o * 8) = make_uint4(pk2(v[0], v[1]), pk2(v[2], v[3]), pk2(v[4], v[5]), pk2(v[6], v[7]));
    }
  }
}
DEV uint4 pack8(const float* v) {
  uint4 r;
  r.x = (unsigned)f2bf(v[0]) | ((unsigned)f2bf(v[1]) << 16);
  r.y = (unsigned)f2bf(v[2]) | ((unsigned)f2bf(v[3]) << 16);
  r.z = (unsigned)f2bf(v[4]) | ((unsigned)f2bf(v[5]) << 16);
  r.w = (unsigned)f2bf(v[6]) | ((unsigned)f2bf(v[7]) << 16);
  return r;
}
#define P1_PREP_ITEMS (NTOK / 64)
#define P1_PREP_SMEM ((64 * 8 * 2 + 64 * 128) * 4)
DEV void p1_prep(const Params& p, int item, char* smem) {
  const int tid = TIDX;
  const int b = item / NBLK, blk = item % NBLK;
  const float* H = (const float*)(p.ws + OFF_H);
  float* sCS = (float*)smem;
  float* sV = sCS + 64 * 8 * 2;
  const size_t tok0 = (size_t)b * SEQ_LEN + blk * 64;
  __syncthreads();
  for (int w = tid; w < 64 * 8; w += NTHREADS) {
    const int tk = w >> 3, i = w & 7;
    const float pos = (float)(blk * 64 + tk);
    const float inv = __expf(-(float)i * (13.122363377404328f / 8.f));
    float sn, cs;
    sincosf(pos * inv, &sn, &cs);
    sCS[w * 2] = cs; sCS[w * 2 + 1] = sn;
  }
  __syncthreads();
  unsigned short* QB = (unsigned short*)(p.ws + OFF_QB);
  unsigned short* KSB = (unsigned short*)(p.ws + OFF_KSB);
  unsigned short* KWB = (unsigned short*)(p.ws + OFF_KWB);
  for (int w = tid; w < 64 * 12 * 8; w += NTHREADS) {
    const int o = w & 7, hd = (w >> 3) % 12, tk = w / 96;
    const int col = hd < 8 ? 512 + hd * 64 : (hd < 10 ? 1280 + (hd - 8) * 64 : 1536 + (hd - 10) * 64);
    const float* x = H + (tok0 + tk) * AB_LD + col;
    float v[8];
    const float4 a0 = ld4(x + o * 8), a1 = ld4(x + o * 8 + 4);
    v[0] = a0.x; v[1] = a0.y; v[2] = a0.z; v[3] = a0.w; v[4] = a1.x; v[5] = a1.y; v[6] = a1.z; v[7] = a1.w;
    if (o < 2) {
      const float4 c0 = ld4(x + (1 - o) * 8), c1 = ld4(x + (1 - o) * 8 + 4);
      const float u[8] = {c0.x, c0.y, c0.z, c0.w, c1.x, c1.y, c1.z, c1.w};
#pragma unroll
      for (int i = 0; i < 8; ++i) {
        const float cs = sCS[(tk * 8 + i) * 2], sn = sCS[(tk * 8 + i) * 2 + 1];
        v[i] = o == 0 ? v[i] * cs - u[i] * sn : v[i] * cs + u[i] * sn;
      }
    }
    if (hd < 8) {
#pragma unroll
      for (int i = 0; i < 8; ++i) v[i] *= NSA_QSCALE;
      *(uint4*)(QB + ((tok0 + tk) * 8 + hd) * 64 + o * 8) = pack8(v);
    } else {
      const int g = (hd - 8) & 1;
      unsigned short* dst = (hd < 10 ? KSB : KWB) + (((size_t)b * 2 + g) * SEQ_LEN + blk * 64 + tk) * 64 + o * 8;
      *(uint4*)dst = pack8(v);
    }
  }
#pragma unroll 1
  for (int which = 0; which < 2; ++which) {
    const int col = which ? 1664 : 1408;
    __syncthreads();
    for (int w = tid; w < 64 * 32; w += NTHREADS) {
      const int tk = w >> 5, c4 = (w & 31) * 4;
      st4(sV + tk * 128 + c4, ld4(H + (tok0 + tk) * AB_LD + col + c4));
    }
    __syncthreads();
    unsigned short* VT = (unsigned short*)(p.ws + (which ? OFF_VWT : OFF_VST));
    for (int w = tid; w < 2 * 64 * 8; w += NTHREADS) {
      const int ko = w & 7, d = (w >> 3) & 63, g = w >> 9;
      float v[8];
#pragma unroll
      for (int i = 0; i < 8; ++i) v[i] = sV[(ko * 8 + i) * 128 + g * 64 + d];
      *(uint4*)(VT + ((((size_t)b * 2 + g) * NBLK + blk) * 64 + d) * 64 + ko * 8) = pack8(v);
    }
  }
}

struct NsaSmem {
  unsigned short k[64][72];
  unsigned short vt[64][68];
  float imp[32][128];
  unsigned selmask[32][4];
  unsigned unionm[4];
  float keyb[4][128];
};
#define P2_NSA_SMEM ((int)sizeof(NsaSmem))
#define NSA_QT (SEQ_LEN / 32)
#define P2_NSA_ITEMS (BATCH * 2 * NSA_QT)

struct TileRegs { uint4 k0, k1, v0, v1; };
DEV void tile_gload(TileRegs& r, const unsigned short* Kg, const unsigned short* Vg, int tid) {
  const int row = tid >> 2, seg = tid & 3;
  r.k0 = *(const uint4*)(Kg + row * 64 + seg * 16);
  r.k1 = *(const uint4*)(Kg + row * 64 + seg * 16 + 8);
  if (Vg) {
    r.v0 = *(const uint4*)(Vg + row * 64 + seg * 16);
    r.v1 = *(const uint4*)(Vg + row * 64 + seg * 16 + 8);
  }
}
DEV void tile_sstore(NsaSmem* sm, const TileRegs& r, bool withV, int tid) {
  const int row = tid >> 2, seg = tid & 3;
  *(uint4*)&sm->k[row][seg * 16] = r.k0;
  *(uint4*)&sm->k[row][seg * 16 + 8] = r.k1;
  if (withV) {
    *(uint2*)&sm->vt[row][seg * 16] = make_uint2(r.v0.x, r.v0.y);
    *(uint2*)&sm->vt[row][seg * 16 + 4] = make_uint2(r.v0.z, r.v0.w);
    *(uint2*)&sm->vt[row][seg * 16 + 8] = make_uint2(r.v1.x, r.v1.y);
    *(uint2*)&sm->vt[row][seg * 16 + 12] = make_uint2(r.v1.z, r.v1.w);
  }
}
DEV void qk_tile(const unsigned short (*ksm)[72], const bf16x8 (&qf)[4], f32x16 (&s)[2], int lane) {
  const int r = lane & 31, hh = lane >> 5;
#pragma unroll
  for (int ks2 = 0; ks2 < 2; ++ks2) {
#pragma unroll
    for (int i = 0; i < 16; ++i) s[ks2][i] = 0.f;
#pragma unroll
    for (int ks = 0; ks < 4; ++ks) {
      const bf16x8 a = *(const bf16x8*)&ksm[ks2 * 32 + r][ks * 16 + hh * 8];
      s[ks2] = __builtin_amdgcn_mfma_f32_32x32x16_bf16(a, qf[ks], s[ks2], 0, 0, 0);
    }
  }
}
DEV void pv_tile(const unsigned short (*vsm)[68], const f32x16 (&pr)[2], f32x16 (&o)[2], int lane) {
  const int r = lane & 31, hh = lane >> 5;
#pragma unroll
  for (int ks2 = 0; ks2 < 2; ++ks2)
#pragma unroll
    for (int s = 0; s < 2; ++s) {
      union { uint4 u; bf16x8 v; } pfu;
      pfu.u = make_uint4(pk2(pr[ks2][8 * s], pr[ks2][8 * s + 1]), pk2(pr[ks2][8 * s + 2], pr[ks2][8 * s + 3]),
                         pk2(pr[ks2][8 * s + 4], pr[ks2][8 * s + 5]), pk2(pr[ks2][8 * s + 6], pr[ks2][8 * s + 7]));
      const bf16x8 pf = pfu.v;
#pragma unroll
      for (int mt = 0; mt < 2; ++mt) {
        const uint2 lo = *(const uint2*)&vsm[mt * 32 + r][ks2 * 32 + 16 * s + 4 * hh];
        const uint2 hi = *(const uint2*)&vsm[mt * 32 + r][ks2 * 32 + 16 * s + 8 + 4 * hh];
        union { uint4 u; bf16x8 v; } au;
        au.u = make_uint4(lo.x, lo.y, hi.x, hi.y);
        const bf16x8 a = au.v;
        o[mt] = __builtin_amdgcn_mfma_f32_32x32x16_bf16(a, pf, o[mt], 0, 0, 0);
      }
    }
}
DEV float quad_sum(float v) {
#ifdef CPU_EMU
  v += __shfl_xor(v, 1); v += __shfl_xor(v, 2); return v;
#else
  int x;
  x = __builtin_amdgcn_update_dpp(0, __builtin_bit_cast(int, v), 0xB1, 0xF, 0xF, false); v += __builtin_bit_cast(float, x);
  x = __builtin_amdgcn_update_dpp(0, __builtin_bit_cast(int, v), 0x4E, 0xF, 0xF, false); v += __builtin_bit_cast(float, x);
  return v;
#endif
}
DEV void softmax_step(f32x16 (&s)[2], float& m, float& l, f32x16 (&o)[2]) {
  float tmax = -INFINITY;
#pragma unroll
  for (int ks2 = 0; ks2 < 2; ++ks2)
#pragma unroll
    for (int i = 0; i < 16; ++i) tmax = fmaxf(tmax, s[ks2][i]);
  tmax = fmaxf(tmax, __shfl_xor(tmax, 32));
  const float mnew = fmaxf(m, tmax);
  const float msafe = mnew == -INFINITY ? 0.f : mnew;
  const float alpha = fexp2(m - msafe);
  float ps = 0.f;
#pragma unroll
  for (int ks2 = 0; ks2 < 2; ++ks2)
#pragma unroll
    for (int i = 0; i < 16; ++i) { s[ks2][i] = fexp2(s[ks2][i] - msafe); ps += s[ks2][i]; }
  l = l * alpha + ps;
#pragma unroll
  for (int mt = 0; mt < 2; ++mt)
#pragma unroll
    for (int i = 0; i < 16; ++i) o[mt][i] *= alpha;
  m = mnew;
}
DEV bool testbit4(unsigned w0, unsigned w1, unsigned w2, unsigned w3, int j) {
  const unsigned lo = j & 32 ? w1 : w0, hi = j & 32 ? w3 : w2;
  const unsigned x = j & 64 ? hi : lo;
  return (x >> (j & 31)) & 1u;
}

DEV void p2_nsa(const Params& p, int item, char* smem) {
  NsaSmem* sm = (NsaSmem*)smem;
  const int tid = TIDX, lane = tid & 63, wave = tid >> 6;
  const int bg = item & 3, b = bg >> 1, g = bg & 1;
  const int qt = NSA_QT - 1 - (item >> 2);
  const int t0 = qt * 32;
  const int c = lane & 31, hh = lane >> 5, tl = c >> 2, h = c & 3;
  const int trow = wave * 8 + tl;
  const int tq = t0 + trow;
  const size_t tok = (size_t)b * SEQ_LEN + tq;
  const int hd = g * 4 + h;
  const float* H = (const float*)(p.ws + OFF_H);
  const unsigned short* QB = (const unsigned short*)(p.ws + OFF_QB);
  const unsigned short* KSB = (const unsigned short*)(p.ws + OFF_KSB) + ((size_t)b * 2 + g) * SEQ_LEN * 64;
  const unsigned short* KWB = (const unsigned short*)(p.ws + OFF_KWB) + ((size_t)b * 2 + g) * SEQ_LEN * 64;
  const unsigned short* VST = (const unsigned short*)(p.ws + OFF_VST) + ((size_t)b * 2 + g) * NBLK * 4096;
  const unsigned short* VWT = (const unsigned short*)(p.ws + OFF_VWT) + ((size_t)b * 2 + g) * NBLK * 4096;
  const unsigned short* KCB = (const unsigned short*)(p.ws + OFF_KCB) + ((size_t)b * 2 + g) * NB_CMP * 4096;
  const unsigned short* VCT = (const unsigned short*)(p.ws + OFF_VCT) + ((size_t)b * 2 + g) * NB_CMP * 4096;
  bf16x8 qf[4];
  {
    const unsigned short* qrow = QB + (tok * 8 + hd) * 64;
#pragma unroll
    for (int ks = 0; ks < 4; ++ks) qf[ks] = *(const bf16x8*)(qrow + ks * 16 + hh * 8);
  }
  const float g0 = sigmoidf_(H[tok * AB_LD + 1792 + hd * 3 + 0]);
  const float g1 = sigmoidf_(H[tok * AB_LD + 1792 + hd * 3 + 1]);
  const float g2 = sigmoidf_(H[tok * AB_LD + 1792 + hd * 3 + 2]);
  f32x16 o[2], s[2];
#pragma unroll
  for (int mt = 0; mt < 2; ++mt)
#pragma unroll
    for (int i = 0; i < 16; ++i) o[mt][i] = 0.f;
  float* mixrow = (float*)(p.ws + OFF_MIX) + tok * 1024 + 512 + hd * 64 + 4 * hh;
  __syncthreads();
  for (int w = tid; w < 32 * 128; w += NTHREADS) (&sm->imp[0][0])[w] = 0.f;
  TileRegs tr;
  tr.k0 = tr.k1 = tr.v0 = tr.v1 = make_uint4(0, 0, 0, 0);
  const int nval = tq >= 31 ? (tq - 31) / 16 + 1 : 0;
  const int nvmax = (t0 + 31 - 31) / 16 + 1;
  const int ktn = (nvmax + 63) / 64;
  float m = -INFINITY, l = 0.f;
  tile_gload(tr, KCB, nullptr, tid);
  for (int kt = 0; kt < ktn; ++kt) {
    __syncthreads();
    tile_sstore(sm, tr, false, tid);
    __syncthreads();
    if (kt + 1 < ktn) tile_gload(tr, KCB + (size_t)(kt + 1) * 4096, nullptr, tid);
    qk_tile(sm->k, qf, s, lane);
    float tmax = -INFINITY;
#pragma unroll
    for (int ks2 = 0; ks2 < 2; ++ks2)
#pragma unroll
      for (int i = 0; i < 16; ++i) {
        const int n = kt * 64 + ks2 * 32 + (i & 3) + 8 * (i >> 2) + 4 * hh;
        s[ks2][i] = n < nval ? s[ks2][i] : -INFINITY;
        tmax = fmaxf(tmax, s[ks2][i]);
      }
    tmax = fmaxf(tmax, __shfl_xor(tmax, 32));
    const float mnew = fmaxf(m, tmax);
    const float msafe = mnew == -INFINITY ? 0.f : mnew;
    float ps = 0.f;
#pragma unroll
    for (int ks2 = 0; ks2 < 2; ++ks2)
#pragma unroll
      for (int i = 0; i < 16; ++i) ps += fexp2(s[ks2][i] - msafe);
    l = l * fexp2(m - msafe) + ps;
    m = mnew;
  }
  {
    const float ltot = l + __shfl_xor(l, 32);
    const float invl = ltot > 0.f ? 1.f / ltot : 0.f;
    const float msafe = m == -INFINITY ? 0.f : m;
    tile_gload(tr, KCB, VCT, tid);
    for (int kt = 0; kt < ktn; ++kt) {
      __syncthreads();
      tile_sstore(sm, tr, true, tid);
      __syncthreads();
      if (kt + 1 < ktn) tile_gload(tr, KCB + (size_t)(kt + 1) * 4096, VCT + (size_t)(kt + 1) * 4096, tid);
      qk_tile(sm->k, qf, s, lane);
#pragma unroll
      for (int ks2 = 0; ks2 < 2; ++ks2)
#pragma unroll
        for (int i = 0; i < 16; ++i) {
          const int n = kt * 64 + ks2 * 32 + (i & 3) + 8 * (i >> 2) + 4 * hh;
          s[ks2][i] = n < nval ? fexp2(s[ks2][i] - msafe) * invl : 0.f;
        }
#pragma unroll
      for (int ks2 = 0; ks2 < 2; ++ks2)
#pragma unroll
        for (int g4 = 0; g4 < 4; ++g4) {
          float A = 2.f * (s[ks2][4 * g4] + s[ks2][4 * g4 + 1] + s[ks2][4 * g4 + 2]) + s[ks2][4 * g4 + 3];
          float Bv = s[ks2][4 * g4 + 3];
          A = quad_sum(A); Bv = quad_sum(Bv);
          const int j = kt * 16 + ks2 * 8 + 2 * g4 + hh;
          if (h == 0 && j < NBLK) sm->imp[trow][j] += A;
          WAVE_SYNC();
          if (h == 0 && j + 1 < NBLK) sm->imp[trow][j + 1] += Bv;
          WAVE_SYNC();
        }
      pv_tile(sm->vt, s, o, lane);
    }
#pragma unroll
    for (int mt = 0; mt < 2; ++mt)
#pragma unroll
      for (int g4 = 0; g4 < 4; ++g4) {
        st4(mixrow + mt * 32 + 8 * g4, make_float4(o[mt][4 * g4] * g0, o[mt][4 * g4 + 1] * g0, o[mt][4 * g4 + 2] * g0, o[mt][4 * g4 + 3] * g0));
        o[mt][4 * g4] = 0.f; o[mt][4 * g4 + 1] = 0.f; o[mt][4 * g4 + 2] = 0.f; o[mt][4 * g4 + 3] = 0.f;
      }
  }
  WAVE_SYNC();
  for (int t8 = 0; t8 < 8; ++t8) {
    const int row = wave * 8 + t8, tt = t0 + row, cur = tt >> 6;
    float kv[2]; bool valid[2];
#pragma unroll
    for (int c2 = 0; c2 < 2; ++c2) {
      const int j = lane + 64 * c2;
      valid[c2] = j < NBLK && j <= cur;
      const bool forced = (j == 0) | (j == cur) | (j == cur - 1);
      kv[c2] = valid[c2] ? (forced ? 1e6f : sm->imp[row][j < NBLK ? j : 0]) : -1.f;
      sm->keyb[wave][j] = kv[c2];
    }
    WAVE_SYNC();
    int rank0 = 0, rank1 = 0;
    const int jlim = cur < NBLK - 1 ? cur : NBLK - 1;
    for (int jj = 0; jj <= jlim; ++jj) {
      const float ov = sm->keyb[wave][jj];
      rank0 += (ov > kv[0] || (ov == kv[0] && jj < lane)) ? 1 : 0;
      rank1 += (ov > kv[1] || (ov == kv[1] && jj < lane + 64)) ? 1 : 0;
    }
    const unsigned long long m0 = __ballot(valid[0] && rank0 < 16);
    const unsigned long long m1 = __ballot(valid[1] && rank1 < 16);
    if (lane == 0) {
      sm->selmask[row][0] = (unsigned)m0; sm->selmask[row][1] = (unsigned)(m0 >> 32);
      sm->selmask[row][2] = (unsigned)m1; sm->selmask[row][3] = (unsigned)(m1 >> 32);
    }
    WAVE_SYNC();
  }
  __syncthreads();
  if (tid < 4) {
    unsigned u = 0;
    for (int r = 0; r < 32; ++r) u |= sm->selmask[r][tid];
    sm->unionm[tid] = u;
  }
  __syncthreads();
  const unsigned um0 = sm->unionm[0], um1 = sm->unionm[1], um2 = sm->unionm[2], um3 = sm->unionm[3];
  const unsigned my0 = sm->selmask[trow][0], my1 = sm->selmask[trow][1], my2 = sm->selmask[trow][2], my3 = sm->selmask[trow][3];
  {
    const int jmax = (t0 + 31) >> 6;
    int j = 0;
    while (j <= jmax && !testbit4(um0, um1, um2, um3, j)) ++j;
    m = -INFINITY; l = 0.f;
    if (j <= jmax) tile_gload(tr, KSB + (size_t)j * 4096, VST + (size_t)j * 4096, tid);
    while (j <= jmax) {
      __syncthreads();
      tile_sstore(sm, tr, true, tid);
      __syncthreads();
      int jn = j + 1;
      while (jn <= jmax && !testbit4(um0, um1, um2, um3, jn)) ++jn;
      if (jn <= jmax) tile_gload(tr, KSB + (size_t)jn * 4096, VST + (size_t)jn * 4096, tid);
      const bool mine = testbit4(my0, my1, my2, my3, j);
      if (__ballot(mine) != 0ull) {
        qk_tile(sm->k, qf, s, lane);
#pragma unroll
        for (int ks2 = 0; ks2 < 2; ++ks2)
#pragma unroll
          for (int i = 0; i < 16; ++i) {
            const int kp = j * 64 + ks2 * 32 + (i & 3) + 8 * (i >> 2) + 4 * hh;
            s[ks2][i] = (mine && kp <= tq) ? s[ks2][i] : -INFINITY;
          }
        softmax_step(s, m, l, o);
        pv_tile(sm->vt, s, o, lane);
      }
      j = jn;
    }
    const float ltot = l + __shfl_xor(l, 32);
    const float sc = ltot > 0.f ? g1 / ltot : 0.f;
#pragma unroll
    for (int mt = 0; mt < 2; ++mt)
#pragma unroll
      for (int g4 = 0; g4 < 4; ++g4) {
        float4 a = ld4(mixrow + mt * 32 + 8 * g4);
        a.x += o[mt][4 * g4] * sc; a.y += o[mt][4 * g4 + 1] * sc; a.z += o[mt][4 * g4 + 2] * sc; a.w += o[mt][4 * g4 + 3] * sc;
        st4(mixrow + mt * 32 + 8 * g4, a);
        o[mt][4 * g4] = 0.f; o[mt][4 * g4 + 1] = 0.f; o[mt][4 * g4 + 2] = 0.f; o[mt][4 * g4 + 3] = 0.f;
      }
  }
  {
    const int jlo = t0 - 511 > 0 ? (t0 - 511) >> 6 : 0, jhi = (t0 + 31) >> 6;
    const int wq0 = t0 + wave * 8;
    m = -INFINITY; l = 0.f;
    tile_gload(tr, KWB + (size_t)jlo * 4096, VWT + (size_t)jlo * 4096, tid);
    for (int j = jlo; j <= jhi; ++j) {
      __syncthreads();
      tile_sstore(sm, tr, true, tid);
      __syncthreads();
      if (j + 1 <= jhi) tile_gload(tr, KWB + (size_t)(j + 1) * 4096, VWT + (size_t)(j + 1) * 4096, tid);
      if (j * 64 <= wq0 + 7 && j * 64 + 63 > wq0 - 512) {
        qk_tile(sm->k, qf, s, lane);
#pragma unroll
        for (int ks2 = 0; ks2 < 2; ++ks2)
#pragma unroll
          for (int i = 0; i < 16; ++i) {
            const int kp = j * 64 + ks2 * 32 + (i & 3) + 8 * (i >> 2) + 4 * hh;
            s[ks2][i] = (kp <= tq && kp > tq - 512) ? s[ks2][i] : -INFINITY;
          }
        softmax_step(s, m, l, o);
        pv_tile(sm->vt, s, o, lane);
      }
    }
    const float ltot = l + __shfl_xor(l, 32);
    const float sc = ltot > 0.f ? g2 / ltot : 0.f;
#pragma unroll
    for (int mt = 0; mt < 2; ++mt)
#pragma unroll
      for (int g4 = 0; g4 < 4; ++g4) {
        float4 a = ld4(mixrow + mt * 32 + 8 * g4);
        a.x += o[mt][4 * g4] * sc; a.y += o[mt][4 * g4 + 1] * sc; a.z += o[mt][4 * g4 + 2] * sc; a.w += o[mt][4 * g4 + 3] * sc;
        st4(mixrow + mt * 32 + 8 * g4, a);
        o[mt][4 * g4] = 0.f; o[mt][4 * g4 + 1] = 0.f; o[mt][4 * g4 + 2] = 0.f; o[mt][4 * g4 + 3] = 0.f;
      }
  }
}

#define P1_SMEM ((8 * 64 + 8 * 128 + 64 * 65 + 128) * 4)
DEV void phase_p1(const Params& p, char* smem) {
  const int total = P1_CMPG_ITEMS + P1_CMPC1_ITEMS + P1_PREP_ITEMS;
  for (int it = BIDX; it < total; it += gridDim.x) {
    if (it < P1_CMPG_ITEMS) p1_cmpgemm(p, it, smem);
    else if (it < P1_CMPG_ITEMS + P1_CMPC1_ITEMS) p1_cmpc1(p, it - P1_CMPG_ITEMS, smem);
    else p1_prep(p, it - P1_CMPG_ITEMS - P1_CMPC1_ITEMS, smem);
  }
  {
    const int Gh = (int)gridDim.x / 2, bid_ = BIDX;
    if (bid_ < Gh) for (int it = bid_; it < P1_S5A_ITEMS; it += Gh) p1_s5a(p, it, smem);
  }
}
#define S5PFX_ITEMS (BATCH * 32 * 64 / NTHREADS)
DEV void s5_prefix(const Params& p, int item) {
  const int gi = item * NTHREADS + TIDX;
  const int lane = gi & 63, g = (gi >> 6) & 31, b = gi >> 11;
  float lb_re, lb_im, bbr[16], bbi[16];
  s5_consts(p, g, lane, lb_re, lb_im, bbr, bbi);
  float ar = lb_re, ai = lb_im;
#pragma unroll
  for (int s = 0; s < 6; ++s) { const float nr = ar * ar - ai * ai, ni = 2.f * ar * ai; ar = nr; ai = ni; }
  float2* E = (float2*)(p.ws + OFF_S5E) + ((size_t)b * S5_NC * 32 + g) * 64 + lane;
  float sr = 0.f, si = 0.f;
  for (int c = 0; c < S5_NC; c += 8) {
    float2 e[8];
#pragma unroll
    for (int q = 0; q < 8; ++q) e[q] = E[(size_t)(c + q) * 32 * 64];
#pragma unroll
    for (int q = 0; q < 8; ++q) {
      E[(size_t)(c + q) * 32 * 64] = make_float2(sr, si);
      const float nr = ar * sr - ai * si + e[q].x, ni = ar * si + ai * sr + e[q].y;
      sr = nr; si = ni;
    }
  }
}
DEV void phase_p1b(const Params& p, char* smem) {
  for (int it = BIDX; it < P1_CMP_ITEMS; it += gridDim.x) p1_compress(p, it, smem);
  for (int it = (int)gridDim.x - 1 - (int)BIDX; it < S5PFX_ITEMS; it += gridDim.x) s5_prefix(p, it);
}

#define P2_S5C_ITEMS (BATCH * 32 * S5_NC / 4)
#define P2_S5C_SMEM ((4 * 16 * S5C_ROW + 2 * 16 * 64 + 4 * 16 * 16) * 4)
DEV void p2_s5c(const Params& p, int item, char* smem) {
  const int lane = TIDX & 63, wave = TIDX >> 6, tid = TIDX;
  const int g = item & 31, c = ((item >> 5) % (S5_NC / 4)) * 4 + wave, b = item / (32 * (S5_NC / 4));
  float lb_re, lb_im;
  {
    float bbr[16], bbi[16];
    s5_consts(p, g, lane, lb_re, lb_im, bbr, bbi);
  }
  bf16x8 bB[4];
  s5_bfrags(p, g, lane, bB);
  const float2* E = (const float2*)(p.ws + OFF_S5E);
  const float2 e0 = E[((size_t)(b * S5_NC + c) * 32 + g) * 64 + lane];
  float sr = e0.x, si = e0.y;
  const float* H = (const float*)(p.ws + OFF_H);
  float* sS = (float*)smem + wave * 16 * S5C_ROW;
  float* sCre = (float*)smem + 4 * 16 * S5C_ROW;
  float* sCim = sCre + 16 * 64;
  float* su = sCim + 16 * 64 + wave * 16 * 16;
  __syncthreads();
  {
    const float* cre = p.in[I_S5_C_RE] + (size_t)g * 16 * 64;
    const float* cim = p.in[I_S5_C_IM] + (size_t)g * 16 * 64;
    st4(sCre + tid * 4, ld4(cre + tid * 4));
    st4(sCim + tid * 4, ld4(cim + tid * 4));
  }
  __syncthreads();
  const int nn = lane & 15, hh = lane >> 5;
  bf16x8 bC[8];
#pragma unroll
  for (int ks = 0; ks < 8; ++ks) {
    const float* src = (ks < 4 ? sCre : sCim) + nn * 64 + 16 * (ks & 3) + 8 * hh;
    float4 c0 = ld4(src), c1 = ld4(src + 4);
    if (ks >= 4) { c0 = make_float4(-c0.x, -c0.y, -c0.z, -c0.w); c1 = make_float4(-c1.x, -c1.y, -c1.z, -c1.w); }
    bC[ks] = pack_bf8(c0, c1);
  }
  const float dch = p.in[I_S5_D][g * 16 + nn];
  float* YG = (float*)(p.ws + OFF_YGELU);
  for (int sc = 0; sc < 4; ++sc) {
    {
      const float* ur = H + (size_t)(b * SEQ_LEN + c * 64 + sc * 16 + (lane >> 2)) * AB_LD + g * 16 + (lane & 3) * 4;
      st4(su + (lane >> 2) * 16 + (lane & 3) * 4, ld4(ur));
    }
    WAVE_SYNC();
    s5_subchunk(su, sS, bB, lb_re, lb_im, sr, si, lane);
    WAVE_SYNC();
    {
      f32x16 acc;
#pragma unroll
      for (int i = 0; i < 16; ++i) acc[i] = 0.f;
      const float* arow = sS + nn * S5C_ROW + 8 * hh;
#pragma unroll
      for (int ks = 0; ks < 8; ++ks) {
        const float* src = arow + 16 * ks;
        acc = __builtin_amdgcn_mfma_f32_32x32x16_bf16(pack_bf8(ld4(src), ld4(src + 4)), bC[ks], acc, 0, 0, 0);
      }
      if ((lane & 16) == 0) {
#pragma unroll
        for (int r8 = 0; r8 < 8; ++r8) {
          const int t = (r8 & 3) + 8 * (r8 >> 2) + 4 * hh;
          const size_t tok = (size_t)(b * SEQ_LEN + c * 64 + sc * 16 + t);
          YG[tok * 512 + g * 16 + nn] = geluf_(acc[r8] + dch * su[t * 16 + nn]);
        }
      }
    }
    WAVE_SYNC();
  }
}

#define P2_SMEM (P2_S5C_SMEM > P2_NSA_SMEM ? P2_S5C_SMEM : P2_NSA_SMEM)
DEV void phase_p2(const Params& p, char* smem) {
  const int G = gridDim.x;
  const int total = P2_NSA_ITEMS + P2_S5C_ITEMS;
  for (int r = 0;; ++r) {
    const int it = r * G + ((r & 1) ? (G - 1 - (int)BIDX) : (int)BIDX);
    if (r * G >= total) break;
    if (it >= total) continue;
    if (it < P2_NSA_ITEMS) p2_nsa(p, it, smem);
    else p2_s5c(p, it - P2_NSA_ITEMS, smem);
  }
}

DEV void phase_glu(const Params& p, char* smem) {
  const float* A = (const float*)(p.ws + OFF_YGELU);
  const float* B = p.in[I_S5_W_GLU];
  const float* bias = p.in[I_S5_B_GLU];
  float* MIX = (float*)(p.ws + OFF_MIX);
  const int NT = 4, MT = NTOK / GEMM_BM;
  const int xcd_ = BIDX & 7, lb_ = BIDX >> 3, nb_ = gridDim.x >> 3;
  for (int j_ = lb_; j_ < (MT / 8) * NT; j_ += nb_) {
    const int it = (xcd_ + 8 * (j_ / NT)) * NT + (j_ % NT);
    const int m0 = (it / NT) * GEMM_BM, n0 = (it % NT) * 128;
    gemm_tile<false>(
        [&](int r) { return (const void*)(A + (size_t)(m0 + r) * 512); },
        [&](int c) { return B + n0 + c; }, 512, 512,
        [&](int row, int col, float v0, float v1) {
          const size_t gm = m0 + row; const int gc = n0 + col;
          const float y0 = A[gm * 512 + gc], y1 = A[gm * 512 + gc + 32];
          MIX[gm * 1024 + gc] = y0 * sigmoidf_(v0 + bias[gc]);
          MIX[gm * 1024 + gc + 32] = y1 * sigmoidf_(v1 + bias[gc + 32]);
        },
        smem);
  }
}

template <int LAYER>
DEV void phase_outproj(const Params& p, char* smem) {
  const float* A = (const float*)(p.ws + OFF_MIX);
  const float* B = LAYER == 0 ? p.in[I_AB_W_OUT] : p.in[I_CD_W_OUT];
  const float* xin = LAYER == 0 ? p.in[I_X] : (const float*)(p.ws + OFF_X2);
  float* PRE = (float*)(p.ws + OFF_H);
  const int NT = 8, MT = NTOK / GEMM_BM;
  const int xcd_ = BIDX & 7, lb_ = BIDX >> 3, nb_ = gridDim.x >> 3;
  for (int j_ = lb_; j_ < (MT / 8) * NT; j_ += nb_) {
    const int it = (xcd_ + 8 * (j_ / NT)) * NT + (j_ % NT);
    const int m0 = (it / NT) * GEMM_BM, n0 = (it % NT) * 128;
    gemm_tile<false>(
        [&](int r) { return (const void*)(A + (size_t)(m0 + r) * 1024); },
        [&](int c) { return B + n0 + c; }, 1024, 1024,
        [&](int row, int col, float v0, float v1) {
          const size_t o = (size_t)(m0 + row) * 1024 + n0 + col;
          PRE[o] = ALPHA_F * xin[o] + v0;
          PRE[o + 32] = ALPHA_F * xin[o + 32] + v1;
        },
        smem);
  }
}

DEV void wave_ln(float (&v)[16], const float* gam, const float* bet, int lane) {
  float s = 0.f;
#pragma unroll
  for (int i = 0; i < 16; ++i) s += v[i];
  const float mu = wave_sum(s) * (1.f / 1024.f);
  float q = 0.f;
#pragma unroll
  for (int i = 0; i < 16; ++i) { const float d = v[i] - mu; q += d * d; }
  const float rstd = rsqrtf(wave_sum(q) * (1.f / 1024.f) + 1e-5f);
#pragma unroll
  for (int i = 0; i < 4; ++i) {
    const float4 gv = ld4(gam + lane * 4 + 256 * i), bv = ld4(bet + lane * 4 + 256 * i);
    v[i * 4 + 0] = (v[i * 4 + 0] - mu) * rstd * gv.x + bv.x;
    v[i * 4 + 1] = (v[i * 4 + 1] - mu) * rstd * gv.y + bv.y;
    v[i * 4 + 2] = (v[i * 4 + 2] - mu) * rstd * gv.z + bv.z;
    v[i * 4 + 3] = (v[i * 4 + 3] - mu) * rstd * gv.w + bv.w;
  }
}

#define LNR_T 4
#define P5_SMEM ((4 * LNR_T * 512 + 4 * 4 * LNR_T * 64 + 4 * 64) * 4)
template <int LAYER>
DEV void phase_ln_router(const Params& p, char* smem) {
  const int lane = TIDX & 63, wave = TIDX >> 6;
  const float* PRE = (const float*)(p.ws + OFF_H);
  float* X1 = (float*)(p.ws + OFF_X1);
  const float* router = p.in[I_ROUTER] + (size_t)LAYER * 1024 * 64;
  const float* bias = p.in[I_MOE_BIAS] + LAYER * 64;
  int* TOPI = (int*)(p.ws + OFF_TOPI);
  float* TOPG = (float*)(p.ws + OFF_TOPG);
  float* xh = (float*)smem;
  float* part = xh + 4 * LNR_T * 512;
  float* ms = part + 4 * 4 * LNR_T * 64 + wave * 64;
  unsigned short* X1B = (unsigned short*)p.out;
  for (int it = BIDX; it < NTOK / (4 * LNR_T); it += gridDim.x) {
    const size_t tokb = (size_t)it * (4 * LNR_T) + wave * LNR_T;
    float v[LNR_T][16];
#pragma unroll
    for (int t = 0; t < LNR_T; ++t) {
      const size_t tok = tokb + t;
#pragma unroll
      for (int i = 0; i < 4; ++i) {
        const float4 a = ld4(PRE + tok * 1024 + lane * 4 + 256 * i);
        v[t][i * 4] = a.x; v[t][i * 4 + 1] = a.y; v[t][i * 4 + 2] = a.z; v[t][i * 4 + 3] = a.w;
      }
      wave_ln(v[t], p.in[I_LN1_G] + LAYER * 1024, p.in[I_LN1_B] + LAYER * 1024, lane);
#pragma unroll
      for (int i = 0; i < 4; ++i) {
        const float4 a = make_float4(v[t][i * 4], v[t][i * 4 + 1], v[t][i * 4 + 2], v[t][i * 4 + 3]);
        st4(X1 + tok * 1024 + lane * 4 + 256 * i, a);
        *(uint2*)(X1B + tok * 1024 + lane * 4 + 256 * i) = make_uint2(pk2(a.x, a.y), pk2(a.z, a.w));
      }
    }
    {
      static_assert(LNR_T == 4, "the MFMA logits tile holds 16 tokens");
      const int hh = lane >> 5;
      f32x16 acc[2];
#pragma unroll
      for (int nt = 0; nt < 2; ++nt)
#pragma unroll
        for (int i = 0; i < 16; ++i) acc[nt][i] = 0.f;
#pragma unroll
      for (int hf = 0; hf < 2; ++hf) {
        __syncthreads();
#pragma unroll
        for (int t = 0; t < LNR_T; ++t)
#pragma unroll
          for (int i2 = 0; i2 < 2; ++i2) {
            const int i = 2 * hf + i2;
            st4(xh + (wave * LNR_T + t) * 512 + lane * 4 + 256 * i2, make_float4(v[t][i * 4], v[t][i * 4 + 1], v[t][i * 4 + 2], v[t][i * 4 + 3]));
          }
        __syncthreads();
#pragma unroll 2
        for (int kk = wave * 128; kk < wave * 128 + 128; kk += 16) {
          const int k = hf * 512 + kk;
          bf16x8 ahi, alo;
          {
            const float* xr = xh + (lane & 15) * 512 + kk + 8 * hh;
            const float4 x0 = ld4(xr), x1 = ld4(xr + 4);
            const unsigned h0 = pk2(x0.x, x0.y), h1 = pk2(x0.z, x0.w), h2 = pk2(x1.x, x1.y), h3 = pk2(x1.z, x1.w);
            union { uint4 u; bf16x8 v; } hi, lo;
            hi.u = make_uint4(h0, h1, h2, h3);
            lo.u = make_uint4(pk2(x0.x - bf2f((unsigned short)(h0 & 0xFFFF)), x0.y - bf2f((unsigned short)(h0 >> 16))),
                              pk2(x0.z - bf2f((unsigned short)(h1 & 0xFFFF)), x0.w - bf2f((unsigned short)(h1 >> 16))),
                              pk2(x1.x - bf2f((unsigned short)(h2 & 0xFFFF)), x1.y - bf2f((unsigned short)(h2 >> 16))),
                              pk2(x1.z - bf2f((unsigned short)(h3 & 0xFFFF)), x1.w - bf2f((unsigned short)(h3 >> 16))));
            ahi = hi.v; alo = lo.v;
          }
#pragma unroll
          for (int nt = 0; nt < 2; ++nt) {
            const float* rp = router + (size_t)(k + 8 * hh) * 64 + 32 * nt + (lane & 31);
            float rb[8];
#pragma unroll
            for (int j = 0; j < 8; ++j) rb[j] = rp[(size_t)j * 64];
            const unsigned h0 = pk2(rb[0], rb[1]), h1 = pk2(rb[2], rb[3]), h2 = pk2(rb[4], rb[5]), h3 = pk2(rb[6], rb[7]);
            union { uint4 u; bf16x8 v; } hi, lo;
            hi.u = make_uint4(h0, h1, h2, h3);
            lo.u = make_uint4(pk2(rb[0] - bf2f((unsigned short)(h0 & 0xFFFF)), rb[1] - bf2f((unsigned short)(h0 >> 16))),
                              pk2(rb[2] - bf2f((unsigned short)(h1 & 0xFFFF)), rb[3] - bf2f((unsigned short)(h1 >> 16))),
                              pk2(rb[4] - bf2f((unsigned short)(h2 & 0xFFFF)), rb[5] - bf2f((unsigned short)(h2 >> 16))),
                              pk2(rb[6] - bf2f((unsigned short)(h3 & 0xFFFF)), rb[7] - bf2f((unsigned short)(h3 >> 16))));
            acc[nt] = __builtin_amdgcn_mfma_f32_32x32x16_bf16(ahi, hi.v, acc[nt], 0, 0, 0);
            acc[nt] = __builtin_amdgcn_mfma_f32_32x32x16_bf16(ahi, lo.v, acc[nt], 0, 0, 0);
            acc[nt] = __builtin_amdgcn_mfma_f32_32x32x16_bf16(alo, hi.v, acc[nt], 0, 0, 0);
          }
        }
      }
#pragma unroll
      for (int nt = 0; nt < 2; ++nt)
#pragma unroll
        for (int r8 = 0; r8 < 8; ++r8)
          part[(wave * 4 * LNR_T + (r8 & 3) + 8 * (r8 >> 2) + 4 * hh) * 64 + 32 * nt + (lane & 31)] = acc[nt][r8];
    }
    __syncthreads();
    float lg[LNR_T];
#pragma unroll
    for (int t = 0; t < LNR_T; ++t) {
      const int tg = wave * LNR_T + t;
      lg[t] = ((part[(0 * 4 * LNR_T + tg) * 64 + lane] + part[(1 * 4 * LNR_T + tg) * 64 + lane]) + part[(2 * 4 * LNR_T + tg) * 64 + lane]) +
              part[(3 * 4 * LNR_T + tg) * 64 + lane];
    }
#pragma unroll
    for (int t = 0; t < LNR_T; ++t) {
      const size_t tok = tokb + t;
      const float score = 1.f / (1.f + expf(-lg[t]));
      const float biased = score + bias[lane];
      float m1 = biased; int a1 = lane;
#pragma unroll
      for (int mm = 1; mm <= 4; mm <<= 1) {
        const float ov = __shfl_xor(m1, mm); const int oa = __shfl_xor(a1, mm);
        if (ov > m1 || (ov == m1 && oa < a1)) { m1 = ov; a1 = oa; }
      }
      float m2 = lane == a1 ? -INFINITY : biased;
#pragma unroll
      for (int mm = 1; mm <= 4; mm <<= 1) m2 = fmaxf(m2, __shfl_xor(m2, mm));
      const float gs = m1 + m2;
      const int mygrp = lane >> 3;
      int rank = 0;
#pragma unroll
      for (int gg = 0; gg < 8; ++gg) {
        const float og = __shfl(gs, gg * 8);
        rank += (og > gs || (og == gs && gg < mygrp)) ? 1 : 0;
      }
      const float masked = rank < 4 ? biased : -INFINITY;
      WAVE_SYNC();
      ms[lane] = masked;
      WAVE_SYNC();
      int erank = 0;
      for (int e = 0; e < 64; ++e) {
        const float ov = ms[e];
        erank += (ov > masked || (ov == masked && e < lane)) ? 1 : 0;
      }
      const bool selected = erank < 8;
      const float gsum = wave_sum(selected ? score : 0.f);
      if (selected) {
        TOPI[tok * 8 + erank] = lane;
        TOPG[tok * 8 + erank] = score / gsum * 2.5f;
      }
    }
  }
}

#define P6_SMEM GEMM_SMEM_BYTES
template <int LAYER>
DEV void phase_lists_shup(const Params& p, char* smem) {
  const int tid = TIDX, lane = tid & 63, wave = tid >> 6;
  const int* TOPI = (const int*)(p.ws + OFF_TOPI);
  const float* TOPG = (const float*)(p.ws + OFF_TOPG);
  int* PPOS = (int*)(p.ws + OFF_S5E);
  int* CNT = (int*)(p.ws + OFF_CNT);
  int* LTOK = (int*)(p.ws + OFF_LTOK);
  float* LGATE = (float*)(p.ws + OFF_LGATE);
  const unsigned short* X1B = (const unsigned short*)p.out;
  unsigned short* HS = (unsigned short*)(p.ws + OFF_HS);
  const float* W1 = p.in[I_SH_W1] + (size_t)LAYER * 1024 * 256;
  const float* W3 = p.in[I_SH_W3] + (size_t)LAYER * 1024 * 256;
  const int MT = NTOK / GEMM_BM;
  int* swave = (int*)smem;
  for (int it = BIDX; it < 64; it += gridDim.x) {
    const int e = it;
    int base = 0;
    for (int t0 = 0; t0 < NTOK; t0 += 4 * NTHREADS) {
      const int tok4 = t0 + 4 * tid;
      int slot[4];
      unsigned long long bal[4];
#pragma unroll
      for (int j = 0; j < 4; ++j) {
        const int4 a = *(const int4*)(TOPI + (size_t)(tok4 + j) * 8), b = *(const int4*)(TOPI + (size_t)(tok4 + j) * 8 + 4);
        int sl = -1;
        sl = a.x == e ? 0 : sl; sl = a.y == e ? 1 : sl; sl = a.z == e ? 2 : sl; sl = a.w == e ? 3 : sl;
        sl = b.x == e ? 4 : sl; sl = b.y == e ? 5 : sl; sl = b.z == e ? 6 : sl; sl = b.w == e ? 7 : sl;
        slot[j] = sl;
        bal[j] = __ballot(sl >= 0);
      }
      const unsigned long long lower = (1ull << lane) - 1ull;
      int pre = 0, wtot = 0;
#pragma unroll
      for (int j = 0; j < 4; ++j) { pre += __popcll(bal[j] & lower); wtot += __popcll(bal[j]); }
      __syncthreads();
      if (lane == 0) swave[wave] = wtot;
      __syncthreads();
      int woff = 0, tot = 0;
#pragma unroll
      for (int w = 0; w < 4; ++w) { const int c = swave[w]; if (w < wave) woff += c; tot += c; }
      int pos = base + woff + pre;
#pragma unroll
      for (int j = 0; j < 4; ++j) {
        if (slot[j] >= 0) {
          const int tok = tok4 + j;
          LTOK[(size_t)e * NTOK + pos] = tok;
          LGATE[(size_t)e * NTOK + pos] = TOPG[(size_t)tok * 8 + slot[j]];
          PPOS[(size_t)e * NTOK + tok] = pos;
          ++pos;
        }
      }
      base += tot;
    }
    if (tid == 0) CNT[e * 32] = base;
    __syncthreads();
  }
  {
    const int NT = 4;
    const int xcd_ = BIDX & 7, lb_ = BIDX >> 3, nb_ = gridDim.x >> 3;
    for (int j_ = lb_; j_ < (MT / 8) * NT; j_ += nb_) {
      const int m0 = (xcd_ + 8 * (j_ / NT)) * GEMM_BM, ct = j_ % NT;
      gemm_tile<true>(
          [&](int r) { return (const void*)(X1B + (size_t)(m0 + r) * 1024); },
          [&](int c) { return (((c >> 5) & 1) ? W3 : W1) + ct * 64 + (c >> 6) * 32 + (c & 31); }, 256, 1024,
          [&](int row, int col, float v0, float v1) {
            const int lc = ct * 64 + (col >> 6) * 32 + (col & 31);
            HS[(size_t)(m0 + row) * 256 + lc] = f2bf(siluf_(v0) * v1);
          },
          smem);
    }
  }
}

struct ExpMap { int tstart[65]; int rbase[65]; int ltile[9]; };
DEV void build_expmap(const Params& p, ExpMap* em) {
  __syncthreads();
  if (TIDX == 0) {
    const int* CNT = (const int*)(p.ws + OFF_CNT);
    int ts = 0, rb = 0;
    for (int e = 0; e < 64; ++e) {
      em->tstart[e] = ts; em->rbase[e] = rb;
      const int c = CNT[e * 32];
      ts += (c + GEMM_BM - 1) / GEMM_BM; rb += c;
    }
    em->tstart[64] = ts; em->rbase[64] = rb;
    const int x = BIDX & 7;
    int lt = 0;
    for (int k = 0; k < 8; ++k) { em->ltile[k] = lt; lt += em->tstart[x + 8 * k + 1] - em->tstart[x + 8 * k]; }
    em->ltile[8] = lt;
  }
  __syncthreads();
}
DEV void map_expert_tile(const ExpMap* em, int j, int CT, int& e, int& rt, int& ct) {
  const int jr = j / CT; ct = j % CT;
  int k = 0;
  for (int q = 1; q < 8; ++q) if (em->ltile[q] <= jr) k = q;
  e = (BIDX & 7) + 8 * k; rt = jr - em->ltile[k];
}
#define P7_SMEM (GEMM_SMEM_BYTES + 1024)
template <int LAYER>
DEV void phase_routed_up(const Params& p, char* smem) {
  ExpMap* em = (ExpMap*)(smem + GEMM_SMEM_BYTES);
  build_expmap(p, em);
  const int* CNT = (const int*)(p.ws + OFF_CNT);
  const int* LTOK = (const int*)(p.ws + OFF_LTOK);
  const unsigned short* X1B = (const unsigned short*)p.out;
  unsigned short* HR = (unsigned short*)(p.ws + OFF_HR);
  const int lb_ = BIDX >> 3, nb_ = gridDim.x >> 3;
  for (int j_ = lb_; j_ < em->ltile[8] * 4; j_ += nb_) {
    int e, rtl, ct;
    map_expert_tile(em, j_, 4, e, rtl, ct);
    const int r0 = rtl * GEMM_BM;
    const int cnt = CNT[e * 32], rbase = em->rbase[e];
    const float* W1 = p.in[I_MOE_W1] + ((size_t)LAYER * 64 + e) * 1024 * 256;
    const float* W3 = p.in[I_MOE_W3] + ((size_t)LAYER * 64 + e) * 1024 * 256;
    gemm_tile<true>(
        [&](int r) { return (r0 + r < cnt) ? (const void*)(X1B + (size_t)LTOK[(size_t)e * NTOK + r0 + r] * 1024) : (const void*)nullptr; },
        [&](int c) { return (((c >> 5) & 1) ? W3 : W1) + ct * 64 + (c >> 6) * 32 + (c & 31); }, 256, 1024,
        [&](int row, int col, float v0, float v1) {
          if (r0 + row < cnt) {
            const int lc = ct * 64 + (col >> 6) * 32 + (col & 31);
            HR[(size_t)(rbase + r0 + row) * 256 + lc] = f2bf(siluf_(v0) * v1);
          }
        },
        smem);
  }
}

template <int LAYER>
DEV void phase_down(const Params& p, char* smem) {
  ExpMap* em = (ExpMap*)(smem + GEMM_SMEM_BYTES);
  build_expmap(p, em);
  const int* CNT = (const int*)(p.ws + OFF_CNT);
  const float* LGATE = (const float*)(p.ws + OFF_LGATE);
  const unsigned short* HR = (const unsigned short*)(p.ws + OFF_HR);
  const unsigned short* HS = (const unsigned short*)(p.ws + OFF_HS);
  unsigned short* Y = (unsigned short*)(p.ws + OFF_Y);
  float* FS = (float*)(p.ws + OFF_FS);
  const int xcd_ = BIDX & 7, lb_ = BIDX >> 3, nb_ = gridDim.x >> 3;
  for (int j_ = lb_; j_ < em->ltile[8] * 8; j_ += nb_) {
    int e, rtl, ct;
    map_expert_tile(em, j_, 8, e, rtl, ct);
    const int r0 = rtl * GEMM_BM;
    const int cnt = CNT[e * 32], rbase = em->rbase[e];
    const float* W2 = p.in[I_MOE_W2] + ((size_t)LAYER * 64 + e) * 256 * 1024;
    const int n0 = ct * 128;
    gemm_tile<true>(
        [&](int r) { return (r0 + r < cnt) ? (const void*)(HR + (size_t)(rbase + r0 + r) * 256) : (const void*)nullptr; },
        [&](int c) { return W2 + n0 + c; }, 1024, 256,
        [&](int row, int col, float v0, float v1) {
          if (r0 + row < cnt) {
            const float gt = LGATE[(size_t)e * NTOK + r0 + row];
            const size_t o = (size_t)(rbase + r0 + row) * 1024 + n0 + col;
            Y[o] = f2bf(v0 * gt); Y[o + 32] = f2bf(v1 * gt);
          }
        },
        smem);
  }
  {
    const int MT = NTOK / GEMM_BM, NT = 8;
    const float* W2 = p.in[I_SH_W2] + (size_t)LAYER * 256 * 1024;
    for (int j_ = lb_; j_ < (MT / 8) * NT; j_ += nb_) {
      const int m0 = (xcd_ + 8 * (j_ / NT)) * GEMM_BM, n0 = (j_ % NT) * 128;
      gemm_tile<true>(
          [&](int r) { return (const void*)(HS + (size_t)(m0 + r) * 256); },
          [&](int c) { return W2 + n0 + c; }, 1024, 256,
          [&](int row, int col, float v0, float v1) {
            const size_t o = (size_t)(m0 + row) * 1024 + n0 + col;
            FS[o] = v0; FS[o + 32] = v1;
          },
          smem);
    }
  }
}

template <int LAYER>
DEV void phase_combine(const Params& p, char* smem) {
  ExpMap* em = (ExpMap*)smem;
  build_expmap(p, em);
  const int lane = TIDX & 63, wave = TIDX >> 6;
  const float* X1 = (const float*)(p.ws + OFF_X1);
  const float* FS = (const float*)(p.ws + OFF_FS);
  const unsigned short* Y = (const unsigned short*)(p.ws + OFF_Y);
  const int* TOPI = (const int*)(p.ws + OFF_TOPI);
  const int* PPOS = (const int*)(p.ws + OFF_S5E);
  float* OUT = LAYER == 0 ? (float*)(p.ws + OFF_X2) : p.out;
  for (int it = BIDX; it < NTOK / 4; it += gridDim.x) {
    const size_t tok = (size_t)it * 4 + wave;
    float v[16];
#pragma unroll
    for (int i = 0; i < 4; ++i) {
      const float4 a = ld4(X1 + tok * 1024 + lane * 4 + 256 * i), f = ld4(FS + tok * 1024 + lane * 4 + 256 * i);
      v[i * 4] = ALPHA_F * a.x + f.x; v[i * 4 + 1] = ALPHA_F * a.y + f.y; v[i * 4 + 2] = ALPHA_F * a.z + f.z; v[i * 4 + 3] = ALPHA_F * a.w + f.w;
    }
    size_t rows[8];
#pragma unroll
    for (int s = 0; s < 8; ++s) { const int e_ = TOPI[tok * 8 + s]; rows[s] = (size_t)em->rbase[e_] + PPOS[(size_t)e_ * NTOK + tok]; }
#pragma unroll
    for (int s0 = 0; s0 < 8; s0 += 4) {
      uint2 yy[4][4];
#pragma unroll
      for (int s = 0; s < 4; ++s)
#pragma unroll
        for (int i = 0; i < 4; ++i) yy[s][i] = *(const uint2*)(Y + rows[s0 + s] * 1024 + lane * 4 + 256 * i);
#pragma unroll
      for (int s = 0; s < 4; ++s)
#pragma unroll
        for (int i = 0; i < 4; ++i) {
          const uint2 y = yy[s][i];
          v[i * 4] += bf2f((unsigned short)(y.x & 0xFFFF)); v[i * 4 + 1] += bf2f((unsigned short)(y.x >> 16));
          v[i * 4 + 2] += bf2f((unsigned short)(y.y & 0xFFFF)); v[i * 4 + 3] += bf2f((unsigned short)(y.y >> 16));
        }
    }
    wave_ln(v, p.in[I_LN2_G] + LAYER * 1024, p.in[I_LN2_B] + LAYER * 1024, lane);
#pragma unroll
    for (int i = 0; i < 4; ++i) st4(OUT + tok * 1024 + lane * 4 + 256 * i, make_float4(v[i * 4], v[i * 4 + 1], v[i * 4 + 2], v[i * 4 + 3]));
    if (LAYER == 0) {
      unsigned short* X2B = (unsigned short*)(p.ws + OFF_X2B);
#pragma unroll
      for (int i = 0; i < 4; ++i) *(uint2*)(X2B + tok * 1024 + lane * 4 + 256 * i) = make_uint2(pk2(v[i * 4], v[i * 4 + 1]), pk2(v[i * 4 + 2], v[i * 4 + 3]));
    }
  }
}

DEV float shifted(const float* Hc, size_t tok, int col, const float* mu) {
  const float cur = Hc[tok * 1792 + col];
  const float prev = (tok % SEQ_LEN) == 0 ? 0.f : Hc[(tok - 1) * 1792 + col];
  return cur + (prev - cur) * mu[col];
}

#define RWP_T 32
#define P11_PREP_ITEMS (NTOK / RWP_T)
#define P11_KV_ITEMS (BATCH * 4 * RET_NC)
#define P11_SMEM (RWP_T * 128 * 4)
DEV void split_bf8(const float (&x)[8], bf16x8& hi, bf16x8& lo) {
  const unsigned h0 = pk2(x[0], x[1]), h1 = pk2(x[2], x[3]), h2 = pk2(x[4], x[5]), h3 = pk2(x[6], x[7]);
  union { uint4 u; bf16x8 v; } a, b;
  a.u = make_uint4(h0, h1, h2, h3);
  b.u = make_uint4(pk2(x[0] - bf2f((unsigned short)(h0 & 0xFFFF)), x[1] - bf2f((unsigned short)(h0 >> 16))),
                   pk2(x[2] - bf2f((unsigned short)(h1 & 0xFFFF)), x[3] - bf2f((unsigned short)(h1 >> 16))),
                   pk2(x[4] - bf2f((unsigned short)(h2 & 0xFFFF)), x[5] - bf2f((unsigned short)(h2 >> 16))),
                   pk2(x[6] - bf2f((unsigned short)(h3 & 0xFFFF)), x[7] - bf2f((unsigned short)(h3 >> 16))));
  hi = a.v; lo = b.v;
}
DEV float half_sum32(float v) {
#ifdef CPU_EMU
#pragma unroll
  for (int m = 16; m >= 1; m >>= 1) v += __shfl_xor(v, m);
  return v;
#else
  int x;
  x = __builtin_amdgcn_update_dpp(0, __builtin_bit_cast(int, v), 0xB1, 0xF, 0xF, false); v += __builtin_bit_cast(float, x);
  x = __builtin_amdgcn_update_dpp(0, __builtin_bit_cast(int, v), 0x4E, 0xF, 0xF, false); v += __builtin_bit_cast(float, x);
  x = __builtin_amdgcn_update_dpp(0, __builtin_bit_cast(int, v), 0x141, 0xF, 0xF, false); v += __builtin_bit_cast(float, x);
  x = __builtin_amdgcn_update_dpp(0, __builtin_bit_cast(int, v), 0x140, 0xF, 0xF, false); v += __builtin_bit_cast(float, x);
  return v + __shfl_xor(v, 16);
#endif
}
DEV void p11_prep(const Params& p, int item, char* smem) {
  const int tid = TIDX, lane = tid & 63, wave = tid >> 6;
  const float* Hc = (const float*)(p.ws + OFF_H);
  const float* mu = p.in[I_RW_MU];
  float* sl = (float*)smem;
  static_assert(RWP_T == 32, "one 32-row MFMA tile of tokens per item");
  __syncthreads();
  for (int w = tid; w < RWP_T * 128; w += NTHREADS) {
    const int tt = w >> 7, j = w & 127;
    const size_t tok = (size_t)item * RWP_T + tt;
    const float v = shifted(Hc, tok, 1536 + j, mu);
    sl[w] = j < 64 ? tanhf(v) : v;
    ((float*)(p.ws + OFF_GLO))[tok * 128 + j] = sigmoidf_(shifted(Hc, tok, 1664 + j, mu));
  }
  __syncthreads();
  float* RWW = (float*)(p.ws + OFF_RWW); float* RWK = (float*)(p.ws + OFF_RWK);
  float* RWKK = (float*)(p.ws + OFF_RWKK); float* RWA = (float*)(p.ws + OFF_RWA);
  float* RWR = p.out + (size_t)NTOK * 512; float* RWV = p.out;
  const float* w_up = p.in[I_RW_W_UP]; const float* a_up = p.in[I_RW_A_UP];
  const int n = lane & 31, hh = lane >> 5;
#pragma unroll 1
  for (int cc = 0; cc < 2; ++cc) {
    const int hd = wave + 4 * cc;
    f32x16 accW[2], accA[2];
#pragma unroll
    for (int nt = 0; nt < 2; ++nt)
#pragma unroll
      for (int i = 0; i < 16; ++i) { accW[nt][i] = 0.f; accA[nt][i] = 0.f; }
#pragma unroll
    for (int ks = 0; ks < 4; ++ks) {
      bf16x8 awh, awl, aah, aal;
      {
        const float* xr = sl + n * 128 + 16 * ks + 8 * hh;
        const float4 x0 = ld4(xr), x1 = ld4(xr + 4), y0 = ld4(xr + 64), y1 = ld4(xr + 68);
        const float xw[8] = {x0.x, x0.y, x0.z, x0.w, x1.x, x1.y, x1.z, x1.w};
        const float xa[8] = {y0.x, y0.y, y0.z, y0.w, y1.x, y1.y, y1.z, y1.w};
        split_bf8(xw, awh, awl);
        split_bf8(xa, aah, aal);
      }
#pragma unroll
      for (int nt = 0; nt < 2; ++nt) {
        const size_t bo = (size_t)(16 * ks + 8 * hh) * 512 + 64 * hd + 32 * nt + n;
        float bw[8], ba[8];
#pragma unroll
        for (int j = 0; j < 8; ++j) { bw[j] = w_up[bo + (size_t)j * 512]; ba[j] = a_up[bo + (size_t)j * 512]; }
        bf16x8 bwh, bwl, bah, bal;
        split_bf8(bw, bwh, bwl);
        split_bf8(ba, bah, bal);
        accW[nt] = __builtin_amdgcn_mfma_f32_32x32x16_bf16(awh, bwh, accW[nt], 0, 0, 0);
        accW[nt] = __builtin_amdgcn_mfma_f32_32x32x16_bf16(awh, bwl, accW[nt], 0, 0, 0);
        accW[nt] = __builtin_amdgcn_mfma_f32_32x32x16_bf16(awl, bwh, accW[nt], 0, 0, 0);
        accA[nt] = __builtin_amdgcn_mfma_f32_32x32x16_bf16(aah, bah, accA[nt], 0, 0, 0);
        accA[nt] = __builtin_amdgcn_mfma_f32_32x32x16_bf16(aah, bal, accA[nt], 0, 0, 0);
        accA[nt] = __builtin_amdgcn_mfma_f32_32x32x16_bf16(aal, bah, accA[nt], 0, 0, 0);
      }
    }
    const int c0 = 64 * hd + n, c1 = c0 + 32;
    const float w0_0 = p.in[I_RW_W0][c0], a0_0 = p.in[I_RW_A0][c0], kkc_0 = p.in[I_RW_K_K][c0], kac_0 = p.in[I_RW_K_A][c0];
    const float w0_1 = p.in[I_RW_W0][c1], a0_1 = p.in[I_RW_A0][c1], kkc_1 = p.in[I_RW_K_K][c1], kac_1 = p.in[I_RW_K_A][c1];
#pragma unroll
    for (int r16 = 0; r16 < 16; ++r16) {
      const int tt = (r16 & 3) + 8 * (r16 >> 2) + 4 * hh;
      const size_t tok = (size_t)item * RWP_T + tt;
      float kkv[2], av[2], ksv[2];
#pragma unroll
      for (int nt = 0; nt < 2; ++nt) {
        const int c = nt ? c1 : c0;
        const float lw = (nt ? w0_1 : w0_0) + accW[nt][r16];
        const float nl = -lw;
        const float sp = nl > 20.f ? nl : log1pf(expf(nl));
        const float wl = -sp - 0.5f;
        const float decay = expf(-expf(wl));
        av[nt] = 1.f / (1.f + expf(-((nt ? a0_1 : a0_0) + accA[nt][r16])));
        const float rs = shifted(Hc, tok, c, mu);
        ksv[nt] = shifted(Hc, tok, 512 + c, mu);
        const float vs = shifted(Hc, tok, 1024 + c, mu);
        kkv[nt] = ksv[nt] * (nt ? kkc_1 : kkc_0);
        RWW[tok * 512 + c] = decay;
        RWR[tok * 512 + c] = rs;
        RWV[tok * 512 + c] = vs;
      }
      const float nrm = sqrtf(half_sum32(kkv[0] * kkv[0] + kkv[1] * kkv[1]));
      const float inv = 1.f / fmaxf(nrm, 1e-12f);
#pragma unroll
      for (int nt = 0; nt < 2; ++nt) {
        const int c = nt ? c1 : c0;
        const float kk = kkv[nt] * inv;
        RWK[tok * 512 + c] = ksv[nt] * (1.f + (av[nt] - 1.f) * (nt ? kac_1 : kac_0));
        RWKK[tok * 512 + c] = kk;
        RWA[tok * 512 + c] = kk * av[nt];
      }
    }
  }
}
DEV float ret_log2gamma(int h) { return log2f(1.f - exp2f(-5.f - (float)h)); }
struct KvSmem { unsigned short vt[128][72]; unsigned short kt[64][72]; };
#define P11_KV_SMEM ((int)sizeof(KvSmem))
DEV void p11_kv(const Params& p, int item, char* smem) {
  KvSmem* sm = (KvSmem*)smem;
  const int c = item % RET_NC, h = (item / RET_NC) & 3, b = item / (RET_NC * 4);
  const int tid = TIDX, lane = tid & 63, wave = tid >> 6;
  const int r = lane & 31, hh = lane >> 5;
  const float* H2 = (const float*)(p.ws + OFF_H2);
  const float lg = ret_log2gamma(h);
  const size_t tok0 = (size_t)b * SEQ_LEN + c * 128;
  f32x16 acc[2];
#pragma unroll
  for (int nt = 0; nt < 2; ++nt)
#pragma unroll
    for (int i = 0; i < 16; ++i) acc[nt][i] = 0.f;
#pragma unroll 1
  for (int kt = 0; kt < 2; ++kt) {
    __syncthreads();
#pragma unroll
    for (int q = 0; q < 8; ++q) {
      const int f = tid + 256 * q;
      const int key = f >> 5, d4 = (f & 31) * 4;
      const float dec = exp2f((float)(127 - (kt * 64 + key)) * lg);
      const float4 v = ld4(H2 + (tok0 + kt * 64 + key) * 1536 + 512 + h * 128 + d4);
      sm->vt[d4][key] = f2bf(v.x * dec); sm->vt[d4 + 1][key] = f2bf(v.y * dec);
      sm->vt[d4 + 2][key] = f2bf(v.z * dec); sm->vt[d4 + 3][key] = f2bf(v.w * dec);
    }
#pragma unroll
    for (int q = 0; q < 4; ++q) {
      const int f = tid + 256 * q;
      const int key = f >> 4, d4 = (f & 15) * 4;
      const float4 v = ld4(H2 + (tok0 + kt * 64 + key) * 1536 + 256 + h * 64 + d4);
      sm->kt[d4][key] = f2bf(v.x); sm->kt[d4 + 1][key] = f2bf(v.y); sm->kt[d4 + 2][key] = f2bf(v.z); sm->kt[d4 + 3][key] = f2bf(v.w);
    }
    __syncthreads();
#pragma unroll
    for (int ks = 0; ks < 4; ++ks) {
      const bf16x8 a = *(const bf16x8*)&sm->vt[wave * 32 + r][ks * 16 + hh * 8];
#pragma unroll
      for (int nt = 0; nt < 2; ++nt) {
        const bf16x8 bb = *(const bf16x8*)&sm->kt[nt * 32 + r][ks * 16 + hh * 8];
        acc[nt] = __builtin_amdgcn_mfma_f32_32x32x16_bf16(a, bb, acc[nt], 0, 0, 0);
      }
    }
  }
  float* KV = (float*)(p.ws + OFF_RETKV) + (size_t)item * 64 * 128;
#pragma unroll
  for (int nt = 0; nt < 2; ++nt)
#pragma unroll
    for (int g4 = 0; g4 < 4; ++g4)
      st4(KV + (nt * 32 + r) * 128 + wave * 32 + 8 * g4 + 4 * hh,
          make_float4(acc[nt][4 * g4], acc[nt][4 * g4 + 1], acc[nt][4 * g4 + 2], acc[nt][4 * g4 + 3]));
}
DEV void phase_p11(const Params& p, char* smem) {
  {
    unsigned* RKF = (unsigned*)(p.ws + OFF_RKF);
    for (int i = BIDX * NTHREADS + TIDX; i < BATCH * 8 * (SEQ_LEN / 32); i += gridDim.x * NTHREADS) RKF[i] = 0u;
  }
  const int total = P11_PREP_ITEMS + P11_KV_ITEMS;
  for (int it = BIDX; it < total; it += gridDim.x) {
    if (it < P11_KV_ITEMS) p11_kv(p, it, smem);
    else p11_prep(p, it - P11_KV_ITEMS, smem);
  }
}

#define RK_T 32
#define RK_NCH (SEQ_LEN / RK_T)
#define RK_NCHT (BATCH * 8 * RK_NCH)
#define OFF_RKPT OFF_H
#define OFF_RKKT (OFF_RKPT + (size_t)RK_NCHT * 64 * 64 * 2)
#define OFF_RKVT (OFF_RKKT + (size_t)RK_NCHT * 64 * 32 * 2)
#define OFF_RKRT (OFF_RKVT + (size_t)RK_NCHT * 64 * 32 * 2)
#define OFF_RKAT (OFF_RKRT + (size_t)RK_NCHT * 32 * 64 * 2)
#define OFF_RKEND (OFF_RKAT + (size_t)RK_NCHT * 32 * 32 * 2)
static_assert(OFF_RKEND <= OFF_H2, "rk buffers must fit in the H1 region");
#define RKPRE_SMEM ((4 * 32 * 64 + 32 * 64) * 4)

DEV unsigned short* rksc_row(char* ws, int b, int h, int c, int i) {
  return (unsigned short*)(ws + OFF_RWW) + (((size_t)b * SEQ_LEN + (size_t)c * RK_T + (i >> 1)) * 512 + h * 64) * 2 + (i & 1) * 64;
}
#if RK_MERGED
DEV void st_wt_u16(unsigned short* q, unsigned short v) { asm volatile("global_store_short %0, %1, off sc1" :: "v"(q), "v"((unsigned)v) : "memory"); }
typedef unsigned u32x4_t __attribute__((ext_vector_type(4)));
DEV void st_wt_b128(void* q, uint4 v) { const u32x4_t w = {v.x, v.y, v.z, v.w}; asm volatile("global_store_dwordx4 %0, %1, off sc1" :: "v"(q), "v"(w) : "memory"); }
#else
DEV void st_wt_u16(unsigned short* q, unsigned short v) { *q = v; }
DEV void st_wt_b128(void* q, uint4 v) { *(uint4*)q = v; }
#endif
DEV void rk_precompute(const Params& p, int ch, char* smem) {
  const int c = ch % RK_NCH, bh = ch / RK_NCH, h = bh & 7, b = bh >> 3;
  const int tid = TIDX, lane = tid & 63, wave = tid >> 6;
  const size_t tok0 = (size_t)b * SEQ_LEN + (size_t)c * RK_T;
  const float* RWW = (const float*)(p.ws + OFF_RWW); const float* RWK = (const float*)(p.ws + OFF_RWK);
  const float* RWKK = (const float*)(p.ws + OFF_RWKK); const float* RWA = (const float*)(p.ws + OFF_RWA);
  const float* RWR = p.out + (size_t)NTOK * 512; const float* RWV = p.out;
  float* sW = (float*)smem;
  float* sNK = sW + 32 * 64;
  float* sKA = sNK + 32 * 64;
  float* sR = sKA + 32 * 64;
  float* sV = sR + 32 * 64;
  __syncthreads();
  for (int w = tid; w < 32 * 16; w += NTHREADS) {
    const int t = w >> 4, c4 = (w & 15) * 4;
    const size_t o = (tok0 + t) * 512 + h * 64 + c4;
    st4(sW + t * 64 + c4, ld4(RWW + o));
    const float4 kk = ld4(RWKK + o);
    st4(sNK + t * 64 + c4, make_float4(-kk.x, -kk.y, -kk.z, -kk.w));
    st4(sKA + t * 64 + c4, ld4(RWA + o));
    st4(sR + t * 64 + c4, ld4(RWR + o));
    st4(sV + t * 64 + c4, ld4(RWV + o));
  }
  __syncthreads();
  const int wrole = (wave + ((BIDX >= (gridDim.x >> 1)) ? 2 : 0)) & 3;
  if (wrole == 0) {
    float z[64];
#pragma unroll
    for (int j = 0; j < 64; ++j) z[j] = (j == lane) ? 1.f : 0.f;
    for (int t = 0; t < RK_T; ++t) {
      float cacc = 0.f;
#pragma unroll
      for (int j4 = 0; j4 < 16; ++j4) {
        const float4 u = ld4(sNK + t * 64 + j4 * 4);
        cacc += z[j4 * 4] * u.x + z[j4 * 4 + 1] * u.y + z[j4 * 4 + 2] * u.z + z[j4 * 4 + 3] * u.w;
      }
#pragma unroll
      for (int j4 = 0; j4 < 16; ++j4) {
        const float4 w = ld4(sW + t * 64 + j4 * 4), v = ld4(sKA + t * 64 + j4 * 4);
        z[j4 * 4] = z[j4 * 4] * w.x + cacc * v.x; z[j4 * 4 + 1] = z[j4 * 4 + 1] * w.y + cacc * v.y;
        z[j4 * 4 + 2] = z[j4 * 4 + 2] * w.z + cacc * v.z; z[j4 * 4 + 3] = z[j4 * 4 + 3] * w.w + cacc * v.w;
      }
    }
    unsigned short* PT = (unsigned short*)(p.ws + OFF_RKPT) + (size_t)ch * 64 * 64;
#pragma unroll
    for (int j = 0; j < 64; ++j) st_wt_u16(PT + j * 64 + lane, f2bf(z[j]));
  } else if (wrole == 1) {
    const bool isA = lane < 32;
    const int me = lane & 31;
    float q[64];
    {
      const float* src = (isA ? RWK : RWR) + (tok0 + me) * 512 + h * 64;
#pragma unroll
      for (int j4 = 0; j4 < 16; ++j4) { const float4 v = ld4(src + j4 * 4); q[j4 * 4] = v.x; q[j4 * 4 + 1] = v.y; q[j4 * 4 + 2] = v.z; q[j4 * 4 + 3] = v.w; }
    }
    const float* Ub = isA ? sNK : sKA;
    const float* Vb = isA ? sKA : sNK;
    unsigned short* AT = (unsigned short*)(p.ws + OFF_RKAT) + (size_t)ch * 32 * 32;
    for (int u = 0; u < RK_T; ++u) {
      const int tt = isA ? u : RK_T - 1 - u;
      const bool upd = isA ? (u > me) : (tt <= me);
      if (upd) {
        float cacc = 0.f;
#pragma unroll
        for (int j4 = 0; j4 < 16; ++j4) {
          const float4 uu = ld4(Ub + tt * 64 + j4 * 4);
          cacc += q[j4 * 4] * uu.x + q[j4 * 4 + 1] * uu.y + q[j4 * 4 + 2] * uu.z + q[j4 * 4 + 3] * uu.w;
        }
#pragma unroll
        for (int j4 = 0; j4 < 16; ++j4) {
          const float4 w = ld4(sW + tt * 64 + j4 * 4), v = ld4(Vb + tt * 64 + j4 * 4);
          q[j4 * 4] = q[j4 * 4] * w.x + cacc * v.x; q[j4 * 4 + 1] = q[j4 * 4 + 1] * w.y + cacc * v.y;
          q[j4 * 4 + 2] = q[j4 * 4 + 2] * w.z + cacc * v.z; q[j4 * 4 + 3] = q[j4 * 4 + 3] * w.w + cacc * v.w;
        }
      }
      if (isA) {
        float av = 0.f;
        if (u >= me) {
#pragma unroll
          for (int j4 = 0; j4 < 16; ++j4) {
            const float4 rr = ld4(sR + u * 64 + j4 * 4);
            av += q[j4 * 4] * rr.x + q[j4 * 4 + 1] * rr.y + q[j4 * 4 + 2] * rr.z + q[j4 * 4 + 3] * rr.w;
          }
        }
        AT[u * 32 + me] = f2bf(av);
      }
    }
    if (isA) {
      unsigned short* KT = (unsigned short*)(p.ws + OFF_RKKT) + (size_t)ch * 64 * 32;
#pragma unroll
      for (int j = 0; j < 64; ++j) st_wt_u16(KT + j * 32 + me, f2bf(q[j]));
    } else {
      unsigned short* RT = (unsigned short*)(p.ws + OFF_RKRT) + ((size_t)ch * 32 + me) * 64;
#pragma unroll
      for (int j8 = 0; j8 < 8; ++j8)
        *(uint4*)(RT + j8 * 8) = make_uint4(pk2(q[j8 * 8], q[j8 * 8 + 1]), pk2(q[j8 * 8 + 2], q[j8 * 8 + 3]), pk2(q[j8 * 8 + 4], q[j8 * 8 + 5]), pk2(q[j8 * 8 + 6], q[j8 * 8 + 7]));
    }
  } else if (wrole == 2) {
    unsigned short* VT = (unsigned short*)(p.ws + OFF_RKVT) + (size_t)ch * 64 * 32;
#pragma unroll
    for (int t8 = 0; t8 < 4; ++t8) {
      float v[8];
#pragma unroll
      for (int q8 = 0; q8 < 8; ++q8) v[q8] = sV[(t8 * 8 + q8) * 64 + lane];
      st_wt_b128(VT + lane * 32 + t8 * 8, make_uint4(pk2(v[0], v[1]), pk2(v[2], v[3]), pk2(v[4], v[5]), pk2(v[6], v[7])));
    }
  }
#if RK_MERGED
  asm volatile("s_waitcnt vmcnt(0)" ::: "memory");
  __syncthreads();
  if (tid == 0) __hip_atomic_store((unsigned*)(p.ws + OFF_RKF) + ch, 1u, __ATOMIC_RELAXED, __HIP_MEMORY_SCOPE_AGENT);
#endif
}
DEV void phase_retpfx(const Params& p, char* smem);
DEV void phase_rkpre(const Params& p, char* smem) {
  phase_retpfx(p, smem);
  for (int it = BIDX; it < RK_NCHT; it += gridDim.x) rk_precompute(p, (it % (BATCH * 8)) * RK_NCH + it / (BATCH * 8), smem);
}

DEV bf16x8 ld_frag2(const unsigned short* p0, const unsigned short* p1) {
  const uint2 lo = *(const uint2*)p0, hi = *(const uint2*)p1;
  union { uint4 u; bf16x8 v; } x;
  x.u = make_uint4(lo.x, lo.y, hi.x, hi.y);
  return x.v;
}
DEV bf16x8 ld_frag(const unsigned short* p0) {
  union { uint4 u; bf16x8 v; } x;
  x.u = *(const uint4*)p0;
  return x.v;
}
DEV unsigned rk_flag_ld(const unsigned* f) {
#if RK_MERGED
  return __hip_atomic_load(f, __ATOMIC_RELAXED, __HIP_MEMORY_SCOPE_AGENT);
#else
  return 1u;
#endif
}
DEV void rk_flag_wait(const unsigned* f, unsigned flv) {
#if RK_MERGED
  asm volatile("" : "+v"(flv));
  unsigned fl = (unsigned)__builtin_amdgcn_readfirstlane((int)flv);
  unsigned sp = 0;
  while (fl == 0u) {
    __builtin_amdgcn_s_sleep(1);
    fl = (unsigned)__builtin_amdgcn_readfirstlane((int)__hip_atomic_load(f, __ATOMIC_RELAXED, __HIP_MEMORY_SCOPE_AGENT));
    if (++sp > (1u << 21)) break;
  }
  asm volatile("buffer_inv sc1" ::: "memory");
#endif
}
#define RK_PREFETCH(S, c_)                                                                                                      \
  {                                                                                                                             \
    const size_t chp_ = (size_t)bh * RK_NCH + (c_);                                                                             \
    _Pragma("unroll") for (int jt = 0; jt < 2; ++jt) _Pragma("unroll") for (int kb = 0; kb < 2; ++kb)                          \
        _Pragma("unroll") for (int s_ = 0; s_ < 2; ++s_) {                                                                      \
      const unsigned short* q0 = PTb + (chp_ * 64 + jt * 32 + r) * 64 + kb * 32 + 16 * s_ + 4 * hh;                             \
      pa##S[jt][kb][s_] = ld_frag2(q0, q0 + 8);                                                                                 \
    }                                                                                                                           \
    _Pragma("unroll") for (int jt = 0; jt < 2; ++jt) _Pragma("unroll") for (int ks = 0; ks < 2; ++ks)                          \
        ka##S[jt][ks] = ld_frag(KTb + (chp_ * 64 + jt * 32 + r) * 32 + 16 * ks + 8 * hh);                                       \
    _Pragma("unroll") for (int ks = 0; ks < 2; ++ks) vb##S[ks] = ld_frag(VTb + (chp_ * 64 + it * 32 + r) * 32 + 16 * ks + 8 * hh); \
  }
#define RK_STEP(S, c_)                                                                                                          \
  {                                                                                                                             \
    unsigned short* scr_ = rksc_row(p.ws, bh >> 3, bh & 7, (c_), it * 32 + r);                                                  \
    _Pragma("unroll") for (int kb = 0; kb < 2; ++kb) _Pragma("unroll") for (int g4 = 0; g4 < 4; ++g4)                          \
        *(uint2*)(scr_ + kb * 32 + 8 * g4 + 4 * hh) =                                                                           \
            make_uint2(pk2(X[kb][4 * g4], X[kb][4 * g4 + 1]), pk2(X[kb][4 * g4 + 2], X[kb][4 * g4 + 3]));                       \
    bf16x8 bh_[2][2], bl_[2][2];                                                                                                \
    _Pragma("unroll") for (int kb = 0; kb < 2; ++kb) _Pragma("unroll") for (int s_ = 0; s_ < 2; ++s_) {                        \
      union { uint4 u; bf16x8 v; } hi, lo;                                                                                      \
      unsigned hw[4], lw[4];                                                                                                    \
      _Pragma("unroll") for (int q2 = 0; q2 < 4; ++q2) {                                                                        \
        const float x0 = X[kb][8 * s_ + 2 * q2], x1 = X[kb][8 * s_ + 2 * q2 + 1];                                               \
        const unsigned hp = pk2(x0, x1);                                                                                        \
        hw[q2] = hp;                                                                                                            \
        lw[q2] = pk2(x0 - bf2f((unsigned short)(hp & 0xFFFF)), x1 - bf2f((unsigned short)(hp >> 16)));                          \
      }                                                                                                                         \
      hi.u = make_uint4(hw[0], hw[1], hw[2], hw[3]); lo.u = make_uint4(lw[0], lw[1], lw[2], lw[3]);                             \
      bh_[kb][s_] = hi.v; bl_[kb][s_] = lo.v;                                                                                   \
    }                                                                                                                           \
    f32x16 acc[2];                                                                                                              \
    _Pragma("unroll") for (int jt = 0; jt < 2; ++jt) {                                                                          \
      _Pragma("unroll") for (int i = 0; i < 16; ++i) acc[jt][i] = 0.f;                                                          \
      _Pragma("unroll") for (int kb = 0; kb < 2; ++kb) _Pragma("unroll") for (int s_ = 0; s_ < 2; ++s_) {                      \
        acc[jt] = __builtin_amdgcn_mfma_f32_32x32x16_bf16(pa##S[jt][kb][s_], bh_[kb][s_], acc[jt], 0, 0, 0);                    \
        acc[jt] = __builtin_amdgcn_mfma_f32_32x32x16_bf16(pa##S[jt][kb][s_], bl_[kb][s_], acc[jt], 0, 0, 0);                    \
      }                                                                                                                         \
      _Pragma("unroll") for (int ks = 0; ks < 2; ++ks)                                                                          \
          acc[jt] = __builtin_amdgcn_mfma_f32_32x32x16_bf16(ka##S[jt][ks], vb##S[ks], acc[jt], 0, 0, 0);                        \
    }                                                                                                                           \
    if ((c_) + 2 < RK_NCH) {                                                                                                    \
      rk_flag_wait(RKFb + (c_) + 2, fl##S);                                                                                     \
      fl##S = rk_flag_ld(RKFb + ((c_) + 4 < RK_NCH ? (c_) + 4 : RK_NCH - 1));          \
      RK_PREFETCH(S, (c_) + 2);                                                                                                 \
    }                                                                                                                           \
    X[0] = acc[0]; X[1] = acc[1];                                                                                               \
  }
DEV void rk_chain(const Params& p, int bh) {
  const int tid = TIDX, lane = tid & 63, wave = tid >> 6;
  if (wave >= 2) return;
  const int r = lane & 31, hh = lane >> 5, it = wave;
  const unsigned short* PTb = (const unsigned short*)(p.ws + OFF_RKPT);
  const unsigned short* KTb = (const unsigned short*)(p.ws + OFF_RKKT);
  const unsigned short* VTb = (const unsigned short*)(p.ws + OFF_RKVT);
  const unsigned* RKFb = (const unsigned*)(p.ws + OFF_RKF) + (size_t)bh * RK_NCH;
  f32x16 X[2];
#pragma unroll
  for (int kb = 0; kb < 2; ++kb)
#pragma unroll
    for (int i = 0; i < 16; ++i) X[kb][i] = 0.f;
  bf16x8 paA[2][2][2], kaA[2][2], vbA[2], paB[2][2][2], kaB[2][2], vbB[2];
  rk_flag_wait(RKFb, rk_flag_ld(RKFb));
  RK_PREFETCH(A, 0);
  rk_flag_wait(RKFb + 1, rk_flag_ld(RKFb + 1));
  RK_PREFETCH(B, 1);
  unsigned flA = rk_flag_ld(RKFb + 2), flB = rk_flag_ld(RKFb + 3);
  for (int c = 0; c < RK_NCH; c += 2) {
    RK_STEP(A, c);
    if (c + 1 < RK_NCH) RK_STEP(B, c + 1);
  }
}
DEV void rk_output(const Params& p, int item) {
  const int tid = TIDX, lane = tid & 63, wave = tid >> 6;
  const int ch = item * 4 + wave;
  const int c = ch % RK_NCH, bhh = ch / RK_NCH, h = bhh & 7, b = bhh >> 3;
  const int r = lane & 31, hh = lane >> 5;
  const unsigned short* RT = (const unsigned short*)(p.ws + OFF_RKRT) + (size_t)ch * 32 * 64;
  const unsigned short* AT = (const unsigned short*)(p.ws + OFF_RKAT) + (size_t)ch * 32 * 32;
  const unsigned short* VT = (const unsigned short*)(p.ws + OFF_RKVT) + (size_t)ch * 64 * 32;
  f32x16 acc[2];
#pragma unroll
  for (int i2 = 0; i2 < 2; ++i2)
#pragma unroll
    for (int i = 0; i < 16; ++i) acc[i2][i] = 0.f;
#pragma unroll
  for (int ks = 0; ks < 4; ++ks) {
    const bf16x8 a = ld_frag(RT + r * 64 + 16 * ks + 8 * hh);
#pragma unroll
    for (int i2 = 0; i2 < 2; ++i2) acc[i2] = __builtin_amdgcn_mfma_f32_32x32x16_bf16(a, ld_frag(rksc_row(p.ws, b, h, c, i2 * 32 + r) + 16 * ks + 8 * hh), acc[i2], 0, 0, 0);
  }
#pragma unroll
  for (int ks = 0; ks < 2; ++ks) {
    const bf16x8 a = ld_frag(AT + r * 32 + 16 * ks + 8 * hh);
#pragma unroll
    for (int i2 = 0; i2 < 2; ++i2) acc[i2] = __builtin_amdgcn_mfma_f32_32x32x16_bf16(a, ld_frag(VT + (i2 * 32 + r) * 32 + 16 * ks + 8 * hh), acc[i2], 0, 0, 0);
  }
  float* Yo = (float*)(p.ws + OFF_MIX);
  const size_t tok0 = (size_t)b * SEQ_LEN + (size_t)c * RK_T;
#pragma unroll
  for (int i2 = 0; i2 < 2; ++i2)
#pragma unroll
    for (int i = 0; i < 16; ++i) {
      const int t = (i & 3) + 8 * (i >> 2) + 4 * hh;
      Yo[(tok0 + t) * 1024 + h * 64 + i2 * 32 + r] = acc[i2][i];
    }
}
#define OFF_RWG OFF_RWKK
DEV void phase_rkout(const Params& p, char* smem) {
  {
    const float* GLO = (const float*)(p.ws + OFF_GLO);
    const float* g_up = p.in[I_RW_G_UP];
    float* G = (float*)(p.ws + OFF_RWG);
    for (int t = BIDX; t < (NTOK / GEMM_BM) * 4; t += gridDim.x) {
      const int m0 = (t >> 2) * GEMM_BM, n0 = (t & 3) * 128;
      gemm_tile<false>(
          [&](int r) { return (const void*)(GLO + (size_t)(m0 + r) * 128); },
          [&](int c) { return g_up + n0 + c; }, 512, 128,
          [&](int row, int col, float v0, float v1) {
            const size_t o = (size_t)(m0 + row) * 512 + n0 + col;
            G[o] = v0; G[o + 32] = v1;
          },
          smem);
    }
  }
  for (int it = BIDX; it < RK_NCHT / 4; it += gridDim.x) rk_output(p, it);
}

#define P12_SCAN_ITEMS (BATCH * 8 * 4)
#define P12_RET_ITEMS (BATCH * 4 * RET_NC)
#define P12_SCAN_SMEM ((2 * (16 * 5 * 64 + 16 * 16) + 16 * 16) * 4)
#define P12_RET_SMEM ((64 * 72 + 2 * 64 * 68) * 2)
#define P12_SMEM (P12_SCAN_SMEM > P12_RET_SMEM ? P12_SCAN_SMEM : P12_RET_SMEM)
DEV float sum16(float v) {
#ifdef CPU_EMU
  return emu_sum16(v);
#else
  int x;
  x = __builtin_amdgcn_update_dpp(0, __builtin_bit_cast(int, v), 0xB1, 0xF, 0xF, false); v += __builtin_bit_cast(float, x);
  x = __builtin_amdgcn_update_dpp(0, __builtin_bit_cast(int, v), 0x4E, 0xF, 0xF, false); v += __builtin_bit_cast(float, x);
  x = __builtin_amdgcn_update_dpp(0, __builtin_bit_cast(int, v), 0x141, 0xF, 0xF, false); v += __builtin_bit_cast(float, x);
  x = __builtin_amdgcn_update_dpp(0, __builtin_bit_cast(int, v), 0x140, 0xF, 0xF, false); v += __builtin_bit_cast(float, x);
  return v;
#endif
}
DEV void p12_scan(const Params& p, int item, char* smem) {
  const int rq = item & 3, h = (item >> 2) & 7, b = item >> 5;
  const int tid = TIDX, rl = tid >> 4, cg = tid & 15;
  const float* ARR[5] = {(const float*)(p.ws + OFF_RWW), (const float*)(p.ws + OFF_RWK), (const float*)(p.ws + OFF_RWKK),
                         (const float*)(p.ws + OFF_RWA), p.out + (size_t)NTOK * 512};
  const float* RWV = p.out;
  float* Yo = (float*)(p.ws + OFF_MIX);
  float* buf = (float*)smem;
  float* vbuf = buf + 2 * 16 * 5 * 64;
  float* ybuf = vbuf + 2 * 16 * 16;
  float S[4] = {0.f, 0.f, 0.f, 0.f};
  float4 rg[5]; float rv;
  const int lstep = tid >> 4, lc4 = tid & 15;
  auto gload = [&](int c) {
    const size_t o = ((size_t)b * SEQ_LEN + c * 16 + lstep) * 512 + h * 64;
#pragma unroll
    for (int a = 0; a < 5; ++a) rg[a] = ld4(ARR[a] + o + lc4 * 4);
    rv = RWV[o + rq * 16 + lc4];
  };
  auto sstore = [&](int bi) {
#pragma unroll
    for (int a = 0; a < 5; ++a) st4(buf + ((bi * 16 + lstep) * 5 + a) * 64 + lc4 * 4, rg[a]);
    vbuf[(bi * 16 + lstep) * 16 + lc4] = rv;
  };
  __syncthreads();
  gload(0);
  sstore(0);
  __syncthreads();
  const int NCH = SEQ_LEN / 16;
  for (int c = 0; c < NCH; ++c) {
    if (c + 1 < NCH) gload(c + 1);
    const float* cb = buf + (c & 1) * 16 * 5 * 64;
    const float* cv = vbuf + (c & 1) * 16 * 16;
    float4 cw = ld4(cb + 0 * 64 + cg * 4), ck = ld4(cb + 1 * 64 + cg * 4), ckk = ld4(cb + 2 * 64 + cg * 4),
           cka = ld4(cb + 3 * 64 + cg * 4), cr = ld4(cb + 4 * 64 + cg * 4);
    float cvv = cv[rl];
#pragma unroll
    for (int s = 0; s < 16; ++s) {
      const float4 w = cw, k = ck, kk = ckk, ka = cka, r = cr;
      const float v = cvv;
      if (s < 15) {
        cw = ld4(cb + ((s + 1) * 5 + 0) * 64 + cg * 4); ck = ld4(cb + ((s + 1) * 5 + 1) * 64 + cg * 4);
        ckk = ld4(cb + ((s + 1) * 5 + 2) * 64 + cg * 4); cka = ld4(cb + ((s + 1) * 5 + 3) * 64 + cg * 4);
        cr = ld4(cb + ((s + 1) * 5 + 4) * 64 + cg * 4); cvv = cv[(s + 1) * 16 + rl];
      }
      float sa = (S[0] * kk.x + S[1] * kk.y) + (S[2] * kk.z + S[3] * kk.w);
      sa = -sum16(sa);
      S[0] = S[0] * w.x + (sa * ka.x + v * k.x);
      S[1] = S[1] * w.y + (sa * ka.y + v * k.y);
      S[2] = S[2] * w.z + (sa * ka.z + v * k.z);
      S[3] = S[3] * w.w + (sa * ka.w + v * k.w);
      float y = (S[0] * r.x + S[1] * r.y) + (S[2] * r.z + S[3] * r.w);
      y = sum16(y);
      if (cg == 0) ybuf[s * 16 + rl] = y;
      asm volatile("" ::: "memory");
    }
    __syncthreads();
    if (c + 1 < NCH) sstore((c + 1) & 1);
    Yo[((size_t)b * SEQ_LEN + c * 16 + lstep) * 1024 + h * 64 + rq * 16 + lc4] = ybuf[lstep * 16 + lc4];
    __syncthreads();
  }
}
struct RetSmem { unsigned short k[64][72]; unsigned short vt[2][64][68]; };
#define RETPFX_ITEMS (BATCH * 4 * 64 * 128 / NTHREADS)
DEV void ret_prefix(const Params& p, int item) {
  const int gi = item * NTHREADS + TIDX;
  const int bh4 = gi >> 13, idx = gi & 8191;
  const float G = exp2f(128.f * ret_log2gamma(bh4 & 3));
  float* KV = (float*)(p.ws + OFF_RETKV) + (size_t)bh4 * RET_NC * 8192 + idx;
  float st = 0.f;
  int c = 0;
  for (; c + 8 <= RET_NC; c += 8) {
    float e[8];
#pragma unroll
    for (int q = 0; q < 8; ++q) e[q] = KV[(size_t)(c + q) * 8192];
#pragma unroll
    for (int q = 0; q < 8; ++q) { KV[(size_t)(c + q) * 8192] = st; st = st * G + e[q]; }
  }
  for (; c < RET_NC; ++c) { const float e = KV[(size_t)c * 8192]; KV[(size_t)c * 8192] = st; st = st * G + e; }
}
DEV void phase_retpfx(const Params& p, char* smem) {
  for (int it = BIDX; it < RETPFX_ITEMS; it += gridDim.x) ret_prefix(p, it);
}
DEV void p12_ret(const Params& p, int item, char* smem) {
  RetSmem* sm = (RetSmem*)smem;
  const int c = item % RET_NC, h = (item / RET_NC) & 3, b = item / (RET_NC * 4);
  const int tid = TIDX, lane = tid & 63, wave = tid >> 6;
  const int cidx = lane & 31, hh = lane >> 5;
  const int qi = wave * 32 + cidx;
  const float* H2 = (const float*)(p.ws + OFF_H2);
  const float lg = ret_log2gamma(h);
  const size_t tok0 = (size_t)b * SEQ_LEN + c * 128;
  bf16x8 qf[4], qfs[4];
  {
    const float* qr = H2 + (tok0 + qi) * 1536 + h * 64;
    const float qs = exp2f((float)(qi + 1) * lg);
#pragma unroll
    for (int ks = 0; ks < 4; ++ks) {
      const float4 a0 = ld4(qr + ks * 16 + hh * 8), a1 = ld4(qr + ks * 16 + hh * 8 + 4);
      const float v[8] = {a0.x, a0.y, a0.z, a0.w, a1.x, a1.y, a1.z, a1.w};
#pragma unroll
      for (int j = 0; j < 8; ++j) { qf[ks][j] = (short)f2bf(v[j]); qfs[ks][j] = (short)f2bf(v[j] * qs); }
    }
  }
  f32x16 o[4], s[2];
#pragma unroll
  for (int mt = 0; mt < 4; ++mt)
#pragma unroll
    for (int i = 0; i < 16; ++i) o[mt][i] = 0.f;
  {
    const float* KV0 = (const float*)(p.ws + OFF_RETKV) + (size_t)((b * 4 + h) * RET_NC) * 64 * 128;
#pragma unroll
    for (int eh = 0; eh < 2; ++eh) {
      __syncthreads();
      {
        const int el = tid & 63, d0 = tid >> 6;
        float stv[16];
#pragma unroll
        for (int i = 0; i < 16; ++i) stv[i] = KV0[(size_t)c * 64 * 128 + (d0 + 4 * i) * 128 + eh * 64 + el];
#pragma unroll
        for (int i = 0; i < 16; ++i) sm->k[el][d0 + 4 * i] = f2bf(stv[i]);
      }
      __syncthreads();
      qk_tile(sm->k, qfs, s, lane);
#pragma unroll
      for (int i = 0; i < 16; ++i) { o[eh * 2][i] += s[0][i]; o[eh * 2 + 1][i] += s[1][i]; }
    }
  }
#pragma unroll 1
  for (int kt = 0; kt < 2; ++kt) {
    __syncthreads();
    {
      const int row = tid >> 2, seg = tid & 3;
      const float* kr = H2 + (tok0 + kt * 64 + row) * 1536 + 256 + h * 64 + seg * 16;
      const float4 a0 = ld4(kr), a1 = ld4(kr + 4), a2 = ld4(kr + 8), a3 = ld4(kr + 12);
      *(uint4*)&sm->k[row][seg * 16] = make_uint4(pk2(a0.x, a0.y), pk2(a0.z, a0.w), pk2(a1.x, a1.y), pk2(a1.z, a1.w));
      *(uint4*)&sm->k[row][seg * 16 + 8] = make_uint4(pk2(a2.x, a2.y), pk2(a2.z, a2.w), pk2(a3.x, a3.y), pk2(a3.z, a3.w));
#pragma unroll
      for (int q = 0; q < 8; ++q) {
        const int f = tid + 256 * q;
        const int key = f >> 5, d4 = (f & 31) * 4;
        const float4 v = ld4(H2 + (tok0 + kt * 64 + key) * 1536 + 512 + h * 128 + d4);
        unsigned short(*vt)[68] = sm->vt[d4 >> 6];
        const int dl = d4 & 63;
        vt[dl][key] = f2bf(v.x); vt[dl + 1][key] = f2bf(v.y); vt[dl + 2][key] = f2bf(v.z); vt[dl + 3][key] = f2bf(v.w);
      }
    }
    __syncthreads();
    if (kt * 64 <= wave * 32 + 31) {
      qk_tile(sm->k, qf, s, lane);
#pragma unroll
      for (int ks2 = 0; ks2 < 2; ++ks2)
#pragma unroll
        for (int i = 0; i < 16; ++i) {
          const int kj = kt * 64 + ks2 * 32 + (i & 3) + 8 * (i >> 2) + 4 * hh;
          s[ks2][i] = kj <= qi ? s[ks2][i] * exp2f((float)(qi - kj) * lg) : 0.f;
        }
      pv_tile(sm->vt[0], s, *(f32x16(*)[2])&o[0], lane);
      pv_tile(sm->vt[1], s, *(f32x16(*)[2])&o[2], lane);
    }
  }
  float s1 = 0.f;
#pragma unroll
  for (int mt = 0; mt < 4; ++mt)
#pragma unroll
    for (int i = 0; i < 16; ++i) s1 += o[mt][i];
  s1 += __shfl_xor(s1, 32);
  const float mu = s1 * (1.f / 128.f);
  float s2 = 0.f;
#pragma unroll
  for (int mt = 0; mt < 4; ++mt)
#pragma unroll
    for (int i = 0; i < 16; ++i) { const float d = o[mt][i] - mu; s2 += d * d; }
  s2 += __shfl_xor(s2, 32);
  const float rstd = rsqrtf(s2 * (1.f / 128.f) + 1e-5f);
  float* MIX = (float*)(p.ws + OFF_MIX);
  const float* gate = H2 + (tok0 + qi) * 1536 + 1024 + h * 128;
  float* dst = MIX + (tok0 + qi) * 1024 + 512 + h * 128;
  const float* lgam = p.in[I_RET_LN_G] + h * 128;
  const float* lbet = p.in[I_RET_LN_B] + h * 128;
#pragma unroll
  for (int mt = 0; mt < 4; ++mt)
#pragma unroll
    for (int g4 = 0; g4 < 4; ++g4) {
      const int dv = mt * 32 + 8 * g4 + 4 * hh;
      const float4 gv = ld4(lgam + dv), bv = ld4(lbet + dv), gt = ld4(gate + dv);
      float4 ov;
      ov.x = siluf_(gt.x) * ((o[mt][4 * g4] - mu) * rstd * gv.x + bv.x);
      ov.y = siluf_(gt.y) * ((o[mt][4 * g4 + 1] - mu) * rstd * gv.y + bv.y);
      ov.z = siluf_(gt.z) * ((o[mt][4 * g4 + 2] - mu) * rstd * gv.z + bv.z);
      ov.w = siluf_(gt.w) * ((o[mt][4 * g4 + 3] - mu) * rstd * gv.w + bv.w);
      st4(dst + dv, ov);
    }
}
DEV void phase_p12(const Params& p, char* smem) {
  const int G = gridDim.x;
  const int bid = BIDX;
  if (bid < BATCH * 8 && G > BATCH * 8) {
    rk_chain(p, bid);
  } else if (G >= 8 * BATCH * 8) {
    const int Gh = G >> 1, NC = BATCH * 8;
    if (bid >= Gh && bid < Gh + NC) return;
    const int w = bid - NC - (bid >= Gh ? NC : 0);
#if RK_MERGED
    if ((G & 15) == 0 && BATCH * 8 == 16) {
      const int x = bid & 7, m = bid >> 3;
      const int rank = m - 2 - (m >= (Gh >> 3) ? 2 : 0), nprod = (G >> 3) - 4;
      for (int k = rank; k < 2 * RK_NCH; k += nprod) rk_precompute(p, (x + 8 * (k & 1)) * RK_NCH + (k >> 1), smem);
    } else {
      for (int it = w; it < RK_NCHT; it += G - 2 * NC) rk_precompute(p, (it % NC) * RK_NCH + it / NC, smem);
    }
#endif
    for (int it = w; it < P12_RET_ITEMS; it += G - 2 * NC) p12_ret(p, it, smem);
  } else if (G > BATCH * 8) {
    for (int it = bid - BATCH * 8; it < P12_RET_ITEMS; it += G - BATCH * 8) p12_ret(p, it, smem);
  } else {
    for (int it = bid; it < BATCH * 8 + P12_RET_ITEMS; it += G) {
      if (it < BATCH * 8) rk_chain(p, it);
      else p12_ret(p, it - BATCH * 8, smem);
    }
  }
}

#define P13_SMEM (RWP_T * 128 * 4)
DEV void phase_p13(const Params& p, char* smem) {
  const int tid = TIDX;
  const float* Hc = (const float*)(p.ws + OFF_H);
  const float* mu = p.in[I_RW_MU];
  const float* GLO = (const float*)(p.ws + OFF_GLO);
  float* sl = (float*)smem;
  float* MIX = (float*)(p.ws + OFF_MIX);
  const float* RWK = (const float*)(p.ws + OFF_RWK); const float* RWR = p.out + (size_t)NTOK * 512; const float* RWV = p.out;
  const float* G = (const float*)(p.ws + OFF_RWG);
  for (int it = BIDX; it < NTOK / RWP_T; it += gridDim.x) {
#pragma unroll
    for (int cc = 0; cc < 2; ++cc) {
      const int c = tid + 256 * cc;
      const float lng = p.in[I_RW_LN_G][c], lnb = p.in[I_RW_LN_B][c], rk = p.in[I_RW_R_K][c];
#pragma unroll 4
      for (int tt = 0; tt < RWP_T; ++tt) {
        const size_t tok = (size_t)it * RWP_T + tt;
        const float y = MIX[tok * 1024 + c];
        const float m = wave_sum(y) * (1.f / 64.f);
        const float d = y - m;
        const float var = wave_sum(d * d) * (1.f / 64.f);
        const float yn = d * rsqrtf(var + 64e-5f) * lng + lnb;
        const float r = RWR[tok * 512 + c], k = RWK[tok * 512 + c], v = RWV[tok * 512 + c];
        const float bonus = wave_sum(r * k * rk) * v;
        MIX[tok * 1024 + c] = (yn + bonus) * G[tok * 512 + c];
      }
    }
  }
}

#define NPHASES 20
#define SMEM_BYTES 53248
DEV void run_phase(const Params& p, int ph, char* smem) {
  switch (ph) {
    case 0: phase_gemm_in<0>(p, smem); break;
    case 1: phase_p1(p, smem); break;
    case 2: phase_p2(p, smem); break;
    case 3: phase_glu(p, smem); break;
    case 4: phase_outproj<0>(p, smem); break;
    case 5: phase_ln_router<0>(p, smem); break;
    case 6: phase_lists_shup<0>(p, smem); break;
    case 7: phase_routed_up<0>(p, smem); break;
    case 8: phase_down<0>(p, smem); break;
    case 9: phase_combine<0>(p, smem); break;
    case 10: phase_gemm_in<1>(p, smem); break;
    case 11: phase_p11(p, smem); break;
    case 12: phase_p12(p, smem); break;
    case 13: phase_p13(p, smem); break;
    case 14: phase_outproj<1>(p, smem); break;
    case 15: phase_ln_router<1>(p, smem); break;
    case 16: phase_lists_shup<1>(p, smem); break;
    case 17: phase_routed_up<1>(p, smem); break;
    case 18: phase_down<1>(p, smem); break;
    case 19: phase_combine<1>(p, smem); break;
    case 20: phase_p1b(p, smem); break;
    case 21: phase_rkpre(p, smem); break;
    case 22: phase_rkout(p, smem); break;
    case 24: phase_retpfx(p, smem); break;
  }
}
static_assert(P1_SMEM <= SMEM_BYTES, "smem");
static_assert(P1_PREP_SMEM <= SMEM_BYTES, "smem");
static_assert(P2_SMEM <= SMEM_BYTES, "smem");
static_assert(P5_SMEM <= SMEM_BYTES, "smem");
static_assert(P7_SMEM <= SMEM_BYTES, "smem");
static_assert(P12_SMEM <= SMEM_BYTES, "smem");
static_assert(RKPRE_SMEM <= SMEM_BYTES, "smem");
static_assert(OFF_HS + (size_t)NTOK * 256 * 2 <= OFF_X1, "layout");

#ifndef CPU_EMU
template <int PH>
__global__ void __launch_bounds__(NTHREADS) phase_kernel(Params p) {
  __shared__ __attribute__((aligned(16))) char smem[SMEM_BYTES];
  run_phase(p, PH, smem);
}
template <int PH>
static void launch_phases(const Params& p, hipStream_t stream) {
  phase_kernel<PH><<<dim3(1024), dim3(NTHREADS), 0, stream>>>(p);
  if constexpr (PH + 1 < NPHASES) launch_phases<PH + 1>(p, stream);
}
#if MEGA
#define XB_TMO      128
#define XB_XCNT(j)  (256  + 64 * (j))
#define XB_XSUB(j)  (1280 + 64 * (j))
#define XB_XGEN(j)  (2304 + 64 * (j))
#define XB_TOP      3328
#define XB_TOPGEN   3392
#define XCD_BAR_WORDS 3456
#define XB_SPIN_CAP (1u << 18)
#define LAS __attribute__((address_space(3)))

__device__ __forceinline__ unsigned xb_ld(unsigned* p)              { return __hip_atomic_load(p, __ATOMIC_RELAXED, __HIP_MEMORY_SCOPE_AGENT); }
__device__ __forceinline__ unsigned xb_add(unsigned* p, unsigned v) { return __hip_atomic_fetch_add(p, v, __ATOMIC_RELAXED, __HIP_MEMORY_SCOPE_AGENT); }
__device__ __forceinline__ unsigned xb_xcc_id() { return (unsigned)__builtin_amdgcn_s_getreg((3 << 11) | 20) & 0xFu; }
#define XB_SPIN(cond, bar) do { unsigned _sp = 0; while (cond) { __builtin_amdgcn_s_sleep(1); \
    if ((++_sp & 255u) == 0u) { if (xb_ld(&(bar)[XB_TMO])) break; if (_sp > XB_SPIN_CAP) { atomicAdd(&(bar)[XB_TMO], 1u); break; } } } } while (0)

struct XcdBarrier {
    unsigned* bar; unsigned x;
    volatile LAS unsigned* st;
};

__device__ __forceinline__ XcdBarrier xcd_barrier_post(unsigned* bar, volatile LAS unsigned* st) {
    XcdBarrier b; b.bar = bar; b.x = xb_xcc_id(); b.st = st;
    if (threadIdx.x == 0) (void)xb_add(&bar[XB_XCNT(b.x)], 1u);
    return b;
}
__device__ __forceinline__ void xcd_barrier_complete(unsigned* bar, unsigned x, unsigned& nloc, unsigned& nx) {
    const unsigned G = gridDim.x * gridDim.y * gridDim.z;
    unsigned sum, cnt, mine, sp = 0u;
    for (;;) {
        sum = 0u; cnt = 0u; mine = 0u;
#pragma unroll
        for (unsigned j = 0; j < 16; ++j) { const unsigned c = xb_ld(&bar[XB_XCNT(j)]); sum += c; cnt += (c > 0u) ? 1u : 0u; mine = (j == x) ? c : mine; }
        if (sum == G) break;
        __builtin_amdgcn_s_sleep(1);
        if ((++sp & 255u) == 0u) { if (xb_ld(&bar[XB_TMO])) break; if (sp > XB_SPIN_CAP) { atomicAdd(&bar[XB_TMO], 1u); break; } }
    }
    nloc = mine > 0u ? mine : 1u; nx = cnt > 0u ? cnt : 1u;
}

__device__ __forceinline__ void xcd_barrier(const XcdBarrier& b) {
    asm volatile("s_waitcnt vmcnt(0)" ::: "memory");
    __syncthreads();
    if (threadIdx.x == 0) {
        unsigned* bar = b.bar;
        __builtin_amdgcn_s_waitcnt(0);
        unsigned nloc = b.st[0], nx = b.st[1];
        if (nloc == 0u) { xcd_barrier_complete(bar, b.x, nloc, nx); b.st[0] = nloc; b.st[1] = nx; }
        const unsigned old = xb_add(&bar[XB_XSUB(b.x)], 1u);
        const unsigned gen = old / nloc;
        if (old + 1u == (gen + 1u) * nloc) {
            __builtin_amdgcn_fence(__ATOMIC_RELEASE, "agent");
            asm volatile("s_waitcnt vmcnt(0)" ::: "memory");
            const unsigned og = xb_add(&bar[XB_TOP], 1u);
            const unsigned tg = og / nx;
            if (og + 1u == (tg + 1u) * nx) xb_add(&bar[XB_TOPGEN], 1u);
            else XB_SPIN(xb_ld(&bar[XB_TOPGEN]) == tg, bar);
            __builtin_amdgcn_fence(__ATOMIC_ACQUIRE, "agent");
            xb_add(&bar[XB_XGEN(b.x)], 1u);
            asm volatile("s_waitcnt vmcnt(0)" ::: "memory");
        } else {
            XB_SPIN(xb_ld(&bar[XB_XGEN(b.x)]) == gen, bar);
            __builtin_amdgcn_fence(__ATOMIC_ACQUIRE, "agent");
            asm volatile("s_waitcnt vmcnt(0)" ::: "memory");
        }
    }
    __syncthreads();
}


__global__ void __launch_bounds__(NTHREADS, 2) mega_kernel(Params p) {
  __shared__ __attribute__((aligned(16))) char smem[SMEM_BYTES];
  unsigned* bar = (unsigned*)(p.ws + OFF_BAR);
  __shared__ uint4 xb_words;
  if (threadIdx.x == 0) xb_words = make_uint4(0u, 0u, 0u, 0u);
  __syncthreads();
  XcdBarrier xb = xcd_barrier_post(bar, (volatile LAS unsigned*)&xb_words);
  if (p.ws == nullptr) cg::this_grid().sync();
  typedef const __attribute__((address_space(4))) Params* KParams;
#define PH_(n) { KParams kp = (KParams)__builtin_amdgcn_kernarg_segment_ptr(); asm volatile("" : "+s"(kp)); const Params lp = *(const Params*)kp; run_phase(lp, n, smem); } xcd_barrier(xb);
  PH_(0) PH_(1) PH_(20) PH_(2) PH_(3) PH_(4) PH_(5) PH_(6) PH_(7) PH_(8) PH_(9)
  PH_(10) PH_(11) PH_(24) PH_(12) PH_(22) PH_(13) PH_(14) PH_(15) PH_(16) PH_(17) PH_(18)
  { KParams kp = (KParams)__builtin_amdgcn_kernarg_segment_ptr(); asm volatile("" : "+s"(kp)); const Params lp = *(const Params*)kp; run_phase(lp, 19, smem); }
}

#endif

extern "C" void kernel_launch(void* const* d_in, const int* in_sizes, int n_in, void* d_out, int out_size, void* d_ws, size_t ws_size,
                              hipStream_t stream) {
  Params p;
  for (int i = 0; i < N_INPUTS; ++i) p.in[i] = (const float*)d_in[i];
  p.out = (float*)d_out;
  p.ws = (char*)d_ws;
#if MEGA
  static int grid_blocks = 0;
  if (!grid_blocks) {
    int dev = 0, cus = 0, per_cu = 0;
    hipGetDevice(&dev);
    hipDeviceGetAttribute(&cus, hipDeviceAttributeMultiprocessorCount, dev);
    hipOccupancyMaxActiveBlocksPerMultiprocessor(&per_cu, mega_kernel, NTHREADS, 0);
    if (per_cu > 2) per_cu = 2;
    grid_blocks = cus * per_cu;
  }
  hipMemsetAsync((char*)d_ws + OFF_BAR, 0, 16384, stream);
  void* args[] = {&p};
  hipError_t e = hipLaunchCooperativeKernel((void*)mega_kernel, dim3(grid_blocks), dim3(NTHREADS), args, 0, stream);
  if (e != hipSuccess) fprintf(stderr, "cooperative launch failed: %s (grid %d)\n", hipGetErrorString(e), grid_blocks);
#else
  launch_phases<0>(p, stream);
#endif
}
#endif
```

```cpp
#ifdef CPU_EMU
#include "emu.h"
#else
#include <hip/hip_runtime.h>
#include <hip/hip_cooperative_groups.h>
#include <cstdio>
namespace cg = cooperative_groups;
#endif
#include <stdint.h>

#ifndef BATCH
#define BATCH 2
#endif
#ifndef SEQ_LEN
#define SEQ_LEN 8192
#endif
#ifndef MEGA
#define MEGA 1
#endif
#if MEGA && !defined(CPU_EMU)
#define RK_MERGED 1
#else
#define RK_MERGED 0
#endif

#define DEV __device__ __forceinline__
#ifdef CPU_EMU
#define TIDX ((int)threadIdx.x)
#define BIDX ((int)blockIdx.x)
#else
__device__ __forceinline__ int tidx_() { int t = __builtin_amdgcn_workitem_id_x(); asm volatile("" : "+v"(t)); return t; }
__device__ __forceinline__ int bidx_() { int b = __builtin_amdgcn_workgroup_id_x(); asm volatile("" : "+s"(b)); return b; }
#define TIDX tidx_()
#define BIDX bidx_()
#endif
#define NTOK (BATCH * SEQ_LEN)
#define DM 1024
#define AB_IN 1816
#define AB_LD 1824
#define CD_IN 3328
#define NCMP ((SEQ_LEN - 32) / 16 + 1)
#define NBLK (SEQ_LEN / 64)
#define NB_CMP ((NCMP + 63) / 64)
#define S5_NC (SEQ_LEN / 64)
#define RET_NC (SEQ_LEN / 128)
#define ALPHA_F 1.4142135623730951f
#define NTHREADS 256

enum { I_X = 0, I_AB_W_IN, I_AB_W_OUT, I_S5_LAM_RE, I_S5_LAM_IM, I_S5_LOG_DT, I_S5_B_RE, I_S5_B_IM, I_S5_C_RE, I_S5_C_IM,
       I_S5_D, I_S5_W_GLU, I_S5_B_GLU, I_PE_K, I_PE_V, I_CK_W1, I_CK_B1, I_CK_W2, I_CV_W1, I_CV_B1, I_CV_W2,
       I_CD_W_IN, I_CD_W_OUT, I_RW_MU, I_RW_W0, I_RW_W_UP, I_RW_A0, I_RW_A_UP, I_RW_G_UP, I_RW_K_K, I_RW_K_A, I_RW_R_K,
       I_RW_LN_G, I_RW_LN_B, I_RET_LN_G, I_RET_LN_B, I_LN1_G, I_LN1_B, I_LN2_G, I_LN2_B, I_ROUTER, I_MOE_BIAS,
       I_MOE_W1, I_MOE_W3, I_MOE_W2, I_SH_W1, I_SH_W3, I_SH_W2, N_INPUTS };

struct Params {
  const float* in[N_INPUTS];
  float* out;
  char* ws;
};

#define MiB_TOK ((size_t)NTOK * 1024 * 4)
#define OFF_H 0
#define OFF_H2 ((size_t)NTOK * 1792 * 4)
#define OFF_MIX ((size_t)NTOK * 3328 * 4)
#define OFF_X1 (OFF_MIX + MiB_TOK)
#define OFF_X2 (OFF_X1 + MiB_TOK)
#define OFF_R4 (OFF_X2 + MiB_TOK)
#define OFF_R5 (OFF_R4 + MiB_TOK)
#define OFF_Y OFF_H
#define OFF_HS (OFF_H + 4 * MiB_TOK)
#define OFF_FS OFF_X2
#define OFF_HR OFF_R4
#define OFF_X2B OFF_R4
#define OFF_TOPI (OFF_R5)
#define OFF_TOPG (OFF_TOPI + (size_t)NTOK * 8 * 4)
#define OFF_POSOF (OFF_TOPG + (size_t)NTOK * 8 * 4)
#define OFF_CNT (OFF_POSOF + (size_t)NTOK * 8 * 4)
#define OFF_LTOK (OFF_CNT + 8192)
#define OFF_LGATE (OFF_LTOK + (size_t)64 * NTOK * 4)
#define OFF_S5E (OFF_LGATE + (size_t)64 * NTOK * 4)
#define OFF_KCMP (OFF_S5E + (size_t)BATCH * S5_NC * 32 * 64 * 8)
#define OFF_VCMP (OFF_KCMP + (size_t)BATCH * NCMP * 2 * 64 * 4)
#define OFF_RETKV (OFF_VCMP + (size_t)BATCH * NCMP * 2 * 64 * 4)
#define OFF_BAR (OFF_RETKV + (size_t)BATCH * 4 * RET_NC * 64 * 128 * 4)
#define OFF_CMPHID (OFF_BAR + 16384)
#define OFF_CMPC1 (OFF_CMPHID + (size_t)2 * BATCH * 2 * NB_CMP * 64 * 128 * 4)
#define OFF_GLO OFF_LTOK
#define OFF_RKF (OFF_CMPC1 + 8192)
#define OFF_END (OFF_RKF + 16384)
#define OFF_YGELU OFF_X1
#define OFF_RWW OFF_X1
#define OFF_RWK (OFF_X1 + (size_t)NTOK * 512 * 4)
#define OFF_RWKK OFF_R4
#define OFF_RWA (OFF_R4 + (size_t)NTOK * 512 * 4)

typedef short bf16x8 __attribute__((ext_vector_type(8)));
typedef float f32x16 __attribute__((ext_vector_type(16)));

#ifdef CPU_EMU
#define WAVE_SYNC() emu_wave_bar()
#else
#define WAVE_SYNC() __builtin_amdgcn_wave_barrier()
#endif

DEV float sigmoidf_(float x) { return 1.f / (1.f + __expf(-x)); }
DEV float siluf_(float x) { return x * sigmoidf_(x); }
DEV float geluf_(float x) { float u = 0.7978845608028654f * (x + 0.044715f * x * x * x); return 0.5f * x * (1.f + tanhf(u)); }
DEV unsigned short f2bf(float f) {
  unsigned u = __builtin_bit_cast(unsigned, f);
  u += 0x7FFFu + ((u >> 16) & 1u);
  return (unsigned short)(u >> 16);
}
DEV float bf2f(unsigned short h) { return __builtin_bit_cast(float, ((unsigned)h) << 16); }
DEV float wave_sum(float v) {
#pragma unroll
  for (int m = 32; m >= 1; m >>= 1) v += __shfl_xor(v, m);
  return v;
}
DEV float wave_max(float v) {
#pragma unroll
  for (int m = 32; m >= 1; m >>= 1) v = fmaxf(v, __shfl_xor(v, m));
  return v;
}
DEV float4 ld4(const float* p) { return *(const float4*)p; }
#ifdef CPU_EMU
DEV float fexp2(float x) { return exp2f(x); }
#else
DEV float fexp2(float x) { return __builtin_amdgcn_exp2f(x); }
#endif
DEV void fast_sincos(float x, float* sn, float* cs) {
  const float k = rintf(x * 0.15915494309189535f);
  float r = fmaf(-k, 6.28125f, x);
  r = fmaf(-k, 1.9353071795864769e-3f, r);
  *sn = __sinf(r); *cs = __cosf(r);
}
DEV void st4(float* p, float4 v) { *(float4*)p = v; }

#define GEMM_BM 128
#define GEMM_MI (GEMM_BM / 64)
#define GEMM_SMEM_BYTES ((GEMM_BM + 128) * 72 * 2)
#ifdef CPU_EMU
DEV unsigned pk2(float a, float b) { return (unsigned)f2bf(a) | ((unsigned)f2bf(b) << 16); }
#else
typedef __bf16 hbf16x2 __attribute__((ext_vector_type(2)));
typedef float hf32x2 __attribute__((ext_vector_type(2)));
DEV unsigned pk2(float a, float b) {
  hf32x2 f = {a, b};
  return __builtin_bit_cast(unsigned, __builtin_convertvector(f, hbf16x2));
}
#endif
template <bool ABF, class AROW, class BPTR, class EPI>
DEV void gemm_tile(AROW arow, BPTR bptr, int ldb, int K, EPI epi, char* smem_raw, int akstep = 64) {
  unsigned short(*sA)[72] = (unsigned short(*)[72])smem_raw;
  unsigned short(*sB)[72] = (unsigned short(*)[72])(smem_raw + GEMM_BM * 72 * 2);
  const int tid = TIDX, lane = tid & 63, wave = tid >> 6;
  const int wm = wave >> 1, wn = wave & 1;
#if defined(CPU_EMU) && !defined(EMU_REAL_GEMM)
  for (int mi = 0; mi < GEMM_MI; ++mi)
    for (int r = 0; r < 16; ++r) {
      const int row = wm * (GEMM_BM / 2) + mi * 32 + (r & 3) + 8 * (r >> 2) + 4 * (lane >> 5);
      const int col = wn * 64 + (lane & 31);
      const void* arp = arow(row);
      float v[2] = {0.f, 0.f};
      for (int ni = 0; ni < 2; ++ni) {
        const int cc = col + ni * 32;
        const float* bq = bptr(cc & ~3);
        if (!arp || !bq) continue;
        bq += cc & 3;
        float a = 0.f;
        for (int k = 0; k < K; ++k) {
          const size_t ka = (size_t)(k >> 6) * akstep + (k & 63);
          const float av = ABF ? bf2f(((const unsigned short*)arp)[ka]) : bf2f(f2bf(((const float*)arp)[ka]));
          a += av * bf2f(f2bf(bq[(size_t)k * ldb]));
        }
        v[ni] = a;
      }
      epi(row, col, v[0], v[1]);
    }
  return;
#endif
  const float* ap[4 * GEMM_MI];
  const unsigned short* aph[2 * GEMM_MI];
  if (ABF) {
#pragma unroll
    for (int i = 0; i < 2 * GEMM_MI; ++i) aph[i] = (const unsigned short*)arow((tid >> 3) + 32 * i);
  } else {
#pragma unroll
    for (int i = 0; i < 4 * GEMM_MI; ++i) ap[i] = (const float*)arow((tid >> 4) + 16 * i);
  }
  const float* bp = bptr((tid & 31) * 4);
  const int kgrp = tid >> 5;
  float4 ra0[4 * GEMM_MI], ra1[4 * GEMM_MI];
  uint4 rah0[2 * GEMM_MI], rah1[2 * GEMM_MI];
  float4 rb0[8], rb1[8];
#define GEMM_GLOAD(S, k0_)                                                                                                          \
  {                                                                                                                                 \
    if (ABF) {                                                                                                                      \
      _Pragma("unroll") for (int i = 0; i < 2 * GEMM_MI; ++i) rah##S[i] =                                                           \
          aph[i] ? *(const uint4*)(aph[i] + (size_t)((k0_) >> 6) * akstep + (tid & 7) * 8) : make_uint4(0, 0, 0, 0);                \
    } else {                                                                                                                        \
      _Pragma("unroll") for (int i = 0; i < 4 * GEMM_MI; ++i) ra##S[i] =                                                            \
          ap[i] ? ld4(ap[i] + (size_t)((k0_) >> 6) * akstep + (tid & 15) * 4) : make_float4(0.f, 0.f, 0.f, 0.f);                    \
    }                                                                                                                               \
    _Pragma("unroll") for (int j = 0; j < 8; ++j) rb##S[j] =                                                                        \
        bp ? ld4(bp + (size_t)((k0_) + kgrp * 8 + j) * ldb) : make_float4(0.f, 0.f, 0.f, 0.f);                                      \
  }
#define GEMM_SSTORE(S)                                                                                                              \
  {                                                                                                                                 \
    if (ABF) {                                                                                                                      \
      _Pragma("unroll") for (int i = 0; i < 2 * GEMM_MI; ++i) *(uint4*)&sA[(tid >> 3) + 32 * i][(tid & 7) * 8] = rah##S[i];         \
    } else {                                                                                                                        \
      _Pragma("unroll") for (int i = 0; i < 4 * GEMM_MI; ++i) *(uint2*)&sA[(tid >> 4) + 16 * i][(tid & 15) * 4] =                   \
          make_uint2(pk2(ra##S[i].x, ra##S[i].y), pk2(ra##S[i].z, ra##S[i].w));                                                     \
    }                                                                                                                               \
    const int nb = (tid & 31) * 4;                                                                                                  \
    *(uint4*)&sB[nb + 0][kgrp * 8] = make_uint4(pk2(rb##S[0].x, rb##S[1].x), pk2(rb##S[2].x, rb##S[3].x), pk2(rb##S[4].x, rb##S[5].x), pk2(rb##S[6].x, rb##S[7].x)); \
    *(uint4*)&sB[nb + 1][kgrp * 8] = make_uint4(pk2(rb##S[0].y, rb##S[1].y), pk2(rb##S[2].y, rb##S[3].y), pk2(rb##S[4].y, rb##S[5].y), pk2(rb##S[6].y, rb##S[7].y)); \
    *(uint4*)&sB[nb + 2][kgrp * 8] = make_uint4(pk2(rb##S[0].z, rb##S[1].z), pk2(rb##S[2].z, rb##S[3].z), pk2(rb##S[4].z, rb##S[5].z), pk2(rb##S[6].z, rb##S[7].z)); \
    *(uint4*)&sB[nb + 3][kgrp * 8] = make_uint4(pk2(rb##S[0].w, rb##S[1].w), pk2(rb##S[2].w, rb##S[3].w), pk2(rb##S[4].w, rb##S[5].w), pk2(rb##S[6].w, rb##S[7].w)); \
  }
  f32x16 acc[GEMM_MI][2];
#pragma unroll
  for (int mi = 0; mi < GEMM_MI; ++mi)
#pragma unroll
    for (int ni = 0; ni < 2; ++ni)
#pragma unroll
      for (int r = 0; r < 16; ++r) acc[mi][ni][r] = 0.f;
  auto compute = [&]() {
#pragma unroll
    for (int ks = 0; ks < 4; ++ks) {
      bf16x8 af[GEMM_MI], bfr[2];
#pragma unroll
      for (int mi = 0; mi < GEMM_MI; ++mi) af[mi] = *(const bf16x8*)&sA[wm * (GEMM_BM / 2) + mi * 32 + (lane & 31)][ks * 16 + (lane >> 5) * 8];
#pragma unroll
      for (int ni = 0; ni < 2; ++ni) bfr[ni] = *(const bf16x8*)&sB[wn * 64 + ni * 32 + (lane & 31)][ks * 16 + (lane >> 5) * 8];
#pragma unroll
      for (int mi = 0; mi < GEMM_MI; ++mi)
#pragma unroll
        for (int ni = 0; ni < 2; ++ni) acc[mi][ni] = __builtin_amdgcn_mfma_f32_32x32x16_bf16(af[mi], bfr[ni], acc[mi][ni], 0, 0, 0);
    }
  };
  if (ABF) {
    GEMM_GLOAD(0, 0);
    GEMM_GLOAD(1, 64);
    for (int k0 = 0; k0 < K; k0 += 128) {
      __syncthreads();
      GEMM_SSTORE(0);
      __syncthreads();
      if (k0 + 128 < K) GEMM_GLOAD(0, k0 + 128);
      compute();
      __syncthreads();
      GEMM_SSTORE(1);
      __syncthreads();
      if (k0 + 192 < K) GEMM_GLOAD(1, k0 + 192);
      compute();
    }
  } else {
    GEMM_GLOAD(0, 0);
    for (int k0 = 0; k0 < K; k0 += 64) {
      __syncthreads();
      GEMM_SSTORE(0);
      __syncthreads();
      if (k0 + 64 < K) GEMM_GLOAD(0, k0 + 64);
      compute();
    }
  }
#pragma unroll
  for (int mi = 0; mi < GEMM_MI; ++mi)
#pragma unroll
    for (int r = 0; r < 16; ++r) {
      int row = wm * (GEMM_BM / 2) + mi * 32 + (r & 3) + 8 * (r >> 2) + 4 * (lane >> 5);
      int col = wn * 64 + (lane & 31);
      epi(row, col, acc[mi][0][r], acc[mi][1][r]);
    }
}

template <int LAYER>
DEV void phase_gemm_in(const Params& p, char* smem) {
  const int N = LAYER == 0 ? AB_IN : CD_IN;
  const float* A = LAYER == 0 ? p.in[I_X] : (const float*)(p.ws + OFF_X2);
  const float* B = LAYER == 0 ? p.in[I_AB_W_IN] : p.in[I_CD_W_IN];
  float* C = (float*)(p.ws + OFF_H);
  const int NT = (N + 127) / 128, MT = NTOK / GEMM_BM;
  const int xcd_ = BIDX & 7, lb_ = BIDX >> 3, nb_ = gridDim.x >> 3;
  for (int j_ = lb_; j_ < (MT / 8) * NT; j_ += nb_) {
    const int it = (xcd_ + 8 * (j_ / NT)) * NT + (j_ % NT);
    const int tm = it / NT, tn = it % NT;
    const int m0 = tm * GEMM_BM, n0 = tn * 128;
    gemm_tile<LAYER == 1>(
        [&](int r) { return LAYER == 1 ? (const void*)((const unsigned short*)(p.ws + OFF_X2B) + (size_t)(m0 + r) * DM) : (const void*)(A + (size_t)(m0 + r) * DM); },
        [&](int c) { return (n0 + c < N) ? (B + n0 + c) : (const float*)nullptr; }, N, DM,
        [&](int row, int col, float v0, float v1) {
          const int gm = m0 + row, gc = n0 + col;
          if (LAYER == 1 && gc >= 1792 && gc < 2304) {
            const int i = gc & 63;
            const float pos = (float)(gm % SEQ_LEN);
            const float inv = __expf(-(float)i * (9.210340371976184f / 32.f));
            float sn, cs;
            fast_sincos(pos * inv, &sn, &cs);
            float o0 = v0 * cs - v1 * sn, o1 = v1 * cs + v0 * sn;
            if (gc >= 2048) { o0 *= 0.125f; o1 *= 0.125f; }
            v0 = o0; v1 = o1;
          }
          if (LAYER == 1) {
            float* dstp = gc < 1792 ? C + (size_t)gm * 1792 + gc : (float*)(p.ws + OFF_H2) + (size_t)gm * 1536 + (gc - 1792);
            dstp[0] = v0; dstp[32] = v1;
          } else {
            if (gc < N) C[(size_t)gm * AB_LD + gc] = v0;
            if (gc + 32 < N) C[(size_t)gm * AB_LD + gc + 32] = v1;
          }
        },
        smem);
  }
}

struct S5Const { float lb_re, lb_im; };
DEV void s5_consts(const Params& p, int g, int pp, float& lb_re, float& lb_im, float (&bbr)[16], float (&bbi)[16]) {
  const float dt = expf(p.in[I_S5_LOG_DT][g]);
  const float lr = p.in[I_S5_LAM_RE][g * 64 + pp], li = p.in[I_S5_LAM_IM][g * 64 + pp];
  const float mag = expf(lr * dt);
  float sn, cs;
  sincosf(li * dt, &sn, &cs);
  lb_re = mag * cs; lb_im = mag * sn;
  const float den = lr * lr + li * li;
  const float f_re = ((lb_re - 1.f) * lr + lb_im * li) / den;
  const float f_im = (lb_im * lr - (lb_re - 1.f) * li) / den;
  const float* br = p.in[I_S5_B_RE] + (size_t)(g * 64 + pp) * 16;
  const float* bi = p.in[I_S5_B_IM] + (size_t)(g * 64 + pp) * 16;
#pragma unroll
  for (int h = 0; h < 16; ++h) {
    bbr[h] = f_re * br[h] - f_im * bi[h];
    bbi[h] = f_re * bi[h] + f_im * br[h];
  }
}

#define OFF_QB OFF_X2
#define OFF_KSB (OFF_QB + (size_t)NTOK * 512 * 2)
#define OFF_KWB (OFF_KSB + (size_t)NTOK * 128 * 2)
#define OFF_VST (OFF_KWB + (size_t)NTOK * 128 * 2)
#define OFF_VWT (OFF_VST + (size_t)NTOK * 128 * 2)
#define OFF_KCB (OFF_VWT + (size_t)NTOK * 128 * 2)
#define OFF_VCT (OFF_KCB + (size_t)BATCH * 2 * NB_CMP * 64 * 64 * 2)
#define NSA_QSCALE (0.125f * 1.4426950408889634f)

#define P1_S5A_ITEMS (BATCH * 32 * S5_NC / 4)
#define P1_CMP_ITEMS (2 * BATCH * 2 * NB_CMP)
#define S5C_ROW 132
DEV bf16x8 pack_bf8(float4 a, float4 b) {
  union { uint4 u; bf16x8 v; } x;
  x.u = make_uint4(pk2(a.x, a.y), pk2(a.z, a.w), pk2(b.x, b.y), pk2(b.z, b.w));
  return x.v;
}
DEV void s5_bfrags(const Params& p, int g, int lane, bf16x8 (&bB)[4]) {
  const int hh = lane >> 5;
#pragma unroll
  for (int ct = 0; ct < 2; ++ct) {
    float lr, li, br_[16], bi_[16];
    s5_consts(p, g, 32 * ct + (lane & 31), lr, li, br_, bi_);
    bB[ct] = pack_bf8(make_float4(hh ? br_[8] : br_[0], hh ? br_[9] : br_[1], hh ? br_[10] : br_[2], hh ? br_[11] : br_[3]),
                      make_float4(hh ? br_[12] : br_[4], hh ? br_[13] : br_[5], hh ? br_[14] : br_[6], hh ? br_[15] : br_[7]));
    bB[2 + ct] = pack_bf8(make_float4(hh ? bi_[8] : bi_[0], hh ? bi_[9] : bi_[1], hh ? bi_[10] : bi_[2], hh ? bi_[11] : bi_[3]),
                          make_float4(hh ? bi_[12] : bi_[4], hh ? bi_[13] : bi_[5], hh ? bi_[14] : bi_[6], hh ? bi_[15] : bi_[7]));
  }
}
DEV void s5_subchunk(const float* su, float* sS, const bf16x8 (&bB)[4], float lb_re, float lb_im, float& sr, float& si, int lane) {
  {
    const int r = lane & 15, hh = lane >> 5, n = lane & 31;
    const bf16x8 a = pack_bf8(ld4(su + r * 16 + 8 * hh), ld4(su + r * 16 + 8 * hh + 4));
#pragma unroll
    for (int j = 0; j < 4; ++j) {
      f32x16 acc;
#pragma unroll
      for (int i = 0; i < 16; ++i) acc[i] = 0.f;
      acc = __builtin_amdgcn_mfma_f32_32x32x16_bf16(a, bB[j], acc, 0, 0, 0);
      const int col = (j >> 1) * 64 + (j & 1) * 32 + n;
#pragma unroll
      for (int r8 = 0; r8 < 8; ++r8) sS[((r8 & 3) + 8 * (r8 >> 2) + 4 * hh) * S5C_ROW + col] = acc[r8];
    }
  }
  WAVE_SYNC();
  for (int tt = 0; tt < 16; ++tt) {
    const float dr = sS[tt * S5C_ROW + lane], di = sS[tt * S5C_ROW + 64 + lane];
    const float nr = lb_re * sr - lb_im * si + dr, ni = lb_re * si + lb_im * sr + di;
    sr = nr; si = ni;
    sS[tt * S5C_ROW + lane] = sr;
    sS[tt * S5C_ROW + 64 + lane] = si;
  }
}
DEV void p1_s5a(const Params& p, int item, char* smem) {
  const int lane = TIDX & 63, wave = TIDX >> 6;
  const int idx = item * 4 + wave;
  const int g = idx & 31, c = (idx >> 5) % S5_NC, b = idx / (32 * S5_NC);
  float lb_re, lb_im;
  {
    float bbr[16], bbi[16];
    s5_consts(p, g, lane, lb_re, lb_im, bbr, bbi);
  }
  bf16x8 bB[4];
  s5_bfrags(p, g, lane, bB);
  const float* H = (const float*)(p.ws + OFF_H);
  float sr = 0.f, si = 0.f;
  float* sS = (float*)smem + wave * 16 * S5C_ROW;
  float* su = (float*)smem + 4 * 16 * S5C_ROW + wave * 16 * 16;
  __syncthreads();
  const float* ur0 = H + (size_t)(b * SEQ_LEN + c * 64 + (lane >> 2)) * AB_LD + g * 16 + (lane & 3) * 4;
  float4 unext = ld4(ur0);
  for (int sc = 0; sc < 4; ++sc) {
    st4(su + (lane >> 2) * 16 + (lane & 3) * 4, unext);
    if (sc + 1 < 4) unext = ld4(ur0 + (size_t)(sc + 1) * 16 * AB_LD);
    WAVE_SYNC();
    s5_subchunk(su, sS, bB, lb_re, lb_im, sr, si, lane);
    WAVE_SYNC();
  }
  float2* E = (float2*)(p.ws + OFF_S5E);
  E[((size_t)(b * S5_NC + c) * 32 + g) * 64 + lane] = make_float2(sr, si);
}
#define P1_CMPG_MT ((NCMP + GEMM_BM - 1) / GEMM_BM)
#define P1_CMPG_ITEMS (2 * BATCH * 2 * P1_CMPG_MT)
DEV void p1_cmpgemm(const Params& p, int item, char* smem) {
  const int mt = item % P1_CMPG_MT;
  int r = item / P1_CMPG_MT;
  const int g = r & 1; r >>= 1;
  const int b = r % BATCH; const int which = r / BATCH;
  const float* H = (const float*)(p.ws + OFF_H);
  const float* w1 = which ? p.in[I_CV_W1] : p.in[I_CK_W1];
  const int colbase = (which ? 1152 : 1024) + g * 64;
  float* HID = (float*)(p.ws + OFF_CMPHID) + ((size_t)(which * BATCH + b) * 2 + g) * NB_CMP * 64 * 128;
  const int n0 = mt * GEMM_BM;
  gemm_tile<false>(
      [&](int rr) { return (n0 + rr < NCMP) ? (const void*)(H + ((size_t)b * SEQ_LEN + 16 * (n0 + rr)) * AB_LD + colbase) : (const void*)nullptr; },
      [&](int c) { return w1 + c; }, 128, 2048,
      [&](int row, int col, float v0, float v1) {
        if (n0 + row < NCMP) { HID[(size_t)(n0 + row) * 128 + col] = v0; HID[(size_t)(n0 + row) * 128 + col + 32] = v1; }
      },
      smem, AB_LD);
}
#define P1_CMPC1_ITEMS 16
DEV void p1_cmpc1(const Params& p, int item, char* smem) {
  const int which = item >> 3, sl = item & 7;
  const float* pe = which ? p.in[I_PE_V] : p.in[I_PE_K];
  const float* w1 = which ? p.in[I_CV_W1] : p.in[I_CK_W1];
  float* sPart = (float*)smem;
  const int tid = TIDX, hid = tid & 127, kh = tid >> 7;
  float a = 0.f;
  const int k0 = sl * 256 + kh * 128;
#pragma unroll 16
  for (int k = k0; k < k0 + 128; ++k) a += pe[k] * w1[(size_t)k * 128 + hid];
  __syncthreads();
  sPart[tid] = a;
  __syncthreads();
  if (tid < 128) ((float*)(p.ws + OFF_CMPC1))[(which * 8 + sl) * 128 + tid] = sPart[tid] + sPart[tid + 128];
  __syncthreads();
}
DEV void p1_compress(const Params& p, int item, char* smem) {
  const int tile = item % NB_CMP;
  int r = item / NB_CMP;
  const int g = r & 1; r >>= 1;
  const int b = r % BATCH; const int which = r / BATCH;
  const float* b1 = which ? p.in[I_CV_B1] : p.in[I_CK_B1];
  const float* w2 = which ? p.in[I_CV_W2] : p.in[I_CK_W2];
  const float* C1P = (const float*)(p.ws + OFF_CMPC1) + which * 8 * 128;
  const float* HID = (const float*)(p.ws + OFF_CMPHID) + ((size_t)(which * BATCH + b) * 2 + g) * NB_CMP * 64 * 128;
  float* sOut = (float*)smem;
  float* sHid = sOut + 8 * 64;
  float* sAll = sHid + 8 * 128;
  float* sC1 = sAll + 64 * 65;
  const int tid = TIDX;
  __syncthreads();
  if (tid < 128) {
    const float* q = C1P + tid;
    sC1[tid] = (((((((q[0] + q[128]) + q[256]) + q[384]) + q[512]) + q[640]) + q[768]) + q[896]) + b1[tid];
  }
  float* dst = (float*)(p.ws + (which ? OFF_VCMP : OFF_KCMP));
#pragma unroll 1
  for (int r8 = 0; r8 < 8; ++r8) {
    const int n0 = tile * 64 + r8 * 8;
    __syncthreads();
    for (int w = tid; w < 8 * 128; w += NTHREADS) {
      const int rr = w >> 7, hid = w & 127;
      const int n = n0 + rr;
      sHid[w] = n < NCMP ? geluf_(HID[(size_t)n * 128 + hid] + sC1[hid]) : 0.f;
    }
    __syncthreads();
    for (int w = tid; w < 8 * 64; w += NTHREADS) {
      const int rr = w >> 6, d = w & 63;
      float a = 0.f;
      for (int hid = 0; hid < 128; ++hid) a += sHid[rr * 128 + hid] * w2[hid * 64 + d];
      sOut[w] = a;
    }
    __syncthreads();
    for (int w = tid; w < 8 * 64; w += NTHREADS) {
      const int rr = w >> 6, d = w & 63;
      const int n = n0 + rr;
      float v = sOut[w];
      if (which == 0 && d < 16) {
        const int i = d & 7;
        const float pos = (float)(n * 16 + 31);
        const float inv = __expf(-(float)i * (13.122363377404328f / 8.f));
        float sn, cs;
        sincosf(pos * inv, &sn, &cs);
        const float x1 = sOut[rr * 64 + i], x2 = sOut[rr * 64 + i + 8];
        v = d < 8 ? x1 * cs - x2 * sn : x2 * cs + x1 * sn;
      }
      if (n >= NCMP) v = 0.f;
      sAll[(r8 * 8 + rr) * 65 + d] = v;
      if (n < NCMP) dst[((size_t)(b * NCMP + n) * 2 + g) * 64 + d] = v;
    }
  }
  __syncthreads();
  if (which == 0) {
    unsigned short* KCB = (unsigned short*)(p.ws + OFF_KCB) + (((size_t)b * 2 + g) * NB_CMP * 64 + tile * 64) * 64;
    for (int w = tid; w < 64 * 8; w += NTHREADS) {
      const int nl = w >> 3, o = w & 7;
      float v[8];
#pragma unroll
      for (int q = 0; q < 8; ++q) v[q] = sAll[nl * 65 + o * 8 + q];
      *(uint4*)(KCB + nl * 64 + o * 8) = make_uint4(pk2(v[0], v[1]), pk2(v[2], v[3]), pk2(v[4], v[5]), pk2(v[6], v[7]));
    }
  } else {
    unsigned short* VCT = (unsigned short*)(p.ws + OFF_VCT) + (((size_t)b * 2 + g) * NB_CMP + tile) * 64 * 64;
    for (int w = tid; w < 64 * 8; w += NTHREADS) {
      const int d = w >> 3, o = w & 7;
      float v[8];
#pragma unroll
      for (int q = 0; q < 8; ++q) v[q] = sAll[(o * 8 + q) * 65 + d];
      *(uint4*)(VCT + d * 64 + o * 8) = make_uint4(pk2(v[0], v[1]), pk2(v[2], v[3]), pk2(v[4], v[5]), pk2(v[6], v[7]));
    }
  }
}
DEV uint4 pack8(const float* v) {
  uint4 r;
  r.x = (unsigned)f2bf(v[0]) | ((unsigned)f2bf(v[1]) << 16);
  r.y = (unsigned)f2bf(v[2]) | ((unsigned)f2bf(v[3]) << 16);
  r.z = (unsigned)f2bf(v[4]) | ((unsigned)f2bf(v[5]) << 16);
  r.w = (unsigned)f2bf(v[6]) | ((unsigned)f2bf(v[7]) << 16);
  return r;
}
#define P1_PREP_ITEMS (NTOK / 64)
#define P1_PREP_SMEM ((64 * 8 * 2 + 64 * 128) * 4)
DEV void p1_prep(const Params& p, int item, char* smem) {
  const int tid = TIDX;
  const int b = item / NBLK, blk = item % NBLK;
  const float* H = (const float*)(p.ws + OFF_H);
  float* sCS = (float*)smem;
  float* sV = sCS + 64 * 8 * 2;
  const size_t tok0 = (size_t)b * SEQ_LEN + blk * 64;
  __syncthreads();
  for (int w = tid; w < 64 * 8; w += NTHREADS) {
    const int tk = w >> 3, i = w & 7;
    const float pos = (float)(blk * 64 + tk);
    const float inv = __expf(-(float)i * (13.122363377404328f / 8.f));
    float sn, cs;
    sincosf(pos * inv, &sn, &cs);
    sCS[w * 2] = cs; sCS[w * 2 + 1] = sn;
  }
  __syncthreads();
  unsigned short* QB = (unsigned short*)(p.ws + OFF_QB);
  unsigned short* KSB = (unsigned short*)(p.ws + OFF_KSB);
  unsigned short* KWB = (unsigned short*)(p.ws + OFF_KWB);
  for (int w = tid; w < 64 * 12 * 8; w += NTHREADS) {
    const int o = w & 7, hd = (w >> 3) % 12, tk = w / 96;
    const int col = hd < 8 ? 512 + hd * 64 : (hd < 10 ? 1280 + (hd - 8) * 64 : 1536 + (hd - 10) * 64);
    const float* x = H + (tok0 + tk) * AB_LD + col;
    float v[8];
    const float4 a0 = ld4(x + o * 8), a1 = ld4(x + o * 8 + 4);
    v[0] = a0.x; v[1] = a0.y; v[2] = a0.z; v[3] = a0.w; v[4] = a1.x; v[5] = a1.y; v[6] = a1.z; v[7] = a1.w;
    if (o < 2) {
      const float4 c0 = ld4(x + (1 - o) * 8), c1 = ld4(x + (1 - o) * 8 + 4);
      const float u[8] = {c0.x, c0.y, c0.z, c0.w, c1.x, c1.y, c1.z, c1.w};
#pragma unroll
      for (int i = 0; i < 8; ++i) {
        const float cs = sCS[(tk * 8 + i) * 2], sn = sCS[(tk * 8 + i) * 2 + 1];
        v[i] = o == 0 ? v[i] * cs - u[i] * sn : v[i] * cs + u[i] * sn;
      }
    }
    if (hd < 8) {
#pragma unroll
      for (int i = 0; i < 8; ++i) v[i] *= NSA_QSCALE;
      *(uint4*)(QB + ((tok0 + tk) * 8 + hd) * 64 + o * 8) = pack8(v);
    } else {
      const int g = (hd - 8) & 1;
      unsigned short* dst = (hd < 10 ? KSB : KWB) + (((size_t)b * 2 + g) * SEQ_LEN + blk * 64 + tk) * 64 + o * 8;
      *(uint4*)dst = pack8(v);
    }
  }
#pragma unroll 1
  for (int which = 0; which < 2; ++which) {
    const int col = which ? 1664 : 1408;
    __syncthreads();
    for (int w = tid; w < 64 * 32; w += NTHREADS) {
      const int tk = w >> 5, c4 = (w & 31) * 4;
      st4(sV + tk * 128 + c4, ld4(H + (tok0 + tk) * AB_LD + col + c4));
    }
    __syncthreads();
    unsigned short* VT = (unsigned short*)(p.ws + (which ? OFF_VWT : OFF_VST));
    for (int w = tid; w < 2 * 64 * 8; w += NTHREADS) {
      const int ko = w & 7, d = (w >> 3) & 63, g = w >> 9;
      float v[8];
#pragma unroll
      for (int i = 0; i < 8; ++i) v[i] = sV[(ko * 8 + i) * 128 + g * 64 + d];
      *(uint4*)(VT + ((((size_t)b * 2 + g) * NBLK + blk) * 64 + d) * 64 + ko * 8) = pack8(v);
    }
  }
}

struct NsaSmem {
  unsigned short k[64][72];
  unsigned short vt[64][68];
  float imp[32][128];
  unsigned selmask[32][4];
  unsigned unionm[4];
  float keyb[4][128];
};
#define P2_NSA_SMEM ((int)sizeof(NsaSmem))
#define NSA_QT (SEQ_LEN / 32)
#define P2_NSA_ITEMS (BATCH * 2 * NSA_QT)

struct TileRegs { uint4 k0, k1, v0, v1; };
DEV void tile_gload(TileRegs& r, const unsigned short* Kg, const unsigned short* Vg, int tid) {
  const int row = tid >> 2, seg = tid & 3;
  r.k0 = *(const uint4*)(Kg + row * 64 + seg * 16);
  r.k1 = *(const uint4*)(Kg + row * 64 + seg * 16 + 8);
  if (Vg) {
    r.v0 = *(const uint4*)(Vg + row * 64 + seg * 16);
    r.v1 = *(const uint4*)(Vg + row * 64 + seg * 16 + 8);
  }
}
DEV void tile_sstore(NsaSmem* sm, const TileRegs& r, bool withV, int tid) {
  const int row = tid >> 2, seg = tid & 3;
  *(uint4*)&sm->k[row][seg * 16] = r.k0;
  *(uint4*)&sm->k[row][seg * 16 + 8] = r.k1;
  if (withV) {
    *(uint2*)&sm->vt[row][seg * 16] = make_uint2(r.v0.x, r.v0.y);
    *(uint2*)&sm->vt[row][seg * 16 + 4] = make_uint2(r.v0.z, r.v0.w);
    *(uint2*)&sm->vt[row][seg * 16 + 8] = make_uint2(r.v1.x, r.v1.y);
    *(uint2*)&sm->vt[row][seg * 16 + 12] = make_uint2(r.v1.z, r.v1.w);
  }
}
DEV void qk_tile(const unsigned short (*ksm)[72], const bf16x8 (&qf)[4], f32x16 (&s)[2], int lane) {
  const int r = lane & 31, hh = lane >> 5;
#pragma unroll
  for (int ks2 = 0; ks2 < 2; ++ks2) {
#pragma unroll
    for (int i = 0; i < 16; ++i) s[ks2][i] = 0.f;
#pragma unroll
    for (int ks = 0; ks < 4; ++ks) {
      const bf16x8 a = *(const bf16x8*)&ksm[ks2 * 32 + r][ks * 16 + hh * 8];
      s[ks2] = __builtin_amdgcn_mfma_f32_32x32x16_bf16(a, qf[ks], s[ks2], 0, 0, 0);
    }
  }
}
DEV void pv_tile(const unsigned short (*vsm)[68], const f32x16 (&pr)[2], f32x16 (&o)[2], int lane) {
  const int r = lane & 31, hh = lane >> 5;
#pragma unroll
  for (int ks2 = 0; ks2 < 2; ++ks2)
#pragma unroll
    for (int s = 0; s < 2; ++s) {
      union { uint4 u; bf16x8 v; } pfu;
      pfu.u = make_uint4(pk2(pr[ks2][8 * s], pr[ks2][8 * s + 1]), pk2(pr[ks2][8 * s + 2], pr[ks2][8 * s + 3]),
                         pk2(pr[ks2][8 * s + 4], pr[ks2][8 * s + 5]), pk2(pr[ks2][8 * s + 6], pr[ks2][8 * s + 7]));
      const bf16x8 pf = pfu.v;
#pragma unroll
      for (int mt = 0; mt < 2; ++mt) {
        const uint2 lo = *(const uint2*)&vsm[mt * 32 + r][ks2 * 32 + 16 * s + 4 * hh];
        const uint2 hi = *(const uint2*)&vsm[mt * 32 + r][ks2 * 32 + 16 * s + 8 + 4 * hh];
        union { uint4 u; bf16x8 v; } au;
        au.u = make_uint4(lo.x, lo.y, hi.x, hi.y);
        const bf16x8 a = au.v;
        o[mt] = __builtin_amdgcn_mfma_f32_32x32x16_bf16(a, pf, o[mt], 0, 0, 0);
      }
    }
}
DEV float quad_sum(float v) {
#ifdef CPU_EMU
  v += __shfl_xor(v, 1); v += __shfl_xor(v, 2); return v;
#else
  int x;
  x = __builtin_amdgcn_update_dpp(0, __builtin_bit_cast(int, v), 0xB1, 0xF, 0xF, false); v += __builtin_bit_cast(float, x);
  x = __builtin_amdgcn_update_dpp(0, __builtin_bit_cast(int, v), 0x4E, 0xF, 0xF, false); v += __builtin_bit_cast(float, x);
  return v;
#endif
}
DEV void softmax_step(f32x16 (&s)[2], float& m, float& l, f32x16 (&o)[2]) {
  float tmax = -INFINITY;
#pragma unroll
  for (int ks2 = 0; ks2 < 2; ++ks2)
#pragma unroll
    for (int i = 0; i < 16; ++i) tmax = fmaxf(tmax, s[ks2][i]);
  tmax = fmaxf(tmax, __shfl_xor(tmax, 32));
  const float mnew = fmaxf(m, tmax);
  const float msafe = mnew == -INFINITY ? 0.f : mnew;
  const float alpha = fexp2(m - msafe);
  float ps = 0.f;
#pragma unroll
  for (int ks2 = 0; ks2 < 2; ++ks2)
#pragma unroll
    for (int i = 0; i < 16; ++i) { s[ks2][i] = fexp2(s[ks2][i] - msafe); ps += s[ks2][i]; }
  l = l * alpha + ps;
#pragma unroll
  for (int mt = 0; mt < 2; ++mt)
#pragma unroll
    for (int i = 0; i < 16; ++i) o[mt][i] *= alpha;
  m = mnew;
}
DEV bool testbit4(unsigned w0, unsigned w1, unsigned w2, unsigned w3, int j) {
  const unsigned lo = j & 32 ? w1 : w0, hi = j & 32 ? w3 : w2;
  const unsigned x = j & 64 ? hi : lo;
  return (x >> (j & 31)) & 1u;
}

DEV void p2_nsa(const Params& p, int item, char* smem) {
  NsaSmem* sm = (NsaSmem*)smem;
  const int tid = TIDX, lane = tid & 63, wave = tid >> 6;
  const int bg = item & 3, b = bg >> 1, g = bg & 1;
  const int qt = NSA_QT - 1 - (item >> 2);
  const int t0 = qt * 32;
  const int c = lane & 31, hh = lane >> 5, tl = c >> 2, h = c & 3;
  const int trow = wave * 8 + tl;
  const int tq = t0 + trow;
  const size_t tok = (size_t)b * SEQ_LEN + tq;
  const int hd = g * 4 + h;
  const float* H = (const float*)(p.ws + OFF_H);
  const unsigned short* QB = (const unsigned short*)(p.ws + OFF_QB);
  const unsigned short* KSB = (const unsigned short*)(p.ws + OFF_KSB) + ((size_t)b * 2 + g) * SEQ_LEN * 64;
  const unsigned short* KWB = (const unsigned short*)(p.ws + OFF_KWB) + ((size_t)b * 2 + g) * SEQ_LEN * 64;
  const unsigned short* VST = (const unsigned short*)(p.ws + OFF_VST) + ((size_t)b * 2 + g) * NBLK * 4096;
  const unsigned short* VWT = (const unsigned short*)(p.ws + OFF_VWT) + ((size_t)b * 2 + g) * NBLK * 4096;
  const unsigned short* KCB = (const unsigned short*)(p.ws + OFF_KCB) + ((size_t)b * 2 + g) * NB_CMP * 4096;
  const unsigned short* VCT = (const unsigned short*)(p.ws + OFF_VCT) + ((size_t)b * 2 + g) * NB_CMP * 4096;
  bf16x8 qf[4];
  {
    const unsigned short* qrow = QB + (tok * 8 + hd) * 64;
#pragma unroll
    for (int ks = 0; ks < 4; ++ks) qf[ks] = *(const bf16x8*)(qrow + ks * 16 + hh * 8);
  }
  const float g0 = sigmoidf_(H[tok * AB_LD + 1792 + hd * 3 + 0]);
  const float g1 = sigmoidf_(H[tok * AB_LD + 1792 + hd * 3 + 1]);
  const float g2 = sigmoidf_(H[tok * AB_LD + 1792 + hd * 3 + 2]);
  f32x16 o[2], s[2];
#pragma unroll
  for (int mt = 0; mt < 2; ++mt)
#pragma unroll
    for (int i = 0; i < 16; ++i) o[mt][i] = 0.f;
  float* mixrow = (float*)(p.ws + OFF_MIX) + tok * 1024 + 512 + hd * 64 + 4 * hh;
  __syncthreads();
  for (int w = tid; w < 32 * 128; w += NTHREADS) (&sm->imp[0][0])[w] = 0.f;
  TileRegs tr;
  tr.k0 = tr.k1 = tr.v0 = tr.v1 = make_uint4(0, 0, 0, 0);
  const int nval = tq >= 31 ? (tq - 31) / 16 + 1 : 0;
  const int nvmax = (t0 + 31 - 31) / 16 + 1;
  const int ktn = (nvmax + 63) / 64;
  float m = -INFINITY, l = 0.f;
  tile_gload(tr, KCB, nullptr, tid);
  for (int kt = 0; kt < ktn; ++kt) {
    __syncthreads();
    tile_sstore(sm, tr, false, tid);
    __syncthreads();
    if (kt + 1 < ktn) tile_gload(tr, KCB + (size_t)(kt + 1) * 4096, nullptr, tid);
    qk_tile(sm->k, qf, s, lane);
    float tmax = -INFINITY;
#pragma unroll
    for (int ks2 = 0; ks2 < 2; ++ks2)
#pragma unroll
      for (int i = 0; i < 16; ++i) {
        const int n = kt * 64 + ks2 * 32 + (i & 3) + 8 * (i >> 2) + 4 * hh;
        s[ks2][i] = n < nval ? s[ks2][i] : -INFINITY;
        tmax = fmaxf(tmax, s[ks2][i]);
      }
    tmax = fmaxf(tmax, __shfl_xor(tmax, 32));
    const float mnew = fmaxf(m, tmax);
    const float msafe = mnew == -INFINITY ? 0.f : mnew;
    float ps = 0.f;
#pragma unroll
    for (int ks2 = 0; ks2 < 2; ++ks2)
#pragma unroll
      for (int i = 0; i < 16; ++i) ps += fexp2(s[ks2][i] - msafe);
    l = l * fexp2(m - msafe) + ps;
    m = mnew;
  }
  {
    const float ltot = l + __shfl_xor(l, 32);
    const float invl = ltot > 0.f ? 1.f / ltot : 0.f;
    const float msafe = m == -INFINITY ? 0.f : m;
    tile_gload(tr, KCB, VCT, tid);
    for (int kt = 0; kt < ktn; ++kt) {
      __syncthreads();
      tile_sstore(sm, tr, true, tid);
      __syncthreads();
      if (kt + 1 < ktn) tile_gload(tr, KCB + (size_t)(kt + 1) * 4096, VCT + (size_t)(kt + 1) * 4096, tid);
      qk_tile(sm->k, qf, s, lane);
#pragma unroll
      for (int ks2 = 0; ks2 < 2; ++ks2)
#pragma unroll
        for (int i = 0; i < 16; ++i) {
          const int n = kt * 64 + ks2 * 32 + (i & 3) + 8 * (i >> 2) + 4 * hh;
          s[ks2][i] = n < nval ? fexp2(s[ks2][i] - msafe) * invl : 0.f;
        }
#pragma unroll
      for (int ks2 = 0; ks2 < 2; ++ks2)
#pragma unroll
        for (int g4 = 0; g4 < 4; ++g4) {
          float A = 2.f * (s[ks2][4 * g4] + s[ks2][4 * g4 + 1] + s[ks2][4 * g4 + 2]) + s[ks2][4 * g4 + 3];
          float Bv = s[ks2][4 * g4 + 3];
          A = quad_sum(A); Bv = quad_sum(Bv);
          const int j = kt * 16 + ks2 * 8 + 2 * g4 + hh;
          if (h == 0 && j < NBLK) sm->imp[trow][j] += A;
          WAVE_SYNC();
          if (h == 0 && j + 1 < NBLK) sm->imp[trow][j + 1] += Bv;
          WAVE_SYNC();
        }
      pv_tile(sm->vt, s, o, lane);
    }
#pragma unroll
    for (int mt = 0; mt < 2; ++mt)
#pragma unroll
      for (int g4 = 0; g4 < 4; ++g4) {
        st4(mixrow + mt * 32 + 8 * g4, make_float4(o[mt][4 * g4] * g0, o[mt][4 * g4 + 1] * g0, o[mt][4 * g4 + 2] * g0, o[mt][4 * g4 + 3] * g0));
        o[mt][4 * g4] = 0.f; o[mt][4 * g4 + 1] = 0.f; o[mt][4 * g4 + 2] = 0.f; o[mt][4 * g4 + 3] = 0.f;
      }
  }
  WAVE_SYNC();
  for (int t8 = 0; t8 < 8; ++t8) {
    const int row = wave * 8 + t8, tt = t0 + row, cur = tt >> 6;
    float kv[2]; bool valid[2];
#pragma unroll
    for (int c2 = 0; c2 < 2; ++c2) {
      const int j = lane + 64 * c2;
      valid[c2] = j < NBLK && j <= cur;
      const bool forced = (j == 0) | (j == cur) | (j == cur - 1);
      kv[c2] = valid[c2] ? (forced ? 1e6f : sm->imp[row][j < NBLK ? j : 0]) : -1.f;
      sm->keyb[wave][j] = kv[c2];
    }
    WAVE_SYNC();
    int rank0 = 0, rank1 = 0;
    const int jlim = cur < NBLK - 1 ? cur : NBLK - 1;
    for (int jj = 0; jj <= jlim; ++jj) {
      const float ov = sm->keyb[wave][jj];
      rank0 += (ov > kv[0] || (ov == kv[0] && jj < lane)) ? 1 : 0;
      rank1 += (ov > kv[1] || (ov == kv[1] && jj < lane + 64)) ? 1 : 0;
    }
    const unsigned long long m0 = __ballot(valid[0] && rank0 < 16);
    const unsigned long long m1 = __ballot(valid[1] && rank1 < 16);
    if (lane == 0) {
      sm->selmask[row][0] = (unsigned)m0; sm->selmask[row][1] = (unsigned)(m0 >> 32);
      sm->selmask[row][2] = (unsigned)m1; sm->selmask[row][3] = (unsigned)(m1 >> 32);
    }
    WAVE_SYNC();
  }
  __syncthreads();
  if (tid < 4) {
    unsigned u = 0;
    for (int r = 0; r < 32; ++r) u |= sm->selmask[r][tid];
    sm->unionm[tid] = u;
  }
  __syncthreads();
  const unsigned um0 = sm->unionm[0], um1 = sm->unionm[1], um2 = sm->unionm[2], um3 = sm->unionm[3];
  const unsigned my0 = sm->selmask[trow][0], my1 = sm->selmask[trow][1], my2 = sm->selmask[trow][2], my3 = sm->selmask[trow][3];
  {
    const int jmax = (t0 + 31) >> 6;
    int j = 0;
    while (j <= jmax && !testbit4(um0, um1, um2, um3, j)) ++j;
    m = -INFINITY; l = 0.f;
    if (j <= jmax) tile_gload(tr, KSB + (size_t)j * 4096, VST + (size_t)j * 4096, tid);
    while (j <= jmax) {
      __syncthreads();
      tile_sstore(sm, tr, true, tid);
      __syncthreads();
      int jn = j + 1;
      while (jn <= jmax && !testbit4(um0, um1, um2, um3, jn)) ++jn;
      if (jn <= jmax) tile_gload(tr, KSB + (size_t)jn * 4096, VST + (size_t)jn * 4096, tid);
      const bool mine = testbit4(my0, my1, my2, my3, j);
      if (__ballot(mine) != 0ull) {
        qk_tile(sm->k, qf, s, lane);
#pragma unroll
        for (int ks2 = 0; ks2 < 2; ++ks2)
#pragma unroll
          for (int i = 0; i < 16; ++i) {
            const int kp = j * 64 + ks2 * 32 + (i & 3) + 8 * (i >> 2) + 4 * hh;
            s[ks2][i] = (mine && kp <= tq) ? s[ks2][i] : -INFINITY;
          }
        softmax_step(s, m, l, o);
        pv_tile(sm->vt, s, o, lane);
      }
      j = jn;
    }
    const float ltot = l + __shfl_xor(l, 32);
    const float sc = ltot > 0.f ? g1 / ltot : 0.f;
#pragma unroll
    for (int mt = 0; mt < 2; ++mt)
#pragma unroll
      for (int g4 = 0; g4 < 4; ++g4) {
        float4 a = ld4(mixrow + mt * 32 + 8 * g4);
        a.x += o[mt][4 * g4] * sc; a.y += o[mt][4 * g4 + 1] * sc; a.z += o[mt][4 * g4 + 2] * sc; a.w += o[mt][4 * g4 + 3] * sc;
        st4(mixrow + mt * 32 + 8 * g4, a);
        o[mt][4 * g4] = 0.f; o[mt][4 * g4 + 1] = 0.f; o[mt][4 * g4 + 2] = 0.f; o[mt][4 * g4 + 3] = 0.f;
      }
  }
  {
    const int jlo = t0 - 511 > 0 ? (t0 - 511) >> 6 : 0, jhi = (t0 + 31) >> 6;
    const int wq0 = t0 + wave * 8;
    m = -INFINITY; l = 0.f;
    tile_gload(tr, KWB + (size_t)jlo * 4096, VWT + (size_t)jlo * 4096, tid);
    for (int j = jlo; j <= jhi; ++j) {
      __syncthreads();
      tile_sstore(sm, tr, true, tid);
      __syncthreads();
      if (j + 1 <= jhi) tile_gload(tr, KWB + (size_t)(j + 1) * 4096, VWT + (size_t)(j + 1) * 4096, tid);
      if (j * 64 <= wq0 + 7 && j * 64 + 63 > wq0 - 512) {
        qk_tile(sm->k, qf, s, lane);
#pragma unroll
        for (int ks2 = 0; ks2 < 2; ++ks2)
#pragma unroll
          for (int i = 0; i < 16; ++i) {
            const int kp = j * 64 + ks2 * 32 + (i & 3) + 8 * (i >> 2) + 4 * hh;
            s[ks2][i] = (kp <= tq && kp > tq - 512) ? s[ks2][i] : -INFINITY;
          }
        softmax_step(s, m, l, o);
        pv_tile(sm->vt, s, o, lane);
      }
    }
    const float ltot = l + __shfl_xor(l, 32);
    const float sc = ltot > 0.f ? g2 / ltot : 0.f;
#pragma unroll
    for (int mt = 0; mt < 2; ++mt)
#pragma unroll
      for (int g4 = 0; g4 < 4; ++g4) {
        float4 a = ld4(mixrow + mt * 32 + 8 * g4);
        a.x += o[mt][4 * g4] * sc; a.y += o[mt][4 * g4 + 1] * sc; a.z += o[mt][4 * g4 + 2] * sc; a.w += o[mt][4 * g4 + 3] * sc;
        st4(mixrow + mt * 32 + 8 * g4, a);
        o[mt][4 * g4] = 0.f; o[mt][4 * g4 + 1] = 0.f; o[mt][4 * g4 + 2] = 0.f; o[mt][4 * g4 + 3] = 0.f;
      }
  }
}

#define P1_SMEM ((8 * 64 + 8 * 128 + 64 * 65 + 128) * 4)
DEV void phase_p1(const Params& p, char* smem) {
  const int total = P1_CMPG_ITEMS + P1_CMPC1_ITEMS + P1_PREP_ITEMS;
  for (int it = BIDX; it < total; it += gridDim.x) {
    if (it < P1_CMPG_ITEMS) p1_cmpgemm(p, it, smem);
    else if (it < P1_CMPG_ITEMS + P1_CMPC1_ITEMS) p1_cmpc1(p, it - P1_CMPG_ITEMS, smem);
    else p1_prep(p, it - P1_CMPG_ITEMS - P1_CMPC1_ITEMS, smem);
  }
  {
    const int Gh = (int)gridDim.x / 2, bid_ = BIDX;
    if (bid_ < Gh) for (int it = bid_; it < P1_S5A_ITEMS; it += Gh) p1_s5a(p, it, smem);
  }
}
#define S5PFX_ITEMS (BATCH * 32 * 64 / NTHREADS)
DEV void s5_prefix(const Params& p, int item) {
  const int gi = item * NTHREADS + TIDX;
  const int lane = gi & 63, g = (gi >> 6) & 31, b = gi >> 11;
  float lb_re, lb_im, bbr[16], bbi[16];
  s5_consts(p, g, lane, lb_re, lb_im, bbr, bbi);
  float ar = lb_re, ai = lb_im;
#pragma unroll
  for (int s = 0; s < 6; ++s) { const float nr = ar * ar - ai * ai, ni = 2.f * ar * ai; ar = nr; ai = ni; }
  float2* E = (float2*)(p.ws + OFF_S5E) + ((size_t)b * S5_NC * 32 + g) * 64 + lane;
  float sr = 0.f, si = 0.f;
  for (int c = 0; c < S5_NC; c += 8) {
    float2 e[8];
#pragma unroll
    for (int q = 0; q < 8; ++q) e[q] = E[(size_t)(c + q) * 32 * 64];
#pragma unroll
    for (int q = 0; q < 8; ++q) {
      E[(size_t)(c + q) * 32 * 64] = make_float2(sr, si);
      const float nr = ar * sr - ai * si + e[q].x, ni = ar * si + ai * sr + e[q].y;
      sr = nr; si = ni;
    }
  }
}
DEV void phase_p1b(const Params& p, char* smem) {
  for (int it = BIDX; it < P1_CMP_ITEMS; it += gridDim.x) p1_compress(p, it, smem);
  for (int it = (int)gridDim.x - 1 - (int)BIDX; it < S5PFX_ITEMS; it += gridDim.x) s5_prefix(p, it);
}

#define P2_S5C_ITEMS (BATCH * 32 * S5_NC / 4)
#define P2_S5C_SMEM ((4 * 16 * S5C_ROW + 2 * 16 * 64 + 4 * 16 * 16) * 4)
DEV void p2_s5c(const Params& p, int item, char* smem) {
  const int lane = TIDX & 63, wave = TIDX >> 6, tid = TIDX;
  const int g = item & 31, c = ((item >> 5) % (S5_NC / 4)) * 4 + wave, b = item / (32 * (S5_NC / 4));
  float lb_re, lb_im;
  {
    float bbr[16], bbi[16];
    s5_consts(p, g, lane, lb_re, lb_im, bbr, bbi);
  }
  bf16x8 bB[4];
  s5_bfrags(p, g, lane, bB);
  const float2* E = (const float2*)(p.ws + OFF_S5E);
  const float2 e0 = E[((size_t)(b * S5_NC + c) * 32 + g) * 64 + lane];
  float sr = e0.x, si = e0.y;
  const float* H = (const float*)(p.ws + OFF_H);
  float* sS = (float*)smem + wave * 16 * S5C_ROW;
  float* sCre = (float*)smem + 4 * 16 * S5C_ROW;
  float* sCim = sCre + 16 * 64;
  float* su = sCim + 16 * 64 + wave * 16 * 16;
  __syncthreads();
  {
    const float* cre = p.in[I_S5_C_RE] + (size_t)g * 16 * 64;
    const float* cim = p.in[I_S5_C_IM] + (size_t)g * 16 * 64;
    st4(sCre + tid * 4, ld4(cre + tid * 4));
    st4(sCim + tid * 4, ld4(cim + tid * 4));
  }
  __syncthreads();
  const int nn = lane & 15, hh = lane >> 5;
  bf16x8 bC[8];
#pragma unroll
  for (int ks = 0; ks < 8; ++ks) {
    const float* src = (ks < 4 ? sCre : sCim) + nn * 64 + 16 * (ks & 3) + 8 * hh;
    float4 c0 = ld4(src), c1 = ld4(src + 4);
    if (ks >= 4) { c0 = make_float4(-c0.x, -c0.y, -c0.z, -c0.w); c1 = make_float4(-c1.x, -c1.y, -c1.z, -c1.w); }
    bC[ks] = pack_bf8(c0, c1);
  }
  const float dch = p.in[I_S5_D][g * 16 + nn];
  float* YG = (float*)(p.ws + OFF_YGELU);
  const float* ur0 = H + (size_t)(b * SEQ_LEN + c * 64 + (lane >> 2)) * AB_LD + g * 16 + (lane & 3) * 4;
  float4 unext = ld4(ur0);
  for (int sc = 0; sc < 4; ++sc) {
    st4(su + (lane >> 2) * 16 + (lane & 3) * 4, unext);
    if (sc + 1 < 4) unext = ld4(ur0 + (size_t)(sc + 1) * 16 * AB_LD);
    WAVE_SYNC();
    s5_subchunk(su, sS, bB, lb_re, lb_im, sr, si, lane);
    WAVE_SYNC();
    {
      f32x16 acc;
#pragma unroll
      for (int i = 0; i < 16; ++i) acc[i] = 0.f;
      const float* arow = sS + nn * S5C_ROW + 8 * hh;
#pragma unroll
      for (int ks = 0; ks < 8; ++ks) {
        const float* src = arow + 16 * ks;
        acc = __builtin_amdgcn_mfma_f32_32x32x16_bf16(pack_bf8(ld4(src), ld4(src + 4)), bC[ks], acc, 0, 0, 0);
      }
      if ((lane & 16) == 0) {
#pragma unroll
        for (int r8 = 0; r8 < 8; ++r8) {
          const int t = (r8 & 3) + 8 * (r8 >> 2) + 4 * hh;
          const size_t tok = (size_t)(b * SEQ_LEN + c * 64 + sc * 16 + t);
          YG[tok * 512 + g * 16 + nn] = geluf_(acc[r8] + dch * su[t * 16 + nn]);
        }
      }
    }
    WAVE_SYNC();
  }
}

#define P2_SMEM (P2_S5C_SMEM > P2_NSA_SMEM ? P2_S5C_SMEM : P2_NSA_SMEM)
DEV void phase_p2(const Params& p, char* smem) {
  const int G = gridDim.x;
  const int total = P2_NSA_ITEMS + P2_S5C_ITEMS;
  for (int r = 0;; ++r) {
    const int it = r * G + ((r & 1) ? (G - 1 - (int)BIDX) : (int)BIDX);
    if (r * G >= total) break;
    if (it >= total) continue;
    if (it < P2_NSA_ITEMS) p2_nsa(p, it, smem);
    else p2_s5c(p, it - P2_NSA_ITEMS, smem);
  }
}

DEV void phase_glu(const Params& p, char* smem) {
  const float* A = (const float*)(p.ws + OFF_YGELU);
  const float* B = p.in[I_S5_W_GLU];
  const float* bias = p.in[I_S5_B_GLU];
  float* MIX = (float*)(p.ws + OFF_MIX);
  const int NT = 4, MT = NTOK / GEMM_BM;
  const int xcd_ = BIDX & 7, lb_ = BIDX >> 3, nb_ = gridDim.x >> 3;
  for (int j_ = lb_; j_ < (MT / 8) * NT; j_ += nb_) {
    const int it = (xcd_ + 8 * (j_ / NT)) * NT + (j_ % NT);
    const int m0 = (it / NT) * GEMM_BM, n0 = (it % NT) * 128;
    gemm_tile<false>(
        [&](int r) { return (const void*)(A + (size_t)(m0 + r) * 512); },
        [&](int c) { return B + n0 + c; }, 512, 512,
        [&](int row, int col, float v0, float v1) {
          const size_t gm = m0 + row; const int gc = n0 + col;
          const float y0 = A[gm * 512 + gc], y1 = A[gm * 512 + gc + 32];
          MIX[gm * 1024 + gc] = y0 * sigmoidf_(v0 + bias[gc]);
          MIX[gm * 1024 + gc + 32] = y1 * sigmoidf_(v1 + bias[gc + 32]);
        },
        smem);
  }
}

template <int LAYER>
DEV void phase_outproj(const Params& p, char* smem) {
  const float* A = (const float*)(p.ws + OFF_MIX);
  const float* B = LAYER == 0 ? p.in[I_AB_W_OUT] : p.in[I_CD_W_OUT];
  const float* xin = LAYER == 0 ? p.in[I_X] : (const float*)(p.ws + OFF_X2);
  float* PRE = (float*)(p.ws + OFF_H);
  const int NT = 8, MT = NTOK / GEMM_BM;
  const int xcd_ = BIDX & 7, lb_ = BIDX >> 3, nb_ = gridDim.x >> 3;
  for (int j_ = lb_; j_ < (MT / 8) * NT; j_ += nb_) {
    const int it = (xcd_ + 8 * (j_ / NT)) * NT + (j_ % NT);
    const int m0 = (it / NT) * GEMM_BM, n0 = (it % NT) * 128;
    gemm_tile<false>(
        [&](int r) { return (const void*)(A + (size_t)(m0 + r) * 1024); },
        [&](int c) { return B + n0 + c; }, 1024, 1024,
        [&](int row, int col, float v0, float v1) {
          const size_t o = (size_t)(m0 + row) * 1024 + n0 + col;
          PRE[o] = ALPHA_F * xin[o] + v0;
          PRE[o + 32] = ALPHA_F * xin[o + 32] + v1;
        },
        smem);
  }
}

DEV void wave_ln(float (&v)[16], const float* gam, const float* bet, int lane) {
  float s = 0.f;
#pragma unroll
  for (int i = 0; i < 16; ++i) s += v[i];
  const float mu = wave_sum(s) * (1.f / 1024.f);
  float q = 0.f;
#pragma unroll
  for (int i = 0; i < 16; ++i) { const float d = v[i] - mu; q += d * d; }
  const float rstd = rsqrtf(wave_sum(q) * (1.f / 1024.f) + 1e-5f);
#pragma unroll
  for (int i = 0; i < 4; ++i) {
    const float4 gv = ld4(gam + lane * 4 + 256 * i), bv = ld4(bet + lane * 4 + 256 * i);
    v[i * 4 + 0] = (v[i * 4 + 0] - mu) * rstd * gv.x + bv.x;
    v[i * 4 + 1] = (v[i * 4 + 1] - mu) * rstd * gv.y + bv.y;
    v[i * 4 + 2] = (v[i * 4 + 2] - mu) * rstd * gv.z + bv.z;
    v[i * 4 + 3] = (v[i * 4 + 3] - mu) * rstd * gv.w + bv.w;
  }
}

#define LNR_T 4
#define P5_SMEM ((4 * LNR_T * 512 + 4 * 4 * LNR_T * 64 + 4 * 64) * 4)
template <int LAYER>
DEV void phase_ln_router(const Params& p, char* smem) {
  const int lane = TIDX & 63, wave = TIDX >> 6;
  const float* PRE = (const float*)(p.ws + OFF_H);
  float* X1 = (float*)(p.ws + OFF_X1);
  const float* router = p.in[I_ROUTER] + (size_t)LAYER * 1024 * 64;
  const float* bias = p.in[I_MOE_BIAS] + LAYER * 64;
  int* TOPI = (int*)(p.ws + OFF_TOPI);
  float* TOPG = (float*)(p.ws + OFF_TOPG);
  float* xh = (float*)smem;
  float* part = xh + 4 * LNR_T * 512;
  float* ms = part + 4 * 4 * LNR_T * 64 + wave * 64;
  unsigned short* X1B = (unsigned short*)p.out;
  for (int it = BIDX; it < NTOK / (4 * LNR_T); it += gridDim.x) {
    const size_t tokb = (size_t)it * (4 * LNR_T) + wave * LNR_T;
    float v[LNR_T][16];
#pragma unroll
    for (int t = 0; t < LNR_T; ++t) {
      const size_t tok = tokb + t;
#pragma unroll
      for (int i = 0; i < 4; ++i) {
        const float4 a = ld4(PRE + tok * 1024 + lane * 4 + 256 * i);
        v[t][i * 4] = a.x; v[t][i * 4 + 1] = a.y; v[t][i * 4 + 2] = a.z; v[t][i * 4 + 3] = a.w;
      }
      wave_ln(v[t], p.in[I_LN1_G] + LAYER * 1024, p.in[I_LN1_B] + LAYER * 1024, lane);
#pragma unroll
      for (int i = 0; i < 4; ++i) {
        const float4 a = make_float4(v[t][i * 4], v[t][i * 4 + 1], v[t][i * 4 + 2], v[t][i * 4 + 3]);
        st4(X1 + tok * 1024 + lane * 4 + 256 * i, a);
        *(uint2*)(X1B + tok * 1024 + lane * 4 + 256 * i) = make_uint2(pk2(a.x, a.y), pk2(a.z, a.w));
      }
    }
    {
      static_assert(LNR_T == 4, "the MFMA logits tile holds 16 tokens");
      const int hh = lane >> 5;
      f32x16 acc[2];
#pragma unroll
      for (int nt = 0; nt < 2; ++nt)
#pragma unroll
        for (int i = 0; i < 16; ++i) acc[nt][i] = 0.f;
#pragma unroll
      for (int hf = 0; hf < 2; ++hf) {
        __syncthreads();
#pragma unroll
        for (int t = 0; t < LNR_T; ++t)
#pragma unroll
          for (int i2 = 0; i2 < 2; ++i2) {
            const int i = 2 * hf + i2;
            st4(xh + (wave * LNR_T + t) * 512 + lane * 4 + 256 * i2, make_float4(v[t][i * 4], v[t][i * 4 + 1], v[t][i * 4 + 2], v[t][i * 4 + 3]));
          }
        __syncthreads();
#pragma unroll 2
        for (int kk = wave * 128; kk < wave * 128 + 128; kk += 16) {
          const int k = hf * 512 + kk;
          bf16x8 ahi, alo;
          {
            const float* xr = xh + (lane & 15) * 512 + kk + 8 * hh;
            const float4 x0 = ld4(xr), x1 = ld4(xr + 4);
            const unsigned h0 = pk2(x0.x, x0.y), h1 = pk2(x0.z, x0.w), h2 = pk2(x1.x, x1.y), h3 = pk2(x1.z, x1.w);
            union { uint4 u; bf16x8 v; } hi, lo;
            hi.u = make_uint4(h0, h1, h2, h3);
            lo.u = make_uint4(pk2(x0.x - bf2f((unsigned short)(h0 & 0xFFFF)), x0.y - bf2f((unsigned short)(h0 >> 16))),
                              pk2(x0.z - bf2f((unsigned short)(h1 & 0xFFFF)), x0.w - bf2f((unsigned short)(h1 >> 16))),
                              pk2(x1.x - bf2f((unsigned short)(h2 & 0xFFFF)), x1.y - bf2f((unsigned short)(h2 >> 16))),
                              pk2(x1.z - bf2f((unsigned short)(h3 & 0xFFFF)), x1.w - bf2f((unsigned short)(h3 >> 16))));
            ahi = hi.v; alo = lo.v;
          }
#pragma unroll
          for (int nt = 0; nt < 2; ++nt) {
            const float* rp = router + (size_t)(k + 8 * hh) * 64 + 32 * nt + (lane & 31);
            float rb[8];
#pragma unroll
            for (int j = 0; j < 8; ++j) rb[j] = rp[(size_t)j * 64];
            const unsigned h0 = pk2(rb[0], rb[1]), h1 = pk2(rb[2], rb[3]), h2 = pk2(rb[4], rb[5]), h3 = pk2(rb[6], rb[7]);
            union { uint4 u; bf16x8 v; } hi, lo;
            hi.u = make_uint4(h0, h1, h2, h3);
            lo.u = make_uint4(pk2(rb[0] - bf2f((unsigned short)(h0 & 0xFFFF)), rb[1] - bf2f((unsigned short)(h0 >> 16))),
                              pk2(rb[2] - bf2f((unsigned short)(h1 & 0xFFFF)), rb[3] - bf2f((unsigned short)(h1 >> 16))),
                              pk2(rb[4] - bf2f((unsigned short)(h2 & 0xFFFF)), rb[5] - bf2f((unsigned short)(h2 >> 16))),
                              pk2(rb[6] - bf2f((unsigned short)(h3 & 0xFFFF)), rb[7] - bf2f((unsigned short)(h3 >> 16))));
            acc[nt] = __builtin_amdgcn_mfma_f32_32x32x16_bf16(ahi, hi.v, acc[nt], 0, 0, 0);
            acc[nt] = __builtin_amdgcn_mfma_f32_32x32x16_bf16(ahi, lo.v, acc[nt], 0, 0, 0);
            acc[nt] = __builtin_amdgcn_mfma_f32_32x32x16_bf16(alo, hi.v, acc[nt], 0, 0, 0);
          }
        }
      }
#pragma unroll
      for (int nt = 0; nt < 2; ++nt)
#pragma unroll
        for (int r8 = 0; r8 < 8; ++r8)
          part[(wave * 4 * LNR_T + (r8 & 3) + 8 * (r8 >> 2) + 4 * hh) * 64 + 32 * nt + (lane & 31)] = acc[nt][r8];
    }
    __syncthreads();
    float lg[LNR_T];
#pragma unroll
    for (int t = 0; t < LNR_T; ++t) {
      const int tg = wave * LNR_T + t;
      lg[t] = ((part[(0 * 4 * LNR_T + tg) * 64 + lane] + part[(1 * 4 * LNR_T + tg) * 64 + lane]) + part[(2 * 4 * LNR_T + tg) * 64 + lane]) +
              part[(3 * 4 * LNR_T + tg) * 64 + lane];
    }
#pragma unroll
    for (int t = 0; t < LNR_T; ++t) {
      const size_t tok = tokb + t;
      const float score = 1.f / (1.f + expf(-lg[t]));
      const float biased = score + bias[lane];
      float m1 = biased; int a1 = lane;
#pragma unroll
      for (int mm = 1; mm <= 4; mm <<= 1) {
        const float ov = __shfl_xor(m1, mm); const int oa = __shfl_xor(a1, mm);
        if (ov > m1 || (ov == m1 && oa < a1)) { m1 = ov; a1 = oa; }
      }
      float m2 = lane == a1 ? -INFINITY : biased;
#pragma unroll
      for (int mm = 1; mm <= 4; mm <<= 1) m2 = fmaxf(m2, __shfl_xor(m2, mm));
      const float gs = m1 + m2;
      const int mygrp = lane >> 3;
      int rank = 0;
#pragma unroll
      for (int gg = 0; gg < 8; ++gg) {
        const float og = __shfl(gs, gg * 8);
        rank += (og > gs || (og == gs && gg < mygrp)) ? 1 : 0;
      }
      const float masked = rank < 4 ? biased : -INFINITY;
      WAVE_SYNC();
      ms[lane] = masked;
      WAVE_SYNC();
      int erank = 0;
      for (int e = 0; e < 64; ++e) {
        const float ov = ms[e];
        erank += (ov > masked || (ov == masked && e < lane)) ? 1 : 0;
      }
      const bool selected = erank < 8;
      const float gsum = wave_sum(selected ? score : 0.f);
      if (selected) {
        TOPI[tok * 8 + erank] = lane;
        TOPG[tok * 8 + erank] = score / gsum * 2.5f;
      }
    }
  }
}

#define P6_SMEM GEMM_SMEM_BYTES
template <int LAYER>
DEV void phase_lists_shup(const Params& p, char* smem) {
  const int tid = TIDX, lane = tid & 63, wave = tid >> 6;
  const int* TOPI = (const int*)(p.ws + OFF_TOPI);
  const float* TOPG = (const float*)(p.ws + OFF_TOPG);
  int* PPOS = (int*)(p.ws + OFF_S5E);
  int* CNT = (int*)(p.ws + OFF_CNT);
  int* LTOK = (int*)(p.ws + OFF_LTOK);
  float* LGATE = (float*)(p.ws + OFF_LGATE);
  const unsigned short* X1B = (const unsigned short*)p.out;
  unsigned short* HS = (unsigned short*)(p.ws + OFF_HS);
  const float* W1 = p.in[I_SH_W1] + (size_t)LAYER * 1024 * 256;
  const float* W3 = p.in[I_SH_W3] + (size_t)LAYER * 1024 * 256;
  const int MT = NTOK / GEMM_BM;
  int* swave = (int*)smem;
  for (int it = BIDX; it < 64; it += gridDim.x) {
    const int e = it;
    int base = 0;
    for (int t0 = 0; t0 < NTOK; t0 += 4 * NTHREADS) {
      const int tok4 = t0 + 4 * tid;
      int slot[4];
      unsigned long long bal[4];
#pragma unroll
      for (int j = 0; j < 4; ++j) {
        const int4 a = *(const int4*)(TOPI + (size_t)(tok4 + j) * 8), b = *(const int4*)(TOPI + (size_t)(tok4 + j) * 8 + 4);
        int sl = -1;
        sl = a.x == e ? 0 : sl; sl = a.y == e ? 1 : sl; sl = a.z == e ? 2 : sl; sl = a.w == e ? 3 : sl;
        sl = b.x == e ? 4 : sl; sl = b.y == e ? 5 : sl; sl = b.z == e ? 6 : sl; sl = b.w == e ? 7 : sl;
        slot[j] = sl;
        bal[j] = __ballot(sl >= 0);
      }
      const unsigned long long lower = (1ull << lane) - 1ull;
      int pre = 0, wtot = 0;
#pragma unroll
      for (int j = 0; j < 4; ++j) { pre += __popcll(bal[j] & lower); wtot += __popcll(bal[j]); }
      __syncthreads();
      if (lane == 0) swave[wave] = wtot;
      __syncthreads();
      int woff = 0, tot = 0;
#pragma unroll
      for (int w = 0; w < 4; ++w) { const int c = swave[w]; if (w < wave) woff += c; tot += c; }
      int pos = base + woff + pre;
#pragma unroll
      for (int j = 0; j < 4; ++j) {
        if (slot[j] >= 0) {
          const int tok = tok4 + j;
          LTOK[(size_t)e * NTOK + pos] = tok;
          LGATE[(size_t)e * NTOK + pos] = TOPG[(size_t)tok * 8 + slot[j]];
          PPOS[(size_t)e * NTOK + tok] = pos;
          ++pos;
        }
      }
      base += tot;
    }
    if (tid == 0) CNT[e * 32] = base;
    __syncthreads();
  }
  {
    const int NT = 4;
    const int xcd_ = BIDX & 7, lb_ = BIDX >> 3, nb_ = gridDim.x >> 3;
    for (int j_ = lb_; j_ < (MT / 8) * NT; j_ += nb_) {
      const int m0 = (xcd_ + 8 * (j_ / NT)) * GEMM_BM, ct = j_ % NT;
      gemm_tile<true>(
          [&](int r) { return (const void*)(X1B + (size_t)(m0 + r) * 1024); },
          [&](int c) { return (((c >> 5) & 1) ? W3 : W1) + ct * 64 + (c >> 6) * 32 + (c & 31); }, 256, 1024,
          [&](int row, int col, float v0, float v1) {
            const int lc = ct * 64 + (col >> 6) * 32 + (col & 31);
            HS[(size_t)(m0 + row) * 256 + lc] = f2bf(siluf_(v0) * v1);
          },
          smem);
    }
  }
}

struct ExpMap { int tstart[65]; int rbase[65]; int ltile[9]; };
DEV void build_expmap(const Params& p, ExpMap* em) {
  __syncthreads();
  if (TIDX == 0) {
    const int* CNT = (const int*)(p.ws + OFF_CNT);
    int ts = 0, rb = 0;
    for (int e = 0; e < 64; ++e) {
      em->tstart[e] = ts; em->rbase[e] = rb;
      const int c = CNT[e * 32];
      ts += (c + GEMM_BM - 1) / GEMM_BM; rb += c;
    }
    em->tstart[64] = ts; em->rbase[64] = rb;
    const int x = BIDX & 7;
    int lt = 0;
    for (int k = 0; k < 8; ++k) { em->ltile[k] = lt; lt += em->tstart[x + 8 * k + 1] - em->tstart[x + 8 * k]; }
    em->ltile[8] = lt;
  }
  __syncthreads();
}
DEV void map_expert_tile(const ExpMap* em, int j, int CT, int& e, int& rt, int& ct) {
  const int jr = j / CT; ct = j % CT;
  int k = 0;
  for (int q = 1; q < 8; ++q) if (em->ltile[q] <= jr) k = q;
  e = (BIDX & 7) + 8 * k; rt = jr - em->ltile[k];
}
#define P7_SMEM (GEMM_SMEM_BYTES + 1024)
template <int LAYER>
DEV void phase_routed_up(const Params& p, char* smem) {
  ExpMap* em = (ExpMap*)(smem + GEMM_SMEM_BYTES);
  build_expmap(p, em);
  const int* CNT = (const int*)(p.ws + OFF_CNT);
  const int* LTOK = (const int*)(p.ws + OFF_LTOK);
  const unsigned short* X1B = (const unsigned short*)p.out;
  unsigned short* HR = (unsigned short*)(p.ws + OFF_HR);
  const int lb_ = BIDX >> 3, nb_ = gridDim.x >> 3;
  for (int j_ = lb_; j_ < em->ltile[8] * 4; j_ += nb_) {
    int e, rtl, ct;
    map_expert_tile(em, j_, 4, e, rtl, ct);
    const int r0 = rtl * GEMM_BM;
    const int cnt = CNT[e * 32], rbase = em->rbase[e];
    const float* W1 = p.in[I_MOE_W1] + ((size_t)LAYER * 64 + e) * 1024 * 256;
    const float* W3 = p.in[I_MOE_W3] + ((size_t)LAYER * 64 + e) * 1024 * 256;
    gemm_tile<true>(
        [&](int r) { return (r0 + r < cnt) ? (const void*)(X1B + (size_t)LTOK[(size_t)e * NTOK + r0 + r] * 1024) : (const void*)nullptr; },
        [&](int c) { return (((c >> 5) & 1) ? W3 : W1) + ct * 64 + (c >> 6) * 32 + (c & 31); }, 256, 1024,
        [&](int row, int col, float v0, float v1) {
          if (r0 + row < cnt) {
            const int lc = ct * 64 + (col >> 6) * 32 + (col & 31);
            HR[(size_t)(rbase + r0 + row) * 256 + lc] = f2bf(siluf_(v0) * v1);
          }
        },
        smem);
  }
}

template <int LAYER>
DEV void phase_down(const Params& p, char* smem) {
  ExpMap* em = (ExpMap*)(smem + GEMM_SMEM_BYTES);
  build_expmap(p, em);
  const int* CNT = (const int*)(p.ws + OFF_CNT);
  const float* LGATE = (const float*)(p.ws + OFF_LGATE);
  const unsigned short* HR = (const unsigned short*)(p.ws + OFF_HR);
  const unsigned short* HS = (const unsigned short*)(p.ws + OFF_HS);
  unsigned short* Y = (unsigned short*)(p.ws + OFF_Y);
  float* FS = (float*)(p.ws + OFF_FS);
  const int xcd_ = BIDX & 7, lb_ = BIDX >> 3, nb_ = gridDim.x >> 3;
  for (int j_ = lb_; j_ < em->ltile[8] * 8; j_ += nb_) {
    int e, rtl, ct;
    map_expert_tile(em, j_, 8, e, rtl, ct);
    const int r0 = rtl * GEMM_BM;
    const int cnt = CNT[e * 32], rbase = em->rbase[e];
    const float* W2 = p.in[I_MOE_W2] + ((size_t)LAYER * 64 + e) * 256 * 1024;
    const int n0 = ct * 128;
    gemm_tile<true>(
        [&](int r) { return (r0 + r < cnt) ? (const void*)(HR + (size_t)(rbase + r0 + r) * 256) : (const void*)nullptr; },
        [&](int c) { return W2 + n0 + c; }, 1024, 256,
        [&](int row, int col, float v0, float v1) {
          if (r0 + row < cnt) {
            const float gt = LGATE[(size_t)e * NTOK + r0 + row];
            const size_t o = (size_t)(rbase + r0 + row) * 1024 + n0 + col;
            Y[o] = f2bf(v0 * gt); Y[o + 32] = f2bf(v1 * gt);
          }
        },
        smem);
  }
  {
    const int MT = NTOK / GEMM_BM, NT = 8;
    const float* W2 = p.in[I_SH_W2] + (size_t)LAYER * 256 * 1024;
    for (int j_ = lb_; j_ < (MT / 8) * NT; j_ += nb_) {
      const int m0 = (xcd_ + 8 * (j_ / NT)) * GEMM_BM, n0 = (j_ % NT) * 128;
      gemm_tile<true>(
          [&](int r) { return (const void*)(HS + (size_t)(m0 + r) * 256); },
          [&](int c) { return W2 + n0 + c; }, 1024, 256,
          [&](int row, int col, float v0, float v1) {
            const size_t o = (size_t)(m0 + row) * 1024 + n0 + col;
            FS[o] = v0; FS[o + 32] = v1;
          },
          smem);
    }
  }
}

template <int LAYER>
DEV void phase_combine(const Params& p, char* smem) {
  ExpMap* em = (ExpMap*)smem;
  build_expmap(p, em);
  const int lane = TIDX & 63, wave = TIDX >> 6;
  const float* X1 = (const float*)(p.ws + OFF_X1);
  const float* FS = (const float*)(p.ws + OFF_FS);
  const unsigned short* Y = (const unsigned short*)(p.ws + OFF_Y);
  const int* TOPI = (const int*)(p.ws + OFF_TOPI);
  const int* PPOS = (const int*)(p.ws + OFF_S5E);
  float* OUT = LAYER == 0 ? (float*)(p.ws + OFF_X2) : p.out;
  for (int it = BIDX; it < NTOK / 4; it += gridDim.x) {
    const size_t tok = (size_t)it * 4 + wave;
    float v[16];
#pragma unroll
    for (int i = 0; i < 4; ++i) {
      const float4 a = ld4(X1 + tok * 1024 + lane * 4 + 256 * i), f = ld4(FS + tok * 1024 + lane * 4 + 256 * i);
      v[i * 4] = ALPHA_F * a.x + f.x; v[i * 4 + 1] = ALPHA_F * a.y + f.y; v[i * 4 + 2] = ALPHA_F * a.z + f.z; v[i * 4 + 3] = ALPHA_F * a.w + f.w;
    }
    size_t rows[8];
#pragma unroll
    for (int s = 0; s < 8; ++s) { const int e_ = TOPI[tok * 8 + s]; rows[s] = (size_t)em->rbase[e_] + PPOS[(size_t)e_ * NTOK + tok]; }
#pragma unroll
    for (int s0 = 0; s0 < 8; s0 += 4) {
      uint2 yy[4][4];
#pragma unroll
      for (int s = 0; s < 4; ++s)
#pragma unroll
        for (int i = 0; i < 4; ++i) yy[s][i] = *(const uint2*)(Y + rows[s0 + s] * 1024 + lane * 4 + 256 * i);
#pragma unroll
      for (int s = 0; s < 4; ++s)
#pragma unroll
        for (int i = 0; i < 4; ++i) {
          const uint2 y = yy[s][i];
          v[i * 4] += bf2f((unsigned short)(y.x & 0xFFFF)); v[i * 4 + 1] += bf2f((unsigned short)(y.x >> 16));
          v[i * 4 + 2] += bf2f((unsigned short)(y.y & 0xFFFF)); v[i * 4 + 3] += bf2f((unsigned short)(y.y >> 16));
        }
    }
    wave_ln(v, p.in[I_LN2_G] + LAYER * 1024, p.in[I_LN2_B] + LAYER * 1024, lane);
#pragma unroll
    for (int i = 0; i < 4; ++i) st4(OUT + tok * 1024 + lane * 4 + 256 * i, make_float4(v[i * 4], v[i * 4 + 1], v[i * 4 + 2], v[i * 4 + 3]));
    if (LAYER == 0) {
      unsigned short* X2B = (unsigned short*)(p.ws + OFF_X2B);
#pragma unroll
      for (int i = 0; i < 4; ++i) *(uint2*)(X2B + tok * 1024 + lane * 4 + 256 * i) = make_uint2(pk2(v[i * 4], v[i * 4 + 1]), pk2(v[i * 4 + 2], v[i * 4 + 3]));
    }
  }
}

DEV float shifted(const float* Hc, size_t tok, int col, const float* mu) {
  const float cur = Hc[tok * 1792 + col];
  const float prev = (tok % SEQ_LEN) == 0 ? 0.f : Hc[(tok - 1) * 1792 + col];
  return cur + (prev - cur) * mu[col];
}

#define RWP_T 32
#define P11_PREP_ITEMS (NTOK / RWP_T)
#define P11_KV_ITEMS (BATCH * 4 * RET_NC)
#define P11_SMEM (RWP_T * 128 * 4)
DEV void split_bf8(const float (&x)[8], bf16x8& hi, bf16x8& lo) {
  const unsigned h0 = pk2(x[0], x[1]), h1 = pk2(x[2], x[3]), h2 = pk2(x[4], x[5]), h3 = pk2(x[6], x[7]);
  union { uint4 u; bf16x8 v; } a, b;
  a.u = make_uint4(h0, h1, h2, h3);
  b.u = make_uint4(pk2(x[0] - bf2f((unsigned short)(h0 & 0xFFFF)), x[1] - bf2f((unsigned short)(h0 >> 16))),
                   pk2(x[2] - bf2f((unsigned short)(h1 & 0xFFFF)), x[3] - bf2f((unsigned short)(h1 >> 16))),
                   pk2(x[4] - bf2f((unsigned short)(h2 & 0xFFFF)), x[5] - bf2f((unsigned short)(h2 >> 16))),
                   pk2(x[6] - bf2f((unsigned short)(h3 & 0xFFFF)), x[7] - bf2f((unsigned short)(h3 >> 16))));
  hi = a.v; lo = b.v;
}
DEV float half_sum32(float v) {
#ifdef CPU_EMU
#pragma unroll
  for (int m = 16; m >= 1; m >>= 1) v += __shfl_xor(v, m);
  return v;
#else
  int x;
  x = __builtin_amdgcn_update_dpp(0, __builtin_bit_cast(int, v), 0xB1, 0xF, 0xF, false); v += __builtin_bit_cast(float, x);
  x = __builtin_amdgcn_update_dpp(0, __builtin_bit_cast(int, v), 0x4E, 0xF, 0xF, false); v += __builtin_bit_cast(float, x);
  x = __builtin_amdgcn_update_dpp(0, __builtin_bit_cast(int, v), 0x141, 0xF, 0xF, false); v += __builtin_bit_cast(float, x);
  x = __builtin_amdgcn_update_dpp(0, __builtin_bit_cast(int, v), 0x140, 0xF, 0xF, false); v += __builtin_bit_cast(float, x);
  return v + __shfl_xor(v, 16);
#endif
}
DEV void p11_prep(const Params& p, int item, char* smem) {
  const int tid = TIDX, lane = tid & 63, wave = tid >> 6;
  const float* Hc = (const float*)(p.ws + OFF_H);
  const float* mu = p.in[I_RW_MU];
  float* sl = (float*)smem;
  static_assert(RWP_T == 32, "one 32-row MFMA tile of tokens per item");
  __syncthreads();
  for (int w = tid; w < RWP_T * 128; w += NTHREADS) {
    const int tt = w >> 7, j = w & 127;
    const size_t tok = (size_t)item * RWP_T + tt;
    const float v = shifted(Hc, tok, 1536 + j, mu);
    sl[w] = j < 64 ? tanhf(v) : v;
    ((float*)(p.ws + OFF_GLO))[tok * 128 + j] = sigmoidf_(shifted(Hc, tok, 1664 + j, mu));
  }
  __syncthreads();
  float* RWW = (float*)(p.ws + OFF_RWW); float* RWK = (float*)(p.ws + OFF_RWK);
  float* RWKK = (float*)(p.ws + OFF_RWKK); float* RWA = (float*)(p.ws + OFF_RWA);
  float* RWR = p.out + (size_t)NTOK * 512; float* RWV = p.out;
  const float* w_up = p.in[I_RW_W_UP]; const float* a_up = p.in[I_RW_A_UP];
  const int n = lane & 31, hh = lane >> 5;
#pragma unroll 1
  for (int cc = 0; cc < 2; ++cc) {
    const int hd = wave + 4 * cc;
    f32x16 accW[2], accA[2];
#pragma unroll
    for (int nt = 0; nt < 2; ++nt)
#pragma unroll
      for (int i = 0; i < 16; ++i) { accW[nt][i] = 0.f; accA[nt][i] = 0.f; }
#pragma unroll
    for (int ks = 0; ks < 4; ++ks) {
      bf16x8 awh, awl, aah, aal;
      {
        const float* xr = sl + n * 128 + 16 * ks + 8 * hh;
        const float4 x0 = ld4(xr), x1 = ld4(xr + 4), y0 = ld4(xr + 64), y1 = ld4(xr + 68);
        const float xw[8] = {x0.x, x0.y, x0.z, x0.w, x1.x, x1.y, x1.z, x1.w};
        const float xa[8] = {y0.x, y0.y, y0.z, y0.w, y1.x, y1.y, y1.z, y1.w};
        split_bf8(xw, awh, awl);
        split_bf8(xa, aah, aal);
      }
#pragma unroll
      for (int nt = 0; nt < 2; ++nt) {
        const size_t bo = (size_t)(16 * ks + 8 * hh) * 512 + 64 * hd + 32 * nt + n;
        float bw[8], ba[8];
#pragma unroll
        for (int j = 0; j < 8; ++j) { bw[j] = w_up[bo + (size_t)j * 512]; ba[j] = a_up[bo + (size_t)j * 512]; }
        bf16x8 bwh, bwl, bah, bal;
        split_bf8(bw, bwh, bwl);
        split_bf8(ba, bah, bal);
        accW[nt] = __builtin_amdgcn_mfma_f32_32x32x16_bf16(awh, bwh, accW[nt], 0, 0, 0);
        accW[nt] = __builtin_amdgcn_mfma_f32_32x32x16_bf16(awh, bwl, accW[nt], 0, 0, 0);
        accW[nt] = __builtin_amdgcn_mfma_f32_32x32x16_bf16(awl, bwh, accW[nt], 0, 0, 0);
        accA[nt] = __builtin_amdgcn_mfma_f32_32x32x16_bf16(aah, bah, accA[nt], 0, 0, 0);
        accA[nt] = __builtin_amdgcn_mfma_f32_32x32x16_bf16(aah, bal, accA[nt], 0, 0, 0);
        accA[nt] = __builtin_amdgcn_mfma_f32_32x32x16_bf16(aal, bah, accA[nt], 0, 0, 0);
      }
    }
    const int c0 = 64 * hd + n, c1 = c0 + 32;
    const float w0_0 = p.in[I_RW_W0][c0], a0_0 = p.in[I_RW_A0][c0], kkc_0 = p.in[I_RW_K_K][c0], kac_0 = p.in[I_RW_K_A][c0];
    const float w0_1 = p.in[I_RW_W0][c1], a0_1 = p.in[I_RW_A0][c1], kkc_1 = p.in[I_RW_K_K][c1], kac_1 = p.in[I_RW_K_A][c1];
#pragma unroll
    for (int r16 = 0; r16 < 16; ++r16) {
      const int tt = (r16 & 3) + 8 * (r16 >> 2) + 4 * hh;
      const size_t tok = (size_t)item * RWP_T + tt;
      float kkv[2], av[2], ksv[2];
#pragma unroll
      for (int nt = 0; nt < 2; ++nt) {
        const int c = nt ? c1 : c0;
        const float lw = (nt ? w0_1 : w0_0) + accW[nt][r16];
        const float nl = -lw;
        const float sp = nl > 20.f ? nl : log1pf(expf(nl));
        const float wl = -sp - 0.5f;
        const float decay = expf(-expf(wl));
        av[nt] = 1.f / (1.f + expf(-((nt ? a0_1 : a0_0) + accA[nt][r16])));
        const float rs = shifted(Hc, tok, c, mu);
        ksv[nt] = shifted(Hc, tok, 512 + c, mu);
        const float vs = shifted(Hc, tok, 1024 + c, mu);
        kkv[nt] = ksv[nt] * (nt ? kkc_1 : kkc_0);
        RWW[tok * 512 + c] = decay;
        RWR[tok * 512 + c] = rs;
        RWV[tok * 512 + c] = vs;
      }
      const float nrm = sqrtf(half_sum32(kkv[0] * kkv[0] + kkv[1] * kkv[1]));
      const float inv = 1.f / fmaxf(nrm, 1e-12f);
#pragma unroll
      for (int nt = 0; nt < 2; ++nt) {
        const int c = nt ? c1 : c0;
        const float kk = kkv[nt] * inv;
        RWK[tok * 512 + c] = ksv[nt] * (1.f + (av[nt] - 1.f) * (nt ? kac_1 : kac_0));
        RWKK[tok * 512 + c] = kk;
        RWA[tok * 512 + c] = kk * av[nt];
      }
    }
  }
}
DEV float ret_log2gamma(int h) { return log2f(1.f - exp2f(-5.f - (float)h)); }
struct KvSmem { unsigned short vt[128][72]; unsigned short kt[64][72]; };
#define P11_KV_SMEM ((int)sizeof(KvSmem))
DEV void p11_kv(const Params& p, int item, char* smem) {
  KvSmem* sm = (KvSmem*)smem;
  const int c = item % RET_NC, h = (item / RET_NC) & 3, b = item / (RET_NC * 4);
  const int tid = TIDX, lane = tid & 63, wave = tid >> 6;
  const int r = lane & 31, hh = lane >> 5;
  const float* H2 = (const float*)(p.ws + OFF_H2);
  const float lg = ret_log2gamma(h);
  const size_t tok0 = (size_t)b * SEQ_LEN + c * 128;
  f32x16 acc[2];
#pragma unroll
  for (int nt = 0; nt < 2; ++nt)
#pragma unroll
    for (int i = 0; i < 16; ++i) acc[nt][i] = 0.f;
#pragma unroll 1
  for (int kt = 0; kt < 2; ++kt) {
    __syncthreads();
#pragma unroll
    for (int q = 0; q < 8; ++q) {
      const int f = tid + 256 * q;
      const int key = f >> 5, d4 = (f & 31) * 4;
      const float dec = exp2f((float)(127 - (kt * 64 + key)) * lg);
      const float4 v = ld4(H2 + (tok0 + kt * 64 + key) * 1536 + 512 + h * 128 + d4);
      sm->vt[d4][key] = f2bf(v.x * dec); sm->vt[d4 + 1][key] = f2bf(v.y * dec);
      sm->vt[d4 + 2][key] = f2bf(v.z * dec); sm->vt[d4 + 3][key] = f2bf(v.w * dec);
    }
#pragma unroll
    for (int q = 0; q < 4; ++q) {
      const int f = tid + 256 * q;
      const int key = f >> 4, d4 = (f & 15) * 4;
      const float4 v = ld4(H2 + (tok0 + kt * 64 + key) * 1536 + 256 + h * 64 + d4);
      sm->kt[d4][key] = f2bf(v.x); sm->kt[d4 + 1][key] = f2bf(v.y); sm->kt[d4 + 2][key] = f2bf(v.z); sm->kt[d4 + 3][key] = f2bf(v.w);
    }
    __syncthreads();
#pragma unroll
    for (int ks = 0; ks < 4; ++ks) {
      const bf16x8 a = *(const bf16x8*)&sm->vt[wave * 32 + r][ks * 16 + hh * 8];
#pragma unroll
      for (int nt = 0; nt < 2; ++nt) {
        const bf16x8 bb = *(const bf16x8*)&sm->kt[nt * 32 + r][ks * 16 + hh * 8];
        acc[nt] = __builtin_amdgcn_mfma_f32_32x32x16_bf16(a, bb, acc[nt], 0, 0, 0);
      }
    }
  }
  float* KV = (float*)(p.ws + OFF_RETKV) + (size_t)item * 64 * 128;
#pragma unroll
  for (int nt = 0; nt < 2; ++nt)
#pragma unroll
    for (int g4 = 0; g4 < 4; ++g4)
      st4(KV + (nt * 32 + r) * 128 + wave * 32 + 8 * g4 + 4 * hh,
          make_float4(acc[nt][4 * g4], acc[nt][4 * g4 + 1], acc[nt][4 * g4 + 2], acc[nt][4 * g4 + 3]));
}
DEV void phase_p11(const Params& p, char* smem) {
  {
    unsigned* RKF = (unsigned*)(p.ws + OFF_RKF);
    for (int i = BIDX * NTHREADS + TIDX; i < BATCH * 8 * (SEQ_LEN / 32); i += gridDim.x * NTHREADS) RKF[i] = 0u;
  }
  const int total = P11_PREP_ITEMS + P11_KV_ITEMS;
  for (int it = BIDX; it < total; it += gridDim.x) {
    if (it < P11_KV_ITEMS) p11_kv(p, it, smem);
    else p11_prep(p, it - P11_KV_ITEMS, smem);
  }
}

#define RK_T 32
#define RK_NCH (SEQ_LEN / RK_T)
#define RK_NCHT (BATCH * 8 * RK_NCH)
#define OFF_RKPT OFF_H
#define OFF_RKKT (OFF_RKPT + (size_t)RK_NCHT * 64 * 64 * 2)
#define OFF_RKVT (OFF_RKKT + (size_t)RK_NCHT * 64 * 32 * 2)
#define OFF_RKRT (OFF_RKVT + (size_t)RK_NCHT * 64 * 32 * 2)
#define OFF_RKAT (OFF_RKRT + (size_t)RK_NCHT * 32 * 64 * 2)
#define OFF_RKEND (OFF_RKAT + (size_t)RK_NCHT * 32 * 32 * 2)
static_assert(OFF_RKEND <= OFF_H2, "rk buffers must fit in the H1 region");
#define RKPRE_SMEM ((4 * 32 * 64 + 32 * 64) * 4)

DEV unsigned short* rksc_row(char* ws, int b, int h, int c, int i) {
  return (unsigned short*)(ws + OFF_RWW) + (((size_t)b * SEQ_LEN + (size_t)c * RK_T + (i >> 1)) * 512 + h * 64) * 2 + (i & 1) * 64;
}
#if RK_MERGED
DEV void st_wt_u16(unsigned short* q, unsigned short v) { asm volatile("global_store_short %0, %1, off sc1" :: "v"(q), "v"((unsigned)v) : "memory"); }
typedef unsigned u32x4_t __attribute__((ext_vector_type(4)));
DEV void st_wt_b128(void* q, uint4 v) { const u32x4_t w = {v.x, v.y, v.z, v.w}; asm volatile("global_store_dwordx4 %0, %1, off sc1" :: "v"(q), "v"(w) : "memory"); }
#else
DEV void st_wt_u16(unsigned short* q, unsigned short v) { *q = v; }
DEV void st_wt_b128(void* q, uint4 v) { *(uint4*)q = v; }
#endif
DEV void rk_precompute(const Params& p, int ch, char* smem) {
  const int c = ch % RK_NCH, bh = ch / RK_NCH, h = bh & 7, b = bh >> 3;
  const int tid = TIDX, lane = tid & 63, wave = tid >> 6;
  const size_t tok0 = (size_t)b * SEQ_LEN + (size_t)c * RK_T;
  const float* RWW = (const float*)(p.ws + OFF_RWW); const float* RWK = (const float*)(p.ws + OFF_RWK);
  const float* RWKK = (const float*)(p.ws + OFF_RWKK); const float* RWA = (const float*)(p.ws + OFF_RWA);
  const float* RWR = p.out + (size_t)NTOK * 512; const float* RWV = p.out;
  float* sW = (float*)smem;
  float* sNK = sW + 32 * 64;
  float* sKA = sNK + 32 * 64;
  float* sR = sKA + 32 * 64;
  float* sV = sR + 32 * 64;
  __syncthreads();
  for (int w = tid; w < 32 * 16; w += NTHREADS) {
    const int t = w >> 4, c4 = (w & 15) * 4;
    const size_t o = (tok0 + t) * 512 + h * 64 + c4;
    st4(sW + t * 64 + c4, ld4(RWW + o));
    const float4 kk = ld4(RWKK + o);
    st4(sNK + t * 64 + c4, make_float4(-kk.x, -kk.y, -kk.z, -kk.w));
    st4(sKA + t * 64 + c4, ld4(RWA + o));
    st4(sR + t * 64 + c4, ld4(RWR + o));
    st4(sV + t * 64 + c4, ld4(RWV + o));
  }
  __syncthreads();
  const int wrole = (wave + ((BIDX >= (gridDim.x >> 1)) ? 2 : 0)) & 3;
  if (wrole == 0) {
    float z[64];
#pragma unroll
    for (int j = 0; j < 64; ++j) z[j] = (j == lane) ? 1.f : 0.f;
    for (int t = 0; t < RK_T; ++t) {
      float cacc = 0.f;
#pragma unroll
      for (int j4 = 0; j4 < 16; ++j4) {
        const float4 u = ld4(sNK + t * 64 + j4 * 4);
        cacc += z[j4 * 4] * u.x + z[j4 * 4 + 1] * u.y + z[j4 * 4 + 2] * u.z + z[j4 * 4 + 3] * u.w;
      }
#pragma unroll
      for (int j4 = 0; j4 < 16; ++j4) {
        const float4 w = ld4(sW + t * 64 + j4 * 4), v = ld4(sKA + t * 64 + j4 * 4);
        z[j4 * 4] = z[j4 * 4] * w.x + cacc * v.x; z[j4 * 4 + 1] = z[j4 * 4 + 1] * w.y + cacc * v.y;
        z[j4 * 4 + 2] = z[j4 * 4 + 2] * w.z + cacc * v.z; z[j4 * 4 + 3] = z[j4 * 4 + 3] * w.w + cacc * v.w;
      }
    }
    unsigned short* PT = (unsigned short*)(p.ws + OFF_RKPT) + (size_t)ch * 64 * 64;
#pragma unroll
    for (int j = 0; j < 64; ++j) st_wt_u16(PT + j * 64 + lane, f2bf(z[j]));
  } else if (wrole == 1) {
    const bool isA = lane < 32;
    const int me = lane & 31;
    float q[64];
    {
      const float* src = (isA ? RWK : RWR) + (tok0 + me) * 512 + h * 64;
#pragma unroll
      for (int j4 = 0; j4 < 16; ++j4) { const float4 v = ld4(src + j4 * 4); q[j4 * 4] = v.x; q[j4 * 4 + 1] = v.y; q[j4 * 4 + 2] = v.z; q[j4 * 4 + 3] = v.w; }
    }
    const float* Ub = isA ? sNK : sKA;
    const float* Vb = isA ? sKA : sNK;
    unsigned short* AT = (unsigned short*)(p.ws + OFF_RKAT) + (size_t)ch * 32 * 32;
    for (int u = 0; u < RK_T; ++u) {
      const int tt = isA ? u : RK_T - 1 - u;
      const bool upd = isA ? (u > me) : (tt <= me);
      if (upd) {
        float cacc = 0.f;
#pragma unroll
        for (int j4 = 0; j4 < 16; ++j4) {
          const float4 uu = ld4(Ub + tt * 64 + j4 * 4);
          cacc += q[j4 * 4] * uu.x + q[j4 * 4 + 1] * uu.y + q[j4 * 4 + 2] * uu.z + q[j4 * 4 + 3] * uu.w;
        }
#pragma unroll
        for (int j4 = 0; j4 < 16; ++j4) {
          const float4 w = ld4(sW + tt * 64 + j4 * 4), v = ld4(Vb + tt * 64 + j4 * 4);
          q[j4 * 4] = q[j4 * 4] * w.x + cacc * v.x; q[j4 * 4 + 1] = q[j4 * 4 + 1] * w.y + cacc * v.y;
          q[j4 * 4 + 2] = q[j4 * 4 + 2] * w.z + cacc * v.z; q[j4 * 4 + 3] = q[j4 * 4 + 3] * w.w + cacc * v.w;
        }
      }
      if (isA) {
        float av = 0.f;
        if (u >= me) {
#pragma unroll
          for (int j4 = 0; j4 < 16; ++j4) {
            const float4 rr = ld4(sR + u * 64 + j4 * 4);
            av += q[j4 * 4] * rr.x + q[j4 * 4 + 1] * rr.y + q[j4 * 4 + 2] * rr.z + q[j4 * 4 + 3] * rr.w;
          }
        }
        AT[u * 32 + me] = f2bf(av);
      }
    }
    if (isA) {
      unsigned short* KT = (unsigned short*)(p.ws + OFF_RKKT) + (size_t)ch * 64 * 32;
#pragma unroll
      for (int j = 0; j < 64; ++j) st_wt_u16(KT + j * 32 + me, f2bf(q[j]));
    } else {
      unsigned short* RT = (unsigned short*)(p.ws + OFF_RKRT) + ((size_t)ch * 32 + me) * 64;
#pragma unroll
      for (int j8 = 0; j8 < 8; ++j8)
        *(uint4*)(RT + j8 * 8) = make_uint4(pk2(q[j8 * 8], q[j8 * 8 + 1]), pk2(q[j8 * 8 + 2], q[j8 * 8 + 3]), pk2(q[j8 * 8 + 4], q[j8 * 8 + 5]), pk2(q[j8 * 8 + 6], q[j8 * 8 + 7]));
    }
  } else if (wrole == 2) {
    unsigned short* VT = (unsigned short*)(p.ws + OFF_RKVT) + (size_t)ch * 64 * 32;
#pragma unroll
    for (int t8 = 0; t8 < 4; ++t8) {
      float v[8];
#pragma unroll
      for (int q8 = 0; q8 < 8; ++q8) v[q8] = sV[(t8 * 8 + q8) * 64 + lane];
      st_wt_b128(VT + lane * 32 + t8 * 8, make_uint4(pk2(v[0], v[1]), pk2(v[2], v[3]), pk2(v[4], v[5]), pk2(v[6], v[7])));
    }
  }
#if RK_MERGED
  asm volatile("s_waitcnt vmcnt(0)" ::: "memory");
  __syncthreads();
  if (tid == 0) __hip_atomic_store((unsigned*)(p.ws + OFF_RKF) + ch, 1u, __ATOMIC_RELAXED, __HIP_MEMORY_SCOPE_AGENT);
#endif
}
DEV void phase_retpfx(const Params& p, char* smem);
DEV void phase_rkpre(const Params& p, char* smem) {
  phase_retpfx(p, smem);
  for (int it = BIDX; it < RK_NCHT; it += gridDim.x) rk_precompute(p, (it % (BATCH * 8)) * RK_NCH + it / (BATCH * 8), smem);
}

DEV bf16x8 ld_frag2(const unsigned short* p0, const unsigned short* p1) {
  const uint2 lo = *(const uint2*)p0, hi = *(const uint2*)p1;
  union { uint4 u; bf16x8 v; } x;
  x.u = make_uint4(lo.x, lo.y, hi.x, hi.y);
  return x.v;
}
DEV bf16x8 ld_frag(const unsigned short* p0) {
  union { uint4 u; bf16x8 v; } x;
  x.u = *(const uint4*)p0;
  return x.v;
}
DEV unsigned rk_flag_ld(const unsigned* f) {
#if RK_MERGED
  return __hip_atomic_load(f, __ATOMIC_RELAXED, __HIP_MEMORY_SCOPE_AGENT);
#else
  return 1u;
#endif
}
DEV void rk_flag_wait(const unsigned* f, unsigned flv) {
#if RK_MERGED
  asm volatile("" : "+v"(flv));
  unsigned fl = (unsigned)__builtin_amdgcn_readfirstlane((int)flv);
  unsigned sp = 0;
  while (fl == 0u) {
    __builtin_amdgcn_s_sleep(1);
    fl = (unsigned)__builtin_amdgcn_readfirstlane((int)__hip_atomic_load(f, __ATOMIC_RELAXED, __HIP_MEMORY_SCOPE_AGENT));
    if (++sp > (1u << 21)) break;
  }
  asm volatile("buffer_inv sc1" ::: "memory");
#endif
}
#define RK_PREFETCH(S, c_)                                                                                                      \
  {                                                                                                                             \
    const size_t chp_ = (size_t)bh * RK_NCH + (c_);                                                                             \
    _Pragma("unroll") for (int jt = 0; jt < 2; ++jt) _Pragma("unroll") for (int kb = 0; kb < 2; ++kb)                          \
        _Pragma("unroll") for (int s_ = 0; s_ < 2; ++s_) {                                                                      \
      const unsigned short* q0 = PTb + (chp_ * 64 + jt * 32 + r) * 64 + kb * 32 + 16 * s_ + 4 * hh;                             \
      pa##S[jt][kb][s_] = ld_frag2(q0, q0 + 8);                                                                                 \
    }                                                                                                                           \
    _Pragma("unroll") for (int jt = 0; jt < 2; ++jt) _Pragma("unroll") for (int ks = 0; ks < 2; ++ks)                          \
        ka##S[jt][ks] = ld_frag(KTb + (chp_ * 64 + jt * 32 + r) * 32 + 16 * ks + 8 * hh);                                       \
    _Pragma("unroll") for (int ks = 0; ks < 2; ++ks) vb##S[ks] = ld_frag(VTb + (chp_ * 64 + it * 32 + r) * 32 + 16 * ks + 8 * hh); \
  }
#define RK_STEP(S, c_)                                                                                                          \
  {                                                                                                                             \
    unsigned short* scr_ = rksc_row(p.ws, bh >> 3, bh & 7, (c_), it * 32 + r);                                                  \
    _Pragma("unroll") for (int kb = 0; kb < 2; ++kb) _Pragma("unroll") for (int g4 = 0; g4 < 4; ++g4)                          \
        *(uint2*)(scr_ + kb * 32 + 8 * g4 + 4 * hh) =                                                                           \
            make_uint2(pk2(X[kb][4 * g4], X[kb][4 * g4 + 1]), pk2(X[kb][4 * g4 + 2], X[kb][4 * g4 + 3]));                       \
    bf16x8 bh_[2][2], bl_[2][2];                                                                                                \
    _Pragma("unroll") for (int kb = 0; kb < 2; ++kb) _Pragma("unroll") for (int s_ = 0; s_ < 2; ++s_) {                        \
      union { uint4 u; bf16x8 v; } hi, lo;                                                                                      \
      unsigned hw[4], lw[4];                                                                                                    \
      _Pragma("unroll") for (int q2 = 0; q2 < 4; ++q2) {                                                                        \
        const float x0 = X[kb][8 * s_ + 2 * q2], x1 = X[kb][8 * s_ + 2 * q2 + 1];                                               \
        const unsigned hp = pk2(x0, x1);                                                                                        \
        hw[q2] = hp;                                                                                                            \
        lw[q2] = pk2(x0 - bf2f((unsigned short)(hp & 0xFFFF)), x1 - bf2f((unsigned short)(hp >> 16)));                          \
      }                                                                                                                         \
      hi.u = make_uint4(hw[0], hw[1], hw[2], hw[3]); lo.u = make_uint4(lw[0], lw[1], lw[2], lw[3]);                             \
      bh_[kb][s_] = hi.v; bl_[kb][s_] = lo.v;                                                                                   \
    }                                                                                                                           \
    f32x16 acc[2];                                                                                                              \
    _Pragma("unroll") for (int jt = 0; jt < 2; ++jt) {                                                                          \
      _Pragma("unroll") for (int i = 0; i < 16; ++i) acc[jt][i] = 0.f;                                                          \
      _Pragma("unroll") for (int kb = 0; kb < 2; ++kb) _Pragma("unroll") for (int s_ = 0; s_ < 2; ++s_) {                      \
        acc[jt] = __builtin_amdgcn_mfma_f32_32x32x16_bf16(pa##S[jt][kb][s_], bh_[kb][s_], acc[jt], 0, 0, 0);                    \
        acc[jt] = __builtin_amdgcn_mfma_f32_32x32x16_bf16(pa##S[jt][kb][s_], bl_[kb][s_], acc[jt], 0, 0, 0);                    \
      }                                                                                                                         \
      _Pragma("unroll") for (int ks = 0; ks < 2; ++ks)                                                                          \
          acc[jt] = __builtin_amdgcn_mfma_f32_32x32x16_bf16(ka##S[jt][ks], vb##S[ks], acc[jt], 0, 0, 0);                        \
    }                                                                                                                           \
    if ((c_) + 2 < RK_NCH) {                                                                                                    \
      rk_flag_wait(RKFb + (c_) + 2, fl##S);                                                                                     \
      fl##S = rk_flag_ld(RKFb + ((c_) + 4 < RK_NCH ? (c_) + 4 : RK_NCH - 1));          \
      RK_PREFETCH(S, (c_) + 2);                                                                                                 \
    }                                                                                                                           \
    X[0] = acc[0]; X[1] = acc[1];                                                                                               \
  }
DEV void rk_chain(const Params& p, int bh) {
  const int tid = TIDX, lane = tid & 63, wave = tid >> 6;
  if (wave >= 2) return;
  const int r = lane & 31, hh = lane >> 5, it = wave;
  const unsigned short* PTb = (const unsigned short*)(p.ws + OFF_RKPT);
  const unsigned short* KTb = (const unsigned short*)(p.ws + OFF_RKKT);
  const unsigned short* VTb = (const unsigned short*)(p.ws + OFF_RKVT);
  const unsigned* RKFb = (const unsigned*)(p.ws + OFF_RKF) + (size_t)bh * RK_NCH;
  f32x16 X[2];
#pragma unroll
  for (int kb = 0; kb < 2; ++kb)
#pragma unroll
    for (int i = 0; i < 16; ++i) X[kb][i] = 0.f;
  bf16x8 paA[2][2][2], kaA[2][2], vbA[2], paB[2][2][2], kaB[2][2], vbB[2];
  rk_flag_wait(RKFb, rk_flag_ld(RKFb));
  RK_PREFETCH(A, 0);
  rk_flag_wait(RKFb + 1, rk_flag_ld(RKFb + 1));
  RK_PREFETCH(B, 1);
  unsigned flA = rk_flag_ld(RKFb + 2), flB = rk_flag_ld(RKFb + 3);
  for (int c = 0; c < RK_NCH; c += 2) {
    RK_STEP(A, c);
    if (c + 1 < RK_NCH) RK_STEP(B, c + 1);
  }
}
DEV void rk_output(const Params& p, int item) {
  const int tid = TIDX, lane = tid & 63, wave = tid >> 6;
  const int ch = item * 4 + wave;
  const int c = ch % RK_NCH, bhh = ch / RK_NCH, h = bhh & 7, b = bhh >> 3;
  const int r = lane & 31, hh = lane >> 5;
  const unsigned short* RT = (const unsigned short*)(p.ws + OFF_RKRT) + (size_t)ch * 32 * 64;
  const unsigned short* AT = (const unsigned short*)(p.ws + OFF_RKAT) + (size_t)ch * 32 * 32;
  const unsigned short* VT = (const unsigned short*)(p.ws + OFF_RKVT) + (size_t)ch * 64 * 32;
  f32x16 acc[2];
#pragma unroll
  for (int i2 = 0; i2 < 2; ++i2)
#pragma unroll
    for (int i = 0; i < 16; ++i) acc[i2][i] = 0.f;
#pragma unroll
  for (int ks = 0; ks < 4; ++ks) {
    const bf16x8 a = ld_frag(RT + r * 64 + 16 * ks + 8 * hh);
#pragma unroll
    for (int i2 = 0; i2 < 2; ++i2) acc[i2] = __builtin_amdgcn_mfma_f32_32x32x16_bf16(a, ld_frag(rksc_row(p.ws, b, h, c, i2 * 32 + r) + 16 * ks + 8 * hh), acc[i2], 0, 0, 0);
  }
#pragma unroll
  for (int ks = 0; ks < 2; ++ks) {
    const bf16x8 a = ld_frag(AT + r * 32 + 16 * ks + 8 * hh);
#pragma unroll
    for (int i2 = 0; i2 < 2; ++i2) acc[i2] = __builtin_amdgcn_mfma_f32_32x32x16_bf16(a, ld_frag(VT + (i2 * 32 + r) * 32 + 16 * ks + 8 * hh), acc[i2], 0, 0, 0);
  }
  float* Yo = (float*)(p.ws + OFF_MIX);
  const size_t tok0 = (size_t)b * SEQ_LEN + (size_t)c * RK_T;
#pragma unroll
  for (int i2 = 0; i2 < 2; ++i2)
#pragma unroll
    for (int i = 0; i < 16; ++i) {
      const int t = (i & 3) + 8 * (i >> 2) + 4 * hh;
      Yo[(tok0 + t) * 1024 + h * 64 + i2 * 32 + r] = acc[i2][i];
    }
}
#define OFF_RWG OFF_RWKK
DEV void phase_rkout(const Params& p, char* smem) {
  {
    const float* GLO = (const float*)(p.ws + OFF_GLO);
    const float* g_up = p.in[I_RW_G_UP];
    float* G = (float*)(p.ws + OFF_RWG);
    for (int t = BIDX; t < (NTOK / GEMM_BM) * 4; t += gridDim.x) {
      const int m0 = (t >> 2) * GEMM_BM, n0 = (t & 3) * 128;
      gemm_tile<false>(
          [&](int r) { return (const void*)(GLO + (size_t)(m0 + r) * 128); },
          [&](int c) { return g_up + n0 + c; }, 512, 128,
          [&](int row, int col, float v0, float v1) {
            const size_t o = (size_t)(m0 + row) * 512 + n0 + col;
            G[o] = v0; G[o + 32] = v1;
          },
          smem);
    }
  }
  for (int it = BIDX; it < RK_NCHT / 4; it += gridDim.x) rk_output(p, it);
}

#define P12_SCAN_ITEMS (BATCH * 8 * 4)
#define P12_RET_ITEMS (BATCH * 4 * RET_NC)
#define P12_SCAN_SMEM ((2 * (16 * 5 * 64 + 16 * 16) + 16 * 16) * 4)
#define P12_RET_SMEM ((64 * 72 + 2 * 64 * 68) * 2)
#define P12_SMEM (P12_SCAN_SMEM > P12_RET_SMEM ? P12_SCAN_SMEM : P12_RET_SMEM)
DEV float sum16(float v) {
#ifdef CPU_EMU
  return emu_sum16(v);
#else
  int x;
  x = __builtin_amdgcn_update_dpp(0, __builtin_bit_cast(int, v), 0xB1, 0xF, 0xF, false); v += __builtin_bit_cast(float, x);
  x = __builtin_amdgcn_update_dpp(0, __builtin_bit_cast(int, v), 0x4E, 0xF, 0xF, false); v += __builtin_bit_cast(float, x);
  x = __builtin_amdgcn_update_dpp(0, __builtin_bit_cast(int, v), 0x141, 0xF, 0xF, false); v += __builtin_bit_cast(float, x);
  x = __builtin_amdgcn_update_dpp(0, __builtin_bit_cast(int, v), 0x140, 0xF, 0xF, false); v += __builtin_bit_cast(float, x);
  return v;
#endif
}
DEV void p12_scan(const Params& p, int item, char* smem) {
  const int rq = item & 3, h = (item >> 2) & 7, b = item >> 5;
  const int tid = TIDX, rl = tid >> 4, cg = tid & 15;
  const float* ARR[5] = {(const float*)(p.ws + OFF_RWW), (const float*)(p.ws + OFF_RWK), (const float*)(p.ws + OFF_RWKK),
                         (const float*)(p.ws + OFF_RWA), p.out + (size_t)NTOK * 512};
  const float* RWV = p.out;
  float* Yo = (float*)(p.ws + OFF_MIX);
  float* buf = (float*)smem;
  float* vbuf = buf + 2 * 16 * 5 * 64;
  float* ybuf = vbuf + 2 * 16 * 16;
  float S[4] = {0.f, 0.f, 0.f, 0.f};
  float4 rg[5]; float rv;
  const int lstep = tid >> 4, lc4 = tid & 15;
  auto gload = [&](int c) {
    const size_t o = ((size_t)b * SEQ_LEN + c * 16 + lstep) * 512 + h * 64;
#pragma unroll
    for (int a = 0; a < 5; ++a) rg[a] = ld4(ARR[a] + o + lc4 * 4);
    rv = RWV[o + rq * 16 + lc4];
  };
  auto sstore = [&](int bi) {
#pragma unroll
    for (int a = 0; a < 5; ++a) st4(buf + ((bi * 16 + lstep) * 5 + a) * 64 + lc4 * 4, rg[a]);
    vbuf[(bi * 16 + lstep) * 16 + lc4] = rv;
  };
  __syncthreads();
  gload(0);
  sstore(0);
  __syncthreads();
  const int NCH = SEQ_LEN / 16;
  for (int c = 0; c < NCH; ++c) {
    if (c + 1 < NCH) gload(c + 1);
    const float* cb = buf + (c & 1) * 16 * 5 * 64;
    const float* cv = vbuf + (c & 1) * 16 * 16;
    float4 cw = ld4(cb + 0 * 64 + cg * 4), ck = ld4(cb + 1 * 64 + cg * 4), ckk = ld4(cb + 2 * 64 + cg * 4),
           cka = ld4(cb + 3 * 64 + cg * 4), cr = ld4(cb + 4 * 64 + cg * 4);
    float cvv = cv[rl];
#pragma unroll
    for (int s = 0; s < 16; ++s) {
      const float4 w = cw, k = ck, kk = ckk, ka = cka, r = cr;
      const float v = cvv;
      if (s < 15) {
        cw = ld4(cb + ((s + 1) * 5 + 0) * 64 + cg * 4); ck = ld4(cb + ((s + 1) * 5 + 1) * 64 + cg * 4);
        ckk = ld4(cb + ((s + 1) * 5 + 2) * 64 + cg * 4); cka = ld4(cb + ((s + 1) * 5 + 3) * 64 + cg * 4);
        cr = ld4(cb + ((s + 1) * 5 + 4) * 64 + cg * 4); cvv = cv[(s + 1) * 16 + rl];
      }
      float sa = (S[0] * kk.x + S[1] * kk.y) + (S[2] * kk.z + S[3] * kk.w);
      sa = -sum16(sa);
      S[0] = S[0] * w.x + (sa * ka.x + v * k.x);
      S[1] = S[1] * w.y + (sa * ka.y + v * k.y);
      S[2] = S[2] * w.z + (sa * ka.z + v * k.z);
      S[3] = S[3] * w.w + (sa * ka.w + v * k.w);
      float y = (S[0] * r.x + S[1] * r.y) + (S[2] * r.z + S[3] * r.w);
      y = sum16(y);
      if (cg == 0) ybuf[s * 16 + rl] = y;
      asm volatile("" ::: "memory");
    }
    __syncthreads();
    if (c + 1 < NCH) sstore((c + 1) & 1);
    Yo[((size_t)b * SEQ_LEN + c * 16 + lstep) * 1024 + h * 64 + rq * 16 + lc4] = ybuf[lstep * 16 + lc4];
    __syncthreads();
  }
}
struct RetSmem { unsigned short k[64][72]; unsigned short vt[2][64][68]; };
#define RETPFX_ITEMS (BATCH * 4 * 64 * 128 / NTHREADS)
DEV void ret_prefix(const Params& p, int item) {
  const int gi = item * NTHREADS + TIDX;
  const int bh4 = gi >> 13, idx = gi & 8191;
  const float G = exp2f(128.f * ret_log2gamma(bh4 & 3));
  float* KV = (float*)(p.ws + OFF_RETKV) + (size_t)bh4 * RET_NC * 8192 + idx;
  float st = 0.f;
  int c = 0;
  for (; c + 8 <= RET_NC; c += 8) {
    float e[8];
#pragma unroll
    for (int q = 0; q < 8; ++q) e[q] = KV[(size_t)(c + q) * 8192];
#pragma unroll
    for (int q = 0; q < 8; ++q) { KV[(size_t)(c + q) * 8192] = st; st = st * G + e[q]; }
  }
  for (; c < RET_NC; ++c) { const float e = KV[(size_t)c * 8192]; KV[(size_t)c * 8192] = st; st = st * G + e; }
}
DEV void phase_retpfx(const Params& p, char* smem) {
  for (int it = BIDX; it < RETPFX_ITEMS; it += gridDim.x) ret_prefix(p, it);
}
DEV void p12_ret(const Params& p, int item, char* smem) {
  RetSmem* sm = (RetSmem*)smem;
  const int c = item % RET_NC, h = (item / RET_NC) & 3, b = item / (RET_NC * 4);
  const int tid = TIDX, lane = tid & 63, wave = tid >> 6;
  const int cidx = lane & 31, hh = lane >> 5;
  const int qi = wave * 32 + cidx;
  const float* H2 = (const float*)(p.ws + OFF_H2);
  const float lg = ret_log2gamma(h);
  const size_t tok0 = (size_t)b * SEQ_LEN + c * 128;
  bf16x8 qf[4], qfs[4];
  {
    const float* qr = H2 + (tok0 + qi) * 1536 + h * 64;
    const float qs = exp2f((float)(qi + 1) * lg);
#pragma unroll
    for (int ks = 0; ks < 4; ++ks) {
      const float4 a0 = ld4(qr + ks * 16 + hh * 8), a1 = ld4(qr + ks * 16 + hh * 8 + 4);
      const float v[8] = {a0.x, a0.y, a0.z, a0.w, a1.x, a1.y, a1.z, a1.w};
#pragma unroll
      for (int j = 0; j < 8; ++j) { qf[ks][j] = (short)f2bf(v[j]); qfs[ks][j] = (short)f2bf(v[j] * qs); }
    }
  }
  f32x16 o[4], s[2];
#pragma unroll
  for (int mt = 0; mt < 4; ++mt)
#pragma unroll
    for (int i = 0; i < 16; ++i) o[mt][i] = 0.f;
  {
    const float* KV0 = (const float*)(p.ws + OFF_RETKV) + (size_t)((b * 4 + h) * RET_NC) * 64 * 128;
#pragma unroll
    for (int eh = 0; eh < 2; ++eh) {
      __syncthreads();
      {
        const int el = tid & 63, d0 = tid >> 6;
        float stv[16];
#pragma unroll
        for (int i = 0; i < 16; ++i) stv[i] = KV0[(size_t)c * 64 * 128 + (d0 + 4 * i) * 128 + eh * 64 + el];
#pragma unroll
        for (int i = 0; i < 16; ++i) sm->k[el][d0 + 4 * i] = f2bf(stv[i]);
      }
      __syncthreads();
      qk_tile(sm->k, qfs, s, lane);
#pragma unroll
      for (int i = 0; i < 16; ++i) { o[eh * 2][i] += s[0][i]; o[eh * 2 + 1][i] += s[1][i]; }
    }
  }
#pragma unroll 1
  for (int kt = 0; kt < 2; ++kt) {
    __syncthreads();
    {
      const int row = tid >> 2, seg = tid & 3;
      const float* kr = H2 + (tok0 + kt * 64 + row) * 1536 + 256 + h * 64 + seg * 16;
      const float4 a0 = ld4(kr), a1 = ld4(kr + 4), a2 = ld4(kr + 8), a3 = ld4(kr + 12);
      *(uint4*)&sm->k[row][seg * 16] = make_uint4(pk2(a0.x, a0.y), pk2(a0.z, a0.w), pk2(a1.x, a1.y), pk2(a1.z, a1.w));
      *(uint4*)&sm->k[row][seg * 16 + 8] = make_uint4(pk2(a2.x, a2.y), pk2(a2.z, a2.w), pk2(a3.x, a3.y), pk2(a3.z, a3.w));
#pragma unroll
      for (int q = 0; q < 8; ++q) {
        const int f = tid + 256 * q;
        const int key = f >> 5, d4 = (f & 31) * 4;
        const float4 v = ld4(H2 + (tok0 + kt * 64 + key) * 1536 + 512 + h * 128 + d4);
        unsigned short(*vt)[68] = sm->vt[d4 >> 6];
        const int dl = d4 & 63;
        vt[dl][key] = f2bf(v.x); vt[dl + 1][key] = f2bf(v.y); vt[dl + 2][key] = f2bf(v.z); vt[dl + 3][key] = f2bf(v.w);
      }
    }
    __syncthreads();
    if (kt * 64 <= wave * 32 + 31) {
      qk_tile(sm->k, qf, s, lane);
#pragma unroll
      for (int ks2 = 0; ks2 < 2; ++ks2)
#pragma unroll
        for (int i = 0; i < 16; ++i) {
          const int kj = kt * 64 + ks2 * 32 + (i & 3) + 8 * (i >> 2) + 4 * hh;
          s[ks2][i] = kj <= qi ? s[ks2][i] * exp2f((float)(qi - kj) * lg) : 0.f;
        }
      pv_tile(sm->vt[0], s, *(f32x16(*)[2])&o[0], lane);
      pv_tile(sm->vt[1], s, *(f32x16(*)[2])&o[2], lane);
    }
  }
  float s1 = 0.f;
#pragma unroll
  for (int mt = 0; mt < 4; ++mt)
#pragma unroll
    for (int i = 0; i < 16; ++i) s1 += o[mt][i];
  s1 += __shfl_xor(s1, 32);
  const float mu = s1 * (1.f / 128.f);
  float s2 = 0.f;
#pragma unroll
  for (int mt = 0; mt < 4; ++mt)
#pragma unroll
    for (int i = 0; i < 16; ++i) { const float d = o[mt][i] - mu; s2 += d * d; }
  s2 += __shfl_xor(s2, 32);
  const float rstd = rsqrtf(s2 * (1.f / 128.f) + 1e-5f);
  float* MIX = (float*)(p.ws + OFF_MIX);
  const float* gate = H2 + (tok0 + qi) * 1536 + 1024 + h * 128;
  float* dst = MIX + (tok0 + qi) * 1024 + 512 + h * 128;
  const float* lgam = p.in[I_RET_LN_G] + h * 128;
  const float* lbet = p.in[I_RET_LN_B] + h * 128;
#pragma unroll
  for (int mt = 0; mt < 4; ++mt)
#pragma unroll
    for (int g4 = 0; g4 < 4; ++g4) {
      const int dv = mt * 32 + 8 * g4 + 4 * hh;
      const float4 gv = ld4(lgam + dv), bv = ld4(lbet + dv), gt = ld4(gate + dv);
      float4 ov;
      ov.x = siluf_(gt.x) * ((o[mt][4 * g4] - mu) * rstd * gv.x + bv.x);
      ov.y = siluf_(gt.y) * ((o[mt][4 * g4 + 1] - mu) * rstd * gv.y + bv.y);
      ov.z = siluf_(gt.z) * ((o[mt][4 * g4 + 2] - mu) * rstd * gv.z + bv.z);
      ov.w = siluf_(gt.w) * ((o[mt][4 * g4 + 3] - mu) * rstd * gv.w + bv.w);
      st4(dst + dv, ov);
    }
}
DEV void phase_p12(const Params& p, char* smem) {
  const int G = gridDim.x;
  const int bid = BIDX;
  if (bid < BATCH * 8 && G > BATCH * 8) {
    rk_chain(p, bid);
  } else if (G >= 8 * BATCH * 8) {
    const int Gh = G >> 1, NC = BATCH * 8;
    if (bid >= Gh && bid < Gh + NC) return;
    const int w = bid - NC - (bid >= Gh ? NC : 0);
#if RK_MERGED
    if ((G & 15) == 0 && BATCH * 8 == 16) {
      const int x = bid & 7, m = bid >> 3;
      const int rank = m - 2 - (m >= (Gh >> 3) ? 2 : 0), nprod = (G >> 3) - 4;
      for (int k = rank; k < 2 * RK_NCH; k += nprod) rk_precompute(p, (x + 8 * (k & 1)) * RK_NCH + (k >> 1), smem);
    } else {
      for (int it = w; it < RK_NCHT; it += G - 2 * NC) rk_precompute(p, (it % NC) * RK_NCH + it / NC, smem);
    }
#endif
    for (int it = w; it < P12_RET_ITEMS; it += G - 2 * NC) p12_ret(p, it, smem);
  } else if (G > BATCH * 8) {
    for (int it = bid - BATCH * 8; it < P12_RET_ITEMS; it += G - BATCH * 8) p12_ret(p, it, smem);
  } else {
    for (int it = bid; it < BATCH * 8 + P12_RET_ITEMS; it += G) {
      if (it < BATCH * 8) rk_chain(p, it);
      else p12_ret(p, it - BATCH * 8, smem);
    }
  }
}

#define P13_SMEM (RWP_T * 128 * 4)
DEV void phase_p13(const Params& p, char* smem) {
  const int tid = TIDX;
  const float* Hc = (const float*)(p.ws + OFF_H);
  const float* mu = p.in[I_RW_MU];
  const float* GLO = (const float*)(p.ws + OFF_GLO);
  float* sl = (float*)smem;
  float* MIX = (float*)(p.ws + OFF_MIX);
  const float* RWK = (const float*)(p.ws + OFF_RWK); const float* RWR = p.out + (size_t)NTOK * 512; const float* RWV = p.out;
  const float* G = (const float*)(p.ws + OFF_RWG);
  for (int it = BIDX; it < NTOK / RWP_T; it += gridDim.x) {
#pragma unroll
    for (int cc = 0; cc < 2; ++cc) {
      const int c = tid + 256 * cc;
      const float lng = p.in[I_RW_LN_G][c], lnb = p.in[I_RW_LN_B][c], rk = p.in[I_RW_R_K][c];
#pragma unroll 4
      for (int tt = 0; tt < RWP_T; ++tt) {
        const size_t tok = (size_t)it * RWP_T + tt;
        const float y = MIX[tok * 1024 + c];
        const float m = wave_sum(y) * (1.f / 64.f);
        const float d = y - m;
        const float var = wave_sum(d * d) * (1.f / 64.f);
        const float yn = d * rsqrtf(var + 64e-5f) * lng + lnb;
        const float r = RWR[tok * 512 + c], k = RWK[tok * 512 + c], v = RWV[tok * 512 + c];
        const float bonus = wave_sum(r * k * rk) * v;
        MIX[tok * 1024 + c] = (yn + bonus) * G[tok * 512 + c];
      }
    }
  }
}

#define NPHASES 20
#define SMEM_BYTES 53248
DEV void run_phase(const Params& p, int ph, char* smem) {
  switch (ph) {
    case 0: phase_gemm_in<0>(p, smem); break;
    case 1: phase_p1(p, smem); break;
    case 2: phase_p2(p, smem); break;
    case 3: phase_glu(p, smem); break;
    case 4: phase_outproj<0>(p, smem); break;
    case 5: phase_ln_router<0>(p, smem); break;
    case 6: phase_lists_shup<0>(p, smem); break;
    case 7: phase_routed_up<0>(p, smem); break;
    case 8: phase_down<0>(p, smem); break;
    case 9: phase_combine<0>(p, smem); break;
    case 10: phase_gemm_in<1>(p, smem); break;
    case 11: phase_p11(p, smem); break;
    case 12: phase_p12(p, smem); break;
    case 13: phase_p13(p, smem); break;
    case 14: phase_outproj<1>(p, smem); break;
    case 15: phase_ln_router<1>(p, smem); break;
    case 16: phase_lists_shup<1>(p, smem); break;
    case 17: phase_routed_up<1>(p, smem); break;
    case 18: phase_down<1>(p, smem); break;
    case 19: phase_combine<1>(p, smem); break;
    case 20: phase_p1b(p, smem); break;
    case 21: phase_rkpre(p, smem); break;
    case 22: phase_rkout(p, smem); break;
    case 24: phase_retpfx(p, smem); break;
  }
}
static_assert(P1_SMEM <= SMEM_BYTES, "smem");
static_assert(P1_PREP_SMEM <= SMEM_BYTES, "smem");
static_assert(P2_SMEM <= SMEM_BYTES, "smem");
static_assert(P5_SMEM <= SMEM_BYTES, "smem");
static_assert(P7_SMEM <= SMEM_BYTES, "smem");
static_assert(P12_SMEM <= SMEM_BYTES, "smem");
static_assert(RKPRE_SMEM <= SMEM_BYTES, "smem");
static_assert(OFF_HS + (size_t)NTOK * 256 * 2 <= OFF_X1, "layout");

#ifndef CPU_EMU
template <int PH>
__global__ void __launch_bounds__(NTHREADS) phase_kernel(Params p) {
  __shared__ __attribute__((aligned(16))) char smem[SMEM_BYTES];
  run_phase(p, PH, smem);
}
template <int PH>
static void launch_phases(const Params& p, hipStream_t stream) {
  phase_kernel<PH><<<dim3(1024), dim3(NTHREADS), 0, stream>>>(p);
  if constexpr (PH + 1 < NPHASES) launch_phases<PH + 1>(p, stream);
}
#if MEGA
#define XB_TMO      128
#define XB_XCNT(j)  (256  + 64 * (j))
#define XB_XSUB(j)  (1280 + 64 * (j))
#define XB_XGEN(j)  (2304 + 64 * (j))
#define XB_TOP      3328
#define XB_TOPGEN   3392
#define XCD_BAR_WORDS 3456
#define XB_SPIN_CAP (1u << 18)
#define LAS __attribute__((address_space(3)))

__device__ __forceinline__ unsigned xb_ld(unsigned* p)              { return __hip_atomic_load(p, __ATOMIC_RELAXED, __HIP_MEMORY_SCOPE_AGENT); }
__device__ __forceinline__ unsigned xb_add(unsigned* p, unsigned v) { return __hip_atomic_fetch_add(p, v, __ATOMIC_RELAXED, __HIP_MEMORY_SCOPE_AGENT); }
__device__ __forceinline__ unsigned xb_xcc_id() { return (unsigned)__builtin_amdgcn_s_getreg((3 << 11) | 20) & 0xFu; }
#define XB_SPIN(cond, bar) do { unsigned _sp = 0; while (cond) { __builtin_amdgcn_s_sleep(1); \
    if ((++_sp & 255u) == 0u) { if (xb_ld(&(bar)[XB_TMO])) break; if (_sp > XB_SPIN_CAP) { atomicAdd(&(bar)[XB_TMO], 1u); break; } } } } while (0)

struct XcdBarrier {
    unsigned* bar; unsigned x;
    volatile LAS unsigned* st;
};

__device__ __forceinline__ XcdBarrier xcd_barrier_post(unsigned* bar, volatile LAS unsigned* st) {
    XcdBarrier b; b.bar = bar; b.x = xb_xcc_id(); b.st = st;
    if (threadIdx.x == 0) (void)xb_add(&bar[XB_XCNT(b.x)], 1u);
    return b;
}
__device__ __forceinline__ void xcd_barrier_complete(unsigned* bar, unsigned x, unsigned& nloc, unsigned& nx) {
    const unsigned G = gridDim.x * gridDim.y * gridDim.z;
    unsigned sum, cnt, mine, sp = 0u;
    for (;;) {
        sum = 0u; cnt = 0u; mine = 0u;
#pragma unroll
        for (unsigned j = 0; j < 16; ++j) { const unsigned c = xb_ld(&bar[XB_XCNT(j)]); sum += c; cnt += (c > 0u) ? 1u : 0u; mine = (j == x) ? c : mine; }
        if (sum == G) break;
        __builtin_amdgcn_s_sleep(1);
        if ((++sp & 255u) == 0u) { if (xb_ld(&bar[XB_TMO])) break; if (sp > XB_SPIN_CAP) { atomicAdd(&bar[XB_TMO], 1u); break; } }
    }
    nloc = mine > 0u ? mine : 1u; nx = cnt > 0u ? cnt : 1u;
}

__device__ __forceinline__ void xcd_barrier(const XcdBarrier& b) {
    asm volatile("s_waitcnt vmcnt(0)" ::: "memory");
    __syncthreads();
    if (threadIdx.x == 0) {
        unsigned* bar = b.bar;
        __builtin_amdgcn_s_waitcnt(0);
        unsigned nloc = b.st[0], nx = b.st[1];
        if (nloc == 0u) { xcd_barrier_complete(bar, b.x, nloc, nx); b.st[0] = nloc; b.st[1] = nx; }
        const unsigned old = xb_add(&bar[XB_XSUB(b.x)], 1u);
        const unsigned gen = old / nloc;
        if (old + 1u == (gen + 1u) * nloc) {
            __builtin_amdgcn_fence(__ATOMIC_RELEASE, "agent");
            asm volatile("s_waitcnt vmcnt(0)" ::: "memory");
            const unsigned og = xb_add(&bar[XB_TOP], 1u);
            const unsigned tg = og / nx;
            if (og + 1u == (tg + 1u) * nx) xb_add(&bar[XB_TOPGEN], 1u);
            else XB_SPIN(xb_ld(&bar[XB_TOPGEN]) == tg, bar);
            __builtin_amdgcn_fence(__ATOMIC_ACQUIRE, "agent");
            xb_add(&bar[XB_XGEN(b.x)], 1u);
            asm volatile("s_waitcnt vmcnt(0)" ::: "memory");
        } else {
            XB_SPIN(xb_ld(&bar[XB_XGEN(b.x)]) == gen, bar);
            __builtin_amdgcn_fence(__ATOMIC_ACQUIRE, "agent");
            asm volatile("s_waitcnt vmcnt(0)" ::: "memory");
        }
    }
    __syncthreads();
}


__global__ void __launch_bounds__(NTHREADS, 2) mega_kernel(Params p) {
  __shared__ __attribute__((aligned(16))) char smem[SMEM_BYTES];
  unsigned* bar = (unsigned*)(p.ws + OFF_BAR);
  __shared__ uint4 xb_words;
  if (threadIdx.x == 0) xb_words = make_uint4(0u, 0u, 0u, 0u);
  __syncthreads();
  XcdBarrier xb = xcd_barrier_post(bar, (volatile LAS unsigned*)&xb_words);
  if (p.ws == nullptr) cg::this_grid().sync();
  typedef const __attribute__((address_space(4))) Params* KParams;
#define PH_(n) { KParams kp = (KParams)__builtin_amdgcn_kernarg_segment_ptr(); asm volatile("" : "+s"(kp)); const Params lp = *(const Params*)kp; run_phase(lp, n, smem); } xcd_barrier(xb);
  PH_(0) PH_(1) PH_(20) PH_(2) PH_(3) PH_(4) PH_(5) PH_(6) PH_(7) PH_(8) PH_(9)
  PH_(10) PH_(11) PH_(24) PH_(12) PH_(22) PH_(13) PH_(14) PH_(15) PH_(16) PH_(17) PH_(18)
  { KParams kp = (KParams)__builtin_amdgcn_kernarg_segment_ptr(); asm volatile("" : "+s"(kp)); const Params lp = *(const Params*)kp; run_phase(lp, 19, smem); }
}

#endif

extern "C" void kernel_launch(void* const* d_in, const int* in_sizes, int n_in, void* d_out, int out_size, void* d_ws, size_t ws_size,
                              hipStream_t stream) {
  Params p;
  for (int i = 0; i < N_INPUTS; ++i) p.in[i] = (const float*)d_in[i];
  p.out = (float*)d_out;
  p.ws = (char*)d_ws;
#if MEGA
  static int grid_blocks = 0;
  if (!grid_blocks) {
    int dev = 0, cus = 0, per_cu = 0;
    hipGetDevice(&dev);
    hipDeviceGetAttribute(&cus, hipDeviceAttributeMultiprocessorCount, dev);
    hipOccupancyMaxActiveBlocksPerMultiprocessor(&per_cu, mega_kernel, NTHREADS, 0);
    if (per_cu > 2) per_cu = 2;
    grid_blocks = cus * per_cu;
  }
  hipMemsetAsync((char*)d_ws + OFF_BAR, 0, 16384, stream);
  void* args[] = {&p};
  hipError_t e = hipLaunchCooperativeKernel((void*)mega_kernel, dim3(grid_blocks), dim3(NTHREADS), args, 0, stream);
  if (e != hipSuccess) fprintf(stderr, "cooperative launch failed: %s (grid %d)\n", hipGetErrorString(e), grid_blocks);
#else
  launch_phases<0>(p, stream);
#endif
}
#endif
```
